# Optimizing an MI355X kernel written in HIP

```python
import math
import jax, jax.numpy as jnp
from jax import lax
import numpy as np

D_MODEL = 1024
BATCH = 32
SEQ = 2048
DEPTH = 1

MOBA_HEADS = 8
MOBA_HEAD_DIM = 64
MOBA_WIDTH = MOBA_HEADS * MOBA_HEAD_DIM
MOBA_BLOCK = 256
MOBA_TOPK = 3
MOBA_QCHUNK = 16
HGRN_HEADS = 4
HGRN_EXPAND = 128
HGRN_HEAD_DIM = 128
HGRN_WIDTH = HGRN_HEADS * HGRN_EXPAND
HGRN_CHUNK = 64
IN_SIZES = (MOBA_WIDTH, MOBA_WIDTH, MOBA_WIDTH,
            HGRN_WIDTH, HGRN_WIDTH, HGRN_WIDTH, HGRN_WIDTH,
            D_MODEL, D_MODEL)
IN_COLS = sum(IN_SIZES)
PEER_HEADS = 8
PEER_NKEYS = 128
PEER_EXPERTS = PEER_NKEYS * PEER_NKEYS
PEER_KEY_DIM = 128
PEER_HALF = PEER_KEY_DIM // 2
PEER_TOPK = 16
PEER_TOKEN_CHUNK = 512
DEEPNORM_ALPHA = (2.0 * DEPTH) ** 0.25
DEEPNORM_BETA = (8.0 * DEPTH) ** -0.25
LN_EPS = 1e-5
RMS_EPS = 1e-6

kernel_name = "hybrid_moba_hgrn2_peer_deepnorm_adaln"

F32 = jnp.float32


def layer_norm(x, g, b):
    xf = x.astype(F32)
    mu = jnp.mean(xf, -1, keepdims=True)
    var = jnp.mean(jnp.square(xf - mu), -1, keepdims=True)
    y = (xf - mu) * lax.rsqrt(var + LN_EPS)
    return (y * g.astype(F32) + b.astype(F32)).astype(x.dtype)


def alibi_slopes(n_heads):
    return jnp.exp2(-8.0 * jnp.arange(1, n_heads + 1, dtype=F32) / n_heads)


def moba_attention(q, k, v):
    B, S, H, dh = q.shape
    BS = MOBA_BLOCK
    nb = -(-S // BS)
    s_pad = nb * BS
    pad = ((0, 0), (0, s_pad - S), (0, 0), (0, 0))
    q = jnp.pad(q, pad).transpose(0, 2, 1, 3) * (dh ** -0.5)
    k = jnp.pad(k, pad).transpose(0, 2, 1, 3)
    v = jnp.pad(v, pad).transpose(0, 2, 1, 3)
    kb = k.reshape(B, H, nb, BS, dh)
    vb = v.reshape(B, H, nb, BS, dh)
    kmean = jnp.mean(kb.astype(F32), axis=3)
    gate = jnp.einsum('bhsd,bhnd->bhsn', q.astype(F32), kmean)
    qblk = jnp.arange(s_pad) // BS
    past = jnp.arange(nb)[None, :] < qblk[:, None]
    gate = jnp.where(past, gate, -jnp.inf)
    topk = min(MOBA_TOPK, nb)
    gval, gidx = lax.top_k(gate, topk)
    gvalid = jnp.isfinite(gval)
    slopes = alibi_slopes(H)
    bi = jnp.arange(B)[:, None, None, None]
    hi = jnp.arange(H)[None, :, None, None]
    offs = jnp.arange(BS)
    QC = MOBA_QCHUNK
    n_q = s_pad // QC

    def chunk(ci):
        p = ci * QC
        qc = lax.dynamic_slice_in_dim(q, p, QC, axis=2)
        idx = lax.dynamic_slice_in_dim(gidx, p, QC, axis=2)
        val = lax.dynamic_slice_in_dim(gvalid, p, QC, axis=2)
        qpos = p + jnp.arange(QC)
        j = p // BS
        k_own = lax.dynamic_index_in_dim(kb, j, axis=2, keepdims=False)
        v_own = lax.dynamic_index_in_dim(vb, j, axis=2, keepdims=False)
        dist_own = (qpos[:, None] - (j * BS + offs)[None, :]).astype(F32)
        s_own = (jnp.einsum('bhqd,bhkd->bhqk', qc, k_own).astype(F32)
                 - slopes[None, :, None, None] * dist_own[None, None])
        s_own = jnp.where(dist_own[None, None] >= 0, s_own, -jnp.inf)
        k_sel = kb[bi, hi, idx]
        v_sel = vb[bi, hi, idx]
        kpos_sel = idx[..., None] * BS + offs
        dist_sel = (qpos[None, None, :, None, None] - kpos_sel).astype(F32)
        s_sel = (jnp.einsum('bhqd,bhqnkd->bhqnk', qc, k_sel).astype(F32)
                 - slopes[None, :, None, None, None] * dist_sel)
        s_sel = jnp.where(val[..., None], s_sel, -jnp.inf)
        scores = jnp.concatenate([s_own, s_sel.reshape(B, H, QC, topk * BS)], axis=-1)
        probs = jax.nn.softmax(scores, axis=-1).astype(v.dtype)
        p_own = probs[..., :BS]
        p_sel = probs[..., BS:].reshape(B, H, QC, topk, BS)
        return (jnp.einsum('bhqk,bhkd->bhqd', p_own, v_own)
                + jnp.einsum('bhqnk,bhqnkd->bhqd', p_sel, v_sel))

    out = lax.map(chunk, jnp.arange(n_q))
    out = out.transpose(1, 0, 3, 2, 4).reshape(B, s_pad, H, dh)[:, :S]
    return out.reshape(B, S, H * dh)


def hgrn2(q, f_logit, i, g, lb, norm_g):
    B, S, _ = q.shape
    H, dk, dv, C = HGRN_HEADS, HGRN_EXPAND, HGRN_HEAD_DIM, HGRN_CHUNK
    nC = S // C

    def heads(t, d):
        return t.astype(F32).reshape(B, nC, C, H, d).transpose(0, 3, 1, 2, 4)

    lbf = lb.astype(F32)
    f = lbf + (1.0 - lbf) * jax.nn.sigmoid(f_logit.astype(F32))
    qh = heads(jax.nn.silu(q.astype(F32)), dk)
    kh = heads(1.0 - f, dk)
    lfh = heads(jnp.log(f), dk)
    vh = heads(i, dv)
    b = jnp.cumsum(lfh, axis=3)
    b_last = b[:, :, :, -1:, :]
    b_ref = b[:, :, :, C // 2:C // 2 + 1, :]
    a = jnp.einsum('bhntd,bhnsd->bhnts', qh * jnp.exp(b - b_ref), kh * jnp.exp(b_ref - b))
    causal = jnp.tril(jnp.ones((C, C), dtype=bool))
    a = jnp.where(causal, a, 0.0)
    o_intra = jnp.einsum('bhnts,bhnsv->bhntv', a, vh)
    ds = jnp.einsum('bhnsd,bhnsv->nbhdv', kh * jnp.exp(b_last - b), vh)
    decay = jnp.exp(b_last[:, :, :, 0, :]).transpose(2, 0, 1, 3)

    def step(state, inp):
        d, dsc = inp
        return d[..., None] * state + dsc, state

    s0 = jnp.zeros((B, H, dk, dv), F32)
    _, s_prev = lax.scan(step, s0, (decay, ds))
    o_inter = jnp.einsum('bhntd,nbhdv->bhntv', qh * jnp.exp(b), s_prev)
    o = (o_intra + o_inter).transpose(0, 2, 3, 1, 4).reshape(B, S, H, dv)
    o = o * lax.rsqrt(jnp.mean(o * o, axis=-1, keepdims=True) + RMS_EPS)
    o = o.reshape(B, S, H * dv) * norm_g.astype(F32) * jax.nn.silu(g.astype(F32))
    return o.astype(q.dtype)


def peer(h, wq, subkeys, u_tab, v_tab):
    B, S, D = h.shape
    T = B * S
    tc = math.gcd(T, PEER_TOKEN_CHUNK)
    H, K, NK = PEER_HEADS, PEER_TOPK, PEER_NKEYS
    hf = h.reshape(T // tc, tc, D)

    def chunk(xc):
        q = (xc @ wq).astype(F32).reshape(tc, H, 2, PEER_HALF)
        s = jnp.einsum('thpd,hpnd->thpn', q, subkeys.astype(F32))
        sv, si = lax.top_k(s, K)
        cand = (sv[:, :, 0, :, None] + sv[:, :, 1, None, :]).reshape(tc, H, K * K)
        cidx = (si[:, :, 0, :, None] * NK + si[:, :, 1, None, :]).reshape(tc, H, K * K)
        best, pos = lax.top_k(cand, K)
        eidx = jnp.take_along_axis(cidx, pos, axis=-1)
        gates = jax.nn.softmax(best, axis=-1)
        u = u_tab[eidx]
        act = jax.nn.gelu(jnp.einsum('td,thkd->thk', xc, u).astype(F32), approximate=False)
        w = (gates * act).astype(xc.dtype)
        return jnp.einsum('thk,thkd->td', w, v_tab[eidx])

    return lax.map(chunk, hf).reshape(B, S, D)


def setup_inputs(seed: int = 0) -> dict:
    key = jax.random.key(seed)
    ks = jax.random.split(key, 20)
    D, L = D_MODEL, DEPTH
    n = jax.random.normal
    return {
        'x': n(ks[0], (BATCH, SEQ, D), F32),
        'c': n(ks[1], (BATCH, D), F32),
        'w_ada': n(ks[2], (L, D, 6 * D), F32) * (0.5 * D ** -0.5),
        'b_ada': n(ks[3], (L, 6 * D), F32) * 0.01,
        'w_in': n(ks[4], (L, D, IN_COLS), F32) * D ** -0.5,
        'w_branch_a': n(ks[5], (L, MOBA_WIDTH, D), F32) * (MOBA_WIDTH ** -0.5 * DEEPNORM_BETA),
        'w_branch_b': n(ks[6], (L, HGRN_WIDTH, D), F32) * (HGRN_WIDTH ** -0.5 * DEEPNORM_BETA),
        'w_out': n(ks[7], (L, D, D), F32) * (D ** -0.5 * DEEPNORM_BETA),
        'hgrn_lb': 1.0 + 0.1 * n(ks[8], (L + 1, HGRN_WIDTH), F32),
        'hgrn_norm_g': 1.0 + 0.01 * n(ks[9], (L, HGRN_WIDTH), F32),
        'ln1_g': 1.0 + 0.01 * n(ks[10], (L, D), F32),
        'ln1_b': 0.01 * n(ks[11], (L, D), F32),
        'peer_wq': n(ks[12], (L, D, PEER_HEADS * PEER_KEY_DIM), F32) * D ** -0.5,
        'peer_subkeys': n(ks[13], (L, PEER_HEADS, 2, PEER_NKEYS, PEER_HALF), F32) * PEER_HALF ** -0.5,
        'peer_u': n(ks[14], (L, PEER_EXPERTS, D), F32) * D ** -0.5,
        'peer_v': n(ks[15], (L, PEER_EXPERTS, D), F32) * DEEPNORM_BETA,
        'ln2_g': 1.0 + 0.01 * n(ks[16], (L, D), F32),
        'ln2_b': 0.01 * n(ks[17], (L, D), F32),
    }


def reference(x, c, w_ada, b_ada, w_in, w_branch_a, w_branch_b, w_out, hgrn_lb, hgrn_norm_g,
              ln1_g, ln1_b, peer_wq, peer_subkeys, peer_u, peer_v, ln2_g, ln2_b):
    B, S, D = x.shape
    lb_all = jnp.cumsum(jax.nn.softmax(hgrn_lb.astype(F32), axis=0), axis=0)
    split_at = [int(v) for v in np.cumsum(IN_SIZES)[:-1]]
    for l in range(DEPTH):
        ada = jax.nn.silu(c) @ w_ada[l] + b_ada[l]
        sh1, sc1, gt1, sh2, sc2, gt2 = jnp.split(ada[:, None, :], 6, axis=-1)
        h = x * (1.0 + sc1) + sh1
        proj = h @ w_in[l]
        qa, ka, va, hq, hf, hi, hg, ga, gb = jnp.split(proj, split_at, axis=-1)
        mh = (B, S, MOBA_HEADS, MOBA_HEAD_DIM)
        ya = moba_attention(qa.reshape(mh), ka.reshape(mh), va.reshape(mh))
        yb = hgrn2(hq, hf, hi, hg, lb_all[l], hgrn_norm_g[l])
        mixed = (jax.nn.sigmoid(ga) * (ya @ w_branch_a[l])
                 + jax.nn.sigmoid(gb) * (yb @ w_branch_b[l]))
        x = layer_norm(DEEPNORM_ALPHA * x + gt1 * (mixed @ w_out[l]), ln1_g[l], ln1_b[l])
        h2 = x * (1.0 + sc2) + sh2
        y = peer(h2, peer_wq[l], peer_subkeys[l], peer_u[l], peer_v[l])
        x = layer_norm(DEEPNORM_ALPHA * x + gt2 * y, ln2_g[l], ln2_b[l])
    return x
```

```cpp
#include <hip/hip_runtime.h>
#include <hip/hip_cooperative_groups.h>
#include <cstdio>
#include <cstdint>
namespace cg = cooperative_groups;

#define LAS __attribute__((address_space(3)))
typedef unsigned short bf16_t;
typedef short bf16x8 __attribute__((ext_vector_type(8)));
typedef short s16x4 __attribute__((ext_vector_type(4)));
typedef float f32x2 __attribute__((ext_vector_type(2)));
typedef float f32x4 __attribute__((ext_vector_type(4)));
typedef float f32x16 __attribute__((ext_vector_type(16)));
typedef unsigned u32x2 __attribute__((ext_vector_type(2)));
typedef unsigned u32x4 __attribute__((ext_vector_type(4)));

constexpr int NB = 32, SEQ = 2048, DM = 1024, NTOK = NB * SEQ;
constexpr int INCOLS = 5632;
constexpr int NTHR = 512;
constexpr int LDS_BYTES = 147456;
constexpr float ALPHA = 1.189207115002721f;
constexpr float LN_EPS = 1e-5f, RMS_EPS = 1e-6f;
constexpr float LOG2E = 1.4426950408889634f;

constexpr size_t SZ_T512 = (size_t)NTOK * 512 * 2, SZ_T1024 = (size_t)NTOK * 1024 * 2;
constexpr size_t OFF_ADA = 0;
constexpr size_t OFF_LB = OFF_ADA + 786432;
constexpr size_t OFF_KMEAN = OFF_LB + 4096;
constexpr size_t OFF_WIN = OFF_KMEAN + 524288;
constexpr size_t OFF_WBA = OFF_WIN + (size_t)5632 * 1024 * 2;
constexpr size_t OFF_WBB = OFF_WBA + 1048576;
constexpr size_t OFF_WOUT = OFF_WBB + 1048576;
constexpr size_t OFF_WQ = OFF_WOUT + 2097152;
constexpr size_t OFF_SK = OFF_WQ + 2097152;
constexpr size_t OFF_U = OFF_SK + 262144;
constexpr size_t OFF_V = OFF_U + 33554432;
constexpr size_t OFF_EG = OFF_V + 33554432;
constexpr size_t OFF_H = OFF_EG + (size_t)NTOK * 128 * 8;
constexpr size_t OFF_QA = OFF_H + SZ_T1024;
constexpr size_t OFF_KA = OFF_QA + SZ_T512;
constexpr size_t OFF_VA = OFF_KA + SZ_T512;
constexpr size_t OFF_HQ = OFF_VA + SZ_T512;
constexpr size_t OFF_HK = OFF_HQ + SZ_T512;
constexpr size_t OFF_HI = OFF_HK + SZ_T512;
constexpr size_t OFF_HG = OFF_HI + SZ_T512;
constexpr size_t OFF_GA = OFF_HG + SZ_T512;
constexpr size_t OFF_GB = OFF_GA + SZ_T1024;
constexpr size_t WS_END = OFF_GB + SZ_T1024;

struct Params {
    const float *x, *c, *w_ada, *b_ada, *w_in, *w_ba, *w_bb, *w_out, *hgrn_lb, *hgrn_ng, *ln1_g, *ln1_b, *peer_wq, *peer_sk, *peer_u, *peer_v, *ln2_g, *ln2_b;
    float* out;
    unsigned char* ws;
};

__device__ __forceinline__ unsigned cvt_pk_bf16(float lo, float hi) { unsigned r; asm("v_cvt_pk_bf16_f32 %0, %1, %2" : "=v"(r) : "v"(lo), "v"(hi)); return r; }
__device__ __forceinline__ float bf_lo(unsigned w) { return __uint_as_float(w << 16); }
__device__ __forceinline__ float bf_hi(unsigned w) { return __uint_as_float(w & 0xffff0000u); }
__device__ __forceinline__ float sigmoidf_(float x) { return 1.0f / (1.0f + __expf(-x)); }
__device__ __forceinline__ float wave_sum(float v) {
#pragma unroll
    for (int o = 1; o < 64; o <<= 1) v += __shfl_xor(v, o);
    return v;
}
__device__ __forceinline__ int tid_opaque() { int t = threadIdx.x; asm volatile("" : "+v"(t)); return t; }
__device__ __forceinline__ int crow(int r, int hi) { return (r & 3) + 8 * (r >> 2) + 4 * hi; }
#define MFMA32(a, b, c) __builtin_amdgcn_mfma_f32_32x32x16_bf16(a, b, c, 0, 0, 0)

namespace pg8 {
constexpr int BM = 256, BK = 64, HALF = 128, HTB = HALF * BK * 2, STAGE_BYTES = 8 * HTB, NXCD = 8, WGM = 8;
__host__ __device__ __forceinline__ int lds_byte(int r, int c) { const int st = (r >> 4) * 2 + (c >> 5), rr = r & 15, cc = c & 31, ob = rr * 64 + cc * 2; return st * 1024 + (ob ^ (((ob >> 9) & 1) << 5)); }
__host__ __device__ __forceinline__ void stage_rc(int b, int& R, int& C) { const int st = b / 1024, sb = b % 1024, swz = sb ^ (((sb >> 9) & 1) << 5); R = (st >> 1) * 16 + swz / 64; C = (st & 1) * 32 + (swz % 64) / 2; }
__host__ __device__ __forceinline__ int perm32(int rho) { const int n = rho >> 4, i = rho & 15; return 8 * (i >> 2) + 4 * n + (i & 3); }

struct Unit { int pm, pn; };
struct Gemm { const bf16_t* A; const bf16_t* Bt; int M, N, K; };

struct StaticOrder {
    int nM, nN, nwg, G, c;
    __device__ void init(int M, int N, int G_, int c_) { nM = M / BM; nN = N / BM; nwg = nM * nN; G = G_; c = c_; }
    __device__ bool next(int i, Unit& u) const {
        const long L = (long)i * G + c; if (L >= nwg) return false;
        int wgid = (int)L; { const int q = nwg / NXCD, r = nwg % NXCD, xcd = wgid % NXCD, off = wgid / NXCD; wgid = (xcd < r ? xcd * (q + 1) : r * (q + 1) + (xcd - r) * q) + off; }
        const int nig = WGM * nN, gid = wgid / nig, fm = gid * WGM, gsz = (nM - fm) < WGM ? (nM - fm) : WGM;
        u.pm = fm + ((wgid % nig) % gsz); u.pn = (wgid % nig) / gsz; return true;
    }
};
struct PanelOrder {
    int pm, npn;
    __device__ bool next(int i, Unit& u) const { if (i >= npn) return false; u.pm = pm; u.pn = i; return true; }
};

template <class Epi, class Sched>
__device__ __forceinline__ void gemm_phase(LAS unsigned char* lds, const Gemm g, const Sched& S, const Epi& E) {
    const int tid = tid_opaque(), wid = __builtin_amdgcn_readfirstlane(tid >> 6), lane = tid & 63, wr = wid >> 2, wc = wid & 3, fr = lane & 15, fq = lane >> 4;
    const int K = g.K, nt = K / BK;
    unsigned voffA[2], voffB[2];
#pragma unroll
    for (int i = 0; i < 2; ++i) { int R, C; stage_rc(tid * 16 + i * 8192, R, C); const int Rb = Epi::PERM ? ((R & ~31) + perm32(R & 31)) : R;
        voffA[i] = (unsigned)(R * K + C) * 2u; voffB[i] = (unsigned)(Rb * K + C) * 2u; }
    const size_t kstep = (size_t)(BK * 2);
    const size_t hstep = (size_t)HALF * K * 2;
    const size_t tstep = 2 * hstep;
    const unsigned ldsw = (unsigned)wid * 1024u;
    const int aoff = lds_byte(wr * 64 + fr, fq * 8), boff = lds_byte(wc * 32 + fr, fq * 8);
#define PG8_SA(b, h) (((b) * 2 + (h)) * HTB)
#define PG8_SB(b, h) ((4 + (b) * 2 + (h)) * HTB)
#define PG8_STAGE(bufoff, gbase, voff) do { _Pragma("unroll") for (int _i = 0; _i < 2; ++_i) \
        __builtin_amdgcn_global_load_lds((const unsigned*)((const char*)(gbase) + (voff)[_i]), (LAS unsigned*)(lds + (bufoff) + ldsw + _i * 8192), 16, 0, 0); } while (0)
#define PG8_LDA(dst, b, h) do { _Pragma("unroll") for (int m = 0; m < 4; ++m) _Pragma("unroll") for (int k = 0; k < 2; ++k) dst[m][k] = *(const LAS bf16x8*)(lds + PG8_SA(b, h) + aoff + m * 2048 + k * 1024); } while (0)
#define PG8_LDB(dst, b, h) do { _Pragma("unroll") for (int n = 0; n < 2; ++n) _Pragma("unroll") for (int k = 0; k < 2; ++k) dst[n][k] = *(const LAS bf16x8*)(lds + PG8_SB(b, h) + boff + n * 2048 + k * 1024); } while (0)
#define PG8_MMA(ai, bj, At, Bt) do { __builtin_amdgcn_s_setprio(1); _Pragma("unroll") for (int m = 0; m < 4; ++m) _Pragma("unroll") for (int n = 0; n < 2; ++n) _Pragma("unroll") for (int k = 0; k < 2; ++k) \
        acc[ai][bj][m][n] = __builtin_amdgcn_mfma_f32_16x16x32_bf16(Bt[n][k], At[m][k], acc[ai][bj][m][n], 0, 0, 0); __builtin_amdgcn_s_setprio(0); } while (0)
#define PG8_WAIT_V(n) asm volatile("s_waitcnt vmcnt(" #n ")" ::: "memory")
#define PG8_WAIT_L(n) asm volatile("s_waitcnt lgkmcnt(" #n ")" ::: "memory")
#define PG8_BAR __builtin_amdgcn_s_barrier()
#define PG8_SCHED __builtin_amdgcn_sched_barrier(0)
    Unit cur, nxt; int ui = 0;
    if (!S.next(0, cur)) return;
    f32x4 acc[2][2][4][2];
#pragma unroll
    for (int a = 0; a < 2; ++a)
#pragma unroll
        for (int b = 0; b < 2; ++b)
#pragma unroll
            for (int m = 0; m < 4; ++m)
#pragma unroll
                for (int n = 0; n < 2; ++n) acc[a][b][m][n] = (f32x4){0.f, 0.f, 0.f, 0.f};
    bf16x8 At[4][2], B0[2][2], B1[2][2];
    const char* cA = (const char*)g.A + (size_t)cur.pm * tstep; const char* cB = (const char*)g.Bt + (size_t)cur.pn * tstep;
    PG8_STAGE(PG8_SB(0, 0), cB, voffB); PG8_STAGE(PG8_SA(0, 0), cA, voffA); PG8_STAGE(PG8_SB(0, 1), cB + hstep, voffB); PG8_STAGE(PG8_SA(0, 1), cA + hstep, voffA);
    if (wr == 1) PG8_BAR;
    PG8_WAIT_V(4); PG8_BAR;
    PG8_STAGE(PG8_SB(1, 0), cB + kstep, voffB); PG8_STAGE(PG8_SA(1, 0), cA + kstep, voffA); PG8_STAGE(PG8_SB(1, 1), cB + hstep + kstep, voffB);
    PG8_WAIT_V(6); PG8_BAR;
    for (;;) {
        const bool has_next = S.next(ui + 1, nxt);
        const char* nA = has_next ? (const char*)g.A + (size_t)nxt.pm * tstep : cA; const char* nB = has_next ? (const char*)g.Bt + (size_t)nxt.pn * tstep : cB;
        for (int t = 0; t < nt; t += 2) {
            const bool last = (t == nt - 2);
            const char* a1 = cA + (size_t)(t + 1) * kstep;
            const char* a2 = last ? nA : cA + (size_t)(t + 2) * kstep; const char* b2 = last ? nB : cB + (size_t)(t + 2) * kstep;
            const char* a3 = a2 + kstep; const char* b3 = b2 + kstep;
            PG8_LDB(B0, 0, 0); PG8_SCHED; PG8_LDA(At, 0, 0); PG8_STAGE(PG8_SA(1, 1), a1 + hstep, voffA);
            PG8_WAIT_L(8); PG8_BAR; PG8_WAIT_L(0); PG8_MMA(0, 0, At, B0); PG8_BAR; PG8_SCHED;
            PG8_LDB(B1, 0, 1); PG8_STAGE(PG8_SB(0, 0), b2, voffB);
            PG8_BAR; PG8_WAIT_L(0); PG8_MMA(0, 1, At, B1); PG8_BAR;
            PG8_LDA(At, 0, 1); PG8_STAGE(PG8_SA(0, 0), a2, voffA);
            PG8_BAR; PG8_WAIT_L(0); PG8_MMA(1, 0, At, B0); PG8_BAR; PG8_SCHED;
            PG8_STAGE(PG8_SB(0, 1), b2 + hstep, voffB);
            PG8_WAIT_V(6); PG8_BAR; PG8_MMA(1, 1, At, B1); PG8_BAR;
            PG8_LDB(B0, 1, 0); PG8_SCHED; PG8_LDA(At, 1, 0); PG8_STAGE(PG8_SA(0, 1), a2 + hstep, voffA);
            PG8_WAIT_L(8); PG8_BAR; PG8_WAIT_L(0); PG8_MMA(0, 0, At, B0); PG8_BAR; PG8_SCHED;
            PG8_LDB(B1, 1, 1); PG8_STAGE(PG8_SB(1, 0), b3, voffB);
            PG8_BAR; PG8_WAIT_L(0); PG8_MMA(0, 1, At, B1); PG8_BAR;
            PG8_LDA(At, 1, 1); PG8_STAGE(PG8_SA(1, 0), a3, voffA);
            PG8_BAR; PG8_WAIT_L(0); PG8_MMA(1, 0, At, B0); PG8_BAR; PG8_SCHED;
            PG8_STAGE(PG8_SB(1, 1), b3 + hstep, voffB);
            PG8_WAIT_V(6); PG8_BAR; PG8_MMA(1, 1, At, B1); PG8_BAR;
        }
        E(acc, cur, wr, wc, fr, fq);
        if (!has_next) break;
#pragma unroll
        for (int a = 0; a < 2; ++a)
#pragma unroll
            for (int b = 0; b < 2; ++b)
#pragma unroll
                for (int m = 0; m < 4; ++m)
#pragma unroll
                    for (int n = 0; n < 2; ++n) acc[a][b][m][n] = (f32x4){0.f, 0.f, 0.f, 0.f};
        cur = nxt; cA = nA; cB = nB; ++ui;
    }
    PG8_WAIT_V(0);
    if (wr == 0) PG8_BAR;
    PG8_BAR;
#undef PG8_SA
#undef PG8_SB
#undef PG8_STAGE
#undef PG8_LDA
#undef PG8_LDB
#undef PG8_MMA
#undef PG8_WAIT_V
#undef PG8_WAIT_L
#undef PG8_BAR
#undef PG8_SCHED
}
}
using pg8::Unit;

struct EpiProj {
    static constexpr bool PERM = true;
    unsigned char* ws; const float* lb; const float* ng; float* kmean;
    __device__ __forceinline__ void operator()(const f32x4 (&acc)[2][2][4][2], const Unit& u, int wr, int wc, int fr, int fq) const {
        const int pn = u.pn; int seg, colt, ldc; size_t boff;
        if (pn < 14) { seg = pn >> 1; colt = (pn & 1) * 256; ldc = 512; boff = OFF_QA + (size_t)seg * SZ_T512; }
        else if (pn < 18) { seg = 7; colt = (pn - 14) * 256; ldc = 1024; boff = OFF_GA; }
        else { seg = 8; colt = (pn - 18) * 256; ldc = 1024; boff = OFF_GB; }
        bf16_t* base = (bf16_t*)(ws + boff);
        const int row0 = u.pm * 256 + wr * 64 + fr, col0 = colt + wc * 32 + 8 * fq;
        float pv[2][8];
#pragma unroll
        for (int bj = 0; bj < 2; ++bj)
#pragma unroll
            for (int e = 0; e < 8; ++e) pv[bj][e] = (seg == 4) ? (1.0f - lb[col0 + bj * 128 + e]) : ((seg == 6) ? ng[col0 + bj * 128 + e] : 0.f);
        float cs[2][8];
#pragma unroll
        for (int bj = 0; bj < 2; ++bj)
#pragma unroll
            for (int e = 0; e < 8; ++e) cs[bj][e] = 0.f;
#pragma unroll
        for (int ai = 0; ai < 2; ++ai)
#pragma unroll
            for (int m = 0; m < 4; ++m) {
                bf16_t* rowp = base + (size_t)(row0 + ai * 128 + m * 16) * ldc + col0;
#pragma unroll
                for (int bj = 0; bj < 2; ++bj) {
                    float v[8];
#pragma unroll
                    for (int e = 0; e < 4; ++e) { v[e] = acc[ai][bj][m][0][e]; v[4 + e] = acc[ai][bj][m][1][e]; }
                    if (seg == 0) {
#pragma unroll
                        for (int e = 0; e < 8; ++e) v[e] *= (0.125f * LOG2E);
                    } else if (seg == 1) {
#pragma unroll
                        for (int e = 0; e < 8; ++e) cs[bj][e] += v[e];
                    } else if (seg == 3) {
#pragma unroll
                        for (int e = 0; e < 8; ++e) v[e] = v[e] * sigmoidf_(v[e]);
                    } else if (seg == 4) {
#pragma unroll
                        for (int e = 0; e < 8; ++e) v[e] = pv[bj][e] * sigmoidf_(-v[e]);
                    } else if (seg == 6) {
#pragma unroll
                        for (int e = 0; e < 8; ++e) v[e] = pv[bj][e] * v[e] * sigmoidf_(v[e]);
                    } else if (seg >= 7) {
#pragma unroll
                        for (int e = 0; e < 8; ++e) v[e] = sigmoidf_(v[e]);
                    }
                    u32x4 w; w.x = cvt_pk_bf16(v[0], v[1]); w.y = cvt_pk_bf16(v[2], v[3]); w.z = cvt_pk_bf16(v[4], v[5]); w.w = cvt_pk_bf16(v[6], v[7]);
                    *(u32x4*)(rowp + bj * 128) = w;
                }
            }
        if (seg == 1) {
#pragma unroll
            for (int bj = 0; bj < 2; ++bj)
#pragma unroll
                for (int e = 0; e < 8; ++e) {
                    float s = cs[bj][e];
                    s += __shfl_xor(s, 1); s += __shfl_xor(s, 2); s += __shfl_xor(s, 4); s += __shfl_xor(s, 8);
                    if (fr == 0) atomicAdd(kmean + (size_t)u.pm * 512 + col0 + bj * 128 + e, s);
                }
        }
    }
};
struct EpiMixA {
    static constexpr bool PERM = true;
    bf16_t* GA;
    __device__ __forceinline__ void operator()(const f32x4 (&acc)[2][2][4][2], const Unit& u, int wr, int wc, int fr, int fq) const {
        const int row0 = u.pm * 256 + wr * 64 + fr, col0 = u.pn * 256 + wc * 32 + 8 * fq;
#pragma unroll
        for (int ai = 0; ai < 2; ++ai)
#pragma unroll
            for (int m = 0; m < 4; ++m) {
                bf16_t* rowp = GA + (size_t)(row0 + ai * 128 + m * 16) * 1024 + col0;
#pragma unroll
                for (int bj = 0; bj < 2; ++bj) {
                    const u32x4 g = *(const u32x4*)(rowp + bj * 128);
                    const f32x4 a0 = acc[ai][bj][m][0], a1 = acc[ai][bj][m][1];
                    u32x4 w;
                    w.x = cvt_pk_bf16(bf_lo(g.x) * a0[0], bf_hi(g.x) * a0[1]); w.y = cvt_pk_bf16(bf_lo(g.y) * a0[2], bf_hi(g.y) * a0[3]);
                    w.z = cvt_pk_bf16(bf_lo(g.z) * a1[0], bf_hi(g.z) * a1[1]); w.w = cvt_pk_bf16(bf_lo(g.w) * a1[2], bf_hi(g.w) * a1[3]);
                    *(u32x4*)(rowp + bj * 128) = w;
                }
            }
    }
};
struct EpiMixB {
    static constexpr bool PERM = true;
    bf16_t* GA; const bf16_t* GB;
    __device__ __forceinline__ void operator()(const f32x4 (&acc)[2][2][4][2], const Unit& u, int wr, int wc, int fr, int fq) const {
        const int row0 = u.pm * 256 + wr * 64 + fr, col0 = u.pn * 256 + wc * 32 + 8 * fq;
#pragma unroll
        for (int ai = 0; ai < 2; ++ai)
#pragma unroll
            for (int m = 0; m < 4; ++m) {
                const size_t off = (size_t)(row0 + ai * 128 + m * 16) * 1024 + col0;
#pragma unroll
                for (int bj = 0; bj < 2; ++bj) {
                    const u32x4 g = *(const u32x4*)(GB + off + bj * 128);
                    const u32x4 mx = *(const u32x4*)(GA + off + bj * 128);
                    const f32x4 a0 = acc[ai][bj][m][0], a1 = acc[ai][bj][m][1];
                    u32x4 w;
                    w.x = cvt_pk_bf16(bf_lo(mx.x) + bf_lo(g.x) * a0[0], bf_hi(mx.x) + bf_hi(g.x) * a0[1]); w.y = cvt_pk_bf16(bf_lo(mx.y) + bf_lo(g.y) * a0[2], bf_hi(mx.y) + bf_hi(g.y) * a0[3]);
                    w.z = cvt_pk_bf16(bf_lo(mx.z) + bf_lo(g.z) * a1[0], bf_hi(mx.z) + bf_hi(g.z) * a1[1]); w.w = cvt_pk_bf16(bf_lo(mx.w) + bf_lo(g.w) * a1[2], bf_hi(mx.w) + bf_hi(g.w) * a1[3]);
                    *(u32x4*)(GA + off + bj * 128) = w;
                }
            }
    }
};
struct EpiOut {
    static constexpr bool PERM = false;
    const float* x; const float* ada; float* out;
    __device__ __forceinline__ void operator()(const f32x4 (&acc)[2][2][4][2], const Unit& u, int wr, int wc, int fr, int fq) const {
        const int row0 = u.pm * 256 + wr * 64 + fr, col0 = u.pn * 256 + wc * 32 + 4 * fq;
        const float* gt1 = ada + (size_t)(u.pm >> 3) * 6144 + 2048;
#pragma unroll
        for (int ai = 0; ai < 2; ++ai)
#pragma unroll
            for (int m = 0; m < 4; ++m) {
                const size_t off = (size_t)(row0 + ai * 128 + m * 16) * 1024 + col0;
#pragma unroll
                for (int bj = 0; bj < 2; ++bj)
#pragma unroll
                    for (int n = 0; n < 2; ++n) {
                        const int cc = bj * 128 + n * 16;
                        const f32x4 xv = *(const f32x4*)(x + off + cc), gv = *(const f32x4*)(gt1 + col0 + cc);
                        *(f32x4*)(out + off + cc) = xv * ALPHA + gv * acc[ai][bj][m][n];
                    }
            }
    }
};
struct EpiBf16 {
    static constexpr bool PERM = true;
    bf16_t* O;
    __device__ __forceinline__ void operator()(const f32x4 (&acc)[2][2][4][2], const Unit& u, int wr, int wc, int fr, int fq) const {
        const int row0 = u.pm * 256 + wr * 64 + fr, col0 = u.pn * 256 + wc * 32 + 8 * fq;
#pragma unroll
        for (int ai = 0; ai < 2; ++ai)
#pragma unroll
            for (int m = 0; m < 4; ++m) {
                bf16_t* rowp = O + (size_t)(row0 + ai * 128 + m * 16) * 1024 + col0;
#pragma unroll
                for (int bj = 0; bj < 2; ++bj) {
                    const f32x4 a0 = acc[ai][bj][m][0], a1 = acc[ai][bj][m][1];
                    u32x4 w; w.x = cvt_pk_bf16(a0[0], a0[1]); w.y = cvt_pk_bf16(a0[2], a0[3]); w.z = cvt_pk_bf16(a1[0], a1[1]); w.w = cvt_pk_bf16(a1[2], a1[3]);
                    *(u32x4*)(rowp + bj * 128) = w;
                }
            }
    }
};

__device__ void phase0a(const Params& P, LAS unsigned char* lds) {
    const int tid = tid_opaque(), G = gridDim.x, bid = blockIdx.x;
    for (int it = bid; it < 192; it += G) {
        LAS float* sc = (LAS float*)lds;
        for (int i = tid; i < 32 * 1024; i += NTHR) { const float cv = P.c[i]; sc[i] = cv * sigmoidf_(cv); }
        __syncthreads();
        const int kg = tid >> 5, col = tid & 31;
        float a[32];
#pragma unroll
        for (int b = 0; b < 32; ++b) a[b] = 0.f;
        for (int k = kg * 64; k < kg * 64 + 64; k += 4) {
            float w[4];
#pragma unroll
            for (int e = 0; e < 4; ++e) w[e] = P.w_ada[(size_t)(k + e) * 6144 + it * 32 + col];
#pragma unroll
            for (int b = 0; b < 32; ++b) { const f32x4 s = *(const LAS f32x4*)(sc + b * 1024 + k); a[b] += s[0] * w[0] + s[1] * w[1] + s[2] * w[2] + s[3] * w[3]; }
        }
        __syncthreads();
        LAS float* red = (LAS float*)lds;
#pragma unroll
        for (int b = 0; b < 32; ++b) red[(kg * 32 + b) * 32 + col] = a[b];
        __syncthreads();
        for (int o = tid; o < 1024; o += NTHR) { const int b = o >> 5, cc = o & 31; float s = 0.f;
#pragma unroll
            for (int g2 = 0; g2 < 16; ++g2) s += red[(g2 * 32 + b) * 32 + cc];
            ((float*)(P.ws + OFF_ADA))[(size_t)b * 6144 + it * 32 + cc] = s + P.b_ada[it * 32 + cc]; }
        __syncthreads();
    }
    const size_t gtid = (size_t)bid * NTHR + tid, gsz = (size_t)G * NTHR;
    for (size_t i = gtid; i < 512; i += gsz) ((float*)(P.ws + OFF_LB))[i] = sigmoidf_(P.hgrn_lb[i] - P.hgrn_lb[512 + i]);
    for (size_t i = gtid; i < 32 * 8 * 512; i += gsz) ((float*)(P.ws + OFF_KMEAN))[i] = 0.f;
    {
        LAS float* tile = (LAS float*)lds;
        const int I0 = 16 * 88, I1 = I0 + 8 * 16, I2 = I1 + 8 * 16, I3 = I2 + 16 * 16, I4 = I3 + 16 * 16;
        for (int it = bid; it < I4; it += G) {
            const float* W; bf16_t* WT; int K, N, r;
            if (it < I0) { W = P.w_in; WT = (bf16_t*)(P.ws + OFF_WIN); K = 1024; N = 5632; r = it; }
            else if (it < I1) { W = P.w_ba; WT = (bf16_t*)(P.ws + OFF_WBA); K = 512; N = 1024; r = it - I0; }
            else if (it < I2) { W = P.w_bb; WT = (bf16_t*)(P.ws + OFF_WBB); K = 512; N = 1024; r = it - I1; }
            else if (it < I3) { W = P.w_out; WT = (bf16_t*)(P.ws + OFF_WOUT); K = 1024; N = 1024; r = it - I2; }
            else { W = P.peer_wq; WT = (bf16_t*)(P.ws + OFF_WQ); K = 1024; N = 1024; r = it - I3; }
            const int nb = N / 64, k0 = (r / nb) * 64, n0 = (r % nb) * 64;
#pragma unroll
            for (int ps = 0; ps < 2; ++ps) { const int kk = (tid >> 4) + 32 * ps, n4 = (tid & 15) * 4;
                const f32x4 v = *(const f32x4*)(W + (size_t)(k0 + kk) * N + n0 + n4);
                tile[kk * 65 + n4] = v[0]; tile[kk * 65 + n4 + 1] = v[1]; tile[kk * 65 + n4 + 2] = v[2]; tile[kk * 65 + n4 + 3] = v[3]; }
            __syncthreads();
            { const int n = tid >> 3, kc = (tid & 7) * 8; u32x4 w;
              w.x = cvt_pk_bf16(tile[(kc + 0) * 65 + n], tile[(kc + 1) * 65 + n]); w.y = cvt_pk_bf16(tile[(kc + 2) * 65 + n], tile[(kc + 3) * 65 + n]);
              w.z = cvt_pk_bf16(tile[(kc + 4) * 65 + n], tile[(kc + 5) * 65 + n]); w.w = cvt_pk_bf16(tile[(kc + 6) * 65 + n], tile[(kc + 7) * 65 + n]);
              *(u32x4*)(WT + (size_t)(n0 + n) * K + k0 + kc) = w; }
            __syncthreads();
        }
    }
    {
        const size_t NU = (size_t)16384 * 1024 / 8;
        for (size_t i = gtid; i < 2 * NU + 16384; i += gsz) {
            const float* src; bf16_t* dst; size_t j;
            if (i < NU) { src = P.peer_u; dst = (bf16_t*)(P.ws + OFF_U); j = i; }
            else if (i < 2 * NU) { src = P.peer_v; dst = (bf16_t*)(P.ws + OFF_V); j = i - NU; }
            else { src = P.peer_sk; dst = (bf16_t*)(P.ws + OFF_SK); j = i - 2 * NU; }
            const f32x4 a = *(const f32x4*)(src + j * 8), b = *(const f32x4*)(src + j * 8 + 4);
            u32x4 w; w.x = cvt_pk_bf16(a[0], a[1]); w.y = cvt_pk_bf16(a[2], a[3]); w.z = cvt_pk_bf16(b[0], b[1]); w.w = cvt_pk_bf16(b[2], b[3]);
            *(u32x4*)(dst + j * 8) = w;
        }
    }
}
__device__ void phase0b(const Params& P) {
    const size_t gtid = (size_t)blockIdx.x * NTHR + threadIdx.x, gsz = (size_t)gridDim.x * NTHR;
    const float* ada = (const float*)(P.ws + OFF_ADA); bf16_t* H = (bf16_t*)(P.ws + OFF_H);
    for (size_t i = gtid; i < (size_t)NTOK * 128; i += gsz) {
        const size_t row = i >> 7; const int c8 = (int)(i & 127) * 8; const int b = (int)(row >> 11);
        const float* xr = P.x + row * 1024 + c8; const float* sh = ada + (size_t)b * 6144 + c8; const float* sc = sh + 1024;
        const f32x4 x0 = *(const f32x4*)xr, x1 = *(const f32x4*)(xr + 4), s0 = *(const f32x4*)sc, s1 = *(const f32x4*)(sc + 4), h0 = *(const f32x4*)sh, h1 = *(const f32x4*)(sh + 4);
        const f32x4 r0 = x0 * (s0 + 1.0f) + h0, r1 = x1 * (s1 + 1.0f) + h1;
        u32x4 w; w.x = cvt_pk_bf16(r0[0], r0[1]); w.y = cvt_pk_bf16(r0[2], r0[3]); w.z = cvt_pk_bf16(r1[0], r1[1]); w.w = cvt_pk_bf16(r1[2], r1[3]);
        *(u32x4*)(H + row * 1024 + c8) = w;
    }
}

__device__ void hgrn_item(const Params& P, int item, LAS unsigned char* lds) {
    const int tid = tid_opaque(), lane = tid & 63, wid = tid >> 6;
    const int b = item >> 3, h = (item >> 1) & 3, vh = item & 1;
    const bf16_t* HQ = (const bf16_t*)(P.ws + OFF_HQ); const bf16_t* HK = (const bf16_t*)(P.ws + OFF_HK); bf16_t* HI = (bf16_t*)(P.ws + OFF_HI);
    LAS float* qs = (LAS float*)lds;
    LAS float* ks = (LAS float*)(lds + 16384);
    LAS float* vs = (LAS float*)(lds + 32768);
    LAS float* part = (LAS float*)(lds + 40960);
    float S[16];
#pragma unroll
    for (int i = 0; i < 16; ++i) S[i] = 0.f;
    const size_t rowb = (size_t)b * SEQ;
    for (int t0 = 0; t0 < SEQ; t0 += 32) {
        { const int row = tid >> 4, c8 = (tid & 15) * 8; const size_t g = (rowb + t0 + row) * 512 + h * 128 + c8;
          const u32x4 qv = *(const u32x4*)(HQ + g), kv = *(const u32x4*)(HK + g);
          LAS float* qd = qs + row * 128 + c8; LAS float* kd = ks + row * 128 + c8;
          *(LAS f32x4*)qd = (f32x4){bf_lo(qv.x), bf_hi(qv.x), bf_lo(qv.y), bf_hi(qv.y)}; *(LAS f32x4*)(qd + 4) = (f32x4){bf_lo(qv.z), bf_hi(qv.z), bf_lo(qv.w), bf_hi(qv.w)};
          *(LAS f32x4*)kd = (f32x4){bf_lo(kv.x), bf_hi(kv.x), bf_lo(kv.y), bf_hi(kv.y)}; *(LAS f32x4*)(kd + 4) = (f32x4){bf_lo(kv.z), bf_hi(kv.z), bf_lo(kv.w), bf_hi(kv.w)};
          const int c4 = (tid & 15) * 4; const u32x2 vv = *(const u32x2*)(HI + (rowb + t0 + row) * 512 + h * 128 + vh * 64 + c4);
          *(LAS f32x4*)(vs + row * 64 + c4) = (f32x4){bf_lo(vv.x), bf_hi(vv.x), bf_lo(vv.y), bf_hi(vv.y)}; }
        __syncthreads();
        for (int t = 0; t < 32; ++t) {
            const float v = vs[t * 64 + lane]; float op = 0.f;
#pragma unroll
            for (int i4 = 0; i4 < 4; ++i4) {
                const f32x4 kq = *(const LAS f32x4*)(ks + t * 128 + wid * 16 + i4 * 4), qq = *(const LAS f32x4*)(qs + t * 128 + wid * 16 + i4 * 4);
#pragma unroll
                for (int e = 0; e < 4; ++e) { float s = S[i4 * 4 + e]; s += kq[e] * (v - s); S[i4 * 4 + e] = s; op += qq[e] * s; }
            }
            part[(t * 8 + wid) * 64 + lane] = op;
        }
        __syncthreads();
        { const int t = tid >> 4, c4 = (tid & 15) * 4; f32x4 s = (f32x4){0.f, 0.f, 0.f, 0.f};
#pragma unroll
          for (int w = 0; w < 8; ++w) s += *(const LAS f32x4*)(part + (t * 8 + w) * 64 + c4);
          u32x2 o; o.x = cvt_pk_bf16(s[0], s[1]); o.y = cvt_pk_bf16(s[2], s[3]);
          *(u32x2*)(HI + (rowb + t0 + t) * 512 + h * 128 + vh * 64 + c4) = o; }
    }
    __syncthreads();
}

__device__ void moba_unit(const Params& P, int b, int h, int j, LAS unsigned char* lds) {
    const int tid = tid_opaque(), lane = tid & 63, wid = tid >> 6, r32 = lane & 31, hi = lane >> 5;
    bf16_t* Q = (bf16_t*)(P.ws + OFF_QA); const bf16_t* Kg = (const bf16_t*)(P.ws + OFF_KA); const bf16_t* Vg = (const bf16_t*)(P.ws + OFF_VA);
    const float* kmean = (const float*)(P.ws + OFF_KMEAN);
    constexpr int KIMG = 64 * 144, VIMG = 64 * 192, LK = 0, LV = 2 * KIMG, LKM = 2 * KIMG + 2 * VIMG;
    LAS float* kmL = (LAS float*)(lds + LKM);
    const size_t rowb = (size_t)b * SEQ; const int q0 = j * 256;
    if (tid < j * 64) kmL[tid] = kmean[(size_t)(b * 8 + (tid >> 6)) * 512 + h * 64 + (tid & 63)];
    bf16_t* qrow = Q + (rowb + q0 + wid * 32 + r32) * 512 + h * 64;
    bf16x8 qf[4];
#pragma unroll
    for (int d0 = 0; d0 < 4; ++d0) qf[d0] = *(const bf16x8*)(qrow + 16 * d0 + 8 * hi);
    const int srow = tid >> 3, sch = tid & 7;
    const bf16_t* ksrc = Kg + (rowb + srow) * 512 + h * 64 + sch * 8; const bf16_t* vsrc = Vg + (rowb + srow) * 512 + h * 64 + sch * 8;
    const int ntile = 4 * (j + 1);
    u32x4 kreg, vreg;
    { const int key0 = q0; kreg = *(const u32x4*)(ksrc + (size_t)key0 * 512); vreg = *(const u32x4*)(vsrc + (size_t)key0 * 512); }
    *(LAS u32x4*)(lds + LK + srow * 144 + sch * 16) = kreg; *(LAS u32x4*)(lds + LV + srow * 192 + sch * 16) = vreg;
    __syncthreads();
    unsigned sel = 0;
    if (j <= 3) sel = (1u << j) - 1u;
    else {
        float g[7];
#pragma unroll
        for (int n = 0; n < 7; ++n) { float s = 0.f;
            if (n < j) {
#pragma unroll
                for (int d0 = 0; d0 < 4; ++d0)
#pragma unroll
                    for (int e = 0; e < 8; ++e) s += __uint_as_float(((unsigned)(unsigned short)qf[d0][e]) << 16) * kmL[n * 64 + 16 * d0 + 8 * hi + e];
            }
            s += __shfl_xor(s, 32); g[n] = s; }
#pragma unroll
        for (int it = 0; it < 3; ++it) { float best = -INFINITY; int bi = 0;
#pragma unroll
            for (int n = 0; n < 7; ++n) if (n < j && !((sel >> n) & 1u) && g[n] > best) { best = g[n]; bi = n; }
            sel |= 1u << bi; }
    }
    const float ch = exp2f(-(float)(h + 1)) * LOG2E;
    const int qb = wid * 32 + r32;
    float m_run = -1e30f, l_run = 0.f;
    f32x16 o0 = {}, o1 = {};
    const int tg = lane >> 4, tc = tg & 1, ti = lane & 15;
    const int vlane = (4 * hi + (ti >> 2)) * 192 + (16 * tc + 4 * (ti & 3)) * 2;
#pragma unroll 1
    for (int i = 0; i < ntile; ++i) {
        const int buf = i & 1;
        const bool own = i < 4; const int blk = own ? j : ((i - 4) >> 2), kt = own ? i : ((i - 4) & 3);
        if (i + 1 < ntile) { const int i1 = i + 1; const int blk1 = (i1 < 4) ? j : ((i1 - 4) >> 2), kt1 = (i1 < 4) ? i1 : ((i1 - 4) & 3); const size_t key1 = (size_t)(blk1 * 256 + kt1 * 64);
            kreg = *(const u32x4*)(ksrc + key1 * 512); vreg = *(const u32x4*)(vsrc + key1 * 512); }
        const bool lane_ok = own ? true : (((sel >> blk) & 1u) != 0u);
        const bool skip = own ? (64 * kt > 32 * wid + 31) : (__ballot(lane_ok) == 0ull);
        if (!skip) {
            LAS unsigned char* kb = lds + LK + buf * KIMG; LAS unsigned char* vb = lds + LV + buf * VIMG;
            f32x16 p0 = {}, p1 = {};
#pragma unroll
            for (int d0 = 0; d0 < 4; ++d0) {
                const bf16x8 kf0 = *(const LAS bf16x8*)(kb + r32 * 144 + (16 * d0 + 8 * hi) * 2);
                const bf16x8 kf1 = *(const LAS bf16x8*)(kb + (32 + r32) * 144 + (16 * d0 + 8 * hi) * 2);
                p0 = MFMA32(kf0, qf[d0], p0); p1 = MFMA32(kf1, qf[d0], p1);
            }
            const float kbase = ch * (float)((blk - j) * 256 + kt * 64);
            float mt = -1e30f;
#pragma unroll
            for (int r = 0; r < 16; ++r) {
                const int kl0 = crow(r, hi), kl1 = kl0 + 32;
                const float t0 = p0[r] + (kbase + ch * (float)kl0), t1 = p1[r] + (kbase + ch * (float)kl1);
                const bool v0 = own ? (kt * 64 + kl0 <= qb) : lane_ok, v1 = own ? (kt * 64 + kl1 <= qb) : lane_ok;
                p0[r] = v0 ? t0 : -1e30f; p1[r] = v1 ? t1 : -1e30f;
                mt = fmaxf(mt, fmaxf(p0[r], p1[r]));
            }
            mt = fmaxf(mt, __shfl_xor(mt, 32));
            const float mnew = fmaxf(m_run, mt), alpha = __builtin_amdgcn_exp2f(m_run - mnew);
            m_run = mnew;
            float rs = 0.f;
#pragma unroll
            for (int r = 0; r < 16; ++r) { p0[r] = __builtin_amdgcn_exp2f(p0[r] - mnew); p1[r] = __builtin_amdgcn_exp2f(p1[r] - mnew); rs += p0[r] + p1[r]; }
            l_run = l_run * alpha + rs;
#pragma unroll
            for (int r = 0; r < 16; ++r) { o0[r] *= alpha; o1[r] *= alpha; }
#pragma unroll
            for (int sub = 0; sub < 2; ++sub)
#pragma unroll
                for (int s = 0; s < 2; ++s) {
                    union { u32x4 u; bf16x8 v; } pb;
                    if (sub == 0) { pb.u.x = cvt_pk_bf16(p0[8 * s + 0], p0[8 * s + 1]); pb.u.y = cvt_pk_bf16(p0[8 * s + 2], p0[8 * s + 3]); pb.u.z = cvt_pk_bf16(p0[8 * s + 4], p0[8 * s + 5]); pb.u.w = cvt_pk_bf16(p0[8 * s + 6], p0[8 * s + 7]); }
                    else { pb.u.x = cvt_pk_bf16(p1[8 * s + 0], p1[8 * s + 1]); pb.u.y = cvt_pk_bf16(p1[8 * s + 2], p1[8 * s + 3]); pb.u.z = cvt_pk_bf16(p1[8 * s + 4], p1[8 * s + 5]); pb.u.w = cvt_pk_bf16(p1[8 * s + 6], p1[8 * s + 7]); }
#pragma unroll
                    for (int dt = 0; dt < 2; ++dt) {
                        LAS unsigned char* va = vb + (32 * sub + 16 * s) * 192 + dt * 64 + vlane;
                        const s16x4 lo = __builtin_bit_cast(s16x4, __builtin_amdgcn_ds_read_tr16_b64_v4i16((LAS s16x4*)va));
                        const s16x4 hh = __builtin_bit_cast(s16x4, __builtin_amdgcn_ds_read_tr16_b64_v4i16((LAS s16x4*)(va + 8 * 192)));
                        const bf16x8 vf = {lo[0], lo[1], lo[2], lo[3], hh[0], hh[1], hh[2], hh[3]};
                        if (dt == 0) o0 = MFMA32(vf, pb.v, o0); else o1 = MFMA32(vf, pb.v, o1);
                    }
                }
        }
        if (i + 1 < ntile) { const int nb = buf ^ 1;
            *(LAS u32x4*)(lds + LK + nb * KIMG + srow * 144 + sch * 16) = kreg; *(LAS u32x4*)(lds + LV + nb * VIMG + srow * 192 + sch * 16) = vreg; }
        __syncthreads();
    }
    l_run += __shfl_xor(l_run, 32);
    const float inv = 1.0f / l_run;
#pragma unroll
    for (int r4 = 0; r4 < 4; ++r4) {
        u32x2 w0, w1;
        w0.x = cvt_pk_bf16(o0[4 * r4] * inv, o0[4 * r4 + 1] * inv); w0.y = cvt_pk_bf16(o0[4 * r4 + 2] * inv, o0[4 * r4 + 3] * inv);
        w1.x = cvt_pk_bf16(o1[4 * r4] * inv, o1[4 * r4 + 1] * inv); w1.y = cvt_pk_bf16(o1[4 * r4 + 2] * inv, o1[4 * r4 + 3] * inv);
        *(u32x2*)(qrow + 8 * r4 + 4 * hi) = w0; *(u32x2*)(qrow + 32 + 8 * r4 + 4 * hi) = w1;
    }
}

__device__ void yb_norm_panel(const Params& P, int pm) {
    const int tid = tid_opaque(), lane = tid & 63, wid = tid >> 6;
    bf16_t* HI = (bf16_t*)(P.ws + OFF_HI); const bf16_t* HG = (const bf16_t*)(P.ws + OFF_HG);
    for (int r = 0; r < 32; ++r) {
        const size_t off = ((size_t)pm * 256 + wid * 32 + r) * 512 + lane * 8;
        const u32x4 ov = *(const u32x4*)(HI + off), gv = *(const u32x4*)(HG + off);
        float o[8] = {bf_lo(ov.x), bf_hi(ov.x), bf_lo(ov.y), bf_hi(ov.y), bf_lo(ov.z), bf_hi(ov.z), bf_lo(ov.w), bf_hi(ov.w)};
        const float g[8] = {bf_lo(gv.x), bf_hi(gv.x), bf_lo(gv.y), bf_hi(gv.y), bf_lo(gv.z), bf_hi(gv.z), bf_lo(gv.w), bf_hi(gv.w)};
        float ss = 0.f;
#pragma unroll
        for (int e = 0; e < 8; ++e) ss += o[e] * o[e];
        ss += __shfl_xor(ss, 1); ss += __shfl_xor(ss, 2); ss += __shfl_xor(ss, 4); ss += __shfl_xor(ss, 8);
        const float rs = rsqrtf(ss * (1.0f / 128.0f) + RMS_EPS);
        u32x4 w; w.x = cvt_pk_bf16(o[0] * rs * g[0], o[1] * rs * g[1]); w.y = cvt_pk_bf16(o[2] * rs * g[2], o[3] * rs * g[3]);
        w.z = cvt_pk_bf16(o[4] * rs * g[4], o[5] * rs * g[5]); w.w = cvt_pk_bf16(o[6] * rs * g[6], o[7] * rs * g[7]);
        *(u32x4*)(HI + off) = w;
    }
}
__device__ void ln1_panel(const Params& P, int pm) {
    const int tid = tid_opaque(), lane = tid & 63, wid = tid >> 6;
    const float* ada = (const float*)(P.ws + OFF_ADA) + (size_t)(pm >> 3) * 6144; bf16_t* H = (bf16_t*)(P.ws + OFF_H);
    for (int r = 0; r < 32; ++r) {
        const size_t row = (size_t)pm * 256 + wid * 32 + r;
        float* xr = P.out + row * 1024 + lane * 4;
        f32x4 v[4]; float s = 0.f;
#pragma unroll
        for (int jx = 0; jx < 4; ++jx) { v[jx] = *(const f32x4*)(xr + 256 * jx); s += (v[jx][0] + v[jx][1]) + (v[jx][2] + v[jx][3]); }
        const float mean = wave_sum(s) * (1.0f / 1024.0f); float s2 = 0.f;
#pragma unroll
        for (int jx = 0; jx < 4; ++jx) { v[jx] = v[jx] - mean; s2 += (v[jx][0] * v[jx][0] + v[jx][1] * v[jx][1]) + (v[jx][2] * v[jx][2] + v[jx][3] * v[jx][3]); }
        const float rstd = rsqrtf(wave_sum(s2) * (1.0f / 1024.0f) + LN_EPS);
#pragma unroll
        for (int jx = 0; jx < 4; ++jx) {
            const int c = lane * 4 + 256 * jx;
            const f32x4 g = *(const f32x4*)(P.ln1_g + c), bb = *(const f32x4*)(P.ln1_b + c), sh = *(const f32x4*)(ada + 3072 + c), sc = *(const f32x4*)(ada + 4096 + c);
            const f32x4 x1 = v[jx] * rstd * g + bb;
            *(f32x4*)(xr + 256 * jx) = x1;
            const f32x4 h2 = x1 * (sc + 1.0f) + sh;
            u32x2 w; w.x = cvt_pk_bf16(h2[0], h2[1]); w.y = cvt_pk_bf16(h2[2], h2[3]);
            *(u32x2*)(H + row * 1024 + c) = w;
        }
    }
}

#define INS16(L, xin) do { float x_ = (xin); _Pragma("unroll") for (int k_ = 0; k_ < 16; ++k_) { const float hi_ = fmaxf(L[k_], x_); x_ = fminf(L[k_], x_); L[k_] = hi_; } } while (0)

__device__ void peer_select_wave(const Params& P, size_t tok0) {
    const int lane = tid_opaque() & 63, r32 = lane & 31, hi = lane >> 5;
    const bf16_t* QP = (const bf16_t*)(P.ws + OFF_GB) + (tok0 + r32) * 1024; const bf16_t* SK = (const bf16_t*)(P.ws + OFF_SK);
    u32x2* EG = (u32x2*)(P.ws + OFF_EG) + (tok0 + r32) * 128;
#pragma unroll 1
    for (int h = 0; h < 8; ++h) {
        float a0[16], a1[16];
#pragma unroll
        for (int k = 0; k < 16; ++k) { a0[k] = -INFINITY; a1[k] = -INFINITY; }
#pragma unroll 1
        for (int p = 0; p < 2; ++p) {
            const int hp = h * 2 + p;
            bf16x8 qf[4];
#pragma unroll
            for (int ks = 0; ks < 4; ++ks) qf[ks] = *(const bf16x8*)(QP + hp * 64 + 16 * ks + 8 * hi);
            float L[16];
#pragma unroll
            for (int k = 0; k < 16; ++k) L[k] = -INFINITY;
#pragma unroll
            for (int kt = 0; kt < 4; ++kt) {
                f32x16 acc = {};
#pragma unroll
                for (int ks = 0; ks < 4; ++ks) { const bf16x8 kf = *(const bf16x8*)(SK + ((size_t)hp * 128 + 32 * kt + r32) * 64 + 16 * ks + 8 * hi); acc = MFMA32(kf, qf[ks], acc); }
#pragma unroll
                for (int r = 0; r < 16; ++r) { const unsigned key = (unsigned)(32 * kt + crow(r, hi)); const float xv = __uint_as_float((__float_as_uint(acc[r]) & ~127u) | key); INS16(L, xv); }
            }
            float O[16];
#pragma unroll
            for (int k = 0; k < 16; ++k) O[k] = __shfl_xor(L[k], 32);
#pragma unroll
            for (int k = 0; k < 16; ++k) INS16(L, O[k]);
#pragma unroll
            for (int k = 0; k < 16; ++k) { a0[k] = (p == 0) ? L[k] : a0[k]; a1[k] = (p == 1) ? L[k] : a1[k]; }
        }
        float best[16];
#pragma unroll
        for (int k = 0; k < 16; ++k) best[k] = -INFINITY;
#pragma unroll
        for (int i = 0; i < 16; ++i)
#pragma unroll
            for (int jx = 0; jx < 16; ++jx)
                if ((i + 1) * (jx + 1) <= 16) {
                    const float cs = a0[i] + a1[jx];
                    const float cv = __uint_as_float((__float_as_uint(cs) & ~255u) | (unsigned)(i * 16 + jx));
                    INS16(best, cv);
                }
        unsigned pk0[4], pk1[4];
#pragma unroll
        for (int q = 0; q < 4; ++q) {
            pk0[q] = (__float_as_uint(a0[4 * q]) & 127u) | ((__float_as_uint(a0[4 * q + 1]) & 127u) << 8) | ((__float_as_uint(a0[4 * q + 2]) & 127u) << 16) | ((__float_as_uint(a0[4 * q + 3]) & 127u) << 24);
            pk1[q] = (__float_as_uint(a1[4 * q]) & 127u) | ((__float_as_uint(a1[4 * q + 1]) & 127u) << 8) | ((__float_as_uint(a1[4 * q + 2]) & 127u) << 16) | ((__float_as_uint(a1[4 * q + 3]) & 127u) << 24);
        }
        unsigned pay[16];
#pragma unroll
        for (int k = 0; k < 16; ++k) {
            const unsigned code = __float_as_uint(best[k]) & 255u, ci = code >> 4, cj = code & 15u;
            const unsigned qi = ci >> 2, qj = cj >> 2;
            const unsigned w0 = (qi == 0u) ? pk0[0] : ((qi == 1u) ? pk0[1] : ((qi == 2u) ? pk0[2] : pk0[3]));
            const unsigned w1 = (qj == 0u) ? pk1[0] : ((qj == 1u) ? pk1[1] : ((qj == 2u) ? pk1[2] : pk1[3]));
            pay[k] = (((w0 >> ((ci & 3u) * 8u)) & 127u) << 7) | ((w1 >> ((cj & 3u) * 8u)) & 127u);
        }
        float e[16], es = 0.f;
#pragma unroll
        for (int k = 0; k < 16; ++k) { e[k] = __expf(best[k] - best[0]); es += e[k]; }
        const float inv = 1.0f / es;
        if (hi == 0) {
#pragma unroll
            for (int k = 0; k < 16; ++k) { u32x2 w; w.x = pay[k]; w.y = __float_as_uint(e[k] * inv); EG[h * 16 + k] = w; }
        }
    }
}
__device__ void peer_gather_token(const Params& P, size_t tok) {
    const int lane = tid_opaque() & 63;
    const bf16_t* H = (const bf16_t*)(P.ws + OFF_H) + tok * 1024; const bf16_t* U = (const bf16_t*)(P.ws + OFF_U); const bf16_t* V = (const bf16_t*)(P.ws + OFF_V);
    const u32x2* EG = (const u32x2*)(P.ws + OFF_EG) + tok * 128;
    float hv[16], y[16];
    { const u32x4 a = *(const u32x4*)(H + lane * 8), b = *(const u32x4*)(H + 512 + lane * 8);
      hv[0] = bf_lo(a.x); hv[1] = bf_hi(a.x); hv[2] = bf_lo(a.y); hv[3] = bf_hi(a.y); hv[4] = bf_lo(a.z); hv[5] = bf_hi(a.z); hv[6] = bf_lo(a.w); hv[7] = bf_hi(a.w);
      hv[8] = bf_lo(b.x); hv[9] = bf_hi(b.x); hv[10] = bf_lo(b.y); hv[11] = bf_hi(b.y); hv[12] = bf_lo(b.z); hv[13] = bf_hi(b.z); hv[14] = bf_lo(b.w); hv[15] = bf_hi(b.w); }
#pragma unroll
    for (int i = 0; i < 16; ++i) y[i] = 0.f;
#pragma unroll 1
    for (int e0 = 0; e0 < 128; e0 += 4) {
        u32x2 eg[4]; u32x4 ua[4], ub[4];
#pragma unroll
        for (int k = 0; k < 4; ++k) eg[k] = EG[e0 + k];
#pragma unroll
        for (int k = 0; k < 4; ++k) { const bf16_t* ur = U + (size_t)eg[k].x * 1024; ua[k] = *(const u32x4*)(ur + lane * 8); ub[k] = *(const u32x4*)(ur + 512 + lane * 8); }
        float d[4];
#pragma unroll
        for (int k = 0; k < 4; ++k) {
            float s = hv[0] * bf_lo(ua[k].x) + hv[1] * bf_hi(ua[k].x) + hv[2] * bf_lo(ua[k].y) + hv[3] * bf_hi(ua[k].y) + hv[4] * bf_lo(ua[k].z) + hv[5] * bf_hi(ua[k].z) + hv[6] * bf_lo(ua[k].w) + hv[7] * bf_hi(ua[k].w);
            s += hv[8] * bf_lo(ub[k].x) + hv[9] * bf_hi(ub[k].x) + hv[10] * bf_lo(ub[k].y) + hv[11] * bf_hi(ub[k].y) + hv[12] * bf_lo(ub[k].z) + hv[13] * bf_hi(ub[k].z) + hv[14] * bf_lo(ub[k].w) + hv[15] * bf_hi(ub[k].w);
            d[k] = s;
        }
#pragma unroll
        for (int k = 0; k < 4; ++k) { const bf16_t* vr = V + (size_t)eg[k].x * 1024; ua[k] = *(const u32x4*)(vr + lane * 8); ub[k] = *(const u32x4*)(vr + 512 + lane * 8); }
#pragma unroll
        for (int k = 0; k < 4; ++k) {
            const float dot = wave_sum(d[k]);
            const float act = 0.5f * dot * (1.0f + erff(dot * 0.70710678118654752f));
            const float w = __uint_as_float(eg[k].y) * act;
            y[0] += w * bf_lo(ua[k].x); y[1] += w * bf_hi(ua[k].x); y[2] += w * bf_lo(ua[k].y); y[3] += w * bf_hi(ua[k].y); y[4] += w * bf_lo(ua[k].z); y[5] += w * bf_hi(ua[k].z); y[6] += w * bf_lo(ua[k].w); y[7] += w * bf_hi(ua[k].w);
            y[8] += w * bf_lo(ub[k].x); y[9] += w * bf_hi(ub[k].x); y[10] += w * bf_lo(ub[k].y); y[11] += w * bf_hi(ub[k].y); y[12] += w * bf_lo(ub[k].z); y[13] += w * bf_hi(ub[k].z); y[14] += w * bf_lo(ub[k].w); y[15] += w * bf_hi(ub[k].w);
        }
    }
    const int b = (int)(tok >> 11);
    const float* gt2 = (const float*)(P.ws + OFF_ADA) + (size_t)b * 6144 + 5120;
    float* xr = P.out + tok * 1024;
    float pre[16]; float s = 0.f;
#pragma unroll
    for (int hb = 0; hb < 2; ++hb)
#pragma unroll
        for (int q4 = 0; q4 < 2; ++q4) {
            const int c = hb * 512 + lane * 8 + q4 * 4;
            const f32x4 xv = *(const f32x4*)(xr + c), gv = *(const f32x4*)(gt2 + c);
#pragma unroll
            for (int e = 0; e < 4; ++e) { const float pvv = ALPHA * xv[e] + gv[e] * y[hb * 8 + q4 * 4 + e]; pre[hb * 8 + q4 * 4 + e] = pvv; s += pvv; }
        }
    const float mean = wave_sum(s) * (1.0f / 1024.0f); float s2 = 0.f;
#pragma unroll
    for (int i = 0; i < 16; ++i) { pre[i] -= mean; s2 += pre[i] * pre[i]; }
    const float rstd = rsqrtf(wave_sum(s2) * (1.0f / 1024.0f) + LN_EPS);
#pragma unroll
    for (int hb = 0; hb < 2; ++hb)
#pragma unroll
        for (int q4 = 0; q4 < 2; ++q4) {
            const int c = hb * 512 + lane * 8 + q4 * 4;
            const f32x4 g = *(const f32x4*)(P.ln2_g + c), bb = *(const f32x4*)(P.ln2_b + c);
            f32x4 o;
#pragma unroll
            for (int e = 0; e < 4; ++e) o[e] = pre[hb * 8 + q4 * 4 + e] * rstd * g[e] + bb[e];
            *(f32x4*)(xr + c) = o;
        }
}

__global__ void __launch_bounds__(NTHR, 2) fwd_megakernel(Params P) {
    extern __shared__ __attribute__((aligned(16))) unsigned char shm[];
    LAS unsigned char* lds = (LAS unsigned char*)shm;
    cg::grid_group grid = cg::this_grid();
    const int G = gridDim.x, bid = blockIdx.x;

#ifndef P3
#define P3 0xff
#endif
#ifndef PH
#define PH 0xff
#endif
    if (PH & 1) phase0a(P, lds);
    grid.sync();
    if (PH & 2) phase0b(P);
    grid.sync();
    if (PH & 4) {
        pg8::Gemm g; g.A = (const bf16_t*)(P.ws + OFF_H); g.Bt = (const bf16_t*)(P.ws + OFF_WIN); g.M = NTOK; g.N = INCOLS; g.K = 1024;
        pg8::StaticOrder S; S.init(NTOK, INCOLS, G, bid);
        EpiProj E; E.ws = P.ws; E.lb = (const float*)(P.ws + OFF_LB); E.ng = P.hgrn_ng; E.kmean = (float*)(P.ws + OFF_KMEAN);
        pg8::gemm_phase<EpiProj, pg8::StaticOrder>(lds, g, S, E);
    }
    grid.sync();
    if (PH & 8) for (int it = bid; it < 256; it += G) hgrn_item(P, it, lds);
    if (PH & 16) for (int u = bid; u < 2048; u += G) { const int bh = u & 255, jj = u >> 8; moba_unit(P, bh >> 3, bh & 7, (jj + bh) & 7, lds); }
    grid.sync();
    if (PH & 32) for (int pm = bid; pm < NTOK / 256; pm += G) {
        if (P3 & 1) yb_norm_panel(P, pm);
        __syncthreads();
        if (P3 & 2) { pg8::Gemm g; g.A = (const bf16_t*)(P.ws + OFF_QA); g.Bt = (const bf16_t*)(P.ws + OFF_WBA); g.M = NTOK; g.N = 1024; g.K = 512;
          pg8::PanelOrder S; S.pm = pm; S.npn = 4; EpiMixA E; E.GA = (bf16_t*)(P.ws + OFF_GA);
          pg8::gemm_phase<EpiMixA, pg8::PanelOrder>(lds, g, S, E); }
        __syncthreads();
        if (P3 & 4) { pg8::Gemm g; g.A = (const bf16_t*)(P.ws + OFF_HI); g.Bt = (const bf16_t*)(P.ws + OFF_WBB); g.M = NTOK; g.N = 1024; g.K = 512;
          pg8::PanelOrder S; S.pm = pm; S.npn = 4; EpiMixB E; E.GA = (bf16_t*)(P.ws + OFF_GA); E.GB = (const bf16_t*)(P.ws + OFF_GB);
          pg8::gemm_phase<EpiMixB, pg8::PanelOrder>(lds, g, S, E); }
        __syncthreads();
        if (P3 & 8) { pg8::Gemm g; g.A = (const bf16_t*)(P.ws + OFF_GA); g.Bt = (const bf16_t*)(P.ws + OFF_WOUT); g.M = NTOK; g.N = 1024; g.K = 1024;
          pg8::PanelOrder S; S.pm = pm; S.npn = 4; EpiOut E; E.x = P.x; E.ada = (const float*)(P.ws + OFF_ADA); E.out = P.out;
          pg8::gemm_phase<EpiOut, pg8::PanelOrder>(lds, g, S, E); }
        __syncthreads();
        if (P3 & 16) ln1_panel(P, pm);
        __syncthreads();
        if (P3 & 32) { pg8::Gemm g; g.A = (const bf16_t*)(P.ws + OFF_H); g.Bt = (const bf16_t*)(P.ws + OFF_WQ); g.M = NTOK; g.N = 1024; g.K = 1024;
          pg8::PanelOrder S; S.pm = pm; S.npn = 4; EpiBf16 E; E.O = (bf16_t*)(P.ws + OFF_GB);
          pg8::gemm_phase<EpiBf16, pg8::PanelOrder>(lds, g, S, E); }
        __syncthreads();
        { const size_t tok0 = (size_t)pm * 256 + (tid_opaque() >> 6) * 32;
          if (P3 & 64) peer_select_wave(P, tok0);
          __syncthreads();
          if (P3 & 128)
#pragma unroll 1
          for (int t = 0; t < 32; ++t) peer_gather_token(P, tok0 + t); }
        __syncthreads();
    }
}

extern "C" void kernel_launch(void* const* d_in, const int* in_sizes, int n_in, void* d_out, int out_size, void* d_ws, size_t ws_size, hipStream_t stream) {
    static int grid_blocks = 0;
    if (grid_blocks == 0) {
        if (n_in != 18 || out_size != NTOK * DM || ws_size < WS_END) { fprintf(stderr, "kernel_launch: unexpected shapes (n_in %d, out %d, ws %zu, need %zu)\n", n_in, out_size, ws_size, (size_t)WS_END); grid_blocks = -1; return; }
        int dev = 0, cus = 0, per_cu = 0;
        hipGetDevice(&dev);
        hipDeviceGetAttribute(&cus, hipDeviceAttributeMultiprocessorCount, dev);
        if (hipFuncSetAttribute((const void*)fwd_megakernel, hipFuncAttributeMaxDynamicSharedMemorySize, LDS_BYTES) != hipSuccess) fprintf(stderr, "kernel_launch: hipFuncSetAttribute failed\n");
        hipOccupancyMaxActiveBlocksPerMultiprocessor(&per_cu, (const void*)fwd_megakernel, NTHR, LDS_BYTES);
        if (per_cu < 1) { fprintf(stderr, "kernel_launch: occupancy query says %d blocks per CU\n", per_cu); per_cu = 1; }
        if (per_cu > 1) per_cu = 1;
        grid_blocks = cus * per_cu;
        (void)hipGetLastError();
    }
    if (grid_blocks < 0) return;
    Params p{};
    p.x = (const float*)d_in[0]; p.c = (const float*)d_in[1]; p.w_ada = (const float*)d_in[2]; p.b_ada = (const float*)d_in[3]; p.w_in = (const float*)d_in[4];
    p.w_ba = (const float*)d_in[5]; p.w_bb = (const float*)d_in[6]; p.w_out = (const float*)d_in[7]; p.hgrn_lb = (const float*)d_in[8]; p.hgrn_ng = (const float*)d_in[9];
    p.ln1_g = (const float*)d_in[10]; p.ln1_b = (const float*)d_in[11]; p.peer_wq = (const float*)d_in[12]; p.peer_sk = (const float*)d_in[13]; p.peer_u = (const float*)d_in[14];
    p.peer_v = (const float*)d_in[15]; p.ln2_g = (const float*)d_in[16]; p.ln2_b = (const float*)d_in[17];
    p.out = (float*)d_out; p.ws = (unsigned char*)d_ws;
    void* args[] = {&p};
    hipError_t e = hipLaunchCooperativeKernel((const void*)fwd_megakernel, dim3(grid_blocks), dim3(NTHR), args, LDS_BYTES, stream);
    if (e != hipSuccess) fprintf(stderr, "cooperative launch failed: %s (grid %d)\n", hipGetErrorString(e), grid_blocks);
}
```

```cpp
#include <hip/hip_runtime.h>
#include <hip/hip_cooperative_groups.h>
#include <cstdio>
#include <cstdint>
namespace cg = cooperative_groups;

#define LAS __attribute__((address_space(3)))
typedef unsigned short bf16_t;
typedef short bf16x8 __attribute__((ext_vector_type(8)));
typedef short s16x4 __attribute__((ext_vector_type(4)));
typedef float f32x2 __attribute__((ext_vector_type(2)));
typedef float f32x4 __attribute__((ext_vector_type(4)));
typedef float f32x16 __attribute__((ext_vector_type(16)));
typedef unsigned u32x2 __attribute__((ext_vector_type(2)));
typedef unsigned u32x4 __attribute__((ext_vector_type(4)));

constexpr int NB = 32, SEQ = 2048, DM = 1024, NTOK = NB * SEQ;
constexpr int INCOLS = 5632;
constexpr int NTHR = 512;
constexpr int LDS_BYTES = 147456;
constexpr float ALPHA = 1.189207115002721f;
constexpr float LN_EPS = 1e-5f, RMS_EPS = 1e-6f;
constexpr float LOG2E = 1.4426950408889634f;

constexpr size_t SZ_T512 = (size_t)NTOK * 512 * 2, SZ_T1024 = (size_t)NTOK * 1024 * 2;
constexpr size_t OFF_ADA = 0;
constexpr size_t OFF_LB = OFF_ADA + 786432;
constexpr size_t OFF_KMEAN = OFF_LB + 4096;
constexpr size_t OFF_WIN = OFF_KMEAN + 524288;
constexpr size_t OFF_WBA = OFF_WIN + (size_t)5632 * 1024 * 2;
constexpr size_t OFF_WBB = OFF_WBA + 1048576;
constexpr size_t OFF_WOUT = OFF_WBB + 1048576;
constexpr size_t OFF_WQ = OFF_WOUT + 2097152;
constexpr size_t OFF_SK = OFF_WQ + 2097152;
constexpr size_t OFF_U8 = OFF_SK + 262144;
constexpr size_t OFF_V8 = OFF_U8 + 16777216;
constexpr size_t OFF_CTR = OFF_V8 + 16777216;
constexpr size_t OFF_EG = OFF_CTR + 4096;
constexpr size_t OFF_H = OFF_EG + (size_t)NTOK * 128 * 8;
constexpr size_t OFF_QA = OFF_H + SZ_T1024;
constexpr size_t OFF_KA = OFF_QA + SZ_T512;
constexpr size_t OFF_VA = OFF_KA + SZ_T512;
constexpr size_t OFF_HQ = OFF_VA + SZ_T512;
constexpr size_t OFF_HK = OFF_HQ + SZ_T512;
constexpr size_t OFF_HI = OFF_HK + SZ_T512;
constexpr size_t OFF_HG = OFF_HI + SZ_T512;
constexpr size_t OFF_GA = OFF_HG + SZ_T512;
constexpr size_t OFF_GB = OFF_GA + SZ_T1024;
constexpr size_t WS_END = OFF_GB + SZ_T1024;
constexpr size_t OFF_W = OFF_QA;
constexpr size_t OFF_Y = OFF_KA;

struct Params {
    const float *x, *c, *w_ada, *b_ada, *w_in, *w_ba, *w_bb, *w_out, *hgrn_lb, *hgrn_ng, *ln1_g, *ln1_b, *peer_wq, *peer_sk, *peer_u, *peer_v, *ln2_g, *ln2_b;
    float* out;
    unsigned char* ws;
};

__device__ __forceinline__ unsigned cvt_pk_bf16(float lo, float hi) { unsigned r; asm("v_cvt_pk_bf16_f32 %0, %1, %2" : "=v"(r) : "v"(lo), "v"(hi)); return r; }
__device__ __forceinline__ float bf_lo(unsigned w) { return __uint_as_float(w << 16); }
__device__ __forceinline__ float bf_hi(unsigned w) { return __uint_as_float(w & 0xffff0000u); }
__device__ __forceinline__ float sigmoidf_(float x) { return 1.0f / (1.0f + __expf(-x)); }
__device__ __forceinline__ float wave_sum(float v) {
#pragma unroll
    for (int o = 1; o < 64; o <<= 1) v += __shfl_xor(v, o);
    return v;
}
__device__ __forceinline__ int tid_opaque() { int t = threadIdx.x; asm volatile("" : "+v"(t)); return t; }
__device__ __forceinline__ int crow(int r, int hi) { return (r & 3) + 8 * (r >> 2) + 4 * hi; }
#define MFMA32(a, b, c) __builtin_amdgcn_mfma_f32_32x32x16_bf16(a, b, c, 0, 0, 0)

namespace pg8 {
constexpr int BM = 256, BK = 64, HALF = 128, HTB = HALF * BK * 2, STAGE_BYTES = 8 * HTB, NXCD = 8, WGM = 8;
__host__ __device__ __forceinline__ int lds_byte(int r, int c) { const int st = (r >> 4) * 2 + (c >> 5), rr = r & 15, cc = c & 31, ob = rr * 64 + cc * 2; return st * 1024 + (ob ^ (((ob >> 9) & 1) << 5)); }
__host__ __device__ __forceinline__ void stage_rc(int b, int& R, int& C) { const int st = b / 1024, sb = b % 1024, swz = sb ^ (((sb >> 9) & 1) << 5); R = (st >> 1) * 16 + swz / 64; C = (st & 1) * 32 + (swz % 64) / 2; }
__host__ __device__ __forceinline__ int perm32(int rho) { const int n = rho >> 4, i = rho & 15; return 8 * (i >> 2) + 4 * n + (i & 3); }

struct Unit { int pm, pn; };
struct Gemm { const bf16_t* A; const bf16_t* Bt; int M, N, K; };

struct StaticOrder {
    int nM, nN, nwg, G, c;
    __device__ void init(int M, int N, int G_, int c_) { nM = M / BM; nN = N / BM; nwg = nM * nN; G = G_; c = c_; }
    __device__ bool next(int i, Unit& u) const {
        const long L = (long)i * G + c; if (L >= nwg) return false;
        int wgid = (int)L; { const int q = nwg / NXCD, r = nwg % NXCD, xcd = wgid % NXCD, off = wgid / NXCD; wgid = (xcd < r ? xcd * (q + 1) : r * (q + 1) + (xcd - r) * q) + off; }
        const int nig = WGM * nN, gid = wgid / nig, fm = gid * WGM, gsz = (nM - fm) < WGM ? (nM - fm) : WGM;
        u.pm = fm + ((wgid % nig) % gsz); u.pn = (wgid % nig) / gsz; return true;
    }
};
struct PanelOrder {
    int pm, npn;
    __device__ bool next(int i, Unit& u) const { if (i >= npn) return false; u.pm = pm; u.pn = i; return true; }
};

template <class Epi, class Sched>
__device__ __forceinline__ void gemm_phase(LAS unsigned char* lds, const Gemm g, const Sched& S, const Epi& E) {
    const int tid = tid_opaque(), wid = __builtin_amdgcn_readfirstlane(tid >> 6), lane = tid & 63, wr = wid >> 2, wc = wid & 3, fr = lane & 15, fq = lane >> 4;
    const int K = g.K, nt = K / BK;
    unsigned voffA[2], voffB[2];
#pragma unroll
    for (int i = 0; i < 2; ++i) { int R, C; stage_rc(tid * 16 + i * 8192, R, C); const int Rb = Epi::PERM ? ((R & ~31) + perm32(R & 31)) : R;
        voffA[i] = (unsigned)(R * K + C) * 2u; voffB[i] = (unsigned)(Rb * K + C) * 2u; }
    const size_t kstep = (size_t)(BK * 2);
    const size_t hstep = (size_t)HALF * K * 2;
    const size_t tstep = 2 * hstep;
    const unsigned ldsw = (unsigned)wid * 1024u;
    const int aoff = lds_byte(wr * 64 + fr, fq * 8), boff = lds_byte(wc * 32 + fr, fq * 8);
#define PG8_SA(b, h) (((b) * 2 + (h)) * HTB)
#define PG8_SB(b, h) ((4 + (b) * 2 + (h)) * HTB)
#define PG8_STAGE(bufoff, gbase, voff) do { _Pragma("unroll") for (int _i = 0; _i < 2; ++_i) \
        __builtin_amdgcn_global_load_lds((const unsigned*)((const char*)(gbase) + (voff)[_i]), (LAS unsigned*)(lds + (bufoff) + ldsw + _i * 8192), 16, 0, 0); } while (0)
#define PG8_LDA(dst, b, h) do { _Pragma("unroll") for (int m = 0; m < 4; ++m) _Pragma("unroll") for (int k = 0; k < 2; ++k) dst[m][k] = *(const LAS bf16x8*)(lds + PG8_SA(b, h) + aoff + m * 2048 + k * 1024); } while (0)
#define PG8_LDB(dst, b, h) do { _Pragma("unroll") for (int n = 0; n < 2; ++n) _Pragma("unroll") for (int k = 0; k < 2; ++k) dst[n][k] = *(const LAS bf16x8*)(lds + PG8_SB(b, h) + boff + n * 2048 + k * 1024); } while (0)
#define PG8_MMA(ai, bj, At, Bt) do { __builtin_amdgcn_s_setprio(1); _Pragma("unroll") for (int m = 0; m < 4; ++m) _Pragma("unroll") for (int n = 0; n < 2; ++n) _Pragma("unroll") for (int k = 0; k < 2; ++k) \
        acc[ai][bj][m][n] = __builtin_amdgcn_mfma_f32_16x16x32_bf16(Bt[n][k], At[m][k], acc[ai][bj][m][n], 0, 0, 0); __builtin_amdgcn_s_setprio(0); } while (0)
#define PG8_WAIT_V(n) asm volatile("s_waitcnt vmcnt(" #n ")" ::: "memory")
#define PG8_WAIT_L(n) asm volatile("s_waitcnt lgkmcnt(" #n ")" ::: "memory")
#define PG8_BAR __builtin_amdgcn_s_barrier()
#define PG8_SCHED __builtin_amdgcn_sched_barrier(0)
    Unit cur, nxt; int ui = 0;
    if (!S.next(0, cur)) return;
    f32x4 acc[2][2][4][2];
#pragma unroll
    for (int a = 0; a < 2; ++a)
#pragma unroll
        for (int b = 0; b < 2; ++b)
#pragma unroll
            for (int m = 0; m < 4; ++m)
#pragma unroll
                for (int n = 0; n < 2; ++n) acc[a][b][m][n] = (f32x4){0.f, 0.f, 0.f, 0.f};
    bf16x8 At[4][2], B0[2][2], B1[2][2];
    const char* cA = (const char*)g.A + (size_t)cur.pm * tstep; const char* cB = (const char*)g.Bt + (size_t)cur.pn * tstep;
    PG8_STAGE(PG8_SB(0, 0), cB, voffB); PG8_STAGE(PG8_SA(0, 0), cA, voffA); PG8_STAGE(PG8_SB(0, 1), cB + hstep, voffB); PG8_STAGE(PG8_SA(0, 1), cA + hstep, voffA);
    if (wr == 1) PG8_BAR;
    PG8_WAIT_V(4); PG8_BAR;
    PG8_STAGE(PG8_SB(1, 0), cB + kstep, voffB); PG8_STAGE(PG8_SA(1, 0), cA + kstep, voffA); PG8_STAGE(PG8_SB(1, 1), cB + hstep + kstep, voffB);
    PG8_WAIT_V(6); PG8_BAR;
    for (;;) {
        const bool has_next = S.next(ui + 1, nxt);
        const char* nA = has_next ? (const char*)g.A + (size_t)nxt.pm * tstep : cA; const char* nB = has_next ? (const char*)g.Bt + (size_t)nxt.pn * tstep : cB;
        for (int t = 0; t < nt; t += 2) {
            const bool last = (t == nt - 2);
            const char* a1 = cA + (size_t)(t + 1) * kstep;
            const char* a2 = last ? nA : cA + (size_t)(t + 2) * kstep; const char* b2 = last ? nB : cB + (size_t)(t + 2) * kstep;
            const char* a3 = a2 + kstep; const char* b3 = b2 + kstep;
            PG8_LDB(B0, 0, 0); PG8_SCHED; PG8_LDA(At, 0, 0); PG8_STAGE(PG8_SA(1, 1), a1 + hstep, voffA);
            PG8_WAIT_L(8); PG8_BAR; PG8_WAIT_L(0); PG8_MMA(0, 0, At, B0); PG8_BAR; PG8_SCHED;
            PG8_LDB(B1, 0, 1); PG8_STAGE(PG8_SB(0, 0), b2, voffB);
            PG8_BAR; PG8_WAIT_L(0); PG8_MMA(0, 1, At, B1); PG8_BAR;
            PG8_LDA(At, 0, 1); PG8_STAGE(PG8_SA(0, 0), a2, voffA);
            PG8_BAR; PG8_WAIT_L(0); PG8_MMA(1, 0, At, B0); PG8_BAR; PG8_SCHED;
            PG8_STAGE(PG8_SB(0, 1), b2 + hstep, voffB);
            PG8_WAIT_V(6); PG8_BAR; PG8_MMA(1, 1, At, B1); PG8_BAR;
            PG8_LDB(B0, 1, 0); PG8_SCHED; PG8_LDA(At, 1, 0); PG8_STAGE(PG8_SA(0, 1), a2 + hstep, voffA);
            PG8_WAIT_L(8); PG8_BAR; PG8_WAIT_L(0); PG8_MMA(0, 0, At, B0); PG8_BAR; PG8_SCHED;
            PG8_LDB(B1, 1, 1); PG8_STAGE(PG8_SB(1, 0), b3, voffB);
            PG8_BAR; PG8_WAIT_L(0); PG8_MMA(0, 1, At, B1); PG8_BAR;
            PG8_LDA(At, 1, 1); PG8_STAGE(PG8_SA(1, 0), a3, voffA);
            PG8_BAR; PG8_WAIT_L(0); PG8_MMA(1, 0, At, B0); PG8_BAR; PG8_SCHED;
            PG8_STAGE(PG8_SB(1, 1), b3 + hstep, voffB);
            PG8_WAIT_V(6); PG8_BAR; PG8_MMA(1, 1, At, B1); PG8_BAR;
        }
        E(acc, cur, wr, wc, fr, fq);
        if (!has_next) break;
#pragma unroll
        for (int a = 0; a < 2; ++a)
#pragma unroll
            for (int b = 0; b < 2; ++b)
#pragma unroll
                for (int m = 0; m < 4; ++m)
#pragma unroll
                    for (int n = 0; n < 2; ++n) acc[a][b][m][n] = (f32x4){0.f, 0.f, 0.f, 0.f};
        cur = nxt; cA = nA; cB = nB; ++ui;
    }
    PG8_WAIT_V(0);
    if (wr == 0) PG8_BAR;
    PG8_BAR;
#undef PG8_SA
#undef PG8_SB
#undef PG8_STAGE
#undef PG8_LDA
#undef PG8_LDB
#undef PG8_MMA
#undef PG8_WAIT_V
#undef PG8_WAIT_L
#undef PG8_BAR
#undef PG8_SCHED
}
}
using pg8::Unit;

struct EpiProj {
    static constexpr bool PERM = true;
    unsigned char* ws; const float* lb; const float* ng; float* kmean;
    __device__ __forceinline__ void operator()(const f32x4 (&acc)[2][2][4][2], const Unit& u, int wr, int wc, int fr, int fq) const {
        const int pn = u.pn; int seg, colt, ldc; size_t boff;
        if (pn < 14) { seg = pn >> 1; colt = (pn & 1) * 256; ldc = 512; boff = OFF_QA + (size_t)seg * SZ_T512; }
        else if (pn < 18) { seg = 7; colt = (pn - 14) * 256; ldc = 1024; boff = OFF_GA; }
        else { seg = 8; colt = (pn - 18) * 256; ldc = 1024; boff = OFF_GB; }
        bf16_t* base = (bf16_t*)(ws + boff);
        const int row0 = u.pm * 256 + wr * 64 + fr, col0 = colt + wc * 32 + 8 * fq;
        float pv[2][8];
#pragma unroll
        for (int bj = 0; bj < 2; ++bj)
#pragma unroll
            for (int e = 0; e < 8; ++e) pv[bj][e] = (seg == 4) ? (1.0f - lb[col0 + bj * 128 + e]) : ((seg == 6) ? ng[col0 + bj * 128 + e] : 0.f);
        float cs[2][8];
#pragma unroll
        for (int bj = 0; bj < 2; ++bj)
#pragma unroll
            for (int e = 0; e < 8; ++e) cs[bj][e] = 0.f;
#pragma unroll
        for (int ai = 0; ai < 2; ++ai)
#pragma unroll
            for (int m = 0; m < 4; ++m) {
                bf16_t* rowp = base + (size_t)(row0 + ai * 128 + m * 16) * ldc + col0;
#pragma unroll
                for (int bj = 0; bj < 2; ++bj) {
                    float v[8];
#pragma unroll
                    for (int e = 0; e < 4; ++e) { v[e] = acc[ai][bj][m][0][e]; v[4 + e] = acc[ai][bj][m][1][e]; }
                    if (seg == 0) {
#pragma unroll
                        for (int e = 0; e < 8; ++e) v[e] *= (0.125f * LOG2E);
                    } else if (seg == 1) {
#pragma unroll
                        for (int e = 0; e < 8; ++e) cs[bj][e] += v[e];
                    } else if (seg == 3) {
#pragma unroll
                        for (int e = 0; e < 8; ++e) v[e] = v[e] * sigmoidf_(v[e]);
                    } else if (seg == 4) {
#pragma unroll
                        for (int e = 0; e < 8; ++e) v[e] = pv[bj][e] * sigmoidf_(-v[e]);
                    } else if (seg == 6) {
#pragma unroll
                        for (int e = 0; e < 8; ++e) v[e] = pv[bj][e] * v[e] * sigmoidf_(v[e]);
                    } else if (seg >= 7) {
#pragma unroll
                        for (int e = 0; e < 8; ++e) v[e] = sigmoidf_(v[e]);
                    }
                    u32x4 w; w.x = cvt_pk_bf16(v[0], v[1]); w.y = cvt_pk_bf16(v[2], v[3]); w.z = cvt_pk_bf16(v[4], v[5]); w.w = cvt_pk_bf16(v[6], v[7]);
                    *(u32x4*)(rowp + bj * 128) = w;
                }
            }
        if (seg == 1) {
#pragma unroll
            for (int bj = 0; bj < 2; ++bj)
#pragma unroll
                for (int e = 0; e < 8; ++e) {
                    float s = cs[bj][e];
                    s += __shfl_xor(s, 1); s += __shfl_xor(s, 2); s += __shfl_xor(s, 4); s += __shfl_xor(s, 8);
                    if (fr == 0) atomicAdd(kmean + (size_t)u.pm * 512 + col0 + bj * 128 + e, s);
                }
        }
    }
};
struct EpiMixA {
    static constexpr bool PERM = true;
    bf16_t* GA;
    __device__ __forceinline__ void operator()(const f32x4 (&acc)[2][2][4][2], const Unit& u, int wr, int wc, int fr, int fq) const {
        const int row0 = u.pm * 256 + wr * 64 + fr, col0 = u.pn * 256 + wc * 32 + 8 * fq;
#pragma unroll
        for (int ai = 0; ai < 2; ++ai)
#pragma unroll
            for (int m = 0; m < 4; ++m) {
                bf16_t* rowp = GA + (size_t)(row0 + ai * 128 + m * 16) * 1024 + col0;
#pragma unroll
                for (int bj = 0; bj < 2; ++bj) {
                    const u32x4 g = *(const u32x4*)(rowp + bj * 128);
                    const f32x4 a0 = acc[ai][bj][m][0], a1 = acc[ai][bj][m][1];
                    u32x4 w;
                    w.x = cvt_pk_bf16(bf_lo(g.x) * a0[0], bf_hi(g.x) * a0[1]); w.y = cvt_pk_bf16(bf_lo(g.y) * a0[2], bf_hi(g.y) * a0[3]);
                    w.z = cvt_pk_bf16(bf_lo(g.z) * a1[0], bf_hi(g.z) * a1[1]); w.w = cvt_pk_bf16(bf_lo(g.w) * a1[2], bf_hi(g.w) * a1[3]);
                    *(u32x4*)(rowp + bj * 128) = w;
                }
            }
    }
};
struct EpiMixB {
    static constexpr bool PERM = true;
    bf16_t* GA; const bf16_t* GB;
    __device__ __forceinline__ void operator()(const f32x4 (&acc)[2][2][4][2], const Unit& u, int wr, int wc, int fr, int fq) const {
        const int row0 = u.pm * 256 + wr * 64 + fr, col0 = u.pn * 256 + wc * 32 + 8 * fq;
#pragma unroll
        for (int ai = 0; ai < 2; ++ai)
#pragma unroll
            for (int m = 0; m < 4; ++m) {
                const size_t off = (size_t)(row0 + ai * 128 + m * 16) * 1024 + col0;
#pragma unroll
                for (int bj = 0; bj < 2; ++bj) {
                    const u32x4 g = *(const u32x4*)(GB + off + bj * 128);
                    const u32x4 mx = *(const u32x4*)(GA + off + bj * 128);
                    const f32x4 a0 = acc[ai][bj][m][0], a1 = acc[ai][bj][m][1];
                    u32x4 w;
                    w.x = cvt_pk_bf16(bf_lo(mx.x) + bf_lo(g.x) * a0[0], bf_hi(mx.x) + bf_hi(g.x) * a0[1]); w.y = cvt_pk_bf16(bf_lo(mx.y) + bf_lo(g.y) * a0[2], bf_hi(mx.y) + bf_hi(g.y) * a0[3]);
                    w.z = cvt_pk_bf16(bf_lo(mx.z) + bf_lo(g.z) * a1[0], bf_hi(mx.z) + bf_hi(g.z) * a1[1]); w.w = cvt_pk_bf16(bf_lo(mx.w) + bf_lo(g.w) * a1[2], bf_hi(mx.w) + bf_hi(g.w) * a1[3]);
                    *(u32x4*)(GA + off + bj * 128) = w;
                }
            }
    }
};
struct EpiOut {
    static constexpr bool PERM = false;
    const float* x; const float* ada; float* out;
    __device__ __forceinline__ void operator()(const f32x4 (&acc)[2][2][4][2], const Unit& u, int wr, int wc, int fr, int fq) const {
        const int row0 = u.pm * 256 + wr * 64 + fr, col0 = u.pn * 256 + wc * 32 + 4 * fq;
        const float* gt1 = ada + (size_t)(u.pm >> 3) * 6144 + 2048;
#pragma unroll
        for (int ai = 0; ai < 2; ++ai)
#pragma unroll
            for (int m = 0; m < 4; ++m) {
                const size_t off = (size_t)(row0 + ai * 128 + m * 16) * 1024 + col0;
#pragma unroll
                for (int bj = 0; bj < 2; ++bj)
#pragma unroll
                    for (int n = 0; n < 2; ++n) {
                        const int cc = bj * 128 + n * 16;
                        const f32x4 xv = *(const f32x4*)(x + off + cc), gv = *(const f32x4*)(gt1 + col0 + cc);
                        *(f32x4*)(out + off + cc) = xv * ALPHA + gv * acc[ai][bj][m][n];
                    }
            }
    }
};
struct EpiBf16 {
    static constexpr bool PERM = true;
    bf16_t* O;
    __device__ __forceinline__ void operator()(const f32x4 (&acc)[2][2][4][2], const Unit& u, int wr, int wc, int fr, int fq) const {
        const int row0 = u.pm * 256 + wr * 64 + fr, col0 = u.pn * 256 + wc * 32 + 8 * fq;
#pragma unroll
        for (int ai = 0; ai < 2; ++ai)
#pragma unroll
            for (int m = 0; m < 4; ++m) {
                bf16_t* rowp = O + (size_t)(row0 + ai * 128 + m * 16) * 1024 + col0;
#pragma unroll
                for (int bj = 0; bj < 2; ++bj) {
                    const f32x4 a0 = acc[ai][bj][m][0], a1 = acc[ai][bj][m][1];
                    u32x4 w; w.x = cvt_pk_bf16(a0[0], a0[1]); w.y = cvt_pk_bf16(a0[2], a0[3]); w.z = cvt_pk_bf16(a1[0], a1[1]); w.w = cvt_pk_bf16(a1[2], a1[3]);
                    *(u32x4*)(rowp + bj * 128) = w;
                }
            }
    }
};

__device__ void phase0a(const Params& P, LAS unsigned char* lds) {
    const int tid = tid_opaque(), G = gridDim.x, bid = blockIdx.x;
    for (int it = bid; it < 192; it += G) {
        LAS float* sc = (LAS float*)lds;
        for (int i = tid; i < 32 * 1024; i += NTHR) { const float cv = P.c[i]; sc[i] = cv * sigmoidf_(cv); }
        __syncthreads();
        const int kg = tid >> 5, col = tid & 31;
        float a[32];
#pragma unroll
        for (int b = 0; b < 32; ++b) a[b] = 0.f;
        for (int k = kg * 64; k < kg * 64 + 64; k += 4) {
            float w[4];
#pragma unroll
            for (int e = 0; e < 4; ++e) w[e] = P.w_ada[(size_t)(k + e) * 6144 + it * 32 + col];
#pragma unroll
            for (int b = 0; b < 32; ++b) { const f32x4 s = *(const LAS f32x4*)(sc + b * 1024 + k); a[b] += s[0] * w[0] + s[1] * w[1] + s[2] * w[2] + s[3] * w[3]; }
        }
        __syncthreads();
        LAS float* red = (LAS float*)lds;
#pragma unroll
        for (int b = 0; b < 32; ++b) red[(kg * 32 + b) * 32 + col] = a[b];
        __syncthreads();
        for (int o = tid; o < 1024; o += NTHR) { const int b = o >> 5, cc = o & 31; float s = 0.f;
#pragma unroll
            for (int g2 = 0; g2 < 16; ++g2) s += red[(g2 * 32 + b) * 32 + cc];
            ((float*)(P.ws + OFF_ADA))[(size_t)b * 6144 + it * 32 + cc] = s + P.b_ada[it * 32 + cc]; }
        __syncthreads();
    }
    const size_t gtid = (size_t)bid * NTHR + tid, gsz = (size_t)G * NTHR;
    for (size_t i = gtid; i < 512; i += gsz) ((float*)(P.ws + OFF_LB))[i] = sigmoidf_(P.hgrn_lb[i] - P.hgrn_lb[512 + i]);
    for (size_t i = gtid; i < 32 * 8 * 512; i += gsz) ((float*)(P.ws + OFF_KMEAN))[i] = 0.f;
    {
        LAS float* tile = (LAS float*)lds;
        const int I0 = 16 * 88, I1 = I0 + 8 * 16, I2 = I1 + 8 * 16, I3 = I2 + 16 * 16, I4 = I3 + 16 * 16;
        for (int it = bid; it < I4; it += G) {
            const float* W; bf16_t* WT; int K, N, r;
            if (it < I0) { W = P.w_in; WT = (bf16_t*)(P.ws + OFF_WIN); K = 1024; N = 5632; r = it; }
            else if (it < I1) { W = P.w_ba; WT = (bf16_t*)(P.ws + OFF_WBA); K = 512; N = 1024; r = it - I0; }
            else if (it < I2) { W = P.w_bb; WT = (bf16_t*)(P.ws + OFF_WBB); K = 512; N = 1024; r = it - I1; }
            else if (it < I3) { W = P.w_out; WT = (bf16_t*)(P.ws + OFF_WOUT); K = 1024; N = 1024; r = it - I2; }
            else { W = P.peer_wq; WT = (bf16_t*)(P.ws + OFF_WQ); K = 1024; N = 1024; r = it - I3; }
            const int nb = N / 64, k0 = (r / nb) * 64, n0 = (r % nb) * 64;
#pragma unroll
            for (int ps = 0; ps < 2; ++ps) { const int kk = (tid >> 4) + 32 * ps, n4 = (tid & 15) * 4;
                const f32x4 v = *(const f32x4*)(W + (size_t)(k0 + kk) * N + n0 + n4);
                tile[kk * 65 + n4] = v[0]; tile[kk * 65 + n4 + 1] = v[1]; tile[kk * 65 + n4 + 2] = v[2]; tile[kk * 65 + n4 + 3] = v[3]; }
            __syncthreads();
            { const int n = tid >> 3, kc = (tid & 7) * 8; u32x4 w;
              w.x = cvt_pk_bf16(tile[(kc + 0) * 65 + n], tile[(kc + 1) * 65 + n]); w.y = cvt_pk_bf16(tile[(kc + 2) * 65 + n], tile[(kc + 3) * 65 + n]);
              w.z = cvt_pk_bf16(tile[(kc + 4) * 65 + n], tile[(kc + 5) * 65 + n]); w.w = cvt_pk_bf16(tile[(kc + 6) * 65 + n], tile[(kc + 7) * 65 + n]);
              *(u32x4*)(WT + (size_t)(n0 + n) * K + k0 + kc) = w; }
            __syncthreads();
        }
    }
    {
        if (gtid < 16) ((unsigned*)(P.ws + OFF_CTR))[gtid] = 0u;
        for (size_t i = gtid; i < 16384; i += gsz) {
            const float* src = P.peer_sk + i * 8; const f32x4 a = *(const f32x4*)src, b = *(const f32x4*)(src + 4);
            u32x4 w; w.x = cvt_pk_bf16(a[0], a[1]); w.y = cvt_pk_bf16(a[2], a[3]); w.z = cvt_pk_bf16(b[0], b[1]); w.w = cvt_pk_bf16(b[2], b[3]);
            *(u32x4*)((bf16_t*)(P.ws + OFF_SK) + i * 8) = w;
        }
        const size_t NV = (size_t)16384 * 1024 / 8;
        for (size_t i = gtid; i < 2 * NV; i += gsz) {
            const bool isv = i >= NV; const size_t j = isv ? i - NV : i;
            const float* src = (isv ? P.peer_v : P.peer_u) + j * 8; const float sc = isv ? 4.0f : 32.0f;
            const f32x4 a = *(const f32x4*)src * sc, b = *(const f32x4*)(src + 4) * sc;
            int w0 = __builtin_amdgcn_cvt_pk_fp8_f32(a[0], a[1], 0, false); w0 = __builtin_amdgcn_cvt_pk_fp8_f32(a[2], a[3], w0, true);
            int w1 = __builtin_amdgcn_cvt_pk_fp8_f32(b[0], b[1], 0, false); w1 = __builtin_amdgcn_cvt_pk_fp8_f32(b[2], b[3], w1, true);
            u32x2 w; w.x = (unsigned)w0; w.y = (unsigned)w1;
            size_t dst;
            if (!isv) dst = OFF_U8 + j * 8;
            else { const size_t e = j >> 7; const int d8 = (int)(j & 127) * 8; dst = OFF_V8 + ((size_t)(d8 >> 7) * 16384 + e) * 128 + (d8 & 127); }
            *(u32x2*)(P.ws + dst) = w;
        }
    }
}
__device__ void phase0b(const Params& P) {
    const size_t gtid = (size_t)blockIdx.x * NTHR + threadIdx.x, gsz = (size_t)gridDim.x * NTHR;
    const float* ada = (const float*)(P.ws + OFF_ADA); bf16_t* H = (bf16_t*)(P.ws + OFF_H);
    for (size_t i = gtid; i < (size_t)NTOK * 128; i += gsz) {
        const size_t row = i >> 7; const int c8 = (int)(i & 127) * 8; const int b = (int)(row >> 11);
        const float* xr = P.x + row * 1024 + c8; const float* sh = ada + (size_t)b * 6144 + c8; const float* sc = sh + 1024;
        const f32x4 x0 = *(const f32x4*)xr, x1 = *(const f32x4*)(xr + 4), s0 = *(const f32x4*)sc, s1 = *(const f32x4*)(sc + 4), h0 = *(const f32x4*)sh, h1 = *(const f32x4*)(sh + 4);
        const f32x4 r0 = x0 * (s0 + 1.0f) + h0, r1 = x1 * (s1 + 1.0f) + h1;
        u32x4 w; w.x = cvt_pk_bf16(r0[0], r0[1]); w.y = cvt_pk_bf16(r0[2], r0[3]); w.z = cvt_pk_bf16(r1[0], r1[1]); w.w = cvt_pk_bf16(r1[2], r1[3]);
        *(u32x4*)(H + row * 1024 + c8) = w;
    }
}

__device__ void hgrn_item(const Params& P, int item, LAS unsigned char* lds) {
    const int tid = tid_opaque(), lane = tid & 63, wid = tid >> 6;
    const int b = item >> 3, h = (item >> 1) & 3, vh = item & 1;
    const bf16_t* HQ = (const bf16_t*)(P.ws + OFF_HQ); const bf16_t* HK = (const bf16_t*)(P.ws + OFF_HK); bf16_t* HI = (bf16_t*)(P.ws + OFF_HI);
    LAS float* qs = (LAS float*)lds;
    LAS float* ks = (LAS float*)(lds + 16384);
    LAS float* vs = (LAS float*)(lds + 32768);
    LAS float* part = (LAS float*)(lds + 40960);
    float S[16];
#pragma unroll
    for (int i = 0; i < 16; ++i) S[i] = 0.f;
    const size_t rowb = (size_t)b * SEQ;
    for (int t0 = 0; t0 < SEQ; t0 += 32) {
        { const int row = tid >> 4, c8 = (tid & 15) * 8; const size_t g = (rowb + t0 + row) * 512 + h * 128 + c8;
          const u32x4 qv = *(const u32x4*)(HQ + g), kv = *(const u32x4*)(HK + g);
          LAS float* qd = qs + row * 128 + c8; LAS float* kd = ks + row * 128 + c8;
          *(LAS f32x4*)qd = (f32x4){bf_lo(qv.x), bf_hi(qv.x), bf_lo(qv.y), bf_hi(qv.y)}; *(LAS f32x4*)(qd + 4) = (f32x4){bf_lo(qv.z), bf_hi(qv.z), bf_lo(qv.w), bf_hi(qv.w)};
          *(LAS f32x4*)kd = (f32x4){bf_lo(kv.x), bf_hi(kv.x), bf_lo(kv.y), bf_hi(kv.y)}; *(LAS f32x4*)(kd + 4) = (f32x4){bf_lo(kv.z), bf_hi(kv.z), bf_lo(kv.w), bf_hi(kv.w)};
          const int c4 = (tid & 15) * 4; const u32x2 vv = *(const u32x2*)(HI + (rowb + t0 + row) * 512 + h * 128 + vh * 64 + c4);
          *(LAS f32x4*)(vs + row * 64 + c4) = (f32x4){bf_lo(vv.x), bf_hi(vv.x), bf_lo(vv.y), bf_hi(vv.y)}; }
        __syncthreads();
        for (int t = 0; t < 32; ++t) {
            const float v = vs[t * 64 + lane]; float op = 0.f;
#pragma unroll
            for (int i4 = 0; i4 < 4; ++i4) {
                const f32x4 kq = *(const LAS f32x4*)(ks + t * 128 + wid * 16 + i4 * 4), qq = *(const LAS f32x4*)(qs + t * 128 + wid * 16 + i4 * 4);
#pragma unroll
                for (int e = 0; e < 4; ++e) { float s = S[i4 * 4 + e]; s += kq[e] * (v - s); S[i4 * 4 + e] = s; op += qq[e] * s; }
            }
            part[(t * 8 + wid) * 64 + lane] = op;
        }
        __syncthreads();
        { const int t = tid >> 4, c4 = (tid & 15) * 4; f32x4 s = (f32x4){0.f, 0.f, 0.f, 0.f};
#pragma unroll
          for (int w = 0; w < 8; ++w) s += *(const LAS f32x4*)(part + (t * 8 + w) * 64 + c4);
          u32x2 o; o.x = cvt_pk_bf16(s[0], s[1]); o.y = cvt_pk_bf16(s[2], s[3]);
          *(u32x2*)(HI + (rowb + t0 + t) * 512 + h * 128 + vh * 64 + c4) = o; }
    }
    __syncthreads();
}

__device__ void moba_unit(const Params& P, int b, int h, int j, LAS unsigned char* lds) {
    const int tid = tid_opaque(), lane = tid & 63, wid = tid >> 6, r32 = lane & 31, hi = lane >> 5;
    bf16_t* Q = (bf16_t*)(P.ws + OFF_QA); const bf16_t* Kg = (const bf16_t*)(P.ws + OFF_KA); const bf16_t* Vg = (const bf16_t*)(P.ws + OFF_VA);
    const float* kmean = (const float*)(P.ws + OFF_KMEAN);
    constexpr int KIMG = 64 * 144, VIMG = 64 * 192, LK = 0, LV = 2 * KIMG, LKM = 2 * KIMG + 2 * VIMG;
    LAS float* kmL = (LAS float*)(lds + LKM);
    const size_t rowb = (size_t)b * SEQ; const int q0 = j * 256;
    if (tid < j * 64) kmL[tid] = kmean[(size_t)(b * 8 + (tid >> 6)) * 512 + h * 64 + (tid & 63)];
    bf16_t* qrow = Q + (rowb + q0 + wid * 32 + r32) * 512 + h * 64;
    bf16x8 qf[4];
#pragma unroll
    for (int d0 = 0; d0 < 4; ++d0) qf[d0] = *(const bf16x8*)(qrow + 16 * d0 + 8 * hi);
    const int srow = tid >> 3, sch = tid & 7;
    const bf16_t* ksrc = Kg + (rowb + srow) * 512 + h * 64 + sch * 8; const bf16_t* vsrc = Vg + (rowb + srow) * 512 + h * 64 + sch * 8;
    const int ntile = 4 * (j + 1);
    u32x4 kreg, vreg;
    { const int key0 = q0; kreg = *(const u32x4*)(ksrc + (size_t)key0 * 512); vreg = *(const u32x4*)(vsrc + (size_t)key0 * 512); }
    *(LAS u32x4*)(lds + LK + srow * 144 + sch * 16) = kreg; *(LAS u32x4*)(lds + LV + srow * 192 + sch * 16) = vreg;
    __syncthreads();
    unsigned sel = 0;
    if (j <= 3) sel = (1u << j) - 1u;
    else {
        float g[7];
#pragma unroll
        for (int n = 0; n < 7; ++n) { float s = 0.f;
            if (n < j) {
#pragma unroll
                for (int d0 = 0; d0 < 4; ++d0)
#pragma unroll
                    for (int e = 0; e < 8; ++e) s += __uint_as_float(((unsigned)(unsigned short)qf[d0][e]) << 16) * kmL[n * 64 + 16 * d0 + 8 * hi + e];
            }
            s += __shfl_xor(s, 32); g[n] = s; }
#pragma unroll
        for (int it = 0; it < 3; ++it) { float best = -INFINITY; int bi = 0;
#pragma unroll
            for (int n = 0; n < 7; ++n) if (n < j && !((sel >> n) & 1u) && g[n] > best) { best = g[n]; bi = n; }
            sel |= 1u << bi; }
    }
    const float ch = exp2f(-(float)(h + 1)) * LOG2E;
    const int qb = wid * 32 + r32;
    float m_run = -1e30f, l_run = 0.f;
    f32x16 o0 = {}, o1 = {};
    const int tg = lane >> 4, tc = tg & 1, ti = lane & 15;
    const int vlane = (4 * hi + (ti >> 2)) * 192 + (16 * tc + 4 * (ti & 3)) * 2;
#pragma unroll 1
    for (int i = 0; i < ntile; ++i) {
        const int buf = i & 1;
        const bool own = i < 4; const int blk = own ? j : ((i - 4) >> 2), kt = own ? i : ((i - 4) & 3);
        if (i + 1 < ntile) { const int i1 = i + 1; const int blk1 = (i1 < 4) ? j : ((i1 - 4) >> 2), kt1 = (i1 < 4) ? i1 : ((i1 - 4) & 3); const size_t key1 = (size_t)(blk1 * 256 + kt1 * 64);
            kreg = *(const u32x4*)(ksrc + key1 * 512); vreg = *(const u32x4*)(vsrc + key1 * 512); }
        const bool lane_ok = own ? true : (((sel >> blk) & 1u) != 0u);
        const bool skip = own ? (64 * kt > 32 * wid + 31) : (__ballot(lane_ok) == 0ull);
        if (!skip) {
            LAS unsigned char* kb = lds + LK + buf * KIMG; LAS unsigned char* vb = lds + LV + buf * VIMG;
            f32x16 p0 = {}, p1 = {};
#pragma unroll
            for (int d0 = 0; d0 < 4; ++d0) {
                const bf16x8 kf0 = *(const LAS bf16x8*)(kb + r32 * 144 + (16 * d0 + 8 * hi) * 2);
                const bf16x8 kf1 = *(const LAS bf16x8*)(kb + (32 + r32) * 144 + (16 * d0 + 8 * hi) * 2);
                p0 = MFMA32(kf0, qf[d0], p0); p1 = MFMA32(kf1, qf[d0], p1);
            }
            const float kbase = ch * (float)((blk - j) * 256 + kt * 64);
            float mt = -1e30f;
#pragma unroll
            for (int r = 0; r < 16; ++r) {
                const int kl0 = crow(r, hi), kl1 = kl0 + 32;
                const float t0 = p0[r] + (kbase + ch * (float)kl0), t1 = p1[r] + (kbase + ch * (float)kl1);
                const bool v0 = own ? (kt * 64 + kl0 <= qb) : lane_ok, v1 = own ? (kt * 64 + kl1 <= qb) : lane_ok;
                p0[r] = v0 ? t0 : -1e30f; p1[r] = v1 ? t1 : -1e30f;
                mt = fmaxf(mt, fmaxf(p0[r], p1[r]));
            }
            mt = fmaxf(mt, __shfl_xor(mt, 32));
            const float mnew = fmaxf(m_run, mt), alpha = __builtin_amdgcn_exp2f(m_run - mnew);
            m_run = mnew;
            float rs = 0.f;
#pragma unroll
            for (int r = 0; r < 16; ++r) { p0[r] = __builtin_amdgcn_exp2f(p0[r] - mnew); p1[r] = __builtin_amdgcn_exp2f(p1[r] - mnew); rs += p0[r] + p1[r]; }
            l_run = l_run * alpha + rs;
#pragma unroll
            for (int r = 0; r < 16; ++r) { o0[r] *= alpha; o1[r] *= alpha; }
#pragma unroll
            for (int sub = 0; sub < 2; ++sub)
#pragma unroll
                for (int s = 0; s < 2; ++s) {
                    union { u32x4 u; bf16x8 v; } pb;
                    if (sub == 0) { pb.u.x = cvt_pk_bf16(p0[8 * s + 0], p0[8 * s + 1]); pb.u.y = cvt_pk_bf16(p0[8 * s + 2], p0[8 * s + 3]); pb.u.z = cvt_pk_bf16(p0[8 * s + 4], p0[8 * s + 5]); pb.u.w = cvt_pk_bf16(p0[8 * s + 6], p0[8 * s + 7]); }
                    else { pb.u.x = cvt_pk_bf16(p1[8 * s + 0], p1[8 * s + 1]); pb.u.y = cvt_pk_bf16(p1[8 * s + 2], p1[8 * s + 3]); pb.u.z = cvt_pk_bf16(p1[8 * s + 4], p1[8 * s + 5]); pb.u.w = cvt_pk_bf16(p1[8 * s + 6], p1[8 * s + 7]); }
#pragma unroll
                    for (int dt = 0; dt < 2; ++dt) {
                        LAS unsigned char* va = vb + (32 * sub + 16 * s) * 192 + dt * 64 + vlane;
                        const s16x4 lo = __builtin_bit_cast(s16x4, __builtin_amdgcn_ds_read_tr16_b64_v4i16((LAS s16x4*)va));
                        const s16x4 hh = __builtin_bit_cast(s16x4, __builtin_amdgcn_ds_read_tr16_b64_v4i16((LAS s16x4*)(va + 8 * 192)));
                        const bf16x8 vf = {lo[0], lo[1], lo[2], lo[3], hh[0], hh[1], hh[2], hh[3]};
                        if (dt == 0) o0 = MFMA32(vf, pb.v, o0); else o1 = MFMA32(vf, pb.v, o1);
                    }
                }
        }
        if (i + 1 < ntile) { const int nb = buf ^ 1;
            *(LAS u32x4*)(lds + LK + nb * KIMG + srow * 144 + sch * 16) = kreg; *(LAS u32x4*)(lds + LV + nb * VIMG + srow * 192 + sch * 16) = vreg; }
        __syncthreads();
    }
    l_run += __shfl_xor(l_run, 32);
    const float inv = 1.0f / l_run;
#pragma unroll
    for (int r4 = 0; r4 < 4; ++r4) {
        u32x2 w0, w1;
        w0.x = cvt_pk_bf16(o0[4 * r4] * inv, o0[4 * r4 + 1] * inv); w0.y = cvt_pk_bf16(o0[4 * r4 + 2] * inv, o0[4 * r4 + 3] * inv);
        w1.x = cvt_pk_bf16(o1[4 * r4] * inv, o1[4 * r4 + 1] * inv); w1.y = cvt_pk_bf16(o1[4 * r4 + 2] * inv, o1[4 * r4 + 3] * inv);
        *(u32x2*)(qrow + 8 * r4 + 4 * hi) = w0; *(u32x2*)(qrow + 32 + 8 * r4 + 4 * hi) = w1;
    }
}

__device__ void yb_norm_panel(const Params& P, int pm) {
    const int tid = tid_opaque(), lane = tid & 63, wid = tid >> 6;
    bf16_t* HI = (bf16_t*)(P.ws + OFF_HI); const bf16_t* HG = (const bf16_t*)(P.ws + OFF_HG);
    for (int r = 0; r < 32; ++r) {
        const size_t off = ((size_t)pm * 256 + wid * 32 + r) * 512 + lane * 8;
        const u32x4 ov = *(const u32x4*)(HI + off), gv = *(const u32x4*)(HG + off);
        float o[8] = {bf_lo(ov.x), bf_hi(ov.x), bf_lo(ov.y), bf_hi(ov.y), bf_lo(ov.z), bf_hi(ov.z), bf_lo(ov.w), bf_hi(ov.w)};
        const float g[8] = {bf_lo(gv.x), bf_hi(gv.x), bf_lo(gv.y), bf_hi(gv.y), bf_lo(gv.z), bf_hi(gv.z), bf_lo(gv.w), bf_hi(gv.w)};
        float ss = 0.f;
#pragma unroll
        for (int e = 0; e < 8; ++e) ss += o[e] * o[e];
        ss += __shfl_xor(ss, 1); ss += __shfl_xor(ss, 2); ss += __shfl_xor(ss, 4); ss += __shfl_xor(ss, 8);
        const float rs = rsqrtf(ss * (1.0f / 128.0f) + RMS_EPS);
        u32x4 w; w.x = cvt_pk_bf16(o[0] * rs * g[0], o[1] * rs * g[1]); w.y = cvt_pk_bf16(o[2] * rs * g[2], o[3] * rs * g[3]);
        w.z = cvt_pk_bf16(o[4] * rs * g[4], o[5] * rs * g[5]); w.w = cvt_pk_bf16(o[6] * rs * g[6], o[7] * rs * g[7]);
        *(u32x4*)(HI + off) = w;
    }
}
__device__ void ln1_panel(const Params& P, int pm) {
    const int tid = tid_opaque(), lane = tid & 63, wid = tid >> 6;
    const float* ada = (const float*)(P.ws + OFF_ADA) + (size_t)(pm >> 3) * 6144; bf16_t* H = (bf16_t*)(P.ws + OFF_H);
    for (int r = 0; r < 32; ++r) {
        const size_t row = (size_t)pm * 256 + wid * 32 + r;
        float* xr = P.out + row * 1024 + lane * 4;
        f32x4 v[4]; float s = 0.f;
#pragma unroll
        for (int jx = 0; jx < 4; ++jx) { v[jx] = *(const f32x4*)(xr + 256 * jx); s += (v[jx][0] + v[jx][1]) + (v[jx][2] + v[jx][3]); }
        const float mean = wave_sum(s) * (1.0f / 1024.0f); float s2 = 0.f;
#pragma unroll
        for (int jx = 0; jx < 4; ++jx) { v[jx] = v[jx] - mean; s2 += (v[jx][0] * v[jx][0] + v[jx][1] * v[jx][1]) + (v[jx][2] * v[jx][2] + v[jx][3] * v[jx][3]); }
        const float rstd = rsqrtf(wave_sum(s2) * (1.0f / 1024.0f) + LN_EPS);
#pragma unroll
        for (int jx = 0; jx < 4; ++jx) {
            const int c = lane * 4 + 256 * jx;
            const f32x4 g = *(const f32x4*)(P.ln1_g + c), bb = *(const f32x4*)(P.ln1_b + c), sh = *(const f32x4*)(ada + 3072 + c), sc = *(const f32x4*)(ada + 4096 + c);
            const f32x4 x1 = v[jx] * rstd * g + bb;
            *(f32x4*)(xr + 256 * jx) = x1;
            const f32x4 h2 = x1 * (sc + 1.0f) + sh;
            u32x2 w; w.x = cvt_pk_bf16(h2[0], h2[1]); w.y = cvt_pk_bf16(h2[2], h2[3]);
            *(u32x2*)(H + row * 1024 + c) = w;
        }
    }
}

#define INS16(L, xin) do { float x_ = (xin); _Pragma("unroll") for (int k_ = 0; k_ < 16; ++k_) { const float hi_ = fmaxf(L[k_], x_); x_ = fminf(L[k_], x_); L[k_] = hi_; } } while (0)

__device__ void peer_select_wave(const Params& P, size_t tok0) {
    const int lane = tid_opaque() & 63, r32 = lane & 31, hi = lane >> 5;
    const bf16_t* QP = (const bf16_t*)(P.ws + OFF_GB) + (tok0 + r32) * 1024; const bf16_t* SK = (const bf16_t*)(P.ws + OFF_SK);
    u32x2* EG = (u32x2*)(P.ws + OFF_EG) + (tok0 + r32) * 128;
#pragma unroll 1
    for (int h = 0; h < 8; ++h) {
        float a0[16], a1[16];
#pragma unroll
        for (int k = 0; k < 16; ++k) { a0[k] = -INFINITY; a1[k] = -INFINITY; }
#pragma unroll 1
        for (int p = 0; p < 2; ++p) {
            const int hp = h * 2 + p;
            bf16x8 qf[4];
#pragma unroll
            for (int ks = 0; ks < 4; ++ks) qf[ks] = *(const bf16x8*)(QP + hp * 64 + 16 * ks + 8 * hi);
            float L[16];
#pragma unroll
            for (int k = 0; k < 16; ++k) L[k] = -INFINITY;
#pragma unroll
            for (int kt = 0; kt < 4; ++kt) {
                f32x16 acc = {};
#pragma unroll
                for (int ks = 0; ks < 4; ++ks) { const bf16x8 kf = *(const bf16x8*)(SK + ((size_t)hp * 128 + 32 * kt + r32) * 64 + 16 * ks + 8 * hi); acc = MFMA32(kf, qf[ks], acc); }
#pragma unroll
                for (int r = 0; r < 16; ++r) { const unsigned key = (unsigned)(32 * kt + crow(r, hi)); const float xv = __uint_as_float((__float_as_uint(acc[r]) & ~127u) | key); INS16(L, xv); }
            }
            float O[16];
#pragma unroll
            for (int k = 0; k < 16; ++k) O[k] = __shfl_xor(L[k], 32);
#pragma unroll
            for (int k = 0; k < 16; ++k) INS16(L, O[k]);
#pragma unroll
            for (int k = 0; k < 16; ++k) { a0[k] = (p == 0) ? L[k] : a0[k]; a1[k] = (p == 1) ? L[k] : a1[k]; }
        }
        float best[16];
#pragma unroll
        for (int k = 0; k < 16; ++k) best[k] = -INFINITY;
#pragma unroll
        for (int i = 0; i < 16; ++i)
#pragma unroll
            for (int jx = 0; jx < 16; ++jx)
                if ((i + 1) * (jx + 1) <= 16) {
                    const float cs = a0[i] + a1[jx];
                    const float cv = __uint_as_float((__float_as_uint(cs) & ~255u) | (unsigned)(i * 16 + jx));
                    INS16(best, cv);
                }
        unsigned pk0[4], pk1[4];
#pragma unroll
        for (int q = 0; q < 4; ++q) {
            pk0[q] = (__float_as_uint(a0[4 * q]) & 127u) | ((__float_as_uint(a0[4 * q + 1]) & 127u) << 8) | ((__float_as_uint(a0[4 * q + 2]) & 127u) << 16) | ((__float_as_uint(a0[4 * q + 3]) & 127u) << 24);
            pk1[q] = (__float_as_uint(a1[4 * q]) & 127u) | ((__float_as_uint(a1[4 * q + 1]) & 127u) << 8) | ((__float_as_uint(a1[4 * q + 2]) & 127u) << 16) | ((__float_as_uint(a1[4 * q + 3]) & 127u) << 24);
        }
        unsigned pay[16];
#pragma unroll
        for (int k = 0; k < 16; ++k) {
            const unsigned code = __float_as_uint(best[k]) & 255u, ci = code >> 4, cj = code & 15u;
            const unsigned qi = ci >> 2, qj = cj >> 2;
            const unsigned w0 = (qi == 0u) ? pk0[0] : ((qi == 1u) ? pk0[1] : ((qi == 2u) ? pk0[2] : pk0[3]));
            const unsigned w1 = (qj == 0u) ? pk1[0] : ((qj == 1u) ? pk1[1] : ((qj == 2u) ? pk1[2] : pk1[3]));
            pay[k] = (((w0 >> ((ci & 3u) * 8u)) & 127u) << 7) | ((w1 >> ((cj & 3u) * 8u)) & 127u);
        }
        float e[16], es = 0.f;
#pragma unroll
        for (int k = 0; k < 16; ++k) { e[k] = __expf(best[k] - best[0]); es += e[k]; }
        const float inv = 1.0f / es;
        if (hi == 0) {
#pragma unroll
            for (int k = 0; k < 16; ++k) { u32x2 w; w.x = pay[k]; w.y = __float_as_uint(e[k] * inv); EG[h * 16 + k] = w; }
        }
    }
}
__device__ __forceinline__ unsigned xcc_id() { return (unsigned)__builtin_amdgcn_s_getreg((3 << 11) | 20) & 0xFu; }
template <int CTRL> __device__ __forceinline__ float dpp_add(float x) { const int v = __builtin_amdgcn_update_dpp(0, __float_as_int(x), CTRL, 0xf, 0xf, true); return x + __int_as_float(v); }
__device__ __forceinline__ float wave_sum_fast(float x) {
    x = dpp_add<0xB1>(x); x = dpp_add<0x4E>(x); x = dpp_add<0x141>(x); x = dpp_add<0x140>(x);
    x += __shfl_xor(x, 16); x += __shfl_xor(x, 32); return x;
}
__device__ __forceinline__ float dot16_fp8(const float (&hv)[16], const u32x4 r) {
    float s = 0.f;
    { const f32x2 a = __builtin_amdgcn_cvt_pk_f32_fp8((int)r.x, false), b = __builtin_amdgcn_cvt_pk_f32_fp8((int)r.x, true); s += hv[0] * a.x + hv[1] * a.y + hv[2] * b.x + hv[3] * b.y; }
    { const f32x2 a = __builtin_amdgcn_cvt_pk_f32_fp8((int)r.y, false), b = __builtin_amdgcn_cvt_pk_f32_fp8((int)r.y, true); s += hv[4] * a.x + hv[5] * a.y + hv[6] * b.x + hv[7] * b.y; }
    { const f32x2 a = __builtin_amdgcn_cvt_pk_f32_fp8((int)r.z, false), b = __builtin_amdgcn_cvt_pk_f32_fp8((int)r.z, true); s += hv[8] * a.x + hv[9] * a.y + hv[10] * b.x + hv[11] * b.y; }
    { const f32x2 a = __builtin_amdgcn_cvt_pk_f32_fp8((int)r.w, false), b = __builtin_amdgcn_cvt_pk_f32_fp8((int)r.w, true); s += hv[12] * a.x + hv[13] * a.y + hv[14] * b.x + hv[15] * b.y; }
    return s;
}
template <class F> __device__ __forceinline__ void partition_queue(const Params& P, LAS unsigned char* lds, int ctr_base, F f) {
    const int tid = tid_opaque();
    LAS int* slot = (LAS int*)(lds + LDS_BYTES - 64);
    unsigned* ctr = (unsigned*)(P.ws + OFF_CTR) + ctr_base;
    const int myx = (int)(xcc_id() & 7u);
    for (int pp = 0; pp < 8; ++pp) {
        const int p = (myx + pp) & 7;
        for (;;) {
            if (tid == 0) *slot = (int)atomicAdd(ctr + p, 1u);
            __syncthreads();
            const int item = *slot;
            __syncthreads();
            if (item >= NTOK / 64) break;
            f(p, item);
        }
    }
}
__device__ __forceinline__ void peer_u_chunk(const Params& P, int p, int chunk) {
    const int tid = tid_opaque(), lane = tid & 63, wid = tid >> 6;
    const bf16_t* H = (const bf16_t*)(P.ws + OFF_H); const unsigned char* U8 = P.ws + OFF_U8;
    const u32x4* EG4 = (const u32x4*)(P.ws + OFF_EG); float* W = (float*)(P.ws + OFF_W);
#pragma unroll 1
    for (int i = 0; i < 8; ++i) {
        const size_t t = (size_t)chunk * 64 + wid * 8 + i;
        const u32x4 ha = __builtin_nontemporal_load((const u32x4*)(H + t * 1024 + lane * 16)), hb = __builtin_nontemporal_load((const u32x4*)(H + t * 1024 + lane * 16 + 8));
        const u32x4 eg = __builtin_nontemporal_load(EG4 + t * 64 + lane);
        float hv[16] = {bf_lo(ha.x), bf_hi(ha.x), bf_lo(ha.y), bf_hi(ha.y), bf_lo(ha.z), bf_hi(ha.z), bf_lo(ha.w), bf_hi(ha.w),
                        bf_lo(hb.x), bf_hi(hb.x), bf_lo(hb.y), bf_hi(hb.y), bf_lo(hb.z), bf_hi(hb.z), bf_lo(hb.w), bf_hi(hb.w)};
        const bool m0 = (int)(eg.x >> 11) == p, m1 = (int)(eg.z >> 11) == p;
        float d0 = 0.f, d1 = 0.f;
#pragma unroll
        for (int half = 0; half < 2; ++half) {
            unsigned long long mask = __ballot(half == 0 ? m0 : m1);
            const int ev = (int)(half == 0 ? eg.x : eg.z);
            while (mask) {
                int l[4]; bool ok[4]; u32x4 row[4];
#pragma unroll
                for (int k = 0; k < 4; ++k) { ok[k] = mask != 0ull; l[k] = ok[k] ? __builtin_ctzll(mask) : 0; if (ok[k]) mask &= mask - 1ull;
                    const int e = ok[k] ? __builtin_amdgcn_readlane(ev, l[k]) : (p << 11);
                    row[k] = *(const u32x4*)(U8 + (size_t)e * 1024 + lane * 16); }
#pragma unroll
                for (int k = 0; k < 4; ++k) { const float r = wave_sum_fast(dot16_fp8(hv, row[k]));
                    if (ok[k] && lane == l[k]) { if (half == 0) d0 = r; else d1 = r; } }
            }
        }
        if (m0) { const float x = d0 * (1.0f / 32.0f); W[t * 128 + 2 * lane] = __uint_as_float(eg.y) * 0.5f * x * (1.0f + erff(x * 0.70710678118654752f)); }
        if (m1) { const float x = d1 * (1.0f / 32.0f); W[t * 128 + 2 * lane + 1] = __uint_as_float(eg.w) * 0.5f * x * (1.0f + erff(x * 0.70710678118654752f)); }
    }
}
__device__ __forceinline__ void peer_v_chunk(const Params& P, int x, int chunk) {
    const int tid = tid_opaque(), lane = tid & 63, wid = tid >> 6, g = lane >> 4, li = lane & 15;
    const unsigned char* V8 = P.ws + OFF_V8 + (size_t)x * 16384 * 128 + li * 8;
    const u32x2* EG = (const u32x2*)(P.ws + OFF_EG); const float* W = (const float*)(P.ws + OFF_W); float* Y = (float*)(P.ws + OFF_Y);
#pragma unroll 1
    for (int i = 0; i < 8; ++i) {
        const size_t t = (size_t)chunk * 64 + wid * 8 + i;
        float acc[8];
#pragma unroll
        for (int j = 0; j < 8; ++j) acc[j] = 0.f;
#pragma unroll 1
        for (int it = 0; it < 32; it += 8) {
            unsigned e[8]; float w[8]; u32x2 r[8];
#pragma unroll
            for (int u = 0; u < 8; ++u) { const int k = 4 * (it + u) + g; e[u] = EG[t * 128 + k].x; w[u] = W[t * 128 + k]; }
#pragma unroll
            for (int u = 0; u < 8; ++u) r[u] = *(const u32x2*)(V8 + (size_t)e[u] * 128);
#pragma unroll
            for (int u = 0; u < 8; ++u) {
                const f32x2 a = __builtin_amdgcn_cvt_pk_f32_fp8((int)r[u].x, false), b = __builtin_amdgcn_cvt_pk_f32_fp8((int)r[u].x, true);
                const f32x2 c = __builtin_amdgcn_cvt_pk_f32_fp8((int)r[u].y, false), d = __builtin_amdgcn_cvt_pk_f32_fp8((int)r[u].y, true);
                acc[0] += w[u] * a.x; acc[1] += w[u] * a.y; acc[2] += w[u] * b.x; acc[3] += w[u] * b.y; acc[4] += w[u] * c.x; acc[5] += w[u] * c.y; acc[6] += w[u] * d.x; acc[7] += w[u] * d.y;
            }
        }
#pragma unroll
        for (int j = 0; j < 8; ++j) { acc[j] += __shfl_xor(acc[j], 16); acc[j] += __shfl_xor(acc[j], 32); }
        if (g == 0) { float* yp = Y + t * 1024 + x * 128 + li * 8;
            *(f32x4*)yp = (f32x4){acc[0], acc[1], acc[2], acc[3]} * 0.25f; *(f32x4*)(yp + 4) = (f32x4){acc[4], acc[5], acc[6], acc[7]} * 0.25f; }
    }
}
__device__ void ln2_phase(const Params& P) {
    const int tid = tid_opaque(), lane = tid & 63, wid = tid >> 6;
    const float* Y = (const float*)(P.ws + OFF_Y);
    for (size_t row = (size_t)blockIdx.x * 8 + wid; row < (size_t)NTOK; row += (size_t)gridDim.x * 8) {
        const float* gt2 = (const float*)(P.ws + OFF_ADA) + (row >> 11) * 6144 + 5120;
        float* xr = P.out + row * 1024 + lane * 4; const float* yr = Y + row * 1024 + lane * 4;
        f32x4 v[4]; float s = 0.f;
#pragma unroll
        for (int jx = 0; jx < 4; ++jx) { const f32x4 xv = *(const f32x4*)(xr + 256 * jx), yv = __builtin_nontemporal_load((const f32x4*)(yr + 256 * jx)), gv = *(const f32x4*)(gt2 + lane * 4 + 256 * jx);
            v[jx] = xv * ALPHA + gv * yv; s += (v[jx][0] + v[jx][1]) + (v[jx][2] + v[jx][3]); }
        const float mean = wave_sum(s) * (1.0f / 1024.0f); float s2 = 0.f;
#pragma unroll
        for (int jx = 0; jx < 4; ++jx) { v[jx] = v[jx] - mean; s2 += (v[jx][0] * v[jx][0] + v[jx][1] * v[jx][1]) + (v[jx][2] * v[jx][2] + v[jx][3] * v[jx][3]); }
        const float rstd = rsqrtf(wave_sum(s2) * (1.0f / 1024.0f) + LN_EPS);
#pragma unroll
        for (int jx = 0; jx < 4; ++jx) { const int c = lane * 4 + 256 * jx; const f32x4 g = *(const f32x4*)(P.ln2_g + c), bb = *(const f32x4*)(P.ln2_b + c);
            *(f32x4*)(xr + 256 * jx) = v[jx] * rstd * g + bb; }
    }
}

__global__ void __launch_bounds__(NTHR, 2) fwd_megakernel(Params P) {
    extern __shared__ __attribute__((aligned(16))) unsigned char shm[];
    LAS unsigned char* lds = (LAS unsigned char*)shm;
    cg::grid_group grid = cg::this_grid();
    const int G = gridDim.x, bid = blockIdx.x;

#ifndef P3
#define P3 0xff
#endif
#ifndef PH
#define PH 0xff
#endif
    if (PH & 1) phase0a(P, lds);
    grid.sync();
    if (PH & 2) phase0b(P);
    grid.sync();
    if (PH & 4) {
        pg8::Gemm g; g.A = (const bf16_t*)(P.ws + OFF_H); g.Bt = (const bf16_t*)(P.ws + OFF_WIN); g.M = NTOK; g.N = INCOLS; g.K = 1024;
        pg8::StaticOrder S; S.init(NTOK, INCOLS, G, bid);
        EpiProj E; E.ws = P.ws; E.lb = (const float*)(P.ws + OFF_LB); E.ng = P.hgrn_ng; E.kmean = (float*)(P.ws + OFF_KMEAN);
        pg8::gemm_phase<EpiProj, pg8::StaticOrder>(lds, g, S, E);
    }
    grid.sync();
    if (PH & 8) for (int it = bid; it < 256; it += G) hgrn_item(P, it, lds);
    if (PH & 16) for (int u = bid; u < 2048; u += G) { const int bh = u & 255, jj = u >> 8; moba_unit(P, bh >> 3, bh & 7, (jj + bh) & 7, lds); }
    grid.sync();
    if (PH & 32) for (int pm = bid; pm < NTOK / 256; pm += G) {
        if (P3 & 1) yb_norm_panel(P, pm);
        __syncthreads();
        if (P3 & 2) { pg8::Gemm g; g.A = (const bf16_t*)(P.ws + OFF_QA); g.Bt = (const bf16_t*)(P.ws + OFF_WBA); g.M = NTOK; g.N = 1024; g.K = 512;
          pg8::PanelOrder S; S.pm = pm; S.npn = 4; EpiMixA E; E.GA = (bf16_t*)(P.ws + OFF_GA);
          pg8::gemm_phase<EpiMixA, pg8::PanelOrder>(lds, g, S, E); }
        __syncthreads();
        if (P3 & 4) { pg8::Gemm g; g.A = (const bf16_t*)(P.ws + OFF_HI); g.Bt = (const bf16_t*)(P.ws + OFF_WBB); g.M = NTOK; g.N = 1024; g.K = 512;
          pg8::PanelOrder S; S.pm = pm; S.npn = 4; EpiMixB E; E.GA = (bf16_t*)(P.ws + OFF_GA); E.GB = (const bf16_t*)(P.ws + OFF_GB);
          pg8::gemm_phase<EpiMixB, pg8::PanelOrder>(lds, g, S, E); }
        __syncthreads();
        if (P3 & 8) { pg8::Gemm g; g.A = (const bf16_t*)(P.ws + OFF_GA); g.Bt = (const bf16_t*)(P.ws + OFF_WOUT); g.M = NTOK; g.N = 1024; g.K = 1024;
          pg8::PanelOrder S; S.pm = pm; S.npn = 4; EpiOut E; E.x = P.x; E.ada = (const float*)(P.ws + OFF_ADA); E.out = P.out;
          pg8::gemm_phase<EpiOut, pg8::PanelOrder>(lds, g, S, E); }
        __syncthreads();
        if (P3 & 16) ln1_panel(P, pm);
        __syncthreads();
        if (P3 & 32) { pg8::Gemm g; g.A = (const bf16_t*)(P.ws + OFF_H); g.Bt = (const bf16_t*)(P.ws + OFF_WQ); g.M = NTOK; g.N = 1024; g.K = 1024;
          pg8::PanelOrder S; S.pm = pm; S.npn = 4; EpiBf16 E; E.O = (bf16_t*)(P.ws + OFF_GB);
          pg8::gemm_phase<EpiBf16, pg8::PanelOrder>(lds, g, S, E); }
        __syncthreads();
        { const size_t tok0 = (size_t)pm * 256 + (tid_opaque() >> 6) * 32;
          peer_select_wave(P, tok0); }
        __syncthreads();
    }
    grid.sync();
    partition_queue(P, lds, 0, [&](int p, int chunk) { peer_u_chunk(P, p, chunk); });
    grid.sync();
    partition_queue(P, lds, 8, [&](int x, int chunk) { peer_v_chunk(P, x, chunk); });
    grid.sync();
    ln2_phase(P);
}

extern "C" void kernel_launch(void* const* d_in, const int* in_sizes, int n_in, void* d_out, int out_size, void* d_ws, size_t ws_size, hipStream_t stream) {
    static int grid_blocks = 0;
    if (grid_blocks == 0) {
        if (n_in != 18 || out_size != NTOK * DM || ws_size < WS_END) { fprintf(stderr, "kernel_launch: unexpected shapes (n_in %d, out %d, ws %zu, need %zu)\n", n_in, out_size, ws_size, (size_t)WS_END); grid_blocks = -1; return; }
        int dev = 0, cus = 0, per_cu = 0;
        hipGetDevice(&dev);
        hipDeviceGetAttribute(&cus, hipDeviceAttributeMultiprocessorCount, dev);
        if (hipFuncSetAttribute((const void*)fwd_megakernel, hipFuncAttributeMaxDynamicSharedMemorySize, LDS_BYTES) != hipSuccess) fprintf(stderr, "kernel_launch: hipFuncSetAttribute failed\n");
        hipOccupancyMaxActiveBlocksPerMultiprocessor(&per_cu, (const void*)fwd_megakernel, NTHR, LDS_BYTES);
        if (per_cu < 1) { fprintf(stderr, "kernel_launch: occupancy query says %d blocks per CU\n", per_cu); per_cu = 1; }
        if (per_cu > 1) per_cu = 1;
        grid_blocks = cus * per_cu;
        (void)hipGetLastError();
    }
    if (grid_blocks < 0) return;
    Params p{};
    p.x = (const float*)d_in[0]; p.c = (const float*)d_in[1]; p.w_ada = (const float*)d_in[2]; p.b_ada = (const float*)d_in[3]; p.w_in = (const float*)d_in[4];
    p.w_ba = (const float*)d_in[5]; p.w_bb = (const float*)d_in[6]; p.w_out = (const float*)d_in[7]; p.hgrn_lb = (const float*)d_in[8]; p.hgrn_ng = (const float*)d_in[9];
    p.ln1_g = (const float*)d_in[10]; p.ln1_b = (const float*)d_in[11]; p.peer_wq = (const float*)d_in[12]; p.peer_sk = (const float*)d_in[13]; p.peer_u = (const float*)d_in[14];
    p.peer_v = (const float*)d_in[15]; p.ln2_g = (const float*)d_in[16]; p.ln2_b = (const float*)d_in[17];
    p.out = (float*)d_out; p.ws = (unsigned char*)d_ws;
    void* args[] = {&p};
    hipError_t e = hipLaunchCooperativeKernel((const void*)fwd_megakernel, dim3(grid_blocks), dim3(NTHR), args, LDS_BYTES, stream);
    if (e != hipSuccess) fprintf(stderr, "cooperative launch failed: %s (grid %d)\n", hipGetErrorString(e), grid_blocks);
}
```

```cpp
#include <hip/hip_runtime.h>
#include <hip/hip_cooperative_groups.h>
#include <cstdio>
#include <cstdint>
namespace cg = cooperative_groups;

#define LAS __attribute__((address_space(3)))
typedef unsigned short bf16_t;
typedef short bf16x8 __attribute__((ext_vector_type(8)));
typedef short s16x4 __attribute__((ext_vector_type(4)));
typedef float f32x2 __attribute__((ext_vector_type(2)));
typedef float f32x4 __attribute__((ext_vector_type(4)));
typedef float f32x16 __attribute__((ext_vector_type(16)));
typedef unsigned u32x2 __attribute__((ext_vector_type(2)));
typedef unsigned u32x4 __attribute__((ext_vector_type(4)));

constexpr int NB = 32, SEQ = 2048, DM = 1024, NTOK = NB * SEQ;
constexpr int INCOLS = 5632;
constexpr int NTHR = 512;
constexpr int LDS_BYTES = 147456;
constexpr float ALPHA = 1.189207115002721f;
constexpr float LN_EPS = 1e-5f, RMS_EPS = 1e-6f;
constexpr float LOG2E = 1.4426950408889634f;

constexpr size_t SZ_T512 = (size_t)NTOK * 512 * 2, SZ_T1024 = (size_t)NTOK * 1024 * 2;
constexpr size_t OFF_ADA = 0;
constexpr size_t OFF_LB = OFF_ADA + 786432;
constexpr size_t OFF_KMEAN = OFF_LB + 4096;
constexpr size_t OFF_WIN = OFF_KMEAN + 524288;
constexpr size_t OFF_WBA = OFF_WIN + (size_t)5632 * 1024 * 2;
constexpr size_t OFF_WBB = OFF_WBA + 1048576;
constexpr size_t OFF_WOUT = OFF_WBB + 1048576;
constexpr size_t OFF_WQ = OFF_WOUT + 2097152;
constexpr size_t OFF_SK = OFF_WQ + 2097152;
constexpr size_t OFF_U8 = OFF_SK + 262144;
constexpr size_t OFF_V8 = OFF_U8 + 16777216;
constexpr size_t OFF_CTR = OFF_V8 + 16777216;
constexpr size_t OFF_EG = OFF_CTR + 4096;
constexpr size_t OFF_H = OFF_EG + (size_t)NTOK * 128 * 8;
constexpr size_t OFF_QA = OFF_H + SZ_T1024;
constexpr size_t OFF_KA = OFF_QA + SZ_T512;
constexpr size_t OFF_VA = OFF_KA + SZ_T512;
constexpr size_t OFF_HQ = OFF_VA + SZ_T512;
constexpr size_t OFF_HK = OFF_HQ + SZ_T512;
constexpr size_t OFF_HI = OFF_HK + SZ_T512;
constexpr size_t OFF_HG = OFF_HI + SZ_T512;
constexpr size_t OFF_GA = OFF_HG + SZ_T512;
constexpr size_t OFF_GB = OFF_GA + SZ_T1024;
constexpr size_t WS_END = OFF_GB + SZ_T1024;
constexpr size_t OFF_W = OFF_QA;
constexpr size_t OFF_Y = OFF_KA;

struct Params {
    const float *x, *c, *w_ada, *b_ada, *w_in, *w_ba, *w_bb, *w_out, *hgrn_lb, *hgrn_ng, *ln1_g, *ln1_b, *peer_wq, *peer_sk, *peer_u, *peer_v, *ln2_g, *ln2_b;
    float* out;
    unsigned char* ws;
};

__device__ __forceinline__ unsigned cvt_pk_bf16(float lo, float hi) { unsigned r; asm("v_cvt_pk_bf16_f32 %0, %1, %2" : "=v"(r) : "v"(lo), "v"(hi)); return r; }
__device__ __forceinline__ float bf_lo(unsigned w) { return __uint_as_float(w << 16); }
__device__ __forceinline__ float bf_hi(unsigned w) { return __uint_as_float(w & 0xffff0000u); }
__device__ __forceinline__ float sigmoidf_(float x) { return 1.0f / (1.0f + __expf(-x)); }
__device__ __forceinline__ float wave_sum(float v) {
#pragma unroll
    for (int o = 1; o < 64; o <<= 1) v += __shfl_xor(v, o);
    return v;
}
__device__ __forceinline__ int tid_opaque() { int t = threadIdx.x; asm volatile("" : "+v"(t)); return t; }
__device__ __forceinline__ int crow(int r, int hi) { return (r & 3) + 8 * (r >> 2) + 4 * hi; }
#define MFMA32(a, b, c) __builtin_amdgcn_mfma_f32_32x32x16_bf16(a, b, c, 0, 0, 0)

namespace pg8 {
constexpr int BM = 256, BK = 64, HALF = 128, HTB = HALF * BK * 2, STAGE_BYTES = 8 * HTB, NXCD = 8, WGM = 8;
__host__ __device__ __forceinline__ int lds_byte(int r, int c) { const int st = (r >> 4) * 2 + (c >> 5), rr = r & 15, cc = c & 31, ob = rr * 64 + cc * 2; return st * 1024 + (ob ^ (((ob >> 9) & 1) << 5)); }
__host__ __device__ __forceinline__ void stage_rc(int b, int& R, int& C) { const int st = b / 1024, sb = b % 1024, swz = sb ^ (((sb >> 9) & 1) << 5); R = (st >> 1) * 16 + swz / 64; C = (st & 1) * 32 + (swz % 64) / 2; }
__host__ __device__ __forceinline__ int perm32(int rho) { const int n = rho >> 4, i = rho & 15; return 8 * (i >> 2) + 4 * n + (i & 3); }

struct Unit { int pm, pn; };
struct Gemm { const bf16_t* A; const bf16_t* Bt; int M, N, K; };

struct StaticOrder {
    int nM, nN, nwg, G, c;
    __device__ void init(int M, int N, int G_, int c_) { nM = M / BM; nN = N / BM; nwg = nM * nN; G = G_; c = c_; }
    __device__ bool next(int i, Unit& u) const {
        const long L = (long)i * G + c; if (L >= nwg) return false;
        int wgid = (int)L; { const int q = nwg / NXCD, r = nwg % NXCD, xcd = wgid % NXCD, off = wgid / NXCD; wgid = (xcd < r ? xcd * (q + 1) : r * (q + 1) + (xcd - r) * q) + off; }
        const int nig = WGM * nN, gid = wgid / nig, fm = gid * WGM, gsz = (nM - fm) < WGM ? (nM - fm) : WGM;
        u.pm = fm + ((wgid % nig) % gsz); u.pn = (wgid % nig) / gsz; return true;
    }
};
struct PanelOrder {
    int pm, npn;
    __device__ bool next(int i, Unit& u) const { if (i >= npn) return false; u.pm = pm; u.pn = i; return true; }
};

template <class Epi, class Sched>
__device__ __forceinline__ void gemm_phase(LAS unsigned char* lds, const Gemm g, const Sched& S, const Epi& E) {
    const int tid = tid_opaque(), wid = __builtin_amdgcn_readfirstlane(tid >> 6), lane = tid & 63, wr = wid >> 2, wc = wid & 3, fr = lane & 15, fq = lane >> 4;
    const int K = g.K, nt = K / BK;
    unsigned voffA[2], voffB[2];
#pragma unroll
    for (int i = 0; i < 2; ++i) { int R, C; stage_rc(tid * 16 + i * 8192, R, C); const int Rb = Epi::PERM ? ((R & ~31) + perm32(R & 31)) : R;
        voffA[i] = (unsigned)(R * K + C) * 2u; voffB[i] = (unsigned)(Rb * K + C) * 2u; }
    const size_t kstep = (size_t)(BK * 2);
    const size_t hstep = (size_t)HALF * K * 2;
    const size_t tstep = 2 * hstep;
    const unsigned ldsw = (unsigned)wid * 1024u;
    const int aoff = lds_byte(wr * 64 + fr, fq * 8), boff = lds_byte(wc * 32 + fr, fq * 8);
#define PG8_SA(b, h) (((b) * 2 + (h)) * HTB)
#define PG8_SB(b, h) ((4 + (b) * 2 + (h)) * HTB)
#define PG8_STAGE(bufoff, gbase, voff) do { _Pragma("unroll") for (int _i = 0; _i < 2; ++_i) \
        __builtin_amdgcn_global_load_lds((const unsigned*)((const char*)(gbase) + (voff)[_i]), (LAS unsigned*)(lds + (bufoff) + ldsw + _i * 8192), 16, 0, 0); } while (0)
#define PG8_LDA(dst, b, h) do { _Pragma("unroll") for (int m = 0; m < 4; ++m) _Pragma("unroll") for (int k = 0; k < 2; ++k) dst[m][k] = *(const LAS bf16x8*)(lds + PG8_SA(b, h) + aoff + m * 2048 + k * 1024); } while (0)
#define PG8_LDB(dst, b, h) do { _Pragma("unroll") for (int n = 0; n < 2; ++n) _Pragma("unroll") for (int k = 0; k < 2; ++k) dst[n][k] = *(const LAS bf16x8*)(lds + PG8_SB(b, h) + boff + n * 2048 + k * 1024); } while (0)
#define PG8_MMA(ai, bj, At, Bt) do { __builtin_amdgcn_s_setprio(1); _Pragma("unroll") for (int m = 0; m < 4; ++m) _Pragma("unroll") for (int n = 0; n < 2; ++n) _Pragma("unroll") for (int k = 0; k < 2; ++k) \
        acc[ai][bj][m][n] = __builtin_amdgcn_mfma_f32_16x16x32_bf16(Bt[n][k], At[m][k], acc[ai][bj][m][n], 0, 0, 0); __builtin_amdgcn_s_setprio(0); } while (0)
#define PG8_WAIT_V(n) asm volatile("s_waitcnt vmcnt(" #n ")" ::: "memory")
#define PG8_WAIT_L(n) asm volatile("s_waitcnt lgkmcnt(" #n ")" ::: "memory")
#define PG8_BAR __builtin_amdgcn_s_barrier()
#define PG8_SCHED __builtin_amdgcn_sched_barrier(0)
    Unit cur, nxt; int ui = 0;
    if (!S.next(0, cur)) return;
    f32x4 acc[2][2][4][2];
#pragma unroll
    for (int a = 0; a < 2; ++a)
#pragma unroll
        for (int b = 0; b < 2; ++b)
#pragma unroll
            for (int m = 0; m < 4; ++m)
#pragma unroll
                for (int n = 0; n < 2; ++n) acc[a][b][m][n] = (f32x4){0.f, 0.f, 0.f, 0.f};
    bf16x8 At[4][2], B0[2][2], B1[2][2];
    const char* cA = (const char*)g.A + (size_t)cur.pm * tstep; const char* cB = (const char*)g.Bt + (size_t)cur.pn * tstep;
    PG8_STAGE(PG8_SB(0, 0), cB, voffB); PG8_STAGE(PG8_SA(0, 0), cA, voffA); PG8_STAGE(PG8_SB(0, 1), cB + hstep, voffB); PG8_STAGE(PG8_SA(0, 1), cA + hstep, voffA);
    if (wr == 1) PG8_BAR;
    PG8_WAIT_V(4); PG8_BAR;
    PG8_STAGE(PG8_SB(1, 0), cB + kstep, voffB); PG8_STAGE(PG8_SA(1, 0), cA + kstep, voffA); PG8_STAGE(PG8_SB(1, 1), cB + hstep + kstep, voffB);
    PG8_WAIT_V(6); PG8_BAR;
    for (;;) {
        const bool has_next = S.next(ui + 1, nxt);
        const char* nA = has_next ? (const char*)g.A + (size_t)nxt.pm * tstep : cA; const char* nB = has_next ? (const char*)g.Bt + (size_t)nxt.pn * tstep : cB;
        for (int t = 0; t < nt; t += 2) {
            const bool last = (t == nt - 2);
            const char* a1 = cA + (size_t)(t + 1) * kstep;
            const char* a2 = last ? nA : cA + (size_t)(t + 2) * kstep; const char* b2 = last ? nB : cB + (size_t)(t + 2) * kstep;
            const char* a3 = a2 + kstep; const char* b3 = b2 + kstep;
            PG8_LDB(B0, 0, 0); PG8_SCHED; PG8_LDA(At, 0, 0); PG8_STAGE(PG8_SA(1, 1), a1 + hstep, voffA);
            PG8_WAIT_L(8); PG8_BAR; PG8_WAIT_L(0); PG8_MMA(0, 0, At, B0); PG8_BAR; PG8_SCHED;
            PG8_LDB(B1, 0, 1); PG8_STAGE(PG8_SB(0, 0), b2, voffB);
            PG8_BAR; PG8_WAIT_L(0); PG8_MMA(0, 1, At, B1); PG8_BAR;
            PG8_LDA(At, 0, 1); PG8_STAGE(PG8_SA(0, 0), a2, voffA);
            PG8_BAR; PG8_WAIT_L(0); PG8_MMA(1, 0, At, B0); PG8_BAR; PG8_SCHED;
            PG8_STAGE(PG8_SB(0, 1), b2 + hstep, voffB);
            PG8_WAIT_V(6); PG8_BAR; PG8_MMA(1, 1, At, B1); PG8_BAR;
            PG8_LDB(B0, 1, 0); PG8_SCHED; PG8_LDA(At, 1, 0); PG8_STAGE(PG8_SA(0, 1), a2 + hstep, voffA);
            PG8_WAIT_L(8); PG8_BAR; PG8_WAIT_L(0); PG8_MMA(0, 0, At, B0); PG8_BAR; PG8_SCHED;
            PG8_LDB(B1, 1, 1); PG8_STAGE(PG8_SB(1, 0), b3, voffB);
            PG8_BAR; PG8_WAIT_L(0); PG8_MMA(0, 1, At, B1); PG8_BAR;
            PG8_LDA(At, 1, 1); PG8_STAGE(PG8_SA(1, 0), a3, voffA);
            PG8_BAR; PG8_WAIT_L(0); PG8_MMA(1, 0, At, B0); PG8_BAR; PG8_SCHED;
            PG8_STAGE(PG8_SB(1, 1), b3 + hstep, voffB);
            PG8_WAIT_V(6); PG8_BAR; PG8_MMA(1, 1, At, B1); PG8_BAR;
        }
        E(acc, cur, wr, wc, fr, fq);
        if (!has_next) break;
#pragma unroll
        for (int a = 0; a < 2; ++a)
#pragma unroll
            for (int b = 0; b < 2; ++b)
#pragma unroll
                for (int m = 0; m < 4; ++m)
#pragma unroll
                    for (int n = 0; n < 2; ++n) acc[a][b][m][n] = (f32x4){0.f, 0.f, 0.f, 0.f};
        cur = nxt; cA = nA; cB = nB; ++ui;
    }
    PG8_WAIT_V(0);
    if (wr == 0) PG8_BAR;
    PG8_BAR;
#undef PG8_SA
#undef PG8_SB
#undef PG8_STAGE
#undef PG8_LDA
#undef PG8_LDB
#undef PG8_MMA
#undef PG8_WAIT_V
#undef PG8_WAIT_L
#undef PG8_BAR
#undef PG8_SCHED
}
}
using pg8::Unit;

struct EpiProj {
    static constexpr bool PERM = true;
    unsigned char* ws; const float* lb; const float* ng; float* kmean;
    __device__ __forceinline__ void operator()(const f32x4 (&acc)[2][2][4][2], const Unit& u, int wr, int wc, int fr, int fq) const {
        const int pn = u.pn; int seg, colt, ldc; size_t boff;
        if (pn < 14) { seg = pn >> 1; colt = (pn & 1) * 256; ldc = 512; boff = OFF_QA + (size_t)seg * SZ_T512; }
        else if (pn < 18) { seg = 7; colt = (pn - 14) * 256; ldc = 1024; boff = OFF_GA; }
        else { seg = 8; colt = (pn - 18) * 256; ldc = 1024; boff = OFF_GB; }
        bf16_t* base = (bf16_t*)(ws + boff);
        const int row0 = u.pm * 256 + wr * 64 + fr, col0 = colt + wc * 32 + 8 * fq;
        float pv[2][8];
#pragma unroll
        for (int bj = 0; bj < 2; ++bj)
#pragma unroll
            for (int e = 0; e < 8; ++e) pv[bj][e] = (seg == 4) ? (1.0f - lb[col0 + bj * 128 + e]) : ((seg == 6) ? ng[col0 + bj * 128 + e] : 0.f);
        float cs[2][8];
#pragma unroll
        for (int bj = 0; bj < 2; ++bj)
#pragma unroll
            for (int e = 0; e < 8; ++e) cs[bj][e] = 0.f;
#pragma unroll
        for (int ai = 0; ai < 2; ++ai)
#pragma unroll
            for (int m = 0; m < 4; ++m) {
                bf16_t* rowp = base + (size_t)(row0 + ai * 128 + m * 16) * ldc + col0;
#pragma unroll
                for (int bj = 0; bj < 2; ++bj) {
                    float v[8];
#pragma unroll
                    for (int e = 0; e < 4; ++e) { v[e] = acc[ai][bj][m][0][e]; v[4 + e] = acc[ai][bj][m][1][e]; }
                    if (seg == 0) {
#pragma unroll
                        for (int e = 0; e < 8; ++e) v[e] *= (0.125f * LOG2E);
                    } else if (seg == 1) {
#pragma unroll
                        for (int e = 0; e < 8; ++e) cs[bj][e] += v[e];
                    } else if (seg == 3) {
#pragma unroll
                        for (int e = 0; e < 8; ++e) v[e] = v[e] * sigmoidf_(v[e]);
                    } else if (seg == 4) {
#pragma unroll
                        for (int e = 0; e < 8; ++e) v[e] = pv[bj][e] * sigmoidf_(-v[e]);
                    } else if (seg == 6) {
#pragma unroll
                        for (int e = 0; e < 8; ++e) v[e] = pv[bj][e] * v[e] * sigmoidf_(v[e]);
                    } else if (seg >= 7) {
#pragma unroll
                        for (int e = 0; e < 8; ++e) v[e] = sigmoidf_(v[e]);
                    }
                    u32x4 w; w.x = cvt_pk_bf16(v[0], v[1]); w.y = cvt_pk_bf16(v[2], v[3]); w.z = cvt_pk_bf16(v[4], v[5]); w.w = cvt_pk_bf16(v[6], v[7]);
                    *(u32x4*)(rowp + bj * 128) = w;
                }
            }
        if (seg == 1) {
#pragma unroll
            for (int bj = 0; bj < 2; ++bj)
#pragma unroll
                for (int e = 0; e < 8; ++e) {
                    float s = cs[bj][e];
                    s += __shfl_xor(s, 1); s += __shfl_xor(s, 2); s += __shfl_xor(s, 4); s += __shfl_xor(s, 8);
                    if (fr == 0) atomicAdd(kmean + (size_t)u.pm * 512 + col0 + bj * 128 + e, s);
                }
        }
    }
};
struct EpiMixA {
    static constexpr bool PERM = true;
    bf16_t* GA;
    __device__ __forceinline__ void operator()(const f32x4 (&acc)[2][2][4][2], const Unit& u, int wr, int wc, int fr, int fq) const {
        const int row0 = u.pm * 256 + wr * 64 + fr, col0 = u.pn * 256 + wc * 32 + 8 * fq;
#pragma unroll
        for (int ai = 0; ai < 2; ++ai)
#pragma unroll
            for (int m = 0; m < 4; ++m) {
                bf16_t* rowp = GA + (size_t)(row0 + ai * 128 + m * 16) * 1024 + col0;
#pragma unroll
                for (int bj = 0; bj < 2; ++bj) {
                    const u32x4 g = *(const u32x4*)(rowp + bj * 128);
                    const f32x4 a0 = acc[ai][bj][m][0], a1 = acc[ai][bj][m][1];
                    u32x4 w;
                    w.x = cvt_pk_bf16(bf_lo(g.x) * a0[0], bf_hi(g.x) * a0[1]); w.y = cvt_pk_bf16(bf_lo(g.y) * a0[2], bf_hi(g.y) * a0[3]);
                    w.z = cvt_pk_bf16(bf_lo(g.z) * a1[0], bf_hi(g.z) * a1[1]); w.w = cvt_pk_bf16(bf_lo(g.w) * a1[2], bf_hi(g.w) * a1[3]);
                    *(u32x4*)(rowp + bj * 128) = w;
                }
            }
    }
};
struct EpiMixB {
    static constexpr bool PERM = true;
    bf16_t* GA; const bf16_t* GB;
    __device__ __forceinline__ void operator()(const f32x4 (&acc)[2][2][4][2], const Unit& u, int wr, int wc, int fr, int fq) const {
        const int row0 = u.pm * 256 + wr * 64 + fr, col0 = u.pn * 256 + wc * 32 + 8 * fq;
#pragma unroll
        for (int ai = 0; ai < 2; ++ai)
#pragma unroll
            for (int m = 0; m < 4; ++m) {
                const size_t off = (size_t)(row0 + ai * 128 + m * 16) * 1024 + col0;
#pragma unroll
                for (int bj = 0; bj < 2; ++bj) {
                    const u32x4 g = *(const u32x4*)(GB + off + bj * 128);
                    const u32x4 mx = *(const u32x4*)(GA + off + bj * 128);
                    const f32x4 a0 = acc[ai][bj][m][0], a1 = acc[ai][bj][m][1];
                    u32x4 w;
                    w.x = cvt_pk_bf16(bf_lo(mx.x) + bf_lo(g.x) * a0[0], bf_hi(mx.x) + bf_hi(g.x) * a0[1]); w.y = cvt_pk_bf16(bf_lo(mx.y) + bf_lo(g.y) * a0[2], bf_hi(mx.y) + bf_hi(g.y) * a0[3]);
                    w.z = cvt_pk_bf16(bf_lo(mx.z) + bf_lo(g.z) * a1[0], bf_hi(mx.z) + bf_hi(g.z) * a1[1]); w.w = cvt_pk_bf16(bf_lo(mx.w) + bf_lo(g.w) * a1[2], bf_hi(mx.w) + bf_hi(g.w) * a1[3]);
                    *(u32x4*)(GA + off + bj * 128) = w;
                }
            }
    }
};
struct EpiOut {
    static constexpr bool PERM = false;
    const float* x; const float* ada; float* out;
    __device__ __forceinline__ void operator()(const f32x4 (&acc)[2][2][4][2], const Unit& u, int wr, int wc, int fr, int fq) const {
        const int row0 = u.pm * 256 + wr * 64 + fr, col0 = u.pn * 256 + wc * 32 + 4 * fq;
        const float* gt1 = ada + (size_t)(u.pm >> 3) * 6144 + 2048;
#pragma unroll
        for (int ai = 0; ai < 2; ++ai)
#pragma unroll
            for (int m = 0; m < 4; ++m) {
                const size_t off = (size_t)(row0 + ai * 128 + m * 16) * 1024 + col0;
#pragma unroll
                for (int bj = 0; bj < 2; ++bj)
#pragma unroll
                    for (int n = 0; n < 2; ++n) {
                        const int cc = bj * 128 + n * 16;
                        const f32x4 xv = *(const f32x4*)(x + off + cc), gv = *(const f32x4*)(gt1 + col0 + cc);
                        *(f32x4*)(out + off + cc) = xv * ALPHA + gv * acc[ai][bj][m][n];
                    }
            }
    }
};
struct EpiBf16 {
    static constexpr bool PERM = true;
    bf16_t* O;
    __device__ __forceinline__ void operator()(const f32x4 (&acc)[2][2][4][2], const Unit& u, int wr, int wc, int fr, int fq) const {
        const int row0 = u.pm * 256 + wr * 64 + fr, col0 = u.pn * 256 + wc * 32 + 8 * fq;
#pragma unroll
        for (int ai = 0; ai < 2; ++ai)
#pragma unroll
            for (int m = 0; m < 4; ++m) {
                bf16_t* rowp = O + (size_t)(row0 + ai * 128 + m * 16) * 1024 + col0;
#pragma unroll
                for (int bj = 0; bj < 2; ++bj) {
                    const f32x4 a0 = acc[ai][bj][m][0], a1 = acc[ai][bj][m][1];
                    u32x4 w; w.x = cvt_pk_bf16(a0[0], a0[1]); w.y = cvt_pk_bf16(a0[2], a0[3]); w.z = cvt_pk_bf16(a1[0], a1[1]); w.w = cvt_pk_bf16(a1[2], a1[3]);
                    *(u32x4*)(rowp + bj * 128) = w;
                }
            }
    }
};

__device__ void phase0a(const Params& P, LAS unsigned char* lds) {
    const int tid = tid_opaque(), G = gridDim.x, bid = blockIdx.x;
    for (int it = bid; it < 192; it += G) {
        LAS float* sc = (LAS float*)lds;
        for (int i = tid; i < 32 * 1024; i += NTHR) { const float cv = P.c[i]; sc[i] = cv * sigmoidf_(cv); }
        __syncthreads();
        const int kg = tid >> 5, col = tid & 31;
        float a[32];
#pragma unroll
        for (int b = 0; b < 32; ++b) a[b] = 0.f;
        for (int k = kg * 64; k < kg * 64 + 64; k += 4) {
            float w[4];
#pragma unroll
            for (int e = 0; e < 4; ++e) w[e] = P.w_ada[(size_t)(k + e) * 6144 + it * 32 + col];
#pragma unroll
            for (int b = 0; b < 32; ++b) { const f32x4 s = *(const LAS f32x4*)(sc + b * 1024 + k); a[b] += s[0] * w[0] + s[1] * w[1] + s[2] * w[2] + s[3] * w[3]; }
        }
        __syncthreads();
        LAS float* red = (LAS float*)lds;
#pragma unroll
        for (int b = 0; b < 32; ++b) red[(kg * 32 + b) * 32 + col] = a[b];
        __syncthreads();
        for (int o = tid; o < 1024; o += NTHR) { const int b = o >> 5, cc = o & 31; float s = 0.f;
#pragma unroll
            for (int g2 = 0; g2 < 16; ++g2) s += red[(g2 * 32 + b) * 32 + cc];
            ((float*)(P.ws + OFF_ADA))[(size_t)b * 6144 + it * 32 + cc] = s + P.b_ada[it * 32 + cc]; }
        __syncthreads();
    }
    const size_t gtid = (size_t)bid * NTHR + tid, gsz = (size_t)G * NTHR;
    for (size_t i = gtid; i < 512; i += gsz) ((float*)(P.ws + OFF_LB))[i] = sigmoidf_(P.hgrn_lb[i] - P.hgrn_lb[512 + i]);
    for (size_t i = gtid; i < 32 * 8 * 512; i += gsz) ((float*)(P.ws + OFF_KMEAN))[i] = 0.f;
    {
        LAS float* tile = (LAS float*)lds;
        const int I0 = 16 * 88, I1 = I0 + 8 * 16, I2 = I1 + 8 * 16, I3 = I2 + 16 * 16, I4 = I3 + 16 * 16;
        for (int it = bid; it < I4; it += G) {
            const float* W; bf16_t* WT; int K, N, r;
            if (it < I0) { W = P.w_in; WT = (bf16_t*)(P.ws + OFF_WIN); K = 1024; N = 5632; r = it; }
            else if (it < I1) { W = P.w_ba; WT = (bf16_t*)(P.ws + OFF_WBA); K = 512; N = 1024; r = it - I0; }
            else if (it < I2) { W = P.w_bb; WT = (bf16_t*)(P.ws + OFF_WBB); K = 512; N = 1024; r = it - I1; }
            else if (it < I3) { W = P.w_out; WT = (bf16_t*)(P.ws + OFF_WOUT); K = 1024; N = 1024; r = it - I2; }
            else { W = P.peer_wq; WT = (bf16_t*)(P.ws + OFF_WQ); K = 1024; N = 1024; r = it - I3; }
            const int nb = N / 64, k0 = (r / nb) * 64, n0 = (r % nb) * 64;
#pragma unroll
            for (int ps = 0; ps < 2; ++ps) { const int kk = (tid >> 4) + 32 * ps, n4 = (tid & 15) * 4;
                const f32x4 v = *(const f32x4*)(W + (size_t)(k0 + kk) * N + n0 + n4);
                tile[kk * 65 + n4] = v[0]; tile[kk * 65 + n4 + 1] = v[1]; tile[kk * 65 + n4 + 2] = v[2]; tile[kk * 65 + n4 + 3] = v[3]; }
            __syncthreads();
            { const int n = tid >> 3, kc = (tid & 7) * 8; u32x4 w;
              w.x = cvt_pk_bf16(tile[(kc + 0) * 65 + n], tile[(kc + 1) * 65 + n]); w.y = cvt_pk_bf16(tile[(kc + 2) * 65 + n], tile[(kc + 3) * 65 + n]);
              w.z = cvt_pk_bf16(tile[(kc + 4) * 65 + n], tile[(kc + 5) * 65 + n]); w.w = cvt_pk_bf16(tile[(kc + 6) * 65 + n], tile[(kc + 7) * 65 + n]);
              *(u32x4*)(WT + (size_t)(n0 + n) * K + k0 + kc) = w; }
            __syncthreads();
        }
    }
    {
        if (gtid < 16) ((unsigned*)(P.ws + OFF_CTR))[gtid] = 0u;
        for (size_t i = gtid; i < 16384; i += gsz) {
            const float* src = P.peer_sk + i * 8; const f32x4 a = *(const f32x4*)src, b = *(const f32x4*)(src + 4);
            u32x4 w; w.x = cvt_pk_bf16(a[0], a[1]); w.y = cvt_pk_bf16(a[2], a[3]); w.z = cvt_pk_bf16(b[0], b[1]); w.w = cvt_pk_bf16(b[2], b[3]);
            *(u32x4*)((bf16_t*)(P.ws + OFF_SK) + i * 8) = w;
        }
        const size_t NV = (size_t)16384 * 1024 / 8;
        for (size_t i = gtid; i < 2 * NV; i += gsz) {
            const bool isv = i >= NV; const size_t j = isv ? i - NV : i;
            const float* src = (isv ? P.peer_v : P.peer_u) + j * 8; const float sc = isv ? 4.0f : 32.0f;
            const f32x4 a = *(const f32x4*)src * sc, b = *(const f32x4*)(src + 4) * sc;
            int w0 = __builtin_amdgcn_cvt_pk_fp8_f32(a[0], a[1], 0, false); w0 = __builtin_amdgcn_cvt_pk_fp8_f32(a[2], a[3], w0, true);
            int w1 = __builtin_amdgcn_cvt_pk_fp8_f32(b[0], b[1], 0, false); w1 = __builtin_amdgcn_cvt_pk_fp8_f32(b[2], b[3], w1, true);
            u32x2 w; w.x = (unsigned)w0; w.y = (unsigned)w1;
            size_t dst;
            if (!isv) dst = OFF_U8 + j * 8;
            else { const size_t e = j >> 7; const int d8 = (int)(j & 127) * 8; dst = OFF_V8 + ((size_t)(d8 >> 7) * 16384 + e) * 128 + (d8 & 127); }
            *(u32x2*)(P.ws + dst) = w;
        }
    }
}
__device__ void phase0b(const Params& P) {
    const size_t gtid = (size_t)blockIdx.x * NTHR + threadIdx.x, gsz = (size_t)gridDim.x * NTHR;
    const float* ada = (const float*)(P.ws + OFF_ADA); bf16_t* H = (bf16_t*)(P.ws + OFF_H);
    for (size_t i = gtid; i < (size_t)NTOK * 128; i += gsz) {
        const size_t row = i >> 7; const int c8 = (int)(i & 127) * 8; const int b = (int)(row >> 11);
        const float* xr = P.x + row * 1024 + c8; const float* sh = ada + (size_t)b * 6144 + c8; const float* sc = sh + 1024;
        const f32x4 x0 = *(const f32x4*)xr, x1 = *(const f32x4*)(xr + 4), s0 = *(const f32x4*)sc, s1 = *(const f32x4*)(sc + 4), h0 = *(const f32x4*)sh, h1 = *(const f32x4*)(sh + 4);
        const f32x4 r0 = x0 * (s0 + 1.0f) + h0, r1 = x1 * (s1 + 1.0f) + h1;
        u32x4 w; w.x = cvt_pk_bf16(r0[0], r0[1]); w.y = cvt_pk_bf16(r0[2], r0[3]); w.z = cvt_pk_bf16(r1[0], r1[1]); w.w = cvt_pk_bf16(r1[2], r1[3]);
        *(u32x4*)(H + row * 1024 + c8) = w;
    }
}

__device__ void hgrn_item(const Params& P, int item, LAS unsigned char* lds) {
    const int tid = tid_opaque(), lane = tid & 63, wid = tid >> 6;
    const int b = item >> 3, h = (item >> 1) & 3, vh = item & 1;
    const bf16_t* HQ = (const bf16_t*)(P.ws + OFF_HQ); const bf16_t* HK = (const bf16_t*)(P.ws + OFF_HK); bf16_t* HI = (bf16_t*)(P.ws + OFF_HI);
    LAS float* qs = (LAS float*)lds;
    LAS float* ks = (LAS float*)(lds + 16384);
    LAS float* vs = (LAS float*)(lds + 32768);
    LAS float* part = (LAS float*)(lds + 40960);
    float S[16];
#pragma unroll
    for (int i = 0; i < 16; ++i) S[i] = 0.f;
    const size_t rowb = (size_t)b * SEQ;
    for (int t0 = 0; t0 < SEQ; t0 += 32) {
        { const int row = tid >> 4, c8 = (tid & 15) * 8; const size_t g = (rowb + t0 + row) * 512 + h * 128 + c8;
          const u32x4 qv = *(const u32x4*)(HQ + g), kv = *(const u32x4*)(HK + g);
          LAS float* qd = qs + row * 128 + c8; LAS float* kd = ks + row * 128 + c8;
          *(LAS f32x4*)qd = (f32x4){bf_lo(qv.x), bf_hi(qv.x), bf_lo(qv.y), bf_hi(qv.y)}; *(LAS f32x4*)(qd + 4) = (f32x4){bf_lo(qv.z), bf_hi(qv.z), bf_lo(qv.w), bf_hi(qv.w)};
          *(LAS f32x4*)kd = (f32x4){bf_lo(kv.x), bf_hi(kv.x), bf_lo(kv.y), bf_hi(kv.y)}; *(LAS f32x4*)(kd + 4) = (f32x4){bf_lo(kv.z), bf_hi(kv.z), bf_lo(kv.w), bf_hi(kv.w)};
          const int c4 = (tid & 15) * 4; const u32x2 vv = *(const u32x2*)(HI + (rowb + t0 + row) * 512 + h * 128 + vh * 64 + c4);
          *(LAS f32x4*)(vs + row * 64 + c4) = (f32x4){bf_lo(vv.x), bf_hi(vv.x), bf_lo(vv.y), bf_hi(vv.y)}; }
        __syncthreads();
        for (int t = 0; t < 32; ++t) {
            const float v = vs[t * 64 + lane]; float op = 0.f;
#pragma unroll
            for (int i4 = 0; i4 < 4; ++i4) {
                const f32x4 kq = *(const LAS f32x4*)(ks + t * 128 + wid * 16 + i4 * 4), qq = *(const LAS f32x4*)(qs + t * 128 + wid * 16 + i4 * 4);
#pragma unroll
                for (int e = 0; e < 4; ++e) { float s = S[i4 * 4 + e]; s += kq[e] * (v - s); S[i4 * 4 + e] = s; op += qq[e] * s; }
            }
            part[(t * 8 + wid) * 64 + lane] = op;
        }
        __syncthreads();
        { const int t = tid >> 4, c4 = (tid & 15) * 4; f32x4 s = (f32x4){0.f, 0.f, 0.f, 0.f};
#pragma unroll
          for (int w = 0; w < 8; ++w) s += *(const LAS f32x4*)(part + (t * 8 + w) * 64 + c4);
          u32x2 o; o.x = cvt_pk_bf16(s[0], s[1]); o.y = cvt_pk_bf16(s[2], s[3]);
          *(u32x2*)(HI + (rowb + t0 + t) * 512 + h * 128 + vh * 64 + c4) = o; }
    }
    __syncthreads();
}

__device__ void moba_unit(const Params& P, int b, int h, int j, LAS unsigned char* lds) {
    const int tid = tid_opaque(), lane = tid & 63, wid = tid >> 6, r32 = lane & 31, hi = lane >> 5;
    bf16_t* Q = (bf16_t*)(P.ws + OFF_QA); const bf16_t* Kg = (const bf16_t*)(P.ws + OFF_KA); const bf16_t* Vg = (const bf16_t*)(P.ws + OFF_VA);
    const float* kmean = (const float*)(P.ws + OFF_KMEAN);
    constexpr int KIMG = 64 * 144, VIMG = 64 * 192, LK = 0, LV = 2 * KIMG, LKM = 2 * KIMG + 2 * VIMG;
    LAS float* kmL = (LAS float*)(lds + LKM);
    const size_t rowb = (size_t)b * SEQ; const int q0 = j * 256;
    if (tid < j * 64) kmL[tid] = kmean[(size_t)(b * 8 + (tid >> 6)) * 512 + h * 64 + (tid & 63)];
    bf16_t* qrow = Q + (rowb + q0 + wid * 32 + r32) * 512 + h * 64;
    bf16x8 qf[4];
#pragma unroll
    for (int d0 = 0; d0 < 4; ++d0) qf[d0] = *(const bf16x8*)(qrow + 16 * d0 + 8 * hi);
    const int srow = tid >> 3, sch = tid & 7;
    const bf16_t* ksrc = Kg + (rowb + srow) * 512 + h * 64 + sch * 8; const bf16_t* vsrc = Vg + (rowb + srow) * 512 + h * 64 + sch * 8;
    const int ntile = 4 * (j + 1);
    u32x4 kreg, vreg;
    { const int key0 = q0; kreg = *(const u32x4*)(ksrc + (size_t)key0 * 512); vreg = *(const u32x4*)(vsrc + (size_t)key0 * 512); }
    *(LAS u32x4*)(lds + LK + srow * 144 + sch * 16) = kreg; *(LAS u32x4*)(lds + LV + srow * 192 + sch * 16) = vreg;
    __syncthreads();
    unsigned sel = 0;
    if (j <= 3) sel = (1u << j) - 1u;
    else {
        float g[7];
#pragma unroll
        for (int n = 0; n < 7; ++n) { float s = 0.f;
            if (n < j) {
#pragma unroll
                for (int d0 = 0; d0 < 4; ++d0)
#pragma unroll
                    for (int e = 0; e < 8; ++e) s += __uint_as_float(((unsigned)(unsigned short)qf[d0][e]) << 16) * kmL[n * 64 + 16 * d0 + 8 * hi + e];
            }
            s += __shfl_xor(s, 32); g[n] = s; }
#pragma unroll
        for (int it = 0; it < 3; ++it) { float best = -INFINITY; int bi = 0;
#pragma unroll
            for (int n = 0; n < 7; ++n) if (n < j && !((sel >> n) & 1u) && g[n] > best) { best = g[n]; bi = n; }
            sel |= 1u << bi; }
    }
    const float ch = exp2f(-(float)(h + 1)) * LOG2E;
    const int qb = wid * 32 + r32;
    float m_run = -1e30f, l_run = 0.f;
    f32x16 o0 = {}, o1 = {};
    const int tg = lane >> 4, tc = tg & 1, ti = lane & 15;
    const int vlane = (4 * hi + (ti >> 2)) * 192 + (16 * tc + 4 * (ti & 3)) * 2;
#pragma unroll 1
    for (int i = 0; i < ntile; ++i) {
        const int buf = i & 1;
        const bool own = i < 4; const int blk = own ? j : ((i - 4) >> 2), kt = own ? i : ((i - 4) & 3);
        if (i + 1 < ntile) { const int i1 = i + 1; const int blk1 = (i1 < 4) ? j : ((i1 - 4) >> 2), kt1 = (i1 < 4) ? i1 : ((i1 - 4) & 3); const size_t key1 = (size_t)(blk1 * 256 + kt1 * 64);
            kreg = *(const u32x4*)(ksrc + key1 * 512); vreg = *(const u32x4*)(vsrc + key1 * 512); }
        const bool lane_ok = own ? true : (((sel >> blk) & 1u) != 0u);
        const bool skip = own ? (64 * kt > 32 * wid + 31) : (__ballot(lane_ok) == 0ull);
        if (!skip) {
            LAS unsigned char* kb = lds + LK + buf * KIMG; LAS unsigned char* vb = lds + LV + buf * VIMG;
            f32x16 p0 = {}, p1 = {};
#pragma unroll
            for (int d0 = 0; d0 < 4; ++d0) {
                const bf16x8 kf0 = *(const LAS bf16x8*)(kb + r32 * 144 + (16 * d0 + 8 * hi) * 2);
                const bf16x8 kf1 = *(const LAS bf16x8*)(kb + (32 + r32) * 144 + (16 * d0 + 8 * hi) * 2);
                p0 = MFMA32(kf0, qf[d0], p0); p1 = MFMA32(kf1, qf[d0], p1);
            }
            const float kbase = ch * (float)((blk - j) * 256 + kt * 64);
            float mt = -1e30f;
#pragma unroll
            for (int r = 0; r < 16; ++r) {
                const int kl0 = crow(r, hi), kl1 = kl0 + 32;
                const float t0 = p0[r] + (kbase + ch * (float)kl0), t1 = p1[r] + (kbase + ch * (float)kl1);
                const bool v0 = own ? (kt * 64 + kl0 <= qb) : lane_ok, v1 = own ? (kt * 64 + kl1 <= qb) : lane_ok;
                p0[r] = v0 ? t0 : -1e30f; p1[r] = v1 ? t1 : -1e30f;
                mt = fmaxf(mt, fmaxf(p0[r], p1[r]));
            }
            mt = fmaxf(mt, __shfl_xor(mt, 32));
            const float mnew = fmaxf(m_run, mt), alpha = __builtin_amdgcn_exp2f(m_run - mnew);
            m_run = mnew;
            float rs = 0.f;
#pragma unroll
            for (int r = 0; r < 16; ++r) { p0[r] = __builtin_amdgcn_exp2f(p0[r] - mnew); p1[r] = __builtin_amdgcn_exp2f(p1[r] - mnew); rs += p0[r] + p1[r]; }
            l_run = l_run * alpha + rs;
#pragma unroll
            for (int r = 0; r < 16; ++r) { o0[r] *= alpha; o1[r] *= alpha; }
#pragma unroll
            for (int sub = 0; sub < 2; ++sub)
#pragma unroll
                for (int s = 0; s < 2; ++s) {
                    union { u32x4 u; bf16x8 v; } pb;
                    if (sub == 0) { pb.u.x = cvt_pk_bf16(p0[8 * s + 0], p0[8 * s + 1]); pb.u.y = cvt_pk_bf16(p0[8 * s + 2], p0[8 * s + 3]); pb.u.z = cvt_pk_bf16(p0[8 * s + 4], p0[8 * s + 5]); pb.u.w = cvt_pk_bf16(p0[8 * s + 6], p0[8 * s + 7]); }
                    else { pb.u.x = cvt_pk_bf16(p1[8 * s + 0], p1[8 * s + 1]); pb.u.y = cvt_pk_bf16(p1[8 * s + 2], p1[8 * s + 3]); pb.u.z = cvt_pk_bf16(p1[8 * s + 4], p1[8 * s + 5]); pb.u.w = cvt_pk_bf16(p1[8 * s + 6], p1[8 * s + 7]); }
#pragma unroll
                    for (int dt = 0; dt < 2; ++dt) {
                        LAS unsigned char* va = vb + (32 * sub + 16 * s) * 192 + dt * 64 + vlane;
                        const s16x4 lo = __builtin_bit_cast(s16x4, __builtin_amdgcn_ds_read_tr16_b64_v4i16((LAS s16x4*)va));
                        const s16x4 hh = __builtin_bit_cast(s16x4, __builtin_amdgcn_ds_read_tr16_b64_v4i16((LAS s16x4*)(va + 8 * 192)));
                        const bf16x8 vf = {lo[0], lo[1], lo[2], lo[3], hh[0], hh[1], hh[2], hh[3]};
                        if (dt == 0) o0 = MFMA32(vf, pb.v, o0); else o1 = MFMA32(vf, pb.v, o1);
                    }
                }
        }
        if (i + 1 < ntile) { const int nb = buf ^ 1;
            *(LAS u32x4*)(lds + LK + nb * KIMG + srow * 144 + sch * 16) = kreg; *(LAS u32x4*)(lds + LV + nb * VIMG + srow * 192 + sch * 16) = vreg; }
        __syncthreads();
    }
    l_run += __shfl_xor(l_run, 32);
    const float inv = 1.0f / l_run;
#pragma unroll
    for (int r4 = 0; r4 < 4; ++r4) {
        u32x2 w0, w1;
        w0.x = cvt_pk_bf16(o0[4 * r4] * inv, o0[4 * r4 + 1] * inv); w0.y = cvt_pk_bf16(o0[4 * r4 + 2] * inv, o0[4 * r4 + 3] * inv);
        w1.x = cvt_pk_bf16(o1[4 * r4] * inv, o1[4 * r4 + 1] * inv); w1.y = cvt_pk_bf16(o1[4 * r4 + 2] * inv, o1[4 * r4 + 3] * inv);
        *(u32x2*)(qrow + 8 * r4 + 4 * hi) = w0; *(u32x2*)(qrow + 32 + 8 * r4 + 4 * hi) = w1;
    }
}

__device__ void yb_norm_panel(const Params& P, int pm) {
    const int tid = tid_opaque(), lane = tid & 63, wid = tid >> 6;
    bf16_t* HI = (bf16_t*)(P.ws + OFF_HI); const bf16_t* HG = (const bf16_t*)(P.ws + OFF_HG);
    for (int r = 0; r < 32; ++r) {
        const size_t off = ((size_t)pm * 256 + wid * 32 + r) * 512 + lane * 8;
        const u32x4 ov = *(const u32x4*)(HI + off), gv = *(const u32x4*)(HG + off);
        float o[8] = {bf_lo(ov.x), bf_hi(ov.x), bf_lo(ov.y), bf_hi(ov.y), bf_lo(ov.z), bf_hi(ov.z), bf_lo(ov.w), bf_hi(ov.w)};
        const float g[8] = {bf_lo(gv.x), bf_hi(gv.x), bf_lo(gv.y), bf_hi(gv.y), bf_lo(gv.z), bf_hi(gv.z), bf_lo(gv.w), bf_hi(gv.w)};
        float ss = 0.f;
#pragma unroll
        for (int e = 0; e < 8; ++e) ss += o[e] * o[e];
        ss += __shfl_xor(ss, 1); ss += __shfl_xor(ss, 2); ss += __shfl_xor(ss, 4); ss += __shfl_xor(ss, 8);
        const float rs = rsqrtf(ss * (1.0f / 128.0f) + RMS_EPS);
        u32x4 w; w.x = cvt_pk_bf16(o[0] * rs * g[0], o[1] * rs * g[1]); w.y = cvt_pk_bf16(o[2] * rs * g[2], o[3] * rs * g[3]);
        w.z = cvt_pk_bf16(o[4] * rs * g[4], o[5] * rs * g[5]); w.w = cvt_pk_bf16(o[6] * rs * g[6], o[7] * rs * g[7]);
        *(u32x4*)(HI + off) = w;
    }
}
__device__ void ln1_panel(const Params& P, int pm) {
    const int tid = tid_opaque(), lane = tid & 63, wid = tid >> 6;
    const float* ada = (const float*)(P.ws + OFF_ADA) + (size_t)(pm >> 3) * 6144; bf16_t* H = (bf16_t*)(P.ws + OFF_H);
    for (int r = 0; r < 32; ++r) {
        const size_t row = (size_t)pm * 256 + wid * 32 + r;
        float* xr = P.out + row * 1024 + lane * 4;
        f32x4 v[4]; float s = 0.f;
#pragma unroll
        for (int jx = 0; jx < 4; ++jx) { v[jx] = *(const f32x4*)(xr + 256 * jx); s += (v[jx][0] + v[jx][1]) + (v[jx][2] + v[jx][3]); }
        const float mean = wave_sum(s) * (1.0f / 1024.0f); float s2 = 0.f;
#pragma unroll
        for (int jx = 0; jx < 4; ++jx) { v[jx] = v[jx] - mean; s2 += (v[jx][0] * v[jx][0] + v[jx][1] * v[jx][1]) + (v[jx][2] * v[jx][2] + v[jx][3] * v[jx][3]); }
        const float rstd = rsqrtf(wave_sum(s2) * (1.0f / 1024.0f) + LN_EPS);
#pragma unroll
        for (int jx = 0; jx < 4; ++jx) {
            const int c = lane * 4 + 256 * jx;
            const f32x4 g = *(const f32x4*)(P.ln1_g + c), bb = *(const f32x4*)(P.ln1_b + c), sh = *(const f32x4*)(ada + 3072 + c), sc = *(const f32x4*)(ada + 4096 + c);
            const f32x4 x1 = v[jx] * rstd * g + bb;
            *(f32x4*)(xr + 256 * jx) = x1;
            const f32x4 h2 = x1 * (sc + 1.0f) + sh;
            u32x2 w; w.x = cvt_pk_bf16(h2[0], h2[1]); w.y = cvt_pk_bf16(h2[2], h2[3]);
            *(u32x2*)(H + row * 1024 + c) = w;
        }
    }
}

#define INS16(L, xin) do { float x_ = (xin); _Pragma("unroll") for (int k_ = 0; k_ < 16; ++k_) { const float hi_ = fmaxf(L[k_], x_); x_ = fminf(L[k_], x_); L[k_] = hi_; } } while (0)

__device__ void peer_select_wave(const Params& P, size_t tok0) {
    const int lane = tid_opaque() & 63, r32 = lane & 31, hi = lane >> 5;
    const bf16_t* QP = (const bf16_t*)(P.ws + OFF_GB) + (tok0 + r32) * 1024; const bf16_t* SK = (const bf16_t*)(P.ws + OFF_SK);
    u32x2* EG = (u32x2*)(P.ws + OFF_EG) + (tok0 + r32) * 128;
#pragma unroll 1
    for (int h = 0; h < 8; ++h) {
        float a0[16], a1[16];
#pragma unroll
        for (int k = 0; k < 16; ++k) { a0[k] = -INFINITY; a1[k] = -INFINITY; }
#pragma unroll 1
        for (int p = 0; p < 2; ++p) {
            const int hp = h * 2 + p;
            bf16x8 qf[4];
#pragma unroll
            for (int ks = 0; ks < 4; ++ks) qf[ks] = *(const bf16x8*)(QP + hp * 64 + 16 * ks + 8 * hi);
            float L[16];
#pragma unroll
            for (int k = 0; k < 16; ++k) L[k] = -INFINITY;
#pragma unroll
            for (int kt = 0; kt < 4; ++kt) {
                f32x16 acc = {};
#pragma unroll
                for (int ks = 0; ks < 4; ++ks) { const bf16x8 kf = *(const bf16x8*)(SK + ((size_t)hp * 128 + 32 * kt + r32) * 64 + 16 * ks + 8 * hi); acc = MFMA32(kf, qf[ks], acc); }
#pragma unroll
                for (int r = 0; r < 16; ++r) { const unsigned key = (unsigned)(32 * kt + crow(r, hi)); const float xv = __uint_as_float((__float_as_uint(acc[r]) & ~127u) | key); INS16(L, xv); }
            }
            float O[16];
#pragma unroll
            for (int k = 0; k < 16; ++k) O[k] = __shfl_xor(L[k], 32);
#pragma unroll
            for (int k = 0; k < 16; ++k) INS16(L, O[k]);
#pragma unroll
            for (int k = 0; k < 16; ++k) { a0[k] = (p == 0) ? L[k] : a0[k]; a1[k] = (p == 1) ? L[k] : a1[k]; }
        }
        float best[16];
#pragma unroll
        for (int k = 0; k < 16; ++k) best[k] = -INFINITY;
#pragma unroll
        for (int i = 0; i < 16; ++i)
#pragma unroll
            for (int jx = 0; jx < 16; ++jx)
                if ((i + 1) * (jx + 1) <= 16) {
                    const float cs = a0[i] + a1[jx];
                    const float cv = __uint_as_float((__float_as_uint(cs) & ~255u) | (unsigned)(i * 16 + jx));
                    INS16(best, cv);
                }
        unsigned pk0[4], pk1[4];
#pragma unroll
        for (int q = 0; q < 4; ++q) {
            pk0[q] = (__float_as_uint(a0[4 * q]) & 127u) | ((__float_as_uint(a0[4 * q + 1]) & 127u) << 8) | ((__float_as_uint(a0[4 * q + 2]) & 127u) << 16) | ((__float_as_uint(a0[4 * q + 3]) & 127u) << 24);
            pk1[q] = (__float_as_uint(a1[4 * q]) & 127u) | ((__float_as_uint(a1[4 * q + 1]) & 127u) << 8) | ((__float_as_uint(a1[4 * q + 2]) & 127u) << 16) | ((__float_as_uint(a1[4 * q + 3]) & 127u) << 24);
        }
        unsigned pay[16];
#pragma unroll
        for (int k = 0; k < 16; ++k) {
            const unsigned code = __float_as_uint(best[k]) & 255u, ci = code >> 4, cj = code & 15u;
            const unsigned qi = ci >> 2, qj = cj >> 2;
            const unsigned w0 = (qi == 0u) ? pk0[0] : ((qi == 1u) ? pk0[1] : ((qi == 2u) ? pk0[2] : pk0[3]));
            const unsigned w1 = (qj == 0u) ? pk1[0] : ((qj == 1u) ? pk1[1] : ((qj == 2u) ? pk1[2] : pk1[3]));
            pay[k] = (((w0 >> ((ci & 3u) * 8u)) & 127u) << 7) | ((w1 >> ((cj & 3u) * 8u)) & 127u);
        }
        float e[16], es = 0.f;
#pragma unroll
        for (int k = 0; k < 16; ++k) { e[k] = __expf(best[k] - best[0]); es += e[k]; }
        const float inv = 1.0f / es;
        if (hi == 0) {
#pragma unroll
            for (int k = 0; k < 16; ++k) { u32x2 w; w.x = pay[k]; w.y = __float_as_uint(e[k] * inv); EG[h * 16 + k] = w; }
        }
    }
}
__device__ __forceinline__ unsigned xcc_id() { return (unsigned)__builtin_amdgcn_s_getreg((3 << 11) | 20) & 0xFu; }
template <int CTRL> __device__ __forceinline__ float dpp_add(float x) { const int v = __builtin_amdgcn_update_dpp(0, __float_as_int(x), CTRL, 0xf, 0xf, true); return x + __int_as_float(v); }
__device__ __forceinline__ float wave_sum_fast(float x) {
    x = dpp_add<0xB1>(x); x = dpp_add<0x4E>(x); x = dpp_add<0x141>(x); x = dpp_add<0x140>(x);
    x += __shfl_xor(x, 16); x += __shfl_xor(x, 32); return x;
}
__device__ __forceinline__ float dot16_fp8(const float (&hv)[16], const u32x4 r) {
    float s = 0.f;
    { const f32x2 a = __builtin_amdgcn_cvt_pk_f32_fp8((int)r.x, false), b = __builtin_amdgcn_cvt_pk_f32_fp8((int)r.x, true); s += hv[0] * a.x + hv[1] * a.y + hv[2] * b.x + hv[3] * b.y; }
    { const f32x2 a = __builtin_amdgcn_cvt_pk_f32_fp8((int)r.y, false), b = __builtin_amdgcn_cvt_pk_f32_fp8((int)r.y, true); s += hv[4] * a.x + hv[5] * a.y + hv[6] * b.x + hv[7] * b.y; }
    { const f32x2 a = __builtin_amdgcn_cvt_pk_f32_fp8((int)r.z, false), b = __builtin_amdgcn_cvt_pk_f32_fp8((int)r.z, true); s += hv[8] * a.x + hv[9] * a.y + hv[10] * b.x + hv[11] * b.y; }
    { const f32x2 a = __builtin_amdgcn_cvt_pk_f32_fp8((int)r.w, false), b = __builtin_amdgcn_cvt_pk_f32_fp8((int)r.w, true); s += hv[12] * a.x + hv[13] * a.y + hv[14] * b.x + hv[15] * b.y; }
    return s;
}
template <class F> __device__ __forceinline__ void partition_queue(const Params& P, LAS unsigned char* lds, int ctr_base, F f) {
    const int tid = tid_opaque();
    LAS int* slot = (LAS int*)(lds + LDS_BYTES - 64);
    unsigned* ctr = (unsigned*)(P.ws + OFF_CTR) + ctr_base;
    const int myx = (int)(xcc_id() & 7u);
    for (int pp = 0; pp < 8; ++pp) {
        const int p = (myx + pp) & 7;
        for (;;) {
            if (tid == 0) *slot = (int)atomicAdd(ctr + p, 1u);
            __syncthreads();
            const int item = *slot;
            __syncthreads();
            if (item >= NTOK / 64) break;
            f(p, item);
        }
    }
}
__device__ __forceinline__ void peer_u_chunk(const Params& P, LAS unsigned char* lds, int p, int chunk) {
    const int tid = tid_opaque(), lane = tid & 63, wid = tid >> 6, g = lane >> 4, li = lane & 15;
    const bf16_t* H = (const bf16_t*)(P.ws + OFF_H); const unsigned char* U8 = P.ws + OFF_U8 + li * 16;
    const u32x4* EG4 = (const u32x4*)(P.ws + OFF_EG); float* W = (float*)(P.ws + OFF_W);
    LAS unsigned* list = (LAS unsigned*)(lds + wid * 2048);
    const size_t t0 = (size_t)chunk * 64 + wid * 8;
    u32x4 eg = __builtin_nontemporal_load(EG4 + t0 * 64 + lane);
    u32x4 hp[8];
#pragma unroll
    for (int c = 0; c < 4; ++c) { hp[2 * c] = __builtin_nontemporal_load((const u32x4*)(H + t0 * 1024 + (li + 16 * c) * 16)); hp[2 * c + 1] = __builtin_nontemporal_load((const u32x4*)(H + t0 * 1024 + (li + 16 * c) * 16 + 8)); }
#pragma unroll 1
    for (int i = 0; i < 8; ++i) {
        const size_t t = t0 + i;
        f32x2 hv[32];
#pragma unroll
        for (int q = 0; q < 8; ++q) { hv[4 * q] = (f32x2){bf_lo(hp[q].x), bf_hi(hp[q].x)}; hv[4 * q + 1] = (f32x2){bf_lo(hp[q].y), bf_hi(hp[q].y)}; hv[4 * q + 2] = (f32x2){bf_lo(hp[q].z), bf_hi(hp[q].z)}; hv[4 * q + 3] = (f32x2){bf_lo(hp[q].w), bf_hi(hp[q].w)}; }
        const bool m0 = (int)(eg.x >> 11) == p, m1 = (int)(eg.z >> 11) == p;
        const unsigned long long b0 = __ballot(m0), b1 = __ballot(m1);
        const int n0 = __builtin_popcountll(b0), n = n0 + __builtin_popcountll(b1);
        { const int r0 = (int)__builtin_amdgcn_mbcnt_hi((unsigned)(b0 >> 32), __builtin_amdgcn_mbcnt_lo((unsigned)b0, 0u));
          const int r1 = n0 + (int)__builtin_amdgcn_mbcnt_hi((unsigned)(b1 >> 32), __builtin_amdgcn_mbcnt_lo((unsigned)b1, 0u));
          if (m0) *(LAS u32x4*)(list + 4 * r0) = (u32x4){eg.x, eg.y, (unsigned)(2 * lane), 0u};
          if (m1) *(LAS u32x4*)(list + 4 * r1) = (u32x4){eg.z, eg.w, (unsigned)(2 * lane + 1), 0u}; }
        if (i + 1 < 8) {
            eg = __builtin_nontemporal_load(EG4 + (t + 1) * 64 + lane);
#pragma unroll
            for (int c = 0; c < 4; ++c) { hp[2 * c] = __builtin_nontemporal_load((const u32x4*)(H + (t + 1) * 1024 + (li + 16 * c) * 16)); hp[2 * c + 1] = __builtin_nontemporal_load((const u32x4*)(H + (t + 1) * 1024 + (li + 16 * c) * 16 + 8)); }
        }
#pragma unroll 1
        for (int base = 0; base < n; base += 16) {
            u32x4 row[4][4]; u32x4 ent[4];
#pragma unroll
            for (int q = 0; q < 4; ++q) { const int k = base + 4 * q + g; ent[q] = *(const LAS u32x4*)(list + 4 * (k < n ? k : 0));
                const unsigned char* rp = U8 + (size_t)ent[q].x * 1024;
#pragma unroll
                for (int c = 0; c < 4; ++c) row[q][c] = *(const u32x4*)(rp + c * 256); }
#pragma unroll
            for (int q = 0; q < 4; ++q) {
                f32x2 a2 = {0.f, 0.f};
#pragma unroll
                for (int c = 0; c < 4; ++c) {
                    const u32x4 r = row[q][c];
                    a2 += hv[8 * c + 0] * __builtin_amdgcn_cvt_pk_f32_fp8((int)r.x, false); a2 += hv[8 * c + 1] * __builtin_amdgcn_cvt_pk_f32_fp8((int)r.x, true);
                    a2 += hv[8 * c + 2] * __builtin_amdgcn_cvt_pk_f32_fp8((int)r.y, false); a2 += hv[8 * c + 3] * __builtin_amdgcn_cvt_pk_f32_fp8((int)r.y, true);
                    a2 += hv[8 * c + 4] * __builtin_amdgcn_cvt_pk_f32_fp8((int)r.z, false); a2 += hv[8 * c + 5] * __builtin_amdgcn_cvt_pk_f32_fp8((int)r.z, true);
                    a2 += hv[8 * c + 6] * __builtin_amdgcn_cvt_pk_f32_fp8((int)r.w, false); a2 += hv[8 * c + 7] * __builtin_amdgcn_cvt_pk_f32_fp8((int)r.w, true);
                }
                float s = a2.x + a2.y;
                s = dpp_add<0xB1>(s); s = dpp_add<0x4E>(s); s = dpp_add<0x141>(s); s = dpp_add<0x140>(s);
                const int k = base + 4 * q + g;
                if (li == 0 && k < n) { const float xv = s * (1.0f / 32.0f); W[t * 128 + ent[q].z] = __uint_as_float(ent[q].y) * 0.5f * xv * (1.0f + erff(xv * 0.70710678118654752f)); }
            }
        }
    }
}
__device__ __forceinline__ void peer_v_chunk(const Params& P, LAS unsigned char* lds, int x, int chunk) {
    const int tid = tid_opaque(), lane = tid & 63, wid = tid >> 6, g = lane >> 4, li = lane & 15;
    const unsigned char* V8 = P.ws + OFF_V8 + (size_t)x * 16384 * 128 + li * 8;
    const u32x4* EG4 = (const u32x4*)(P.ws + OFF_EG); const f32x2* W2 = (const f32x2*)(P.ws + OFF_W); float* Y = (float*)(P.ws + OFF_Y);
    LAS unsigned* list = (LAS unsigned*)(lds + wid * 2048);
    const size_t t0 = (size_t)chunk * 64 + wid * 8;
    u32x4 eg = EG4[t0 * 64 + lane]; f32x2 ww = W2[t0 * 64 + lane];
#pragma unroll 1
    for (int i = 0; i < 8; ++i) {
        const size_t t = t0 + i;
        *(LAS u32x4*)(list + 4 * lane) = (u32x4){eg.x, __float_as_uint(ww.x), eg.z, __float_as_uint(ww.y)};
        if (i + 1 < 8) { eg = EG4[(t + 1) * 64 + lane]; ww = W2[(t + 1) * 64 + lane]; }
        u32x2 r[32]; float w[32];
#pragma unroll
        for (int j = 0; j < 32; ++j) { const u32x2 en = *(const LAS u32x2*)(list + 2 * (4 * j + g)); w[j] = __uint_as_float(en.y); r[j] = *(const u32x2*)(V8 + (size_t)en.x * 128); }
        f32x2 a0 = {0.f, 0.f}, a1 = {0.f, 0.f}, a2 = {0.f, 0.f}, a3 = {0.f, 0.f};
#pragma unroll
        for (int j = 0; j < 32; ++j) {
            const f32x2 wv = {w[j], w[j]};
            a0 += wv * __builtin_amdgcn_cvt_pk_f32_fp8((int)r[j].x, false); a1 += wv * __builtin_amdgcn_cvt_pk_f32_fp8((int)r[j].x, true);
            a2 += wv * __builtin_amdgcn_cvt_pk_f32_fp8((int)r[j].y, false); a3 += wv * __builtin_amdgcn_cvt_pk_f32_fp8((int)r[j].y, true);
        }
        float acc[8] = {a0.x, a0.y, a1.x, a1.y, a2.x, a2.y, a3.x, a3.y};
#pragma unroll
        for (int j = 0; j < 8; ++j) { acc[j] += __shfl_xor(acc[j], 16); acc[j] += __shfl_xor(acc[j], 32); }
        if (g == 0) { float* yp = Y + t * 1024 + x * 128 + li * 8;
            *(f32x4*)yp = (f32x4){acc[0], acc[1], acc[2], acc[3]} * 0.25f; *(f32x4*)(yp + 4) = (f32x4){acc[4], acc[5], acc[6], acc[7]} * 0.25f; }
    }
}
__device__ void ln2_phase(const Params& P) {
    const int tid = tid_opaque(), lane = tid & 63, wid = tid >> 6;
    const float* Y = (const float*)(P.ws + OFF_Y);
    for (size_t row = (size_t)blockIdx.x * 8 + wid; row < (size_t)NTOK; row += (size_t)gridDim.x * 8) {
        const float* gt2 = (const float*)(P.ws + OFF_ADA) + (row >> 11) * 6144 + 5120;
        float* xr = P.out + row * 1024 + lane * 4; const float* yr = Y + row * 1024 + lane * 4;
        f32x4 v[4]; float s = 0.f;
#pragma unroll
        for (int jx = 0; jx < 4; ++jx) { const f32x4 xv = *(const f32x4*)(xr + 256 * jx), yv = __builtin_nontemporal_load((const f32x4*)(yr + 256 * jx)), gv = *(const f32x4*)(gt2 + lane * 4 + 256 * jx);
            v[jx] = xv * ALPHA + gv * yv; s += (v[jx][0] + v[jx][1]) + (v[jx][2] + v[jx][3]); }
        const float mean = wave_sum(s) * (1.0f / 1024.0f); float s2 = 0.f;
#pragma unroll
        for (int jx = 0; jx < 4; ++jx) { v[jx] = v[jx] - mean; s2 += (v[jx][0] * v[jx][0] + v[jx][1] * v[jx][1]) + (v[jx][2] * v[jx][2] + v[jx][3] * v[jx][3]); }
        const float rstd = rsqrtf(wave_sum(s2) * (1.0f / 1024.0f) + LN_EPS);
#pragma unroll
        for (int jx = 0; jx < 4; ++jx) { const int c = lane * 4 + 256 * jx; const f32x4 g = *(const f32x4*)(P.ln2_g + c), bb = *(const f32x4*)(P.ln2_b + c);
            *(f32x4*)(xr + 256 * jx) = v[jx] * rstd * g + bb; }
    }
}

__global__ void __launch_bounds__(NTHR, 2) fwd_megakernel(Params P) {
    extern __shared__ __attribute__((aligned(16))) unsigned char shm[];
    LAS unsigned char* lds = (LAS unsigned char*)shm;
    cg::grid_group grid = cg::this_grid();
    const int G = gridDim.x, bid = blockIdx.x;

#ifndef P3
#define P3 0xff
#endif
#ifndef PH
#define PH 0xff
#endif
    if (PH & 1) phase0a(P, lds);
    grid.sync();
    if (PH & 2) phase0b(P);
    grid.sync();
    if (PH & 4) {
        pg8::Gemm g; g.A = (const bf16_t*)(P.ws + OFF_H); g.Bt = (const bf16_t*)(P.ws + OFF_WIN); g.M = NTOK; g.N = INCOLS; g.K = 1024;
        pg8::StaticOrder S; S.init(NTOK, INCOLS, G, bid);
        EpiProj E; E.ws = P.ws; E.lb = (const float*)(P.ws + OFF_LB); E.ng = P.hgrn_ng; E.kmean = (float*)(P.ws + OFF_KMEAN);
        pg8::gemm_phase<EpiProj, pg8::StaticOrder>(lds, g, S, E);
    }
    grid.sync();
    if (PH & 8) for (int it = bid; it < 256; it += G) hgrn_item(P, it, lds);
    if (PH & 16) for (int u = bid; u < 2048; u += G) { const int bh = u & 255, jj = u >> 8; moba_unit(P, bh >> 3, bh & 7, (jj + bh) & 7, lds); }
    grid.sync();
    if (PH & 32) for (int pm = bid; pm < NTOK / 256; pm += G) {
        if (P3 & 1) yb_norm_panel(P, pm);
        __syncthreads();
        if (P3 & 2) { pg8::Gemm g; g.A = (const bf16_t*)(P.ws + OFF_QA); g.Bt = (const bf16_t*)(P.ws + OFF_WBA); g.M = NTOK; g.N = 1024; g.K = 512;
          pg8::PanelOrder S; S.pm = pm; S.npn = 4; EpiMixA E; E.GA = (bf16_t*)(P.ws + OFF_GA);
          pg8::gemm_phase<EpiMixA, pg8::PanelOrder>(lds, g, S, E); }
        __syncthreads();
        if (P3 & 4) { pg8::Gemm g; g.A = (const bf16_t*)(P.ws + OFF_HI); g.Bt = (const bf16_t*)(P.ws + OFF_WBB); g.M = NTOK; g.N = 1024; g.K = 512;
          pg8::PanelOrder S; S.pm = pm; S.npn = 4; EpiMixB E; E.GA = (bf16_t*)(P.ws + OFF_GA); E.GB = (const bf16_t*)(P.ws + OFF_GB);
          pg8::gemm_phase<EpiMixB, pg8::PanelOrder>(lds, g, S, E); }
        __syncthreads();
        if (P3 & 8) { pg8::Gemm g; g.A = (const bf16_t*)(P.ws + OFF_GA); g.Bt = (const bf16_t*)(P.ws + OFF_WOUT); g.M = NTOK; g.N = 1024; g.K = 1024;
          pg8::PanelOrder S; S.pm = pm; S.npn = 4; EpiOut E; E.x = P.x; E.ada = (const float*)(P.ws + OFF_ADA); E.out = P.out;
          pg8::gemm_phase<EpiOut, pg8::PanelOrder>(lds, g, S, E); }
        __syncthreads();
        if (P3 & 16) ln1_panel(P, pm);
        __syncthreads();
        if (P3 & 32) { pg8::Gemm g; g.A = (const bf16_t*)(P.ws + OFF_H); g.Bt = (const bf16_t*)(P.ws + OFF_WQ); g.M = NTOK; g.N = 1024; g.K = 1024;
          pg8::PanelOrder S; S.pm = pm; S.npn = 4; EpiBf16 E; E.O = (bf16_t*)(P.ws + OFF_GB);
          pg8::gemm_phase<EpiBf16, pg8::PanelOrder>(lds, g, S, E); }
        __syncthreads();
        { const size_t tok0 = (size_t)pm * 256 + (tid_opaque() >> 6) * 32;
          peer_select_wave(P, tok0); }
        __syncthreads();
    }
    grid.sync();
    partition_queue(P, lds, 0, [&](int p, int chunk) { peer_u_chunk(P, lds, p, chunk); });
    grid.sync();
    partition_queue(P, lds, 8, [&](int x, int chunk) { peer_v_chunk(P, lds, x, chunk); });
    grid.sync();
    ln2_phase(P);
}

extern "C" void kernel_launch(void* const* d_in, const int* in_sizes, int n_in, void* d_out, int out_size, void* d_ws, size_t ws_size, hipStream_t stream) {
    static int grid_blocks = 0;
    if (grid_blocks == 0) {
        if (n_in != 18 || out_size != NTOK * DM || ws_size < WS_END) { fprintf(stderr, "kernel_launch: unexpected shapes (n_in %d, out %d, ws %zu, need %zu)\n", n_in, out_size, ws_size, (size_t)WS_END); grid_blocks = -1; return; }
        int dev = 0, cus = 0, per_cu = 0;
        hipGetDevice(&dev);
        hipDeviceGetAttribute(&cus, hipDeviceAttributeMultiprocessorCount, dev);
        if (hipFuncSetAttribute((const void*)fwd_megakernel, hipFuncAttributeMaxDynamicSharedMemorySize, LDS_BYTES) != hipSuccess) fprintf(stderr, "kernel_launch: hipFuncSetAttribute failed\n");
        hipOccupancyMaxActiveBlocksPerMultiprocessor(&per_cu, (const void*)fwd_megakernel, NTHR, LDS_BYTES);
        if (per_cu < 1) { fprintf(stderr, "kernel_launch: occupancy query says %d blocks per CU\n", per_cu); per_cu = 1; }
        if (per_cu > 1) per_cu = 1;
        grid_blocks = cus * per_cu;
        (void)hipGetLastError();
    }
    if (grid_blocks < 0) return;
    Params p{};
    p.x = (const float*)d_in[0]; p.c = (const float*)d_in[1]; p.w_ada = (const float*)d_in[2]; p.b_ada = (const float*)d_in[3]; p.w_in = (const float*)d_in[4];
    p.w_ba = (const float*)d_in[5]; p.w_bb = (const float*)d_in[6]; p.w_out = (const float*)d_in[7]; p.hgrn_lb = (const float*)d_in[8]; p.hgrn_ng = (const float*)d_in[9];
    p.ln1_g = (const float*)d_in[10]; p.ln1_b = (const float*)d_in[11]; p.peer_wq = (const float*)d_in[12]; p.peer_sk = (const float*)d_in[13]; p.peer_u = (const float*)d_in[14];
    p.peer_v = (const float*)d_in[15]; p.ln2_g = (const float*)d_in[16]; p.ln2_b = (const float*)d_in[17];
    p.out = (float*)d_out; p.ws = (unsigned char*)d_ws;
    void* args[] = {&p};
    hipError_t e = hipLaunchCooperativeKernel((const void*)fwd_megakernel, dim3(grid_blocks), dim3(NTHR), args, LDS_BYTES, stream);
    if (e != hipSuccess) fprintf(stderr, "cooperative launch failed: %s (grid %d)\n", hipGetErrorString(e), grid_blocks);
}
```

```cpp
#include <hip/hip_runtime.h>
#include <hip/hip_cooperative_groups.h>
#include <cstdio>
#include <cstdint>
namespace cg = cooperative_groups;

#define LAS __attribute__((address_space(3)))
typedef unsigned short bf16_t;
typedef short bf16x8 __attribute__((ext_vector_type(8)));
typedef short s16x4 __attribute__((ext_vector_type(4)));
typedef float f32x2 __attribute__((ext_vector_type(2)));
typedef float f32x4 __attribute__((ext_vector_type(4)));
typedef float f32x16 __attribute__((ext_vector_type(16)));
typedef unsigned u32x2 __attribute__((ext_vector_type(2)));
typedef unsigned u32x4 __attribute__((ext_vector_type(4)));

constexpr int NB = 32, SEQ = 2048, DM = 1024, NTOK = NB * SEQ;
constexpr int INCOLS = 5632;
constexpr int NTHR = 512;
constexpr int LDS_BYTES = 147456;
constexpr float ALPHA = 1.189207115002721f;
constexpr float LN_EPS = 1e-5f, RMS_EPS = 1e-6f;
constexpr float LOG2E = 1.4426950408889634f;

constexpr size_t SZ_T512 = (size_t)NTOK * 512 * 2, SZ_T1024 = (size_t)NTOK * 1024 * 2;
constexpr size_t OFF_ADA = 0;
constexpr size_t OFF_LB = OFF_ADA + 786432;
constexpr size_t OFF_KMEAN = OFF_LB + 4096;
constexpr size_t OFF_WIN = OFF_KMEAN + 524288;
constexpr size_t OFF_WBA = OFF_WIN + (size_t)5632 * 1024 * 2;
constexpr size_t OFF_WBB = OFF_WBA + 1048576;
constexpr size_t OFF_WOUT = OFF_WBB + 1048576;
constexpr size_t OFF_WQ = OFF_WOUT + 2097152;
constexpr size_t OFF_SK = OFF_WQ + 2097152;
constexpr size_t OFF_U8 = OFF_SK + 262144;
constexpr size_t OFF_V8 = OFF_U8 + 16777216;
constexpr size_t OFF_CTR = OFF_V8 + 16777216;
constexpr size_t OFF_EG = OFF_CTR + 4096;
constexpr size_t OFF_H = OFF_EG + (size_t)NTOK * 128 * 8;
constexpr size_t OFF_QA = OFF_H + SZ_T1024;
constexpr size_t OFF_KA = OFF_QA + SZ_T512;
constexpr size_t OFF_VA = OFF_KA + SZ_T512;
constexpr size_t OFF_HQ = OFF_VA + SZ_T512;
constexpr size_t OFF_HK = OFF_HQ + SZ_T512;
constexpr size_t OFF_HI = OFF_HK + SZ_T512;
constexpr size_t OFF_HG = OFF_HI + SZ_T512;
constexpr size_t OFF_GA = OFF_HG + SZ_T512;
constexpr size_t OFF_GB = OFF_GA + SZ_T1024;
constexpr size_t WS_END = OFF_GB + SZ_T1024;
constexpr size_t OFF_W = OFF_QA;
constexpr size_t OFF_Y = OFF_KA;

struct Params {
    const float *x, *c, *w_ada, *b_ada, *w_in, *w_ba, *w_bb, *w_out, *hgrn_lb, *hgrn_ng, *ln1_g, *ln1_b, *peer_wq, *peer_sk, *peer_u, *peer_v, *ln2_g, *ln2_b;
    float* out;
    unsigned char* ws;
};

__device__ __forceinline__ unsigned cvt_pk_bf16(float lo, float hi) { unsigned r; asm("v_cvt_pk_bf16_f32 %0, %1, %2" : "=v"(r) : "v"(lo), "v"(hi)); return r; }
__device__ __forceinline__ float bf_lo(unsigned w) { return __uint_as_float(w << 16); }
__device__ __forceinline__ float bf_hi(unsigned w) { return __uint_as_float(w & 0xffff0000u); }
__device__ __forceinline__ float sigmoidf_(float x) { return 1.0f / (1.0f + __expf(-x)); }
__device__ __forceinline__ float wave_sum(float v) {
#pragma unroll
    for (int o = 1; o < 64; o <<= 1) v += __shfl_xor(v, o);
    return v;
}
__device__ __forceinline__ int tid_opaque() { int t = threadIdx.x; asm volatile("" : "+v"(t)); return t; }
__device__ __forceinline__ int crow(int r, int hi) { return (r & 3) + 8 * (r >> 2) + 4 * hi; }
#define MFMA32(a, b, c) __builtin_amdgcn_mfma_f32_32x32x16_bf16(a, b, c, 0, 0, 0)

namespace pg8 {
constexpr int BM = 256, BK = 64, HALF = 128, HTB = HALF * BK * 2, STAGE_BYTES = 8 * HTB, NXCD = 8, WGM = 8;
__host__ __device__ __forceinline__ int lds_byte(int r, int c) { const int st = (r >> 4) * 2 + (c >> 5), rr = r & 15, cc = c & 31, ob = rr * 64 + cc * 2; return st * 1024 + (ob ^ (((ob >> 9) & 1) << 5)); }
__host__ __device__ __forceinline__ void stage_rc(int b, int& R, int& C) { const int st = b / 1024, sb = b % 1024, swz = sb ^ (((sb >> 9) & 1) << 5); R = (st >> 1) * 16 + swz / 64; C = (st & 1) * 32 + (swz % 64) / 2; }
__host__ __device__ __forceinline__ int perm32(int rho) { const int n = rho >> 4, i = rho & 15; return 8 * (i >> 2) + 4 * n + (i & 3); }

struct Unit { int pm, pn; };
struct Gemm { const bf16_t* A; const bf16_t* Bt; int M, N, K; };

struct StaticOrder {
    int nM, nN, nwg, G, c;
    __device__ void init(int M, int N, int G_, int c_) { nM = M / BM; nN = N / BM; nwg = nM * nN; G = G_; c = c_; }
    __device__ bool next(int i, Unit& u) const {
        const long L = (long)i * G + c; if (L >= nwg) return false;
        int wgid = (int)L; { const int q = nwg / NXCD, r = nwg % NXCD, xcd = wgid % NXCD, off = wgid / NXCD; wgid = (xcd < r ? xcd * (q + 1) : r * (q + 1) + (xcd - r) * q) + off; }
        const int nig = WGM * nN, gid = wgid / nig, fm = gid * WGM, gsz = (nM - fm) < WGM ? (nM - fm) : WGM;
        u.pm = fm + ((wgid % nig) % gsz); u.pn = (wgid % nig) / gsz; return true;
    }
};
struct PanelOrder {
    int pm, npn;
    __device__ bool next(int i, Unit& u) const { if (i >= npn) return false; u.pm = pm; u.pn = i; return true; }
};

template <class Epi, class Sched>
__device__ __forceinline__ void gemm_phase(LAS unsigned char* lds, const Gemm g, const Sched& S, const Epi& E) {
    const int tid = tid_opaque(), wid = __builtin_amdgcn_readfirstlane(tid >> 6), lane = tid & 63, wr = wid >> 2, wc = wid & 3, fr = lane & 15, fq = lane >> 4;
    const int K = g.K, nt = K / BK;
    unsigned voffA[2], voffB[2];
#pragma unroll
    for (int i = 0; i < 2; ++i) { int R, C; stage_rc(tid * 16 + i * 8192, R, C); const int Rb = Epi::PERM ? ((R & ~31) + perm32(R & 31)) : R;
        voffA[i] = (unsigned)(R * K + C) * 2u; voffB[i] = (unsigned)(Rb * K + C) * 2u; }
    const size_t kstep = (size_t)(BK * 2);
    const size_t hstep = (size_t)HALF * K * 2;
    const size_t tstep = 2 * hstep;
    const unsigned ldsw = (unsigned)wid * 1024u;
    const int aoff = lds_byte(wr * 64 + fr, fq * 8), boff = lds_byte(wc * 32 + fr, fq * 8);
#define PG8_SA(b, h) (((b) * 2 + (h)) * HTB)
#define PG8_SB(b, h) ((4 + (b) * 2 + (h)) * HTB)
#define PG8_STAGE(bufoff, gbase, voff) do { _Pragma("unroll") for (int _i = 0; _i < 2; ++_i) \
        __builtin_amdgcn_global_load_lds((const unsigned*)((const char*)(gbase) + (voff)[_i]), (LAS unsigned*)(lds + (bufoff) + ldsw + _i * 8192), 16, 0, 0); } while (0)
#define PG8_LDA(dst, b, h) do { _Pragma("unroll") for (int m = 0; m < 4; ++m) _Pragma("unroll") for (int k = 0; k < 2; ++k) dst[m][k] = *(const LAS bf16x8*)(lds + PG8_SA(b, h) + aoff + m * 2048 + k * 1024); } while (0)
#define PG8_LDB(dst, b, h) do { _Pragma("unroll") for (int n = 0; n < 2; ++n) _Pragma("unroll") for (int k = 0; k < 2; ++k) dst[n][k] = *(const LAS bf16x8*)(lds + PG8_SB(b, h) + boff + n * 2048 + k * 1024); } while (0)
#define PG8_MMA(ai, bj, At, Bt) do { __builtin_amdgcn_s_setprio(1); _Pragma("unroll") for (int m = 0; m < 4; ++m) _Pragma("unroll") for (int n = 0; n < 2; ++n) _Pragma("unroll") for (int k = 0; k < 2; ++k) \
        acc[ai][bj][m][n] = __builtin_amdgcn_mfma_f32_16x16x32_bf16(Bt[n][k], At[m][k], acc[ai][bj][m][n], 0, 0, 0); __builtin_amdgcn_s_setprio(0); } while (0)
#define PG8_WAIT_V(n) asm volatile("s_waitcnt vmcnt(" #n ")" ::: "memory")
#define PG8_WAIT_L(n) asm volatile("s_waitcnt lgkmcnt(" #n ")" ::: "memory")
#define PG8_BAR __builtin_amdgcn_s_barrier()
#define PG8_SCHED __builtin_amdgcn_sched_barrier(0)
    Unit cur, nxt; int ui = 0;
    if (!S.next(0, cur)) return;
    f32x4 acc[2][2][4][2];
#pragma unroll
    for (int a = 0; a < 2; ++a)
#pragma unroll
        for (int b = 0; b < 2; ++b)
#pragma unroll
            for (int m = 0; m < 4; ++m)
#pragma unroll
                for (int n = 0; n < 2; ++n) acc[a][b][m][n] = (f32x4){0.f, 0.f, 0.f, 0.f};
    bf16x8 At[4][2], B0[2][2], B1[2][2];
    const char* cA = (const char*)g.A + (size_t)cur.pm * tstep; const char* cB = (const char*)g.Bt + (size_t)cur.pn * tstep;
    PG8_STAGE(PG8_SB(0, 0), cB, voffB); PG8_STAGE(PG8_SA(0, 0), cA, voffA); PG8_STAGE(PG8_SB(0, 1), cB + hstep, voffB); PG8_STAGE(PG8_SA(0, 1), cA + hstep, voffA);
    if (wr == 1) PG8_BAR;
    PG8_WAIT_V(4); PG8_BAR;
    PG8_STAGE(PG8_SB(1, 0), cB + kstep, voffB); PG8_STAGE(PG8_SA(1, 0), cA + kstep, voffA); PG8_STAGE(PG8_SB(1, 1), cB + hstep + kstep, voffB);
    PG8_WAIT_V(6); PG8_BAR;
    for (;;) {
        const bool has_next = S.next(ui + 1, nxt);
        const char* nA = has_next ? (const char*)g.A + (size_t)nxt.pm * tstep : cA; const char* nB = has_next ? (const char*)g.Bt + (size_t)nxt.pn * tstep : cB;
        for (int t = 0; t < nt; t += 2) {
            const bool last = (t == nt - 2);
            const char* a1 = cA + (size_t)(t + 1) * kstep;
            const char* a2 = last ? nA : cA + (size_t)(t + 2) * kstep; const char* b2 = last ? nB : cB + (size_t)(t + 2) * kstep;
            const char* a3 = a2 + kstep; const char* b3 = b2 + kstep;
            PG8_LDB(B0, 0, 0); PG8_SCHED; PG8_LDA(At, 0, 0); PG8_STAGE(PG8_SA(1, 1), a1 + hstep, voffA);
            PG8_WAIT_L(8); PG8_BAR; PG8_WAIT_L(0); PG8_MMA(0, 0, At, B0); PG8_BAR; PG8_SCHED;
            PG8_LDB(B1, 0, 1); PG8_STAGE(PG8_SB(0, 0), b2, voffB);
            PG8_BAR; PG8_WAIT_L(0); PG8_MMA(0, 1, At, B1); PG8_BAR;
            PG8_LDA(At, 0, 1); PG8_STAGE(PG8_SA(0, 0), a2, voffA);
            PG8_BAR; PG8_WAIT_L(0); PG8_MMA(1, 0, At, B0); PG8_BAR; PG8_SCHED;
            PG8_STAGE(PG8_SB(0, 1), b2 + hstep, voffB);
            PG8_WAIT_V(6); PG8_BAR; PG8_MMA(1, 1, At, B1); PG8_BAR;
            PG8_LDB(B0, 1, 0); PG8_SCHED; PG8_LDA(At, 1, 0); PG8_STAGE(PG8_SA(0, 1), a2 + hstep, voffA);
            PG8_WAIT_L(8); PG8_BAR; PG8_WAIT_L(0); PG8_MMA(0, 0, At, B0); PG8_BAR; PG8_SCHED;
            PG8_LDB(B1, 1, 1); PG8_STAGE(PG8_SB(1, 0), b3, voffB);
            PG8_BAR; PG8_WAIT_L(0); PG8_MMA(0, 1, At, B1); PG8_BAR;
            PG8_LDA(At, 1, 1); PG8_STAGE(PG8_SA(1, 0), a3, voffA);
            PG8_BAR; PG8_WAIT_L(0); PG8_MMA(1, 0, At, B0); PG8_BAR; PG8_SCHED;
            PG8_STAGE(PG8_SB(1, 1), b3 + hstep, voffB);
            PG8_WAIT_V(6); PG8_BAR; PG8_MMA(1, 1, At, B1); PG8_BAR;
        }
        E(acc, cur, wr, wc, fr, fq);
        if (!has_next) break;
#pragma unroll
        for (int a = 0; a < 2; ++a)
#pragma unroll
            for (int b = 0; b < 2; ++b)
#pragma unroll
                for (int m = 0; m < 4; ++m)
#pragma unroll
                    for (int n = 0; n < 2; ++n) acc[a][b][m][n] = (f32x4){0.f, 0.f, 0.f, 0.f};
        cur = nxt; cA = nA; cB = nB; ++ui;
    }
    PG8_WAIT_V(0);
    if (wr == 0) PG8_BAR;
    PG8_BAR;
#undef PG8_SA
#undef PG8_SB
#undef PG8_STAGE
#undef PG8_LDA
#undef PG8_LDB
#undef PG8_MMA
#undef PG8_WAIT_V
#undef PG8_WAIT_L
#undef PG8_BAR
#undef PG8_SCHED
}
}
using pg8::Unit;

struct EpiProj {
    static constexpr bool PERM = true;
    unsigned char* ws; const float* lb; const float* ng; float* kmean;
    __device__ __forceinline__ void operator()(const f32x4 (&acc)[2][2][4][2], const Unit& u, int wr, int wc, int fr, int fq) const {
        const int pn = u.pn; int seg, colt, ldc; size_t boff;
        if (pn < 14) { seg = pn >> 1; colt = (pn & 1) * 256; ldc = 512; boff = OFF_QA + (size_t)seg * SZ_T512; }
        else if (pn < 18) { seg = 7; colt = (pn - 14) * 256; ldc = 1024; boff = OFF_GA; }
        else { seg = 8; colt = (pn - 18) * 256; ldc = 1024; boff = OFF_GB; }
        bf16_t* base = (bf16_t*)(ws + boff);
        const int row0 = u.pm * 256 + wr * 64 + fr, col0 = colt + wc * 32 + 8 * fq;
        float pv[2][8];
#pragma unroll
        for (int bj = 0; bj < 2; ++bj)
#pragma unroll
            for (int e = 0; e < 8; ++e) pv[bj][e] = (seg == 4) ? (1.0f - lb[col0 + bj * 128 + e]) : ((seg == 6) ? ng[col0 + bj * 128 + e] : 0.f);
        float cs[2][8];
#pragma unroll
        for (int bj = 0; bj < 2; ++bj)
#pragma unroll
            for (int e = 0; e < 8; ++e) cs[bj][e] = 0.f;
#pragma unroll
        for (int ai = 0; ai < 2; ++ai)
#pragma unroll
            for (int m = 0; m < 4; ++m) {
                bf16_t* rowp = base + (size_t)(row0 + ai * 128 + m * 16) * ldc + col0;
#pragma unroll
                for (int bj = 0; bj < 2; ++bj) {
                    float v[8];
#pragma unroll
                    for (int e = 0; e < 4; ++e) { v[e] = acc[ai][bj][m][0][e]; v[4 + e] = acc[ai][bj][m][1][e]; }
                    if (seg == 0) {
#pragma unroll
                        for (int e = 0; e < 8; ++e) v[e] *= (0.125f * LOG2E);
                    } else if (seg == 1) {
#pragma unroll
                        for (int e = 0; e < 8; ++e) cs[bj][e] += v[e];
                    } else if (seg == 3) {
#pragma unroll
                        for (int e = 0; e < 8; ++e) v[e] = v[e] * sigmoidf_(v[e]);
                    } else if (seg == 4) {
#pragma unroll
                        for (int e = 0; e < 8; ++e) v[e] = pv[bj][e] * sigmoidf_(-v[e]);
                    } else if (seg == 6) {
#pragma unroll
                        for (int e = 0; e < 8; ++e) v[e] = pv[bj][e] * v[e] * sigmoidf_(v[e]);
                    } else if (seg >= 7) {
#pragma unroll
                        for (int e = 0; e < 8; ++e) v[e] = sigmoidf_(v[e]);
                    }
                    u32x4 w; w.x = cvt_pk_bf16(v[0], v[1]); w.y = cvt_pk_bf16(v[2], v[3]); w.z = cvt_pk_bf16(v[4], v[5]); w.w = cvt_pk_bf16(v[6], v[7]);
                    *(u32x4*)(rowp + bj * 128) = w;
                }
            }
        if (seg == 1) {
#pragma unroll
            for (int bj = 0; bj < 2; ++bj)
#pragma unroll
                for (int e = 0; e < 8; ++e) {
                    float s = cs[bj][e];
                    s += __shfl_xor(s, 1); s += __shfl_xor(s, 2); s += __shfl_xor(s, 4); s += __shfl_xor(s, 8);
                    if (fr == 0) atomicAdd(kmean + (size_t)u.pm * 512 + col0 + bj * 128 + e, s);
                }
        }
    }
};
struct EpiMixA {
    static constexpr bool PERM = true;
    bf16_t* GA;
    __device__ __forceinline__ void operator()(const f32x4 (&acc)[2][2][4][2], const Unit& u, int wr, int wc, int fr, int fq) const {
        const int row0 = u.pm * 256 + wr * 64 + fr, col0 = u.pn * 256 + wc * 32 + 8 * fq;
#pragma unroll
        for (int ai = 0; ai < 2; ++ai)
#pragma unroll
            for (int m = 0; m < 4; ++m) {
                bf16_t* rowp = GA + (size_t)(row0 + ai * 128 + m * 16) * 1024 + col0;
#pragma unroll
                for (int bj = 0; bj < 2; ++bj) {
                    const u32x4 g = *(const u32x4*)(rowp + bj * 128);
                    const f32x4 a0 = acc[ai][bj][m][0], a1 = acc[ai][bj][m][1];
                    u32x4 w;
                    w.x = cvt_pk_bf16(bf_lo(g.x) * a0[0], bf_hi(g.x) * a0[1]); w.y = cvt_pk_bf16(bf_lo(g.y) * a0[2], bf_hi(g.y) * a0[3]);
                    w.z = cvt_pk_bf16(bf_lo(g.z) * a1[0], bf_hi(g.z) * a1[1]); w.w = cvt_pk_bf16(bf_lo(g.w) * a1[2], bf_hi(g.w) * a1[3]);
                    *(u32x4*)(rowp + bj * 128) = w;
                }
            }
    }
};
struct EpiMixB {
    static constexpr bool PERM = true;
    bf16_t* GA; const bf16_t* GB;
    __device__ __forceinline__ void operator()(const f32x4 (&acc)[2][2][4][2], const Unit& u, int wr, int wc, int fr, int fq) const {
        const int row0 = u.pm * 256 + wr * 64 + fr, col0 = u.pn * 256 + wc * 32 + 8 * fq;
#pragma unroll
        for (int ai = 0; ai < 2; ++ai)
#pragma unroll
            for (int m = 0; m < 4; ++m) {
                const size_t off = (size_t)(row0 + ai * 128 + m * 16) * 1024 + col0;
#pragma unroll
                for (int bj = 0; bj < 2; ++bj) {
                    const u32x4 g = *(const u32x4*)(GB + off + bj * 128);
                    const u32x4 mx = *(const u32x4*)(GA + off + bj * 128);
                    const f32x4 a0 = acc[ai][bj][m][0], a1 = acc[ai][bj][m][1];
                    u32x4 w;
                    w.x = cvt_pk_bf16(bf_lo(mx.x) + bf_lo(g.x) * a0[0], bf_hi(mx.x) + bf_hi(g.x) * a0[1]); w.y = cvt_pk_bf16(bf_lo(mx.y) + bf_lo(g.y) * a0[2], bf_hi(mx.y) + bf_hi(g.y) * a0[3]);
                    w.z = cvt_pk_bf16(bf_lo(mx.z) + bf_lo(g.z) * a1[0], bf_hi(mx.z) + bf_hi(g.z) * a1[1]); w.w = cvt_pk_bf16(bf_lo(mx.w) + bf_lo(g.w) * a1[2], bf_hi(mx.w) + bf_hi(g.w) * a1[3]);
                    *(u32x4*)(GA + off + bj * 128) = w;
                }
            }
    }
};
struct EpiOut {
    static constexpr bool PERM = false;
    const float* x; const float* ada; float* out;
    __device__ __forceinline__ void operator()(const f32x4 (&acc)[2][2][4][2], const Unit& u, int wr, int wc, int fr, int fq) const {
        const int row0 = u.pm * 256 + wr * 64 + fr, col0 = u.pn * 256 + wc * 32 + 4 * fq;
        const float* gt1 = ada + (size_t)(u.pm >> 3) * 6144 + 2048;
#pragma unroll
        for (int ai = 0; ai < 2; ++ai)
#pragma unroll
            for (int m = 0; m < 4; ++m) {
                const size_t off = (size_t)(row0 + ai * 128 + m * 16) * 1024 + col0;
#pragma unroll
                for (int bj = 0; bj < 2; ++bj)
#pragma unroll
                    for (int n = 0; n < 2; ++n) {
                        const int cc = bj * 128 + n * 16;
                        const f32x4 xv = *(const f32x4*)(x + off + cc), gv = *(const f32x4*)(gt1 + col0 + cc);
                        *(f32x4*)(out + off + cc) = xv * ALPHA + gv * acc[ai][bj][m][n];
                    }
            }
    }
};
struct EpiBf16 {
    static constexpr bool PERM = true;
    bf16_t* O;
    __device__ __forceinline__ void operator()(const f32x4 (&acc)[2][2][4][2], const Unit& u, int wr, int wc, int fr, int fq) const {
        const int row0 = u.pm * 256 + wr * 64 + fr, col0 = u.pn * 256 + wc * 32 + 8 * fq;
#pragma unroll
        for (int ai = 0; ai < 2; ++ai)
#pragma unroll
            for (int m = 0; m < 4; ++m) {
                bf16_t* rowp = O + (size_t)(row0 + ai * 128 + m * 16) * 1024 + col0;
#pragma unroll
                for (int bj = 0; bj < 2; ++bj) {
                    const f32x4 a0 = acc[ai][bj][m][0], a1 = acc[ai][bj][m][1];
                    u32x4 w; w.x = cvt_pk_bf16(a0[0], a0[1]); w.y = cvt_pk_bf16(a0[2], a0[3]); w.z = cvt_pk_bf16(a1[0], a1[1]); w.w = cvt_pk_bf16(a1[2], a1[3]);
                    *(u32x4*)(rowp + bj * 128) = w;
                }
            }
    }
};

__device__ void phase0a(const Params& P, LAS unsigned char* lds) {
    const int tid = tid_opaque(), G = gridDim.x, bid = blockIdx.x;
    for (int it = bid; it < 192; it += G) {
        LAS float* sc = (LAS float*)lds;
        for (int i = tid; i < 32 * 1024; i += NTHR) { const float cv = P.c[i]; sc[i] = cv * sigmoidf_(cv); }
        __syncthreads();
        const int kg = tid >> 5, col = tid & 31;
        float a[32];
#pragma unroll
        for (int b = 0; b < 32; ++b) a[b] = 0.f;
        for (int k = kg * 64; k < kg * 64 + 64; k += 4) {
            float w[4];
#pragma unroll
            for (int e = 0; e < 4; ++e) w[e] = P.w_ada[(size_t)(k + e) * 6144 + it * 32 + col];
#pragma unroll
            for (int b = 0; b < 32; ++b) { const f32x4 s = *(const LAS f32x4*)(sc + b * 1024 + k); a[b] += s[0] * w[0] + s[1] * w[1] + s[2] * w[2] + s[3] * w[3]; }
        }
        __syncthreads();
        LAS float* red = (LAS float*)lds;
#pragma unroll
        for (int b = 0; b < 32; ++b) red[(kg * 32 + b) * 32 + col] = a[b];
        __syncthreads();
        for (int o = tid; o < 1024; o += NTHR) { const int b = o >> 5, cc = o & 31; float s = 0.f;
#pragma unroll
            for (int g2 = 0; g2 < 16; ++g2) s += red[(g2 * 32 + b) * 32 + cc];
            ((float*)(P.ws + OFF_ADA))[(size_t)b * 6144 + it * 32 + cc] = s + P.b_ada[it * 32 + cc]; }
        __syncthreads();
    }
    const size_t gtid = (size_t)bid * NTHR + tid, gsz = (size_t)G * NTHR;
    for (size_t i = gtid; i < 512; i += gsz) ((float*)(P.ws + OFF_LB))[i] = sigmoidf_(P.hgrn_lb[i] - P.hgrn_lb[512 + i]);
    for (size_t i = gtid; i < 32 * 8 * 512; i += gsz) ((float*)(P.ws + OFF_KMEAN))[i] = 0.f;
    {
        LAS float* tile = (LAS float*)lds;
        const int I0 = 16 * 88, I1 = I0 + 8 * 16, I2 = I1 + 8 * 16, I3 = I2 + 16 * 16, I4 = I3 + 16 * 16;
        for (int it = bid; it < I4; it += G) {
            const float* W; bf16_t* WT; int K, N, r;
            if (it < I0) { W = P.w_in; WT = (bf16_t*)(P.ws + OFF_WIN); K = 1024; N = 5632; r = it; }
            else if (it < I1) { W = P.w_ba; WT = (bf16_t*)(P.ws + OFF_WBA); K = 512; N = 1024; r = it - I0; }
            else if (it < I2) { W = P.w_bb; WT = (bf16_t*)(P.ws + OFF_WBB); K = 512; N = 1024; r = it - I1; }
            else if (it < I3) { W = P.w_out; WT = (bf16_t*)(P.ws + OFF_WOUT); K = 1024; N = 1024; r = it - I2; }
            else { W = P.peer_wq; WT = (bf16_t*)(P.ws + OFF_WQ); K = 1024; N = 1024; r = it - I3; }
            const int nb = N / 64, k0 = (r / nb) * 64, n0 = (r % nb) * 64;
#pragma unroll
            for (int ps = 0; ps < 2; ++ps) { const int kk = (tid >> 4) + 32 * ps, n4 = (tid & 15) * 4;
                const f32x4 v = *(const f32x4*)(W + (size_t)(k0 + kk) * N + n0 + n4);
                tile[kk * 65 + n4] = v[0]; tile[kk * 65 + n4 + 1] = v[1]; tile[kk * 65 + n4 + 2] = v[2]; tile[kk * 65 + n4 + 3] = v[3]; }
            __syncthreads();
            { const int n = tid >> 3, kc = (tid & 7) * 8; u32x4 w;
              w.x = cvt_pk_bf16(tile[(kc + 0) * 65 + n], tile[(kc + 1) * 65 + n]); w.y = cvt_pk_bf16(tile[(kc + 2) * 65 + n], tile[(kc + 3) * 65 + n]);
              w.z = cvt_pk_bf16(tile[(kc + 4) * 65 + n], tile[(kc + 5) * 65 + n]); w.w = cvt_pk_bf16(tile[(kc + 6) * 65 + n], tile[(kc + 7) * 65 + n]);
              *(u32x4*)(WT + (size_t)(n0 + n) * K + k0 + kc) = w; }
            __syncthreads();
        }
    }
    {
        if (gtid < 16) ((unsigned*)(P.ws + OFF_CTR))[gtid] = 0u;
        for (size_t i = gtid; i < 16384; i += gsz) {
            const float* src = P.peer_sk + i * 8; const f32x4 a = *(const f32x4*)src, b = *(const f32x4*)(src + 4);
            u32x4 w; w.x = cvt_pk_bf16(a[0], a[1]); w.y = cvt_pk_bf16(a[2], a[3]); w.z = cvt_pk_bf16(b[0], b[1]); w.w = cvt_pk_bf16(b[2], b[3]);
            *(u32x4*)((bf16_t*)(P.ws + OFF_SK) + i * 8) = w;
        }
        const size_t NV = (size_t)16384 * 1024 / 8;
        for (size_t i = gtid; i < 2 * NV; i += gsz) {
            const bool isv = i >= NV; const size_t j = isv ? i - NV : i;
            const float* src = (isv ? P.peer_v : P.peer_u) + j * 8; const float sc = isv ? 4.0f : 32.0f;
            const f32x4 a = *(const f32x4*)src * sc, b = *(const f32x4*)(src + 4) * sc;
            int w0 = __builtin_amdgcn_cvt_pk_fp8_f32(a[0], a[1], 0, false); w0 = __builtin_amdgcn_cvt_pk_fp8_f32(a[2], a[3], w0, true);
            int w1 = __builtin_amdgcn_cvt_pk_fp8_f32(b[0], b[1], 0, false); w1 = __builtin_amdgcn_cvt_pk_fp8_f32(b[2], b[3], w1, true);
            u32x2 w; w.x = (unsigned)w0; w.y = (unsigned)w1;
            size_t dst;
            if (!isv) dst = OFF_U8 + j * 8;
            else { const size_t e = j >> 7; const int d8 = (int)(j & 127) * 8; dst = OFF_V8 + ((size_t)(d8 >> 7) * 16384 + e) * 128 + (d8 & 127); }
            *(u32x2*)(P.ws + dst) = w;
        }
    }
}
__device__ void phase0b(const Params& P) {
    const size_t gtid = (size_t)blockIdx.x * NTHR + threadIdx.x, gsz = (size_t)gridDim.x * NTHR;
    const float* ada = (const float*)(P.ws + OFF_ADA); bf16_t* H = (bf16_t*)(P.ws + OFF_H);
    for (size_t i = gtid; i < (size_t)NTOK * 128; i += gsz) {
        const size_t row = i >> 7; const int c8 = (int)(i & 127) * 8; const int b = (int)(row >> 11);
        const float* xr = P.x + row * 1024 + c8; const float* sh = ada + (size_t)b * 6144 + c8; const float* sc = sh + 1024;
        const f32x4 x0 = *(const f32x4*)xr, x1 = *(const f32x4*)(xr + 4), s0 = *(const f32x4*)sc, s1 = *(const f32x4*)(sc + 4), h0 = *(const f32x4*)sh, h1 = *(const f32x4*)(sh + 4);
        const f32x4 r0 = x0 * (s0 + 1.0f) + h0, r1 = x1 * (s1 + 1.0f) + h1;
        u32x4 w; w.x = cvt_pk_bf16(r0[0], r0[1]); w.y = cvt_pk_bf16(r0[2], r0[3]); w.z = cvt_pk_bf16(r1[0], r1[1]); w.w = cvt_pk_bf16(r1[2], r1[3]);
        *(u32x4*)(H + row * 1024 + c8) = w;
    }
}

__device__ void hgrn_item(const Params& P, int item, LAS unsigned char* lds) {
    const int tid = tid_opaque(), lane = tid & 63, wid = tid >> 6;
    const int b = item >> 3, h = (item >> 1) & 3, vh = item & 1;
    const bf16_t* HQ = (const bf16_t*)(P.ws + OFF_HQ); const bf16_t* HK = (const bf16_t*)(P.ws + OFF_HK); bf16_t* HI = (bf16_t*)(P.ws + OFF_HI);
    LAS float* qs = (LAS float*)lds;
    LAS float* ks = (LAS float*)(lds + 16384);
    LAS float* vs = (LAS float*)(lds + 32768);
    LAS float* part = (LAS float*)(lds + 40960);
    float S[16];
#pragma unroll
    for (int i = 0; i < 16; ++i) S[i] = 0.f;
    const size_t rowb = (size_t)b * SEQ;
    for (int t0 = 0; t0 < SEQ; t0 += 32) {
        { const int row = tid >> 4, c8 = (tid & 15) * 8; const size_t g = (rowb + t0 + row) * 512 + h * 128 + c8;
          const u32x4 qv = *(const u32x4*)(HQ + g), kv = *(const u32x4*)(HK + g);
          LAS float* qd = qs + row * 128 + c8; LAS float* kd = ks + row * 128 + c8;
          *(LAS f32x4*)qd = (f32x4){bf_lo(qv.x), bf_hi(qv.x), bf_lo(qv.y), bf_hi(qv.y)}; *(LAS f32x4*)(qd + 4) = (f32x4){bf_lo(qv.z), bf_hi(qv.z), bf_lo(qv.w), bf_hi(qv.w)};
          *(LAS f32x4*)kd = (f32x4){bf_lo(kv.x), bf_hi(kv.x), bf_lo(kv.y), bf_hi(kv.y)}; *(LAS f32x4*)(kd + 4) = (f32x4){bf_lo(kv.z), bf_hi(kv.z), bf_lo(kv.w), bf_hi(kv.w)};
          const int c4 = (tid & 15) * 4; const u32x2 vv = *(const u32x2*)(HI + (rowb + t0 + row) * 512 + h * 128 + vh * 64 + c4);
          *(LAS f32x4*)(vs + row * 64 + c4) = (f32x4){bf_lo(vv.x), bf_hi(vv.x), bf_lo(vv.y), bf_hi(vv.y)}; }
        __syncthreads();
        for (int t = 0; t < 32; ++t) {
            const float v = vs[t * 64 + lane]; float op = 0.f;
#pragma unroll
            for (int i4 = 0; i4 < 4; ++i4) {
                const f32x4 kq = *(const LAS f32x4*)(ks + t * 128 + wid * 16 + i4 * 4), qq = *(const LAS f32x4*)(qs + t * 128 + wid * 16 + i4 * 4);
#pragma unroll
                for (int e = 0; e < 4; ++e) { float s = S[i4 * 4 + e]; s += kq[e] * (v - s); S[i4 * 4 + e] = s; op += qq[e] * s; }
            }
            part[(t * 8 + wid) * 64 + lane] = op;
        }
        __syncthreads();
        { const int t = tid >> 4, c4 = (tid & 15) * 4; f32x4 s = (f32x4){0.f, 0.f, 0.f, 0.f};
#pragma unroll
          for (int w = 0; w < 8; ++w) s += *(const LAS f32x4*)(part + (t * 8 + w) * 64 + c4);
          u32x2 o; o.x = cvt_pk_bf16(s[0], s[1]); o.y = cvt_pk_bf16(s[2], s[3]);
          *(u32x2*)(HI + (rowb + t0 + t) * 512 + h * 128 + vh * 64 + c4) = o; }
    }
    __syncthreads();
}

__device__ void moba_unit(const Params& P, int b, int h, int j, LAS unsigned char* lds) {
    const int tid = tid_opaque(), lane = tid & 63, wid = tid >> 6, r32 = lane & 31, hi = lane >> 5;
    bf16_t* Q = (bf16_t*)(P.ws + OFF_QA); const bf16_t* Kg = (const bf16_t*)(P.ws + OFF_KA); const bf16_t* Vg = (const bf16_t*)(P.ws + OFF_VA);
    const float* kmean = (const float*)(P.ws + OFF_KMEAN);
    constexpr int KIMG = 64 * 144, VIMG = 64 * 192, LK = 0, LV = 2 * KIMG, LKM = 2 * KIMG + 2 * VIMG;
    LAS float* kmL = (LAS float*)(lds + LKM);
    const size_t rowb = (size_t)b * SEQ; const int q0 = j * 256;
    if (tid < j * 64) kmL[tid] = kmean[(size_t)(b * 8 + (tid >> 6)) * 512 + h * 64 + (tid & 63)];
    bf16_t* qrow = Q + (rowb + q0 + wid * 32 + r32) * 512 + h * 64;
    bf16x8 qf[4];
#pragma unroll
    for (int d0 = 0; d0 < 4; ++d0) qf[d0] = *(const bf16x8*)(qrow + 16 * d0 + 8 * hi);
    const int srow = tid >> 3, sch = tid & 7;
    const bf16_t* ksrc = Kg + (rowb + srow) * 512 + h * 64 + sch * 8; const bf16_t* vsrc = Vg + (rowb + srow) * 512 + h * 64 + sch * 8;
    const int ntile = 4 * (j + 1);
    u32x4 kreg, vreg;
    { const int key0 = q0; kreg = *(const u32x4*)(ksrc + (size_t)key0 * 512); vreg = *(const u32x4*)(vsrc + (size_t)key0 * 512); }
    *(LAS u32x4*)(lds + LK + srow * 144 + sch * 16) = kreg; *(LAS u32x4*)(lds + LV + srow * 192 + sch * 16) = vreg;
    __syncthreads();
    unsigned sel = 0;
    if (j <= 3) sel = (1u << j) - 1u;
    else {
        float g[7];
#pragma unroll
        for (int n = 0; n < 7; ++n) { float s = 0.f;
            if (n < j) {
#pragma unroll
                for (int d0 = 0; d0 < 4; ++d0)
#pragma unroll
                    for (int e = 0; e < 8; ++e) s += __uint_as_float(((unsigned)(unsigned short)qf[d0][e]) << 16) * kmL[n * 64 + 16 * d0 + 8 * hi + e];
            }
            s += __shfl_xor(s, 32); g[n] = s; }
#pragma unroll
        for (int it = 0; it < 3; ++it) { float best = -INFINITY; int bi = 0;
#pragma unroll
            for (int n = 0; n < 7; ++n) if (n < j && !((sel >> n) & 1u) && g[n] > best) { best = g[n]; bi = n; }
            sel |= 1u << bi; }
    }
    const float ch = exp2f(-(float)(h + 1)) * LOG2E;
    const int qb = wid * 32 + r32;
    float m_run = -1e30f, l_run = 0.f;
    f32x16 o0 = {}, o1 = {};
    const int tg = lane >> 4, tc = tg & 1, ti = lane & 15;
    const int vlane = (4 * hi + (ti >> 2)) * 192 + (16 * tc + 4 * (ti & 3)) * 2;
#pragma unroll 1
    for (int i = 0; i < ntile; ++i) {
        const int buf = i & 1;
        const bool own = i < 4; const int blk = own ? j : ((i - 4) >> 2), kt = own ? i : ((i - 4) & 3);
        if (i + 1 < ntile) { const int i1 = i + 1; const int blk1 = (i1 < 4) ? j : ((i1 - 4) >> 2), kt1 = (i1 < 4) ? i1 : ((i1 - 4) & 3); const size_t key1 = (size_t)(blk1 * 256 + kt1 * 64);
            kreg = *(const u32x4*)(ksrc + key1 * 512); vreg = *(const u32x4*)(vsrc + key1 * 512); }
        const bool lane_ok = own ? true : (((sel >> blk) & 1u) != 0u);
        const bool skip = own ? (64 * kt > 32 * wid + 31) : (__ballot(lane_ok) == 0ull);
        if (!skip) {
            LAS unsigned char* kb = lds + LK + buf * KIMG; LAS unsigned char* vb = lds + LV + buf * VIMG;
            f32x16 p0 = {}, p1 = {};
#pragma unroll
            for (int d0 = 0; d0 < 4; ++d0) {
                const bf16x8 kf0 = *(const LAS bf16x8*)(kb + r32 * 144 + (16 * d0 + 8 * hi) * 2);
                const bf16x8 kf1 = *(const LAS bf16x8*)(kb + (32 + r32) * 144 + (16 * d0 + 8 * hi) * 2);
                p0 = MFMA32(kf0, qf[d0], p0); p1 = MFMA32(kf1, qf[d0], p1);
            }
            const float kbase = ch * (float)((blk - j) * 256 + kt * 64);
            float mt = -1e30f;
#pragma unroll
            for (int r = 0; r < 16; ++r) {
                const int kl0 = crow(r, hi), kl1 = kl0 + 32;
                const float t0 = p0[r] + (kbase + ch * (float)kl0), t1 = p1[r] + (kbase + ch * (float)kl1);
                const bool v0 = own ? (kt * 64 + kl0 <= qb) : lane_ok, v1 = own ? (kt * 64 + kl1 <= qb) : lane_ok;
                p0[r] = v0 ? t0 : -1e30f; p1[r] = v1 ? t1 : -1e30f;
                mt = fmaxf(mt, fmaxf(p0[r], p1[r]));
            }
            mt = fmaxf(mt, __shfl_xor(mt, 32));
            const float mnew = fmaxf(m_run, mt), alpha = __builtin_amdgcn_exp2f(m_run - mnew);
            m_run = mnew;
            float rs = 0.f;
#pragma unroll
            for (int r = 0; r < 16; ++r) { p0[r] = __builtin_amdgcn_exp2f(p0[r] - mnew); p1[r] = __builtin_amdgcn_exp2f(p1[r] - mnew); rs += p0[r] + p1[r]; }
            l_run = l_run * alpha + rs;
#pragma unroll
            for (int r = 0; r < 16; ++r) { o0[r] *= alpha; o1[r] *= alpha; }
#pragma unroll
            for (int sub = 0; sub < 2; ++sub)
#pragma unroll
                for (int s = 0; s < 2; ++s) {
                    union { u32x4 u; bf16x8 v; } pb;
                    if (sub == 0) { pb.u.x = cvt_pk_bf16(p0[8 * s + 0], p0[8 * s + 1]); pb.u.y = cvt_pk_bf16(p0[8 * s + 2], p0[8 * s + 3]); pb.u.z = cvt_pk_bf16(p0[8 * s + 4], p0[8 * s + 5]); pb.u.w = cvt_pk_bf16(p0[8 * s + 6], p0[8 * s + 7]); }
                    else { pb.u.x = cvt_pk_bf16(p1[8 * s + 0], p1[8 * s + 1]); pb.u.y = cvt_pk_bf16(p1[8 * s + 2], p1[8 * s + 3]); pb.u.z = cvt_pk_bf16(p1[8 * s + 4], p1[8 * s + 5]); pb.u.w = cvt_pk_bf16(p1[8 * s + 6], p1[8 * s + 7]); }
#pragma unroll
                    for (int dt = 0; dt < 2; ++dt) {
                        LAS unsigned char* va = vb + (32 * sub + 16 * s) * 192 + dt * 64 + vlane;
                        const s16x4 lo = __builtin_bit_cast(s16x4, __builtin_amdgcn_ds_read_tr16_b64_v4i16((LAS s16x4*)va));
                        const s16x4 hh = __builtin_bit_cast(s16x4, __builtin_amdgcn_ds_read_tr16_b64_v4i16((LAS s16x4*)(va + 8 * 192)));
                        const bf16x8 vf = {lo[0], lo[1], lo[2], lo[3], hh[0], hh[1], hh[2], hh[3]};
                        if (dt == 0) o0 = MFMA32(vf, pb.v, o0); else o1 = MFMA32(vf, pb.v, o1);
                    }
                }
        }
        if (i + 1 < ntile) { const int nb = buf ^ 1;
            *(LAS u32x4*)(lds + LK + nb * KIMG + srow * 144 + sch * 16) = kreg; *(LAS u32x4*)(lds + LV + nb * VIMG + srow * 192 + sch * 16) = vreg; }
        __syncthreads();
    }
    l_run += __shfl_xor(l_run, 32);
    const float inv = 1.0f / l_run;
#pragma unroll
    for (int r4 = 0; r4 < 4; ++r4) {
        u32x2 w0, w1;
        w0.x = cvt_pk_bf16(o0[4 * r4] * inv, o0[4 * r4 + 1] * inv); w0.y = cvt_pk_bf16(o0[4 * r4 + 2] * inv, o0[4 * r4 + 3] * inv);
        w1.x = cvt_pk_bf16(o1[4 * r4] * inv, o1[4 * r4 + 1] * inv); w1.y = cvt_pk_bf16(o1[4 * r4 + 2] * inv, o1[4 * r4 + 3] * inv);
        *(u32x2*)(qrow + 8 * r4 + 4 * hi) = w0; *(u32x2*)(qrow + 32 + 8 * r4 + 4 * hi) = w1;
    }
}

__device__ void yb_norm_panel(const Params& P, int pm) {
    const int tid = tid_opaque(), lane = tid & 63, wid = tid >> 6;
    bf16_t* HI = (bf16_t*)(P.ws + OFF_HI); const bf16_t* HG = (const bf16_t*)(P.ws + OFF_HG);
    for (int r = 0; r < 32; ++r) {
        const size_t off = ((size_t)pm * 256 + wid * 32 + r) * 512 + lane * 8;
        const u32x4 ov = *(const u32x4*)(HI + off), gv = *(const u32x4*)(HG + off);
        float o[8] = {bf_lo(ov.x), bf_hi(ov.x), bf_lo(ov.y), bf_hi(ov.y), bf_lo(ov.z), bf_hi(ov.z), bf_lo(ov.w), bf_hi(ov.w)};
        const float g[8] = {bf_lo(gv.x), bf_hi(gv.x), bf_lo(gv.y), bf_hi(gv.y), bf_lo(gv.z), bf_hi(gv.z), bf_lo(gv.w), bf_hi(gv.w)};
        float ss = 0.f;
#pragma unroll
        for (int e = 0; e < 8; ++e) ss += o[e] * o[e];
        ss += __shfl_xor(ss, 1); ss += __shfl_xor(ss, 2); ss += __shfl_xor(ss, 4); ss += __shfl_xor(ss, 8);
        const float rs = rsqrtf(ss * (1.0f / 128.0f) + RMS_EPS);
        u32x4 w; w.x = cvt_pk_bf16(o[0] * rs * g[0], o[1] * rs * g[1]); w.y = cvt_pk_bf16(o[2] * rs * g[2], o[3] * rs * g[3]);
        w.z = cvt_pk_bf16(o[4] * rs * g[4], o[5] * rs * g[5]); w.w = cvt_pk_bf16(o[6] * rs * g[6], o[7] * rs * g[7]);
        *(u32x4*)(HI + off) = w;
    }
}
__device__ void ln1_panel(const Params& P, int pm) {
    const int tid = tid_opaque(), lane = tid & 63, wid = tid >> 6;
    const float* ada = (const float*)(P.ws + OFF_ADA) + (size_t)(pm >> 3) * 6144; bf16_t* H = (bf16_t*)(P.ws + OFF_H);
    for (int r = 0; r < 32; ++r) {
        const size_t row = (size_t)pm * 256 + wid * 32 + r;
        float* xr = P.out + row * 1024 + lane * 4;
        f32x4 v[4]; float s = 0.f;
#pragma unroll
        for (int jx = 0; jx < 4; ++jx) { v[jx] = *(const f32x4*)(xr + 256 * jx); s += (v[jx][0] + v[jx][1]) + (v[jx][2] + v[jx][3]); }
        const float mean = wave_sum(s) * (1.0f / 1024.0f); float s2 = 0.f;
#pragma unroll
        for (int jx = 0; jx < 4; ++jx) { v[jx] = v[jx] - mean; s2 += (v[jx][0] * v[jx][0] + v[jx][1] * v[jx][1]) + (v[jx][2] * v[jx][2] + v[jx][3] * v[jx][3]); }
        const float rstd = rsqrtf(wave_sum(s2) * (1.0f / 1024.0f) + LN_EPS);
#pragma unroll
        for (int jx = 0; jx < 4; ++jx) {
            const int c = lane * 4 + 256 * jx;
            const f32x4 g = *(const f32x4*)(P.ln1_g + c), bb = *(const f32x4*)(P.ln1_b + c), sh = *(const f32x4*)(ada + 3072 + c), sc = *(const f32x4*)(ada + 4096 + c);
            const f32x4 x1 = v[jx] * rstd * g + bb;
            *(f32x4*)(xr + 256 * jx) = x1;
            const f32x4 h2 = x1 * (sc + 1.0f) + sh;
            u32x2 w; w.x = cvt_pk_bf16(h2[0], h2[1]); w.y = cvt_pk_bf16(h2[2], h2[3]);
            *(u32x2*)(H + row * 1024 + c) = w;
        }
    }
}

#define INS16(L, xin) do { float x_ = (xin); _Pragma("unroll") for (int k_ = 0; k_ < 16; ++k_) { const float hi_ = fmaxf(L[k_], x_); x_ = fminf(L[k_], x_); L[k_] = hi_; } } while (0)

__device__ void peer_select_wave(const Params& P, size_t tok0) {
    const int lane = tid_opaque() & 63, r32 = lane & 31, hi = lane >> 5;
    const bf16_t* QP = (const bf16_t*)(P.ws + OFF_GB) + (tok0 + r32) * 1024; const bf16_t* SK = (const bf16_t*)(P.ws + OFF_SK);
    u32x2* EG = (u32x2*)(P.ws + OFF_EG) + (tok0 + r32) * 128;
#pragma unroll 1
    for (int h = 0; h < 8; ++h) {
        float a0[16], a1[16];
#pragma unroll
        for (int k = 0; k < 16; ++k) { a0[k] = -INFINITY; a1[k] = -INFINITY; }
#pragma unroll 1
        for (int p = 0; p < 2; ++p) {
            const int hp = h * 2 + p;
            bf16x8 qf[4];
#pragma unroll
            for (int ks = 0; ks < 4; ++ks) qf[ks] = *(const bf16x8*)(QP + hp * 64 + 16 * ks + 8 * hi);
            float L[16];
#pragma unroll
            for (int k = 0; k < 16; ++k) L[k] = -INFINITY;
#pragma unroll
            for (int kt = 0; kt < 4; ++kt) {
                f32x16 acc = {};
#pragma unroll
                for (int ks = 0; ks < 4; ++ks) { const bf16x8 kf = *(const bf16x8*)(SK + ((size_t)hp * 128 + 32 * kt + r32) * 64 + 16 * ks + 8 * hi); acc = MFMA32(kf, qf[ks], acc); }
#pragma unroll
                for (int r = 0; r < 16; ++r) { const unsigned key = (unsigned)(32 * kt + crow(r, hi)); const float xv = __uint_as_float((__float_as_uint(acc[r]) & ~127u) | key); INS16(L, xv); }
            }
            float O[16];
#pragma unroll
            for (int k = 0; k < 16; ++k) O[k] = __shfl_xor(L[k], 32);
#pragma unroll
            for (int k = 0; k < 16; ++k) INS16(L, O[k]);
#pragma unroll
            for (int k = 0; k < 16; ++k) { a0[k] = (p == 0) ? L[k] : a0[k]; a1[k] = (p == 1) ? L[k] : a1[k]; }
        }
        float best[16];
#pragma unroll
        for (int k = 0; k < 16; ++k) best[k] = -INFINITY;
#pragma unroll
        for (int i = 0; i < 16; ++i)
#pragma unroll
            for (int jx = 0; jx < 16; ++jx)
                if ((i + 1) * (jx + 1) <= 16) {
                    const float cs = a0[i] + a1[jx];
                    const float cv = __uint_as_float((__float_as_uint(cs) & ~255u) | (unsigned)(i * 16 + jx));
                    INS16(best, cv);
                }
        unsigned pk0[4], pk1[4];
#pragma unroll
        for (int q = 0; q < 4; ++q) {
            pk0[q] = (__float_as_uint(a0[4 * q]) & 127u) | ((__float_as_uint(a0[4 * q + 1]) & 127u) << 8) | ((__float_as_uint(a0[4 * q + 2]) & 127u) << 16) | ((__float_as_uint(a0[4 * q + 3]) & 127u) << 24);
            pk1[q] = (__float_as_uint(a1[4 * q]) & 127u) | ((__float_as_uint(a1[4 * q + 1]) & 127u) << 8) | ((__float_as_uint(a1[4 * q + 2]) & 127u) << 16) | ((__float_as_uint(a1[4 * q + 3]) & 127u) << 24);
        }
        unsigned pay[16];
#pragma unroll
        for (int k = 0; k < 16; ++k) {
            const unsigned code = __float_as_uint(best[k]) & 255u, ci = code >> 4, cj = code & 15u;
            const unsigned qi = ci >> 2, qj = cj >> 2;
            const unsigned w0 = (qi == 0u) ? pk0[0] : ((qi == 1u) ? pk0[1] : ((qi == 2u) ? pk0[2] : pk0[3]));
            const unsigned w1 = (qj == 0u) ? pk1[0] : ((qj == 1u) ? pk1[1] : ((qj == 2u) ? pk1[2] : pk1[3]));
            pay[k] = (((w0 >> ((ci & 3u) * 8u)) & 127u) << 7) | ((w1 >> ((cj & 3u) * 8u)) & 127u);
        }
        float e[16], es = 0.f;
#pragma unroll
        for (int k = 0; k < 16; ++k) { e[k] = __expf(best[k] - best[0]); es += e[k]; }
        const float inv = 1.0f / es;
        if (hi == 0) {
#pragma unroll
            for (int k = 0; k < 16; ++k) { u32x2 w; w.x = pay[k]; w.y = __float_as_uint(e[k] * inv); EG[h * 16 + k] = w; }
        }
    }
}
__device__ __forceinline__ unsigned xcc_id() { return (unsigned)__builtin_amdgcn_s_getreg((3 << 11) | 20) & 0xFu; }
template <int CTRL> __device__ __forceinline__ float dpp_add(float x) { const int v = __builtin_amdgcn_update_dpp(0, __float_as_int(x), CTRL, 0xf, 0xf, true); return x + __int_as_float(v); }
__device__ __forceinline__ float wave_sum_fast(float x) {
    x = dpp_add<0xB1>(x); x = dpp_add<0x4E>(x); x = dpp_add<0x141>(x); x = dpp_add<0x140>(x);
    x += __shfl_xor(x, 16); x += __shfl_xor(x, 32); return x;
}
__device__ __forceinline__ float dot16_fp8(const float (&hv)[16], const u32x4 r) {
    float s = 0.f;
    { const f32x2 a = __builtin_amdgcn_cvt_pk_f32_fp8((int)r.x, false), b = __builtin_amdgcn_cvt_pk_f32_fp8((int)r.x, true); s += hv[0] * a.x + hv[1] * a.y + hv[2] * b.x + hv[3] * b.y; }
    { const f32x2 a = __builtin_amdgcn_cvt_pk_f32_fp8((int)r.y, false), b = __builtin_amdgcn_cvt_pk_f32_fp8((int)r.y, true); s += hv[4] * a.x + hv[5] * a.y + hv[6] * b.x + hv[7] * b.y; }
    { const f32x2 a = __builtin_amdgcn_cvt_pk_f32_fp8((int)r.z, false), b = __builtin_amdgcn_cvt_pk_f32_fp8((int)r.z, true); s += hv[8] * a.x + hv[9] * a.y + hv[10] * b.x + hv[11] * b.y; }
    { const f32x2 a = __builtin_amdgcn_cvt_pk_f32_fp8((int)r.w, false), b = __builtin_amdgcn_cvt_pk_f32_fp8((int)r.w, true); s += hv[12] * a.x + hv[13] * a.y + hv[14] * b.x + hv[15] * b.y; }
    return s;
}
template <class F> __device__ __forceinline__ void partition_queue(const Params& P, LAS unsigned char* lds, int ctr_base, F f) {
    const int tid = tid_opaque();
    LAS int* slot = (LAS int*)(lds + LDS_BYTES - 64);
    unsigned* ctr = (unsigned*)(P.ws + OFF_CTR) + ctr_base;
    const int myx = (int)(xcc_id() & 7u);
    for (int pp = 0; pp < 8; ++pp) {
        const int p = (myx + pp) & 7;
        for (;;) {
            if (tid == 0) *slot = (int)atomicAdd(ctr + p, 1u);
            __syncthreads();
            const int item = *slot;
            __syncthreads();
            if (item >= NTOK / 64) break;
            f(p, item);
        }
    }
}
typedef __bf16 bf16v2 __attribute__((ext_vector_type(2)));
__device__ __forceinline__ float dot2bf(unsigned a, bf16v2 b, float c) { return __builtin_amdgcn_fdot2_f32_bf16(__builtin_bit_cast(bf16v2, a), b, c, false); }
struct UQuad { u32x4 r[4]; u32x4 ent; };
__device__ __forceinline__ void uq_issue(UQuad& q, const LAS u32x4* list, int J, int NQ, int g, const unsigned char* U8) {
    const int jj = J < NQ ? J : NQ - 1;
    q.ent = list[4 * jj + g];
    const unsigned char* rp = U8 + (size_t)q.ent.x * 1024;
#pragma unroll
    for (int c = 0; c < 4; ++c) q.r[c] = *(const u32x4*)(rp + c * 256);
}
__device__ __forceinline__ float uq_dot(const UQuad& q, const u32x4 (&hp)[8]) {
    float a = 0.f, b = 0.f;
    constexpr float SC = 1.0f / 32.0f;
#pragma unroll
    for (int c = 0; c < 4; ++c) {
        const u32x4 r = q.r[c];
        a = dot2bf(hp[2 * c].x, __builtin_amdgcn_cvt_scalef32_pk_bf16_fp8((int)r.x, SC, false), a); b = dot2bf(hp[2 * c].y, __builtin_amdgcn_cvt_scalef32_pk_bf16_fp8((int)r.x, SC, true), b);
        a = dot2bf(hp[2 * c].z, __builtin_amdgcn_cvt_scalef32_pk_bf16_fp8((int)r.y, SC, false), a); b = dot2bf(hp[2 * c].w, __builtin_amdgcn_cvt_scalef32_pk_bf16_fp8((int)r.y, SC, true), b);
        a = dot2bf(hp[2 * c + 1].x, __builtin_amdgcn_cvt_scalef32_pk_bf16_fp8((int)r.z, SC, false), a); b = dot2bf(hp[2 * c + 1].y, __builtin_amdgcn_cvt_scalef32_pk_bf16_fp8((int)r.z, SC, true), b);
        a = dot2bf(hp[2 * c + 1].z, __builtin_amdgcn_cvt_scalef32_pk_bf16_fp8((int)r.w, SC, false), a); b = dot2bf(hp[2 * c + 1].w, __builtin_amdgcn_cvt_scalef32_pk_bf16_fp8((int)r.w, SC, true), b);
    }
    float s = a + b;
    s = dpp_add<0xB1>(s); s = dpp_add<0x4E>(s); s = dpp_add<0x141>(s); s = dpp_add<0x140>(s);
    return s;
}
__device__ __forceinline__ void peer_u_chunk(const Params& P, LAS unsigned char* lds, int p, int chunk) {
    const int tid = tid_opaque(), lane = tid & 63, wid = tid >> 6, g = lane >> 4, li = lane & 15;
    const bf16_t* H = (const bf16_t*)(P.ws + OFF_H); const unsigned char* U8 = P.ws + OFF_U8 + li * 16;
    const u32x4* EG4 = (const u32x4*)(P.ws + OFF_EG); float* W = (float*)(P.ws + OFF_W);
    LAS u32x4* list = (LAS u32x4*)(lds + wid * 16384);
    const size_t t0 = (size_t)chunk * 64 + wid * 8;
    int base = 0;
    {
        u32x4 eg[8];
#pragma unroll
        for (int i = 0; i < 8; ++i) eg[i] = __builtin_nontemporal_load(EG4 + (t0 + i) * 64 + lane);
#pragma unroll
        for (int i = 0; i < 8; ++i) {
            const bool m0 = (int)(eg[i].x >> 11) == p, m1 = (int)(eg[i].z >> 11) == p;
            const unsigned long long b0 = __ballot(m0), b1 = __ballot(m1);
            const int n0 = __builtin_popcountll(b0), n = n0 + __builtin_popcountll(b1);
            const int r0 = (int)__builtin_amdgcn_mbcnt_hi((unsigned)(b0 >> 32), __builtin_amdgcn_mbcnt_lo((unsigned)b0, 0u));
            const int r1 = n0 + (int)__builtin_amdgcn_mbcnt_hi((unsigned)(b1 >> 32), __builtin_amdgcn_mbcnt_lo((unsigned)b1, 0u));
            if (m0) list[base + r0] = (u32x4){eg[i].x, eg[i].y, (unsigned)(2 * lane) | (unsigned)(i << 8), 1u};
            if (m1) list[base + r1] = (u32x4){eg[i].z, eg[i].w, (unsigned)(2 * lane + 1) | (unsigned)(i << 8), 1u};
            const int npad = n == 0 ? 4 : ((n + 3) & ~3);
            if (lane < npad - n) list[base + n + lane] = (u32x4){(unsigned)(p << 11), 0u, (unsigned)(i << 8), 0u};
            base += npad;
        }
        const int rem = (16 - (base & 15)) & 15;
        if (lane < rem) list[base + lane] = (u32x4){(unsigned)(p << 11), 0u, (unsigned)(7 << 8), 0u};
        base += rem;
    }
    const int NQ = base >> 2;
    u32x4 hp[8], hn[8];
#pragma unroll
    for (int c = 0; c < 4; ++c) { hp[2 * c] = __builtin_nontemporal_load((const u32x4*)(H + t0 * 1024 + (li + 16 * c) * 16)); hp[2 * c + 1] = __builtin_nontemporal_load((const u32x4*)(H + t0 * 1024 + (li + 16 * c) * 16 + 8));
                                  hn[2 * c] = __builtin_nontemporal_load((const u32x4*)(H + (t0 + 1) * 1024 + (li + 16 * c) * 16)); hn[2 * c + 1] = __builtin_nontemporal_load((const u32x4*)(H + (t0 + 1) * 1024 + (li + 16 * c) * 16 + 8)); }
    int curtok = 0;
    UQuad q0, q1, q2, q3;
    uq_issue(q0, list, 0, NQ, g, U8); uq_issue(q1, list, 1, NQ, g, U8); uq_issue(q2, list, 2, NQ, g, U8); uq_issue(q3, list, 3, NQ, g, U8);
#define UQ_STEP(q, Jn) do { \
        const int tk = __builtin_amdgcn_readfirstlane((int)(q.ent.z >> 8)); \
        if (tk != curtok) { curtok = tk; _Pragma("unroll") for (int c = 0; c < 8; ++c) hp[c] = hn[c]; \
            if (tk + 1 < 8) { _Pragma("unroll") for (int c = 0; c < 4; ++c) { hn[2 * c] = __builtin_nontemporal_load((const u32x4*)(H + (t0 + tk + 1) * 1024 + (li + 16 * c) * 16)); hn[2 * c + 1] = __builtin_nontemporal_load((const u32x4*)(H + (t0 + tk + 1) * 1024 + (li + 16 * c) * 16 + 8)); } } } \
        const float s = uq_dot(q, hp); \
        if (li == 0 && q.ent.w != 0u) W[(t0 + tk) * 128 + (q.ent.z & 255u)] = __uint_as_float(q.ent.y) * 0.5f * s * (1.0f + erff(s * 0.70710678118654752f)); \
        uq_issue(q, list, (Jn), NQ, g, U8); } while (0)
#pragma unroll 1
    for (int J = 0; J < NQ; J += 4) { UQ_STEP(q0, J + 4); UQ_STEP(q1, J + 5); UQ_STEP(q2, J + 6); UQ_STEP(q3, J + 7); }
#undef UQ_STEP
}
__device__ __forceinline__ void pv_issue(u32x2 (&r)[32], const LAS u32x2* list, int g, const unsigned char* V8) {
#pragma unroll
    for (int j = 0; j < 32; ++j) r[j] = *(const u32x2*)(V8 + (size_t)list[4 * j + g].x * 128);
}
__device__ __forceinline__ void pv_reduce(const u32x2 (&r)[32], const LAS u32x2* list, int g, int li, float* yp) {
    f32x2 a0 = {0.f, 0.f}, a1 = {0.f, 0.f}, a2 = {0.f, 0.f}, a3 = {0.f, 0.f};
#pragma unroll
    for (int j = 0; j < 32; ++j) {
        const float w = __uint_as_float(list[4 * j + g].y); const f32x2 wv = {w, w};
        a0 += wv * __builtin_amdgcn_cvt_pk_f32_fp8((int)r[j].x, false); a1 += wv * __builtin_amdgcn_cvt_pk_f32_fp8((int)r[j].x, true);
        a2 += wv * __builtin_amdgcn_cvt_pk_f32_fp8((int)r[j].y, false); a3 += wv * __builtin_amdgcn_cvt_pk_f32_fp8((int)r[j].y, true);
    }
    float acc[8] = {a0.x, a0.y, a1.x, a1.y, a2.x, a2.y, a3.x, a3.y};
#pragma unroll
    for (int j = 0; j < 8; ++j) { acc[j] += __shfl_xor(acc[j], 16); acc[j] += __shfl_xor(acc[j], 32); }
    if (g == 0) { *(f32x4*)yp = (f32x4){acc[0], acc[1], acc[2], acc[3]} * 0.25f; *(f32x4*)(yp + 4) = (f32x4){acc[4], acc[5], acc[6], acc[7]} * 0.25f; }
}
__device__ __forceinline__ void peer_v_chunk(const Params& P, LAS unsigned char* lds, int x, int chunk) {
    const int tid = tid_opaque(), lane = tid & 63, wid = tid >> 6, g = lane >> 4, li = lane & 15;
    const unsigned char* V8 = P.ws + OFF_V8 + (size_t)x * 16384 * 128 + li * 8;
    const u32x4* EG4 = (const u32x4*)(P.ws + OFF_EG); const f32x2* W2 = (const f32x2*)(P.ws + OFF_W); float* Y = (float*)(P.ws + OFF_Y);
    LAS u32x2* lists = (LAS u32x2*)(lds + wid * 8192);
    const size_t t0 = (size_t)chunk * 64 + wid * 8;
#pragma unroll
    for (int i = 0; i < 8; ++i) { const u32x4 eg = EG4[(t0 + i) * 64 + lane]; const f32x2 ww = W2[(t0 + i) * 64 + lane];
        *(LAS u32x4*)(lists + i * 128 + 2 * lane) = (u32x4){eg.x, __float_as_uint(ww.x), eg.z, __float_as_uint(ww.y)}; }
    float* yp = Y + t0 * 1024 + x * 128 + li * 8;
    u32x2 ra[32], rb[32];
    pv_issue(ra, lists, g, V8);
#pragma unroll
    for (int i = 0; i < 8; i += 2) {
        pv_issue(rb, lists + (i + 1) * 128, g, V8);
        pv_reduce(ra, lists + i * 128, g, li, yp + (size_t)i * 1024);
        if (i + 2 < 8) pv_issue(ra, lists + (i + 2) * 128, g, V8);
        pv_reduce(rb, lists + (i + 1) * 128, g, li, yp + (size_t)(i + 1) * 1024);
    }
}
__device__ void ln2_phase(const Params& P) {
    const int tid = tid_opaque(), lane = tid & 63, wid = tid >> 6;
    const float* Y = (const float*)(P.ws + OFF_Y);
    for (size_t row = (size_t)blockIdx.x * 8 + wid; row < (size_t)NTOK; row += (size_t)gridDim.x * 8) {
        const float* gt2 = (const float*)(P.ws + OFF_ADA) + (row >> 11) * 6144 + 5120;
        float* xr = P.out + row * 1024 + lane * 4; const float* yr = Y + row * 1024 + lane * 4;
        f32x4 v[4]; float s = 0.f;
#pragma unroll
        for (int jx = 0; jx < 4; ++jx) { const f32x4 xv = *(const f32x4*)(xr + 256 * jx), yv = __builtin_nontemporal_load((const f32x4*)(yr + 256 * jx)), gv = *(const f32x4*)(gt2 + lane * 4 + 256 * jx);
            v[jx] = xv * ALPHA + gv * yv; s += (v[jx][0] + v[jx][1]) + (v[jx][2] + v[jx][3]); }
        const float mean = wave_sum(s) * (1.0f / 1024.0f); float s2 = 0.f;
#pragma unroll
        for (int jx = 0; jx < 4; ++jx) { v[jx] = v[jx] - mean; s2 += (v[jx][0] * v[jx][0] + v[jx][1] * v[jx][1]) + (v[jx][2] * v[jx][2] + v[jx][3] * v[jx][3]); }
        const float rstd = rsqrtf(wave_sum(s2) * (1.0f / 1024.0f) + LN_EPS);
#pragma unroll
        for (int jx = 0; jx < 4; ++jx) { const int c = lane * 4 + 256 * jx; const f32x4 g = *(const f32x4*)(P.ln2_g + c), bb = *(const f32x4*)(P.ln2_b + c);
            *(f32x4*)(xr + 256 * jx) = v[jx] * rstd * g + bb; }
    }
}

__global__ void __launch_bounds__(NTHR, 2) fwd_megakernel(Params P) {
    extern __shared__ __attribute__((aligned(16))) unsigned char shm[];
    LAS unsigned char* lds = (LAS unsigned char*)shm;
    cg::grid_group grid = cg::this_grid();
    const int G = gridDim.x, bid = blockIdx.x;

#ifndef P3
#define P3 0xff
#endif
#ifndef PH
#define PH 0xff
#endif
    if (PH & 1) phase0a(P, lds);
    grid.sync();
    if (PH & 2) phase0b(P);
    grid.sync();
    if (PH & 4) {
        pg8::Gemm g; g.A = (const bf16_t*)(P.ws + OFF_H); g.Bt = (const bf16_t*)(P.ws + OFF_WIN); g.M = NTOK; g.N = INCOLS; g.K = 1024;
        pg8::StaticOrder S; S.init(NTOK, INCOLS, G, bid);
        EpiProj E; E.ws = P.ws; E.lb = (const float*)(P.ws + OFF_LB); E.ng = P.hgrn_ng; E.kmean = (float*)(P.ws + OFF_KMEAN);
        pg8::gemm_phase<EpiProj, pg8::StaticOrder>(lds, g, S, E);
    }
    grid.sync();
    if (PH & 8) for (int it = bid; it < 256; it += G) hgrn_item(P, it, lds);
    if (PH & 16) for (int u = bid; u < 2048; u += G) { const int bh = u & 255, jj = u >> 8; moba_unit(P, bh >> 3, bh & 7, (jj + bh) & 7, lds); }
    grid.sync();
    if (PH & 32) for (int pm = bid; pm < NTOK / 256; pm += G) {
        if (P3 & 1) yb_norm_panel(P, pm);
        __syncthreads();
        if (P3 & 2) { pg8::Gemm g; g.A = (const bf16_t*)(P.ws + OFF_QA); g.Bt = (const bf16_t*)(P.ws + OFF_WBA); g.M = NTOK; g.N = 1024; g.K = 512;
          pg8::PanelOrder S; S.pm = pm; S.npn = 4; EpiMixA E; E.GA = (bf16_t*)(P.ws + OFF_GA);
          pg8::gemm_phase<EpiMixA, pg8::PanelOrder>(lds, g, S, E); }
        __syncthreads();
        if (P3 & 4) { pg8::Gemm g; g.A = (const bf16_t*)(P.ws + OFF_HI); g.Bt = (const bf16_t*)(P.ws + OFF_WBB); g.M = NTOK; g.N = 1024; g.K = 512;
          pg8::PanelOrder S; S.pm = pm; S.npn = 4; EpiMixB E; E.GA = (bf16_t*)(P.ws + OFF_GA); E.GB = (const bf16_t*)(P.ws + OFF_GB);
          pg8::gemm_phase<EpiMixB, pg8::PanelOrder>(lds, g, S, E); }
        __syncthreads();
        if (P3 & 8) { pg8::Gemm g; g.A = (const bf16_t*)(P.ws + OFF_GA); g.Bt = (const bf16_t*)(P.ws + OFF_WOUT); g.M = NTOK; g.N = 1024; g.K = 1024;
          pg8::PanelOrder S; S.pm = pm; S.npn = 4; EpiOut E; E.x = P.x; E.ada = (const float*)(P.ws + OFF_ADA); E.out = P.out;
          pg8::gemm_phase<EpiOut, pg8::PanelOrder>(lds, g, S, E); }
        __syncthreads();
        if (P3 & 16) ln1_panel(P, pm);
        __syncthreads();
        if (P3 & 32) { pg8::Gemm g; g.A = (const bf16_t*)(P.ws + OFF_H); g.Bt = (const bf16_t*)(P.ws + OFF_WQ); g.M = NTOK; g.N = 1024; g.K = 1024;
          pg8::PanelOrder S; S.pm = pm; S.npn = 4; EpiBf16 E; E.O = (bf16_t*)(P.ws + OFF_GB);
          pg8::gemm_phase<EpiBf16, pg8::PanelOrder>(lds, g, S, E); }
        __syncthreads();
        { const size_t tok0 = (size_t)pm * 256 + (tid_opaque() >> 6) * 32;
          peer_select_wave(P, tok0); }
        __syncthreads();
    }
    grid.sync();
    partition_queue(P, lds, 0, [&](int p, int chunk) { peer_u_chunk(P, lds, p, chunk); });
    grid.sync();
    partition_queue(P, lds, 8, [&](int x, int chunk) { peer_v_chunk(P, lds, x, chunk); });
    grid.sync();
    ln2_phase(P);
}

extern "C" void kernel_launch(void* const* d_in, const int* in_sizes, int n_in, void* d_out, int out_size, void* d_ws, size_t ws_size, hipStream_t stream) {
    static int grid_blocks = 0;
    if (grid_blocks == 0) {
        if (n_in != 18 || out_size != NTOK * DM || ws_size < WS_END) { fprintf(stderr, "kernel_launch: unexpected shapes (n_in %d, out %d, ws %zu, need %zu)\n", n_in, out_size, ws_size, (size_t)WS_END); grid_blocks = -1; return; }
        int dev = 0, cus = 0, per_cu = 0;
        hipGetDevice(&dev);
        hipDeviceGetAttribute(&cus, hipDeviceAttributeMultiprocessorCount, dev);
        if (hipFuncSetAttribute((const void*)fwd_megakernel, hipFuncAttributeMaxDynamicSharedMemorySize, LDS_BYTES) != hipSuccess) fprintf(stderr, "kernel_launch: hipFuncSetAttribute failed\n");
        hipOccupancyMaxActiveBlocksPerMultiprocessor(&per_cu, (const void*)fwd_megakernel, NTHR, LDS_BYTES);
        if (per_cu < 1) { fprintf(stderr, "kernel_launch: occupancy query says %d blocks per CU\n", per_cu); per_cu = 1; }
        if (per_cu > 1) per_cu = 1;
        grid_blocks = cus * per_cu;
        (void)hipGetLastError();
    }
    if (grid_blocks < 0) return;
    Params p{};
    p.x = (const float*)d_in[0]; p.c = (const float*)d_in[1]; p.w_ada = (const float*)d_in[2]; p.b_ada = (const float*)d_in[3]; p.w_in = (const float*)d_in[4];
    p.w_ba = (const float*)d_in[5]; p.w_bb = (const float*)d_in[6]; p.w_out = (const float*)d_in[7]; p.hgrn_lb = (const float*)d_in[8]; p.hgrn_ng = (const float*)d_in[9];
    p.ln1_g = (const float*)d_in[10]; p.ln1_b = (const float*)d_in[11]; p.peer_wq = (const float*)d_in[12]; p.peer_sk = (const float*)d_in[13]; p.peer_u = (const float*)d_in[14];
    p.peer_v = (const float*)d_in[15]; p.ln2_g = (const float*)d_in[16]; p.ln2_b = (const float*)d_in[17];
    p.out = (float*)d_out; p.ws = (unsigned char*)d_ws;
    void* args[] = {&p};
    hipError_t e = hipLaunchCooperativeKernel((const void*)fwd_megakernel, dim3(grid_blocks), dim3(NTHR), args, LDS_BYTES, stream);
    if (e != hipSuccess) fprintf(stderr, "cooperative launch failed: %s (grid %d)\n", hipGetErrorString(e), grid_blocks);
}
```

```cpp
#include <hip/hip_runtime.h>
#include <hip/hip_cooperative_groups.h>
#include <cstdio>
#include <cstdint>
namespace cg = cooperative_groups;

#define LAS __attribute__((address_space(3)))
typedef unsigned short bf16_t;
typedef short bf16x8 __attribute__((ext_vector_type(8)));
typedef short s16x4 __attribute__((ext_vector_type(4)));
typedef float f32x2 __attribute__((ext_vector_type(2)));
typedef float f32x4 __attribute__((ext_vector_type(4)));
typedef float f32x16 __attribute__((ext_vector_type(16)));
typedef unsigned u32x2 __attribute__((ext_vector_type(2)));
typedef unsigned u32x4 __attribute__((ext_vector_type(4)));

constexpr int NB = 32, SEQ = 2048, DM = 1024, NTOK = NB * SEQ;
constexpr int INCOLS = 5632;
constexpr int NTHR = 512;
constexpr int LDS_BYTES = 147456;
constexpr float ALPHA = 1.189207115002721f;
constexpr float LN_EPS = 1e-5f, RMS_EPS = 1e-6f;
constexpr float LOG2E = 1.4426950408889634f;

constexpr size_t SZ_T512 = (size_t)NTOK * 512 * 2, SZ_T1024 = (size_t)NTOK * 1024 * 2;
constexpr size_t OFF_ADA = 0;
constexpr size_t OFF_LB = OFF_ADA + 786432;
constexpr size_t OFF_KMEAN = OFF_LB + 4096;
constexpr size_t OFF_WIN = OFF_KMEAN + 524288;
constexpr size_t OFF_WBA = OFF_WIN + (size_t)5632 * 1024 * 2;
constexpr size_t OFF_WBB = OFF_WBA + 1048576;
constexpr size_t OFF_WOUT = OFF_WBB + 1048576;
constexpr size_t OFF_WQ = OFF_WOUT + 2097152;
constexpr size_t OFF_SK = OFF_WQ + 2097152;
constexpr size_t OFF_U8 = OFF_SK + 262144;
constexpr size_t OFF_V8 = OFF_U8 + 16777216;
constexpr size_t OFF_CTR = OFF_V8 + 16777216;
constexpr size_t OFF_BAR = OFF_CTR + 4096;
constexpr size_t OFF_EG = OFF_BAR + 16384;
constexpr size_t OFF_H = OFF_EG + (size_t)NTOK * 128 * 8;
constexpr size_t OFF_QA = OFF_H + SZ_T1024;
constexpr size_t OFF_KA = OFF_QA + SZ_T512;
constexpr size_t OFF_VA = OFF_KA + SZ_T512;
constexpr size_t OFF_HQ = OFF_VA + SZ_T512;
constexpr size_t OFF_HK = OFF_HQ + SZ_T512;
constexpr size_t OFF_HI = OFF_HK + SZ_T512;
constexpr size_t OFF_HG = OFF_HI + SZ_T512;
constexpr size_t OFF_GA = OFF_HG + SZ_T512;
constexpr size_t OFF_GB = OFF_GA + SZ_T1024;
constexpr size_t WS_END = OFF_GB + SZ_T1024;
constexpr size_t OFF_W = OFF_QA;
constexpr size_t OFF_Y = OFF_KA;

struct Params {
    const float *x, *c, *w_ada, *b_ada, *w_in, *w_ba, *w_bb, *w_out, *hgrn_lb, *hgrn_ng, *ln1_g, *ln1_b, *peer_wq, *peer_sk, *peer_u, *peer_v, *ln2_g, *ln2_b;
    float* out;
    unsigned char* ws;
};

__device__ __forceinline__ unsigned cvt_pk_bf16(float lo, float hi) { unsigned r; asm("v_cvt_pk_bf16_f32 %0, %1, %2" : "=v"(r) : "v"(lo), "v"(hi)); return r; }
__device__ __forceinline__ float bf_lo(unsigned w) { return __uint_as_float(w << 16); }
__device__ __forceinline__ float bf_hi(unsigned w) { return __uint_as_float(w & 0xffff0000u); }
__device__ __forceinline__ float sigmoidf_(float x) { return 1.0f / (1.0f + __expf(-x)); }
__device__ __forceinline__ float wave_sum(float v) {
#pragma unroll
    for (int o = 1; o < 64; o <<= 1) v += __shfl_xor(v, o);
    return v;
}
__device__ __forceinline__ int tid_opaque() { int t = threadIdx.x; asm volatile("" : "+v"(t)); return t; }
__device__ __forceinline__ int crow(int r, int hi) { return (r & 3) + 8 * (r >> 2) + 4 * hi; }
#define MFMA32(a, b, c) __builtin_amdgcn_mfma_f32_32x32x16_bf16(a, b, c, 0, 0, 0)

namespace pg8 {
constexpr int BM = 256, BK = 64, HALF = 128, HTB = HALF * BK * 2, STAGE_BYTES = 8 * HTB, NXCD = 8, WGM = 8;
__host__ __device__ __forceinline__ int lds_byte(int r, int c) { const int st = (r >> 4) * 2 + (c >> 5), rr = r & 15, cc = c & 31, ob = rr * 64 + cc * 2; return st * 1024 + (ob ^ (((ob >> 9) & 1) << 5)); }
__host__ __device__ __forceinline__ void stage_rc(int b, int& R, int& C) { const int st = b / 1024, sb = b % 1024, swz = sb ^ (((sb >> 9) & 1) << 5); R = (st >> 1) * 16 + swz / 64; C = (st & 1) * 32 + (swz % 64) / 2; }
__host__ __device__ __forceinline__ int perm32(int rho) { const int n = rho >> 4, i = rho & 15; return 8 * (i >> 2) + 4 * n + (i & 3); }

struct Unit { int pm, pn; };
struct Gemm { const bf16_t* A; const bf16_t* Bt; int M, N, K; };

struct StaticOrder {
    int nM, nN, nwg, G, c;
    __device__ void init(int M, int N, int G_, int c_) { nM = M / BM; nN = N / BM; nwg = nM * nN; G = G_; c = c_; }
    __device__ bool next(int i, Unit& u) const {
        const long L = (long)i * G + c; if (L >= nwg) return false;
        int wgid = (int)L; { const int q = nwg / NXCD, r = nwg % NXCD, xcd = wgid % NXCD, off = wgid / NXCD; wgid = (xcd < r ? xcd * (q + 1) : r * (q + 1) + (xcd - r) * q) + off; }
        const int nig = WGM * nN, gid = wgid / nig, fm = gid * WGM, gsz = (nM - fm) < WGM ? (nM - fm) : WGM;
        u.pm = fm + ((wgid % nig) % gsz); u.pn = (wgid % nig) / gsz; return true;
    }
};
struct PanelOrder {
    int pm, npn;
    __device__ bool next(int i, Unit& u) const { if (i >= npn) return false; u.pm = pm; u.pn = i; return true; }
};

template <class Epi, class Sched>
__device__ __forceinline__ void gemm_phase(LAS unsigned char* lds, const Gemm g, const Sched& S, const Epi& E) {
    const int tid = tid_opaque(), wid = __builtin_amdgcn_readfirstlane(tid >> 6), lane = tid & 63, wr = wid >> 2, wc = wid & 3, fr = lane & 15, fq = lane >> 4;
    const int K = g.K, nt = K / BK;
    unsigned voffA[2], voffB[2];
#pragma unroll
    for (int i = 0; i < 2; ++i) { int R, C; stage_rc(tid * 16 + i * 8192, R, C); const int Rb = Epi::PERM ? ((R & ~31) + perm32(R & 31)) : R;
        voffA[i] = (unsigned)(R * K + C) * 2u; voffB[i] = (unsigned)(Rb * K + C) * 2u; }
    const size_t kstep = (size_t)(BK * 2);
    const size_t hstep = (size_t)HALF * K * 2;
    const size_t tstep = 2 * hstep;
    const unsigned ldsw = (unsigned)wid * 1024u;
    const int aoff = lds_byte(wr * 64 + fr, fq * 8), boff = lds_byte(wc * 32 + fr, fq * 8);
#define PG8_SA(b, h) (((b) * 2 + (h)) * HTB)
#define PG8_SB(b, h) ((4 + (b) * 2 + (h)) * HTB)
#define PG8_STAGE(bufoff, gbase, voff) do { _Pragma("unroll") for (int _i = 0; _i < 2; ++_i) \
        __builtin_amdgcn_global_load_lds((const unsigned*)((const char*)(gbase) + (voff)[_i]), (LAS unsigned*)(lds + (bufoff) + ldsw + _i * 8192), 16, 0, 0); } while (0)
#define PG8_LDA(dst, b, h) do { _Pragma("unroll") for (int m = 0; m < 4; ++m) _Pragma("unroll") for (int k = 0; k < 2; ++k) dst[m][k] = *(const LAS bf16x8*)(lds + PG8_SA(b, h) + aoff + m * 2048 + k * 1024); } while (0)
#define PG8_LDB(dst, b, h) do { _Pragma("unroll") for (int n = 0; n < 2; ++n) _Pragma("unroll") for (int k = 0; k < 2; ++k) dst[n][k] = *(const LAS bf16x8*)(lds + PG8_SB(b, h) + boff + n * 2048 + k * 1024); } while (0)
#define PG8_MMA(ai, bj, At, Bt) do { __builtin_amdgcn_s_setprio(1); _Pragma("unroll") for (int m = 0; m < 4; ++m) _Pragma("unroll") for (int n = 0; n < 2; ++n) _Pragma("unroll") for (int k = 0; k < 2; ++k) \
        acc[ai][bj][m][n] = __builtin_amdgcn_mfma_f32_16x16x32_bf16(Bt[n][k], At[m][k], acc[ai][bj][m][n], 0, 0, 0); __builtin_amdgcn_s_setprio(0); } while (0)
#define PG8_WAIT_V(n) asm volatile("s_waitcnt vmcnt(" #n ")" ::: "memory")
#define PG8_WAIT_L(n) asm volatile("s_waitcnt lgkmcnt(" #n ")" ::: "memory")
#define PG8_BAR __builtin_amdgcn_s_barrier()
#define PG8_SCHED __builtin_amdgcn_sched_barrier(0)
    Unit cur, nxt; int ui = 0;
    if (!S.next(0, cur)) return;
    f32x4 acc[2][2][4][2];
#pragma unroll
    for (int a = 0; a < 2; ++a)
#pragma unroll
        for (int b = 0; b < 2; ++b)
#pragma unroll
            for (int m = 0; m < 4; ++m)
#pragma unroll
                for (int n = 0; n < 2; ++n) acc[a][b][m][n] = (f32x4){0.f, 0.f, 0.f, 0.f};
    bf16x8 At[4][2], B0[2][2], B1[2][2];
    const char* cA = (const char*)g.A + (size_t)cur.pm * tstep; const char* cB = (const char*)g.Bt + (size_t)cur.pn * tstep;
    PG8_STAGE(PG8_SB(0, 0), cB, voffB); PG8_STAGE(PG8_SA(0, 0), cA, voffA); PG8_STAGE(PG8_SB(0, 1), cB + hstep, voffB); PG8_STAGE(PG8_SA(0, 1), cA + hstep, voffA);
    if (wr == 1) PG8_BAR;
    PG8_WAIT_V(4); PG8_BAR;
    PG8_STAGE(PG8_SB(1, 0), cB + kstep, voffB); PG8_STAGE(PG8_SA(1, 0), cA + kstep, voffA); PG8_STAGE(PG8_SB(1, 1), cB + hstep + kstep, voffB);
    PG8_WAIT_V(6); PG8_BAR;
    for (;;) {
        const bool has_next = S.next(ui + 1, nxt);
        const char* nA = has_next ? (const char*)g.A + (size_t)nxt.pm * tstep : cA; const char* nB = has_next ? (const char*)g.Bt + (size_t)nxt.pn * tstep : cB;
        for (int t = 0; t < nt; t += 2) {
            const bool last = (t == nt - 2);
            const char* a1 = cA + (size_t)(t + 1) * kstep;
            const char* a2 = last ? nA : cA + (size_t)(t + 2) * kstep; const char* b2 = last ? nB : cB + (size_t)(t + 2) * kstep;
            const char* a3 = a2 + kstep; const char* b3 = b2 + kstep;
            PG8_LDB(B0, 0, 0); PG8_SCHED; PG8_LDA(At, 0, 0); PG8_STAGE(PG8_SA(1, 1), a1 + hstep, voffA);
            PG8_WAIT_L(8); PG8_BAR; PG8_WAIT_L(0); PG8_MMA(0, 0, At, B0); PG8_BAR; PG8_SCHED;
            PG8_LDB(B1, 0, 1); PG8_STAGE(PG8_SB(0, 0), b2, voffB);
            PG8_BAR; PG8_WAIT_L(0); PG8_MMA(0, 1, At, B1); PG8_BAR;
            PG8_LDA(At, 0, 1); PG8_STAGE(PG8_SA(0, 0), a2, voffA);
            PG8_BAR; PG8_WAIT_L(0); PG8_MMA(1, 0, At, B0); PG8_BAR; PG8_SCHED;
            PG8_STAGE(PG8_SB(0, 1), b2 + hstep, voffB);
            PG8_WAIT_V(6); PG8_BAR; PG8_MMA(1, 1, At, B1); PG8_BAR;
            PG8_LDB(B0, 1, 0); PG8_SCHED; PG8_LDA(At, 1, 0); PG8_STAGE(PG8_SA(0, 1), a2 + hstep, voffA);
            PG8_WAIT_L(8); PG8_BAR; PG8_WAIT_L(0); PG8_MMA(0, 0, At, B0); PG8_BAR; PG8_SCHED;
            PG8_LDB(B1, 1, 1); PG8_STAGE(PG8_SB(1, 0), b3, voffB);
            PG8_BAR; PG8_WAIT_L(0); PG8_MMA(0, 1, At, B1); PG8_BAR;
            PG8_LDA(At, 1, 1); PG8_STAGE(PG8_SA(1, 0), a3, voffA);
            PG8_BAR; PG8_WAIT_L(0); PG8_MMA(1, 0, At, B0); PG8_BAR; PG8_SCHED;
            PG8_STAGE(PG8_SB(1, 1), b3 + hstep, voffB);
            PG8_WAIT_V(6); PG8_BAR; PG8_MMA(1, 1, At, B1); PG8_BAR;
        }
        E(acc, cur, wr, wc, fr, fq);
        if (!has_next) break;
#pragma unroll
        for (int a = 0; a < 2; ++a)
#pragma unroll
            for (int b = 0; b < 2; ++b)
#pragma unroll
                for (int m = 0; m < 4; ++m)
#pragma unroll
                    for (int n = 0; n < 2; ++n) acc[a][b][m][n] = (f32x4){0.f, 0.f, 0.f, 0.f};
        cur = nxt; cA = nA; cB = nB; ++ui;
    }
    PG8_WAIT_V(0);
    if (wr == 0) PG8_BAR;
    PG8_BAR;
#undef PG8_SA
#undef PG8_SB
#undef PG8_STAGE
#undef PG8_LDA
#undef PG8_LDB
#undef PG8_MMA
#undef PG8_WAIT_V
#undef PG8_WAIT_L
#undef PG8_BAR
#undef PG8_SCHED
}
}
using pg8::Unit;

struct EpiProj {
    static constexpr bool PERM = true;
    unsigned char* ws; const float* lb; const float* ng; float* kmean;
    __device__ __forceinline__ void operator()(const f32x4 (&acc)[2][2][4][2], const Unit& u, int wr, int wc, int fr, int fq) const {
        const int pn = u.pn; int seg, colt, ldc; size_t boff;
        if (pn < 14) { seg = pn >> 1; colt = (pn & 1) * 256; ldc = 512; boff = OFF_QA + (size_t)seg * SZ_T512; }
        else if (pn < 18) { seg = 7; colt = (pn - 14) * 256; ldc = 1024; boff = OFF_GA; }
        else { seg = 8; colt = (pn - 18) * 256; ldc = 1024; boff = OFF_GB; }
        bf16_t* base = (bf16_t*)(ws + boff);
        const int row0 = u.pm * 256 + wr * 64 + fr, col0 = colt + wc * 32 + 8 * fq;
        float pv[2][8];
#pragma unroll
        for (int bj = 0; bj < 2; ++bj)
#pragma unroll
            for (int e = 0; e < 8; ++e) pv[bj][e] = (seg == 4) ? (1.0f - lb[col0 + bj * 128 + e]) : ((seg == 6) ? ng[col0 + bj * 128 + e] : 0.f);
        float cs[2][8];
#pragma unroll
        for (int bj = 0; bj < 2; ++bj)
#pragma unroll
            for (int e = 0; e < 8; ++e) cs[bj][e] = 0.f;
#pragma unroll
        for (int ai = 0; ai < 2; ++ai)
#pragma unroll
            for (int m = 0; m < 4; ++m) {
                bf16_t* rowp = base + (size_t)(row0 + ai * 128 + m * 16) * ldc + col0;
#pragma unroll
                for (int bj = 0; bj < 2; ++bj) {
                    float v[8];
#pragma unroll
                    for (int e = 0; e < 4; ++e) { v[e] = acc[ai][bj][m][0][e]; v[4 + e] = acc[ai][bj][m][1][e]; }
                    if (seg == 0) {
#pragma unroll
                        for (int e = 0; e < 8; ++e) v[e] *= (0.125f * LOG2E);
                    } else if (seg == 1) {
#pragma unroll
                        for (int e = 0; e < 8; ++e) cs[bj][e] += v[e];
                    } else if (seg == 3) {
#pragma unroll
                        for (int e = 0; e < 8; ++e) v[e] = v[e] * sigmoidf_(v[e]);
                    } else if (seg == 4) {
#pragma unroll
                        for (int e = 0; e < 8; ++e) v[e] = pv[bj][e] * sigmoidf_(-v[e]);
                    } else if (seg == 6) {
#pragma unroll
                        for (int e = 0; e < 8; ++e) v[e] = pv[bj][e] * v[e] * sigmoidf_(v[e]);
                    } else if (seg >= 7) {
#pragma unroll
                        for (int e = 0; e < 8; ++e) v[e] = sigmoidf_(v[e]);
                    }
                    u32x4 w; w.x = cvt_pk_bf16(v[0], v[1]); w.y = cvt_pk_bf16(v[2], v[3]); w.z = cvt_pk_bf16(v[4], v[5]); w.w = cvt_pk_bf16(v[6], v[7]);
                    *(u32x4*)(rowp + bj * 128) = w;
                }
            }
        if (seg == 1) {
#pragma unroll
            for (int bj = 0; bj < 2; ++bj)
#pragma unroll
                for (int e = 0; e < 8; ++e) {
                    float s = cs[bj][e];
                    s += __shfl_xor(s, 1); s += __shfl_xor(s, 2); s += __shfl_xor(s, 4); s += __shfl_xor(s, 8);
                    if (fr == 0) atomicAdd(kmean + (size_t)u.pm * 512 + col0 + bj * 128 + e, s);
                }
        }
    }
};
struct EpiMixA {
    static constexpr bool PERM = true;
    bf16_t* GA;
    __device__ __forceinline__ void operator()(const f32x4 (&acc)[2][2][4][2], const Unit& u, int wr, int wc, int fr, int fq) const {
        const int row0 = u.pm * 256 + wr * 64 + fr, col0 = u.pn * 256 + wc * 32 + 8 * fq;
#pragma unroll
        for (int ai = 0; ai < 2; ++ai)
#pragma unroll
            for (int m = 0; m < 4; ++m) {
                bf16_t* rowp = GA + (size_t)(row0 + ai * 128 + m * 16) * 1024 + col0;
#pragma unroll
                for (int bj = 0; bj < 2; ++bj) {
                    const u32x4 g = *(const u32x4*)(rowp + bj * 128);
                    const f32x4 a0 = acc[ai][bj][m][0], a1 = acc[ai][bj][m][1];
                    u32x4 w;
                    w.x = cvt_pk_bf16(bf_lo(g.x) * a0[0], bf_hi(g.x) * a0[1]); w.y = cvt_pk_bf16(bf_lo(g.y) * a0[2], bf_hi(g.y) * a0[3]);
                    w.z = cvt_pk_bf16(bf_lo(g.z) * a1[0], bf_hi(g.z) * a1[1]); w.w = cvt_pk_bf16(bf_lo(g.w) * a1[2], bf_hi(g.w) * a1[3]);
                    *(u32x4*)(rowp + bj * 128) = w;
                }
            }
    }
};
struct EpiMixB {
    static constexpr bool PERM = true;
    bf16_t* GA; const bf16_t* GB;
    __device__ __forceinline__ void operator()(const f32x4 (&acc)[2][2][4][2], const Unit& u, int wr, int wc, int fr, int fq) const {
        const int row0 = u.pm * 256 + wr * 64 + fr, col0 = u.pn * 256 + wc * 32 + 8 * fq;
#pragma unroll
        for (int ai = 0; ai < 2; ++ai)
#pragma unroll
            for (int m = 0; m < 4; ++m) {
                const size_t off = (size_t)(row0 + ai * 128 + m * 16) * 1024 + col0;
#pragma unroll
                for (int bj = 0; bj < 2; ++bj) {
                    const u32x4 g = *(const u32x4*)(GB + off + bj * 128);
                    const u32x4 mx = *(const u32x4*)(GA + off + bj * 128);
                    const f32x4 a0 = acc[ai][bj][m][0], a1 = acc[ai][bj][m][1];
                    u32x4 w;
                    w.x = cvt_pk_bf16(bf_lo(mx.x) + bf_lo(g.x) * a0[0], bf_hi(mx.x) + bf_hi(g.x) * a0[1]); w.y = cvt_pk_bf16(bf_lo(mx.y) + bf_lo(g.y) * a0[2], bf_hi(mx.y) + bf_hi(g.y) * a0[3]);
                    w.z = cvt_pk_bf16(bf_lo(mx.z) + bf_lo(g.z) * a1[0], bf_hi(mx.z) + bf_hi(g.z) * a1[1]); w.w = cvt_pk_bf16(bf_lo(mx.w) + bf_lo(g.w) * a1[2], bf_hi(mx.w) + bf_hi(g.w) * a1[3]);
                    *(u32x4*)(GA + off + bj * 128) = w;
                }
            }
    }
};
struct EpiOut {
    static constexpr bool PERM = false;
    const float* x; const float* ada; float* out;
    __device__ __forceinline__ void operator()(const f32x4 (&acc)[2][2][4][2], const Unit& u, int wr, int wc, int fr, int fq) const {
        const int row0 = u.pm * 256 + wr * 64 + fr, col0 = u.pn * 256 + wc * 32 + 4 * fq;
        const float* gt1 = ada + (size_t)(u.pm >> 3) * 6144 + 2048;
#pragma unroll
        for (int ai = 0; ai < 2; ++ai)
#pragma unroll
            for (int m = 0; m < 4; ++m) {
                const size_t off = (size_t)(row0 + ai * 128 + m * 16) * 1024 + col0;
#pragma unroll
                for (int bj = 0; bj < 2; ++bj)
#pragma unroll
                    for (int n = 0; n < 2; ++n) {
                        const int cc = bj * 128 + n * 16;
                        const f32x4 xv = *(const f32x4*)(x + off + cc), gv = *(const f32x4*)(gt1 + col0 + cc);
                        *(f32x4*)(out + off + cc) = xv * ALPHA + gv * acc[ai][bj][m][n];
                    }
            }
    }
};
struct EpiBf16 {
    static constexpr bool PERM = true;
    bf16_t* O;
    __device__ __forceinline__ void operator()(const f32x4 (&acc)[2][2][4][2], const Unit& u, int wr, int wc, int fr, int fq) const {
        const int row0 = u.pm * 256 + wr * 64 + fr, col0 = u.pn * 256 + wc * 32 + 8 * fq;
#pragma unroll
        for (int ai = 0; ai < 2; ++ai)
#pragma unroll
            for (int m = 0; m < 4; ++m) {
                bf16_t* rowp = O + (size_t)(row0 + ai * 128 + m * 16) * 1024 + col0;
#pragma unroll
                for (int bj = 0; bj < 2; ++bj) {
                    const f32x4 a0 = acc[ai][bj][m][0], a1 = acc[ai][bj][m][1];
                    u32x4 w; w.x = cvt_pk_bf16(a0[0], a0[1]); w.y = cvt_pk_bf16(a0[2], a0[3]); w.z = cvt_pk_bf16(a1[0], a1[1]); w.w = cvt_pk_bf16(a1[2], a1[3]);
                    *(u32x4*)(rowp + bj * 128) = w;
                }
            }
    }
};

__device__ void phase0a(const Params& P, LAS unsigned char* lds) {
    const int tid = tid_opaque(), G = gridDim.x, bid = blockIdx.x;
    for (int it = bid; it < 192; it += G) {
        LAS float* sc = (LAS float*)lds;
        for (int i = tid; i < 32 * 1024; i += NTHR) { const float cv = P.c[i]; sc[i] = cv * sigmoidf_(cv); }
        __syncthreads();
        const int kg = tid >> 5, col = tid & 31;
        float a[32];
#pragma unroll
        for (int b = 0; b < 32; ++b) a[b] = 0.f;
        for (int k = kg * 64; k < kg * 64 + 64; k += 4) {
            float w[4];
#pragma unroll
            for (int e = 0; e < 4; ++e) w[e] = P.w_ada[(size_t)(k + e) * 6144 + it * 32 + col];
#pragma unroll
            for (int b = 0; b < 32; ++b) { const f32x4 s = *(const LAS f32x4*)(sc + b * 1024 + k); a[b] += s[0] * w[0] + s[1] * w[1] + s[2] * w[2] + s[3] * w[3]; }
        }
        __syncthreads();
        LAS float* red = (LAS float*)lds;
#pragma unroll
        for (int b = 0; b < 32; ++b) red[(kg * 32 + b) * 32 + col] = a[b];
        __syncthreads();
        for (int o = tid; o < 1024; o += NTHR) { const int b = o >> 5, cc = o & 31; float s = 0.f;
#pragma unroll
            for (int g2 = 0; g2 < 16; ++g2) s += red[(g2 * 32 + b) * 32 + cc];
            ((float*)(P.ws + OFF_ADA))[(size_t)b * 6144 + it * 32 + cc] = s + P.b_ada[it * 32 + cc]; }
        __syncthreads();
    }
    const size_t gtid = (size_t)bid * NTHR + tid, gsz = (size_t)G * NTHR;
    for (size_t i = gtid; i < 512; i += gsz) ((float*)(P.ws + OFF_LB))[i] = sigmoidf_(P.hgrn_lb[i] - P.hgrn_lb[512 + i]);
    for (size_t i = gtid; i < 32 * 8 * 512; i += gsz) ((float*)(P.ws + OFF_KMEAN))[i] = 0.f;
    {
        LAS float* tile = (LAS float*)lds;
        const int I0 = 16 * 88, I1 = I0 + 8 * 16, I2 = I1 + 8 * 16, I3 = I2 + 16 * 16, I4 = I3 + 16 * 16;
        for (int it = bid; it < I4; it += G) {
            const float* W; bf16_t* WT; int K, N, r;
            if (it < I0) { W = P.w_in; WT = (bf16_t*)(P.ws + OFF_WIN); K = 1024; N = 5632; r = it; }
            else if (it < I1) { W = P.w_ba; WT = (bf16_t*)(P.ws + OFF_WBA); K = 512; N = 1024; r = it - I0; }
            else if (it < I2) { W = P.w_bb; WT = (bf16_t*)(P.ws + OFF_WBB); K = 512; N = 1024; r = it - I1; }
            else if (it < I3) { W = P.w_out; WT = (bf16_t*)(P.ws + OFF_WOUT); K = 1024; N = 1024; r = it - I2; }
            else { W = P.peer_wq; WT = (bf16_t*)(P.ws + OFF_WQ); K = 1024; N = 1024; r = it - I3; }
            const int nb = N / 64, k0 = (r / nb) * 64, n0 = (r % nb) * 64;
#pragma unroll
            for (int ps = 0; ps < 2; ++ps) { const int kk = (tid >> 4) + 32 * ps, n4 = (tid & 15) * 4;
                const f32x4 v = *(const f32x4*)(W + (size_t)(k0 + kk) * N + n0 + n4);
                tile[kk * 65 + n4] = v[0]; tile[kk * 65 + n4 + 1] = v[1]; tile[kk * 65 + n4 + 2] = v[2]; tile[kk * 65 + n4 + 3] = v[3]; }
            __syncthreads();
            { const int n = tid >> 3, kc = (tid & 7) * 8; u32x4 w;
              w.x = cvt_pk_bf16(tile[(kc + 0) * 65 + n], tile[(kc + 1) * 65 + n]); w.y = cvt_pk_bf16(tile[(kc + 2) * 65 + n], tile[(kc + 3) * 65 + n]);
              w.z = cvt_pk_bf16(tile[(kc + 4) * 65 + n], tile[(kc + 5) * 65 + n]); w.w = cvt_pk_bf16(tile[(kc + 6) * 65 + n], tile[(kc + 7) * 65 + n]);
              *(u32x4*)(WT + (size_t)(n0 + n) * K + k0 + kc) = w; }
            __syncthreads();
        }
    }
    {
        if (gtid < 16) ((unsigned*)(P.ws + OFF_CTR))[gtid] = 0u;
        for (size_t i = gtid; i < 16384; i += gsz) {
            const float* src = P.peer_sk + i * 8; const f32x4 a = *(const f32x4*)src, b = *(const f32x4*)(src + 4);
            u32x4 w; w.x = cvt_pk_bf16(a[0], a[1]); w.y = cvt_pk_bf16(a[2], a[3]); w.z = cvt_pk_bf16(b[0], b[1]); w.w = cvt_pk_bf16(b[2], b[3]);
            *(u32x4*)((bf16_t*)(P.ws + OFF_SK) + i * 8) = w;
        }
        const size_t NV = (size_t)16384 * 1024 / 8;
        for (size_t i = gtid; i < 2 * NV; i += gsz) {
            const bool isv = i >= NV; const size_t j = isv ? i - NV : i;
            const float* src = (isv ? P.peer_v : P.peer_u) + j * 8; const float sc = isv ? 4.0f : 32.0f;
            const f32x4 a = *(const f32x4*)src * sc, b = *(const f32x4*)(src + 4) * sc;
            int w0 = __builtin_amdgcn_cvt_pk_fp8_f32(a[0], a[1], 0, false); w0 = __builtin_amdgcn_cvt_pk_fp8_f32(a[2], a[3], w0, true);
            int w1 = __builtin_amdgcn_cvt_pk_fp8_f32(b[0], b[1], 0, false); w1 = __builtin_amdgcn_cvt_pk_fp8_f32(b[2], b[3], w1, true);
            u32x2 w; w.x = (unsigned)w0; w.y = (unsigned)w1;
            size_t dst;
            if (!isv) dst = OFF_U8 + j * 8;
            else { const size_t e = j >> 7; const int d8 = (int)(j & 127) * 8; dst = OFF_V8 + ((size_t)(d8 >> 7) * 16384 + e) * 128 + (d8 & 127); }
            *(u32x2*)(P.ws + dst) = w;
        }
    }
}
__device__ void phase0b(const Params& P) {
    const size_t gtid = (size_t)blockIdx.x * NTHR + threadIdx.x, gsz = (size_t)gridDim.x * NTHR;
    const float* ada = (const float*)(P.ws + OFF_ADA); bf16_t* H = (bf16_t*)(P.ws + OFF_H);
    for (size_t i = gtid; i < (size_t)NTOK * 128; i += gsz) {
        const size_t row = i >> 7; const int c8 = (int)(i & 127) * 8; const int b = (int)(row >> 11);
        const float* xr = P.x + row * 1024 + c8; const float* sh = ada + (size_t)b * 6144 + c8; const float* sc = sh + 1024;
        const f32x4 x0 = *(const f32x4*)xr, x1 = *(const f32x4*)(xr + 4), s0 = *(const f32x4*)sc, s1 = *(const f32x4*)(sc + 4), h0 = *(const f32x4*)sh, h1 = *(const f32x4*)(sh + 4);
        const f32x4 r0 = x0 * (s0 + 1.0f) + h0, r1 = x1 * (s1 + 1.0f) + h1;
        u32x4 w; w.x = cvt_pk_bf16(r0[0], r0[1]); w.y = cvt_pk_bf16(r0[2], r0[3]); w.z = cvt_pk_bf16(r1[0], r1[1]); w.w = cvt_pk_bf16(r1[2], r1[3]);
        *(u32x4*)(H + row * 1024 + c8) = w;
    }
}

__device__ void hgrn_item(const Params& P, int item, LAS unsigned char* lds) {
    const int tid = tid_opaque(), lane = tid & 63, wid = tid >> 6;
    const int b = item >> 3, h = (item >> 1) & 3, vh = item & 1;
    const bf16_t* HQ = (const bf16_t*)(P.ws + OFF_HQ); const bf16_t* HK = (const bf16_t*)(P.ws + OFF_HK); bf16_t* HI = (bf16_t*)(P.ws + OFF_HI);
    LAS float* qs = (LAS float*)lds;
    LAS float* ks = (LAS float*)(lds + 16384);
    LAS float* vs = (LAS float*)(lds + 32768);
    LAS float* part = (LAS float*)(lds + 40960);
    float S[16];
#pragma unroll
    for (int i = 0; i < 16; ++i) S[i] = 0.f;
    const size_t rowb = (size_t)b * SEQ;
    for (int t0 = 0; t0 < SEQ; t0 += 32) {
        { const int row = tid >> 4, c8 = (tid & 15) * 8; const size_t g = (rowb + t0 + row) * 512 + h * 128 + c8;
          const u32x4 qv = *(const u32x4*)(HQ + g), kv = *(const u32x4*)(HK + g);
          LAS float* qd = qs + row * 128 + c8; LAS float* kd = ks + row * 128 + c8;
          *(LAS f32x4*)qd = (f32x4){bf_lo(qv.x), bf_hi(qv.x), bf_lo(qv.y), bf_hi(qv.y)}; *(LAS f32x4*)(qd + 4) = (f32x4){bf_lo(qv.z), bf_hi(qv.z), bf_lo(qv.w), bf_hi(qv.w)};
          *(LAS f32x4*)kd = (f32x4){bf_lo(kv.x), bf_hi(kv.x), bf_lo(kv.y), bf_hi(kv.y)}; *(LAS f32x4*)(kd + 4) = (f32x4){bf_lo(kv.z), bf_hi(kv.z), bf_lo(kv.w), bf_hi(kv.w)};
          const int c4 = (tid & 15) * 4; const u32x2 vv = *(const u32x2*)(HI + (rowb + t0 + row) * 512 + h * 128 + vh * 64 + c4);
          *(LAS f32x4*)(vs + row * 64 + c4) = (f32x4){bf_lo(vv.x), bf_hi(vv.x), bf_lo(vv.y), bf_hi(vv.y)}; }
        __syncthreads();
        for (int t = 0; t < 32; ++t) {
            const float v = vs[t * 64 + lane]; float op = 0.f;
#pragma unroll
            for (int i4 = 0; i4 < 4; ++i4) {
                const f32x4 kq = *(const LAS f32x4*)(ks + t * 128 + wid * 16 + i4 * 4), qq = *(const LAS f32x4*)(qs + t * 128 + wid * 16 + i4 * 4);
#pragma unroll
                for (int e = 0; e < 4; ++e) { float s = S[i4 * 4 + e]; s += kq[e] * (v - s); S[i4 * 4 + e] = s; op += qq[e] * s; }
            }
            part[(t * 8 + wid) * 64 + lane] = op;
        }
        __syncthreads();
        { const int t = tid >> 4, c4 = (tid & 15) * 4; f32x4 s = (f32x4){0.f, 0.f, 0.f, 0.f};
#pragma unroll
          for (int w = 0; w < 8; ++w) s += *(const LAS f32x4*)(part + (t * 8 + w) * 64 + c4);
          u32x2 o; o.x = cvt_pk_bf16(s[0], s[1]); o.y = cvt_pk_bf16(s[2], s[3]);
          *(u32x2*)(HI + (rowb + t0 + t) * 512 + h * 128 + vh * 64 + c4) = o; }
    }
    __syncthreads();
}

__device__ void moba_unit(const Params& P, int b, int h, int j, LAS unsigned char* lds) {
    const int tid = tid_opaque(), lane = tid & 63, wid = tid >> 6, r32 = lane & 31, hi = lane >> 5;
    bf16_t* Q = (bf16_t*)(P.ws + OFF_QA); const bf16_t* Kg = (const bf16_t*)(P.ws + OFF_KA); const bf16_t* Vg = (const bf16_t*)(P.ws + OFF_VA);
    const float* kmean = (const float*)(P.ws + OFF_KMEAN);
    constexpr int KIMG = 64 * 144, VIMG = 64 * 192, LK = 0, LV = 2 * KIMG, LKM = 2 * KIMG + 2 * VIMG;
    LAS float* kmL = (LAS float*)(lds + LKM);
    const size_t rowb = (size_t)b * SEQ; const int q0 = j * 256;
    if (tid < j * 64) kmL[tid] = kmean[(size_t)(b * 8 + (tid >> 6)) * 512 + h * 64 + (tid & 63)];
    bf16_t* qrow = Q + (rowb + q0 + wid * 32 + r32) * 512 + h * 64;
    bf16x8 qf[4];
#pragma unroll
    for (int d0 = 0; d0 < 4; ++d0) qf[d0] = *(const bf16x8*)(qrow + 16 * d0 + 8 * hi);
    const int srow = tid >> 3, sch = tid & 7;
    const bf16_t* ksrc = Kg + (rowb + srow) * 512 + h * 64 + sch * 8; const bf16_t* vsrc = Vg + (rowb + srow) * 512 + h * 64 + sch * 8;
    const int ntile = 4 * (j + 1);
    u32x4 kreg, vreg;
    { const int key0 = q0; kreg = *(const u32x4*)(ksrc + (size_t)key0 * 512); vreg = *(const u32x4*)(vsrc + (size_t)key0 * 512); }
    *(LAS u32x4*)(lds + LK + srow * 144 + sch * 16) = kreg; *(LAS u32x4*)(lds + LV + srow * 192 + sch * 16) = vreg;
    __syncthreads();
    unsigned sel = 0;
    if (j <= 3) sel = (1u << j) - 1u;
    else {
        float g[7];
#pragma unroll
        for (int n = 0; n < 7; ++n) { float s = 0.f;
            if (n < j) {
#pragma unroll
                for (int d0 = 0; d0 < 4; ++d0)
#pragma unroll
                    for (int e = 0; e < 8; ++e) s += __uint_as_float(((unsigned)(unsigned short)qf[d0][e]) << 16) * kmL[n * 64 + 16 * d0 + 8 * hi + e];
            }
            s += __shfl_xor(s, 32); g[n] = s; }
#pragma unroll
        for (int it = 0; it < 3; ++it) { float best = -INFINITY; int bi = 0;
#pragma unroll
            for (int n = 0; n < 7; ++n) if (n < j && !((sel >> n) & 1u) && g[n] > best) { best = g[n]; bi = n; }
            sel |= 1u << bi; }
    }
    const float ch = exp2f(-(float)(h + 1)) * LOG2E;
    const int qb = wid * 32 + r32;
    float m_run = -1e30f, l_run = 0.f;
    f32x16 o0 = {}, o1 = {};
    const int tg = lane >> 4, tc = tg & 1, ti = lane & 15;
    const int vlane = (4 * hi + (ti >> 2)) * 192 + (16 * tc + 4 * (ti & 3)) * 2;
#pragma unroll 1
    for (int i = 0; i < ntile; ++i) {
        const int buf = i & 1;
        const bool own = i < 4; const int blk = own ? j : ((i - 4) >> 2), kt = own ? i : ((i - 4) & 3);
        if (i + 1 < ntile) { const int i1 = i + 1; const int blk1 = (i1 < 4) ? j : ((i1 - 4) >> 2), kt1 = (i1 < 4) ? i1 : ((i1 - 4) & 3); const size_t key1 = (size_t)(blk1 * 256 + kt1 * 64);
            kreg = *(const u32x4*)(ksrc + key1 * 512); vreg = *(const u32x4*)(vsrc + key1 * 512); }
        const bool lane_ok = own ? true : (((sel >> blk) & 1u) != 0u);
        const bool skip = own ? (64 * kt > 32 * wid + 31) : (__ballot(lane_ok) == 0ull);
        if (!skip) {
            LAS unsigned char* kb = lds + LK + buf * KIMG; LAS unsigned char* vb = lds + LV + buf * VIMG;
            f32x16 p0 = {}, p1 = {};
#pragma unroll
            for (int d0 = 0; d0 < 4; ++d0) {
                const bf16x8 kf0 = *(const LAS bf16x8*)(kb + r32 * 144 + (16 * d0 + 8 * hi) * 2);
                const bf16x8 kf1 = *(const LAS bf16x8*)(kb + (32 + r32) * 144 + (16 * d0 + 8 * hi) * 2);
                p0 = MFMA32(kf0, qf[d0], p0); p1 = MFMA32(kf1, qf[d0], p1);
            }
            const float kbase = ch * (float)((blk - j) * 256 + kt * 64);
            float mt = -1e30f;
#pragma unroll
            for (int r = 0; r < 16; ++r) {
                const int kl0 = crow(r, hi), kl1 = kl0 + 32;
                const float t0 = p0[r] + (kbase + ch * (float)kl0), t1 = p1[r] + (kbase + ch * (float)kl1);
                const bool v0 = own ? (kt * 64 + kl0 <= qb) : lane_ok, v1 = own ? (kt * 64 + kl1 <= qb) : lane_ok;
                p0[r] = v0 ? t0 : -1e30f; p1[r] = v1 ? t1 : -1e30f;
                mt = fmaxf(mt, fmaxf(p0[r], p1[r]));
            }
            mt = fmaxf(mt, __shfl_xor(mt, 32));
            const float mnew = fmaxf(m_run, mt), alpha = __builtin_amdgcn_exp2f(m_run - mnew);
            m_run = mnew;
            float rs = 0.f;
#pragma unroll
            for (int r = 0; r < 16; ++r) { p0[r] = __builtin_amdgcn_exp2f(p0[r] - mnew); p1[r] = __builtin_amdgcn_exp2f(p1[r] - mnew); rs += p0[r] + p1[r]; }
            l_run = l_run * alpha + rs;
#pragma unroll
            for (int r = 0; r < 16; ++r) { o0[r] *= alpha; o1[r] *= alpha; }
#pragma unroll
            for (int sub = 0; sub < 2; ++sub)
#pragma unroll
                for (int s = 0; s < 2; ++s) {
                    union { u32x4 u; bf16x8 v; } pb;
                    if (sub == 0) { pb.u.x = cvt_pk_bf16(p0[8 * s + 0], p0[8 * s + 1]); pb.u.y = cvt_pk_bf16(p0[8 * s + 2], p0[8 * s + 3]); pb.u.z = cvt_pk_bf16(p0[8 * s + 4], p0[8 * s + 5]); pb.u.w = cvt_pk_bf16(p0[8 * s + 6], p0[8 * s + 7]); }
                    else { pb.u.x = cvt_pk_bf16(p1[8 * s + 0], p1[8 * s + 1]); pb.u.y = cvt_pk_bf16(p1[8 * s + 2], p1[8 * s + 3]); pb.u.z = cvt_pk_bf16(p1[8 * s + 4], p1[8 * s + 5]); pb.u.w = cvt_pk_bf16(p1[8 * s + 6], p1[8 * s + 7]); }
#pragma unroll
                    for (int dt = 0; dt < 2; ++dt) {
                        LAS unsigned char* va = vb + (32 * sub + 16 * s) * 192 + dt * 64 + vlane;
                        const s16x4 lo = __builtin_bit_cast(s16x4, __builtin_amdgcn_ds_read_tr16_b64_v4i16((LAS s16x4*)va));
                        const s16x4 hh = __builtin_bit_cast(s16x4, __builtin_amdgcn_ds_read_tr16_b64_v4i16((LAS s16x4*)(va + 8 * 192)));
                        const bf16x8 vf = {lo[0], lo[1], lo[2], lo[3], hh[0], hh[1], hh[2], hh[3]};
                        if (dt == 0) o0 = MFMA32(vf, pb.v, o0); else o1 = MFMA32(vf, pb.v, o1);
                    }
                }
        }
        if (i + 1 < ntile) { const int nb = buf ^ 1;
            *(LAS u32x4*)(lds + LK + nb * KIMG + srow * 144 + sch * 16) = kreg; *(LAS u32x4*)(lds + LV + nb * VIMG + srow * 192 + sch * 16) = vreg; }
        __syncthreads();
    }
    l_run += __shfl_xor(l_run, 32);
    const float inv = 1.0f / l_run;
#pragma unroll
    for (int r4 = 0; r4 < 4; ++r4) {
        u32x2 w0, w1;
        w0.x = cvt_pk_bf16(o0[4 * r4] * inv, o0[4 * r4 + 1] * inv); w0.y = cvt_pk_bf16(o0[4 * r4 + 2] * inv, o0[4 * r4 + 3] * inv);
        w1.x = cvt_pk_bf16(o1[4 * r4] * inv, o1[4 * r4 + 1] * inv); w1.y = cvt_pk_bf16(o1[4 * r4 + 2] * inv, o1[4 * r4 + 3] * inv);
        *(u32x2*)(qrow + 8 * r4 + 4 * hi) = w0; *(u32x2*)(qrow + 32 + 8 * r4 + 4 * hi) = w1;
    }
}

__device__ void yb_norm_panel(const Params& P, int pm) {
    const int tid = tid_opaque(), lane = tid & 63, wid = tid >> 6;
    bf16_t* HI = (bf16_t*)(P.ws + OFF_HI); const bf16_t* HG = (const bf16_t*)(P.ws + OFF_HG);
    for (int r = 0; r < 32; ++r) {
        const size_t off = ((size_t)pm * 256 + wid * 32 + r) * 512 + lane * 8;
        const u32x4 ov = *(const u32x4*)(HI + off), gv = *(const u32x4*)(HG + off);
        float o[8] = {bf_lo(ov.x), bf_hi(ov.x), bf_lo(ov.y), bf_hi(ov.y), bf_lo(ov.z), bf_hi(ov.z), bf_lo(ov.w), bf_hi(ov.w)};
        const float g[8] = {bf_lo(gv.x), bf_hi(gv.x), bf_lo(gv.y), bf_hi(gv.y), bf_lo(gv.z), bf_hi(gv.z), bf_lo(gv.w), bf_hi(gv.w)};
        float ss = 0.f;
#pragma unroll
        for (int e = 0; e < 8; ++e) ss += o[e] * o[e];
        ss += __shfl_xor(ss, 1); ss += __shfl_xor(ss, 2); ss += __shfl_xor(ss, 4); ss += __shfl_xor(ss, 8);
        const float rs = rsqrtf(ss * (1.0f / 128.0f) + RMS_EPS);
        u32x4 w; w.x = cvt_pk_bf16(o[0] * rs * g[0], o[1] * rs * g[1]); w.y = cvt_pk_bf16(o[2] * rs * g[2], o[3] * rs * g[3]);
        w.z = cvt_pk_bf16(o[4] * rs * g[4], o[5] * rs * g[5]); w.w = cvt_pk_bf16(o[6] * rs * g[6], o[7] * rs * g[7]);
        *(u32x4*)(HI + off) = w;
    }
}
__device__ void ln1_panel(const Params& P, int pm) {
    const int tid = tid_opaque(), lane = tid & 63, wid = tid >> 6;
    const float* ada = (const float*)(P.ws + OFF_ADA) + (size_t)(pm >> 3) * 6144; bf16_t* H = (bf16_t*)(P.ws + OFF_H);
    for (int r = 0; r < 32; ++r) {
        const size_t row = (size_t)pm * 256 + wid * 32 + r;
        float* xr = P.out + row * 1024 + lane * 4;
        f32x4 v[4]; float s = 0.f;
#pragma unroll
        for (int jx = 0; jx < 4; ++jx) { v[jx] = *(const f32x4*)(xr + 256 * jx); s += (v[jx][0] + v[jx][1]) + (v[jx][2] + v[jx][3]); }
        const float mean = wave_sum(s) * (1.0f / 1024.0f); float s2 = 0.f;
#pragma unroll
        for (int jx = 0; jx < 4; ++jx) { v[jx] = v[jx] - mean; s2 += (v[jx][0] * v[jx][0] + v[jx][1] * v[jx][1]) + (v[jx][2] * v[jx][2] + v[jx][3] * v[jx][3]); }
        const float rstd = rsqrtf(wave_sum(s2) * (1.0f / 1024.0f) + LN_EPS);
#pragma unroll
        for (int jx = 0; jx < 4; ++jx) {
            const int c = lane * 4 + 256 * jx;
            const f32x4 g = *(const f32x4*)(P.ln1_g + c), bb = *(const f32x4*)(P.ln1_b + c), sh = *(const f32x4*)(ada + 3072 + c), sc = *(const f32x4*)(ada + 4096 + c);
            const f32x4 x1 = v[jx] * rstd * g + bb;
            *(f32x4*)(xr + 256 * jx) = x1;
            const f32x4 h2 = x1 * (sc + 1.0f) + sh;
            u32x2 w; w.x = cvt_pk_bf16(h2[0], h2[1]); w.y = cvt_pk_bf16(h2[2], h2[3]);
            *(u32x2*)(H + row * 1024 + c) = w;
        }
    }
}

#define INS16(L, xin) do { float x_ = (xin); _Pragma("unroll") for (int k_ = 0; k_ < 16; ++k_) { const float hi_ = fmaxf(L[k_], x_); x_ = fminf(L[k_], x_); L[k_] = hi_; } } while (0)

__device__ void peer_select_wave(const Params& P, size_t tok0) {
    const int lane = tid_opaque() & 63, r32 = lane & 31, hi = lane >> 5;
    const bf16_t* QP = (const bf16_t*)(P.ws + OFF_GB) + (tok0 + r32) * 1024; const bf16_t* SK = (const bf16_t*)(P.ws + OFF_SK);
    u32x2* EG = (u32x2*)(P.ws + OFF_EG) + (tok0 + r32) * 128;
#pragma unroll 1
    for (int h = 0; h < 8; ++h) {
        float a0[16], a1[16];
#pragma unroll
        for (int k = 0; k < 16; ++k) { a0[k] = -INFINITY; a1[k] = -INFINITY; }
#pragma unroll 1
        for (int p = 0; p < 2; ++p) {
            const int hp = h * 2 + p;
            bf16x8 qf[4];
#pragma unroll
            for (int ks = 0; ks < 4; ++ks) qf[ks] = *(const bf16x8*)(QP + hp * 64 + 16 * ks + 8 * hi);
            float L[16];
#pragma unroll
            for (int k = 0; k < 16; ++k) L[k] = -INFINITY;
#pragma unroll
            for (int kt = 0; kt < 4; ++kt) {
                f32x16 acc = {};
#pragma unroll
                for (int ks = 0; ks < 4; ++ks) { const bf16x8 kf = *(const bf16x8*)(SK + ((size_t)hp * 128 + 32 * kt + r32) * 64 + 16 * ks + 8 * hi); acc = MFMA32(kf, qf[ks], acc); }
#pragma unroll
                for (int r = 0; r < 16; ++r) { const unsigned key = (unsigned)(32 * kt + crow(r, hi)); const float xv = __uint_as_float((__float_as_uint(acc[r]) & ~127u) | key); INS16(L, xv); }
            }
            float O[16];
#pragma unroll
            for (int k = 0; k < 16; ++k) O[k] = __shfl_xor(L[k], 32);
#pragma unroll
            for (int k = 0; k < 16; ++k) INS16(L, O[k]);
#pragma unroll
            for (int k = 0; k < 16; ++k) { a0[k] = (p == 0) ? L[k] : a0[k]; a1[k] = (p == 1) ? L[k] : a1[k]; }
        }
        float best[16];
#pragma unroll
        for (int k = 0; k < 16; ++k) best[k] = -INFINITY;
#pragma unroll
        for (int i = 0; i < 16; ++i)
#pragma unroll
            for (int jx = 0; jx < 16; ++jx)
                if ((i + 1) * (jx + 1) <= 16) {
                    const float cs = a0[i] + a1[jx];
                    const float cv = __uint_as_float((__float_as_uint(cs) & ~255u) | (unsigned)(i * 16 + jx));
                    INS16(best, cv);
                }
        unsigned pk0[4], pk1[4];
#pragma unroll
        for (int q = 0; q < 4; ++q) {
            pk0[q] = (__float_as_uint(a0[4 * q]) & 127u) | ((__float_as_uint(a0[4 * q + 1]) & 127u) << 8) | ((__float_as_uint(a0[4 * q + 2]) & 127u) << 16) | ((__float_as_uint(a0[4 * q + 3]) & 127u) << 24);
            pk1[q] = (__float_as_uint(a1[4 * q]) & 127u) | ((__float_as_uint(a1[4 * q + 1]) & 127u) << 8) | ((__float_as_uint(a1[4 * q + 2]) & 127u) << 16) | ((__float_as_uint(a1[4 * q + 3]) & 127u) << 24);
        }
        unsigned pay[16];
#pragma unroll
        for (int k = 0; k < 16; ++k) {
            const unsigned code = __float_as_uint(best[k]) & 255u, ci = code >> 4, cj = code & 15u;
            const unsigned qi = ci >> 2, qj = cj >> 2;
            const unsigned w0 = (qi == 0u) ? pk0[0] : ((qi == 1u) ? pk0[1] : ((qi == 2u) ? pk0[2] : pk0[3]));
            const unsigned w1 = (qj == 0u) ? pk1[0] : ((qj == 1u) ? pk1[1] : ((qj == 2u) ? pk1[2] : pk1[3]));
            pay[k] = (((w0 >> ((ci & 3u) * 8u)) & 127u) << 7) | ((w1 >> ((cj & 3u) * 8u)) & 127u);
        }
        float e[16], es = 0.f;
#pragma unroll
        for (int k = 0; k < 16; ++k) { e[k] = __expf(best[k] - best[0]); es += e[k]; }
        const float inv = 1.0f / es;
        if (hi == 0) {
#pragma unroll
            for (int k = 0; k < 16; ++k) { u32x2 w; w.x = pay[k]; w.y = __float_as_uint(e[k] * inv); EG[h * 16 + k] = w; }
        }
    }
}
__device__ __forceinline__ unsigned xcc_id() { return (unsigned)__builtin_amdgcn_s_getreg((3 << 11) | 20) & 0xFu; }
template <int CTRL> __device__ __forceinline__ float dpp_add(float x) { const int v = __builtin_amdgcn_update_dpp(0, __float_as_int(x), CTRL, 0xf, 0xf, true); return x + __int_as_float(v); }
__device__ __forceinline__ float wave_sum_fast(float x) {
    x = dpp_add<0xB1>(x); x = dpp_add<0x4E>(x); x = dpp_add<0x141>(x); x = dpp_add<0x140>(x);
    x += __shfl_xor(x, 16); x += __shfl_xor(x, 32); return x;
}
__device__ __forceinline__ float dot16_fp8(const float (&hv)[16], const u32x4 r) {
    float s = 0.f;
    { const f32x2 a = __builtin_amdgcn_cvt_pk_f32_fp8((int)r.x, false), b = __builtin_amdgcn_cvt_pk_f32_fp8((int)r.x, true); s += hv[0] * a.x + hv[1] * a.y + hv[2] * b.x + hv[3] * b.y; }
    { const f32x2 a = __builtin_amdgcn_cvt_pk_f32_fp8((int)r.y, false), b = __builtin_amdgcn_cvt_pk_f32_fp8((int)r.y, true); s += hv[4] * a.x + hv[5] * a.y + hv[6] * b.x + hv[7] * b.y; }
    { const f32x2 a = __builtin_amdgcn_cvt_pk_f32_fp8((int)r.z, false), b = __builtin_amdgcn_cvt_pk_f32_fp8((int)r.z, true); s += hv[8] * a.x + hv[9] * a.y + hv[10] * b.x + hv[11] * b.y; }
    { const f32x2 a = __builtin_amdgcn_cvt_pk_f32_fp8((int)r.w, false), b = __builtin_amdgcn_cvt_pk_f32_fp8((int)r.w, true); s += hv[12] * a.x + hv[13] * a.y + hv[14] * b.x + hv[15] * b.y; }
    return s;
}
template <class F> __device__ __forceinline__ void partition_queue(const Params& P, LAS unsigned char* lds, int ctr_base, F f) {
    const int tid = tid_opaque();
    LAS int* slot = (LAS int*)(lds + LDS_BYTES - 64);
    unsigned* ctr = (unsigned*)(P.ws + OFF_CTR) + ctr_base;
    const int myx = (int)(xcc_id() & 7u);
    for (int pp = 0; pp < 8; ++pp) {
        const int p = (myx + pp) & 7;
        for (;;) {
            if (tid == 0) *slot = (int)atomicAdd(ctr + p, 1u);
            __syncthreads();
            const int item = *slot;
            __syncthreads();
            if (item >= NTOK / 64) break;
            f(p, item);
        }
    }
}
typedef __bf16 bf16v2 __attribute__((ext_vector_type(2)));
__device__ __forceinline__ float dot2bf(unsigned a, bf16v2 b, float c) { return __builtin_amdgcn_fdot2_f32_bf16(__builtin_bit_cast(bf16v2, a), b, c, false); }
struct UQuad { u32x4 r[4]; u32x4 ent; };
__device__ __forceinline__ void uq_issue(UQuad& q, const LAS u32x4* list, int J, int NQ, int g, const unsigned char* U8) {
    const int jj = J < NQ ? J : NQ - 1;
    q.ent = list[4 * jj + g];
    const unsigned char* rp = U8 + (size_t)q.ent.x * 1024;
#pragma unroll
    for (int c = 0; c < 4; ++c) q.r[c] = *(const u32x4*)(rp + c * 256);
}
__device__ __forceinline__ float uq_dot(const UQuad& q, const u32x4 (&hp)[8]) {
    float a = 0.f, b = 0.f;
    constexpr float SC = 1.0f / 32.0f;
#pragma unroll
    for (int c = 0; c < 4; ++c) {
        const u32x4 r = q.r[c];
        a = dot2bf(hp[2 * c].x, __builtin_amdgcn_cvt_scalef32_pk_bf16_fp8((int)r.x, SC, false), a); b = dot2bf(hp[2 * c].y, __builtin_amdgcn_cvt_scalef32_pk_bf16_fp8((int)r.x, SC, true), b);
        a = dot2bf(hp[2 * c].z, __builtin_amdgcn_cvt_scalef32_pk_bf16_fp8((int)r.y, SC, false), a); b = dot2bf(hp[2 * c].w, __builtin_amdgcn_cvt_scalef32_pk_bf16_fp8((int)r.y, SC, true), b);
        a = dot2bf(hp[2 * c + 1].x, __builtin_amdgcn_cvt_scalef32_pk_bf16_fp8((int)r.z, SC, false), a); b = dot2bf(hp[2 * c + 1].y, __builtin_amdgcn_cvt_scalef32_pk_bf16_fp8((int)r.z, SC, true), b);
        a = dot2bf(hp[2 * c + 1].z, __builtin_amdgcn_cvt_scalef32_pk_bf16_fp8((int)r.w, SC, false), a); b = dot2bf(hp[2 * c + 1].w, __builtin_amdgcn_cvt_scalef32_pk_bf16_fp8((int)r.w, SC, true), b);
    }
    float s = a + b;
    s = dpp_add<0xB1>(s); s = dpp_add<0x4E>(s); s = dpp_add<0x141>(s); s = dpp_add<0x140>(s);
    return s;
}
__device__ __forceinline__ void peer_u_chunk(const Params& P, LAS unsigned char* lds, int p, int chunk) {
    const int tid = tid_opaque(), lane = tid & 63, wid = tid >> 6, g = lane >> 4, li = lane & 15;
    const bf16_t* H = (const bf16_t*)(P.ws + OFF_H); const unsigned char* U8 = P.ws + OFF_U8 + li * 16;
    const u32x4* EG4 = (const u32x4*)(P.ws + OFF_EG); float* W = (float*)(P.ws + OFF_W);
    LAS u32x4* list = (LAS u32x4*)(lds + wid * 16384);
    const size_t t0 = (size_t)chunk * 64 + wid * 8;
    int base = 0;
    {
        u32x4 eg[8];
#pragma unroll
        for (int i = 0; i < 8; ++i) eg[i] = __builtin_nontemporal_load(EG4 + (t0 + i) * 64 + lane);
#pragma unroll
        for (int i = 0; i < 8; ++i) {
            const bool m0 = (int)(eg[i].x >> 11) == p, m1 = (int)(eg[i].z >> 11) == p;
            const unsigned long long b0 = __ballot(m0), b1 = __ballot(m1);
            const int n0 = __builtin_popcountll(b0), n = n0 + __builtin_popcountll(b1);
            const int r0 = (int)__builtin_amdgcn_mbcnt_hi((unsigned)(b0 >> 32), __builtin_amdgcn_mbcnt_lo((unsigned)b0, 0u));
            const int r1 = n0 + (int)__builtin_amdgcn_mbcnt_hi((unsigned)(b1 >> 32), __builtin_amdgcn_mbcnt_lo((unsigned)b1, 0u));
            if (m0) list[base + r0] = (u32x4){eg[i].x, eg[i].y, (unsigned)(2 * lane) | (unsigned)(i << 8), 1u};
            if (m1) list[base + r1] = (u32x4){eg[i].z, eg[i].w, (unsigned)(2 * lane + 1) | (unsigned)(i << 8), 1u};
            const int npad = n == 0 ? 4 : ((n + 3) & ~3);
            if (lane < npad - n) list[base + n + lane] = (u32x4){(unsigned)(p << 11), 0u, (unsigned)(i << 8), 0u};
            base += npad;
        }
        const int rem = (16 - (base & 15)) & 15;
        if (lane < rem) list[base + lane] = (u32x4){(unsigned)(p << 11), 0u, (unsigned)(7 << 8), 0u};
        base += rem;
    }
    const int NQ = base >> 2;
    u32x4 hp[8], hn[8];
#pragma unroll
    for (int c = 0; c < 4; ++c) { hp[2 * c] = __builtin_nontemporal_load((const u32x4*)(H + t0 * 1024 + (li + 16 * c) * 16)); hp[2 * c + 1] = __builtin_nontemporal_load((const u32x4*)(H + t0 * 1024 + (li + 16 * c) * 16 + 8));
                                  hn[2 * c] = __builtin_nontemporal_load((const u32x4*)(H + (t0 + 1) * 1024 + (li + 16 * c) * 16)); hn[2 * c + 1] = __builtin_nontemporal_load((const u32x4*)(H + (t0 + 1) * 1024 + (li + 16 * c) * 16 + 8)); }
    int curtok = 0;
    UQuad q0, q1, q2, q3;
    uq_issue(q0, list, 0, NQ, g, U8); uq_issue(q1, list, 1, NQ, g, U8); uq_issue(q2, list, 2, NQ, g, U8); uq_issue(q3, list, 3, NQ, g, U8);
#define UQ_STEP(q, Jn) do { \
        const int tk = __builtin_amdgcn_readfirstlane((int)(q.ent.z >> 8)); \
        if (tk != curtok) { curtok = tk; _Pragma("unroll") for (int c = 0; c < 8; ++c) hp[c] = hn[c]; \
            if (tk + 1 < 8) { _Pragma("unroll") for (int c = 0; c < 4; ++c) { hn[2 * c] = __builtin_nontemporal_load((const u32x4*)(H + (t0 + tk + 1) * 1024 + (li + 16 * c) * 16)); hn[2 * c + 1] = __builtin_nontemporal_load((const u32x4*)(H + (t0 + tk + 1) * 1024 + (li + 16 * c) * 16 + 8)); } } } \
        const float s = uq_dot(q, hp); \
        if (li == 0 && q.ent.w != 0u) W[(t0 + tk) * 128 + (q.ent.z & 255u)] = __uint_as_float(q.ent.y) * 0.5f * s * (1.0f + erff(s * 0.70710678118654752f)); \
        uq_issue(q, list, (Jn), NQ, g, U8); } while (0)
#pragma unroll 1
    for (int J = 0; J < NQ; J += 4) { UQ_STEP(q0, J + 4); UQ_STEP(q1, J + 5); UQ_STEP(q2, J + 6); UQ_STEP(q3, J + 7); }
#undef UQ_STEP
}
__device__ __forceinline__ void pv_issue(u32x2 (&r)[32], const LAS u32x2* list, int g, const unsigned char* V8) {
#pragma unroll
    for (int j = 0; j < 32; ++j) r[j] = *(const u32x2*)(V8 + (size_t)list[4 * j + g].x * 128);
}
__device__ __forceinline__ void pv_reduce(const u32x2 (&r)[32], const LAS u32x2* list, int g, int li, float* yp) {
    f32x2 a0 = {0.f, 0.f}, a1 = {0.f, 0.f}, a2 = {0.f, 0.f}, a3 = {0.f, 0.f};
#pragma unroll
    for (int j = 0; j < 32; ++j) {
        const float w = __uint_as_float(list[4 * j + g].y); const f32x2 wv = {w, w};
        a0 += wv * __builtin_amdgcn_cvt_pk_f32_fp8((int)r[j].x, false); a1 += wv * __builtin_amdgcn_cvt_pk_f32_fp8((int)r[j].x, true);
        a2 += wv * __builtin_amdgcn_cvt_pk_f32_fp8((int)r[j].y, false); a3 += wv * __builtin_amdgcn_cvt_pk_f32_fp8((int)r[j].y, true);
    }
    float acc[8] = {a0.x, a0.y, a1.x, a1.y, a2.x, a2.y, a3.x, a3.y};
#pragma unroll
    for (int j = 0; j < 8; ++j) { acc[j] += __shfl_xor(acc[j], 16); acc[j] += __shfl_xor(acc[j], 32); }
    if (g == 0) { *(f32x4*)yp = (f32x4){acc[0], acc[1], acc[2], acc[3]} * 0.25f; *(f32x4*)(yp + 4) = (f32x4){acc[4], acc[5], acc[6], acc[7]} * 0.25f; }
}
__device__ __forceinline__ void peer_v_chunk(const Params& P, LAS unsigned char* lds, int x, int chunk) {
    const int tid = tid_opaque(), lane = tid & 63, wid = tid >> 6, g = lane >> 4, li = lane & 15;
    const unsigned char* V8 = P.ws + OFF_V8 + (size_t)x * 16384 * 128 + li * 8;
    const u32x4* EG4 = (const u32x4*)(P.ws + OFF_EG); const f32x2* W2 = (const f32x2*)(P.ws + OFF_W); float* Y = (float*)(P.ws + OFF_Y);
    LAS u32x2* lists = (LAS u32x2*)(lds + wid * 8192);
    const size_t t0 = (size_t)chunk * 64 + wid * 8;
#pragma unroll
    for (int i = 0; i < 8; ++i) { const u32x4 eg = EG4[(t0 + i) * 64 + lane]; const f32x2 ww = W2[(t0 + i) * 64 + lane];
        *(LAS u32x4*)(lists + i * 128 + 2 * lane) = (u32x4){eg.x, __float_as_uint(ww.x), eg.z, __float_as_uint(ww.y)}; }
    float* yp = Y + t0 * 1024 + x * 128 + li * 8;
    u32x2 ra[32], rb[32];
    pv_issue(ra, lists, g, V8);
#pragma unroll
    for (int i = 0; i < 8; i += 2) {
        pv_issue(rb, lists + (i + 1) * 128, g, V8);
        pv_reduce(ra, lists + i * 128, g, li, yp + (size_t)i * 1024);
        if (i + 2 < 8) pv_issue(ra, lists + (i + 2) * 128, g, V8);
        pv_reduce(rb, lists + (i + 1) * 128, g, li, yp + (size_t)(i + 1) * 1024);
    }
}
__device__ void ln2_phase(const Params& P) {
    const int tid = tid_opaque(), lane = tid & 63, wid = tid >> 6;
    const float* Y = (const float*)(P.ws + OFF_Y);
    for (size_t row = (size_t)blockIdx.x * 8 + wid; row < (size_t)NTOK; row += (size_t)gridDim.x * 8) {
        const float* gt2 = (const float*)(P.ws + OFF_ADA) + (row >> 11) * 6144 + 5120;
        float* xr = P.out + row * 1024 + lane * 4; const float* yr = Y + row * 1024 + lane * 4;
        f32x4 v[4]; float s = 0.f;
#pragma unroll
        for (int jx = 0; jx < 4; ++jx) { const f32x4 xv = *(const f32x4*)(xr + 256 * jx), yv = __builtin_nontemporal_load((const f32x4*)(yr + 256 * jx)), gv = *(const f32x4*)(gt2 + lane * 4 + 256 * jx);
            v[jx] = xv * ALPHA + gv * yv; s += (v[jx][0] + v[jx][1]) + (v[jx][2] + v[jx][3]); }
        const float mean = wave_sum(s) * (1.0f / 1024.0f); float s2 = 0.f;
#pragma unroll
        for (int jx = 0; jx < 4; ++jx) { v[jx] = v[jx] - mean; s2 += (v[jx][0] * v[jx][0] + v[jx][1] * v[jx][1]) + (v[jx][2] * v[jx][2] + v[jx][3] * v[jx][3]); }
        const float rstd = rsqrtf(wave_sum(s2) * (1.0f / 1024.0f) + LN_EPS);
#pragma unroll
        for (int jx = 0; jx < 4; ++jx) { const int c = lane * 4 + 256 * jx; const f32x4 g = *(const f32x4*)(P.ln2_g + c), bb = *(const f32x4*)(P.ln2_b + c);
            *(f32x4*)(xr + 256 * jx) = v[jx] * rstd * g + bb; }
    }
}


#define XB_TMO      128
#define XB_XCNT(j)  (256  + 64 * (j))
#define XB_XSUB(j)  (1280 + 64 * (j))
#define XB_XGEN(j)  (2304 + 64 * (j))
#define XB_TOP      3328
#define XB_TOPGEN   3392
#define XCD_BAR_WORDS 3456
#define XB_SPIN_CAP (1u << 22)
__device__ __forceinline__ unsigned xb_ld(unsigned* p)              { return __hip_atomic_load(p, __ATOMIC_RELAXED, __HIP_MEMORY_SCOPE_AGENT); }
__device__ __forceinline__ unsigned xb_add(unsigned* p, unsigned v) { return __hip_atomic_fetch_add(p, v, __ATOMIC_RELAXED, __HIP_MEMORY_SCOPE_AGENT); }
#define XB_SPIN(cond, bar) do { unsigned _sp = 0; while (cond) { __builtin_amdgcn_s_sleep(1); \
    if ((++_sp & 255u) == 0u) { if (xb_ld(&(bar)[XB_TMO])) break; if (_sp > XB_SPIN_CAP) { atomicAdd(&(bar)[XB_TMO], 1u); break; } } } } while (0)
struct XcdBarrier { unsigned* bar; unsigned x; volatile LAS unsigned* st; };
__device__ __forceinline__ XcdBarrier xcd_barrier_post(unsigned* bar, volatile LAS unsigned* st) {
    XcdBarrier b; b.bar = bar; b.x = xcc_id(); b.st = st;
    if (threadIdx.x == 0) (void)xb_add(&bar[XB_XCNT(b.x)], 1u);
    return b;
}
__device__ __forceinline__ void xcd_barrier_complete(unsigned* bar, unsigned x, unsigned& nloc, unsigned& nx) {
    const unsigned G = gridDim.x * gridDim.y * gridDim.z;
    unsigned sum, cnt, mine, sp = 0u;
    for (;;) {
        sum = 0u; cnt = 0u; mine = 0u;
#pragma unroll
        for (unsigned j = 0; j < 16; ++j) { const unsigned c = xb_ld(&bar[XB_XCNT(j)]); sum += c; cnt += (c > 0u) ? 1u : 0u; mine = (j == x) ? c : mine; }
        if (sum == G) break;
        __builtin_amdgcn_s_sleep(1);
        if ((++sp & 255u) == 0u) { if (xb_ld(&bar[XB_TMO])) break; if (sp > XB_SPIN_CAP) { atomicAdd(&bar[XB_TMO], 1u); break; } }
    }
    nloc = mine > 0u ? mine : 1u; nx = cnt > 0u ? cnt : 1u;
}
__device__ __forceinline__ void xcd_barrier(const XcdBarrier& b) {
    asm volatile("s_waitcnt vmcnt(0)" ::: "memory");
    __syncthreads();
    if (threadIdx.x == 0) {
        unsigned* bar = b.bar;
        __builtin_amdgcn_s_waitcnt(0);
        unsigned nloc = b.st[0], nx = b.st[1];
        if (nloc == 0u) { xcd_barrier_complete(bar, b.x, nloc, nx); b.st[0] = nloc; b.st[1] = nx; }
        const unsigned old = xb_add(&bar[XB_XSUB(b.x)], 1u);
        const unsigned gen = old / nloc;
        if (old + 1u == (gen + 1u) * nloc) {
            __builtin_amdgcn_fence(__ATOMIC_RELEASE, "agent");
            asm volatile("s_waitcnt vmcnt(0)" ::: "memory");
            const unsigned og = xb_add(&bar[XB_TOP], 1u);
            const unsigned tg = og / nx;
            if (og + 1u == (tg + 1u) * nx) xb_add(&bar[XB_TOPGEN], 1u);
            else XB_SPIN(xb_ld(&bar[XB_TOPGEN]) == tg, bar);
            __builtin_amdgcn_fence(__ATOMIC_ACQUIRE, "agent");
            xb_add(&bar[XB_XGEN(b.x)], 1u);
            asm volatile("s_waitcnt vmcnt(0)" ::: "memory");
        } else {
            XB_SPIN(xb_ld(&bar[XB_XGEN(b.x)]) == gen, bar);
            __builtin_amdgcn_fence(__ATOMIC_ACQUIRE, "agent");
            asm volatile("s_waitcnt vmcnt(0)" ::: "memory");
        }
    }
    __syncthreads();
}

__global__ void __launch_bounds__(NTHR, 2) fwd_megakernel(Params P) {
    extern __shared__ __attribute__((aligned(16))) unsigned char shm[];
    LAS unsigned char* lds = (LAS unsigned char*)shm;
    cg::grid_group grid = cg::this_grid();
    const int G = gridDim.x, bid = blockIdx.x;
    volatile LAS unsigned* xst = (volatile LAS unsigned*)(lds + LDS_BYTES - 128);
    if (threadIdx.x == 0) { xst[0] = 0u; xst[1] = 0u; }
    __syncthreads();
    const XcdBarrier xb = xcd_barrier_post((unsigned*)(P.ws + OFF_BAR), xst);

#ifndef P3
#define P3 0xff
#endif
#ifndef PH
#define PH 0xff
#endif
    if (PH & 1) phase0a(P, lds);
    grid.sync();
    if (PH & 2) phase0b(P);
    xcd_barrier(xb);
    if (PH & 4) {
        pg8::Gemm g; g.A = (const bf16_t*)(P.ws + OFF_H); g.Bt = (const bf16_t*)(P.ws + OFF_WIN); g.M = NTOK; g.N = INCOLS; g.K = 1024;
        pg8::StaticOrder S; S.init(NTOK, INCOLS, G, bid);
        EpiProj E; E.ws = P.ws; E.lb = (const float*)(P.ws + OFF_LB); E.ng = P.hgrn_ng; E.kmean = (float*)(P.ws + OFF_KMEAN);
        pg8::gemm_phase<EpiProj, pg8::StaticOrder>(lds, g, S, E);
    }
    xcd_barrier(xb);
    if (PH & 8) for (int it = bid; it < 256; it += G) hgrn_item(P, it, lds);
    if (PH & 16) for (int u = bid; u < 2048; u += G) { const int bh = u & 255, jj = u >> 8; moba_unit(P, bh >> 3, bh & 7, (jj + bh) & 7, lds); }
    xcd_barrier(xb);
    if (PH & 32) for (int pm = bid; pm < NTOK / 256; pm += G) {
        if (P3 & 1) yb_norm_panel(P, pm);
        __syncthreads();
        if (P3 & 2) { pg8::Gemm g; g.A = (const bf16_t*)(P.ws + OFF_QA); g.Bt = (const bf16_t*)(P.ws + OFF_WBA); g.M = NTOK; g.N = 1024; g.K = 512;
          pg8::PanelOrder S; S.pm = pm; S.npn = 4; EpiMixA E; E.GA = (bf16_t*)(P.ws + OFF_GA);
          pg8::gemm_phase<EpiMixA, pg8::PanelOrder>(lds, g, S, E); }
        __syncthreads();
        if (P3 & 4) { pg8::Gemm g; g.A = (const bf16_t*)(P.ws + OFF_HI); g.Bt = (const bf16_t*)(P.ws + OFF_WBB); g.M = NTOK; g.N = 1024; g.K = 512;
          pg8::PanelOrder S; S.pm = pm; S.npn = 4; EpiMixB E; E.GA = (bf16_t*)(P.ws + OFF_GA); E.GB = (const bf16_t*)(P.ws + OFF_GB);
          pg8::gemm_phase<EpiMixB, pg8::PanelOrder>(lds, g, S, E); }
        __syncthreads();
        if (P3 & 8) { pg8::Gemm g; g.A = (const bf16_t*)(P.ws + OFF_GA); g.Bt = (const bf16_t*)(P.ws + OFF_WOUT); g.M = NTOK; g.N = 1024; g.K = 1024;
          pg8::PanelOrder S; S.pm = pm; S.npn = 4; EpiOut E; E.x = P.x; E.ada = (const float*)(P.ws + OFF_ADA); E.out = P.out;
          pg8::gemm_phase<EpiOut, pg8::PanelOrder>(lds, g, S, E); }
        __syncthreads();
        if (P3 & 16) ln1_panel(P, pm);
        __syncthreads();
        if (P3 & 32) { pg8::Gemm g; g.A = (const bf16_t*)(P.ws + OFF_H); g.Bt = (const bf16_t*)(P.ws + OFF_WQ); g.M = NTOK; g.N = 1024; g.K = 1024;
          pg8::PanelOrder S; S.pm = pm; S.npn = 4; EpiBf16 E; E.O = (bf16_t*)(P.ws + OFF_GB);
          pg8::gemm_phase<EpiBf16, pg8::PanelOrder>(lds, g, S, E); }
        __syncthreads();
        { const size_t tok0 = (size_t)pm * 256 + (tid_opaque() >> 6) * 32;
          peer_select_wave(P, tok0); }
        __syncthreads();
    }
    xcd_barrier(xb);
    partition_queue(P, lds, 0, [&](int p, int chunk) { peer_u_chunk(P, lds, p, chunk); });
    xcd_barrier(xb);
    partition_queue(P, lds, 8, [&](int x, int chunk) { peer_v_chunk(P, lds, x, chunk); });
    xcd_barrier(xb);
    ln2_phase(P);
}

extern "C" void kernel_launch(void* const* d_in, const int* in_sizes, int n_in, void* d_out, int out_size, void* d_ws, size_t ws_size, hipStream_t stream) {
    static int grid_blocks = 0;
    if (grid_blocks == 0) {
        if (n_in != 18 || out_size != NTOK * DM || ws_size < WS_END) { fprintf(stderr, "kernel_launch: unexpected shapes (n_in %d, out %d, ws %zu, need %zu)\n", n_in, out_size, ws_size, (size_t)WS_END); grid_blocks = -1; return; }
        int dev = 0, cus = 0, per_cu = 0;
        hipGetDevice(&dev);
        hipDeviceGetAttribute(&cus, hipDeviceAttributeMultiprocessorCount, dev);
        if (hipFuncSetAttribute((const void*)fwd_megakernel, hipFuncAttributeMaxDynamicSharedMemorySize, LDS_BYTES) != hipSuccess) fprintf(stderr, "kernel_launch: hipFuncSetAttribute failed\n");
        hipOccupancyMaxActiveBlocksPerMultiprocessor(&per_cu, (const void*)fwd_megakernel, NTHR, LDS_BYTES);
        if (per_cu < 1) { fprintf(stderr, "kernel_launch: occupancy query says %d blocks per CU\n", per_cu); per_cu = 1; }
        if (per_cu > 1) per_cu = 1;
        grid_blocks = cus * per_cu;
        (void)hipGetLastError();
    }
    if (grid_blocks < 0) return;
    Params p{};
    p.x = (const float*)d_in[0]; p.c = (const float*)d_in[1]; p.w_ada = (const float*)d_in[2]; p.b_ada = (const float*)d_in[3]; p.w_in = (const float*)d_in[4];
    p.w_ba = (const float*)d_in[5]; p.w_bb = (const float*)d_in[6]; p.w_out = (const float*)d_in[7]; p.hgrn_lb = (const float*)d_in[8]; p.hgrn_ng = (const float*)d_in[9];
    p.ln1_g = (const float*)d_in[10]; p.ln1_b = (const float*)d_in[11]; p.peer_wq = (const float*)d_in[12]; p.peer_sk = (const float*)d_in[13]; p.peer_u = (const float*)d_in[14];
    p.peer_v = (const float*)d_in[15]; p.ln2_g = (const float*)d_in[16]; p.ln2_b = (const float*)d_in[17];
    p.out = (float*)d_out; p.ws = (unsigned char*)d_ws;
    if (hipMemsetAsync((char*)d_ws + OFF_BAR, 0, XCD_BAR_WORDS * 4, stream) != hipSuccess) fprintf(stderr, "kernel_launch: memset of the barrier words failed\n");
    void* args[] = {&p};
    hipError_t e = hipLaunchCooperativeKernel((const void*)fwd_megakernel, dim3(grid_blocks), dim3(NTHR), args, LDS_BYTES, stream);
    if (e != hipSuccess) fprintf(stderr, "cooperative launch failed: %s (grid %d)\n", hipGetErrorString(e), grid_blocks);
}
```

```cpp
#include <hip/hip_runtime.h>
#include <hip/hip_cooperative_groups.h>
#include <cstdio>
#include <cstdint>
namespace cg = cooperative_groups;

#define LAS __attribute__((address_space(3)))
typedef unsigned short bf16_t;
typedef short bf16x8 __attribute__((ext_vector_type(8)));
typedef short s16x4 __attribute__((ext_vector_type(4)));
typedef float f32x2 __attribute__((ext_vector_type(2)));
typedef float f32x4 __attribute__((ext_vector_type(4)));
typedef float f32x16 __attribute__((ext_vector_type(16)));
typedef unsigned u32x2 __attribute__((ext_vector_type(2)));
typedef unsigned u32x4 __attribute__((ext_vector_type(4)));

constexpr int NB = 32, SEQ = 2048, DM = 1024, NTOK = NB * SEQ;
constexpr int INCOLS = 5632;
constexpr int NTHR = 512;
constexpr int LDS_BYTES = 147456;
constexpr float ALPHA = 1.189207115002721f;
constexpr float LN_EPS = 1e-5f, RMS_EPS = 1e-6f;
constexpr float LOG2E = 1.4426950408889634f;

constexpr size_t SZ_T512 = (size_t)NTOK * 512 * 2, SZ_T1024 = (size_t)NTOK * 1024 * 2;
constexpr size_t OFF_ADA = 0;
constexpr size_t OFF_LB = OFF_ADA + 786432;
constexpr size_t OFF_KMEAN = OFF_LB + 4096;
constexpr size_t OFF_WIN = OFF_KMEAN + 524288;
constexpr size_t OFF_WBA = OFF_WIN + (size_t)5632 * 1024 * 2;
constexpr size_t OFF_WBB = OFF_WBA + 1048576;
constexpr size_t OFF_WOUT = OFF_WBB + 1048576;
constexpr size_t OFF_WQ = OFF_WOUT + 2097152;
constexpr size_t OFF_SK = OFF_WQ + 2097152;
constexpr size_t OFF_U8 = OFF_SK + 262144;
constexpr size_t OFF_V8 = OFF_U8 + 16777216;
constexpr size_t OFF_CTR = OFF_V8 + 16777216;
constexpr size_t OFF_BAR = OFF_CTR + 4096;
constexpr size_t OFF_EG = OFF_BAR + 16384;
constexpr size_t OFF_H = OFF_EG + (size_t)NTOK * 128 * 8;
constexpr size_t OFF_QA = OFF_H + SZ_T1024;
constexpr size_t OFF_KA = OFF_QA + SZ_T512;
constexpr size_t OFF_VA = OFF_KA + SZ_T512;
constexpr size_t OFF_HQ = OFF_VA + SZ_T512;
constexpr size_t OFF_HK = OFF_HQ + SZ_T512;
constexpr size_t OFF_HI = OFF_HK + SZ_T512;
constexpr size_t OFF_HG = OFF_HI + SZ_T512;
constexpr size_t OFF_GA = OFF_HG + SZ_T512;
constexpr size_t OFF_GB = OFF_GA + SZ_T1024;
constexpr size_t WS_END = OFF_GB + SZ_T1024;
constexpr size_t OFF_W = OFF_QA;
constexpr size_t OFF_Y = OFF_KA;

struct Params {
    const float *x, *c, *w_ada, *b_ada, *w_in, *w_ba, *w_bb, *w_out, *hgrn_lb, *hgrn_ng, *ln1_g, *ln1_b, *peer_wq, *peer_sk, *peer_u, *peer_v, *ln2_g, *ln2_b;
    float* out;
    unsigned char* ws;
};

typedef __bf16 bf16v2 __attribute__((ext_vector_type(2)));
__device__ __forceinline__ unsigned cvt_pk_bf16(float lo, float hi) { return __builtin_bit_cast(unsigned, __builtin_convertvector((f32x2){lo, hi}, bf16v2)); }
__device__ __forceinline__ float bf_lo(unsigned w) { return __uint_as_float(w << 16); }
__device__ __forceinline__ float bf_hi(unsigned w) { return __uint_as_float(w & 0xffff0000u); }
__device__ __forceinline__ float sigmoidf_(float x) { return 1.0f / (1.0f + __expf(-x)); }
__device__ __forceinline__ float wave_sum(float v) {
#pragma unroll
    for (int o = 1; o < 64; o <<= 1) v += __shfl_xor(v, o);
    return v;
}
__device__ __forceinline__ int tid_opaque() { int t = threadIdx.x; asm volatile("" : "+v"(t)); return t; }
__device__ __forceinline__ int crow(int r, int hi) { return (r & 3) + 8 * (r >> 2) + 4 * hi; }
#define MFMA32(a, b, c) __builtin_amdgcn_mfma_f32_32x32x16_bf16(a, b, c, 0, 0, 0)

namespace pg8 {
constexpr int BM = 256, BK = 64, HALF = 128, HTB = HALF * BK * 2, STAGE_BYTES = 8 * HTB, NXCD = 8, WGM = 8;
__host__ __device__ __forceinline__ int lds_byte(int r, int c) { const int st = (r >> 4) * 2 + (c >> 5), rr = r & 15, cc = c & 31, ob = rr * 64 + cc * 2; return st * 1024 + (ob ^ (((ob >> 9) & 1) << 5)); }
__host__ __device__ __forceinline__ void stage_rc(int b, int& R, int& C) { const int st = b / 1024, sb = b % 1024, swz = sb ^ (((sb >> 9) & 1) << 5); R = (st >> 1) * 16 + swz / 64; C = (st & 1) * 32 + (swz % 64) / 2; }
__host__ __device__ __forceinline__ int perm32(int rho) { const int n = rho >> 4, i = rho & 15; return 8 * (i >> 2) + 4 * n + (i & 3); }

struct Unit { int pm, pn; };
struct Gemm { const bf16_t* A; const bf16_t* Bt; int M, N, K; };

struct StaticOrder {
    int nM, nN, nwg, G, c;
    __device__ void init(int M, int N, int G_, int c_) { nM = M / BM; nN = N / BM; nwg = nM * nN; G = G_; c = c_; }
    __device__ bool next(int i, Unit& u) const {
        const long L = (long)i * G + c; if (L >= nwg) return false;
        int wgid = (int)L; { const int q = nwg / NXCD, r = nwg % NXCD, xcd = wgid % NXCD, off = wgid / NXCD; wgid = (xcd < r ? xcd * (q + 1) : r * (q + 1) + (xcd - r) * q) + off; }
        const int nig = WGM * nN, gid = wgid / nig, fm = gid * WGM, gsz = (nM - fm) < WGM ? (nM - fm) : WGM;
        u.pm = fm + ((wgid % nig) % gsz); u.pn = (wgid % nig) / gsz; return true;
    }
};
struct PanelOrder {
    int pm, npn;
    __device__ bool next(int i, Unit& u) const { if (i >= npn) return false; u.pm = pm; u.pn = i; return true; }
};

template <class Epi, class Sched>
__device__ __forceinline__ void gemm_phase(LAS unsigned char* lds, const Gemm g, const Sched& S, const Epi& E) {
    const int tid = tid_opaque(), wid = __builtin_amdgcn_readfirstlane(tid >> 6), lane = tid & 63, wr = wid >> 2, wc = wid & 3, fr = lane & 15, fq = lane >> 4;
    const int K = g.K, nt = K / BK;
    unsigned voffA[2], voffB[2];
#pragma unroll
    for (int i = 0; i < 2; ++i) { int R, C; stage_rc(tid * 16 + i * 8192, R, C); const int Rb = Epi::PERM ? ((R & ~31) + perm32(R & 31)) : R;
        voffA[i] = (unsigned)(R * K + C) * 2u; voffB[i] = (unsigned)(Rb * K + C) * 2u; }
    const size_t kstep = (size_t)(BK * 2);
    const size_t hstep = (size_t)HALF * K * 2;
    const size_t tstep = 2 * hstep;
    const unsigned ldsw = (unsigned)wid * 1024u;
    const int aoff = lds_byte(wr * 64 + fr, fq * 8), boff = lds_byte(wc * 32 + fr, fq * 8);
#define PG8_SA(b, h) (((b) * 2 + (h)) * HTB)
#define PG8_SB(b, h) ((4 + (b) * 2 + (h)) * HTB)
#define PG8_STAGE(bufoff, gbase, voff) do { _Pragma("unroll") for (int _i = 0; _i < 2; ++_i) \
        __builtin_amdgcn_global_load_lds((const unsigned*)((const char*)(gbase) + (voff)[_i]), (LAS unsigned*)(lds + (bufoff) + ldsw + _i * 8192), 16, 0, 0); } while (0)
#define PG8_LDA(dst, b, h) do { _Pragma("unroll") for (int m = 0; m < 4; ++m) _Pragma("unroll") for (int k = 0; k < 2; ++k) dst[m][k] = *(const LAS bf16x8*)(lds + PG8_SA(b, h) + aoff + m * 2048 + k * 1024); } while (0)
#define PG8_LDB(dst, b, h) do { _Pragma("unroll") for (int n = 0; n < 2; ++n) _Pragma("unroll") for (int k = 0; k < 2; ++k) dst[n][k] = *(const LAS bf16x8*)(lds + PG8_SB(b, h) + boff + n * 2048 + k * 1024); } while (0)
#define PG8_MMA(ai, bj, At, Bt) do { __builtin_amdgcn_s_setprio(1); _Pragma("unroll") for (int m = 0; m < 4; ++m) _Pragma("unroll") for (int n = 0; n < 2; ++n) _Pragma("unroll") for (int k = 0; k < 2; ++k) \
        acc[ai][bj][m][n] = __builtin_amdgcn_mfma_f32_16x16x32_bf16(Bt[n][k], At[m][k], acc[ai][bj][m][n], 0, 0, 0); __builtin_amdgcn_s_setprio(0); } while (0)
#define PG8_WAIT_V(n) asm volatile("s_waitcnt vmcnt(" #n ")" ::: "memory")
#define PG8_WAIT_L(n) asm volatile("s_waitcnt lgkmcnt(" #n ")" ::: "memory")
#define PG8_BAR __builtin_amdgcn_s_barrier()
#define PG8_SCHED __builtin_amdgcn_sched_barrier(0)
    Unit cur, nxt; int ui = 0;
    if (!S.next(0, cur)) return;
    f32x4 acc[2][2][4][2];
#pragma unroll
    for (int a = 0; a < 2; ++a)
#pragma unroll
        for (int b = 0; b < 2; ++b)
#pragma unroll
            for (int m = 0; m < 4; ++m)
#pragma unroll
                for (int n = 0; n < 2; ++n) acc[a][b][m][n] = (f32x4){0.f, 0.f, 0.f, 0.f};
    bf16x8 At[4][2], B0[2][2], B1[2][2];
    const char* cA = (const char*)g.A + (size_t)cur.pm * tstep; const char* cB = (const char*)g.Bt + (size_t)cur.pn * tstep;
    PG8_STAGE(PG8_SB(0, 0), cB, voffB); PG8_STAGE(PG8_SA(0, 0), cA, voffA); PG8_STAGE(PG8_SB(0, 1), cB + hstep, voffB); PG8_STAGE(PG8_SA(0, 1), cA + hstep, voffA);
    if (wr == 1) PG8_BAR;
    PG8_WAIT_V(4); PG8_BAR;
    PG8_STAGE(PG8_SB(1, 0), cB + kstep, voffB); PG8_STAGE(PG8_SA(1, 0), cA + kstep, voffA); PG8_STAGE(PG8_SB(1, 1), cB + hstep + kstep, voffB);
    PG8_WAIT_V(6); PG8_BAR;
    for (;;) {
        const bool has_next = S.next(ui + 1, nxt);
        const char* nA = has_next ? (const char*)g.A + (size_t)nxt.pm * tstep : cA; const char* nB = has_next ? (const char*)g.Bt + (size_t)nxt.pn * tstep : cB;
        for (int t = 0; t < nt; t += 2) {
            const bool last = (t == nt - 2);
            const char* a1 = cA + (size_t)(t + 1) * kstep;
            const char* a2 = last ? nA : cA + (size_t)(t + 2) * kstep; const char* b2 = last ? nB : cB + (size_t)(t + 2) * kstep;
            const char* a3 = a2 + kstep; const char* b3 = b2 + kstep;
            PG8_LDB(B0, 0, 0); PG8_SCHED; PG8_LDA(At, 0, 0); PG8_STAGE(PG8_SA(1, 1), a1 + hstep, voffA);
            PG8_WAIT_L(8); PG8_BAR; PG8_WAIT_L(0); PG8_MMA(0, 0, At, B0); PG8_BAR; PG8_SCHED;
            PG8_LDB(B1, 0, 1); PG8_STAGE(PG8_SB(0, 0), b2, voffB);
            PG8_BAR; PG8_WAIT_L(0); PG8_MMA(0, 1, At, B1); PG8_BAR;
            PG8_LDA(At, 0, 1); PG8_STAGE(PG8_SA(0, 0), a2, voffA);
            PG8_BAR; PG8_WAIT_L(0); PG8_MMA(1, 0, At, B0); PG8_BAR; PG8_SCHED;
            PG8_STAGE(PG8_SB(0, 1), b2 + hstep, voffB);
            PG8_WAIT_V(6); PG8_BAR; PG8_MMA(1, 1, At, B1); PG8_BAR;
            PG8_LDB(B0, 1, 0); PG8_SCHED; PG8_LDA(At, 1, 0); PG8_STAGE(PG8_SA(0, 1), a2 + hstep, voffA);
            PG8_WAIT_L(8); PG8_BAR; PG8_WAIT_L(0); PG8_MMA(0, 0, At, B0); PG8_BAR; PG8_SCHED;
            PG8_LDB(B1, 1, 1); PG8_STAGE(PG8_SB(1, 0), b3, voffB);
            PG8_BAR; PG8_WAIT_L(0); PG8_MMA(0, 1, At, B1); PG8_BAR;
            PG8_LDA(At, 1, 1); PG8_STAGE(PG8_SA(1, 0), a3, voffA);
            PG8_BAR; PG8_WAIT_L(0); PG8_MMA(1, 0, At, B0); PG8_BAR; PG8_SCHED;
            PG8_STAGE(PG8_SB(1, 1), b3 + hstep, voffB);
            PG8_WAIT_V(6); PG8_BAR; PG8_MMA(1, 1, At, B1); PG8_BAR;
        }
        E(acc, cur, wr, wc, fr, fq);
        if (!has_next) break;
#pragma unroll
        for (int a = 0; a < 2; ++a)
#pragma unroll
            for (int b = 0; b < 2; ++b)
#pragma unroll
                for (int m = 0; m < 4; ++m)
#pragma unroll
                    for (int n = 0; n < 2; ++n) acc[a][b][m][n] = (f32x4){0.f, 0.f, 0.f, 0.f};
        cur = nxt; cA = nA; cB = nB; ++ui;
    }
    PG8_WAIT_V(0);
    if (wr == 0) PG8_BAR;
    PG8_BAR;
#undef PG8_SA
#undef PG8_SB
#undef PG8_STAGE
#undef PG8_LDA
#undef PG8_LDB
#undef PG8_MMA
#undef PG8_WAIT_V
#undef PG8_WAIT_L
#undef PG8_BAR
#undef PG8_SCHED
}
}
using pg8::Unit;

struct EpiProj {
    static constexpr bool PERM = true;
    unsigned char* ws; const float* lb; const float* ng; float* kmean;
    __device__ __forceinline__ void operator()(const f32x4 (&acc)[2][2][4][2], const Unit& u, int wr, int wc, int fr, int fq) const {
        const int pn = u.pn; int seg, colt, ldc; size_t boff;
        if (pn < 14) { seg = pn >> 1; colt = (pn & 1) * 256; ldc = 512; boff = OFF_QA + (size_t)seg * SZ_T512; }
        else if (pn < 18) { seg = 7; colt = (pn - 14) * 256; ldc = 1024; boff = OFF_GA; }
        else { seg = 8; colt = (pn - 18) * 256; ldc = 1024; boff = OFF_GB; }
        bf16_t* base = (bf16_t*)(ws + boff);
        const int row0 = u.pm * 256 + wr * 64 + fr, col0 = colt + wc * 32 + 8 * fq;
        float pv[2][8];
#pragma unroll
        for (int bj = 0; bj < 2; ++bj)
#pragma unroll
            for (int e = 0; e < 8; ++e) pv[bj][e] = (seg == 4) ? (1.0f - lb[col0 + bj * 128 + e]) : ((seg == 6) ? ng[col0 + bj * 128 + e] : 0.f);
        float cs[2][8];
#pragma unroll
        for (int bj = 0; bj < 2; ++bj)
#pragma unroll
            for (int e = 0; e < 8; ++e) cs[bj][e] = 0.f;
#pragma unroll
        for (int ai = 0; ai < 2; ++ai)
#pragma unroll
            for (int m = 0; m < 4; ++m) {
                bf16_t* rowp = base + (size_t)(row0 + ai * 128 + m * 16) * ldc + col0;
#pragma unroll
                for (int bj = 0; bj < 2; ++bj) {
                    float v[8];
#pragma unroll
                    for (int e = 0; e < 4; ++e) { v[e] = acc[ai][bj][m][0][e]; v[4 + e] = acc[ai][bj][m][1][e]; }
                    if (seg == 0) {
#pragma unroll
                        for (int e = 0; e < 8; ++e) v[e] *= (0.125f * LOG2E);
                    } else if (seg == 1) {
#pragma unroll
                        for (int e = 0; e < 8; ++e) cs[bj][e] += v[e];
                    } else if (seg == 3) {
#pragma unroll
                        for (int e = 0; e < 8; ++e) v[e] = v[e] * sigmoidf_(v[e]);
                    } else if (seg == 4) {
#pragma unroll
                        for (int e = 0; e < 8; ++e) v[e] = pv[bj][e] * sigmoidf_(-v[e]);
                    } else if (seg == 6) {
#pragma unroll
                        for (int e = 0; e < 8; ++e) v[e] = pv[bj][e] * v[e] * sigmoidf_(v[e]);
                    } else if (seg >= 7) {
#pragma unroll
                        for (int e = 0; e < 8; ++e) v[e] = sigmoidf_(v[e]);
                    }
                    u32x4 w; w.x = cvt_pk_bf16(v[0], v[1]); w.y = cvt_pk_bf16(v[2], v[3]); w.z = cvt_pk_bf16(v[4], v[5]); w.w = cvt_pk_bf16(v[6], v[7]);
                    *(u32x4*)(rowp + bj * 128) = w;
                }
            }
        if (seg == 1) {
#pragma unroll
            for (int bj = 0; bj < 2; ++bj)
#pragma unroll
                for (int e = 0; e < 8; ++e) {
                    float s = cs[bj][e];
                    s += __shfl_xor(s, 1); s += __shfl_xor(s, 2); s += __shfl_xor(s, 4); s += __shfl_xor(s, 8);
                    if (fr == 0) atomicAdd(kmean + (size_t)u.pm * 512 + col0 + bj * 128 + e, s);
                }
        }
    }
};
struct EpiMixA {
    static constexpr bool PERM = true;
    bf16_t* GA;
    __device__ __forceinline__ void operator()(const f32x4 (&acc)[2][2][4][2], const Unit& u, int wr, int wc, int fr, int fq) const {
        const int row0 = u.pm * 256 + wr * 64 + fr, col0 = u.pn * 256 + wc * 32 + 8 * fq;
#pragma unroll
        for (int ai = 0; ai < 2; ++ai)
#pragma unroll
            for (int m = 0; m < 4; ++m) {
                bf16_t* rowp = GA + (size_t)(row0 + ai * 128 + m * 16) * 1024 + col0;
#pragma unroll
                for (int bj = 0; bj < 2; ++bj) {
                    const u32x4 g = *(const u32x4*)(rowp + bj * 128);
                    const f32x4 a0 = acc[ai][bj][m][0], a1 = acc[ai][bj][m][1];
                    u32x4 w;
                    w.x = cvt_pk_bf16(bf_lo(g.x) * a0[0], bf_hi(g.x) * a0[1]); w.y = cvt_pk_bf16(bf_lo(g.y) * a0[2], bf_hi(g.y) * a0[3]);
                    w.z = cvt_pk_bf16(bf_lo(g.z) * a1[0], bf_hi(g.z) * a1[1]); w.w = cvt_pk_bf16(bf_lo(g.w) * a1[2], bf_hi(g.w) * a1[3]);
                    *(u32x4*)(rowp + bj * 128) = w;
                }
            }
    }
};
struct EpiMixB {
    static constexpr bool PERM = true;
    bf16_t* GA; const bf16_t* GB;
    __device__ __forceinline__ void operator()(const f32x4 (&acc)[2][2][4][2], const Unit& u, int wr, int wc, int fr, int fq) const {
        const int row0 = u.pm * 256 + wr * 64 + fr, col0 = u.pn * 256 + wc * 32 + 8 * fq;
#pragma unroll
        for (int ai = 0; ai < 2; ++ai)
#pragma unroll
            for (int m = 0; m < 4; ++m) {
                const size_t off = (size_t)(row0 + ai * 128 + m * 16) * 1024 + col0;
#pragma unroll
                for (int bj = 0; bj < 2; ++bj) {
                    const u32x4 g = *(const u32x4*)(GB + off + bj * 128);
                    const u32x4 mx = *(const u32x4*)(GA + off + bj * 128);
                    const f32x4 a0 = acc[ai][bj][m][0], a1 = acc[ai][bj][m][1];
                    u32x4 w;
                    w.x = cvt_pk_bf16(bf_lo(mx.x) + bf_lo(g.x) * a0[0], bf_hi(mx.x) + bf_hi(g.x) * a0[1]); w.y = cvt_pk_bf16(bf_lo(mx.y) + bf_lo(g.y) * a0[2], bf_hi(mx.y) + bf_hi(g.y) * a0[3]);
                    w.z = cvt_pk_bf16(bf_lo(mx.z) + bf_lo(g.z) * a1[0], bf_hi(mx.z) + bf_hi(g.z) * a1[1]); w.w = cvt_pk_bf16(bf_lo(mx.w) + bf_lo(g.w) * a1[2], bf_hi(mx.w) + bf_hi(g.w) * a1[3]);
                    *(u32x4*)(GA + off + bj * 128) = w;
                }
            }
    }
};
struct EpiOut {
    static constexpr bool PERM = false;
    const float* x; const float* ada; float* out;
    __device__ __forceinline__ void operator()(const f32x4 (&acc)[2][2][4][2], const Unit& u, int wr, int wc, int fr, int fq) const {
        const int row0 = u.pm * 256 + wr * 64 + fr, col0 = u.pn * 256 + wc * 32 + 4 * fq;
        const float* gt1 = ada + (size_t)(u.pm >> 3) * 6144 + 2048;
#pragma unroll
        for (int ai = 0; ai < 2; ++ai)
#pragma unroll
            for (int m = 0; m < 4; ++m) {
                const size_t off = (size_t)(row0 + ai * 128 + m * 16) * 1024 + col0;
#pragma unroll
                for (int bj = 0; bj < 2; ++bj)
#pragma unroll
                    for (int n = 0; n < 2; ++n) {
                        const int cc = bj * 128 + n * 16;
                        const f32x4 xv = *(const f32x4*)(x + off + cc), gv = *(const f32x4*)(gt1 + col0 + cc);
                        *(f32x4*)(out + off + cc) = xv * ALPHA + gv * acc[ai][bj][m][n];
                    }
            }
    }
};
struct EpiBf16 {
    static constexpr bool PERM = true;
    bf16_t* O;
    __device__ __forceinline__ void operator()(const f32x4 (&acc)[2][2][4][2], const Unit& u, int wr, int wc, int fr, int fq) const {
        const int row0 = u.pm * 256 + wr * 64 + fr, col0 = u.pn * 256 + wc * 32 + 8 * fq;
#pragma unroll
        for (int ai = 0; ai < 2; ++ai)
#pragma unroll
            for (int m = 0; m < 4; ++m) {
                bf16_t* rowp = O + (size_t)(row0 + ai * 128 + m * 16) * 1024 + col0;
#pragma unroll
                for (int bj = 0; bj < 2; ++bj) {
                    const f32x4 a0 = acc[ai][bj][m][0], a1 = acc[ai][bj][m][1];
                    u32x4 w; w.x = cvt_pk_bf16(a0[0], a0[1]); w.y = cvt_pk_bf16(a0[2], a0[3]); w.z = cvt_pk_bf16(a1[0], a1[1]); w.w = cvt_pk_bf16(a1[2], a1[3]);
                    *(u32x4*)(rowp + bj * 128) = w;
                }
            }
    }
};

__device__ void phase0a(const Params& P, LAS unsigned char* lds) {
    const int tid = tid_opaque(), G = gridDim.x, bid = blockIdx.x;
    for (int it = bid; it < 192; it += G) {
        LAS float* sc = (LAS float*)lds;
        for (int i = tid; i < 32 * 1024; i += NTHR) { const float cv = P.c[i]; sc[i] = cv * sigmoidf_(cv); }
        __syncthreads();
        const int kg = tid >> 5, col = tid & 31;
        float a[32];
#pragma unroll
        for (int b = 0; b < 32; ++b) a[b] = 0.f;
#pragma unroll 1
        for (int k = kg * 64; k < kg * 64 + 64; k += 8) {
            float w[8];
#pragma unroll
            for (int e = 0; e < 8; ++e) w[e] = __builtin_nontemporal_load(P.w_ada + (size_t)(k + e) * 6144 + it * 32 + col);
#pragma unroll
            for (int e4 = 0; e4 < 2; ++e4) {
#pragma unroll
                for (int b = 0; b < 32; ++b) { const f32x4 s = *(const LAS f32x4*)(sc + b * 1024 + k + 4 * e4); a[b] += s[0] * w[4 * e4] + s[1] * w[4 * e4 + 1] + s[2] * w[4 * e4 + 2] + s[3] * w[4 * e4 + 3]; }
                asm volatile("" ::: "memory");
            }
        }
        __syncthreads();
        LAS float* red = (LAS float*)lds;
#pragma unroll
        for (int b = 0; b < 32; ++b) red[(kg * 32 + b) * 32 + col] = a[b];
        __syncthreads();
        for (int o = tid; o < 1024; o += NTHR) { const int b = o >> 5, cc = o & 31; float s = 0.f;
#pragma unroll
            for (int g2 = 0; g2 < 16; ++g2) s += red[(g2 * 32 + b) * 32 + cc];
            ((float*)(P.ws + OFF_ADA))[(size_t)b * 6144 + it * 32 + cc] = s + P.b_ada[it * 32 + cc]; }
        __syncthreads();
    }
    const size_t gtid = (size_t)bid * NTHR + tid, gsz = (size_t)G * NTHR;
    for (size_t i = gtid; i < 512; i += gsz) ((float*)(P.ws + OFF_LB))[i] = sigmoidf_(P.hgrn_lb[i] - P.hgrn_lb[512 + i]);
    for (size_t i = gtid; i < 32 * 8 * 512; i += gsz) ((float*)(P.ws + OFF_KMEAN))[i] = 0.f;
    {
        LAS float* tile = (LAS float*)lds;
        const int I0 = 16 * 88, I1 = I0 + 8 * 16, I2 = I1 + 8 * 16, I3 = I2 + 16 * 16, I4 = I3 + 16 * 16;
        for (int it = bid; it < I4; it += G) {
            const float* W; bf16_t* WT; int K, N, r;
            if (it < I0) { W = P.w_in; WT = (bf16_t*)(P.ws + OFF_WIN); K = 1024; N = 5632; r = it; }
            else if (it < I1) { W = P.w_ba; WT = (bf16_t*)(P.ws + OFF_WBA); K = 512; N = 1024; r = it - I0; }
            else if (it < I2) { W = P.w_bb; WT = (bf16_t*)(P.ws + OFF_WBB); K = 512; N = 1024; r = it - I1; }
            else if (it < I3) { W = P.w_out; WT = (bf16_t*)(P.ws + OFF_WOUT); K = 1024; N = 1024; r = it - I2; }
            else { W = P.peer_wq; WT = (bf16_t*)(P.ws + OFF_WQ); K = 1024; N = 1024; r = it - I3; }
            const int nb = N / 64, k0 = (r / nb) * 64, n0 = (r % nb) * 64;
#pragma unroll
            for (int ps = 0; ps < 2; ++ps) { const int kk = (tid >> 4) + 32 * ps, n4 = (tid & 15) * 4;
                const f32x4 v = *(const f32x4*)(W + (size_t)(k0 + kk) * N + n0 + n4);
                tile[kk * 65 + n4] = v[0]; tile[kk * 65 + n4 + 1] = v[1]; tile[kk * 65 + n4 + 2] = v[2]; tile[kk * 65 + n4 + 3] = v[3]; }
            __syncthreads();
            { const int n = tid >> 3, kc = (tid & 7) * 8; u32x4 w;
              w.x = cvt_pk_bf16(tile[(kc + 0) * 65 + n], tile[(kc + 1) * 65 + n]); w.y = cvt_pk_bf16(tile[(kc + 2) * 65 + n], tile[(kc + 3) * 65 + n]);
              w.z = cvt_pk_bf16(tile[(kc + 4) * 65 + n], tile[(kc + 5) * 65 + n]); w.w = cvt_pk_bf16(tile[(kc + 6) * 65 + n], tile[(kc + 7) * 65 + n]);
              *(u32x4*)(WT + (size_t)(n0 + n) * K + k0 + kc) = w; }
            __syncthreads();
        }
    }
    {
        if (gtid < 16) ((unsigned*)(P.ws + OFF_CTR))[gtid] = 0u;
        for (size_t i = gtid; i < 16384; i += gsz) {
            const float* src = P.peer_sk + i * 8; const f32x4 a = *(const f32x4*)src, b = *(const f32x4*)(src + 4);
            u32x4 w; w.x = cvt_pk_bf16(a[0], a[1]); w.y = cvt_pk_bf16(a[2], a[3]); w.z = cvt_pk_bf16(b[0], b[1]); w.w = cvt_pk_bf16(b[2], b[3]);
            *(u32x4*)((bf16_t*)(P.ws + OFF_SK) + i * 8) = w;
        }
        const size_t NV = (size_t)16384 * 1024 / 8;
        for (size_t i = gtid; i < 2 * NV; i += gsz) {
            const bool isv = i >= NV; const size_t j = isv ? i - NV : i;
            const float* src = (isv ? P.peer_v : P.peer_u) + j * 8; const float sc = isv ? 4.0f : 32.0f;
            const f32x4 a = *(const f32x4*)src * sc, b = *(const f32x4*)(src + 4) * sc;
            int w0 = __builtin_amdgcn_cvt_pk_fp8_f32(a[0], a[1], 0, false); w0 = __builtin_amdgcn_cvt_pk_fp8_f32(a[2], a[3], w0, true);
            int w1 = __builtin_amdgcn_cvt_pk_fp8_f32(b[0], b[1], 0, false); w1 = __builtin_amdgcn_cvt_pk_fp8_f32(b[2], b[3], w1, true);
            u32x2 w; w.x = (unsigned)w0; w.y = (unsigned)w1;
            size_t dst;
            if (!isv) dst = OFF_U8 + j * 8;
            else { const size_t e = j >> 7; const int d8 = (int)(j & 127) * 8; dst = OFF_V8 + ((size_t)(d8 >> 7) * 16384 + e) * 128 + (d8 & 127); }
            *(u32x2*)(P.ws + dst) = w;
        }
    }
}
__device__ void phase0b(const Params& P) {
    const size_t gtid = (size_t)blockIdx.x * NTHR + threadIdx.x, gsz = (size_t)gridDim.x * NTHR;
    const float* ada = (const float*)(P.ws + OFF_ADA); bf16_t* H = (bf16_t*)(P.ws + OFF_H);
    for (size_t i = gtid; i < (size_t)NTOK * 128; i += gsz) {
        const size_t row = i >> 7; const int c8 = (int)(i & 127) * 8; const int b = (int)(row >> 11);
        const float* xr = P.x + row * 1024 + c8; const float* sh = ada + (size_t)b * 6144 + c8; const float* sc = sh + 1024;
        const f32x4 x0 = *(const f32x4*)xr, x1 = *(const f32x4*)(xr + 4), s0 = *(const f32x4*)sc, s1 = *(const f32x4*)(sc + 4), h0 = *(const f32x4*)sh, h1 = *(const f32x4*)(sh + 4);
        const f32x4 r0 = x0 * (s0 + 1.0f) + h0, r1 = x1 * (s1 + 1.0f) + h1;
        u32x4 w; w.x = cvt_pk_bf16(r0[0], r0[1]); w.y = cvt_pk_bf16(r0[2], r0[3]); w.z = cvt_pk_bf16(r1[0], r1[1]); w.w = cvt_pk_bf16(r1[2], r1[3]);
        *(u32x4*)(H + row * 1024 + c8) = w;
    }
}

__device__ __forceinline__ s16x4 tr4(const LAS unsigned char* p) { return __builtin_bit_cast(s16x4, __builtin_amdgcn_ds_read_tr16_b64_v4i16((LAS s16x4*)p)); }
__device__ void hgrn_item(const Params& P, int item, LAS unsigned char* lds) {
    const int tid = tid_opaque(), lane = tid & 63, wid = __builtin_amdgcn_readfirstlane(tid >> 6), r32 = lane & 31, hi = lane >> 5;
    const int b = item >> 3, h = (item >> 1) & 3, vh = item & 1;
    const bf16_t* HQ = (const bf16_t*)(P.ws + OFF_HQ); const bf16_t* HK = (const bf16_t*)(P.ws + OFF_HK); bf16_t* HI = (bf16_t*)(P.ws + OFF_HI);
    constexpr int SQ = 272, SKD = 320, SV = 192, SS = 192;
    constexpr int LQR = 0, LKR = 17408, LQB = 34816, LKD = 52224, LV = 72704, LS = 84992, LG = 109568, LT = 142336, LCL = 144384;
    LAS float* G = (LAS float*)(lds + LG); LAS float* TOT = (LAS float*)(lds + LT); LAS float* CL = (LAS float*)(lds + LCL);
    const size_t rowb = (size_t)b * SEQ;
    const int row = tid >> 3, seg = tid & 7;
    const bf16_t* qsrc = HQ + (rowb + row) * 512 + h * 128 + seg * 16; const bf16_t* ksrc = HK + (rowb + row) * 512 + h * 128 + seg * 16;
    bf16_t* vsrc = HI + (rowb + row) * 512 + h * 128 + vh * 64 + seg * 8;
    for (int i = tid; i < 128 * SS / 4; i += NTHR) ((LAS unsigned*)(lds + LS))[i] = 0u;
    f32x16 Sacc = {};
    const int di = wid >> 1, vi = wid & 1, ti = wid >> 1;
    const int tg = lane >> 4, tc = tg & 1, tI = lane & 15;
    const int trow = 4 * hi + (tI >> 2), tcol = 16 * tc + 4 * (tI & 3);
    u32x4 qn0 = *(const u32x4*)qsrc, qn1 = *(const u32x4*)(qsrc + 8), kn0 = *(const u32x4*)ksrc, kn1 = *(const u32x4*)(ksrc + 8), vn = *(const u32x4*)vsrc;
#pragma unroll 1
    for (int n = 0; n < SEQ / 64; ++n) {
        const u32x4 q0 = qn0, q1 = qn1, k0 = kn0, k1 = kn1, vv = vn;
        float qf[16] = {bf_lo(q0.x), bf_hi(q0.x), bf_lo(q0.y), bf_hi(q0.y), bf_lo(q0.z), bf_hi(q0.z), bf_lo(q0.w), bf_hi(q0.w), bf_lo(q1.x), bf_hi(q1.x), bf_lo(q1.y), bf_hi(q1.y), bf_lo(q1.z), bf_hi(q1.z), bf_lo(q1.w), bf_hi(q1.w)};
        float kf[16] = {bf_lo(k0.x), bf_hi(k0.x), bf_lo(k0.y), bf_hi(k0.y), bf_lo(k0.z), bf_hi(k0.z), bf_lo(k0.w), bf_hi(k0.w), bf_lo(k1.x), bf_hi(k1.x), bf_lo(k1.y), bf_hi(k1.y), bf_lo(k1.z), bf_hi(k1.z), bf_lo(k1.w), bf_hi(k1.w)};
#pragma unroll
        for (int e4 = 0; e4 < 4; ++e4) *(LAS f32x4*)(G + row * 128 + seg * 16 + 4 * e4) = (f32x4){__logf(1.0f - kf[4 * e4]), __logf(1.0f - kf[4 * e4 + 1]), __logf(1.0f - kf[4 * e4 + 2]), __logf(1.0f - kf[4 * e4 + 3])};
        *(LAS u32x4*)(lds + LV + row * SV + seg * 16) = vv;
        if (n + 1 < SEQ / 64) { const size_t o = (size_t)(n + 1) * 64 * 512; qn0 = *(const u32x4*)(qsrc + o); qn1 = *(const u32x4*)(qsrc + o + 8); kn0 = *(const u32x4*)(ksrc + o); kn1 = *(const u32x4*)(ksrc + o + 8); vn = *(const u32x4*)(vsrc + o); }
        __syncthreads();
        { const int d = tid & 127, q4 = tid >> 7; float s = 0.f;
#pragma unroll
          for (int i = 0; i < 16; ++i) { s += G[(16 * q4 + i) * 128 + d]; G[(16 * q4 + i) * 128 + d] = s; }
          TOT[q4 * 128 + d] = s; }
        __syncthreads();
        {
            const int qq = row >> 4;
#pragma unroll
            for (int e4 = 0; e4 < 4; ++e4) {
                const int d4 = seg * 16 + 4 * e4;
                const f32x4 t0 = *(const LAS f32x4*)(TOT + d4), t1 = *(const LAS f32x4*)(TOT + 128 + d4), t2 = *(const LAS f32x4*)(TOT + 256 + d4), t3 = *(const LAS f32x4*)(TOT + 384 + d4);
                const f32x4 off = (qq == 0) ? (f32x4){0.f, 0.f, 0.f, 0.f} : ((qq == 1) ? t0 : ((qq == 2) ? t0 + t1 : t0 + t1 + t2));
                const f32x4 bb = *(const LAS f32x4*)(G + row * 128 + d4) + off;
                const f32x4 bref = *(const LAS f32x4*)(G + 32 * 128 + d4) + t0 + t1, blast = t0 + t1 + t2 + t3;
                float vqb[4], vqr[4], vkr[4], vkd[4];
#pragma unroll
                for (int e = 0; e < 4; ++e) {
                    const float e1 = __expf(bb[e]), e2 = __expf(-bb[e]);
                    vqb[e] = qf[4 * e4 + e] * e1; vqr[e] = vqb[e] * __expf(-bref[e]);
                    const float ke = kf[4 * e4 + e] * e2; vkr[e] = ke * __expf(bref[e]); vkd[e] = ke * __expf(blast[e]);
                }
                *(LAS u32x2*)(lds + LQB + row * SQ + seg * 32 + 8 * e4) = (u32x2){cvt_pk_bf16(vqb[0], vqb[1]), cvt_pk_bf16(vqb[2], vqb[3])};
                *(LAS u32x2*)(lds + LQR + row * SQ + seg * 32 + 8 * e4) = (u32x2){cvt_pk_bf16(vqr[0], vqr[1]), cvt_pk_bf16(vqr[2], vqr[3])};
                *(LAS u32x2*)(lds + LKR + row * SQ + seg * 32 + 8 * e4) = (u32x2){cvt_pk_bf16(vkr[0], vkr[1]), cvt_pk_bf16(vkr[2], vkr[3])};
                *(LAS u32x2*)(lds + LKD + row * SKD + seg * 32 + 8 * e4) = (u32x2){cvt_pk_bf16(vkd[0], vkd[1]), cvt_pk_bf16(vkd[2], vkd[3])};
                if (row == 0) *(LAS f32x4*)(CL + d4) = (f32x4){__expf(blast[0]), __expf(blast[1]), __expf(blast[2]), __expf(blast[3])};
                asm volatile("" ::: "memory");
            }
        }
        __syncthreads();
        if (wid < 4) {
            f32x16 Z = {};
            for (int si = 0; si <= ti; ++si) {
                f32x16 X = {};
#pragma unroll
                for (int ks = 0; ks < 8; ++ks) {
                    const bf16x8 a = *(const LAS bf16x8*)(lds + LKR + (32 * si + r32) * SQ + (16 * ks + 8 * hi) * 2);
                    const bf16x8 bq = *(const LAS bf16x8*)(lds + LQR + (32 * ti + r32) * SQ + (16 * ks + 8 * hi) * 2);
                    X = MFMA32(a, bq, X);
                }
                if (si == ti) {
#pragma unroll
                    for (int r = 0; r < 16; ++r) if (crow(r, hi) > r32) X[r] = 0.f;
                }
#pragma unroll
                for (int s2 = 0; s2 < 2; ++s2) {
                    union { u32x4 u; bf16x8 v; } pa;
                    pa.u.x = cvt_pk_bf16(X[8 * s2 + 0], X[8 * s2 + 1]); pa.u.y = cvt_pk_bf16(X[8 * s2 + 2], X[8 * s2 + 3]); pa.u.z = cvt_pk_bf16(X[8 * s2 + 4], X[8 * s2 + 5]); pa.u.w = cvt_pk_bf16(X[8 * s2 + 6], X[8 * s2 + 7]);
                    const LAS unsigned char* vp = lds + LV + (32 * si + 16 * s2 + trow) * SV + (32 * vi + tcol) * 2;
                    const s16x4 lo = tr4(vp), hh = tr4(vp + 8 * SV);
                    const bf16x8 vf = {lo[0], lo[1], lo[2], lo[3], hh[0], hh[1], hh[2], hh[3]};
                    Z = MFMA32(pa.v, vf, Z);
                }
            }
#pragma unroll
            for (int ks = 0; ks < 8; ++ks) {
                const bf16x8 a = *(const LAS bf16x8*)(lds + LQB + (32 * ti + r32) * SQ + (16 * ks + 8 * hi) * 2);
                const LAS unsigned char* sp = lds + LS + (16 * ks + 8 * hi + (tI >> 2)) * SS + (32 * vi + tcol) * 2;
                const s16x4 lo = tr4(sp), hh = tr4(sp + 4 * SS);
                const bf16x8 sf = {lo[0], lo[1], lo[2], lo[3], hh[0], hh[1], hh[2], hh[3]};
                Z = MFMA32(a, sf, Z);
            }
            bf16_t* op = HI + (rowb + (size_t)n * 64 + 32 * ti) * 512 + h * 128 + vh * 64 + 32 * vi + r32;
#pragma unroll
            for (int r = 0; r < 16; ++r) op[(size_t)crow(r, hi) * 512] = (bf16_t)(cvt_pk_bf16(Z[r], 0.f) & 0xffffu);
        }
        {
#pragma unroll
            for (int r = 0; r < 16; ++r) Sacc[r] *= CL[32 * di + crow(r, hi)];
#pragma unroll
            for (int ks = 0; ks < 4; ++ks) {
                const LAS unsigned char* kp = lds + LKD + (16 * ks + 8 * hi + (tI >> 2)) * SKD + (32 * di + tcol) * 2;
                const s16x4 klo = tr4(kp), khi = tr4(kp + 4 * SKD);
                const bf16x8 ka = {klo[0], klo[1], klo[2], klo[3], khi[0], khi[1], khi[2], khi[3]};
                const LAS unsigned char* vp = lds + LV + (16 * ks + 8 * hi + (tI >> 2)) * SV + (32 * vi + tcol) * 2;
                const s16x4 vlo = tr4(vp), vhi = tr4(vp + 4 * SV);
                const bf16x8 vb = {vlo[0], vlo[1], vlo[2], vlo[3], vhi[0], vhi[1], vhi[2], vhi[3]};
                Sacc = MFMA32(ka, vb, Sacc);
            }
        }
        __syncthreads();
        {
            LAS bf16_t* sp = (LAS bf16_t*)(lds + LS + (32 * di) * SS + (32 * vi + r32) * 2);
#pragma unroll
            for (int r = 0; r < 16; ++r) sp[crow(r, hi) * (SS / 2)] = (bf16_t)(cvt_pk_bf16(Sacc[r], 0.f) & 0xffffu);
        }
    }
    __syncthreads();
}

__device__ void moba_unit(const Params& P, int b, int h, int j, LAS unsigned char* lds) {
    const int tid = tid_opaque(), lane = tid & 63, wid = tid >> 6, r32 = lane & 31, hi = lane >> 5;
    bf16_t* Q = (bf16_t*)(P.ws + OFF_QA); const bf16_t* Kg = (const bf16_t*)(P.ws + OFF_KA); const bf16_t* Vg = (const bf16_t*)(P.ws + OFF_VA);
    const float* kmean = (const float*)(P.ws + OFF_KMEAN);
    constexpr int KIMG = 64 * 144, VIMG = 64 * 192, LK = 0, LV = 2 * KIMG, LKM = 2 * KIMG + 2 * VIMG;
    LAS float* kmL = (LAS float*)(lds + LKM);
    const size_t rowb = (size_t)b * SEQ; const int q0 = j * 256;
    if (tid < j * 64) kmL[tid] = kmean[(size_t)(b * 8 + (tid >> 6)) * 512 + h * 64 + (tid & 63)];
    bf16_t* qrow = Q + (rowb + q0 + wid * 32 + r32) * 512 + h * 64;
    bf16x8 qf[4];
#pragma unroll
    for (int d0 = 0; d0 < 4; ++d0) qf[d0] = *(const bf16x8*)(qrow + 16 * d0 + 8 * hi);
    const int srow = tid >> 3, sch = tid & 7;
    const bf16_t* ksrc = Kg + (rowb + srow) * 512 + h * 64 + sch * 8; const bf16_t* vsrc = Vg + (rowb + srow) * 512 + h * 64 + sch * 8;
    const int ntile = 4 * (j + 1);
    u32x4 kreg, vreg;
    { const int key0 = q0; kreg = *(const u32x4*)(ksrc + (size_t)key0 * 512); vreg = *(const u32x4*)(vsrc + (size_t)key0 * 512); }
    *(LAS u32x4*)(lds + LK + srow * 144 + sch * 16) = kreg; *(LAS u32x4*)(lds + LV + srow * 192 + sch * 16) = vreg;
    __syncthreads();
    unsigned sel = 0;
    if (j <= 3) sel = (1u << j) - 1u;
    else {
        float g[7];
#pragma unroll
        for (int n = 0; n < 7; ++n) { float s = 0.f;
            if (n < j) {
#pragma unroll
                for (int d0 = 0; d0 < 4; ++d0)
#pragma unroll
                    for (int e = 0; e < 8; ++e) s += __uint_as_float(((unsigned)(unsigned short)qf[d0][e]) << 16) * kmL[n * 64 + 16 * d0 + 8 * hi + e];
            }
            s += __shfl_xor(s, 32); g[n] = s; }
#pragma unroll
        for (int it = 0; it < 3; ++it) { float best = -INFINITY; int bi = 0;
#pragma unroll
            for (int n = 0; n < 7; ++n) if (n < j && !((sel >> n) & 1u) && g[n] > best) { best = g[n]; bi = n; }
            sel |= 1u << bi; }
    }
    const float ch = exp2f(-(float)(h + 1)) * LOG2E;
    const int qb = wid * 32 + r32;
    float m_run = -1e30f, l_run = 0.f;
    f32x16 o0 = {}, o1 = {};
    const int tg = lane >> 4, tc = tg & 1, ti = lane & 15;
    const int vlane = (4 * hi + (ti >> 2)) * 192 + (16 * tc + 4 * (ti & 3)) * 2;
#pragma unroll 1
    for (int i = 0; i < ntile; ++i) {
        const int buf = i & 1;
        const bool own = i < 4; const int blk = own ? j : ((i - 4) >> 2), kt = own ? i : ((i - 4) & 3);
        if (i + 1 < ntile) { const int i1 = i + 1; const int blk1 = (i1 < 4) ? j : ((i1 - 4) >> 2), kt1 = (i1 < 4) ? i1 : ((i1 - 4) & 3); const size_t key1 = (size_t)(blk1 * 256 + kt1 * 64);
            kreg = *(const u32x4*)(ksrc + key1 * 512); vreg = *(const u32x4*)(vsrc + key1 * 512); }
        const bool lane_ok = own ? true : (((sel >> blk) & 1u) != 0u);
        const bool skip = own ? (64 * kt > 32 * wid + 31) : (__ballot(lane_ok) == 0ull);
        if (!skip) {
            LAS unsigned char* kb = lds + LK + buf * KIMG; LAS unsigned char* vb = lds + LV + buf * VIMG;
            f32x16 p0 = {}, p1 = {};
#pragma unroll
            for (int d0 = 0; d0 < 4; ++d0) {
                const bf16x8 kf0 = *(const LAS bf16x8*)(kb + r32 * 144 + (16 * d0 + 8 * hi) * 2);
                const bf16x8 kf1 = *(const LAS bf16x8*)(kb + (32 + r32) * 144 + (16 * d0 + 8 * hi) * 2);
                p0 = MFMA32(kf0, qf[d0], p0); p1 = MFMA32(kf1, qf[d0], p1);
            }
            const float kbase = ch * (float)((blk - j) * 256 + kt * 64);
            float mt = -1e30f;
#pragma unroll
            for (int r = 0; r < 16; ++r) {
                const int kl0 = crow(r, hi), kl1 = kl0 + 32;
                const float t0 = p0[r] + (kbase + ch * (float)kl0), t1 = p1[r] + (kbase + ch * (float)kl1);
                const bool v0 = own ? (kt * 64 + kl0 <= qb) : lane_ok, v1 = own ? (kt * 64 + kl1 <= qb) : lane_ok;
                p0[r] = v0 ? t0 : -1e30f; p1[r] = v1 ? t1 : -1e30f;
                mt = fmaxf(mt, fmaxf(p0[r], p1[r]));
            }
            mt = fmaxf(mt, __shfl_xor(mt, 32));
            const float mnew = fmaxf(m_run, mt), alpha = __builtin_amdgcn_exp2f(m_run - mnew);
            m_run = mnew;
            float rs = 0.f;
#pragma unroll
            for (int r = 0; r < 16; ++r) { p0[r] = __builtin_amdgcn_exp2f(p0[r] - mnew); p1[r] = __builtin_amdgcn_exp2f(p1[r] - mnew); rs += p0[r] + p1[r]; }
            l_run = l_run * alpha + rs;
#pragma unroll
            for (int r = 0; r < 16; ++r) { o0[r] *= alpha; o1[r] *= alpha; }
#pragma unroll
            for (int sub = 0; sub < 2; ++sub)
#pragma unroll
                for (int s = 0; s < 2; ++s) {
                    union { u32x4 u; bf16x8 v; } pb;
                    if (sub == 0) { pb.u.x = cvt_pk_bf16(p0[8 * s + 0], p0[8 * s + 1]); pb.u.y = cvt_pk_bf16(p0[8 * s + 2], p0[8 * s + 3]); pb.u.z = cvt_pk_bf16(p0[8 * s + 4], p0[8 * s + 5]); pb.u.w = cvt_pk_bf16(p0[8 * s + 6], p0[8 * s + 7]); }
                    else { pb.u.x = cvt_pk_bf16(p1[8 * s + 0], p1[8 * s + 1]); pb.u.y = cvt_pk_bf16(p1[8 * s + 2], p1[8 * s + 3]); pb.u.z = cvt_pk_bf16(p1[8 * s + 4], p1[8 * s + 5]); pb.u.w = cvt_pk_bf16(p1[8 * s + 6], p1[8 * s + 7]); }
#pragma unroll
                    for (int dt = 0; dt < 2; ++dt) {
                        LAS unsigned char* va = vb + (32 * sub + 16 * s) * 192 + dt * 64 + vlane;
                        const s16x4 lo = __builtin_bit_cast(s16x4, __builtin_amdgcn_ds_read_tr16_b64_v4i16((LAS s16x4*)va));
                        const s16x4 hh = __builtin_bit_cast(s16x4, __builtin_amdgcn_ds_read_tr16_b64_v4i16((LAS s16x4*)(va + 8 * 192)));
                        const bf16x8 vf = {lo[0], lo[1], lo[2], lo[3], hh[0], hh[1], hh[2], hh[3]};
                        if (dt == 0) o0 = MFMA32(vf, pb.v, o0); else o1 = MFMA32(vf, pb.v, o1);
                    }
                }
        }
        if (i + 1 < ntile) { const int nb = buf ^ 1;
            *(LAS u32x4*)(lds + LK + nb * KIMG + srow * 144 + sch * 16) = kreg; *(LAS u32x4*)(lds + LV + nb * VIMG + srow * 192 + sch * 16) = vreg; }
        __syncthreads();
    }
    l_run += __shfl_xor(l_run, 32);
    const float inv = 1.0f / l_run;
#pragma unroll
    for (int r4 = 0; r4 < 4; ++r4) {
        u32x2 w0, w1;
        w0.x = cvt_pk_bf16(o0[4 * r4] * inv, o0[4 * r4 + 1] * inv); w0.y = cvt_pk_bf16(o0[4 * r4 + 2] * inv, o0[4 * r4 + 3] * inv);
        w1.x = cvt_pk_bf16(o1[4 * r4] * inv, o1[4 * r4 + 1] * inv); w1.y = cvt_pk_bf16(o1[4 * r4 + 2] * inv, o1[4 * r4 + 3] * inv);
        *(u32x2*)(qrow + 8 * r4 + 4 * hi) = w0; *(u32x2*)(qrow + 32 + 8 * r4 + 4 * hi) = w1;
    }
}

__device__ void yb_norm_panel(const Params& P, int pm) {
    const int tid = tid_opaque(), lane = tid & 63, wid = tid >> 6;
    bf16_t* HI = (bf16_t*)(P.ws + OFF_HI); const bf16_t* HG = (const bf16_t*)(P.ws + OFF_HG);
    for (int r = 0; r < 32; ++r) {
        const size_t off = ((size_t)pm * 256 + wid * 32 + r) * 512 + lane * 8;
        const u32x4 ov = *(const u32x4*)(HI + off), gv = *(const u32x4*)(HG + off);
        float o[8] = {bf_lo(ov.x), bf_hi(ov.x), bf_lo(ov.y), bf_hi(ov.y), bf_lo(ov.z), bf_hi(ov.z), bf_lo(ov.w), bf_hi(ov.w)};
        const float g[8] = {bf_lo(gv.x), bf_hi(gv.x), bf_lo(gv.y), bf_hi(gv.y), bf_lo(gv.z), bf_hi(gv.z), bf_lo(gv.w), bf_hi(gv.w)};
        float ss = 0.f;
#pragma unroll
        for (int e = 0; e < 8; ++e) ss += o[e] * o[e];
        ss += __shfl_xor(ss, 1); ss += __shfl_xor(ss, 2); ss += __shfl_xor(ss, 4); ss += __shfl_xor(ss, 8);
        const float rs = rsqrtf(ss * (1.0f / 128.0f) + RMS_EPS);
        u32x4 w; w.x = cvt_pk_bf16(o[0] * rs * g[0], o[1] * rs * g[1]); w.y = cvt_pk_bf16(o[2] * rs * g[2], o[3] * rs * g[3]);
        w.z = cvt_pk_bf16(o[4] * rs * g[4], o[5] * rs * g[5]); w.w = cvt_pk_bf16(o[6] * rs * g[6], o[7] * rs * g[7]);
        *(u32x4*)(HI + off) = w;
    }
}
__device__ void ln1_panel(const Params& P, int pm) {
    const int tid = tid_opaque(), lane = tid & 63, wid = tid >> 6;
    const float* ada = (const float*)(P.ws + OFF_ADA) + (size_t)(pm >> 3) * 6144; bf16_t* H = (bf16_t*)(P.ws + OFF_H);
    for (int r = 0; r < 32; ++r) {
        const size_t row = (size_t)pm * 256 + wid * 32 + r;
        float* xr = P.out + row * 1024 + lane * 4;
        f32x4 v[4]; float s = 0.f;
#pragma unroll
        for (int jx = 0; jx < 4; ++jx) { v[jx] = *(const f32x4*)(xr + 256 * jx); s += (v[jx][0] + v[jx][1]) + (v[jx][2] + v[jx][3]); }
        const float mean = wave_sum(s) * (1.0f / 1024.0f); float s2 = 0.f;
#pragma unroll
        for (int jx = 0; jx < 4; ++jx) { v[jx] = v[jx] - mean; s2 += (v[jx][0] * v[jx][0] + v[jx][1] * v[jx][1]) + (v[jx][2] * v[jx][2] + v[jx][3] * v[jx][3]); }
        const float rstd = rsqrtf(wave_sum(s2) * (1.0f / 1024.0f) + LN_EPS);
#pragma unroll
        for (int jx = 0; jx < 4; ++jx) {
            const int c = lane * 4 + 256 * jx;
            const f32x4 g = *(const f32x4*)(P.ln1_g + c), bb = *(const f32x4*)(P.ln1_b + c), sh = *(const f32x4*)(ada + 3072 + c), sc = *(const f32x4*)(ada + 4096 + c);
            const f32x4 x1 = v[jx] * rstd * g + bb;
            *(f32x4*)(xr + 256 * jx) = x1;
            const f32x4 h2 = x1 * (sc + 1.0f) + sh;
            u32x2 w; w.x = cvt_pk_bf16(h2[0], h2[1]); w.y = cvt_pk_bf16(h2[2], h2[3]);
            *(u32x2*)(H + row * 1024 + c) = w;
        }
    }
}

#define INS16(L, xin) do { float x_ = (xin); _Pragma("unroll") for (int k_ = 0; k_ < 16; ++k_) { const float hi_ = fmaxf(L[k_], x_); x_ = fminf(L[k_], x_); L[k_] = hi_; } } while (0)

__device__ void peer_select_wave(const Params& P, size_t tok0) {
    const int lane = tid_opaque() & 63, r32 = lane & 31, hi = lane >> 5;
    const bf16_t* QP = (const bf16_t*)(P.ws + OFF_GB) + (tok0 + r32) * 1024; const bf16_t* SK = (const bf16_t*)(P.ws + OFF_SK);
    u32x2* EG = (u32x2*)(P.ws + OFF_EG) + (tok0 + r32) * 128;
#pragma unroll 1
    for (int h = 0; h < 8; ++h) {
        float a0[16], a1[16];
#pragma unroll
        for (int k = 0; k < 16; ++k) { a0[k] = -INFINITY; a1[k] = -INFINITY; }
#pragma unroll 1
        for (int p = 0; p < 2; ++p) {
            const int hp = h * 2 + p;
            bf16x8 qf[4];
#pragma unroll
            for (int ks = 0; ks < 4; ++ks) qf[ks] = *(const bf16x8*)(QP + hp * 64 + 16 * ks + 8 * hi);
            float L[16];
#pragma unroll
            for (int k = 0; k < 16; ++k) L[k] = -INFINITY;
#pragma unroll
            for (int kt = 0; kt < 4; ++kt) {
                f32x16 acc = {};
#pragma unroll
                for (int ks = 0; ks < 4; ++ks) { const bf16x8 kf = *(const bf16x8*)(SK + ((size_t)hp * 128 + 32 * kt + r32) * 64 + 16 * ks + 8 * hi); acc = MFMA32(kf, qf[ks], acc); }
#pragma unroll
                for (int r = 0; r < 16; ++r) { const unsigned key = (unsigned)(32 * kt + crow(r, hi)); const float xv = __uint_as_float((__float_as_uint(acc[r]) & ~127u) | key); INS16(L, xv); }
            }
            float O[16];
#pragma unroll
            for (int k = 0; k < 16; ++k) O[k] = __shfl_xor(L[k], 32);
#pragma unroll
            for (int k = 0; k < 16; ++k) INS16(L, O[k]);
#pragma unroll
            for (int k = 0; k < 16; ++k) { a0[k] = (p == 0) ? L[k] : a0[k]; a1[k] = (p == 1) ? L[k] : a1[k]; }
        }
        float best[16];
#pragma unroll
        for (int k = 0; k < 16; ++k) best[k] = -INFINITY;
#pragma unroll
        for (int i = 0; i < 16; ++i)
#pragma unroll
            for (int jx = 0; jx < 16; ++jx)
                if ((i + 1) * (jx + 1) <= 16) {
                    const float cs = a0[i] + a1[jx];
                    const float cv = __uint_as_float((__float_as_uint(cs) & ~255u) | (unsigned)(i * 16 + jx));
                    INS16(best, cv);
                }
        unsigned pk0[4], pk1[4];
#pragma unroll
        for (int q = 0; q < 4; ++q) {
            pk0[q] = (__float_as_uint(a0[4 * q]) & 127u) | ((__float_as_uint(a0[4 * q + 1]) & 127u) << 8) | ((__float_as_uint(a0[4 * q + 2]) & 127u) << 16) | ((__float_as_uint(a0[4 * q + 3]) & 127u) << 24);
            pk1[q] = (__float_as_uint(a1[4 * q]) & 127u) | ((__float_as_uint(a1[4 * q + 1]) & 127u) << 8) | ((__float_as_uint(a1[4 * q + 2]) & 127u) << 16) | ((__float_as_uint(a1[4 * q + 3]) & 127u) << 24);
        }
        unsigned pay[16];
#pragma unroll
        for (int k = 0; k < 16; ++k) {
            const unsigned code = __float_as_uint(best[k]) & 255u, ci = code >> 4, cj = code & 15u;
            const unsigned qi = ci >> 2, qj = cj >> 2;
            const unsigned w0 = (qi == 0u) ? pk0[0] : ((qi == 1u) ? pk0[1] : ((qi == 2u) ? pk0[2] : pk0[3]));
            const unsigned w1 = (qj == 0u) ? pk1[0] : ((qj == 1u) ? pk1[1] : ((qj == 2u) ? pk1[2] : pk1[3]));
            pay[k] = (((w0 >> ((ci & 3u) * 8u)) & 127u) << 7) | ((w1 >> ((cj & 3u) * 8u)) & 127u);
        }
        float e[16], es = 0.f;
#pragma unroll
        for (int k = 0; k < 16; ++k) { e[k] = __expf(best[k] - best[0]); es += e[k]; }
        const float inv = 1.0f / es;
        if (hi == 0) {
#pragma unroll
            for (int k = 0; k < 16; ++k) { u32x2 w; w.x = pay[k]; w.y = __float_as_uint(e[k] * inv); EG[h * 16 + k] = w; }
        }
    }
}
__device__ __forceinline__ unsigned xcc_id() { return (unsigned)__builtin_amdgcn_s_getreg((3 << 11) | 20) & 0xFu; }
template <int CTRL> __device__ __forceinline__ float dpp_add(float x) { const int v = __builtin_amdgcn_update_dpp(0, __float_as_int(x), CTRL, 0xf, 0xf, true); return x + __int_as_float(v); }
__device__ __forceinline__ float wave_sum_fast(float x) {
    x = dpp_add<0xB1>(x); x = dpp_add<0x4E>(x); x = dpp_add<0x141>(x); x = dpp_add<0x140>(x);
    x += __shfl_xor(x, 16); x += __shfl_xor(x, 32); return x;
}
__device__ __forceinline__ float dot16_fp8(const float (&hv)[16], const u32x4 r) {
    float s = 0.f;
    { const f32x2 a = __builtin_amdgcn_cvt_pk_f32_fp8((int)r.x, false), b = __builtin_amdgcn_cvt_pk_f32_fp8((int)r.x, true); s += hv[0] * a.x + hv[1] * a.y + hv[2] * b.x + hv[3] * b.y; }
    { const f32x2 a = __builtin_amdgcn_cvt_pk_f32_fp8((int)r.y, false), b = __builtin_amdgcn_cvt_pk_f32_fp8((int)r.y, true); s += hv[4] * a.x + hv[5] * a.y + hv[6] * b.x + hv[7] * b.y; }
    { const f32x2 a = __builtin_amdgcn_cvt_pk_f32_fp8((int)r.z, false), b = __builtin_amdgcn_cvt_pk_f32_fp8((int)r.z, true); s += hv[8] * a.x + hv[9] * a.y + hv[10] * b.x + hv[11] * b.y; }
    { const f32x2 a = __builtin_amdgcn_cvt_pk_f32_fp8((int)r.w, false), b = __builtin_amdgcn_cvt_pk_f32_fp8((int)r.w, true); s += hv[12] * a.x + hv[13] * a.y + hv[14] * b.x + hv[15] * b.y; }
    return s;
}
template <class F> __device__ __forceinline__ void partition_queue(const Params& P, LAS unsigned char* lds, int ctr_base, F f) {
    const int tid = tid_opaque();
    LAS int* slot = (LAS int*)(lds + LDS_BYTES - 64);
    unsigned* ctr = (unsigned*)(P.ws + OFF_CTR) + ctr_base;
    const int myx = (int)(xcc_id() & 7u);
    for (int pp = 0; pp < 8; ++pp) {
        const int p = (myx + pp) & 7;
        for (;;) {
            if (tid == 0) *slot = (int)atomicAdd(ctr + p, 1u);
            __syncthreads();
            const int item = *slot;
            __syncthreads();
            if (item >= NTOK / 64) break;
            f(p, item);
        }
    }
}
__device__ __forceinline__ float dot2bf(unsigned a, bf16v2 b, float c) { return __builtin_amdgcn_fdot2_f32_bf16(__builtin_bit_cast(bf16v2, a), b, c, false); }
struct UQuad { u32x4 r[4]; u32x4 ent; };
__device__ __forceinline__ void uq_issue(UQuad& q, const LAS u32x4* list, int J, int NQ, int g, const unsigned char* U8) {
    const int jj = J < NQ ? J : NQ - 1;
    q.ent = list[4 * jj + g];
    const unsigned char* rp = U8 + (size_t)q.ent.x * 1024;
#pragma unroll
    for (int c = 0; c < 4; ++c) q.r[c] = *(const u32x4*)(rp + c * 256);
}
__device__ __forceinline__ float uq_dot(const UQuad& q, const u32x4 (&hp)[8]) {
    float a = 0.f, b = 0.f;
    constexpr float SC = 1.0f / 32.0f;
#pragma unroll
    for (int c = 0; c < 4; ++c) {
        const u32x4 r = q.r[c];
        a = dot2bf(hp[2 * c].x, __builtin_amdgcn_cvt_scalef32_pk_bf16_fp8((int)r.x, SC, false), a); b = dot2bf(hp[2 * c].y, __builtin_amdgcn_cvt_scalef32_pk_bf16_fp8((int)r.x, SC, true), b);
        a = dot2bf(hp[2 * c].z, __builtin_amdgcn_cvt_scalef32_pk_bf16_fp8((int)r.y, SC, false), a); b = dot2bf(hp[2 * c].w, __builtin_amdgcn_cvt_scalef32_pk_bf16_fp8((int)r.y, SC, true), b);
        a = dot2bf(hp[2 * c + 1].x, __builtin_amdgcn_cvt_scalef32_pk_bf16_fp8((int)r.z, SC, false), a); b = dot2bf(hp[2 * c + 1].y, __builtin_amdgcn_cvt_scalef32_pk_bf16_fp8((int)r.z, SC, true), b);
        a = dot2bf(hp[2 * c + 1].z, __builtin_amdgcn_cvt_scalef32_pk_bf16_fp8((int)r.w, SC, false), a); b = dot2bf(hp[2 * c + 1].w, __builtin_amdgcn_cvt_scalef32_pk_bf16_fp8((int)r.w, SC, true), b);
    }
    float s = a + b;
    s = dpp_add<0xB1>(s); s = dpp_add<0x4E>(s); s = dpp_add<0x141>(s); s = dpp_add<0x140>(s);
    return s;
}
__device__ __forceinline__ void peer_u_chunk(const Params& P, LAS unsigned char* lds, int p, int chunk) {
    const int tid = tid_opaque(), lane = tid & 63, wid = tid >> 6, g = lane >> 4, li = lane & 15;
    const bf16_t* H = (const bf16_t*)(P.ws + OFF_H); const unsigned char* U8 = P.ws + OFF_U8 + li * 16;
    const u32x4* EG4 = (const u32x4*)(P.ws + OFF_EG); float* W = (float*)(P.ws + OFF_W);
    LAS u32x4* list = (LAS u32x4*)(lds + wid * 16384);
    const size_t t0 = (size_t)chunk * 64 + wid * 8;
    int base = 0;
    {
        u32x4 eg[8];
#pragma unroll
        for (int i = 0; i < 8; ++i) eg[i] = __builtin_nontemporal_load(EG4 + (t0 + i) * 64 + lane);
#pragma unroll
        for (int i = 0; i < 8; ++i) {
            const bool m0 = (int)(eg[i].x >> 11) == p, m1 = (int)(eg[i].z >> 11) == p;
            const unsigned long long b0 = __ballot(m0), b1 = __ballot(m1);
            const int n0 = __builtin_popcountll(b0), n = n0 + __builtin_popcountll(b1);
            const int r0 = (int)__builtin_amdgcn_mbcnt_hi((unsigned)(b0 >> 32), __builtin_amdgcn_mbcnt_lo((unsigned)b0, 0u));
            const int r1 = n0 + (int)__builtin_amdgcn_mbcnt_hi((unsigned)(b1 >> 32), __builtin_amdgcn_mbcnt_lo((unsigned)b1, 0u));
            if (m0) list[base + r0] = (u32x4){eg[i].x, eg[i].y, (unsigned)(2 * lane) | (unsigned)(i << 8), 1u};
            if (m1) list[base + r1] = (u32x4){eg[i].z, eg[i].w, (unsigned)(2 * lane + 1) | (unsigned)(i << 8), 1u};
            const int npad = n == 0 ? 4 : ((n + 3) & ~3);
            if (lane < npad - n) list[base + n + lane] = (u32x4){(unsigned)(p << 11), 0u, (unsigned)(i << 8), 0u};
            base += npad;
        }
        const int rem = (16 - (base & 15)) & 15;
        if (lane < rem) list[base + lane] = (u32x4){(unsigned)(p << 11), 0u, (unsigned)(7 << 8), 0u};
        base += rem;
    }
    const int NQ = base >> 2;
    u32x4 hp[8], hn[8];
#pragma unroll
    for (int c = 0; c < 4; ++c) { hp[2 * c] = __builtin_nontemporal_load((const u32x4*)(H + t0 * 1024 + (li + 16 * c) * 16)); hp[2 * c + 1] = __builtin_nontemporal_load((const u32x4*)(H + t0 * 1024 + (li + 16 * c) * 16 + 8));
                                  hn[2 * c] = __builtin_nontemporal_load((const u32x4*)(H + (t0 + 1) * 1024 + (li + 16 * c) * 16)); hn[2 * c + 1] = __builtin_nontemporal_load((const u32x4*)(H + (t0 + 1) * 1024 + (li + 16 * c) * 16 + 8)); }
    int curtok = 0;
    UQuad q0, q1, q2, q3;
    uq_issue(q0, list, 0, NQ, g, U8); uq_issue(q1, list, 1, NQ, g, U8); uq_issue(q2, list, 2, NQ, g, U8); uq_issue(q3, list, 3, NQ, g, U8);
#define UQ_STEP(q, Jn) do { \
        const int tk = __builtin_amdgcn_readfirstlane((int)(q.ent.z >> 8)); \
        if (tk != curtok) { curtok = tk; _Pragma("unroll") for (int c = 0; c < 8; ++c) hp[c] = hn[c]; \
            if (tk + 1 < 8) { _Pragma("unroll") for (int c = 0; c < 4; ++c) { hn[2 * c] = __builtin_nontemporal_load((const u32x4*)(H + (t0 + tk + 1) * 1024 + (li + 16 * c) * 16)); hn[2 * c + 1] = __builtin_nontemporal_load((const u32x4*)(H + (t0 + tk + 1) * 1024 + (li + 16 * c) * 16 + 8)); } } } \
        const float s = uq_dot(q, hp); \
        if (li == 0 && q.ent.w != 0u) W[(t0 + tk) * 128 + (q.ent.z & 255u)] = __uint_as_float(q.ent.y) * 0.5f * s * (1.0f + erff(s * 0.70710678118654752f)); \
        uq_issue(q, list, (Jn), NQ, g, U8); } while (0)
#pragma unroll 1
    for (int J = 0; J < NQ; J += 4) { UQ_STEP(q0, J + 4); UQ_STEP(q1, J + 5); UQ_STEP(q2, J + 6); UQ_STEP(q3, J + 7); }
#undef UQ_STEP
}
__device__ __forceinline__ void pv_issue(u32x2 (&r)[32], const LAS u32x2* list, int g, const unsigned char* V8) {
#pragma unroll
    for (int j = 0; j < 32; ++j) r[j] = *(const u32x2*)(V8 + (size_t)list[4 * j + g].x * 128);
}
__device__ __forceinline__ void pv_reduce(const u32x2 (&r)[32], const LAS u32x2* list, int g, int li, float* yp) {
    f32x2 a0 = {0.f, 0.f}, a1 = {0.f, 0.f}, a2 = {0.f, 0.f}, a3 = {0.f, 0.f};
#pragma unroll
    for (int j = 0; j < 32; ++j) {
        const float w = __uint_as_float(list[4 * j + g].y); const f32x2 wv = {w, w};
        a0 += wv * __builtin_amdgcn_cvt_pk_f32_fp8((int)r[j].x, false); a1 += wv * __builtin_amdgcn_cvt_pk_f32_fp8((int)r[j].x, true);
        a2 += wv * __builtin_amdgcn_cvt_pk_f32_fp8((int)r[j].y, false); a3 += wv * __builtin_amdgcn_cvt_pk_f32_fp8((int)r[j].y, true);
    }
    float acc[8] = {a0.x, a0.y, a1.x, a1.y, a2.x, a2.y, a3.x, a3.y};
#pragma unroll
    for (int j = 0; j < 8; ++j) { acc[j] += __shfl_xor(acc[j], 16); acc[j] += __shfl_xor(acc[j], 32); }
    if (g == 0) { *(f32x4*)yp = (f32x4){acc[0], acc[1], acc[2], acc[3]} * 0.25f; *(f32x4*)(yp + 4) = (f32x4){acc[4], acc[5], acc[6], acc[7]} * 0.25f; }
}
__device__ __forceinline__ void peer_v_chunk(const Params& P, LAS unsigned char* lds, int x, int chunk) {
    const int tid = tid_opaque(), lane = tid & 63, wid = tid >> 6, g = lane >> 4, li = lane & 15;
    const unsigned char* V8 = P.ws + OFF_V8 + (size_t)x * 16384 * 128 + li * 8;
    const u32x4* EG4 = (const u32x4*)(P.ws + OFF_EG); const f32x2* W2 = (const f32x2*)(P.ws + OFF_W); float* Y = (float*)(P.ws + OFF_Y);
    LAS u32x2* lists = (LAS u32x2*)(lds + wid * 8192);
    const size_t t0 = (size_t)chunk * 64 + wid * 8;
#pragma unroll
    for (int i = 0; i < 8; ++i) { const u32x4 eg = EG4[(t0 + i) * 64 + lane]; const f32x2 ww = W2[(t0 + i) * 64 + lane];
        *(LAS u32x4*)(lists + i * 128 + 2 * lane) = (u32x4){eg.x, __float_as_uint(ww.x), eg.z, __float_as_uint(ww.y)}; }
    float* yp = Y + t0 * 1024 + x * 128 + li * 8;
    u32x2 ra[32], rb[32];
    pv_issue(ra, lists, g, V8);
#pragma unroll
    for (int i = 0; i < 8; i += 2) {
        pv_issue(rb, lists + (i + 1) * 128, g, V8);
        pv_reduce(ra, lists + i * 128, g, li, yp + (size_t)i * 1024);
        if (i + 2 < 8) pv_issue(ra, lists + (i + 2) * 128, g, V8);
        pv_reduce(rb, lists + (i + 1) * 128, g, li, yp + (size_t)(i + 1) * 1024);
    }
}
__device__ void ln2_phase(const Params& P) {
    const int tid = tid_opaque(), lane = tid & 63, wid = tid >> 6;
    const float* Y = (const float*)(P.ws + OFF_Y);
    for (size_t row0 = ((size_t)blockIdx.x * 8 + wid) * 2; row0 < (size_t)NTOK; row0 += (size_t)gridDim.x * 16) {
        f32x4 v[2][4];
#pragma unroll
        for (int rr = 0; rr < 2; ++rr) {
            const size_t row = row0 + rr;
            const float* gt2 = (const float*)(P.ws + OFF_ADA) + (row >> 11) * 6144 + 5120;
            const float* xr = P.out + row * 1024 + lane * 4; const float* yr = Y + row * 1024 + lane * 4;
#pragma unroll
            for (int jx = 0; jx < 4; ++jx) { const f32x4 xv = *(const f32x4*)(xr + 256 * jx), yv = __builtin_nontemporal_load((const f32x4*)(yr + 256 * jx)), gv = *(const f32x4*)(gt2 + lane * 4 + 256 * jx);
                v[rr][jx] = xv * ALPHA + gv * yv; }
        }
#pragma unroll
        for (int rr = 0; rr < 2; ++rr) {
            float s = 0.f;
#pragma unroll
            for (int jx = 0; jx < 4; ++jx) s += (v[rr][jx][0] + v[rr][jx][1]) + (v[rr][jx][2] + v[rr][jx][3]);
            const float mean = wave_sum(s) * (1.0f / 1024.0f); float s2 = 0.f;
#pragma unroll
            for (int jx = 0; jx < 4; ++jx) { v[rr][jx] = v[rr][jx] - mean; s2 += (v[rr][jx][0] * v[rr][jx][0] + v[rr][jx][1] * v[rr][jx][1]) + (v[rr][jx][2] * v[rr][jx][2] + v[rr][jx][3] * v[rr][jx][3]); }
            const float rstd = rsqrtf(wave_sum(s2) * (1.0f / 1024.0f) + LN_EPS);
            float* xr = P.out + (row0 + rr) * 1024 + lane * 4;
#pragma unroll
            for (int jx = 0; jx < 4; ++jx) { const int c = lane * 4 + 256 * jx; const f32x4 g = *(const f32x4*)(P.ln2_g + c), bb = *(const f32x4*)(P.ln2_b + c);
                __builtin_nontemporal_store(v[rr][jx] * rstd * g + bb, (f32x4*)(xr + 256 * jx)); }
        }
    }
}

#define XB_TMO      128
#define XB_XCNT(j)  (256  + 64 * (j))
#define XB_XSUB(j)  (1280 + 64 * (j))
#define XB_XGEN(j)  (2304 + 64 * (j))
#define XB_TOP      3328
#define XB_TOPGEN   3392
#define XCD_BAR_WORDS 3456
#define XB_SPIN_CAP (1u << 22)
__device__ __forceinline__ unsigned xb_ld(unsigned* p)              { return __hip_atomic_load(p, __ATOMIC_RELAXED, __HIP_MEMORY_SCOPE_AGENT); }
__device__ __forceinline__ unsigned xb_add(unsigned* p, unsigned v) { return __hip_atomic_fetch_add(p, v, __ATOMIC_RELAXED, __HIP_MEMORY_SCOPE_AGENT); }
#define XB_SPIN(cond, bar) do { unsigned _sp = 0; while (cond) { __builtin_amdgcn_s_sleep(1); \
    if ((++_sp & 255u) == 0u) { if (xb_ld(&(bar)[XB_TMO])) break; if (_sp > XB_SPIN_CAP) { atomicAdd(&(bar)[XB_TMO], 1u); break; } } } } while (0)
struct XcdBarrier { unsigned* bar; unsigned x; volatile LAS unsigned* st; };
__device__ __forceinline__ XcdBarrier xcd_barrier_post(unsigned* bar, volatile LAS unsigned* st) {
    XcdBarrier b; b.bar = bar; b.x = xcc_id(); b.st = st;
    if (threadIdx.x == 0) (void)xb_add(&bar[XB_XCNT(b.x)], 1u);
    return b;
}
__device__ __forceinline__ void xcd_barrier_complete(unsigned* bar, unsigned x, unsigned& nloc, unsigned& nx) {
    const unsigned G = gridDim.x * gridDim.y * gridDim.z;
    unsigned sum, cnt, mine, sp = 0u;
    for (;;) {
        sum = 0u; cnt = 0u; mine = 0u;
#pragma unroll
        for (unsigned j = 0; j < 16; ++j) { const unsigned c = xb_ld(&bar[XB_XCNT(j)]); sum += c; cnt += (c > 0u) ? 1u : 0u; mine = (j == x) ? c : mine; }
        if (sum == G) break;
        __builtin_amdgcn_s_sleep(1);
        if ((++sp & 255u) == 0u) { if (xb_ld(&bar[XB_TMO])) break; if (sp > XB_SPIN_CAP) { atomicAdd(&bar[XB_TMO], 1u); break; } }
    }
    nloc = mine > 0u ? mine : 1u; nx = cnt > 0u ? cnt : 1u;
}
__device__ __forceinline__ void xcd_barrier(const XcdBarrier& b) {
    asm volatile("s_waitcnt vmcnt(0)" ::: "memory");
    __syncthreads();
    if (threadIdx.x == 0) {
        unsigned* bar = b.bar;
        __builtin_amdgcn_s_waitcnt(0);
        unsigned nloc = b.st[0], nx = b.st[1];
        if (nloc == 0u) { xcd_barrier_complete(bar, b.x, nloc, nx); b.st[0] = nloc; b.st[1] = nx; }
        const unsigned old = xb_add(&bar[XB_XSUB(b.x)], 1u);
        const unsigned gen = old / nloc;
        if (old + 1u == (gen + 1u) * nloc) {
            __builtin_amdgcn_fence(__ATOMIC_RELEASE, "agent");
            asm volatile("s_waitcnt vmcnt(0)" ::: "memory");
            const unsigned og = xb_add(&bar[XB_TOP], 1u);
            const unsigned tg = og / nx;
            if (og + 1u == (tg + 1u) * nx) xb_add(&bar[XB_TOPGEN], 1u);
            else XB_SPIN(xb_ld(&bar[XB_TOPGEN]) == tg, bar);
            __builtin_amdgcn_fence(__ATOMIC_ACQUIRE, "agent");
            xb_add(&bar[XB_XGEN(b.x)], 1u);
            asm volatile("s_waitcnt vmcnt(0)" ::: "memory");
        } else {
            XB_SPIN(xb_ld(&bar[XB_XGEN(b.x)]) == gen, bar);
            __builtin_amdgcn_fence(__ATOMIC_ACQUIRE, "agent");
            asm volatile("s_waitcnt vmcnt(0)" ::: "memory");
        }
    }
    __syncthreads();
}

__global__ void __launch_bounds__(NTHR, 2) fwd_megakernel(Params P) {
    extern __shared__ __attribute__((aligned(16))) unsigned char shm[];
    LAS unsigned char* lds = (LAS unsigned char*)shm;
    cg::grid_group grid = cg::this_grid();
    const int G = gridDim.x, bid = blockIdx.x;
    volatile LAS unsigned* xst = (volatile LAS unsigned*)(lds + LDS_BYTES - 128);
    if (threadIdx.x == 0) { xst[0] = 0u; xst[1] = 0u; }
    __syncthreads();
    const XcdBarrier xb = xcd_barrier_post((unsigned*)(P.ws + OFF_BAR), xst);

#ifndef P3
#define P3 0xff
#endif
#ifndef PH
#define PH 0xff
#endif
    if (PH & 1) phase0a(P, lds);
    grid.sync();
    if (PH & 2) phase0b(P);
    xcd_barrier(xb);
    if (PH & 4) {
        pg8::Gemm g; g.A = (const bf16_t*)(P.ws + OFF_H); g.Bt = (const bf16_t*)(P.ws + OFF_WIN); g.M = NTOK; g.N = INCOLS; g.K = 1024;
        pg8::StaticOrder S; S.init(NTOK, INCOLS, G, bid);
        EpiProj E; E.ws = P.ws; E.lb = (const float*)(P.ws + OFF_LB); E.ng = P.hgrn_ng; E.kmean = (float*)(P.ws + OFF_KMEAN);
        pg8::gemm_phase<EpiProj, pg8::StaticOrder>(lds, g, S, E);
    }
    xcd_barrier(xb);
    if (PH & 8) for (int it = bid; it < 256; it += G) hgrn_item(P, it, lds);
    if (PH & 16) for (int u = bid; u < 2048; u += G) { const int bh = u & 255, jj = u >> 8; moba_unit(P, bh >> 3, bh & 7, (jj + bh) & 7, lds); }
    xcd_barrier(xb);
    if (PH & 32) for (int pm = bid; pm < NTOK / 256; pm += G) {
        if (P3 & 1) yb_norm_panel(P, pm);
        __syncthreads();
        if (P3 & 2) { pg8::Gemm g; g.A = (const bf16_t*)(P.ws + OFF_QA); g.Bt = (const bf16_t*)(P.ws + OFF_WBA); g.M = NTOK; g.N = 1024; g.K = 512;
          pg8::PanelOrder S; S.pm = pm; S.npn = 4; EpiMixA E; E.GA = (bf16_t*)(P.ws + OFF_GA);
          pg8::gemm_phase<EpiMixA, pg8::PanelOrder>(lds, g, S, E); }
        __syncthreads();
        if (P3 & 4) { pg8::Gemm g; g.A = (const bf16_t*)(P.ws + OFF_HI); g.Bt = (const bf16_t*)(P.ws + OFF_WBB); g.M = NTOK; g.N = 1024; g.K = 512;
          pg8::PanelOrder S; S.pm = pm; S.npn = 4; EpiMixB E; E.GA = (bf16_t*)(P.ws + OFF_GA); E.GB = (const bf16_t*)(P.ws + OFF_GB);
          pg8::gemm_phase<EpiMixB, pg8::PanelOrder>(lds, g, S, E); }
        __syncthreads();
        if (P3 & 8) { pg8::Gemm g; g.A = (const bf16_t*)(P.ws + OFF_GA); g.Bt = (const bf16_t*)(P.ws + OFF_WOUT); g.M = NTOK; g.N = 1024; g.K = 1024;
          pg8::PanelOrder S; S.pm = pm; S.npn = 4; EpiOut E; E.x = P.x; E.ada = (const float*)(P.ws + OFF_ADA); E.out = P.out;
          pg8::gemm_phase<EpiOut, pg8::PanelOrder>(lds, g, S, E); }
        __syncthreads();
        if (P3 & 16) ln1_panel(P, pm);
        __syncthreads();
        if (P3 & 32) { pg8::Gemm g; g.A = (const bf16_t*)(P.ws + OFF_H); g.Bt = (const bf16_t*)(P.ws + OFF_WQ); g.M = NTOK; g.N = 1024; g.K = 1024;
          pg8::PanelOrder S; S.pm = pm; S.npn = 4; EpiBf16 E; E.O = (bf16_t*)(P.ws + OFF_GB);
          pg8::gemm_phase<EpiBf16, pg8::PanelOrder>(lds, g, S, E); }
        __syncthreads();
        { const size_t tok0 = (size_t)pm * 256 + (tid_opaque() >> 6) * 32;
          peer_select_wave(P, tok0); }
        __syncthreads();
    }
    xcd_barrier(xb);
    partition_queue(P, lds, 0, [&](int p, int chunk) { peer_u_chunk(P, lds, p, chunk); });
    xcd_barrier(xb);
    partition_queue(P, lds, 8, [&](int x, int chunk) { peer_v_chunk(P, lds, x, chunk); });
    xcd_barrier(xb);
    ln2_phase(P);
}

extern "C" void kernel_launch(void* const* d_in, const int* in_sizes, int n_in, void* d_out, int out_size, void* d_ws, size_t ws_size, hipStream_t stream) {
    static int grid_blocks = 0;
    if (grid_blocks == 0) {
        if (n_in != 18 || out_size != NTOK * DM || ws_size < WS_END) { fprintf(stderr, "kernel_launch: unexpected shapes (n_in %d, out %d, ws %zu, need %zu)\n", n_in, out_size, ws_size, (size_t)WS_END); grid_blocks = -1; return; }
        int dev = 0, cus = 0, per_cu = 0;
        hipGetDevice(&dev);
        hipDeviceGetAttribute(&cus, hipDeviceAttributeMultiprocessorCount, dev);
        if (hipFuncSetAttribute((const void*)fwd_megakernel, hipFuncAttributeMaxDynamicSharedMemorySize, LDS_BYTES) != hipSuccess) fprintf(stderr, "kernel_launch: hipFuncSetAttribute failed\n");
        hipOccupancyMaxActiveBlocksPerMultiprocessor(&per_cu, (const void*)fwd_megakernel, NTHR, LDS_BYTES);
        if (per_cu < 1) { fprintf(stderr, "kernel_launch: occupancy query says %d blocks per CU\n", per_cu); per_cu = 1; }
        if (per_cu > 1) per_cu = 1;
        grid_blocks = cus * per_cu;
        (void)hipGetLastError();
    }
    if (grid_blocks < 0) return;
    Params p{};
    p.x = (const float*)d_in[0]; p.c = (const float*)d_in[1]; p.w_ada = (const float*)d_in[2]; p.b_ada = (const float*)d_in[3]; p.w_in = (const float*)d_in[4];
    p.w_ba = (const float*)d_in[5]; p.w_bb = (const float*)d_in[6]; p.w_out = (const float*)d_in[7]; p.hgrn_lb = (const float*)d_in[8]; p.hgrn_ng = (const float*)d_in[9];
    p.ln1_g = (const float*)d_in[10]; p.ln1_b = (const float*)d_in[11]; p.peer_wq = (const float*)d_in[12]; p.peer_sk = (const float*)d_in[13]; p.peer_u = (const float*)d_in[14];
    p.peer_v = (const float*)d_in[15]; p.ln2_g = (const float*)d_in[16]; p.ln2_b = (const float*)d_in[17];
    p.out = (float*)d_out; p.ws = (unsigned char*)d_ws;
    if (hipMemsetAsync((char*)d_ws + OFF_BAR, 0, XCD_BAR_WORDS * 4, stream) != hipSuccess) fprintf(stderr, "kernel_launch: memset of the barrier words failed\n");
    void* args[] = {&p};
    hipError_t e = hipLaunchCooperativeKernel((const void*)fwd_megakernel, dim3(grid_blocks), dim3(NTHR), args, LDS_BYTES, stream);
    if (e != hipSuccess) fprintf(stderr, "cooperative launch failed: %s (grid %d)\n", hipGetErrorString(e), grid_blocks);
}
```

```cpp
#include <hip/hip_runtime.h>
#include <hip/hip_cooperative_groups.h>
#include <cstdio>
#include <cstdint>
namespace cg = cooperative_groups;

#define LAS __attribute__((address_space(3)))
typedef unsigned short bf16_t;
typedef short bf16x8 __attribute__((ext_vector_type(8)));
typedef short s16x4 __attribute__((ext_vector_type(4)));
typedef float f32x2 __attribute__((ext_vector_type(2)));
typedef float f32x4 __attribute__((ext_vector_type(4)));
typedef float f32x16 __attribute__((ext_vector_type(16)));
typedef unsigned u32x2 __attribute__((ext_vector_type(2)));
typedef unsigned u32x4 __attribute__((ext_vector_type(4)));

constexpr int NB = 32, SEQ = 2048, DM = 1024, NTOK = NB * SEQ;
constexpr int INCOLS = 5632;
constexpr int NTHR = 512;
constexpr int LDS_BYTES = 147456;
constexpr float ALPHA = 1.189207115002721f;
constexpr float LN_EPS = 1e-5f, RMS_EPS = 1e-6f;
constexpr float LOG2E = 1.4426950408889634f;

constexpr size_t SZ_T512 = (size_t)NTOK * 512 * 2, SZ_T1024 = (size_t)NTOK * 1024 * 2;
constexpr size_t OFF_ADA = 0;
constexpr size_t OFF_LB = OFF_ADA + 786432;
constexpr size_t OFF_KMEAN = OFF_LB + 4096;
constexpr size_t OFF_WIN = OFF_KMEAN + 524288;
constexpr size_t OFF_WBA = OFF_WIN + (size_t)5632 * 1024 * 2;
constexpr size_t OFF_WBB = OFF_WBA + 1048576;
constexpr size_t OFF_WOUT = OFF_WBB + 1048576;
constexpr size_t OFF_WQ = OFF_WOUT + 2097152;
constexpr size_t OFF_SK = OFF_WQ + 2097152;
constexpr size_t OFF_U8 = OFF_SK + 262144;
constexpr size_t OFF_V8 = OFF_U8 + 16777216;
constexpr size_t OFF_CTR = OFF_V8 + 16777216;
constexpr size_t OFF_BAR = OFF_CTR + 4096;
constexpr size_t OFF_EG = OFF_BAR + 16384;
constexpr size_t OFF_H = OFF_EG + (size_t)NTOK * 128 * 8;
constexpr size_t OFF_QA = OFF_H + SZ_T1024;
constexpr size_t OFF_KA = OFF_QA + SZ_T512;
constexpr size_t OFF_VA = OFF_KA + SZ_T512;
constexpr size_t OFF_HQ = OFF_VA + SZ_T512;
constexpr size_t OFF_HK = OFF_HQ + SZ_T512;
constexpr size_t OFF_HI = OFF_HK + SZ_T512;
constexpr size_t OFF_HG = OFF_HI + SZ_T512;
constexpr size_t OFF_GA = OFF_HG + SZ_T512;
constexpr size_t OFF_GB = OFF_GA + SZ_T1024;
constexpr size_t WS_END = OFF_GB + SZ_T1024;
constexpr size_t OFF_W = OFF_KA;
constexpr size_t OFF_Y = OFF_KA;

struct Params {
    const float *x, *c, *w_ada, *b_ada, *w_in, *w_ba, *w_bb, *w_out, *hgrn_lb, *hgrn_ng, *ln1_g, *ln1_b, *peer_wq, *peer_sk, *peer_u, *peer_v, *ln2_g, *ln2_b;
    float* out;
    unsigned char* ws;
};

typedef __bf16 bf16v2 __attribute__((ext_vector_type(2)));
__device__ __forceinline__ unsigned cvt_pk_bf16(float lo, float hi) { return __builtin_bit_cast(unsigned, __builtin_convertvector((f32x2){lo, hi}, bf16v2)); }
__device__ __forceinline__ float bf_lo(unsigned w) { return __uint_as_float(w << 16); }
__device__ __forceinline__ float bf_hi(unsigned w) { return __uint_as_float(w & 0xffff0000u); }
__device__ __forceinline__ float sigmoidf_(float x) { return 1.0f / (1.0f + __expf(-x)); }
__device__ __forceinline__ float wave_sum(float v) {
#pragma unroll
    for (int o = 1; o < 64; o <<= 1) v += __shfl_xor(v, o);
    return v;
}
__device__ __forceinline__ int tid_opaque() { int t = threadIdx.x; asm volatile("" : "+v"(t)); return t; }
__device__ __forceinline__ int crow(int r, int hi) { return (r & 3) + 8 * (r >> 2) + 4 * hi; }
#define MFMA32(a, b, c) __builtin_amdgcn_mfma_f32_32x32x16_bf16(a, b, c, 0, 0, 0)

namespace pg8 {
constexpr int BM = 256, BK = 64, HALF = 128, HTB = HALF * BK * 2, STAGE_BYTES = 8 * HTB, NXCD = 8, WGM = 8;
__host__ __device__ __forceinline__ int lds_byte(int r, int c) { const int st = (r >> 4) * 2 + (c >> 5), rr = r & 15, cc = c & 31, ob = rr * 64 + cc * 2; return st * 1024 + (ob ^ (((ob >> 9) & 1) << 5)); }
__host__ __device__ __forceinline__ void stage_rc(int b, int& R, int& C) { const int st = b / 1024, sb = b % 1024, swz = sb ^ (((sb >> 9) & 1) << 5); R = (st >> 1) * 16 + swz / 64; C = (st & 1) * 32 + (swz % 64) / 2; }
__host__ __device__ __forceinline__ int perm32(int rho) { const int n = rho >> 4, i = rho & 15; return 8 * (i >> 2) + 4 * n + (i & 3); }

struct Unit { int pm, pn; };
struct Gemm { const bf16_t* A; const bf16_t* Bt; int M, N, K; };

struct StaticOrder {
    int nM, nN, nwg, G, c;
    __device__ void init(int M, int N, int G_, int c_) { nM = M / BM; nN = N / BM; nwg = nM * nN; G = G_; c = c_; }
    __device__ bool next(int i, Unit& u) const {
        const long L = (long)i * G + c; if (L >= nwg) return false;
        int wgid = (int)L; { const int q = nwg / NXCD, r = nwg % NXCD, xcd = wgid % NXCD, off = wgid / NXCD; wgid = (xcd < r ? xcd * (q + 1) : r * (q + 1) + (xcd - r) * q) + off; }
        const int nig = WGM * nN, gid = wgid / nig, fm = gid * WGM, gsz = (nM - fm) < WGM ? (nM - fm) : WGM;
        u.pm = fm + ((wgid % nig) % gsz); u.pn = (wgid % nig) / gsz; return true;
    }
};
struct PanelOrder {
    int pm, npn;
    __device__ bool next(int i, Unit& u) const { if (i >= npn) return false; u.pm = pm; u.pn = i; return true; }
};

template <class Epi, class Sched>
__device__ __forceinline__ void gemm_phase(LAS unsigned char* lds, const Gemm g, const Sched& S, const Epi& E) {
    const int tid = tid_opaque(), wid = __builtin_amdgcn_readfirstlane(tid >> 6), lane = tid & 63, wr = wid >> 2, wc = wid & 3, fr = lane & 15, fq = lane >> 4;
    const int K = g.K, nt = K / BK;
    unsigned voffA[2], voffB[2];
#pragma unroll
    for (int i = 0; i < 2; ++i) { int R, C; stage_rc(tid * 16 + i * 8192, R, C); const int Rb = Epi::PERM ? ((R & ~31) + perm32(R & 31)) : R;
        voffA[i] = (unsigned)(R * K + C) * 2u; voffB[i] = (unsigned)(Rb * K + C) * 2u; }
    const size_t kstep = (size_t)(BK * 2);
    const size_t hstep = (size_t)HALF * K * 2;
    const size_t tstep = 2 * hstep;
    const unsigned ldsw = (unsigned)wid * 1024u;
    const int aoff = lds_byte(wr * 64 + fr, fq * 8), boff = lds_byte(wc * 32 + fr, fq * 8);
#define PG8_SA(b, h) (((b) * 2 + (h)) * HTB)
#define PG8_SB(b, h) ((4 + (b) * 2 + (h)) * HTB)
#define PG8_STAGE(bufoff, gbase, voff) do { _Pragma("unroll") for (int _i = 0; _i < 2; ++_i) \
        __builtin_amdgcn_global_load_lds((const unsigned*)((const char*)(gbase) + (voff)[_i]), (LAS unsigned*)(lds + (bufoff) + ldsw + _i * 8192), 16, 0, 0); } while (0)
#define PG8_LDA(dst, b, h) do { _Pragma("unroll") for (int m = 0; m < 4; ++m) _Pragma("unroll") for (int k = 0; k < 2; ++k) dst[m][k] = *(const LAS bf16x8*)(lds + PG8_SA(b, h) + aoff + m * 2048 + k * 1024); } while (0)
#define PG8_LDB(dst, b, h) do { _Pragma("unroll") for (int n = 0; n < 2; ++n) _Pragma("unroll") for (int k = 0; k < 2; ++k) dst[n][k] = *(const LAS bf16x8*)(lds + PG8_SB(b, h) + boff + n * 2048 + k * 1024); } while (0)
#define PG8_MMA(ai, bj, At, Bt) do { __builtin_amdgcn_s_setprio(1); _Pragma("unroll") for (int m = 0; m < 4; ++m) _Pragma("unroll") for (int n = 0; n < 2; ++n) _Pragma("unroll") for (int k = 0; k < 2; ++k) \
        acc[ai][bj][m][n] = __builtin_amdgcn_mfma_f32_16x16x32_bf16(Bt[n][k], At[m][k], acc[ai][bj][m][n], 0, 0, 0); __builtin_amdgcn_s_setprio(0); } while (0)
#define PG8_WAIT_V(n) asm volatile("s_waitcnt vmcnt(" #n ")" ::: "memory")
#define PG8_WAIT_L(n) asm volatile("s_waitcnt lgkmcnt(" #n ")" ::: "memory")
#define PG8_BAR __builtin_amdgcn_s_barrier()
#define PG8_SCHED __builtin_amdgcn_sched_barrier(0)
    Unit cur, nxt; int ui = 0;
    if (!S.next(0, cur)) return;
    f32x4 acc[2][2][4][2];
#pragma unroll
    for (int a = 0; a < 2; ++a)
#pragma unroll
        for (int b = 0; b < 2; ++b)
#pragma unroll
            for (int m = 0; m < 4; ++m)
#pragma unroll
                for (int n = 0; n < 2; ++n) acc[a][b][m][n] = (f32x4){0.f, 0.f, 0.f, 0.f};
    bf16x8 At[4][2], B0[2][2], B1[2][2];
    const char* cA = (const char*)g.A + (size_t)cur.pm * tstep; const char* cB = (const char*)g.Bt + (size_t)cur.pn * tstep;
    PG8_STAGE(PG8_SB(0, 0), cB, voffB); PG8_STAGE(PG8_SA(0, 0), cA, voffA); PG8_STAGE(PG8_SB(0, 1), cB + hstep, voffB); PG8_STAGE(PG8_SA(0, 1), cA + hstep, voffA);
    if (wr == 1) PG8_BAR;
    PG8_WAIT_V(4); PG8_BAR;
    PG8_STAGE(PG8_SB(1, 0), cB + kstep, voffB); PG8_STAGE(PG8_SA(1, 0), cA + kstep, voffA); PG8_STAGE(PG8_SB(1, 1), cB + hstep + kstep, voffB);
    PG8_WAIT_V(6); PG8_BAR;
    for (;;) {
        const bool has_next = S.next(ui + 1, nxt);
        const char* nA = has_next ? (const char*)g.A + (size_t)nxt.pm * tstep : cA; const char* nB = has_next ? (const char*)g.Bt + (size_t)nxt.pn * tstep : cB;
        for (int t = 0; t < nt; t += 2) {
            const bool last = (t == nt - 2);
            const char* a1 = cA + (size_t)(t + 1) * kstep;
            const char* a2 = last ? nA : cA + (size_t)(t + 2) * kstep; const char* b2 = last ? nB : cB + (size_t)(t + 2) * kstep;
            const char* a3 = a2 + kstep; const char* b3 = b2 + kstep;
            PG8_LDB(B0, 0, 0); PG8_SCHED; PG8_LDA(At, 0, 0); PG8_STAGE(PG8_SA(1, 1), a1 + hstep, voffA);
            PG8_WAIT_L(8); PG8_BAR; PG8_WAIT_L(0); PG8_MMA(0, 0, At, B0); PG8_BAR; PG8_SCHED;
            PG8_LDB(B1, 0, 1); PG8_STAGE(PG8_SB(0, 0), b2, voffB);
            PG8_BAR; PG8_WAIT_L(0); PG8_MMA(0, 1, At, B1); PG8_BAR;
            PG8_LDA(At, 0, 1); PG8_STAGE(PG8_SA(0, 0), a2, voffA);
            PG8_BAR; PG8_WAIT_L(0); PG8_MMA(1, 0, At, B0); PG8_BAR; PG8_SCHED;
            PG8_STAGE(PG8_SB(0, 1), b2 + hstep, voffB);
            PG8_WAIT_V(6); PG8_BAR; PG8_MMA(1, 1, At, B1); PG8_BAR;
            PG8_LDB(B0, 1, 0); PG8_SCHED; PG8_LDA(At, 1, 0); PG8_STAGE(PG8_SA(0, 1), a2 + hstep, voffA);
            PG8_WAIT_L(8); PG8_BAR; PG8_WAIT_L(0); PG8_MMA(0, 0, At, B0); PG8_BAR; PG8_SCHED;
            PG8_LDB(B1, 1, 1); PG8_STAGE(PG8_SB(1, 0), b3, voffB);
            PG8_BAR; PG8_WAIT_L(0); PG8_MMA(0, 1, At, B1); PG8_BAR;
            PG8_LDA(At, 1, 1); PG8_STAGE(PG8_SA(1, 0), a3, voffA);
            PG8_BAR; PG8_WAIT_L(0); PG8_MMA(1, 0, At, B0); PG8_BAR; PG8_SCHED;
            PG8_STAGE(PG8_SB(1, 1), b3 + hstep, voffB);
            PG8_WAIT_V(6); PG8_BAR; PG8_MMA(1, 1, At, B1); PG8_BAR;
        }
        E(acc, cur, wr, wc, fr, fq);
        if (!has_next) break;
#pragma unroll
        for (int a = 0; a < 2; ++a)
#pragma unroll
            for (int b = 0; b < 2; ++b)
#pragma unroll
                for (int m = 0; m < 4; ++m)
#pragma unroll
                    for (int n = 0; n < 2; ++n) acc[a][b][m][n] = (f32x4){0.f, 0.f, 0.f, 0.f};
        cur = nxt; cA = nA; cB = nB; ++ui;
    }
    PG8_WAIT_V(0);
    if (wr == 0) PG8_BAR;
    PG8_BAR;
#undef PG8_SA
#undef PG8_SB
#undef PG8_STAGE
#undef PG8_LDA
#undef PG8_LDB
#undef PG8_MMA
#undef PG8_WAIT_V
#undef PG8_WAIT_L
#undef PG8_BAR
#undef PG8_SCHED
}
}
using pg8::Unit;

struct EpiProj {
    static constexpr bool PERM = true;
    unsigned char* ws; const float* lb; const float* ng; float* kmean;
    __device__ __forceinline__ void operator()(const f32x4 (&acc)[2][2][4][2], const Unit& u, int wr, int wc, int fr, int fq) const {
        const int pn = u.pn; int seg, colt, ldc; size_t boff;
        if (pn < 14) { seg = pn >> 1; colt = (pn & 1) * 256; ldc = 512; boff = OFF_QA + (size_t)seg * SZ_T512; }
        else if (pn < 18) { seg = 7; colt = (pn - 14) * 256; ldc = 1024; boff = OFF_GA; }
        else { seg = 8; colt = (pn - 18) * 256; ldc = 1024; boff = OFF_GB; }
        bf16_t* base = (bf16_t*)(ws + boff);
        const int row0 = u.pm * 256 + wr * 64 + fr, col0 = colt + wc * 32 + 8 * fq;
        float pv[2][8];
#pragma unroll
        for (int bj = 0; bj < 2; ++bj)
#pragma unroll
            for (int e = 0; e < 8; ++e) pv[bj][e] = (seg == 4) ? (1.0f - lb[col0 + bj * 128 + e]) : ((seg == 6) ? ng[col0 + bj * 128 + e] : 0.f);
        float cs[2][8];
#pragma unroll
        for (int bj = 0; bj < 2; ++bj)
#pragma unroll
            for (int e = 0; e < 8; ++e) cs[bj][e] = 0.f;
#pragma unroll
        for (int ai = 0; ai < 2; ++ai)
#pragma unroll
            for (int m = 0; m < 4; ++m) {
                bf16_t* rowp = base + (size_t)(row0 + ai * 128 + m * 16) * ldc + col0;
#pragma unroll
                for (int bj = 0; bj < 2; ++bj) {
                    float v[8];
#pragma unroll
                    for (int e = 0; e < 4; ++e) { v[e] = acc[ai][bj][m][0][e]; v[4 + e] = acc[ai][bj][m][1][e]; }
                    if (seg == 0) {
#pragma unroll
                        for (int e = 0; e < 8; ++e) v[e] *= (0.125f * LOG2E);
                    } else if (seg == 1) {
#pragma unroll
                        for (int e = 0; e < 8; ++e) cs[bj][e] += v[e];
                    } else if (seg == 3) {
#pragma unroll
                        for (int e = 0; e < 8; ++e) v[e] = v[e] * sigmoidf_(v[e]);
                    } else if (seg == 4) {
#pragma unroll
                        for (int e = 0; e < 8; ++e) v[e] = pv[bj][e] * sigmoidf_(-v[e]);
                    } else if (seg == 6) {
#pragma unroll
                        for (int e = 0; e < 8; ++e) v[e] = pv[bj][e] * v[e] * sigmoidf_(v[e]);
                    } else if (seg >= 7) {
#pragma unroll
                        for (int e = 0; e < 8; ++e) v[e] = sigmoidf_(v[e]);
                    }
                    u32x4 w; w.x = cvt_pk_bf16(v[0], v[1]); w.y = cvt_pk_bf16(v[2], v[3]); w.z = cvt_pk_bf16(v[4], v[5]); w.w = cvt_pk_bf16(v[6], v[7]);
                    *(u32x4*)(rowp + bj * 128) = w;
                }
            }
        if (seg == 1) {
#pragma unroll
            for (int bj = 0; bj < 2; ++bj)
#pragma unroll
                for (int e = 0; e < 8; ++e) {
                    float s = cs[bj][e];
                    s += __shfl_xor(s, 1); s += __shfl_xor(s, 2); s += __shfl_xor(s, 4); s += __shfl_xor(s, 8);
                    if (fr == 0) atomicAdd(kmean + (size_t)u.pm * 512 + col0 + bj * 128 + e, s);
                }
        }
    }
};
struct EpiMixA {
    static constexpr bool PERM = true;
    bf16_t* GA;
    __device__ __forceinline__ void operator()(const f32x4 (&acc)[2][2][4][2], const Unit& u, int wr, int wc, int fr, int fq) const {
        const int row0 = u.pm * 256 + wr * 64 + fr, col0 = u.pn * 256 + wc * 32 + 8 * fq;
#pragma unroll
        for (int ai = 0; ai < 2; ++ai)
#pragma unroll
            for (int m = 0; m < 4; ++m) {
                bf16_t* rowp = GA + (size_t)(row0 + ai * 128 + m * 16) * 1024 + col0;
#pragma unroll
                for (int bj = 0; bj < 2; ++bj) {
                    const u32x4 g = *(const u32x4*)(rowp + bj * 128);
                    const f32x4 a0 = acc[ai][bj][m][0], a1 = acc[ai][bj][m][1];
                    u32x4 w;
                    w.x = cvt_pk_bf16(bf_lo(g.x) * a0[0], bf_hi(g.x) * a0[1]); w.y = cvt_pk_bf16(bf_lo(g.y) * a0[2], bf_hi(g.y) * a0[3]);
                    w.z = cvt_pk_bf16(bf_lo(g.z) * a1[0], bf_hi(g.z) * a1[1]); w.w = cvt_pk_bf16(bf_lo(g.w) * a1[2], bf_hi(g.w) * a1[3]);
                    *(u32x4*)(rowp + bj * 128) = w;
                }
            }
    }
};
struct EpiMixB {
    static constexpr bool PERM = true;
    bf16_t* GA; const bf16_t* GB;
    __device__ __forceinline__ void operator()(const f32x4 (&acc)[2][2][4][2], const Unit& u, int wr, int wc, int fr, int fq) const {
        const int row0 = u.pm * 256 + wr * 64 + fr, col0 = u.pn * 256 + wc * 32 + 8 * fq;
#pragma unroll
        for (int ai = 0; ai < 2; ++ai)
#pragma unroll
            for (int m = 0; m < 4; ++m) {
                const size_t off = (size_t)(row0 + ai * 128 + m * 16) * 1024 + col0;
#pragma unroll
                for (int bj = 0; bj < 2; ++bj) {
                    const u32x4 g = *(const u32x4*)(GB + off + bj * 128);
                    const u32x4 mx = *(const u32x4*)(GA + off + bj * 128);
                    const f32x4 a0 = acc[ai][bj][m][0], a1 = acc[ai][bj][m][1];
                    u32x4 w;
                    w.x = cvt_pk_bf16(bf_lo(mx.x) + bf_lo(g.x) * a0[0], bf_hi(mx.x) + bf_hi(g.x) * a0[1]); w.y = cvt_pk_bf16(bf_lo(mx.y) + bf_lo(g.y) * a0[2], bf_hi(mx.y) + bf_hi(g.y) * a0[3]);
                    w.z = cvt_pk_bf16(bf_lo(mx.z) + bf_lo(g.z) * a1[0], bf_hi(mx.z) + bf_hi(g.z) * a1[1]); w.w = cvt_pk_bf16(bf_lo(mx.w) + bf_lo(g.w) * a1[2], bf_hi(mx.w) + bf_hi(g.w) * a1[3]);
                    *(u32x4*)(GA + off + bj * 128) = w;
                }
            }
    }
};
struct EpiOut {
    static constexpr bool PERM = false;
    const float* x; const float* ada; float* out;
    __device__ __forceinline__ void operator()(const f32x4 (&acc)[2][2][4][2], const Unit& u, int wr, int wc, int fr, int fq) const {
        const int row0 = u.pm * 256 + wr * 64 + fr, col0 = u.pn * 256 + wc * 32 + 4 * fq;
        const float* gt1 = ada + (size_t)(u.pm >> 3) * 6144 + 2048;
#pragma unroll
        for (int ai = 0; ai < 2; ++ai)
#pragma unroll
            for (int m = 0; m < 4; ++m) {
                const size_t off = (size_t)(row0 + ai * 128 + m * 16) * 1024 + col0;
#pragma unroll
                for (int bj = 0; bj < 2; ++bj)
#pragma unroll
                    for (int n = 0; n < 2; ++n) {
                        const int cc = bj * 128 + n * 16;
                        const f32x4 xv = *(const f32x4*)(x + off + cc), gv = *(const f32x4*)(gt1 + col0 + cc);
                        *(f32x4*)(out + off + cc) = xv * ALPHA + gv * acc[ai][bj][m][n];
                    }
            }
    }
};
struct EpiBf16 {
    static constexpr bool PERM = true;
    bf16_t* O;
    __device__ __forceinline__ void operator()(const f32x4 (&acc)[2][2][4][2], const Unit& u, int wr, int wc, int fr, int fq) const {
        const int row0 = u.pm * 256 + wr * 64 + fr, col0 = u.pn * 256 + wc * 32 + 8 * fq;
#pragma unroll
        for (int ai = 0; ai < 2; ++ai)
#pragma unroll
            for (int m = 0; m < 4; ++m) {
                bf16_t* rowp = O + (size_t)(row0 + ai * 128 + m * 16) * 1024 + col0;
#pragma unroll
                for (int bj = 0; bj < 2; ++bj) {
                    const f32x4 a0 = acc[ai][bj][m][0], a1 = acc[ai][bj][m][1];
                    u32x4 w; w.x = cvt_pk_bf16(a0[0], a0[1]); w.y = cvt_pk_bf16(a0[2], a0[3]); w.z = cvt_pk_bf16(a1[0], a1[1]); w.w = cvt_pk_bf16(a1[2], a1[3]);
                    *(u32x4*)(rowp + bj * 128) = w;
                }
            }
    }
};

__device__ void phase0a(const Params& P, LAS unsigned char* lds) {
    const int tid = tid_opaque(), G = gridDim.x, bid = blockIdx.x;
    for (int it = bid; it < 192; it += G) {
        LAS float* sc = (LAS float*)lds;
        for (int i = tid; i < 32 * 1024; i += NTHR) { const float cv = P.c[i]; sc[i] = cv * sigmoidf_(cv); }
        __syncthreads();
        const int kg = tid >> 5, col = tid & 31;
        float a[32];
#pragma unroll
        for (int b = 0; b < 32; ++b) a[b] = 0.f;
#pragma unroll 1
        for (int k = kg * 64; k < kg * 64 + 64; k += 8) {
            float w[8];
#pragma unroll
            for (int e = 0; e < 8; ++e) w[e] = __builtin_nontemporal_load(P.w_ada + (size_t)(k + e) * 6144 + it * 32 + col);
#pragma unroll
            for (int e4 = 0; e4 < 2; ++e4) {
#pragma unroll
                for (int b = 0; b < 32; ++b) { const f32x4 s = *(const LAS f32x4*)(sc + b * 1024 + k + 4 * e4); a[b] += s[0] * w[4 * e4] + s[1] * w[4 * e4 + 1] + s[2] * w[4 * e4 + 2] + s[3] * w[4 * e4 + 3]; }
                asm volatile("" ::: "memory");
            }
        }
        __syncthreads();
        LAS float* red = (LAS float*)lds;
#pragma unroll
        for (int b = 0; b < 32; ++b) red[(kg * 32 + b) * 32 + col] = a[b];
        __syncthreads();
        for (int o = tid; o < 1024; o += NTHR) { const int b = o >> 5, cc = o & 31; float s = 0.f;
#pragma unroll
            for (int g2 = 0; g2 < 16; ++g2) s += red[(g2 * 32 + b) * 32 + cc];
            ((float*)(P.ws + OFF_ADA))[(size_t)b * 6144 + it * 32 + cc] = s + P.b_ada[it * 32 + cc]; }
        __syncthreads();
    }
    const size_t gtid = (size_t)bid * NTHR + tid, gsz = (size_t)G * NTHR;
    for (size_t i = gtid; i < 512; i += gsz) ((float*)(P.ws + OFF_LB))[i] = sigmoidf_(P.hgrn_lb[i] - P.hgrn_lb[512 + i]);
    for (size_t i = gtid; i < 32 * 8 * 512; i += gsz) ((float*)(P.ws + OFF_KMEAN))[i] = 0.f;
    {
        LAS float* tile = (LAS float*)lds;
        const int I0 = 16 * 88, I1 = I0 + 8 * 16, I2 = I1 + 8 * 16, I3 = I2 + 16 * 16, I4 = I3 + 16 * 16;
        for (int it = bid; it < I4; it += G) {
            const float* W; bf16_t* WT; int K, N, r;
            if (it < I0) { W = P.w_in; WT = (bf16_t*)(P.ws + OFF_WIN); K = 1024; N = 5632; r = it; }
            else if (it < I1) { W = P.w_ba; WT = (bf16_t*)(P.ws + OFF_WBA); K = 512; N = 1024; r = it - I0; }
            else if (it < I2) { W = P.w_bb; WT = (bf16_t*)(P.ws + OFF_WBB); K = 512; N = 1024; r = it - I1; }
            else if (it < I3) { W = P.w_out; WT = (bf16_t*)(P.ws + OFF_WOUT); K = 1024; N = 1024; r = it - I2; }
            else { W = P.peer_wq; WT = (bf16_t*)(P.ws + OFF_WQ); K = 1024; N = 1024; r = it - I3; }
            const int nb = N / 64, k0 = (r / nb) * 64, n0 = (r % nb) * 64;
#pragma unroll
            for (int ps = 0; ps < 2; ++ps) { const int kk = (tid >> 4) + 32 * ps, n4 = (tid & 15) * 4;
                const f32x4 v = *(const f32x4*)(W + (size_t)(k0 + kk) * N + n0 + n4);
                tile[kk * 65 + n4] = v[0]; tile[kk * 65 + n4 + 1] = v[1]; tile[kk * 65 + n4 + 2] = v[2]; tile[kk * 65 + n4 + 3] = v[3]; }
            __syncthreads();
            { const int n = tid >> 3, kc = (tid & 7) * 8; u32x4 w;
              w.x = cvt_pk_bf16(tile[(kc + 0) * 65 + n], tile[(kc + 1) * 65 + n]); w.y = cvt_pk_bf16(tile[(kc + 2) * 65 + n], tile[(kc + 3) * 65 + n]);
              w.z = cvt_pk_bf16(tile[(kc + 4) * 65 + n], tile[(kc + 5) * 65 + n]); w.w = cvt_pk_bf16(tile[(kc + 6) * 65 + n], tile[(kc + 7) * 65 + n]);
              *(u32x4*)(WT + (size_t)(n0 + n) * K + k0 + kc) = w; }
            __syncthreads();
        }
    }
    {
        if (gtid < 64) ((unsigned*)(P.ws + OFF_CTR))[gtid] = 0u;
        for (size_t i = gtid; i < 16384; i += gsz) {
            const float* src = P.peer_sk + i * 8; const f32x4 a = *(const f32x4*)src, b = *(const f32x4*)(src + 4);
            u32x4 w; w.x = cvt_pk_bf16(a[0], a[1]); w.y = cvt_pk_bf16(a[2], a[3]); w.z = cvt_pk_bf16(b[0], b[1]); w.w = cvt_pk_bf16(b[2], b[3]);
            *(u32x4*)((bf16_t*)(P.ws + OFF_SK) + i * 8) = w;
        }
        const size_t NV = (size_t)16384 * 1024 / 8;
        for (size_t i = gtid; i < 2 * NV; i += gsz) {
            const bool isv = i >= NV; const size_t j = isv ? i - NV : i;
            const float* src = (isv ? P.peer_v : P.peer_u) + j * 8; const float sc = isv ? 4.0f : 32.0f;
            const f32x4 a = *(const f32x4*)src * sc, b = *(const f32x4*)(src + 4) * sc;
            int w0 = __builtin_amdgcn_cvt_pk_fp8_f32(a[0], a[1], 0, false); w0 = __builtin_amdgcn_cvt_pk_fp8_f32(a[2], a[3], w0, true);
            int w1 = __builtin_amdgcn_cvt_pk_fp8_f32(b[0], b[1], 0, false); w1 = __builtin_amdgcn_cvt_pk_fp8_f32(b[2], b[3], w1, true);
            u32x2 w; w.x = (unsigned)w0; w.y = (unsigned)w1;
            size_t dst;
            dst = (isv ? OFF_V8 : OFF_U8) + j * 8;
            *(u32x2*)(P.ws + dst) = w;
        }
    }
}
__device__ void phase0b(const Params& P) {
    const size_t gtid = (size_t)blockIdx.x * NTHR + threadIdx.x, gsz = (size_t)gridDim.x * NTHR;
    const float* ada = (const float*)(P.ws + OFF_ADA); bf16_t* H = (bf16_t*)(P.ws + OFF_H);
    for (size_t i = gtid; i < (size_t)NTOK * 128; i += gsz) {
        const size_t row = i >> 7; const int c8 = (int)(i & 127) * 8; const int b = (int)(row >> 11);
        const float* xr = P.x + row * 1024 + c8; const float* sh = ada + (size_t)b * 6144 + c8; const float* sc = sh + 1024;
        const f32x4 x0 = *(const f32x4*)xr, x1 = *(const f32x4*)(xr + 4), s0 = *(const f32x4*)sc, s1 = *(const f32x4*)(sc + 4), h0 = *(const f32x4*)sh, h1 = *(const f32x4*)(sh + 4);
        const f32x4 r0 = x0 * (s0 + 1.0f) + h0, r1 = x1 * (s1 + 1.0f) + h1;
        u32x4 w; w.x = cvt_pk_bf16(r0[0], r0[1]); w.y = cvt_pk_bf16(r0[2], r0[3]); w.z = cvt_pk_bf16(r1[0], r1[1]); w.w = cvt_pk_bf16(r1[2], r1[3]);
        *(u32x4*)(H + row * 1024 + c8) = w;
    }
}

__device__ __forceinline__ s16x4 tr4(const LAS unsigned char* p) { return __builtin_bit_cast(s16x4, __builtin_amdgcn_ds_read_tr16_b64_v4i16((LAS s16x4*)p)); }
__device__ void hgrn_item(const Params& P, int item, LAS unsigned char* lds) {
    const int tid = tid_opaque(), lane = tid & 63, wid = __builtin_amdgcn_readfirstlane(tid >> 6), r32 = lane & 31, hi = lane >> 5;
    const int b = item >> 3, h = (item >> 1) & 3, vh = item & 1;
    const bf16_t* HQ = (const bf16_t*)(P.ws + OFF_HQ); const bf16_t* HK = (const bf16_t*)(P.ws + OFF_HK); bf16_t* HI = (bf16_t*)(P.ws + OFF_HI);
    constexpr int SQ = 272, SKD = 320, SV = 192, SS = 192;
    constexpr int LQR = 0, LKR = 17408, LQB = 34816, LKD = 52224, LV = 72704, LS = 84992, LG = 109568, LT = 142336, LCL = 144384;
    LAS float* G = (LAS float*)(lds + LG); LAS float* TOT = (LAS float*)(lds + LT); LAS float* CL = (LAS float*)(lds + LCL);
    const size_t rowb = (size_t)b * SEQ;
    const int row = tid >> 3, seg = tid & 7;
    const bf16_t* qsrc = HQ + (rowb + row) * 512 + h * 128 + seg * 16; const bf16_t* ksrc = HK + (rowb + row) * 512 + h * 128 + seg * 16;
    bf16_t* vsrc = HI + (rowb + row) * 512 + h * 128 + vh * 64 + seg * 8;
    for (int i = tid; i < 128 * SS / 4; i += NTHR) ((LAS unsigned*)(lds + LS))[i] = 0u;
    f32x16 Sacc = {};
    const int di = wid >> 1, vi = wid & 1, ti = wid >> 1;
    const int tg = lane >> 4, tc = tg & 1, tI = lane & 15;
    const int trow = 4 * hi + (tI >> 2), tcol = 16 * tc + 4 * (tI & 3);
    u32x4 qn0 = *(const u32x4*)qsrc, qn1 = *(const u32x4*)(qsrc + 8), kn0 = *(const u32x4*)ksrc, kn1 = *(const u32x4*)(ksrc + 8), vn = *(const u32x4*)vsrc;
#pragma unroll 1
    for (int n = 0; n < SEQ / 64; ++n) {
        const u32x4 q0 = qn0, q1 = qn1, k0 = kn0, k1 = kn1, vv = vn;
        float qf[16] = {bf_lo(q0.x), bf_hi(q0.x), bf_lo(q0.y), bf_hi(q0.y), bf_lo(q0.z), bf_hi(q0.z), bf_lo(q0.w), bf_hi(q0.w), bf_lo(q1.x), bf_hi(q1.x), bf_lo(q1.y), bf_hi(q1.y), bf_lo(q1.z), bf_hi(q1.z), bf_lo(q1.w), bf_hi(q1.w)};
        float kf[16] = {bf_lo(k0.x), bf_hi(k0.x), bf_lo(k0.y), bf_hi(k0.y), bf_lo(k0.z), bf_hi(k0.z), bf_lo(k0.w), bf_hi(k0.w), bf_lo(k1.x), bf_hi(k1.x), bf_lo(k1.y), bf_hi(k1.y), bf_lo(k1.z), bf_hi(k1.z), bf_lo(k1.w), bf_hi(k1.w)};
#pragma unroll
        for (int e4 = 0; e4 < 4; ++e4) *(LAS f32x4*)(G + row * 128 + seg * 16 + 4 * e4) = (f32x4){__logf(1.0f - kf[4 * e4]), __logf(1.0f - kf[4 * e4 + 1]), __logf(1.0f - kf[4 * e4 + 2]), __logf(1.0f - kf[4 * e4 + 3])};
        *(LAS u32x4*)(lds + LV + row * SV + seg * 16) = vv;
        if (n + 1 < SEQ / 64) { const size_t o = (size_t)(n + 1) * 64 * 512; qn0 = *(const u32x4*)(qsrc + o); qn1 = *(const u32x4*)(qsrc + o + 8); kn0 = *(const u32x4*)(ksrc + o); kn1 = *(const u32x4*)(ksrc + o + 8); vn = *(const u32x4*)(vsrc + o); }
        __syncthreads();
        { const int d = tid & 127, q4 = tid >> 7; float s = 0.f;
#pragma unroll
          for (int i = 0; i < 16; ++i) { s += G[(16 * q4 + i) * 128 + d]; G[(16 * q4 + i) * 128 + d] = s; }
          TOT[q4 * 128 + d] = s; }
        __syncthreads();
        {
            const int qq = row >> 4;
#pragma unroll
            for (int e4 = 0; e4 < 4; ++e4) {
                const int d4 = seg * 16 + 4 * e4;
                const f32x4 t0 = *(const LAS f32x4*)(TOT + d4), t1 = *(const LAS f32x4*)(TOT + 128 + d4), t2 = *(const LAS f32x4*)(TOT + 256 + d4), t3 = *(const LAS f32x4*)(TOT + 384 + d4);
                const f32x4 off = (qq == 0) ? (f32x4){0.f, 0.f, 0.f, 0.f} : ((qq == 1) ? t0 : ((qq == 2) ? t0 + t1 : t0 + t1 + t2));
                const f32x4 bb = *(const LAS f32x4*)(G + row * 128 + d4) + off;
                const f32x4 bref = *(const LAS f32x4*)(G + 32 * 128 + d4) + t0 + t1, blast = t0 + t1 + t2 + t3;
                float vqb[4], vqr[4], vkr[4], vkd[4];
#pragma unroll
                for (int e = 0; e < 4; ++e) {
                    const float e1 = __expf(bb[e]), e2 = __expf(-bb[e]);
                    vqb[e] = qf[4 * e4 + e] * e1; vqr[e] = vqb[e] * __expf(-bref[e]);
                    const float ke = kf[4 * e4 + e] * e2; vkr[e] = ke * __expf(bref[e]); vkd[e] = ke * __expf(blast[e]);
                }
                *(LAS u32x2*)(lds + LQB + row * SQ + seg * 32 + 8 * e4) = (u32x2){cvt_pk_bf16(vqb[0], vqb[1]), cvt_pk_bf16(vqb[2], vqb[3])};
                *(LAS u32x2*)(lds + LQR + row * SQ + seg * 32 + 8 * e4) = (u32x2){cvt_pk_bf16(vqr[0], vqr[1]), cvt_pk_bf16(vqr[2], vqr[3])};
                *(LAS u32x2*)(lds + LKR + row * SQ + seg * 32 + 8 * e4) = (u32x2){cvt_pk_bf16(vkr[0], vkr[1]), cvt_pk_bf16(vkr[2], vkr[3])};
                *(LAS u32x2*)(lds + LKD + row * SKD + seg * 32 + 8 * e4) = (u32x2){cvt_pk_bf16(vkd[0], vkd[1]), cvt_pk_bf16(vkd[2], vkd[3])};
                if (row == 0) *(LAS f32x4*)(CL + d4) = (f32x4){__expf(blast[0]), __expf(blast[1]), __expf(blast[2]), __expf(blast[3])};
                asm volatile("" ::: "memory");
            }
        }
        __syncthreads();
        if (wid < 4) {
            f32x16 Z = {};
            for (int si = 0; si <= ti; ++si) {
                f32x16 X = {};
#pragma unroll
                for (int ks = 0; ks < 8; ++ks) {
                    const bf16x8 a = *(const LAS bf16x8*)(lds + LKR + (32 * si + r32) * SQ + (16 * ks + 8 * hi) * 2);
                    const bf16x8 bq = *(const LAS bf16x8*)(lds + LQR + (32 * ti + r32) * SQ + (16 * ks + 8 * hi) * 2);
                    X = MFMA32(a, bq, X);
                }
                if (si == ti) {
#pragma unroll
                    for (int r = 0; r < 16; ++r) if (crow(r, hi) > r32) X[r] = 0.f;
                }
#pragma unroll
                for (int s2 = 0; s2 < 2; ++s2) {
                    union { u32x4 u; bf16x8 v; } pa;
                    pa.u.x = cvt_pk_bf16(X[8 * s2 + 0], X[8 * s2 + 1]); pa.u.y = cvt_pk_bf16(X[8 * s2 + 2], X[8 * s2 + 3]); pa.u.z = cvt_pk_bf16(X[8 * s2 + 4], X[8 * s2 + 5]); pa.u.w = cvt_pk_bf16(X[8 * s2 + 6], X[8 * s2 + 7]);
                    const LAS unsigned char* vp = lds + LV + (32 * si + 16 * s2 + trow) * SV + (32 * vi + tcol) * 2;
                    const s16x4 lo = tr4(vp), hh = tr4(vp + 8 * SV);
                    const bf16x8 vf = {lo[0], lo[1], lo[2], lo[3], hh[0], hh[1], hh[2], hh[3]};
                    Z = MFMA32(pa.v, vf, Z);
                }
            }
#pragma unroll
            for (int ks = 0; ks < 8; ++ks) {
                const bf16x8 a = *(const LAS bf16x8*)(lds + LQB + (32 * ti + r32) * SQ + (16 * ks + 8 * hi) * 2);
                const LAS unsigned char* sp = lds + LS + (16 * ks + 8 * hi + (tI >> 2)) * SS + (32 * vi + tcol) * 2;
                const s16x4 lo = tr4(sp), hh = tr4(sp + 4 * SS);
                const bf16x8 sf = {lo[0], lo[1], lo[2], lo[3], hh[0], hh[1], hh[2], hh[3]};
                Z = MFMA32(a, sf, Z);
            }
            bf16_t* op = HI + (rowb + (size_t)n * 64 + 32 * ti) * 512 + h * 128 + vh * 64 + 32 * vi + r32;
#pragma unroll
            for (int r = 0; r < 16; ++r) op[(size_t)crow(r, hi) * 512] = (bf16_t)(cvt_pk_bf16(Z[r], 0.f) & 0xffffu);
        }
        {
#pragma unroll
            for (int r = 0; r < 16; ++r) Sacc[r] *= CL[32 * di + crow(r, hi)];
#pragma unroll
            for (int ks = 0; ks < 4; ++ks) {
                const LAS unsigned char* kp = lds + LKD + (16 * ks + 8 * hi + (tI >> 2)) * SKD + (32 * di + tcol) * 2;
                const s16x4 klo = tr4(kp), khi = tr4(kp + 4 * SKD);
                const bf16x8 ka = {klo[0], klo[1], klo[2], klo[3], khi[0], khi[1], khi[2], khi[3]};
                const LAS unsigned char* vp = lds + LV + (16 * ks + 8 * hi + (tI >> 2)) * SV + (32 * vi + tcol) * 2;
                const s16x4 vlo = tr4(vp), vhi = tr4(vp + 4 * SV);
                const bf16x8 vb = {vlo[0], vlo[1], vlo[2], vlo[3], vhi[0], vhi[1], vhi[2], vhi[3]};
                Sacc = MFMA32(ka, vb, Sacc);
            }
        }
        __syncthreads();
        {
            LAS bf16_t* sp = (LAS bf16_t*)(lds + LS + (32 * di) * SS + (32 * vi + r32) * 2);
#pragma unroll
            for (int r = 0; r < 16; ++r) sp[crow(r, hi) * (SS / 2)] = (bf16_t)(cvt_pk_bf16(Sacc[r], 0.f) & 0xffffu);
        }
    }
    __syncthreads();
}

__device__ void moba_unit(const Params& P, int b, int h, int j, LAS unsigned char* lds) {
    const int tid = tid_opaque(), lane = tid & 63, wid = tid >> 6, r32 = lane & 31, hi = lane >> 5;
    bf16_t* Q = (bf16_t*)(P.ws + OFF_QA); const bf16_t* Kg = (const bf16_t*)(P.ws + OFF_KA); const bf16_t* Vg = (const bf16_t*)(P.ws + OFF_VA);
    const float* kmean = (const float*)(P.ws + OFF_KMEAN);
    constexpr int KIMG = 64 * 144, VIMG = 64 * 192, LK = 0, LV = 2 * KIMG, LKM = 2 * KIMG + 2 * VIMG;
    LAS float* kmL = (LAS float*)(lds + LKM);
    const size_t rowb = (size_t)b * SEQ; const int q0 = j * 256;
    if (tid < j * 64) kmL[tid] = kmean[(size_t)(b * 8 + (tid >> 6)) * 512 + h * 64 + (tid & 63)];
    bf16_t* qrow = Q + (rowb + q0 + wid * 32 + r32) * 512 + h * 64;
    bf16x8 qf[4];
#pragma unroll
    for (int d0 = 0; d0 < 4; ++d0) qf[d0] = *(const bf16x8*)(qrow + 16 * d0 + 8 * hi);
    const int srow = tid >> 3, sch = tid & 7;
    const bf16_t* ksrc = Kg + (rowb + srow) * 512 + h * 64 + sch * 8; const bf16_t* vsrc = Vg + (rowb + srow) * 512 + h * 64 + sch * 8;
    const int ntile = 4 * (j + 1);
    u32x4 kreg, vreg;
    { const int key0 = q0; kreg = *(const u32x4*)(ksrc + (size_t)key0 * 512); vreg = *(const u32x4*)(vsrc + (size_t)key0 * 512); }
    *(LAS u32x4*)(lds + LK + srow * 144 + sch * 16) = kreg; *(LAS u32x4*)(lds + LV + srow * 192 + sch * 16) = vreg;
    __syncthreads();
    unsigned sel = 0;
    if (j <= 3) sel = (1u << j) - 1u;
    else {
        float g[7];
#pragma unroll
        for (int n = 0; n < 7; ++n) { float s = 0.f;
            if (n < j) {
#pragma unroll
                for (int d0 = 0; d0 < 4; ++d0)
#pragma unroll
                    for (int e = 0; e < 8; ++e) s += __uint_as_float(((unsigned)(unsigned short)qf[d0][e]) << 16) * kmL[n * 64 + 16 * d0 + 8 * hi + e];
            }
            s += __shfl_xor(s, 32); g[n] = s; }
#pragma unroll
        for (int it = 0; it < 3; ++it) { float best = -INFINITY; int bi = 0;
#pragma unroll
            for (int n = 0; n < 7; ++n) if (n < j && !((sel >> n) & 1u) && g[n] > best) { best = g[n]; bi = n; }
            sel |= 1u << bi; }
    }
    const float ch = exp2f(-(float)(h + 1)) * LOG2E;
    const int qb = wid * 32 + r32;
    float m_run = -1e30f, l_run = 0.f;
    f32x16 o0 = {}, o1 = {};
    const int tg = lane >> 4, tc = tg & 1, ti = lane & 15;
    const int vlane = (4 * hi + (ti >> 2)) * 192 + (16 * tc + 4 * (ti & 3)) * 2;
#pragma unroll 1
    for (int i = 0; i < ntile; ++i) {
        const int buf = i & 1;
        const bool own = i < 4; const int blk = own ? j : ((i - 4) >> 2), kt = own ? i : ((i - 4) & 3);
        if (i + 1 < ntile) { const int i1 = i + 1; const int blk1 = (i1 < 4) ? j : ((i1 - 4) >> 2), kt1 = (i1 < 4) ? i1 : ((i1 - 4) & 3); const size_t key1 = (size_t)(blk1 * 256 + kt1 * 64);
            kreg = *(const u32x4*)(ksrc + key1 * 512); vreg = *(const u32x4*)(vsrc + key1 * 512); }
        const bool lane_ok = own ? true : (((sel >> blk) & 1u) != 0u);
        const bool skip = own ? (64 * kt > 32 * wid + 31) : (__ballot(lane_ok) == 0ull);
        if (!skip) {
            LAS unsigned char* kb = lds + LK + buf * KIMG; LAS unsigned char* vb = lds + LV + buf * VIMG;
            f32x16 p0 = {}, p1 = {};
#pragma unroll
            for (int d0 = 0; d0 < 4; ++d0) {
                const bf16x8 kf0 = *(const LAS bf16x8*)(kb + r32 * 144 + (16 * d0 + 8 * hi) * 2);
                const bf16x8 kf1 = *(const LAS bf16x8*)(kb + (32 + r32) * 144 + (16 * d0 + 8 * hi) * 2);
                p0 = MFMA32(kf0, qf[d0], p0); p1 = MFMA32(kf1, qf[d0], p1);
            }
            const float kbase = ch * (float)((blk - j) * 256 + kt * 64);
            float mt = -1e30f;
#pragma unroll
            for (int r = 0; r < 16; ++r) {
                const int kl0 = crow(r, hi), kl1 = kl0 + 32;
                const float t0 = p0[r] + (kbase + ch * (float)kl0), t1 = p1[r] + (kbase + ch * (float)kl1);
                const bool v0 = own ? (kt * 64 + kl0 <= qb) : lane_ok, v1 = own ? (kt * 64 + kl1 <= qb) : lane_ok;
                p0[r] = v0 ? t0 : -1e30f; p1[r] = v1 ? t1 : -1e30f;
                mt = fmaxf(mt, fmaxf(p0[r], p1[r]));
            }
            mt = fmaxf(mt, __shfl_xor(mt, 32));
            const float mnew = fmaxf(m_run, mt), alpha = __builtin_amdgcn_exp2f(m_run - mnew);
            m_run = mnew;
            float rs = 0.f;
#pragma unroll
            for (int r = 0; r < 16; ++r) { p0[r] = __builtin_amdgcn_exp2f(p0[r] - mnew); p1[r] = __builtin_amdgcn_exp2f(p1[r] - mnew); rs += p0[r] + p1[r]; }
            l_run = l_run * alpha + rs;
#pragma unroll
            for (int r = 0; r < 16; ++r) { o0[r] *= alpha; o1[r] *= alpha; }
#pragma unroll
            for (int sub = 0; sub < 2; ++sub)
#pragma unroll
                for (int s = 0; s < 2; ++s) {
                    union { u32x4 u; bf16x8 v; } pb;
                    if (sub == 0) { pb.u.x = cvt_pk_bf16(p0[8 * s + 0], p0[8 * s + 1]); pb.u.y = cvt_pk_bf16(p0[8 * s + 2], p0[8 * s + 3]); pb.u.z = cvt_pk_bf16(p0[8 * s + 4], p0[8 * s + 5]); pb.u.w = cvt_pk_bf16(p0[8 * s + 6], p0[8 * s + 7]); }
                    else { pb.u.x = cvt_pk_bf16(p1[8 * s + 0], p1[8 * s + 1]); pb.u.y = cvt_pk_bf16(p1[8 * s + 2], p1[8 * s + 3]); pb.u.z = cvt_pk_bf16(p1[8 * s + 4], p1[8 * s + 5]); pb.u.w = cvt_pk_bf16(p1[8 * s + 6], p1[8 * s + 7]); }
#pragma unroll
                    for (int dt = 0; dt < 2; ++dt) {
                        LAS unsigned char* va = vb + (32 * sub + 16 * s) * 192 + dt * 64 + vlane;
                        const s16x4 lo = __builtin_bit_cast(s16x4, __builtin_amdgcn_ds_read_tr16_b64_v4i16((LAS s16x4*)va));
                        const s16x4 hh = __builtin_bit_cast(s16x4, __builtin_amdgcn_ds_read_tr16_b64_v4i16((LAS s16x4*)(va + 8 * 192)));
                        const bf16x8 vf = {lo[0], lo[1], lo[2], lo[3], hh[0], hh[1], hh[2], hh[3]};
                        if (dt == 0) o0 = MFMA32(vf, pb.v, o0); else o1 = MFMA32(vf, pb.v, o1);
                    }
                }
        }
        if (i + 1 < ntile) { const int nb = buf ^ 1;
            *(LAS u32x4*)(lds + LK + nb * KIMG + srow * 144 + sch * 16) = kreg; *(LAS u32x4*)(lds + LV + nb * VIMG + srow * 192 + sch * 16) = vreg; }
        __syncthreads();
    }
    l_run += __shfl_xor(l_run, 32);
    const float inv = 1.0f / l_run;
#pragma unroll
    for (int r4 = 0; r4 < 4; ++r4) {
        u32x2 w0, w1;
        w0.x = cvt_pk_bf16(o0[4 * r4] * inv, o0[4 * r4 + 1] * inv); w0.y = cvt_pk_bf16(o0[4 * r4 + 2] * inv, o0[4 * r4 + 3] * inv);
        w1.x = cvt_pk_bf16(o1[4 * r4] * inv, o1[4 * r4 + 1] * inv); w1.y = cvt_pk_bf16(o1[4 * r4 + 2] * inv, o1[4 * r4 + 3] * inv);
        *(u32x2*)(qrow + 8 * r4 + 4 * hi) = w0; *(u32x2*)(qrow + 32 + 8 * r4 + 4 * hi) = w1;
    }
}

__device__ void yb_norm_panel(const Params& P, int pm) {
    const int tid = tid_opaque(), lane = tid & 63, wid = tid >> 6;
    bf16_t* HI = (bf16_t*)(P.ws + OFF_HI); const bf16_t* HG = (const bf16_t*)(P.ws + OFF_HG);
    for (int r = 0; r < 32; ++r) {
        const size_t off = ((size_t)pm * 256 + wid * 32 + r) * 512 + lane * 8;
        const u32x4 ov = *(const u32x4*)(HI + off), gv = *(const u32x4*)(HG + off);
        float o[8] = {bf_lo(ov.x), bf_hi(ov.x), bf_lo(ov.y), bf_hi(ov.y), bf_lo(ov.z), bf_hi(ov.z), bf_lo(ov.w), bf_hi(ov.w)};
        const float g[8] = {bf_lo(gv.x), bf_hi(gv.x), bf_lo(gv.y), bf_hi(gv.y), bf_lo(gv.z), bf_hi(gv.z), bf_lo(gv.w), bf_hi(gv.w)};
        float ss = 0.f;
#pragma unroll
        for (int e = 0; e < 8; ++e) ss += o[e] * o[e];
        ss += __shfl_xor(ss, 1); ss += __shfl_xor(ss, 2); ss += __shfl_xor(ss, 4); ss += __shfl_xor(ss, 8);
        const float rs = rsqrtf(ss * (1.0f / 128.0f) + RMS_EPS);
        u32x4 w; w.x = cvt_pk_bf16(o[0] * rs * g[0], o[1] * rs * g[1]); w.y = cvt_pk_bf16(o[2] * rs * g[2], o[3] * rs * g[3]);
        w.z = cvt_pk_bf16(o[4] * rs * g[4], o[5] * rs * g[5]); w.w = cvt_pk_bf16(o[6] * rs * g[6], o[7] * rs * g[7]);
        *(u32x4*)(HI + off) = w;
    }
}
__device__ void ln1_panel(const Params& P, int pm) {
    const int tid = tid_opaque(), lane = tid & 63, wid = tid >> 6;
    const float* ada = (const float*)(P.ws + OFF_ADA) + (size_t)(pm >> 3) * 6144; bf16_t* H = (bf16_t*)(P.ws + OFF_H);
    for (int r = 0; r < 32; ++r) {
        const size_t row = (size_t)pm * 256 + wid * 32 + r;
        float* xr = P.out + row * 1024 + lane * 4;
        f32x4 v[4]; float s = 0.f;
#pragma unroll
        for (int jx = 0; jx < 4; ++jx) { v[jx] = *(const f32x4*)(xr + 256 * jx); s += (v[jx][0] + v[jx][1]) + (v[jx][2] + v[jx][3]); }
        const float mean = wave_sum(s) * (1.0f / 1024.0f); float s2 = 0.f;
#pragma unroll
        for (int jx = 0; jx < 4; ++jx) { v[jx] = v[jx] - mean; s2 += (v[jx][0] * v[jx][0] + v[jx][1] * v[jx][1]) + (v[jx][2] * v[jx][2] + v[jx][3] * v[jx][3]); }
        const float rstd = rsqrtf(wave_sum(s2) * (1.0f / 1024.0f) + LN_EPS);
#pragma unroll
        for (int jx = 0; jx < 4; ++jx) {
            const int c = lane * 4 + 256 * jx;
            const f32x4 g = *(const f32x4*)(P.ln1_g + c), bb = *(const f32x4*)(P.ln1_b + c), sh = *(const f32x4*)(ada + 3072 + c), sc = *(const f32x4*)(ada + 4096 + c);
            const f32x4 x1 = v[jx] * rstd * g + bb;
            *(f32x4*)(xr + 256 * jx) = x1;
            const f32x4 h2 = x1 * (sc + 1.0f) + sh;
            u32x2 w; w.x = cvt_pk_bf16(h2[0], h2[1]); w.y = cvt_pk_bf16(h2[2], h2[3]);
            *(u32x2*)(H + row * 1024 + c) = w;
        }
    }
}

#define INS16(L, xin) do { float x_ = (xin); _Pragma("unroll") for (int k_ = 0; k_ < 16; ++k_) { const float hi_ = fmaxf(L[k_], x_); x_ = fminf(L[k_], x_); L[k_] = hi_; } } while (0)

__device__ void peer_select_wave(const Params& P, size_t tok0) {
    const int lane = tid_opaque() & 63, r32 = lane & 31, hi = lane >> 5;
    const bf16_t* QP = (const bf16_t*)(P.ws + OFF_GB) + (tok0 + r32) * 1024; const bf16_t* SK = (const bf16_t*)(P.ws + OFF_SK);
    u32x2* EG = (u32x2*)(P.ws + OFF_EG) + (tok0 + r32) * 128;
#pragma unroll 1
    for (int h = 0; h < 8; ++h) {
        float a0[16], a1[16];
#pragma unroll
        for (int k = 0; k < 16; ++k) { a0[k] = -INFINITY; a1[k] = -INFINITY; }
#pragma unroll 1
        for (int p = 0; p < 2; ++p) {
            const int hp = h * 2 + p;
            bf16x8 qf[4];
#pragma unroll
            for (int ks = 0; ks < 4; ++ks) qf[ks] = *(const bf16x8*)(QP + hp * 64 + 16 * ks + 8 * hi);
            float L[16];
#pragma unroll
            for (int k = 0; k < 16; ++k) L[k] = -INFINITY;
#pragma unroll
            for (int kt = 0; kt < 4; ++kt) {
                f32x16 acc = {};
#pragma unroll
                for (int ks = 0; ks < 4; ++ks) { const bf16x8 kf = *(const bf16x8*)(SK + ((size_t)hp * 128 + 32 * kt + r32) * 64 + 16 * ks + 8 * hi); acc = MFMA32(kf, qf[ks], acc); }
#pragma unroll
                for (int r = 0; r < 16; ++r) { const unsigned key = (unsigned)(32 * kt + crow(r, hi)); const float xv = __uint_as_float((__float_as_uint(acc[r]) & ~127u) | key); INS16(L, xv); }
            }
            float O[16];
#pragma unroll
            for (int k = 0; k < 16; ++k) O[k] = __shfl_xor(L[k], 32);
#pragma unroll
            for (int k = 0; k < 16; ++k) INS16(L, O[k]);
#pragma unroll
            for (int k = 0; k < 16; ++k) { a0[k] = (p == 0) ? L[k] : a0[k]; a1[k] = (p == 1) ? L[k] : a1[k]; }
        }
        float best[16];
#pragma unroll
        for (int k = 0; k < 16; ++k) best[k] = -INFINITY;
#pragma unroll
        for (int i = 0; i < 16; ++i)
#pragma unroll
            for (int jx = 0; jx < 16; ++jx)
                if ((i + 1) * (jx + 1) <= 16) {
                    const float cs = a0[i] + a1[jx];
                    const float cv = __uint_as_float((__float_as_uint(cs) & ~255u) | (unsigned)(i * 16 + jx));
                    INS16(best, cv);
                }
        unsigned pk0[4], pk1[4];
#pragma unroll
        for (int q = 0; q < 4; ++q) {
            pk0[q] = (__float_as_uint(a0[4 * q]) & 127u) | ((__float_as_uint(a0[4 * q + 1]) & 127u) << 8) | ((__float_as_uint(a0[4 * q + 2]) & 127u) << 16) | ((__float_as_uint(a0[4 * q + 3]) & 127u) << 24);
            pk1[q] = (__float_as_uint(a1[4 * q]) & 127u) | ((__float_as_uint(a1[4 * q + 1]) & 127u) << 8) | ((__float_as_uint(a1[4 * q + 2]) & 127u) << 16) | ((__float_as_uint(a1[4 * q + 3]) & 127u) << 24);
        }
        unsigned pay[16];
#pragma unroll
        for (int k = 0; k < 16; ++k) {
            const unsigned code = __float_as_uint(best[k]) & 255u, ci = code >> 4, cj = code & 15u;
            const unsigned qi = ci >> 2, qj = cj >> 2;
            const unsigned w0 = (qi == 0u) ? pk0[0] : ((qi == 1u) ? pk0[1] : ((qi == 2u) ? pk0[2] : pk0[3]));
            const unsigned w1 = (qj == 0u) ? pk1[0] : ((qj == 1u) ? pk1[1] : ((qj == 2u) ? pk1[2] : pk1[3]));
            pay[k] = (((w0 >> ((ci & 3u) * 8u)) & 127u) << 7) | ((w1 >> ((cj & 3u) * 8u)) & 127u);
        }
        float e[16], es = 0.f;
#pragma unroll
        for (int k = 0; k < 16; ++k) { e[k] = __expf(best[k] - best[0]); es += e[k]; }
        const float inv = 1.0f / es;
        if (hi == 0) {
#pragma unroll
            for (int k = 0; k < 16; ++k) { u32x2 w; w.x = pay[k]; w.y = __float_as_uint(e[k] * inv); EG[h * 16 + k] = w; }
        }
    }
}
__device__ __forceinline__ unsigned xcc_id() { return (unsigned)__builtin_amdgcn_s_getreg((3 << 11) | 20) & 0xFu; }
template <int CTRL> __device__ __forceinline__ float dpp_add(float x) { const int v = __builtin_amdgcn_update_dpp(0, __float_as_int(x), CTRL, 0xf, 0xf, true); return x + __int_as_float(v); }
__device__ __forceinline__ float wave_sum_fast(float x) {
    x = dpp_add<0xB1>(x); x = dpp_add<0x4E>(x); x = dpp_add<0x141>(x); x = dpp_add<0x140>(x);
    x += __shfl_xor(x, 16); x += __shfl_xor(x, 32); return x;
}
__device__ __forceinline__ float dot16_fp8(const float (&hv)[16], const u32x4 r) {
    float s = 0.f;
    { const f32x2 a = __builtin_amdgcn_cvt_pk_f32_fp8((int)r.x, false), b = __builtin_amdgcn_cvt_pk_f32_fp8((int)r.x, true); s += hv[0] * a.x + hv[1] * a.y + hv[2] * b.x + hv[3] * b.y; }
    { const f32x2 a = __builtin_amdgcn_cvt_pk_f32_fp8((int)r.y, false), b = __builtin_amdgcn_cvt_pk_f32_fp8((int)r.y, true); s += hv[4] * a.x + hv[5] * a.y + hv[6] * b.x + hv[7] * b.y; }
    { const f32x2 a = __builtin_amdgcn_cvt_pk_f32_fp8((int)r.z, false), b = __builtin_amdgcn_cvt_pk_f32_fp8((int)r.z, true); s += hv[8] * a.x + hv[9] * a.y + hv[10] * b.x + hv[11] * b.y; }
    { const f32x2 a = __builtin_amdgcn_cvt_pk_f32_fp8((int)r.w, false), b = __builtin_amdgcn_cvt_pk_f32_fp8((int)r.w, true); s += hv[12] * a.x + hv[13] * a.y + hv[14] * b.x + hv[15] * b.y; }
    return s;
}
template <int NP, class F> __device__ __forceinline__ void partition_queue(const Params& P, LAS unsigned char* lds, int ctr_base, F f) {
    const int tid = tid_opaque();
    LAS int* slot = (LAS int*)(lds + LDS_BYTES - 64);
    unsigned* ctr = (unsigned*)(P.ws + OFF_CTR) + ctr_base;
    const int myx = (int)(xcc_id() & 7u);
    for (int pp = 0; pp < NP; ++pp) {
        const int p = (myx * (NP / 8) + pp) % NP;
        for (;;) {
            if (tid == 0) *slot = (int)atomicAdd(ctr + p, 1u);
            __syncthreads();
            const int item = *slot;
            __syncthreads();
            if (item >= NTOK / 64) break;
            f(p, item);
        }
    }
}
__device__ __forceinline__ float dot2bf(unsigned a, bf16v2 b, float c) { return __builtin_amdgcn_fdot2_f32_bf16(__builtin_bit_cast(bf16v2, a), b, c, false); }
constexpr int UP_SHIFT = 14;
struct UQuad { u32x4 r[4]; u32x4 ent; };
__device__ __forceinline__ void uq_issue(UQuad& q, const LAS u32x4* list, int J, int NQ, int g, const unsigned char* U8) {
    const int jj = J < NQ ? J : NQ - 1;
    q.ent = list[4 * jj + g];
    const unsigned char* rp = U8 + (size_t)q.ent.x * 1024;
#pragma unroll
    for (int c = 0; c < 4; ++c) q.r[c] = *(const u32x4*)(rp + c * 256);
}
__device__ __forceinline__ float uq_dot(const UQuad& q, const u32x4 (&hp)[8]) {
    float a = 0.f, b = 0.f;
    constexpr float SC = 1.0f / 32.0f;
#pragma unroll
    for (int c = 0; c < 4; ++c) {
        const u32x4 r = q.r[c];
        a = dot2bf(hp[2 * c].x, __builtin_amdgcn_cvt_scalef32_pk_bf16_fp8((int)r.x, SC, false), a); b = dot2bf(hp[2 * c].y, __builtin_amdgcn_cvt_scalef32_pk_bf16_fp8((int)r.x, SC, true), b);
        a = dot2bf(hp[2 * c].z, __builtin_amdgcn_cvt_scalef32_pk_bf16_fp8((int)r.y, SC, false), a); b = dot2bf(hp[2 * c].w, __builtin_amdgcn_cvt_scalef32_pk_bf16_fp8((int)r.y, SC, true), b);
        a = dot2bf(hp[2 * c + 1].x, __builtin_amdgcn_cvt_scalef32_pk_bf16_fp8((int)r.z, SC, false), a); b = dot2bf(hp[2 * c + 1].y, __builtin_amdgcn_cvt_scalef32_pk_bf16_fp8((int)r.z, SC, true), b);
        a = dot2bf(hp[2 * c + 1].z, __builtin_amdgcn_cvt_scalef32_pk_bf16_fp8((int)r.w, SC, false), a); b = dot2bf(hp[2 * c + 1].w, __builtin_amdgcn_cvt_scalef32_pk_bf16_fp8((int)r.w, SC, true), b);
    }
    float s = a + b;
    s = dpp_add<0xB1>(s); s = dpp_add<0x4E>(s); s = dpp_add<0x141>(s); s = dpp_add<0x140>(s);
    return s;
}
__device__ __forceinline__ void peer_u_tokens(const Params& P, LAS unsigned char* lds, const size_t t0) {
    const int tid = tid_opaque(), lane = tid & 63, wid = tid >> 6, g = lane >> 4, li = lane & 15;
    const bf16_t* H = (const bf16_t*)(P.ws + OFF_H); const unsigned char* U8 = P.ws + OFF_U8 + li * 16;
    const u32x4* EG4 = (const u32x4*)(P.ws + OFF_EG); float* W = (float*)(P.ws + OFF_W);
    LAS u32x4* list = (LAS u32x4*)(lds + wid * 16384);
#pragma unroll 2
    for (int i = 0; i < 8; ++i) {
        const u32x4 eg = EG4[(t0 + i) * 64 + lane];
        list[i * 128 + 2 * lane] = (u32x4){eg.x, eg.y, (unsigned)(2 * lane) | (unsigned)(i << 8), 1u};
        list[i * 128 + 2 * lane + 1] = (u32x4){eg.z, eg.w, (unsigned)(2 * lane + 1) | (unsigned)(i << 8), 1u};
    }
    constexpr int base = 1024;
    const int NQ = base >> 2;
    u32x4 hp[8], hn[8];
#pragma unroll
    for (int c = 0; c < 4; ++c) { hp[2 * c] = __builtin_nontemporal_load((const u32x4*)(H + t0 * 1024 + (li + 16 * c) * 16)); hp[2 * c + 1] = __builtin_nontemporal_load((const u32x4*)(H + t0 * 1024 + (li + 16 * c) * 16 + 8));
                                  hn[2 * c] = __builtin_nontemporal_load((const u32x4*)(H + (t0 + 1) * 1024 + (li + 16 * c) * 16)); hn[2 * c + 1] = __builtin_nontemporal_load((const u32x4*)(H + (t0 + 1) * 1024 + (li + 16 * c) * 16 + 8)); }
    int curtok = 0;
    UQuad q0, q1, q2, q3;
    uq_issue(q0, list, 0, NQ, g, U8); uq_issue(q1, list, 1, NQ, g, U8); uq_issue(q2, list, 2, NQ, g, U8); uq_issue(q3, list, 3, NQ, g, U8);
#define UQ_STEP(q, Jn) do { \
        const int tk = __builtin_amdgcn_readfirstlane((int)(q.ent.z >> 8)); \
        if (tk != curtok) { curtok = tk; _Pragma("unroll") for (int c = 0; c < 8; ++c) hp[c] = hn[c]; \
            if (tk + 1 < 8) { _Pragma("unroll") for (int c = 0; c < 4; ++c) { hn[2 * c] = __builtin_nontemporal_load((const u32x4*)(H + (t0 + tk + 1) * 1024 + (li + 16 * c) * 16)); hn[2 * c + 1] = __builtin_nontemporal_load((const u32x4*)(H + (t0 + tk + 1) * 1024 + (li + 16 * c) * 16 + 8)); } } } \
        const float s = uq_dot(q, hp); \
        if (li == 0 && q.ent.w != 0u) W[(t0 + tk) * 128 + (q.ent.z & 255u)] = __uint_as_float(q.ent.y) * 0.5f * s * (1.0f + erff(s * 0.70710678118654752f)); \
        uq_issue(q, list, (Jn), NQ, g, U8); } while (0)
#pragma unroll 1
    for (int J = 0; J < NQ; J += 4) { UQ_STEP(q0, J + 4); UQ_STEP(q1, J + 5); UQ_STEP(q2, J + 6); UQ_STEP(q3, J + 7); }
#undef UQ_STEP
}
struct VQuad { u32x4 r[4]; u32x2 ent; };
__device__ __forceinline__ void vq_issue(VQuad& q, const LAS u32x2* list, int J, int g, const unsigned char* V8) {
    const int jj = J < 32 ? J : 31;
    q.ent = list[4 * jj + g];
    const unsigned char* rp = V8 + (size_t)q.ent.x * 1024;
#pragma unroll
    for (int c = 0; c < 4; ++c) q.r[c] = *(const u32x4*)(rp + c * 256);
}
__device__ __forceinline__ void vq_acc(const VQuad& q, f32x2 (&acc)[32]) {
    const float w = __uint_as_float(q.ent.y); const f32x2 wv = {w, w};
#pragma unroll
    for (int c = 0; c < 4; ++c) {
        const u32x4 r = q.r[c];
        acc[8 * c + 0] += wv * __builtin_amdgcn_cvt_pk_f32_fp8((int)r.x, false); acc[8 * c + 1] += wv * __builtin_amdgcn_cvt_pk_f32_fp8((int)r.x, true);
        acc[8 * c + 2] += wv * __builtin_amdgcn_cvt_pk_f32_fp8((int)r.y, false); acc[8 * c + 3] += wv * __builtin_amdgcn_cvt_pk_f32_fp8((int)r.y, true);
        acc[8 * c + 4] += wv * __builtin_amdgcn_cvt_pk_f32_fp8((int)r.z, false); acc[8 * c + 5] += wv * __builtin_amdgcn_cvt_pk_f32_fp8((int)r.z, true);
        acc[8 * c + 6] += wv * __builtin_amdgcn_cvt_pk_f32_fp8((int)r.w, false); acc[8 * c + 7] += wv * __builtin_amdgcn_cvt_pk_f32_fp8((int)r.w, true);
    }
}
__device__ __forceinline__ void peer_v_tokens(const Params& P, LAS unsigned char* lds, const size_t t0) {
    const int tid = tid_opaque(), lane = tid & 63, wid = tid >> 6, g = lane >> 4, li = lane & 15, hi = lane >> 5, tc = g & 1;
    const unsigned char* V8 = P.ws + OFF_V8 + li * 16;
    const u32x4* EG4 = (const u32x4*)(P.ws + OFF_EG); const f32x2* W2 = (const f32x2*)(P.ws + OFF_W);
    LAS u32x2* lists = (LAS u32x2*)(lds + wid * 8192);
#pragma unroll
    for (int i = 0; i < 8; ++i) { const u32x4 eg = EG4[(t0 + i) * 64 + lane]; const f32x2 ww = W2[(t0 + i) * 64 + lane];
        *(LAS u32x4*)(lists + i * 128 + 2 * lane) = (u32x4){eg.x, __float_as_uint(ww.x), eg.z, __float_as_uint(ww.y)}; }
#pragma unroll 1
    for (int i = 0; i < 8; ++i) {
        const size_t t = t0 + i;
        const LAS u32x2* list = lists + i * 128;
        f32x2 acc[32];
#pragma unroll
        for (int j = 0; j < 32; ++j) acc[j] = (f32x2){0.f, 0.f};
        VQuad q0, q1, q2, q3;
        vq_issue(q0, list, 0, g, V8); vq_issue(q1, list, 1, g, V8); vq_issue(q2, list, 2, g, V8); vq_issue(q3, list, 3, g, V8);
#pragma unroll 1
        for (int J = 0; J < 32; J += 4) {
            vq_acc(q0, acc); vq_issue(q0, list, J + 4, g, V8);
            vq_acc(q1, acc); vq_issue(q1, list, J + 5, g, V8);
            vq_acc(q2, acc); vq_issue(q2, list, J + 6, g, V8);
            vq_acc(q3, acc); vq_issue(q3, list, J + 7, g, V8);
        }
        f32x2 k1[16];
#pragma unroll
        for (int j = 0; j < 16; ++j) { const f32x2 keep = hi ? acc[16 + j] : acc[j], send = hi ? acc[j] : acc[16 + j];
            k1[j] = keep + (f32x2){__shfl_xor(send.x, 32), __shfl_xor(send.y, 32)}; }
        float y[16];
#pragma unroll
        for (int j = 0; j < 8; ++j) { const f32x2 keep = tc ? k1[8 + j] : k1[j], send = tc ? k1[j] : k1[8 + j];
            y[2 * j] = keep.x + __shfl_xor(send.x, 16); y[2 * j + 1] = keep.y + __shfl_xor(send.y, 16); }
        const int d0 = 16 * (li + 16 * g);
        const float* gt2 = (const float*)(P.ws + OFF_ADA) + (t >> 11) * 6144 + 5120 + d0;
        float* xr = P.out + t * 1024 + d0;
        float pre[16]; float s = 0.f;
#pragma unroll
        for (int q4 = 0; q4 < 4; ++q4) { const f32x4 xv = *(const f32x4*)(xr + 4 * q4), gv = *(const f32x4*)(gt2 + 4 * q4);
#pragma unroll
            for (int e = 0; e < 4; ++e) { const float pv = ALPHA * xv[e] + gv[e] * (0.25f * y[4 * q4 + e]); pre[4 * q4 + e] = pv; s += pv; } }
        const float mean = wave_sum(s) * (1.0f / 1024.0f); float s2 = 0.f;
#pragma unroll
        for (int e = 0; e < 16; ++e) { pre[e] -= mean; s2 += pre[e] * pre[e]; }
        const float rstd = rsqrtf(wave_sum(s2) * (1.0f / 1024.0f) + LN_EPS);
#pragma unroll
        for (int q4 = 0; q4 < 4; ++q4) { const f32x4 gg = *(const f32x4*)(P.ln2_g + d0 + 4 * q4), bb = *(const f32x4*)(P.ln2_b + d0 + 4 * q4);
            f32x4 o;
#pragma unroll
            for (int e = 0; e < 4; ++e) o[e] = pre[4 * q4 + e] * rstd * gg[e] + bb[e];
            __builtin_nontemporal_store(o, (f32x4*)(xr + 4 * q4)); }
    }
}

#define XB_TMO      128
#define XB_XCNT(j)  (256  + 64 * (j))
#define XB_XSUB(j)  (1280 + 64 * (j))
#define XB_XGEN(j)  (2304 + 64 * (j))
#define XB_TOP      3328
#define XB_TOPGEN   3392
#define XCD_BAR_WORDS 3456
#define XB_SPIN_CAP (1u << 22)
__device__ __forceinline__ unsigned xb_ld(unsigned* p)              { return __hip_atomic_load(p, __ATOMIC_RELAXED, __HIP_MEMORY_SCOPE_AGENT); }
__device__ __forceinline__ unsigned xb_add(unsigned* p, unsigned v) { return __hip_atomic_fetch_add(p, v, __ATOMIC_RELAXED, __HIP_MEMORY_SCOPE_AGENT); }
#define XB_SPIN(cond, bar) do { unsigned _sp = 0; while (cond) { __builtin_amdgcn_s_sleep(1); \
    if ((++_sp & 255u) == 0u) { if (xb_ld(&(bar)[XB_TMO])) break; if (_sp > XB_SPIN_CAP) { atomicAdd(&(bar)[XB_TMO], 1u); break; } } } } while (0)
struct XcdBarrier { unsigned* bar; unsigned x; volatile LAS unsigned* st; };
__device__ __forceinline__ XcdBarrier xcd_barrier_post(unsigned* bar, volatile LAS unsigned* st) {
    XcdBarrier b; b.bar = bar; b.x = xcc_id(); b.st = st;
    if (threadIdx.x == 0) (void)xb_add(&bar[XB_XCNT(b.x)], 1u);
    return b;
}
__device__ __forceinline__ void xcd_barrier_complete(unsigned* bar, unsigned x, unsigned& nloc, unsigned& nx) {
    const unsigned G = gridDim.x * gridDim.y * gridDim.z;
    unsigned sum, cnt, mine, sp = 0u;
    for (;;) {
        sum = 0u; cnt = 0u; mine = 0u;
#pragma unroll
        for (unsigned j = 0; j < 16; ++j) { const unsigned c = xb_ld(&bar[XB_XCNT(j)]); sum += c; cnt += (c > 0u) ? 1u : 0u; mine = (j == x) ? c : mine; }
        if (sum == G) break;
        __builtin_amdgcn_s_sleep(1);
        if ((++sp & 255u) == 0u) { if (xb_ld(&bar[XB_TMO])) break; if (sp > XB_SPIN_CAP) { atomicAdd(&bar[XB_TMO], 1u); break; } }
    }
    nloc = mine > 0u ? mine : 1u; nx = cnt > 0u ? cnt : 1u;
}
__device__ __forceinline__ void xcd_barrier(const XcdBarrier& b) {
    asm volatile("s_waitcnt vmcnt(0)" ::: "memory");
    __syncthreads();
    if (threadIdx.x == 0) {
        unsigned* bar = b.bar;
        __builtin_amdgcn_s_waitcnt(0);
        unsigned nloc = b.st[0], nx = b.st[1];
        if (nloc == 0u) { xcd_barrier_complete(bar, b.x, nloc, nx); b.st[0] = nloc; b.st[1] = nx; }
        const unsigned old = xb_add(&bar[XB_XSUB(b.x)], 1u);
        const unsigned gen = old / nloc;
        if (old + 1u == (gen + 1u) * nloc) {
            __builtin_amdgcn_fence(__ATOMIC_RELEASE, "agent");
            asm volatile("s_waitcnt vmcnt(0)" ::: "memory");
            const unsigned og = xb_add(&bar[XB_TOP], 1u);
            const unsigned tg = og / nx;
            if (og + 1u == (tg + 1u) * nx) xb_add(&bar[XB_TOPGEN], 1u);
            else XB_SPIN(xb_ld(&bar[XB_TOPGEN]) == tg, bar);
            __builtin_amdgcn_fence(__ATOMIC_ACQUIRE, "agent");
            xb_add(&bar[XB_XGEN(b.x)], 1u);
            asm volatile("s_waitcnt vmcnt(0)" ::: "memory");
        } else {
            XB_SPIN(xb_ld(&bar[XB_XGEN(b.x)]) == gen, bar);
            __builtin_amdgcn_fence(__ATOMIC_ACQUIRE, "agent");
            asm volatile("s_waitcnt vmcnt(0)" ::: "memory");
        }
    }
    __syncthreads();
}

__global__ void __launch_bounds__(NTHR, 2) fwd_megakernel(Params P) {
    extern __shared__ __attribute__((aligned(16))) unsigned char shm[];
    LAS unsigned char* lds = (LAS unsigned char*)shm;
    cg::grid_group grid = cg::this_grid();
    const int G = gridDim.x, bid = blockIdx.x;
    volatile LAS unsigned* xst = (volatile LAS unsigned*)(lds + LDS_BYTES - 128);
    if (threadIdx.x == 0) { xst[0] = 0u; xst[1] = 0u; }
    __syncthreads();
    const XcdBarrier xb = xcd_barrier_post((unsigned*)(P.ws + OFF_BAR), xst);

#ifndef P3
#define P3 0xff
#endif
#ifndef PH
#define PH 0xff
#endif
    if (PH & 1) phase0a(P, lds);
    grid.sync();
    if (PH & 2) phase0b(P);
    xcd_barrier(xb);
    if (PH & 4) {
        pg8::Gemm g; g.A = (const bf16_t*)(P.ws + OFF_H); g.Bt = (const bf16_t*)(P.ws + OFF_WIN); g.M = NTOK; g.N = INCOLS; g.K = 1024;
        pg8::StaticOrder S; S.init(NTOK, INCOLS, G, bid);
        EpiProj E; E.ws = P.ws; E.lb = (const float*)(P.ws + OFF_LB); E.ng = P.hgrn_ng; E.kmean = (float*)(P.ws + OFF_KMEAN);
        pg8::gemm_phase<EpiProj, pg8::StaticOrder>(lds, g, S, E);
    }
    xcd_barrier(xb);
    if (PH & 8) for (int it = bid; it < 256; it += G) hgrn_item(P, it, lds);
    if (PH & 16) for (int u = bid; u < 2048; u += G) { const int bh = u & 255, jj = u >> 8; moba_unit(P, bh >> 3, bh & 7, (jj + bh) & 7, lds); }
    xcd_barrier(xb);
    if (PH & 32) for (int pm = bid; pm < NTOK / 256; pm += G) {
        if (P3 & 1) yb_norm_panel(P, pm);
        __syncthreads();
        if (P3 & 2) { pg8::Gemm g; g.A = (const bf16_t*)(P.ws + OFF_QA); g.Bt = (const bf16_t*)(P.ws + OFF_WBA); g.M = NTOK; g.N = 1024; g.K = 512;
          pg8::PanelOrder S; S.pm = pm; S.npn = 4; EpiMixA E; E.GA = (bf16_t*)(P.ws + OFF_GA);
          pg8::gemm_phase<EpiMixA, pg8::PanelOrder>(lds, g, S, E); }
        __syncthreads();
        if (P3 & 4) { pg8::Gemm g; g.A = (const bf16_t*)(P.ws + OFF_HI); g.Bt = (const bf16_t*)(P.ws + OFF_WBB); g.M = NTOK; g.N = 1024; g.K = 512;
          pg8::PanelOrder S; S.pm = pm; S.npn = 4; EpiMixB E; E.GA = (bf16_t*)(P.ws + OFF_GA); E.GB = (const bf16_t*)(P.ws + OFF_GB);
          pg8::gemm_phase<EpiMixB, pg8::PanelOrder>(lds, g, S, E); }
        __syncthreads();
        if (P3 & 8) { pg8::Gemm g; g.A = (const bf16_t*)(P.ws + OFF_GA); g.Bt = (const bf16_t*)(P.ws + OFF_WOUT); g.M = NTOK; g.N = 1024; g.K = 1024;
          pg8::PanelOrder S; S.pm = pm; S.npn = 4; EpiOut E; E.x = P.x; E.ada = (const float*)(P.ws + OFF_ADA); E.out = P.out;
          pg8::gemm_phase<EpiOut, pg8::PanelOrder>(lds, g, S, E); }
        __syncthreads();
        if (P3 & 16) ln1_panel(P, pm);
        __syncthreads();
        if (P3 & 32) { pg8::Gemm g; g.A = (const bf16_t*)(P.ws + OFF_H); g.Bt = (const bf16_t*)(P.ws + OFF_WQ); g.M = NTOK; g.N = 1024; g.K = 1024;
          pg8::PanelOrder S; S.pm = pm; S.npn = 4; EpiBf16 E; E.O = (bf16_t*)(P.ws + OFF_GB);
          pg8::gemm_phase<EpiBf16, pg8::PanelOrder>(lds, g, S, E); }
        __syncthreads();
        { const size_t tok0 = (size_t)pm * 256 + (tid_opaque() >> 6) * 32;
          peer_select_wave(P, tok0);
          __syncthreads();
#pragma unroll 1
          for (int sb = 0; sb < 4; ++sb) {
              peer_u_tokens(P, lds, tok0 + 8 * sb);
              __syncthreads();
              peer_v_tokens(P, lds, tok0 + 8 * sb);
              __syncthreads();
          } }
    }
}

extern "C" void kernel_launch(void* const* d_in, const int* in_sizes, int n_in, void* d_out, int out_size, void* d_ws, size_t ws_size, hipStream_t stream) {
    static int grid_blocks = 0;
    if (grid_blocks == 0) {
        if (n_in != 18 || out_size != NTOK * DM || ws_size < WS_END) { fprintf(stderr, "kernel_launch: unexpected shapes (n_in %d, out %d, ws %zu, need %zu)\n", n_in, out_size, ws_size, (size_t)WS_END); grid_blocks = -1; return; }
        int dev = 0, cus = 0, per_cu = 0;
        hipGetDevice(&dev);
        hipDeviceGetAttribute(&cus, hipDeviceAttributeMultiprocessorCount, dev);
        if (hipFuncSetAttribute((const void*)fwd_megakernel, hipFuncAttributeMaxDynamicSharedMemorySize, LDS_BYTES) != hipSuccess) fprintf(stderr, "kernel_launch: hipFuncSetAttribute failed\n");
        hipOccupancyMaxActiveBlocksPerMultiprocessor(&per_cu, (const void*)fwd_megakernel, NTHR, LDS_BYTES);
        if (per_cu < 1) { fprintf(stderr, "kernel_launch: occupancy query says %d blocks per CU\n", per_cu); per_cu = 1; }
        if (per_cu > 1) per_cu = 1;
        grid_blocks = cus * per_cu;
        (void)hipGetLastError();
    }
    if (grid_blocks < 0) return;
    Params p{};
    p.x = (const float*)d_in[0]; p.c = (const float*)d_in[1]; p.w_ada = (const float*)d_in[2]; p.b_ada = (const float*)d_in[3]; p.w_in = (const float*)d_in[4];
    p.w_ba = (const float*)d_in[5]; p.w_bb = (const float*)d_in[6]; p.w_out = (const float*)d_in[7]; p.hgrn_lb = (const float*)d_in[8]; p.hgrn_ng = (const float*)d_in[9];
    p.ln1_g = (const float*)d_in[10]; p.ln1_b = (const float*)d_in[11]; p.peer_wq = (const float*)d_in[12]; p.peer_sk = (const float*)d_in[13]; p.peer_u = (const float*)d_in[14];
    p.peer_v = (const float*)d_in[15]; p.ln2_g = (const float*)d_in[16]; p.ln2_b = (const float*)d_in[17];
    p.out = (float*)d_out; p.ws = (unsigned char*)d_ws;
    if (hipMemsetAsync((char*)d_ws + OFF_BAR, 0, XCD_BAR_WORDS * 4, stream) != hipSuccess) fprintf(stderr, "kernel_launch: memset of the barrier words failed\n");
    void* args[] = {&p};
    hipError_t e = hipLaunchCooperativeKernel((const void*)fwd_megakernel, dim3(grid_blocks), dim3(NTHR), args, LDS_BYTES, stream);
    if (e != hipSuccess) fprintf(stderr, "cooperative launch failed: %s (grid %d)\n", hipGetErrorString(e), grid_blocks);
}
```

```cpp
#include <hip/hip_runtime.h>
#include <hip/hip_cooperative_groups.h>
#include <cstdio>
#include <cstdint>
namespace cg = cooperative_groups;

#define LAS __attribute__((address_space(3)))
typedef unsigned short bf16_t;
typedef short bf16x8 __attribute__((ext_vector_type(8)));
typedef short s16x4 __attribute__((ext_vector_type(4)));
typedef float f32x2 __attribute__((ext_vector_type(2)));
typedef float f32x4 __attribute__((ext_vector_type(4)));
typedef float f32x16 __attribute__((ext_vector_type(16)));
typedef unsigned u32x2 __attribute__((ext_vector_type(2)));
typedef unsigned u32x4 __attribute__((ext_vector_type(4)));

constexpr int NB = 32, SEQ = 2048, DM = 1024, NTOK = NB * SEQ;
constexpr int INCOLS = 5632;
constexpr int NTHR = 512;
constexpr int LDS_BYTES = 147456;
constexpr float ALPHA = 1.189207115002721f;
constexpr float LN_EPS = 1e-5f, RMS_EPS = 1e-6f;
constexpr float LOG2E = 1.4426950408889634f;

constexpr size_t SZ_T512 = (size_t)NTOK * 512 * 2, SZ_T1024 = (size_t)NTOK * 1024 * 2;
constexpr size_t OFF_ADA = 0;
constexpr size_t OFF_LB = OFF_ADA + 786432;
constexpr size_t OFF_KMEAN = OFF_LB + 4096;
constexpr size_t OFF_WIN = OFF_KMEAN + 524288;
constexpr size_t OFF_WBA = OFF_WIN + (size_t)5632 * 1024 * 2;
constexpr size_t OFF_WBB = OFF_WBA + 1048576;
constexpr size_t OFF_WOUT = OFF_WBB + 1048576;
constexpr size_t OFF_WQ = OFF_WOUT + 2097152;
constexpr size_t OFF_SK = OFF_WQ + 2097152;
constexpr size_t OFF_U8 = OFF_SK + 262144;
constexpr size_t OFF_USC = OFF_U8 + 8388608;
constexpr size_t OFF_V8 = OFF_U8 + 16777216;
constexpr size_t OFF_VSC = OFF_V8 + 8388608;
constexpr size_t OFF_CTR = OFF_V8 + 16777216;
constexpr size_t OFF_BAR = OFF_CTR + 4096;
constexpr size_t OFF_EG = OFF_BAR + 16384;
constexpr size_t OFF_H = OFF_EG + (size_t)NTOK * 128 * 8;
constexpr size_t OFF_QA = OFF_H + SZ_T1024;
constexpr size_t OFF_KA = OFF_QA + SZ_T512;
constexpr size_t OFF_VA = OFF_KA + SZ_T512;
constexpr size_t OFF_HQ = OFF_VA + SZ_T512;
constexpr size_t OFF_HK = OFF_HQ + SZ_T512;
constexpr size_t OFF_HI = OFF_HK + SZ_T512;
constexpr size_t OFF_HG = OFF_HI + SZ_T512;
constexpr size_t OFF_GA = OFF_HG + SZ_T512;
constexpr size_t OFF_GB = OFF_GA + SZ_T1024;
constexpr size_t WS_END = OFF_GB + SZ_T1024;
constexpr size_t OFF_H8 = OFF_VA;
constexpr size_t OFF_HS = OFF_HQ;
constexpr size_t OFF_W = OFF_KA;
constexpr size_t OFF_Y = OFF_KA;

struct Params {
    const float *x, *c, *w_ada, *b_ada, *w_in, *w_ba, *w_bb, *w_out, *hgrn_lb, *hgrn_ng, *ln1_g, *ln1_b, *peer_wq, *peer_sk, *peer_u, *peer_v, *ln2_g, *ln2_b;
    float* out;
    unsigned char* ws;
};

typedef __bf16 bf16v2 __attribute__((ext_vector_type(2)));
__device__ __forceinline__ unsigned cvt_pk_bf16(float lo, float hi) { return __builtin_bit_cast(unsigned, __builtin_convertvector((f32x2){lo, hi}, bf16v2)); }
__device__ __forceinline__ float bf_lo(unsigned w) { return __uint_as_float(w << 16); }
__device__ __forceinline__ float bf_hi(unsigned w) { return __uint_as_float(w & 0xffff0000u); }
__device__ __forceinline__ float sigmoidf_(float x) { return 1.0f / (1.0f + __expf(-x)); }
__device__ __forceinline__ float wave_sum(float v) {
#pragma unroll
    for (int o = 1; o < 64; o <<= 1) v += __shfl_xor(v, o);
    return v;
}
__device__ __forceinline__ int tid_opaque() { int t = threadIdx.x; asm volatile("" : "+v"(t)); return t; }
__device__ __forceinline__ int crow(int r, int hi) { return (r & 3) + 8 * (r >> 2) + 4 * hi; }
#define MFMA32(a, b, c) __builtin_amdgcn_mfma_f32_32x32x16_bf16(a, b, c, 0, 0, 0)

namespace pg8 {
constexpr int BM = 256, BK = 64, HALF = 128, HTB = HALF * BK * 2, STAGE_BYTES = 8 * HTB, NXCD = 8, WGM = 8;
__host__ __device__ __forceinline__ int lds_byte(int r, int c) { const int st = (r >> 4) * 2 + (c >> 5), rr = r & 15, cc = c & 31, ob = rr * 64 + cc * 2; return st * 1024 + (ob ^ (((ob >> 9) & 1) << 5)); }
__host__ __device__ __forceinline__ void stage_rc(int b, int& R, int& C) { const int st = b / 1024, sb = b % 1024, swz = sb ^ (((sb >> 9) & 1) << 5); R = (st >> 1) * 16 + swz / 64; C = (st & 1) * 32 + (swz % 64) / 2; }
__host__ __device__ __forceinline__ int perm32(int rho) { const int n = rho >> 4, i = rho & 15; return 8 * (i >> 2) + 4 * n + (i & 3); }

struct Unit { int pm, pn; };
struct Gemm { const bf16_t* A; const bf16_t* Bt; int M, N, K; };

struct StaticOrder {
    int nM, nN, nwg, G, c;
    __device__ void init(int M, int N, int G_, int c_) { nM = M / BM; nN = N / BM; nwg = nM * nN; G = G_; c = c_; }
    __device__ bool next(int i, Unit& u) const {
        const long L = (long)i * G + c; if (L >= nwg) return false;
        int wgid = (int)L; { const int q = nwg / NXCD, r = nwg % NXCD, xcd = wgid % NXCD, off = wgid / NXCD; wgid = (xcd < r ? xcd * (q + 1) : r * (q + 1) + (xcd - r) * q) + off; }
        const int nig = WGM * nN, gid = wgid / nig, fm = gid * WGM, gsz = (nM - fm) < WGM ? (nM - fm) : WGM;
        u.pm = fm + ((wgid % nig) % gsz); u.pn = (wgid % nig) / gsz; return true;
    }
};
struct PanelOrder {
    int pm, npn;
    __device__ bool next(int i, Unit& u) const { if (i >= npn) return false; u.pm = pm; u.pn = i; return true; }
};

template <class Epi, class Sched>
__device__ __forceinline__ void gemm_phase(LAS unsigned char* lds, const Gemm g, const Sched& S, const Epi& E) {
    const int tid = tid_opaque(), wid = __builtin_amdgcn_readfirstlane(tid >> 6), lane = tid & 63, wr = wid >> 2, wc = wid & 3, fr = lane & 15, fq = lane >> 4;
    const int K = g.K, nt = K / BK;
    unsigned voffA[2], voffB[2];
#pragma unroll
    for (int i = 0; i < 2; ++i) { int R, C; stage_rc(tid * 16 + i * 8192, R, C); const int Rb = Epi::PERM ? ((R & ~31) + perm32(R & 31)) : R;
        voffA[i] = (unsigned)(R * K + C) * 2u; voffB[i] = (unsigned)(Rb * K + C) * 2u; }
    const size_t kstep = (size_t)(BK * 2);
    const size_t hstep = (size_t)HALF * K * 2;
    const size_t tstep = 2 * hstep;
    const unsigned ldsw = (unsigned)wid * 1024u;
    const int aoff = lds_byte(wr * 64 + fr, fq * 8), boff = lds_byte(wc * 32 + fr, fq * 8);
#define PG8_SA(b, h) (((b) * 2 + (h)) * HTB)
#define PG8_SB(b, h) ((4 + (b) * 2 + (h)) * HTB)
#define PG8_STAGE(bufoff, gbase, voff) do { _Pragma("unroll") for (int _i = 0; _i < 2; ++_i) \
        __builtin_amdgcn_global_load_lds((const unsigned*)((const char*)(gbase) + (voff)[_i]), (LAS unsigned*)(lds + (bufoff) + ldsw + _i * 8192), 16, 0, 0); } while (0)
#define PG8_LDA(dst, b, h) do { _Pragma("unroll") for (int m = 0; m < 4; ++m) _Pragma("unroll") for (int k = 0; k < 2; ++k) dst[m][k] = *(const LAS bf16x8*)(lds + PG8_SA(b, h) + aoff + m * 2048 + k * 1024); } while (0)
#define PG8_LDB(dst, b, h) do { _Pragma("unroll") for (int n = 0; n < 2; ++n) _Pragma("unroll") for (int k = 0; k < 2; ++k) dst[n][k] = *(const LAS bf16x8*)(lds + PG8_SB(b, h) + boff + n * 2048 + k * 1024); } while (0)
#define PG8_MMA(ai, bj, At, Bt) do { __builtin_amdgcn_s_setprio(1); _Pragma("unroll") for (int m = 0; m < 4; ++m) _Pragma("unroll") for (int n = 0; n < 2; ++n) _Pragma("unroll") for (int k = 0; k < 2; ++k) \
        acc[ai][bj][m][n] = __builtin_amdgcn_mfma_f32_16x16x32_bf16(Bt[n][k], At[m][k], acc[ai][bj][m][n], 0, 0, 0); __builtin_amdgcn_s_setprio(0); } while (0)
#define PG8_WAIT_V(n) asm volatile("s_waitcnt vmcnt(" #n ")" ::: "memory")
#define PG8_WAIT_L(n) asm volatile("s_waitcnt lgkmcnt(" #n ")" ::: "memory")
#define PG8_BAR __builtin_amdgcn_s_barrier()
#define PG8_SCHED __builtin_amdgcn_sched_barrier(0)
    Unit cur, nxt; int ui = 0;
    if (!S.next(0, cur)) return;
    f32x4 acc[2][2][4][2];
#pragma unroll
    for (int a = 0; a < 2; ++a)
#pragma unroll
        for (int b = 0; b < 2; ++b)
#pragma unroll
            for (int m = 0; m < 4; ++m)
#pragma unroll
                for (int n = 0; n < 2; ++n) acc[a][b][m][n] = (f32x4){0.f, 0.f, 0.f, 0.f};
    bf16x8 At[4][2], B0[2][2], B1[2][2];
    const char* cA = (const char*)g.A + (size_t)cur.pm * tstep; const char* cB = (const char*)g.Bt + (size_t)cur.pn * tstep;
    PG8_STAGE(PG8_SB(0, 0), cB, voffB); PG8_STAGE(PG8_SA(0, 0), cA, voffA); PG8_STAGE(PG8_SB(0, 1), cB + hstep, voffB); PG8_STAGE(PG8_SA(0, 1), cA + hstep, voffA);
    if (wr == 1) PG8_BAR;
    PG8_WAIT_V(4); PG8_BAR;
    PG8_STAGE(PG8_SB(1, 0), cB + kstep, voffB); PG8_STAGE(PG8_SA(1, 0), cA + kstep, voffA); PG8_STAGE(PG8_SB(1, 1), cB + hstep + kstep, voffB);
    PG8_WAIT_V(6); PG8_BAR;
    for (;;) {
        const bool has_next = S.next(ui + 1, nxt);
        const char* nA = has_next ? (const char*)g.A + (size_t)nxt.pm * tstep : cA; const char* nB = has_next ? (const char*)g.Bt + (size_t)nxt.pn * tstep : cB;
        for (int t = 0; t < nt; t += 2) {
            const bool last = (t == nt - 2);
            const char* a1 = cA + (size_t)(t + 1) * kstep;
            const char* a2 = last ? nA : cA + (size_t)(t + 2) * kstep; const char* b2 = last ? nB : cB + (size_t)(t + 2) * kstep;
            const char* a3 = a2 + kstep; const char* b3 = b2 + kstep;
            PG8_LDB(B0, 0, 0); PG8_SCHED; PG8_LDA(At, 0, 0); PG8_STAGE(PG8_SA(1, 1), a1 + hstep, voffA);
            PG8_WAIT_L(8); PG8_BAR; PG8_WAIT_L(0); PG8_MMA(0, 0, At, B0); PG8_BAR; PG8_SCHED;
            PG8_LDB(B1, 0, 1); PG8_STAGE(PG8_SB(0, 0), b2, voffB);
            PG8_BAR; PG8_WAIT_L(0); PG8_MMA(0, 1, At, B1); PG8_BAR;
            PG8_LDA(At, 0, 1); PG8_STAGE(PG8_SA(0, 0), a2, voffA);
            PG8_BAR; PG8_WAIT_L(0); PG8_MMA(1, 0, At, B0); PG8_BAR; PG8_SCHED;
            PG8_STAGE(PG8_SB(0, 1), b2 + hstep, voffB);
            PG8_WAIT_V(6); PG8_BAR; PG8_MMA(1, 1, At, B1); PG8_BAR;
            PG8_LDB(B0, 1, 0); PG8_SCHED; PG8_LDA(At, 1, 0); PG8_STAGE(PG8_SA(0, 1), a2 + hstep, voffA);
            PG8_WAIT_L(8); PG8_BAR; PG8_WAIT_L(0); PG8_MMA(0, 0, At, B0); PG8_BAR; PG8_SCHED;
            PG8_LDB(B1, 1, 1); PG8_STAGE(PG8_SB(1, 0), b3, voffB);
            PG8_BAR; PG8_WAIT_L(0); PG8_MMA(0, 1, At, B1); PG8_BAR;
            PG8_LDA(At, 1, 1); PG8_STAGE(PG8_SA(1, 0), a3, voffA);
            PG8_BAR; PG8_WAIT_L(0); PG8_MMA(1, 0, At, B0); PG8_BAR; PG8_SCHED;
            PG8_STAGE(PG8_SB(1, 1), b3 + hstep, voffB);
            PG8_WAIT_V(6); PG8_BAR; PG8_MMA(1, 1, At, B1); PG8_BAR;
        }
        E(acc, cur, wr, wc, fr, fq);
        if (!has_next) break;
#pragma unroll
        for (int a = 0; a < 2; ++a)
#pragma unroll
            for (int b = 0; b < 2; ++b)
#pragma unroll
                for (int m = 0; m < 4; ++m)
#pragma unroll
                    for (int n = 0; n < 2; ++n) acc[a][b][m][n] = (f32x4){0.f, 0.f, 0.f, 0.f};
        cur = nxt; cA = nA; cB = nB; ++ui;
    }
    PG8_WAIT_V(0);
    if (wr == 0) PG8_BAR;
    PG8_BAR;
#undef PG8_SA
#undef PG8_SB
#undef PG8_STAGE
#undef PG8_LDA
#undef PG8_LDB
#undef PG8_MMA
#undef PG8_WAIT_V
#undef PG8_WAIT_L
#undef PG8_BAR
#undef PG8_SCHED
}
}
using pg8::Unit;

struct EpiProj {
    static constexpr bool PERM = true;
    unsigned char* ws; const float* lb; const float* ng; float* kmean;
    __device__ __forceinline__ void operator()(const f32x4 (&acc)[2][2][4][2], const Unit& u, int wr, int wc, int fr, int fq) const {
        const int pn = u.pn; int seg, colt, ldc; size_t boff;
        if (pn < 14) { seg = pn >> 1; colt = (pn & 1) * 256; ldc = 512; boff = OFF_QA + (size_t)seg * SZ_T512; }
        else if (pn < 18) { seg = 7; colt = (pn - 14) * 256; ldc = 1024; boff = OFF_GA; }
        else { seg = 8; colt = (pn - 18) * 256; ldc = 1024; boff = OFF_GB; }
        bf16_t* base = (bf16_t*)(ws + boff);
        const int row0 = u.pm * 256 + wr * 64 + fr, col0 = colt + wc * 32 + 8 * fq;
        float pv[2][8];
#pragma unroll
        for (int bj = 0; bj < 2; ++bj)
#pragma unroll
            for (int e = 0; e < 8; ++e) pv[bj][e] = (seg == 4) ? (1.0f - lb[col0 + bj * 128 + e]) : ((seg == 6) ? ng[col0 + bj * 128 + e] : 0.f);
        float cs[2][8];
#pragma unroll
        for (int bj = 0; bj < 2; ++bj)
#pragma unroll
            for (int e = 0; e < 8; ++e) cs[bj][e] = 0.f;
#pragma unroll
        for (int ai = 0; ai < 2; ++ai)
#pragma unroll
            for (int m = 0; m < 4; ++m) {
                bf16_t* rowp = base + (size_t)(row0 + ai * 128 + m * 16) * ldc + col0;
#pragma unroll
                for (int bj = 0; bj < 2; ++bj) {
                    float v[8];
#pragma unroll
                    for (int e = 0; e < 4; ++e) { v[e] = acc[ai][bj][m][0][e]; v[4 + e] = acc[ai][bj][m][1][e]; }
                    if (seg == 0) {
#pragma unroll
                        for (int e = 0; e < 8; ++e) v[e] *= (0.125f * LOG2E);
                    } else if (seg == 1) {
#pragma unroll
                        for (int e = 0; e < 8; ++e) cs[bj][e] += v[e];
                    } else if (seg == 3) {
#pragma unroll
                        for (int e = 0; e < 8; ++e) v[e] = v[e] * sigmoidf_(v[e]);
                    } else if (seg == 4) {
#pragma unroll
                        for (int e = 0; e < 8; ++e) v[e] = pv[bj][e] * sigmoidf_(-v[e]);
                    } else if (seg == 6) {
#pragma unroll
                        for (int e = 0; e < 8; ++e) v[e] = pv[bj][e] * v[e] * sigmoidf_(v[e]);
                    } else if (seg >= 7) {
#pragma unroll
                        for (int e = 0; e < 8; ++e) v[e] = sigmoidf_(v[e]);
                    }
                    u32x4 w; w.x = cvt_pk_bf16(v[0], v[1]); w.y = cvt_pk_bf16(v[2], v[3]); w.z = cvt_pk_bf16(v[4], v[5]); w.w = cvt_pk_bf16(v[6], v[7]);
                    *(u32x4*)(rowp + bj * 128) = w;
                }
            }
        if (seg == 1) {
#pragma unroll
            for (int bj = 0; bj < 2; ++bj)
#pragma unroll
                for (int e = 0; e < 8; ++e) {
                    float s = cs[bj][e];
                    s += __shfl_xor(s, 1); s += __shfl_xor(s, 2); s += __shfl_xor(s, 4); s += __shfl_xor(s, 8);
                    if (fr == 0) atomicAdd(kmean + (size_t)u.pm * 512 + col0 + bj * 128 + e, s);
                }
        }
    }
};
struct EpiMixA {
    static constexpr bool PERM = true;
    bf16_t* GA;
    __device__ __forceinline__ void operator()(const f32x4 (&acc)[2][2][4][2], const Unit& u, int wr, int wc, int fr, int fq) const {
        const int row0 = u.pm * 256 + wr * 64 + fr, col0 = u.pn * 256 + wc * 32 + 8 * fq;
#pragma unroll
        for (int ai = 0; ai < 2; ++ai)
#pragma unroll
            for (int m = 0; m < 4; ++m) {
                bf16_t* rowp = GA + (size_t)(row0 + ai * 128 + m * 16) * 1024 + col0;
#pragma unroll
                for (int bj = 0; bj < 2; ++bj) {
                    const u32x4 g = *(const u32x4*)(rowp + bj * 128);
                    const f32x4 a0 = acc[ai][bj][m][0], a1 = acc[ai][bj][m][1];
                    u32x4 w;
                    w.x = cvt_pk_bf16(bf_lo(g.x) * a0[0], bf_hi(g.x) * a0[1]); w.y = cvt_pk_bf16(bf_lo(g.y) * a0[2], bf_hi(g.y) * a0[3]);
                    w.z = cvt_pk_bf16(bf_lo(g.z) * a1[0], bf_hi(g.z) * a1[1]); w.w = cvt_pk_bf16(bf_lo(g.w) * a1[2], bf_hi(g.w) * a1[3]);
                    *(u32x4*)(rowp + bj * 128) = w;
                }
            }
    }
};
struct EpiMixB {
    static constexpr bool PERM = true;
    bf16_t* GA; const bf16_t* GB;
    __device__ __forceinline__ void operator()(const f32x4 (&acc)[2][2][4][2], const Unit& u, int wr, int wc, int fr, int fq) const {
        const int row0 = u.pm * 256 + wr * 64 + fr, col0 = u.pn * 256 + wc * 32 + 8 * fq;
#pragma unroll
        for (int ai = 0; ai < 2; ++ai)
#pragma unroll
            for (int m = 0; m < 4; ++m) {
                const size_t off = (size_t)(row0 + ai * 128 + m * 16) * 1024 + col0;
#pragma unroll
                for (int bj = 0; bj < 2; ++bj) {
                    const u32x4 g = *(const u32x4*)(GB + off + bj * 128);
                    const u32x4 mx = *(const u32x4*)(GA + off + bj * 128);
                    const f32x4 a0 = acc[ai][bj][m][0], a1 = acc[ai][bj][m][1];
                    u32x4 w;
                    w.x = cvt_pk_bf16(bf_lo(mx.x) + bf_lo(g.x) * a0[0], bf_hi(mx.x) + bf_hi(g.x) * a0[1]); w.y = cvt_pk_bf16(bf_lo(mx.y) + bf_lo(g.y) * a0[2], bf_hi(mx.y) + bf_hi(g.y) * a0[3]);
                    w.z = cvt_pk_bf16(bf_lo(mx.z) + bf_lo(g.z) * a1[0], bf_hi(mx.z) + bf_hi(g.z) * a1[1]); w.w = cvt_pk_bf16(bf_lo(mx.w) + bf_lo(g.w) * a1[2], bf_hi(mx.w) + bf_hi(g.w) * a1[3]);
                    *(u32x4*)(GA + off + bj * 128) = w;
                }
            }
    }
};
struct EpiOut {
    static constexpr bool PERM = true;
    const float* ada; bf16_t* D;
    __device__ __forceinline__ void operator()(const f32x4 (&acc)[2][2][4][2], const Unit& u, int wr, int wc, int fr, int fq) const {
        const int row0 = u.pm * 256 + wr * 64 + fr, col0 = u.pn * 256 + wc * 32 + 8 * fq;
        const float* gt1 = ada + (size_t)(u.pm >> 3) * 6144 + 2048 + col0;
        f32x4 g[2][2];
#pragma unroll
        for (int bj = 0; bj < 2; ++bj) { g[bj][0] = *(const f32x4*)(gt1 + bj * 128); g[bj][1] = *(const f32x4*)(gt1 + bj * 128 + 4); }
#pragma unroll
        for (int ai = 0; ai < 2; ++ai)
#pragma unroll
            for (int m = 0; m < 4; ++m) {
                bf16_t* rowp = D + (size_t)(row0 + ai * 128 + m * 16) * 1024 + col0;
#pragma unroll
                for (int bj = 0; bj < 2; ++bj) {
                    const f32x4 a0 = acc[ai][bj][m][0] * g[bj][0], a1 = acc[ai][bj][m][1] * g[bj][1];
                    u32x4 w; w.x = cvt_pk_bf16(a0[0], a0[1]); w.y = cvt_pk_bf16(a0[2], a0[3]); w.z = cvt_pk_bf16(a1[0], a1[1]); w.w = cvt_pk_bf16(a1[2], a1[3]);
                    *(u32x4*)(rowp + bj * 128) = w;
                }
            }
    }
};
struct EpiBf16 {
    static constexpr bool PERM = true;
    bf16_t* O;
    __device__ __forceinline__ void operator()(const f32x4 (&acc)[2][2][4][2], const Unit& u, int wr, int wc, int fr, int fq) const {
        const int row0 = u.pm * 256 + wr * 64 + fr, col0 = u.pn * 256 + wc * 32 + 8 * fq;
#pragma unroll
        for (int ai = 0; ai < 2; ++ai)
#pragma unroll
            for (int m = 0; m < 4; ++m) {
                bf16_t* rowp = O + (size_t)(row0 + ai * 128 + m * 16) * 1024 + col0;
#pragma unroll
                for (int bj = 0; bj < 2; ++bj) {
                    const f32x4 a0 = acc[ai][bj][m][0], a1 = acc[ai][bj][m][1];
                    u32x4 w; w.x = cvt_pk_bf16(a0[0], a0[1]); w.y = cvt_pk_bf16(a0[2], a0[3]); w.z = cvt_pk_bf16(a1[0], a1[1]); w.w = cvt_pk_bf16(a1[2], a1[3]);
                    *(u32x4*)(rowp + bj * 128) = w;
                }
            }
    }
};

__device__ void phase0a(const Params& P, LAS unsigned char* lds) {
    const int tid = tid_opaque(), G = gridDim.x, bid = blockIdx.x;
    for (int it = bid; it < 192; it += G) {
        LAS float* sc = (LAS float*)lds;
        for (int i = tid; i < 32 * 1024; i += NTHR) { const float cv = P.c[i]; sc[i] = cv * sigmoidf_(cv); }
        __syncthreads();
        const int kg = tid >> 5, col = tid & 31;
        float a[32];
#pragma unroll
        for (int b = 0; b < 32; ++b) a[b] = 0.f;
#pragma unroll 1
        for (int k = kg * 64; k < kg * 64 + 64; k += 8) {
            float w[8];
#pragma unroll
            for (int e = 0; e < 8; ++e) w[e] = __builtin_nontemporal_load(P.w_ada + (size_t)(k + e) * 6144 + it * 32 + col);
#pragma unroll
            for (int e4 = 0; e4 < 2; ++e4) {
#pragma unroll
                for (int b = 0; b < 32; ++b) { const f32x4 s = *(const LAS f32x4*)(sc + b * 1024 + k + 4 * e4); a[b] += s[0] * w[4 * e4] + s[1] * w[4 * e4 + 1] + s[2] * w[4 * e4 + 2] + s[3] * w[4 * e4 + 3]; }
                asm volatile("" ::: "memory");
            }
        }
        __syncthreads();
        LAS float* red = (LAS float*)lds;
#pragma unroll
        for (int b = 0; b < 32; ++b) red[(kg * 32 + b) * 32 + col] = a[b];
        __syncthreads();
        for (int o = tid; o < 1024; o += NTHR) { const int b = o >> 5, cc = o & 31; float s = 0.f;
#pragma unroll
            for (int g2 = 0; g2 < 16; ++g2) s += red[(g2 * 32 + b) * 32 + cc];
            ((float*)(P.ws + OFF_ADA))[(size_t)b * 6144 + it * 32 + cc] = s + P.b_ada[it * 32 + cc]; }
        __syncthreads();
    }
    const size_t gsz = (size_t)G * NTHR;
    { const int gt = bid * NTHR + tid, gs = G * NTHR;
      if (gt < 512) ((float*)(P.ws + OFF_LB))[gt] = sigmoidf_(P.hgrn_lb[gt] - P.hgrn_lb[512 + gt]);
      for (int i = gt; i < 32 * 8 * 512; i += gs) ((float*)(P.ws + OFF_KMEAN))[i] = 0.f; }
    {
        LAS float* tile = (LAS float*)lds;
        const int I0 = 16 * 88, I1 = I0 + 8 * 16, I2 = I1 + 8 * 16, I3 = I2 + 16 * 16, I4 = I3 + 16 * 16;
        for (int it = bid; it < I4; it += G) {
            const float* W; bf16_t* WT; int K, N, r;
            if (it < I0) { W = P.w_in; WT = (bf16_t*)(P.ws + OFF_WIN); K = 1024; N = 5632; r = it; }
            else if (it < I1) { W = P.w_ba; WT = (bf16_t*)(P.ws + OFF_WBA); K = 512; N = 1024; r = it - I0; }
            else if (it < I2) { W = P.w_bb; WT = (bf16_t*)(P.ws + OFF_WBB); K = 512; N = 1024; r = it - I1; }
            else if (it < I3) { W = P.w_out; WT = (bf16_t*)(P.ws + OFF_WOUT); K = 1024; N = 1024; r = it - I2; }
            else { W = P.peer_wq; WT = (bf16_t*)(P.ws + OFF_WQ); K = 1024; N = 1024; r = it - I3; }
            const int nb = N / 64, k0 = (r / nb) * 64, n0 = (r % nb) * 64;
#pragma unroll
            for (int ps = 0; ps < 2; ++ps) { const int kk = (tid >> 4) + 32 * ps, n4 = (tid & 15) * 4;
                const f32x4 v = *(const f32x4*)(W + (size_t)(k0 + kk) * N + n0 + n4);
                tile[kk * 65 + n4] = v[0]; tile[kk * 65 + n4 + 1] = v[1]; tile[kk * 65 + n4 + 2] = v[2]; tile[kk * 65 + n4 + 3] = v[3]; }
            __syncthreads();
            { const int n = tid >> 3, kc = (tid & 7) * 8; u32x4 w;
              w.x = cvt_pk_bf16(tile[(kc + 0) * 65 + n], tile[(kc + 1) * 65 + n]); w.y = cvt_pk_bf16(tile[(kc + 2) * 65 + n], tile[(kc + 3) * 65 + n]);
              w.z = cvt_pk_bf16(tile[(kc + 4) * 65 + n], tile[(kc + 5) * 65 + n]); w.w = cvt_pk_bf16(tile[(kc + 6) * 65 + n], tile[(kc + 7) * 65 + n]);
              *(u32x4*)(WT + (size_t)(n0 + n) * K + k0 + kc) = w; }
            __syncthreads();
        }
    }
    {
        const size_t gtid = (size_t)bid * NTHR + tid_opaque();
        for (size_t i = gtid; i < 16384; i += gsz) {
            const float* src = P.peer_sk + i * 8; const f32x4 a = *(const f32x4*)src, b = *(const f32x4*)(src + 4);
            u32x4 w; w.x = cvt_pk_bf16(a[0], a[1]); w.y = cvt_pk_bf16(a[2], a[3]); w.z = cvt_pk_bf16(b[0], b[1]); w.w = cvt_pk_bf16(b[2], b[3]);
            *(u32x4*)((bf16_t*)(P.ws + OFF_SK) + i * 8) = w;
        }
        { const int lane = tid & 63, gw = bid * 8 + (tid >> 6), ngw = G * 8;
          for (int r = gw; r < 2 * 16384; r += ngw) {
              const bool isv = r >= 16384; const int e = isv ? r - 16384 : r;
              const float* s = (isv ? P.peer_v : P.peer_u) + (size_t)e * 1024 + lane * 16;
              f32x4 x[4]; float ss = 0.f;
#pragma unroll
              for (int q = 0; q < 4; ++q) { x[q] = __builtin_nontemporal_load((const f32x4*)(s + 4 * q)); ss += (x[q][0] * x[q][0] + x[q][1] * x[q][1]) + (x[q][2] * x[q][2] + x[q][3] * x[q][3]); }
              const float sc = fmaxf(sqrtf(wave_sum(ss) * (1.0f / 1024.0f)) * (2.6f / 7.5f), 1e-30f), inv = 1.0f / sc;
              unsigned nb[16];
#pragma unroll
              for (int q = 0; q < 4; ++q)
#pragma unroll
                  for (int el = 0; el < 4; ++el) nb[4 * q + el] = (unsigned)fminf(fmaxf(floorf(x[q][el] * inv) + 8.0f, 0.0f), 15.0f);
              u32x2 w;
              w.x = (nb[0] | (nb[4] << 4)) | ((nb[1] | (nb[5] << 4)) << 8) | ((nb[2] | (nb[6] << 4)) << 16) | ((nb[3] | (nb[7] << 4)) << 24);
              w.y = (nb[8] | (nb[12] << 4)) | ((nb[9] | (nb[13] << 4)) << 8) | ((nb[10] | (nb[14] << 4)) << 16) | ((nb[11] | (nb[15] << 4)) << 24);
              *(u32x2*)(P.ws + (isv ? OFF_V8 : OFF_U8) + (size_t)e * 512 + lane * 8) = w;
              if (lane == 0) ((float*)(P.ws + (isv ? OFF_VSC : OFF_USC)))[e] = sc;
          } }
    }
}
__device__ void phase0b(const Params& P) {
    const size_t gtid = (size_t)blockIdx.x * NTHR + threadIdx.x, gsz = (size_t)gridDim.x * NTHR;
    const float* ada = (const float*)(P.ws + OFF_ADA); bf16_t* H = (bf16_t*)(P.ws + OFF_H);
    for (size_t i = gtid; i < (size_t)NTOK * 128; i += gsz) {
        const size_t row = i >> 7; const int c8 = (int)(i & 127) * 8; const int b = (int)(row >> 11);
        const float* xr = P.x + row * 1024 + c8; const float* sh = ada + (size_t)b * 6144 + c8; const float* sc = sh + 1024;
        const f32x4 x0 = *(const f32x4*)xr, x1 = *(const f32x4*)(xr + 4), s0 = *(const f32x4*)sc, s1 = *(const f32x4*)(sc + 4), h0 = *(const f32x4*)sh, h1 = *(const f32x4*)(sh + 4);
        const f32x4 r0 = x0 * (s0 + 1.0f) + h0, r1 = x1 * (s1 + 1.0f) + h1;
        u32x4 w; w.x = cvt_pk_bf16(r0[0], r0[1]); w.y = cvt_pk_bf16(r0[2], r0[3]); w.z = cvt_pk_bf16(r1[0], r1[1]); w.w = cvt_pk_bf16(r1[2], r1[3]);
        *(u32x4*)(H + row * 1024 + c8) = w;
    }
}

__device__ __forceinline__ s16x4 tr4(const LAS unsigned char* p) { return __builtin_bit_cast(s16x4, __builtin_amdgcn_ds_read_tr16_b64_v4i16((LAS s16x4*)p)); }
__device__ void hgrn_item(const Params& P, int item, LAS unsigned char* lds) {
    const int tid = tid_opaque(), lane = tid & 63, wid = __builtin_amdgcn_readfirstlane(tid >> 6), r32 = lane & 31, hi = lane >> 5;
    const int b = item >> 3, h = (item >> 1) & 3, vh = item & 1;
    const bf16_t* HQ = (const bf16_t*)(P.ws + OFF_HQ); const bf16_t* HK = (const bf16_t*)(P.ws + OFF_HK); bf16_t* HI = (bf16_t*)(P.ws + OFF_HI);
    constexpr int SQ = 272, SKD = 320, SV = 192, SS = 192;
    constexpr int LQR = 0, LKR = 17408, LQB = 34816, LKD = 52224, LV = 72704, LS = 84992, LG = 109568, LT = 142336, LCL = 144384;
    LAS float* G = (LAS float*)(lds + LG); LAS float* TOT = (LAS float*)(lds + LT); LAS float* CL = (LAS float*)(lds + LCL);
    const size_t rowb = (size_t)b * SEQ;
    const int row = tid >> 3, seg = tid & 7;
    const bf16_t* qsrc = HQ + (rowb + row) * 512 + h * 128 + seg * 16; const bf16_t* ksrc = HK + (rowb + row) * 512 + h * 128 + seg * 16;
    bf16_t* vsrc = HI + (rowb + row) * 512 + h * 128 + vh * 64 + seg * 8;
    for (int i = tid; i < 128 * SS / 4; i += NTHR) ((LAS unsigned*)(lds + LS))[i] = 0u;
    f32x16 Sacc = {};
    const int di = wid >> 1, vi = wid & 1, ti = wid >> 1;
    const int tg = lane >> 4, tc = tg & 1, tI = lane & 15;
    const int trow = 4 * hi + (tI >> 2), tcol = 16 * tc + 4 * (tI & 3);
    u32x4 qn0 = *(const u32x4*)qsrc, qn1 = *(const u32x4*)(qsrc + 8), kn0 = *(const u32x4*)ksrc, kn1 = *(const u32x4*)(ksrc + 8), vn = *(const u32x4*)vsrc;
#pragma unroll 1
    for (int n = 0; n < SEQ / 64; ++n) {
        const u32x4 q0 = qn0, q1 = qn1, k0 = kn0, k1 = kn1, vv = vn;
        float qf[16] = {bf_lo(q0.x), bf_hi(q0.x), bf_lo(q0.y), bf_hi(q0.y), bf_lo(q0.z), bf_hi(q0.z), bf_lo(q0.w), bf_hi(q0.w), bf_lo(q1.x), bf_hi(q1.x), bf_lo(q1.y), bf_hi(q1.y), bf_lo(q1.z), bf_hi(q1.z), bf_lo(q1.w), bf_hi(q1.w)};
        float kf[16] = {bf_lo(k0.x), bf_hi(k0.x), bf_lo(k0.y), bf_hi(k0.y), bf_lo(k0.z), bf_hi(k0.z), bf_lo(k0.w), bf_hi(k0.w), bf_lo(k1.x), bf_hi(k1.x), bf_lo(k1.y), bf_hi(k1.y), bf_lo(k1.z), bf_hi(k1.z), bf_lo(k1.w), bf_hi(k1.w)};
#pragma unroll
        for (int e4 = 0; e4 < 4; ++e4) *(LAS f32x4*)(G + row * 128 + seg * 16 + 4 * e4) = (f32x4){__logf(1.0f - kf[4 * e4]), __logf(1.0f - kf[4 * e4 + 1]), __logf(1.0f - kf[4 * e4 + 2]), __logf(1.0f - kf[4 * e4 + 3])};
        *(LAS u32x4*)(lds + LV + row * SV + seg * 16) = vv;
        if (n + 1 < SEQ / 64) { const size_t o = (size_t)(n + 1) * 64 * 512; qn0 = *(const u32x4*)(qsrc + o); qn1 = *(const u32x4*)(qsrc + o + 8); kn0 = *(const u32x4*)(ksrc + o); kn1 = *(const u32x4*)(ksrc + o + 8); vn = *(const u32x4*)(vsrc + o); }
        __syncthreads();
        { const int d = tid & 127, q4 = tid >> 7; float s = 0.f;
#pragma unroll
          for (int i = 0; i < 16; ++i) { s += G[(16 * q4 + i) * 128 + d]; G[(16 * q4 + i) * 128 + d] = s; }
          TOT[q4 * 128 + d] = s; }
        __syncthreads();
        {
            const int qq = row >> 4;
#pragma unroll
            for (int e4 = 0; e4 < 4; ++e4) {
                const int d4 = seg * 16 + 4 * e4;
                const f32x4 t0 = *(const LAS f32x4*)(TOT + d4), t1 = *(const LAS f32x4*)(TOT + 128 + d4), t2 = *(const LAS f32x4*)(TOT + 256 + d4), t3 = *(const LAS f32x4*)(TOT + 384 + d4);
                const f32x4 off = (qq == 0) ? (f32x4){0.f, 0.f, 0.f, 0.f} : ((qq == 1) ? t0 : ((qq == 2) ? t0 + t1 : t0 + t1 + t2));
                const f32x4 bb = *(const LAS f32x4*)(G + row * 128 + d4) + off;
                const f32x4 bref = *(const LAS f32x4*)(G + 32 * 128 + d4) + t0 + t1, blast = t0 + t1 + t2 + t3;
                float vqb[4], vqr[4], vkr[4], vkd[4];
#pragma unroll
                for (int e = 0; e < 4; ++e) {
                    const float e1 = __expf(bb[e]), e2 = __expf(-bb[e]);
                    vqb[e] = qf[4 * e4 + e] * e1; vqr[e] = vqb[e] * __expf(-bref[e]);
                    const float ke = kf[4 * e4 + e] * e2; vkr[e] = ke * __expf(bref[e]); vkd[e] = ke * __expf(blast[e]);
                }
                *(LAS u32x2*)(lds + LQB + row * SQ + seg * 32 + 8 * e4) = (u32x2){cvt_pk_bf16(vqb[0], vqb[1]), cvt_pk_bf16(vqb[2], vqb[3])};
                *(LAS u32x2*)(lds + LQR + row * SQ + seg * 32 + 8 * e4) = (u32x2){cvt_pk_bf16(vqr[0], vqr[1]), cvt_pk_bf16(vqr[2], vqr[3])};
                *(LAS u32x2*)(lds + LKR + row * SQ + seg * 32 + 8 * e4) = (u32x2){cvt_pk_bf16(vkr[0], vkr[1]), cvt_pk_bf16(vkr[2], vkr[3])};
                *(LAS u32x2*)(lds + LKD + row * SKD + seg * 32 + 8 * e4) = (u32x2){cvt_pk_bf16(vkd[0], vkd[1]), cvt_pk_bf16(vkd[2], vkd[3])};
                if (row == 0) *(LAS f32x4*)(CL + d4) = (f32x4){__expf(blast[0]), __expf(blast[1]), __expf(blast[2]), __expf(blast[3])};
                asm volatile("" ::: "memory");
            }
        }
        __syncthreads();
        if (wid < 4) {
            f32x16 Z = {};
            for (int si = 0; si <= ti; ++si) {
                f32x16 X = {};
#pragma unroll
                for (int ks = 0; ks < 8; ++ks) {
                    const bf16x8 a = *(const LAS bf16x8*)(lds + LKR + (32 * si + r32) * SQ + (16 * ks + 8 * hi) * 2);
                    const bf16x8 bq = *(const LAS bf16x8*)(lds + LQR + (32 * ti + r32) * SQ + (16 * ks + 8 * hi) * 2);
                    X = MFMA32(a, bq, X);
                }
                if (si == ti) {
#pragma unroll
                    for (int r = 0; r < 16; ++r) if (crow(r, hi) > r32) X[r] = 0.f;
                }
#pragma unroll
                for (int s2 = 0; s2 < 2; ++s2) {
                    union { u32x4 u; bf16x8 v; } pa;
                    pa.u.x = cvt_pk_bf16(X[8 * s2 + 0], X[8 * s2 + 1]); pa.u.y = cvt_pk_bf16(X[8 * s2 + 2], X[8 * s2 + 3]); pa.u.z = cvt_pk_bf16(X[8 * s2 + 4], X[8 * s2 + 5]); pa.u.w = cvt_pk_bf16(X[8 * s2 + 6], X[8 * s2 + 7]);
                    const LAS unsigned char* vp = lds + LV + (32 * si + 16 * s2 + trow) * SV + (32 * vi + tcol) * 2;
                    const s16x4 lo = tr4(vp), hh = tr4(vp + 8 * SV);
                    const bf16x8 vf = {lo[0], lo[1], lo[2], lo[3], hh[0], hh[1], hh[2], hh[3]};
                    Z = MFMA32(pa.v, vf, Z);
                }
            }
#pragma unroll
            for (int ks = 0; ks < 8; ++ks) {
                const bf16x8 a = *(const LAS bf16x8*)(lds + LQB + (32 * ti + r32) * SQ + (16 * ks + 8 * hi) * 2);
                const LAS unsigned char* sp = lds + LS + (16 * ks + 8 * hi + (tI >> 2)) * SS + (32 * vi + tcol) * 2;
                const s16x4 lo = tr4(sp), hh = tr4(sp + 4 * SS);
                const bf16x8 sf = {lo[0], lo[1], lo[2], lo[3], hh[0], hh[1], hh[2], hh[3]};
                Z = MFMA32(a, sf, Z);
            }
            bf16_t* op = HI + (rowb + (size_t)n * 64 + 32 * ti) * 512 + h * 128 + vh * 64 + 32 * vi + r32;
#pragma unroll
            for (int r = 0; r < 16; ++r) op[(size_t)crow(r, hi) * 512] = (bf16_t)(cvt_pk_bf16(Z[r], 0.f) & 0xffffu);
        }
        {
#pragma unroll
            for (int r = 0; r < 16; ++r) Sacc[r] *= CL[32 * di + crow(r, hi)];
#pragma unroll
            for (int ks = 0; ks < 4; ++ks) {
                const LAS unsigned char* kp = lds + LKD + (16 * ks + 8 * hi + (tI >> 2)) * SKD + (32 * di + tcol) * 2;
                const s16x4 klo = tr4(kp), khi = tr4(kp + 4 * SKD);
                const bf16x8 ka = {klo[0], klo[1], klo[2], klo[3], khi[0], khi[1], khi[2], khi[3]};
                const LAS unsigned char* vp = lds + LV + (16 * ks + 8 * hi + (tI >> 2)) * SV + (32 * vi + tcol) * 2;
                const s16x4 vlo = tr4(vp), vhi = tr4(vp + 4 * SV);
                const bf16x8 vb = {vlo[0], vlo[1], vlo[2], vlo[3], vhi[0], vhi[1], vhi[2], vhi[3]};
                Sacc = MFMA32(ka, vb, Sacc);
            }
        }
        __syncthreads();
        {
            LAS bf16_t* sp = (LAS bf16_t*)(lds + LS + (32 * di) * SS + (32 * vi + r32) * 2);
#pragma unroll
            for (int r = 0; r < 16; ++r) sp[crow(r, hi) * (SS / 2)] = (bf16_t)(cvt_pk_bf16(Sacc[r], 0.f) & 0xffffu);
        }
    }
    __syncthreads();
}

__device__ void moba_unit(const Params& P, int b, int h, int j, LAS unsigned char* lds) {
    const int tid = tid_opaque(), lane = tid & 63, wid = tid >> 6, r32 = lane & 31, hi = lane >> 5;
    bf16_t* Q = (bf16_t*)(P.ws + OFF_QA); const bf16_t* Kg = (const bf16_t*)(P.ws + OFF_KA); const bf16_t* Vg = (const bf16_t*)(P.ws + OFF_VA);
    const float* kmean = (const float*)(P.ws + OFF_KMEAN);
    constexpr int KIMG = 64 * 144, VIMG = 64 * 192, LK = 0, LV = 2 * KIMG, LKM = 2 * KIMG + 2 * VIMG;
    LAS float* kmL = (LAS float*)(lds + LKM);
    const size_t rowb = (size_t)b * SEQ; const int q0 = j * 256;
    if (tid < j * 64) kmL[tid] = kmean[(size_t)(b * 8 + (tid >> 6)) * 512 + h * 64 + (tid & 63)];
    bf16_t* qrow = Q + (rowb + q0 + wid * 32 + r32) * 512 + h * 64;
    bf16x8 qf[4];
#pragma unroll
    for (int d0 = 0; d0 < 4; ++d0) qf[d0] = *(const bf16x8*)(qrow + 16 * d0 + 8 * hi);
    const int srow = tid >> 3, sch = tid & 7;
    const bf16_t* ksrc = Kg + (rowb + srow) * 512 + h * 64 + sch * 8; const bf16_t* vsrc = Vg + (rowb + srow) * 512 + h * 64 + sch * 8;
    const int ntile = 4 * (j + 1);
    u32x4 kreg, vreg;
    { const int key0 = q0; kreg = *(const u32x4*)(ksrc + (size_t)key0 * 512); vreg = *(const u32x4*)(vsrc + (size_t)key0 * 512); }
    *(LAS u32x4*)(lds + LK + srow * 144 + sch * 16) = kreg; *(LAS u32x4*)(lds + LV + srow * 192 + sch * 16) = vreg;
    __syncthreads();
    unsigned sel = 0;
    if (j <= 3) sel = (1u << j) - 1u;
    else {
        float g[7];
#pragma unroll
        for (int n = 0; n < 7; ++n) { float s = 0.f;
            if (n < j) {
#pragma unroll
                for (int d0 = 0; d0 < 4; ++d0)
#pragma unroll
                    for (int e = 0; e < 8; ++e) s += __uint_as_float(((unsigned)(unsigned short)qf[d0][e]) << 16) * kmL[n * 64 + 16 * d0 + 8 * hi + e];
            }
            s += __shfl_xor(s, 32); g[n] = s; }
#pragma unroll
        for (int it = 0; it < 3; ++it) { float best = -INFINITY; int bi = 0;
#pragma unroll
            for (int n = 0; n < 7; ++n) if (n < j && !((sel >> n) & 1u) && g[n] > best) { best = g[n]; bi = n; }
            sel |= 1u << bi; }
    }
    const float ch = exp2f(-(float)(h + 1)) * LOG2E;
    const int qb = wid * 32 + r32;
    float m_run = -1e30f, l_run = 0.f;
    f32x16 o0 = {}, o1 = {};
    const int tg = lane >> 4, tc = tg & 1, ti = lane & 15;
    const int vlane = (4 * hi + (ti >> 2)) * 192 + (16 * tc + 4 * (ti & 3)) * 2;
#pragma unroll 1
    for (int i = 0; i < ntile; ++i) {
        const int buf = i & 1;
        const bool own = i < 4; const int blk = own ? j : ((i - 4) >> 2), kt = own ? i : ((i - 4) & 3);
        if (i + 1 < ntile) { const int i1 = i + 1; const int blk1 = (i1 < 4) ? j : ((i1 - 4) >> 2), kt1 = (i1 < 4) ? i1 : ((i1 - 4) & 3); const size_t key1 = (size_t)(blk1 * 256 + kt1 * 64);
            kreg = *(const u32x4*)(ksrc + key1 * 512); vreg = *(const u32x4*)(vsrc + key1 * 512); }
        const bool lane_ok = own ? true : (((sel >> blk) & 1u) != 0u);
        const bool skip = own ? (64 * kt > 32 * wid + 31) : (__ballot(lane_ok) == 0ull);
        if (!skip) {
            LAS unsigned char* kb = lds + LK + buf * KIMG; LAS unsigned char* vb = lds + LV + buf * VIMG;
            f32x16 p0 = {}, p1 = {};
#pragma unroll
            for (int d0 = 0; d0 < 4; ++d0) {
                const bf16x8 kf0 = *(const LAS bf16x8*)(kb + r32 * 144 + (16 * d0 + 8 * hi) * 2);
                const bf16x8 kf1 = *(const LAS bf16x8*)(kb + (32 + r32) * 144 + (16 * d0 + 8 * hi) * 2);
                p0 = MFMA32(kf0, qf[d0], p0); p1 = MFMA32(kf1, qf[d0], p1);
            }
            const float kbase = ch * (float)((blk - j) * 256 + kt * 64);
            float mt = -1e30f;
#pragma unroll
            for (int r = 0; r < 16; ++r) {
                const int kl0 = crow(r, hi), kl1 = kl0 + 32;
                const float t0 = p0[r] + (kbase + ch * (float)kl0), t1 = p1[r] + (kbase + ch * (float)kl1);
                const bool v0 = own ? (kt * 64 + kl0 <= qb) : lane_ok, v1 = own ? (kt * 64 + kl1 <= qb) : lane_ok;
                p0[r] = v0 ? t0 : -1e30f; p1[r] = v1 ? t1 : -1e30f;
                mt = fmaxf(mt, fmaxf(p0[r], p1[r]));
            }
            mt = fmaxf(mt, __shfl_xor(mt, 32));
            const float mnew = fmaxf(m_run, mt), alpha = __builtin_amdgcn_exp2f(m_run - mnew);
            m_run = mnew;
            float rs = 0.f;
#pragma unroll
            for (int r = 0; r < 16; ++r) { p0[r] = __builtin_amdgcn_exp2f(p0[r] - mnew); p1[r] = __builtin_amdgcn_exp2f(p1[r] - mnew); rs += p0[r] + p1[r]; }
            l_run = l_run * alpha + rs;
#pragma unroll
            for (int r = 0; r < 16; ++r) { o0[r] *= alpha; o1[r] *= alpha; }
#pragma unroll
            for (int sub = 0; sub < 2; ++sub)
#pragma unroll
                for (int s = 0; s < 2; ++s) {
                    union { u32x4 u; bf16x8 v; } pb;
                    if (sub == 0) { pb.u.x = cvt_pk_bf16(p0[8 * s + 0], p0[8 * s + 1]); pb.u.y = cvt_pk_bf16(p0[8 * s + 2], p0[8 * s + 3]); pb.u.z = cvt_pk_bf16(p0[8 * s + 4], p0[8 * s + 5]); pb.u.w = cvt_pk_bf16(p0[8 * s + 6], p0[8 * s + 7]); }
                    else { pb.u.x = cvt_pk_bf16(p1[8 * s + 0], p1[8 * s + 1]); pb.u.y = cvt_pk_bf16(p1[8 * s + 2], p1[8 * s + 3]); pb.u.z = cvt_pk_bf16(p1[8 * s + 4], p1[8 * s + 5]); pb.u.w = cvt_pk_bf16(p1[8 * s + 6], p1[8 * s + 7]); }
#pragma unroll
                    for (int dt = 0; dt < 2; ++dt) {
                        LAS unsigned char* va = vb + (32 * sub + 16 * s) * 192 + dt * 64 + vlane;
                        const s16x4 lo = __builtin_bit_cast(s16x4, __builtin_amdgcn_ds_read_tr16_b64_v4i16((LAS s16x4*)va));
                        const s16x4 hh = __builtin_bit_cast(s16x4, __builtin_amdgcn_ds_read_tr16_b64_v4i16((LAS s16x4*)(va + 8 * 192)));
                        const bf16x8 vf = {lo[0], lo[1], lo[2], lo[3], hh[0], hh[1], hh[2], hh[3]};
                        if (dt == 0) o0 = MFMA32(vf, pb.v, o0); else o1 = MFMA32(vf, pb.v, o1);
                    }
                }
        }
        if (i + 1 < ntile) { const int nb = buf ^ 1;
            *(LAS u32x4*)(lds + LK + nb * KIMG + srow * 144 + sch * 16) = kreg; *(LAS u32x4*)(lds + LV + nb * VIMG + srow * 192 + sch * 16) = vreg; }
        __syncthreads();
    }
    l_run += __shfl_xor(l_run, 32);
    const float inv = 1.0f / l_run;
#pragma unroll
    for (int r4 = 0; r4 < 4; ++r4) {
        u32x2 w0, w1;
        w0.x = cvt_pk_bf16(o0[4 * r4] * inv, o0[4 * r4 + 1] * inv); w0.y = cvt_pk_bf16(o0[4 * r4 + 2] * inv, o0[4 * r4 + 3] * inv);
        w1.x = cvt_pk_bf16(o1[4 * r4] * inv, o1[4 * r4 + 1] * inv); w1.y = cvt_pk_bf16(o1[4 * r4 + 2] * inv, o1[4 * r4 + 3] * inv);
        *(u32x2*)(qrow + 8 * r4 + 4 * hi) = w0; *(u32x2*)(qrow + 32 + 8 * r4 + 4 * hi) = w1;
    }
}

__device__ void yb_norm_panel(const Params& P, int pm) {
    const int tid = tid_opaque(), lane = tid & 63, wid = tid >> 6;
    bf16_t* HI = (bf16_t*)(P.ws + OFF_HI); const bf16_t* HG = (const bf16_t*)(P.ws + OFF_HG);
    for (int r = 0; r < 32; ++r) {
        const size_t off = ((size_t)pm * 256 + wid * 32 + r) * 512 + lane * 8;
        const u32x4 ov = *(const u32x4*)(HI + off), gv = *(const u32x4*)(HG + off);
        float o[8] = {bf_lo(ov.x), bf_hi(ov.x), bf_lo(ov.y), bf_hi(ov.y), bf_lo(ov.z), bf_hi(ov.z), bf_lo(ov.w), bf_hi(ov.w)};
        const float g[8] = {bf_lo(gv.x), bf_hi(gv.x), bf_lo(gv.y), bf_hi(gv.y), bf_lo(gv.z), bf_hi(gv.z), bf_lo(gv.w), bf_hi(gv.w)};
        float ss = 0.f;
#pragma unroll
        for (int e = 0; e < 8; ++e) ss += o[e] * o[e];
        ss += __shfl_xor(ss, 1); ss += __shfl_xor(ss, 2); ss += __shfl_xor(ss, 4); ss += __shfl_xor(ss, 8);
        const float rs = rsqrtf(ss * (1.0f / 128.0f) + RMS_EPS);
        u32x4 w; w.x = cvt_pk_bf16(o[0] * rs * g[0], o[1] * rs * g[1]); w.y = cvt_pk_bf16(o[2] * rs * g[2], o[3] * rs * g[3]);
        w.z = cvt_pk_bf16(o[4] * rs * g[4], o[5] * rs * g[5]); w.w = cvt_pk_bf16(o[6] * rs * g[6], o[7] * rs * g[7]);
        *(u32x4*)(HI + off) = w;
    }
}
__device__ void ln1_panel(const Params& P, int pm) {
    const int tid = tid_opaque(), lane = tid & 63, wid = tid >> 6;
    const float* ada = (const float*)(P.ws + OFF_ADA) + (size_t)(pm >> 3) * 6144; bf16_t* H = (bf16_t*)(P.ws + OFF_H);
    for (int r = 0; r < 32; ++r) {
        const size_t row = (size_t)pm * 256 + wid * 32 + r;
        float* xr = P.out + row * 1024 + lane * 4; const float* xin = P.x + row * 1024 + lane * 4; const bf16_t* dl = (const bf16_t*)(P.ws + OFF_GB) + row * 1024 + lane * 4;
        f32x4 v[4]; float s = 0.f;
#pragma unroll
        for (int jx = 0; jx < 4; ++jx) { const u32x2 dv = *(const u32x2*)(dl + 256 * jx); const f32x4 xv = __builtin_nontemporal_load((const f32x4*)(xin + 256 * jx));
            v[jx] = xv * ALPHA + (f32x4){bf_lo(dv.x), bf_hi(dv.x), bf_lo(dv.y), bf_hi(dv.y)}; s += (v[jx][0] + v[jx][1]) + (v[jx][2] + v[jx][3]); }
        const float mean = wave_sum(s) * (1.0f / 1024.0f); float s2 = 0.f;
#pragma unroll
        for (int jx = 0; jx < 4; ++jx) { v[jx] = v[jx] - mean; s2 += (v[jx][0] * v[jx][0] + v[jx][1] * v[jx][1]) + (v[jx][2] * v[jx][2] + v[jx][3] * v[jx][3]); }
        const float rstd = rsqrtf(wave_sum(s2) * (1.0f / 1024.0f) + LN_EPS);
#pragma unroll
        for (int jx = 0; jx < 4; ++jx) {
            const int c = lane * 4 + 256 * jx;
            const f32x4 g = *(const f32x4*)(P.ln1_g + c), bb = *(const f32x4*)(P.ln1_b + c), sh = *(const f32x4*)(ada + 3072 + c), sc = *(const f32x4*)(ada + 4096 + c);
            const f32x4 x1 = v[jx] * rstd * g + bb;
            *(f32x4*)(xr + 256 * jx) = x1;
            const f32x4 h2 = x1 * (sc + 1.0f) + sh;
            u32x2 w; w.x = cvt_pk_bf16(h2[0], h2[1]); w.y = cvt_pk_bf16(h2[2], h2[3]);
            *(u32x2*)(H + row * 1024 + c) = w;
            v[jx] = h2;
        }
        {
            float mx = 0.f;
#pragma unroll
            for (int jx = 0; jx < 4; ++jx) mx = fmaxf(mx, fmaxf(fmaxf(fabsf(v[jx][0]), fabsf(v[jx][1])), fmaxf(fabsf(v[jx][2]), fabsf(v[jx][3]))));
#pragma unroll
            for (int o = 1; o < 64; o <<= 1) mx = fmaxf(mx, __shfl_xor(mx, o));
            const float hs = fmaxf(mx * (1.0f / 127.0f), 1e-30f), inv = 1.0f / hs; int qs = 0;
#pragma unroll
            for (int jx = 0; jx < 4; ++jx) {
                const int q0 = (int)rintf(v[jx][0] * inv), q1 = (int)rintf(v[jx][1] * inv), q2 = (int)rintf(v[jx][2] * inv), q3 = (int)rintf(v[jx][3] * inv);
                qs += (q0 + q1) + (q2 + q3);
                *(unsigned*)(P.ws + OFF_H8 + row * 1024 + lane * 4 + 256 * jx) = (unsigned)(q0 & 255) | ((unsigned)(q1 & 255) << 8) | ((unsigned)(q2 & 255) << 16) | ((unsigned)(q3 & 255) << 24);
            }
#pragma unroll
            for (int o = 1; o < 64; o <<= 1) qs += __shfl_xor(qs, o);
            if (lane == 0) *(f32x2*)(P.ws + OFF_HS + row * 8) = (f32x2){hs, (float)qs};
        }
    }
}

#define INS16(L, xin) do { float x_ = (xin); _Pragma("unroll") for (int k_ = 0; k_ < 16; ++k_) { const float hi_ = fmaxf(L[k_], x_); x_ = fminf(L[k_], x_); L[k_] = hi_; } } while (0)

__device__ void peer_select_wave(const Params& P, size_t tok0) {
    const int lane = tid_opaque() & 63, r32 = lane & 31, hi = lane >> 5;
    const bf16_t* QP = (const bf16_t*)(P.ws + OFF_GB) + (tok0 + r32) * 1024; const bf16_t* SK = (const bf16_t*)(P.ws + OFF_SK);
    u32x2* EG = (u32x2*)(P.ws + OFF_EG) + (tok0 + r32) * 128;
#pragma unroll 1
    for (int h = 0; h < 8; ++h) {
        float a0[16], a1[16];
#pragma unroll
        for (int k = 0; k < 16; ++k) { a0[k] = -INFINITY; a1[k] = -INFINITY; }
#pragma unroll 1
        for (int p = 0; p < 2; ++p) {
            const int hp = h * 2 + p;
            bf16x8 qf[4];
#pragma unroll
            for (int ks = 0; ks < 4; ++ks) qf[ks] = *(const bf16x8*)(QP + hp * 64 + 16 * ks + 8 * hi);
            float L[16];
#pragma unroll
            for (int k = 0; k < 16; ++k) L[k] = -INFINITY;
#pragma unroll
            for (int kt = 0; kt < 4; ++kt) {
                f32x16 acc = {};
#pragma unroll
                for (int ks = 0; ks < 4; ++ks) { const bf16x8 kf = *(const bf16x8*)(SK + ((size_t)hp * 128 + 32 * kt + r32) * 64 + 16 * ks + 8 * hi); acc = MFMA32(kf, qf[ks], acc); }
#pragma unroll
                for (int r = 0; r < 16; ++r) { const unsigned key = (unsigned)(32 * kt + crow(r, hi)); const float xv = __uint_as_float((__float_as_uint(acc[r]) & ~127u) | key); INS16(L, xv); }
            }
            float O[16];
#pragma unroll
            for (int k = 0; k < 16; ++k) O[k] = __shfl_xor(L[k], 32);
#pragma unroll
            for (int k = 0; k < 16; ++k) INS16(L, O[k]);
#pragma unroll
            for (int k = 0; k < 16; ++k) { a0[k] = (p == 0) ? L[k] : a0[k]; a1[k] = (p == 1) ? L[k] : a1[k]; }
        }
        float best[16];
#pragma unroll
        for (int k = 0; k < 16; ++k) best[k] = -INFINITY;
#pragma unroll
        for (int i = 0; i < 16; ++i)
#pragma unroll
            for (int jx = 0; jx < 16; ++jx)
                if ((i + 1) * (jx + 1) <= 16) {
                    const float cs = a0[i] + a1[jx];
                    const float cv = __uint_as_float((__float_as_uint(cs) & ~255u) | (unsigned)(i * 16 + jx));
                    INS16(best, cv);
                }
        unsigned pk0[4], pk1[4];
#pragma unroll
        for (int q = 0; q < 4; ++q) {
            pk0[q] = (__float_as_uint(a0[4 * q]) & 127u) | ((__float_as_uint(a0[4 * q + 1]) & 127u) << 8) | ((__float_as_uint(a0[4 * q + 2]) & 127u) << 16) | ((__float_as_uint(a0[4 * q + 3]) & 127u) << 24);
            pk1[q] = (__float_as_uint(a1[4 * q]) & 127u) | ((__float_as_uint(a1[4 * q + 1]) & 127u) << 8) | ((__float_as_uint(a1[4 * q + 2]) & 127u) << 16) | ((__float_as_uint(a1[4 * q + 3]) & 127u) << 24);
        }
        unsigned pay[16];
#pragma unroll
        for (int k = 0; k < 16; ++k) {
            const unsigned code = __float_as_uint(best[k]) & 255u, ci = code >> 4, cj = code & 15u;
            const unsigned qi = ci >> 2, qj = cj >> 2;
            const unsigned w0 = (qi == 0u) ? pk0[0] : ((qi == 1u) ? pk0[1] : ((qi == 2u) ? pk0[2] : pk0[3]));
            const unsigned w1 = (qj == 0u) ? pk1[0] : ((qj == 1u) ? pk1[1] : ((qj == 2u) ? pk1[2] : pk1[3]));
            pay[k] = (((w0 >> ((ci & 3u) * 8u)) & 127u) << 7) | ((w1 >> ((cj & 3u) * 8u)) & 127u);
        }
        float e[16], es = 0.f;
#pragma unroll
        for (int k = 0; k < 16; ++k) { e[k] = __expf(best[k] - best[0]); es += e[k]; }
        const float inv = 1.0f / es;
        if (hi == 0) {
#pragma unroll
            for (int k = 0; k < 16; ++k) { u32x2 w; w.x = pay[k]; w.y = __float_as_uint(e[k] * inv); EG[h * 16 + k] = w; }
        }
    }
}
__device__ __forceinline__ unsigned xcc_id() { return (unsigned)__builtin_amdgcn_s_getreg((3 << 11) | 20) & 0xFu; }
template <int CTRL> __device__ __forceinline__ float dpp_add(float x) { const int v = __builtin_amdgcn_update_dpp(0, __float_as_int(x), CTRL, 0xf, 0xf, true); return x + __int_as_float(v); }
__device__ __forceinline__ float wave_sum_fast(float x) {
    x = dpp_add<0xB1>(x); x = dpp_add<0x4E>(x); x = dpp_add<0x141>(x); x = dpp_add<0x140>(x);
    x += __shfl_xor(x, 16); x += __shfl_xor(x, 32); return x;
}
__device__ __forceinline__ float dot16_fp8(const float (&hv)[16], const u32x4 r) {
    float s = 0.f;
    { const f32x2 a = __builtin_amdgcn_cvt_pk_f32_fp8((int)r.x, false), b = __builtin_amdgcn_cvt_pk_f32_fp8((int)r.x, true); s += hv[0] * a.x + hv[1] * a.y + hv[2] * b.x + hv[3] * b.y; }
    { const f32x2 a = __builtin_amdgcn_cvt_pk_f32_fp8((int)r.y, false), b = __builtin_amdgcn_cvt_pk_f32_fp8((int)r.y, true); s += hv[4] * a.x + hv[5] * a.y + hv[6] * b.x + hv[7] * b.y; }
    { const f32x2 a = __builtin_amdgcn_cvt_pk_f32_fp8((int)r.z, false), b = __builtin_amdgcn_cvt_pk_f32_fp8((int)r.z, true); s += hv[8] * a.x + hv[9] * a.y + hv[10] * b.x + hv[11] * b.y; }
    { const f32x2 a = __builtin_amdgcn_cvt_pk_f32_fp8((int)r.w, false), b = __builtin_amdgcn_cvt_pk_f32_fp8((int)r.w, true); s += hv[12] * a.x + hv[13] * a.y + hv[14] * b.x + hv[15] * b.y; }
    return s;
}
template <int NP, class F> __device__ __forceinline__ void partition_queue(const Params& P, LAS unsigned char* lds, int ctr_base, F f) {
    const int tid = tid_opaque();
    LAS int* slot = (LAS int*)(lds + LDS_BYTES - 64);
    unsigned* ctr = (unsigned*)(P.ws + OFF_CTR) + ctr_base;
    const int myx = (int)(xcc_id() & 7u);
    for (int pp = 0; pp < NP; ++pp) {
        const int p = (myx * (NP / 8) + pp) % NP;
        for (;;) {
            if (tid == 0) *slot = (int)atomicAdd(ctr + p, 1u);
            __syncthreads();
            const int item = *slot;
            __syncthreads();
            if (item >= NTOK / 64) break;
            f(p, item);
        }
    }
}
__device__ __forceinline__ float dot2bf(unsigned a, bf16v2 b, float c) { return __builtin_amdgcn_fdot2_f32_bf16(__builtin_bit_cast(bf16v2, a), b, c, false); }
struct UQuad { u32x4 r[2]; u32x4 ent; };
__device__ __forceinline__ void uq_issue(UQuad& q, const LAS u32x4* list, int J, int NQ, int g, const unsigned char* U4) {
    const int jj = J < NQ ? J : NQ - 1;
    q.ent = list[4 * jj + g];
    const unsigned char* rp = U4 + (size_t)q.ent.x * 512;
    q.r[0] = *(const u32x4*)rp; q.r[1] = *(const u32x4*)(rp + 256);
}
__device__ __forceinline__ int dot8_i4(unsigned w, unsigned hlo, unsigned hhi, int acc) {
    acc = __builtin_amdgcn_sdot4((int)hlo, (int)(w & 0x0F0F0F0Fu), acc, false);
    return __builtin_amdgcn_sdot4((int)hhi, (int)((w >> 4) & 0x0F0F0F0Fu), acc, false);
}
__device__ __forceinline__ float uq_dot(const UQuad& q, const u32x4 (&hp)[4]) {
    int a = 0, b = 0;
#pragma unroll
    for (int c = 0; c < 2; ++c) {
        const u32x4 r = q.r[c];
        a = dot8_i4(r.x, hp[2 * c].x, hp[2 * c].y, a); b = dot8_i4(r.y, hp[2 * c].z, hp[2 * c].w, b);
        a = dot8_i4(r.z, hp[2 * c + 1].x, hp[2 * c + 1].y, a); b = dot8_i4(r.w, hp[2 * c + 1].z, hp[2 * c + 1].w, b);
    }
    float s = (float)(a + b);
    s = dpp_add<0xB1>(s); s = dpp_add<0x4E>(s); s = dpp_add<0x141>(s); s = dpp_add<0x140>(s);
    return s;
}
__device__ __forceinline__ void peer_u_tokens(const Params& P, LAS unsigned char* lds, const size_t t0) {
    const int tid = tid_opaque(), lane = tid & 63, wid = tid >> 6, g = lane >> 4, li = lane & 15;
    const unsigned char* H8 = P.ws + OFF_H8 + li * 32; const unsigned char* U4 = P.ws + OFF_U8 + li * 16;
    const f32x2* HS = (const f32x2*)(P.ws + OFF_HS); const float* USC = (const float*)(P.ws + OFF_USC);
    const u32x4* EG4 = (const u32x4*)(P.ws + OFF_EG); float* W = (float*)(P.ws + OFF_W);
    LAS u32x4* list = (LAS u32x4*)(lds + wid * 16384);
#pragma unroll 2
    for (int i = 0; i < 8; ++i) {
        const u32x4 eg = EG4[(t0 + i) * 64 + lane];
        list[i * 128 + 2 * lane] = (u32x4){eg.x, eg.y, (unsigned)(2 * lane) | (unsigned)(i << 8), __float_as_uint(USC[eg.x])};
        list[i * 128 + 2 * lane + 1] = (u32x4){eg.z, eg.w, (unsigned)(2 * lane + 1) | (unsigned)(i << 8), __float_as_uint(USC[eg.z])};
    }
    constexpr int NQ = 256;
    u32x4 hp[4], hn[4]; f32x2 hsc = HS[t0], hsn = HS[t0 + 1];
#pragma unroll
    for (int c = 0; c < 2; ++c) { hp[2 * c] = *(const u32x4*)(H8 + t0 * 1024 + 512 * c); hp[2 * c + 1] = *(const u32x4*)(H8 + t0 * 1024 + 512 * c + 16);
                                  hn[2 * c] = *(const u32x4*)(H8 + (t0 + 1) * 1024 + 512 * c); hn[2 * c + 1] = *(const u32x4*)(H8 + (t0 + 1) * 1024 + 512 * c + 16); }
    int curtok = 0;
    UQuad q0, q1, q2, q3;
    uq_issue(q0, list, 0, NQ, g, U4); uq_issue(q1, list, 1, NQ, g, U4); uq_issue(q2, list, 2, NQ, g, U4); uq_issue(q3, list, 3, NQ, g, U4);
#define UQ_STEP(q, Jn) do { \
        const int tk = __builtin_amdgcn_readfirstlane((int)(q.ent.z >> 8)); \
        if (tk != curtok) { curtok = tk; _Pragma("unroll") for (int c = 0; c < 4; ++c) hp[c] = hn[c]; hsc = hsn; \
            if (tk + 1 < 8) { hsn = HS[t0 + tk + 1]; _Pragma("unroll") for (int c = 0; c < 2; ++c) { hn[2 * c] = *(const u32x4*)(H8 + (t0 + tk + 1) * 1024 + 512 * c); hn[2 * c + 1] = *(const u32x4*)(H8 + (t0 + tk + 1) * 1024 + 512 * c + 16); } } } \
        const float s = __uint_as_float(q.ent.w) * hsc.x * (uq_dot(q, hp) - 7.5f * hsc.y); \
        if (li == 0) W[(t0 + tk) * 128 + (q.ent.z & 255u)] = __uint_as_float(q.ent.y) * 0.5f * s * (1.0f + erff(s * 0.70710678118654752f)); \
        uq_issue(q, list, (Jn), NQ, g, U4); } while (0)
#pragma unroll 1
    for (int J = 0; J < NQ; J += 4) { UQ_STEP(q0, J + 4); UQ_STEP(q1, J + 5); UQ_STEP(q2, J + 6); UQ_STEP(q3, J + 7); }
#undef UQ_STEP
}
struct VQuad { u32x4 r[2]; u32x2 ent; };
__device__ __forceinline__ void vq_issue(VQuad& q, const LAS u32x2* list, int J, int g, const unsigned char* V4) {
    const int jj = J < 32 ? J : 31;
    q.ent = list[4 * jj + g];
    const unsigned char* rp = V4 + (size_t)q.ent.x * 512;
    q.r[0] = *(const u32x4*)rp; q.r[1] = *(const u32x4*)(rp + 256);
}
__device__ __forceinline__ void acc8_i4(unsigned w, const f32x2 wv, f32x2& a0, f32x2& a1, f32x2& a2, f32x2& a3) {
    const unsigned lo = w & 0x0F0F0F0Fu, hi = (w >> 4) & 0x0F0F0F0Fu;
    a0 += wv * (f32x2){(float)(lo & 255u), (float)((lo >> 8) & 255u)}; a1 += wv * (f32x2){(float)((lo >> 16) & 255u), (float)(lo >> 24)};
    a2 += wv * (f32x2){(float)(hi & 255u), (float)((hi >> 8) & 255u)}; a3 += wv * (f32x2){(float)((hi >> 16) & 255u), (float)(hi >> 24)};
}
__device__ __forceinline__ void vq_acc(const VQuad& q, f32x2 (&acc)[32]) {
    const float w = __uint_as_float(q.ent.y); const f32x2 wv = {w, w};
#pragma unroll
    for (int c = 0; c < 2; ++c) {
        const u32x4 r = q.r[c];
        acc8_i4(r.x, wv, acc[16 * c + 0], acc[16 * c + 1], acc[16 * c + 2], acc[16 * c + 3]);
        acc8_i4(r.y, wv, acc[16 * c + 4], acc[16 * c + 5], acc[16 * c + 6], acc[16 * c + 7]);
        acc8_i4(r.z, wv, acc[16 * c + 8], acc[16 * c + 9], acc[16 * c + 10], acc[16 * c + 11]);
        acc8_i4(r.w, wv, acc[16 * c + 12], acc[16 * c + 13], acc[16 * c + 14], acc[16 * c + 15]);
    }
}
__device__ __forceinline__ void peer_v_tokens(const Params& P, LAS unsigned char* lds, const size_t t0) {
    const int tid = tid_opaque(), lane = tid & 63, wid = tid >> 6, g = lane >> 4, li = lane & 15, hi = lane >> 5, tc = g & 1;
    const unsigned char* V4 = P.ws + OFF_V8 + li * 16; const float* VSC = (const float*)(P.ws + OFF_VSC);
    const u32x4* EG4 = (const u32x4*)(P.ws + OFF_EG); const f32x2* W2 = (const f32x2*)(P.ws + OFF_W);
    LAS u32x2* lists = (LAS u32x2*)(lds + wid * 8192);
    float wsum[8];
#pragma unroll
    for (int i = 0; i < 8; ++i) { const u32x4 eg = EG4[(t0 + i) * 64 + lane]; const f32x2 ww = W2[(t0 + i) * 64 + lane];
        const float w0 = ww.x * VSC[eg.x], w1 = ww.y * VSC[eg.z];
        *(LAS u32x4*)(lists + i * 128 + 2 * lane) = (u32x4){eg.x, __float_as_uint(w0), eg.z, __float_as_uint(w1)};
        wsum[i] = wave_sum(w0 + w1); }
#pragma unroll
    for (int i = 0; i < 8; ++i) {
        const size_t t = t0 + i;
        const LAS u32x2* list = lists + i * 128;
        f32x2 acc[32];
#pragma unroll
        for (int j = 0; j < 32; ++j) acc[j] = (f32x2){0.f, 0.f};
        VQuad q0, q1, q2, q3;
        vq_issue(q0, list, 0, g, V4); vq_issue(q1, list, 1, g, V4); vq_issue(q2, list, 2, g, V4); vq_issue(q3, list, 3, g, V4);
#pragma unroll 1
        for (int J = 0; J < 32; J += 4) {
            vq_acc(q0, acc); vq_issue(q0, list, J + 4, g, V4);
            vq_acc(q1, acc); vq_issue(q1, list, J + 5, g, V4);
            vq_acc(q2, acc); vq_issue(q2, list, J + 6, g, V4);
            vq_acc(q3, acc); vq_issue(q3, list, J + 7, g, V4);
        }
        f32x2 k1[16];
#pragma unroll
        for (int j = 0; j < 16; ++j) { const f32x2 keep = hi ? acc[16 + j] : acc[j], send = hi ? acc[j] : acc[16 + j];
            k1[j] = keep + (f32x2){__shfl_xor(send.x, 32), __shfl_xor(send.y, 32)}; }
        float y[16];
#pragma unroll
        for (int j = 0; j < 8; ++j) { const f32x2 keep = tc ? k1[8 + j] : k1[j], send = tc ? k1[j] : k1[8 + j];
            y[2 * j] = keep.x + __shfl_xor(send.x, 16); y[2 * j + 1] = keep.y + __shfl_xor(send.y, 16); }
        const float yoff = 7.5f * wsum[i];
        const int d0 = 512 * (g >> 1) + 32 * li + 16 * (g & 1);
        const float* gt2 = (const float*)(P.ws + OFF_ADA) + (t >> 11) * 6144 + 5120 + d0;
        float* xr = P.out + t * 1024 + d0;
        float pre[16]; float s = 0.f;
#pragma unroll
        for (int q4 = 0; q4 < 4; ++q4) { const f32x4 xv = *(const f32x4*)(xr + 4 * q4), gv = *(const f32x4*)(gt2 + 4 * q4);
#pragma unroll
            for (int e = 0; e < 4; ++e) { const float pv = ALPHA * xv[e] + gv[e] * (y[4 * q4 + e] - yoff); pre[4 * q4 + e] = pv; s += pv; } }
        const float mean = wave_sum(s) * (1.0f / 1024.0f); float s2 = 0.f;
#pragma unroll
        for (int e = 0; e < 16; ++e) { pre[e] -= mean; s2 += pre[e] * pre[e]; }
        const float rstd = rsqrtf(wave_sum(s2) * (1.0f / 1024.0f) + LN_EPS);
#pragma unroll
        for (int q4 = 0; q4 < 4; ++q4) { const f32x4 gg = *(const f32x4*)(P.ln2_g + d0 + 4 * q4), bb = *(const f32x4*)(P.ln2_b + d0 + 4 * q4);
            f32x4 o;
#pragma unroll
            for (int e = 0; e < 4; ++e) o[e] = pre[4 * q4 + e] * rstd * gg[e] + bb[e];
            __builtin_nontemporal_store(o, (f32x4*)(xr + 4 * q4)); }
    }
}

#define XB_TMO      128
#define XB_XCNT(j)  (256  + 64 * (j))
#define XB_XSUB(j)  (1280 + 64 * (j))
#define XB_XGEN(j)  (2304 + 64 * (j))
#define XB_TOP      3328
#define XB_TOPGEN   3392
#define XCD_BAR_WORDS 3456
#define XB_SPIN_CAP (1u << 22)
__device__ __forceinline__ unsigned xb_ld(unsigned* p)              { return __hip_atomic_load(p, __ATOMIC_RELAXED, __HIP_MEMORY_SCOPE_AGENT); }
__device__ __forceinline__ unsigned xb_add(unsigned* p, unsigned v) { return __hip_atomic_fetch_add(p, v, __ATOMIC_RELAXED, __HIP_MEMORY_SCOPE_AGENT); }
#define XB_SPIN(cond, bar) do { unsigned _sp = 0; while (cond) { __builtin_amdgcn_s_sleep(1); \
    if ((++_sp & 255u) == 0u) { if (xb_ld(&(bar)[XB_TMO])) break; if (_sp > XB_SPIN_CAP) { atomicAdd(&(bar)[XB_TMO], 1u); break; } } } } while (0)
struct XcdBarrier { unsigned* bar; unsigned x; volatile LAS unsigned* st; };
__device__ __forceinline__ XcdBarrier xcd_barrier_post(unsigned* bar, volatile LAS unsigned* st) {
    XcdBarrier b; b.bar = bar; b.x = xcc_id(); b.st = st;
    if (threadIdx.x == 0) (void)xb_add(&bar[XB_XCNT(b.x)], 1u);
    return b;
}
__device__ __forceinline__ void xcd_barrier_complete(unsigned* bar, unsigned x, unsigned& nloc, unsigned& nx) {
    const unsigned G = gridDim.x * gridDim.y * gridDim.z;
    unsigned sum, cnt, mine, sp = 0u;
    for (;;) {
        sum = 0u; cnt = 0u; mine = 0u;
#pragma unroll
        for (unsigned j = 0; j < 16; ++j) { const unsigned c = xb_ld(&bar[XB_XCNT(j)]); sum += c; cnt += (c > 0u) ? 1u : 0u; mine = (j == x) ? c : mine; }
        if (sum == G) break;
        __builtin_amdgcn_s_sleep(1);
        if ((++sp & 255u) == 0u) { if (xb_ld(&bar[XB_TMO])) break; if (sp > XB_SPIN_CAP) { atomicAdd(&bar[XB_TMO], 1u); break; } }
    }
    nloc = mine > 0u ? mine : 1u; nx = cnt > 0u ? cnt : 1u;
}
__device__ __forceinline__ void xcd_barrier(const XcdBarrier& b) {
    asm volatile("s_waitcnt vmcnt(0)" ::: "memory");
    __syncthreads();
    if (threadIdx.x == 0) {
        unsigned* bar = b.bar;
        __builtin_amdgcn_s_waitcnt(0);
        unsigned nloc = b.st[0], nx = b.st[1];
        if (nloc == 0u) { xcd_barrier_complete(bar, b.x, nloc, nx); b.st[0] = nloc; b.st[1] = nx; }
        const unsigned old = xb_add(&bar[XB_XSUB(b.x)], 1u);
        const unsigned gen = old / nloc;
        if (old + 1u == (gen + 1u) * nloc) {
            __builtin_amdgcn_fence(__ATOMIC_RELEASE, "agent");
            asm volatile("s_waitcnt vmcnt(0)" ::: "memory");
            const unsigned og = xb_add(&bar[XB_TOP], 1u);
            const unsigned tg = og / nx;
            if (og + 1u == (tg + 1u) * nx) xb_add(&bar[XB_TOPGEN], 1u);
            else XB_SPIN(xb_ld(&bar[XB_TOPGEN]) == tg, bar);
            __builtin_amdgcn_fence(__ATOMIC_ACQUIRE, "agent");
            xb_add(&bar[XB_XGEN(b.x)], 1u);
            asm volatile("s_waitcnt vmcnt(0)" ::: "memory");
        } else {
            XB_SPIN(xb_ld(&bar[XB_XGEN(b.x)]) == gen, bar);
            __builtin_amdgcn_fence(__ATOMIC_ACQUIRE, "agent");
            asm volatile("s_waitcnt vmcnt(0)" ::: "memory");
        }
    }
    __syncthreads();
}

__global__ void __launch_bounds__(NTHR, 2) fwd_megakernel(Params P) {
    extern __shared__ __attribute__((aligned(16))) unsigned char shm[];
    LAS unsigned char* lds = (LAS unsigned char*)shm;
    cg::grid_group grid = cg::this_grid();
    const int G = gridDim.x, bid = blockIdx.x;
    volatile LAS unsigned* xst = (volatile LAS unsigned*)(lds + LDS_BYTES - 128);
    if (threadIdx.x == 0) { xst[0] = 0u; xst[1] = 0u; }
    __syncthreads();
    const XcdBarrier xb = xcd_barrier_post((unsigned*)(P.ws + OFF_BAR), xst);

#ifndef P3
#define P3 0xff
#endif
#ifndef PH
#define PH 0xff
#endif
    if (PH & 1) phase0a(P, lds);
    grid.sync();
    if (PH & 2) phase0b(P);
    xcd_barrier(xb);
    if (PH & 4) {
        pg8::Gemm g; g.A = (const bf16_t*)(P.ws + OFF_H); g.Bt = (const bf16_t*)(P.ws + OFF_WIN); g.M = NTOK; g.N = INCOLS; g.K = 1024;
        pg8::StaticOrder S; S.init(NTOK, INCOLS, G, bid);
        EpiProj E; E.ws = P.ws; E.lb = (const float*)(P.ws + OFF_LB); E.ng = P.hgrn_ng; E.kmean = (float*)(P.ws + OFF_KMEAN);
        pg8::gemm_phase<EpiProj, pg8::StaticOrder>(lds, g, S, E);
    }
    xcd_barrier(xb);
    if (PH & 8) for (int it = bid; it < 256; it += G) hgrn_item(P, it, lds);
    if (PH & 16) for (int u = bid; u < 2048; u += G) { const int bh = u & 255, jj = u >> 8; moba_unit(P, bh >> 3, bh & 7, (jj + bh) & 7, lds); }
    xcd_barrier(xb);
    if (PH & 32) for (int pm = bid; pm < NTOK / 256; pm += G) {
        if (P3 & 1) yb_norm_panel(P, pm);
        __syncthreads();
        if (P3 & 2) { pg8::Gemm g; g.A = (const bf16_t*)(P.ws + OFF_QA); g.Bt = (const bf16_t*)(P.ws + OFF_WBA); g.M = NTOK; g.N = 1024; g.K = 512;
          pg8::PanelOrder S; S.pm = pm; S.npn = 4; EpiMixA E; E.GA = (bf16_t*)(P.ws + OFF_GA);
          pg8::gemm_phase<EpiMixA, pg8::PanelOrder>(lds, g, S, E); }
        __syncthreads();
        if (P3 & 4) { pg8::Gemm g; g.A = (const bf16_t*)(P.ws + OFF_HI); g.Bt = (const bf16_t*)(P.ws + OFF_WBB); g.M = NTOK; g.N = 1024; g.K = 512;
          pg8::PanelOrder S; S.pm = pm; S.npn = 4; EpiMixB E; E.GA = (bf16_t*)(P.ws + OFF_GA); E.GB = (const bf16_t*)(P.ws + OFF_GB);
          pg8::gemm_phase<EpiMixB, pg8::PanelOrder>(lds, g, S, E); }
        __syncthreads();
        if (P3 & 8) { pg8::Gemm g; g.A = (const bf16_t*)(P.ws + OFF_GA); g.Bt = (const bf16_t*)(P.ws + OFF_WOUT); g.M = NTOK; g.N = 1024; g.K = 1024;
          pg8::PanelOrder S; S.pm = pm; S.npn = 4; EpiOut E; E.ada = (const float*)(P.ws + OFF_ADA); E.D = (bf16_t*)(P.ws + OFF_GB);
          pg8::gemm_phase<EpiOut, pg8::PanelOrder>(lds, g, S, E); }
        __syncthreads();
        if (P3 & 16) ln1_panel(P, pm);
        __syncthreads();
        if (P3 & 32) { pg8::Gemm g; g.A = (const bf16_t*)(P.ws + OFF_H); g.Bt = (const bf16_t*)(P.ws + OFF_WQ); g.M = NTOK; g.N = 1024; g.K = 1024;
          pg8::PanelOrder S; S.pm = pm; S.npn = 4; EpiBf16 E; E.O = (bf16_t*)(P.ws + OFF_GB);
          pg8::gemm_phase<EpiBf16, pg8::PanelOrder>(lds, g, S, E); }
        __syncthreads();
        { const size_t tok0 = (size_t)pm * 256 + (tid_opaque() >> 6) * 32;
          peer_select_wave(P, tok0);
          __syncthreads();
#pragma unroll 1
          for (int sb = 0; sb < 4; ++sb) {
              peer_u_tokens(P, lds, tok0 + 8 * sb);
              __syncthreads();
              peer_v_tokens(P, lds, tok0 + 8 * sb);
              __syncthreads();
          } }
    }
}

extern "C" void kernel_launch(void* const* d_in, const int* in_sizes, int n_in, void* d_out, int out_size, void* d_ws, size_t ws_size, hipStream_t stream) {
    static int grid_blocks = 0;
    if (grid_blocks == 0) {
        if (n_in != 18 || out_size != NTOK * DM || ws_size < WS_END) { fprintf(stderr, "kernel_launch: unexpected shapes (n_in %d, out %d, ws %zu, need %zu)\n", n_in, out_size, ws_size, (size_t)WS_END); grid_blocks = -1; return; }
        int dev = 0, cus = 0, per_cu = 0;
        hipGetDevice(&dev);
        hipDeviceGetAttribute(&cus, hipDeviceAttributeMultiprocessorCount, dev);
        if (hipFuncSetAttribute((const void*)fwd_megakernel, hipFuncAttributeMaxDynamicSharedMemorySize, LDS_BYTES) != hipSuccess) fprintf(stderr, "kernel_launch: hipFuncSetAttribute failed\n");
        hipOccupancyMaxActiveBlocksPerMultiprocessor(&per_cu, (const void*)fwd_megakernel, NTHR, LDS_BYTES);
        if (per_cu < 1) { fprintf(stderr, "kernel_launch: occupancy query says %d blocks per CU\n", per_cu); per_cu = 1; }
        if (per_cu > 1) per_cu = 1;
        grid_blocks = cus * per_cu;
        (void)hipGetLastError();
    }
    if (grid_blocks < 0) return;
    Params p{};
    p.x = (const float*)d_in[0]; p.c = (const float*)d_in[1]; p.w_ada = (const float*)d_in[2]; p.b_ada = (const float*)d_in[3]; p.w_in = (const float*)d_in[4];
    p.w_ba = (const float*)d_in[5]; p.w_bb = (const float*)d_in[6]; p.w_out = (const float*)d_in[7]; p.hgrn_lb = (const float*)d_in[8]; p.hgrn_ng = (const float*)d_in[9];
    p.ln1_g = (const float*)d_in[10]; p.ln1_b = (const float*)d_in[11]; p.peer_wq = (const float*)d_in[12]; p.peer_sk = (const float*)d_in[13]; p.peer_u = (const float*)d_in[14];
    p.peer_v = (const float*)d_in[15]; p.ln2_g = (const float*)d_in[16]; p.ln2_b = (const float*)d_in[17];
    p.out = (float*)d_out; p.ws = (unsigned char*)d_ws;
    if (hipMemsetAsync((char*)d_ws + OFF_BAR, 0, XCD_BAR_WORDS * 4, stream) != hipSuccess) fprintf(stderr, "kernel_launch: memset of the barrier words failed\n");
    void* args[] = {&p};
    hipError_t e = hipLaunchCooperativeKernel((const void*)fwd_megakernel, dim3(grid_blocks), dim3(NTHR), args, LDS_BYTES, stream);
    if (e != hipSuccess) fprintf(stderr, "cooperative launch failed: %s (grid %d)\n", hipGetErrorString(e), grid_blocks);
}
```

```cpp
#include <hip/hip_runtime.h>
#include <hip/hip_cooperative_groups.h>
#include <cstdio>
#include <cstdint>
namespace cg = cooperative_groups;

#define LAS __attribute__((address_space(3)))
typedef unsigned short bf16_t;
typedef short bf16x8 __attribute__((ext_vector_type(8)));
typedef short s16x4 __attribute__((ext_vector_type(4)));
typedef float f32x2 __attribute__((ext_vector_type(2)));
typedef float f32x4 __attribute__((ext_vector_type(4)));
typedef float f32x16 __attribute__((ext_vector_type(16)));
typedef unsigned u32x2 __attribute__((ext_vector_type(2)));
typedef unsigned u32x4 __attribute__((ext_vector_type(4)));

constexpr int NB = 32, SEQ = 2048, DM = 1024, NTOK = NB * SEQ;
constexpr int INCOLS = 5632;
constexpr int NTHR = 512;
constexpr int LDS_BYTES = 147456;
constexpr float ALPHA = 1.189207115002721f;
constexpr float LN_EPS = 1e-5f, RMS_EPS = 1e-6f;
constexpr float LOG2E = 1.4426950408889634f;

constexpr size_t SZ_T512 = (size_t)NTOK * 512 * 2, SZ_T1024 = (size_t)NTOK * 1024 * 2;
constexpr size_t OFF_ADA = 0;
constexpr size_t OFF_LB = OFF_ADA + 786432;
constexpr size_t OFF_KMEAN = OFF_LB + 4096;
constexpr size_t OFF_WIN = OFF_KMEAN + 524288;
constexpr size_t OFF_WBA = OFF_WIN + (size_t)5632 * 1024 * 2;
constexpr size_t OFF_WBB = OFF_WBA + 1048576;
constexpr size_t OFF_WOUT = OFF_WBB + 1048576;
constexpr size_t OFF_WQ = OFF_WOUT + 2097152;
constexpr size_t OFF_SK = OFF_WQ + 2097152;
constexpr size_t OFF_U8 = OFF_SK + 262144;
constexpr size_t OFF_USC = OFF_U8 + 8388608;
constexpr size_t OFF_V8 = OFF_U8 + 16777216;
constexpr size_t OFF_VSC = OFF_V8 + 8388608;
constexpr size_t OFF_CTR = OFF_V8 + 16777216;
constexpr size_t OFF_BAR = OFF_CTR + 4096;
constexpr size_t OFF_EG = OFF_BAR + 16384;
constexpr size_t OFF_H = OFF_EG + (size_t)NTOK * 128 * 8;
constexpr size_t OFF_QA = OFF_H + SZ_T1024;
constexpr size_t OFF_KA = OFF_QA + SZ_T512;
constexpr size_t OFF_VA = OFF_KA + SZ_T512;
constexpr size_t OFF_HQ = OFF_VA + SZ_T512;
constexpr size_t OFF_HK = OFF_HQ + SZ_T512;
constexpr size_t OFF_HI = OFF_HK + SZ_T512;
constexpr size_t OFF_HG = OFF_HI + SZ_T512;
constexpr size_t OFF_GA = OFF_HG + SZ_T512;
constexpr size_t OFF_GB = OFF_GA + SZ_T1024;
constexpr size_t WS_END = OFF_GB + SZ_T1024;
constexpr size_t OFF_H8 = OFF_VA;
constexpr size_t OFF_HS = OFF_HQ;
constexpr size_t OFF_W = OFF_KA;
constexpr size_t OFF_Y = OFF_KA;

struct Params {
    const float *x, *c, *w_ada, *b_ada, *w_in, *w_ba, *w_bb, *w_out, *hgrn_lb, *hgrn_ng, *ln1_g, *ln1_b, *peer_wq, *peer_sk, *peer_u, *peer_v, *ln2_g, *ln2_b;
    float* out;
    unsigned char* ws;
};

typedef __bf16 bf16v2 __attribute__((ext_vector_type(2)));
__device__ __forceinline__ unsigned cvt_pk_bf16(float lo, float hi) { return __builtin_bit_cast(unsigned, __builtin_convertvector((f32x2){lo, hi}, bf16v2)); }
__device__ __forceinline__ float bf_lo(unsigned w) { return __uint_as_float(w << 16); }
__device__ __forceinline__ float bf_hi(unsigned w) { return __uint_as_float(w & 0xffff0000u); }
__device__ __forceinline__ float sigmoidf_(float x) { return 1.0f / (1.0f + __expf(-x)); }
__device__ __forceinline__ float wave_sum(float v) {
#pragma unroll
    for (int o = 1; o < 64; o <<= 1) v += __shfl_xor(v, o);
    return v;
}
__device__ __forceinline__ int tid_opaque() { int t = threadIdx.x; asm volatile("" : "+v"(t)); return t; }
__device__ __forceinline__ int crow(int r, int hi) { return (r & 3) + 8 * (r >> 2) + 4 * hi; }
#define MFMA32(a, b, c) __builtin_amdgcn_mfma_f32_32x32x16_bf16(a, b, c, 0, 0, 0)

namespace pg8 {
constexpr int BM = 256, BK = 64, HALF = 128, HTB = HALF * BK * 2, STAGE_BYTES = 8 * HTB, NXCD = 8, WGM = 8;
__host__ __device__ __forceinline__ int lds_byte(int r, int c) { const int st = (r >> 4) * 2 + (c >> 5), rr = r & 15, cc = c & 31, ob = rr * 64 + cc * 2; return st * 1024 + (ob ^ (((ob >> 9) & 1) << 5)); }
__host__ __device__ __forceinline__ void stage_rc(int b, int& R, int& C) { const int st = b / 1024, sb = b % 1024, swz = sb ^ (((sb >> 9) & 1) << 5); R = (st >> 1) * 16 + swz / 64; C = (st & 1) * 32 + (swz % 64) / 2; }
__host__ __device__ __forceinline__ int perm32(int rho) { const int n = rho >> 4, i = rho & 15; return 8 * (i >> 2) + 4 * n + (i & 3); }

struct Unit { int pm, pn; };
struct Gemm { const bf16_t* A; const bf16_t* Bt; int M, N, K; };

struct StaticOrder {
    int nM, nN, nwg, G, c;
    __device__ void init(int M, int N, int G_, int c_) { nM = M / BM; nN = N / BM; nwg = nM * nN; G = G_; c = c_; }
    __device__ bool next(int i, Unit& u) const {
        const long L = (long)i * G + c; if (L >= nwg) return false;
        int wgid = (int)L; { const int q = nwg / NXCD, r = nwg % NXCD, xcd = wgid % NXCD, off = wgid / NXCD; wgid = (xcd < r ? xcd * (q + 1) : r * (q + 1) + (xcd - r) * q) + off; }
        const int nig = WGM * nN, gid = wgid / nig, fm = gid * WGM, gsz = (nM - fm) < WGM ? (nM - fm) : WGM;
        u.pm = fm + ((wgid % nig) % gsz); u.pn = (wgid % nig) / gsz; return true;
    }
};
struct PanelOrder {
    int pm, npn;
    __device__ bool next(int i, Unit& u) const { if (i >= npn) return false; u.pm = pm; u.pn = i; return true; }
};

template <class Epi, class Sched>
__device__ __forceinline__ void gemm_phase(LAS unsigned char* lds, const Gemm g, const Sched& S, const Epi& E) {
    const int tid = tid_opaque(), wid = __builtin_amdgcn_readfirstlane(tid >> 6), lane = tid & 63, wr = wid >> 2, wc = wid & 3, fr = lane & 15, fq = lane >> 4;
    const int K = g.K, nt = K / BK;
    unsigned voffA[2], voffB[2];
#pragma unroll
    for (int i = 0; i < 2; ++i) { int R, C; stage_rc(tid * 16 + i * 8192, R, C); const int Rb = Epi::PERM ? ((R & ~31) + perm32(R & 31)) : R;
        voffA[i] = (unsigned)(R * K + C) * 2u; voffB[i] = (unsigned)(Rb * K + C) * 2u; }
    const size_t kstep = (size_t)(BK * 2);
    const size_t hstep = (size_t)HALF * K * 2;
    const size_t tstep = 2 * hstep;
    const unsigned ldsw = (unsigned)wid * 1024u;
    const int aoff = lds_byte(wr * 64 + fr, fq * 8), boff = lds_byte(wc * 32 + fr, fq * 8);
#define PG8_SA(b, h) (((b) * 2 + (h)) * HTB)
#define PG8_SB(b, h) ((4 + (b) * 2 + (h)) * HTB)
#define PG8_STAGE(bufoff, gbase, voff) do { _Pragma("unroll") for (int _i = 0; _i < 2; ++_i) \
        __builtin_amdgcn_global_load_lds((const unsigned*)((const char*)(gbase) + (voff)[_i]), (LAS unsigned*)(lds + (bufoff) + ldsw + _i * 8192), 16, 0, 0); } while (0)
#define PG8_LDA(dst, b, h) do { _Pragma("unroll") for (int m = 0; m < 4; ++m) _Pragma("unroll") for (int k = 0; k < 2; ++k) dst[m][k] = *(const LAS bf16x8*)(lds + PG8_SA(b, h) + aoff + m * 2048 + k * 1024); } while (0)
#define PG8_LDB(dst, b, h) do { _Pragma("unroll") for (int n = 0; n < 2; ++n) _Pragma("unroll") for (int k = 0; k < 2; ++k) dst[n][k] = *(const LAS bf16x8*)(lds + PG8_SB(b, h) + boff + n * 2048 + k * 1024); } while (0)
#define PG8_MMA(ai, bj, At, Bt) do { __builtin_amdgcn_s_setprio(1); _Pragma("unroll") for (int m = 0; m < 4; ++m) _Pragma("unroll") for (int n = 0; n < 2; ++n) _Pragma("unroll") for (int k = 0; k < 2; ++k) \
        acc[ai][bj][m][n] = __builtin_amdgcn_mfma_f32_16x16x32_bf16(Bt[n][k], At[m][k], acc[ai][bj][m][n], 0, 0, 0); __builtin_amdgcn_s_setprio(0); } while (0)
#define PG8_WAIT_V(n) asm volatile("s_waitcnt vmcnt(" #n ")" ::: "memory")
#define PG8_WAIT_L(n) asm volatile("s_waitcnt lgkmcnt(" #n ")" ::: "memory")
#define PG8_BAR __builtin_amdgcn_s_barrier()
#define PG8_SCHED __builtin_amdgcn_sched_barrier(0)
    Unit cur, nxt; int ui = 0;
    if (!S.next(0, cur)) return;
    f32x4 acc[2][2][4][2];
#pragma unroll
    for (int a = 0; a < 2; ++a)
#pragma unroll
        for (int b = 0; b < 2; ++b)
#pragma unroll
            for (int m = 0; m < 4; ++m)
#pragma unroll
                for (int n = 0; n < 2; ++n) acc[a][b][m][n] = (f32x4){0.f, 0.f, 0.f, 0.f};
    bf16x8 At[4][2], B0[2][2], B1[2][2];
    const char* cA = (const char*)g.A + (size_t)cur.pm * tstep; const char* cB = (const char*)g.Bt + (size_t)cur.pn * tstep;
    PG8_STAGE(PG8_SB(0, 0), cB, voffB); PG8_STAGE(PG8_SA(0, 0), cA, voffA); PG8_STAGE(PG8_SB(0, 1), cB + hstep, voffB); PG8_STAGE(PG8_SA(0, 1), cA + hstep, voffA);
    if (wr == 1) PG8_BAR;
    PG8_WAIT_V(4); PG8_BAR;
    PG8_STAGE(PG8_SB(1, 0), cB + kstep, voffB); PG8_STAGE(PG8_SA(1, 0), cA + kstep, voffA); PG8_STAGE(PG8_SB(1, 1), cB + hstep + kstep, voffB);
    PG8_WAIT_V(6); PG8_BAR;
    for (;;) {
        const bool has_next = S.next(ui + 1, nxt);
        const char* nA = has_next ? (const char*)g.A + (size_t)nxt.pm * tstep : cA; const char* nB = has_next ? (const char*)g.Bt + (size_t)nxt.pn * tstep : cB;
        for (int t = 0; t < nt; t += 2) {
            const bool last = (t == nt - 2);
            const char* a1 = cA + (size_t)(t + 1) * kstep;
            const char* a2 = last ? nA : cA + (size_t)(t + 2) * kstep; const char* b2 = last ? nB : cB + (size_t)(t + 2) * kstep;
            const char* a3 = a2 + kstep; const char* b3 = b2 + kstep;
            PG8_LDB(B0, 0, 0); PG8_SCHED; PG8_LDA(At, 0, 0); PG8_STAGE(PG8_SA(1, 1), a1 + hstep, voffA);
            PG8_WAIT_L(8); PG8_BAR; PG8_WAIT_L(0); PG8_MMA(0, 0, At, B0); PG8_BAR; PG8_SCHED;
            PG8_LDB(B1, 0, 1); PG8_STAGE(PG8_SB(0, 0), b2, voffB);
            PG8_BAR; PG8_WAIT_L(0); PG8_MMA(0, 1, At, B1); PG8_BAR;
            PG8_LDA(At, 0, 1); PG8_STAGE(PG8_SA(0, 0), a2, voffA);
            PG8_BAR; PG8_WAIT_L(0); PG8_MMA(1, 0, At, B0); PG8_BAR; PG8_SCHED;
            PG8_STAGE(PG8_SB(0, 1), b2 + hstep, voffB);
            PG8_WAIT_V(6); PG8_BAR; PG8_MMA(1, 1, At, B1); PG8_BAR;
            PG8_LDB(B0, 1, 0); PG8_SCHED; PG8_LDA(At, 1, 0); PG8_STAGE(PG8_SA(0, 1), a2 + hstep, voffA);
            PG8_WAIT_L(8); PG8_BAR; PG8_WAIT_L(0); PG8_MMA(0, 0, At, B0); PG8_BAR; PG8_SCHED;
            PG8_LDB(B1, 1, 1); PG8_STAGE(PG8_SB(1, 0), b3, voffB);
            PG8_BAR; PG8_WAIT_L(0); PG8_MMA(0, 1, At, B1); PG8_BAR;
            PG8_LDA(At, 1, 1); PG8_STAGE(PG8_SA(1, 0), a3, voffA);
            PG8_BAR; PG8_WAIT_L(0); PG8_MMA(1, 0, At, B0); PG8_BAR; PG8_SCHED;
            PG8_STAGE(PG8_SB(1, 1), b3 + hstep, voffB);
            PG8_WAIT_V(6); PG8_BAR; PG8_MMA(1, 1, At, B1); PG8_BAR;
        }
        E(acc, cur, wr, wc, fr, fq);
        if (!has_next) break;
#pragma unroll
        for (int a = 0; a < 2; ++a)
#pragma unroll
            for (int b = 0; b < 2; ++b)
#pragma unroll
                for (int m = 0; m < 4; ++m)
#pragma unroll
                    for (int n = 0; n < 2; ++n) acc[a][b][m][n] = (f32x4){0.f, 0.f, 0.f, 0.f};
        cur = nxt; cA = nA; cB = nB; ++ui;
    }
    PG8_WAIT_V(0);
    if (wr == 0) PG8_BAR;
    PG8_BAR;
#undef PG8_SA
#undef PG8_SB
#undef PG8_STAGE
#undef PG8_LDA
#undef PG8_LDB
#undef PG8_MMA
#undef PG8_WAIT_V
#undef PG8_WAIT_L
#undef PG8_BAR
#undef PG8_SCHED
}
}
using pg8::Unit;

struct EpiProj {
    static constexpr bool PERM = true;
    unsigned char* ws; const float* lb; const float* ng; float* kmean;
    __device__ __forceinline__ void operator()(const f32x4 (&acc)[2][2][4][2], const Unit& u, int wr, int wc, int fr, int fq) const {
        const int pn = u.pn; int seg, colt, ldc; size_t boff;
        if (pn < 14) { seg = pn >> 1; colt = (pn & 1) * 256; ldc = 512; boff = OFF_QA + (size_t)seg * SZ_T512; }
        else if (pn < 18) { seg = 7; colt = (pn - 14) * 256; ldc = 1024; boff = OFF_GA; }
        else { seg = 8; colt = (pn - 18) * 256; ldc = 1024; boff = OFF_GB; }
        bf16_t* base = (bf16_t*)(ws + boff);
        const int row0 = u.pm * 256 + wr * 64 + fr, col0 = colt + wc * 32 + 8 * fq;
        float pv[2][8];
#pragma unroll
        for (int bj = 0; bj < 2; ++bj)
#pragma unroll
            for (int e = 0; e < 8; ++e) pv[bj][e] = (seg == 4) ? (1.0f - lb[col0 + bj * 128 + e]) : ((seg == 6) ? ng[col0 + bj * 128 + e] : 0.f);
        float cs[2][8];
#pragma unroll
        for (int bj = 0; bj < 2; ++bj)
#pragma unroll
            for (int e = 0; e < 8; ++e) cs[bj][e] = 0.f;
#pragma unroll
        for (int ai = 0; ai < 2; ++ai)
#pragma unroll
            for (int m = 0; m < 4; ++m) {
                bf16_t* rowp = base + (size_t)(row0 + ai * 128 + m * 16) * ldc + col0;
#pragma unroll
                for (int bj = 0; bj < 2; ++bj) {
                    float v[8];
#pragma unroll
                    for (int e = 0; e < 4; ++e) { v[e] = acc[ai][bj][m][0][e]; v[4 + e] = acc[ai][bj][m][1][e]; }
                    if (seg == 0) {
#pragma unroll
                        for (int e = 0; e < 8; ++e) v[e] *= (0.125f * LOG2E);
                    } else if (seg == 1) {
#pragma unroll
                        for (int e = 0; e < 8; ++e) cs[bj][e] += v[e];
                    } else if (seg == 3) {
#pragma unroll
                        for (int e = 0; e < 8; ++e) v[e] = v[e] * sigmoidf_(v[e]);
                    } else if (seg == 4) {
#pragma unroll
                        for (int e = 0; e < 8; ++e) v[e] = pv[bj][e] * sigmoidf_(-v[e]);
                    } else if (seg == 6) {
#pragma unroll
                        for (int e = 0; e < 8; ++e) v[e] = pv[bj][e] * v[e] * sigmoidf_(v[e]);
                    } else if (seg >= 7) {
#pragma unroll
                        for (int e = 0; e < 8; ++e) v[e] = sigmoidf_(v[e]);
                    }
                    u32x4 w; w.x = cvt_pk_bf16(v[0], v[1]); w.y = cvt_pk_bf16(v[2], v[3]); w.z = cvt_pk_bf16(v[4], v[5]); w.w = cvt_pk_bf16(v[6], v[7]);
                    *(u32x4*)(rowp + bj * 128) = w;
                }
            }
        if (seg == 1) {
#pragma unroll
            for (int bj = 0; bj < 2; ++bj)
#pragma unroll
                for (int e = 0; e < 8; ++e) {
                    float s = cs[bj][e];
                    s += __shfl_xor(s, 1); s += __shfl_xor(s, 2); s += __shfl_xor(s, 4); s += __shfl_xor(s, 8);
                    if (fr == 0) atomicAdd(kmean + (size_t)u.pm * 512 + col0 + bj * 128 + e, s);
                }
        }
    }
};
struct EpiMixA {
    static constexpr bool PERM = true;
    bf16_t* GA;
    __device__ __forceinline__ void operator()(const f32x4 (&acc)[2][2][4][2], const Unit& u, int wr, int wc, int fr, int fq) const {
        const int row0 = u.pm * 256 + wr * 64 + fr, col0 = u.pn * 256 + wc * 32 + 8 * fq;
#pragma unroll
        for (int ai = 0; ai < 2; ++ai)
#pragma unroll
            for (int m = 0; m < 4; ++m) {
                bf16_t* rowp = GA + (size_t)(row0 + ai * 128 + m * 16) * 1024 + col0;
#pragma unroll
                for (int bj = 0; bj < 2; ++bj) {
                    const u32x4 g = *(const u32x4*)(rowp + bj * 128);
                    const f32x4 a0 = acc[ai][bj][m][0], a1 = acc[ai][bj][m][1];
                    u32x4 w;
                    w.x = cvt_pk_bf16(bf_lo(g.x) * a0[0], bf_hi(g.x) * a0[1]); w.y = cvt_pk_bf16(bf_lo(g.y) * a0[2], bf_hi(g.y) * a0[3]);
                    w.z = cvt_pk_bf16(bf_lo(g.z) * a1[0], bf_hi(g.z) * a1[1]); w.w = cvt_pk_bf16(bf_lo(g.w) * a1[2], bf_hi(g.w) * a1[3]);
                    *(u32x4*)(rowp + bj * 128) = w;
                }
            }
    }
};
struct EpiMixB {
    static constexpr bool PERM = true;
    bf16_t* GA; const bf16_t* GB;
    __device__ __forceinline__ void operator()(const f32x4 (&acc)[2][2][4][2], const Unit& u, int wr, int wc, int fr, int fq) const {
        const int row0 = u.pm * 256 + wr * 64 + fr, col0 = u.pn * 256 + wc * 32 + 8 * fq;
#pragma unroll
        for (int ai = 0; ai < 2; ++ai)
#pragma unroll
            for (int m = 0; m < 4; ++m) {
                const size_t off = (size_t)(row0 + ai * 128 + m * 16) * 1024 + col0;
#pragma unroll
                for (int bj = 0; bj < 2; ++bj) {
                    const u32x4 g = *(const u32x4*)(GB + off + bj * 128);
                    const u32x4 mx = *(const u32x4*)(GA + off + bj * 128);
                    const f32x4 a0 = acc[ai][bj][m][0], a1 = acc[ai][bj][m][1];
                    u32x4 w;
                    w.x = cvt_pk_bf16(bf_lo(mx.x) + bf_lo(g.x) * a0[0], bf_hi(mx.x) + bf_hi(g.x) * a0[1]); w.y = cvt_pk_bf16(bf_lo(mx.y) + bf_lo(g.y) * a0[2], bf_hi(mx.y) + bf_hi(g.y) * a0[3]);
                    w.z = cvt_pk_bf16(bf_lo(mx.z) + bf_lo(g.z) * a1[0], bf_hi(mx.z) + bf_hi(g.z) * a1[1]); w.w = cvt_pk_bf16(bf_lo(mx.w) + bf_lo(g.w) * a1[2], bf_hi(mx.w) + bf_hi(g.w) * a1[3]);
                    *(u32x4*)(GA + off + bj * 128) = w;
                }
            }
    }
};
struct EpiOut {
    static constexpr bool PERM = true;
    const float* ada; bf16_t* D;
    __device__ __forceinline__ void operator()(const f32x4 (&acc)[2][2][4][2], const Unit& u, int wr, int wc, int fr, int fq) const {
        const int row0 = u.pm * 256 + wr * 64 + fr, col0 = u.pn * 256 + wc * 32 + 8 * fq;
        const float* gt1 = ada + (size_t)(u.pm >> 3) * 6144 + 2048 + col0;
        f32x4 g[2][2];
#pragma unroll
        for (int bj = 0; bj < 2; ++bj) { g[bj][0] = *(const f32x4*)(gt1 + bj * 128); g[bj][1] = *(const f32x4*)(gt1 + bj * 128 + 4); }
#pragma unroll
        for (int ai = 0; ai < 2; ++ai)
#pragma unroll
            for (int m = 0; m < 4; ++m) {
                bf16_t* rowp = D + (size_t)(row0 + ai * 128 + m * 16) * 1024 + col0;
#pragma unroll
                for (int bj = 0; bj < 2; ++bj) {
                    const f32x4 a0 = acc[ai][bj][m][0] * g[bj][0], a1 = acc[ai][bj][m][1] * g[bj][1];
                    u32x4 w; w.x = cvt_pk_bf16(a0[0], a0[1]); w.y = cvt_pk_bf16(a0[2], a0[3]); w.z = cvt_pk_bf16(a1[0], a1[1]); w.w = cvt_pk_bf16(a1[2], a1[3]);
                    *(u32x4*)(rowp + bj * 128) = w;
                }
            }
    }
};
struct EpiBf16 {
    static constexpr bool PERM = true;
    bf16_t* O;
    __device__ __forceinline__ void operator()(const f32x4 (&acc)[2][2][4][2], const Unit& u, int wr, int wc, int fr, int fq) const {
        const int row0 = u.pm * 256 + wr * 64 + fr, col0 = u.pn * 256 + wc * 32 + 8 * fq;
#pragma unroll
        for (int ai = 0; ai < 2; ++ai)
#pragma unroll
            for (int m = 0; m < 4; ++m) {
                bf16_t* rowp = O + (size_t)(row0 + ai * 128 + m * 16) * 1024 + col0;
#pragma unroll
                for (int bj = 0; bj < 2; ++bj) {
                    const f32x4 a0 = acc[ai][bj][m][0], a1 = acc[ai][bj][m][1];
                    u32x4 w; w.x = cvt_pk_bf16(a0[0], a0[1]); w.y = cvt_pk_bf16(a0[2], a0[3]); w.z = cvt_pk_bf16(a1[0], a1[1]); w.w = cvt_pk_bf16(a1[2], a1[3]);
                    *(u32x4*)(rowp + bj * 128) = w;
                }
            }
    }
};

__device__ void phase0a(const Params& P, LAS unsigned char* lds) {
    const int tid = tid_opaque(), G = gridDim.x, bid = blockIdx.x;
    for (int it = bid; it < 192; it += G) {
        LAS float* sc = (LAS float*)lds;
        for (int i = tid; i < 32 * 1024; i += NTHR) { const float cv = P.c[i]; sc[i] = cv * sigmoidf_(cv); }
        __syncthreads();
        const int kg = tid >> 5, col = tid & 31;
        float a[32];
#pragma unroll
        for (int b = 0; b < 32; ++b) a[b] = 0.f;
#pragma unroll 1
        for (int k = kg * 64; k < kg * 64 + 64; k += 8) {
            float w[8];
#pragma unroll
            for (int e = 0; e < 8; ++e) w[e] = __builtin_nontemporal_load(P.w_ada + (size_t)(k + e) * 6144 + it * 32 + col);
#pragma unroll
            for (int e4 = 0; e4 < 2; ++e4) {
#pragma unroll
                for (int b = 0; b < 32; ++b) { const f32x4 s = *(const LAS f32x4*)(sc + b * 1024 + k + 4 * e4); a[b] += s[0] * w[4 * e4] + s[1] * w[4 * e4 + 1] + s[2] * w[4 * e4 + 2] + s[3] * w[4 * e4 + 3]; }
                asm volatile("" ::: "memory");
            }
        }
        __syncthreads();
        LAS float* red = (LAS float*)lds;
#pragma unroll
        for (int b = 0; b < 32; ++b) red[(kg * 32 + b) * 32 + col] = a[b];
        __syncthreads();
        for (int o = tid; o < 1024; o += NTHR) { const int b = o >> 5, cc = o & 31; float s = 0.f;
#pragma unroll
            for (int g2 = 0; g2 < 16; ++g2) s += red[(g2 * 32 + b) * 32 + cc];
            ((float*)(P.ws + OFF_ADA))[(size_t)b * 6144 + it * 32 + cc] = s + P.b_ada[it * 32 + cc]; }
        __syncthreads();
    }
    const size_t gsz = (size_t)G * NTHR;
    { const int gt = bid * NTHR + tid, gs = G * NTHR;
      if (gt < 512) ((float*)(P.ws + OFF_LB))[gt] = sigmoidf_(P.hgrn_lb[gt] - P.hgrn_lb[512 + gt]);
      for (int i = gt; i < 32 * 8 * 512; i += gs) ((float*)(P.ws + OFF_KMEAN))[i] = 0.f; }
    {
        LAS float* tile = (LAS float*)lds;
        const int I0 = 16 * 88, I1 = I0 + 8 * 16, I2 = I1 + 8 * 16, I3 = I2 + 16 * 16, I4 = I3 + 16 * 16;
        for (int it = bid; it < I4; it += G) {
            const float* W; bf16_t* WT; int K, N, r;
            if (it < I0) { W = P.w_in; WT = (bf16_t*)(P.ws + OFF_WIN); K = 1024; N = 5632; r = it; }
            else if (it < I1) { W = P.w_ba; WT = (bf16_t*)(P.ws + OFF_WBA); K = 512; N = 1024; r = it - I0; }
            else if (it < I2) { W = P.w_bb; WT = (bf16_t*)(P.ws + OFF_WBB); K = 512; N = 1024; r = it - I1; }
            else if (it < I3) { W = P.w_out; WT = (bf16_t*)(P.ws + OFF_WOUT); K = 1024; N = 1024; r = it - I2; }
            else { W = P.peer_wq; WT = (bf16_t*)(P.ws + OFF_WQ); K = 1024; N = 1024; r = it - I3; }
            const int nb = N / 64, k0 = (r / nb) * 64, n0 = (r % nb) * 64;
#pragma unroll
            for (int ps = 0; ps < 2; ++ps) { const int kk = (tid >> 4) + 32 * ps, n4 = (tid & 15) * 4;
                const f32x4 v = *(const f32x4*)(W + (size_t)(k0 + kk) * N + n0 + n4);
                tile[kk * 65 + n4] = v[0]; tile[kk * 65 + n4 + 1] = v[1]; tile[kk * 65 + n4 + 2] = v[2]; tile[kk * 65 + n4 + 3] = v[3]; }
            __syncthreads();
            { const int n = tid >> 3, kc = (tid & 7) * 8; u32x4 w;
              w.x = cvt_pk_bf16(tile[(kc + 0) * 65 + n], tile[(kc + 1) * 65 + n]); w.y = cvt_pk_bf16(tile[(kc + 2) * 65 + n], tile[(kc + 3) * 65 + n]);
              w.z = cvt_pk_bf16(tile[(kc + 4) * 65 + n], tile[(kc + 5) * 65 + n]); w.w = cvt_pk_bf16(tile[(kc + 6) * 65 + n], tile[(kc + 7) * 65 + n]);
              *(u32x4*)(WT + (size_t)(n0 + n) * K + k0 + kc) = w; }
            __syncthreads();
        }
    }
    {
        const size_t gtid = (size_t)bid * NTHR + tid_opaque();
        for (size_t i = gtid; i < 16384; i += gsz) {
            const float* src = P.peer_sk + i * 8; const f32x4 a = *(const f32x4*)src, b = *(const f32x4*)(src + 4);
            u32x4 w; w.x = cvt_pk_bf16(a[0], a[1]); w.y = cvt_pk_bf16(a[2], a[3]); w.z = cvt_pk_bf16(b[0], b[1]); w.w = cvt_pk_bf16(b[2], b[3]);
            *(u32x4*)((bf16_t*)(P.ws + OFF_SK) + i * 8) = w;
        }
        { const int lane = tid & 63, gw = bid * 8 + (tid >> 6), ngw = G * 8;
          for (int r = gw; r < 2 * 16384; r += ngw) {
              const bool isv = r >= 16384; const int e = isv ? r - 16384 : r;
              const float* s = (isv ? P.peer_v : P.peer_u) + (size_t)e * 1024 + lane * 16;
              f32x4 x[4]; float ss = 0.f;
#pragma unroll
              for (int q = 0; q < 4; ++q) { x[q] = __builtin_nontemporal_load((const f32x4*)(s + 4 * q)); ss += (x[q][0] * x[q][0] + x[q][1] * x[q][1]) + (x[q][2] * x[q][2] + x[q][3] * x[q][3]); }
              const float sc = fmaxf(sqrtf(wave_sum(ss) * (1.0f / 1024.0f)) * (2.6f / 7.5f), 1e-30f), inv = 1.0f / sc;
              unsigned nb[16];
#pragma unroll
              for (int q = 0; q < 4; ++q)
#pragma unroll
                  for (int el = 0; el < 4; ++el) nb[4 * q + el] = (unsigned)fminf(fmaxf(floorf(x[q][el] * inv) + 8.0f, 0.0f), 15.0f);
              u32x2 w;
              w.x = (nb[0] | (nb[4] << 4)) | ((nb[1] | (nb[5] << 4)) << 8) | ((nb[2] | (nb[6] << 4)) << 16) | ((nb[3] | (nb[7] << 4)) << 24);
              w.y = (nb[8] | (nb[12] << 4)) | ((nb[9] | (nb[13] << 4)) << 8) | ((nb[10] | (nb[14] << 4)) << 16) | ((nb[11] | (nb[15] << 4)) << 24);
              *(u32x2*)(P.ws + (isv ? OFF_V8 : OFF_U8) + (size_t)e * 512 + lane * 8) = w;
              if (lane == 0) ((float*)(P.ws + (isv ? OFF_VSC : OFF_USC)))[e] = sc;
          } }
    }
}
__device__ void phase0b(const Params& P) {
    const size_t gtid = (size_t)blockIdx.x * NTHR + threadIdx.x, gsz = (size_t)gridDim.x * NTHR;
    const float* ada = (const float*)(P.ws + OFF_ADA); bf16_t* H = (bf16_t*)(P.ws + OFF_H);
    for (size_t i = gtid; i < (size_t)NTOK * 128; i += gsz) {
        const size_t row = i >> 7; const int c8 = (int)(i & 127) * 8; const int b = (int)(row >> 11);
        const float* xr = P.x + row * 1024 + c8; const float* sh = ada + (size_t)b * 6144 + c8; const float* sc = sh + 1024;
        const f32x4 x0 = *(const f32x4*)xr, x1 = *(const f32x4*)(xr + 4), s0 = *(const f32x4*)sc, s1 = *(const f32x4*)(sc + 4), h0 = *(const f32x4*)sh, h1 = *(const f32x4*)(sh + 4);
        const f32x4 r0 = x0 * (s0 + 1.0f) + h0, r1 = x1 * (s1 + 1.0f) + h1;
        u32x4 w; w.x = cvt_pk_bf16(r0[0], r0[1]); w.y = cvt_pk_bf16(r0[2], r0[3]); w.z = cvt_pk_bf16(r1[0], r1[1]); w.w = cvt_pk_bf16(r1[2], r1[3]);
        *(u32x4*)(H + row * 1024 + c8) = w;
    }
}

__device__ __forceinline__ s16x4 tr4(const LAS unsigned char* p) { return __builtin_bit_cast(s16x4, __builtin_amdgcn_ds_read_tr16_b64_v4i16((LAS s16x4*)p)); }
__device__ void hgrn_item(const Params& P, int item, LAS unsigned char* lds) {
    const int tid = tid_opaque(), lane = tid & 63, wid = __builtin_amdgcn_readfirstlane(tid >> 6), r32 = lane & 31, hi = lane >> 5;
    const int b = item >> 3, h = (item >> 1) & 3, vh = item & 1;
    const bf16_t* HQ = (const bf16_t*)(P.ws + OFF_HQ); const bf16_t* HK = (const bf16_t*)(P.ws + OFF_HK); bf16_t* HI = (bf16_t*)(P.ws + OFF_HI);
    constexpr int SQ = 272, SKD = 320, SV = 192, SS = 192;
    constexpr int LQR = 0, LKR = 17408, LQB = 34816, LKD = 52224, LV = 72704, LS = 84992, LG = 109568, LT = 142336, LCL = 144384;
    LAS float* G = (LAS float*)(lds + LG); LAS float* TOT = (LAS float*)(lds + LT); LAS float* CL = (LAS float*)(lds + LCL);
    const size_t rowb = (size_t)b * SEQ;
    const int row = tid >> 3, seg = tid & 7;
    const bf16_t* qsrc = HQ + (rowb + row) * 512 + h * 128 + seg * 16; const bf16_t* ksrc = HK + (rowb + row) * 512 + h * 128 + seg * 16;
    bf16_t* vsrc = HI + (rowb + row) * 512 + h * 128 + vh * 64 + seg * 8;
    for (int i = tid; i < 128 * SS / 4; i += NTHR) ((LAS unsigned*)(lds + LS))[i] = 0u;
    f32x16 Sacc = {};
    const int di = wid >> 1, vi = wid & 1, ti = wid >> 1;
    const int tg = lane >> 4, tc = tg & 1, tI = lane & 15;
    const int trow = 4 * hi + (tI >> 2), tcol = 16 * tc + 4 * (tI & 3);
    u32x4 qn0 = *(const u32x4*)qsrc, qn1 = *(const u32x4*)(qsrc + 8), kn0 = *(const u32x4*)ksrc, kn1 = *(const u32x4*)(ksrc + 8), vn = *(const u32x4*)vsrc;
#pragma unroll 1
    for (int n = 0; n < SEQ / 64; ++n) {
        const u32x4 q0 = qn0, q1 = qn1, k0 = kn0, k1 = kn1, vv = vn;
        float qf[16] = {bf_lo(q0.x), bf_hi(q0.x), bf_lo(q0.y), bf_hi(q0.y), bf_lo(q0.z), bf_hi(q0.z), bf_lo(q0.w), bf_hi(q0.w), bf_lo(q1.x), bf_hi(q1.x), bf_lo(q1.y), bf_hi(q1.y), bf_lo(q1.z), bf_hi(q1.z), bf_lo(q1.w), bf_hi(q1.w)};
        float kf[16] = {bf_lo(k0.x), bf_hi(k0.x), bf_lo(k0.y), bf_hi(k0.y), bf_lo(k0.z), bf_hi(k0.z), bf_lo(k0.w), bf_hi(k0.w), bf_lo(k1.x), bf_hi(k1.x), bf_lo(k1.y), bf_hi(k1.y), bf_lo(k1.z), bf_hi(k1.z), bf_lo(k1.w), bf_hi(k1.w)};
#pragma unroll
        for (int e4 = 0; e4 < 4; ++e4) *(LAS f32x4*)(G + row * 128 + seg * 16 + 4 * e4) = (f32x4){__logf(1.0f - kf[4 * e4]), __logf(1.0f - kf[4 * e4 + 1]), __logf(1.0f - kf[4 * e4 + 2]), __logf(1.0f - kf[4 * e4 + 3])};
        *(LAS u32x4*)(lds + LV + row * SV + seg * 16) = vv;
        if (n + 1 < SEQ / 64) { const size_t o = (size_t)(n + 1) * 64 * 512; qn0 = *(const u32x4*)(qsrc + o); qn1 = *(const u32x4*)(qsrc + o + 8); kn0 = *(const u32x4*)(ksrc + o); kn1 = *(const u32x4*)(ksrc + o + 8); vn = *(const u32x4*)(vsrc + o); }
        __syncthreads();
        { const int d = tid & 127, q4 = tid >> 7; float s = 0.f;
#pragma unroll
          for (int i = 0; i < 16; ++i) { s += G[(16 * q4 + i) * 128 + d]; G[(16 * q4 + i) * 128 + d] = s; }
          TOT[q4 * 128 + d] = s; }
        __syncthreads();
        {
            const int qq = row >> 4;
#pragma unroll
            for (int e4 = 0; e4 < 4; ++e4) {
                const int d4 = seg * 16 + 4 * e4;
                const f32x4 t0 = *(const LAS f32x4*)(TOT + d4), t1 = *(const LAS f32x4*)(TOT + 128 + d4), t2 = *(const LAS f32x4*)(TOT + 256 + d4), t3 = *(const LAS f32x4*)(TOT + 384 + d4);
                const f32x4 off = (qq == 0) ? (f32x4){0.f, 0.f, 0.f, 0.f} : ((qq == 1) ? t0 : ((qq == 2) ? t0 + t1 : t0 + t1 + t2));
                const f32x4 bb = *(const LAS f32x4*)(G + row * 128 + d4) + off;
                const f32x4 bref = *(const LAS f32x4*)(G + 32 * 128 + d4) + t0 + t1, blast = t0 + t1 + t2 + t3;
                float vqb[4], vqr[4], vkr[4], vkd[4];
#pragma unroll
                for (int e = 0; e < 4; ++e) {
                    const float e1 = __expf(bb[e]), e2 = __expf(-bb[e]);
                    vqb[e] = qf[4 * e4 + e] * e1; vqr[e] = vqb[e] * __expf(-bref[e]);
                    const float ke = kf[4 * e4 + e] * e2; vkr[e] = ke * __expf(bref[e]); vkd[e] = ke * __expf(blast[e]);
                }
                *(LAS u32x2*)(lds + LQB + row * SQ + seg * 32 + 8 * e4) = (u32x2){cvt_pk_bf16(vqb[0], vqb[1]), cvt_pk_bf16(vqb[2], vqb[3])};
                *(LAS u32x2*)(lds + LQR + row * SQ + seg * 32 + 8 * e4) = (u32x2){cvt_pk_bf16(vqr[0], vqr[1]), cvt_pk_bf16(vqr[2], vqr[3])};
                *(LAS u32x2*)(lds + LKR + row * SQ + seg * 32 + 8 * e4) = (u32x2){cvt_pk_bf16(vkr[0], vkr[1]), cvt_pk_bf16(vkr[2], vkr[3])};
                *(LAS u32x2*)(lds + LKD + row * SKD + seg * 32 + 8 * e4) = (u32x2){cvt_pk_bf16(vkd[0], vkd[1]), cvt_pk_bf16(vkd[2], vkd[3])};
                if (row == 0) *(LAS f32x4*)(CL + d4) = (f32x4){__expf(blast[0]), __expf(blast[1]), __expf(blast[2]), __expf(blast[3])};
                asm volatile("" ::: "memory");
            }
        }
        __syncthreads();
        if (wid < 4) {
            f32x16 Z = {};
            for (int si = 0; si <= ti; ++si) {
                f32x16 X = {};
#pragma unroll
                for (int ks = 0; ks < 8; ++ks) {
                    const bf16x8 a = *(const LAS bf16x8*)(lds + LKR + (32 * si + r32) * SQ + (16 * ks + 8 * hi) * 2);
                    const bf16x8 bq = *(const LAS bf16x8*)(lds + LQR + (32 * ti + r32) * SQ + (16 * ks + 8 * hi) * 2);
                    X = MFMA32(a, bq, X);
                }
                if (si == ti) {
#pragma unroll
                    for (int r = 0; r < 16; ++r) if (crow(r, hi) > r32) X[r] = 0.f;
                }
#pragma unroll
                for (int s2 = 0; s2 < 2; ++s2) {
                    union { u32x4 u; bf16x8 v; } pa;
                    pa.u.x = cvt_pk_bf16(X[8 * s2 + 0], X[8 * s2 + 1]); pa.u.y = cvt_pk_bf16(X[8 * s2 + 2], X[8 * s2 + 3]); pa.u.z = cvt_pk_bf16(X[8 * s2 + 4], X[8 * s2 + 5]); pa.u.w = cvt_pk_bf16(X[8 * s2 + 6], X[8 * s2 + 7]);
                    const LAS unsigned char* vp = lds + LV + (32 * si + 16 * s2 + trow) * SV + (32 * vi + tcol) * 2;
                    const s16x4 lo = tr4(vp), hh = tr4(vp + 8 * SV);
                    const bf16x8 vf = {lo[0], lo[1], lo[2], lo[3], hh[0], hh[1], hh[2], hh[3]};
                    Z = MFMA32(pa.v, vf, Z);
                }
            }
#pragma unroll
            for (int ks = 0; ks < 8; ++ks) {
                const bf16x8 a = *(const LAS bf16x8*)(lds + LQB + (32 * ti + r32) * SQ + (16 * ks + 8 * hi) * 2);
                const LAS unsigned char* sp = lds + LS + (16 * ks + 8 * hi + (tI >> 2)) * SS + (32 * vi + tcol) * 2;
                const s16x4 lo = tr4(sp), hh = tr4(sp + 4 * SS);
                const bf16x8 sf = {lo[0], lo[1], lo[2], lo[3], hh[0], hh[1], hh[2], hh[3]};
                Z = MFMA32(a, sf, Z);
            }
            bf16_t* op = HI + (rowb + (size_t)n * 64 + 32 * ti) * 512 + h * 128 + vh * 64 + 32 * vi + r32;
#pragma unroll
            for (int r = 0; r < 16; ++r) op[(size_t)crow(r, hi) * 512] = (bf16_t)(cvt_pk_bf16(Z[r], 0.f) & 0xffffu);
        }
        {
#pragma unroll
            for (int r = 0; r < 16; ++r) Sacc[r] *= CL[32 * di + crow(r, hi)];
#pragma unroll
            for (int ks = 0; ks < 4; ++ks) {
                const LAS unsigned char* kp = lds + LKD + (16 * ks + 8 * hi + (tI >> 2)) * SKD + (32 * di + tcol) * 2;
                const s16x4 klo = tr4(kp), khi = tr4(kp + 4 * SKD);
                const bf16x8 ka = {klo[0], klo[1], klo[2], klo[3], khi[0], khi[1], khi[2], khi[3]};
                const LAS unsigned char* vp = lds + LV + (16 * ks + 8 * hi + (tI >> 2)) * SV + (32 * vi + tcol) * 2;
                const s16x4 vlo = tr4(vp), vhi = tr4(vp + 4 * SV);
                const bf16x8 vb = {vlo[0], vlo[1], vlo[2], vlo[3], vhi[0], vhi[1], vhi[2], vhi[3]};
                Sacc = MFMA32(ka, vb, Sacc);
            }
        }
        __syncthreads();
        {
            LAS bf16_t* sp = (LAS bf16_t*)(lds + LS + (32 * di) * SS + (32 * vi + r32) * 2);
#pragma unroll
            for (int r = 0; r < 16; ++r) sp[crow(r, hi) * (SS / 2)] = (bf16_t)(cvt_pk_bf16(Sacc[r], 0.f) & 0xffffu);
        }
    }
    __syncthreads();
}

__device__ void moba_unit(const Params& P, int b, int h, int j, LAS unsigned char* lds) {
    const int tid = tid_opaque(), lane = tid & 63, wid = tid >> 6, r32 = lane & 31, hi = lane >> 5;
    bf16_t* Q = (bf16_t*)(P.ws + OFF_QA); const bf16_t* Kg = (const bf16_t*)(P.ws + OFF_KA); const bf16_t* Vg = (const bf16_t*)(P.ws + OFF_VA);
    const float* kmean = (const float*)(P.ws + OFF_KMEAN);
    constexpr int KIMG = 64 * 144, VIMG = 64 * 192, LK = 0, LV = 2 * KIMG, LKM = 2 * KIMG + 2 * VIMG;
    LAS float* kmL = (LAS float*)(lds + LKM);
    const size_t rowb = (size_t)b * SEQ; const int q0 = j * 256;
    if (tid < j * 64) kmL[tid] = kmean[(size_t)(b * 8 + (tid >> 6)) * 512 + h * 64 + (tid & 63)];
    bf16_t* qrow = Q + (rowb + q0 + wid * 32 + r32) * 512 + h * 64;
    bf16x8 qf[4];
#pragma unroll
    for (int d0 = 0; d0 < 4; ++d0) qf[d0] = *(const bf16x8*)(qrow + 16 * d0 + 8 * hi);
    const int srow = tid >> 3, sch = tid & 7;
    const bf16_t* ksrc = Kg + (rowb + srow) * 512 + h * 64 + sch * 8; const bf16_t* vsrc = Vg + (rowb + srow) * 512 + h * 64 + sch * 8;
    const int ntile = 4 * (j + 1);
    u32x4 kreg, vreg;
    { const int key0 = q0; kreg = *(const u32x4*)(ksrc + (size_t)key0 * 512); vreg = *(const u32x4*)(vsrc + (size_t)key0 * 512); }
    *(LAS u32x4*)(lds + LK + srow * 144 + sch * 16) = kreg; *(LAS u32x4*)(lds + LV + srow * 192 + sch * 16) = vreg;
    __syncthreads();
    unsigned sel = 0;
    if (j <= 3) sel = (1u << j) - 1u;
    else {
        float g[7];
#pragma unroll
        for (int n = 0; n < 7; ++n) { float s = 0.f;
            if (n < j) {
#pragma unroll
                for (int d0 = 0; d0 < 4; ++d0)
#pragma unroll
                    for (int e = 0; e < 8; ++e) s += __uint_as_float(((unsigned)(unsigned short)qf[d0][e]) << 16) * kmL[n * 64 + 16 * d0 + 8 * hi + e];
            }
            s += __shfl_xor(s, 32); g[n] = s; }
#pragma unroll
        for (int it = 0; it < 3; ++it) { float best = -INFINITY; int bi = 0;
#pragma unroll
            for (int n = 0; n < 7; ++n) if (n < j && !((sel >> n) & 1u) && g[n] > best) { best = g[n]; bi = n; }
            sel |= 1u << bi; }
    }
    const float ch = exp2f(-(float)(h + 1)) * LOG2E;
    const int qb = wid * 32 + r32;
    float m_run = -1e30f, l_run = 0.f;
    f32x16 o0 = {}, o1 = {};
    const int tg = lane >> 4, tc = tg & 1, ti = lane & 15;
    const int vlane = (4 * hi + (ti >> 2)) * 192 + (16 * tc + 4 * (ti & 3)) * 2;
#pragma unroll 1
    for (int i = 0; i < ntile; ++i) {
        const int buf = i & 1;
        const bool own = i < 4; const int blk = own ? j : ((i - 4) >> 2), kt = own ? i : ((i - 4) & 3);
        if (i + 1 < ntile) { const int i1 = i + 1; const int blk1 = (i1 < 4) ? j : ((i1 - 4) >> 2), kt1 = (i1 < 4) ? i1 : ((i1 - 4) & 3); const size_t key1 = (size_t)(blk1 * 256 + kt1 * 64);
            kreg = *(const u32x4*)(ksrc + key1 * 512); vreg = *(const u32x4*)(vsrc + key1 * 512); }
        const bool lane_ok = own ? true : (((sel >> blk) & 1u) != 0u);
        const bool skip = own ? (64 * kt > 32 * wid + 31) : (__ballot(lane_ok) == 0ull);
        if (!skip) {
            LAS unsigned char* kb = lds + LK + buf * KIMG; LAS unsigned char* vb = lds + LV + buf * VIMG;
            f32x16 p0 = {}, p1 = {};
#pragma unroll
            for (int d0 = 0; d0 < 4; ++d0) {
                const bf16x8 kf0 = *(const LAS bf16x8*)(kb + r32 * 144 + (16 * d0 + 8 * hi) * 2);
                const bf16x8 kf1 = *(const LAS bf16x8*)(kb + (32 + r32) * 144 + (16 * d0 + 8 * hi) * 2);
                p0 = MFMA32(kf0, qf[d0], p0); p1 = MFMA32(kf1, qf[d0], p1);
            }
            const float kbase = ch * (float)((blk - j) * 256 + kt * 64);
            float mt = -1e30f;
#pragma unroll
            for (int r = 0; r < 16; ++r) {
                const int kl0 = crow(r, hi), kl1 = kl0 + 32;
                const float t0 = p0[r] + (kbase + ch * (float)kl0), t1 = p1[r] + (kbase + ch * (float)kl1);
                const bool v0 = own ? (kt * 64 + kl0 <= qb) : lane_ok, v1 = own ? (kt * 64 + kl1 <= qb) : lane_ok;
                p0[r] = v0 ? t0 : -1e30f; p1[r] = v1 ? t1 : -1e30f;
                mt = fmaxf(mt, fmaxf(p0[r], p1[r]));
            }
            mt = fmaxf(mt, __shfl_xor(mt, 32));
            const float mnew = fmaxf(m_run, mt), alpha = __builtin_amdgcn_exp2f(m_run - mnew);
            m_run = mnew;
            float rs = 0.f;
#pragma unroll
            for (int r = 0; r < 16; ++r) { p0[r] = __builtin_amdgcn_exp2f(p0[r] - mnew); p1[r] = __builtin_amdgcn_exp2f(p1[r] - mnew); rs += p0[r] + p1[r]; }
            l_run = l_run * alpha + rs;
#pragma unroll
            for (int r = 0; r < 16; ++r) { o0[r] *= alpha; o1[r] *= alpha; }
#pragma unroll
            for (int sub = 0; sub < 2; ++sub)
#pragma unroll
                for (int s = 0; s < 2; ++s) {
                    union { u32x4 u; bf16x8 v; } pb;
                    if (sub == 0) { pb.u.x = cvt_pk_bf16(p0[8 * s + 0], p0[8 * s + 1]); pb.u.y = cvt_pk_bf16(p0[8 * s + 2], p0[8 * s + 3]); pb.u.z = cvt_pk_bf16(p0[8 * s + 4], p0[8 * s + 5]); pb.u.w = cvt_pk_bf16(p0[8 * s + 6], p0[8 * s + 7]); }
                    else { pb.u.x = cvt_pk_bf16(p1[8 * s + 0], p1[8 * s + 1]); pb.u.y = cvt_pk_bf16(p1[8 * s + 2], p1[8 * s + 3]); pb.u.z = cvt_pk_bf16(p1[8 * s + 4], p1[8 * s + 5]); pb.u.w = cvt_pk_bf16(p1[8 * s + 6], p1[8 * s + 7]); }
#pragma unroll
                    for (int dt = 0; dt < 2; ++dt) {
                        LAS unsigned char* va = vb + (32 * sub + 16 * s) * 192 + dt * 64 + vlane;
                        const s16x4 lo = __builtin_bit_cast(s16x4, __builtin_amdgcn_ds_read_tr16_b64_v4i16((LAS s16x4*)va));
                        const s16x4 hh = __builtin_bit_cast(s16x4, __builtin_amdgcn_ds_read_tr16_b64_v4i16((LAS s16x4*)(va + 8 * 192)));
                        const bf16x8 vf = {lo[0], lo[1], lo[2], lo[3], hh[0], hh[1], hh[2], hh[3]};
                        if (dt == 0) o0 = MFMA32(vf, pb.v, o0); else o1 = MFMA32(vf, pb.v, o1);
                    }
                }
        }
        if (i + 1 < ntile) { const int nb = buf ^ 1;
            *(LAS u32x4*)(lds + LK + nb * KIMG + srow * 144 + sch * 16) = kreg; *(LAS u32x4*)(lds + LV + nb * VIMG + srow * 192 + sch * 16) = vreg; }
        __syncthreads();
    }
    l_run += __shfl_xor(l_run, 32);
    const float inv = 1.0f / l_run;
#pragma unroll
    for (int r4 = 0; r4 < 4; ++r4) {
        u32x2 w0, w1;
        w0.x = cvt_pk_bf16(o0[4 * r4] * inv, o0[4 * r4 + 1] * inv); w0.y = cvt_pk_bf16(o0[4 * r4 + 2] * inv, o0[4 * r4 + 3] * inv);
        w1.x = cvt_pk_bf16(o1[4 * r4] * inv, o1[4 * r4 + 1] * inv); w1.y = cvt_pk_bf16(o1[4 * r4 + 2] * inv, o1[4 * r4 + 3] * inv);
        *(u32x2*)(qrow + 8 * r4 + 4 * hi) = w0; *(u32x2*)(qrow + 32 + 8 * r4 + 4 * hi) = w1;
    }
}

__device__ void yb_norm_panel(const Params& P, int pm) {
    const int tid = tid_opaque(), lane = tid & 63, wid = tid >> 6;
    bf16_t* HI = (bf16_t*)(P.ws + OFF_HI); const bf16_t* HG = (const bf16_t*)(P.ws + OFF_HG);
    for (int r = 0; r < 32; ++r) {
        const size_t off = ((size_t)pm * 256 + wid * 32 + r) * 512 + lane * 8;
        const u32x4 ov = *(const u32x4*)(HI + off), gv = *(const u32x4*)(HG + off);
        float o[8] = {bf_lo(ov.x), bf_hi(ov.x), bf_lo(ov.y), bf_hi(ov.y), bf_lo(ov.z), bf_hi(ov.z), bf_lo(ov.w), bf_hi(ov.w)};
        const float g[8] = {bf_lo(gv.x), bf_hi(gv.x), bf_lo(gv.y), bf_hi(gv.y), bf_lo(gv.z), bf_hi(gv.z), bf_lo(gv.w), bf_hi(gv.w)};
        float ss = 0.f;
#pragma unroll
        for (int e = 0; e < 8; ++e) ss += o[e] * o[e];
        ss += __shfl_xor(ss, 1); ss += __shfl_xor(ss, 2); ss += __shfl_xor(ss, 4); ss += __shfl_xor(ss, 8);
        const float rs = rsqrtf(ss * (1.0f / 128.0f) + RMS_EPS);
        u32x4 w; w.x = cvt_pk_bf16(o[0] * rs * g[0], o[1] * rs * g[1]); w.y = cvt_pk_bf16(o[2] * rs * g[2], o[3] * rs * g[3]);
        w.z = cvt_pk_bf16(o[4] * rs * g[4], o[5] * rs * g[5]); w.w = cvt_pk_bf16(o[6] * rs * g[6], o[7] * rs * g[7]);
        *(u32x4*)(HI + off) = w;
    }
}
__device__ void ln1_panel(const Params& P, int pm) {
    const int tid = tid_opaque(), lane = tid & 63, wid = tid >> 6;
    const float* ada = (const float*)(P.ws + OFF_ADA) + (size_t)(pm >> 3) * 6144; bf16_t* H = (bf16_t*)(P.ws + OFF_H);
    for (int r = 0; r < 32; ++r) {
        const size_t row = (size_t)pm * 256 + wid * 32 + r;
        float* xr = P.out + row * 1024 + lane * 4; const float* xin = P.x + row * 1024 + lane * 4; const bf16_t* dl = (const bf16_t*)(P.ws + OFF_GB) + row * 1024 + lane * 4;
        f32x4 v[4]; float s = 0.f;
#pragma unroll
        for (int jx = 0; jx < 4; ++jx) { const u32x2 dv = *(const u32x2*)(dl + 256 * jx); const f32x4 xv = __builtin_nontemporal_load((const f32x4*)(xin + 256 * jx));
            v[jx] = xv * ALPHA + (f32x4){bf_lo(dv.x), bf_hi(dv.x), bf_lo(dv.y), bf_hi(dv.y)}; s += (v[jx][0] + v[jx][1]) + (v[jx][2] + v[jx][3]); }
        const float mean = wave_sum(s) * (1.0f / 1024.0f); float s2 = 0.f;
#pragma unroll
        for (int jx = 0; jx < 4; ++jx) { v[jx] = v[jx] - mean; s2 += (v[jx][0] * v[jx][0] + v[jx][1] * v[jx][1]) + (v[jx][2] * v[jx][2] + v[jx][3] * v[jx][3]); }
        const float rstd = rsqrtf(wave_sum(s2) * (1.0f / 1024.0f) + LN_EPS);
#pragma unroll
        for (int jx = 0; jx < 4; ++jx) {
            const int c = lane * 4 + 256 * jx;
            const f32x4 g = *(const f32x4*)(P.ln1_g + c), bb = *(const f32x4*)(P.ln1_b + c), sh = *(const f32x4*)(ada + 3072 + c), sc = *(const f32x4*)(ada + 4096 + c);
            const f32x4 x1 = v[jx] * rstd * g + bb;
            *(f32x4*)(xr + 256 * jx) = x1;
            const f32x4 h2 = x1 * (sc + 1.0f) + sh;
            u32x2 w; w.x = cvt_pk_bf16(h2[0], h2[1]); w.y = cvt_pk_bf16(h2[2], h2[3]);
            *(u32x2*)(H + row * 1024 + c) = w;
            v[jx] = h2;
        }
        {
            float mx = 0.f;
#pragma unroll
            for (int jx = 0; jx < 4; ++jx) mx = fmaxf(mx, fmaxf(fmaxf(fabsf(v[jx][0]), fabsf(v[jx][1])), fmaxf(fabsf(v[jx][2]), fabsf(v[jx][3]))));
#pragma unroll
            for (int o = 1; o < 64; o <<= 1) mx = fmaxf(mx, __shfl_xor(mx, o));
            const float hs = fmaxf(mx * (1.0f / 127.0f), 1e-30f), inv = 1.0f / hs; int qs = 0;
#pragma unroll
            for (int jx = 0; jx < 4; ++jx) {
                const int q0 = (int)rintf(v[jx][0] * inv), q1 = (int)rintf(v[jx][1] * inv), q2 = (int)rintf(v[jx][2] * inv), q3 = (int)rintf(v[jx][3] * inv);
                qs += (q0 + q1) + (q2 + q3);
                *(unsigned*)(P.ws + OFF_H8 + row * 1024 + lane * 4 + 256 * jx) = (unsigned)(q0 & 255) | ((unsigned)(q1 & 255) << 8) | ((unsigned)(q2 & 255) << 16) | ((unsigned)(q3 & 255) << 24);
            }
#pragma unroll
            for (int o = 1; o < 64; o <<= 1) qs += __shfl_xor(qs, o);
            if (lane == 0) *(f32x2*)(P.ws + OFF_HS + row * 8) = (f32x2){hs, (float)qs};
        }
    }
}

#define INS16(L, xin) do { float x_ = (xin); _Pragma("unroll") for (int k_ = 0; k_ < 16; ++k_) { const float hi_ = fmaxf(L[k_], x_); x_ = fminf(L[k_], x_); L[k_] = hi_; } } while (0)

__device__ void peer_select_wave(const Params& P, size_t tok0) {
    const int lane = tid_opaque() & 63, r32 = lane & 31, hi = lane >> 5;
    const bf16_t* QP = (const bf16_t*)(P.ws + OFF_GB) + (tok0 + r32) * 1024; const bf16_t* SK = (const bf16_t*)(P.ws + OFF_SK);
    u32x2* EG = (u32x2*)(P.ws + OFF_EG) + (tok0 + r32) * 128;
#pragma unroll 1
    for (int h = 0; h < 8; ++h) {
        float a0[16], a1[16];
#pragma unroll
        for (int k = 0; k < 16; ++k) { a0[k] = -INFINITY; a1[k] = -INFINITY; }
#pragma unroll 1
        for (int p = 0; p < 2; ++p) {
            const int hp = h * 2 + p;
            bf16x8 qf[4];
#pragma unroll
            for (int ks = 0; ks < 4; ++ks) qf[ks] = *(const bf16x8*)(QP + hp * 64 + 16 * ks + 8 * hi);
            float L[16];
#pragma unroll
            for (int k = 0; k < 16; ++k) L[k] = -INFINITY;
#pragma unroll
            for (int kt = 0; kt < 4; ++kt) {
                f32x16 acc = {};
#pragma unroll
                for (int ks = 0; ks < 4; ++ks) { const bf16x8 kf = *(const bf16x8*)(SK + ((size_t)hp * 128 + 32 * kt + r32) * 64 + 16 * ks + 8 * hi); acc = MFMA32(kf, qf[ks], acc); }
#pragma unroll
                for (int r = 0; r < 16; ++r) { const unsigned key = (unsigned)(32 * kt + crow(r, hi)); const float xv = __uint_as_float((__float_as_uint(acc[r]) & ~127u) | key); INS16(L, xv); }
            }
            float O[16];
#pragma unroll
            for (int k = 0; k < 16; ++k) O[k] = __shfl_xor(L[k], 32);
#pragma unroll
            for (int k = 0; k < 16; ++k) INS16(L, O[k]);
#pragma unroll
            for (int k = 0; k < 16; ++k) { a0[k] = (p == 0) ? L[k] : a0[k]; a1[k] = (p == 1) ? L[k] : a1[k]; }
        }
        float best[16];
#pragma unroll
        for (int k = 0; k < 16; ++k) best[k] = -INFINITY;
#pragma unroll
        for (int i = 0; i < 16; ++i)
#pragma unroll
            for (int jx = 0; jx < 16; ++jx)
                if ((i + 1) * (jx + 1) <= 16) {
                    const float cs = a0[i] + a1[jx];
                    const float cv = __uint_as_float((__float_as_uint(cs) & ~255u) | (unsigned)(i * 16 + jx));
                    INS16(best, cv);
                }
        unsigned pk0[4], pk1[4];
#pragma unroll
        for (int q = 0; q < 4; ++q) {
            pk0[q] = (__float_as_uint(a0[4 * q]) & 127u) | ((__float_as_uint(a0[4 * q + 1]) & 127u) << 8) | ((__float_as_uint(a0[4 * q + 2]) & 127u) << 16) | ((__float_as_uint(a0[4 * q + 3]) & 127u) << 24);
            pk1[q] = (__float_as_uint(a1[4 * q]) & 127u) | ((__float_as_uint(a1[4 * q + 1]) & 127u) << 8) | ((__float_as_uint(a1[4 * q + 2]) & 127u) << 16) | ((__float_as_uint(a1[4 * q + 3]) & 127u) << 24);
        }
        unsigned pay[16];
#pragma unroll
        for (int k = 0; k < 16; ++k) {
            const unsigned code = __float_as_uint(best[k]) & 255u, ci = code >> 4, cj = code & 15u;
            const unsigned qi = ci >> 2, qj = cj >> 2;
            const unsigned w0 = (qi == 0u) ? pk0[0] : ((qi == 1u) ? pk0[1] : ((qi == 2u) ? pk0[2] : pk0[3]));
            const unsigned w1 = (qj == 0u) ? pk1[0] : ((qj == 1u) ? pk1[1] : ((qj == 2u) ? pk1[2] : pk1[3]));
            pay[k] = (((w0 >> ((ci & 3u) * 8u)) & 127u) << 7) | ((w1 >> ((cj & 3u) * 8u)) & 127u);
        }
        float e[16], es = 0.f;
#pragma unroll
        for (int k = 0; k < 16; ++k) { e[k] = __expf(best[k] - best[0]); es += e[k]; }
        const float inv = 1.0f / es;
        if (hi == 0) {
#pragma unroll
            for (int k = 0; k < 16; ++k) { u32x2 w; w.x = pay[k]; w.y = __float_as_uint(e[k] * inv); EG[h * 16 + k] = w; }
        }
    }
}
__device__ __forceinline__ unsigned xcc_id() { return (unsigned)__builtin_amdgcn_s_getreg((3 << 11) | 20) & 0xFu; }
template <int CTRL> __device__ __forceinline__ float dpp_add(float x) { const int v = __builtin_amdgcn_update_dpp(0, __float_as_int(x), CTRL, 0xf, 0xf, true); return x + __int_as_float(v); }
__device__ __forceinline__ float wave_sum_fast(float x) {
    x = dpp_add<0xB1>(x); x = dpp_add<0x4E>(x); x = dpp_add<0x141>(x); x = dpp_add<0x140>(x);
    x += __shfl_xor(x, 16); x += __shfl_xor(x, 32); return x;
}
__device__ __forceinline__ float dot16_fp8(const float (&hv)[16], const u32x4 r) {
    float s = 0.f;
    { const f32x2 a = __builtin_amdgcn_cvt_pk_f32_fp8((int)r.x, false), b = __builtin_amdgcn_cvt_pk_f32_fp8((int)r.x, true); s += hv[0] * a.x + hv[1] * a.y + hv[2] * b.x + hv[3] * b.y; }
    { const f32x2 a = __builtin_amdgcn_cvt_pk_f32_fp8((int)r.y, false), b = __builtin_amdgcn_cvt_pk_f32_fp8((int)r.y, true); s += hv[4] * a.x + hv[5] * a.y + hv[6] * b.x + hv[7] * b.y; }
    { const f32x2 a = __builtin_amdgcn_cvt_pk_f32_fp8((int)r.z, false), b = __builtin_amdgcn_cvt_pk_f32_fp8((int)r.z, true); s += hv[8] * a.x + hv[9] * a.y + hv[10] * b.x + hv[11] * b.y; }
    { const f32x2 a = __builtin_amdgcn_cvt_pk_f32_fp8((int)r.w, false), b = __builtin_amdgcn_cvt_pk_f32_fp8((int)r.w, true); s += hv[12] * a.x + hv[13] * a.y + hv[14] * b.x + hv[15] * b.y; }
    return s;
}
template <int NP, class F> __device__ __forceinline__ void partition_queue(const Params& P, LAS unsigned char* lds, int ctr_base, F f) {
    const int tid = tid_opaque();
    LAS int* slot = (LAS int*)(lds + LDS_BYTES - 64);
    unsigned* ctr = (unsigned*)(P.ws + OFF_CTR) + ctr_base;
    const int myx = (int)(xcc_id() & 7u);
    for (int pp = 0; pp < NP; ++pp) {
        const int p = (myx * (NP / 8) + pp) % NP;
        for (;;) {
            if (tid == 0) *slot = (int)atomicAdd(ctr + p, 1u);
            __syncthreads();
            const int item = *slot;
            __syncthreads();
            if (item >= NTOK / 64) break;
            f(p, item);
        }
    }
}
__device__ __forceinline__ float dot2bf(unsigned a, bf16v2 b, float c) { return __builtin_amdgcn_fdot2_f32_bf16(__builtin_bit_cast(bf16v2, a), b, c, false); }
struct UQuad { u32x4 r[2]; u32x4 ent; };
__device__ __forceinline__ void uq_issue(UQuad& q, const LAS u32x4* list, int J, int NQ, int g, const unsigned char* U4) {
    const int jj = J < NQ ? J : NQ - 1;
    q.ent = list[4 * jj + g];
    const unsigned char* rp = U4 + (size_t)q.ent.x * 512;
    q.r[0] = *(const u32x4*)rp; q.r[1] = *(const u32x4*)(rp + 256);
}
__device__ __forceinline__ int dot8_i4(unsigned w, unsigned hlo, unsigned hhi, int acc) {
    acc = __builtin_amdgcn_sdot4((int)hlo, (int)(w & 0x0F0F0F0Fu), acc, false);
    return __builtin_amdgcn_sdot4((int)hhi, (int)((w >> 4) & 0x0F0F0F0Fu), acc, false);
}
__device__ __forceinline__ float uq_dot(const UQuad& q, const u32x4 (&hp)[4]) {
    int a = 0, b = 0;
#pragma unroll
    for (int c = 0; c < 2; ++c) {
        const u32x4 r = q.r[c];
        a = dot8_i4(r.x, hp[2 * c].x, hp[2 * c].y, a); b = dot8_i4(r.y, hp[2 * c].z, hp[2 * c].w, b);
        a = dot8_i4(r.z, hp[2 * c + 1].x, hp[2 * c + 1].y, a); b = dot8_i4(r.w, hp[2 * c + 1].z, hp[2 * c + 1].w, b);
    }
    float s = (float)(a + b);
    s = dpp_add<0xB1>(s); s = dpp_add<0x4E>(s); s = dpp_add<0x141>(s); s = dpp_add<0x140>(s);
    return s;
}
__device__ __forceinline__ void peer_u_tokens(const Params& P, LAS unsigned char* lds, const size_t t0) {
    const int tid = tid_opaque(), lane = tid & 63, wid = tid >> 6, g = lane >> 4, li = lane & 15;
    const unsigned char* H8 = P.ws + OFF_H8 + li * 32; const unsigned char* U4 = P.ws + OFF_U8 + li * 16;
    const f32x2* HS = (const f32x2*)(P.ws + OFF_HS); const float* USC = (const float*)(P.ws + OFF_USC);
    const u32x4* EG4 = (const u32x4*)(P.ws + OFF_EG); float* W = (float*)(P.ws + OFF_W);
    LAS u32x4* list = (LAS u32x4*)(lds + wid * 16384);
#pragma unroll 2
    for (int i = 0; i < 8; ++i) {
        const u32x4 eg = EG4[(t0 + i) * 64 + lane];
        list[i * 128 + 2 * lane] = (u32x4){eg.x, eg.y, (unsigned)(2 * lane) | (unsigned)(i << 8), __float_as_uint(USC[eg.x])};
        list[i * 128 + 2 * lane + 1] = (u32x4){eg.z, eg.w, (unsigned)(2 * lane + 1) | (unsigned)(i << 8), __float_as_uint(USC[eg.z])};
    }
    constexpr int NQ = 256;
    u32x4 hp[4], hn[4]; f32x2 hsc = HS[t0], hsn = HS[t0 + 1];
#pragma unroll
    for (int c = 0; c < 2; ++c) { hp[2 * c] = *(const u32x4*)(H8 + t0 * 1024 + 512 * c); hp[2 * c + 1] = *(const u32x4*)(H8 + t0 * 1024 + 512 * c + 16);
                                  hn[2 * c] = *(const u32x4*)(H8 + (t0 + 1) * 1024 + 512 * c); hn[2 * c + 1] = *(const u32x4*)(H8 + (t0 + 1) * 1024 + 512 * c + 16); }
    int curtok = 0;
    UQuad q0, q1, q2, q3;
    uq_issue(q0, list, 0, NQ, g, U4); uq_issue(q1, list, 1, NQ, g, U4); uq_issue(q2, list, 2, NQ, g, U4); uq_issue(q3, list, 3, NQ, g, U4);
#define UQ_STEP(q, Jn) do { \
        const int tk = __builtin_amdgcn_readfirstlane((int)(q.ent.z >> 8)); \
        if (tk != curtok) { curtok = tk; _Pragma("unroll") for (int c = 0; c < 4; ++c) hp[c] = hn[c]; hsc = hsn; \
            if (tk + 1 < 8) { hsn = HS[t0 + tk + 1]; _Pragma("unroll") for (int c = 0; c < 2; ++c) { hn[2 * c] = *(const u32x4*)(H8 + (t0 + tk + 1) * 1024 + 512 * c); hn[2 * c + 1] = *(const u32x4*)(H8 + (t0 + tk + 1) * 1024 + 512 * c + 16); } } } \
        const float s = __uint_as_float(q.ent.w) * hsc.x * (uq_dot(q, hp) - 7.5f * hsc.y); \
        if (li == 0) W[(t0 + tk) * 128 + (q.ent.z & 255u)] = __uint_as_float(q.ent.y) * 0.5f * s * (1.0f + erff(s * 0.70710678118654752f)); \
        uq_issue(q, list, (Jn), NQ, g, U4); } while (0)
#pragma unroll 1
    for (int J = 0; J < NQ; J += 4) { UQ_STEP(q0, J + 4); UQ_STEP(q1, J + 5); UQ_STEP(q2, J + 6); UQ_STEP(q3, J + 7); }
#undef UQ_STEP
}
typedef int v4i_t __attribute__((ext_vector_type(4)));
struct VQuad { u32x4 r[2]; u32x2 ent; };
__device__ __forceinline__ void vq_issue(VQuad& q, const LAS u32x2* list, int J, int g, const unsigned char* V4) {
    const int jj = J < 32 ? J : 31;
    q.ent = list[4 * jj + g];
    const unsigned char* rp = V4 + (size_t)q.ent.x * 512;
    q.r[0] = *(const u32x4*)rp; q.r[1] = *(const u32x4*)(rp + 256);
}
__device__ __forceinline__ void vq_mma(const VQuad& q, v4i_t (&acc)[4], const unsigned sh, const u32x4 bm, const bool live) {
    const unsigned t = live ? ((q.ent.y & 255u) << sh) : 0u;
    const v4i_t B = {(int)(t & bm.x), (int)(t & bm.y), (int)(t & bm.z), (int)(t & bm.w)};
#pragma unroll
    for (int c = 0; c < 2; ++c) {
        const u32x4 r = q.r[c];
        const v4i_t lo = {(int)(r.x & 0x0F0F0F0Fu), (int)(r.y & 0x0F0F0F0Fu), (int)(r.z & 0x0F0F0F0Fu), (int)(r.w & 0x0F0F0F0Fu)};
        const v4i_t hi = {(int)((r.x >> 4) & 0x0F0F0F0Fu), (int)((r.y >> 4) & 0x0F0F0F0Fu), (int)((r.z >> 4) & 0x0F0F0F0Fu), (int)((r.w >> 4) & 0x0F0F0F0Fu)};
        acc[2 * c] = __builtin_amdgcn_mfma_i32_16x16x64_i8(lo, B, acc[2 * c], 0, 0, 0);
        acc[2 * c + 1] = __builtin_amdgcn_mfma_i32_16x16x64_i8(hi, B, acc[2 * c + 1], 0, 0, 0);
    }
}
__device__ __forceinline__ void peer_v_tokens(const Params& P, LAS unsigned char* lds, const size_t t0) {
    const int tid = tid_opaque(), lane = tid & 63, wid = tid >> 6, g = lane >> 4, li = lane & 15;
    const unsigned char* V4 = P.ws + OFF_V8 + li * 16; const float* VSC = (const float*)(P.ws + OFF_VSC);
    const u32x4* EG4 = (const u32x4*)(P.ws + OFF_EG); const f32x2* W2 = (const f32x2*)(P.ws + OFF_W);
    LAS u32x2* lists = (LAS u32x2*)(lds + wid * 8192);
    float swv[8], yoffv[8];
#pragma unroll
    for (int i = 0; i < 8; ++i) { const u32x4 eg = EG4[(t0 + i) * 64 + lane]; const f32x2 ww = W2[(t0 + i) * 64 + lane];
        const float w0 = ww.x * VSC[eg.x], w1 = ww.y * VSC[eg.z];
        float mx = fmaxf(fabsf(w0), fabsf(w1));
#pragma unroll
        for (int o = 1; o < 64; o <<= 1) mx = fmaxf(mx, __shfl_xor(mx, o));
        const float sw = fmaxf(mx * (1.0f / 127.0f), 1e-30f), inv = 1.0f / sw;
        const int q0 = (int)rintf(w0 * inv), q1 = (int)rintf(w1 * inv);
        *(LAS u32x4*)(lists + i * 128 + 2 * lane) = (u32x4){eg.x, (unsigned)q0, eg.z, (unsigned)q1};
        int qs = q0 + q1;
#pragma unroll
        for (int o = 1; o < 64; o <<= 1) qs += __shfl_xor(qs, o);
        swv[i] = sw; yoffv[i] = 7.5f * sw * (float)qs; }
    const unsigned sh = 8u * (unsigned)(li & 3);
    const u32x4 bm = {(li >> 2) == 0 ? 0xFFFFFFFFu : 0u, (li >> 2) == 1 ? 0xFFFFFFFFu : 0u, (li >> 2) == 2 ? 0xFFFFFFFFu : 0u, (li >> 2) == 3 ? 0xFFFFFFFFu : 0u};
#pragma unroll
    for (int i = 0; i < 8; ++i) {
        const size_t t = t0 + i;
        const LAS u32x2* list = lists + i * 128;
        v4i_t acc[4];
#pragma unroll
        for (int j = 0; j < 4; ++j) acc[j] = (v4i_t){0, 0, 0, 0};
        VQuad q0, q1, q2, q3;
        vq_issue(q0, list, 0, g, V4); vq_issue(q1, list, 1, g, V4); vq_issue(q2, list, 2, g, V4); vq_issue(q3, list, 3, g, V4);
#pragma unroll 1
        for (int J = 0; J < 32; J += 4) {
            vq_mma(q0, acc, sh, bm, true); vq_issue(q0, list, J + 4, g, V4);
            vq_mma(q1, acc, sh, bm, true); vq_issue(q1, list, J + 5, g, V4);
            vq_mma(q2, acc, sh, bm, true); vq_issue(q2, list, J + 6, g, V4);
            vq_mma(q3, acc, sh, bm, true); vq_issue(q3, list, J + 7, g, V4);
        }
        const float sw = swv[i], yoff = yoffv[i];
        const int dbase = 128 * g + 8 * (li >> 2) + (li & 3);
        const float* gt2 = (const float*)(P.ws + OFF_ADA) + (t >> 11) * 6144 + 5120;
        float* xr = P.out + t * 1024;
        float pre[16]; float s = 0.f;
#pragma unroll
        for (int c = 0; c < 2; ++c)
#pragma unroll
            for (int hf = 0; hf < 2; ++hf)
#pragma unroll
                for (int r = 0; r < 4; ++r) { const int d = dbase + 512 * c + 32 * r + 4 * hf;
                    const float yv = sw * (float)acc[2 * c + hf][r] - yoff;
                    const float pv = ALPHA * xr[d] + gt2[d] * yv; pre[8 * c + 4 * hf + r] = pv; s += pv; }
        const float mean = wave_sum(s) * (1.0f / 1024.0f); float s2 = 0.f;
#pragma unroll
        for (int e = 0; e < 16; ++e) { pre[e] -= mean; s2 += pre[e] * pre[e]; }
        const float rstd = rsqrtf(wave_sum(s2) * (1.0f / 1024.0f) + LN_EPS);
#pragma unroll
        for (int c = 0; c < 2; ++c)
#pragma unroll
            for (int hf = 0; hf < 2; ++hf)
#pragma unroll
                for (int r = 0; r < 4; ++r) { const int d = dbase + 512 * c + 32 * r + 4 * hf;
                    xr[d] = pre[8 * c + 4 * hf + r] * rstd * P.ln2_g[d] + P.ln2_b[d]; }
    }
}

#define XB_TMO      128
#define XB_XCNT(j)  (256  + 64 * (j))
#define XB_XSUB(j)  (1280 + 64 * (j))
#define XB_XGEN(j)  (2304 + 64 * (j))
#define XB_TOP      3328
#define XB_TOPGEN   3392
#define XCD_BAR_WORDS 3456
#define XB_SPIN_CAP (1u << 22)
__device__ __forceinline__ unsigned xb_ld(unsigned* p)              { return __hip_atomic_load(p, __ATOMIC_RELAXED, __HIP_MEMORY_SCOPE_AGENT); }
__device__ __forceinline__ unsigned xb_add(unsigned* p, unsigned v) { return __hip_atomic_fetch_add(p, v, __ATOMIC_RELAXED, __HIP_MEMORY_SCOPE_AGENT); }
#define XB_SPIN(cond, bar) do { unsigned _sp = 0; while (cond) { __builtin_amdgcn_s_sleep(1); \
    if ((++_sp & 255u) == 0u) { if (xb_ld(&(bar)[XB_TMO])) break; if (_sp > XB_SPIN_CAP) { atomicAdd(&(bar)[XB_TMO], 1u); break; } } } } while (0)
struct XcdBarrier { unsigned* bar; unsigned x; volatile LAS unsigned* st; };
__device__ __forceinline__ XcdBarrier xcd_barrier_post(unsigned* bar, volatile LAS unsigned* st) {
    XcdBarrier b; b.bar = bar; b.x = xcc_id(); b.st = st;
    if (threadIdx.x == 0) (void)xb_add(&bar[XB_XCNT(b.x)], 1u);
    return b;
}
__device__ __forceinline__ void xcd_barrier_complete(unsigned* bar, unsigned x, unsigned& nloc, unsigned& nx) {
    const unsigned G = gridDim.x * gridDim.y * gridDim.z;
    unsigned sum, cnt, mine, sp = 0u;
    for (;;) {
        sum = 0u; cnt = 0u; mine = 0u;
#pragma unroll
        for (unsigned j = 0; j < 16; ++j) { const unsigned c = xb_ld(&bar[XB_XCNT(j)]); sum += c; cnt += (c > 0u) ? 1u : 0u; mine = (j == x) ? c : mine; }
        if (sum == G) break;
        __builtin_amdgcn_s_sleep(1);
        if ((++sp & 255u) == 0u) { if (xb_ld(&bar[XB_TMO])) break; if (sp > XB_SPIN_CAP) { atomicAdd(&bar[XB_TMO], 1u); break; } }
    }
    nloc = mine > 0u ? mine : 1u; nx = cnt > 0u ? cnt : 1u;
}
__device__ __forceinline__ void xcd_barrier(const XcdBarrier& b) {
    asm volatile("s_waitcnt vmcnt(0)" ::: "memory");
    __syncthreads();
    if (threadIdx.x == 0) {
        unsigned* bar = b.bar;
        __builtin_amdgcn_s_waitcnt(0);
        unsigned nloc = b.st[0], nx = b.st[1];
        if (nloc == 0u) { xcd_barrier_complete(bar, b.x, nloc, nx); b.st[0] = nloc; b.st[1] = nx; }
        const unsigned old = xb_add(&bar[XB_XSUB(b.x)], 1u);
        const unsigned gen = old / nloc;
        if (old + 1u == (gen + 1u) * nloc) {
            __builtin_amdgcn_fence(__ATOMIC_RELEASE, "agent");
            asm volatile("s_waitcnt vmcnt(0)" ::: "memory");
            const unsigned og = xb_add(&bar[XB_TOP], 1u);
            const unsigned tg = og / nx;
            if (og + 1u == (tg + 1u) * nx) xb_add(&bar[XB_TOPGEN], 1u);
            else XB_SPIN(xb_ld(&bar[XB_TOPGEN]) == tg, bar);
            __builtin_amdgcn_fence(__ATOMIC_ACQUIRE, "agent");
            xb_add(&bar[XB_XGEN(b.x)], 1u);
            asm volatile("s_waitcnt vmcnt(0)" ::: "memory");
        } else {
            XB_SPIN(xb_ld(&bar[XB_XGEN(b.x)]) == gen, bar);
            __builtin_amdgcn_fence(__ATOMIC_ACQUIRE, "agent");
            asm volatile("s_waitcnt vmcnt(0)" ::: "memory");
        }
    }
    __syncthreads();
}

__global__ void __launch_bounds__(NTHR, 2) fwd_megakernel(Params P) {
    extern __shared__ __attribute__((aligned(16))) unsigned char shm[];
    LAS unsigned char* lds = (LAS unsigned char*)shm;
    cg::grid_group grid = cg::this_grid();
    const int G = gridDim.x, bid = blockIdx.x;
    volatile LAS unsigned* xst = (volatile LAS unsigned*)(lds + LDS_BYTES - 128);
    if (threadIdx.x == 0) { xst[0] = 0u; xst[1] = 0u; }
    __syncthreads();
    const XcdBarrier xb = xcd_barrier_post((unsigned*)(P.ws + OFF_BAR), xst);

#ifndef P3
#define P3 0xff
#endif
#ifndef PH
#define PH 0xff
#endif
    if (PH & 1) phase0a(P, lds);
    grid.sync();
    if (PH & 2) phase0b(P);
    xcd_barrier(xb);
    if (PH & 4) {
        pg8::Gemm g; g.A = (const bf16_t*)(P.ws + OFF_H); g.Bt = (const bf16_t*)(P.ws + OFF_WIN); g.M = NTOK; g.N = INCOLS; g.K = 1024;
        pg8::StaticOrder S; S.init(NTOK, INCOLS, G, bid);
        EpiProj E; E.ws = P.ws; E.lb = (const float*)(P.ws + OFF_LB); E.ng = P.hgrn_ng; E.kmean = (float*)(P.ws + OFF_KMEAN);
        pg8::gemm_phase<EpiProj, pg8::StaticOrder>(lds, g, S, E);
    }
    xcd_barrier(xb);
    if (PH & 8) for (int it = bid; it < 256; it += G) hgrn_item(P, it, lds);
    if (PH & 16) for (int u = bid; u < 2048; u += G) { const int bh = u & 255, jj = u >> 8; moba_unit(P, bh >> 3, bh & 7, (jj + bh) & 7, lds); }
    xcd_barrier(xb);
    if (PH & 32) for (int pm = bid; pm < NTOK / 256; pm += G) {
        if (P3 & 1) yb_norm_panel(P, pm);
        __syncthreads();
        if (P3 & 2) { pg8::Gemm g; g.A = (const bf16_t*)(P.ws + OFF_QA); g.Bt = (const bf16_t*)(P.ws + OFF_WBA); g.M = NTOK; g.N = 1024; g.K = 512;
          pg8::PanelOrder S; S.pm = pm; S.npn = 4; EpiMixA E; E.GA = (bf16_t*)(P.ws + OFF_GA);
          pg8::gemm_phase<EpiMixA, pg8::PanelOrder>(lds, g, S, E); }
        __syncthreads();
        if (P3 & 4) { pg8::Gemm g; g.A = (const bf16_t*)(P.ws + OFF_HI); g.Bt = (const bf16_t*)(P.ws + OFF_WBB); g.M = NTOK; g.N = 1024; g.K = 512;
          pg8::PanelOrder S; S.pm = pm; S.npn = 4; EpiMixB E; E.GA = (bf16_t*)(P.ws + OFF_GA); E.GB = (const bf16_t*)(P.ws + OFF_GB);
          pg8::gemm_phase<EpiMixB, pg8::PanelOrder>(lds, g, S, E); }
        __syncthreads();
        if (P3 & 8) { pg8::Gemm g; g.A = (const bf16_t*)(P.ws + OFF_GA); g.Bt = (const bf16_t*)(P.ws + OFF_WOUT); g.M = NTOK; g.N = 1024; g.K = 1024;
          pg8::PanelOrder S; S.pm = pm; S.npn = 4; EpiOut E; E.ada = (const float*)(P.ws + OFF_ADA); E.D = (bf16_t*)(P.ws + OFF_GB);
          pg8::gemm_phase<EpiOut, pg8::PanelOrder>(lds, g, S, E); }
        __syncthreads();
        if (P3 & 16) ln1_panel(P, pm);
        __syncthreads();
        if (P3 & 32) { pg8::Gemm g; g.A = (const bf16_t*)(P.ws + OFF_H); g.Bt = (const bf16_t*)(P.ws + OFF_WQ); g.M = NTOK; g.N = 1024; g.K = 1024;
          pg8::PanelOrder S; S.pm = pm; S.npn = 4; EpiBf16 E; E.O = (bf16_t*)(P.ws + OFF_GB);
          pg8::gemm_phase<EpiBf16, pg8::PanelOrder>(lds, g, S, E); }
        __syncthreads();
        { const size_t tok0 = (size_t)pm * 256 + (tid_opaque() >> 6) * 32;
          peer_select_wave(P, tok0);
          __syncthreads();
#pragma unroll 1
          for (int sb = 0; sb < 4; ++sb) {
              peer_u_tokens(P, lds, tok0 + 8 * sb);
              __syncthreads();
              peer_v_tokens(P, lds, tok0 + 8 * sb);
              __syncthreads();
          } }
    }
}

extern "C" void kernel_launch(void* const* d_in, const int* in_sizes, int n_in, void* d_out, int out_size, void* d_ws, size_t ws_size, hipStream_t stream) {
    static int grid_blocks = 0;
    if (grid_blocks == 0) {
        if (n_in != 18 || out_size != NTOK * DM || ws_size < WS_END) { fprintf(stderr, "kernel_launch: unexpected shapes (n_in %d, out %d, ws %zu, need %zu)\n", n_in, out_size, ws_size, (size_t)WS_END); grid_blocks = -1; return; }
        int dev = 0, cus = 0, per_cu = 0;
        hipGetDevice(&dev);
        hipDeviceGetAttribute(&cus, hipDeviceAttributeMultiprocessorCount, dev);
        if (hipFuncSetAttribute((const void*)fwd_megakernel, hipFuncAttributeMaxDynamicSharedMemorySize, LDS_BYTES) != hipSuccess) fprintf(stderr, "kernel_launch: hipFuncSetAttribute failed\n");
        hipOccupancyMaxActiveBlocksPerMultiprocessor(&per_cu, (const void*)fwd_megakernel, NTHR, LDS_BYTES);
        if (per_cu < 1) { fprintf(stderr, "kernel_launch: occupancy query says %d blocks per CU\n", per_cu); per_cu = 1; }
        if (per_cu > 1) per_cu = 1;
        grid_blocks = cus * per_cu;
        (void)hipGetLastError();
    }
    if (grid_blocks < 0) return;
    Params p{};
    p.x = (const float*)d_in[0]; p.c = (const float*)d_in[1]; p.w_ada = (const float*)d_in[2]; p.b_ada = (const float*)d_in[3]; p.w_in = (const float*)d_in[4];
    p.w_ba = (const float*)d_in[5]; p.w_bb = (const float*)d_in[6]; p.w_out = (const float*)d_in[7]; p.hgrn_lb = (const float*)d_in[8]; p.hgrn_ng = (const float*)d_in[9];
    p.ln1_g = (const float*)d_in[10]; p.ln1_b = (const float*)d_in[11]; p.peer_wq = (const float*)d_in[12]; p.peer_sk = (const float*)d_in[13]; p.peer_u = (const float*)d_in[14];
    p.peer_v = (const float*)d_in[15]; p.ln2_g = (const float*)d_in[16]; p.ln2_b = (const float*)d_in[17];
    p.out = (float*)d_out; p.ws = (unsigned char*)d_ws;
    if (hipMemsetAsync((char*)d_ws + OFF_BAR, 0, XCD_BAR_WORDS * 4, stream) != hipSuccess) fprintf(stderr, "kernel_launch: memset of the barrier words failed\n");
    void* args[] = {&p};
    hipError_t e = hipLaunchCooperativeKernel((const void*)fwd_megakernel, dim3(grid_blocks), dim3(NTHR), args, LDS_BYTES, stream);
    if (e != hipSuccess) fprintf(stderr, "cooperative launch failed: %s (grid %d)\n", hipGetErrorString(e), grid_blocks);
}
```

```cpp
#include <hip/hip_runtime.h>
#include <hip/hip_cooperative_groups.h>
#include <cstdio>
#include <cstdint>
#include <type_traits>
namespace cg = cooperative_groups;

#define LAS __attribute__((address_space(3)))
typedef unsigned short bf16_t;
typedef short bf16x8 __attribute__((ext_vector_type(8)));
typedef short s16x4 __attribute__((ext_vector_type(4)));
typedef float f32x2 __attribute__((ext_vector_type(2)));
typedef float f32x4 __attribute__((ext_vector_type(4)));
typedef float f32x16 __attribute__((ext_vector_type(16)));
typedef unsigned u32x2 __attribute__((ext_vector_type(2)));
typedef unsigned u32x4 __attribute__((ext_vector_type(4)));

constexpr int NB = 32, SEQ = 2048, DM = 1024, NTOK = NB * SEQ;
constexpr int INCOLS = 5632;
constexpr int NTHR = 512;
constexpr int LDS_BYTES = 147456;
constexpr float ALPHA = 1.189207115002721f;
constexpr float LN_EPS = 1e-5f, RMS_EPS = 1e-6f;
constexpr float LOG2E = 1.4426950408889634f;

constexpr size_t SZ_T512 = (size_t)NTOK * 512 * 2, SZ_T1024 = (size_t)NTOK * 1024 * 2;
constexpr size_t OFF_ADA = 0;
constexpr size_t OFF_LB = OFF_ADA + 786432;
constexpr size_t OFF_KMEAN = OFF_LB + 4096;
constexpr size_t OFF_WIN = OFF_KMEAN + 524288;
constexpr size_t OFF_WBA = OFF_WIN + (size_t)5632 * 1024 * 2;
constexpr size_t OFF_WBB = OFF_WBA + 1048576;
constexpr size_t OFF_WOUT = OFF_WBB + 1048576;
constexpr size_t OFF_WQ = OFF_WOUT + 2097152;
constexpr size_t OFF_SK = OFF_WQ + 2097152;
constexpr size_t OFF_U8 = OFF_SK + 262144;
constexpr size_t OFF_USC = OFF_U8 + 8388608;
constexpr size_t OFF_V8 = OFF_U8 + 16777216;
constexpr size_t OFF_VSC = OFF_V8 + 8388608;
constexpr size_t OFF_CTR = OFF_V8 + 16777216;
constexpr size_t OFF_BAR = OFF_CTR + 4096;
constexpr size_t OFF_EG = OFF_BAR + 16384;
constexpr size_t OFF_H = OFF_EG + (size_t)NTOK * 128 * 8;
constexpr size_t OFF_QA = OFF_H + SZ_T1024;
constexpr size_t OFF_KA = OFF_QA + SZ_T512;
constexpr size_t OFF_VA = OFF_KA + SZ_T512;
constexpr size_t OFF_HQ = OFF_VA + SZ_T512;
constexpr size_t OFF_HK = OFF_HQ + SZ_T512;
constexpr size_t OFF_HI = OFF_HK + SZ_T512;
constexpr size_t OFF_HG = OFF_HI + SZ_T512;
constexpr size_t OFF_GA = OFF_HG + SZ_T512;
constexpr size_t OFF_GB = OFF_GA + SZ_T1024;
constexpr size_t WS_END = OFF_GB + SZ_T1024;
constexpr size_t OFF_H8 = OFF_VA;
constexpr size_t OFF_HS = OFF_HQ;
constexpr size_t OFF_W = OFF_KA;
constexpr size_t OFF_Y = OFF_KA;

struct Params {
    const float *x, *c, *w_ada, *b_ada, *w_in, *w_ba, *w_bb, *w_out, *hgrn_lb, *hgrn_ng, *ln1_g, *ln1_b, *peer_wq, *peer_sk, *peer_u, *peer_v, *ln2_g, *ln2_b;
    float* out;
    unsigned char* ws;
};

typedef __bf16 bf16v2 __attribute__((ext_vector_type(2)));
__device__ __forceinline__ unsigned cvt_pk_bf16(float lo, float hi) { return __builtin_bit_cast(unsigned, __builtin_convertvector((f32x2){lo, hi}, bf16v2)); }
__device__ __forceinline__ float bf_lo(unsigned w) { return __uint_as_float(w << 16); }
__device__ __forceinline__ float bf_hi(unsigned w) { return __uint_as_float(w & 0xffff0000u); }
__device__ __forceinline__ float sigmoidf_(float x) { return 1.0f / (1.0f + __expf(-x)); }
__device__ __forceinline__ float wave_sum(float v) {
#pragma unroll
    for (int o = 1; o < 64; o <<= 1) v += __shfl_xor(v, o);
    return v;
}
__device__ __forceinline__ int tid_opaque() { int t = threadIdx.x; asm volatile("" : "+v"(t)); return t; }
__device__ __forceinline__ int crow(int r, int hi) { return (r & 3) + 8 * (r >> 2) + 4 * hi; }
#define MFMA32(a, b, c) __builtin_amdgcn_mfma_f32_32x32x16_bf16(a, b, c, 0, 0, 0)

namespace pg8 {
constexpr int BM = 256, BK = 64, HALF = 128, HTB = HALF * BK * 2, STAGE_BYTES = 8 * HTB, NXCD = 8, WGM = 8;
__host__ __device__ __forceinline__ int lds_byte(int r, int c) { const int st = (r >> 4) * 2 + (c >> 5), rr = r & 15, cc = c & 31, ob = rr * 64 + cc * 2; return st * 1024 + (ob ^ (((ob >> 9) & 1) << 5)); }
__host__ __device__ __forceinline__ void stage_rc(int b, int& R, int& C) { const int st = b / 1024, sb = b % 1024, swz = sb ^ (((sb >> 9) & 1) << 5); R = (st >> 1) * 16 + swz / 64; C = (st & 1) * 32 + (swz % 64) / 2; }
__host__ __device__ __forceinline__ int perm32(int rho) { const int n = rho >> 4, i = rho & 15; return 8 * (i >> 2) + 4 * n + (i & 3); }

struct Unit { int pm, pn; };
struct Gemm { const bf16_t* A; const bf16_t* Bt; int M, N, K; };

struct StaticOrder {
    int nM, nN, nwg, G, c;
    __device__ void init(int M, int N, int G_, int c_) { nM = M / BM; nN = N / BM; nwg = nM * nN; G = G_; c = c_; }
    __device__ bool next(int i, Unit& u) const {
        const long L = (long)i * G + c; if (L >= nwg) return false;
        int wgid = (int)L; { const int q = nwg / NXCD, r = nwg % NXCD, xcd = wgid % NXCD, off = wgid / NXCD; wgid = (xcd < r ? xcd * (q + 1) : r * (q + 1) + (xcd - r) * q) + off; }
        const int nig = WGM * nN, gid = wgid / nig, fm = gid * WGM, gsz = (nM - fm) < WGM ? (nM - fm) : WGM;
        u.pm = fm + ((wgid % nig) % gsz); u.pn = (wgid % nig) / gsz; return true;
    }
};
struct PanelOrder {
    int pm, npn;
    __device__ bool next(int i, Unit& u) const { if (i >= npn) return false; u.pm = pm; u.pn = i; return true; }
};

template <class Epi, class Sched, bool MX = false>
__device__ __forceinline__ void gemm_phase(LAS unsigned char* lds, const Gemm g, const Sched& S, const Epi& E) {
    const int tid = tid_opaque(), wid = __builtin_amdgcn_readfirstlane(tid >> 6), lane = tid & 63, wr = wid >> 2, wc = wid & 3, fr = lane & 15, fq = lane >> 4;
    const int K = g.K, nt = K / BK;
    unsigned voffA[2], voffB[2];
#pragma unroll
    for (int i = 0; i < 2; ++i) { int R, C; stage_rc(tid * 16 + i * 8192, R, C); const int Rb = Epi::PERM ? ((R & ~31) + perm32(R & 31)) : R;
        voffA[i] = (unsigned)(R * K + C) * 2u; voffB[i] = (unsigned)(Rb * K + C) * 2u; }
    const size_t kstep = (size_t)(BK * 2);
    const size_t hstep = (size_t)HALF * K * 2;
    const size_t tstep = 2 * hstep;
    const unsigned ldsw = (unsigned)wid * 1024u;
    const int aoff = lds_byte(wr * 64 + fr, fq * 8), boff = lds_byte(wc * 32 + fr, fq * 8);
#define PG8_SA(b, h) (((b) * 2 + (h)) * HTB)
#define PG8_SB(b, h) ((4 + (b) * 2 + (h)) * HTB)
#define PG8_STAGE(bufoff, gbase, voff) do { _Pragma("unroll") for (int _i = 0; _i < 2; ++_i) \
        __builtin_amdgcn_global_load_lds((const unsigned*)((const char*)(gbase) + (voff)[_i]), (LAS unsigned*)(lds + (bufoff) + ldsw + _i * 8192), 16, 0, 0); } while (0)
#define PG8_LDX(dst, off) do { const v4i_ lo_ = *(const LAS v4i_*)(lds + (off)), hi_ = *(const LAS v4i_*)(lds + (off) + 1024); dst = __builtin_shufflevector(lo_, hi_, 0, 1, 2, 3, 4, 5, 6, 7); } while (0)
#define PG8_LDA(dst, b, h) do { if constexpr (MX) { _Pragma("unroll") for (int m = 0; m < 4; ++m) PG8_LDX(dst##X[m], PG8_SA(b, h) + aoff + m * 2048); } \
        else { _Pragma("unroll") for (int m = 0; m < 4; ++m) _Pragma("unroll") for (int k = 0; k < 2; ++k) dst[m][k] = *(const LAS bf16x8*)(lds + PG8_SA(b, h) + aoff + m * 2048 + k * 1024); } } while (0)
#define PG8_LDB(dst, b, h) do { if constexpr (MX) { _Pragma("unroll") for (int n = 0; n < 2; ++n) PG8_LDX(dst##X[n], PG8_SB(b, h) + boff + n * 2048); } \
        else { _Pragma("unroll") for (int n = 0; n < 2; ++n) _Pragma("unroll") for (int k = 0; k < 2; ++k) dst[n][k] = *(const LAS bf16x8*)(lds + PG8_SB(b, h) + boff + n * 2048 + k * 1024); } } while (0)
#define PG8_MMA(ai, bj, At, Bt) do { __builtin_amdgcn_s_setprio(1); \
        if constexpr (MX) { _Pragma("unroll") for (int m = 0; m < 4; ++m) _Pragma("unroll") for (int n = 0; n < 2; ++n) \
            asm volatile("v_mfma_scale_f32_16x16x128_f8f6f4 %0, %1, %2, %0, %3, %3 op_sel_hi:[0,0,0]" : "+v"(acc[ai][bj][m][n]) : "v"(Bt##X[n]), "v"(At##X[m]), "v"(mxscale)); } \
        else { _Pragma("unroll") for (int m = 0; m < 4; ++m) _Pragma("unroll") for (int n = 0; n < 2; ++n) _Pragma("unroll") for (int k = 0; k < 2; ++k) \
            acc[ai][bj][m][n] = __builtin_amdgcn_mfma_f32_16x16x32_bf16(Bt[n][k], At[m][k], acc[ai][bj][m][n], 0, 0, 0); } \
        __builtin_amdgcn_s_setprio(0); } while (0)
#define PG8_WAIT_V(n) asm volatile("s_waitcnt vmcnt(" #n ")" ::: "memory")
#define PG8_WAIT_L(n) asm volatile("s_waitcnt lgkmcnt(" #n ")" ::: "memory")
#define PG8_BAR __builtin_amdgcn_s_barrier()
#define PG8_SCHED __builtin_amdgcn_sched_barrier(0)
    Unit cur, nxt; int ui = 0;
    if (!S.next(0, cur)) return;
    f32x4 acc[2][2][4][2];
#pragma unroll
    for (int a = 0; a < 2; ++a)
#pragma unroll
        for (int b = 0; b < 2; ++b)
#pragma unroll
            for (int m = 0; m < 4; ++m)
#pragma unroll
                for (int n = 0; n < 2; ++n) acc[a][b][m][n] = (f32x4){0.f, 0.f, 0.f, 0.f};
    typedef int v4i_ __attribute__((ext_vector_type(4))); typedef int v8i_ __attribute__((ext_vector_type(8)));
    bf16x8 At[4][2], B0[2][2], B1[2][2];
    v8i_ AtX[4], B0X[2], B1X[2];
    const int mxscale = 0x7f7f7f7f;
    const char* cA = (const char*)g.A + (size_t)cur.pm * tstep; const char* cB = (const char*)g.Bt + (size_t)cur.pn * tstep;
    PG8_STAGE(PG8_SB(0, 0), cB, voffB); PG8_STAGE(PG8_SA(0, 0), cA, voffA); PG8_STAGE(PG8_SB(0, 1), cB + hstep, voffB); PG8_STAGE(PG8_SA(0, 1), cA + hstep, voffA);
    if (wr == 1) PG8_BAR;
    PG8_WAIT_V(4); PG8_BAR;
    PG8_STAGE(PG8_SB(1, 0), cB + kstep, voffB); PG8_STAGE(PG8_SA(1, 0), cA + kstep, voffA); PG8_STAGE(PG8_SB(1, 1), cB + hstep + kstep, voffB);
    PG8_WAIT_V(6); PG8_BAR;
    for (;;) {
        const bool has_next = S.next(ui + 1, nxt);
        const char* nA = has_next ? (const char*)g.A + (size_t)nxt.pm * tstep : cA; const char* nB = has_next ? (const char*)g.Bt + (size_t)nxt.pn * tstep : cB;
        for (int t = 0; t < nt; t += 2) {
            const bool last = (t == nt - 2);
            const char* a1 = cA + (size_t)(t + 1) * kstep;
            const char* a2 = last ? nA : cA + (size_t)(t + 2) * kstep; const char* b2 = last ? nB : cB + (size_t)(t + 2) * kstep;
            const char* a3 = a2 + kstep; const char* b3 = b2 + kstep;
            PG8_LDB(B0, 0, 0); PG8_SCHED; PG8_LDA(At, 0, 0); PG8_STAGE(PG8_SA(1, 1), a1 + hstep, voffA);
            PG8_WAIT_L(8); PG8_BAR; PG8_WAIT_L(0); PG8_MMA(0, 0, At, B0); PG8_BAR; PG8_SCHED;
            PG8_LDB(B1, 0, 1); PG8_STAGE(PG8_SB(0, 0), b2, voffB);
            PG8_BAR; PG8_WAIT_L(0); PG8_MMA(0, 1, At, B1); PG8_BAR;
            PG8_LDA(At, 0, 1); PG8_STAGE(PG8_SA(0, 0), a2, voffA);
            PG8_BAR; PG8_WAIT_L(0); PG8_MMA(1, 0, At, B0); PG8_BAR; PG8_SCHED;
            PG8_STAGE(PG8_SB(0, 1), b2 + hstep, voffB);
            PG8_WAIT_V(6); PG8_BAR; PG8_MMA(1, 1, At, B1); PG8_BAR;
            PG8_LDB(B0, 1, 0); PG8_SCHED; PG8_LDA(At, 1, 0); PG8_STAGE(PG8_SA(0, 1), a2 + hstep, voffA);
            PG8_WAIT_L(8); PG8_BAR; PG8_WAIT_L(0); PG8_MMA(0, 0, At, B0); PG8_BAR; PG8_SCHED;
            PG8_LDB(B1, 1, 1); PG8_STAGE(PG8_SB(1, 0), b3, voffB);
            PG8_BAR; PG8_WAIT_L(0); PG8_MMA(0, 1, At, B1); PG8_BAR;
            PG8_LDA(At, 1, 1); PG8_STAGE(PG8_SA(1, 0), a3, voffA);
            PG8_BAR; PG8_WAIT_L(0); PG8_MMA(1, 0, At, B0); PG8_BAR; PG8_SCHED;
            PG8_STAGE(PG8_SB(1, 1), b3 + hstep, voffB);
            PG8_WAIT_V(6); PG8_BAR; PG8_MMA(1, 1, At, B1); PG8_BAR;
        }
        if constexpr (MX) asm volatile("s_nop 15\n\ts_nop 15" ::: "memory");
        E(acc, cur, wr, wc, fr, fq);
        if (!has_next) break;
#pragma unroll
        for (int a = 0; a < 2; ++a)
#pragma unroll
            for (int b = 0; b < 2; ++b)
#pragma unroll
                for (int m = 0; m < 4; ++m)
#pragma unroll
                    for (int n = 0; n < 2; ++n) acc[a][b][m][n] = (f32x4){0.f, 0.f, 0.f, 0.f};
        cur = nxt; cA = nA; cB = nB; ++ui;
    }
    PG8_WAIT_V(0);
    if (wr == 0) PG8_BAR;
    PG8_BAR;
#undef PG8_SA
#undef PG8_SB
#undef PG8_STAGE
#undef PG8_LDX
#undef PG8_LDA
#undef PG8_LDB
#undef PG8_MMA
#undef PG8_WAIT_V
#undef PG8_WAIT_L
#undef PG8_BAR
#undef PG8_SCHED
}
}
using pg8::Unit;

struct EpiProj {
    static constexpr bool PERM = true;
    unsigned char* ws; const float* lb; const float* ng; float* kmean;
    __device__ __forceinline__ void operator()(const f32x4 (&acc)[2][2][4][2], const Unit& u, int wr, int wc, int fr, int fq) const {
        const int pn = u.pn; int seg, colt, ldc; size_t boff;
        if (pn < 14) { seg = pn >> 1; colt = (pn & 1) * 256; ldc = 512; boff = OFF_QA + (size_t)seg * SZ_T512; }
        else if (pn < 18) { seg = 7; colt = (pn - 14) * 256; ldc = 1024; boff = OFF_GA; }
        else { seg = 8; colt = (pn - 18) * 256; ldc = 1024; boff = OFF_GB; }
        bf16_t* base = (bf16_t*)(ws + boff);
        const int row0 = u.pm * 256 + wr * 64 + fr, col0 = colt + wc * 32 + 8 * fq;
        float pv[2][8];
#pragma unroll
        for (int bj = 0; bj < 2; ++bj)
#pragma unroll
            for (int e = 0; e < 8; ++e) pv[bj][e] = (seg == 4) ? (1.0f - lb[col0 + bj * 128 + e]) : ((seg == 6) ? ng[col0 + bj * 128 + e] : 0.f);
        float cs[2][8];
#pragma unroll
        for (int bj = 0; bj < 2; ++bj)
#pragma unroll
            for (int e = 0; e < 8; ++e) cs[bj][e] = 0.f;
#pragma unroll
        for (int ai = 0; ai < 2; ++ai)
#pragma unroll
            for (int m = 0; m < 4; ++m) {
                bf16_t* rowp = base + (size_t)(row0 + ai * 128 + m * 16) * ldc + col0;
#pragma unroll
                for (int bj = 0; bj < 2; ++bj) {
                    float v[8];
#pragma unroll
                    for (int e = 0; e < 4; ++e) { v[e] = acc[ai][bj][m][0][e] * (1.0f / 32.0f); v[4 + e] = acc[ai][bj][m][1][e] * (1.0f / 32.0f); }
                    if (seg == 0) {
#pragma unroll
                        for (int e = 0; e < 8; ++e) v[e] *= (0.125f * LOG2E);
                    } else if (seg == 1) {
#pragma unroll
                        for (int e = 0; e < 8; ++e) cs[bj][e] += v[e];
                    } else if (seg == 3) {
#pragma unroll
                        for (int e = 0; e < 8; ++e) v[e] = v[e] * sigmoidf_(v[e]);
                    } else if (seg == 4) {
#pragma unroll
                        for (int e = 0; e < 8; ++e) v[e] = pv[bj][e] * sigmoidf_(-v[e]);
                    } else if (seg == 6) {
#pragma unroll
                        for (int e = 0; e < 8; ++e) v[e] = pv[bj][e] * v[e] * sigmoidf_(v[e]);
                    } else if (seg >= 7) {
#pragma unroll
                        for (int e = 0; e < 8; ++e) v[e] = sigmoidf_(v[e]);
                    }
                    u32x4 w; w.x = cvt_pk_bf16(v[0], v[1]); w.y = cvt_pk_bf16(v[2], v[3]); w.z = cvt_pk_bf16(v[4], v[5]); w.w = cvt_pk_bf16(v[6], v[7]);
                    *(u32x4*)(rowp + bj * 128) = w;
                }
            }
        if (seg == 1) {
#pragma unroll
            for (int bj = 0; bj < 2; ++bj)
#pragma unroll
                for (int e = 0; e < 8; ++e) {
                    float s = cs[bj][e];
                    s += __shfl_xor(s, 1); s += __shfl_xor(s, 2); s += __shfl_xor(s, 4); s += __shfl_xor(s, 8);
                    if (fr == 0) atomicAdd(kmean + (size_t)u.pm * 512 + col0 + bj * 128 + e, s);
                }
        }
    }
};
struct EpiMixA {
    static constexpr bool PERM = true;
    bf16_t* GA;
    __device__ __forceinline__ void operator()(const f32x4 (&acc)[2][2][4][2], const Unit& u, int wr, int wc, int fr, int fq) const {
        const int row0 = u.pm * 256 + wr * 64 + fr, col0 = u.pn * 256 + wc * 32 + 8 * fq;
#pragma unroll
        for (int ai = 0; ai < 2; ++ai)
#pragma unroll
            for (int m = 0; m < 4; ++m) {
                bf16_t* rowp = GA + (size_t)(row0 + ai * 128 + m * 16) * 1024 + col0;
#pragma unroll
                for (int bj = 0; bj < 2; ++bj) {
                    const u32x4 g = *(const u32x4*)(rowp + bj * 128);
                    const f32x4 a0 = acc[ai][bj][m][0], a1 = acc[ai][bj][m][1];
                    u32x4 w;
                    w.x = cvt_pk_bf16(bf_lo(g.x) * a0[0], bf_hi(g.x) * a0[1]); w.y = cvt_pk_bf16(bf_lo(g.y) * a0[2], bf_hi(g.y) * a0[3]);
                    w.z = cvt_pk_bf16(bf_lo(g.z) * a1[0], bf_hi(g.z) * a1[1]); w.w = cvt_pk_bf16(bf_lo(g.w) * a1[2], bf_hi(g.w) * a1[3]);
                    *(u32x4*)(rowp + bj * 128) = w;
                }
            }
    }
};
struct EpiMixB {
    static constexpr bool PERM = true;
    bf16_t* GA; const bf16_t* GB;
    __device__ __forceinline__ void operator()(const f32x4 (&acc)[2][2][4][2], const Unit& u, int wr, int wc, int fr, int fq) const {
        const int row0 = u.pm * 256 + wr * 64 + fr, col0 = u.pn * 256 + wc * 32 + 8 * fq;
#pragma unroll
        for (int ai = 0; ai < 2; ++ai)
#pragma unroll
            for (int m = 0; m < 4; ++m) {
                const size_t off = (size_t)(row0 + ai * 128 + m * 16) * 1024 + col0;
#pragma unroll
                for (int bj = 0; bj < 2; ++bj) {
                    const u32x4 g = *(const u32x4*)(GB + off + bj * 128);
                    const u32x4 mx = *(const u32x4*)(GA + off + bj * 128);
                    const f32x4 a0 = acc[ai][bj][m][0], a1 = acc[ai][bj][m][1];
                    u32x4 w;
                    w.x = cvt_pk_bf16(bf_lo(mx.x) + bf_lo(g.x) * a0[0], bf_hi(mx.x) + bf_hi(g.x) * a0[1]); w.y = cvt_pk_bf16(bf_lo(mx.y) + bf_lo(g.y) * a0[2], bf_hi(mx.y) + bf_hi(g.y) * a0[3]);
                    w.z = cvt_pk_bf16(bf_lo(mx.z) + bf_lo(g.z) * a1[0], bf_hi(mx.z) + bf_hi(g.z) * a1[1]); w.w = cvt_pk_bf16(bf_lo(mx.w) + bf_lo(g.w) * a1[2], bf_hi(mx.w) + bf_hi(g.w) * a1[3]);
                    *(u32x4*)(GA + off + bj * 128) = w;
                }
            }
    }
};
struct EpiOut {
    static constexpr bool PERM = true;
    const float* ada; bf16_t* D;
    __device__ __forceinline__ void operator()(const f32x4 (&acc)[2][2][4][2], const Unit& u, int wr, int wc, int fr, int fq) const {
        const int row0 = u.pm * 256 + wr * 64 + fr, col0 = u.pn * 256 + wc * 32 + 8 * fq;
        const float* gt1 = ada + (size_t)(u.pm >> 3) * 6144 + 2048 + col0;
        f32x4 g[2][2];
#pragma unroll
        for (int bj = 0; bj < 2; ++bj) { g[bj][0] = *(const f32x4*)(gt1 + bj * 128); g[bj][1] = *(const f32x4*)(gt1 + bj * 128 + 4); }
#pragma unroll
        for (int ai = 0; ai < 2; ++ai)
#pragma unroll
            for (int m = 0; m < 4; ++m) {
                bf16_t* rowp = D + (size_t)(row0 + ai * 128 + m * 16) * 1024 + col0;
#pragma unroll
                for (int bj = 0; bj < 2; ++bj) {
                    const f32x4 a0 = acc[ai][bj][m][0] * g[bj][0], a1 = acc[ai][bj][m][1] * g[bj][1];
                    u32x4 w; w.x = cvt_pk_bf16(a0[0], a0[1]); w.y = cvt_pk_bf16(a0[2], a0[3]); w.z = cvt_pk_bf16(a1[0], a1[1]); w.w = cvt_pk_bf16(a1[2], a1[3]);
                    *(u32x4*)(rowp + bj * 128) = w;
                }
            }
    }
};
struct EpiBf16 {
    static constexpr bool PERM = true;
    bf16_t* O;
    __device__ __forceinline__ void operator()(const f32x4 (&acc)[2][2][4][2], const Unit& u, int wr, int wc, int fr, int fq) const {
        const int row0 = u.pm * 256 + wr * 64 + fr, col0 = u.pn * 256 + wc * 32 + 8 * fq;
#pragma unroll
        for (int ai = 0; ai < 2; ++ai)
#pragma unroll
            for (int m = 0; m < 4; ++m) {
                bf16_t* rowp = O + (size_t)(row0 + ai * 128 + m * 16) * 1024 + col0;
#pragma unroll
                for (int bj = 0; bj < 2; ++bj) {
                    const f32x4 a0 = acc[ai][bj][m][0], a1 = acc[ai][bj][m][1];
                    u32x4 w; w.x = cvt_pk_bf16(a0[0], a0[1]); w.y = cvt_pk_bf16(a0[2], a0[3]); w.z = cvt_pk_bf16(a1[0], a1[1]); w.w = cvt_pk_bf16(a1[2], a1[3]);
                    *(u32x4*)(rowp + bj * 128) = w;
                }
            }
    }
};

__device__ void phase0a(const Params& P, LAS unsigned char* lds) {
    const int tid = tid_opaque(), G = gridDim.x, bid = blockIdx.x;
    for (int it = bid; it < 192; it += G) {
        LAS float* sc = (LAS float*)lds;
        for (int i = tid; i < 32 * 1024; i += NTHR) { const float cv = P.c[i]; sc[i] = cv * sigmoidf_(cv); }
        __syncthreads();
        const int kg = tid >> 5, col = tid & 31;
        float a[32];
#pragma unroll
        for (int b = 0; b < 32; ++b) a[b] = 0.f;
#pragma unroll 1
        for (int k = kg * 64; k < kg * 64 + 64; k += 8) {
            float w[8];
#pragma unroll
            for (int e = 0; e < 8; ++e) w[e] = __builtin_nontemporal_load(P.w_ada + (size_t)(k + e) * 6144 + it * 32 + col);
#pragma unroll
            for (int e4 = 0; e4 < 2; ++e4) {
#pragma unroll
                for (int b = 0; b < 32; ++b) { const f32x4 s = *(const LAS f32x4*)(sc + b * 1024 + k + 4 * e4); a[b] += s[0] * w[4 * e4] + s[1] * w[4 * e4 + 1] + s[2] * w[4 * e4 + 2] + s[3] * w[4 * e4 + 3]; }
                asm volatile("" ::: "memory");
            }
        }
        __syncthreads();
        LAS float* red = (LAS float*)lds;
#pragma unroll
        for (int b = 0; b < 32; ++b) red[(kg * 32 + b) * 32 + col] = a[b];
        __syncthreads();
        for (int o = tid; o < 1024; o += NTHR) { const int b = o >> 5, cc = o & 31; float s = 0.f;
#pragma unroll
            for (int g2 = 0; g2 < 16; ++g2) s += red[(g2 * 32 + b) * 32 + cc];
            ((float*)(P.ws + OFF_ADA))[(size_t)b * 6144 + it * 32 + cc] = s + P.b_ada[it * 32 + cc]; }
        __syncthreads();
    }
    const size_t gsz = (size_t)G * NTHR;
    { const int gt = bid * NTHR + tid, gs = G * NTHR;
      if (gt < 512) ((float*)(P.ws + OFF_LB))[gt] = sigmoidf_(P.hgrn_lb[gt] - P.hgrn_lb[512 + gt]);
      for (int i = gt; i < 32 * 8 * 512; i += gs) ((float*)(P.ws + OFF_KMEAN))[i] = 0.f; }
    {
        LAS float* tile = (LAS float*)lds;
        const int I0 = 16 * 88, I1 = I0 + 8 * 16, I2 = I1 + 8 * 16, I3 = I2 + 16 * 16, I4 = I3 + 16 * 16;
        for (int it = bid; it < I4; it += G) {
            const float* W; bf16_t* WT; int K, N, r;
            if (it < I0) { W = P.w_in; WT = (bf16_t*)(P.ws + OFF_WIN); K = 1024; N = 5632; r = it; }
            else if (it < I1) { W = P.w_ba; WT = (bf16_t*)(P.ws + OFF_WBA); K = 512; N = 1024; r = it - I0; }
            else if (it < I2) { W = P.w_bb; WT = (bf16_t*)(P.ws + OFF_WBB); K = 512; N = 1024; r = it - I1; }
            else if (it < I3) { W = P.w_out; WT = (bf16_t*)(P.ws + OFF_WOUT); K = 1024; N = 1024; r = it - I2; }
            else { W = P.peer_wq; WT = (bf16_t*)(P.ws + OFF_WQ); K = 1024; N = 1024; r = it - I3; }
            const int nb = N / 64, k0 = (r / nb) * 64, n0 = (r % nb) * 64;
#pragma unroll
            for (int ps = 0; ps < 2; ++ps) { const int kk = (tid >> 4) + 32 * ps, n4 = (tid & 15) * 4;
                const f32x4 v = *(const f32x4*)(W + (size_t)(k0 + kk) * N + n0 + n4);
                tile[kk * 65 + n4] = v[0]; tile[kk * 65 + n4 + 1] = v[1]; tile[kk * 65 + n4 + 2] = v[2]; tile[kk * 65 + n4 + 3] = v[3]; }
            __syncthreads();
            { const int n = tid >> 3, kc = (tid & 7) * 8;
              if (it < I0) {
                  int w0 = __builtin_amdgcn_cvt_pk_fp8_f32(32.f * tile[(kc + 0) * 65 + n], 32.f * tile[(kc + 1) * 65 + n], 0, false); w0 = __builtin_amdgcn_cvt_pk_fp8_f32(32.f * tile[(kc + 2) * 65 + n], 32.f * tile[(kc + 3) * 65 + n], w0, true);
                  int w1 = __builtin_amdgcn_cvt_pk_fp8_f32(32.f * tile[(kc + 4) * 65 + n], 32.f * tile[(kc + 5) * 65 + n], 0, false); w1 = __builtin_amdgcn_cvt_pk_fp8_f32(32.f * tile[(kc + 6) * 65 + n], 32.f * tile[(kc + 7) * 65 + n], w1, true);
                  *(u32x2*)((unsigned char*)WT + (size_t)(n0 + n) * K + k0 + kc) = (u32x2){(unsigned)w0, (unsigned)w1};
              } else { u32x4 w;
              w.x = cvt_pk_bf16(tile[(kc + 0) * 65 + n], tile[(kc + 1) * 65 + n]); w.y = cvt_pk_bf16(tile[(kc + 2) * 65 + n], tile[(kc + 3) * 65 + n]);
              w.z = cvt_pk_bf16(tile[(kc + 4) * 65 + n], tile[(kc + 5) * 65 + n]); w.w = cvt_pk_bf16(tile[(kc + 6) * 65 + n], tile[(kc + 7) * 65 + n]);
              *(u32x4*)(WT + (size_t)(n0 + n) * K + k0 + kc) = w; } }
            __syncthreads();
        }
    }
    {
        const size_t gtid = (size_t)bid * NTHR + tid_opaque();
        for (size_t i = gtid; i < 16384; i += gsz) {
            const float* src = P.peer_sk + i * 8; const f32x4 a = *(const f32x4*)src, b = *(const f32x4*)(src + 4);
            u32x4 w; w.x = cvt_pk_bf16(a[0], a[1]); w.y = cvt_pk_bf16(a[2], a[3]); w.z = cvt_pk_bf16(b[0], b[1]); w.w = cvt_pk_bf16(b[2], b[3]);
            *(u32x4*)((bf16_t*)(P.ws + OFF_SK) + i * 8) = w;
        }
        { const int lane = tid & 63, gw = bid * 8 + (tid >> 6), ngw = G * 8;
          for (int r = gw; r < 2 * 16384; r += ngw) {
              const bool isv = r >= 16384; const int e = isv ? r - 16384 : r;
              const float* s = (isv ? P.peer_v : P.peer_u) + (size_t)e * 1024 + lane * 16;
              f32x4 x[4]; float ss = 0.f;
#pragma unroll
              for (int q = 0; q < 4; ++q) { x[q] = __builtin_nontemporal_load((const f32x4*)(s + 4 * q)); ss += (x[q][0] * x[q][0] + x[q][1] * x[q][1]) + (x[q][2] * x[q][2] + x[q][3] * x[q][3]); }
              const float sc = fmaxf(sqrtf(wave_sum(ss) * (1.0f / 1024.0f)) * (2.6f / 7.5f), 1e-30f), inv = 1.0f / sc;
              unsigned nb[16];
#pragma unroll
              for (int q = 0; q < 4; ++q)
#pragma unroll
                  for (int el = 0; el < 4; ++el) nb[4 * q + el] = (unsigned)fminf(fmaxf(floorf(x[q][el] * inv) + 8.0f, 0.0f), 15.0f);
              u32x2 w;
              w.x = (nb[0] | (nb[4] << 4)) | ((nb[1] | (nb[5] << 4)) << 8) | ((nb[2] | (nb[6] << 4)) << 16) | ((nb[3] | (nb[7] << 4)) << 24);
              w.y = (nb[8] | (nb[12] << 4)) | ((nb[9] | (nb[13] << 4)) << 8) | ((nb[10] | (nb[14] << 4)) << 16) | ((nb[11] | (nb[15] << 4)) << 24);
              *(u32x2*)(P.ws + (isv ? OFF_V8 : OFF_U8) + (size_t)e * 512 + lane * 8) = w;
              if (lane == 0) ((float*)(P.ws + (isv ? OFF_VSC : OFF_USC)))[e] = sc;
          } }
    }
}
__device__ void phase0b(const Params& P) {
    const size_t gtid = (size_t)blockIdx.x * NTHR + threadIdx.x, gsz = (size_t)gridDim.x * NTHR;
    const float* ada = (const float*)(P.ws + OFF_ADA); bf16_t* H = (bf16_t*)(P.ws + OFF_H);
    for (size_t i = gtid; i < (size_t)NTOK * 128; i += gsz) {
        const size_t row = i >> 7; const int c8 = (int)(i & 127) * 8; const int b = (int)(row >> 11);
        const float* xr = P.x + row * 1024 + c8; const float* sh = ada + (size_t)b * 6144 + c8; const float* sc = sh + 1024;
        const f32x4 x0 = *(const f32x4*)xr, x1 = *(const f32x4*)(xr + 4), s0 = *(const f32x4*)sc, s1 = *(const f32x4*)(sc + 4), h0 = *(const f32x4*)sh, h1 = *(const f32x4*)(sh + 4);
        const f32x4 r0 = x0 * (s0 + 1.0f) + h0, r1 = x1 * (s1 + 1.0f) + h1;
        int w0 = __builtin_amdgcn_cvt_pk_fp8_f32(r0[0], r0[1], 0, false); w0 = __builtin_amdgcn_cvt_pk_fp8_f32(r0[2], r0[3], w0, true);
        int w1 = __builtin_amdgcn_cvt_pk_fp8_f32(r1[0], r1[1], 0, false); w1 = __builtin_amdgcn_cvt_pk_fp8_f32(r1[2], r1[3], w1, true);
        *(u32x2*)((unsigned char*)H + row * 1024 + c8) = (u32x2){(unsigned)w0, (unsigned)w1};
    }
}

__device__ __forceinline__ s16x4 tr4(const LAS unsigned char* p) { return __builtin_bit_cast(s16x4, __builtin_amdgcn_ds_read_tr16_b64_v4i16((LAS s16x4*)p)); }
__device__ void hgrn_item(const Params& P, int item, LAS unsigned char* lds) {
    const int tid = tid_opaque(), lane = tid & 63, wid = __builtin_amdgcn_readfirstlane(tid >> 6), r32 = lane & 31, hi = lane >> 5;
    const int b = item >> 3, h = (item >> 1) & 3, vh = item & 1;
    const bf16_t* HQ = (const bf16_t*)(P.ws + OFF_HQ); const bf16_t* HK = (const bf16_t*)(P.ws + OFF_HK); bf16_t* HI = (bf16_t*)(P.ws + OFF_HI);
    constexpr int SQ = 272, SKD = 320, SV = 192, SS = 192;
    constexpr int LQR = 0, LKR = 17408, LQB = 34816, LKD = 52224, LV = 72704, LS = 84992, LG = 109568, LT = 142336, LCL = 144384;
    LAS float* G = (LAS float*)(lds + LG); LAS float* TOT = (LAS float*)(lds + LT); LAS float* CL = (LAS float*)(lds + LCL);
    const size_t rowb = (size_t)b * SEQ;
    const int row = tid >> 3, seg = tid & 7;
    const bf16_t* qsrc = HQ + (rowb + row) * 512 + h * 128 + seg * 16; const bf16_t* ksrc = HK + (rowb + row) * 512 + h * 128 + seg * 16;
    bf16_t* vsrc = HI + (rowb + row) * 512 + h * 128 + vh * 64 + seg * 8;
    for (int i = tid; i < 128 * SS / 4; i += NTHR) ((LAS unsigned*)(lds + LS))[i] = 0u;
    f32x16 Sacc = {};
    const int di = wid >> 1, vi = wid & 1, ti = wid >> 1;
    const int tg = lane >> 4, tc = tg & 1, tI = lane & 15;
    const int trow = 4 * hi + (tI >> 2), tcol = 16 * tc + 4 * (tI & 3);
    u32x4 qn0 = *(const u32x4*)qsrc, qn1 = *(const u32x4*)(qsrc + 8), kn0 = *(const u32x4*)ksrc, kn1 = *(const u32x4*)(ksrc + 8), vn = *(const u32x4*)vsrc;
#pragma unroll 1
    for (int n = 0; n < SEQ / 64; ++n) {
        const u32x4 q0 = qn0, q1 = qn1, k0 = kn0, k1 = kn1, vv = vn;
        float qf[16] = {bf_lo(q0.x), bf_hi(q0.x), bf_lo(q0.y), bf_hi(q0.y), bf_lo(q0.z), bf_hi(q0.z), bf_lo(q0.w), bf_hi(q0.w), bf_lo(q1.x), bf_hi(q1.x), bf_lo(q1.y), bf_hi(q1.y), bf_lo(q1.z), bf_hi(q1.z), bf_lo(q1.w), bf_hi(q1.w)};
        float kf[16] = {bf_lo(k0.x), bf_hi(k0.x), bf_lo(k0.y), bf_hi(k0.y), bf_lo(k0.z), bf_hi(k0.z), bf_lo(k0.w), bf_hi(k0.w), bf_lo(k1.x), bf_hi(k1.x), bf_lo(k1.y), bf_hi(k1.y), bf_lo(k1.z), bf_hi(k1.z), bf_lo(k1.w), bf_hi(k1.w)};
#pragma unroll
        for (int e4 = 0; e4 < 4; ++e4) *(LAS f32x4*)(G + row * 128 + seg * 16 + 4 * e4) = (f32x4){__logf(1.0f - kf[4 * e4]), __logf(1.0f - kf[4 * e4 + 1]), __logf(1.0f - kf[4 * e4 + 2]), __logf(1.0f - kf[4 * e4 + 3])};
        *(LAS u32x4*)(lds + LV + row * SV + seg * 16) = vv;
        if (n + 1 < SEQ / 64) { const size_t o = (size_t)(n + 1) * 64 * 512; qn0 = *(const u32x4*)(qsrc + o); qn1 = *(const u32x4*)(qsrc + o + 8); kn0 = *(const u32x4*)(ksrc + o); kn1 = *(const u32x4*)(ksrc + o + 8); vn = *(const u32x4*)(vsrc + o); }
        __syncthreads();
        { const int d = tid & 127, q4 = tid >> 7; float s = 0.f;
#pragma unroll
          for (int i = 0; i < 16; ++i) { s += G[(16 * q4 + i) * 128 + d]; G[(16 * q4 + i) * 128 + d] = s; }
          TOT[q4 * 128 + d] = s; }
        __syncthreads();
        {
            const int qq = row >> 4;
#pragma unroll
            for (int e4 = 0; e4 < 4; ++e4) {
                const int d4 = seg * 16 + 4 * e4;
                const f32x4 t0 = *(const LAS f32x4*)(TOT + d4), t1 = *(const LAS f32x4*)(TOT + 128 + d4), t2 = *(const LAS f32x4*)(TOT + 256 + d4), t3 = *(const LAS f32x4*)(TOT + 384 + d4);
                const f32x4 off = (qq == 0) ? (f32x4){0.f, 0.f, 0.f, 0.f} : ((qq == 1) ? t0 : ((qq == 2) ? t0 + t1 : t0 + t1 + t2));
                const f32x4 bb = *(const LAS f32x4*)(G + row * 128 + d4) + off;
                const f32x4 bref = *(const LAS f32x4*)(G + 32 * 128 + d4) + t0 + t1, blast = t0 + t1 + t2 + t3;
                float vqb[4], vqr[4], vkr[4], vkd[4];
#pragma unroll
                for (int e = 0; e < 4; ++e) {
                    const float e1 = __expf(bb[e]), e2 = __expf(-bb[e]);
                    vqb[e] = qf[4 * e4 + e] * e1; vqr[e] = vqb[e] * __expf(-bref[e]);
                    const float ke = kf[4 * e4 + e] * e2; vkr[e] = ke * __expf(bref[e]); vkd[e] = ke * __expf(blast[e]);
                }
                *(LAS u32x2*)(lds + LQB + row * SQ + seg * 32 + 8 * e4) = (u32x2){cvt_pk_bf16(vqb[0], vqb[1]), cvt_pk_bf16(vqb[2], vqb[3])};
                *(LAS u32x2*)(lds + LQR + row * SQ + seg * 32 + 8 * e4) = (u32x2){cvt_pk_bf16(vqr[0], vqr[1]), cvt_pk_bf16(vqr[2], vqr[3])};
                *(LAS u32x2*)(lds + LKR + row * SQ + seg * 32 + 8 * e4) = (u32x2){cvt_pk_bf16(vkr[0], vkr[1]), cvt_pk_bf16(vkr[2], vkr[3])};
                *(LAS u32x2*)(lds + LKD + row * SKD + seg * 32 + 8 * e4) = (u32x2){cvt_pk_bf16(vkd[0], vkd[1]), cvt_pk_bf16(vkd[2], vkd[3])};
                if (row == 0) *(LAS f32x4*)(CL + d4) = (f32x4){__expf(blast[0]), __expf(blast[1]), __expf(blast[2]), __expf(blast[3])};
                asm volatile("" ::: "memory");
            }
        }
        __syncthreads();
        if (wid < 4) {
            f32x16 Z = {};
            for (int si = 0; si <= ti; ++si) {
                f32x16 X = {};
#pragma unroll
                for (int ks = 0; ks < 8; ++ks) {
                    const bf16x8 a = *(const LAS bf16x8*)(lds + LKR + (32 * si + r32) * SQ + (16 * ks + 8 * hi) * 2);
                    const bf16x8 bq = *(const LAS bf16x8*)(lds + LQR + (32 * ti + r32) * SQ + (16 * ks + 8 * hi) * 2);
                    X = MFMA32(a, bq, X);
                }
                if (si == ti) {
#pragma unroll
                    for (int r = 0; r < 16; ++r) if (crow(r, hi) > r32) X[r] = 0.f;
                }
#pragma unroll
                for (int s2 = 0; s2 < 2; ++s2) {
                    union { u32x4 u; bf16x8 v; } pa;
                    pa.u.x = cvt_pk_bf16(X[8 * s2 + 0], X[8 * s2 + 1]); pa.u.y = cvt_pk_bf16(X[8 * s2 + 2], X[8 * s2 + 3]); pa.u.z = cvt_pk_bf16(X[8 * s2 + 4], X[8 * s2 + 5]); pa.u.w = cvt_pk_bf16(X[8 * s2 + 6], X[8 * s2 + 7]);
                    const LAS unsigned char* vp = lds + LV + (32 * si + 16 * s2 + trow) * SV + (32 * vi + tcol) * 2;
                    const s16x4 lo = tr4(vp), hh = tr4(vp + 8 * SV);
                    const bf16x8 vf = {lo[0], lo[1], lo[2], lo[3], hh[0], hh[1], hh[2], hh[3]};
                    Z = MFMA32(pa.v, vf, Z);
                }
            }
#pragma unroll
            for (int ks = 0; ks < 8; ++ks) {
                const bf16x8 a = *(const LAS bf16x8*)(lds + LQB + (32 * ti + r32) * SQ + (16 * ks + 8 * hi) * 2);
                const LAS unsigned char* sp = lds + LS + (16 * ks + 8 * hi + (tI >> 2)) * SS + (32 * vi + tcol) * 2;
                const s16x4 lo = tr4(sp), hh = tr4(sp + 4 * SS);
                const bf16x8 sf = {lo[0], lo[1], lo[2], lo[3], hh[0], hh[1], hh[2], hh[3]};
                Z = MFMA32(a, sf, Z);
            }
            bf16_t* op = HI + (rowb + (size_t)n * 64 + 32 * ti) * 512 + h * 128 + vh * 64 + 32 * vi + r32;
#pragma unroll
            for (int r = 0; r < 16; ++r) op[(size_t)crow(r, hi) * 512] = (bf16_t)(cvt_pk_bf16(Z[r], 0.f) & 0xffffu);
        }
        {
#pragma unroll
            for (int r = 0; r < 16; ++r) Sacc[r] *= CL[32 * di + crow(r, hi)];
#pragma unroll
            for (int ks = 0; ks < 4; ++ks) {
                const LAS unsigned char* kp = lds + LKD + (16 * ks + 8 * hi + (tI >> 2)) * SKD + (32 * di + tcol) * 2;
                const s16x4 klo = tr4(kp), khi = tr4(kp + 4 * SKD);
                const bf16x8 ka = {klo[0], klo[1], klo[2], klo[3], khi[0], khi[1], khi[2], khi[3]};
                const LAS unsigned char* vp = lds + LV + (16 * ks + 8 * hi + (tI >> 2)) * SV + (32 * vi + tcol) * 2;
                const s16x4 vlo = tr4(vp), vhi = tr4(vp + 4 * SV);
                const bf16x8 vb = {vlo[0], vlo[1], vlo[2], vlo[3], vhi[0], vhi[1], vhi[2], vhi[3]};
                Sacc = MFMA32(ka, vb, Sacc);
            }
        }
        __syncthreads();
        {
            LAS bf16_t* sp = (LAS bf16_t*)(lds + LS + (32 * di) * SS + (32 * vi + r32) * 2);
#pragma unroll
            for (int r = 0; r < 16; ++r) sp[crow(r, hi) * (SS / 2)] = (bf16_t)(cvt_pk_bf16(Sacc[r], 0.f) & 0xffffu);
        }
    }
    __syncthreads();
}

__device__ void moba_unit(const Params& P, int b, int h, int j, LAS unsigned char* lds) {
    const int tid = tid_opaque(), lane = tid & 63, wid = tid >> 6, r32 = lane & 31, hi = lane >> 5;
    bf16_t* Q = (bf16_t*)(P.ws + OFF_QA); const bf16_t* Kg = (const bf16_t*)(P.ws + OFF_KA); const bf16_t* Vg = (const bf16_t*)(P.ws + OFF_VA);
    const float* kmean = (const float*)(P.ws + OFF_KMEAN);
    constexpr int KIMG = 64 * 144, VIMG = 64 * 192, LK = 0, LV = 2 * KIMG, LKM = 2 * KIMG + 2 * VIMG;
    LAS float* kmL = (LAS float*)(lds + LKM);
    const size_t rowb = (size_t)b * SEQ; const int q0 = j * 256;
    if (tid < j * 64) kmL[tid] = kmean[(size_t)(b * 8 + (tid >> 6)) * 512 + h * 64 + (tid & 63)];
    bf16_t* qrow = Q + (rowb + q0 + wid * 32 + r32) * 512 + h * 64;
    bf16x8 qf[4];
#pragma unroll
    for (int d0 = 0; d0 < 4; ++d0) qf[d0] = *(const bf16x8*)(qrow + 16 * d0 + 8 * hi);
    const int srow = tid >> 3, sch = tid & 7;
    const bf16_t* ksrc = Kg + (rowb + srow) * 512 + h * 64 + sch * 8; const bf16_t* vsrc = Vg + (rowb + srow) * 512 + h * 64 + sch * 8;
    const int ntile = 4 * (j + 1);
    u32x4 kreg, vreg;
    { const int key0 = q0; kreg = *(const u32x4*)(ksrc + (size_t)key0 * 512); vreg = *(const u32x4*)(vsrc + (size_t)key0 * 512); }
    *(LAS u32x4*)(lds + LK + srow * 144 + sch * 16) = kreg; *(LAS u32x4*)(lds + LV + srow * 192 + sch * 16) = vreg;
    __syncthreads();
    unsigned sel = 0;
    if (j <= 3) sel = (1u << j) - 1u;
    else {
        float g[7];
#pragma unroll
        for (int n = 0; n < 7; ++n) { float s = 0.f;
            if (n < j) {
#pragma unroll
                for (int d0 = 0; d0 < 4; ++d0)
#pragma unroll
                    for (int e = 0; e < 8; ++e) s += __uint_as_float(((unsigned)(unsigned short)qf[d0][e]) << 16) * kmL[n * 64 + 16 * d0 + 8 * hi + e];
            }
            s += __shfl_xor(s, 32); g[n] = s; }
#pragma unroll
        for (int it = 0; it < 3; ++it) { float best = -INFINITY; int bi = 0;
#pragma unroll
            for (int n = 0; n < 7; ++n) if (n < j && !((sel >> n) & 1u) && g[n] > best) { best = g[n]; bi = n; }
            sel |= 1u << bi; }
    }
    const float ch = exp2f(-(float)(h + 1)) * LOG2E;
    const int qb = wid * 32 + r32;
    float m_run = -1e30f, l_run = 0.f;
    f32x16 o0 = {}, o1 = {};
    const int tg = lane >> 4, tc = tg & 1, ti = lane & 15;
    const int vlane = (4 * hi + (ti >> 2)) * 192 + (16 * tc + 4 * (ti & 3)) * 2;
#pragma unroll 1
    for (int i = 0; i < ntile; ++i) {
        const int buf = i & 1;
        const bool own = i < 4; const int blk = own ? j : ((i - 4) >> 2), kt = own ? i : ((i - 4) & 3);
        if (i + 1 < ntile) { const int i1 = i + 1; const int blk1 = (i1 < 4) ? j : ((i1 - 4) >> 2), kt1 = (i1 < 4) ? i1 : ((i1 - 4) & 3); const size_t key1 = (size_t)(blk1 * 256 + kt1 * 64);
            kreg = *(const u32x4*)(ksrc + key1 * 512); vreg = *(const u32x4*)(vsrc + key1 * 512); }
        const bool lane_ok = own ? true : (((sel >> blk) & 1u) != 0u);
        const bool skip = own ? (64 * kt > 32 * wid + 31) : (__ballot(lane_ok) == 0ull);
        if (!skip) {
            LAS unsigned char* kb = lds + LK + buf * KIMG; LAS unsigned char* vb = lds + LV + buf * VIMG;
            f32x16 p0 = {}, p1 = {};
#pragma unroll
            for (int d0 = 0; d0 < 4; ++d0) {
                const bf16x8 kf0 = *(const LAS bf16x8*)(kb + r32 * 144 + (16 * d0 + 8 * hi) * 2);
                const bf16x8 kf1 = *(const LAS bf16x8*)(kb + (32 + r32) * 144 + (16 * d0 + 8 * hi) * 2);
                p0 = MFMA32(kf0, qf[d0], p0); p1 = MFMA32(kf1, qf[d0], p1);
            }
            const float kbase = ch * (float)((blk - j) * 256 + kt * 64);
            float mt = -1e30f;
#pragma unroll
            for (int r = 0; r < 16; ++r) {
                const int kl0 = crow(r, hi), kl1 = kl0 + 32;
                const float t0 = p0[r] + (kbase + ch * (float)kl0), t1 = p1[r] + (kbase + ch * (float)kl1);
                const bool v0 = own ? (kt * 64 + kl0 <= qb) : lane_ok, v1 = own ? (kt * 64 + kl1 <= qb) : lane_ok;
                p0[r] = v0 ? t0 : -1e30f; p1[r] = v1 ? t1 : -1e30f;
                mt = fmaxf(mt, fmaxf(p0[r], p1[r]));
            }
            mt = fmaxf(mt, __shfl_xor(mt, 32));
            const float mnew = fmaxf(m_run, mt), alpha = __builtin_amdgcn_exp2f(m_run - mnew);
            m_run = mnew;
            float rs = 0.f;
#pragma unroll
            for (int r = 0; r < 16; ++r) { p0[r] = __builtin_amdgcn_exp2f(p0[r] - mnew); p1[r] = __builtin_amdgcn_exp2f(p1[r] - mnew); rs += p0[r] + p1[r]; }
            l_run = l_run * alpha + rs;
#pragma unroll
            for (int r = 0; r < 16; ++r) { o0[r] *= alpha; o1[r] *= alpha; }
#pragma unroll
            for (int sub = 0; sub < 2; ++sub)
#pragma unroll
                for (int s = 0; s < 2; ++s) {
                    union { u32x4 u; bf16x8 v; } pb;
                    if (sub == 0) { pb.u.x = cvt_pk_bf16(p0[8 * s + 0], p0[8 * s + 1]); pb.u.y = cvt_pk_bf16(p0[8 * s + 2], p0[8 * s + 3]); pb.u.z = cvt_pk_bf16(p0[8 * s + 4], p0[8 * s + 5]); pb.u.w = cvt_pk_bf16(p0[8 * s + 6], p0[8 * s + 7]); }
                    else { pb.u.x = cvt_pk_bf16(p1[8 * s + 0], p1[8 * s + 1]); pb.u.y = cvt_pk_bf16(p1[8 * s + 2], p1[8 * s + 3]); pb.u.z = cvt_pk_bf16(p1[8 * s + 4], p1[8 * s + 5]); pb.u.w = cvt_pk_bf16(p1[8 * s + 6], p1[8 * s + 7]); }
#pragma unroll
                    for (int dt = 0; dt < 2; ++dt) {
                        LAS unsigned char* va = vb + (32 * sub + 16 * s) * 192 + dt * 64 + vlane;
                        const s16x4 lo = __builtin_bit_cast(s16x4, __builtin_amdgcn_ds_read_tr16_b64_v4i16((LAS s16x4*)va));
                        const s16x4 hh = __builtin_bit_cast(s16x4, __builtin_amdgcn_ds_read_tr16_b64_v4i16((LAS s16x4*)(va + 8 * 192)));
                        const bf16x8 vf = {lo[0], lo[1], lo[2], lo[3], hh[0], hh[1], hh[2], hh[3]};
                        if (dt == 0) o0 = MFMA32(vf, pb.v, o0); else o1 = MFMA32(vf, pb.v, o1);
                    }
                }
        }
        if (i + 1 < ntile) { const int nb = buf ^ 1;
            *(LAS u32x4*)(lds + LK + nb * KIMG + srow * 144 + sch * 16) = kreg; *(LAS u32x4*)(lds + LV + nb * VIMG + srow * 192 + sch * 16) = vreg; }
        __syncthreads();
    }
    l_run += __shfl_xor(l_run, 32);
    const float inv = 1.0f / l_run;
#pragma unroll
    for (int r4 = 0; r4 < 4; ++r4) {
        u32x2 w0, w1;
        w0.x = cvt_pk_bf16(o0[4 * r4] * inv, o0[4 * r4 + 1] * inv); w0.y = cvt_pk_bf16(o0[4 * r4 + 2] * inv, o0[4 * r4 + 3] * inv);
        w1.x = cvt_pk_bf16(o1[4 * r4] * inv, o1[4 * r4 + 1] * inv); w1.y = cvt_pk_bf16(o1[4 * r4 + 2] * inv, o1[4 * r4 + 3] * inv);
        *(u32x2*)(qrow + 8 * r4 + 4 * hi) = w0; *(u32x2*)(qrow + 32 + 8 * r4 + 4 * hi) = w1;
    }
}

__device__ void yb_norm_panel(const Params& P, int pm) {
    const int tid = tid_opaque(), lane = tid & 63, wid = tid >> 6;
    bf16_t* HI = (bf16_t*)(P.ws + OFF_HI); const bf16_t* HG = (const bf16_t*)(P.ws + OFF_HG);
    for (int r = 0; r < 32; ++r) {
        const size_t off = ((size_t)pm * 256 + wid * 32 + r) * 512 + lane * 8;
        const u32x4 ov = *(const u32x4*)(HI + off), gv = *(const u32x4*)(HG + off);
        float o[8] = {bf_lo(ov.x), bf_hi(ov.x), bf_lo(ov.y), bf_hi(ov.y), bf_lo(ov.z), bf_hi(ov.z), bf_lo(ov.w), bf_hi(ov.w)};
        const float g[8] = {bf_lo(gv.x), bf_hi(gv.x), bf_lo(gv.y), bf_hi(gv.y), bf_lo(gv.z), bf_hi(gv.z), bf_lo(gv.w), bf_hi(gv.w)};
        float ss = 0.f;
#pragma unroll
        for (int e = 0; e < 8; ++e) ss += o[e] * o[e];
        ss += __shfl_xor(ss, 1); ss += __shfl_xor(ss, 2); ss += __shfl_xor(ss, 4); ss += __shfl_xor(ss, 8);
        const float rs = rsqrtf(ss * (1.0f / 128.0f) + RMS_EPS);
        u32x4 w; w.x = cvt_pk_bf16(o[0] * rs * g[0], o[1] * rs * g[1]); w.y = cvt_pk_bf16(o[2] * rs * g[2], o[3] * rs * g[3]);
        w.z = cvt_pk_bf16(o[4] * rs * g[4], o[5] * rs * g[5]); w.w = cvt_pk_bf16(o[6] * rs * g[6], o[7] * rs * g[7]);
        *(u32x4*)(HI + off) = w;
    }
}
__device__ void ln1_panel(const Params& P, int pm) {
    const int tid = tid_opaque(), lane = tid & 63, wid = tid >> 6;
    const float* ada = (const float*)(P.ws + OFF_ADA) + (size_t)(pm >> 3) * 6144; bf16_t* H = (bf16_t*)(P.ws + OFF_H);
    for (int r = 0; r < 32; ++r) {
        const size_t row = (size_t)pm * 256 + wid * 32 + r;
        float* xr = P.out + row * 1024 + lane * 4; const float* xin = P.x + row * 1024 + lane * 4; const bf16_t* dl = (const bf16_t*)(P.ws + OFF_GB) + row * 1024 + lane * 4;
        f32x4 v[4]; float s = 0.f;
#pragma unroll
        for (int jx = 0; jx < 4; ++jx) { const u32x2 dv = *(const u32x2*)(dl + 256 * jx); const f32x4 xv = __builtin_nontemporal_load((const f32x4*)(xin + 256 * jx));
            v[jx] = xv * ALPHA + (f32x4){bf_lo(dv.x), bf_hi(dv.x), bf_lo(dv.y), bf_hi(dv.y)}; s += (v[jx][0] + v[jx][1]) + (v[jx][2] + v[jx][3]); }
        const float mean = wave_sum(s) * (1.0f / 1024.0f); float s2 = 0.f;
#pragma unroll
        for (int jx = 0; jx < 4; ++jx) { v[jx] = v[jx] - mean; s2 += (v[jx][0] * v[jx][0] + v[jx][1] * v[jx][1]) + (v[jx][2] * v[jx][2] + v[jx][3] * v[jx][3]); }
        const float rstd = rsqrtf(wave_sum(s2) * (1.0f / 1024.0f) + LN_EPS);
#pragma unroll
        for (int jx = 0; jx < 4; ++jx) {
            const int c = lane * 4 + 256 * jx;
            const f32x4 g = *(const f32x4*)(P.ln1_g + c), bb = *(const f32x4*)(P.ln1_b + c), sh = *(const f32x4*)(ada + 3072 + c), sc = *(const f32x4*)(ada + 4096 + c);
            const f32x4 x1 = v[jx] * rstd * g + bb;
            *(f32x4*)(xr + 256 * jx) = x1;
            const f32x4 h2 = x1 * (sc + 1.0f) + sh;
            u32x2 w; w.x = cvt_pk_bf16(h2[0], h2[1]); w.y = cvt_pk_bf16(h2[2], h2[3]);
            *(u32x2*)(H + row * 1024 + c) = w;
            v[jx] = h2;
        }
        {
            float mx = 0.f;
#pragma unroll
            for (int jx = 0; jx < 4; ++jx) mx = fmaxf(mx, fmaxf(fmaxf(fabsf(v[jx][0]), fabsf(v[jx][1])), fmaxf(fabsf(v[jx][2]), fabsf(v[jx][3]))));
#pragma unroll
            for (int o = 1; o < 64; o <<= 1) mx = fmaxf(mx, __shfl_xor(mx, o));
            const float hs = fmaxf(mx * (1.0f / 127.0f), 1e-30f), inv = 1.0f / hs; int qs = 0;
#pragma unroll
            for (int jx = 0; jx < 4; ++jx) {
                const int q0 = (int)rintf(v[jx][0] * inv), q1 = (int)rintf(v[jx][1] * inv), q2 = (int)rintf(v[jx][2] * inv), q3 = (int)rintf(v[jx][3] * inv);
                qs += (q0 + q1) + (q2 + q3);
                *(unsigned*)(P.ws + OFF_H8 + row * 1024 + lane * 4 + 256 * jx) = (unsigned)(q0 & 255) | ((unsigned)(q1 & 255) << 8) | ((unsigned)(q2 & 255) << 16) | ((unsigned)(q3 & 255) << 24);
            }
#pragma unroll
            for (int o = 1; o < 64; o <<= 1) qs += __shfl_xor(qs, o);
            if (lane == 0) *(f32x2*)(P.ws + OFF_HS + row * 8) = (f32x2){hs, (float)qs};
        }
    }
}

#define INS16(L, xin) do { float x_ = (xin); _Pragma("unroll") for (int k_ = 0; k_ < 16; ++k_) { const float hi_ = fmaxf(L[k_], x_); x_ = fminf(L[k_], x_); L[k_] = hi_; } } while (0)

__device__ void peer_select_wave(const Params& P, size_t tok0) {
    const int lane = tid_opaque() & 63, r32 = lane & 31, hi = lane >> 5;
    const bf16_t* QP = (const bf16_t*)(P.ws + OFF_GB) + (tok0 + r32) * 1024; const bf16_t* SK = (const bf16_t*)(P.ws + OFF_SK);
    u32x2* EG = (u32x2*)(P.ws + OFF_EG) + (tok0 + r32) * 128;
#pragma unroll 1
    for (int h = 0; h < 8; ++h) {
        float a0[16], a1[16];
#pragma unroll
        for (int k = 0; k < 16; ++k) { a0[k] = -INFINITY; a1[k] = -INFINITY; }
#pragma unroll 1
        for (int p = 0; p < 2; ++p) {
            const int hp = h * 2 + p;
            bf16x8 qf[4];
#pragma unroll
            for (int ks = 0; ks < 4; ++ks) qf[ks] = *(const bf16x8*)(QP + hp * 64 + 16 * ks + 8 * hi);
            float L[16];
#pragma unroll
            for (int k = 0; k < 16; ++k) L[k] = -INFINITY;
#pragma unroll
            for (int kt = 0; kt < 4; ++kt) {
                f32x16 acc = {};
#pragma unroll
                for (int ks = 0; ks < 4; ++ks) { const bf16x8 kf = *(const bf16x8*)(SK + ((size_t)hp * 128 + 32 * kt + r32) * 64 + 16 * ks + 8 * hi); acc = MFMA32(kf, qf[ks], acc); }
#pragma unroll
                for (int r = 0; r < 16; ++r) { const unsigned key = (unsigned)(32 * kt + crow(r, hi)); const float xv = __uint_as_float((__float_as_uint(acc[r]) & ~127u) | key); INS16(L, xv); }
            }
            float O[16];
#pragma unroll
            for (int k = 0; k < 16; ++k) O[k] = __shfl_xor(L[k], 32);
#pragma unroll
            for (int k = 0; k < 16; ++k) INS16(L, O[k]);
#pragma unroll
            for (int k = 0; k < 16; ++k) { a0[k] = (p == 0) ? L[k] : a0[k]; a1[k] = (p == 1) ? L[k] : a1[k]; }
        }
        float best[16];
#pragma unroll
        for (int k = 0; k < 16; ++k) best[k] = -INFINITY;
#pragma unroll
        for (int i = 0; i < 16; ++i)
#pragma unroll
            for (int jx = 0; jx < 16; ++jx)
                if ((i + 1) * (jx + 1) <= 16) {
                    const float cs = a0[i] + a1[jx];
                    const float cv = __uint_as_float((__float_as_uint(cs) & ~255u) | (unsigned)(i * 16 + jx));
                    INS16(best, cv);
                }
        unsigned pk0[4], pk1[4];
#pragma unroll
        for (int q = 0; q < 4; ++q) {
            pk0[q] = (__float_as_uint(a0[4 * q]) & 127u) | ((__float_as_uint(a0[4 * q + 1]) & 127u) << 8) | ((__float_as_uint(a0[4 * q + 2]) & 127u) << 16) | ((__float_as_uint(a0[4 * q + 3]) & 127u) << 24);
            pk1[q] = (__float_as_uint(a1[4 * q]) & 127u) | ((__float_as_uint(a1[4 * q + 1]) & 127u) << 8) | ((__float_as_uint(a1[4 * q + 2]) & 127u) << 16) | ((__float_as_uint(a1[4 * q + 3]) & 127u) << 24);
        }
        unsigned pay[16];
#pragma unroll
        for (int k = 0; k < 16; ++k) {
            const unsigned code = __float_as_uint(best[k]) & 255u, ci = code >> 4, cj = code & 15u;
            const unsigned qi = ci >> 2, qj = cj >> 2;
            const unsigned w0 = (qi == 0u) ? pk0[0] : ((qi == 1u) ? pk0[1] : ((qi == 2u) ? pk0[2] : pk0[3]));
            const unsigned w1 = (qj == 0u) ? pk1[0] : ((qj == 1u) ? pk1[1] : ((qj == 2u) ? pk1[2] : pk1[3]));
            pay[k] = (((w0 >> ((ci & 3u) * 8u)) & 127u) << 7) | ((w1 >> ((cj & 3u) * 8u)) & 127u);
        }
        float e[16], es = 0.f;
#pragma unroll
        for (int k = 0; k < 16; ++k) { e[k] = __expf(best[k] - best[0]); es += e[k]; }
        const float inv = 1.0f / es;
        if (hi == 0) {
#pragma unroll
            for (int k = 0; k < 16; ++k) { u32x2 w; w.x = pay[k]; w.y = __float_as_uint(e[k] * inv); EG[h * 16 + k] = w; }
        }
    }
}
__device__ __forceinline__ unsigned xcc_id() { return (unsigned)__builtin_amdgcn_s_getreg((3 << 11) | 20) & 0xFu; }
template <int CTRL> __device__ __forceinline__ float dpp_add(float x) { const int v = __builtin_amdgcn_update_dpp(0, __float_as_int(x), CTRL, 0xf, 0xf, true); return x + __int_as_float(v); }
__device__ __forceinline__ float wave_sum_fast(float x) {
    x = dpp_add<0xB1>(x); x = dpp_add<0x4E>(x); x = dpp_add<0x141>(x); x = dpp_add<0x140>(x);
    x += __shfl_xor(x, 16); x += __shfl_xor(x, 32); return x;
}
__device__ __forceinline__ float dot16_fp8(const float (&hv)[16], const u32x4 r) {
    float s = 0.f;
    { const f32x2 a = __builtin_amdgcn_cvt_pk_f32_fp8((int)r.x, false), b = __builtin_amdgcn_cvt_pk_f32_fp8((int)r.x, true); s += hv[0] * a.x + hv[1] * a.y + hv[2] * b.x + hv[3] * b.y; }
    { const f32x2 a = __builtin_amdgcn_cvt_pk_f32_fp8((int)r.y, false), b = __builtin_amdgcn_cvt_pk_f32_fp8((int)r.y, true); s += hv[4] * a.x + hv[5] * a.y + hv[6] * b.x + hv[7] * b.y; }
    { const f32x2 a = __builtin_amdgcn_cvt_pk_f32_fp8((int)r.z, false), b = __builtin_amdgcn_cvt_pk_f32_fp8((int)r.z, true); s += hv[8] * a.x + hv[9] * a.y + hv[10] * b.x + hv[11] * b.y; }
    { const f32x2 a = __builtin_amdgcn_cvt_pk_f32_fp8((int)r.w, false), b = __builtin_amdgcn_cvt_pk_f32_fp8((int)r.w, true); s += hv[12] * a.x + hv[13] * a.y + hv[14] * b.x + hv[15] * b.y; }
    return s;
}
template <int NP, class F> __device__ __forceinline__ void partition_queue(const Params& P, LAS unsigned char* lds, int ctr_base, F f) {
    const int tid = tid_opaque();
    LAS int* slot = (LAS int*)(lds + LDS_BYTES - 64);
    unsigned* ctr = (unsigned*)(P.ws + OFF_CTR) + ctr_base;
    const int myx = (int)(xcc_id() & 7u);
    for (int pp = 0; pp < NP; ++pp) {
        const int p = (myx * (NP / 8) + pp) % NP;
        for (;;) {
            if (tid == 0) *slot = (int)atomicAdd(ctr + p, 1u);
            __syncthreads();
            const int item = *slot;
            __syncthreads();
            if (item >= NTOK / 64) break;
            f(p, item);
        }
    }
}
__device__ __forceinline__ float dot2bf(unsigned a, bf16v2 b, float c) { return __builtin_amdgcn_fdot2_f32_bf16(__builtin_bit_cast(bf16v2, a), b, c, false); }
struct UQuad { u32x4 r[2]; u32x4 ent; };
__device__ __forceinline__ void uq_issue(UQuad& q, const LAS u32x4* list, int J, int NQ, int g, const unsigned char* U4) {
    const int jj = J < NQ ? J : NQ - 1;
    q.ent = list[4 * jj + g];
    const unsigned char* rp = U4 + (size_t)q.ent.x * 512;
    q.r[0] = *(const u32x4*)rp; q.r[1] = *(const u32x4*)(rp + 256);
}
__device__ __forceinline__ int dot8_i4(unsigned w, unsigned hlo, unsigned hhi, int acc) {
    acc = __builtin_amdgcn_sdot4((int)hlo, (int)(w & 0x0F0F0F0Fu), acc, false);
    return __builtin_amdgcn_sdot4((int)hhi, (int)((w >> 4) & 0x0F0F0F0Fu), acc, false);
}
__device__ __forceinline__ float uq_dot(const UQuad& q, const u32x4 (&hp)[4]) {
    int a = 0, b = 0;
#pragma unroll
    for (int c = 0; c < 2; ++c) {
        const u32x4 r = q.r[c];
        a = dot8_i4(r.x, hp[2 * c].x, hp[2 * c].y, a); b = dot8_i4(r.y, hp[2 * c].z, hp[2 * c].w, b);
        a = dot8_i4(r.z, hp[2 * c + 1].x, hp[2 * c + 1].y, a); b = dot8_i4(r.w, hp[2 * c + 1].z, hp[2 * c + 1].w, b);
    }
    float s = (float)(a + b);
    s = dpp_add<0xB1>(s); s = dpp_add<0x4E>(s); s = dpp_add<0x141>(s); s = dpp_add<0x140>(s);
    return s;
}
__device__ __forceinline__ void peer_u_tokens(const Params& P, LAS unsigned char* lds, const size_t t0) {
    const int tid = tid_opaque(), lane = tid & 63, wid = tid >> 6, g = lane >> 4, li = lane & 15;
    const unsigned char* H8 = P.ws + OFF_H8 + li * 32; const unsigned char* U4 = P.ws + OFF_U8 + li * 16;
    const f32x2* HS = (const f32x2*)(P.ws + OFF_HS); const float* USC = (const float*)(P.ws + OFF_USC);
    const u32x4* EG4 = (const u32x4*)(P.ws + OFF_EG); float* W = (float*)(P.ws + OFF_W);
    LAS u32x4* list = (LAS u32x4*)(lds + wid * 16384);
#pragma unroll 2
    for (int i = 0; i < 8; ++i) {
        const u32x4 eg = EG4[(t0 + i) * 64 + lane];
        list[i * 128 + 2 * lane] = (u32x4){eg.x, eg.y, (unsigned)(2 * lane) | (unsigned)(i << 8), __float_as_uint(USC[eg.x])};
        list[i * 128 + 2 * lane + 1] = (u32x4){eg.z, eg.w, (unsigned)(2 * lane + 1) | (unsigned)(i << 8), __float_as_uint(USC[eg.z])};
    }
    constexpr int NQ = 256;
    u32x4 hp[4], hn[4]; f32x2 hsc = HS[t0], hsn = HS[t0 + 1];
#pragma unroll
    for (int c = 0; c < 2; ++c) { hp[2 * c] = *(const u32x4*)(H8 + t0 * 1024 + 512 * c); hp[2 * c + 1] = *(const u32x4*)(H8 + t0 * 1024 + 512 * c + 16);
                                  hn[2 * c] = *(const u32x4*)(H8 + (t0 + 1) * 1024 + 512 * c); hn[2 * c + 1] = *(const u32x4*)(H8 + (t0 + 1) * 1024 + 512 * c + 16); }
    int curtok = 0;
    UQuad q0, q1, q2, q3;
    uq_issue(q0, list, 0, NQ, g, U4); uq_issue(q1, list, 1, NQ, g, U4); uq_issue(q2, list, 2, NQ, g, U4); uq_issue(q3, list, 3, NQ, g, U4);
#define UQ_STEP(q, Jn) do { \
        const int tk = __builtin_amdgcn_readfirstlane((int)(q.ent.z >> 8)); \
        if (tk != curtok) { curtok = tk; _Pragma("unroll") for (int c = 0; c < 4; ++c) hp[c] = hn[c]; hsc = hsn; \
            if (tk + 1 < 8) { hsn = HS[t0 + tk + 1]; _Pragma("unroll") for (int c = 0; c < 2; ++c) { hn[2 * c] = *(const u32x4*)(H8 + (t0 + tk + 1) * 1024 + 512 * c); hn[2 * c + 1] = *(const u32x4*)(H8 + (t0 + tk + 1) * 1024 + 512 * c + 16); } } } \
        const float s = __uint_as_float(q.ent.w) * hsc.x * (uq_dot(q, hp) - 7.5f * hsc.y); \
        if (li == 0) W[(t0 + tk) * 128 + (q.ent.z & 255u)] = __uint_as_float(q.ent.y) * 0.5f * s * (1.0f + erff(s * 0.70710678118654752f)); \
        uq_issue(q, list, (Jn), NQ, g, U4); } while (0)
#pragma unroll 1
    for (int J = 0; J < NQ; J += 4) { UQ_STEP(q0, J + 4); UQ_STEP(q1, J + 5); UQ_STEP(q2, J + 6); UQ_STEP(q3, J + 7); }
#undef UQ_STEP
}
typedef int v4i_t __attribute__((ext_vector_type(4)));
struct VQuad { u32x4 r[2]; u32x2 ent; };
__device__ __forceinline__ void vq_issue(VQuad& q, const LAS u32x2* list, int J, int g, const unsigned char* V4) {
    const int jj = J < 32 ? J : 31;
    q.ent = list[4 * jj + g];
    const unsigned char* rp = V4 + (size_t)q.ent.x * 512;
    q.r[0] = *(const u32x4*)rp; q.r[1] = *(const u32x4*)(rp + 256);
}
__device__ __forceinline__ void vq_mma(const VQuad& q, v4i_t (&acc)[4], const unsigned sh, const u32x4 bm, const bool live) {
    const unsigned t = live ? ((q.ent.y & 255u) << sh) : 0u;
    const v4i_t B = {(int)(t & bm.x), (int)(t & bm.y), (int)(t & bm.z), (int)(t & bm.w)};
#pragma unroll
    for (int c = 0; c < 2; ++c) {
        const u32x4 r = q.r[c];
        const v4i_t lo = {(int)(r.x & 0x0F0F0F0Fu), (int)(r.y & 0x0F0F0F0Fu), (int)(r.z & 0x0F0F0F0Fu), (int)(r.w & 0x0F0F0F0Fu)};
        const v4i_t hi = {(int)((r.x >> 4) & 0x0F0F0F0Fu), (int)((r.y >> 4) & 0x0F0F0F0Fu), (int)((r.z >> 4) & 0x0F0F0F0Fu), (int)((r.w >> 4) & 0x0F0F0F0Fu)};
        acc[2 * c] = __builtin_amdgcn_mfma_i32_16x16x64_i8(lo, B, acc[2 * c], 0, 0, 0);
        acc[2 * c + 1] = __builtin_amdgcn_mfma_i32_16x16x64_i8(hi, B, acc[2 * c + 1], 0, 0, 0);
    }
}
__device__ __forceinline__ void peer_v_tokens(const Params& P, LAS unsigned char* lds, const size_t t0) {
    const int tid = tid_opaque(), lane = tid & 63, wid = tid >> 6, g = lane >> 4, li = lane & 15;
    const unsigned char* V4 = P.ws + OFF_V8 + li * 16; const float* VSC = (const float*)(P.ws + OFF_VSC);
    const u32x4* EG4 = (const u32x4*)(P.ws + OFF_EG); const f32x2* W2 = (const f32x2*)(P.ws + OFF_W);
    LAS u32x2* lists = (LAS u32x2*)(lds + wid * 8192);
    float swv[8], yoffv[8];
#pragma unroll
    for (int i = 0; i < 8; ++i) { const u32x4 eg = EG4[(t0 + i) * 64 + lane]; const f32x2 ww = W2[(t0 + i) * 64 + lane];
        const float w0 = ww.x * VSC[eg.x], w1 = ww.y * VSC[eg.z];
        float mx = fmaxf(fabsf(w0), fabsf(w1));
#pragma unroll
        for (int o = 1; o < 64; o <<= 1) mx = fmaxf(mx, __shfl_xor(mx, o));
        const float sw = fmaxf(mx * (1.0f / 127.0f), 1e-30f), inv = 1.0f / sw;
        const int q0 = (int)rintf(w0 * inv), q1 = (int)rintf(w1 * inv);
        *(LAS u32x4*)(lists + i * 128 + 2 * lane) = (u32x4){eg.x, (unsigned)q0, eg.z, (unsigned)q1};
        int qs = q0 + q1;
#pragma unroll
        for (int o = 1; o < 64; o <<= 1) qs += __shfl_xor(qs, o);
        swv[i] = sw; yoffv[i] = 7.5f * sw * (float)qs; }
    const unsigned sh = 8u * (unsigned)(li & 3);
    const u32x4 bm = {(li >> 2) == 0 ? 0xFFFFFFFFu : 0u, (li >> 2) == 1 ? 0xFFFFFFFFu : 0u, (li >> 2) == 2 ? 0xFFFFFFFFu : 0u, (li >> 2) == 3 ? 0xFFFFFFFFu : 0u};
#pragma unroll
    for (int i = 0; i < 8; ++i) {
        const size_t t = t0 + i;
        const LAS u32x2* list = lists + i * 128;
        v4i_t acc[4];
#pragma unroll
        for (int j = 0; j < 4; ++j) acc[j] = (v4i_t){0, 0, 0, 0};
        VQuad q0, q1, q2, q3;
        vq_issue(q0, list, 0, g, V4); vq_issue(q1, list, 1, g, V4); vq_issue(q2, list, 2, g, V4); vq_issue(q3, list, 3, g, V4);
#pragma unroll 1
        for (int J = 0; J < 32; J += 4) {
            vq_mma(q0, acc, sh, bm, true); vq_issue(q0, list, J + 4, g, V4);
            vq_mma(q1, acc, sh, bm, true); vq_issue(q1, list, J + 5, g, V4);
            vq_mma(q2, acc, sh, bm, true); vq_issue(q2, list, J + 6, g, V4);
            vq_mma(q3, acc, sh, bm, true); vq_issue(q3, list, J + 7, g, V4);
        }
        const float sw = swv[i], yoff = yoffv[i];
        const int dbase = 128 * g + 8 * (li >> 2) + (li & 3);
        const float* gt2 = (const float*)(P.ws + OFF_ADA) + (t >> 11) * 6144 + 5120;
        float* xr = P.out + t * 1024;
        float pre[16]; float s = 0.f;
#pragma unroll
        for (int c = 0; c < 2; ++c)
#pragma unroll
            for (int hf = 0; hf < 2; ++hf)
#pragma unroll
                for (int r = 0; r < 4; ++r) { const int d = dbase + 512 * c + 32 * r + 4 * hf;
                    const float yv = sw * (float)acc[2 * c + hf][r] - yoff;
                    const float pv = ALPHA * xr[d] + gt2[d] * yv; pre[8 * c + 4 * hf + r] = pv; s += pv; }
        const float mean = wave_sum(s) * (1.0f / 1024.0f); float s2 = 0.f;
#pragma unroll
        for (int e = 0; e < 16; ++e) { pre[e] -= mean; s2 += pre[e] * pre[e]; }
        const float rstd = rsqrtf(wave_sum(s2) * (1.0f / 1024.0f) + LN_EPS);
#pragma unroll
        for (int c = 0; c < 2; ++c)
#pragma unroll
            for (int hf = 0; hf < 2; ++hf)
#pragma unroll
                for (int r = 0; r < 4; ++r) { const int d = dbase + 512 * c + 32 * r + 4 * hf;
                    xr[d] = pre[8 * c + 4 * hf + r] * rstd * P.ln2_g[d] + P.ln2_b[d]; }
    }
}

#define XB_TMO      128
#define XB_XCNT(j)  (256  + 64 * (j))
#define XB_XSUB(j)  (1280 + 64 * (j))
#define XB_XGEN(j)  (2304 + 64 * (j))
#define XB_TOP      3328
#define XB_TOPGEN   3392
#define XCD_BAR_WORDS 3456
#define XB_SPIN_CAP (1u << 22)
__device__ __forceinline__ unsigned xb_ld(unsigned* p)              { return __hip_atomic_load(p, __ATOMIC_RELAXED, __HIP_MEMORY_SCOPE_AGENT); }
__device__ __forceinline__ unsigned xb_add(unsigned* p, unsigned v) { return __hip_atomic_fetch_add(p, v, __ATOMIC_RELAXED, __HIP_MEMORY_SCOPE_AGENT); }
#define XB_SPIN(cond, bar) do { unsigned _sp = 0; while (cond) { __builtin_amdgcn_s_sleep(1); \
    if ((++_sp & 255u) == 0u) { if (xb_ld(&(bar)[XB_TMO])) break; if (_sp > XB_SPIN_CAP) { atomicAdd(&(bar)[XB_TMO], 1u); break; } } } } while (0)
struct XcdBarrier { unsigned* bar; unsigned x; volatile LAS unsigned* st; };
__device__ __forceinline__ XcdBarrier xcd_barrier_post(unsigned* bar, volatile LAS unsigned* st) {
    XcdBarrier b; b.bar = bar; b.x = xcc_id(); b.st = st;
    if (threadIdx.x == 0) (void)xb_add(&bar[XB_XCNT(b.x)], 1u);
    return b;
}
__device__ __forceinline__ void xcd_barrier_complete(unsigned* bar, unsigned x, unsigned& nloc, unsigned& nx) {
    const unsigned G = gridDim.x * gridDim.y * gridDim.z;
    unsigned sum, cnt, mine, sp = 0u;
    for (;;) {
        sum = 0u; cnt = 0u; mine = 0u;
#pragma unroll
        for (unsigned j = 0; j < 16; ++j) { const unsigned c = xb_ld(&bar[XB_XCNT(j)]); sum += c; cnt += (c > 0u) ? 1u : 0u; mine = (j == x) ? c : mine; }
        if (sum == G) break;
        __builtin_amdgcn_s_sleep(1);
        if ((++sp & 255u) == 0u) { if (xb_ld(&bar[XB_TMO])) break; if (sp > XB_SPIN_CAP) { atomicAdd(&bar[XB_TMO], 1u); break; } }
    }
    nloc = mine > 0u ? mine : 1u; nx = cnt > 0u ? cnt : 1u;
}
__device__ __forceinline__ void xcd_barrier(const XcdBarrier& b) {
    asm volatile("s_waitcnt vmcnt(0)" ::: "memory");
    __syncthreads();
    if (threadIdx.x == 0) {
        unsigned* bar = b.bar;
        __builtin_amdgcn_s_waitcnt(0);
        unsigned nloc = b.st[0], nx = b.st[1];
        if (nloc == 0u) { xcd_barrier_complete(bar, b.x, nloc, nx); b.st[0] = nloc; b.st[1] = nx; }
        const unsigned old = xb_add(&bar[XB_XSUB(b.x)], 1u);
        const unsigned gen = old / nloc;
        if (old + 1u == (gen + 1u) * nloc) {
            __builtin_amdgcn_fence(__ATOMIC_RELEASE, "agent");
            asm volatile("s_waitcnt vmcnt(0)" ::: "memory");
            const unsigned og = xb_add(&bar[XB_TOP], 1u);
            const unsigned tg = og / nx;
            if (og + 1u == (tg + 1u) * nx) xb_add(&bar[XB_TOPGEN], 1u);
            else XB_SPIN(xb_ld(&bar[XB_TOPGEN]) == tg, bar);
            __builtin_amdgcn_fence(__ATOMIC_ACQUIRE, "agent");
            xb_add(&bar[XB_XGEN(b.x)], 1u);
            asm volatile("s_waitcnt vmcnt(0)" ::: "memory");
        } else {
            XB_SPIN(xb_ld(&bar[XB_XGEN(b.x)]) == gen, bar);
            __builtin_amdgcn_fence(__ATOMIC_ACQUIRE, "agent");
            asm volatile("s_waitcnt vmcnt(0)" ::: "memory");
        }
    }
    __syncthreads();
}

__global__ void __launch_bounds__(NTHR, 2) fwd_megakernel(Params P) {
    extern __shared__ __attribute__((aligned(16))) unsigned char shm[];
    LAS unsigned char* lds = (LAS unsigned char*)shm;
    cg::grid_group grid = cg::this_grid();
    const int G = gridDim.x, bid = blockIdx.x;
    volatile LAS unsigned* xst = (volatile LAS unsigned*)(lds + LDS_BYTES - 128);
    if (threadIdx.x == 0) { xst[0] = 0u; xst[1] = 0u; }
    __syncthreads();
    const XcdBarrier xb = xcd_barrier_post((unsigned*)(P.ws + OFF_BAR), xst);

#ifndef P3
#define P3 0xff
#endif
#ifndef PH
#define PH 0xff
#endif
    if (PH & 1) phase0a(P, lds);
    grid.sync();
    if (PH & 2) phase0b(P);
    xcd_barrier(xb);
    if (PH & 4) {
        pg8::Gemm g; g.A = (const bf16_t*)(P.ws + OFF_H); g.Bt = (const bf16_t*)(P.ws + OFF_WIN); g.M = NTOK; g.N = INCOLS; { int k_ = 512; asm volatile("" : "+s"(k_)); g.K = k_; }
        pg8::StaticOrder S; S.init(NTOK, INCOLS, G, bid);
        EpiProj E; E.ws = P.ws; E.lb = (const float*)(P.ws + OFF_LB); E.ng = P.hgrn_ng; E.kmean = (float*)(P.ws + OFF_KMEAN);
        pg8::gemm_phase<EpiProj, pg8::StaticOrder, true>(lds, g, S, E);
    }
    xcd_barrier(xb);
    if (PH & 8) for (int it = bid; it < 256; it += G) hgrn_item(P, it, lds);
    if (PH & 16) for (int u = bid; u < 2048; u += G) { const int bh = u & 255, jj = u >> 8; moba_unit(P, bh >> 3, bh & 7, (jj + bh) & 7, lds); }
    xcd_barrier(xb);
    if (PH & 32) for (int pm = bid; pm < NTOK / 256; pm += G) {
        if (P3 & 1) yb_norm_panel(P, pm);
        __syncthreads();
        if (P3 & 2) { pg8::Gemm g; g.A = (const bf16_t*)(P.ws + OFF_QA); g.Bt = (const bf16_t*)(P.ws + OFF_WBA); g.M = NTOK; g.N = 1024; g.K = 512;
          pg8::PanelOrder S; S.pm = pm; S.npn = 4; EpiMixA E; E.GA = (bf16_t*)(P.ws + OFF_GA);
          pg8::gemm_phase<EpiMixA, pg8::PanelOrder>(lds, g, S, E); }
        __syncthreads();
        if (P3 & 4) { pg8::Gemm g; g.A = (const bf16_t*)(P.ws + OFF_HI); g.Bt = (const bf16_t*)(P.ws + OFF_WBB); g.M = NTOK; g.N = 1024; g.K = 512;
          pg8::PanelOrder S; S.pm = pm; S.npn = 4; EpiMixB E; E.GA = (bf16_t*)(P.ws + OFF_GA); E.GB = (const bf16_t*)(P.ws + OFF_GB);
          pg8::gemm_phase<EpiMixB, pg8::PanelOrder>(lds, g, S, E); }
        __syncthreads();
        if (P3 & 8) { pg8::Gemm g; g.A = (const bf16_t*)(P.ws + OFF_GA); g.Bt = (const bf16_t*)(P.ws + OFF_WOUT); g.M = NTOK; g.N = 1024; g.K = 1024;
          pg8::PanelOrder S; S.pm = pm; S.npn = 4; EpiOut E; E.ada = (const float*)(P.ws + OFF_ADA); E.D = (bf16_t*)(P.ws + OFF_GB);
          pg8::gemm_phase<EpiOut, pg8::PanelOrder>(lds, g, S, E); }
        __syncthreads();
        if (P3 & 16) ln1_panel(P, pm);
        __syncthreads();
        if (P3 & 32) { pg8::Gemm g; g.A = (const bf16_t*)(P.ws + OFF_H); g.Bt = (const bf16_t*)(P.ws + OFF_WQ); g.M = NTOK; g.N = 1024; g.K = 1024;
          pg8::PanelOrder S; S.pm = pm; S.npn = 4; EpiBf16 E; E.O = (bf16_t*)(P.ws + OFF_GB);
          pg8::gemm_phase<EpiBf16, pg8::PanelOrder>(lds, g, S, E); }
        __syncthreads();
        { const size_t tok0 = (size_t)pm * 256 + (tid_opaque() >> 6) * 32;
          peer_select_wave(P, tok0);
          __syncthreads();
#pragma unroll 1
          for (int sb = 0; sb < 4; ++sb) {
              peer_u_tokens(P, lds, tok0 + 8 * sb);
              __syncthreads();
              peer_v_tokens(P, lds, tok0 + 8 * sb);
              __syncthreads();
          } }
    }
}

extern "C" void kernel_launch(void* const* d_in, const int* in_sizes, int n_in, void* d_out, int out_size, void* d_ws, size_t ws_size, hipStream_t stream) {
    static int grid_blocks = 0;
    if (grid_blocks == 0) {
        if (n_in != 18 || out_size != NTOK * DM || ws_size < WS_END) { fprintf(stderr, "kernel_launch: unexpected shapes (n_in %d, out %d, ws %zu, need %zu)\n", n_in, out_size, ws_size, (size_t)WS_END); grid_blocks = -1; return; }
        int dev = 0, cus = 0, per_cu = 0;
        hipGetDevice(&dev);
        hipDeviceGetAttribute(&cus, hipDeviceAttributeMultiprocessorCount, dev);
        if (hipFuncSetAttribute((const void*)fwd_megakernel, hipFuncAttributeMaxDynamicSharedMemorySize, LDS_BYTES) != hipSuccess) fprintf(stderr, "kernel_launch: hipFuncSetAttribute failed\n");
        hipOccupancyMaxActiveBlocksPerMultiprocessor(&per_cu, (const void*)fwd_megakernel, NTHR, LDS_BYTES);
        if (per_cu < 1) { fprintf(stderr, "kernel_launch: occupancy query says %d blocks per CU\n", per_cu); per_cu = 1; }
        if (per_cu > 1) per_cu = 1;
        grid_blocks = cus * per_cu;
        (void)hipGetLastError();
    }
    if (grid_blocks < 0) return;
    Params p{};
    p.x = (const float*)d_in[0]; p.c = (const float*)d_in[1]; p.w_ada = (const float*)d_in[2]; p.b_ada = (const float*)d_in[3]; p.w_in = (const float*)d_in[4];
    p.w_ba = (const float*)d_in[5]; p.w_bb = (const float*)d_in[6]; p.w_out = (const float*)d_in[7]; p.hgrn_lb = (const float*)d_in[8]; p.hgrn_ng = (const float*)d_in[9];
    p.ln1_g = (const float*)d_in[10]; p.ln1_b = (const float*)d_in[11]; p.peer_wq = (const float*)d_in[12]; p.peer_sk = (const float*)d_in[13]; p.peer_u = (const float*)d_in[14];
    p.peer_v = (const float*)d_in[15]; p.ln2_g = (const float*)d_in[16]; p.ln2_b = (const float*)d_in[17];
    p.out = (float*)d_out; p.ws = (unsigned char*)d_ws;
    if (hipMemsetAsync((char*)d_ws + OFF_BAR, 0, XCD_BAR_WORDS * 4, stream) != hipSuccess) fprintf(stderr, "kernel_launch: memset of the barrier words failed\n");
    void* args[] = {&p};
    hipError_t e = hipLaunchCooperativeKernel((const void*)fwd_megakernel, dim3(grid_blocks), dim3(NTHR), args, LDS_BYTES, stream);
    if (e != hipSuccess) fprintf(stderr, "cooperative launch failed: %s (grid %d)\n", hipGetErrorString(e), grid_blocks);
}
```

```cpp
#include <hip/hip_runtime.h>
#include <hip/hip_cooperative_groups.h>
#include <cstdio>
#include <cstdint>
#include <type_traits>
namespace cg = cooperative_groups;

#define LAS __attribute__((address_space(3)))
typedef unsigned short bf16_t;
typedef short bf16x8 __attribute__((ext_vector_type(8)));
typedef short s16x4 __attribute__((ext_vector_type(4)));
typedef float f32x2 __attribute__((ext_vector_type(2)));
typedef float f32x4 __attribute__((ext_vector_type(4)));
typedef float f32x16 __attribute__((ext_vector_type(16)));
typedef unsigned u32x2 __attribute__((ext_vector_type(2)));
typedef unsigned u32x4 __attribute__((ext_vector_type(4)));

constexpr int NB = 32, SEQ = 2048, DM = 1024, NTOK = NB * SEQ;
constexpr int INCOLS = 5632;
constexpr int NTHR = 512;
constexpr int LDS_BYTES = 147456;
constexpr float ALPHA = 1.189207115002721f;
constexpr float LN_EPS = 1e-5f, RMS_EPS = 1e-6f;
constexpr float LOG2E = 1.4426950408889634f;

constexpr size_t SZ_T512 = (size_t)NTOK * 512 * 2, SZ_T1024 = (size_t)NTOK * 1024 * 2;
constexpr size_t OFF_ADA = 0;
constexpr size_t OFF_LB = OFF_ADA + 786432;
constexpr size_t OFF_KMEAN = OFF_LB + 4096;
constexpr size_t OFF_WIN = OFF_KMEAN + 524288;
constexpr size_t OFF_WBA = OFF_WIN + (size_t)5632 * 1024 * 2;
constexpr size_t OFF_WBB = OFF_WBA + 1048576;
constexpr size_t OFF_WOUT = OFF_WBB + 1048576;
constexpr size_t OFF_WQ = OFF_WOUT + 2097152;
constexpr size_t OFF_SK = OFF_WQ + 2097152;
constexpr size_t OFF_U8 = OFF_SK + 262144;
constexpr size_t OFF_USC = OFF_U8 + 8388608;
constexpr size_t OFF_V8 = OFF_U8 + 16777216;
constexpr size_t OFF_VSC = OFF_V8 + 8388608;
constexpr size_t OFF_CTR = OFF_V8 + 16777216;
constexpr size_t OFF_BAR = OFF_CTR + 4096;
constexpr size_t OFF_EG = OFF_BAR + 16384;
constexpr size_t OFF_H = OFF_EG + (size_t)NTOK * 128 * 8;
constexpr size_t OFF_QA = OFF_H + SZ_T1024;
constexpr size_t OFF_KA = OFF_QA + SZ_T512;
constexpr size_t OFF_VA = OFF_KA + SZ_T512;
constexpr size_t OFF_HQ = OFF_VA + SZ_T512;
constexpr size_t OFF_HK = OFF_HQ + SZ_T512;
constexpr size_t OFF_HI = OFF_HK + SZ_T512;
constexpr size_t OFF_HG = OFF_HI + SZ_T512;
constexpr size_t OFF_GA = OFF_HG + SZ_T512;
constexpr size_t OFF_GB = OFF_GA + SZ_T1024;
constexpr size_t WS_END = OFF_GB + SZ_T1024;
constexpr size_t OFF_H8 = OFF_VA;
constexpr size_t OFF_HS = OFF_HQ;
constexpr size_t OFF_W = OFF_KA;
constexpr size_t OFF_Y = OFF_KA;

struct Params {
    const float *x, *c, *w_ada, *b_ada, *w_in, *w_ba, *w_bb, *w_out, *hgrn_lb, *hgrn_ng, *ln1_g, *ln1_b, *peer_wq, *peer_sk, *peer_u, *peer_v, *ln2_g, *ln2_b;
    float* out;
    unsigned char* ws;
};

typedef __bf16 bf16v2 __attribute__((ext_vector_type(2)));
__device__ __forceinline__ unsigned cvt_pk_bf16(float lo, float hi) { return __builtin_bit_cast(unsigned, __builtin_convertvector((f32x2){lo, hi}, bf16v2)); }
__device__ __forceinline__ float bf_lo(unsigned w) { return __uint_as_float(w << 16); }
__device__ __forceinline__ float bf_hi(unsigned w) { return __uint_as_float(w & 0xffff0000u); }
__device__ __forceinline__ float sigmoidf_(float x) { return 1.0f / (1.0f + __expf(-x)); }
__device__ __forceinline__ float wave_sum(float v) {
#pragma unroll
    for (int o = 1; o < 64; o <<= 1) v += __shfl_xor(v, o);
    return v;
}
__device__ __forceinline__ int tid_opaque() { int t = threadIdx.x; asm volatile("" : "+v"(t)); return t; }
__device__ __forceinline__ int crow(int r, int hi) { return (r & 3) + 8 * (r >> 2) + 4 * hi; }
#define MFMA32(a, b, c) __builtin_amdgcn_mfma_f32_32x32x16_bf16(a, b, c, 0, 0, 0)

namespace pg8 {
constexpr int BM = 256, BK = 64, HALF = 128, HTB = HALF * BK * 2, STAGE_BYTES = 8 * HTB, NXCD = 8, WGM = 8;
__host__ __device__ __forceinline__ int lds_byte(int r, int c) { const int st = (r >> 4) * 2 + (c >> 5), rr = r & 15, cc = c & 31, ob = rr * 64 + cc * 2; return st * 1024 + (ob ^ (((ob >> 9) & 1) << 5)); }
__host__ __device__ __forceinline__ void stage_rc(int b, int& R, int& C) { const int st = b / 1024, sb = b % 1024, swz = sb ^ (((sb >> 9) & 1) << 5); R = (st >> 1) * 16 + swz / 64; C = (st & 1) * 32 + (swz % 64) / 2; }
__host__ __device__ __forceinline__ int perm32(int rho) { const int n = rho >> 4, i = rho & 15; return 8 * (i >> 2) + 4 * n + (i & 3); }

struct Unit { int pm, pn; };
struct Gemm { const bf16_t* A; const bf16_t* Bt; int M, N, K, lda; };

struct StaticOrder {
    int nM, nN, nwg, G, c;
    __device__ void init(int M, int N, int G_, int c_) { nM = M / BM; nN = N / BM; nwg = nM * nN; G = G_; c = c_; }
    __device__ bool next(int i, Unit& u) const {
        const long L = (long)i * G + c; if (L >= nwg) return false;
        int wgid = (int)L; { const int q = nwg / NXCD, r = nwg % NXCD, xcd = wgid % NXCD, off = wgid / NXCD; wgid = (xcd < r ? xcd * (q + 1) : r * (q + 1) + (xcd - r) * q) + off; }
        const int nig = WGM * nN, gid = wgid / nig, fm = gid * WGM, gsz = (nM - fm) < WGM ? (nM - fm) : WGM;
        u.pm = fm + ((wgid % nig) % gsz); u.pn = (wgid % nig) / gsz; return true;
    }
};
struct PanelOrder {
    int pm, npn;
    __device__ bool next(int i, Unit& u) const { if (i >= npn) return false; u.pm = pm; u.pn = i; return true; }
};

template <class Epi, class Sched, bool MX = false>
__device__ __forceinline__ void gemm_phase(LAS unsigned char* lds, const Gemm g, const Sched& S, const Epi& E) {
    const int tid = tid_opaque(), wid = __builtin_amdgcn_readfirstlane(tid >> 6), lane = tid & 63, wr = wid >> 2, wc = wid & 3, fr = lane & 15, fq = lane >> 4;
    const int K = g.K, nt = K / BK;
    unsigned voffA, voffB;
    { int R, C; stage_rc(tid * 16, R, C); const int Rb = Epi::PERM ? ((R & ~31) + perm32(R & 31)) : R;
      voffA = (unsigned)(R * g.lda + C) * 2u; voffB = (unsigned)(Rb * K + C) * 2u; }
    const size_t rvoffA = (size_t)128 * g.lda, rvoffB = (size_t)128 * K;
    const size_t kstep = (size_t)(BK * 2);
    const size_t hstep = (size_t)HALF * K * 2;
    const size_t tstep = 2 * hstep;
    const size_t hstepA = (size_t)HALF * g.lda * 2, tstepA = 2 * hstepA;
    const unsigned ldsw = (unsigned)wid * 1024u;
    const int aoff = lds_byte(wr * 64 + fr, fq * 8), boff = lds_byte(wc * 32 + fr, fq * 8);
#define PG8_SA(b, h) (((b) * 2 + (h)) * HTB)
#define PG8_SB(b, h) ((4 + (b) * 2 + (h)) * HTB)
#define PG8_STAGE(bufoff, gbase, voff) do { unsigned vo_ = (voff); asm volatile("" : "+v"(vo_));     \
        _Pragma("unroll") for (int _i = 0; _i < 2; ++_i) \
        __builtin_amdgcn_global_load_lds((const unsigned*)((const char*)(gbase) + _i * r##voff + vo_), (LAS unsigned*)(lds + (bufoff) + ldsw + _i * 8192), 16, 0, 0); } while (0)
#define PG8_LDX(dst, off) do { const v4i_ lo_ = *(const LAS v4i_*)(lds + (off)), hi_ = *(const LAS v4i_*)(lds + (off) + 1024); dst = __builtin_shufflevector(lo_, hi_, 0, 1, 2, 3, 4, 5, 6, 7); } while (0)
#define PG8_LDA(dst, b, h) do { if constexpr (MX) { _Pragma("unroll") for (int m = 0; m < 4; ++m) PG8_LDX(dst##X[m], PG8_SA(b, h) + aoff + m * 2048); } \
        else { _Pragma("unroll") for (int m = 0; m < 4; ++m) _Pragma("unroll") for (int k = 0; k < 2; ++k) dst[m][k] = *(const LAS bf16x8*)(lds + PG8_SA(b, h) + aoff + m * 2048 + k * 1024); } } while (0)
#define PG8_LDB(dst, b, h) do { if constexpr (MX) { _Pragma("unroll") for (int n = 0; n < 2; ++n) PG8_LDX(dst##X[n], PG8_SB(b, h) + boff + n * 2048); } \
        else { _Pragma("unroll") for (int n = 0; n < 2; ++n) _Pragma("unroll") for (int k = 0; k < 2; ++k) dst[n][k] = *(const LAS bf16x8*)(lds + PG8_SB(b, h) + boff + n * 2048 + k * 1024); } } while (0)
#define PG8_MMA(ai, bj, At, Bt) do { __builtin_amdgcn_s_setprio(1); \
        if constexpr (MX) { _Pragma("unroll") for (int m = 0; m < 4; ++m) _Pragma("unroll") for (int n = 0; n < 2; ++n) \
            asm volatile("v_mfma_scale_f32_16x16x128_f8f6f4 %0, %1, %2, %0, %3, %3 op_sel_hi:[0,0,0]" : "+v"(acc[ai][bj][m][n]) : "v"(Bt##X[n]), "v"(At##X[m]), "v"(mxscale)); } \
        else { _Pragma("unroll") for (int m = 0; m < 4; ++m) _Pragma("unroll") for (int n = 0; n < 2; ++n) _Pragma("unroll") for (int k = 0; k < 2; ++k) \
            acc[ai][bj][m][n] = __builtin_amdgcn_mfma_f32_16x16x32_bf16(Bt[n][k], At[m][k], acc[ai][bj][m][n], 0, 0, 0); } \
        __builtin_amdgcn_s_setprio(0); } while (0)
#define PG8_WAIT_V(n) asm volatile("s_waitcnt vmcnt(" #n ")" ::: "memory")
#define PG8_WAIT_L(n) asm volatile("s_waitcnt lgkmcnt(" #n ")" ::: "memory")
#define PG8_BAR __builtin_amdgcn_s_barrier()
#define PG8_SCHED __builtin_amdgcn_sched_barrier(0)
    Unit cur, nxt; int ui = 0;
    if (!S.next(0, cur)) return;
    f32x4 acc[2][2][4][2];
#pragma unroll
    for (int a = 0; a < 2; ++a)
#pragma unroll
        for (int b = 0; b < 2; ++b)
#pragma unroll
            for (int m = 0; m < 4; ++m)
#pragma unroll
                for (int n = 0; n < 2; ++n) acc[a][b][m][n] = (f32x4){0.f, 0.f, 0.f, 0.f};
    typedef int v4i_ __attribute__((ext_vector_type(4))); typedef int v8i_ __attribute__((ext_vector_type(8)));
    bf16x8 At[4][2], B0[2][2], B1[2][2];
    v8i_ AtX[4], B0X[2], B1X[2];
    const int mxscale = 0x7f7f7f7f;
    const char* cA = (const char*)g.A + (size_t)cur.pm * tstepA; const char* cB = (const char*)g.Bt + (size_t)cur.pn * tstep;
    PG8_STAGE(PG8_SB(0, 0), cB, voffB); PG8_STAGE(PG8_SA(0, 0), cA, voffA); PG8_STAGE(PG8_SB(0, 1), cB + hstep, voffB); PG8_STAGE(PG8_SA(0, 1), cA + hstepA, voffA);
    if (wr == 1) PG8_BAR;
    PG8_WAIT_V(4); PG8_BAR;
    PG8_STAGE(PG8_SB(1, 0), cB + kstep, voffB); PG8_STAGE(PG8_SA(1, 0), cA + kstep, voffA); PG8_STAGE(PG8_SB(1, 1), cB + hstep + kstep, voffB);
    PG8_WAIT_V(6); PG8_BAR;
    for (;;) {
        const bool has_next = S.next(ui + 1, nxt);
        const char* nA = has_next ? (const char*)g.A + (size_t)nxt.pm * tstepA : cA; const char* nB = has_next ? (const char*)g.Bt + (size_t)nxt.pn * tstep : cB;
        for (int t = 0; t < nt; t += 2) {
            const bool last = (t == nt - 2);
            const char* a1 = cA + (size_t)(t + 1) * kstep;
            const char* a2 = last ? nA : cA + (size_t)(t + 2) * kstep; const char* b2 = last ? nB : cB + (size_t)(t + 2) * kstep;
            const char* a3 = a2 + kstep; const char* b3 = b2 + kstep;
            PG8_LDB(B0, 0, 0); PG8_SCHED; PG8_LDA(At, 0, 0); PG8_STAGE(PG8_SA(1, 1), a1 + hstepA, voffA);
            PG8_WAIT_L(8); PG8_BAR; PG8_WAIT_L(0); PG8_MMA(0, 0, At, B0); PG8_BAR; PG8_SCHED;
            PG8_LDB(B1, 0, 1); PG8_STAGE(PG8_SB(0, 0), b2, voffB);
            PG8_BAR; PG8_WAIT_L(0); PG8_MMA(0, 1, At, B1); PG8_BAR;
            PG8_LDA(At, 0, 1); PG8_STAGE(PG8_SA(0, 0), a2, voffA);
            PG8_BAR; PG8_WAIT_L(0); PG8_MMA(1, 0, At, B0); PG8_BAR; PG8_SCHED;
            PG8_STAGE(PG8_SB(0, 1), b2 + hstep, voffB);
            PG8_WAIT_V(6); PG8_BAR; PG8_MMA(1, 1, At, B1); PG8_BAR;
            PG8_LDB(B0, 1, 0); PG8_SCHED; PG8_LDA(At, 1, 0); PG8_STAGE(PG8_SA(0, 1), a2 + hstepA, voffA);
            PG8_WAIT_L(8); PG8_BAR; PG8_WAIT_L(0); PG8_MMA(0, 0, At, B0); PG8_BAR; PG8_SCHED;
            PG8_LDB(B1, 1, 1); PG8_STAGE(PG8_SB(1, 0), b3, voffB);
            PG8_BAR; PG8_WAIT_L(0); PG8_MMA(0, 1, At, B1); PG8_BAR;
            PG8_LDA(At, 1, 1); PG8_STAGE(PG8_SA(1, 0), a3, voffA);
            PG8_BAR; PG8_WAIT_L(0); PG8_MMA(1, 0, At, B0); PG8_BAR; PG8_SCHED;
            PG8_STAGE(PG8_SB(1, 1), b3 + hstep, voffB);
            PG8_WAIT_V(6); PG8_BAR; PG8_MMA(1, 1, At, B1); PG8_BAR;
        }
        if constexpr (MX) asm volatile("s_nop 15\n\ts_nop 15" ::: "memory");
        E(acc, cur, wr, wc, fr, fq);
        if (!has_next) break;
#pragma unroll
        for (int a = 0; a < 2; ++a)
#pragma unroll
            for (int b = 0; b < 2; ++b)
#pragma unroll
                for (int m = 0; m < 4; ++m)
#pragma unroll
                    for (int n = 0; n < 2; ++n) acc[a][b][m][n] = (f32x4){0.f, 0.f, 0.f, 0.f};
        cur = nxt; cA = nA; cB = nB; ++ui;
    }
    PG8_WAIT_V(0);
    if (wr == 0) PG8_BAR;
    PG8_BAR;
#undef PG8_SA
#undef PG8_SB
#undef PG8_STAGE
#undef PG8_LDX
#undef PG8_LDA
#undef PG8_LDB
#undef PG8_MMA
#undef PG8_WAIT_V
#undef PG8_WAIT_L
#undef PG8_BAR
#undef PG8_SCHED
}
}
using pg8::Unit;

struct EpiProj {
    static constexpr bool PERM = true;
    unsigned char* ws; const float* lb; const float* ng; float* kmean;
    __device__ __forceinline__ void operator()(const f32x4 (&acc)[2][2][4][2], const Unit& u, int wr, int wc, int fr, int fq) const {
        const int pn = u.pn; int seg, colt, ldc; size_t boff;
        if (pn < 14) { seg = pn >> 1; colt = (pn & 1) * 256; ldc = 512; boff = OFF_QA + (size_t)seg * SZ_T512; }
        else if (pn < 18) { seg = 7; colt = (pn - 14) * 256; ldc = 1024; boff = OFF_GA; }
        else { seg = 8; colt = (pn - 18) * 256; ldc = 1024; boff = OFF_GB; }
        bf16_t* base = (bf16_t*)(ws + boff);
        const int row0 = u.pm * 256 + wr * 64 + fr, col0 = colt + wc * 32 + 8 * fq;
        float pv[2][8];
#pragma unroll
        for (int bj = 0; bj < 2; ++bj)
#pragma unroll
            for (int e = 0; e < 8; ++e) pv[bj][e] = (seg == 4) ? (1.0f - lb[col0 + bj * 128 + e]) : ((seg == 6) ? ng[col0 + bj * 128 + e] : 0.f);
        float cs[2][8];
#pragma unroll
        for (int bj = 0; bj < 2; ++bj)
#pragma unroll
            for (int e = 0; e < 8; ++e) cs[bj][e] = 0.f;
#pragma unroll
        for (int ai = 0; ai < 2; ++ai)
#pragma unroll
            for (int m = 0; m < 4; ++m) {
                bf16_t* rowp = base + (size_t)(row0 + ai * 128 + m * 16) * ldc + col0;
#pragma unroll
                for (int bj = 0; bj < 2; ++bj) {
                    float v[8];
#pragma unroll
                    for (int e = 0; e < 4; ++e) { v[e] = acc[ai][bj][m][0][e] * (1.0f / 32.0f); v[4 + e] = acc[ai][bj][m][1][e] * (1.0f / 32.0f); }
                    if (seg == 0) {
#pragma unroll
                        for (int e = 0; e < 8; ++e) v[e] *= (0.125f * LOG2E);
                    } else if (seg == 1) {
#pragma unroll
                        for (int e = 0; e < 8; ++e) cs[bj][e] += v[e];
                    } else if (seg == 3) {
#pragma unroll
                        for (int e = 0; e < 8; ++e) v[e] = v[e] * sigmoidf_(v[e]);
                    } else if (seg == 4) {
#pragma unroll
                        for (int e = 0; e < 8; ++e) v[e] = pv[bj][e] * sigmoidf_(-v[e]);
                    } else if (seg == 6) {
#pragma unroll
                        for (int e = 0; e < 8; ++e) v[e] = pv[bj][e] * v[e] * sigmoidf_(v[e]);
                    } else if (seg >= 7) {
#pragma unroll
                        for (int e = 0; e < 8; ++e) v[e] = sigmoidf_(v[e]);
                    }
                    u32x4 w; w.x = cvt_pk_bf16(v[0], v[1]); w.y = cvt_pk_bf16(v[2], v[3]); w.z = cvt_pk_bf16(v[4], v[5]); w.w = cvt_pk_bf16(v[6], v[7]);
                    *(u32x4*)(rowp + bj * 128) = w;
                }
            }
        if (seg == 1) {
#pragma unroll
            for (int bj = 0; bj < 2; ++bj)
#pragma unroll
                for (int e = 0; e < 8; ++e) {
                    float s = cs[bj][e];
                    s += __shfl_xor(s, 1); s += __shfl_xor(s, 2); s += __shfl_xor(s, 4); s += __shfl_xor(s, 8);
                    if (fr == 0) atomicAdd(kmean + (size_t)u.pm * 512 + col0 + bj * 128 + e, s);
                }
        }
    }
};
struct EpiMixA {
    static constexpr bool PERM = true;
    bf16_t* GA;
    __device__ __forceinline__ void operator()(const f32x4 (&acc)[2][2][4][2], const Unit& u, int wr, int wc, int fr, int fq) const {
        const int row0 = u.pm * 256 + wr * 64 + fr, col0 = u.pn * 256 + wc * 32 + 8 * fq;
#pragma unroll
        for (int ai = 0; ai < 2; ++ai)
#pragma unroll
            for (int m = 0; m < 4; ++m) {
                bf16_t* rowp = GA + (size_t)(row0 + ai * 128 + m * 16) * 1024 + col0;
#pragma unroll
                for (int bj = 0; bj < 2; ++bj) {
                    const u32x4 g = *(const u32x4*)(rowp + bj * 128);
                    const f32x4 a0 = acc[ai][bj][m][0], a1 = acc[ai][bj][m][1];
                    u32x4 w;
                    constexpr float S = 1.0f / 32.0f;
                    w.x = cvt_pk_bf16(bf_lo(g.x) * a0[0] * S, bf_hi(g.x) * a0[1] * S); w.y = cvt_pk_bf16(bf_lo(g.y) * a0[2] * S, bf_hi(g.y) * a0[3] * S);
                    w.z = cvt_pk_bf16(bf_lo(g.z) * a1[0] * S, bf_hi(g.z) * a1[1] * S); w.w = cvt_pk_bf16(bf_lo(g.w) * a1[2] * S, bf_hi(g.w) * a1[3] * S);
                    *(u32x4*)(rowp + bj * 128) = w;
                }
            }
    }
};
struct EpiMixB {
    static constexpr bool PERM = true;
    const bf16_t* GA; const bf16_t* GB; unsigned char* M8;
    __device__ __forceinline__ void operator()(const f32x4 (&acc)[2][2][4][2], const Unit& u, int wr, int wc, int fr, int fq) const {
        const int row0 = u.pm * 256 + wr * 64 + fr, col0 = u.pn * 256 + wc * 32 + 8 * fq;
#pragma unroll
        for (int ai = 0; ai < 2; ++ai)
#pragma unroll
            for (int m = 0; m < 4; ++m) {
                const size_t off = (size_t)(row0 + ai * 128 + m * 16) * 1024 + col0;
#pragma unroll
                for (int bj = 0; bj < 2; ++bj) {
                    const u32x4 g = *(const u32x4*)(GB + off + bj * 128);
                    const u32x4 mx = *(const u32x4*)(GA + off + bj * 128);
                    const f32x4 a0 = acc[ai][bj][m][0], a1 = acc[ai][bj][m][1];
                    constexpr float S = 1.0f / 32.0f;
                    int w0 = __builtin_amdgcn_cvt_pk_fp8_f32(bf_lo(mx.x) + bf_lo(g.x) * a0[0] * S, bf_hi(mx.x) + bf_hi(g.x) * a0[1] * S, 0, false); w0 = __builtin_amdgcn_cvt_pk_fp8_f32(bf_lo(mx.y) + bf_lo(g.y) * a0[2] * S, bf_hi(mx.y) + bf_hi(g.y) * a0[3] * S, w0, true);
                    int w1 = __builtin_amdgcn_cvt_pk_fp8_f32(bf_lo(mx.z) + bf_lo(g.z) * a1[0] * S, bf_hi(mx.z) + bf_hi(g.z) * a1[1] * S, 0, false); w1 = __builtin_amdgcn_cvt_pk_fp8_f32(bf_lo(mx.w) + bf_lo(g.w) * a1[2] * S, bf_hi(mx.w) + bf_hi(g.w) * a1[3] * S, w1, true);
                    *(u32x2*)(M8 + off + bj * 128) = (u32x2){(unsigned)w0, (unsigned)w1};
                }
            }
    }
};
struct EpiOut {
    static constexpr bool PERM = true;
    const float* ada; bf16_t* D;
    __device__ __forceinline__ void operator()(const f32x4 (&acc)[2][2][4][2], const Unit& u, int wr, int wc, int fr, int fq) const {
        const int row0 = u.pm * 256 + wr * 64 + fr, col0 = u.pn * 256 + wc * 32 + 8 * fq;
        const float* gt1 = ada + (size_t)(u.pm >> 3) * 6144 + 2048 + col0;
        f32x4 g[2][2];
#pragma unroll
        for (int bj = 0; bj < 2; ++bj) { g[bj][0] = *(const f32x4*)(gt1 + bj * 128); g[bj][1] = *(const f32x4*)(gt1 + bj * 128 + 4); }
#pragma unroll
        for (int ai = 0; ai < 2; ++ai)
#pragma unroll
            for (int m = 0; m < 4; ++m) {
                bf16_t* rowp = D + (size_t)(row0 + ai * 128 + m * 16) * 1024 + col0;
#pragma unroll
                for (int bj = 0; bj < 2; ++bj) {
                    const f32x4 a0 = acc[ai][bj][m][0] * g[bj][0] * (1.0f / 32.0f), a1 = acc[ai][bj][m][1] * g[bj][1] * (1.0f / 32.0f);
                    u32x4 w; w.x = cvt_pk_bf16(a0[0], a0[1]); w.y = cvt_pk_bf16(a0[2], a0[3]); w.z = cvt_pk_bf16(a1[0], a1[1]); w.w = cvt_pk_bf16(a1[2], a1[3]);
                    *(u32x4*)(rowp + bj * 128) = w;
                }
            }
    }
};
struct EpiBf16 {
    static constexpr bool PERM = true;
    bf16_t* O;
    __device__ __forceinline__ void operator()(const f32x4 (&acc)[2][2][4][2], const Unit& u, int wr, int wc, int fr, int fq) const {
        const int row0 = u.pm * 256 + wr * 64 + fr, col0 = u.pn * 256 + wc * 32 + 8 * fq;
#pragma unroll
        for (int ai = 0; ai < 2; ++ai)
#pragma unroll
            for (int m = 0; m < 4; ++m) {
                bf16_t* rowp = O + (size_t)(row0 + ai * 128 + m * 16) * 1024 + col0;
#pragma unroll
                for (int bj = 0; bj < 2; ++bj) {
                    const f32x4 a0 = acc[ai][bj][m][0], a1 = acc[ai][bj][m][1];
                    u32x4 w; w.x = cvt_pk_bf16(a0[0], a0[1]); w.y = cvt_pk_bf16(a0[2], a0[3]); w.z = cvt_pk_bf16(a1[0], a1[1]); w.w = cvt_pk_bf16(a1[2], a1[3]);
                    *(u32x4*)(rowp + bj * 128) = w;
                }
            }
    }
};

__device__ void phase0a(const Params& P, LAS unsigned char* lds) {
    const int tid = tid_opaque(), G = gridDim.x, bid = blockIdx.x;
    for (int it = bid; it < 192; it += G) {
        LAS float* sc = (LAS float*)lds;
        for (int i = tid; i < 32 * 1024; i += NTHR) { const float cv = P.c[i]; sc[i] = cv * sigmoidf_(cv); }
        __syncthreads();
        const int kg = tid >> 5, col = tid & 31;
        float a[32];
#pragma unroll
        for (int b = 0; b < 32; ++b) a[b] = 0.f;
#pragma unroll 1
        for (int k = kg * 64; k < kg * 64 + 64; k += 8) {
            float w[8];
#pragma unroll
            for (int e = 0; e < 8; ++e) w[e] = __builtin_nontemporal_load(P.w_ada + (size_t)(k + e) * 6144 + it * 32 + col);
#pragma unroll
            for (int e4 = 0; e4 < 2; ++e4) {
#pragma unroll
                for (int b = 0; b < 32; ++b) { const f32x4 s = *(const LAS f32x4*)(sc + b * 1024 + k + 4 * e4); a[b] += s[0] * w[4 * e4] + s[1] * w[4 * e4 + 1] + s[2] * w[4 * e4 + 2] + s[3] * w[4 * e4 + 3]; }
                asm volatile("" ::: "memory");
            }
        }
        __syncthreads();
        LAS float* red = (LAS float*)lds;
#pragma unroll
        for (int b = 0; b < 32; ++b) red[(kg * 32 + b) * 32 + col] = a[b];
        __syncthreads();
        for (int o = tid; o < 1024; o += NTHR) { const int b = o >> 5, cc = o & 31; float s = 0.f;
#pragma unroll
            for (int g2 = 0; g2 < 16; ++g2) s += red[(g2 * 32 + b) * 32 + cc];
            ((float*)(P.ws + OFF_ADA))[(size_t)b * 6144 + it * 32 + cc] = s + P.b_ada[it * 32 + cc]; }
        __syncthreads();
    }
    const size_t gsz = (size_t)G * NTHR;
    { const int gt = bid * NTHR + tid, gs = G * NTHR;
      if (gt < 512) ((float*)(P.ws + OFF_LB))[gt] = sigmoidf_(P.hgrn_lb[gt] - P.hgrn_lb[512 + gt]);
      for (int i = gt; i < 32 * 8 * 512; i += gs) ((float*)(P.ws + OFF_KMEAN))[i] = 0.f; }
    {
        LAS float* tile = (LAS float*)lds;
        const int I0 = 16 * 88, I1 = I0 + 8 * 16, I2 = I1 + 8 * 16, I3 = I2 + 16 * 16, I4 = I3 + 16 * 16;
        for (int it = bid; it < I4; it += G) {
            const float* W; bf16_t* WT; int K, N, r;
            if (it < I0) { W = P.w_in; WT = (bf16_t*)(P.ws + OFF_WIN); K = 1024; N = 5632; r = it; }
            else if (it < I1) { W = P.w_ba; WT = (bf16_t*)(P.ws + OFF_WBA); K = 512; N = 1024; r = it - I0; }
            else if (it < I2) { W = P.w_bb; WT = (bf16_t*)(P.ws + OFF_WBB); K = 512; N = 1024; r = it - I1; }
            else if (it < I3) { W = P.w_out; WT = (bf16_t*)(P.ws + OFF_WOUT); K = 1024; N = 1024; r = it - I2; }
            else { W = P.peer_wq; WT = (bf16_t*)(P.ws + OFF_WQ); K = 1024; N = 1024; r = it - I3; }
            const int nb = N / 64, k0 = (r / nb) * 64, n0 = (r % nb) * 64;
#pragma unroll
            for (int ps = 0; ps < 2; ++ps) { const int kk = (tid >> 4) + 32 * ps, n4 = (tid & 15) * 4;
                const f32x4 v = *(const f32x4*)(W + (size_t)(k0 + kk) * N + n0 + n4);
                tile[kk * 65 + n4] = v[0]; tile[kk * 65 + n4 + 1] = v[1]; tile[kk * 65 + n4 + 2] = v[2]; tile[kk * 65 + n4 + 3] = v[3]; }
            __syncthreads();
            { const int n = tid >> 3, kc = (tid & 7) * 8;
              if (it < I3) {
                  int w0 = __builtin_amdgcn_cvt_pk_fp8_f32(32.f * tile[(kc + 0) * 65 + n], 32.f * tile[(kc + 1) * 65 + n], 0, false); w0 = __builtin_amdgcn_cvt_pk_fp8_f32(32.f * tile[(kc + 2) * 65 + n], 32.f * tile[(kc + 3) * 65 + n], w0, true);
                  int w1 = __builtin_amdgcn_cvt_pk_fp8_f32(32.f * tile[(kc + 4) * 65 + n], 32.f * tile[(kc + 5) * 65 + n], 0, false); w1 = __builtin_amdgcn_cvt_pk_fp8_f32(32.f * tile[(kc + 6) * 65 + n], 32.f * tile[(kc + 7) * 65 + n], w1, true);
                  *(u32x2*)((unsigned char*)WT + (size_t)(n0 + n) * K + k0 + kc) = (u32x2){(unsigned)w0, (unsigned)w1};
              } else { u32x4 w;
              w.x = cvt_pk_bf16(tile[(kc + 0) * 65 + n], tile[(kc + 1) * 65 + n]); w.y = cvt_pk_bf16(tile[(kc + 2) * 65 + n], tile[(kc + 3) * 65 + n]);
              w.z = cvt_pk_bf16(tile[(kc + 4) * 65 + n], tile[(kc + 5) * 65 + n]); w.w = cvt_pk_bf16(tile[(kc + 6) * 65 + n], tile[(kc + 7) * 65 + n]);
              *(u32x4*)(WT + (size_t)(n0 + n) * K + k0 + kc) = w; } }
            __syncthreads();
        }
    }
    {
        const size_t gtid = (size_t)bid * NTHR + tid_opaque();
        for (size_t i = gtid; i < 16384; i += gsz) {
            const float* src = P.peer_sk + i * 8; const f32x4 a = *(const f32x4*)src, b = *(const f32x4*)(src + 4);
            u32x4 w; w.x = cvt_pk_bf16(a[0], a[1]); w.y = cvt_pk_bf16(a[2], a[3]); w.z = cvt_pk_bf16(b[0], b[1]); w.w = cvt_pk_bf16(b[2], b[3]);
            *(u32x4*)((bf16_t*)(P.ws + OFF_SK) + i * 8) = w;
        }
        { const int lane = tid & 63, gw = bid * 8 + (tid >> 6), ngw = G * 8;
          for (int r = gw; r < 2 * 16384; r += ngw) {
              const bool isv = r >= 16384; const int e = isv ? r - 16384 : r;
              const float* s = (isv ? P.peer_v : P.peer_u) + (size_t)e * 1024 + lane * 16;
              f32x4 x[4]; float ss = 0.f;
#pragma unroll
              for (int q = 0; q < 4; ++q) { x[q] = __builtin_nontemporal_load((const f32x4*)(s + 4 * q)); ss += (x[q][0] * x[q][0] + x[q][1] * x[q][1]) + (x[q][2] * x[q][2] + x[q][3] * x[q][3]); }
              const float sc = fmaxf(sqrtf(wave_sum(ss) * (1.0f / 1024.0f)) * (2.6f / 7.5f), 1e-30f), inv = 1.0f / sc;
              unsigned nb[16];
#pragma unroll
              for (int q = 0; q < 4; ++q)
#pragma unroll
                  for (int el = 0; el < 4; ++el) nb[4 * q + el] = (unsigned)fminf(fmaxf(floorf(x[q][el] * inv) + 8.0f, 0.0f), 15.0f);
              u32x2 w;
              w.x = (nb[0] | (nb[4] << 4)) | ((nb[1] | (nb[5] << 4)) << 8) | ((nb[2] | (nb[6] << 4)) << 16) | ((nb[3] | (nb[7] << 4)) << 24);
              w.y = (nb[8] | (nb[12] << 4)) | ((nb[9] | (nb[13] << 4)) << 8) | ((nb[10] | (nb[14] << 4)) << 16) | ((nb[11] | (nb[15] << 4)) << 24);
              *(u32x2*)(P.ws + (isv ? OFF_V8 : OFF_U8) + (size_t)e * 512 + lane * 8) = w;
              if (lane == 0) ((float*)(P.ws + (isv ? OFF_VSC : OFF_USC)))[e] = sc;
          } }
    }
}
__device__ void phase0b(const Params& P) {
    const size_t gtid = (size_t)blockIdx.x * NTHR + threadIdx.x, gsz = (size_t)gridDim.x * NTHR;
    const float* ada = (const float*)(P.ws + OFF_ADA); bf16_t* H = (bf16_t*)(P.ws + OFF_H);
    for (size_t i = gtid; i < (size_t)NTOK * 128; i += gsz) {
        const size_t row = i >> 7; const int c8 = (int)(i & 127) * 8; const int b = (int)(row >> 11);
        const float* xr = P.x + row * 1024 + c8; const float* sh = ada + (size_t)b * 6144 + c8; const float* sc = sh + 1024;
        const f32x4 x0 = *(const f32x4*)xr, x1 = *(const f32x4*)(xr + 4), s0 = *(const f32x4*)sc, s1 = *(const f32x4*)(sc + 4), h0 = *(const f32x4*)sh, h1 = *(const f32x4*)(sh + 4);
        const f32x4 r0 = x0 * (s0 + 1.0f) + h0, r1 = x1 * (s1 + 1.0f) + h1;
        int w0 = __builtin_amdgcn_cvt_pk_fp8_f32(r0[0], r0[1], 0, false); w0 = __builtin_amdgcn_cvt_pk_fp8_f32(r0[2], r0[3], w0, true);
        int w1 = __builtin_amdgcn_cvt_pk_fp8_f32(r1[0], r1[1], 0, false); w1 = __builtin_amdgcn_cvt_pk_fp8_f32(r1[2], r1[3], w1, true);
        *(u32x2*)((unsigned char*)H + row * 1024 + c8) = (u32x2){(unsigned)w0, (unsigned)w1};
    }
}

__device__ __forceinline__ s16x4 tr4(const LAS unsigned char* p) { return __builtin_bit_cast(s16x4, __builtin_amdgcn_ds_read_tr16_b64_v4i16((LAS s16x4*)p)); }
__device__ void hgrn_item(const Params& P, int item, LAS unsigned char* lds) {
    const int tid = tid_opaque(), lane = tid & 63, wid = __builtin_amdgcn_readfirstlane(tid >> 6), r32 = lane & 31, hi = lane >> 5;
    const int b = item >> 3, h = (item >> 1) & 3, vh = item & 1;
    const bf16_t* HQ = (const bf16_t*)(P.ws + OFF_HQ); const bf16_t* HK = (const bf16_t*)(P.ws + OFF_HK); bf16_t* HI = (bf16_t*)(P.ws + OFF_HI);
    constexpr int SQ = 272, SKD = 320, SV = 192, SS = 192;
    constexpr int LQR = 0, LKR = 17408, LQB = 34816, LKD = 52224, LV = 72704, LS = 84992, LG = 109568, LT = 142336, LCL = 144384;
    LAS float* G = (LAS float*)(lds + LG); LAS float* TOT = (LAS float*)(lds + LT); LAS float* CL = (LAS float*)(lds + LCL);
    const size_t rowb = (size_t)b * SEQ;
    const int row = tid >> 3, seg = tid & 7;
    const bf16_t* qsrc = HQ + (rowb + row) * 512 + h * 128 + seg * 16; const bf16_t* ksrc = HK + (rowb + row) * 512 + h * 128 + seg * 16;
    bf16_t* vsrc = HI + (rowb + row) * 512 + h * 128 + vh * 64 + seg * 8;
    for (int i = tid; i < 128 * SS / 4; i += NTHR) ((LAS unsigned*)(lds + LS))[i] = 0u;
    f32x16 Sacc = {};
    const int di = wid >> 1, vi = wid & 1, ti = wid >> 1;
    const int tg = lane >> 4, tc = tg & 1, tI = lane & 15;
    const int trow = 4 * hi + (tI >> 2), tcol = 16 * tc + 4 * (tI & 3);
    u32x4 qn0 = *(const u32x4*)qsrc, qn1 = *(const u32x4*)(qsrc + 8), kn0 = *(const u32x4*)ksrc, kn1 = *(const u32x4*)(ksrc + 8), vn = *(const u32x4*)vsrc;
#pragma unroll 1
    for (int n = 0; n < SEQ / 64; ++n) {
        const u32x4 q0 = qn0, q1 = qn1, k0 = kn0, k1 = kn1, vv = vn;
        float qf[16] = {bf_lo(q0.x), bf_hi(q0.x), bf_lo(q0.y), bf_hi(q0.y), bf_lo(q0.z), bf_hi(q0.z), bf_lo(q0.w), bf_hi(q0.w), bf_lo(q1.x), bf_hi(q1.x), bf_lo(q1.y), bf_hi(q1.y), bf_lo(q1.z), bf_hi(q1.z), bf_lo(q1.w), bf_hi(q1.w)};
        float kf[16] = {bf_lo(k0.x), bf_hi(k0.x), bf_lo(k0.y), bf_hi(k0.y), bf_lo(k0.z), bf_hi(k0.z), bf_lo(k0.w), bf_hi(k0.w), bf_lo(k1.x), bf_hi(k1.x), bf_lo(k1.y), bf_hi(k1.y), bf_lo(k1.z), bf_hi(k1.z), bf_lo(k1.w), bf_hi(k1.w)};
#pragma unroll
        for (int e4 = 0; e4 < 4; ++e4) *(LAS f32x4*)(G + row * 128 + seg * 16 + 4 * e4) = (f32x4){__logf(1.0f - kf[4 * e4]), __logf(1.0f - kf[4 * e4 + 1]), __logf(1.0f - kf[4 * e4 + 2]), __logf(1.0f - kf[4 * e4 + 3])};
        *(LAS u32x4*)(lds + LV + row * SV + seg * 16) = vv;
        if (n + 1 < SEQ / 64) { const size_t o = (size_t)(n + 1) * 64 * 512; qn0 = *(const u32x4*)(qsrc + o); qn1 = *(const u32x4*)(qsrc + o + 8); kn0 = *(const u32x4*)(ksrc + o); kn1 = *(const u32x4*)(ksrc + o + 8); vn = *(const u32x4*)(vsrc + o); }
        __syncthreads();
        { const int d = tid & 127, q4 = tid >> 7; float s = 0.f;
#pragma unroll
          for (int i = 0; i < 16; ++i) { s += G[(16 * q4 + i) * 128 + d]; G[(16 * q4 + i) * 128 + d] = s; }
          TOT[q4 * 128 + d] = s; }
        __syncthreads();
        {
            const int qq = row >> 4;
#pragma unroll
            for (int e4 = 0; e4 < 4; ++e4) {
                const int d4 = seg * 16 + 4 * e4;
                const f32x4 t0 = *(const LAS f32x4*)(TOT + d4), t1 = *(const LAS f32x4*)(TOT + 128 + d4), t2 = *(const LAS f32x4*)(TOT + 256 + d4), t3 = *(const LAS f32x4*)(TOT + 384 + d4);
                const f32x4 off = (qq == 0) ? (f32x4){0.f, 0.f, 0.f, 0.f} : ((qq == 1) ? t0 : ((qq == 2) ? t0 + t1 : t0 + t1 + t2));
                const f32x4 bb = *(const LAS f32x4*)(G + row * 128 + d4) + off;
                const f32x4 bref = *(const LAS f32x4*)(G + 32 * 128 + d4) + t0 + t1, blast = t0 + t1 + t2 + t3;
                float vqb[4], vqr[4], vkr[4], vkd[4];
#pragma unroll
                for (int e = 0; e < 4; ++e) {
                    const float e1 = __expf(bb[e]), e2 = __expf(-bb[e]);
                    vqb[e] = qf[4 * e4 + e] * e1; vqr[e] = vqb[e] * __expf(-bref[e]);
                    const float ke = kf[4 * e4 + e] * e2; vkr[e] = ke * __expf(bref[e]); vkd[e] = ke * __expf(blast[e]);
                }
                *(LAS u32x2*)(lds + LQB + row * SQ + seg * 32 + 8 * e4) = (u32x2){cvt_pk_bf16(vqb[0], vqb[1]), cvt_pk_bf16(vqb[2], vqb[3])};
                *(LAS u32x2*)(lds + LQR + row * SQ + seg * 32 + 8 * e4) = (u32x2){cvt_pk_bf16(vqr[0], vqr[1]), cvt_pk_bf16(vqr[2], vqr[3])};
                *(LAS u32x2*)(lds + LKR + row * SQ + seg * 32 + 8 * e4) = (u32x2){cvt_pk_bf16(vkr[0], vkr[1]), cvt_pk_bf16(vkr[2], vkr[3])};
                *(LAS u32x2*)(lds + LKD + row * SKD + seg * 32 + 8 * e4) = (u32x2){cvt_pk_bf16(vkd[0], vkd[1]), cvt_pk_bf16(vkd[2], vkd[3])};
                if (row == 0) *(LAS f32x4*)(CL + d4) = (f32x4){__expf(blast[0]), __expf(blast[1]), __expf(blast[2]), __expf(blast[3])};
                asm volatile("" ::: "memory");
            }
        }
        __syncthreads();
        if (wid < 4) {
            f32x16 Z = {};
            for (int si = 0; si <= ti; ++si) {
                f32x16 X = {};
#pragma unroll
                for (int ks = 0; ks < 8; ++ks) {
                    const bf16x8 a = *(const LAS bf16x8*)(lds + LKR + (32 * si + r32) * SQ + (16 * ks + 8 * hi) * 2);
                    const bf16x8 bq = *(const LAS bf16x8*)(lds + LQR + (32 * ti + r32) * SQ + (16 * ks + 8 * hi) * 2);
                    X = MFMA32(a, bq, X);
                }
                if (si == ti) {
#pragma unroll
                    for (int r = 0; r < 16; ++r) if (crow(r, hi) > r32) X[r] = 0.f;
                }
#pragma unroll
                for (int s2 = 0; s2 < 2; ++s2) {
                    union { u32x4 u; bf16x8 v; } pa;
                    pa.u.x = cvt_pk_bf16(X[8 * s2 + 0], X[8 * s2 + 1]); pa.u.y = cvt_pk_bf16(X[8 * s2 + 2], X[8 * s2 + 3]); pa.u.z = cvt_pk_bf16(X[8 * s2 + 4], X[8 * s2 + 5]); pa.u.w = cvt_pk_bf16(X[8 * s2 + 6], X[8 * s2 + 7]);
                    const LAS unsigned char* vp = lds + LV + (32 * si + 16 * s2 + trow) * SV + (32 * vi + tcol) * 2;
                    const s16x4 lo = tr4(vp), hh = tr4(vp + 8 * SV);
                    const bf16x8 vf = {lo[0], lo[1], lo[2], lo[3], hh[0], hh[1], hh[2], hh[3]};
                    Z = MFMA32(pa.v, vf, Z);
                }
            }
#pragma unroll
            for (int ks = 0; ks < 8; ++ks) {
                const bf16x8 a = *(const LAS bf16x8*)(lds + LQB + (32 * ti + r32) * SQ + (16 * ks + 8 * hi) * 2);
                const LAS unsigned char* sp = lds + LS + (16 * ks + 8 * hi + (tI >> 2)) * SS + (32 * vi + tcol) * 2;
                const s16x4 lo = tr4(sp), hh = tr4(sp + 4 * SS);
                const bf16x8 sf = {lo[0], lo[1], lo[2], lo[3], hh[0], hh[1], hh[2], hh[3]};
                Z = MFMA32(a, sf, Z);
            }
            bf16_t* op = HI + (rowb + (size_t)n * 64 + 32 * ti) * 512 + h * 128 + vh * 64 + 32 * vi + r32;
#pragma unroll
            for (int r = 0; r < 16; ++r) op[(size_t)crow(r, hi) * 512] = (bf16_t)(cvt_pk_bf16(Z[r], 0.f) & 0xffffu);
        }
        {
#pragma unroll
            for (int r = 0; r < 16; ++r) Sacc[r] *= CL[32 * di + crow(r, hi)];
#pragma unroll
            for (int ks = 0; ks < 4; ++ks) {
                const LAS unsigned char* kp = lds + LKD + (16 * ks + 8 * hi + (tI >> 2)) * SKD + (32 * di + tcol) * 2;
                const s16x4 klo = tr4(kp), khi = tr4(kp + 4 * SKD);
                const bf16x8 ka = {klo[0], klo[1], klo[2], klo[3], khi[0], khi[1], khi[2], khi[3]};
                const LAS unsigned char* vp = lds + LV + (16 * ks + 8 * hi + (tI >> 2)) * SV + (32 * vi + tcol) * 2;
                const s16x4 vlo = tr4(vp), vhi = tr4(vp + 4 * SV);
                const bf16x8 vb = {vlo[0], vlo[1], vlo[2], vlo[3], vhi[0], vhi[1], vhi[2], vhi[3]};
                Sacc = MFMA32(ka, vb, Sacc);
            }
        }
        __syncthreads();
        {
            LAS bf16_t* sp = (LAS bf16_t*)(lds + LS + (32 * di) * SS + (32 * vi + r32) * 2);
#pragma unroll
            for (int r = 0; r < 16; ++r) sp[crow(r, hi) * (SS / 2)] = (bf16_t)(cvt_pk_bf16(Sacc[r], 0.f) & 0xffffu);
        }
    }
    __syncthreads();
}

__device__ void moba_unit(const Params& P, int b, int h, int j, LAS unsigned char* lds) {
    const int tid = tid_opaque(), lane = tid & 63, wid = tid >> 6, r32 = lane & 31, hi = lane >> 5;
    bf16_t* Q = (bf16_t*)(P.ws + OFF_QA); const bf16_t* Kg = (const bf16_t*)(P.ws + OFF_KA); const bf16_t* Vg = (const bf16_t*)(P.ws + OFF_VA);
    const float* kmean = (const float*)(P.ws + OFF_KMEAN);
    constexpr int KIMG = 64 * 144, VIMG = 64 * 192, LK = 0, LV = 2 * KIMG, LKM = 2 * KIMG + 2 * VIMG;
    LAS float* kmL = (LAS float*)(lds + LKM);
    const size_t rowb = (size_t)b * SEQ; const int q0 = j * 256;
    if (tid < j * 64) kmL[tid] = kmean[(size_t)(b * 8 + (tid >> 6)) * 512 + h * 64 + (tid & 63)];
    bf16_t* qrow = Q + (rowb + q0 + wid * 32 + r32) * 512 + h * 64;
    bf16x8 qf[4];
#pragma unroll
    for (int d0 = 0; d0 < 4; ++d0) qf[d0] = *(const bf16x8*)(qrow + 16 * d0 + 8 * hi);
    const int srow = tid >> 3, sch = tid & 7;
    const bf16_t* ksrc = Kg + (rowb + srow) * 512 + h * 64 + sch * 8; const bf16_t* vsrc = Vg + (rowb + srow) * 512 + h * 64 + sch * 8;
    const int ntile = 4 * (j + 1);
    u32x4 kreg, vreg;
    { const int key0 = q0; kreg = *(const u32x4*)(ksrc + (size_t)key0 * 512); vreg = *(const u32x4*)(vsrc + (size_t)key0 * 512); }
    *(LAS u32x4*)(lds + LK + srow * 144 + sch * 16) = kreg; *(LAS u32x4*)(lds + LV + srow * 192 + sch * 16) = vreg;
    __syncthreads();
    unsigned sel = 0;
    if (j <= 3) sel = (1u << j) - 1u;
    else {
        float g[7];
#pragma unroll
        for (int n = 0; n < 7; ++n) { float s = 0.f;
            if (n < j) {
#pragma unroll
                for (int d0 = 0; d0 < 4; ++d0)
#pragma unroll
                    for (int e = 0; e < 8; ++e) s += __uint_as_float(((unsigned)(unsigned short)qf[d0][e]) << 16) * kmL[n * 64 + 16 * d0 + 8 * hi + e];
            }
            s += __shfl_xor(s, 32); g[n] = s; }
#pragma unroll
        for (int it = 0; it < 3; ++it) { float best = -INFINITY; int bi = 0;
#pragma unroll
            for (int n = 0; n < 7; ++n) if (n < j && !((sel >> n) & 1u) && g[n] > best) { best = g[n]; bi = n; }
            sel |= 1u << bi; }
    }
    const float ch = exp2f(-(float)(h + 1)) * LOG2E;
    const int qb = wid * 32 + r32;
    float m_run = -1e30f, l_run = 0.f;
    f32x16 o0 = {}, o1 = {};
    const int tg = lane >> 4, tc = tg & 1, ti = lane & 15;
    const int vlane = (4 * hi + (ti >> 2)) * 192 + (16 * tc + 4 * (ti & 3)) * 2;
#pragma unroll 1
    for (int i = 0; i < ntile; ++i) {
        const int buf = i & 1;
        const bool own = i < 4; const int blk = own ? j : ((i - 4) >> 2), kt = own ? i : ((i - 4) & 3);
        if (i + 1 < ntile) { const int i1 = i + 1; const int blk1 = (i1 < 4) ? j : ((i1 - 4) >> 2), kt1 = (i1 < 4) ? i1 : ((i1 - 4) & 3); const size_t key1 = (size_t)(blk1 * 256 + kt1 * 64);
            kreg = *(const u32x4*)(ksrc + key1 * 512); vreg = *(const u32x4*)(vsrc + key1 * 512); }
        const bool lane_ok = own ? true : (((sel >> blk) & 1u) != 0u);
        const bool skip = own ? (64 * kt > 32 * wid + 31) : (__ballot(lane_ok) == 0ull);
        if (!skip) {
            LAS unsigned char* kb = lds + LK + buf * KIMG; LAS unsigned char* vb = lds + LV + buf * VIMG;
            f32x16 p0 = {}, p1 = {};
#pragma unroll
            for (int d0 = 0; d0 < 4; ++d0) {
                const bf16x8 kf0 = *(const LAS bf16x8*)(kb + r32 * 144 + (16 * d0 + 8 * hi) * 2);
                const bf16x8 kf1 = *(const LAS bf16x8*)(kb + (32 + r32) * 144 + (16 * d0 + 8 * hi) * 2);
                p0 = MFMA32(kf0, qf[d0], p0); p1 = MFMA32(kf1, qf[d0], p1);
            }
            const float kbase = ch * (float)((blk - j) * 256 + kt * 64);
            float mt = -1e30f;
#pragma unroll
            for (int r = 0; r < 16; ++r) {
                const int kl0 = crow(r, hi), kl1 = kl0 + 32;
                const float t0 = p0[r] + (kbase + ch * (float)kl0), t1 = p1[r] + (kbase + ch * (float)kl1);
                const bool v0 = own ? (kt * 64 + kl0 <= qb) : lane_ok, v1 = own ? (kt * 64 + kl1 <= qb) : lane_ok;
                p0[r] = v0 ? t0 : -1e30f; p1[r] = v1 ? t1 : -1e30f;
                mt = fmaxf(mt, fmaxf(p0[r], p1[r]));
            }
            mt = fmaxf(mt, __shfl_xor(mt, 32));
            const float mnew = fmaxf(m_run, mt), alpha = __builtin_amdgcn_exp2f(m_run - mnew);
            m_run = mnew;
            float rs = 0.f;
#pragma unroll
            for (int r = 0; r < 16; ++r) { p0[r] = __builtin_amdgcn_exp2f(p0[r] - mnew); p1[r] = __builtin_amdgcn_exp2f(p1[r] - mnew); rs += p0[r] + p1[r]; }
            l_run = l_run * alpha + rs;
#pragma unroll
            for (int r = 0; r < 16; ++r) { o0[r] *= alpha; o1[r] *= alpha; }
#pragma unroll
            for (int sub = 0; sub < 2; ++sub)
#pragma unroll
                for (int s = 0; s < 2; ++s) {
                    union { u32x4 u; bf16x8 v; } pb;
                    if (sub == 0) { pb.u.x = cvt_pk_bf16(p0[8 * s + 0], p0[8 * s + 1]); pb.u.y = cvt_pk_bf16(p0[8 * s + 2], p0[8 * s + 3]); pb.u.z = cvt_pk_bf16(p0[8 * s + 4], p0[8 * s + 5]); pb.u.w = cvt_pk_bf16(p0[8 * s + 6], p0[8 * s + 7]); }
                    else { pb.u.x = cvt_pk_bf16(p1[8 * s + 0], p1[8 * s + 1]); pb.u.y = cvt_pk_bf16(p1[8 * s + 2], p1[8 * s + 3]); pb.u.z = cvt_pk_bf16(p1[8 * s + 4], p1[8 * s + 5]); pb.u.w = cvt_pk_bf16(p1[8 * s + 6], p1[8 * s + 7]); }
#pragma unroll
                    for (int dt = 0; dt < 2; ++dt) {
                        LAS unsigned char* va = vb + (32 * sub + 16 * s) * 192 + dt * 64 + vlane;
                        const s16x4 lo = __builtin_bit_cast(s16x4, __builtin_amdgcn_ds_read_tr16_b64_v4i16((LAS s16x4*)va));
                        const s16x4 hh = __builtin_bit_cast(s16x4, __builtin_amdgcn_ds_read_tr16_b64_v4i16((LAS s16x4*)(va + 8 * 192)));
                        const bf16x8 vf = {lo[0], lo[1], lo[2], lo[3], hh[0], hh[1], hh[2], hh[3]};
                        if (dt == 0) o0 = MFMA32(vf, pb.v, o0); else o1 = MFMA32(vf, pb.v, o1);
                    }
                }
        }
        if (i + 1 < ntile) { const int nb = buf ^ 1;
            *(LAS u32x4*)(lds + LK + nb * KIMG + srow * 144 + sch * 16) = kreg; *(LAS u32x4*)(lds + LV + nb * VIMG + srow * 192 + sch * 16) = vreg; }
        __syncthreads();
    }
    l_run += __shfl_xor(l_run, 32);
    const float inv = 1.0f / l_run;
#pragma unroll
    for (int r4 = 0; r4 < 4; ++r4) {
        int w0 = __builtin_amdgcn_cvt_pk_fp8_f32(o0[4 * r4] * inv, o0[4 * r4 + 1] * inv, 0, false); w0 = __builtin_amdgcn_cvt_pk_fp8_f32(o0[4 * r4 + 2] * inv, o0[4 * r4 + 3] * inv, w0, true);
        int w1 = __builtin_amdgcn_cvt_pk_fp8_f32(o1[4 * r4] * inv, o1[4 * r4 + 1] * inv, 0, false); w1 = __builtin_amdgcn_cvt_pk_fp8_f32(o1[4 * r4 + 2] * inv, o1[4 * r4 + 3] * inv, w1, true);
        unsigned char* yrow = P.ws + OFF_EG + (rowb + q0 + wid * 32 + r32) * 1024 + h * 64;
        *(int*)(yrow + 8 * r4 + 4 * hi) = w0; *(int*)(yrow + 32 + 8 * r4 + 4 * hi) = w1;
    }
}

__device__ void yb_norm_panel(const Params& P, int pm) {
    const int tid = tid_opaque(), lane = tid & 63, wid = tid >> 6;
    bf16_t* HI = (bf16_t*)(P.ws + OFF_HI); const bf16_t* HG = (const bf16_t*)(P.ws + OFF_HG);
    for (int r = 0; r < 32; ++r) {
        const size_t off = ((size_t)pm * 256 + wid * 32 + r) * 512 + lane * 8;
        const u32x4 ov = *(const u32x4*)(HI + off), gv = *(const u32x4*)(HG + off);
        float o[8] = {bf_lo(ov.x), bf_hi(ov.x), bf_lo(ov.y), bf_hi(ov.y), bf_lo(ov.z), bf_hi(ov.z), bf_lo(ov.w), bf_hi(ov.w)};
        const float g[8] = {bf_lo(gv.x), bf_hi(gv.x), bf_lo(gv.y), bf_hi(gv.y), bf_lo(gv.z), bf_hi(gv.z), bf_lo(gv.w), bf_hi(gv.w)};
        float ss = 0.f;
#pragma unroll
        for (int e = 0; e < 8; ++e) ss += o[e] * o[e];
        ss += __shfl_xor(ss, 1); ss += __shfl_xor(ss, 2); ss += __shfl_xor(ss, 4); ss += __shfl_xor(ss, 8);
        const float rs = rsqrtf(ss * (1.0f / 128.0f) + RMS_EPS);
        int w0 = __builtin_amdgcn_cvt_pk_fp8_f32(o[0] * rs * g[0], o[1] * rs * g[1], 0, false); w0 = __builtin_amdgcn_cvt_pk_fp8_f32(o[2] * rs * g[2], o[3] * rs * g[3], w0, true);
        int w1 = __builtin_amdgcn_cvt_pk_fp8_f32(o[4] * rs * g[4], o[5] * rs * g[5], 0, false); w1 = __builtin_amdgcn_cvt_pk_fp8_f32(o[6] * rs * g[6], o[7] * rs * g[7], w1, true);
        *(u32x2*)(P.ws + OFF_EG + ((size_t)pm * 256 + wid * 32 + r) * 1024 + 512 + lane * 8) = (u32x2){(unsigned)w0, (unsigned)w1};
    }
}
__device__ void ln1_panel(const Params& P, int pm) {
    const int tid = tid_opaque(), lane = tid & 63, wid = tid >> 6;
    const float* ada = (const float*)(P.ws + OFF_ADA) + (size_t)(pm >> 3) * 6144; bf16_t* H = (bf16_t*)(P.ws + OFF_H);
    for (int r = 0; r < 32; ++r) {
        const size_t row = (size_t)pm * 256 + wid * 32 + r;
        float* xr = P.out + row * 1024 + lane * 4; const float* xin = P.x + row * 1024 + lane * 4; const bf16_t* dl = (const bf16_t*)(P.ws + OFF_GB) + row * 1024 + lane * 4;
        f32x4 v[4]; float s = 0.f;
#pragma unroll
        for (int jx = 0; jx < 4; ++jx) { const u32x2 dv = *(const u32x2*)(dl + 256 * jx); const f32x4 xv = __builtin_nontemporal_load((const f32x4*)(xin + 256 * jx));
            v[jx] = xv * ALPHA + (f32x4){bf_lo(dv.x), bf_hi(dv.x), bf_lo(dv.y), bf_hi(dv.y)}; s += (v[jx][0] + v[jx][1]) + (v[jx][2] + v[jx][3]); }
        const float mean = wave_sum(s) * (1.0f / 1024.0f); float s2 = 0.f;
#pragma unroll
        for (int jx = 0; jx < 4; ++jx) { v[jx] = v[jx] - mean; s2 += (v[jx][0] * v[jx][0] + v[jx][1] * v[jx][1]) + (v[jx][2] * v[jx][2] + v[jx][3] * v[jx][3]); }
        const float rstd = rsqrtf(wave_sum(s2) * (1.0f / 1024.0f) + LN_EPS);
#pragma unroll
        for (int jx = 0; jx < 4; ++jx) {
            const int c = lane * 4 + 256 * jx;
            const f32x4 g = *(const f32x4*)(P.ln1_g + c), bb = *(const f32x4*)(P.ln1_b + c), sh = *(const f32x4*)(ada + 3072 + c), sc = *(const f32x4*)(ada + 4096 + c);
            const f32x4 x1 = v[jx] * rstd * g + bb;
            *(f32x4*)(xr + 256 * jx) = x1;
            const f32x4 h2 = x1 * (sc + 1.0f) + sh;
            u32x2 w; w.x = cvt_pk_bf16(h2[0], h2[1]); w.y = cvt_pk_bf16(h2[2], h2[3]);
            *(u32x2*)(H + row * 1024 + c) = w;
            v[jx] = h2;
        }
        {
            float mx = 0.f;
#pragma unroll
            for (int jx = 0; jx < 4; ++jx) mx = fmaxf(mx, fmaxf(fmaxf(fabsf(v[jx][0]), fabsf(v[jx][1])), fmaxf(fabsf(v[jx][2]), fabsf(v[jx][3]))));
#pragma unroll
            for (int o = 1; o < 64; o <<= 1) mx = fmaxf(mx, __shfl_xor(mx, o));
            const float hs = fmaxf(mx * (1.0f / 127.0f), 1e-30f), inv = 1.0f / hs; int qs = 0;
#pragma unroll
            for (int jx = 0; jx < 4; ++jx) {
                const int q0 = (int)rintf(v[jx][0] * inv), q1 = (int)rintf(v[jx][1] * inv), q2 = (int)rintf(v[jx][2] * inv), q3 = (int)rintf(v[jx][3] * inv);
                qs += (q0 + q1) + (q2 + q3);
                *(unsigned*)(P.ws + OFF_H8 + row * 1024 + lane * 4 + 256 * jx) = (unsigned)(q0 & 255) | ((unsigned)(q1 & 255) << 8) | ((unsigned)(q2 & 255) << 16) | ((unsigned)(q3 & 255) << 24);
            }
#pragma unroll
            for (int o = 1; o < 64; o <<= 1) qs += __shfl_xor(qs, o);
            if (lane == 0) *(f32x2*)(P.ws + OFF_HS + row * 8) = (f32x2){hs, (float)qs};
        }
    }
}

#define INS16(L, xin) do { float x_ = (xin); _Pragma("unroll") for (int k_ = 0; k_ < 16; ++k_) { const float hi_ = fmaxf(L[k_], x_); x_ = fminf(L[k_], x_); L[k_] = hi_; } } while (0)

__device__ void peer_select_wave(const Params& P, size_t tok0) {
    const int lane = tid_opaque() & 63, r32 = lane & 31, hi = lane >> 5;
    const bf16_t* QP = (const bf16_t*)(P.ws + OFF_GB) + (tok0 + r32) * 1024; const bf16_t* SK = (const bf16_t*)(P.ws + OFF_SK);
    u32x2* EG = (u32x2*)(P.ws + OFF_EG) + (tok0 + r32) * 128;
#pragma unroll 1
    for (int h = 0; h < 8; ++h) {
        float a0[16], a1[16];
#pragma unroll
        for (int k = 0; k < 16; ++k) { a0[k] = -INFINITY; a1[k] = -INFINITY; }
#pragma unroll 1
        for (int p = 0; p < 2; ++p) {
            const int hp = h * 2 + p;
            bf16x8 qf[4];
#pragma unroll
            for (int ks = 0; ks < 4; ++ks) qf[ks] = *(const bf16x8*)(QP + hp * 64 + 16 * ks + 8 * hi);
            float L[16];
#pragma unroll
            for (int k = 0; k < 16; ++k) L[k] = -INFINITY;
#pragma unroll
            for (int kt = 0; kt < 4; ++kt) {
                f32x16 acc = {};
#pragma unroll
                for (int ks = 0; ks < 4; ++ks) { const bf16x8 kf = *(const bf16x8*)(SK + ((size_t)hp * 128 + 32 * kt + r32) * 64 + 16 * ks + 8 * hi); acc = MFMA32(kf, qf[ks], acc); }
#pragma unroll
                for (int r = 0; r < 16; ++r) { const unsigned key = (unsigned)(32 * kt + crow(r, hi)); const float xv = __uint_as_float((__float_as_uint(acc[r]) & ~127u) | key); INS16(L, xv); }
            }
            float O[16];
#pragma unroll
            for (int k = 0; k < 16; ++k) O[k] = __shfl_xor(L[k], 32);
#pragma unroll
            for (int k = 0; k < 16; ++k) INS16(L, O[k]);
#pragma unroll
            for (int k = 0; k < 16; ++k) { a0[k] = (p == 0) ? L[k] : a0[k]; a1[k] = (p == 1) ? L[k] : a1[k]; }
        }
        float best[16];
#pragma unroll
        for (int k = 0; k < 16; ++k) best[k] = -INFINITY;
#pragma unroll
        for (int i = 0; i < 16; ++i)
#pragma unroll
            for (int jx = 0; jx < 16; ++jx)
                if ((i + 1) * (jx + 1) <= 16) {
                    const float cs = a0[i] + a1[jx];
                    const float cv = __uint_as_float((__float_as_uint(cs) & ~255u) | (unsigned)(i * 16 + jx));
                    INS16(best, cv);
                }
        unsigned pk0[4], pk1[4];
#pragma unroll
        for (int q = 0; q < 4; ++q) {
            pk0[q] = (__float_as_uint(a0[4 * q]) & 127u) | ((__float_as_uint(a0[4 * q + 1]) & 127u) << 8) | ((__float_as_uint(a0[4 * q + 2]) & 127u) << 16) | ((__float_as_uint(a0[4 * q + 3]) & 127u) << 24);
            pk1[q] = (__float_as_uint(a1[4 * q]) & 127u) | ((__float_as_uint(a1[4 * q + 1]) & 127u) << 8) | ((__float_as_uint(a1[4 * q + 2]) & 127u) << 16) | ((__float_as_uint(a1[4 * q + 3]) & 127u) << 24);
        }
        unsigned pay[16];
#pragma unroll
        for (int k = 0; k < 16; ++k) {
            const unsigned code = __float_as_uint(best[k]) & 255u, ci = code >> 4, cj = code & 15u;
            const unsigned qi = ci >> 2, qj = cj >> 2;
            const unsigned w0 = (qi == 0u) ? pk0[0] : ((qi == 1u) ? pk0[1] : ((qi == 2u) ? pk0[2] : pk0[3]));
            const unsigned w1 = (qj == 0u) ? pk1[0] : ((qj == 1u) ? pk1[1] : ((qj == 2u) ? pk1[2] : pk1[3]));
            pay[k] = (((w0 >> ((ci & 3u) * 8u)) & 127u) << 7) | ((w1 >> ((cj & 3u) * 8u)) & 127u);
        }
        float e[16], es = 0.f;
#pragma unroll
        for (int k = 0; k < 16; ++k) { e[k] = __expf(best[k] - best[0]); es += e[k]; }
        const float inv = 1.0f / es;
        if (hi == 0) {
#pragma unroll
            for (int k = 0; k < 16; ++k) { u32x2 w; w.x = pay[k]; w.y = __float_as_uint(e[k] * inv); EG[h * 16 + k] = w; }
        }
    }
}
__device__ __forceinline__ unsigned xcc_id() { return (unsigned)__builtin_amdgcn_s_getreg((3 << 11) | 20) & 0xFu; }
template <int CTRL> __device__ __forceinline__ float dpp_add(float x) { const int v = __builtin_amdgcn_update_dpp(0, __float_as_int(x), CTRL, 0xf, 0xf, true); return x + __int_as_float(v); }
__device__ __forceinline__ float wave_sum_fast(float x) {
    x = dpp_add<0xB1>(x); x = dpp_add<0x4E>(x); x = dpp_add<0x141>(x); x = dpp_add<0x140>(x);
    x += __shfl_xor(x, 16); x += __shfl_xor(x, 32); return x;
}
__device__ __forceinline__ float dot16_fp8(const float (&hv)[16], const u32x4 r) {
    float s = 0.f;
    { const f32x2 a = __builtin_amdgcn_cvt_pk_f32_fp8((int)r.x, false), b = __builtin_amdgcn_cvt_pk_f32_fp8((int)r.x, true); s += hv[0] * a.x + hv[1] * a.y + hv[2] * b.x + hv[3] * b.y; }
    { const f32x2 a = __builtin_amdgcn_cvt_pk_f32_fp8((int)r.y, false), b = __builtin_amdgcn_cvt_pk_f32_fp8((int)r.y, true); s += hv[4] * a.x + hv[5] * a.y + hv[6] * b.x + hv[7] * b.y; }
    { const f32x2 a = __builtin_amdgcn_cvt_pk_f32_fp8((int)r.z, false), b = __builtin_amdgcn_cvt_pk_f32_fp8((int)r.z, true); s += hv[8] * a.x + hv[9] * a.y + hv[10] * b.x + hv[11] * b.y; }
    { const f32x2 a = __builtin_amdgcn_cvt_pk_f32_fp8((int)r.w, false), b = __builtin_amdgcn_cvt_pk_f32_fp8((int)r.w, true); s += hv[12] * a.x + hv[13] * a.y + hv[14] * b.x + hv[15] * b.y; }
    return s;
}
template <int NP, class F> __device__ __forceinline__ void partition_queue(const Params& P, LAS unsigned char* lds, int ctr_base, F f) {
    const int tid = tid_opaque();
    LAS int* slot = (LAS int*)(lds + LDS_BYTES - 64);
    unsigned* ctr = (unsigned*)(P.ws + OFF_CTR) + ctr_base;
    const int myx = (int)(xcc_id() & 7u);
    for (int pp = 0; pp < NP; ++pp) {
        const int p = (myx * (NP / 8) + pp) % NP;
        for (;;) {
            if (tid == 0) *slot = (int)atomicAdd(ctr + p, 1u);
            __syncthreads();
            const int item = *slot;
            __syncthreads();
            if (item >= NTOK / 64) break;
            f(p, item);
        }
    }
}
__device__ __forceinline__ float dot2bf(unsigned a, bf16v2 b, float c) { return __builtin_amdgcn_fdot2_f32_bf16(__builtin_bit_cast(bf16v2, a), b, c, false); }
struct UQuad { u32x4 r[2]; u32x4 ent; };
__device__ __forceinline__ void uq_issue(UQuad& q, const LAS u32x4* list, int J, int NQ, int g, const unsigned char* U4) {
    const int jj = J < NQ ? J : NQ - 1;
    q.ent = list[4 * jj + g];
    const unsigned char* rp = U4 + (size_t)q.ent.x * 512;
    q.r[0] = *(const u32x4*)rp; q.r[1] = *(const u32x4*)(rp + 256);
}
__device__ __forceinline__ int dot8_i4(unsigned w, unsigned hlo, unsigned hhi, int acc) {
    acc = __builtin_amdgcn_sdot4((int)hlo, (int)(w & 0x0F0F0F0Fu), acc, false);
    return __builtin_amdgcn_sdot4((int)hhi, (int)((w >> 4) & 0x0F0F0F0Fu), acc, false);
}
__device__ __forceinline__ float uq_dot(const UQuad& q, const u32x4 (&hp)[4]) {
    int a = 0, b = 0;
#pragma unroll
    for (int c = 0; c < 2; ++c) {
        const u32x4 r = q.r[c];
        a = dot8_i4(r.x, hp[2 * c].x, hp[2 * c].y, a); b = dot8_i4(r.y, hp[2 * c].z, hp[2 * c].w, b);
        a = dot8_i4(r.z, hp[2 * c + 1].x, hp[2 * c + 1].y, a); b = dot8_i4(r.w, hp[2 * c + 1].z, hp[2 * c + 1].w, b);
    }
    float s = (float)(a + b);
    s = dpp_add<0xB1>(s); s = dpp_add<0x4E>(s); s = dpp_add<0x141>(s); s = dpp_add<0x140>(s);
    return s;
}
__device__ __forceinline__ void peer_u_tokens(const Params& P, LAS unsigned char* lds, const size_t t0) {
    const int tid = tid_opaque(), lane = tid & 63, wid = tid >> 6, g = lane >> 4, li = lane & 15;
    const unsigned char* H8 = P.ws + OFF_H8 + li * 32; const unsigned char* U4 = P.ws + OFF_U8 + li * 16;
    const f32x2* HS = (const f32x2*)(P.ws + OFF_HS); const float* USC = (const float*)(P.ws + OFF_USC);
    const u32x4* EG4 = (const u32x4*)(P.ws + OFF_EG); float* W = (float*)(P.ws + OFF_W);
    LAS u32x4* list = (LAS u32x4*)(lds + wid * 16384);
#pragma unroll 2
    for (int i = 0; i < 8; ++i) {
        const u32x4 eg = EG4[(t0 + i) * 64 + lane];
        list[i * 128 + 2 * lane] = (u32x4){eg.x, eg.y, (unsigned)(2 * lane) | (unsigned)(i << 8), __float_as_uint(USC[eg.x])};
        list[i * 128 + 2 * lane + 1] = (u32x4){eg.z, eg.w, (unsigned)(2 * lane + 1) | (unsigned)(i << 8), __float_as_uint(USC[eg.z])};
    }
    constexpr int NQ = 256;
    u32x4 hp[4], hn[4]; f32x2 hsc = HS[t0], hsn = HS[t0 + 1];
#pragma unroll
    for (int c = 0; c < 2; ++c) { hp[2 * c] = *(const u32x4*)(H8 + t0 * 1024 + 512 * c); hp[2 * c + 1] = *(const u32x4*)(H8 + t0 * 1024 + 512 * c + 16);
                                  hn[2 * c] = *(const u32x4*)(H8 + (t0 + 1) * 1024 + 512 * c); hn[2 * c + 1] = *(const u32x4*)(H8 + (t0 + 1) * 1024 + 512 * c + 16); }
    int curtok = 0;
    UQuad q0, q1, q2, q3;
    uq_issue(q0, list, 0, NQ, g, U4); uq_issue(q1, list, 1, NQ, g, U4); uq_issue(q2, list, 2, NQ, g, U4); uq_issue(q3, list, 3, NQ, g, U4);
#define UQ_STEP(q, Jn) do { \
        const int tk = __builtin_amdgcn_readfirstlane((int)(q.ent.z >> 8)); \
        if (tk != curtok) { curtok = tk; _Pragma("unroll") for (int c = 0; c < 4; ++c) hp[c] = hn[c]; hsc = hsn; \
            if (tk + 1 < 8) { hsn = HS[t0 + tk + 1]; _Pragma("unroll") for (int c = 0; c < 2; ++c) { hn[2 * c] = *(const u32x4*)(H8 + (t0 + tk + 1) * 1024 + 512 * c); hn[2 * c + 1] = *(const u32x4*)(H8 + (t0 + tk + 1) * 1024 + 512 * c + 16); } } } \
        const float s = __uint_as_float(q.ent.w) * hsc.x * (uq_dot(q, hp) - 7.5f * hsc.y); \
        if (li == 0) W[(t0 + tk) * 128 + (q.ent.z & 255u)] = __uint_as_float(q.ent.y) * 0.5f * s * (1.0f + erff(s * 0.70710678118654752f)); \
        uq_issue(q, list, (Jn), NQ, g, U4); } while (0)
#pragma unroll 1
    for (int J = 0; J < NQ; J += 4) { UQ_STEP(q0, J + 4); UQ_STEP(q1, J + 5); UQ_STEP(q2, J + 6); UQ_STEP(q3, J + 7); }
#undef UQ_STEP
}
typedef int v4i_t __attribute__((ext_vector_type(4)));
struct VQuad { u32x4 r[2]; u32x2 ent; };
__device__ __forceinline__ void vq_issue(VQuad& q, const LAS u32x2* list, int J, int g, const unsigned char* V4) {
    const int jj = J < 32 ? J : 31;
    q.ent = list[4 * jj + g];
    const unsigned char* rp = V4 + (size_t)q.ent.x * 512;
    q.r[0] = *(const u32x4*)rp; q.r[1] = *(const u32x4*)(rp + 256);
}
__device__ __forceinline__ void vq_mma(const VQuad& q, v4i_t (&acc)[4], const unsigned sh, const u32x4 bm, const bool live) {
    const unsigned t = live ? ((q.ent.y & 255u) << sh) : 0u;
    const v4i_t B = {(int)(t & bm.x), (int)(t & bm.y), (int)(t & bm.z), (int)(t & bm.w)};
#pragma unroll
    for (int c = 0; c < 2; ++c) {
        const u32x4 r = q.r[c];
        const v4i_t lo = {(int)(r.x & 0x0F0F0F0Fu), (int)(r.y & 0x0F0F0F0Fu), (int)(r.z & 0x0F0F0F0Fu), (int)(r.w & 0x0F0F0F0Fu)};
        const v4i_t hi = {(int)((r.x >> 4) & 0x0F0F0F0Fu), (int)((r.y >> 4) & 0x0F0F0F0Fu), (int)((r.z >> 4) & 0x0F0F0F0Fu), (int)((r.w >> 4) & 0x0F0F0F0Fu)};
        acc[2 * c] = __builtin_amdgcn_mfma_i32_16x16x64_i8(lo, B, acc[2 * c], 0, 0, 0);
        acc[2 * c + 1] = __builtin_amdgcn_mfma_i32_16x16x64_i8(hi, B, acc[2 * c + 1], 0, 0, 0);
    }
}
__device__ __forceinline__ void peer_v_tokens(const Params& P, LAS unsigned char* lds, const size_t t0) {
    const int tid = tid_opaque(), lane = tid & 63, wid = tid >> 6, g = lane >> 4, li = lane & 15;
    const unsigned char* V4 = P.ws + OFF_V8 + li * 16; const float* VSC = (const float*)(P.ws + OFF_VSC);
    const u32x4* EG4 = (const u32x4*)(P.ws + OFF_EG); const f32x2* W2 = (const f32x2*)(P.ws + OFF_W);
    LAS u32x2* lists = (LAS u32x2*)(lds + wid * 8192);
    float swv[8], yoffv[8];
#pragma unroll
    for (int i = 0; i < 8; ++i) { const u32x4 eg = EG4[(t0 + i) * 64 + lane]; const f32x2 ww = W2[(t0 + i) * 64 + lane];
        const float w0 = ww.x * VSC[eg.x], w1 = ww.y * VSC[eg.z];
        float mx = fmaxf(fabsf(w0), fabsf(w1));
#pragma unroll
        for (int o = 1; o < 64; o <<= 1) mx = fmaxf(mx, __shfl_xor(mx, o));
        const float sw = fmaxf(mx * (1.0f / 127.0f), 1e-30f), inv = 1.0f / sw;
        const int q0 = (int)rintf(w0 * inv), q1 = (int)rintf(w1 * inv);
        *(LAS u32x4*)(lists + i * 128 + 2 * lane) = (u32x4){eg.x, (unsigned)q0, eg.z, (unsigned)q1};
        int qs = q0 + q1;
#pragma unroll
        for (int o = 1; o < 64; o <<= 1) qs += __shfl_xor(qs, o);
        swv[i] = sw; yoffv[i] = 7.5f * sw * (float)qs; }
    const unsigned sh = 8u * (unsigned)(li & 3);
    const u32x4 bm = {(li >> 2) == 0 ? 0xFFFFFFFFu : 0u, (li >> 2) == 1 ? 0xFFFFFFFFu : 0u, (li >> 2) == 2 ? 0xFFFFFFFFu : 0u, (li >> 2) == 3 ? 0xFFFFFFFFu : 0u};
#pragma unroll
    for (int i = 0; i < 8; ++i) {
        const size_t t = t0 + i;
        const LAS u32x2* list = lists + i * 128;
        v4i_t acc[4];
#pragma unroll
        for (int j = 0; j < 4; ++j) acc[j] = (v4i_t){0, 0, 0, 0};
        VQuad q0, q1, q2, q3;
        vq_issue(q0, list, 0, g, V4); vq_issue(q1, list, 1, g, V4); vq_issue(q2, list, 2, g, V4); vq_issue(q3, list, 3, g, V4);
#pragma unroll 1
        for (int J = 0; J < 32; J += 4) {
            vq_mma(q0, acc, sh, bm, true); vq_issue(q0, list, J + 4, g, V4);
            vq_mma(q1, acc, sh, bm, true); vq_issue(q1, list, J + 5, g, V4);
            vq_mma(q2, acc, sh, bm, true); vq_issue(q2, list, J + 6, g, V4);
            vq_mma(q3, acc, sh, bm, true); vq_issue(q3, list, J + 7, g, V4);
        }
        const float sw = swv[i], yoff = yoffv[i];
        const int dbase = 128 * g + 8 * (li >> 2) + (li & 3);
        const float* gt2 = (const float*)(P.ws + OFF_ADA) + (t >> 11) * 6144 + 5120;
        float* xr = P.out + t * 1024;
        float pre[16]; float s = 0.f;
#pragma unroll
        for (int c = 0; c < 2; ++c)
#pragma unroll
            for (int hf = 0; hf < 2; ++hf)
#pragma unroll
                for (int r = 0; r < 4; ++r) { const int d = dbase + 512 * c + 32 * r + 4 * hf;
                    const float yv = sw * (float)acc[2 * c + hf][r] - yoff;
                    const float pv = ALPHA * xr[d] + gt2[d] * yv; pre[8 * c + 4 * hf + r] = pv; s += pv; }
        const float mean = wave_sum(s) * (1.0f / 1024.0f); float s2 = 0.f;
#pragma unroll
        for (int e = 0; e < 16; ++e) { pre[e] -= mean; s2 += pre[e] * pre[e]; }
        const float rstd = rsqrtf(wave_sum(s2) * (1.0f / 1024.0f) + LN_EPS);
#pragma unroll
        for (int c = 0; c < 2; ++c)
#pragma unroll
            for (int hf = 0; hf < 2; ++hf)
#pragma unroll
                for (int r = 0; r < 4; ++r) { const int d = dbase + 512 * c + 32 * r + 4 * hf;
                    xr[d] = pre[8 * c + 4 * hf + r] * rstd * P.ln2_g[d] + P.ln2_b[d]; }
    }
}

#define XB_TMO      128
#define XB_XCNT(j)  (256  + 64 * (j))
#define XB_XSUB(j)  (1280 + 64 * (j))
#define XB_XGEN(j)  (2304 + 64 * (j))
#define XB_TOP      3328
#define XB_TOPGEN   3392
#define XCD_BAR_WORDS 3456
#define XB_SPIN_CAP (1u << 22)
__device__ __forceinline__ unsigned xb_ld(unsigned* p)              { return __hip_atomic_load(p, __ATOMIC_RELAXED, __HIP_MEMORY_SCOPE_AGENT); }
__device__ __forceinline__ unsigned xb_add(unsigned* p, unsigned v) { return __hip_atomic_fetch_add(p, v, __ATOMIC_RELAXED, __HIP_MEMORY_SCOPE_AGENT); }
#define XB_SPIN(cond, bar) do { unsigned _sp = 0; while (cond) { __builtin_amdgcn_s_sleep(1); \
    if ((++_sp & 255u) == 0u) { if (xb_ld(&(bar)[XB_TMO])) break; if (_sp > XB_SPIN_CAP) { atomicAdd(&(bar)[XB_TMO], 1u); break; } } } } while (0)
struct XcdBarrier { unsigned* bar; unsigned x; volatile LAS unsigned* st; };
__device__ __forceinline__ XcdBarrier xcd_barrier_post(unsigned* bar, volatile LAS unsigned* st) {
    XcdBarrier b; b.bar = bar; b.x = xcc_id(); b.st = st;
    if (threadIdx.x == 0) (void)xb_add(&bar[XB_XCNT(b.x)], 1u);
    return b;
}
__device__ __forceinline__ void xcd_barrier_complete(unsigned* bar, unsigned x, unsigned& nloc, unsigned& nx) {
    const unsigned G = gridDim.x * gridDim.y * gridDim.z;
    unsigned sum, cnt, mine, sp = 0u;
    for (;;) {
        sum = 0u; cnt = 0u; mine = 0u;
#pragma unroll
        for (unsigned j = 0; j < 16; ++j) { const unsigned c = xb_ld(&bar[XB_XCNT(j)]); sum += c; cnt += (c > 0u) ? 1u : 0u; mine = (j == x) ? c : mine; }
        if (sum == G) break;
        __builtin_amdgcn_s_sleep(1);
        if ((++sp & 255u) == 0u) { if (xb_ld(&bar[XB_TMO])) break; if (sp > XB_SPIN_CAP) { atomicAdd(&bar[XB_TMO], 1u); break; } }
    }
    nloc = mine > 0u ? mine : 1u; nx = cnt > 0u ? cnt : 1u;
}
__device__ __forceinline__ void xcd_barrier(const XcdBarrier& b) {
    asm volatile("s_waitcnt vmcnt(0)" ::: "memory");
    __syncthreads();
    if (threadIdx.x == 0) {
        unsigned* bar = b.bar;
        __builtin_amdgcn_s_waitcnt(0);
        unsigned nloc = b.st[0], nx = b.st[1];
        if (nloc == 0u) { xcd_barrier_complete(bar, b.x, nloc, nx); b.st[0] = nloc; b.st[1] = nx; }
        const unsigned old = xb_add(&bar[XB_XSUB(b.x)], 1u);
        const unsigned gen = old / nloc;
        if (old + 1u == (gen + 1u) * nloc) {
            __builtin_amdgcn_fence(__ATOMIC_RELEASE, "agent");
            asm volatile("s_waitcnt vmcnt(0)" ::: "memory");
            const unsigned og = xb_add(&bar[XB_TOP], 1u);
            const unsigned tg = og / nx;
            if (og + 1u == (tg + 1u) * nx) xb_add(&bar[XB_TOPGEN], 1u);
            else XB_SPIN(xb_ld(&bar[XB_TOPGEN]) == tg, bar);
            __builtin_amdgcn_fence(__ATOMIC_ACQUIRE, "agent");
            xb_add(&bar[XB_XGEN(b.x)], 1u);
            asm volatile("s_waitcnt vmcnt(0)" ::: "memory");
        } else {
            XB_SPIN(xb_ld(&bar[XB_XGEN(b.x)]) == gen, bar);
            __builtin_amdgcn_fence(__ATOMIC_ACQUIRE, "agent");
            asm volatile("s_waitcnt vmcnt(0)" ::: "memory");
        }
    }
    __syncthreads();
}

__global__ void __launch_bounds__(NTHR, 2) fwd_megakernel(Params P) {
    extern __shared__ __attribute__((aligned(16))) unsigned char shm[];
    LAS unsigned char* lds = (LAS unsigned char*)shm;
    cg::grid_group grid = cg::this_grid();
    const int G = gridDim.x, bid = blockIdx.x;
    volatile LAS unsigned* xst = (volatile LAS unsigned*)(lds + LDS_BYTES - 128);
    if (threadIdx.x == 0) { xst[0] = 0u; xst[1] = 0u; }
    __syncthreads();
    const XcdBarrier xb = xcd_barrier_post((unsigned*)(P.ws + OFF_BAR), xst);

#ifndef P3
#define P3 0xff
#endif
#ifndef PH
#define PH 0xff
#endif
    if (PH & 1) phase0a(P, lds);
    grid.sync();
    if (PH & 2) phase0b(P);
    xcd_barrier(xb);
    if (PH & 4) {
        pg8::Gemm g; g.A = (const bf16_t*)(P.ws + OFF_H); g.Bt = (const bf16_t*)(P.ws + OFF_WIN); g.M = NTOK; g.N = INCOLS; { int k_ = 512; asm volatile("" : "+s"(k_)); g.K = k_; g.lda = k_; }
        pg8::StaticOrder S; S.init(NTOK, INCOLS, G, bid);
        EpiProj E; E.ws = P.ws; E.lb = (const float*)(P.ws + OFF_LB); E.ng = P.hgrn_ng; E.kmean = (float*)(P.ws + OFF_KMEAN);
        pg8::gemm_phase<EpiProj, pg8::StaticOrder, true>(lds, g, S, E);
    }
    xcd_barrier(xb);
    if (PH & 8) for (int it = bid; it < 256; it += G) hgrn_item(P, it, lds);
    if (PH & 16) for (int u = bid; u < 2048; u += G) { const int bh = u & 255, jj = u >> 8; moba_unit(P, bh >> 3, bh & 7, (jj + bh) & 7, lds); }
    xcd_barrier(xb);
    if ((PH & 32) && bid < NTOK / 256) { const int pm = bid;
        if (P3 & 1) yb_norm_panel(P, pm);
        __syncthreads();
        if (P3 & 2) { pg8::Gemm g; g.A = (const bf16_t*)(P.ws + OFF_EG); g.Bt = (const bf16_t*)(P.ws + OFF_WBA); g.M = NTOK; g.N = 1024; { int k_ = 256; asm volatile("" : "+s"(k_)); g.K = k_; } g.lda = 512;
          pg8::PanelOrder S; S.pm = pm; S.npn = 4; EpiMixA E; E.GA = (bf16_t*)(P.ws + OFF_GA);
          pg8::gemm_phase<EpiMixA, pg8::PanelOrder, true>(lds, g, S, E); }
        __syncthreads();
        if (P3 & 4) { pg8::Gemm g; g.A = (const bf16_t*)(P.ws + OFF_EG + 512); g.Bt = (const bf16_t*)(P.ws + OFF_WBB); g.M = NTOK; g.N = 1024; { int k_ = 256; asm volatile("" : "+s"(k_)); g.K = k_; } g.lda = 512;
          pg8::PanelOrder S; S.pm = pm; S.npn = 4; EpiMixB E; E.GA = (const bf16_t*)(P.ws + OFF_GA); E.GB = (const bf16_t*)(P.ws + OFF_GB); E.M8 = P.ws + OFF_QA;
          pg8::gemm_phase<EpiMixB, pg8::PanelOrder, true>(lds, g, S, E); }
        __syncthreads();
        if (P3 & 8) { pg8::Gemm g; g.A = (const bf16_t*)(P.ws + OFF_QA); g.Bt = (const bf16_t*)(P.ws + OFF_WOUT); g.M = NTOK; g.N = 1024; { int k_ = 512; asm volatile("" : "+s"(k_)); g.K = k_; g.lda = k_; }
          pg8::PanelOrder S; S.pm = pm; S.npn = 4; EpiOut E; E.ada = (const float*)(P.ws + OFF_ADA); E.D = (bf16_t*)(P.ws + OFF_GB);
          pg8::gemm_phase<EpiOut, pg8::PanelOrder, true>(lds, g, S, E); }
        __syncthreads();
        if (P3 & 16) ln1_panel(P, pm);
        __syncthreads();
        if (P3 & 32) { pg8::Gemm g; g.A = (const bf16_t*)(P.ws + OFF_H); g.Bt = (const bf16_t*)(P.ws + OFF_WQ); g.M = NTOK; g.N = 1024; g.K = 1024; g.lda = 1024;
          pg8::PanelOrder S; S.pm = pm; S.npn = 4; EpiBf16 E; E.O = (bf16_t*)(P.ws + OFF_GB);
          pg8::gemm_phase<EpiBf16, pg8::PanelOrder>(lds, g, S, E); }
        __syncthreads();
        { const size_t tok0 = (size_t)pm * 256 + (tid_opaque() >> 6) * 32;
          peer_select_wave(P, tok0);
          __syncthreads();
#pragma unroll 1
          for (int sb = 0; sb < 4; ++sb) {
              peer_u_tokens(P, lds, tok0 + 8 * sb);
              __syncthreads();
              peer_v_tokens(P, lds, tok0 + 8 * sb);
              __syncthreads();
          } }
    }
}

extern "C" void kernel_launch(void* const* d_in, const int* in_sizes, int n_in, void* d_out, int out_size, void* d_ws, size_t ws_size, hipStream_t stream) {
    static int grid_blocks = 0;
    if (grid_blocks == 0) {
        if (n_in != 18 || out_size != NTOK * DM || ws_size < WS_END) { fprintf(stderr, "kernel_launch: unexpected shapes (n_in %d, out %d, ws %zu, need %zu)\n", n_in, out_size, ws_size, (size_t)WS_END); grid_blocks = -1; return; }
        int dev = 0, cus = 0, per_cu = 0;
        hipGetDevice(&dev);
        hipDeviceGetAttribute(&cus, hipDeviceAttributeMultiprocessorCount, dev);
        if (hipFuncSetAttribute((const void*)fwd_megakernel, hipFuncAttributeMaxDynamicSharedMemorySize, LDS_BYTES) != hipSuccess) fprintf(stderr, "kernel_launch: hipFuncSetAttribute failed\n");
        hipOccupancyMaxActiveBlocksPerMultiprocessor(&per_cu, (const void*)fwd_megakernel, NTHR, LDS_BYTES);
        if (per_cu < 1) { fprintf(stderr, "kernel_launch: occupancy query says %d blocks per CU\n", per_cu); per_cu = 1; }
        if (per_cu > 1) per_cu = 1;
        grid_blocks = cus * per_cu;
        if (grid_blocks != NTOK / 256) { fprintf(stderr, "kernel_launch: built for a %d-CU device (one 256-token panel per workgroup), found %d\n", NTOK / 256, grid_blocks); grid_blocks = -1; return; }
        (void)hipGetLastError();
    }
    if (grid_blocks < 0) return;
    Params p{};
    p.x = (const float*)d_in[0]; p.c = (const float*)d_in[1]; p.w_ada = (const float*)d_in[2]; p.b_ada = (const float*)d_in[3]; p.w_in = (const float*)d_in[4];
    p.w_ba = (const float*)d_in[5]; p.w_bb = (const float*)d_in[6]; p.w_out = (const float*)d_in[7]; p.hgrn_lb = (const float*)d_in[8]; p.hgrn_ng = (const float*)d_in[9];
    p.ln1_g = (const float*)d_in[10]; p.ln1_b = (const float*)d_in[11]; p.peer_wq = (const float*)d_in[12]; p.peer_sk = (const float*)d_in[13]; p.peer_u = (const float*)d_in[14];
    p.peer_v = (const float*)d_in[15]; p.ln2_g = (const float*)d_in[16]; p.ln2_b = (const float*)d_in[17];
    p.out = (float*)d_out; p.ws = (unsigned char*)d_ws;
    if (hipMemsetAsync((char*)d_ws + OFF_BAR, 0, XCD_BAR_WORDS * 4, stream) != hipSuccess) fprintf(stderr, "kernel_launch: memset of the barrier words failed\n");
    void* args[] = {&p};
    hipError_t e = hipLaunchCooperativeKernel((const void*)fwd_megakernel, dim3(grid_blocks), dim3(NTHR), args, LDS_BYTES, stream);
    if (e != hipSuccess) fprintf(stderr, "cooperative launch failed: %s (grid %d)\n", hipGetErrorString(e), grid_blocks);
}
```

```cpp
#include <hip/hip_runtime.h>
#include <hip/hip_cooperative_groups.h>
#include <cstdio>
#include <cstdint>
#include <type_traits>
namespace cg = cooperative_groups;

#define LAS __attribute__((address_space(3)))
typedef unsigned short bf16_t;
typedef short bf16x8 __attribute__((ext_vector_type(8)));
typedef short s16x4 __attribute__((ext_vector_type(4)));
typedef float f32x2 __attribute__((ext_vector_type(2)));
typedef float f32x4 __attribute__((ext_vector_type(4)));
typedef float f32x16 __attribute__((ext_vector_type(16)));
typedef unsigned u32x2 __attribute__((ext_vector_type(2)));
typedef unsigned u32x4 __attribute__((ext_vector_type(4)));

constexpr int NB = 32, SEQ = 2048, DM = 1024, NTOK = NB * SEQ;
constexpr int INCOLS = 5632;
constexpr int NTHR = 512;
constexpr int LDS_BYTES = 147456;
constexpr float ALPHA = 1.189207115002721f;
constexpr float LN_EPS = 1e-5f, RMS_EPS = 1e-6f;
constexpr float LOG2E = 1.4426950408889634f;

constexpr size_t SZ_T512 = (size_t)NTOK * 512 * 2, SZ_T1024 = (size_t)NTOK * 1024 * 2;
constexpr size_t OFF_ADA = 0;
constexpr size_t OFF_LB = OFF_ADA + 786432;
constexpr size_t OFF_KMEAN = OFF_LB + 4096;
constexpr size_t OFF_WIN = OFF_KMEAN + 524288;
constexpr size_t OFF_WBA = OFF_WIN + (size_t)5632 * 1024 * 2;
constexpr size_t OFF_WBB = OFF_WBA + 1048576;
constexpr size_t OFF_WOUT = OFF_WBB + 1048576;
constexpr size_t OFF_WQ = OFF_WOUT + 2097152;
constexpr size_t OFF_SK = OFF_WQ + 2097152;
constexpr size_t OFF_U8 = OFF_SK + 262144;
constexpr size_t OFF_USC = OFF_U8 + 8388608;
constexpr size_t OFF_V8 = OFF_U8 + 16777216;
constexpr size_t OFF_VSC = OFF_V8 + 8388608;
constexpr size_t OFF_CTR = OFF_V8 + 16777216;
constexpr size_t OFF_BAR = OFF_CTR + 4096;
constexpr size_t OFF_EG = OFF_BAR + 16384;
constexpr size_t OFF_H = OFF_EG + (size_t)NTOK * 128 * 8;
constexpr size_t OFF_QA = OFF_H + SZ_T1024;
constexpr size_t OFF_KA = OFF_QA + SZ_T512;
constexpr size_t OFF_VA = OFF_KA + SZ_T512;
constexpr size_t OFF_HQ = OFF_VA + SZ_T512;
constexpr size_t OFF_HK = OFF_HQ + SZ_T512;
constexpr size_t OFF_HI = OFF_HK + SZ_T512;
constexpr size_t OFF_HG = OFF_HI + SZ_T512;
constexpr size_t OFF_GA = OFF_HG + SZ_T512;
constexpr size_t OFF_GB = OFF_GA + SZ_T1024;
constexpr size_t WS_END = OFF_GB + SZ_T1024;
constexpr size_t OFF_H8 = OFF_VA;
constexpr size_t OFF_HS = OFF_HQ;
constexpr size_t OFF_W = OFF_KA;
constexpr size_t OFF_Y = OFF_KA;

struct Params {
    const float *x, *c, *w_ada, *b_ada, *w_in, *w_ba, *w_bb, *w_out, *hgrn_lb, *hgrn_ng, *ln1_g, *ln1_b, *peer_wq, *peer_sk, *peer_u, *peer_v, *ln2_g, *ln2_b;
    float* out;
    unsigned char* ws;
};

typedef __bf16 bf16v2 __attribute__((ext_vector_type(2)));
__device__ __forceinline__ unsigned cvt_pk_bf16(float lo, float hi) { return __builtin_bit_cast(unsigned, __builtin_convertvector((f32x2){lo, hi}, bf16v2)); }
__device__ __forceinline__ float bf_lo(unsigned w) { return __uint_as_float(w << 16); }
__device__ __forceinline__ float bf_hi(unsigned w) { return __uint_as_float(w & 0xffff0000u); }
__device__ __forceinline__ float sigmoidf_(float x) { return 1.0f / (1.0f + __expf(-x)); }
__device__ __forceinline__ float wave_sum(float v) {
#pragma unroll
    for (int o = 1; o < 64; o <<= 1) v += __shfl_xor(v, o);
    return v;
}
__device__ __forceinline__ int tid_opaque() { int t = threadIdx.x; asm volatile("" : "+v"(t)); return t; }
__device__ __forceinline__ int crow(int r, int hi) { return (r & 3) + 8 * (r >> 2) + 4 * hi; }
#define MFMA32(a, b, c) __builtin_amdgcn_mfma_f32_32x32x16_bf16(a, b, c, 0, 0, 0)

namespace pg8 {
constexpr int BM = 256, BK = 64, HALF = 128, HTB = HALF * BK * 2, STAGE_BYTES = 8 * HTB, NXCD = 8, WGM = 8;
__host__ __device__ __forceinline__ int lds_byte(int r, int c) { const int st = (r >> 4) * 2 + (c >> 5), rr = r & 15, cc = c & 31, ob = rr * 64 + cc * 2; return st * 1024 + (ob ^ (((ob >> 9) & 1) << 5)); }
__host__ __device__ __forceinline__ void stage_rc(int b, int& R, int& C) { const int st = b / 1024, sb = b % 1024, swz = sb ^ (((sb >> 9) & 1) << 5); R = (st >> 1) * 16 + swz / 64; C = (st & 1) * 32 + (swz % 64) / 2; }
__host__ __device__ __forceinline__ int perm32(int rho) { const int n = rho >> 4, i = rho & 15; return 8 * (i >> 2) + 4 * n + (i & 3); }

struct Unit { int pm, pn; };
struct Gemm { const bf16_t* A; const bf16_t* Bt; int M, N, K, lda; };

struct StaticOrder {
    int nM, nN, nwg, G, c;
    __device__ void init(int M, int N, int G_, int c_) { nM = M / BM; nN = N / BM; nwg = nM * nN; G = G_; c = c_; }
    __device__ bool next(int i, Unit& u) const {
        const long L = (long)i * G + c; if (L >= nwg) return false;
        int wgid = (int)L; { const int q = nwg / NXCD, r = nwg % NXCD, xcd = wgid % NXCD, off = wgid / NXCD; wgid = (xcd < r ? xcd * (q + 1) : r * (q + 1) + (xcd - r) * q) + off; }
        const int nig = WGM * nN, gid = wgid / nig, fm = gid * WGM, gsz = (nM - fm) < WGM ? (nM - fm) : WGM;
        u.pm = fm + ((wgid % nig) % gsz); u.pn = (wgid % nig) / gsz; return true;
    }
};
struct PanelOrder {
    int pm, npn;
    __device__ bool next(int i, Unit& u) const { if (i >= npn) return false; u.pm = pm; u.pn = i; return true; }
};

template <class Epi, class Sched, bool MX = false>
__device__ __forceinline__ void gemm_phase(LAS unsigned char* lds, const Gemm g, const Sched& S, const Epi& E) {
    const int tid = tid_opaque(), wid = __builtin_amdgcn_readfirstlane(tid >> 6), lane = tid & 63, wr = wid >> 2, wc = wid & 3, fr = lane & 15, fq = lane >> 4;
    const int K = g.K, nt = K / BK;
    unsigned voffA, voffB;
    { int R, C; stage_rc(tid * 16, R, C); const int Rb = Epi::PERM ? ((R & ~31) + perm32(R & 31)) : R;
      voffA = (unsigned)(R * g.lda + C) * 2u; voffB = (unsigned)(Rb * K + C) * 2u; }
    const size_t rvoffA = (size_t)128 * g.lda, rvoffB = (size_t)128 * K;
    const size_t kstep = (size_t)(BK * 2);
    const size_t hstep = (size_t)HALF * K * 2;
    const size_t tstep = 2 * hstep;
    const size_t hstepA = (size_t)HALF * g.lda * 2, tstepA = 2 * hstepA;
    const unsigned ldsw = (unsigned)wid * 1024u;
    const int aoff = lds_byte(wr * 64 + fr, fq * 8), boff = lds_byte(wc * 32 + fr, fq * 8);
#define PG8_SA(b, h) (((b) * 2 + (h)) * HTB)
#define PG8_SB(b, h) ((4 + (b) * 2 + (h)) * HTB)
#define PG8_STAGE(bufoff, gbase, voff) do { unsigned vo_ = (voff); asm volatile("" : "+v"(vo_));     \
        _Pragma("unroll") for (int _i = 0; _i < 2; ++_i) \
        __builtin_amdgcn_global_load_lds((const unsigned*)((const char*)(gbase) + _i * r##voff + vo_), (LAS unsigned*)(lds + (bufoff) + ldsw + _i * 8192), 16, 0, 0); } while (0)
#define PG8_LDX(dst, off) do { const v4i_ lo_ = *(const LAS v4i_*)(lds + (off)), hi_ = *(const LAS v4i_*)(lds + (off) + 1024); dst = __builtin_shufflevector(lo_, hi_, 0, 1, 2, 3, 4, 5, 6, 7); } while (0)
#define PG8_LDA(dst, b, h) do { if constexpr (MX) { _Pragma("unroll") for (int m = 0; m < 4; ++m) PG8_LDX(dst##X[m], PG8_SA(b, h) + aoff + m * 2048); } \
        else { _Pragma("unroll") for (int m = 0; m < 4; ++m) _Pragma("unroll") for (int k = 0; k < 2; ++k) dst[m][k] = *(const LAS bf16x8*)(lds + PG8_SA(b, h) + aoff + m * 2048 + k * 1024); } } while (0)
#define PG8_LDB(dst, b, h) do { if constexpr (MX) { _Pragma("unroll") for (int n = 0; n < 2; ++n) PG8_LDX(dst##X[n], PG8_SB(b, h) + boff + n * 2048); } \
        else { _Pragma("unroll") for (int n = 0; n < 2; ++n) _Pragma("unroll") for (int k = 0; k < 2; ++k) dst[n][k] = *(const LAS bf16x8*)(lds + PG8_SB(b, h) + boff + n * 2048 + k * 1024); } } while (0)
#define PG8_MMA(ai, bj, At, Bt) do { __builtin_amdgcn_s_setprio(1); \
        if constexpr (MX) { _Pragma("unroll") for (int m = 0; m < 4; ++m) _Pragma("unroll") for (int n = 0; n < 2; ++n) \
            asm volatile("v_mfma_scale_f32_16x16x128_f8f6f4 %0, %1, %2, %0, %3, %3 op_sel_hi:[0,0,0]" : "+v"(acc[ai][bj][m][n]) : "v"(Bt##X[n]), "v"(At##X[m]), "v"(mxscale)); } \
        else { _Pragma("unroll") for (int m = 0; m < 4; ++m) _Pragma("unroll") for (int n = 0; n < 2; ++n) _Pragma("unroll") for (int k = 0; k < 2; ++k) \
            acc[ai][bj][m][n] = __builtin_amdgcn_mfma_f32_16x16x32_bf16(Bt[n][k], At[m][k], acc[ai][bj][m][n], 0, 0, 0); } \
        __builtin_amdgcn_s_setprio(0); } while (0)
#define PG8_WAIT_V(n) asm volatile("s_waitcnt vmcnt(" #n ")" ::: "memory")
#define PG8_WAIT_L(n) asm volatile("s_waitcnt lgkmcnt(" #n ")" ::: "memory")
#define PG8_BAR __builtin_amdgcn_s_barrier()
#define PG8_SCHED __builtin_amdgcn_sched_barrier(0)
    Unit cur, nxt; int ui = 0;
    if (!S.next(0, cur)) return;
    f32x4 acc[2][2][4][2];
#pragma unroll
    for (int a = 0; a < 2; ++a)
#pragma unroll
        for (int b = 0; b < 2; ++b)
#pragma unroll
            for (int m = 0; m < 4; ++m)
#pragma unroll
                for (int n = 0; n < 2; ++n) acc[a][b][m][n] = (f32x4){0.f, 0.f, 0.f, 0.f};
    typedef int v4i_ __attribute__((ext_vector_type(4))); typedef int v8i_ __attribute__((ext_vector_type(8)));
    bf16x8 At[4][2], B0[2][2], B1[2][2];
    v8i_ AtX[4], B0X[2], B1X[2];
    const int mxscale = 0x7f7f7f7f;
    const char* cA = (const char*)g.A + (size_t)cur.pm * tstepA; const char* cB = (const char*)g.Bt + (size_t)cur.pn * tstep;
    PG8_STAGE(PG8_SB(0, 0), cB, voffB); PG8_STAGE(PG8_SA(0, 0), cA, voffA); PG8_STAGE(PG8_SB(0, 1), cB + hstep, voffB); PG8_STAGE(PG8_SA(0, 1), cA + hstepA, voffA);
    if (wr == 1) PG8_BAR;
    PG8_WAIT_V(4); PG8_BAR;
    PG8_STAGE(PG8_SB(1, 0), cB + kstep, voffB); PG8_STAGE(PG8_SA(1, 0), cA + kstep, voffA); PG8_STAGE(PG8_SB(1, 1), cB + hstep + kstep, voffB);
    PG8_WAIT_V(6); PG8_BAR;
    for (;;) {
        const bool has_next = S.next(ui + 1, nxt);
        const char* nA = has_next ? (const char*)g.A + (size_t)nxt.pm * tstepA : cA; const char* nB = has_next ? (const char*)g.Bt + (size_t)nxt.pn * tstep : cB;
        for (int t = 0; t < nt; t += 2) {
            const bool last = (t == nt - 2);
            const char* a1 = cA + (size_t)(t + 1) * kstep;
            const char* a2 = last ? nA : cA + (size_t)(t + 2) * kstep; const char* b2 = last ? nB : cB + (size_t)(t + 2) * kstep;
            const char* a3 = a2 + kstep; const char* b3 = b2 + kstep;
            PG8_LDB(B0, 0, 0); PG8_SCHED; PG8_LDA(At, 0, 0); PG8_STAGE(PG8_SA(1, 1), a1 + hstepA, voffA);
            PG8_WAIT_L(8); PG8_BAR; PG8_WAIT_L(0); PG8_MMA(0, 0, At, B0); PG8_BAR; PG8_SCHED;
            PG8_LDB(B1, 0, 1); PG8_STAGE(PG8_SB(0, 0), b2, voffB);
            PG8_BAR; PG8_WAIT_L(0); PG8_MMA(0, 1, At, B1); PG8_BAR;
            PG8_LDA(At, 0, 1); PG8_STAGE(PG8_SA(0, 0), a2, voffA);
            PG8_BAR; PG8_WAIT_L(0); PG8_MMA(1, 0, At, B0); PG8_BAR; PG8_SCHED;
            PG8_STAGE(PG8_SB(0, 1), b2 + hstep, voffB);
            PG8_WAIT_V(6); PG8_BAR; PG8_MMA(1, 1, At, B1); PG8_BAR;
            PG8_LDB(B0, 1, 0); PG8_SCHED; PG8_LDA(At, 1, 0); PG8_STAGE(PG8_SA(0, 1), a2 + hstepA, voffA);
            PG8_WAIT_L(8); PG8_BAR; PG8_WAIT_L(0); PG8_MMA(0, 0, At, B0); PG8_BAR; PG8_SCHED;
            PG8_LDB(B1, 1, 1); PG8_STAGE(PG8_SB(1, 0), b3, voffB);
            PG8_BAR; PG8_WAIT_L(0); PG8_MMA(0, 1, At, B1); PG8_BAR;
            PG8_LDA(At, 1, 1); PG8_STAGE(PG8_SA(1, 0), a3, voffA);
            PG8_BAR; PG8_WAIT_L(0); PG8_MMA(1, 0, At, B0); PG8_BAR; PG8_SCHED;
            PG8_STAGE(PG8_SB(1, 1), b3 + hstep, voffB);
            PG8_WAIT_V(6); PG8_BAR; PG8_MMA(1, 1, At, B1); PG8_BAR;
        }
        if constexpr (MX) asm volatile("s_nop 15\n\ts_nop 15" ::: "memory");
        E(acc, cur, wr, wc, fr, fq);
        if (!has_next) break;
#pragma unroll
        for (int a = 0; a < 2; ++a)
#pragma unroll
            for (int b = 0; b < 2; ++b)
#pragma unroll
                for (int m = 0; m < 4; ++m)
#pragma unroll
                    for (int n = 0; n < 2; ++n) acc[a][b][m][n] = (f32x4){0.f, 0.f, 0.f, 0.f};
        cur = nxt; cA = nA; cB = nB; ++ui;
    }
    PG8_WAIT_V(0);
    if (wr == 0) PG8_BAR;
    PG8_BAR;
#undef PG8_SA
#undef PG8_SB
#undef PG8_STAGE
#undef PG8_LDX
#undef PG8_LDA
#undef PG8_LDB
#undef PG8_MMA
#undef PG8_WAIT_V
#undef PG8_WAIT_L
#undef PG8_BAR
#undef PG8_SCHED
}
}
using pg8::Unit;

struct EpiProj {
    static constexpr bool PERM = true;
    unsigned char* ws; const float* lb; const float* ng; float* kmean;
    __device__ __forceinline__ void operator()(const f32x4 (&acc)[2][2][4][2], const Unit& u, int wr, int wc, int fr, int fq) const {
        const int pn = u.pn; int seg, colt, ldc; size_t boff;
        if (pn < 14) { seg = pn >> 1; colt = (pn & 1) * 256; ldc = 512; boff = OFF_QA + (size_t)seg * SZ_T512; }
        else if (pn < 18) { seg = 7; colt = (pn - 14) * 256; ldc = 1024; boff = OFF_GA; }
        else { seg = 8; colt = (pn - 18) * 256; ldc = 1024; boff = OFF_GB; }
        bf16_t* base = (bf16_t*)(ws + boff);
        const int row0 = u.pm * 256 + wr * 64 + fr, col0 = colt + wc * 32 + 8 * fq;
        float pv[2][8];
#pragma unroll
        for (int bj = 0; bj < 2; ++bj)
#pragma unroll
            for (int e = 0; e < 8; ++e) pv[bj][e] = (seg == 4) ? (1.0f - lb[col0 + bj * 128 + e]) : ((seg == 6) ? ng[col0 + bj * 128 + e] : 0.f);
        float cs[2][8];
#pragma unroll
        for (int bj = 0; bj < 2; ++bj)
#pragma unroll
            for (int e = 0; e < 8; ++e) cs[bj][e] = 0.f;
#pragma unroll
        for (int ai = 0; ai < 2; ++ai)
#pragma unroll
            for (int m = 0; m < 4; ++m) {
                bf16_t* rowp = base + (size_t)(row0 + ai * 128 + m * 16) * ldc + col0;
#pragma unroll
                for (int bj = 0; bj < 2; ++bj) {
                    float v[8];
#pragma unroll
                    for (int e = 0; e < 4; ++e) { v[e] = acc[ai][bj][m][0][e] * (1.0f / 32.0f); v[4 + e] = acc[ai][bj][m][1][e] * (1.0f / 32.0f); }
                    if (seg == 0) {
#pragma unroll
                        for (int e = 0; e < 8; ++e) v[e] *= (0.125f * LOG2E);
                    } else if (seg == 1) {
#pragma unroll
                        for (int e = 0; e < 8; ++e) cs[bj][e] += v[e];
                    } else if (seg == 3) {
#pragma unroll
                        for (int e = 0; e < 8; ++e) v[e] = v[e] * sigmoidf_(v[e]);
                    } else if (seg == 4) {
#pragma unroll
                        for (int e = 0; e < 8; ++e) v[e] = pv[bj][e] * sigmoidf_(-v[e]);
                    } else if (seg == 6) {
#pragma unroll
                        for (int e = 0; e < 8; ++e) v[e] = pv[bj][e] * v[e] * sigmoidf_(v[e]);
                    } else if (seg >= 7) {
#pragma unroll
                        for (int e = 0; e < 8; ++e) v[e] = sigmoidf_(v[e]);
                    }
                    u32x4 w; w.x = cvt_pk_bf16(v[0], v[1]); w.y = cvt_pk_bf16(v[2], v[3]); w.z = cvt_pk_bf16(v[4], v[5]); w.w = cvt_pk_bf16(v[6], v[7]);
                    *(u32x4*)(rowp + bj * 128) = w;
                }
            }
        if (seg == 1) {
#pragma unroll
            for (int bj = 0; bj < 2; ++bj)
#pragma unroll
                for (int e = 0; e < 8; ++e) {
                    float s = cs[bj][e];
                    s += __shfl_xor(s, 1); s += __shfl_xor(s, 2); s += __shfl_xor(s, 4); s += __shfl_xor(s, 8);
                    if (fr == 0) atomicAdd(kmean + (size_t)u.pm * 512 + col0 + bj * 128 + e, s);
                }
        }
    }
};
struct EpiMixA {
    static constexpr bool PERM = true;
    bf16_t* GA;
    __device__ __forceinline__ void operator()(const f32x4 (&acc)[2][2][4][2], const Unit& u, int wr, int wc, int fr, int fq) const {
        const int row0 = u.pm * 256 + wr * 64 + fr, col0 = u.pn * 256 + wc * 32 + 8 * fq;
#pragma unroll
        for (int ai = 0; ai < 2; ++ai)
#pragma unroll
            for (int m = 0; m < 4; ++m) {
                bf16_t* rowp = GA + (size_t)(row0 + ai * 128 + m * 16) * 1024 + col0;
#pragma unroll
                for (int bj = 0; bj < 2; ++bj) {
                    const u32x4 g = *(const u32x4*)(rowp + bj * 128);
                    const f32x4 a0 = acc[ai][bj][m][0], a1 = acc[ai][bj][m][1];
                    u32x4 w;
                    constexpr float S = 1.0f / 32.0f;
                    w.x = cvt_pk_bf16(bf_lo(g.x) * a0[0] * S, bf_hi(g.x) * a0[1] * S); w.y = cvt_pk_bf16(bf_lo(g.y) * a0[2] * S, bf_hi(g.y) * a0[3] * S);
                    w.z = cvt_pk_bf16(bf_lo(g.z) * a1[0] * S, bf_hi(g.z) * a1[1] * S); w.w = cvt_pk_bf16(bf_lo(g.w) * a1[2] * S, bf_hi(g.w) * a1[3] * S);
                    *(u32x4*)(rowp + bj * 128) = w;
                }
            }
    }
};
struct EpiMixB {
    static constexpr bool PERM = true;
    const bf16_t* GA; const bf16_t* GB; unsigned char* M8;
    __device__ __forceinline__ void operator()(const f32x4 (&acc)[2][2][4][2], const Unit& u, int wr, int wc, int fr, int fq) const {
        const int row0 = u.pm * 256 + wr * 64 + fr, col0 = u.pn * 256 + wc * 32 + 8 * fq;
#pragma unroll
        for (int ai = 0; ai < 2; ++ai)
#pragma unroll
            for (int m = 0; m < 4; ++m) {
                const size_t off = (size_t)(row0 + ai * 128 + m * 16) * 1024 + col0;
#pragma unroll
                for (int bj = 0; bj < 2; ++bj) {
                    const u32x4 g = *(const u32x4*)(GB + off + bj * 128);
                    const u32x4 mx = *(const u32x4*)(GA + off + bj * 128);
                    const f32x4 a0 = acc[ai][bj][m][0], a1 = acc[ai][bj][m][1];
                    constexpr float S = 1.0f / 32.0f;
                    int w0 = __builtin_amdgcn_cvt_pk_fp8_f32(bf_lo(mx.x) + bf_lo(g.x) * a0[0] * S, bf_hi(mx.x) + bf_hi(g.x) * a0[1] * S, 0, false); w0 = __builtin_amdgcn_cvt_pk_fp8_f32(bf_lo(mx.y) + bf_lo(g.y) * a0[2] * S, bf_hi(mx.y) + bf_hi(g.y) * a0[3] * S, w0, true);
                    int w1 = __builtin_amdgcn_cvt_pk_fp8_f32(bf_lo(mx.z) + bf_lo(g.z) * a1[0] * S, bf_hi(mx.z) + bf_hi(g.z) * a1[1] * S, 0, false); w1 = __builtin_amdgcn_cvt_pk_fp8_f32(bf_lo(mx.w) + bf_lo(g.w) * a1[2] * S, bf_hi(mx.w) + bf_hi(g.w) * a1[3] * S, w1, true);
                    *(u32x2*)(M8 + off + bj * 128) = (u32x2){(unsigned)w0, (unsigned)w1};
                }
            }
    }
};
struct EpiOut {
    static constexpr bool PERM = true;
    const float* ada; bf16_t* D;
    __device__ __forceinline__ void operator()(const f32x4 (&acc)[2][2][4][2], const Unit& u, int wr, int wc, int fr, int fq) const {
        const int row0 = u.pm * 256 + wr * 64 + fr, col0 = u.pn * 256 + wc * 32 + 8 * fq;
        const float* gt1 = ada + (size_t)(u.pm >> 3) * 6144 + 2048 + col0;
        f32x4 g[2][2];
#pragma unroll
        for (int bj = 0; bj < 2; ++bj) { g[bj][0] = *(const f32x4*)(gt1 + bj * 128); g[bj][1] = *(const f32x4*)(gt1 + bj * 128 + 4); }
#pragma unroll
        for (int ai = 0; ai < 2; ++ai)
#pragma unroll
            for (int m = 0; m < 4; ++m) {
                bf16_t* rowp = D + (size_t)(row0 + ai * 128 + m * 16) * 1024 + col0;
#pragma unroll
                for (int bj = 0; bj < 2; ++bj) {
                    const f32x4 a0 = acc[ai][bj][m][0] * g[bj][0] * (1.0f / 32.0f), a1 = acc[ai][bj][m][1] * g[bj][1] * (1.0f / 32.0f);
                    u32x4 w; w.x = cvt_pk_bf16(a0[0], a0[1]); w.y = cvt_pk_bf16(a0[2], a0[3]); w.z = cvt_pk_bf16(a1[0], a1[1]); w.w = cvt_pk_bf16(a1[2], a1[3]);
                    *(u32x4*)(rowp + bj * 128) = w;
                }
            }
    }
};
struct EpiBf16 {
    static constexpr bool PERM = true;
    bf16_t* O;
    __device__ __forceinline__ void operator()(const f32x4 (&acc)[2][2][4][2], const Unit& u, int wr, int wc, int fr, int fq) const {
        const int row0 = u.pm * 256 + wr * 64 + fr, col0 = u.pn * 256 + wc * 32 + 8 * fq;
#pragma unroll
        for (int ai = 0; ai < 2; ++ai)
#pragma unroll
            for (int m = 0; m < 4; ++m) {
                bf16_t* rowp = O + (size_t)(row0 + ai * 128 + m * 16) * 1024 + col0;
#pragma unroll
                for (int bj = 0; bj < 2; ++bj) {
                    const f32x4 a0 = acc[ai][bj][m][0], a1 = acc[ai][bj][m][1];
                    u32x4 w; w.x = cvt_pk_bf16(a0[0], a0[1]); w.y = cvt_pk_bf16(a0[2], a0[3]); w.z = cvt_pk_bf16(a1[0], a1[1]); w.w = cvt_pk_bf16(a1[2], a1[3]);
                    *(u32x4*)(rowp + bj * 128) = w;
                }
            }
    }
};

__device__ void phase0a(const Params& P, LAS unsigned char* lds) {
    const int tid = tid_opaque(), G = gridDim.x, bid = blockIdx.x;
    for (int it = bid; it < 192; it += G) {
        LAS float* sc = (LAS float*)lds;
        for (int i = tid; i < 32 * 1024; i += NTHR) { const float cv = P.c[i]; sc[i] = cv * sigmoidf_(cv); }
        __syncthreads();
        const int kg = tid >> 5, col = tid & 31;
        float a[32];
#pragma unroll
        for (int b = 0; b < 32; ++b) a[b] = 0.f;
#pragma unroll 1
        for (int k = kg * 64; k < kg * 64 + 64; k += 8) {
            float w[8];
#pragma unroll
            for (int e = 0; e < 8; ++e) w[e] = __builtin_nontemporal_load(P.w_ada + (size_t)(k + e) * 6144 + it * 32 + col);
#pragma unroll
            for (int e4 = 0; e4 < 2; ++e4) {
#pragma unroll
                for (int b = 0; b < 32; ++b) { const f32x4 s = *(const LAS f32x4*)(sc + b * 1024 + k + 4 * e4); a[b] += s[0] * w[4 * e4] + s[1] * w[4 * e4 + 1] + s[2] * w[4 * e4 + 2] + s[3] * w[4 * e4 + 3]; }
                asm volatile("" ::: "memory");
            }
        }
        __syncthreads();
        LAS float* red = (LAS float*)lds;
#pragma unroll
        for (int b = 0; b < 32; ++b) red[(kg * 32 + b) * 32 + col] = a[b];
        __syncthreads();
        for (int o = tid; o < 1024; o += NTHR) { const int b = o >> 5, cc = o & 31; float s = 0.f;
#pragma unroll
            for (int g2 = 0; g2 < 16; ++g2) s += red[(g2 * 32 + b) * 32 + cc];
            ((float*)(P.ws + OFF_ADA))[(size_t)b * 6144 + it * 32 + cc] = s + P.b_ada[it * 32 + cc]; }
        __syncthreads();
    }
    const size_t gsz = (size_t)G * NTHR;
    { const int gt = bid * NTHR + tid, gs = G * NTHR;
      if (gt < 512) ((float*)(P.ws + OFF_LB))[gt] = sigmoidf_(P.hgrn_lb[gt] - P.hgrn_lb[512 + gt]);
      for (int i = gt; i < 32 * 8 * 512; i += gs) ((float*)(P.ws + OFF_KMEAN))[i] = 0.f; }
    {
        LAS float* tile = (LAS float*)lds;
        const int I0 = 16 * 88, I1 = I0 + 8 * 16, I2 = I1 + 8 * 16, I3 = I2 + 16 * 16, I4 = I3 + 16 * 16;
        for (int it = bid; it < I4; it += G) {
            const float* W; bf16_t* WT; int K, N, r;
            if (it < I0) { W = P.w_in; WT = (bf16_t*)(P.ws + OFF_WIN); K = 1024; N = 5632; r = it; }
            else if (it < I1) { W = P.w_ba; WT = (bf16_t*)(P.ws + OFF_WBA); K = 512; N = 1024; r = it - I0; }
            else if (it < I2) { W = P.w_bb; WT = (bf16_t*)(P.ws + OFF_WBB); K = 512; N = 1024; r = it - I1; }
            else if (it < I3) { W = P.w_out; WT = (bf16_t*)(P.ws + OFF_WOUT); K = 1024; N = 1024; r = it - I2; }
            else { W = P.peer_wq; WT = (bf16_t*)(P.ws + OFF_WQ); K = 1024; N = 1024; r = it - I3; }
            const int nb = N / 64, k0 = (r / nb) * 64, n0 = (r % nb) * 64;
#pragma unroll
            for (int ps = 0; ps < 2; ++ps) { const int kk = (tid >> 4) + 32 * ps, n4 = (tid & 15) * 4;
                const f32x4 v = *(const f32x4*)(W + (size_t)(k0 + kk) * N + n0 + n4);
                tile[kk * 65 + n4] = v[0]; tile[kk * 65 + n4 + 1] = v[1]; tile[kk * 65 + n4 + 2] = v[2]; tile[kk * 65 + n4 + 3] = v[3]; }
            __syncthreads();
            { const int n = tid >> 3, kc = (tid & 7) * 8;
              if (it < I3) {
                  int w0 = __builtin_amdgcn_cvt_pk_fp8_f32(32.f * tile[(kc + 0) * 65 + n], 32.f * tile[(kc + 1) * 65 + n], 0, false); w0 = __builtin_amdgcn_cvt_pk_fp8_f32(32.f * tile[(kc + 2) * 65 + n], 32.f * tile[(kc + 3) * 65 + n], w0, true);
                  int w1 = __builtin_amdgcn_cvt_pk_fp8_f32(32.f * tile[(kc + 4) * 65 + n], 32.f * tile[(kc + 5) * 65 + n], 0, false); w1 = __builtin_amdgcn_cvt_pk_fp8_f32(32.f * tile[(kc + 6) * 65 + n], 32.f * tile[(kc + 7) * 65 + n], w1, true);
                  *(u32x2*)((unsigned char*)WT + (size_t)(n0 + n) * K + k0 + kc) = (u32x2){(unsigned)w0, (unsigned)w1};
              } else { u32x4 w;
              w.x = cvt_pk_bf16(tile[(kc + 0) * 65 + n], tile[(kc + 1) * 65 + n]); w.y = cvt_pk_bf16(tile[(kc + 2) * 65 + n], tile[(kc + 3) * 65 + n]);
              w.z = cvt_pk_bf16(tile[(kc + 4) * 65 + n], tile[(kc + 5) * 65 + n]); w.w = cvt_pk_bf16(tile[(kc + 6) * 65 + n], tile[(kc + 7) * 65 + n]);
              *(u32x4*)(WT + (size_t)(n0 + n) * K + k0 + kc) = w; } }
            __syncthreads();
        }
    }
    {
        const size_t gtid = (size_t)bid * NTHR + tid_opaque();
        for (size_t i = gtid; i < 16384; i += gsz) {
            const float* src = P.peer_sk + i * 8; const f32x4 a = *(const f32x4*)src, b = *(const f32x4*)(src + 4);
            u32x4 w; w.x = cvt_pk_bf16(a[0], a[1]); w.y = cvt_pk_bf16(a[2], a[3]); w.z = cvt_pk_bf16(b[0], b[1]); w.w = cvt_pk_bf16(b[2], b[3]);
            *(u32x4*)((bf16_t*)(P.ws + OFF_SK) + i * 8) = w;
        }
        { const int lane = tid & 63, gw = bid * 8 + (tid >> 6), ngw = G * 8;
          for (int r = gw; r < 2 * 16384; r += ngw) {
              const bool isv = r >= 16384; const int e = isv ? r - 16384 : r;
              const float* s = (isv ? P.peer_v : P.peer_u) + (size_t)e * 1024 + lane * 16;
              f32x4 x[4]; float ss = 0.f;
#pragma unroll
              for (int q = 0; q < 4; ++q) { x[q] = __builtin_nontemporal_load((const f32x4*)(s + 4 * q)); ss += (x[q][0] * x[q][0] + x[q][1] * x[q][1]) + (x[q][2] * x[q][2] + x[q][3] * x[q][3]); }
              const float sc = fmaxf(sqrtf(wave_sum(ss) * (1.0f / 1024.0f)) * (2.6f / 7.5f), 1e-30f), inv = 1.0f / sc;
              unsigned nb[16];
#pragma unroll
              for (int q = 0; q < 4; ++q)
#pragma unroll
                  for (int el = 0; el < 4; ++el) nb[4 * q + el] = (unsigned)fminf(fmaxf(floorf(x[q][el] * inv) + 8.0f, 0.0f), 15.0f);
              u32x2 w;
              w.x = (nb[0] | (nb[4] << 4)) | ((nb[1] | (nb[5] << 4)) << 8) | ((nb[2] | (nb[6] << 4)) << 16) | ((nb[3] | (nb[7] << 4)) << 24);
              w.y = (nb[8] | (nb[12] << 4)) | ((nb[9] | (nb[13] << 4)) << 8) | ((nb[10] | (nb[14] << 4)) << 16) | ((nb[11] | (nb[15] << 4)) << 24);
              *(u32x2*)(P.ws + (isv ? OFF_V8 : OFF_U8) + (size_t)e * 512 + lane * 8) = w;
              if (lane == 0) ((float*)(P.ws + (isv ? OFF_VSC : OFF_USC)))[e] = sc;
          } }
    }
}
__device__ void phase0b(const Params& P) {
    const size_t gtid = (size_t)blockIdx.x * NTHR + threadIdx.x, gsz = (size_t)gridDim.x * NTHR;
    const float* ada = (const float*)(P.ws + OFF_ADA); bf16_t* H = (bf16_t*)(P.ws + OFF_H);
    for (size_t i = gtid; i < (size_t)NTOK * 128; i += gsz) {
        const size_t row = i >> 7; const int c8 = (int)(i & 127) * 8; const int b = (int)(row >> 11);
        const float* xr = P.x + row * 1024 + c8; const float* sh = ada + (size_t)b * 6144 + c8; const float* sc = sh + 1024;
        const f32x4 x0 = *(const f32x4*)xr, x1 = *(const f32x4*)(xr + 4), s0 = *(const f32x4*)sc, s1 = *(const f32x4*)(sc + 4), h0 = *(const f32x4*)sh, h1 = *(const f32x4*)(sh + 4);
        const f32x4 r0 = x0 * (s0 + 1.0f) + h0, r1 = x1 * (s1 + 1.0f) + h1;
        int w0 = __builtin_amdgcn_cvt_pk_fp8_f32(r0[0], r0[1], 0, false); w0 = __builtin_amdgcn_cvt_pk_fp8_f32(r0[2], r0[3], w0, true);
        int w1 = __builtin_amdgcn_cvt_pk_fp8_f32(r1[0], r1[1], 0, false); w1 = __builtin_amdgcn_cvt_pk_fp8_f32(r1[2], r1[3], w1, true);
        *(u32x2*)((unsigned char*)H + row * 1024 + c8) = (u32x2){(unsigned)w0, (unsigned)w1};
    }
}

__device__ __forceinline__ s16x4 tr4(const LAS unsigned char* p) { return __builtin_bit_cast(s16x4, __builtin_amdgcn_ds_read_tr16_b64_v4i16((LAS s16x4*)p)); }
__device__ void hgrn_item(const Params& P, int item, LAS unsigned char* lds) {
    const int tid = tid_opaque(), lane = tid & 63, wid = __builtin_amdgcn_readfirstlane(tid >> 6), r32 = lane & 31, hi = lane >> 5;
    const int b = item >> 3, h = (item >> 1) & 3, vh = item & 1;
    const bf16_t* HQ = (const bf16_t*)(P.ws + OFF_HQ); const bf16_t* HK = (const bf16_t*)(P.ws + OFF_HK); bf16_t* HI = (bf16_t*)(P.ws + OFF_HI);
    constexpr int SQ = 272, SKD = 320, SV = 192, SS = 192;
    constexpr int LQR = 0, LKR = 17408, LQB = 34816, LKD = 52224, LV = 72704, LS = 84992, LG = 109568, LT = 142336, LCL = 144384;
    LAS float* G = (LAS float*)(lds + LG); LAS float* TOT = (LAS float*)(lds + LT); LAS float* CL = (LAS float*)(lds + LCL);
    const size_t rowb = (size_t)b * SEQ;
    const int row = tid >> 3, seg = tid & 7;
    const bf16_t* qsrc = HQ + (rowb + row) * 512 + h * 128 + seg * 16; const bf16_t* ksrc = HK + (rowb + row) * 512 + h * 128 + seg * 16;
    bf16_t* vsrc = HI + (rowb + row) * 512 + h * 128 + vh * 64 + seg * 8;
    for (int i = tid; i < 128 * SS / 4; i += NTHR) ((LAS unsigned*)(lds + LS))[i] = 0u;
    f32x16 Sacc = {};
    const int di = wid >> 1, vi = wid & 1, ti = wid >> 1;
    const int tg = lane >> 4, tc = tg & 1, tI = lane & 15;
    const int trow = 4 * hi + (tI >> 2), tcol = 16 * tc + 4 * (tI & 3);
    u32x4 qn0 = *(const u32x4*)qsrc, qn1 = *(const u32x4*)(qsrc + 8), kn0 = *(const u32x4*)ksrc, kn1 = *(const u32x4*)(ksrc + 8), vn = *(const u32x4*)vsrc;
#pragma unroll 1
    for (int n = 0; n < SEQ / 64; ++n) {
        const u32x4 q0 = qn0, q1 = qn1, k0 = kn0, k1 = kn1, vv = vn;
        float qf[16] = {bf_lo(q0.x), bf_hi(q0.x), bf_lo(q0.y), bf_hi(q0.y), bf_lo(q0.z), bf_hi(q0.z), bf_lo(q0.w), bf_hi(q0.w), bf_lo(q1.x), bf_hi(q1.x), bf_lo(q1.y), bf_hi(q1.y), bf_lo(q1.z), bf_hi(q1.z), bf_lo(q1.w), bf_hi(q1.w)};
        float kf[16] = {bf_lo(k0.x), bf_hi(k0.x), bf_lo(k0.y), bf_hi(k0.y), bf_lo(k0.z), bf_hi(k0.z), bf_lo(k0.w), bf_hi(k0.w), bf_lo(k1.x), bf_hi(k1.x), bf_lo(k1.y), bf_hi(k1.y), bf_lo(k1.z), bf_hi(k1.z), bf_lo(k1.w), bf_hi(k1.w)};
#pragma unroll
        for (int e4 = 0; e4 < 4; ++e4) *(LAS f32x4*)(G + row * 128 + seg * 16 + 4 * e4) = (f32x4){__logf(1.0f - kf[4 * e4]), __logf(1.0f - kf[4 * e4 + 1]), __logf(1.0f - kf[4 * e4 + 2]), __logf(1.0f - kf[4 * e4 + 3])};
        *(LAS u32x4*)(lds + LV + row * SV + seg * 16) = vv;
        if (n + 1 < SEQ / 64) { const size_t o = (size_t)(n + 1) * 64 * 512; qn0 = *(const u32x4*)(qsrc + o); qn1 = *(const u32x4*)(qsrc + o + 8); kn0 = *(const u32x4*)(ksrc + o); kn1 = *(const u32x4*)(ksrc + o + 8); vn = *(const u32x4*)(vsrc + o); }
        __syncthreads();
        { const int d = tid & 127, q4 = tid >> 7; float s = 0.f;
#pragma unroll
          for (int i = 0; i < 16; ++i) { s += G[(16 * q4 + i) * 128 + d]; G[(16 * q4 + i) * 128 + d] = s; }
          TOT[q4 * 128 + d] = s; }
        __syncthreads();
        {
            const int qq = row >> 4;
#pragma unroll
            for (int e4 = 0; e4 < 4; ++e4) {
                const int d4 = seg * 16 + 4 * e4;
                const f32x4 t0 = *(const LAS f32x4*)(TOT + d4), t1 = *(const LAS f32x4*)(TOT + 128 + d4), t2 = *(const LAS f32x4*)(TOT + 256 + d4), t3 = *(const LAS f32x4*)(TOT + 384 + d4);
                const f32x4 off = (qq == 0) ? (f32x4){0.f, 0.f, 0.f, 0.f} : ((qq == 1) ? t0 : ((qq == 2) ? t0 + t1 : t0 + t1 + t2));
                const f32x4 bb = *(const LAS f32x4*)(G + row * 128 + d4) + off;
                const f32x4 bref = *(const LAS f32x4*)(G + 32 * 128 + d4) + t0 + t1, blast = t0 + t1 + t2 + t3;
                float vqb[4], vqr[4], vkr[4], vkd[4];
#pragma unroll
                for (int e = 0; e < 4; ++e) {
                    const float e1 = __expf(bb[e]), e2 = __expf(-bb[e]);
                    vqb[e] = qf[4 * e4 + e] * e1; vqr[e] = vqb[e] * __expf(-bref[e]);
                    const float ke = kf[4 * e4 + e] * e2; vkr[e] = ke * __expf(bref[e]); vkd[e] = ke * __expf(blast[e]);
                }
                *(LAS u32x2*)(lds + LQB + row * SQ + seg * 32 + 8 * e4) = (u32x2){cvt_pk_bf16(vqb[0], vqb[1]), cvt_pk_bf16(vqb[2], vqb[3])};
                *(LAS u32x2*)(lds + LQR + row * SQ + seg * 32 + 8 * e4) = (u32x2){cvt_pk_bf16(vqr[0], vqr[1]), cvt_pk_bf16(vqr[2], vqr[3])};
                *(LAS u32x2*)(lds + LKR + row * SQ + seg * 32 + 8 * e4) = (u32x2){cvt_pk_bf16(vkr[0], vkr[1]), cvt_pk_bf16(vkr[2], vkr[3])};
                *(LAS u32x2*)(lds + LKD + row * SKD + seg * 32 + 8 * e4) = (u32x2){cvt_pk_bf16(vkd[0], vkd[1]), cvt_pk_bf16(vkd[2], vkd[3])};
                if (row == 0) *(LAS f32x4*)(CL + d4) = (f32x4){__expf(blast[0]), __expf(blast[1]), __expf(blast[2]), __expf(blast[3])};
                asm volatile("" ::: "memory");
            }
        }
        __syncthreads();
        if (wid < 4) {
            f32x16 Z = {};
            for (int si = 0; si <= ti; ++si) {
                f32x16 X = {};
#pragma unroll
                for (int ks = 0; ks < 8; ++ks) {
                    const bf16x8 a = *(const LAS bf16x8*)(lds + LKR + (32 * si + r32) * SQ + (16 * ks + 8 * hi) * 2);
                    const bf16x8 bq = *(const LAS bf16x8*)(lds + LQR + (32 * ti + r32) * SQ + (16 * ks + 8 * hi) * 2);
                    X = MFMA32(a, bq, X);
                }
                if (si == ti) {
#pragma unroll
                    for (int r = 0; r < 16; ++r) if (crow(r, hi) > r32) X[r] = 0.f;
                }
#pragma unroll
                for (int s2 = 0; s2 < 2; ++s2) {
                    union { u32x4 u; bf16x8 v; } pa;
                    pa.u.x = cvt_pk_bf16(X[8 * s2 + 0], X[8 * s2 + 1]); pa.u.y = cvt_pk_bf16(X[8 * s2 + 2], X[8 * s2 + 3]); pa.u.z = cvt_pk_bf16(X[8 * s2 + 4], X[8 * s2 + 5]); pa.u.w = cvt_pk_bf16(X[8 * s2 + 6], X[8 * s2 + 7]);
                    const LAS unsigned char* vp = lds + LV + (32 * si + 16 * s2 + trow) * SV + (32 * vi + tcol) * 2;
                    const s16x4 lo = tr4(vp), hh = tr4(vp + 8 * SV);
                    const bf16x8 vf = {lo[0], lo[1], lo[2], lo[3], hh[0], hh[1], hh[2], hh[3]};
                    Z = MFMA32(pa.v, vf, Z);
                }
            }
#pragma unroll
            for (int ks = 0; ks < 8; ++ks) {
                const bf16x8 a = *(const LAS bf16x8*)(lds + LQB + (32 * ti + r32) * SQ + (16 * ks + 8 * hi) * 2);
                const LAS unsigned char* sp = lds + LS + (16 * ks + 8 * hi + (tI >> 2)) * SS + (32 * vi + tcol) * 2;
                const s16x4 lo = tr4(sp), hh = tr4(sp + 4 * SS);
                const bf16x8 sf = {lo[0], lo[1], lo[2], lo[3], hh[0], hh[1], hh[2], hh[3]};
                Z = MFMA32(a, sf, Z);
            }
            bf16_t* op = HI + (rowb + (size_t)n * 64 + 32 * ti) * 512 + h * 128 + vh * 64 + 32 * vi + r32;
#pragma unroll
            for (int r = 0; r < 16; ++r) op[(size_t)crow(r, hi) * 512] = (bf16_t)(cvt_pk_bf16(Z[r], 0.f) & 0xffffu);
        }
        {
#pragma unroll
            for (int r = 0; r < 16; ++r) Sacc[r] *= CL[32 * di + crow(r, hi)];
#pragma unroll
            for (int ks = 0; ks < 4; ++ks) {
                const LAS unsigned char* kp = lds + LKD + (16 * ks + 8 * hi + (tI >> 2)) * SKD + (32 * di + tcol) * 2;
                const s16x4 klo = tr4(kp), khi = tr4(kp + 4 * SKD);
                const bf16x8 ka = {klo[0], klo[1], klo[2], klo[3], khi[0], khi[1], khi[2], khi[3]};
                const LAS unsigned char* vp = lds + LV + (16 * ks + 8 * hi + (tI >> 2)) * SV + (32 * vi + tcol) * 2;
                const s16x4 vlo = tr4(vp), vhi = tr4(vp + 4 * SV);
                const bf16x8 vb = {vlo[0], vlo[1], vlo[2], vlo[3], vhi[0], vhi[1], vhi[2], vhi[3]};
                Sacc = MFMA32(ka, vb, Sacc);
            }
        }
        __syncthreads();
        {
            LAS bf16_t* sp = (LAS bf16_t*)(lds + LS + (32 * di) * SS + (32 * vi + r32) * 2);
#pragma unroll
            for (int r = 0; r < 16; ++r) sp[crow(r, hi) * (SS / 2)] = (bf16_t)(cvt_pk_bf16(Sacc[r], 0.f) & 0xffffu);
        }
    }
    __syncthreads();
}

__device__ void moba_unit(const Params& P, int b, int h, int j, LAS unsigned char* lds) {
    const int tid = tid_opaque(), lane = tid & 63, wid = tid >> 6, r32 = lane & 31, hi = lane >> 5;
    bf16_t* Q = (bf16_t*)(P.ws + OFF_QA); const bf16_t* Kg = (const bf16_t*)(P.ws + OFF_KA); const bf16_t* Vg = (const bf16_t*)(P.ws + OFF_VA);
    const float* kmean = (const float*)(P.ws + OFF_KMEAN);
    constexpr int KIMG = 64 * 144, VIMG = 64 * 192, LK = 0, LV = 2 * KIMG, LKM = 2 * KIMG + 2 * VIMG;
    LAS float* kmL = (LAS float*)(lds + LKM);
    const size_t rowb = (size_t)b * SEQ; const int q0 = j * 256;
    if (tid < j * 64) kmL[tid] = kmean[(size_t)(b * 8 + (tid >> 6)) * 512 + h * 64 + (tid & 63)];
    bf16_t* qrow = Q + (rowb + q0 + wid * 32 + r32) * 512 + h * 64;
    bf16x8 qf[4];
#pragma unroll
    for (int d0 = 0; d0 < 4; ++d0) qf[d0] = *(const bf16x8*)(qrow + 16 * d0 + 8 * hi);
    const int srow = tid >> 3, sch = tid & 7;
    const bf16_t* ksrc = Kg + (rowb + srow) * 512 + h * 64 + sch * 8; const bf16_t* vsrc = Vg + (rowb + srow) * 512 + h * 64 + sch * 8;
    const int ntile = 4 * (j + 1);
    u32x4 kreg, vreg;
    { const int key0 = q0; kreg = *(const u32x4*)(ksrc + (size_t)key0 * 512); vreg = *(const u32x4*)(vsrc + (size_t)key0 * 512); }
    *(LAS u32x4*)(lds + LK + srow * 144 + sch * 16) = kreg; *(LAS u32x4*)(lds + LV + srow * 192 + sch * 16) = vreg;
    __syncthreads();
    unsigned sel = 0;
    if (j <= 3) sel = (1u << j) - 1u;
    else {
        float g[7];
#pragma unroll
        for (int n = 0; n < 7; ++n) { float s = 0.f;
            if (n < j) {
#pragma unroll
                for (int d0 = 0; d0 < 4; ++d0)
#pragma unroll
                    for (int e = 0; e < 8; ++e) s += __uint_as_float(((unsigned)(unsigned short)qf[d0][e]) << 16) * kmL[n * 64 + 16 * d0 + 8 * hi + e];
            }
            s += __shfl_xor(s, 32); g[n] = s; }
#pragma unroll
        for (int it = 0; it < 3; ++it) { float best = -INFINITY; int bi = 0;
#pragma unroll
            for (int n = 0; n < 7; ++n) if (n < j && !((sel >> n) & 1u) && g[n] > best) { best = g[n]; bi = n; }
            sel |= 1u << bi; }
    }
    const float ch = exp2f(-(float)(h + 1)) * LOG2E;
    const int qb = wid * 32 + r32;
    float m_run = -1e30f, l_run = 0.f;
    f32x16 o0 = {}, o1 = {};
    const int tg = lane >> 4, tc = tg & 1, ti = lane & 15;
    const int vlane = (4 * hi + (ti >> 2)) * 192 + (16 * tc + 4 * (ti & 3)) * 2;
#pragma unroll 1
    for (int i = 0; i < ntile; ++i) {
        const int buf = i & 1;
        const bool own = i < 4; const int blk = own ? j : ((i - 4) >> 2), kt = own ? i : ((i - 4) & 3);
        if (i + 1 < ntile) { const int i1 = i + 1; const int blk1 = (i1 < 4) ? j : ((i1 - 4) >> 2), kt1 = (i1 < 4) ? i1 : ((i1 - 4) & 3); const size_t key1 = (size_t)(blk1 * 256 + kt1 * 64);
            kreg = *(const u32x4*)(ksrc + key1 * 512); vreg = *(const u32x4*)(vsrc + key1 * 512); }
        const bool lane_ok = own ? true : (((sel >> blk) & 1u) != 0u);
        const bool skip = own ? (64 * kt > 32 * wid + 31) : (__ballot(lane_ok) == 0ull);
        if (!skip) {
            LAS unsigned char* kb = lds + LK + buf * KIMG; LAS unsigned char* vb = lds + LV + buf * VIMG;
            f32x16 p0 = {}, p1 = {};
#pragma unroll
            for (int d0 = 0; d0 < 4; ++d0) {
                const bf16x8 kf0 = *(const LAS bf16x8*)(kb + r32 * 144 + (16 * d0 + 8 * hi) * 2);
                const bf16x8 kf1 = *(const LAS bf16x8*)(kb + (32 + r32) * 144 + (16 * d0 + 8 * hi) * 2);
                p0 = MFMA32(kf0, qf[d0], p0); p1 = MFMA32(kf1, qf[d0], p1);
            }
            const float kbase = ch * (float)((blk - j) * 256 + kt * 64);
            float mt = -1e30f;
#pragma unroll
            for (int r = 0; r < 16; ++r) {
                const int kl0 = crow(r, hi), kl1 = kl0 + 32;
                const float t0 = p0[r] + (kbase + ch * (float)kl0), t1 = p1[r] + (kbase + ch * (float)kl1);
                const bool v0 = own ? (kt * 64 + kl0 <= qb) : lane_ok, v1 = own ? (kt * 64 + kl1 <= qb) : lane_ok;
                p0[r] = v0 ? t0 : -1e30f; p1[r] = v1 ? t1 : -1e30f;
                mt = fmaxf(mt, fmaxf(p0[r], p1[r]));
            }
            mt = fmaxf(mt, __shfl_xor(mt, 32));
            const float mnew = fmaxf(m_run, mt), alpha = __builtin_amdgcn_exp2f(m_run - mnew);
            m_run = mnew;
            float rs = 0.f;
#pragma unroll
            for (int r = 0; r < 16; ++r) { p0[r] = __builtin_amdgcn_exp2f(p0[r] - mnew); p1[r] = __builtin_amdgcn_exp2f(p1[r] - mnew); rs += p0[r] + p1[r]; }
            l_run = l_run * alpha + rs;
#pragma unroll
            for (int r = 0; r < 16; ++r) { o0[r] *= alpha; o1[r] *= alpha; }
#pragma unroll
            for (int sub = 0; sub < 2; ++sub)
#pragma unroll
                for (int s = 0; s < 2; ++s) {
                    union { u32x4 u; bf16x8 v; } pb;
                    if (sub == 0) { pb.u.x = cvt_pk_bf16(p0[8 * s + 0], p0[8 * s + 1]); pb.u.y = cvt_pk_bf16(p0[8 * s + 2], p0[8 * s + 3]); pb.u.z = cvt_pk_bf16(p0[8 * s + 4], p0[8 * s + 5]); pb.u.w = cvt_pk_bf16(p0[8 * s + 6], p0[8 * s + 7]); }
                    else { pb.u.x = cvt_pk_bf16(p1[8 * s + 0], p1[8 * s + 1]); pb.u.y = cvt_pk_bf16(p1[8 * s + 2], p1[8 * s + 3]); pb.u.z = cvt_pk_bf16(p1[8 * s + 4], p1[8 * s + 5]); pb.u.w = cvt_pk_bf16(p1[8 * s + 6], p1[8 * s + 7]); }
#pragma unroll
                    for (int dt = 0; dt < 2; ++dt) {
                        LAS unsigned char* va = vb + (32 * sub + 16 * s) * 192 + dt * 64 + vlane;
                        const s16x4 lo = __builtin_bit_cast(s16x4, __builtin_amdgcn_ds_read_tr16_b64_v4i16((LAS s16x4*)va));
                        const s16x4 hh = __builtin_bit_cast(s16x4, __builtin_amdgcn_ds_read_tr16_b64_v4i16((LAS s16x4*)(va + 8 * 192)));
                        const bf16x8 vf = {lo[0], lo[1], lo[2], lo[3], hh[0], hh[1], hh[2], hh[3]};
                        if (dt == 0) o0 = MFMA32(vf, pb.v, o0); else o1 = MFMA32(vf, pb.v, o1);
                    }
                }
        }
        if (i + 1 < ntile) { const int nb = buf ^ 1;
            *(LAS u32x4*)(lds + LK + nb * KIMG + srow * 144 + sch * 16) = kreg; *(LAS u32x4*)(lds + LV + nb * VIMG + srow * 192 + sch * 16) = vreg; }
        __syncthreads();
    }
    l_run += __shfl_xor(l_run, 32);
    const float inv = 1.0f / l_run;
#pragma unroll
    for (int r4 = 0; r4 < 4; ++r4) {
        int w0 = __builtin_amdgcn_cvt_pk_fp8_f32(o0[4 * r4] * inv, o0[4 * r4 + 1] * inv, 0, false); w0 = __builtin_amdgcn_cvt_pk_fp8_f32(o0[4 * r4 + 2] * inv, o0[4 * r4 + 3] * inv, w0, true);
        int w1 = __builtin_amdgcn_cvt_pk_fp8_f32(o1[4 * r4] * inv, o1[4 * r4 + 1] * inv, 0, false); w1 = __builtin_amdgcn_cvt_pk_fp8_f32(o1[4 * r4 + 2] * inv, o1[4 * r4 + 3] * inv, w1, true);
        unsigned char* yrow = P.ws + OFF_EG + (rowb + q0 + wid * 32 + r32) * 1024 + h * 64;
        *(int*)(yrow + 8 * r4 + 4 * hi) = w0; *(int*)(yrow + 32 + 8 * r4 + 4 * hi) = w1;
    }
}

__device__ void yb_norm_panel(const Params& P, int pm) {
    const int tid = tid_opaque(), lane = tid & 63, wid = tid >> 6;
    bf16_t* HI = (bf16_t*)(P.ws + OFF_HI); const bf16_t* HG = (const bf16_t*)(P.ws + OFF_HG);
    for (int r = 0; r < 32; ++r) {
        const size_t off = ((size_t)pm * 256 + wid * 32 + r) * 512 + lane * 8;
        const u32x4 ov = *(const u32x4*)(HI + off), gv = *(const u32x4*)(HG + off);
        float o[8] = {bf_lo(ov.x), bf_hi(ov.x), bf_lo(ov.y), bf_hi(ov.y), bf_lo(ov.z), bf_hi(ov.z), bf_lo(ov.w), bf_hi(ov.w)};
        const float g[8] = {bf_lo(gv.x), bf_hi(gv.x), bf_lo(gv.y), bf_hi(gv.y), bf_lo(gv.z), bf_hi(gv.z), bf_lo(gv.w), bf_hi(gv.w)};
        float ss = 0.f;
#pragma unroll
        for (int e = 0; e < 8; ++e) ss += o[e] * o[e];
        ss += __shfl_xor(ss, 1); ss += __shfl_xor(ss, 2); ss += __shfl_xor(ss, 4); ss += __shfl_xor(ss, 8);
        const float rs = rsqrtf(ss * (1.0f / 128.0f) + RMS_EPS);
        int w0 = __builtin_amdgcn_cvt_pk_fp8_f32(o[0] * rs * g[0], o[1] * rs * g[1], 0, false); w0 = __builtin_amdgcn_cvt_pk_fp8_f32(o[2] * rs * g[2], o[3] * rs * g[3], w0, true);
        int w1 = __builtin_amdgcn_cvt_pk_fp8_f32(o[4] * rs * g[4], o[5] * rs * g[5], 0, false); w1 = __builtin_amdgcn_cvt_pk_fp8_f32(o[6] * rs * g[6], o[7] * rs * g[7], w1, true);
        *(u32x2*)(P.ws + OFF_EG + ((size_t)pm * 256 + wid * 32 + r) * 1024 + 512 + lane * 8) = (u32x2){(unsigned)w0, (unsigned)w1};
    }
}
__device__ void ln1_panel(const Params& P, int pm) {
    const int tid = tid_opaque(), lane = tid & 63, wid = tid >> 6;
    const float* ada = (const float*)(P.ws + OFF_ADA) + (size_t)(pm >> 3) * 6144; bf16_t* H = (bf16_t*)(P.ws + OFF_H);
    for (int r = 0; r < 32; ++r) {
        const size_t row = (size_t)pm * 256 + wid * 32 + r;
        float* xr = P.out + row * 1024 + lane * 4; const float* xin = P.x + row * 1024 + lane * 4; const bf16_t* dl = (const bf16_t*)(P.ws + OFF_GB) + row * 1024 + lane * 4;
        f32x4 v[4]; float s = 0.f;
#pragma unroll
        for (int jx = 0; jx < 4; ++jx) { const u32x2 dv = *(const u32x2*)(dl + 256 * jx); const f32x4 xv = __builtin_nontemporal_load((const f32x4*)(xin + 256 * jx));
            v[jx] = xv * ALPHA + (f32x4){bf_lo(dv.x), bf_hi(dv.x), bf_lo(dv.y), bf_hi(dv.y)}; s += (v[jx][0] + v[jx][1]) + (v[jx][2] + v[jx][3]); }
        const float mean = wave_sum(s) * (1.0f / 1024.0f); float s2 = 0.f;
#pragma unroll
        for (int jx = 0; jx < 4; ++jx) { v[jx] = v[jx] - mean; s2 += (v[jx][0] * v[jx][0] + v[jx][1] * v[jx][1]) + (v[jx][2] * v[jx][2] + v[jx][3] * v[jx][3]); }
        const float rstd = rsqrtf(wave_sum(s2) * (1.0f / 1024.0f) + LN_EPS);
#pragma unroll
        for (int jx = 0; jx < 4; ++jx) {
            const int c = lane * 4 + 256 * jx;
            const f32x4 g = *(const f32x4*)(P.ln1_g + c), bb = *(const f32x4*)(P.ln1_b + c), sh = *(const f32x4*)(ada + 3072 + c), sc = *(const f32x4*)(ada + 4096 + c);
            const f32x4 x1 = v[jx] * rstd * g + bb;
            *(f32x4*)(xr + 256 * jx) = x1;
            const f32x4 h2 = x1 * (sc + 1.0f) + sh;
            u32x2 w; w.x = cvt_pk_bf16(h2[0], h2[1]); w.y = cvt_pk_bf16(h2[2], h2[3]);
            *(u32x2*)(H + row * 1024 + c) = w;
            v[jx] = h2;
        }
        {
            float mx = 0.f;
#pragma unroll
            for (int jx = 0; jx < 4; ++jx) mx = fmaxf(mx, fmaxf(fmaxf(fabsf(v[jx][0]), fabsf(v[jx][1])), fmaxf(fabsf(v[jx][2]), fabsf(v[jx][3]))));
#pragma unroll
            for (int o = 1; o < 64; o <<= 1) mx = fmaxf(mx, __shfl_xor(mx, o));
            const float hs = fmaxf(mx * (1.0f / 127.0f), 1e-30f), inv = 1.0f / hs; int qs = 0;
#pragma unroll
            for (int jx = 0; jx < 4; ++jx) {
                const int q0 = (int)rintf(v[jx][0] * inv), q1 = (int)rintf(v[jx][1] * inv), q2 = (int)rintf(v[jx][2] * inv), q3 = (int)rintf(v[jx][3] * inv);
                qs += (q0 + q1) + (q2 + q3);
                *(unsigned*)(P.ws + OFF_H8 + row * 1024 + lane * 4 + 256 * jx) = (unsigned)(q0 & 255) | ((unsigned)(q1 & 255) << 8) | ((unsigned)(q2 & 255) << 16) | ((unsigned)(q3 & 255) << 24);
            }
#pragma unroll
            for (int o = 1; o < 64; o <<= 1) qs += __shfl_xor(qs, o);
            if (lane == 0) *(f32x2*)(P.ws + OFF_HS + row * 8) = (f32x2){hs, (float)qs};
        }
    }
}

#define CE16(A, i, j) do { const float hi_ = fmaxf(A[i], A[j]); A[j] = fminf(A[i], A[j]); A[i] = hi_; } while (0)
#define SORT16(A) do { CE16(A, 0, 1); CE16(A, 2, 3); CE16(A, 0, 2); CE16(A, 1, 3); CE16(A, 1, 2); CE16(A, 4, 5); CE16(A, 6, 7); CE16(A, 4, 6); CE16(A, 5, 7); CE16(A, 5, 6); CE16(A, 0, 4); CE16(A, 2, 6); CE16(A, 2, 4); CE16(A, 1, 5); CE16(A, 3, 7); CE16(A, 3, 5); CE16(A, 1, 2); CE16(A, 3, 4); CE16(A, 5, 6); CE16(A, 8, 9); CE16(A, 10, 11); CE16(A, 8, 10); CE16(A, 9, 11); CE16(A, 9, 10); CE16(A, 12, 13); CE16(A, 14, 15); CE16(A, 12, 14); CE16(A, 13, 15); CE16(A, 13, 14); CE16(A, 8, 12); CE16(A, 10, 14); CE16(A, 10, 12); CE16(A, 9, 13); CE16(A, 11, 15); CE16(A, 11, 13); CE16(A, 9, 10); CE16(A, 11, 12); CE16(A, 13, 14); CE16(A, 0, 8); CE16(A, 4, 12); CE16(A, 4, 8); CE16(A, 2, 10); CE16(A, 6, 14); CE16(A, 6, 10); CE16(A, 2, 4); CE16(A, 6, 8); CE16(A, 10, 12); CE16(A, 1, 9); CE16(A, 5, 13); CE16(A, 5, 9); CE16(A, 3, 11); CE16(A, 7, 15); CE16(A, 7, 11); CE16(A, 3, 5); CE16(A, 7, 9); CE16(A, 11, 13); CE16(A, 1, 2); CE16(A, 3, 4); CE16(A, 5, 6); CE16(A, 7, 8); CE16(A, 9, 10); CE16(A, 11, 12); CE16(A, 13, 14); } while (0)
#define BITONIC16(A) do { CE16(A, 0, 8); CE16(A, 1, 9); CE16(A, 2, 10); CE16(A, 3, 11); CE16(A, 4, 12); CE16(A, 5, 13); CE16(A, 6, 14); CE16(A, 7, 15); CE16(A, 0, 4); CE16(A, 1, 5); CE16(A, 2, 6); CE16(A, 3, 7); CE16(A, 8, 12); CE16(A, 9, 13); CE16(A, 10, 14); CE16(A, 11, 15); CE16(A, 0, 2); CE16(A, 1, 3); CE16(A, 4, 6); CE16(A, 5, 7); CE16(A, 8, 10); CE16(A, 9, 11); CE16(A, 12, 14); CE16(A, 13, 15); CE16(A, 0, 1); CE16(A, 2, 3); CE16(A, 4, 5); CE16(A, 6, 7); CE16(A, 8, 9); CE16(A, 10, 11); CE16(A, 12, 13); CE16(A, 14, 15); } while (0)
#define INS16(L, xin) do { float x_ = (xin); _Pragma("unroll") for (int k_ = 0; k_ < 16; ++k_) { const float hi_ = fmaxf(L[k_], x_); x_ = fminf(L[k_], x_); L[k_] = hi_; } } while (0)

__device__ void peer_select_wave(const Params& P, size_t tok0) {
    const int lane = tid_opaque() & 63, r32 = lane & 31, hi = lane >> 5;
    const bf16_t* QP = (const bf16_t*)(P.ws + OFF_GB) + (tok0 + r32) * 1024; const bf16_t* SK = (const bf16_t*)(P.ws + OFF_SK);
    u32x2* EG = (u32x2*)(P.ws + OFF_EG) + (tok0 + r32) * 128;
#pragma unroll 1
    for (int h = 0; h < 8; ++h) {
        float a0[16], a1[16];
#pragma unroll
        for (int k = 0; k < 16; ++k) { a0[k] = -INFINITY; a1[k] = -INFINITY; }
#pragma unroll 1
        for (int p = 0; p < 2; ++p) {
            const int hp = h * 2 + p;
            bf16x8 qf[4];
#pragma unroll
            for (int ks = 0; ks < 4; ++ks) qf[ks] = *(const bf16x8*)(QP + hp * 64 + 16 * ks + 8 * hi);
            float L[16];
#pragma unroll
            for (int kt = 0; kt < 4; ++kt) {
                f32x16 acc = {};
#pragma unroll
                for (int ks = 0; ks < 4; ++ks) { const bf16x8 kf = *(const bf16x8*)(SK + ((size_t)hp * 128 + 32 * kt + r32) * 64 + 16 * ks + 8 * hi); acc = MFMA32(kf, qf[ks], acc); }
                float S[16];
#pragma unroll
                for (int r = 0; r < 16; ++r) { const unsigned key = (unsigned)(32 * kt + crow(r, hi)); S[r] = __uint_as_float((__float_as_uint(acc[r]) & ~127u) | key); }
                SORT16(S);
                if (kt == 0) {
#pragma unroll
                    for (int k = 0; k < 16; ++k) L[k] = S[k];
                } else {
#pragma unroll
                    for (int k = 0; k < 16; ++k) L[k] = fmaxf(L[k], S[15 - k]);
                    BITONIC16(L);
                }
            }
            {
                float O[16];
#pragma unroll
                for (int k = 0; k < 16; ++k) O[k] = __shfl_xor(L[15 - k], 32);
#pragma unroll
                for (int k = 0; k < 16; ++k) L[k] = fmaxf(L[k], O[k]);
                BITONIC16(L);
            }
#pragma unroll
            for (int k = 0; k < 16; ++k) { a0[k] = (p == 0) ? L[k] : a0[k]; a1[k] = (p == 1) ? L[k] : a1[k]; }
        }
        float best[16];
#pragma unroll
        for (int k = 0; k < 16; ++k) best[k] = __uint_as_float((__float_as_uint(a0[0] + a1[k]) & ~255u) | (unsigned)k);
#pragma unroll
        for (int i = 1; i < 16; ++i)
#pragma unroll
            for (int jx = 0; jx < 16; ++jx)
                if ((i + 1) * (jx + 1) <= 16) {
                    const float cs = a0[i] + a1[jx];
                    const float cv = __uint_as_float((__float_as_uint(cs) & ~255u) | (unsigned)(i * 16 + jx));
                    INS16(best, cv);
                }
        unsigned pk0[4], pk1[4];
#pragma unroll
        for (int q = 0; q < 4; ++q) {
            pk0[q] = (__float_as_uint(a0[4 * q]) & 127u) | ((__float_as_uint(a0[4 * q + 1]) & 127u) << 8) | ((__float_as_uint(a0[4 * q + 2]) & 127u) << 16) | ((__float_as_uint(a0[4 * q + 3]) & 127u) << 24);
            pk1[q] = (__float_as_uint(a1[4 * q]) & 127u) | ((__float_as_uint(a1[4 * q + 1]) & 127u) << 8) | ((__float_as_uint(a1[4 * q + 2]) & 127u) << 16) | ((__float_as_uint(a1[4 * q + 3]) & 127u) << 24);
        }
        unsigned pay[16];
#pragma unroll
        for (int k = 0; k < 16; ++k) {
            const unsigned code = __float_as_uint(best[k]) & 255u, ci = code >> 4, cj = code & 15u;
            const unsigned qi = ci >> 2, qj = cj >> 2;
            const unsigned w0 = (qi == 0u) ? pk0[0] : ((qi == 1u) ? pk0[1] : ((qi == 2u) ? pk0[2] : pk0[3]));
            const unsigned w1 = (qj == 0u) ? pk1[0] : ((qj == 1u) ? pk1[1] : ((qj == 2u) ? pk1[2] : pk1[3]));
            pay[k] = (((w0 >> ((ci & 3u) * 8u)) & 127u) << 7) | ((w1 >> ((cj & 3u) * 8u)) & 127u);
        }
        float e[16], es = 0.f;
#pragma unroll
        for (int k = 0; k < 16; ++k) { e[k] = __expf(best[k] - best[0]); es += e[k]; }
        const float inv = 1.0f / es;
        if (hi == 0) {
#pragma unroll
            for (int k = 0; k < 16; ++k) { u32x2 w; w.x = pay[k]; w.y = __float_as_uint(e[k] * inv); EG[h * 16 + k] = w; }
        }
    }
}
__device__ __forceinline__ unsigned xcc_id() { return (unsigned)__builtin_amdgcn_s_getreg((3 << 11) | 20) & 0xFu; }
template <int CTRL> __device__ __forceinline__ float dpp_add(float x) { const int v = __builtin_amdgcn_update_dpp(0, __float_as_int(x), CTRL, 0xf, 0xf, true); return x + __int_as_float(v); }
__device__ __forceinline__ float wave_sum_fast(float x) {
    x = dpp_add<0xB1>(x); x = dpp_add<0x4E>(x); x = dpp_add<0x141>(x); x = dpp_add<0x140>(x);
    x += __shfl_xor(x, 16); x += __shfl_xor(x, 32); return x;
}
__device__ __forceinline__ float dot16_fp8(const float (&hv)[16], const u32x4 r) {
    float s = 0.f;
    { const f32x2 a = __builtin_amdgcn_cvt_pk_f32_fp8((int)r.x, false), b = __builtin_amdgcn_cvt_pk_f32_fp8((int)r.x, true); s += hv[0] * a.x + hv[1] * a.y + hv[2] * b.x + hv[3] * b.y; }
    { const f32x2 a = __builtin_amdgcn_cvt_pk_f32_fp8((int)r.y, false), b = __builtin_amdgcn_cvt_pk_f32_fp8((int)r.y, true); s += hv[4] * a.x + hv[5] * a.y + hv[6] * b.x + hv[7] * b.y; }
    { const f32x2 a = __builtin_amdgcn_cvt_pk_f32_fp8((int)r.z, false), b = __builtin_amdgcn_cvt_pk_f32_fp8((int)r.z, true); s += hv[8] * a.x + hv[9] * a.y + hv[10] * b.x + hv[11] * b.y; }
    { const f32x2 a = __builtin_amdgcn_cvt_pk_f32_fp8((int)r.w, false), b = __builtin_amdgcn_cvt_pk_f32_fp8((int)r.w, true); s += hv[12] * a.x + hv[13] * a.y + hv[14] * b.x + hv[15] * b.y; }
    return s;
}
template <int NP, class F> __device__ __forceinline__ void partition_queue(const Params& P, LAS unsigned char* lds, int ctr_base, F f) {
    const int tid = tid_opaque();
    LAS int* slot = (LAS int*)(lds + LDS_BYTES - 64);
    unsigned* ctr = (unsigned*)(P.ws + OFF_CTR) + ctr_base;
    const int myx = (int)(xcc_id() & 7u);
    for (int pp = 0; pp < NP; ++pp) {
        const int p = (myx * (NP / 8) + pp) % NP;
        for (;;) {
            if (tid == 0) *slot = (int)atomicAdd(ctr + p, 1u);
            __syncthreads();
            const int item = *slot;
            __syncthreads();
            if (item >= NTOK / 64) break;
            f(p, item);
        }
    }
}
__device__ __forceinline__ float dot2bf(unsigned a, bf16v2 b, float c) { return __builtin_amdgcn_fdot2_f32_bf16(__builtin_bit_cast(bf16v2, a), b, c, false); }
struct UQuad { u32x4 r[2]; u32x4 ent; };
__device__ __forceinline__ void uq_issue(UQuad& q, const LAS u32x4* list, int J, int NQ, int g, const unsigned char* U4) {
    const int jj = J < NQ ? J : NQ - 1;
    q.ent = list[4 * jj + g];
    const unsigned char* rp = U4 + (size_t)q.ent.x * 512;
    q.r[0] = *(const u32x4*)rp; q.r[1] = *(const u32x4*)(rp + 256);
}
__device__ __forceinline__ int dot8_i4(unsigned w, unsigned hlo, unsigned hhi, int acc) {
    acc = __builtin_amdgcn_sdot4((int)hlo, (int)(w & 0x0F0F0F0Fu), acc, false);
    return __builtin_amdgcn_sdot4((int)hhi, (int)((w >> 4) & 0x0F0F0F0Fu), acc, false);
}
__device__ __forceinline__ float uq_dot(const UQuad& q, const u32x4 (&hp)[4]) {
    int a = 0, b = 0;
#pragma unroll
    for (int c = 0; c < 2; ++c) {
        const u32x4 r = q.r[c];
        a = dot8_i4(r.x, hp[2 * c].x, hp[2 * c].y, a); b = dot8_i4(r.y, hp[2 * c].z, hp[2 * c].w, b);
        a = dot8_i4(r.z, hp[2 * c + 1].x, hp[2 * c + 1].y, a); b = dot8_i4(r.w, hp[2 * c + 1].z, hp[2 * c + 1].w, b);
    }
    float s = (float)(a + b);
    s = dpp_add<0xB1>(s); s = dpp_add<0x4E>(s); s = dpp_add<0x141>(s); s = dpp_add<0x140>(s);
    return s;
}
__device__ __forceinline__ void peer_u_tokens(const Params& P, LAS unsigned char* lds, const size_t t0) {
    const int tid = tid_opaque(), lane = tid & 63, wid = tid >> 6, g = lane >> 4, li = lane & 15;
    const unsigned char* H8 = P.ws + OFF_H8 + li * 32; const unsigned char* U4 = P.ws + OFF_U8 + li * 16;
    const f32x2* HS = (const f32x2*)(P.ws + OFF_HS); const float* USC = (const float*)(P.ws + OFF_USC);
    const u32x4* EG4 = (const u32x4*)(P.ws + OFF_EG); float* W = (float*)(P.ws + OFF_W);
    LAS u32x4* list = (LAS u32x4*)(lds + wid * 16384);
#pragma unroll 2
    for (int i = 0; i < 8; ++i) {
        const u32x4 eg = EG4[(t0 + i) * 64 + lane];
        list[i * 128 + 2 * lane] = (u32x4){eg.x, eg.y, (unsigned)(2 * lane) | (unsigned)(i << 8), __float_as_uint(USC[eg.x])};
        list[i * 128 + 2 * lane + 1] = (u32x4){eg.z, eg.w, (unsigned)(2 * lane + 1) | (unsigned)(i << 8), __float_as_uint(USC[eg.z])};
    }
    constexpr int NQ = 256;
    u32x4 hp[4], hn[4]; f32x2 hsc = HS[t0], hsn = HS[t0 + 1];
#pragma unroll
    for (int c = 0; c < 2; ++c) { hp[2 * c] = *(const u32x4*)(H8 + t0 * 1024 + 512 * c); hp[2 * c + 1] = *(const u32x4*)(H8 + t0 * 1024 + 512 * c + 16);
                                  hn[2 * c] = *(const u32x4*)(H8 + (t0 + 1) * 1024 + 512 * c); hn[2 * c + 1] = *(const u32x4*)(H8 + (t0 + 1) * 1024 + 512 * c + 16); }
    int curtok = 0;
    UQuad q0, q1, q2, q3;
    uq_issue(q0, list, 0, NQ, g, U4); uq_issue(q1, list, 1, NQ, g, U4); uq_issue(q2, list, 2, NQ, g, U4); uq_issue(q3, list, 3, NQ, g, U4);
#define UQ_STEP(q, Jn) do { \
        const int tk = __builtin_amdgcn_readfirstlane((int)(q.ent.z >> 8)); \
        if (tk != curtok) { curtok = tk; _Pragma("unroll") for (int c = 0; c < 4; ++c) hp[c] = hn[c]; hsc = hsn; \
            if (tk + 1 < 8) { hsn = HS[t0 + tk + 1]; _Pragma("unroll") for (int c = 0; c < 2; ++c) { hn[2 * c] = *(const u32x4*)(H8 + (t0 + tk + 1) * 1024 + 512 * c); hn[2 * c + 1] = *(const u32x4*)(H8 + (t0 + tk + 1) * 1024 + 512 * c + 16); } } } \
        const float s = __uint_as_float(q.ent.w) * hsc.x * (uq_dot(q, hp) - 7.5f * hsc.y); \
        if (li == 0) W[(t0 + tk) * 128 + (q.ent.z & 255u)] = __uint_as_float(q.ent.y) * 0.5f * s * (1.0f + erff(s * 0.70710678118654752f)); \
        uq_issue(q, list, (Jn), NQ, g, U4); } while (0)
#pragma unroll 1
    for (int J = 0; J < NQ; J += 4) { UQ_STEP(q0, J + 4); UQ_STEP(q1, J + 5); UQ_STEP(q2, J + 6); UQ_STEP(q3, J + 7); }
#undef UQ_STEP
}
typedef int v4i_t __attribute__((ext_vector_type(4)));
struct VQuad { u32x4 r[2]; u32x2 ent; };
__device__ __forceinline__ void vq_issue(VQuad& q, const LAS u32x2* list, int J, int g, const unsigned char* V4) {
    const int jj = J < 32 ? J : 31;
    q.ent = list[4 * jj + g];
    const unsigned char* rp = V4 + (size_t)q.ent.x * 512;
    q.r[0] = *(const u32x4*)rp; q.r[1] = *(const u32x4*)(rp + 256);
}
__device__ __forceinline__ void vq_mma(const VQuad& q, v4i_t (&acc)[4], const unsigned sh, const u32x4 bm, const bool live) {
    const unsigned t = live ? ((q.ent.y & 255u) << sh) : 0u;
    const v4i_t B = {(int)(t & bm.x), (int)(t & bm.y), (int)(t & bm.z), (int)(t & bm.w)};
#pragma unroll
    for (int c = 0; c < 2; ++c) {
        const u32x4 r = q.r[c];
        const v4i_t lo = {(int)(r.x & 0x0F0F0F0Fu), (int)(r.y & 0x0F0F0F0Fu), (int)(r.z & 0x0F0F0F0Fu), (int)(r.w & 0x0F0F0F0Fu)};
        const v4i_t hi = {(int)((r.x >> 4) & 0x0F0F0F0Fu), (int)((r.y >> 4) & 0x0F0F0F0Fu), (int)((r.z >> 4) & 0x0F0F0F0Fu), (int)((r.w >> 4) & 0x0F0F0F0Fu)};
        acc[2 * c] = __builtin_amdgcn_mfma_i32_16x16x64_i8(lo, B, acc[2 * c], 0, 0, 0);
        acc[2 * c + 1] = __builtin_amdgcn_mfma_i32_16x16x64_i8(hi, B, acc[2 * c + 1], 0, 0, 0);
    }
}
__device__ __forceinline__ void peer_v_tokens(const Params& P, LAS unsigned char* lds, const size_t t0) {
    const int tid = tid_opaque(), lane = tid & 63, wid = tid >> 6, g = lane >> 4, li = lane & 15;
    const unsigned char* V4 = P.ws + OFF_V8 + li * 16; const float* VSC = (const float*)(P.ws + OFF_VSC);
    const u32x4* EG4 = (const u32x4*)(P.ws + OFF_EG); const f32x2* W2 = (const f32x2*)(P.ws + OFF_W);
    LAS u32x2* lists = (LAS u32x2*)(lds + wid * 8192);
    float swv[8], yoffv[8];
#pragma unroll
    for (int i = 0; i < 8; ++i) { const u32x4 eg = EG4[(t0 + i) * 64 + lane]; const f32x2 ww = W2[(t0 + i) * 64 + lane];
        const float w0 = ww.x * VSC[eg.x], w1 = ww.y * VSC[eg.z];
        float mx = fmaxf(fabsf(w0), fabsf(w1));
#pragma unroll
        for (int o = 1; o < 64; o <<= 1) mx = fmaxf(mx, __shfl_xor(mx, o));
        const float sw = fmaxf(mx * (1.0f / 127.0f), 1e-30f), inv = 1.0f / sw;
        const int q0 = (int)rintf(w0 * inv), q1 = (int)rintf(w1 * inv);
        *(LAS u32x4*)(lists + i * 128 + 2 * lane) = (u32x4){eg.x, (unsigned)q0, eg.z, (unsigned)q1};
        int qs = q0 + q1;
#pragma unroll
        for (int o = 1; o < 64; o <<= 1) qs += __shfl_xor(qs, o);
        swv[i] = sw; yoffv[i] = 7.5f * sw * (float)qs; }
    const unsigned sh = 8u * (unsigned)(li & 3);
    const u32x4 bm = {(li >> 2) == 0 ? 0xFFFFFFFFu : 0u, (li >> 2) == 1 ? 0xFFFFFFFFu : 0u, (li >> 2) == 2 ? 0xFFFFFFFFu : 0u, (li >> 2) == 3 ? 0xFFFFFFFFu : 0u};
#pragma unroll
    for (int i = 0; i < 8; ++i) {
        const size_t t = t0 + i;
        const LAS u32x2* list = lists + i * 128;
        v4i_t acc[4];
#pragma unroll
        for (int j = 0; j < 4; ++j) acc[j] = (v4i_t){0, 0, 0, 0};
        VQuad q0, q1, q2, q3;
        vq_issue(q0, list, 0, g, V4); vq_issue(q1, list, 1, g, V4); vq_issue(q2, list, 2, g, V4); vq_issue(q3, list, 3, g, V4);
#pragma unroll 1
        for (int J = 0; J < 32; J += 4) {
            vq_mma(q0, acc, sh, bm, true); vq_issue(q0, list, J + 4, g, V4);
            vq_mma(q1, acc, sh, bm, true); vq_issue(q1, list, J + 5, g, V4);
            vq_mma(q2, acc, sh, bm, true); vq_issue(q2, list, J + 6, g, V4);
            vq_mma(q3, acc, sh, bm, true); vq_issue(q3, list, J + 7, g, V4);
        }
        const float sw = swv[i], yoff = yoffv[i];
        const int dbase = 128 * g + 8 * (li >> 2) + (li & 3);
        const float* gt2 = (const float*)(P.ws + OFF_ADA) + (t >> 11) * 6144 + 5120;
        float* xr = P.out + t * 1024;
        float pre[16]; float s = 0.f;
#pragma unroll
        for (int c = 0; c < 2; ++c)
#pragma unroll
            for (int hf = 0; hf < 2; ++hf)
#pragma unroll
                for (int r = 0; r < 4; ++r) { const int d = dbase + 512 * c + 32 * r + 4 * hf;
                    const float yv = sw * (float)acc[2 * c + hf][r] - yoff;
                    const float pv = ALPHA * xr[d] + gt2[d] * yv; pre[8 * c + 4 * hf + r] = pv; s += pv; }
        const float mean = wave_sum(s) * (1.0f / 1024.0f); float s2 = 0.f;
#pragma unroll
        for (int e = 0; e < 16; ++e) { pre[e] -= mean; s2 += pre[e] * pre[e]; }
        const float rstd = rsqrtf(wave_sum(s2) * (1.0f / 1024.0f) + LN_EPS);
#pragma unroll
        for (int c = 0; c < 2; ++c)
#pragma unroll
            for (int hf = 0; hf < 2; ++hf)
#pragma unroll
                for (int r = 0; r < 4; ++r) { const int d = dbase + 512 * c + 32 * r + 4 * hf;
                    xr[d] = pre[8 * c + 4 * hf + r] * rstd * P.ln2_g[d] + P.ln2_b[d]; }
    }
}

#define XB_TMO      128
#define XB_XCNT(j)  (256  + 64 * (j))
#define XB_XSUB(j)  (1280 + 64 * (j))
#define XB_XGEN(j)  (2304 + 64 * (j))
#define XB_TOP      3328
#define XB_TOPGEN   3392
#define XCD_BAR_WORDS 3456
#define XB_SPIN_CAP (1u << 22)
__device__ __forceinline__ unsigned xb_ld(unsigned* p)              { return __hip_atomic_load(p, __ATOMIC_RELAXED, __HIP_MEMORY_SCOPE_AGENT); }
__device__ __forceinline__ unsigned xb_add(unsigned* p, unsigned v) { return __hip_atomic_fetch_add(p, v, __ATOMIC_RELAXED, __HIP_MEMORY_SCOPE_AGENT); }
#define XB_SPIN(cond, bar) do { unsigned _sp = 0; while (cond) { __builtin_amdgcn_s_sleep(1); \
    if ((++_sp & 255u) == 0u) { if (xb_ld(&(bar)[XB_TMO])) break; if (_sp > XB_SPIN_CAP) { atomicAdd(&(bar)[XB_TMO], 1u); break; } } } } while (0)
struct XcdBarrier { unsigned* bar; unsigned x; volatile LAS unsigned* st; };
__device__ __forceinline__ XcdBarrier xcd_barrier_post(unsigned* bar, volatile LAS unsigned* st) {
    XcdBarrier b; b.bar = bar; b.x = xcc_id(); b.st = st;
    if (threadIdx.x == 0) (void)xb_add(&bar[XB_XCNT(b.x)], 1u);
    return b;
}
__device__ __forceinline__ void xcd_barrier_complete(unsigned* bar, unsigned x, unsigned& nloc, unsigned& nx) {
    const unsigned G = gridDim.x * gridDim.y * gridDim.z;
    unsigned sum, cnt, mine, sp = 0u;
    for (;;) {
        sum = 0u; cnt = 0u; mine = 0u;
#pragma unroll
        for (unsigned j = 0; j < 16; ++j) { const unsigned c = xb_ld(&bar[XB_XCNT(j)]); sum += c; cnt += (c > 0u) ? 1u : 0u; mine = (j == x) ? c : mine; }
        if (sum == G) break;
        __builtin_amdgcn_s_sleep(1);
        if ((++sp & 255u) == 0u) { if (xb_ld(&bar[XB_TMO])) break; if (sp > XB_SPIN_CAP) { atomicAdd(&bar[XB_TMO], 1u); break; } }
    }
    nloc = mine > 0u ? mine : 1u; nx = cnt > 0u ? cnt : 1u;
}
__device__ __forceinline__ void xcd_barrier(const XcdBarrier& b) {
    asm volatile("s_waitcnt vmcnt(0)" ::: "memory");
    __syncthreads();
    if (threadIdx.x == 0) {
        unsigned* bar = b.bar;
        __builtin_amdgcn_s_waitcnt(0);
        unsigned nloc = b.st[0], nx = b.st[1];
        if (nloc == 0u) { xcd_barrier_complete(bar, b.x, nloc, nx); b.st[0] = nloc; b.st[1] = nx; }
        const unsigned old = xb_add(&bar[XB_XSUB(b.x)], 1u);
        const unsigned gen = old / nloc;
        if (old + 1u == (gen + 1u) * nloc) {
            __builtin_amdgcn_fence(__ATOMIC_RELEASE, "agent");
            asm volatile("s_waitcnt vmcnt(0)" ::: "memory");
            const unsigned og = xb_add(&bar[XB_TOP], 1u);
            const unsigned tg = og / nx;
            if (og + 1u == (tg + 1u) * nx) xb_add(&bar[XB_TOPGEN], 1u);
            else XB_SPIN(xb_ld(&bar[XB_TOPGEN]) == tg, bar);
            __builtin_amdgcn_fence(__ATOMIC_ACQUIRE, "agent");
            xb_add(&bar[XB_XGEN(b.x)], 1u);
            asm volatile("s_waitcnt vmcnt(0)" ::: "memory");
        } else {
            XB_SPIN(xb_ld(&bar[XB_XGEN(b.x)]) == gen, bar);
            __builtin_amdgcn_fence(__ATOMIC_ACQUIRE, "agent");
            asm volatile("s_waitcnt vmcnt(0)" ::: "memory");
        }
    }
    __syncthreads();
}

__global__ void __launch_bounds__(NTHR, 2) fwd_megakernel(Params P) {
    extern __shared__ __attribute__((aligned(16))) unsigned char shm[];
    LAS unsigned char* lds = (LAS unsigned char*)shm;
    cg::grid_group grid = cg::this_grid();
    const int G = gridDim.x, bid = blockIdx.x;
    volatile LAS unsigned* xst = (volatile LAS unsigned*)(lds + LDS_BYTES - 128);
    if (threadIdx.x == 0) { xst[0] = 0u; xst[1] = 0u; }
    __syncthreads();
    const XcdBarrier xb = xcd_barrier_post((unsigned*)(P.ws + OFF_BAR), xst);

#ifndef P3
#define P3 0xff
#endif
#ifndef PH
#define PH 0xff
#endif
    if (PH & 1) phase0a(P, lds);
    grid.sync();
    if (PH & 2) phase0b(P);
    xcd_barrier(xb);
    if (PH & 4) {
        pg8::Gemm g; g.A = (const bf16_t*)(P.ws + OFF_H); g.Bt = (const bf16_t*)(P.ws + OFF_WIN); g.M = NTOK; g.N = INCOLS; { int k_ = 512; asm volatile("" : "+s"(k_)); g.K = k_; g.lda = k_; }
        pg8::StaticOrder S; S.init(NTOK, INCOLS, G, bid);
        EpiProj E; E.ws = P.ws; E.lb = (const float*)(P.ws + OFF_LB); E.ng = P.hgrn_ng; E.kmean = (float*)(P.ws + OFF_KMEAN);
        pg8::gemm_phase<EpiProj, pg8::StaticOrder, true>(lds, g, S, E);
    }
    xcd_barrier(xb);
    if (PH & 8) for (int it = bid; it < 256; it += G) hgrn_item(P, it, lds);
    if (PH & 16) for (int u = bid; u < 2048; u += G) { const int bh = u & 255, jj = u >> 8; moba_unit(P, bh >> 3, bh & 7, (jj + bh) & 7, lds); }
    xcd_barrier(xb);
    if ((PH & 32) && bid < NTOK / 256) { const int pm = bid;
        if (P3 & 1) yb_norm_panel(P, pm);
        __syncthreads();
        if (P3 & 2) { pg8::Gemm g; g.A = (const bf16_t*)(P.ws + OFF_EG); g.Bt = (const bf16_t*)(P.ws + OFF_WBA); g.M = NTOK; g.N = 1024; { int k_ = 256; asm volatile("" : "+s"(k_)); g.K = k_; } g.lda = 512;
          pg8::PanelOrder S; S.pm = pm; S.npn = 4; EpiMixA E; E.GA = (bf16_t*)(P.ws + OFF_GA);
          pg8::gemm_phase<EpiMixA, pg8::PanelOrder, true>(lds, g, S, E); }
        __syncthreads();
        if (P3 & 4) { pg8::Gemm g; g.A = (const bf16_t*)(P.ws + OFF_EG + 512); g.Bt = (const bf16_t*)(P.ws + OFF_WBB); g.M = NTOK; g.N = 1024; { int k_ = 256; asm volatile("" : "+s"(k_)); g.K = k_; } g.lda = 512;
          pg8::PanelOrder S; S.pm = pm; S.npn = 4; EpiMixB E; E.GA = (const bf16_t*)(P.ws + OFF_GA); E.GB = (const bf16_t*)(P.ws + OFF_GB); E.M8 = P.ws + OFF_QA;
          pg8::gemm_phase<EpiMixB, pg8::PanelOrder, true>(lds, g, S, E); }
        __syncthreads();
        if (P3 & 8) { pg8::Gemm g; g.A = (const bf16_t*)(P.ws + OFF_QA); g.Bt = (const bf16_t*)(P.ws + OFF_WOUT); g.M = NTOK; g.N = 1024; { int k_ = 512; asm volatile("" : "+s"(k_)); g.K = k_; g.lda = k_; }
          pg8::PanelOrder S; S.pm = pm; S.npn = 4; EpiOut E; E.ada = (const float*)(P.ws + OFF_ADA); E.D = (bf16_t*)(P.ws + OFF_GB);
          pg8::gemm_phase<EpiOut, pg8::PanelOrder, true>(lds, g, S, E); }
        __syncthreads();
        if (P3 & 16) ln1_panel(P, pm);
        __syncthreads();
        if (P3 & 32) { pg8::Gemm g; g.A = (const bf16_t*)(P.ws + OFF_H); g.Bt = (const bf16_t*)(P.ws + OFF_WQ); g.M = NTOK; g.N = 1024; g.K = 1024; g.lda = 1024;
          pg8::PanelOrder S; S.pm = pm; S.npn = 4; EpiBf16 E; E.O = (bf16_t*)(P.ws + OFF_GB);
          pg8::gemm_phase<EpiBf16, pg8::PanelOrder>(lds, g, S, E); }
        __syncthreads();
        { const size_t tok0 = (size_t)pm * 256 + (tid_opaque() >> 6) * 32;
          peer_select_wave(P, tok0);
          __syncthreads();
#pragma unroll 1
          for (int sb = 0; sb < 4; ++sb) {
              peer_u_tokens(P, lds, tok0 + 8 * sb);
              __syncthreads();
              peer_v_tokens(P, lds, tok0 + 8 * sb);
              __syncthreads();
          } }
    }
}

extern "C" void kernel_launch(void* const* d_in, const int* in_sizes, int n_in, void* d_out, int out_size, void* d_ws, size_t ws_size, hipStream_t stream) {
    static int grid_blocks = 0;
    if (grid_blocks == 0) {
        if (n_in != 18 || out_size != NTOK * DM || ws_size < WS_END) { fprintf(stderr, "kernel_launch: unexpected shapes (n_in %d, out %d, ws %zu, need %zu)\n", n_in, out_size, ws_size, (size_t)WS_END); grid_blocks = -1; return; }
        int dev = 0, cus = 0, per_cu = 0;
        hipGetDevice(&dev);
        hipDeviceGetAttribute(&cus, hipDeviceAttributeMultiprocessorCount, dev);
        if (hipFuncSetAttribute((const void*)fwd_megakernel, hipFuncAttributeMaxDynamicSharedMemorySize, LDS_BYTES) != hipSuccess) fprintf(stderr, "kernel_launch: hipFuncSetAttribute failed\n");
        hipOccupancyMaxActiveBlocksPerMultiprocessor(&per_cu, (const void*)fwd_megakernel, NTHR, LDS_BYTES);
        if (per_cu < 1) { fprintf(stderr, "kernel_launch: occupancy query says %d blocks per CU\n", per_cu); per_cu = 1; }
        if (per_cu > 1) per_cu = 1;
        grid_blocks = cus * per_cu;
        if (grid_blocks != NTOK / 256) { fprintf(stderr, "kernel_launch: built for a %d-CU device (one 256-token panel per workgroup), found %d\n", NTOK / 256, grid_blocks); grid_blocks = -1; return; }
        (void)hipGetLastError();
    }
    if (grid_blocks < 0) return;
    Params p{};
    p.x = (const float*)d_in[0]; p.c = (const float*)d_in[1]; p.w_ada = (const float*)d_in[2]; p.b_ada = (const float*)d_in[3]; p.w_in = (const float*)d_in[4];
    p.w_ba = (const float*)d_in[5]; p.w_bb = (const float*)d_in[6]; p.w_out = (const float*)d_in[7]; p.hgrn_lb = (const float*)d_in[8]; p.hgrn_ng = (const float*)d_in[9];
    p.ln1_g = (const float*)d_in[10]; p.ln1_b = (const float*)d_in[11]; p.peer_wq = (const float*)d_in[12]; p.peer_sk = (const float*)d_in[13]; p.peer_u = (const float*)d_in[14];
    p.peer_v = (const float*)d_in[15]; p.ln2_g = (const float*)d_in[16]; p.ln2_b = (const float*)d_in[17];
    p.out = (float*)d_out; p.ws = (unsigned char*)d_ws;
    if (hipMemsetAsync((char*)d_ws + OFF_BAR, 0, XCD_BAR_WORDS * 4, stream) != hipSuccess) fprintf(stderr, "kernel_launch: memset of the barrier words failed\n");
    void* args[] = {&p};
    hipError_t e = hipLaunchCooperativeKernel((const void*)fwd_megakernel, dim3(grid_blocks), dim3(NTHR), args, LDS_BYTES, stream);
    if (e != hipSuccess) fprintf(stderr, "cooperative launch failed: %s (grid %d)\n", hipGetErrorString(e), grid_blocks);
}
```

```cpp
#include <hip/hip_runtime.h>
#include <hip/hip_cooperative_groups.h>
#include <cstdio>
#include <cstdint>
#include <type_traits>
namespace cg = cooperative_groups;

#define LAS __attribute__((address_space(3)))
typedef unsigned short bf16_t;
typedef short bf16x8 __attribute__((ext_vector_type(8)));
typedef short s16x4 __attribute__((ext_vector_type(4)));
typedef float f32x2 __attribute__((ext_vector_type(2)));
typedef float f32x4 __attribute__((ext_vector_type(4)));
typedef float f32x16 __attribute__((ext_vector_type(16)));
typedef unsigned u32x2 __attribute__((ext_vector_type(2)));
typedef unsigned u32x4 __attribute__((ext_vector_type(4)));

constexpr int NB = 32, SEQ = 2048, DM = 1024, NTOK = NB * SEQ;
constexpr int INCOLS = 5632;
constexpr int NTHR = 512;
constexpr int LDS_BYTES = 147456;
constexpr float ALPHA = 1.189207115002721f;
constexpr float LN_EPS = 1e-5f, RMS_EPS = 1e-6f;
constexpr float LOG2E = 1.4426950408889634f;

constexpr size_t SZ_T512 = (size_t)NTOK * 512 * 2, SZ_T1024 = (size_t)NTOK * 1024 * 2;
constexpr size_t OFF_ADA = 0;
constexpr size_t OFF_LB = OFF_ADA + 786432;
constexpr size_t OFF_KMEAN = OFF_LB + 4096;
constexpr size_t OFF_WIN = OFF_KMEAN + 524288;
constexpr size_t OFF_WBA = OFF_WIN + (size_t)5632 * 1024 * 2;
constexpr size_t OFF_WBB = OFF_WBA + 1048576;
constexpr size_t OFF_WOUT = OFF_WBB + 1048576;
constexpr size_t OFF_WQ = OFF_WOUT + 2097152;
constexpr size_t OFF_SK = OFF_WQ + 2097152;
constexpr size_t OFF_U8 = OFF_SK + 262144;
constexpr size_t OFF_USC = OFF_U8 + 8388608;
constexpr size_t OFF_V8 = OFF_U8 + 16777216;
constexpr size_t OFF_VSC = OFF_V8 + 8388608;
constexpr size_t OFF_CTR = OFF_V8 + 16777216;
constexpr size_t OFF_BAR = OFF_CTR + 4096;
constexpr size_t OFF_EG = OFF_BAR + 16384;
constexpr size_t OFF_H = OFF_EG + (size_t)NTOK * 128 * 8;
constexpr size_t OFF_QA = OFF_H + SZ_T1024;
constexpr size_t OFF_KA = OFF_QA + SZ_T512;
constexpr size_t OFF_VA = OFF_KA + SZ_T512;
constexpr size_t OFF_HQ = OFF_VA + SZ_T512;
constexpr size_t OFF_HK = OFF_HQ + SZ_T512;
constexpr size_t OFF_HI = OFF_HK + SZ_T512;
constexpr size_t OFF_HG = OFF_HI + SZ_T512;
constexpr size_t OFF_GA = OFF_HG + SZ_T512;
constexpr size_t OFF_GB = OFF_GA + SZ_T1024;
constexpr size_t WS_END = OFF_GB + SZ_T1024;
constexpr size_t OFF_H8 = OFF_VA;
constexpr size_t OFF_HS = OFF_HQ;
constexpr size_t OFF_W = OFF_KA;
constexpr size_t OFF_Y = OFF_KA;

struct Params {
    const float *x, *c, *w_ada, *b_ada, *w_in, *w_ba, *w_bb, *w_out, *hgrn_lb, *hgrn_ng, *ln1_g, *ln1_b, *peer_wq, *peer_sk, *peer_u, *peer_v, *ln2_g, *ln2_b;
    float* out;
    unsigned char* ws;
};

typedef __bf16 bf16v2 __attribute__((ext_vector_type(2)));
__device__ __forceinline__ unsigned cvt_pk_bf16(float lo, float hi) { return __builtin_bit_cast(unsigned, __builtin_convertvector((f32x2){lo, hi}, bf16v2)); }
__device__ __forceinline__ float bf_lo(unsigned w) { return __uint_as_float(w << 16); }
__device__ __forceinline__ float bf_hi(unsigned w) { return __uint_as_float(w & 0xffff0000u); }
__device__ __forceinline__ float sigmoidf_(float x) { return 1.0f / (1.0f + __expf(-x)); }
__device__ __forceinline__ float wave_sum(float v) {
#pragma unroll
    for (int o = 1; o < 64; o <<= 1) v += __shfl_xor(v, o);
    return v;
}
__device__ __forceinline__ int tid_opaque() { int t = threadIdx.x; asm volatile("" : "+v"(t)); return t; }
__device__ __forceinline__ int crow(int r, int hi) { return (r & 3) + 8 * (r >> 2) + 4 * hi; }
#define MFMA32(a, b, c) __builtin_amdgcn_mfma_f32_32x32x16_bf16(a, b, c, 0, 0, 0)

namespace pg8 {
constexpr int BM = 256, BK = 64, HALF = 128, HTB = HALF * BK * 2, STAGE_BYTES = 8 * HTB, NXCD = 8, WGM = 8;
__host__ __device__ __forceinline__ int lds_byte(int r, int c) { const int st = (r >> 4) * 2 + (c >> 5), rr = r & 15, cc = c & 31, ob = rr * 64 + cc * 2; return st * 1024 + (ob ^ (((ob >> 9) & 1) << 5)); }
__host__ __device__ __forceinline__ void stage_rc(int b, int& R, int& C) { const int st = b / 1024, sb = b % 1024, swz = sb ^ (((sb >> 9) & 1) << 5); R = (st >> 1) * 16 + swz / 64; C = (st & 1) * 32 + (swz % 64) / 2; }
__host__ __device__ __forceinline__ int perm32(int rho) { const int n = rho >> 4, i = rho & 15; return 8 * (i >> 2) + 4 * n + (i & 3); }

struct Unit { int pm, pn; };
struct Gemm { const bf16_t* A; const bf16_t* Bt; int M, N, K, lda; };

struct StaticOrder {
    int nM, nN, nwg, G, c;
    __device__ void init(int M, int N, int G_, int c_) { nM = M / BM; nN = N / BM; nwg = nM * nN; G = G_; c = c_; }
    __device__ bool next(int i, Unit& u) const {
        const long L = (long)i * G + c; if (L >= nwg) return false;
        int wgid = (int)L; { const int q = nwg / NXCD, r = nwg % NXCD, xcd = wgid % NXCD, off = wgid / NXCD; wgid = (xcd < r ? xcd * (q + 1) : r * (q + 1) + (xcd - r) * q) + off; }
        const int nig = WGM * nN, gid = wgid / nig, fm = gid * WGM, gsz = (nM - fm) < WGM ? (nM - fm) : WGM;
        u.pm = fm + ((wgid % nig) % gsz); u.pn = (wgid % nig) / gsz; return true;
    }
};
struct PanelOrder {
    int pm, npn;
    __device__ bool next(int i, Unit& u) const { if (i >= npn) return false; u.pm = pm; u.pn = i; return true; }
};

template <class Epi, class Sched, bool MX = false>
__device__ __forceinline__ void gemm_phase(LAS unsigned char* lds, const Gemm g, const Sched& S, const Epi& E) {
    const int tid = tid_opaque(), wid = __builtin_amdgcn_readfirstlane(tid >> 6), lane = tid & 63, wr = wid >> 2, wc = wid & 3, fr = lane & 15, fq = lane >> 4;
    const int K = g.K, nt = K / BK;
    unsigned voffA, voffB;
    { int R, C; stage_rc(tid * 16, R, C); const int Rb = Epi::PERM ? ((R & ~31) + perm32(R & 31)) : R;
      voffA = (unsigned)(R * g.lda + C) * 2u; voffB = (unsigned)(Rb * K + C) * 2u; }
    const size_t rvoffA = (size_t)128 * g.lda, rvoffB = (size_t)128 * K;
    const size_t kstep = (size_t)(BK * 2);
    const size_t hstep = (size_t)HALF * K * 2;
    const size_t tstep = 2 * hstep;
    const size_t hstepA = (size_t)HALF * g.lda * 2, tstepA = 2 * hstepA;
    const unsigned ldsw = (unsigned)wid * 1024u;
    const int aoff = lds_byte(wr * 64 + fr, fq * 8), boff = lds_byte(wc * 32 + fr, fq * 8);
#define PG8_SA(b, h) (((b) * 2 + (h)) * HTB)
#define PG8_SB(b, h) ((4 + (b) * 2 + (h)) * HTB)
#define PG8_STAGE(bufoff, gbase, voff) do { unsigned vo_ = (voff); asm volatile("" : "+v"(vo_));     \
        _Pragma("unroll") for (int _i = 0; _i < 2; ++_i) \
        __builtin_amdgcn_global_load_lds((const unsigned*)((const char*)(gbase) + _i * r##voff + vo_), (LAS unsigned*)(lds + (bufoff) + ldsw + _i * 8192), 16, 0, 0); } while (0)
#define PG8_LDX(dst, off) do { const v4i_ lo_ = *(const LAS v4i_*)(lds + (off)), hi_ = *(const LAS v4i_*)(lds + (off) + 1024); dst = __builtin_shufflevector(lo_, hi_, 0, 1, 2, 3, 4, 5, 6, 7); } while (0)
#define PG8_LDA(dst, b, h) do { if constexpr (MX) { _Pragma("unroll") for (int m = 0; m < 4; ++m) PG8_LDX(dst##X[m], PG8_SA(b, h) + aoff + m * 2048); } \
        else { _Pragma("unroll") for (int m = 0; m < 4; ++m) _Pragma("unroll") for (int k = 0; k < 2; ++k) dst[m][k] = *(const LAS bf16x8*)(lds + PG8_SA(b, h) + aoff + m * 2048 + k * 1024); } } while (0)
#define PG8_LDB(dst, b, h) do { if constexpr (MX) { _Pragma("unroll") for (int n = 0; n < 2; ++n) PG8_LDX(dst##X[n], PG8_SB(b, h) + boff + n * 2048); } \
        else { _Pragma("unroll") for (int n = 0; n < 2; ++n) _Pragma("unroll") for (int k = 0; k < 2; ++k) dst[n][k] = *(const LAS bf16x8*)(lds + PG8_SB(b, h) + boff + n * 2048 + k * 1024); } } while (0)
#define PG8_MMA(ai, bj, At, Bt) do { __builtin_amdgcn_s_setprio(1); \
        if constexpr (MX) { _Pragma("unroll") for (int m = 0; m < 4; ++m) _Pragma("unroll") for (int n = 0; n < 2; ++n) \
            asm volatile("v_mfma_scale_f32_16x16x128_f8f6f4 %0, %1, %2, %0, %3, %3 op_sel_hi:[0,0,0]" : "+v"(acc[ai][bj][m][n]) : "v"(Bt##X[n]), "v"(At##X[m]), "v"(mxscale)); } \
        else { _Pragma("unroll") for (int m = 0; m < 4; ++m) _Pragma("unroll") for (int n = 0; n < 2; ++n) _Pragma("unroll") for (int k = 0; k < 2; ++k) \
            acc[ai][bj][m][n] = __builtin_amdgcn_mfma_f32_16x16x32_bf16(Bt[n][k], At[m][k], acc[ai][bj][m][n], 0, 0, 0); } \
        __builtin_amdgcn_s_setprio(0); } while (0)
#define PG8_WAIT_V(n) asm volatile("s_waitcnt vmcnt(" #n ")" ::: "memory")
#define PG8_WAIT_L(n) asm volatile("s_waitcnt lgkmcnt(" #n ")" ::: "memory")
#define PG8_BAR __builtin_amdgcn_s_barrier()
#define PG8_SCHED __builtin_amdgcn_sched_barrier(0)
    Unit cur, nxt; int ui = 0;
    if (!S.next(0, cur)) return;
    f32x4 acc[2][2][4][2];
#pragma unroll
    for (int a = 0; a < 2; ++a)
#pragma unroll
        for (int b = 0; b < 2; ++b)
#pragma unroll
            for (int m = 0; m < 4; ++m)
#pragma unroll
                for (int n = 0; n < 2; ++n) acc[a][b][m][n] = (f32x4){0.f, 0.f, 0.f, 0.f};
    typedef int v4i_ __attribute__((ext_vector_type(4))); typedef int v8i_ __attribute__((ext_vector_type(8)));
    bf16x8 At[4][2], B0[2][2], B1[2][2];
    v8i_ AtX[4], B0X[2], B1X[2];
    const int mxscale = 0x7f7f7f7f;
    const char* cA = (const char*)g.A + (size_t)cur.pm * tstepA; const char* cB = (const char*)g.Bt + (size_t)cur.pn * tstep;
    PG8_STAGE(PG8_SB(0, 0), cB, voffB); PG8_STAGE(PG8_SA(0, 0), cA, voffA); PG8_STAGE(PG8_SB(0, 1), cB + hstep, voffB); PG8_STAGE(PG8_SA(0, 1), cA + hstepA, voffA);
    if (wr == 1) PG8_BAR;
    PG8_WAIT_V(4); PG8_BAR;
    PG8_STAGE(PG8_SB(1, 0), cB + kstep, voffB); PG8_STAGE(PG8_SA(1, 0), cA + kstep, voffA); PG8_STAGE(PG8_SB(1, 1), cB + hstep + kstep, voffB);
    PG8_WAIT_V(6); PG8_BAR;
    for (;;) {
        const bool has_next = S.next(ui + 1, nxt);
        const char* nA = has_next ? (const char*)g.A + (size_t)nxt.pm * tstepA : cA; const char* nB = has_next ? (const char*)g.Bt + (size_t)nxt.pn * tstep : cB;
        for (int t = 0; t < nt; t += 2) {
            const bool last = (t == nt - 2);
            const char* a1 = cA + (size_t)(t + 1) * kstep;
            const char* a2 = last ? nA : cA + (size_t)(t + 2) * kstep; const char* b2 = last ? nB : cB + (size_t)(t + 2) * kstep;
            const char* a3 = a2 + kstep; const char* b3 = b2 + kstep;
            PG8_LDB(B0, 0, 0); PG8_SCHED; PG8_LDA(At, 0, 0); PG8_STAGE(PG8_SA(1, 1), a1 + hstepA, voffA);
            PG8_WAIT_L(8); PG8_BAR; PG8_WAIT_L(0); PG8_MMA(0, 0, At, B0); PG8_BAR; PG8_SCHED;
            PG8_LDB(B1, 0, 1); PG8_STAGE(PG8_SB(0, 0), b2, voffB);
            PG8_BAR; PG8_WAIT_L(0); PG8_MMA(0, 1, At, B1); PG8_BAR;
            PG8_LDA(At, 0, 1); PG8_STAGE(PG8_SA(0, 0), a2, voffA);
            PG8_BAR; PG8_WAIT_L(0); PG8_MMA(1, 0, At, B0); PG8_BAR; PG8_SCHED;
            PG8_STAGE(PG8_SB(0, 1), b2 + hstep, voffB);
            PG8_WAIT_V(6); PG8_BAR; PG8_MMA(1, 1, At, B1); PG8_BAR;
            PG8_LDB(B0, 1, 0); PG8_SCHED; PG8_LDA(At, 1, 0); PG8_STAGE(PG8_SA(0, 1), a2 + hstepA, voffA);
            PG8_WAIT_L(8); PG8_BAR; PG8_WAIT_L(0); PG8_MMA(0, 0, At, B0); PG8_BAR; PG8_SCHED;
            PG8_LDB(B1, 1, 1); PG8_STAGE(PG8_SB(1, 0), b3, voffB);
            PG8_BAR; PG8_WAIT_L(0); PG8_MMA(0, 1, At, B1); PG8_BAR;
            PG8_LDA(At, 1, 1); PG8_STAGE(PG8_SA(1, 0), a3, voffA);
            PG8_BAR; PG8_WAIT_L(0); PG8_MMA(1, 0, At, B0); PG8_BAR; PG8_SCHED;
            PG8_STAGE(PG8_SB(1, 1), b3 + hstep, voffB);
            PG8_WAIT_V(6); PG8_BAR; PG8_MMA(1, 1, At, B1); PG8_BAR;
        }
        if constexpr (MX) asm volatile("s_nop 15\n\ts_nop 15" ::: "memory");
        E(acc, cur, wr, wc, fr, fq);
        if (!has_next) break;
#pragma unroll
        for (int a = 0; a < 2; ++a)
#pragma unroll
            for (int b = 0; b < 2; ++b)
#pragma unroll
                for (int m = 0; m < 4; ++m)
#pragma unroll
                    for (int n = 0; n < 2; ++n) acc[a][b][m][n] = (f32x4){0.f, 0.f, 0.f, 0.f};
        cur = nxt; cA = nA; cB = nB; ++ui;
    }
    PG8_WAIT_V(0);
    if (wr == 0) PG8_BAR;
    PG8_BAR;
#undef PG8_SA
#undef PG8_SB
#undef PG8_STAGE
#undef PG8_LDX
#undef PG8_LDA
#undef PG8_LDB
#undef PG8_MMA
#undef PG8_WAIT_V
#undef PG8_WAIT_L
#undef PG8_BAR
#undef PG8_SCHED
}
}
using pg8::Unit;

struct EpiProj {
    static constexpr bool PERM = true;
    unsigned char* ws; const float* lb; const float* ng; float* kmean;
    __device__ __forceinline__ void operator()(const f32x4 (&acc)[2][2][4][2], const Unit& u, int wr, int wc, int fr, int fq) const {
        const int pn = u.pn; int seg, colt, ldc; size_t boff;
        if (pn < 14) { seg = pn >> 1; colt = (pn & 1) * 256; ldc = 512; boff = OFF_QA + (size_t)seg * SZ_T512; }
        else if (pn < 18) { seg = 7; colt = (pn - 14) * 256; ldc = 1024; boff = OFF_GA; }
        else { seg = 8; colt = (pn - 18) * 256; ldc = 1024; boff = OFF_GB; }
        bf16_t* base = (bf16_t*)(ws + boff);
        const int row0 = u.pm * 256 + wr * 64 + fr, col0 = colt + wc * 32 + 8 * fq;
        float pv[2][8];
#pragma unroll
        for (int bj = 0; bj < 2; ++bj)
#pragma unroll
            for (int e = 0; e < 8; ++e) pv[bj][e] = (seg == 4) ? (1.0f - lb[col0 + bj * 128 + e]) : ((seg == 6) ? ng[col0 + bj * 128 + e] : 0.f);
        float cs[2][8];
#pragma unroll
        for (int bj = 0; bj < 2; ++bj)
#pragma unroll
            for (int e = 0; e < 8; ++e) cs[bj][e] = 0.f;
#pragma unroll
        for (int ai = 0; ai < 2; ++ai)
#pragma unroll
            for (int m = 0; m < 4; ++m) {
                bf16_t* rowp = base + (size_t)(row0 + ai * 128 + m * 16) * ldc + col0;
#pragma unroll
                for (int bj = 0; bj < 2; ++bj) {
                    float v[8];
#pragma unroll
                    for (int e = 0; e < 4; ++e) { v[e] = acc[ai][bj][m][0][e] * (1.0f / 32.0f); v[4 + e] = acc[ai][bj][m][1][e] * (1.0f / 32.0f); }
                    if (seg == 0) {
#pragma unroll
                        for (int e = 0; e < 8; ++e) v[e] *= (0.125f * LOG2E);
                    } else if (seg == 1) {
#pragma unroll
                        for (int e = 0; e < 8; ++e) cs[bj][e] += v[e];
                    } else if (seg == 3) {
#pragma unroll
                        for (int e = 0; e < 8; ++e) v[e] = v[e] * sigmoidf_(v[e]);
                    } else if (seg == 4) {
#pragma unroll
                        for (int e = 0; e < 8; ++e) v[e] = pv[bj][e] * sigmoidf_(-v[e]);
                    } else if (seg == 6) {
#pragma unroll
                        for (int e = 0; e < 8; ++e) v[e] = pv[bj][e] * v[e] * sigmoidf_(v[e]);
                    } else if (seg >= 7) {
#pragma unroll
                        for (int e = 0; e < 8; ++e) v[e] = sigmoidf_(v[e]);
                    }
                    u32x4 w; w.x = cvt_pk_bf16(v[0], v[1]); w.y = cvt_pk_bf16(v[2], v[3]); w.z = cvt_pk_bf16(v[4], v[5]); w.w = cvt_pk_bf16(v[6], v[7]);
                    *(u32x4*)(rowp + bj * 128) = w;
                }
            }
        if (seg == 1) {
#pragma unroll
            for (int bj = 0; bj < 2; ++bj)
#pragma unroll
                for (int e = 0; e < 8; ++e) {
                    float s = cs[bj][e];
                    s += __shfl_xor(s, 1); s += __shfl_xor(s, 2); s += __shfl_xor(s, 4); s += __shfl_xor(s, 8);
                    if (fr == 0) atomicAdd(kmean + (size_t)u.pm * 512 + col0 + bj * 128 + e, s);
                }
        }
    }
};
struct EpiMixA {
    static constexpr bool PERM = true;
    bf16_t* GA;
    __device__ __forceinline__ void operator()(const f32x4 (&acc)[2][2][4][2], const Unit& u, int wr, int wc, int fr, int fq) const {
        const int row0 = u.pm * 256 + wr * 64 + fr, col0 = u.pn * 256 + wc * 32 + 8 * fq;
#pragma unroll
        for (int ai = 0; ai < 2; ++ai)
#pragma unroll
            for (int m = 0; m < 4; ++m) {
                bf16_t* rowp = GA + (size_t)(row0 + ai * 128 + m * 16) * 1024 + col0;
#pragma unroll
                for (int bj = 0; bj < 2; ++bj) {
                    const u32x4 g = *(const u32x4*)(rowp + bj * 128);
                    const f32x4 a0 = acc[ai][bj][m][0], a1 = acc[ai][bj][m][1];
                    u32x4 w;
                    constexpr float S = 1.0f / 32.0f;
                    w.x = cvt_pk_bf16(bf_lo(g.x) * a0[0] * S, bf_hi(g.x) * a0[1] * S); w.y = cvt_pk_bf16(bf_lo(g.y) * a0[2] * S, bf_hi(g.y) * a0[3] * S);
                    w.z = cvt_pk_bf16(bf_lo(g.z) * a1[0] * S, bf_hi(g.z) * a1[1] * S); w.w = cvt_pk_bf16(bf_lo(g.w) * a1[2] * S, bf_hi(g.w) * a1[3] * S);
                    *(u32x4*)(rowp + bj * 128) = w;
                }
            }
    }
};
struct EpiMixB {
    static constexpr bool PERM = true;
    const bf16_t* GA; const bf16_t* GB; unsigned char* M8;
    __device__ __forceinline__ void operator()(const f32x4 (&acc)[2][2][4][2], const Unit& u, int wr, int wc, int fr, int fq) const {
        const int row0 = u.pm * 256 + wr * 64 + fr, col0 = u.pn * 256 + wc * 32 + 8 * fq;
#pragma unroll
        for (int ai = 0; ai < 2; ++ai)
#pragma unroll
            for (int m = 0; m < 4; ++m) {
                const size_t off = (size_t)(row0 + ai * 128 + m * 16) * 1024 + col0;
#pragma unroll
                for (int bj = 0; bj < 2; ++bj) {
                    const u32x4 g = *(const u32x4*)(GB + off + bj * 128);
                    const u32x4 mx = *(const u32x4*)(GA + off + bj * 128);
                    const f32x4 a0 = acc[ai][bj][m][0], a1 = acc[ai][bj][m][1];
                    constexpr float S = 1.0f / 32.0f;
                    int w0 = __builtin_amdgcn_cvt_pk_fp8_f32(bf_lo(mx.x) + bf_lo(g.x) * a0[0] * S, bf_hi(mx.x) + bf_hi(g.x) * a0[1] * S, 0, false); w0 = __builtin_amdgcn_cvt_pk_fp8_f32(bf_lo(mx.y) + bf_lo(g.y) * a0[2] * S, bf_hi(mx.y) + bf_hi(g.y) * a0[3] * S, w0, true);
                    int w1 = __builtin_amdgcn_cvt_pk_fp8_f32(bf_lo(mx.z) + bf_lo(g.z) * a1[0] * S, bf_hi(mx.z) + bf_hi(g.z) * a1[1] * S, 0, false); w1 = __builtin_amdgcn_cvt_pk_fp8_f32(bf_lo(mx.w) + bf_lo(g.w) * a1[2] * S, bf_hi(mx.w) + bf_hi(g.w) * a1[3] * S, w1, true);
                    *(u32x2*)(M8 + off + bj * 128) = (u32x2){(unsigned)w0, (unsigned)w1};
                }
            }
    }
};
struct EpiOut {
    static constexpr bool PERM = true;
    const float* ada; bf16_t* D;
    __device__ __forceinline__ void operator()(const f32x4 (&acc)[2][2][4][2], const Unit& u, int wr, int wc, int fr, int fq) const {
        const int row0 = u.pm * 256 + wr * 64 + fr, col0 = u.pn * 256 + wc * 32 + 8 * fq;
        const float* gt1 = ada + (size_t)(u.pm >> 3) * 6144 + 2048 + col0;
        f32x4 g[2][2];
#pragma unroll
        for (int bj = 0; bj < 2; ++bj) { g[bj][0] = *(const f32x4*)(gt1 + bj * 128); g[bj][1] = *(const f32x4*)(gt1 + bj * 128 + 4); }
#pragma unroll
        for (int ai = 0; ai < 2; ++ai)
#pragma unroll
            for (int m = 0; m < 4; ++m) {
                bf16_t* rowp = D + (size_t)(row0 + ai * 128 + m * 16) * 1024 + col0;
#pragma unroll
                for (int bj = 0; bj < 2; ++bj) {
                    const f32x4 a0 = acc[ai][bj][m][0] * g[bj][0] * (1.0f / 32.0f), a1 = acc[ai][bj][m][1] * g[bj][1] * (1.0f / 32.0f);
                    u32x4 w; w.x = cvt_pk_bf16(a0[0], a0[1]); w.y = cvt_pk_bf16(a0[2], a0[3]); w.z = cvt_pk_bf16(a1[0], a1[1]); w.w = cvt_pk_bf16(a1[2], a1[3]);
                    *(u32x4*)(rowp + bj * 128) = w;
                }
            }
    }
};
struct EpiBf16 {
    static constexpr bool PERM = true;
    bf16_t* O;
    __device__ __forceinline__ void operator()(const f32x4 (&acc)[2][2][4][2], const Unit& u, int wr, int wc, int fr, int fq) const {
        const int row0 = u.pm * 256 + wr * 64 + fr, col0 = u.pn * 256 + wc * 32 + 8 * fq;
#pragma unroll
        for (int ai = 0; ai < 2; ++ai)
#pragma unroll
            for (int m = 0; m < 4; ++m) {
                bf16_t* rowp = O + (size_t)(row0 + ai * 128 + m * 16) * 1024 + col0;
#pragma unroll
                for (int bj = 0; bj < 2; ++bj) {
                    const f32x4 a0 = acc[ai][bj][m][0], a1 = acc[ai][bj][m][1];
                    u32x4 w; w.x = cvt_pk_bf16(a0[0], a0[1]); w.y = cvt_pk_bf16(a0[2], a0[3]); w.z = cvt_pk_bf16(a1[0], a1[1]); w.w = cvt_pk_bf16(a1[2], a1[3]);
                    *(u32x4*)(rowp + bj * 128) = w;
                }
            }
    }
};

__device__ void phase0a(const Params& P, LAS unsigned char* lds) {
    const int tid = tid_opaque(), G = gridDim.x, bid = blockIdx.x;
    for (int it = bid; it < 192; it += G) {
        LAS float* sc = (LAS float*)lds;
        for (int i = tid; i < 32 * 1024; i += NTHR) { const float cv = P.c[i]; sc[i] = cv * sigmoidf_(cv); }
        __syncthreads();
        const int kg = tid >> 5, col = tid & 31;
        float a[32];
#pragma unroll
        for (int b = 0; b < 32; ++b) a[b] = 0.f;
#pragma unroll 1
        for (int k = kg * 64; k < kg * 64 + 64; k += 8) {
            float w[8];
#pragma unroll
            for (int e = 0; e < 8; ++e) w[e] = __builtin_nontemporal_load(P.w_ada + (size_t)(k + e) * 6144 + it * 32 + col);
#pragma unroll
            for (int e4 = 0; e4 < 2; ++e4) {
#pragma unroll
                for (int b = 0; b < 32; ++b) { const f32x4 s = *(const LAS f32x4*)(sc + b * 1024 + k + 4 * e4); a[b] += s[0] * w[4 * e4] + s[1] * w[4 * e4 + 1] + s[2] * w[4 * e4 + 2] + s[3] * w[4 * e4 + 3]; }
                asm volatile("" ::: "memory");
            }
        }
        __syncthreads();
        LAS float* red = (LAS float*)lds;
#pragma unroll
        for (int b = 0; b < 32; ++b) red[(kg * 32 + b) * 32 + col] = a[b];
        __syncthreads();
        for (int o = tid; o < 1024; o += NTHR) { const int b = o >> 5, cc = o & 31; float s = 0.f;
#pragma unroll
            for (int g2 = 0; g2 < 16; ++g2) s += red[(g2 * 32 + b) * 32 + cc];
            ((float*)(P.ws + OFF_ADA))[(size_t)b * 6144 + it * 32 + cc] = s + P.b_ada[it * 32 + cc]; }
        __syncthreads();
    }
    const size_t gsz = (size_t)G * NTHR;
    { const int gt = bid * NTHR + tid, gs = G * NTHR;
      if (gt < 512) ((float*)(P.ws + OFF_LB))[gt] = sigmoidf_(P.hgrn_lb[gt] - P.hgrn_lb[512 + gt]);
      for (int i = gt; i < 32 * 8 * 512; i += gs) ((float*)(P.ws + OFF_KMEAN))[i] = 0.f; }
    {
        LAS float* tile = (LAS float*)lds;
        const int I0 = 16 * 88, I1 = I0 + 8 * 16, I2 = I1 + 8 * 16, I3 = I2 + 16 * 16, I4 = I3 + 16 * 16;
        for (int it = bid; it < I4; it += G) {
            const float* W; bf16_t* WT; int K, N, r;
            if (it < I0) { W = P.w_in; WT = (bf16_t*)(P.ws + OFF_WIN); K = 1024; N = 5632; r = it; }
            else if (it < I1) { W = P.w_ba; WT = (bf16_t*)(P.ws + OFF_WBA); K = 512; N = 1024; r = it - I0; }
            else if (it < I2) { W = P.w_bb; WT = (bf16_t*)(P.ws + OFF_WBB); K = 512; N = 1024; r = it - I1; }
            else if (it < I3) { W = P.w_out; WT = (bf16_t*)(P.ws + OFF_WOUT); K = 1024; N = 1024; r = it - I2; }
            else { W = P.peer_wq; WT = (bf16_t*)(P.ws + OFF_WQ); K = 1024; N = 1024; r = it - I3; }
            const int nb = N / 64, k0 = (r / nb) * 64, n0 = (r % nb) * 64;
#pragma unroll
            for (int ps = 0; ps < 2; ++ps) { const int kk = (tid >> 4) + 32 * ps, n4 = (tid & 15) * 4;
                const f32x4 v = *(const f32x4*)(W + (size_t)(k0 + kk) * N + n0 + n4);
                tile[kk * 65 + n4] = v[0]; tile[kk * 65 + n4 + 1] = v[1]; tile[kk * 65 + n4 + 2] = v[2]; tile[kk * 65 + n4 + 3] = v[3]; }
            __syncthreads();
            { const int n = tid >> 3, kc = (tid & 7) * 8;
              if (it < I3) {
                  int w0 = __builtin_amdgcn_cvt_pk_fp8_f32(32.f * tile[(kc + 0) * 65 + n], 32.f * tile[(kc + 1) * 65 + n], 0, false); w0 = __builtin_amdgcn_cvt_pk_fp8_f32(32.f * tile[(kc + 2) * 65 + n], 32.f * tile[(kc + 3) * 65 + n], w0, true);
                  int w1 = __builtin_amdgcn_cvt_pk_fp8_f32(32.f * tile[(kc + 4) * 65 + n], 32.f * tile[(kc + 5) * 65 + n], 0, false); w1 = __builtin_amdgcn_cvt_pk_fp8_f32(32.f * tile[(kc + 6) * 65 + n], 32.f * tile[(kc + 7) * 65 + n], w1, true);
                  *(u32x2*)((unsigned char*)WT + (size_t)(n0 + n) * K + k0 + kc) = (u32x2){(unsigned)w0, (unsigned)w1};
              } else { u32x4 w;
              w.x = cvt_pk_bf16(tile[(kc + 0) * 65 + n], tile[(kc + 1) * 65 + n]); w.y = cvt_pk_bf16(tile[(kc + 2) * 65 + n], tile[(kc + 3) * 65 + n]);
              w.z = cvt_pk_bf16(tile[(kc + 4) * 65 + n], tile[(kc + 5) * 65 + n]); w.w = cvt_pk_bf16(tile[(kc + 6) * 65 + n], tile[(kc + 7) * 65 + n]);
              *(u32x4*)(WT + (size_t)(n0 + n) * K + k0 + kc) = w; } }
            __syncthreads();
        }
    }
    {
        const size_t gtid = (size_t)bid * NTHR + tid_opaque();
        for (size_t i = gtid; i < 16384; i += gsz) {
            const float* src = P.peer_sk + i * 8; const f32x4 a = *(const f32x4*)src, b = *(const f32x4*)(src + 4);
            u32x4 w; w.x = cvt_pk_bf16(a[0], a[1]); w.y = cvt_pk_bf16(a[2], a[3]); w.z = cvt_pk_bf16(b[0], b[1]); w.w = cvt_pk_bf16(b[2], b[3]);
            *(u32x4*)((bf16_t*)(P.ws + OFF_SK) + i * 8) = w;
        }
        { const int lane = tid & 63, gw = bid * 8 + (tid >> 6), ngw = G * 8;
          for (int r = gw; r < 2 * 16384; r += ngw) {
              const bool isv = r >= 16384; const int e = isv ? r - 16384 : r;
              const float* s = (isv ? P.peer_v : P.peer_u) + (size_t)e * 1024 + lane * 16;
              f32x4 x[4]; float ss = 0.f;
#pragma unroll
              for (int q = 0; q < 4; ++q) { x[q] = __builtin_nontemporal_load((const f32x4*)(s + 4 * q)); ss += (x[q][0] * x[q][0] + x[q][1] * x[q][1]) + (x[q][2] * x[q][2] + x[q][3] * x[q][3]); }
              const float sc = fmaxf(sqrtf(wave_sum(ss) * (1.0f / 1024.0f)) * (2.6f / 7.5f), 1e-30f), inv = 1.0f / sc;
              unsigned nb[16];
#pragma unroll
              for (int q = 0; q < 4; ++q)
#pragma unroll
                  for (int el = 0; el < 4; ++el) nb[4 * q + el] = (unsigned)fminf(fmaxf(floorf(x[q][el] * inv) + 8.0f, 0.0f), 15.0f);
              u32x2 w;
              w.x = (nb[0] | (nb[4] << 4)) | ((nb[1] | (nb[5] << 4)) << 8) | ((nb[2] | (nb[6] << 4)) << 16) | ((nb[3] | (nb[7] << 4)) << 24);
              w.y = (nb[8] | (nb[12] << 4)) | ((nb[9] | (nb[13] << 4)) << 8) | ((nb[10] | (nb[14] << 4)) << 16) | ((nb[11] | (nb[15] << 4)) << 24);
              *(u32x2*)(P.ws + (isv ? OFF_V8 : OFF_U8) + (size_t)e * 512 + lane * 8) = w;
              if (lane == 0) ((float*)(P.ws + (isv ? OFF_VSC : OFF_USC)))[e] = sc;
          } }
    }
}
__device__ void phase0b(const Params& P) {
    const size_t gtid = (size_t)blockIdx.x * NTHR + threadIdx.x, gsz = (size_t)gridDim.x * NTHR;
    const float* ada = (const float*)(P.ws + OFF_ADA); bf16_t* H = (bf16_t*)(P.ws + OFF_H);
    for (size_t i = gtid; i < (size_t)NTOK * 128; i += gsz) {
        const size_t row = i >> 7; const int c8 = (int)(i & 127) * 8; const int b = (int)(row >> 11);
        const float* xr = P.x + row * 1024 + c8; const float* sh = ada + (size_t)b * 6144 + c8; const float* sc = sh + 1024;
        const f32x4 x0 = *(const f32x4*)xr, x1 = *(const f32x4*)(xr + 4), s0 = *(const f32x4*)sc, s1 = *(const f32x4*)(sc + 4), h0 = *(const f32x4*)sh, h1 = *(const f32x4*)(sh + 4);
        const f32x4 r0 = x0 * (s0 + 1.0f) + h0, r1 = x1 * (s1 + 1.0f) + h1;
        int w0 = __builtin_amdgcn_cvt_pk_fp8_f32(r0[0], r0[1], 0, false); w0 = __builtin_amdgcn_cvt_pk_fp8_f32(r0[2], r0[3], w0, true);
        int w1 = __builtin_amdgcn_cvt_pk_fp8_f32(r1[0], r1[1], 0, false); w1 = __builtin_amdgcn_cvt_pk_fp8_f32(r1[2], r1[3], w1, true);
        *(u32x2*)((unsigned char*)H + row * 1024 + c8) = (u32x2){(unsigned)w0, (unsigned)w1};
    }
}

__device__ __forceinline__ s16x4 tr4(const LAS unsigned char* p) { return __builtin_bit_cast(s16x4, __builtin_amdgcn_ds_read_tr16_b64_v4i16((LAS s16x4*)p)); }
__device__ void hgrn_item(const Params& P, int item, LAS unsigned char* lds) {
    const int tid = tid_opaque(), lane = tid & 63, wid = __builtin_amdgcn_readfirstlane(tid >> 6), r32 = lane & 31, hi = lane >> 5;
    const int b = item >> 3, h = (item >> 1) & 3, vh = item & 1;
    const bf16_t* HQ = (const bf16_t*)(P.ws + OFF_HQ); const bf16_t* HK = (const bf16_t*)(P.ws + OFF_HK); bf16_t* HI = (bf16_t*)(P.ws + OFF_HI);
    constexpr int SQ = 272, SKD = 320, SV = 192, SS = 192;
    constexpr int LQR = 0, LKR = 17408, LQB = 34816, LKD = 52224, LV = 72704, LS = 84992, LG = 109568, LT = 142336, LCL = 144384;
    LAS float* G = (LAS float*)(lds + LG); LAS float* TOT = (LAS float*)(lds + LT); LAS float* CL = (LAS float*)(lds + LCL);
    const size_t rowb = (size_t)b * SEQ;
    const int row = tid >> 3, seg = tid & 7;
    const bf16_t* qsrc = HQ + (rowb + row) * 512 + h * 128 + seg * 16; const bf16_t* ksrc = HK + (rowb + row) * 512 + h * 128 + seg * 16;
    bf16_t* vsrc = HI + (rowb + row) * 512 + h * 128 + vh * 64 + seg * 8;
    for (int i = tid; i < 128 * SS / 4; i += NTHR) ((LAS unsigned*)(lds + LS))[i] = 0u;
    f32x16 Sacc = {};
    const int di = wid >> 1, vi = wid & 1, ti = wid >> 1;
    const int tg = lane >> 4, tc = tg & 1, tI = lane & 15;
    const int trow = 4 * hi + (tI >> 2), tcol = 16 * tc + 4 * (tI & 3);
    u32x4 qn0 = *(const u32x4*)qsrc, qn1 = *(const u32x4*)(qsrc + 8), kn0 = *(const u32x4*)ksrc, kn1 = *(const u32x4*)(ksrc + 8), vn = *(const u32x4*)vsrc;
#pragma unroll 1
    for (int n = 0; n < SEQ / 64; ++n) {
        const u32x4 q0 = qn0, q1 = qn1, k0 = kn0, k1 = kn1, vv = vn;
        float qf[16] = {bf_lo(q0.x), bf_hi(q0.x), bf_lo(q0.y), bf_hi(q0.y), bf_lo(q0.z), bf_hi(q0.z), bf_lo(q0.w), bf_hi(q0.w), bf_lo(q1.x), bf_hi(q1.x), bf_lo(q1.y), bf_hi(q1.y), bf_lo(q1.z), bf_hi(q1.z), bf_lo(q1.w), bf_hi(q1.w)};
        float kf[16] = {bf_lo(k0.x), bf_hi(k0.x), bf_lo(k0.y), bf_hi(k0.y), bf_lo(k0.z), bf_hi(k0.z), bf_lo(k0.w), bf_hi(k0.w), bf_lo(k1.x), bf_hi(k1.x), bf_lo(k1.y), bf_hi(k1.y), bf_lo(k1.z), bf_hi(k1.z), bf_lo(k1.w), bf_hi(k1.w)};
#pragma unroll
        for (int e4 = 0; e4 < 4; ++e4) *(LAS f32x4*)(G + row * 128 + seg * 16 + 4 * e4) = (f32x4){__logf(1.0f - kf[4 * e4]), __logf(1.0f - kf[4 * e4 + 1]), __logf(1.0f - kf[4 * e4 + 2]), __logf(1.0f - kf[4 * e4 + 3])};
        *(LAS u32x4*)(lds + LV + row * SV + seg * 16) = vv;
        if (n + 1 < SEQ / 64) { const size_t o = (size_t)(n + 1) * 64 * 512; qn0 = *(const u32x4*)(qsrc + o); qn1 = *(const u32x4*)(qsrc + o + 8); kn0 = *(const u32x4*)(ksrc + o); kn1 = *(const u32x4*)(ksrc + o + 8); vn = *(const u32x4*)(vsrc + o); }
        __syncthreads();
        { const int d = tid & 127, q4 = tid >> 7; float s = 0.f;
#pragma unroll
          for (int i = 0; i < 16; ++i) { s += G[(16 * q4 + i) * 128 + d]; G[(16 * q4 + i) * 128 + d] = s; }
          TOT[q4 * 128 + d] = s; }
        __syncthreads();
        {
            const int qq = row >> 4;
#pragma unroll
            for (int e4 = 0; e4 < 4; ++e4) {
                const int d4 = seg * 16 + 4 * e4;
                const f32x4 t0 = *(const LAS f32x4*)(TOT + d4), t1 = *(const LAS f32x4*)(TOT + 128 + d4), t2 = *(const LAS f32x4*)(TOT + 256 + d4), t3 = *(const LAS f32x4*)(TOT + 384 + d4);
                const f32x4 off = (qq == 0) ? (f32x4){0.f, 0.f, 0.f, 0.f} : ((qq == 1) ? t0 : ((qq == 2) ? t0 + t1 : t0 + t1 + t2));
                const f32x4 bb = *(const LAS f32x4*)(G + row * 128 + d4) + off;
                const f32x4 bref = *(const LAS f32x4*)(G + 32 * 128 + d4) + t0 + t1, blast = t0 + t1 + t2 + t3;
                float vqb[4], vqr[4], vkr[4], vkd[4];
#pragma unroll
                for (int e = 0; e < 4; ++e) {
                    const float e1 = __expf(bb[e]), e2 = __expf(-bb[e]);
                    vqb[e] = qf[4 * e4 + e] * e1; vqr[e] = vqb[e] * __expf(-bref[e]);
                    const float ke = kf[4 * e4 + e] * e2; vkr[e] = ke * __expf(bref[e]); vkd[e] = ke * __expf(blast[e]);
                }
                *(LAS u32x2*)(lds + LQB + row * SQ + seg * 32 + 8 * e4) = (u32x2){cvt_pk_bf16(vqb[0], vqb[1]), cvt_pk_bf16(vqb[2], vqb[3])};
                *(LAS u32x2*)(lds + LQR + row * SQ + seg * 32 + 8 * e4) = (u32x2){cvt_pk_bf16(vqr[0], vqr[1]), cvt_pk_bf16(vqr[2], vqr[3])};
                *(LAS u32x2*)(lds + LKR + row * SQ + seg * 32 + 8 * e4) = (u32x2){cvt_pk_bf16(vkr[0], vkr[1]), cvt_pk_bf16(vkr[2], vkr[3])};
                *(LAS u32x2*)(lds + LKD + row * SKD + seg * 32 + 8 * e4) = (u32x2){cvt_pk_bf16(vkd[0], vkd[1]), cvt_pk_bf16(vkd[2], vkd[3])};
                if (row == 0) *(LAS f32x4*)(CL + d4) = (f32x4){__expf(blast[0]), __expf(blast[1]), __expf(blast[2]), __expf(blast[3])};
                asm volatile("" ::: "memory");
            }
        }
        __syncthreads();
        if (wid < 4) {
            f32x16 Z = {};
            for (int si = 0; si <= ti; ++si) {
                f32x16 X = {};
#pragma unroll
                for (int ks = 0; ks < 8; ++ks) {
                    const bf16x8 a = *(const LAS bf16x8*)(lds + LKR + (32 * si + r32) * SQ + (16 * ks + 8 * hi) * 2);
                    const bf16x8 bq = *(const LAS bf16x8*)(lds + LQR + (32 * ti + r32) * SQ + (16 * ks + 8 * hi) * 2);
                    X = MFMA32(a, bq, X);
                }
                if (si == ti) {
#pragma unroll
                    for (int r = 0; r < 16; ++r) if (crow(r, hi) > r32) X[r] = 0.f;
                }
#pragma unroll
                for (int s2 = 0; s2 < 2; ++s2) {
                    union { u32x4 u; bf16x8 v; } pa;
                    pa.u.x = cvt_pk_bf16(X[8 * s2 + 0], X[8 * s2 + 1]); pa.u.y = cvt_pk_bf16(X[8 * s2 + 2], X[8 * s2 + 3]); pa.u.z = cvt_pk_bf16(X[8 * s2 + 4], X[8 * s2 + 5]); pa.u.w = cvt_pk_bf16(X[8 * s2 + 6], X[8 * s2 + 7]);
                    const LAS unsigned char* vp = lds + LV + (32 * si + 16 * s2 + trow) * SV + (32 * vi + tcol) * 2;
                    const s16x4 lo = tr4(vp), hh = tr4(vp + 8 * SV);
                    const bf16x8 vf = {lo[0], lo[1], lo[2], lo[3], hh[0], hh[1], hh[2], hh[3]};
                    Z = MFMA32(pa.v, vf, Z);
                }
            }
#pragma unroll
            for (int ks = 0; ks < 8; ++ks) {
                const bf16x8 a = *(const LAS bf16x8*)(lds + LQB + (32 * ti + r32) * SQ + (16 * ks + 8 * hi) * 2);
                const LAS unsigned char* sp = lds + LS + (16 * ks + 8 * hi + (tI >> 2)) * SS + (32 * vi + tcol) * 2;
                const s16x4 lo = tr4(sp), hh = tr4(sp + 4 * SS);
                const bf16x8 sf = {lo[0], lo[1], lo[2], lo[3], hh[0], hh[1], hh[2], hh[3]};
                Z = MFMA32(a, sf, Z);
            }
            bf16_t* op = HI + (rowb + (size_t)n * 64 + 32 * ti) * 512 + h * 128 + vh * 64 + 32 * vi + r32;
#pragma unroll
            for (int r = 0; r < 16; ++r) op[(size_t)crow(r, hi) * 512] = (bf16_t)(cvt_pk_bf16(Z[r], 0.f) & 0xffffu);
        }
        {
#pragma unroll
            for (int r = 0; r < 16; ++r) Sacc[r] *= CL[32 * di + crow(r, hi)];
#pragma unroll
            for (int ks = 0; ks < 4; ++ks) {
                const LAS unsigned char* kp = lds + LKD + (16 * ks + 8 * hi + (tI >> 2)) * SKD + (32 * di + tcol) * 2;
                const s16x4 klo = tr4(kp), khi = tr4(kp + 4 * SKD);
                const bf16x8 ka = {klo[0], klo[1], klo[2], klo[3], khi[0], khi[1], khi[2], khi[3]};
                const LAS unsigned char* vp = lds + LV + (16 * ks + 8 * hi + (tI >> 2)) * SV + (32 * vi + tcol) * 2;
                const s16x4 vlo = tr4(vp), vhi = tr4(vp + 4 * SV);
                const bf16x8 vb = {vlo[0], vlo[1], vlo[2], vlo[3], vhi[0], vhi[1], vhi[2], vhi[3]};
                Sacc = MFMA32(ka, vb, Sacc);
            }
        }
        __syncthreads();
        {
            LAS bf16_t* sp = (LAS bf16_t*)(lds + LS + (32 * di) * SS + (32 * vi + r32) * 2);
#pragma unroll
            for (int r = 0; r < 16; ++r) sp[crow(r, hi) * (SS / 2)] = (bf16_t)(cvt_pk_bf16(Sacc[r], 0.f) & 0xffffu);
        }
    }
    __syncthreads();
}

__device__ void moba_unit(const Params& P, int b, int h, int j, LAS unsigned char* lds) {
    const int tid = tid_opaque(), lane = tid & 63, wid = tid >> 6, r32 = lane & 31, hi = lane >> 5;
    bf16_t* Q = (bf16_t*)(P.ws + OFF_QA); const bf16_t* Kg = (const bf16_t*)(P.ws + OFF_KA); const bf16_t* Vg = (const bf16_t*)(P.ws + OFF_VA);
    const float* kmean = (const float*)(P.ws + OFF_KMEAN);
    constexpr int KIMG = 64 * 144, VIMG = 64 * 192, LK = 0, LV = 2 * KIMG, LKM = 2 * KIMG + 2 * VIMG;
    LAS float* kmL = (LAS float*)(lds + LKM);
    const size_t rowb = (size_t)b * SEQ; const int q0 = j * 256;
    if (tid < j * 64) kmL[tid] = kmean[(size_t)(b * 8 + (tid >> 6)) * 512 + h * 64 + (tid & 63)];
    bf16_t* qrow = Q + (rowb + q0 + wid * 32 + r32) * 512 + h * 64;
    bf16x8 qf[4];
#pragma unroll
    for (int d0 = 0; d0 < 4; ++d0) qf[d0] = *(const bf16x8*)(qrow + 16 * d0 + 8 * hi);
    const int srow = tid >> 3, sch = tid & 7;
    const bf16_t* ksrc = Kg + (rowb + srow) * 512 + h * 64 + sch * 8; const bf16_t* vsrc = Vg + (rowb + srow) * 512 + h * 64 + sch * 8;
    const int ntile = 4 * (j + 1);
    u32x4 kreg, vreg;
    { const int key0 = q0; kreg = *(const u32x4*)(ksrc + (size_t)key0 * 512); vreg = *(const u32x4*)(vsrc + (size_t)key0 * 512); }
    *(LAS u32x4*)(lds + LK + srow * 144 + sch * 16) = kreg; *(LAS u32x4*)(lds + LV + srow * 192 + sch * 16) = vreg;
    __syncthreads();
    unsigned sel = 0;
    if (j <= 3) sel = (1u << j) - 1u;
    else {
        float g[7];
#pragma unroll
        for (int n = 0; n < 7; ++n) { float s = 0.f;
            if (n < j) {
#pragma unroll
                for (int d0 = 0; d0 < 4; ++d0)
#pragma unroll
                    for (int e = 0; e < 8; ++e) s += __uint_as_float(((unsigned)(unsigned short)qf[d0][e]) << 16) * kmL[n * 64 + 16 * d0 + 8 * hi + e];
            }
            s += __shfl_xor(s, 32); g[n] = s; }
#pragma unroll
        for (int it = 0; it < 3; ++it) { float best = -INFINITY; int bi = 0;
#pragma unroll
            for (int n = 0; n < 7; ++n) if (n < j && !((sel >> n) & 1u) && g[n] > best) { best = g[n]; bi = n; }
            sel |= 1u << bi; }
    }
    const float ch = exp2f(-(float)(h + 1)) * LOG2E;
    const int qb = wid * 32 + r32;
    float m_run = -1e30f, l_run = 0.f;
    f32x16 o0 = {}, o1 = {};
    const int tg = lane >> 4, tc = tg & 1, ti = lane & 15;
    const int vlane = (4 * hi + (ti >> 2)) * 192 + (16 * tc + 4 * (ti & 3)) * 2;
#pragma unroll 1
    for (int i = 0; i < ntile; ++i) {
        const int buf = i & 1;
        const bool own = i < 4; const int blk = own ? j : ((i - 4) >> 2), kt = own ? i : ((i - 4) & 3);
        if (i + 1 < ntile) { const int i1 = i + 1; const int blk1 = (i1 < 4) ? j : ((i1 - 4) >> 2), kt1 = (i1 < 4) ? i1 : ((i1 - 4) & 3); const size_t key1 = (size_t)(blk1 * 256 + kt1 * 64);
            kreg = *(const u32x4*)(ksrc + key1 * 512); vreg = *(const u32x4*)(vsrc + key1 * 512); }
        const bool lane_ok = own ? true : (((sel >> blk) & 1u) != 0u);
        const bool skip = own ? (64 * kt > 32 * wid + 31) : (__ballot(lane_ok) == 0ull);
        if (!skip) {
            LAS unsigned char* kb = lds + LK + buf * KIMG; LAS unsigned char* vb = lds + LV + buf * VIMG;
            f32x16 p0 = {}, p1 = {};
#pragma unroll
            for (int d0 = 0; d0 < 4; ++d0) {
                const bf16x8 kf0 = *(const LAS bf16x8*)(kb + r32 * 144 + (16 * d0 + 8 * hi) * 2);
                const bf16x8 kf1 = *(const LAS bf16x8*)(kb + (32 + r32) * 144 + (16 * d0 + 8 * hi) * 2);
                p0 = MFMA32(kf0, qf[d0], p0); p1 = MFMA32(kf1, qf[d0], p1);
            }
            const float kbase = ch * (float)((blk - j) * 256 + kt * 64);
            float mt = -1e30f;
#pragma unroll
            for (int r = 0; r < 16; ++r) {
                const int kl0 = crow(r, hi), kl1 = kl0 + 32;
                p0[r] = __builtin_fmaf(ch, (float)kl0, p0[r]); p1[r] = __builtin_fmaf(ch, (float)kl1, p1[r]);
                if (own) { if (kt * 64 + kl0 > qb) p0[r] = -1e30f; if (kt * 64 + kl1 > qb) p1[r] = -1e30f; }
                mt = fmaxf(mt, fmaxf(p0[r], p1[r]));
            }
            mt = lane_ok ? mt + kbase : -1e30f;
            mt = fmaxf(mt, __shfl_xor(mt, 32));
            if (__ballot(mt > m_run) != 0ull) {
                const float mnew = fmaxf(m_run, mt), alpha = __builtin_amdgcn_exp2f(m_run - mnew);
                m_run = mnew; l_run *= alpha;
#pragma unroll
                for (int r = 0; r < 16; ++r) { o0[r] *= alpha; o1[r] *= alpha; }
            }
            const float sh = lane_ok ? kbase - m_run : -1e30f;
            float rs = 0.f;
#pragma unroll
            for (int r = 0; r < 16; ++r) { p0[r] = __builtin_amdgcn_exp2f(p0[r] + sh); p1[r] = __builtin_amdgcn_exp2f(p1[r] + sh); rs += p0[r] + p1[r]; }
            l_run += rs;
#pragma unroll
            for (int sub = 0; sub < 2; ++sub)
#pragma unroll
                for (int s = 0; s < 2; ++s) {
                    union { u32x4 u; bf16x8 v; } pb;
                    if (sub == 0) { pb.u.x = cvt_pk_bf16(p0[8 * s + 0], p0[8 * s + 1]); pb.u.y = cvt_pk_bf16(p0[8 * s + 2], p0[8 * s + 3]); pb.u.z = cvt_pk_bf16(p0[8 * s + 4], p0[8 * s + 5]); pb.u.w = cvt_pk_bf16(p0[8 * s + 6], p0[8 * s + 7]); }
                    else { pb.u.x = cvt_pk_bf16(p1[8 * s + 0], p1[8 * s + 1]); pb.u.y = cvt_pk_bf16(p1[8 * s + 2], p1[8 * s + 3]); pb.u.z = cvt_pk_bf16(p1[8 * s + 4], p1[8 * s + 5]); pb.u.w = cvt_pk_bf16(p1[8 * s + 6], p1[8 * s + 7]); }
#pragma unroll
                    for (int dt = 0; dt < 2; ++dt) {
                        LAS unsigned char* va = vb + (32 * sub + 16 * s) * 192 + dt * 64 + vlane;
                        const s16x4 lo = __builtin_bit_cast(s16x4, __builtin_amdgcn_ds_read_tr16_b64_v4i16((LAS s16x4*)va));
                        const s16x4 hh = __builtin_bit_cast(s16x4, __builtin_amdgcn_ds_read_tr16_b64_v4i16((LAS s16x4*)(va + 8 * 192)));
                        const bf16x8 vf = {lo[0], lo[1], lo[2], lo[3], hh[0], hh[1], hh[2], hh[3]};
                        if (dt == 0) o0 = MFMA32(vf, pb.v, o0); else o1 = MFMA32(vf, pb.v, o1);
                    }
                }
        }
        if (i + 1 < ntile) { const int nb = buf ^ 1;
            *(LAS u32x4*)(lds + LK + nb * KIMG + srow * 144 + sch * 16) = kreg; *(LAS u32x4*)(lds + LV + nb * VIMG + srow * 192 + sch * 16) = vreg; }
        __syncthreads();
    }
    l_run += __shfl_xor(l_run, 32);
    const float inv = 1.0f / l_run;
#pragma unroll
    for (int r4 = 0; r4 < 4; ++r4) {
        int w0 = __builtin_amdgcn_cvt_pk_fp8_f32(o0[4 * r4] * inv, o0[4 * r4 + 1] * inv, 0, false); w0 = __builtin_amdgcn_cvt_pk_fp8_f32(o0[4 * r4 + 2] * inv, o0[4 * r4 + 3] * inv, w0, true);
        int w1 = __builtin_amdgcn_cvt_pk_fp8_f32(o1[4 * r4] * inv, o1[4 * r4 + 1] * inv, 0, false); w1 = __builtin_amdgcn_cvt_pk_fp8_f32(o1[4 * r4 + 2] * inv, o1[4 * r4 + 3] * inv, w1, true);
        unsigned char* yrow = P.ws + OFF_EG + (rowb + q0 + wid * 32 + r32) * 1024 + h * 64;
        *(int*)(yrow + 8 * r4 + 4 * hi) = w0; *(int*)(yrow + 32 + 8 * r4 + 4 * hi) = w1;
    }
}

__device__ void yb_norm_panel(const Params& P, int pm) {
    const int tid = tid_opaque(), lane = tid & 63, wid = tid >> 6;
    bf16_t* HI = (bf16_t*)(P.ws + OFF_HI); const bf16_t* HG = (const bf16_t*)(P.ws + OFF_HG);
    for (int r = 0; r < 32; ++r) {
        const size_t off = ((size_t)pm * 256 + wid * 32 + r) * 512 + lane * 8;
        const u32x4 ov = *(const u32x4*)(HI + off), gv = *(const u32x4*)(HG + off);
        float o[8] = {bf_lo(ov.x), bf_hi(ov.x), bf_lo(ov.y), bf_hi(ov.y), bf_lo(ov.z), bf_hi(ov.z), bf_lo(ov.w), bf_hi(ov.w)};
        const float g[8] = {bf_lo(gv.x), bf_hi(gv.x), bf_lo(gv.y), bf_hi(gv.y), bf_lo(gv.z), bf_hi(gv.z), bf_lo(gv.w), bf_hi(gv.w)};
        float ss = 0.f;
#pragma unroll
        for (int e = 0; e < 8; ++e) ss += o[e] * o[e];
        ss += __shfl_xor(ss, 1); ss += __shfl_xor(ss, 2); ss += __shfl_xor(ss, 4); ss += __shfl_xor(ss, 8);
        const float rs = rsqrtf(ss * (1.0f / 128.0f) + RMS_EPS);
        int w0 = __builtin_amdgcn_cvt_pk_fp8_f32(o[0] * rs * g[0], o[1] * rs * g[1], 0, false); w0 = __builtin_amdgcn_cvt_pk_fp8_f32(o[2] * rs * g[2], o[3] * rs * g[3], w0, true);
        int w1 = __builtin_amdgcn_cvt_pk_fp8_f32(o[4] * rs * g[4], o[5] * rs * g[5], 0, false); w1 = __builtin_amdgcn_cvt_pk_fp8_f32(o[6] * rs * g[6], o[7] * rs * g[7], w1, true);
        *(u32x2*)(P.ws + OFF_EG + ((size_t)pm * 256 + wid * 32 + r) * 1024 + 512 + lane * 8) = (u32x2){(unsigned)w0, (unsigned)w1};
    }
}
__device__ void ln1_panel(const Params& P, int pm) {
    const int tid = tid_opaque(), lane = tid & 63, wid = tid >> 6;
    const float* ada = (const float*)(P.ws + OFF_ADA) + (size_t)(pm >> 3) * 6144; bf16_t* H = (bf16_t*)(P.ws + OFF_H);
    for (int r = 0; r < 32; ++r) {
        const size_t row = (size_t)pm * 256 + wid * 32 + r;
        float* xr = P.out + row * 1024 + lane * 4; const float* xin = P.x + row * 1024 + lane * 4; const bf16_t* dl = (const bf16_t*)(P.ws + OFF_GB) + row * 1024 + lane * 4;
        f32x4 v[4]; float s = 0.f;
#pragma unroll
        for (int jx = 0; jx < 4; ++jx) { const u32x2 dv = *(const u32x2*)(dl + 256 * jx); const f32x4 xv = __builtin_nontemporal_load((const f32x4*)(xin + 256 * jx));
            v[jx] = xv * ALPHA + (f32x4){bf_lo(dv.x), bf_hi(dv.x), bf_lo(dv.y), bf_hi(dv.y)}; s += (v[jx][0] + v[jx][1]) + (v[jx][2] + v[jx][3]); }
        const float mean = wave_sum(s) * (1.0f / 1024.0f); float s2 = 0.f;
#pragma unroll
        for (int jx = 0; jx < 4; ++jx) { v[jx] = v[jx] - mean; s2 += (v[jx][0] * v[jx][0] + v[jx][1] * v[jx][1]) + (v[jx][2] * v[jx][2] + v[jx][3] * v[jx][3]); }
        const float rstd = rsqrtf(wave_sum(s2) * (1.0f / 1024.0f) + LN_EPS);
#pragma unroll
        for (int jx = 0; jx < 4; ++jx) {
            const int c = lane * 4 + 256 * jx;
            const f32x4 g = *(const f32x4*)(P.ln1_g + c), bb = *(const f32x4*)(P.ln1_b + c), sh = *(const f32x4*)(ada + 3072 + c), sc = *(const f32x4*)(ada + 4096 + c);
            const f32x4 x1 = v[jx] * rstd * g + bb;
            *(f32x4*)(xr + 256 * jx) = x1;
            const f32x4 h2 = x1 * (sc + 1.0f) + sh;
            u32x2 w; w.x = cvt_pk_bf16(h2[0], h2[1]); w.y = cvt_pk_bf16(h2[2], h2[3]);
            *(u32x2*)(H + row * 1024 + c) = w;
            v[jx] = h2;
        }
        {
            float mx = 0.f;
#pragma unroll
            for (int jx = 0; jx < 4; ++jx) mx = fmaxf(mx, fmaxf(fmaxf(fabsf(v[jx][0]), fabsf(v[jx][1])), fmaxf(fabsf(v[jx][2]), fabsf(v[jx][3]))));
#pragma unroll
            for (int o = 1; o < 64; o <<= 1) mx = fmaxf(mx, __shfl_xor(mx, o));
            const float hs = fmaxf(mx * (1.0f / 127.0f), 1e-30f), inv = 1.0f / hs; int qs = 0;
#pragma unroll
            for (int jx = 0; jx < 4; ++jx) {
                const int q0 = (int)rintf(v[jx][0] * inv), q1 = (int)rintf(v[jx][1] * inv), q2 = (int)rintf(v[jx][2] * inv), q3 = (int)rintf(v[jx][3] * inv);
                qs += (q0 + q1) + (q2 + q3);
                *(unsigned*)(P.ws + OFF_H8 + row * 1024 + lane * 4 + 256 * jx) = (unsigned)(q0 & 255) | ((unsigned)(q1 & 255) << 8) | ((unsigned)(q2 & 255) << 16) | ((unsigned)(q3 & 255) << 24);
            }
#pragma unroll
            for (int o = 1; o < 64; o <<= 1) qs += __shfl_xor(qs, o);
            if (lane == 0) *(f32x2*)(P.ws + OFF_HS + row * 8) = (f32x2){hs, (float)qs};
        }
    }
}

#define CE16(A, i, j) do { const float hi_ = fmaxf(A[i], A[j]); A[j] = fminf(A[i], A[j]); A[i] = hi_; } while (0)
#define SORT16(A) do { CE16(A, 0, 1); CE16(A, 2, 3); CE16(A, 0, 2); CE16(A, 1, 3); CE16(A, 1, 2); CE16(A, 4, 5); CE16(A, 6, 7); CE16(A, 4, 6); CE16(A, 5, 7); CE16(A, 5, 6); CE16(A, 0, 4); CE16(A, 2, 6); CE16(A, 2, 4); CE16(A, 1, 5); CE16(A, 3, 7); CE16(A, 3, 5); CE16(A, 1, 2); CE16(A, 3, 4); CE16(A, 5, 6); CE16(A, 8, 9); CE16(A, 10, 11); CE16(A, 8, 10); CE16(A, 9, 11); CE16(A, 9, 10); CE16(A, 12, 13); CE16(A, 14, 15); CE16(A, 12, 14); CE16(A, 13, 15); CE16(A, 13, 14); CE16(A, 8, 12); CE16(A, 10, 14); CE16(A, 10, 12); CE16(A, 9, 13); CE16(A, 11, 15); CE16(A, 11, 13); CE16(A, 9, 10); CE16(A, 11, 12); CE16(A, 13, 14); CE16(A, 0, 8); CE16(A, 4, 12); CE16(A, 4, 8); CE16(A, 2, 10); CE16(A, 6, 14); CE16(A, 6, 10); CE16(A, 2, 4); CE16(A, 6, 8); CE16(A, 10, 12); CE16(A, 1, 9); CE16(A, 5, 13); CE16(A, 5, 9); CE16(A, 3, 11); CE16(A, 7, 15); CE16(A, 7, 11); CE16(A, 3, 5); CE16(A, 7, 9); CE16(A, 11, 13); CE16(A, 1, 2); CE16(A, 3, 4); CE16(A, 5, 6); CE16(A, 7, 8); CE16(A, 9, 10); CE16(A, 11, 12); CE16(A, 13, 14); } while (0)
#define BITONIC16(A) do { CE16(A, 0, 8); CE16(A, 1, 9); CE16(A, 2, 10); CE16(A, 3, 11); CE16(A, 4, 12); CE16(A, 5, 13); CE16(A, 6, 14); CE16(A, 7, 15); CE16(A, 0, 4); CE16(A, 1, 5); CE16(A, 2, 6); CE16(A, 3, 7); CE16(A, 8, 12); CE16(A, 9, 13); CE16(A, 10, 14); CE16(A, 11, 15); CE16(A, 0, 2); CE16(A, 1, 3); CE16(A, 4, 6); CE16(A, 5, 7); CE16(A, 8, 10); CE16(A, 9, 11); CE16(A, 12, 14); CE16(A, 13, 15); CE16(A, 0, 1); CE16(A, 2, 3); CE16(A, 4, 5); CE16(A, 6, 7); CE16(A, 8, 9); CE16(A, 10, 11); CE16(A, 12, 13); CE16(A, 14, 15); } while (0)
#define INS16(L, xin) do { float x_ = (xin); _Pragma("unroll") for (int k_ = 0; k_ < 16; ++k_) { const float hi_ = fmaxf(L[k_], x_); x_ = fminf(L[k_], x_); L[k_] = hi_; } } while (0)

__device__ void peer_select_wave(const Params& P, size_t tok0) {
    const int lane = tid_opaque() & 63, r32 = lane & 31, hi = lane >> 5;
    const bf16_t* QP = (const bf16_t*)(P.ws + OFF_GB) + (tok0 + r32) * 1024; const bf16_t* SK = (const bf16_t*)(P.ws + OFF_SK);
    u32x2* EG = (u32x2*)(P.ws + OFF_EG) + (tok0 + r32) * 128;
#pragma unroll 1
    for (int h = 0; h < 8; ++h) {
        float a0[16], a1[16];
#pragma unroll
        for (int k = 0; k < 16; ++k) { a0[k] = -INFINITY; a1[k] = -INFINITY; }
#pragma unroll 1
        for (int p = 0; p < 2; ++p) {
            const int hp = h * 2 + p;
            bf16x8 qf[4];
#pragma unroll
            for (int ks = 0; ks < 4; ++ks) qf[ks] = *(const bf16x8*)(QP + hp * 64 + 16 * ks + 8 * hi);
            float L[16];
#pragma unroll
            for (int kt = 0; kt < 4; ++kt) {
                f32x16 acc = {};
#pragma unroll
                for (int ks = 0; ks < 4; ++ks) { const bf16x8 kf = *(const bf16x8*)(SK + ((size_t)hp * 128 + 32 * kt + r32) * 64 + 16 * ks + 8 * hi); acc = MFMA32(kf, qf[ks], acc); }
                float S[16];
#pragma unroll
                for (int r = 0; r < 16; ++r) { const unsigned key = (unsigned)(32 * kt + crow(r, hi)); S[r] = __uint_as_float((__float_as_uint(acc[r]) & ~127u) | key); }
                SORT16(S);
                if (kt == 0) {
#pragma unroll
                    for (int k = 0; k < 16; ++k) L[k] = S[k];
                } else {
#pragma unroll
                    for (int k = 0; k < 16; ++k) L[k] = fmaxf(L[k], S[15 - k]);
                    BITONIC16(L);
                }
            }
            {
                float O[16];
#pragma unroll
                for (int k = 0; k < 16; ++k) O[k] = __shfl_xor(L[15 - k], 32);
#pragma unroll
                for (int k = 0; k < 16; ++k) L[k] = fmaxf(L[k], O[k]);
                BITONIC16(L);
            }
#pragma unroll
            for (int k = 0; k < 16; ++k) { a0[k] = (p == 0) ? L[k] : a0[k]; a1[k] = (p == 1) ? L[k] : a1[k]; }
        }
        float best[16];
#pragma unroll
        for (int k = 0; k < 16; ++k) best[k] = __uint_as_float((__float_as_uint(a0[0] + a1[k]) & ~255u) | (unsigned)k);
#pragma unroll
        for (int i = 1; i < 16; ++i)
#pragma unroll
            for (int jx = 0; jx < 16; ++jx)
                if ((i + 1) * (jx + 1) <= 16) {
                    const float cs = a0[i] + a1[jx];
                    const float cv = __uint_as_float((__float_as_uint(cs) & ~255u) | (unsigned)(i * 16 + jx));
                    INS16(best, cv);
                }
        unsigned pk0[4], pk1[4];
#pragma unroll
        for (int q = 0; q < 4; ++q) {
            pk0[q] = (__float_as_uint(a0[4 * q]) & 127u) | ((__float_as_uint(a0[4 * q + 1]) & 127u) << 8) | ((__float_as_uint(a0[4 * q + 2]) & 127u) << 16) | ((__float_as_uint(a0[4 * q + 3]) & 127u) << 24);
            pk1[q] = (__float_as_uint(a1[4 * q]) & 127u) | ((__float_as_uint(a1[4 * q + 1]) & 127u) << 8) | ((__float_as_uint(a1[4 * q + 2]) & 127u) << 16) | ((__float_as_uint(a1[4 * q + 3]) & 127u) << 24);
        }
        unsigned pay[16];
#pragma unroll
        for (int k = 0; k < 16; ++k) {
            const unsigned code = __float_as_uint(best[k]) & 255u, ci = code >> 4, cj = code & 15u;
            const unsigned qi = ci >> 2, qj = cj >> 2;
            const unsigned w0 = (qi == 0u) ? pk0[0] : ((qi == 1u) ? pk0[1] : ((qi == 2u) ? pk0[2] : pk0[3]));
            const unsigned w1 = (qj == 0u) ? pk1[0] : ((qj == 1u) ? pk1[1] : ((qj == 2u) ? pk1[2] : pk1[3]));
            pay[k] = (((w0 >> ((ci & 3u) * 8u)) & 127u) << 7) | ((w1 >> ((cj & 3u) * 8u)) & 127u);
        }
        float e[16], es = 0.f;
#pragma unroll
        for (int k = 0; k < 16; ++k) { e[k] = __expf(best[k] - best[0]); es += e[k]; }
        const float inv = 1.0f / es;
        if (hi == 0) {
#pragma unroll
            for (int k = 0; k < 16; ++k) { u32x2 w; w.x = pay[k]; w.y = __float_as_uint(e[k] * inv); EG[h * 16 + k] = w; }
        }
    }
}
__device__ __forceinline__ unsigned xcc_id() { return (unsigned)__builtin_amdgcn_s_getreg((3 << 11) | 20) & 0xFu; }
template <int CTRL> __device__ __forceinline__ float dpp_add(float x) { const int v = __builtin_amdgcn_update_dpp(0, __float_as_int(x), CTRL, 0xf, 0xf, true); return x + __int_as_float(v); }
__device__ __forceinline__ float wave_sum_fast(float x) {
    x = dpp_add<0xB1>(x); x = dpp_add<0x4E>(x); x = dpp_add<0x141>(x); x = dpp_add<0x140>(x);
    x += __shfl_xor(x, 16); x += __shfl_xor(x, 32); return x;
}
__device__ __forceinline__ float dot16_fp8(const float (&hv)[16], const u32x4 r) {
    float s = 0.f;
    { const f32x2 a = __builtin_amdgcn_cvt_pk_f32_fp8((int)r.x, false), b = __builtin_amdgcn_cvt_pk_f32_fp8((int)r.x, true); s += hv[0] * a.x + hv[1] * a.y + hv[2] * b.x + hv[3] * b.y; }
    { const f32x2 a = __builtin_amdgcn_cvt_pk_f32_fp8((int)r.y, false), b = __builtin_amdgcn_cvt_pk_f32_fp8((int)r.y, true); s += hv[4] * a.x + hv[5] * a.y + hv[6] * b.x + hv[7] * b.y; }
    { const f32x2 a = __builtin_amdgcn_cvt_pk_f32_fp8((int)r.z, false), b = __builtin_amdgcn_cvt_pk_f32_fp8((int)r.z, true); s += hv[8] * a.x + hv[9] * a.y + hv[10] * b.x + hv[11] * b.y; }
    { const f32x2 a = __builtin_amdgcn_cvt_pk_f32_fp8((int)r.w, false), b = __builtin_amdgcn_cvt_pk_f32_fp8((int)r.w, true); s += hv[12] * a.x + hv[13] * a.y + hv[14] * b.x + hv[15] * b.y; }
    return s;
}
template <int NP, class F> __device__ __forceinline__ void partition_queue(const Params& P, LAS unsigned char* lds, int ctr_base, F f) {
    const int tid = tid_opaque();
    LAS int* slot = (LAS int*)(lds + LDS_BYTES - 64);
    unsigned* ctr = (unsigned*)(P.ws + OFF_CTR) + ctr_base;
    const int myx = (int)(xcc_id() & 7u);
    for (int pp = 0; pp < NP; ++pp) {
        const int p = (myx * (NP / 8) + pp) % NP;
        for (;;) {
            if (tid == 0) *slot = (int)atomicAdd(ctr + p, 1u);
            __syncthreads();
            const int item = *slot;
            __syncthreads();
            if (item >= NTOK / 64) break;
            f(p, item);
        }
    }
}
__device__ __forceinline__ float dot2bf(unsigned a, bf16v2 b, float c) { return __builtin_amdgcn_fdot2_f32_bf16(__builtin_bit_cast(bf16v2, a), b, c, false); }
struct UQuad { u32x4 r[2]; u32x4 ent; };
__device__ __forceinline__ void uq_issue(UQuad& q, const LAS u32x4* list, int J, int NQ, int g, const unsigned char* U4) {
    const int jj = J < NQ ? J : NQ - 1;
    q.ent = list[4 * jj + g];
    const unsigned char* rp = U4 + (size_t)q.ent.x * 512;
    q.r[0] = *(const u32x4*)rp; q.r[1] = *(const u32x4*)(rp + 256);
}
__device__ __forceinline__ int dot8_i4(unsigned w, unsigned hlo, unsigned hhi, int acc) {
    acc = __builtin_amdgcn_sdot4((int)hlo, (int)(w & 0x0F0F0F0Fu), acc, false);
    return __builtin_amdgcn_sdot4((int)hhi, (int)((w >> 4) & 0x0F0F0F0Fu), acc, false);
}
__device__ __forceinline__ float uq_dot(const UQuad& q, const u32x4 (&hp)[4]) {
    int a = 0, b = 0;
#pragma unroll
    for (int c = 0; c < 2; ++c) {
        const u32x4 r = q.r[c];
        a = dot8_i4(r.x, hp[2 * c].x, hp[2 * c].y, a); b = dot8_i4(r.y, hp[2 * c].z, hp[2 * c].w, b);
        a = dot8_i4(r.z, hp[2 * c + 1].x, hp[2 * c + 1].y, a); b = dot8_i4(r.w, hp[2 * c + 1].z, hp[2 * c + 1].w, b);
    }
    float s = (float)(a + b);
    s = dpp_add<0xB1>(s); s = dpp_add<0x4E>(s); s = dpp_add<0x141>(s); s = dpp_add<0x140>(s);
    return s;
}
__device__ __forceinline__ void peer_u_tokens(const Params& P, LAS unsigned char* lds, const size_t t0) {
    const int tid = tid_opaque(), lane = tid & 63, wid = tid >> 6, g = lane >> 4, li = lane & 15;
    const unsigned char* H8 = P.ws + OFF_H8 + li * 32; const unsigned char* U4 = P.ws + OFF_U8 + li * 16;
    const f32x2* HS = (const f32x2*)(P.ws + OFF_HS); const float* USC = (const float*)(P.ws + OFF_USC);
    const u32x4* EG4 = (const u32x4*)(P.ws + OFF_EG); float* W = (float*)(P.ws + OFF_W);
    LAS u32x4* list = (LAS u32x4*)(lds + wid * 16384);
#pragma unroll 2
    for (int i = 0; i < 8; ++i) {
        const u32x4 eg = EG4[(t0 + i) * 64 + lane];
        list[i * 128 + 2 * lane] = (u32x4){eg.x, eg.y, (unsigned)(2 * lane) | (unsigned)(i << 8), __float_as_uint(USC[eg.x])};
        list[i * 128 + 2 * lane + 1] = (u32x4){eg.z, eg.w, (unsigned)(2 * lane + 1) | (unsigned)(i << 8), __float_as_uint(USC[eg.z])};
    }
    constexpr int NQ = 256;
    u32x4 hp[4], hn[4]; f32x2 hsc = HS[t0], hsn = HS[t0 + 1];
#pragma unroll
    for (int c = 0; c < 2; ++c) { hp[2 * c] = *(const u32x4*)(H8 + t0 * 1024 + 512 * c); hp[2 * c + 1] = *(const u32x4*)(H8 + t0 * 1024 + 512 * c + 16);
                                  hn[2 * c] = *(const u32x4*)(H8 + (t0 + 1) * 1024 + 512 * c); hn[2 * c + 1] = *(const u32x4*)(H8 + (t0 + 1) * 1024 + 512 * c + 16); }
    int curtok = 0;
    UQuad q0, q1, q2, q3;
    uq_issue(q0, list, 0, NQ, g, U4); uq_issue(q1, list, 1, NQ, g, U4); uq_issue(q2, list, 2, NQ, g, U4); uq_issue(q3, list, 3, NQ, g, U4);
#define UQ_STEP(q, Jn) do { \
        const int tk = __builtin_amdgcn_readfirstlane((int)(q.ent.z >> 8)); \
        if (tk != curtok) { curtok = tk; _Pragma("unroll") for (int c = 0; c < 4; ++c) hp[c] = hn[c]; hsc = hsn; \
            if (tk + 1 < 8) { hsn = HS[t0 + tk + 1]; _Pragma("unroll") for (int c = 0; c < 2; ++c) { hn[2 * c] = *(const u32x4*)(H8 + (t0 + tk + 1) * 1024 + 512 * c); hn[2 * c + 1] = *(const u32x4*)(H8 + (t0 + tk + 1) * 1024 + 512 * c + 16); } } } \
        const float s = __uint_as_float(q.ent.w) * hsc.x * (uq_dot(q, hp) - 7.5f * hsc.y); \
        if (li == 0) W[(t0 + tk) * 128 + (q.ent.z & 255u)] = __uint_as_float(q.ent.y) * 0.5f * s * (1.0f + erff(s * 0.70710678118654752f)); \
        uq_issue(q, list, (Jn), NQ, g, U4); } while (0)
#pragma unroll 1
    for (int J = 0; J < NQ; J += 4) { UQ_STEP(q0, J + 4); UQ_STEP(q1, J + 5); UQ_STEP(q2, J + 6); UQ_STEP(q3, J + 7); }
#undef UQ_STEP
}
typedef int v4i_t __attribute__((ext_vector_type(4)));
struct VQuad { u32x4 r[2]; u32x2 ent; };
__device__ __forceinline__ void vq_issue(VQuad& q, const LAS u32x2* list, int J, int g, const unsigned char* V4) {
    const int jj = J < 32 ? J : 31;
    q.ent = list[4 * jj + g];
    const unsigned char* rp = V4 + (size_t)q.ent.x * 512;
    q.r[0] = *(const u32x4*)rp; q.r[1] = *(const u32x4*)(rp + 256);
}
__device__ __forceinline__ void vq_mma(const VQuad& q, v4i_t (&acc)[4], const unsigned sh, const u32x4 bm, const bool live) {
    const unsigned t = live ? ((q.ent.y & 255u) << sh) : 0u;
    const v4i_t B = {(int)(t & bm.x), (int)(t & bm.y), (int)(t & bm.z), (int)(t & bm.w)};
#pragma unroll
    for (int c = 0; c < 2; ++c) {
        const u32x4 r = q.r[c];
        const v4i_t lo = {(int)(r.x & 0x0F0F0F0Fu), (int)(r.y & 0x0F0F0F0Fu), (int)(r.z & 0x0F0F0F0Fu), (int)(r.w & 0x0F0F0F0Fu)};
        const v4i_t hi = {(int)((r.x >> 4) & 0x0F0F0F0Fu), (int)((r.y >> 4) & 0x0F0F0F0Fu), (int)((r.z >> 4) & 0x0F0F0F0Fu), (int)((r.w >> 4) & 0x0F0F0F0Fu)};
        acc[2 * c] = __builtin_amdgcn_mfma_i32_16x16x64_i8(lo, B, acc[2 * c], 0, 0, 0);
        acc[2 * c + 1] = __builtin_amdgcn_mfma_i32_16x16x64_i8(hi, B, acc[2 * c + 1], 0, 0, 0);
    }
}
__device__ __forceinline__ void peer_v_tokens(const Params& P, LAS unsigned char* lds, const size_t t0) {
    const int tid = tid_opaque(), lane = tid & 63, wid = tid >> 6, g = lane >> 4, li = lane & 15;
    const unsigned char* V4 = P.ws + OFF_V8 + li * 16; const float* VSC = (const float*)(P.ws + OFF_VSC);
    const u32x4* EG4 = (const u32x4*)(P.ws + OFF_EG); const f32x2* W2 = (const f32x2*)(P.ws + OFF_W);
    LAS u32x2* lists = (LAS u32x2*)(lds + wid * 8192);
    float swv[8], yoffv[8];
#pragma unroll
    for (int i = 0; i < 8; ++i) { const u32x4 eg = EG4[(t0 + i) * 64 + lane]; const f32x2 ww = W2[(t0 + i) * 64 + lane];
        const float w0 = ww.x * VSC[eg.x], w1 = ww.y * VSC[eg.z];
        float mx = fmaxf(fabsf(w0), fabsf(w1));
#pragma unroll
        for (int o = 1; o < 64; o <<= 1) mx = fmaxf(mx, __shfl_xor(mx, o));
        const float sw = fmaxf(mx * (1.0f / 127.0f), 1e-30f), inv = 1.0f / sw;
        const int q0 = (int)rintf(w0 * inv), q1 = (int)rintf(w1 * inv);
        *(LAS u32x4*)(lists + i * 128 + 2 * lane) = (u32x4){eg.x, (unsigned)q0, eg.z, (unsigned)q1};
        int qs = q0 + q1;
#pragma unroll
        for (int o = 1; o < 64; o <<= 1) qs += __shfl_xor(qs, o);
        swv[i] = sw; yoffv[i] = 7.5f * sw * (float)qs; }
    const unsigned sh = 8u * (unsigned)(li & 3);
    const u32x4 bm = {(li >> 2) == 0 ? 0xFFFFFFFFu : 0u, (li >> 2) == 1 ? 0xFFFFFFFFu : 0u, (li >> 2) == 2 ? 0xFFFFFFFFu : 0u, (li >> 2) == 3 ? 0xFFFFFFFFu : 0u};
#pragma unroll
    for (int i = 0; i < 8; ++i) {
        const size_t t = t0 + i;
        const LAS u32x2* list = lists + i * 128;
        v4i_t acc[4];
#pragma unroll
        for (int j = 0; j < 4; ++j) acc[j] = (v4i_t){0, 0, 0, 0};
        VQuad q0, q1, q2, q3;
        vq_issue(q0, list, 0, g, V4); vq_issue(q1, list, 1, g, V4); vq_issue(q2, list, 2, g, V4); vq_issue(q3, list, 3, g, V4);
#pragma unroll 1
        for (int J = 0; J < 32; J += 4) {
            vq_mma(q0, acc, sh, bm, true); vq_issue(q0, list, J + 4, g, V4);
            vq_mma(q1, acc, sh, bm, true); vq_issue(q1, list, J + 5, g, V4);
            vq_mma(q2, acc, sh, bm, true); vq_issue(q2, list, J + 6, g, V4);
            vq_mma(q3, acc, sh, bm, true); vq_issue(q3, list, J + 7, g, V4);
        }
        const float sw = swv[i], yoff = yoffv[i];
        const int dbase = 128 * g + 8 * (li >> 2) + (li & 3);
        const float* gt2 = (const float*)(P.ws + OFF_ADA) + (t >> 11) * 6144 + 5120;
        float* xr = P.out + t * 1024;
        float pre[16]; float s = 0.f;
#pragma unroll
        for (int c = 0; c < 2; ++c)
#pragma unroll
            for (int hf = 0; hf < 2; ++hf)
#pragma unroll
                for (int r = 0; r < 4; ++r) { const int d = dbase + 512 * c + 32 * r + 4 * hf;
                    const float yv = sw * (float)acc[2 * c + hf][r] - yoff;
                    const float pv = ALPHA * xr[d] + gt2[d] * yv; pre[8 * c + 4 * hf + r] = pv; s += pv; }
        const float mean = wave_sum(s) * (1.0f / 1024.0f); float s2 = 0.f;
#pragma unroll
        for (int e = 0; e < 16; ++e) { pre[e] -= mean; s2 += pre[e] * pre[e]; }
        const float rstd = rsqrtf(wave_sum(s2) * (1.0f / 1024.0f) + LN_EPS);
#pragma unroll
        for (int c = 0; c < 2; ++c)
#pragma unroll
            for (int hf = 0; hf < 2; ++hf)
#pragma unroll
                for (int r = 0; r < 4; ++r) { const int d = dbase + 512 * c + 32 * r + 4 * hf;
                    xr[d] = pre[8 * c + 4 * hf + r] * rstd * P.ln2_g[d] + P.ln2_b[d]; }
    }
}

#define XB_TMO      128
#define XB_XCNT(j)  (256  + 64 * (j))
#define XB_XSUB(j)  (1280 + 64 * (j))
#define XB_XGEN(j)  (2304 + 64 * (j))
#define XB_TOP      3328
#define XB_TOPGEN   3392
#define XCD_BAR_WORDS 3456
#define XB_SPIN_CAP (1u << 22)
__device__ __forceinline__ unsigned xb_ld(unsigned* p)              { return __hip_atomic_load(p, __ATOMIC_RELAXED, __HIP_MEMORY_SCOPE_AGENT); }
__device__ __forceinline__ unsigned xb_add(unsigned* p, unsigned v) { return __hip_atomic_fetch_add(p, v, __ATOMIC_RELAXED, __HIP_MEMORY_SCOPE_AGENT); }
#define XB_SPIN(cond, bar) do { unsigned _sp = 0; while (cond) { __builtin_amdgcn_s_sleep(1); \
    if ((++_sp & 255u) == 0u) { if (xb_ld(&(bar)[XB_TMO])) break; if (_sp > XB_SPIN_CAP) { atomicAdd(&(bar)[XB_TMO], 1u); break; } } } } while (0)
struct XcdBarrier { unsigned* bar; unsigned x; volatile LAS unsigned* st; };
__device__ __forceinline__ XcdBarrier xcd_barrier_post(unsigned* bar, volatile LAS unsigned* st) {
    XcdBarrier b; b.bar = bar; b.x = xcc_id(); b.st = st;
    if (threadIdx.x == 0) (void)xb_add(&bar[XB_XCNT(b.x)], 1u);
    return b;
}
__device__ __forceinline__ void xcd_barrier_complete(unsigned* bar, unsigned x, unsigned& nloc, unsigned& nx) {
    const unsigned G = gridDim.x * gridDim.y * gridDim.z;
    unsigned sum, cnt, mine, sp = 0u;
    for (;;) {
        sum = 0u; cnt = 0u; mine = 0u;
#pragma unroll
        for (unsigned j = 0; j < 16; ++j) { const unsigned c = xb_ld(&bar[XB_XCNT(j)]); sum += c; cnt += (c > 0u) ? 1u : 0u; mine = (j == x) ? c : mine; }
        if (sum == G) break;
        __builtin_amdgcn_s_sleep(1);
        if ((++sp & 255u) == 0u) { if (xb_ld(&bar[XB_TMO])) break; if (sp > XB_SPIN_CAP) { atomicAdd(&bar[XB_TMO], 1u); break; } }
    }
    nloc = mine > 0u ? mine : 1u; nx = cnt > 0u ? cnt : 1u;
}
__device__ __forceinline__ void xcd_barrier(const XcdBarrier& b) {
    asm volatile("s_waitcnt vmcnt(0)" ::: "memory");
    __syncthreads();
    if (threadIdx.x == 0) {
        unsigned* bar = b.bar;
        __builtin_amdgcn_s_waitcnt(0);
        unsigned nloc = b.st[0], nx = b.st[1];
        if (nloc == 0u) { xcd_barrier_complete(bar, b.x, nloc, nx); b.st[0] = nloc; b.st[1] = nx; }
        const unsigned old = xb_add(&bar[XB_XSUB(b.x)], 1u);
        const unsigned gen = old / nloc;
        if (old + 1u == (gen + 1u) * nloc) {
            __builtin_amdgcn_fence(__ATOMIC_RELEASE, "agent");
            asm volatile("s_waitcnt vmcnt(0)" ::: "memory");
            const unsigned og = xb_add(&bar[XB_TOP], 1u);
            const unsigned tg = og / nx;
            if (og + 1u == (tg + 1u) * nx) xb_add(&bar[XB_TOPGEN], 1u);
            else XB_SPIN(xb_ld(&bar[XB_TOPGEN]) == tg, bar);
            __builtin_amdgcn_fence(__ATOMIC_ACQUIRE, "agent");
            xb_add(&bar[XB_XGEN(b.x)], 1u);
            asm volatile("s_waitcnt vmcnt(0)" ::: "memory");
        } else {
            XB_SPIN(xb_ld(&bar[XB_XGEN(b.x)]) == gen, bar);
            __builtin_amdgcn_fence(__ATOMIC_ACQUIRE, "agent");
            asm volatile("s_waitcnt vmcnt(0)" ::: "memory");
        }
    }
    __syncthreads();
}

__global__ void __launch_bounds__(NTHR, 2) fwd_megakernel(Params P) {
    extern __shared__ __attribute__((aligned(16))) unsigned char shm[];
    LAS unsigned char* lds = (LAS unsigned char*)shm;
    cg::grid_group grid = cg::this_grid();
    const int G = gridDim.x, bid = blockIdx.x;
    volatile LAS unsigned* xst = (volatile LAS unsigned*)(lds + LDS_BYTES - 128);
    if (threadIdx.x == 0) { xst[0] = 0u; xst[1] = 0u; }
    __syncthreads();
    const XcdBarrier xb = xcd_barrier_post((unsigned*)(P.ws + OFF_BAR), xst);

#ifndef P3
#define P3 0xff
#endif
#ifndef PH
#define PH 0xff
#endif
    if (PH & 1) phase0a(P, lds);
    grid.sync();
    if (PH & 2) phase0b(P);
    xcd_barrier(xb);
    if (PH & 4) {
        pg8::Gemm g; g.A = (const bf16_t*)(P.ws + OFF_H); g.Bt = (const bf16_t*)(P.ws + OFF_WIN); g.M = NTOK; g.N = INCOLS; { int k_ = 512; asm volatile("" : "+s"(k_)); g.K = k_; g.lda = k_; }
        pg8::StaticOrder S; S.init(NTOK, INCOLS, G, bid);
        EpiProj E; E.ws = P.ws; E.lb = (const float*)(P.ws + OFF_LB); E.ng = P.hgrn_ng; E.kmean = (float*)(P.ws + OFF_KMEAN);
        pg8::gemm_phase<EpiProj, pg8::StaticOrder, true>(lds, g, S, E);
    }
    xcd_barrier(xb);
    if (PH & 8) for (int it = bid; it < 256; it += G) hgrn_item(P, it, lds);
    if (PH & 16) for (int u = bid; u < 2048; u += G) { const int bh = u & 255, jj = u >> 8; moba_unit(P, bh >> 3, bh & 7, (jj + bh) & 7, lds); }
    xcd_barrier(xb);
    if ((PH & 32) && bid < NTOK / 256) { const int pm = bid;
        if (P3 & 1) yb_norm_panel(P, pm);
        __syncthreads();
        if (P3 & 2) { pg8::Gemm g; g.A = (const bf16_t*)(P.ws + OFF_EG); g.Bt = (const bf16_t*)(P.ws + OFF_WBA); g.M = NTOK; g.N = 1024; { int k_ = 256; asm volatile("" : "+s"(k_)); g.K = k_; } g.lda = 512;
          pg8::PanelOrder S; S.pm = pm; S.npn = 4; EpiMixA E; E.GA = (bf16_t*)(P.ws + OFF_GA);
          pg8::gemm_phase<EpiMixA, pg8::PanelOrder, true>(lds, g, S, E); }
        __syncthreads();
        if (P3 & 4) { pg8::Gemm g; g.A = (const bf16_t*)(P.ws + OFF_EG + 512); g.Bt = (const bf16_t*)(P.ws + OFF_WBB); g.M = NTOK; g.N = 1024; { int k_ = 256; asm volatile("" : "+s"(k_)); g.K = k_; } g.lda = 512;
          pg8::PanelOrder S; S.pm = pm; S.npn = 4; EpiMixB E; E.GA = (const bf16_t*)(P.ws + OFF_GA); E.GB = (const bf16_t*)(P.ws + OFF_GB); E.M8 = P.ws + OFF_QA;
          pg8::gemm_phase<EpiMixB, pg8::PanelOrder, true>(lds, g, S, E); }
        __syncthreads();
        if (P3 & 8) { pg8::Gemm g; g.A = (const bf16_t*)(P.ws + OFF_QA); g.Bt = (const bf16_t*)(P.ws + OFF_WOUT); g.M = NTOK; g.N = 1024; { int k_ = 512; asm volatile("" : "+s"(k_)); g.K = k_; g.lda = k_; }
          pg8::PanelOrder S; S.pm = pm; S.npn = 4; EpiOut E; E.ada = (const float*)(P.ws + OFF_ADA); E.D = (bf16_t*)(P.ws + OFF_GB);
          pg8::gemm_phase<EpiOut, pg8::PanelOrder, true>(lds, g, S, E); }
        __syncthreads();
        if (P3 & 16) ln1_panel(P, pm);
        __syncthreads();
        if (P3 & 32) { pg8::Gemm g; g.A = (const bf16_t*)(P.ws + OFF_H); g.Bt = (const bf16_t*)(P.ws + OFF_WQ); g.M = NTOK; g.N = 1024; g.K = 1024; g.lda = 1024;
          pg8::PanelOrder S; S.pm = pm; S.npn = 4; EpiBf16 E; E.O = (bf16_t*)(P.ws + OFF_GB);
          pg8::gemm_phase<EpiBf16, pg8::PanelOrder>(lds, g, S, E); }
        __syncthreads();
        { const size_t tok0 = (size_t)pm * 256 + (tid_opaque() >> 6) * 32;
          peer_select_wave(P, tok0);
          __syncthreads();
#pragma unroll 1
          for (int sb = 0; sb < 4; ++sb) {
              peer_u_tokens(P, lds, tok0 + 8 * sb);
              __syncthreads();
              peer_v_tokens(P, lds, tok0 + 8 * sb);
              __syncthreads();
          } }
    }
}

extern "C" void kernel_launch(void* const* d_in, const int* in_sizes, int n_in, void* d_out, int out_size, void* d_ws, size_t ws_size, hipStream_t stream) {
    static int grid_blocks = 0;
    if (grid_blocks == 0) {
        if (n_in != 18 || out_size != NTOK * DM || ws_size < WS_END) { fprintf(stderr, "kernel_launch: unexpected shapes (n_in %d, out %d, ws %zu, need %zu)\n", n_in, out_size, ws_size, (size_t)WS_END); grid_blocks = -1; return; }
        int dev = 0, cus = 0, per_cu = 0;
        hipGetDevice(&dev);
        hipDeviceGetAttribute(&cus, hipDeviceAttributeMultiprocessorCount, dev);
        if (hipFuncSetAttribute((const void*)fwd_megakernel, hipFuncAttributeMaxDynamicSharedMemorySize, LDS_BYTES) != hipSuccess) fprintf(stderr, "kernel_launch: hipFuncSetAttribute failed\n");
        hipOccupancyMaxActiveBlocksPerMultiprocessor(&per_cu, (const void*)fwd_megakernel, NTHR, LDS_BYTES);
        if (per_cu < 1) { fprintf(stderr, "kernel_launch: occupancy query says %d blocks per CU\n", per_cu); per_cu = 1; }
        if (per_cu > 1) per_cu = 1;
        grid_blocks = cus * per_cu;
        if (grid_blocks != NTOK / 256) { fprintf(stderr, "kernel_launch: built for a %d-CU device (one 256-token panel per workgroup), found %d\n", NTOK / 256, grid_blocks); grid_blocks = -1; return; }
        (void)hipGetLastError();
    }
    if (grid_blocks < 0) return;
    Params p{};
    p.x = (const float*)d_in[0]; p.c = (const float*)d_in[1]; p.w_ada = (const float*)d_in[2]; p.b_ada = (const float*)d_in[3]; p.w_in = (const float*)d_in[4];
    p.w_ba = (const float*)d_in[5]; p.w_bb = (const float*)d_in[6]; p.w_out = (const float*)d_in[7]; p.hgrn_lb = (const float*)d_in[8]; p.hgrn_ng = (const float*)d_in[9];
    p.ln1_g = (const float*)d_in[10]; p.ln1_b = (const float*)d_in[11]; p.peer_wq = (const float*)d_in[12]; p.peer_sk = (const float*)d_in[13]; p.peer_u = (const float*)d_in[14];
    p.peer_v = (const float*)d_in[15]; p.ln2_g = (const float*)d_in[16]; p.ln2_b = (const float*)d_in[17];
    p.out = (float*)d_out; p.ws = (unsigned char*)d_ws;
    if (hipMemsetAsync((char*)d_ws + OFF_BAR, 0, XCD_BAR_WORDS * 4, stream) != hipSuccess) fprintf(stderr, "kernel_launch: memset of the barrier words failed\n");
    void* args[] = {&p};
    hipError_t e = hipLaunchCooperativeKernel((const void*)fwd_megakernel, dim3(grid_blocks), dim3(NTHR), args, LDS_BYTES, stream);
    if (e != hipSuccess) fprintf(stderr, "cooperative launch failed: %s (grid %d)\n", hipGetErrorString(e), grid_blocks);
}
```

```cpp
#include <hip/hip_runtime.h>
#include <hip/hip_cooperative_groups.h>
#include <cstdio>
#include <cstdint>
#include <type_traits>
namespace cg = cooperative_groups;

#define LAS __attribute__((address_space(3)))
typedef unsigned short bf16_t;
typedef short bf16x8 __attribute__((ext_vector_type(8)));
typedef short s16x4 __attribute__((ext_vector_type(4)));
typedef float f32x2 __attribute__((ext_vector_type(2)));
typedef float f32x4 __attribute__((ext_vector_type(4)));
typedef float f32x16 __attribute__((ext_vector_type(16)));
typedef unsigned u32x2 __attribute__((ext_vector_type(2)));
typedef unsigned u32x4 __attribute__((ext_vector_type(4)));

constexpr int NB = 32, SEQ = 2048, DM = 1024, NTOK = NB * SEQ;
constexpr int INCOLS = 5632;
constexpr int NTHR = 512;
constexpr int LDS_BYTES = 147456;
constexpr float ALPHA = 1.189207115002721f;
constexpr float LN_EPS = 1e-5f, RMS_EPS = 1e-6f;
constexpr float LOG2E = 1.4426950408889634f;

constexpr size_t SZ_T512 = (size_t)NTOK * 512 * 2, SZ_T1024 = (size_t)NTOK * 1024 * 2;
constexpr size_t OFF_ADA = 0;
constexpr size_t OFF_LB = OFF_ADA + 786432;
constexpr size_t OFF_KMEAN = OFF_LB + 4096;
constexpr size_t OFF_WIN = OFF_KMEAN + 524288;
constexpr size_t OFF_WBA = OFF_WIN + (size_t)5632 * 1024 * 2;
constexpr size_t OFF_WBB = OFF_WBA + 1048576;
constexpr size_t OFF_WOUT = OFF_WBB + 1048576;
constexpr size_t OFF_WQ = OFF_WOUT + 2097152;
constexpr size_t OFF_SK = OFF_WQ + 2097152;
constexpr size_t OFF_U8 = OFF_SK + 262144;
constexpr size_t OFF_USC = OFF_U8 + 8388608;
constexpr size_t OFF_V8 = OFF_U8 + 16777216;
constexpr size_t OFF_VSC = OFF_V8 + 8388608;
constexpr size_t OFF_CTR = OFF_V8 + 16777216;
constexpr size_t OFF_BAR = OFF_CTR + 4096;
constexpr size_t OFF_EG = OFF_BAR + 16384;
constexpr size_t OFF_H = OFF_EG + (size_t)NTOK * 128 * 8;
constexpr size_t OFF_QA = OFF_H + SZ_T1024;
constexpr size_t OFF_KA = OFF_QA + SZ_T512;
constexpr size_t OFF_VA = OFF_KA + SZ_T512;
constexpr size_t OFF_HQ = OFF_VA + SZ_T512;
constexpr size_t OFF_HK = OFF_HQ + SZ_T512;
constexpr size_t OFF_HI = OFF_HK + SZ_T512;
constexpr size_t OFF_HG = OFF_HI + SZ_T512;
constexpr size_t OFF_GA = OFF_HG + SZ_T512;
constexpr size_t OFF_GB = OFF_GA + SZ_T1024;
constexpr size_t WS_END = OFF_GB + SZ_T1024;
constexpr size_t OFF_H8 = OFF_VA;
constexpr size_t OFF_HS = OFF_HQ;
constexpr size_t OFF_W = OFF_KA;
constexpr size_t OFF_Y = OFF_KA;

struct Params {
    const float *x, *c, *w_ada, *b_ada, *w_in, *w_ba, *w_bb, *w_out, *hgrn_lb, *hgrn_ng, *ln1_g, *ln1_b, *peer_wq, *peer_sk, *peer_u, *peer_v, *ln2_g, *ln2_b;
    float* out;
    unsigned char* ws;
};

typedef __bf16 bf16v2 __attribute__((ext_vector_type(2)));
__device__ __forceinline__ unsigned cvt_pk_bf16(float lo, float hi) { return __builtin_bit_cast(unsigned, __builtin_convertvector((f32x2){lo, hi}, bf16v2)); }
__device__ __forceinline__ float bf_lo(unsigned w) { return __uint_as_float(w << 16); }
__device__ __forceinline__ float bf_hi(unsigned w) { return __uint_as_float(w & 0xffff0000u); }
__device__ __forceinline__ float sigmoidf_(float x) { return 1.0f / (1.0f + __expf(-x)); }
__device__ __forceinline__ float wave_sum(float v) {
#pragma unroll
    for (int o = 1; o < 64; o <<= 1) v += __shfl_xor(v, o);
    return v;
}
__device__ __forceinline__ int tid_opaque() { int t = threadIdx.x; asm volatile("" : "+v"(t)); return t; }
__device__ __forceinline__ int crow(int r, int hi) { return (r & 3) + 8 * (r >> 2) + 4 * hi; }
#define MFMA32(a, b, c) __builtin_amdgcn_mfma_f32_32x32x16_bf16(a, b, c, 0, 0, 0)

namespace pg8 {
constexpr int BM = 256, BK = 64, HALF = 128, HTB = HALF * BK * 2, STAGE_BYTES = 8 * HTB, NXCD = 8, WGM = 8;
__host__ __device__ __forceinline__ int lds_byte(int r, int c) { const int st = (r >> 4) * 2 + (c >> 5), rr = r & 15, cc = c & 31, ob = rr * 64 + cc * 2; return st * 1024 + (ob ^ (((ob >> 9) & 1) << 5)); }
__host__ __device__ __forceinline__ void stage_rc(int b, int& R, int& C) { const int st = b / 1024, sb = b % 1024, swz = sb ^ (((sb >> 9) & 1) << 5); R = (st >> 1) * 16 + swz / 64; C = (st & 1) * 32 + (swz % 64) / 2; }
__host__ __device__ __forceinline__ int perm32(int rho) { const int n = rho >> 4, i = rho & 15; return 8 * (i >> 2) + 4 * n + (i & 3); }

struct Unit { int pm, pn; };
struct Gemm { const bf16_t* A; const bf16_t* Bt; int M, N, K, lda; };

struct StaticOrder {
    int nM, nN, nwg, G, c;
    __device__ void init(int M, int N, int G_, int c_) { nM = M / BM; nN = N / BM; nwg = nM * nN; G = G_; c = c_; }
    __device__ bool next(int i, Unit& u) const {
        const long L = (long)i * G + c; if (L >= nwg) return false;
        int wgid = (int)L; { const int q = nwg / NXCD, r = nwg % NXCD, xcd = wgid % NXCD, off = wgid / NXCD; wgid = (xcd < r ? xcd * (q + 1) : r * (q + 1) + (xcd - r) * q) + off; }
        const int nig = WGM * nN, gid = wgid / nig, fm = gid * WGM, gsz = (nM - fm) < WGM ? (nM - fm) : WGM;
        u.pm = fm + ((wgid % nig) % gsz); u.pn = (wgid % nig) / gsz; return true;
    }
};
struct PanelOrder {
    int pm, npn;
    __device__ bool next(int i, Unit& u) const { if (i >= npn) return false; u.pm = pm; u.pn = i; return true; }
};

template <class Epi, class Sched, bool MX = false>
__device__ __forceinline__ void gemm_phase(LAS unsigned char* lds, const Gemm g, const Sched& S, const Epi& E) {
    const int tid = tid_opaque(), wid = __builtin_amdgcn_readfirstlane(tid >> 6), lane = tid & 63, wr = wid >> 2, wc = wid & 3, fr = lane & 15, fq = lane >> 4;
    const int K = g.K, nt = K / BK;
    unsigned voffA, voffB;
    { int R, C; stage_rc(tid * 16, R, C); const int Rb = Epi::PERM ? ((R & ~31) + perm32(R & 31)) : R;
      voffA = (unsigned)(R * g.lda + C) * 2u; voffB = (unsigned)(Rb * K + C) * 2u; }
    const size_t rvoffA = (size_t)128 * g.lda, rvoffB = (size_t)128 * K;
    const size_t kstep = (size_t)(BK * 2);
    const size_t hstep = (size_t)HALF * K * 2;
    const size_t tstep = 2 * hstep;
    const size_t hstepA = (size_t)HALF * g.lda * 2, tstepA = 2 * hstepA;
    const unsigned ldsw = (unsigned)wid * 1024u;
    const int aoff = lds_byte(wr * 64 + fr, fq * 8), boff = lds_byte(wc * 32 + fr, fq * 8);
#define PG8_SA(b, h) (((b) * 2 + (h)) * HTB)
#define PG8_SB(b, h) ((4 + (b) * 2 + (h)) * HTB)
#define PG8_STAGE(bufoff, gbase, voff) do { unsigned vo_ = (voff); asm volatile("" : "+v"(vo_));     \
        _Pragma("unroll") for (int _i = 0; _i < 2; ++_i) \
        __builtin_amdgcn_global_load_lds((const unsigned*)((const char*)(gbase) + _i * r##voff + vo_), (LAS unsigned*)(lds + (bufoff) + ldsw + _i * 8192), 16, 0, 0); } while (0)
#define PG8_LDX(dst, off) do { const v4i_ lo_ = *(const LAS v4i_*)(lds + (off)), hi_ = *(const LAS v4i_*)(lds + (off) + 1024); dst = __builtin_shufflevector(lo_, hi_, 0, 1, 2, 3, 4, 5, 6, 7); } while (0)
#define PG8_LDA(dst, b, h) do { if constexpr (MX) { _Pragma("unroll") for (int m = 0; m < 4; ++m) PG8_LDX(dst##X[m], PG8_SA(b, h) + aoff + m * 2048); } \
        else { _Pragma("unroll") for (int m = 0; m < 4; ++m) _Pragma("unroll") for (int k = 0; k < 2; ++k) dst[m][k] = *(const LAS bf16x8*)(lds + PG8_SA(b, h) + aoff + m * 2048 + k * 1024); } } while (0)
#define PG8_LDB(dst, b, h) do { if constexpr (MX) { _Pragma("unroll") for (int n = 0; n < 2; ++n) PG8_LDX(dst##X[n], PG8_SB(b, h) + boff + n * 2048); } \
        else { _Pragma("unroll") for (int n = 0; n < 2; ++n) _Pragma("unroll") for (int k = 0; k < 2; ++k) dst[n][k] = *(const LAS bf16x8*)(lds + PG8_SB(b, h) + boff + n * 2048 + k * 1024); } } while (0)
#define PG8_MMA(ai, bj, At, Bt) do { __builtin_amdgcn_s_setprio(1); \
        if constexpr (MX) { _Pragma("unroll") for (int m = 0; m < 4; ++m) _Pragma("unroll") for (int n = 0; n < 2; ++n) \
            asm volatile("v_mfma_scale_f32_16x16x128_f8f6f4 %0, %1, %2, %0, %3, %3 op_sel_hi:[0,0,0]" : "+v"(acc[ai][bj][m][n]) : "v"(Bt##X[n]), "v"(At##X[m]), "v"(mxscale)); } \
        else { _Pragma("unroll") for (int m = 0; m < 4; ++m) _Pragma("unroll") for (int n = 0; n < 2; ++n) _Pragma("unroll") for (int k = 0; k < 2; ++k) \
            acc[ai][bj][m][n] = __builtin_amdgcn_mfma_f32_16x16x32_bf16(Bt[n][k], At[m][k], acc[ai][bj][m][n], 0, 0, 0); } \
        __builtin_amdgcn_s_setprio(0); } while (0)
#define PG8_WAIT_V(n) asm volatile("s_waitcnt vmcnt(" #n ")" ::: "memory")
#define PG8_WAIT_L(n) asm volatile("s_waitcnt lgkmcnt(" #n ")" ::: "memory")
#define PG8_BAR __builtin_amdgcn_s_barrier()
#define PG8_SCHED __builtin_amdgcn_sched_barrier(0)
    Unit cur, nxt; int ui = 0;
    if (!S.next(0, cur)) return;
    f32x4 acc[2][2][4][2];
#pragma unroll
    for (int a = 0; a < 2; ++a)
#pragma unroll
        for (int b = 0; b < 2; ++b)
#pragma unroll
            for (int m = 0; m < 4; ++m)
#pragma unroll
                for (int n = 0; n < 2; ++n) acc[a][b][m][n] = (f32x4){0.f, 0.f, 0.f, 0.f};
    typedef int v4i_ __attribute__((ext_vector_type(4))); typedef int v8i_ __attribute__((ext_vector_type(8)));
    bf16x8 At[4][2], B0[2][2], B1[2][2];
    v8i_ AtX[4], B0X[2], B1X[2];
    const int mxscale = 0x7f7f7f7f;
    const char* cA = (const char*)g.A + (size_t)cur.pm * tstepA; const char* cB = (const char*)g.Bt + (size_t)cur.pn * tstep;
    PG8_STAGE(PG8_SB(0, 0), cB, voffB); PG8_STAGE(PG8_SA(0, 0), cA, voffA); PG8_STAGE(PG8_SB(0, 1), cB + hstep, voffB); PG8_STAGE(PG8_SA(0, 1), cA + hstepA, voffA);
    if (wr == 1) PG8_BAR;
    PG8_WAIT_V(4); PG8_BAR;
    PG8_STAGE(PG8_SB(1, 0), cB + kstep, voffB); PG8_STAGE(PG8_SA(1, 0), cA + kstep, voffA); PG8_STAGE(PG8_SB(1, 1), cB + hstep + kstep, voffB);
    PG8_WAIT_V(6); PG8_BAR;
    for (;;) {
        const bool has_next = S.next(ui + 1, nxt);
        const char* nA = has_next ? (const char*)g.A + (size_t)nxt.pm * tstepA : cA; const char* nB = has_next ? (const char*)g.Bt + (size_t)nxt.pn * tstep : cB;
        for (int t = 0; t < nt; t += 2) {
            const bool last = (t == nt - 2);
            const char* a1 = cA + (size_t)(t + 1) * kstep;
            const char* a2 = last ? nA : cA + (size_t)(t + 2) * kstep; const char* b2 = last ? nB : cB + (size_t)(t + 2) * kstep;
            const char* a3 = a2 + kstep; const char* b3 = b2 + kstep;
            PG8_LDB(B0, 0, 0); PG8_SCHED; PG8_LDA(At, 0, 0); PG8_STAGE(PG8_SA(1, 1), a1 + hstepA, voffA);
            PG8_WAIT_L(8); PG8_BAR; PG8_WAIT_L(0); PG8_MMA(0, 0, At, B0); PG8_BAR; PG8_SCHED;
            PG8_LDB(B1, 0, 1); PG8_STAGE(PG8_SB(0, 0), b2, voffB);
            PG8_BAR; PG8_WAIT_L(0); PG8_MMA(0, 1, At, B1); PG8_BAR;
            PG8_LDA(At, 0, 1); PG8_STAGE(PG8_SA(0, 0), a2, voffA);
            PG8_BAR; PG8_WAIT_L(0); PG8_MMA(1, 0, At, B0); PG8_BAR; PG8_SCHED;
            PG8_STAGE(PG8_SB(0, 1), b2 + hstep, voffB);
            PG8_WAIT_V(6); PG8_BAR; PG8_MMA(1, 1, At, B1); PG8_BAR;
            PG8_LDB(B0, 1, 0); PG8_SCHED; PG8_LDA(At, 1, 0); PG8_STAGE(PG8_SA(0, 1), a2 + hstepA, voffA);
            PG8_WAIT_L(8); PG8_BAR; PG8_WAIT_L(0); PG8_MMA(0, 0, At, B0); PG8_BAR; PG8_SCHED;
            PG8_LDB(B1, 1, 1); PG8_STAGE(PG8_SB(1, 0), b3, voffB);
            PG8_BAR; PG8_WAIT_L(0); PG8_MMA(0, 1, At, B1); PG8_BAR;
            PG8_LDA(At, 1, 1); PG8_STAGE(PG8_SA(1, 0), a3, voffA);
            PG8_BAR; PG8_WAIT_L(0); PG8_MMA(1, 0, At, B0); PG8_BAR; PG8_SCHED;
            PG8_STAGE(PG8_SB(1, 1), b3 + hstep, voffB);
            PG8_WAIT_V(6); PG8_BAR; PG8_MMA(1, 1, At, B1); PG8_BAR;
        }
        if constexpr (MX) asm volatile("s_nop 15\n\ts_nop 15" ::: "memory");
        E(acc, cur, wr, wc, fr, fq);
        if (!has_next) break;
#pragma unroll
        for (int a = 0; a < 2; ++a)
#pragma unroll
            for (int b = 0; b < 2; ++b)
#pragma unroll
                for (int m = 0; m < 4; ++m)
#pragma unroll
                    for (int n = 0; n < 2; ++n) acc[a][b][m][n] = (f32x4){0.f, 0.f, 0.f, 0.f};
        cur = nxt; cA = nA; cB = nB; ++ui;
    }
    PG8_WAIT_V(0);
    if (wr == 0) PG8_BAR;
    PG8_BAR;
#undef PG8_SA
#undef PG8_SB
#undef PG8_STAGE
#undef PG8_LDX
#undef PG8_LDA
#undef PG8_LDB
#undef PG8_MMA
#undef PG8_WAIT_V
#undef PG8_WAIT_L
#undef PG8_BAR
#undef PG8_SCHED
}
}
using pg8::Unit;

struct EpiProj {
    static constexpr bool PERM = true;
    unsigned char* ws; const float* lb; const float* ng; float* kmean;
    __device__ __forceinline__ void operator()(const f32x4 (&acc)[2][2][4][2], const Unit& u, int wr, int wc, int fr, int fq) const {
        const int pn = u.pn; int seg, colt, ldc; size_t boff;
        if (pn < 14) { seg = pn >> 1; colt = (pn & 1) * 256; ldc = 512; boff = OFF_QA + (size_t)seg * SZ_T512; }
        else if (pn < 18) { seg = 7; colt = (pn - 14) * 256; ldc = 1024; boff = OFF_GA; }
        else { seg = 8; colt = (pn - 18) * 256; ldc = 1024; boff = OFF_GB; }
        bf16_t* base = (bf16_t*)(ws + boff);
        const int row0 = u.pm * 256 + wr * 64 + fr, col0 = colt + wc * 32 + 8 * fq;
        float pv[2][8];
#pragma unroll
        for (int bj = 0; bj < 2; ++bj)
#pragma unroll
            for (int e = 0; e < 8; ++e) pv[bj][e] = (seg == 4) ? (1.0f - lb[col0 + bj * 128 + e]) : ((seg == 6) ? ng[col0 + bj * 128 + e] : 0.f);
        float cs[2][8];
#pragma unroll
        for (int bj = 0; bj < 2; ++bj)
#pragma unroll
            for (int e = 0; e < 8; ++e) cs[bj][e] = 0.f;
#pragma unroll
        for (int ai = 0; ai < 2; ++ai)
#pragma unroll
            for (int m = 0; m < 4; ++m) {
                bf16_t* rowp = base + (size_t)(row0 + ai * 128 + m * 16) * ldc + col0;
#pragma unroll
                for (int bj = 0; bj < 2; ++bj) {
                    float v[8];
#pragma unroll
                    for (int e = 0; e < 4; ++e) { v[e] = acc[ai][bj][m][0][e] * (1.0f / 32.0f); v[4 + e] = acc[ai][bj][m][1][e] * (1.0f / 32.0f); }
                    if (seg == 0) {
#pragma unroll
                        for (int e = 0; e < 8; ++e) v[e] *= (0.125f * LOG2E);
                    } else if (seg == 1) {
#pragma unroll
                        for (int e = 0; e < 8; ++e) cs[bj][e] += v[e];
                    } else if (seg == 3) {
#pragma unroll
                        for (int e = 0; e < 8; ++e) v[e] = v[e] * sigmoidf_(v[e]);
                    } else if (seg == 4) {
#pragma unroll
                        for (int e = 0; e < 8; ++e) v[e] = pv[bj][e] * sigmoidf_(-v[e]);
                    } else if (seg == 6) {
#pragma unroll
                        for (int e = 0; e < 8; ++e) v[e] = pv[bj][e] * v[e] * sigmoidf_(v[e]);
                    } else if (seg >= 7) {
#pragma unroll
                        for (int e = 0; e < 8; ++e) v[e] = sigmoidf_(v[e]);
                    }
                    u32x4 w; w.x = cvt_pk_bf16(v[0], v[1]); w.y = cvt_pk_bf16(v[2], v[3]); w.z = cvt_pk_bf16(v[4], v[5]); w.w = cvt_pk_bf16(v[6], v[7]);
                    *(u32x4*)(rowp + bj * 128) = w;
                }
            }
        if (seg == 1) {
#pragma unroll
            for (int bj = 0; bj < 2; ++bj)
#pragma unroll
                for (int e = 0; e < 8; ++e) {
                    float s = cs[bj][e];
                    s += __shfl_xor(s, 1); s += __shfl_xor(s, 2); s += __shfl_xor(s, 4); s += __shfl_xor(s, 8);
                    if (fr == 0) atomicAdd(kmean + (size_t)u.pm * 512 + col0 + bj * 128 + e, s);
                }
        }
    }
};
struct EpiMixA {
    static constexpr bool PERM = true;
    bf16_t* GA;
    __device__ __forceinline__ void operator()(const f32x4 (&acc)[2][2][4][2], const Unit& u, int wr, int wc, int fr, int fq) const {
        const int row0 = u.pm * 256 + wr * 64 + fr, col0 = u.pn * 256 + wc * 32 + 8 * fq;
#pragma unroll
        for (int ai = 0; ai < 2; ++ai)
#pragma unroll
            for (int m = 0; m < 4; ++m) {
                bf16_t* rowp = GA + (size_t)(row0 + ai * 128 + m * 16) * 1024 + col0;
#pragma unroll
                for (int bj = 0; bj < 2; ++bj) {
                    const u32x4 g = *(const u32x4*)(rowp + bj * 128);
                    const f32x4 a0 = acc[ai][bj][m][0], a1 = acc[ai][bj][m][1];
                    u32x4 w;
                    constexpr float S = 1.0f / 32.0f;
                    w.x = cvt_pk_bf16(bf_lo(g.x) * a0[0] * S, bf_hi(g.x) * a0[1] * S); w.y = cvt_pk_bf16(bf_lo(g.y) * a0[2] * S, bf_hi(g.y) * a0[3] * S);
                    w.z = cvt_pk_bf16(bf_lo(g.z) * a1[0] * S, bf_hi(g.z) * a1[1] * S); w.w = cvt_pk_bf16(bf_lo(g.w) * a1[2] * S, bf_hi(g.w) * a1[3] * S);
                    *(u32x4*)(rowp + bj * 128) = w;
                }
            }
    }
};
struct EpiMixB {
    static constexpr bool PERM = true;
    const bf16_t* GA; const bf16_t* GB; unsigned char* M8;
    __device__ __forceinline__ void operator()(const f32x4 (&acc)[2][2][4][2], const Unit& u, int wr, int wc, int fr, int fq) const {
        const int row0 = u.pm * 256 + wr * 64 + fr, col0 = u.pn * 256 + wc * 32 + 8 * fq;
#pragma unroll
        for (int ai = 0; ai < 2; ++ai)
#pragma unroll
            for (int m = 0; m < 4; ++m) {
                const size_t off = (size_t)(row0 + ai * 128 + m * 16) * 1024 + col0;
#pragma unroll
                for (int bj = 0; bj < 2; ++bj) {
                    const u32x4 g = *(const u32x4*)(GB + off + bj * 128);
                    const u32x4 mx = *(const u32x4*)(GA + off + bj * 128);
                    const f32x4 a0 = acc[ai][bj][m][0], a1 = acc[ai][bj][m][1];
                    constexpr float S = 1.0f / 32.0f;
                    int w0 = __builtin_amdgcn_cvt_pk_fp8_f32(bf_lo(mx.x) + bf_lo(g.x) * a0[0] * S, bf_hi(mx.x) + bf_hi(g.x) * a0[1] * S, 0, false); w0 = __builtin_amdgcn_cvt_pk_fp8_f32(bf_lo(mx.y) + bf_lo(g.y) * a0[2] * S, bf_hi(mx.y) + bf_hi(g.y) * a0[3] * S, w0, true);
                    int w1 = __builtin_amdgcn_cvt_pk_fp8_f32(bf_lo(mx.z) + bf_lo(g.z) * a1[0] * S, bf_hi(mx.z) + bf_hi(g.z) * a1[1] * S, 0, false); w1 = __builtin_amdgcn_cvt_pk_fp8_f32(bf_lo(mx.w) + bf_lo(g.w) * a1[2] * S, bf_hi(mx.w) + bf_hi(g.w) * a1[3] * S, w1, true);
                    *(u32x2*)(M8 + off + bj * 128) = (u32x2){(unsigned)w0, (unsigned)w1};
                }
            }
    }
};
struct EpiOut {
    static constexpr bool PERM = true;
    const float* ada; bf16_t* D;
    __device__ __forceinline__ void operator()(const f32x4 (&acc)[2][2][4][2], const Unit& u, int wr, int wc, int fr, int fq) const {
        const int row0 = u.pm * 256 + wr * 64 + fr, col0 = u.pn * 256 + wc * 32 + 8 * fq;
        const float* gt1 = ada + (size_t)(u.pm >> 3) * 6144 + 2048 + col0;
        f32x4 g[2][2];
#pragma unroll
        for (int bj = 0; bj < 2; ++bj) { g[bj][0] = *(const f32x4*)(gt1 + bj * 128); g[bj][1] = *(const f32x4*)(gt1 + bj * 128 + 4); }
#pragma unroll
        for (int ai = 0; ai < 2; ++ai)
#pragma unroll
            for (int m = 0; m < 4; ++m) {
                bf16_t* rowp = D + (size_t)(row0 + ai * 128 + m * 16) * 1024 + col0;
#pragma unroll
                for (int bj = 0; bj < 2; ++bj) {
                    const f32x4 a0 = acc[ai][bj][m][0] * g[bj][0] * (1.0f / 32.0f), a1 = acc[ai][bj][m][1] * g[bj][1] * (1.0f / 32.0f);
                    u32x4 w; w.x = cvt_pk_bf16(a0[0], a0[1]); w.y = cvt_pk_bf16(a0[2], a0[3]); w.z = cvt_pk_bf16(a1[0], a1[1]); w.w = cvt_pk_bf16(a1[2], a1[3]);
                    *(u32x4*)(rowp + bj * 128) = w;
                }
            }
    }
};
struct EpiBf16 {
    static constexpr bool PERM = true;
    bf16_t* O;
    __device__ __forceinline__ void operator()(const f32x4 (&acc)[2][2][4][2], const Unit& u, int wr, int wc, int fr, int fq) const {
        const int row0 = u.pm * 256 + wr * 64 + fr, col0 = u.pn * 256 + wc * 32 + 8 * fq;
#pragma unroll
        for (int ai = 0; ai < 2; ++ai)
#pragma unroll
            for (int m = 0; m < 4; ++m) {
                bf16_t* rowp = O + (size_t)(row0 + ai * 128 + m * 16) * 1024 + col0;
#pragma unroll
                for (int bj = 0; bj < 2; ++bj) {
                    const f32x4 a0 = acc[ai][bj][m][0], a1 = acc[ai][bj][m][1];
                    u32x4 w; w.x = cvt_pk_bf16(a0[0], a0[1]); w.y = cvt_pk_bf16(a0[2], a0[3]); w.z = cvt_pk_bf16(a1[0], a1[1]); w.w = cvt_pk_bf16(a1[2], a1[3]);
                    *(u32x4*)(rowp + bj * 128) = w;
                }
            }
    }
};

__device__ void phase0a(const Params& P, LAS unsigned char* lds) {
    const int tid = tid_opaque(), G = gridDim.x, bid = blockIdx.x;
    for (int it = bid; it < 192; it += G) {
        LAS float* sc = (LAS float*)lds;
        for (int i = tid; i < 32 * 1024; i += NTHR) { const float cv = P.c[i]; sc[i] = cv * sigmoidf_(cv); }
        __syncthreads();
        const int kg = tid >> 5, col = tid & 31;
        float a[32];
#pragma unroll
        for (int b = 0; b < 32; ++b) a[b] = 0.f;
#pragma unroll 1
        for (int k = kg * 64; k < kg * 64 + 64; k += 8) {
            float w[8];
#pragma unroll
            for (int e = 0; e < 8; ++e) w[e] = __builtin_nontemporal_load(P.w_ada + (size_t)(k + e) * 6144 + it * 32 + col);
#pragma unroll
            for (int e4 = 0; e4 < 2; ++e4) {
#pragma unroll
                for (int b = 0; b < 32; ++b) { const f32x4 s = *(const LAS f32x4*)(sc + b * 1024 + k + 4 * e4); a[b] += s[0] * w[4 * e4] + s[1] * w[4 * e4 + 1] + s[2] * w[4 * e4 + 2] + s[3] * w[4 * e4 + 3]; }
                asm volatile("" ::: "memory");
            }
        }
        __syncthreads();
        LAS float* red = (LAS float*)lds;
#pragma unroll
        for (int b = 0; b < 32; ++b) red[(kg * 32 + b) * 32 + col] = a[b];
        __syncthreads();
        for (int o = tid; o < 1024; o += NTHR) { const int b = o >> 5, cc = o & 31; float s = 0.f;
#pragma unroll
            for (int g2 = 0; g2 < 16; ++g2) s += red[(g2 * 32 + b) * 32 + cc];
            ((float*)(P.ws + OFF_ADA))[(size_t)b * 6144 + it * 32 + cc] = s + P.b_ada[it * 32 + cc]; }
        __syncthreads();
    }
    const size_t gsz = (size_t)G * NTHR;
    { const int gt = bid * NTHR + tid, gs = G * NTHR;
      if (gt < 512) ((float*)(P.ws + OFF_LB))[gt] = sigmoidf_(P.hgrn_lb[gt] - P.hgrn_lb[512 + gt]);
      for (int i = gt; i < 32 * 8 * 512; i += gs) ((float*)(P.ws + OFF_KMEAN))[i] = 0.f; }
    {
        LAS float* tile = (LAS float*)lds;
        const int I0 = 16 * 88, I1 = I0 + 8 * 16, I2 = I1 + 8 * 16, I3 = I2 + 16 * 16, I4 = I3 + 16 * 16;
        for (int it = bid; it < I4; it += G) {
            const float* W; bf16_t* WT; int K, N, r;
            if (it < I0) { W = P.w_in; WT = (bf16_t*)(P.ws + OFF_WIN); K = 1024; N = 5632; r = it; }
            else if (it < I1) { W = P.w_ba; WT = (bf16_t*)(P.ws + OFF_WBA); K = 512; N = 1024; r = it - I0; }
            else if (it < I2) { W = P.w_bb; WT = (bf16_t*)(P.ws + OFF_WBB); K = 512; N = 1024; r = it - I1; }
            else if (it < I3) { W = P.w_out; WT = (bf16_t*)(P.ws + OFF_WOUT); K = 1024; N = 1024; r = it - I2; }
            else { W = P.peer_wq; WT = (bf16_t*)(P.ws + OFF_WQ); K = 1024; N = 1024; r = it - I3; }
            const int nb = N / 64, k0 = (r / nb) * 64, n0 = (r % nb) * 64;
#pragma unroll
            for (int ps = 0; ps < 2; ++ps) { const int kk = (tid >> 4) + 32 * ps, n4 = (tid & 15) * 4;
                const f32x4 v = *(const f32x4*)(W + (size_t)(k0 + kk) * N + n0 + n4);
                tile[kk * 65 + n4] = v[0]; tile[kk * 65 + n4 + 1] = v[1]; tile[kk * 65 + n4 + 2] = v[2]; tile[kk * 65 + n4 + 3] = v[3]; }
            __syncthreads();
            { const int n = tid >> 3, kc = (tid & 7) * 8;
              if (it < I3) {
                  int w0 = __builtin_amdgcn_cvt_pk_fp8_f32(32.f * tile[(kc + 0) * 65 + n], 32.f * tile[(kc + 1) * 65 + n], 0, false); w0 = __builtin_amdgcn_cvt_pk_fp8_f32(32.f * tile[(kc + 2) * 65 + n], 32.f * tile[(kc + 3) * 65 + n], w0, true);
                  int w1 = __builtin_amdgcn_cvt_pk_fp8_f32(32.f * tile[(kc + 4) * 65 + n], 32.f * tile[(kc + 5) * 65 + n], 0, false); w1 = __builtin_amdgcn_cvt_pk_fp8_f32(32.f * tile[(kc + 6) * 65 + n], 32.f * tile[(kc + 7) * 65 + n], w1, true);
                  *(u32x2*)((unsigned char*)WT + (size_t)(n0 + n) * K + k0 + kc) = (u32x2){(unsigned)w0, (unsigned)w1};
              } else { u32x4 w;
              w.x = cvt_pk_bf16(tile[(kc + 0) * 65 + n], tile[(kc + 1) * 65 + n]); w.y = cvt_pk_bf16(tile[(kc + 2) * 65 + n], tile[(kc + 3) * 65 + n]);
              w.z = cvt_pk_bf16(tile[(kc + 4) * 65 + n], tile[(kc + 5) * 65 + n]); w.w = cvt_pk_bf16(tile[(kc + 6) * 65 + n], tile[(kc + 7) * 65 + n]);
              *(u32x4*)(WT + (size_t)(n0 + n) * K + k0 + kc) = w; } }
            __syncthreads();
        }
    }
    {
        const size_t gtid = (size_t)bid * NTHR + tid_opaque();
        for (size_t i = gtid; i < 16384; i += gsz) {
            const float* src = P.peer_sk + i * 8; const f32x4 a = *(const f32x4*)src, b = *(const f32x4*)(src + 4);
            u32x4 w; w.x = cvt_pk_bf16(a[0], a[1]); w.y = cvt_pk_bf16(a[2], a[3]); w.z = cvt_pk_bf16(b[0], b[1]); w.w = cvt_pk_bf16(b[2], b[3]);
            *(u32x4*)((bf16_t*)(P.ws + OFF_SK) + i * 8) = w;
        }
        { const int lane = tid & 63, gw = bid * 8 + (tid >> 6), ngw = G * 8;
          for (int r = gw; r < 2 * 16384; r += ngw) {
              const bool isv = r >= 16384; const int e = isv ? r - 16384 : r;
              const float* s = (isv ? P.peer_v : P.peer_u) + (size_t)e * 1024 + lane * 16;
              f32x4 x[4]; float ss = 0.f;
#pragma unroll
              for (int q = 0; q < 4; ++q) { x[q] = __builtin_nontemporal_load((const f32x4*)(s + 4 * q)); ss += (x[q][0] * x[q][0] + x[q][1] * x[q][1]) + (x[q][2] * x[q][2] + x[q][3] * x[q][3]); }
              const float sc = fmaxf(sqrtf(wave_sum(ss) * (1.0f / 1024.0f)) * (2.6f / 7.5f), 1e-30f), inv = 1.0f / sc;
              unsigned nb[16];
#pragma unroll
              for (int q = 0; q < 4; ++q)
#pragma unroll
                  for (int el = 0; el < 4; ++el) nb[4 * q + el] = (unsigned)fminf(fmaxf(floorf(x[q][el] * inv) + 8.0f, 0.0f), 15.0f);
              u32x2 w;
              w.x = (nb[0] | (nb[4] << 4)) | ((nb[1] | (nb[5] << 4)) << 8) | ((nb[2] | (nb[6] << 4)) << 16) | ((nb[3] | (nb[7] << 4)) << 24);
              w.y = (nb[8] | (nb[12] << 4)) | ((nb[9] | (nb[13] << 4)) << 8) | ((nb[10] | (nb[14] << 4)) << 16) | ((nb[11] | (nb[15] << 4)) << 24);
              *(u32x2*)(P.ws + (isv ? OFF_V8 : OFF_U8) + (size_t)e * 512 + lane * 8) = w;
              if (lane == 0) ((float*)(P.ws + (isv ? OFF_VSC : OFF_USC)))[e] = sc;
          } }
    }
}
__device__ void phase0b(const Params& P) {
    const size_t gtid = (size_t)blockIdx.x * NTHR + threadIdx.x, gsz = (size_t)gridDim.x * NTHR;
    const float* ada = (const float*)(P.ws + OFF_ADA); bf16_t* H = (bf16_t*)(P.ws + OFF_H);
    for (size_t i = gtid; i < (size_t)NTOK * 128; i += gsz) {
        const size_t row = i >> 7; const int c8 = (int)(i & 127) * 8; const int b = (int)(row >> 11);
        const float* xr = P.x + row * 1024 + c8; const float* sh = ada + (size_t)b * 6144 + c8; const float* sc = sh + 1024;
        const f32x4 x0 = *(const f32x4*)xr, x1 = *(const f32x4*)(xr + 4), s0 = *(const f32x4*)sc, s1 = *(const f32x4*)(sc + 4), h0 = *(const f32x4*)sh, h1 = *(const f32x4*)(sh + 4);
        const f32x4 r0 = x0 * (s0 + 1.0f) + h0, r1 = x1 * (s1 + 1.0f) + h1;
        int w0 = __builtin_amdgcn_cvt_pk_fp8_f32(r0[0], r0[1], 0, false); w0 = __builtin_amdgcn_cvt_pk_fp8_f32(r0[2], r0[3], w0, true);
        int w1 = __builtin_amdgcn_cvt_pk_fp8_f32(r1[0], r1[1], 0, false); w1 = __builtin_amdgcn_cvt_pk_fp8_f32(r1[2], r1[3], w1, true);
        *(u32x2*)((unsigned char*)H + row * 1024 + c8) = (u32x2){(unsigned)w0, (unsigned)w1};
    }
}

__device__ __forceinline__ s16x4 tr4(const LAS unsigned char* p) { return __builtin_bit_cast(s16x4, __builtin_amdgcn_ds_read_tr16_b64_v4i16((LAS s16x4*)p)); }
__device__ void hgrn_item(const Params& P, int item, LAS unsigned char* lds) {
    const int tid = tid_opaque(), lane = tid & 63, wid = __builtin_amdgcn_readfirstlane(tid >> 6), r32 = lane & 31, hi = lane >> 5;
    const int b = item >> 3, h = (item >> 1) & 3, vh = item & 1;
    const bf16_t* HQ = (const bf16_t*)(P.ws + OFF_HQ); const bf16_t* HK = (const bf16_t*)(P.ws + OFF_HK); bf16_t* HI = (bf16_t*)(P.ws + OFF_HI);
    constexpr int SQ = 272, SKD = 320, SV = 192, SS = 192;
    constexpr int LQR = 0, LKR = 17408, LQB = 34816, LKD = 52224, LV = 72704, LS = 84992, LG = 109568, LT = 142336, LCL = 144384;
    LAS float* G = (LAS float*)(lds + LG); LAS float* TOT = (LAS float*)(lds + LT); LAS float* CL = (LAS float*)(lds + LCL);
    const size_t rowb = (size_t)b * SEQ;
    const int row = tid >> 3, seg = tid & 7;
    const bf16_t* qsrc = HQ + (rowb + row) * 512 + h * 128 + seg * 16; const bf16_t* ksrc = HK + (rowb + row) * 512 + h * 128 + seg * 16;
    bf16_t* vsrc = HI + (rowb + row) * 512 + h * 128 + vh * 64 + seg * 8;
    for (int i = tid; i < 128 * SS / 4; i += NTHR) ((LAS unsigned*)(lds + LS))[i] = 0u;
    f32x16 Sacc = {};
    const int di = wid >> 1, vi = wid & 1, ti = wid >> 1;
    const int tg = lane >> 4, tc = tg & 1, tI = lane & 15;
    const int trow = 4 * hi + (tI >> 2), tcol = 16 * tc + 4 * (tI & 3);
    u32x4 qn0 = *(const u32x4*)qsrc, qn1 = *(const u32x4*)(qsrc + 8), kn0 = *(const u32x4*)ksrc, kn1 = *(const u32x4*)(ksrc + 8), vn = *(const u32x4*)vsrc;
#pragma unroll 1
    for (int n = 0; n < SEQ / 64; ++n) {
        const u32x4 q0 = qn0, q1 = qn1, k0 = kn0, k1 = kn1, vv = vn;
        float qf[16] = {bf_lo(q0.x), bf_hi(q0.x), bf_lo(q0.y), bf_hi(q0.y), bf_lo(q0.z), bf_hi(q0.z), bf_lo(q0.w), bf_hi(q0.w), bf_lo(q1.x), bf_hi(q1.x), bf_lo(q1.y), bf_hi(q1.y), bf_lo(q1.z), bf_hi(q1.z), bf_lo(q1.w), bf_hi(q1.w)};
        float kf[16] = {bf_lo(k0.x), bf_hi(k0.x), bf_lo(k0.y), bf_hi(k0.y), bf_lo(k0.z), bf_hi(k0.z), bf_lo(k0.w), bf_hi(k0.w), bf_lo(k1.x), bf_hi(k1.x), bf_lo(k1.y), bf_hi(k1.y), bf_lo(k1.z), bf_hi(k1.z), bf_lo(k1.w), bf_hi(k1.w)};
#pragma unroll
        for (int e4 = 0; e4 < 4; ++e4) *(LAS f32x4*)(G + row * 128 + seg * 16 + 4 * e4) = (f32x4){__logf(1.0f - kf[4 * e4]), __logf(1.0f - kf[4 * e4 + 1]), __logf(1.0f - kf[4 * e4 + 2]), __logf(1.0f - kf[4 * e4 + 3])};
        *(LAS u32x4*)(lds + LV + row * SV + seg * 16) = vv;
        if (n + 1 < SEQ / 64) { const size_t o = (size_t)(n + 1) * 64 * 512; qn0 = *(const u32x4*)(qsrc + o); qn1 = *(const u32x4*)(qsrc + o + 8); kn0 = *(const u32x4*)(ksrc + o); kn1 = *(const u32x4*)(ksrc + o + 8); vn = *(const u32x4*)(vsrc + o); }
        __syncthreads();
        { const int d = tid & 127, q4 = tid >> 7; float s = 0.f;
#pragma unroll
          for (int i = 0; i < 16; ++i) { s += G[(16 * q4 + i) * 128 + d]; G[(16 * q4 + i) * 128 + d] = s; }
          TOT[q4 * 128 + d] = s; }
        __syncthreads();
        {
            const int qq = row >> 4;
#pragma unroll
            for (int e4 = 0; e4 < 4; ++e4) {
                const int d4 = seg * 16 + 4 * e4;
                const f32x4 t0 = *(const LAS f32x4*)(TOT + d4), t1 = *(const LAS f32x4*)(TOT + 128 + d4), t2 = *(const LAS f32x4*)(TOT + 256 + d4), t3 = *(const LAS f32x4*)(TOT + 384 + d4);
                const f32x4 off = (qq == 0) ? (f32x4){0.f, 0.f, 0.f, 0.f} : ((qq == 1) ? t0 : ((qq == 2) ? t0 + t1 : t0 + t1 + t2));
                const f32x4 bb = *(const LAS f32x4*)(G + row * 128 + d4) + off;
                const f32x4 bref = *(const LAS f32x4*)(G + 32 * 128 + d4) + t0 + t1, blast = t0 + t1 + t2 + t3;
                float vqb[4], vqr[4], vkr[4], vkd[4];
#pragma unroll
                for (int e = 0; e < 4; ++e) {
                    const float e1 = __expf(bb[e]), e2 = __expf(-bb[e]);
                    vqb[e] = qf[4 * e4 + e] * e1; vqr[e] = vqb[e] * __expf(-bref[e]);
                    const float ke = kf[4 * e4 + e] * e2; vkr[e] = ke * __expf(bref[e]); vkd[e] = ke * __expf(blast[e]);
                }
                *(LAS u32x2*)(lds + LQB + row * SQ + seg * 32 + 8 * e4) = (u32x2){cvt_pk_bf16(vqb[0], vqb[1]), cvt_pk_bf16(vqb[2], vqb[3])};
                *(LAS u32x2*)(lds + LQR + row * SQ + seg * 32 + 8 * e4) = (u32x2){cvt_pk_bf16(vqr[0], vqr[1]), cvt_pk_bf16(vqr[2], vqr[3])};
                *(LAS u32x2*)(lds + LKR + row * SQ + seg * 32 + 8 * e4) = (u32x2){cvt_pk_bf16(vkr[0], vkr[1]), cvt_pk_bf16(vkr[2], vkr[3])};
                *(LAS u32x2*)(lds + LKD + row * SKD + seg * 32 + 8 * e4) = (u32x2){cvt_pk_bf16(vkd[0], vkd[1]), cvt_pk_bf16(vkd[2], vkd[3])};
                if (row == 0) *(LAS f32x4*)(CL + d4) = (f32x4){__expf(blast[0]), __expf(blast[1]), __expf(blast[2]), __expf(blast[3])};
                asm volatile("" ::: "memory");
            }
        }
        __syncthreads();
        if (wid < 4) {
            f32x16 Z = {};
            for (int si = 0; si <= ti; ++si) {
                f32x16 X = {};
#pragma unroll
                for (int ks = 0; ks < 8; ++ks) {
                    const bf16x8 a = *(const LAS bf16x8*)(lds + LKR + (32 * si + r32) * SQ + (16 * ks + 8 * hi) * 2);
                    const bf16x8 bq = *(const LAS bf16x8*)(lds + LQR + (32 * ti + r32) * SQ + (16 * ks + 8 * hi) * 2);
                    X = MFMA32(a, bq, X);
                }
                if (si == ti) {
#pragma unroll
                    for (int r = 0; r < 16; ++r) if (crow(r, hi) > r32) X[r] = 0.f;
                }
#pragma unroll
                for (int s2 = 0; s2 < 2; ++s2) {
                    union { u32x4 u; bf16x8 v; } pa;
                    pa.u.x = cvt_pk_bf16(X[8 * s2 + 0], X[8 * s2 + 1]); pa.u.y = cvt_pk_bf16(X[8 * s2 + 2], X[8 * s2 + 3]); pa.u.z = cvt_pk_bf16(X[8 * s2 + 4], X[8 * s2 + 5]); pa.u.w = cvt_pk_bf16(X[8 * s2 + 6], X[8 * s2 + 7]);
                    const LAS unsigned char* vp = lds + LV + (32 * si + 16 * s2 + trow) * SV + (32 * vi + tcol) * 2;
                    const s16x4 lo = tr4(vp), hh = tr4(vp + 8 * SV);
                    const bf16x8 vf = {lo[0], lo[1], lo[2], lo[3], hh[0], hh[1], hh[2], hh[3]};
                    Z = MFMA32(pa.v, vf, Z);
                }
            }
#pragma unroll
            for (int ks = 0; ks < 8; ++ks) {
                const bf16x8 a = *(const LAS bf16x8*)(lds + LQB + (32 * ti + r32) * SQ + (16 * ks + 8 * hi) * 2);
                const LAS unsigned char* sp = lds + LS + (16 * ks + 8 * hi + (tI >> 2)) * SS + (32 * vi + tcol) * 2;
                const s16x4 lo = tr4(sp), hh = tr4(sp + 4 * SS);
                const bf16x8 sf = {lo[0], lo[1], lo[2], lo[3], hh[0], hh[1], hh[2], hh[3]};
                Z = MFMA32(a, sf, Z);
            }
            bf16_t* op = HI + (rowb + (size_t)n * 64 + 32 * ti) * 512 + h * 128 + vh * 64 + 32 * vi + r32;
#pragma unroll
            for (int r = 0; r < 16; ++r) op[(size_t)crow(r, hi) * 512] = (bf16_t)(cvt_pk_bf16(Z[r], 0.f) & 0xffffu);
        }
        {
#pragma unroll
            for (int r = 0; r < 16; ++r) Sacc[r] *= CL[32 * di + crow(r, hi)];
#pragma unroll
            for (int ks = 0; ks < 4; ++ks) {
                const LAS unsigned char* kp = lds + LKD + (16 * ks + 8 * hi + (tI >> 2)) * SKD + (32 * di + tcol) * 2;
                const s16x4 klo = tr4(kp), khi = tr4(kp + 4 * SKD);
                const bf16x8 ka = {klo[0], klo[1], klo[2], klo[3], khi[0], khi[1], khi[2], khi[3]};
                const LAS unsigned char* vp = lds + LV + (16 * ks + 8 * hi + (tI >> 2)) * SV + (32 * vi + tcol) * 2;
                const s16x4 vlo = tr4(vp), vhi = tr4(vp + 4 * SV);
                const bf16x8 vb = {vlo[0], vlo[1], vlo[2], vlo[3], vhi[0], vhi[1], vhi[2], vhi[3]};
                Sacc = MFMA32(ka, vb, Sacc);
            }
        }
        __syncthreads();
        {
            LAS bf16_t* sp = (LAS bf16_t*)(lds + LS + (32 * di) * SS + (32 * vi + r32) * 2);
#pragma unroll
            for (int r = 0; r < 16; ++r) sp[crow(r, hi) * (SS / 2)] = (bf16_t)(cvt_pk_bf16(Sacc[r], 0.f) & 0xffffu);
        }
    }
    __syncthreads();
}

__device__ void moba_unit(const Params& P, int b, int h, int j, LAS unsigned char* lds) {
    const int tid = tid_opaque(), lane = tid & 63, wid = tid >> 6, r32 = lane & 31, hi = lane >> 5;
    bf16_t* Q = (bf16_t*)(P.ws + OFF_QA); const bf16_t* Kg = (const bf16_t*)(P.ws + OFF_KA); const bf16_t* Vg = (const bf16_t*)(P.ws + OFF_VA);
    const float* kmean = (const float*)(P.ws + OFF_KMEAN);
    constexpr int KIMG = 64 * 144, VIMG = 64 * 192, LK = 0, LV = 2 * KIMG, LKM = 2 * KIMG + 2 * VIMG;
    LAS float* kmL = (LAS float*)(lds + LKM);
    const size_t rowb = (size_t)b * SEQ; const int q0 = j * 256;
    if (tid < j * 64) kmL[tid] = kmean[(size_t)(b * 8 + (tid >> 6)) * 512 + h * 64 + (tid & 63)];
    bf16_t* qrow = Q + (rowb + q0 + wid * 32 + r32) * 512 + h * 64;
    bf16x8 qf[4];
#pragma unroll
    for (int d0 = 0; d0 < 4; ++d0) qf[d0] = *(const bf16x8*)(qrow + 16 * d0 + 8 * hi);
    const int srow = tid >> 3, sch = tid & 7;
    const bf16_t* ksrc = Kg + (rowb + srow) * 512 + h * 64 + sch * 8; const bf16_t* vsrc = Vg + (rowb + srow) * 512 + h * 64 + sch * 8;
    const int ntile = 4 * (j + 1);
    u32x4 kreg, vreg;
    { const int key0 = q0; kreg = *(const u32x4*)(ksrc + (size_t)key0 * 512); vreg = *(const u32x4*)(vsrc + (size_t)key0 * 512); }
    *(LAS u32x4*)(lds + LK + srow * 144 + sch * 16) = kreg; *(LAS u32x4*)(lds + LV + srow * 192 + sch * 16) = vreg;
    __syncthreads();
    unsigned sel = 0;
    if (j <= 3) sel = (1u << j) - 1u;
    else {
        float g[7];
#pragma unroll
        for (int n = 0; n < 7; ++n) { float s = 0.f;
            if (n < j) {
#pragma unroll
                for (int d0 = 0; d0 < 4; ++d0)
#pragma unroll
                    for (int e = 0; e < 8; ++e) s += __uint_as_float(((unsigned)(unsigned short)qf[d0][e]) << 16) * kmL[n * 64 + 16 * d0 + 8 * hi + e];
            }
            s += __shfl_xor(s, 32); g[n] = s; }
#pragma unroll
        for (int it = 0; it < 3; ++it) { float best = -INFINITY; int bi = 0;
#pragma unroll
            for (int n = 0; n < 7; ++n) if (n < j && !((sel >> n) & 1u) && g[n] > best) { best = g[n]; bi = n; }
            sel |= 1u << bi; }
    }
    const float ch = exp2f(-(float)(h + 1)) * LOG2E;
    const int qb = wid * 32 + r32;
    float m_run = -1e30f, l_run = 0.f;
    f32x16 o0 = {}, o1 = {};
    const int tg = lane >> 4, tc = tg & 1, ti = lane & 15;
    const int vlane = (4 * hi + (ti >> 2)) * 192 + (16 * tc + 4 * (ti & 3)) * 2;
#pragma unroll 1
    for (int i = 0; i < ntile; ++i) {
        const int buf = i & 1;
        const bool own = i < 4; const int blk = own ? j : ((i - 4) >> 2), kt = own ? i : ((i - 4) & 3);
        if (i + 1 < ntile) { const int i1 = i + 1; const int blk1 = (i1 < 4) ? j : ((i1 - 4) >> 2), kt1 = (i1 < 4) ? i1 : ((i1 - 4) & 3); const size_t key1 = (size_t)(blk1 * 256 + kt1 * 64);
            kreg = *(const u32x4*)(ksrc + key1 * 512); vreg = *(const u32x4*)(vsrc + key1 * 512); }
        const bool lane_ok = own ? true : (((sel >> blk) & 1u) != 0u);
        const bool skip = own ? (64 * kt > 32 * wid + 31) : (__ballot(lane_ok) == 0ull);
        if (!skip) {
            LAS unsigned char* kb = lds + LK + buf * KIMG; LAS unsigned char* vb = lds + LV + buf * VIMG;
            f32x16 p0 = {}, p1 = {};
#pragma unroll
            for (int d0 = 0; d0 < 4; ++d0) {
                const bf16x8 kf0 = *(const LAS bf16x8*)(kb + r32 * 144 + (16 * d0 + 8 * hi) * 2);
                const bf16x8 kf1 = *(const LAS bf16x8*)(kb + (32 + r32) * 144 + (16 * d0 + 8 * hi) * 2);
                p0 = MFMA32(kf0, qf[d0], p0); p1 = MFMA32(kf1, qf[d0], p1);
            }
            const float kbase = ch * (float)((blk - j) * 256 + kt * 64);
            float mt = -1e30f;
#pragma unroll
            for (int r = 0; r < 16; ++r) {
                const int kl0 = crow(r, hi), kl1 = kl0 + 32;
                p0[r] = __builtin_fmaf(ch, (float)kl0, p0[r]); p1[r] = __builtin_fmaf(ch, (float)kl1, p1[r]);
                if (own) { if (kt * 64 + kl0 > qb) p0[r] = -1e30f; if (kt * 64 + kl1 > qb) p1[r] = -1e30f; }
                mt = fmaxf(mt, fmaxf(p0[r], p1[r]));
            }
            mt = lane_ok ? mt + kbase : -1e30f;
            mt = fmaxf(mt, __shfl_xor(mt, 32));
            if (__ballot(mt > m_run) != 0ull) {
                const float mnew = fmaxf(m_run, mt), alpha = __builtin_amdgcn_exp2f(m_run - mnew);
                m_run = mnew; l_run *= alpha;
#pragma unroll
                for (int r = 0; r < 16; ++r) { o0[r] *= alpha; o1[r] *= alpha; }
            }
            const float sh = lane_ok ? kbase - m_run : -1e30f;
            float rs = 0.f;
#pragma unroll
            for (int r = 0; r < 16; ++r) { p0[r] = __builtin_amdgcn_exp2f(p0[r] + sh); p1[r] = __builtin_amdgcn_exp2f(p1[r] + sh); rs += p0[r] + p1[r]; }
            l_run += rs;
#pragma unroll
            for (int sub = 0; sub < 2; ++sub)
#pragma unroll
                for (int s = 0; s < 2; ++s) {
                    union { u32x4 u; bf16x8 v; } pb;
                    if (sub == 0) { pb.u.x = cvt_pk_bf16(p0[8 * s + 0], p0[8 * s + 1]); pb.u.y = cvt_pk_bf16(p0[8 * s + 2], p0[8 * s + 3]); pb.u.z = cvt_pk_bf16(p0[8 * s + 4], p0[8 * s + 5]); pb.u.w = cvt_pk_bf16(p0[8 * s + 6], p0[8 * s + 7]); }
                    else { pb.u.x = cvt_pk_bf16(p1[8 * s + 0], p1[8 * s + 1]); pb.u.y = cvt_pk_bf16(p1[8 * s + 2], p1[8 * s + 3]); pb.u.z = cvt_pk_bf16(p1[8 * s + 4], p1[8 * s + 5]); pb.u.w = cvt_pk_bf16(p1[8 * s + 6], p1[8 * s + 7]); }
#pragma unroll
                    for (int dt = 0; dt < 2; ++dt) {
                        LAS unsigned char* va = vb + (32 * sub + 16 * s) * 192 + dt * 64 + vlane;
                        const s16x4 lo = __builtin_bit_cast(s16x4, __builtin_amdgcn_ds_read_tr16_b64_v4i16((LAS s16x4*)va));
                        const s16x4 hh = __builtin_bit_cast(s16x4, __builtin_amdgcn_ds_read_tr16_b64_v4i16((LAS s16x4*)(va + 8 * 192)));
                        const bf16x8 vf = {lo[0], lo[1], lo[2], lo[3], hh[0], hh[1], hh[2], hh[3]};
                        if (dt == 0) o0 = MFMA32(vf, pb.v, o0); else o1 = MFMA32(vf, pb.v, o1);
                    }
                }
        }
        if (i + 1 < ntile) { const int nb = buf ^ 1;
            *(LAS u32x4*)(lds + LK + nb * KIMG + srow * 144 + sch * 16) = kreg; *(LAS u32x4*)(lds + LV + nb * VIMG + srow * 192 + sch * 16) = vreg; }
        __syncthreads();
    }
    l_run += __shfl_xor(l_run, 32);
    const float inv = 1.0f / l_run;
#pragma unroll
    for (int r4 = 0; r4 < 4; ++r4) {
        int w0 = __builtin_amdgcn_cvt_pk_fp8_f32(o0[4 * r4] * inv, o0[4 * r4 + 1] * inv, 0, false); w0 = __builtin_amdgcn_cvt_pk_fp8_f32(o0[4 * r4 + 2] * inv, o0[4 * r4 + 3] * inv, w0, true);
        int w1 = __builtin_amdgcn_cvt_pk_fp8_f32(o1[4 * r4] * inv, o1[4 * r4 + 1] * inv, 0, false); w1 = __builtin_amdgcn_cvt_pk_fp8_f32(o1[4 * r4 + 2] * inv, o1[4 * r4 + 3] * inv, w1, true);
        unsigned char* yrow = P.ws + OFF_EG + (rowb + q0 + wid * 32 + r32) * 1024 + h * 64;
        *(int*)(yrow + 8 * r4 + 4 * hi) = w0; *(int*)(yrow + 32 + 8 * r4 + 4 * hi) = w1;
    }
}

__device__ void yb_norm_panel(const Params& P, int pm) {
    const int tid = tid_opaque(), lane = tid & 63, wid = tid >> 6;
    bf16_t* HI = (bf16_t*)(P.ws + OFF_HI); const bf16_t* HG = (const bf16_t*)(P.ws + OFF_HG);
    for (int r = 0; r < 32; ++r) {
        const size_t off = ((size_t)pm * 256 + wid * 32 + r) * 512 + lane * 8;
        const u32x4 ov = *(const u32x4*)(HI + off), gv = *(const u32x4*)(HG + off);
        float o[8] = {bf_lo(ov.x), bf_hi(ov.x), bf_lo(ov.y), bf_hi(ov.y), bf_lo(ov.z), bf_hi(ov.z), bf_lo(ov.w), bf_hi(ov.w)};
        const float g[8] = {bf_lo(gv.x), bf_hi(gv.x), bf_lo(gv.y), bf_hi(gv.y), bf_lo(gv.z), bf_hi(gv.z), bf_lo(gv.w), bf_hi(gv.w)};
        float ss = 0.f;
#pragma unroll
        for (int e = 0; e < 8; ++e) ss += o[e] * o[e];
        ss += __shfl_xor(ss, 1); ss += __shfl_xor(ss, 2); ss += __shfl_xor(ss, 4); ss += __shfl_xor(ss, 8);
        const float rs = rsqrtf(ss * (1.0f / 128.0f) + RMS_EPS);
        int w0 = __builtin_amdgcn_cvt_pk_fp8_f32(o[0] * rs * g[0], o[1] * rs * g[1], 0, false); w0 = __builtin_amdgcn_cvt_pk_fp8_f32(o[2] * rs * g[2], o[3] * rs * g[3], w0, true);
        int w1 = __builtin_amdgcn_cvt_pk_fp8_f32(o[4] * rs * g[4], o[5] * rs * g[5], 0, false); w1 = __builtin_amdgcn_cvt_pk_fp8_f32(o[6] * rs * g[6], o[7] * rs * g[7], w1, true);
        *(u32x2*)(P.ws + OFF_EG + ((size_t)pm * 256 + wid * 32 + r) * 1024 + 512 + lane * 8) = (u32x2){(unsigned)w0, (unsigned)w1};
    }
}
__device__ void ln1_panel(const Params& P, int pm) {
    const int tid = tid_opaque(), lane = tid & 63, wid = tid >> 6;
    const float* ada = (const float*)(P.ws + OFF_ADA) + (size_t)(pm >> 3) * 6144; bf16_t* H = (bf16_t*)(P.ws + OFF_H);
    for (int r = 0; r < 32; ++r) {
        const size_t row = (size_t)pm * 256 + wid * 32 + r;
        float* xr = P.out + row * 1024 + lane * 4; const float* xin = P.x + row * 1024 + lane * 4; const bf16_t* dl = (const bf16_t*)(P.ws + OFF_GB) + row * 1024 + lane * 4;
        f32x4 v[4]; float s = 0.f;
#pragma unroll
        for (int jx = 0; jx < 4; ++jx) { const u32x2 dv = *(const u32x2*)(dl + 256 * jx); const f32x4 xv = __builtin_nontemporal_load((const f32x4*)(xin + 256 * jx));
            v[jx] = xv * ALPHA + (f32x4){bf_lo(dv.x), bf_hi(dv.x), bf_lo(dv.y), bf_hi(dv.y)}; s += (v[jx][0] + v[jx][1]) + (v[jx][2] + v[jx][3]); }
        const float mean = wave_sum(s) * (1.0f / 1024.0f); float s2 = 0.f;
#pragma unroll
        for (int jx = 0; jx < 4; ++jx) { v[jx] = v[jx] - mean; s2 += (v[jx][0] * v[jx][0] + v[jx][1] * v[jx][1]) + (v[jx][2] * v[jx][2] + v[jx][3] * v[jx][3]); }
        const float rstd = rsqrtf(wave_sum(s2) * (1.0f / 1024.0f) + LN_EPS);
#pragma unroll
        for (int jx = 0; jx < 4; ++jx) {
            const int c = lane * 4 + 256 * jx;
            const f32x4 g = *(const f32x4*)(P.ln1_g + c), bb = *(const f32x4*)(P.ln1_b + c), sh = *(const f32x4*)(ada + 3072 + c), sc = *(const f32x4*)(ada + 4096 + c);
            const f32x4 x1 = v[jx] * rstd * g + bb;
            *(f32x4*)(xr + 256 * jx) = x1;
            const f32x4 h2 = x1 * (sc + 1.0f) + sh;
            u32x2 w; w.x = cvt_pk_bf16(h2[0], h2[1]); w.y = cvt_pk_bf16(h2[2], h2[3]);
            *(u32x2*)(H + row * 1024 + c) = w;
            v[jx] = h2;
        }
        {
            float mx = 0.f;
#pragma unroll
            for (int jx = 0; jx < 4; ++jx) mx = fmaxf(mx, fmaxf(fmaxf(fabsf(v[jx][0]), fabsf(v[jx][1])), fmaxf(fabsf(v[jx][2]), fabsf(v[jx][3]))));
#pragma unroll
            for (int o = 1; o < 64; o <<= 1) mx = fmaxf(mx, __shfl_xor(mx, o));
            const float hs = fmaxf(mx * (1.0f / 127.0f), 1e-30f), inv = 1.0f / hs; int qs = 0;
#pragma unroll
            for (int jx = 0; jx < 4; ++jx) {
                const int q0 = (int)rintf(v[jx][0] * inv), q1 = (int)rintf(v[jx][1] * inv), q2 = (int)rintf(v[jx][2] * inv), q3 = (int)rintf(v[jx][3] * inv);
                qs += (q0 + q1) + (q2 + q3);
                *(unsigned*)(P.ws + OFF_H8 + row * 1024 + lane * 4 + 256 * jx) = (unsigned)(q0 & 255) | ((unsigned)(q1 & 255) << 8) | ((unsigned)(q2 & 255) << 16) | ((unsigned)(q3 & 255) << 24);
            }
#pragma unroll
            for (int o = 1; o < 64; o <<= 1) qs += __shfl_xor(qs, o);
            if (lane == 0) *(f32x2*)(P.ws + OFF_HS + row * 8) = (f32x2){hs, (float)qs};
        }
    }
}

#define CE16(A, i, j) do { const float hi_ = fmaxf(A[i], A[j]); A[j] = fminf(A[i], A[j]); A[i] = hi_; } while (0)
#define SORT16(A) do { CE16(A, 0, 1); CE16(A, 2, 3); CE16(A, 0, 2); CE16(A, 1, 3); CE16(A, 1, 2); CE16(A, 4, 5); CE16(A, 6, 7); CE16(A, 4, 6); CE16(A, 5, 7); CE16(A, 5, 6); CE16(A, 0, 4); CE16(A, 2, 6); CE16(A, 2, 4); CE16(A, 1, 5); CE16(A, 3, 7); CE16(A, 3, 5); CE16(A, 1, 2); CE16(A, 3, 4); CE16(A, 5, 6); CE16(A, 8, 9); CE16(A, 10, 11); CE16(A, 8, 10); CE16(A, 9, 11); CE16(A, 9, 10); CE16(A, 12, 13); CE16(A, 14, 15); CE16(A, 12, 14); CE16(A, 13, 15); CE16(A, 13, 14); CE16(A, 8, 12); CE16(A, 10, 14); CE16(A, 10, 12); CE16(A, 9, 13); CE16(A, 11, 15); CE16(A, 11, 13); CE16(A, 9, 10); CE16(A, 11, 12); CE16(A, 13, 14); CE16(A, 0, 8); CE16(A, 4, 12); CE16(A, 4, 8); CE16(A, 2, 10); CE16(A, 6, 14); CE16(A, 6, 10); CE16(A, 2, 4); CE16(A, 6, 8); CE16(A, 10, 12); CE16(A, 1, 9); CE16(A, 5, 13); CE16(A, 5, 9); CE16(A, 3, 11); CE16(A, 7, 15); CE16(A, 7, 11); CE16(A, 3, 5); CE16(A, 7, 9); CE16(A, 11, 13); CE16(A, 1, 2); CE16(A, 3, 4); CE16(A, 5, 6); CE16(A, 7, 8); CE16(A, 9, 10); CE16(A, 11, 12); CE16(A, 13, 14); } while (0)
#define BITONIC16(A) do { CE16(A, 0, 8); CE16(A, 1, 9); CE16(A, 2, 10); CE16(A, 3, 11); CE16(A, 4, 12); CE16(A, 5, 13); CE16(A, 6, 14); CE16(A, 7, 15); CE16(A, 0, 4); CE16(A, 1, 5); CE16(A, 2, 6); CE16(A, 3, 7); CE16(A, 8, 12); CE16(A, 9, 13); CE16(A, 10, 14); CE16(A, 11, 15); CE16(A, 0, 2); CE16(A, 1, 3); CE16(A, 4, 6); CE16(A, 5, 7); CE16(A, 8, 10); CE16(A, 9, 11); CE16(A, 12, 14); CE16(A, 13, 15); CE16(A, 0, 1); CE16(A, 2, 3); CE16(A, 4, 5); CE16(A, 6, 7); CE16(A, 8, 9); CE16(A, 10, 11); CE16(A, 12, 13); CE16(A, 14, 15); } while (0)
#define INS16(L, xin) do { float x_ = (xin); _Pragma("unroll") for (int k_ = 0; k_ < 16; ++k_) { const float hi_ = fmaxf(L[k_], x_); x_ = fminf(L[k_], x_); L[k_] = hi_; } } while (0)

__device__ void peer_select_wave(const Params& P, size_t tok0) {
    const int lane = tid_opaque() & 63, r32 = lane & 31, hi = lane >> 5;
    const bf16_t* QP = (const bf16_t*)(P.ws + OFF_GB) + (tok0 + r32) * 1024; const bf16_t* SK = (const bf16_t*)(P.ws + OFF_SK);
    u32x2* EG = (u32x2*)(P.ws + OFF_EG) + (tok0 + r32) * 128;
#pragma unroll 1
    for (int h = 0; h < 8; ++h) {
        float a0[16], a1[16];
#pragma unroll
        for (int k = 0; k < 16; ++k) { a0[k] = -INFINITY; a1[k] = -INFINITY; }
#pragma unroll
        for (int p = 0; p < 2; ++p) {
            const int hp = h * 2 + p;
            bf16x8 qf[4];
#pragma unroll
            for (int ks = 0; ks < 4; ++ks) qf[ks] = *(const bf16x8*)(QP + hp * 64 + 16 * ks + 8 * hi);
            float L[16];
#pragma unroll
            for (int kt = 0; kt < 4; ++kt) {
                f32x16 acc = {};
#pragma unroll
                for (int ks = 0; ks < 4; ++ks) { const bf16x8 kf = *(const bf16x8*)(SK + ((size_t)hp * 128 + 32 * kt + r32) * 64 + 16 * ks + 8 * hi); acc = MFMA32(kf, qf[ks], acc); }
                float S[16];
#pragma unroll
                for (int r = 0; r < 16; ++r) { const unsigned key = (unsigned)(32 * kt + crow(r, hi)); S[r] = __uint_as_float((__float_as_uint(acc[r]) & ~127u) | key); }
                SORT16(S);
                if (kt == 0) {
#pragma unroll
                    for (int k = 0; k < 16; ++k) L[k] = S[k];
                } else {
#pragma unroll
                    for (int k = 0; k < 16; ++k) L[k] = fmaxf(L[k], S[15 - k]);
                    BITONIC16(L);
                }
            }
            {
                float O[16];
#pragma unroll
                for (int k = 0; k < 16; ++k) O[k] = __shfl_xor(L[15 - k], 32);
#pragma unroll
                for (int k = 0; k < 16; ++k) L[k] = fmaxf(L[k], O[k]);
                BITONIC16(L);
            }
#pragma unroll
            for (int k = 0; k < 16; ++k) { a0[k] = (p == 0) ? L[k] : a0[k]; a1[k] = (p == 1) ? L[k] : a1[k]; }
        }
        float best[16];
#pragma unroll
        for (int k = 0; k < 16; ++k) best[k] = __uint_as_float((__float_as_uint(a0[0] + a1[k]) & ~255u) | (unsigned)k);
#pragma unroll
        for (int i = 1; i < 16; ++i)
#pragma unroll
            for (int jx = 0; jx < 16; ++jx)
                if ((i + 1) * (jx + 1) <= 16) {
                    const float cs = a0[i] + a1[jx];
                    const float cv = __uint_as_float((__float_as_uint(cs) & ~255u) | (unsigned)(i * 16 + jx));
                    INS16(best, cv);
                }
        unsigned pk0[4], pk1[4];
#pragma unroll
        for (int q = 0; q < 4; ++q) {
            pk0[q] = (__float_as_uint(a0[4 * q]) & 127u) | ((__float_as_uint(a0[4 * q + 1]) & 127u) << 8) | ((__float_as_uint(a0[4 * q + 2]) & 127u) << 16) | ((__float_as_uint(a0[4 * q + 3]) & 127u) << 24);
            pk1[q] = (__float_as_uint(a1[4 * q]) & 127u) | ((__float_as_uint(a1[4 * q + 1]) & 127u) << 8) | ((__float_as_uint(a1[4 * q + 2]) & 127u) << 16) | ((__float_as_uint(a1[4 * q + 3]) & 127u) << 24);
        }
        unsigned pay[16];
#pragma unroll
        for (int k = 0; k < 16; ++k) {
            const unsigned code = __float_as_uint(best[k]) & 255u, ci = code >> 4, cj = code & 15u;
            const unsigned qi = ci >> 2, qj = cj >> 2;
            const unsigned w0 = (qi == 0u) ? pk0[0] : ((qi == 1u) ? pk0[1] : ((qi == 2u) ? pk0[2] : pk0[3]));
            const unsigned w1 = (qj == 0u) ? pk1[0] : ((qj == 1u) ? pk1[1] : ((qj == 2u) ? pk1[2] : pk1[3]));
            pay[k] = (((w0 >> ((ci & 3u) * 8u)) & 127u) << 7) | ((w1 >> ((cj & 3u) * 8u)) & 127u);
        }
        float e[16], es = 0.f;
#pragma unroll
        for (int k = 0; k < 16; ++k) { e[k] = __expf(best[k] - best[0]); es += e[k]; }
        const float inv = 1.0f / es;
        if (hi == 0) {
#pragma unroll
            for (int k = 0; k < 16; ++k) { u32x2 w; w.x = pay[k]; w.y = __float_as_uint(e[k] * inv); EG[h * 16 + k] = w; }
        }
    }
}
__device__ __forceinline__ unsigned xcc_id() { return (unsigned)__builtin_amdgcn_s_getreg((3 << 11) | 20) & 0xFu; }
template <int CTRL> __device__ __forceinline__ float dpp_add(float x) { const int v = __builtin_amdgcn_update_dpp(0, __float_as_int(x), CTRL, 0xf, 0xf, true); return x + __int_as_float(v); }
__device__ __forceinline__ float wave_sum_fast(float x) {
    x = dpp_add<0xB1>(x); x = dpp_add<0x4E>(x); x = dpp_add<0x141>(x); x = dpp_add<0x140>(x);
    x += __shfl_xor(x, 16); x += __shfl_xor(x, 32); return x;
}
__device__ __forceinline__ float dot16_fp8(const float (&hv)[16], const u32x4 r) {
    float s = 0.f;
    { const f32x2 a = __builtin_amdgcn_cvt_pk_f32_fp8((int)r.x, false), b = __builtin_amdgcn_cvt_pk_f32_fp8((int)r.x, true); s += hv[0] * a.x + hv[1] * a.y + hv[2] * b.x + hv[3] * b.y; }
    { const f32x2 a = __builtin_amdgcn_cvt_pk_f32_fp8((int)r.y, false), b = __builtin_amdgcn_cvt_pk_f32_fp8((int)r.y, true); s += hv[4] * a.x + hv[5] * a.y + hv[6] * b.x + hv[7] * b.y; }
    { const f32x2 a = __builtin_amdgcn_cvt_pk_f32_fp8((int)r.z, false), b = __builtin_amdgcn_cvt_pk_f32_fp8((int)r.z, true); s += hv[8] * a.x + hv[9] * a.y + hv[10] * b.x + hv[11] * b.y; }
    { const f32x2 a = __builtin_amdgcn_cvt_pk_f32_fp8((int)r.w, false), b = __builtin_amdgcn_cvt_pk_f32_fp8((int)r.w, true); s += hv[12] * a.x + hv[13] * a.y + hv[14] * b.x + hv[15] * b.y; }
    return s;
}
template <int NP, class F> __device__ __forceinline__ void partition_queue(const Params& P, LAS unsigned char* lds, int ctr_base, F f) {
    const int tid = tid_opaque();
    LAS int* slot = (LAS int*)(lds + LDS_BYTES - 64);
    unsigned* ctr = (unsigned*)(P.ws + OFF_CTR) + ctr_base;
    const int myx = (int)(xcc_id() & 7u);
    for (int pp = 0; pp < NP; ++pp) {
        const int p = (myx * (NP / 8) + pp) % NP;
        for (;;) {
            if (tid == 0) *slot = (int)atomicAdd(ctr + p, 1u);
            __syncthreads();
            const int item = *slot;
            __syncthreads();
            if (item >= NTOK / 64) break;
            f(p, item);
        }
    }
}
__device__ __forceinline__ float dot2bf(unsigned a, bf16v2 b, float c) { return __builtin_amdgcn_fdot2_f32_bf16(__builtin_bit_cast(bf16v2, a), b, c, false); }
struct UQuad { u32x4 r[2]; u32x4 ent; };
__device__ __forceinline__ void uq_issue(UQuad& q, const LAS u32x4* list, int J, int NQ, int g, const unsigned char* U4) {
    const int jj = J < NQ ? J : NQ - 1;
    q.ent = list[4 * jj + g];
    const unsigned char* rp = U4 + (size_t)q.ent.x * 512;
    q.r[0] = *(const u32x4*)rp; q.r[1] = *(const u32x4*)(rp + 256);
}
__device__ __forceinline__ int dot8_i4(unsigned w, unsigned hlo, unsigned hhi, int acc) {
    acc = __builtin_amdgcn_sdot4((int)hlo, (int)(w & 0x0F0F0F0Fu), acc, false);
    return __builtin_amdgcn_sdot4((int)hhi, (int)((w >> 4) & 0x0F0F0F0Fu), acc, false);
}
__device__ __forceinline__ float uq_dot(const UQuad& q, const u32x4 (&hp)[4]) {
    int a = 0, b = 0;
#pragma unroll
    for (int c = 0; c < 2; ++c) {
        const u32x4 r = q.r[c];
        a = dot8_i4(r.x, hp[2 * c].x, hp[2 * c].y, a); b = dot8_i4(r.y, hp[2 * c].z, hp[2 * c].w, b);
        a = dot8_i4(r.z, hp[2 * c + 1].x, hp[2 * c + 1].y, a); b = dot8_i4(r.w, hp[2 * c + 1].z, hp[2 * c + 1].w, b);
    }
    float s = (float)(a + b);
    s = dpp_add<0xB1>(s); s = dpp_add<0x4E>(s); s = dpp_add<0x141>(s); s = dpp_add<0x140>(s);
    return s;
}
__device__ __forceinline__ void peer_u_tokens(const Params& P, LAS unsigned char* lds, const size_t t0) {
    const int tid = tid_opaque(), lane = tid & 63, wid = tid >> 6, g = lane >> 4, li = lane & 15;
    const unsigned char* H8 = P.ws + OFF_H8 + li * 32; const unsigned char* U4 = P.ws + OFF_U8 + li * 16;
    const f32x2* HS = (const f32x2*)(P.ws + OFF_HS); const float* USC = (const float*)(P.ws + OFF_USC);
    const u32x4* EG4 = (const u32x4*)(P.ws + OFF_EG); float* W = (float*)(P.ws + OFF_W);
    LAS u32x4* list = (LAS u32x4*)(lds + wid * 16384);
#pragma unroll 2
    for (int i = 0; i < 8; ++i) {
        const u32x4 eg = EG4[(t0 + i) * 64 + lane];
        list[i * 128 + 2 * lane] = (u32x4){eg.x, eg.y, (unsigned)(2 * lane) | (unsigned)(i << 8), __float_as_uint(USC[eg.x])};
        list[i * 128 + 2 * lane + 1] = (u32x4){eg.z, eg.w, (unsigned)(2 * lane + 1) | (unsigned)(i << 8), __float_as_uint(USC[eg.z])};
    }
    constexpr int NQ = 256;
    u32x4 hp[4], hn[4]; f32x2 hsc = HS[t0], hsn = HS[t0 + 1];
#pragma unroll
    for (int c = 0; c < 2; ++c) { hp[2 * c] = *(const u32x4*)(H8 + t0 * 1024 + 512 * c); hp[2 * c + 1] = *(const u32x4*)(H8 + t0 * 1024 + 512 * c + 16);
                                  hn[2 * c] = *(const u32x4*)(H8 + (t0 + 1) * 1024 + 512 * c); hn[2 * c + 1] = *(const u32x4*)(H8 + (t0 + 1) * 1024 + 512 * c + 16); }
    int curtok = 0;
    UQuad q0, q1, q2, q3;
    uq_issue(q0, list, 0, NQ, g, U4); uq_issue(q1, list, 1, NQ, g, U4); uq_issue(q2, list, 2, NQ, g, U4); uq_issue(q3, list, 3, NQ, g, U4);
#define UQ_STEP(q, Jn) do { \
        const int tk = __builtin_amdgcn_readfirstlane((int)(q.ent.z >> 8)); \
        if (tk != curtok) { curtok = tk; _Pragma("unroll") for (int c = 0; c < 4; ++c) hp[c] = hn[c]; hsc = hsn; \
            if (tk + 1 < 8) { hsn = HS[t0 + tk + 1]; _Pragma("unroll") for (int c = 0; c < 2; ++c) { hn[2 * c] = *(const u32x4*)(H8 + (t0 + tk + 1) * 1024 + 512 * c); hn[2 * c + 1] = *(const u32x4*)(H8 + (t0 + tk + 1) * 1024 + 512 * c + 16); } } } \
        const float s = __uint_as_float(q.ent.w) * hsc.x * (uq_dot(q, hp) - 7.5f * hsc.y); \
        if (li == 0) W[(t0 + tk) * 128 + (q.ent.z & 255u)] = __uint_as_float(q.ent.y) * 0.5f * s * (1.0f + erff(s * 0.70710678118654752f)); \
        uq_issue(q, list, (Jn), NQ, g, U4); } while (0)
#pragma unroll 1
    for (int J = 0; J < NQ; J += 4) { UQ_STEP(q0, J + 4); UQ_STEP(q1, J + 5); UQ_STEP(q2, J + 6); UQ_STEP(q3, J + 7); }
#undef UQ_STEP
}
typedef int v4i_t __attribute__((ext_vector_type(4)));
struct VQuad { u32x4 r[2]; u32x2 ent; };
__device__ __forceinline__ void vq_issue(VQuad& q, const LAS u32x2* list, int J, int g, const unsigned char* V4) {
    const int jj = J < 32 ? J : 31;
    q.ent = list[4 * jj + g];
    const unsigned char* rp = V4 + (size_t)q.ent.x * 512;
    q.r[0] = *(const u32x4*)rp; q.r[1] = *(const u32x4*)(rp + 256);
}
__device__ __forceinline__ void vq_mma(const VQuad& q, v4i_t (&acc)[4], const unsigned sh, const u32x4 bm, const bool live) {
    const unsigned t = live ? ((q.ent.y & 255u) << sh) : 0u;
    const v4i_t B = {(int)(t & bm.x), (int)(t & bm.y), (int)(t & bm.z), (int)(t & bm.w)};
#pragma unroll
    for (int c = 0; c < 2; ++c) {
        const u32x4 r = q.r[c];
        const v4i_t lo = {(int)(r.x & 0x0F0F0F0Fu), (int)(r.y & 0x0F0F0F0Fu), (int)(r.z & 0x0F0F0F0Fu), (int)(r.w & 0x0F0F0F0Fu)};
        const v4i_t hi = {(int)((r.x >> 4) & 0x0F0F0F0Fu), (int)((r.y >> 4) & 0x0F0F0F0Fu), (int)((r.z >> 4) & 0x0F0F0F0Fu), (int)((r.w >> 4) & 0x0F0F0F0Fu)};
        acc[2 * c] = __builtin_amdgcn_mfma_i32_16x16x64_i8(lo, B, acc[2 * c], 0, 0, 0);
        acc[2 * c + 1] = __builtin_amdgcn_mfma_i32_16x16x64_i8(hi, B, acc[2 * c + 1], 0, 0, 0);
    }
}
__device__ __forceinline__ void peer_v_tokens(const Params& P, LAS unsigned char* lds, const size_t t0) {
    const int tid = tid_opaque(), lane = tid & 63, wid = tid >> 6, g = lane >> 4, li = lane & 15;
    const unsigned char* V4 = P.ws + OFF_V8 + li * 16; const float* VSC = (const float*)(P.ws + OFF_VSC);
    const u32x4* EG4 = (const u32x4*)(P.ws + OFF_EG); const f32x2* W2 = (const f32x2*)(P.ws + OFF_W);
    LAS u32x2* lists = (LAS u32x2*)(lds + wid * 8192);
    float swv[8], yoffv[8];
#pragma unroll
    for (int i = 0; i < 8; ++i) { const u32x4 eg = EG4[(t0 + i) * 64 + lane]; const f32x2 ww = W2[(t0 + i) * 64 + lane];
        const float w0 = ww.x * VSC[eg.x], w1 = ww.y * VSC[eg.z];
        float mx = fmaxf(fabsf(w0), fabsf(w1));
#pragma unroll
        for (int o = 1; o < 64; o <<= 1) mx = fmaxf(mx, __shfl_xor(mx, o));
        const float sw = fmaxf(mx * (1.0f / 127.0f), 1e-30f), inv = 1.0f / sw;
        const int q0 = (int)rintf(w0 * inv), q1 = (int)rintf(w1 * inv);
        *(LAS u32x4*)(lists + i * 128 + 2 * lane) = (u32x4){eg.x, (unsigned)q0, eg.z, (unsigned)q1};
        int qs = q0 + q1;
#pragma unroll
        for (int o = 1; o < 64; o <<= 1) qs += __shfl_xor(qs, o);
        swv[i] = sw; yoffv[i] = 7.5f * sw * (float)qs; }
    const unsigned sh = 8u * (unsigned)(li & 3);
    const u32x4 bm = {(li >> 2) == 0 ? 0xFFFFFFFFu : 0u, (li >> 2) == 1 ? 0xFFFFFFFFu : 0u, (li >> 2) == 2 ? 0xFFFFFFFFu : 0u, (li >> 2) == 3 ? 0xFFFFFFFFu : 0u};
#pragma unroll
    for (int i = 0; i < 8; ++i) {
        const size_t t = t0 + i;
        const LAS u32x2* list = lists + i * 128;
        v4i_t acc[4];
#pragma unroll
        for (int j = 0; j < 4; ++j) acc[j] = (v4i_t){0, 0, 0, 0};
        VQuad q0, q1, q2, q3;
        vq_issue(q0, list, 0, g, V4); vq_issue(q1, list, 1, g, V4); vq_issue(q2, list, 2, g, V4); vq_issue(q3, list, 3, g, V4);
#pragma unroll 1
        for (int J = 0; J < 32; J += 4) {
            vq_mma(q0, acc, sh, bm, true); vq_issue(q0, list, J + 4, g, V4);
            vq_mma(q1, acc, sh, bm, true); vq_issue(q1, list, J + 5, g, V4);
            vq_mma(q2, acc, sh, bm, true); vq_issue(q2, list, J + 6, g, V4);
            vq_mma(q3, acc, sh, bm, true); vq_issue(q3, list, J + 7, g, V4);
        }
        const float sw = swv[i], yoff = yoffv[i];
        const int dbase = 128 * g + 8 * (li >> 2) + (li & 3);
        const float* gt2 = (const float*)(P.ws + OFF_ADA) + (t >> 11) * 6144 + 5120;
        float* xr = P.out + t * 1024;
        float pre[16]; float s = 0.f;
#pragma unroll
        for (int c = 0; c < 2; ++c)
#pragma unroll
            for (int hf = 0; hf < 2; ++hf)
#pragma unroll
                for (int r = 0; r < 4; ++r) { const int d = dbase + 512 * c + 32 * r + 4 * hf;
                    const float yv = sw * (float)acc[2 * c + hf][r] - yoff;
                    const float pv = ALPHA * xr[d] + gt2[d] * yv; pre[8 * c + 4 * hf + r] = pv; s += pv; }
        const float mean = wave_sum(s) * (1.0f / 1024.0f); float s2 = 0.f;
#pragma unroll
        for (int e = 0; e < 16; ++e) { pre[e] -= mean; s2 += pre[e] * pre[e]; }
        const float rstd = rsqrtf(wave_sum(s2) * (1.0f / 1024.0f) + LN_EPS);
#pragma unroll
        for (int c = 0; c < 2; ++c)
#pragma unroll
            for (int hf = 0; hf < 2; ++hf)
#pragma unroll
                for (int r = 0; r < 4; ++r) { const int d = dbase + 512 * c + 32 * r + 4 * hf;
                    xr[d] = pre[8 * c + 4 * hf + r] * rstd * P.ln2_g[d] + P.ln2_b[d]; }
    }
}

#define XB_TMO      128
#define XB_XCNT(j)  (256  + 64 * (j))
#define XB_XSUB(j)  (1280 + 64 * (j))
#define XB_XGEN(j)  (2304 + 64 * (j))
#define XB_TOP      3328
#define XB_TOPGEN   3392
#define XCD_BAR_WORDS 3456
#define XB_SPIN_CAP (1u << 22)
__device__ __forceinline__ unsigned xb_ld(unsigned* p)              { return __hip_atomic_load(p, __ATOMIC_RELAXED, __HIP_MEMORY_SCOPE_AGENT); }
__device__ __forceinline__ unsigned xb_add(unsigned* p, unsigned v) { return __hip_atomic_fetch_add(p, v, __ATOMIC_RELAXED, __HIP_MEMORY_SCOPE_AGENT); }
#define XB_SPIN(cond, bar) do { unsigned _sp = 0; while (cond) { __builtin_amdgcn_s_sleep(1); \
    if ((++_sp & 255u) == 0u) { if (xb_ld(&(bar)[XB_TMO])) break; if (_sp > XB_SPIN_CAP) { atomicAdd(&(bar)[XB_TMO], 1u); break; } } } } while (0)
struct XcdBarrier { unsigned* bar; unsigned x; volatile LAS unsigned* st; };
__device__ __forceinline__ XcdBarrier xcd_barrier_post(unsigned* bar, volatile LAS unsigned* st) {
    XcdBarrier b; b.bar = bar; b.x = xcc_id(); b.st = st;
    if (threadIdx.x == 0) (void)xb_add(&bar[XB_XCNT(b.x)], 1u);
    return b;
}
__device__ __forceinline__ void xcd_barrier_complete(unsigned* bar, unsigned x, unsigned& nloc, unsigned& nx) {
    const unsigned G = gridDim.x * gridDim.y * gridDim.z;
    unsigned sum, cnt, mine, sp = 0u;
    for (;;) {
        sum = 0u; cnt = 0u; mine = 0u;
#pragma unroll
        for (unsigned j = 0; j < 16; ++j) { const unsigned c = xb_ld(&bar[XB_XCNT(j)]); sum += c; cnt += (c > 0u) ? 1u : 0u; mine = (j == x) ? c : mine; }
        if (sum == G) break;
        __builtin_amdgcn_s_sleep(1);
        if ((++sp & 255u) == 0u) { if (xb_ld(&bar[XB_TMO])) break; if (sp > XB_SPIN_CAP) { atomicAdd(&bar[XB_TMO], 1u); break; } }
    }
    nloc = mine > 0u ? mine : 1u; nx = cnt > 0u ? cnt : 1u;
}
__device__ __forceinline__ void xcd_barrier(const XcdBarrier& b) {
    asm volatile("s_waitcnt vmcnt(0)" ::: "memory");
    __syncthreads();
    if (threadIdx.x == 0) {
        unsigned* bar = b.bar;
        __builtin_amdgcn_s_waitcnt(0);
        unsigned nloc = b.st[0], nx = b.st[1];
        if (nloc == 0u) { xcd_barrier_complete(bar, b.x, nloc, nx); b.st[0] = nloc; b.st[1] = nx; }
        const unsigned old = xb_add(&bar[XB_XSUB(b.x)], 1u);
        const unsigned gen = old / nloc;
        if (old + 1u == (gen + 1u) * nloc) {
            __builtin_amdgcn_fence(__ATOMIC_RELEASE, "agent");
            asm volatile("s_waitcnt vmcnt(0)" ::: "memory");
            const unsigned og = xb_add(&bar[XB_TOP], 1u);
            const unsigned tg = og / nx;
            if (og + 1u == (tg + 1u) * nx) xb_add(&bar[XB_TOPGEN], 1u);
            else XB_SPIN(xb_ld(&bar[XB_TOPGEN]) == tg, bar);
            __builtin_amdgcn_fence(__ATOMIC_ACQUIRE, "agent");
            xb_add(&bar[XB_XGEN(b.x)], 1u);
            asm volatile("s_waitcnt vmcnt(0)" ::: "memory");
        } else {
            XB_SPIN(xb_ld(&bar[XB_XGEN(b.x)]) == gen, bar);
            __builtin_amdgcn_fence(__ATOMIC_ACQUIRE, "agent");
            asm volatile("s_waitcnt vmcnt(0)" ::: "memory");
        }
    }
    __syncthreads();
}

__global__ void __launch_bounds__(NTHR, 2) fwd_megakernel(Params P) {
    extern __shared__ __attribute__((aligned(16))) unsigned char shm[];
    LAS unsigned char* lds = (LAS unsigned char*)shm;
    cg::grid_group grid = cg::this_grid();
    const int G = gridDim.x, bid = blockIdx.x;
    volatile LAS unsigned* xst = (volatile LAS unsigned*)(lds + LDS_BYTES - 128);
    if (threadIdx.x == 0) { xst[0] = 0u; xst[1] = 0u; }
    __syncthreads();
    const XcdBarrier xb = xcd_barrier_post((unsigned*)(P.ws + OFF_BAR), xst);

#ifndef P3
#define P3 0xff
#endif
#ifndef PH
#define PH 0xff
#endif
    if (PH & 1) phase0a(P, lds);
    grid.sync();
    if (PH & 2) phase0b(P);
    xcd_barrier(xb);
    if (PH & 4) {
        pg8::Gemm g; g.A = (const bf16_t*)(P.ws + OFF_H); g.Bt = (const bf16_t*)(P.ws + OFF_WIN); g.M = NTOK; g.N = INCOLS; { int k_ = 512; asm volatile("" : "+s"(k_)); g.K = k_; g.lda = k_; }
        pg8::StaticOrder S; S.init(NTOK, INCOLS, G, bid);
        EpiProj E; E.ws = P.ws; E.lb = (const float*)(P.ws + OFF_LB); E.ng = P.hgrn_ng; E.kmean = (float*)(P.ws + OFF_KMEAN);
        pg8::gemm_phase<EpiProj, pg8::StaticOrder, true>(lds, g, S, E);
    }
    xcd_barrier(xb);
    if (PH & 8) for (int it = bid; it < 256; it += G) hgrn_item(P, it, lds);
    if (PH & 16) for (int u = bid; u < 2048; u += G) { const int bh = u & 255, jj = u >> 8; moba_unit(P, bh >> 3, bh & 7, (jj + bh) & 7, lds); }
    xcd_barrier(xb);
    if ((PH & 32) && bid < NTOK / 256) { const int pm = bid;
        if (P3 & 1) yb_norm_panel(P, pm);
        __syncthreads();
        if (P3 & 2) { pg8::Gemm g; g.A = (const bf16_t*)(P.ws + OFF_EG); g.Bt = (const bf16_t*)(P.ws + OFF_WBA); g.M = NTOK; g.N = 1024; { int k_ = 256; asm volatile("" : "+s"(k_)); g.K = k_; } g.lda = 512;
          pg8::PanelOrder S; S.pm = pm; S.npn = 4; EpiMixA E; E.GA = (bf16_t*)(P.ws + OFF_GA);
          pg8::gemm_phase<EpiMixA, pg8::PanelOrder, true>(lds, g, S, E); }
        __syncthreads();
        if (P3 & 4) { pg8::Gemm g; g.A = (const bf16_t*)(P.ws + OFF_EG + 512); g.Bt = (const bf16_t*)(P.ws + OFF_WBB); g.M = NTOK; g.N = 1024; { int k_ = 256; asm volatile("" : "+s"(k_)); g.K = k_; } g.lda = 512;
          pg8::PanelOrder S; S.pm = pm; S.npn = 4; EpiMixB E; E.GA = (const bf16_t*)(P.ws + OFF_GA); E.GB = (const bf16_t*)(P.ws + OFF_GB); E.M8 = P.ws + OFF_QA;
          pg8::gemm_phase<EpiMixB, pg8::PanelOrder, true>(lds, g, S, E); }
        __syncthreads();
        if (P3 & 8) { pg8::Gemm g; g.A = (const bf16_t*)(P.ws + OFF_QA); g.Bt = (const bf16_t*)(P.ws + OFF_WOUT); g.M = NTOK; g.N = 1024; { int k_ = 512; asm volatile("" : "+s"(k_)); g.K = k_; g.lda = k_; }
          pg8::PanelOrder S; S.pm = pm; S.npn = 4; EpiOut E; E.ada = (const float*)(P.ws + OFF_ADA); E.D = (bf16_t*)(P.ws + OFF_GB);
          pg8::gemm_phase<EpiOut, pg8::PanelOrder, true>(lds, g, S, E); }
        __syncthreads();
        if (P3 & 16) ln1_panel(P, pm);
        __syncthreads();
        if (P3 & 32) { pg8::Gemm g; g.A = (const bf16_t*)(P.ws + OFF_H); g.Bt = (const bf16_t*)(P.ws + OFF_WQ); g.M = NTOK; g.N = 1024; g.K = 1024; g.lda = 1024;
          pg8::PanelOrder S; S.pm = pm; S.npn = 4; EpiBf16 E; E.O = (bf16_t*)(P.ws + OFF_GB);
          pg8::gemm_phase<EpiBf16, pg8::PanelOrder>(lds, g, S, E); }
        __syncthreads();
        { const size_t tok0 = (size_t)pm * 256 + (tid_opaque() >> 6) * 32;
          peer_select_wave(P, tok0);
          __syncthreads();
#pragma unroll 1
          for (int sb = 0; sb < 4; ++sb) {
              peer_u_tokens(P, lds, tok0 + 8 * sb);
              __syncthreads();
              peer_v_tokens(P, lds, tok0 + 8 * sb);
              __syncthreads();
          } }
    }
}

extern "C" void kernel_launch(void* const* d_in, const int* in_sizes, int n_in, void* d_out, int out_size, void* d_ws, size_t ws_size, hipStream_t stream) {
    static int grid_blocks = 0;
    if (grid_blocks == 0) {
        if (n_in != 18 || out_size != NTOK * DM || ws_size < WS_END) { fprintf(stderr, "kernel_launch: unexpected shapes (n_in %d, out %d, ws %zu, need %zu)\n", n_in, out_size, ws_size, (size_t)WS_END); grid_blocks = -1; return; }
        int dev = 0, cus = 0, per_cu = 0;
        hipGetDevice(&dev);
        hipDeviceGetAttribute(&cus, hipDeviceAttributeMultiprocessorCount, dev);
        if (hipFuncSetAttribute((const void*)fwd_megakernel, hipFuncAttributeMaxDynamicSharedMemorySize, LDS_BYTES) != hipSuccess) fprintf(stderr, "kernel_launch: hipFuncSetAttribute failed\n");
        hipOccupancyMaxActiveBlocksPerMultiprocessor(&per_cu, (const void*)fwd_megakernel, NTHR, LDS_BYTES);
        if (per_cu < 1) { fprintf(stderr, "kernel_launch: occupancy query says %d blocks per CU\n", per_cu); per_cu = 1; }
        if (per_cu > 1) per_cu = 1;
        grid_blocks = cus * per_cu;
        if (grid_blocks != NTOK / 256) { fprintf(stderr, "kernel_launch: built for a %d-CU device (one 256-token panel per workgroup), found %d\n", NTOK / 256, grid_blocks); grid_blocks = -1; return; }
        (void)hipGetLastError();
    }
    if (grid_blocks < 0) return;
    Params p{};
    p.x = (const float*)d_in[0]; p.c = (const float*)d_in[1]; p.w_ada = (const float*)d_in[2]; p.b_ada = (const float*)d_in[3]; p.w_in = (const float*)d_in[4];
    p.w_ba = (const float*)d_in[5]; p.w_bb = (const float*)d_in[6]; p.w_out = (const float*)d_in[7]; p.hgrn_lb = (const float*)d_in[8]; p.hgrn_ng = (const float*)d_in[9];
    p.ln1_g = (const float*)d_in[10]; p.ln1_b = (const float*)d_in[11]; p.peer_wq = (const float*)d_in[12]; p.peer_sk = (const float*)d_in[13]; p.peer_u = (const float*)d_in[14];
    p.peer_v = (const float*)d_in[15]; p.ln2_g = (const float*)d_in[16]; p.ln2_b = (const float*)d_in[17];
    p.out = (float*)d_out; p.ws = (unsigned char*)d_ws;
    if (hipMemsetAsync((char*)d_ws + OFF_BAR, 0, XCD_BAR_WORDS * 4, stream) != hipSuccess) fprintf(stderr, "kernel_launch: memset of the barrier words failed\n");
    void* args[] = {&p};
    hipError_t e = hipLaunchCooperativeKernel((const void*)fwd_megakernel, dim3(grid_blocks), dim3(NTHR), args, LDS_BYTES, stream);
    if (e != hipSuccess) fprintf(stderr, "cooperative launch failed: %s (grid %d)\n", hipGetErrorString(e), grid_blocks);
}
```

```cpp
#include <hip/hip_runtime.h>
#include <hip/hip_cooperative_groups.h>
#include <cstdio>
#include <cstdint>
#include <type_traits>
namespace cg = cooperative_groups;

#define LAS __attribute__((address_space(3)))
typedef unsigned short bf16_t;
typedef short bf16x8 __attribute__((ext_vector_type(8)));
typedef short s16x4 __attribute__((ext_vector_type(4)));
typedef float f32x2 __attribute__((ext_vector_type(2)));
typedef float f32x4 __attribute__((ext_vector_type(4)));
typedef float f32x16 __attribute__((ext_vector_type(16)));
typedef unsigned u32x2 __attribute__((ext_vector_type(2)));
typedef unsigned u32x4 __attribute__((ext_vector_type(4)));

constexpr int NB = 32, SEQ = 2048, DM = 1024, NTOK = NB * SEQ;
constexpr int INCOLS = 5632;
constexpr int NTHR = 512;
constexpr int LDS_BYTES = 147456;
constexpr float ALPHA = 1.189207115002721f;
constexpr float LN_EPS = 1e-5f, RMS_EPS = 1e-6f;
constexpr float LOG2E = 1.4426950408889634f;

constexpr size_t SZ_T512 = (size_t)NTOK * 512 * 2, SZ_T1024 = (size_t)NTOK * 1024 * 2;
constexpr size_t OFF_ADA = 0;
constexpr size_t OFF_LB = OFF_ADA + 786432;
constexpr size_t OFF_KMEAN = OFF_LB + 4096;
constexpr size_t OFF_WIN = OFF_KMEAN + 524288;
constexpr size_t OFF_WBA = OFF_WIN + (size_t)5632 * 1024 * 2;
constexpr size_t OFF_WBB = OFF_WBA + 1048576;
constexpr size_t OFF_WOUT = OFF_WBB + 1048576;
constexpr size_t OFF_WQ = OFF_WOUT + 2097152;
constexpr size_t OFF_SK = OFF_WQ + 2097152;
constexpr size_t OFF_U8 = OFF_SK + 262144;
constexpr size_t OFF_USC = OFF_U8 + 8388608;
constexpr size_t OFF_V8 = OFF_U8 + 16777216;
constexpr size_t OFF_VSC = OFF_V8 + 8388608;
constexpr size_t OFF_CTR = OFF_V8 + 16777216;
constexpr size_t OFF_BAR = OFF_CTR + 4096;
constexpr size_t OFF_EG = OFF_BAR + 16384;
constexpr size_t OFF_H = OFF_EG + (size_t)NTOK * 128 * 8;
constexpr size_t OFF_QA = OFF_H + SZ_T1024;
constexpr size_t OFF_KA = OFF_QA + SZ_T512;
constexpr size_t OFF_VA = OFF_KA + SZ_T512;
constexpr size_t OFF_HQ = OFF_VA + SZ_T512;
constexpr size_t OFF_HK = OFF_HQ + SZ_T512;
constexpr size_t OFF_HI = OFF_HK + SZ_T512;
constexpr size_t OFF_HG = OFF_HI + SZ_T512;
constexpr size_t OFF_GA = OFF_HG + SZ_T512;
constexpr size_t OFF_GB = OFF_GA + SZ_T1024;
constexpr size_t WS_END = OFF_GB + SZ_T1024;
constexpr size_t OFF_H8 = OFF_VA;
constexpr size_t OFF_HS = OFF_HQ;
constexpr size_t OFF_W = OFF_KA;
constexpr size_t OFF_Y = OFF_KA;

struct Params {
    const float *x, *c, *w_ada, *b_ada, *w_in, *w_ba, *w_bb, *w_out, *hgrn_lb, *hgrn_ng, *ln1_g, *ln1_b, *peer_wq, *peer_sk, *peer_u, *peer_v, *ln2_g, *ln2_b;
    float* out;
    unsigned char* ws;
};

typedef __bf16 bf16v2 __attribute__((ext_vector_type(2)));
__device__ __forceinline__ unsigned cvt_pk_bf16(float lo, float hi) { return __builtin_bit_cast(unsigned, __builtin_convertvector((f32x2){lo, hi}, bf16v2)); }
__device__ __forceinline__ float bf_lo(unsigned w) { return __uint_as_float(w << 16); }
__device__ __forceinline__ float bf_hi(unsigned w) { return __uint_as_float(w & 0xffff0000u); }
__device__ __forceinline__ float sigmoidf_(float x) { return __builtin_amdgcn_rcpf(1.0f + __builtin_amdgcn_exp2f(-LOG2E * x)); }
__device__ __forceinline__ float wave_sum(float v) {
#pragma unroll
    for (int o = 1; o < 64; o <<= 1) v += __shfl_xor(v, o);
    return v;
}
__device__ __forceinline__ int tid_opaque() { int t = threadIdx.x; asm volatile("" : "+v"(t)); return t; }
__device__ __forceinline__ int crow(int r, int hi) { return (r & 3) + 8 * (r >> 2) + 4 * hi; }
#define MFMA32(a, b, c) __builtin_amdgcn_mfma_f32_32x32x16_bf16(a, b, c, 0, 0, 0)

namespace pg8 {
constexpr int BM = 256, BK = 64, HALF = 128, HTB = HALF * BK * 2, STAGE_BYTES = 8 * HTB, NXCD = 8, WGM = 8;
__host__ __device__ __forceinline__ int lds_byte(int r, int c) { const int st = (r >> 4) * 2 + (c >> 5), rr = r & 15, cc = c & 31, ob = rr * 64 + cc * 2; return st * 1024 + (ob ^ (((ob >> 9) & 1) << 5)); }
__host__ __device__ __forceinline__ void stage_rc(int b, int& R, int& C) { const int st = b / 1024, sb = b % 1024, swz = sb ^ (((sb >> 9) & 1) << 5); R = (st >> 1) * 16 + swz / 64; C = (st & 1) * 32 + (swz % 64) / 2; }
__host__ __device__ __forceinline__ int perm32(int rho) { const int n = rho >> 4, i = rho & 15; return 8 * (i >> 2) + 4 * n + (i & 3); }

struct Unit { int pm, pn; };
struct Gemm { const bf16_t* A; const bf16_t* Bt; int M, N, K, lda; };

struct StaticOrder {
    int nM, nN, nwg, G, c;
    __device__ void init(int M, int N, int G_, int c_) { nM = M / BM; nN = N / BM; nwg = nM * nN; G = G_; c = c_; }
    __device__ bool next(int i, Unit& u) const {
        const long L = (long)i * G + c; if (L >= nwg) return false;
        int wgid = (int)L; { const int q = nwg / NXCD, r = nwg % NXCD, xcd = wgid % NXCD, off = wgid / NXCD; wgid = (xcd < r ? xcd * (q + 1) : r * (q + 1) + (xcd - r) * q) + off; }
        const int nig = WGM * nN, gid = wgid / nig, fm = gid * WGM, gsz = (nM - fm) < WGM ? (nM - fm) : WGM;
        u.pm = fm + ((wgid % nig) % gsz); u.pn = (wgid % nig) / gsz; return true;
    }
};
struct PanelOrder {
    int pm, npn;
    __device__ bool next(int i, Unit& u) const { if (i >= npn) return false; u.pm = pm; u.pn = i; return true; }
};

template <class Epi, class Sched, bool MX = false>
__device__ __forceinline__ void gemm_phase(LAS unsigned char* lds, const Gemm g, const Sched& S, const Epi& E) {
    const int tid = tid_opaque(), wid = __builtin_amdgcn_readfirstlane(tid >> 6), lane = tid & 63, wr = wid >> 2, wc = wid & 3, fr = lane & 15, fq = lane >> 4;
    const int K = g.K, nt = K / BK;
    unsigned voffA, voffB;
    { int R, C; stage_rc(tid * 16, R, C); const int Rb = Epi::PERM ? ((R & ~31) + perm32(R & 31)) : R;
      voffA = (unsigned)(R * g.lda + C) * 2u; voffB = (unsigned)(Rb * K + C) * 2u; }
    const size_t rvoffA = (size_t)128 * g.lda, rvoffB = (size_t)128 * K;
    const size_t kstep = (size_t)(BK * 2);
    const size_t hstep = (size_t)HALF * K * 2;
    const size_t tstep = 2 * hstep;
    const size_t hstepA = (size_t)HALF * g.lda * 2, tstepA = 2 * hstepA;
    const unsigned ldsw = (unsigned)wid * 1024u;
    const int aoff = lds_byte(wr * 64 + fr, fq * 8), boff = lds_byte(wc * 32 + fr, fq * 8);
#define PG8_SA(b, h) (((b) * 2 + (h)) * HTB)
#define PG8_SB(b, h) ((4 + (b) * 2 + (h)) * HTB)
#define PG8_STAGE(bufoff, gbase, voff) do { unsigned vo_ = (voff); asm volatile("" : "+v"(vo_));     \
        _Pragma("unroll") for (int _i = 0; _i < 2; ++_i) \
        __builtin_amdgcn_global_load_lds((const unsigned*)((const char*)(gbase) + _i * r##voff + vo_), (LAS unsigned*)(lds + (bufoff) + ldsw + _i * 8192), 16, 0, 0); } while (0)
#define PG8_LDX(dst, off) do { const v4i_ lo_ = *(const LAS v4i_*)(lds + (off)), hi_ = *(const LAS v4i_*)(lds + (off) + 1024); dst = __builtin_shufflevector(lo_, hi_, 0, 1, 2, 3, 4, 5, 6, 7); } while (0)
#define PG8_LDA(dst, b, h) do { if constexpr (MX) { _Pragma("unroll") for (int m = 0; m < 4; ++m) PG8_LDX(dst##X[m], PG8_SA(b, h) + aoff + m * 2048); } \
        else { _Pragma("unroll") for (int m = 0; m < 4; ++m) _Pragma("unroll") for (int k = 0; k < 2; ++k) dst[m][k] = *(const LAS bf16x8*)(lds + PG8_SA(b, h) + aoff + m * 2048 + k * 1024); } } while (0)
#define PG8_LDB(dst, b, h) do { if constexpr (MX) { _Pragma("unroll") for (int n = 0; n < 2; ++n) PG8_LDX(dst##X[n], PG8_SB(b, h) + boff + n * 2048); } \
        else { _Pragma("unroll") for (int n = 0; n < 2; ++n) _Pragma("unroll") for (int k = 0; k < 2; ++k) dst[n][k] = *(const LAS bf16x8*)(lds + PG8_SB(b, h) + boff + n * 2048 + k * 1024); } } while (0)
#define PG8_MMA(ai, bj, At, Bt) do { __builtin_amdgcn_s_setprio(1); \
        if constexpr (MX) { _Pragma("unroll") for (int m = 0; m < 4; ++m) _Pragma("unroll") for (int n = 0; n < 2; ++n) \
            asm volatile("v_mfma_scale_f32_16x16x128_f8f6f4 %0, %1, %2, %0, %3, %3 op_sel_hi:[0,0,0]" : "+v"(acc[ai][bj][m][n]) : "v"(Bt##X[n]), "v"(At##X[m]), "v"(mxscale)); } \
        else { _Pragma("unroll") for (int m = 0; m < 4; ++m) _Pragma("unroll") for (int n = 0; n < 2; ++n) _Pragma("unroll") for (int k = 0; k < 2; ++k) \
            acc[ai][bj][m][n] = __builtin_amdgcn_mfma_f32_16x16x32_bf16(Bt[n][k], At[m][k], acc[ai][bj][m][n], 0, 0, 0); } \
        __builtin_amdgcn_s_setprio(0); } while (0)
#define PG8_WAIT_V(n) asm volatile("s_waitcnt vmcnt(" #n ")" ::: "memory")
#define PG8_WAIT_L(n) asm volatile("s_waitcnt lgkmcnt(" #n ")" ::: "memory")
#define PG8_BAR __builtin_amdgcn_s_barrier()
#define PG8_SCHED __builtin_amdgcn_sched_barrier(0)
    Unit cur, nxt; int ui = 0;
    if (!S.next(0, cur)) return;
    f32x4 acc[2][2][4][2];
#pragma unroll
    for (int a = 0; a < 2; ++a)
#pragma unroll
        for (int b = 0; b < 2; ++b)
#pragma unroll
            for (int m = 0; m < 4; ++m)
#pragma unroll
                for (int n = 0; n < 2; ++n) acc[a][b][m][n] = (f32x4){0.f, 0.f, 0.f, 0.f};
    typedef int v4i_ __attribute__((ext_vector_type(4))); typedef int v8i_ __attribute__((ext_vector_type(8)));
    bf16x8 At[4][2], B0[2][2], B1[2][2];
    v8i_ AtX[4], B0X[2], B1X[2];
    const int mxscale = 0x7f7f7f7f;
    const char* cA = (const char*)g.A + (size_t)cur.pm * tstepA; const char* cB = (const char*)g.Bt + (size_t)cur.pn * tstep;
    PG8_STAGE(PG8_SB(0, 0), cB, voffB); PG8_STAGE(PG8_SA(0, 0), cA, voffA); PG8_STAGE(PG8_SB(0, 1), cB + hstep, voffB); PG8_STAGE(PG8_SA(0, 1), cA + hstepA, voffA);
    if (wr == 1) PG8_BAR;
    PG8_WAIT_V(4); PG8_BAR;
    PG8_STAGE(PG8_SB(1, 0), cB + kstep, voffB); PG8_STAGE(PG8_SA(1, 0), cA + kstep, voffA); PG8_STAGE(PG8_SB(1, 1), cB + hstep + kstep, voffB);
    PG8_WAIT_V(6); PG8_BAR;
    for (;;) {
        const bool has_next = S.next(ui + 1, nxt);
        const char* nA = has_next ? (const char*)g.A + (size_t)nxt.pm * tstepA : cA; const char* nB = has_next ? (const char*)g.Bt + (size_t)nxt.pn * tstep : cB;
        for (int t = 0; t < nt; t += 2) {
            const bool last = (t == nt - 2);
            const char* a1 = cA + (size_t)(t + 1) * kstep;
            const char* a2 = last ? nA : cA + (size_t)(t + 2) * kstep; const char* b2 = last ? nB : cB + (size_t)(t + 2) * kstep;
            const char* a3 = a2 + kstep; const char* b3 = b2 + kstep;
            PG8_LDB(B0, 0, 0); PG8_SCHED; PG8_LDA(At, 0, 0); PG8_STAGE(PG8_SA(1, 1), a1 + hstepA, voffA);
            PG8_WAIT_L(8); PG8_BAR; PG8_WAIT_L(0); PG8_MMA(0, 0, At, B0); PG8_BAR; PG8_SCHED;
            PG8_LDB(B1, 0, 1); PG8_STAGE(PG8_SB(0, 0), b2, voffB);
            PG8_BAR; PG8_WAIT_L(0); PG8_MMA(0, 1, At, B1); PG8_BAR;
            PG8_LDA(At, 0, 1); PG8_STAGE(PG8_SA(0, 0), a2, voffA);
            PG8_BAR; PG8_WAIT_L(0); PG8_MMA(1, 0, At, B0); PG8_BAR; PG8_SCHED;
            PG8_STAGE(PG8_SB(0, 1), b2 + hstep, voffB);
            PG8_WAIT_V(6); PG8_BAR; PG8_MMA(1, 1, At, B1); PG8_BAR;
            PG8_LDB(B0, 1, 0); PG8_SCHED; PG8_LDA(At, 1, 0); PG8_STAGE(PG8_SA(0, 1), a2 + hstepA, voffA);
            PG8_WAIT_L(8); PG8_BAR; PG8_WAIT_L(0); PG8_MMA(0, 0, At, B0); PG8_BAR; PG8_SCHED;
            PG8_LDB(B1, 1, 1); PG8_STAGE(PG8_SB(1, 0), b3, voffB);
            PG8_BAR; PG8_WAIT_L(0); PG8_MMA(0, 1, At, B1); PG8_BAR;
            PG8_LDA(At, 1, 1); PG8_STAGE(PG8_SA(1, 0), a3, voffA);
            PG8_BAR; PG8_WAIT_L(0); PG8_MMA(1, 0, At, B0); PG8_BAR; PG8_SCHED;
            PG8_STAGE(PG8_SB(1, 1), b3 + hstep, voffB);
            PG8_WAIT_V(6); PG8_BAR; PG8_MMA(1, 1, At, B1); PG8_BAR;
        }
        if constexpr (MX) asm volatile("s_nop 15\n\ts_nop 15" ::: "memory");
        E(acc, cur, wr, wc, fr, fq);
        if (!has_next) break;
#pragma unroll
        for (int a = 0; a < 2; ++a)
#pragma unroll
            for (int b = 0; b < 2; ++b)
#pragma unroll
                for (int m = 0; m < 4; ++m)
#pragma unroll
                    for (int n = 0; n < 2; ++n) acc[a][b][m][n] = (f32x4){0.f, 0.f, 0.f, 0.f};
        cur = nxt; cA = nA; cB = nB; ++ui;
    }
    PG8_WAIT_V(0);
    if (wr == 0) PG8_BAR;
    PG8_BAR;
#undef PG8_SA
#undef PG8_SB
#undef PG8_STAGE
#undef PG8_LDX
#undef PG8_LDA
#undef PG8_LDB
#undef PG8_MMA
#undef PG8_WAIT_V
#undef PG8_WAIT_L
#undef PG8_BAR
#undef PG8_SCHED
}
}
using pg8::Unit;

struct EpiProj {
    static constexpr bool PERM = true;
    unsigned char* ws; const float* lb; const float* ng; float* kmean;
    __device__ __forceinline__ void operator()(const f32x4 (&acc)[2][2][4][2], const Unit& u, int wr, int wc, int fr, int fq) const {
        const int pn = u.pn; int seg, colt, ldc; size_t boff;
        if (pn < 14) { seg = pn >> 1; colt = (pn & 1) * 256; ldc = 512; boff = OFF_QA + (size_t)seg * SZ_T512; }
        else if (pn < 18) { seg = 7; colt = (pn - 14) * 256; ldc = 1024; boff = OFF_GA; }
        else { seg = 8; colt = (pn - 18) * 256; ldc = 1024; boff = OFF_GB; }
        bf16_t* base = (bf16_t*)(ws + boff);
        const int row0 = u.pm * 256 + wr * 64 + fr, col0 = colt + wc * 32 + 8 * fq;
        float pv[2][8];
#pragma unroll
        for (int bj = 0; bj < 2; ++bj)
#pragma unroll
            for (int e = 0; e < 8; ++e) pv[bj][e] = (seg == 4) ? (1.0f - lb[col0 + bj * 128 + e]) : ((seg == 6) ? ng[col0 + bj * 128 + e] : 0.f);
        float cs[2][8];
#pragma unroll
        for (int bj = 0; bj < 2; ++bj)
#pragma unroll
            for (int e = 0; e < 8; ++e) cs[bj][e] = 0.f;
#pragma unroll
        for (int ai = 0; ai < 2; ++ai)
#pragma unroll
            for (int m = 0; m < 4; ++m) {
                bf16_t* rowp = base + (size_t)(row0 + ai * 128 + m * 16) * ldc + col0;
#pragma unroll
                for (int bj = 0; bj < 2; ++bj) {
                    float v[8];
#pragma unroll
                    for (int e = 0; e < 4; ++e) { v[e] = acc[ai][bj][m][0][e] * (1.0f / 32.0f); v[4 + e] = acc[ai][bj][m][1][e] * (1.0f / 32.0f); }
                    if (seg == 0) {
#pragma unroll
                        for (int e = 0; e < 8; ++e) v[e] *= (0.125f * LOG2E);
                    } else if (seg == 1) {
#pragma unroll
                        for (int e = 0; e < 8; ++e) cs[bj][e] += v[e];
                    } else if (seg == 3) {
#pragma unroll
                        for (int e = 0; e < 8; ++e) v[e] = v[e] * sigmoidf_(v[e]);
                    } else if (seg == 4) {
#pragma unroll
                        for (int e = 0; e < 8; ++e) v[e] = pv[bj][e] * sigmoidf_(-v[e]);
                    } else if (seg == 6) {
#pragma unroll
                        for (int e = 0; e < 8; ++e) v[e] = pv[bj][e] * v[e] * sigmoidf_(v[e]);
                    } else if (seg >= 7) {
#pragma unroll
                        for (int e = 0; e < 8; ++e) v[e] = sigmoidf_(v[e]);
                    }
                    u32x4 w; w.x = cvt_pk_bf16(v[0], v[1]); w.y = cvt_pk_bf16(v[2], v[3]); w.z = cvt_pk_bf16(v[4], v[5]); w.w = cvt_pk_bf16(v[6], v[7]);
                    *(u32x4*)(rowp + bj * 128) = w;
                }
            }
        if (seg == 1) {
#pragma unroll
            for (int bj = 0; bj < 2; ++bj)
#pragma unroll
                for (int e = 0; e < 8; ++e) {
                    float s = cs[bj][e];
                    s += __shfl_xor(s, 1); s += __shfl_xor(s, 2); s += __shfl_xor(s, 4); s += __shfl_xor(s, 8);
                    if (fr == 0) atomicAdd(kmean + (size_t)u.pm * 512 + col0 + bj * 128 + e, s);
                }
        }
    }
};
struct EpiMixA {
    static constexpr bool PERM = true;
    bf16_t* GA;
    __device__ __forceinline__ void operator()(const f32x4 (&acc)[2][2][4][2], const Unit& u, int wr, int wc, int fr, int fq) const {
        const int row0 = u.pm * 256 + wr * 64 + fr, col0 = u.pn * 256 + wc * 32 + 8 * fq;
#pragma unroll
        for (int ai = 0; ai < 2; ++ai)
#pragma unroll
            for (int m = 0; m < 4; ++m) {
                bf16_t* rowp = GA + (size_t)(row0 + ai * 128 + m * 16) * 1024 + col0;
#pragma unroll
                for (int bj = 0; bj < 2; ++bj) {
                    const u32x4 g = *(const u32x4*)(rowp + bj * 128);
                    const f32x4 a0 = acc[ai][bj][m][0], a1 = acc[ai][bj][m][1];
                    u32x4 w;
                    constexpr float S = 1.0f / 32.0f;
                    w.x = cvt_pk_bf16(bf_lo(g.x) * a0[0] * S, bf_hi(g.x) * a0[1] * S); w.y = cvt_pk_bf16(bf_lo(g.y) * a0[2] * S, bf_hi(g.y) * a0[3] * S);
                    w.z = cvt_pk_bf16(bf_lo(g.z) * a1[0] * S, bf_hi(g.z) * a1[1] * S); w.w = cvt_pk_bf16(bf_lo(g.w) * a1[2] * S, bf_hi(g.w) * a1[3] * S);
                    *(u32x4*)(rowp + bj * 128) = w;
                }
            }
    }
};
struct EpiMixB {
    static constexpr bool PERM = true;
    const bf16_t* GA; const bf16_t* GB; unsigned char* M8;
    __device__ __forceinline__ void operator()(const f32x4 (&acc)[2][2][4][2], const Unit& u, int wr, int wc, int fr, int fq) const {
        const int row0 = u.pm * 256 + wr * 64 + fr, col0 = u.pn * 256 + wc * 32 + 8 * fq;
#pragma unroll
        for (int ai = 0; ai < 2; ++ai)
#pragma unroll
            for (int m = 0; m < 4; ++m) {
                const size_t off = (size_t)(row0 + ai * 128 + m * 16) * 1024 + col0;
#pragma unroll
                for (int bj = 0; bj < 2; ++bj) {
                    const u32x4 g = *(const u32x4*)(GB + off + bj * 128);
                    const u32x4 mx = *(const u32x4*)(GA + off + bj * 128);
                    const f32x4 a0 = acc[ai][bj][m][0], a1 = acc[ai][bj][m][1];
                    constexpr float S = 1.0f / 32.0f;
                    int w0 = __builtin_amdgcn_cvt_pk_fp8_f32(bf_lo(mx.x) + bf_lo(g.x) * a0[0] * S, bf_hi(mx.x) + bf_hi(g.x) * a0[1] * S, 0, false); w0 = __builtin_amdgcn_cvt_pk_fp8_f32(bf_lo(mx.y) + bf_lo(g.y) * a0[2] * S, bf_hi(mx.y) + bf_hi(g.y) * a0[3] * S, w0, true);
                    int w1 = __builtin_amdgcn_cvt_pk_fp8_f32(bf_lo(mx.z) + bf_lo(g.z) * a1[0] * S, bf_hi(mx.z) + bf_hi(g.z) * a1[1] * S, 0, false); w1 = __builtin_amdgcn_cvt_pk_fp8_f32(bf_lo(mx.w) + bf_lo(g.w) * a1[2] * S, bf_hi(mx.w) + bf_hi(g.w) * a1[3] * S, w1, true);
                    *(u32x2*)(M8 + off + bj * 128) = (u32x2){(unsigned)w0, (unsigned)w1};
                }
            }
    }
};
struct EpiOut {
    static constexpr bool PERM = true;
    const float* ada; bf16_t* D;
    __device__ __forceinline__ void operator()(const f32x4 (&acc)[2][2][4][2], const Unit& u, int wr, int wc, int fr, int fq) const {
        const int row0 = u.pm * 256 + wr * 64 + fr, col0 = u.pn * 256 + wc * 32 + 8 * fq;
        const float* gt1 = ada + (size_t)(u.pm >> 3) * 6144 + 2048 + col0;
        f32x4 g[2][2];
#pragma unroll
        for (int bj = 0; bj < 2; ++bj) { g[bj][0] = *(const f32x4*)(gt1 + bj * 128); g[bj][1] = *(const f32x4*)(gt1 + bj * 128 + 4); }
#pragma unroll
        for (int ai = 0; ai < 2; ++ai)
#pragma unroll
            for (int m = 0; m < 4; ++m) {
                bf16_t* rowp = D + (size_t)(row0 + ai * 128 + m * 16) * 1024 + col0;
#pragma unroll
                for (int bj = 0; bj < 2; ++bj) {
                    const f32x4 a0 = acc[ai][bj][m][0] * g[bj][0] * (1.0f / 32.0f), a1 = acc[ai][bj][m][1] * g[bj][1] * (1.0f / 32.0f);
                    u32x4 w; w.x = cvt_pk_bf16(a0[0], a0[1]); w.y = cvt_pk_bf16(a0[2], a0[3]); w.z = cvt_pk_bf16(a1[0], a1[1]); w.w = cvt_pk_bf16(a1[2], a1[3]);
                    *(u32x4*)(rowp + bj * 128) = w;
                }
            }
    }
};
struct EpiBf16 {
    static constexpr bool PERM = true;
    bf16_t* O;
    __device__ __forceinline__ void operator()(const f32x4 (&acc)[2][2][4][2], const Unit& u, int wr, int wc, int fr, int fq) const {
        const int row0 = u.pm * 256 + wr * 64 + fr, col0 = u.pn * 256 + wc * 32 + 8 * fq;
#pragma unroll
        for (int ai = 0; ai < 2; ++ai)
#pragma unroll
            for (int m = 0; m < 4; ++m) {
                bf16_t* rowp = O + (size_t)(row0 + ai * 128 + m * 16) * 1024 + col0;
#pragma unroll
                for (int bj = 0; bj < 2; ++bj) {
                    const f32x4 a0 = acc[ai][bj][m][0], a1 = acc[ai][bj][m][1];
                    u32x4 w; w.x = cvt_pk_bf16(a0[0], a0[1]); w.y = cvt_pk_bf16(a0[2], a0[3]); w.z = cvt_pk_bf16(a1[0], a1[1]); w.w = cvt_pk_bf16(a1[2], a1[3]);
                    *(u32x4*)(rowp + bj * 128) = w;
                }
            }
    }
};

__device__ void phase0a(const Params& P, LAS unsigned char* lds) {
    const int tid = tid_opaque(), G = gridDim.x, bid = blockIdx.x;
    for (int it = bid; it < 192; it += G) {
        LAS float* sc = (LAS float*)lds;
        for (int i = tid; i < 32 * 1024; i += NTHR) { const float cv = P.c[i]; sc[i] = cv * sigmoidf_(cv); }
        __syncthreads();
        const int kg = tid >> 5, col = tid & 31;
        float a[32];
#pragma unroll
        for (int b = 0; b < 32; ++b) a[b] = 0.f;
#pragma unroll 1
        for (int k = kg * 64; k < kg * 64 + 64; k += 8) {
            float w[8];
#pragma unroll
            for (int e = 0; e < 8; ++e) w[e] = __builtin_nontemporal_load(P.w_ada + (size_t)(k + e) * 6144 + it * 32 + col);
#pragma unroll
            for (int e4 = 0; e4 < 2; ++e4) {
#pragma unroll
                for (int b = 0; b < 32; ++b) { const f32x4 s = *(const LAS f32x4*)(sc + b * 1024 + k + 4 * e4); a[b] += s[0] * w[4 * e4] + s[1] * w[4 * e4 + 1] + s[2] * w[4 * e4 + 2] + s[3] * w[4 * e4 + 3]; }
                asm volatile("" ::: "memory");
            }
        }
        __syncthreads();
        LAS float* red = (LAS float*)lds;
#pragma unroll
        for (int b = 0; b < 32; ++b) red[(kg * 32 + b) * 32 + col] = a[b];
        __syncthreads();
        for (int o = tid; o < 1024; o += NTHR) { const int b = o >> 5, cc = o & 31; float s = 0.f;
#pragma unroll
            for (int g2 = 0; g2 < 16; ++g2) s += red[(g2 * 32 + b) * 32 + cc];
            ((float*)(P.ws + OFF_ADA))[(size_t)b * 6144 + it * 32 + cc] = s + P.b_ada[it * 32 + cc]; }
        __syncthreads();
    }
    const size_t gsz = (size_t)G * NTHR;
    { const int gt = bid * NTHR + tid, gs = G * NTHR;
      if (gt < 512) ((float*)(P.ws + OFF_LB))[gt] = sigmoidf_(P.hgrn_lb[gt] - P.hgrn_lb[512 + gt]);
      for (int i = gt; i < 32 * 8 * 512; i += gs) ((float*)(P.ws + OFF_KMEAN))[i] = 0.f; }
    {
        LAS float* tile = (LAS float*)lds;
        const int I0 = 16 * 88, I1 = I0 + 8 * 16, I2 = I1 + 8 * 16, I3 = I2 + 16 * 16, I4 = I3 + 16 * 16;
        for (int it = bid; it < I4; it += G) {
            const float* W; bf16_t* WT; int K, N, r;
            if (it < I0) { W = P.w_in; WT = (bf16_t*)(P.ws + OFF_WIN); K = 1024; N = 5632; r = it; }
            else if (it < I1) { W = P.w_ba; WT = (bf16_t*)(P.ws + OFF_WBA); K = 512; N = 1024; r = it - I0; }
            else if (it < I2) { W = P.w_bb; WT = (bf16_t*)(P.ws + OFF_WBB); K = 512; N = 1024; r = it - I1; }
            else if (it < I3) { W = P.w_out; WT = (bf16_t*)(P.ws + OFF_WOUT); K = 1024; N = 1024; r = it - I2; }
            else { W = P.peer_wq; WT = (bf16_t*)(P.ws + OFF_WQ); K = 1024; N = 1024; r = it - I3; }
            const int nb = N / 64, k0 = (r / nb) * 64, n0 = (r % nb) * 64;
#pragma unroll
            for (int ps = 0; ps < 2; ++ps) { const int kk = (tid >> 4) + 32 * ps, n4 = (tid & 15) * 4;
                const f32x4 v = *(const f32x4*)(W + (size_t)(k0 + kk) * N + n0 + n4);
                tile[kk * 65 + n4] = v[0]; tile[kk * 65 + n4 + 1] = v[1]; tile[kk * 65 + n4 + 2] = v[2]; tile[kk * 65 + n4 + 3] = v[3]; }
            __syncthreads();
            { const int n = tid >> 3, kc = (tid & 7) * 8;
              if (it < I3) {
                  int w0 = __builtin_amdgcn_cvt_pk_fp8_f32(32.f * tile[(kc + 0) * 65 + n], 32.f * tile[(kc + 1) * 65 + n], 0, false); w0 = __builtin_amdgcn_cvt_pk_fp8_f32(32.f * tile[(kc + 2) * 65 + n], 32.f * tile[(kc + 3) * 65 + n], w0, true);
                  int w1 = __builtin_amdgcn_cvt_pk_fp8_f32(32.f * tile[(kc + 4) * 65 + n], 32.f * tile[(kc + 5) * 65 + n], 0, false); w1 = __builtin_amdgcn_cvt_pk_fp8_f32(32.f * tile[(kc + 6) * 65 + n], 32.f * tile[(kc + 7) * 65 + n], w1, true);
                  *(u32x2*)((unsigned char*)WT + (size_t)(n0 + n) * K + k0 + kc) = (u32x2){(unsigned)w0, (unsigned)w1};
              } else { u32x4 w;
              w.x = cvt_pk_bf16(tile[(kc + 0) * 65 + n], tile[(kc + 1) * 65 + n]); w.y = cvt_pk_bf16(tile[(kc + 2) * 65 + n], tile[(kc + 3) * 65 + n]);
              w.z = cvt_pk_bf16(tile[(kc + 4) * 65 + n], tile[(kc + 5) * 65 + n]); w.w = cvt_pk_bf16(tile[(kc + 6) * 65 + n], tile[(kc + 7) * 65 + n]);
              *(u32x4*)(WT + (size_t)(n0 + n) * K + k0 + kc) = w; } }
            __syncthreads();
        }
    }
    {
        const size_t gtid = (size_t)bid * NTHR + tid_opaque();
        for (size_t i = gtid; i < 16384; i += gsz) {
            const float* src = P.peer_sk + i * 8; const f32x4 a = *(const f32x4*)src, b = *(const f32x4*)(src + 4);
            u32x4 w; w.x = cvt_pk_bf16(a[0], a[1]); w.y = cvt_pk_bf16(a[2], a[3]); w.z = cvt_pk_bf16(b[0], b[1]); w.w = cvt_pk_bf16(b[2], b[3]);
            *(u32x4*)((bf16_t*)(P.ws + OFF_SK) + i * 8) = w;
        }
        { const int lane = tid & 63, gw = bid * 8 + (tid >> 6), ngw = G * 8;
          for (int r = gw; r < 2 * 16384; r += ngw) {
              const bool isv = r >= 16384; const int e = isv ? r - 16384 : r;
              const float* s = (isv ? P.peer_v : P.peer_u) + (size_t)e * 1024 + lane * 16;
              f32x4 x[4]; float ss = 0.f;
#pragma unroll
              for (int q = 0; q < 4; ++q) { x[q] = __builtin_nontemporal_load((const f32x4*)(s + 4 * q)); ss += (x[q][0] * x[q][0] + x[q][1] * x[q][1]) + (x[q][2] * x[q][2] + x[q][3] * x[q][3]); }
              const float sc = fmaxf(sqrtf(wave_sum(ss) * (1.0f / 1024.0f)) * (2.6f / 7.5f), 1e-30f), inv = 1.0f / sc;
              unsigned nb[16];
#pragma unroll
              for (int q = 0; q < 4; ++q)
#pragma unroll
                  for (int el = 0; el < 4; ++el) nb[4 * q + el] = (unsigned)fminf(fmaxf(floorf(x[q][el] * inv) + 8.0f, 0.0f), 15.0f);
              u32x2 w;
              w.x = (nb[0] | (nb[4] << 4)) | ((nb[1] | (nb[5] << 4)) << 8) | ((nb[2] | (nb[6] << 4)) << 16) | ((nb[3] | (nb[7] << 4)) << 24);
              w.y = (nb[8] | (nb[12] << 4)) | ((nb[9] | (nb[13] << 4)) << 8) | ((nb[10] | (nb[14] << 4)) << 16) | ((nb[11] | (nb[15] << 4)) << 24);
              *(u32x2*)(P.ws + (isv ? OFF_V8 : OFF_U8) + (size_t)e * 512 + lane * 8) = w;
              if (lane == 0) ((float*)(P.ws + (isv ? OFF_VSC : OFF_USC)))[e] = sc;
          } }
    }
}
__device__ void phase0b(const Params& P) {
    const size_t gtid = (size_t)blockIdx.x * NTHR + threadIdx.x, gsz = (size_t)gridDim.x * NTHR;
    const float* ada = (const float*)(P.ws + OFF_ADA); bf16_t* H = (bf16_t*)(P.ws + OFF_H);
    for (size_t i = gtid; i < (size_t)NTOK * 128; i += gsz) {
        const size_t row = i >> 7; const int c8 = (int)(i & 127) * 8; const int b = (int)(row >> 11);
        const float* xr = P.x + row * 1024 + c8; const float* sh = ada + (size_t)b * 6144 + c8; const float* sc = sh + 1024;
        const f32x4 x0 = *(const f32x4*)xr, x1 = *(const f32x4*)(xr + 4), s0 = *(const f32x4*)sc, s1 = *(const f32x4*)(sc + 4), h0 = *(const f32x4*)sh, h1 = *(const f32x4*)(sh + 4);
        const f32x4 r0 = x0 * (s0 + 1.0f) + h0, r1 = x1 * (s1 + 1.0f) + h1;
        int w0 = __builtin_amdgcn_cvt_pk_fp8_f32(r0[0], r0[1], 0, false); w0 = __builtin_amdgcn_cvt_pk_fp8_f32(r0[2], r0[3], w0, true);
        int w1 = __builtin_amdgcn_cvt_pk_fp8_f32(r1[0], r1[1], 0, false); w1 = __builtin_amdgcn_cvt_pk_fp8_f32(r1[2], r1[3], w1, true);
        *(u32x2*)((unsigned char*)H + row * 1024 + c8) = (u32x2){(unsigned)w0, (unsigned)w1};
    }
}

__device__ __forceinline__ s16x4 tr4(const LAS unsigned char* p) { return __builtin_bit_cast(s16x4, __builtin_amdgcn_ds_read_tr16_b64_v4i16((LAS s16x4*)p)); }
__device__ void hgrn_item(const Params& P, int item, LAS unsigned char* lds) {
    const int tid = tid_opaque(), lane = tid & 63, wid = __builtin_amdgcn_readfirstlane(tid >> 6), r32 = lane & 31, hi = lane >> 5;
    const int b = item >> 3, h = (item >> 1) & 3, vh = item & 1;
    const bf16_t* HQ = (const bf16_t*)(P.ws + OFF_HQ); const bf16_t* HK = (const bf16_t*)(P.ws + OFF_HK); bf16_t* HI = (bf16_t*)(P.ws + OFF_HI);
    constexpr int SQ = 272, SKD = 320, SV = 192, SS = 192;
    constexpr int LQR = 0, LKR = 17408, LQB = 34816, LKD = 52224, LV = 72704, LS = 84992, LG = 109568, LT = 142336, LCL = 144384;
    LAS float* G = (LAS float*)(lds + LG); LAS float* TOT = (LAS float*)(lds + LT); LAS float* CL = (LAS float*)(lds + LCL);
    const size_t rowb = (size_t)b * SEQ;
    const int row = tid >> 3, seg = tid & 7;
    const bf16_t* qsrc = HQ + (rowb + row) * 512 + h * 128 + seg * 16; const bf16_t* ksrc = HK + (rowb + row) * 512 + h * 128 + seg * 16;
    bf16_t* vsrc = HI + (rowb + row) * 512 + h * 128 + vh * 64 + seg * 8;
    for (int i = tid; i < 128 * SS / 4; i += NTHR) ((LAS unsigned*)(lds + LS))[i] = 0u;
    f32x16 Sacc = {};
    const int di = wid >> 1, vi = wid & 1, ti = wid >> 1;
    const int tg = lane >> 4, tc = tg & 1, tI = lane & 15;
    const int trow = 4 * hi + (tI >> 2), tcol = 16 * tc + 4 * (tI & 3);
    u32x4 qn0 = *(const u32x4*)qsrc, qn1 = *(const u32x4*)(qsrc + 8), kn0 = *(const u32x4*)ksrc, kn1 = *(const u32x4*)(ksrc + 8), vn = *(const u32x4*)vsrc;
#pragma unroll 1
    for (int n = 0; n < SEQ / 64; ++n) {
        const u32x4 q0 = qn0, q1 = qn1, k0 = kn0, k1 = kn1, vv = vn;
        float qf[16] = {bf_lo(q0.x), bf_hi(q0.x), bf_lo(q0.y), bf_hi(q0.y), bf_lo(q0.z), bf_hi(q0.z), bf_lo(q0.w), bf_hi(q0.w), bf_lo(q1.x), bf_hi(q1.x), bf_lo(q1.y), bf_hi(q1.y), bf_lo(q1.z), bf_hi(q1.z), bf_lo(q1.w), bf_hi(q1.w)};
        float kf[16] = {bf_lo(k0.x), bf_hi(k0.x), bf_lo(k0.y), bf_hi(k0.y), bf_lo(k0.z), bf_hi(k0.z), bf_lo(k0.w), bf_hi(k0.w), bf_lo(k1.x), bf_hi(k1.x), bf_lo(k1.y), bf_hi(k1.y), bf_lo(k1.z), bf_hi(k1.z), bf_lo(k1.w), bf_hi(k1.w)};
#pragma unroll
        for (int e4 = 0; e4 < 4; ++e4) *(LAS f32x4*)(G + row * 128 + seg * 16 + 4 * e4) = (f32x4){__logf(1.0f - kf[4 * e4]), __logf(1.0f - kf[4 * e4 + 1]), __logf(1.0f - kf[4 * e4 + 2]), __logf(1.0f - kf[4 * e4 + 3])};
        *(LAS u32x4*)(lds + LV + row * SV + seg * 16) = vv;
        if (n + 1 < SEQ / 64) { const size_t o = (size_t)(n + 1) * 64 * 512; qn0 = *(const u32x4*)(qsrc + o); qn1 = *(const u32x4*)(qsrc + o + 8); kn0 = *(const u32x4*)(ksrc + o); kn1 = *(const u32x4*)(ksrc + o + 8); vn = *(const u32x4*)(vsrc + o); }
        __syncthreads();
        { const int d = tid & 127, q4 = tid >> 7; float s = 0.f;
#pragma unroll
          for (int i = 0; i < 16; ++i) { s += G[(16 * q4 + i) * 128 + d]; G[(16 * q4 + i) * 128 + d] = s; }
          TOT[q4 * 128 + d] = s; }
        __syncthreads();
        {
            const int qq = row >> 4;
#pragma unroll
            for (int e4 = 0; e4 < 4; ++e4) {
                const int d4 = seg * 16 + 4 * e4;
                const f32x4 t0 = *(const LAS f32x4*)(TOT + d4), t1 = *(const LAS f32x4*)(TOT + 128 + d4), t2 = *(const LAS f32x4*)(TOT + 256 + d4), t3 = *(const LAS f32x4*)(TOT + 384 + d4);
                const f32x4 off = (qq == 0) ? (f32x4){0.f, 0.f, 0.f, 0.f} : ((qq == 1) ? t0 : ((qq == 2) ? t0 + t1 : t0 + t1 + t2));
                const f32x4 bb = *(const LAS f32x4*)(G + row * 128 + d4) + off;
                const f32x4 bref = *(const LAS f32x4*)(G + 32 * 128 + d4) + t0 + t1, blast = t0 + t1 + t2 + t3;
                float vqb[4], vqr[4], vkr[4], vkd[4];
#pragma unroll
                for (int e = 0; e < 4; ++e) {
                    const float e1 = __expf(bb[e]), e2 = __expf(-bb[e]);
                    vqb[e] = qf[4 * e4 + e] * e1; vqr[e] = vqb[e] * __expf(-bref[e]);
                    const float ke = kf[4 * e4 + e] * e2; vkr[e] = ke * __expf(bref[e]); vkd[e] = ke * __expf(blast[e]);
                }
                *(LAS u32x2*)(lds + LQB + row * SQ + seg * 32 + 8 * e4) = (u32x2){cvt_pk_bf16(vqb[0], vqb[1]), cvt_pk_bf16(vqb[2], vqb[3])};
                *(LAS u32x2*)(lds + LQR + row * SQ + seg * 32 + 8 * e4) = (u32x2){cvt_pk_bf16(vqr[0], vqr[1]), cvt_pk_bf16(vqr[2], vqr[3])};
                *(LAS u32x2*)(lds + LKR + row * SQ + seg * 32 + 8 * e4) = (u32x2){cvt_pk_bf16(vkr[0], vkr[1]), cvt_pk_bf16(vkr[2], vkr[3])};
                *(LAS u32x2*)(lds + LKD + row * SKD + seg * 32 + 8 * e4) = (u32x2){cvt_pk_bf16(vkd[0], vkd[1]), cvt_pk_bf16(vkd[2], vkd[3])};
                if (row == 0) *(LAS f32x4*)(CL + d4) = (f32x4){__expf(blast[0]), __expf(blast[1]), __expf(blast[2]), __expf(blast[3])};
                asm volatile("" ::: "memory");
            }
        }
        __syncthreads();
        if (wid < 4) {
            f32x16 Z = {};
            for (int si = 0; si <= ti; ++si) {
                f32x16 X = {};
#pragma unroll
                for (int ks = 0; ks < 8; ++ks) {
                    const bf16x8 a = *(const LAS bf16x8*)(lds + LKR + (32 * si + r32) * SQ + (16 * ks + 8 * hi) * 2);
                    const bf16x8 bq = *(const LAS bf16x8*)(lds + LQR + (32 * ti + r32) * SQ + (16 * ks + 8 * hi) * 2);
                    X = MFMA32(a, bq, X);
                }
                if (si == ti) {
#pragma unroll
                    for (int r = 0; r < 16; ++r) if (crow(r, hi) > r32) X[r] = 0.f;
                }
#pragma unroll
                for (int s2 = 0; s2 < 2; ++s2) {
                    union { u32x4 u; bf16x8 v; } pa;
                    pa.u.x = cvt_pk_bf16(X[8 * s2 + 0], X[8 * s2 + 1]); pa.u.y = cvt_pk_bf16(X[8 * s2 + 2], X[8 * s2 + 3]); pa.u.z = cvt_pk_bf16(X[8 * s2 + 4], X[8 * s2 + 5]); pa.u.w = cvt_pk_bf16(X[8 * s2 + 6], X[8 * s2 + 7]);
                    const LAS unsigned char* vp = lds + LV + (32 * si + 16 * s2 + trow) * SV + (32 * vi + tcol) * 2;
                    const s16x4 lo = tr4(vp), hh = tr4(vp + 8 * SV);
                    const bf16x8 vf = {lo[0], lo[1], lo[2], lo[3], hh[0], hh[1], hh[2], hh[3]};
                    Z = MFMA32(pa.v, vf, Z);
                }
            }
#pragma unroll
            for (int ks = 0; ks < 8; ++ks) {
                const bf16x8 a = *(const LAS bf16x8*)(lds + LQB + (32 * ti + r32) * SQ + (16 * ks + 8 * hi) * 2);
                const LAS unsigned char* sp = lds + LS + (16 * ks + 8 * hi + (tI >> 2)) * SS + (32 * vi + tcol) * 2;
                const s16x4 lo = tr4(sp), hh = tr4(sp + 4 * SS);
                const bf16x8 sf = {lo[0], lo[1], lo[2], lo[3], hh[0], hh[1], hh[2], hh[3]};
                Z = MFMA32(a, sf, Z);
            }
            bf16_t* op = HI + (rowb + (size_t)n * 64 + 32 * ti) * 512 + h * 128 + vh * 64 + 32 * vi + r32;
#pragma unroll
            for (int r = 0; r < 16; ++r) op[(size_t)crow(r, hi) * 512] = (bf16_t)(cvt_pk_bf16(Z[r], 0.f) & 0xffffu);
        }
        {
#pragma unroll
            for (int r = 0; r < 16; ++r) Sacc[r] *= CL[32 * di + crow(r, hi)];
#pragma unroll
            for (int ks = 0; ks < 4; ++ks) {
                const LAS unsigned char* kp = lds + LKD + (16 * ks + 8 * hi + (tI >> 2)) * SKD + (32 * di + tcol) * 2;
                const s16x4 klo = tr4(kp), khi = tr4(kp + 4 * SKD);
                const bf16x8 ka = {klo[0], klo[1], klo[2], klo[3], khi[0], khi[1], khi[2], khi[3]};
                const LAS unsigned char* vp = lds + LV + (16 * ks + 8 * hi + (tI >> 2)) * SV + (32 * vi + tcol) * 2;
                const s16x4 vlo = tr4(vp), vhi = tr4(vp + 4 * SV);
                const bf16x8 vb = {vlo[0], vlo[1], vlo[2], vlo[3], vhi[0], vhi[1], vhi[2], vhi[3]};
                Sacc = MFMA32(ka, vb, Sacc);
            }
        }
        __syncthreads();
        {
            LAS bf16_t* sp = (LAS bf16_t*)(lds + LS + (32 * di) * SS + (32 * vi + r32) * 2);
#pragma unroll
            for (int r = 0; r < 16; ++r) sp[crow(r, hi) * (SS / 2)] = (bf16_t)(cvt_pk_bf16(Sacc[r], 0.f) & 0xffffu);
        }
    }
    __syncthreads();
}

__device__ void moba_unit(const Params& P, int b, int h, int j, LAS unsigned char* lds) {
    const int tid = tid_opaque(), lane = tid & 63, wid = tid >> 6, r32 = lane & 31, hi = lane >> 5;
    bf16_t* Q = (bf16_t*)(P.ws + OFF_QA); const bf16_t* Kg = (const bf16_t*)(P.ws + OFF_KA); const bf16_t* Vg = (const bf16_t*)(P.ws + OFF_VA);
    const float* kmean = (const float*)(P.ws + OFF_KMEAN);
    constexpr int KIMG = 64 * 144, VIMG = 64 * 192, LK = 0, LV = 2 * KIMG, LKM = 2 * KIMG + 2 * VIMG;
    LAS float* kmL = (LAS float*)(lds + LKM);
    const size_t rowb = (size_t)b * SEQ; const int q0 = j * 256;
    if (tid < j * 64) kmL[tid] = kmean[(size_t)(b * 8 + (tid >> 6)) * 512 + h * 64 + (tid & 63)];
    bf16_t* qrow = Q + (rowb + q0 + wid * 32 + r32) * 512 + h * 64;
    bf16x8 qf[4];
#pragma unroll
    for (int d0 = 0; d0 < 4; ++d0) qf[d0] = *(const bf16x8*)(qrow + 16 * d0 + 8 * hi);
    const int srow = tid >> 3, sch = tid & 7;
    const bf16_t* ksrc = Kg + (rowb + srow) * 512 + h * 64 + sch * 8; const bf16_t* vsrc = Vg + (rowb + srow) * 512 + h * 64 + sch * 8;
    const int ntile = 4 * (j + 1);
    u32x4 kreg, vreg;
    { const int key0 = q0; kreg = *(const u32x4*)(ksrc + (size_t)key0 * 512); vreg = *(const u32x4*)(vsrc + (size_t)key0 * 512); }
    *(LAS u32x4*)(lds + LK + srow * 144 + sch * 16) = kreg; *(LAS u32x4*)(lds + LV + srow * 192 + sch * 16) = vreg;
    __syncthreads();
    unsigned sel = 0;
    if (j <= 3) sel = (1u << j) - 1u;
    else {
        float g[7];
#pragma unroll
        for (int n = 0; n < 7; ++n) { float s = 0.f;
            if (n < j) {
#pragma unroll
                for (int d0 = 0; d0 < 4; ++d0)
#pragma unroll
                    for (int e = 0; e < 8; ++e) s += __uint_as_float(((unsigned)(unsigned short)qf[d0][e]) << 16) * kmL[n * 64 + 16 * d0 + 8 * hi + e];
            }
            s += __shfl_xor(s, 32); g[n] = s; }
#pragma unroll
        for (int it = 0; it < 3; ++it) { float best = -INFINITY; int bi = 0;
#pragma unroll
            for (int n = 0; n < 7; ++n) if (n < j && !((sel >> n) & 1u) && g[n] > best) { best = g[n]; bi = n; }
            sel |= 1u << bi; }
    }
    const float ch = exp2f(-(float)(h + 1)) * LOG2E;
    const int qb = wid * 32 + r32;
    float m_run = -1e30f, l_run = 0.f;
    f32x16 o0 = {}, o1 = {};
    const int tg = lane >> 4, tc = tg & 1, ti = lane & 15;
    const int vlane = (4 * hi + (ti >> 2)) * 192 + (16 * tc + 4 * (ti & 3)) * 2;
#pragma unroll 1
    for (int i = 0; i < ntile; ++i) {
        const int buf = i & 1;
        const bool own = i < 4; const int blk = own ? j : ((i - 4) >> 2), kt = own ? i : ((i - 4) & 3);
        if (i + 1 < ntile) { const int i1 = i + 1; const int blk1 = (i1 < 4) ? j : ((i1 - 4) >> 2), kt1 = (i1 < 4) ? i1 : ((i1 - 4) & 3); const size_t key1 = (size_t)(blk1 * 256 + kt1 * 64);
            kreg = *(const u32x4*)(ksrc + key1 * 512); vreg = *(const u32x4*)(vsrc + key1 * 512); }
        const bool lane_ok = own ? true : (((sel >> blk) & 1u) != 0u);
        const bool skip = own ? (64 * kt > 32 * wid + 31) : (__ballot(lane_ok) == 0ull);
        if (!skip) {
            LAS unsigned char* kb = lds + LK + buf * KIMG; LAS unsigned char* vb = lds + LV + buf * VIMG;
            f32x16 p0 = {}, p1 = {};
#pragma unroll
            for (int d0 = 0; d0 < 4; ++d0) {
                const bf16x8 kf0 = *(const LAS bf16x8*)(kb + r32 * 144 + (16 * d0 + 8 * hi) * 2);
                const bf16x8 kf1 = *(const LAS bf16x8*)(kb + (32 + r32) * 144 + (16 * d0 + 8 * hi) * 2);
                p0 = MFMA32(kf0, qf[d0], p0); p1 = MFMA32(kf1, qf[d0], p1);
            }
            const float kbase = ch * (float)((blk - j) * 256 + kt * 64);
            float mt = -1e30f;
#pragma unroll
            for (int r = 0; r < 16; ++r) {
                const int kl0 = crow(r, hi), kl1 = kl0 + 32;
                p0[r] = __builtin_fmaf(ch, (float)kl0, p0[r]); p1[r] = __builtin_fmaf(ch, (float)kl1, p1[r]);
                if (own) { if (kt * 64 + kl0 > qb) p0[r] = -1e30f; if (kt * 64 + kl1 > qb) p1[r] = -1e30f; }
                mt = fmaxf(mt, fmaxf(p0[r], p1[r]));
            }
            mt = lane_ok ? mt + kbase : -1e30f;
            mt = fmaxf(mt, __shfl_xor(mt, 32));
            if (__ballot(mt > m_run) != 0ull) {
                const float mnew = fmaxf(m_run, mt), alpha = __builtin_amdgcn_exp2f(m_run - mnew);
                m_run = mnew; l_run *= alpha;
#pragma unroll
                for (int r = 0; r < 16; ++r) { o0[r] *= alpha; o1[r] *= alpha; }
            }
            const float sh = lane_ok ? kbase - m_run : -1e30f;
            float rs = 0.f;
#pragma unroll
            for (int r = 0; r < 16; ++r) { p0[r] = __builtin_amdgcn_exp2f(p0[r] + sh); p1[r] = __builtin_amdgcn_exp2f(p1[r] + sh); rs += p0[r] + p1[r]; }
            l_run += rs;
#pragma unroll
            for (int sub = 0; sub < 2; ++sub)
#pragma unroll
                for (int s = 0; s < 2; ++s) {
                    union { u32x4 u; bf16x8 v; } pb;
                    if (sub == 0) { pb.u.x = cvt_pk_bf16(p0[8 * s + 0], p0[8 * s + 1]); pb.u.y = cvt_pk_bf16(p0[8 * s + 2], p0[8 * s + 3]); pb.u.z = cvt_pk_bf16(p0[8 * s + 4], p0[8 * s + 5]); pb.u.w = cvt_pk_bf16(p0[8 * s + 6], p0[8 * s + 7]); }
                    else { pb.u.x = cvt_pk_bf16(p1[8 * s + 0], p1[8 * s + 1]); pb.u.y = cvt_pk_bf16(p1[8 * s + 2], p1[8 * s + 3]); pb.u.z = cvt_pk_bf16(p1[8 * s + 4], p1[8 * s + 5]); pb.u.w = cvt_pk_bf16(p1[8 * s + 6], p1[8 * s + 7]); }
#pragma unroll
                    for (int dt = 0; dt < 2; ++dt) {
                        LAS unsigned char* va = vb + (32 * sub + 16 * s) * 192 + dt * 64 + vlane;
                        const s16x4 lo = __builtin_bit_cast(s16x4, __builtin_amdgcn_ds_read_tr16_b64_v4i16((LAS s16x4*)va));
                        const s16x4 hh = __builtin_bit_cast(s16x4, __builtin_amdgcn_ds_read_tr16_b64_v4i16((LAS s16x4*)(va + 8 * 192)));
                        const bf16x8 vf = {lo[0], lo[1], lo[2], lo[3], hh[0], hh[1], hh[2], hh[3]};
                        if (dt == 0) o0 = MFMA32(vf, pb.v, o0); else o1 = MFMA32(vf, pb.v, o1);
                    }
                }
        }
        if (i + 1 < ntile) { const int nb = buf ^ 1;
            *(LAS u32x4*)(lds + LK + nb * KIMG + srow * 144 + sch * 16) = kreg; *(LAS u32x4*)(lds + LV + nb * VIMG + srow * 192 + sch * 16) = vreg; }
        __syncthreads();
    }
    l_run += __shfl_xor(l_run, 32);
    const float inv = 1.0f / l_run;
#pragma unroll
    for (int r4 = 0; r4 < 4; ++r4) {
        int w0 = __builtin_amdgcn_cvt_pk_fp8_f32(o0[4 * r4] * inv, o0[4 * r4 + 1] * inv, 0, false); w0 = __builtin_amdgcn_cvt_pk_fp8_f32(o0[4 * r4 + 2] * inv, o0[4 * r4 + 3] * inv, w0, true);
        int w1 = __builtin_amdgcn_cvt_pk_fp8_f32(o1[4 * r4] * inv, o1[4 * r4 + 1] * inv, 0, false); w1 = __builtin_amdgcn_cvt_pk_fp8_f32(o1[4 * r4 + 2] * inv, o1[4 * r4 + 3] * inv, w1, true);
        unsigned char* yrow = P.ws + OFF_EG + (rowb + q0 + wid * 32 + r32) * 1024 + h * 64;
        *(int*)(yrow + 8 * r4 + 4 * hi) = w0; *(int*)(yrow + 32 + 8 * r4 + 4 * hi) = w1;
    }
}

__device__ void yb_norm_panel(const Params& P, int pm) {
    const int tid = tid_opaque(), lane = tid & 63, wid = tid >> 6;
    bf16_t* HI = (bf16_t*)(P.ws + OFF_HI); const bf16_t* HG = (const bf16_t*)(P.ws + OFF_HG);
    for (int r = 0; r < 32; ++r) {
        const size_t off = ((size_t)pm * 256 + wid * 32 + r) * 512 + lane * 8;
        const u32x4 ov = *(const u32x4*)(HI + off), gv = *(const u32x4*)(HG + off);
        float o[8] = {bf_lo(ov.x), bf_hi(ov.x), bf_lo(ov.y), bf_hi(ov.y), bf_lo(ov.z), bf_hi(ov.z), bf_lo(ov.w), bf_hi(ov.w)};
        const float g[8] = {bf_lo(gv.x), bf_hi(gv.x), bf_lo(gv.y), bf_hi(gv.y), bf_lo(gv.z), bf_hi(gv.z), bf_lo(gv.w), bf_hi(gv.w)};
        float ss = 0.f;
#pragma unroll
        for (int e = 0; e < 8; ++e) ss += o[e] * o[e];
        ss += __shfl_xor(ss, 1); ss += __shfl_xor(ss, 2); ss += __shfl_xor(ss, 4); ss += __shfl_xor(ss, 8);
        const float rs = rsqrtf(ss * (1.0f / 128.0f) + RMS_EPS);
        int w0 = __builtin_amdgcn_cvt_pk_fp8_f32(o[0] * rs * g[0], o[1] * rs * g[1], 0, false); w0 = __builtin_amdgcn_cvt_pk_fp8_f32(o[2] * rs * g[2], o[3] * rs * g[3], w0, true);
        int w1 = __builtin_amdgcn_cvt_pk_fp8_f32(o[4] * rs * g[4], o[5] * rs * g[5], 0, false); w1 = __builtin_amdgcn_cvt_pk_fp8_f32(o[6] * rs * g[6], o[7] * rs * g[7], w1, true);
        *(u32x2*)(P.ws + OFF_EG + ((size_t)pm * 256 + wid * 32 + r) * 1024 + 512 + lane * 8) = (u32x2){(unsigned)w0, (unsigned)w1};
    }
}
__device__ void ln1_panel(const Params& P, int pm) {
    const int tid = tid_opaque(), lane = tid & 63, wid = tid >> 6;
    const float* ada = (const float*)(P.ws + OFF_ADA) + (size_t)(pm >> 3) * 6144; bf16_t* H = (bf16_t*)(P.ws + OFF_H);
    for (int r = 0; r < 32; ++r) {
        const size_t row = (size_t)pm * 256 + wid * 32 + r;
        float* xr = P.out + row * 1024 + lane * 4; const float* xin = P.x + row * 1024 + lane * 4; const bf16_t* dl = (const bf16_t*)(P.ws + OFF_GB) + row * 1024 + lane * 4;
        f32x4 v[4]; float s = 0.f;
#pragma unroll
        for (int jx = 0; jx < 4; ++jx) { const u32x2 dv = *(const u32x2*)(dl + 256 * jx); const f32x4 xv = __builtin_nontemporal_load((const f32x4*)(xin + 256 * jx));
            v[jx] = xv * ALPHA + (f32x4){bf_lo(dv.x), bf_hi(dv.x), bf_lo(dv.y), bf_hi(dv.y)}; s += (v[jx][0] + v[jx][1]) + (v[jx][2] + v[jx][3]); }
        const float mean = wave_sum(s) * (1.0f / 1024.0f); float s2 = 0.f;
#pragma unroll
        for (int jx = 0; jx < 4; ++jx) { v[jx] = v[jx] - mean; s2 += (v[jx][0] * v[jx][0] + v[jx][1] * v[jx][1]) + (v[jx][2] * v[jx][2] + v[jx][3] * v[jx][3]); }
        const float rstd = rsqrtf(wave_sum(s2) * (1.0f / 1024.0f) + LN_EPS);
#pragma unroll
        for (int jx = 0; jx < 4; ++jx) {
            const int c = lane * 4 + 256 * jx;
            const f32x4 g = *(const f32x4*)(P.ln1_g + c), bb = *(const f32x4*)(P.ln1_b + c), sh = *(const f32x4*)(ada + 3072 + c), sc = *(const f32x4*)(ada + 4096 + c);
            const f32x4 x1 = v[jx] * rstd * g + bb;
            *(f32x4*)(xr + 256 * jx) = x1;
            const f32x4 h2 = x1 * (sc + 1.0f) + sh;
            u32x2 w; w.x = cvt_pk_bf16(h2[0], h2[1]); w.y = cvt_pk_bf16(h2[2], h2[3]);
            *(u32x2*)(H + row * 1024 + c) = w;
            v[jx] = h2;
        }
        {
            float mx = 0.f;
#pragma unroll
            for (int jx = 0; jx < 4; ++jx) mx = fmaxf(mx, fmaxf(fmaxf(fabsf(v[jx][0]), fabsf(v[jx][1])), fmaxf(fabsf(v[jx][2]), fabsf(v[jx][3]))));
#pragma unroll
            for (int o = 1; o < 64; o <<= 1) mx = fmaxf(mx, __shfl_xor(mx, o));
            const float hs = fmaxf(mx * (1.0f / 127.0f), 1e-30f), inv = 1.0f / hs; int qs = 0;
#pragma unroll
            for (int jx = 0; jx < 4; ++jx) {
                const int q0 = (int)rintf(v[jx][0] * inv), q1 = (int)rintf(v[jx][1] * inv), q2 = (int)rintf(v[jx][2] * inv), q3 = (int)rintf(v[jx][3] * inv);
                qs += (q0 + q1) + (q2 + q3);
                *(unsigned*)(P.ws + OFF_H8 + row * 1024 + lane * 4 + 256 * jx) = (unsigned)(q0 & 255) | ((unsigned)(q1 & 255) << 8) | ((unsigned)(q2 & 255) << 16) | ((unsigned)(q3 & 255) << 24);
            }
#pragma unroll
            for (int o = 1; o < 64; o <<= 1) qs += __shfl_xor(qs, o);
            if (lane == 0) *(f32x2*)(P.ws + OFF_HS + row * 8) = (f32x2){hs, (float)qs};
        }
    }
}

#define CE16(A, i, j) do { const float hi_ = fmaxf(A[i], A[j]); A[j] = fminf(A[i], A[j]); A[i] = hi_; } while (0)
#define SORT16(A) do { CE16(A, 0, 1); CE16(A, 2, 3); CE16(A, 0, 2); CE16(A, 1, 3); CE16(A, 1, 2); CE16(A, 4, 5); CE16(A, 6, 7); CE16(A, 4, 6); CE16(A, 5, 7); CE16(A, 5, 6); CE16(A, 0, 4); CE16(A, 2, 6); CE16(A, 2, 4); CE16(A, 1, 5); CE16(A, 3, 7); CE16(A, 3, 5); CE16(A, 1, 2); CE16(A, 3, 4); CE16(A, 5, 6); CE16(A, 8, 9); CE16(A, 10, 11); CE16(A, 8, 10); CE16(A, 9, 11); CE16(A, 9, 10); CE16(A, 12, 13); CE16(A, 14, 15); CE16(A, 12, 14); CE16(A, 13, 15); CE16(A, 13, 14); CE16(A, 8, 12); CE16(A, 10, 14); CE16(A, 10, 12); CE16(A, 9, 13); CE16(A, 11, 15); CE16(A, 11, 13); CE16(A, 9, 10); CE16(A, 11, 12); CE16(A, 13, 14); CE16(A, 0, 8); CE16(A, 4, 12); CE16(A, 4, 8); CE16(A, 2, 10); CE16(A, 6, 14); CE16(A, 6, 10); CE16(A, 2, 4); CE16(A, 6, 8); CE16(A, 10, 12); CE16(A, 1, 9); CE16(A, 5, 13); CE16(A, 5, 9); CE16(A, 3, 11); CE16(A, 7, 15); CE16(A, 7, 11); CE16(A, 3, 5); CE16(A, 7, 9); CE16(A, 11, 13); CE16(A, 1, 2); CE16(A, 3, 4); CE16(A, 5, 6); CE16(A, 7, 8); CE16(A, 9, 10); CE16(A, 11, 12); CE16(A, 13, 14); } while (0)
#define BITONIC16(A) do { CE16(A, 0, 8); CE16(A, 1, 9); CE16(A, 2, 10); CE16(A, 3, 11); CE16(A, 4, 12); CE16(A, 5, 13); CE16(A, 6, 14); CE16(A, 7, 15); CE16(A, 0, 4); CE16(A, 1, 5); CE16(A, 2, 6); CE16(A, 3, 7); CE16(A, 8, 12); CE16(A, 9, 13); CE16(A, 10, 14); CE16(A, 11, 15); CE16(A, 0, 2); CE16(A, 1, 3); CE16(A, 4, 6); CE16(A, 5, 7); CE16(A, 8, 10); CE16(A, 9, 11); CE16(A, 12, 14); CE16(A, 13, 15); CE16(A, 0, 1); CE16(A, 2, 3); CE16(A, 4, 5); CE16(A, 6, 7); CE16(A, 8, 9); CE16(A, 10, 11); CE16(A, 12, 13); CE16(A, 14, 15); } while (0)
#define INS16(L, xin) do { float x_ = (xin); _Pragma("unroll") for (int k_ = 0; k_ < 16; ++k_) { const float hi_ = fmaxf(L[k_], x_); x_ = fminf(L[k_], x_); L[k_] = hi_; } } while (0)

__device__ void peer_select_wave(const Params& P, size_t tok0) {
    const int lane = tid_opaque() & 63, r32 = lane & 31, hi = lane >> 5;
    const bf16_t* QP = (const bf16_t*)(P.ws + OFF_GB) + (tok0 + r32) * 1024; const bf16_t* SK = (const bf16_t*)(P.ws + OFF_SK);
    u32x2* EG = (u32x2*)(P.ws + OFF_EG) + (tok0 + r32) * 128;
#pragma unroll 1
    for (int h = 0; h < 8; ++h) {
        float a0[16], a1[16];
#pragma unroll
        for (int k = 0; k < 16; ++k) { a0[k] = -INFINITY; a1[k] = -INFINITY; }
#pragma unroll
        for (int p = 0; p < 2; ++p) {
            const int hp = h * 2 + p;
            bf16x8 qf[4];
#pragma unroll
            for (int ks = 0; ks < 4; ++ks) qf[ks] = *(const bf16x8*)(QP + hp * 64 + 16 * ks + 8 * hi);
            float L[16];
#pragma unroll
            for (int kt = 0; kt < 4; ++kt) {
                f32x16 acc = {};
#pragma unroll
                for (int ks = 0; ks < 4; ++ks) { const bf16x8 kf = *(const bf16x8*)(SK + ((size_t)hp * 128 + 32 * kt + r32) * 64 + 16 * ks + 8 * hi); acc = MFMA32(kf, qf[ks], acc); }
                float S[16];
#pragma unroll
                for (int r = 0; r < 16; ++r) { const unsigned key = (unsigned)(32 * kt + crow(r, hi)); S[r] = __uint_as_float((__float_as_uint(acc[r]) & ~127u) | key); }
                SORT16(S);
                if (kt == 0) {
#pragma unroll
                    for (int k = 0; k < 16; ++k) L[k] = S[k];
                } else {
#pragma unroll
                    for (int k = 0; k < 16; ++k) L[k] = fmaxf(L[k], S[15 - k]);
                    BITONIC16(L);
                }
            }
            {
                float O[16];
#pragma unroll
                for (int k = 0; k < 16; ++k) O[k] = __shfl_xor(L[15 - k], 32);
#pragma unroll
                for (int k = 0; k < 16; ++k) L[k] = fmaxf(L[k], O[k]);
                BITONIC16(L);
            }
#pragma unroll
            for (int k = 0; k < 16; ++k) { a0[k] = (p == 0) ? L[k] : a0[k]; a1[k] = (p == 1) ? L[k] : a1[k]; }
        }
        float best[16];
#pragma unroll
        for (int k = 0; k < 16; ++k) best[k] = __uint_as_float((__float_as_uint(a0[0] + a1[k]) & ~255u) | (unsigned)k);
#pragma unroll
        for (int i = 1; i < 16; ++i)
#pragma unroll
            for (int jx = 0; jx < 16; ++jx)
                if ((i + 1) * (jx + 1) <= 16) {
                    const float cs = a0[i] + a1[jx];
                    const float cv = __uint_as_float((__float_as_uint(cs) & ~255u) | (unsigned)(i * 16 + jx));
                    INS16(best, cv);
                }
        unsigned pk0[4], pk1[4];
#pragma unroll
        for (int q = 0; q < 4; ++q) {
            pk0[q] = (__float_as_uint(a0[4 * q]) & 127u) | ((__float_as_uint(a0[4 * q + 1]) & 127u) << 8) | ((__float_as_uint(a0[4 * q + 2]) & 127u) << 16) | ((__float_as_uint(a0[4 * q + 3]) & 127u) << 24);
            pk1[q] = (__float_as_uint(a1[4 * q]) & 127u) | ((__float_as_uint(a1[4 * q + 1]) & 127u) << 8) | ((__float_as_uint(a1[4 * q + 2]) & 127u) << 16) | ((__float_as_uint(a1[4 * q + 3]) & 127u) << 24);
        }
        unsigned pay[16];
#pragma unroll
        for (int k = 0; k < 16; ++k) {
            const unsigned code = __float_as_uint(best[k]) & 255u, ci = code >> 4, cj = code & 15u;
            const unsigned qi = ci >> 2, qj = cj >> 2;
            const unsigned w0 = (qi == 0u) ? pk0[0] : ((qi == 1u) ? pk0[1] : ((qi == 2u) ? pk0[2] : pk0[3]));
            const unsigned w1 = (qj == 0u) ? pk1[0] : ((qj == 1u) ? pk1[1] : ((qj == 2u) ? pk1[2] : pk1[3]));
            pay[k] = (((w0 >> ((ci & 3u) * 8u)) & 127u) << 7) | ((w1 >> ((cj & 3u) * 8u)) & 127u);
        }
        float e[16], es = 0.f;
#pragma unroll
        for (int k = 0; k < 16; ++k) { e[k] = __expf(best[k] - best[0]); es += e[k]; }
        const float inv = 1.0f / es;
        if (hi == 0) {
#pragma unroll
            for (int k = 0; k < 16; ++k) { u32x2 w; w.x = pay[k]; w.y = __float_as_uint(e[k] * inv); EG[h * 16 + k] = w; }
        }
    }
}
__device__ __forceinline__ unsigned xcc_id() { return (unsigned)__builtin_amdgcn_s_getreg((3 << 11) | 20) & 0xFu; }
template <int CTRL> __device__ __forceinline__ float dpp_add(float x) { const int v = __builtin_amdgcn_update_dpp(0, __float_as_int(x), CTRL, 0xf, 0xf, true); return x + __int_as_float(v); }
__device__ __forceinline__ float wave_sum_fast(float x) {
    x = dpp_add<0xB1>(x); x = dpp_add<0x4E>(x); x = dpp_add<0x141>(x); x = dpp_add<0x140>(x);
    x += __shfl_xor(x, 16); x += __shfl_xor(x, 32); return x;
}
__device__ __forceinline__ float dot16_fp8(const float (&hv)[16], const u32x4 r) {
    float s = 0.f;
    { const f32x2 a = __builtin_amdgcn_cvt_pk_f32_fp8((int)r.x, false), b = __builtin_amdgcn_cvt_pk_f32_fp8((int)r.x, true); s += hv[0] * a.x + hv[1] * a.y + hv[2] * b.x + hv[3] * b.y; }
    { const f32x2 a = __builtin_amdgcn_cvt_pk_f32_fp8((int)r.y, false), b = __builtin_amdgcn_cvt_pk_f32_fp8((int)r.y, true); s += hv[4] * a.x + hv[5] * a.y + hv[6] * b.x + hv[7] * b.y; }
    { const f32x2 a = __builtin_amdgcn_cvt_pk_f32_fp8((int)r.z, false), b = __builtin_amdgcn_cvt_pk_f32_fp8((int)r.z, true); s += hv[8] * a.x + hv[9] * a.y + hv[10] * b.x + hv[11] * b.y; }
    { const f32x2 a = __builtin_amdgcn_cvt_pk_f32_fp8((int)r.w, false), b = __builtin_amdgcn_cvt_pk_f32_fp8((int)r.w, true); s += hv[12] * a.x + hv[13] * a.y + hv[14] * b.x + hv[15] * b.y; }
    return s;
}
template <int NP, class F> __device__ __forceinline__ void partition_queue(const Params& P, LAS unsigned char* lds, int ctr_base, F f) {
    const int tid = tid_opaque();
    LAS int* slot = (LAS int*)(lds + LDS_BYTES - 64);
    unsigned* ctr = (unsigned*)(P.ws + OFF_CTR) + ctr_base;
    const int myx = (int)(xcc_id() & 7u);
    for (int pp = 0; pp < NP; ++pp) {
        const int p = (myx * (NP / 8) + pp) % NP;
        for (;;) {
            if (tid == 0) *slot = (int)atomicAdd(ctr + p, 1u);
            __syncthreads();
            const int item = *slot;
            __syncthreads();
            if (item >= NTOK / 64) break;
            f(p, item);
        }
    }
}
__device__ __forceinline__ float dot2bf(unsigned a, bf16v2 b, float c) { return __builtin_amdgcn_fdot2_f32_bf16(__builtin_bit_cast(bf16v2, a), b, c, false); }
__device__ __forceinline__ float gelu_erf(float v) {
    const float av = fabsf(v), t = __builtin_amdgcn_rcpf(__builtin_fmaf(av, 0.2316418882f, 1.0f));
    float q = __builtin_fmaf(t, 0.5307027145f, -0.7265760135f); q = __builtin_fmaf(q, t, 0.7107068705f); q = __builtin_fmaf(q, t, -0.142248368f); q = __builtin_fmaf(q, t, 0.127414796f); q = q * t;
    const float m = v * (q * __builtin_amdgcn_exp2f(v * v * -0.72134752044f));
    return v < 0.f ? m : v - m;
}
struct UQuad { u32x4 r[2]; u32x4 ent; };
__device__ __forceinline__ void uq_issue(UQuad& q, const LAS u32x4* list, int J, int NQ, int g, const unsigned char* U4) {
    const int jj = J < NQ ? J : NQ - 1;
    q.ent = list[4 * jj + g];
    const unsigned char* rp = U4 + (size_t)q.ent.x * 512;
    q.r[0] = *(const u32x4*)rp; q.r[1] = *(const u32x4*)(rp + 256);
}
__device__ __forceinline__ int dot8_i4(unsigned w, unsigned hlo, unsigned hhi, int acc) {
    acc = __builtin_amdgcn_sdot4((int)hlo, (int)(w & 0x0F0F0F0Fu), acc, false);
    return __builtin_amdgcn_sdot4((int)hhi, (int)((w >> 4) & 0x0F0F0F0Fu), acc, false);
}
__device__ __forceinline__ float uq_dot(const UQuad& q, const u32x4 (&hp)[4]) {
    int a = 0, b = 0;
#pragma unroll
    for (int c = 0; c < 2; ++c) {
        const u32x4 r = q.r[c];
        a = dot8_i4(r.x, hp[2 * c].x, hp[2 * c].y, a); b = dot8_i4(r.y, hp[2 * c].z, hp[2 * c].w, b);
        a = dot8_i4(r.z, hp[2 * c + 1].x, hp[2 * c + 1].y, a); b = dot8_i4(r.w, hp[2 * c + 1].z, hp[2 * c + 1].w, b);
    }
    float s = (float)(a + b);
    s = dpp_add<0xB1>(s); s = dpp_add<0x4E>(s); s = dpp_add<0x141>(s); s = dpp_add<0x140>(s);
    return s;
}
__device__ __forceinline__ void peer_u_tokens(const Params& P, LAS unsigned char* lds, const size_t t0) {
    const int tid = tid_opaque(), lane = tid & 63, wid = tid >> 6, g = lane >> 4, li = lane & 15;
    const unsigned char* H8 = P.ws + OFF_H8 + li * 32; const unsigned char* U4 = P.ws + OFF_U8 + li * 16;
    const f32x2* HS = (const f32x2*)(P.ws + OFF_HS); const float* USC = (const float*)(P.ws + OFF_USC);
    const u32x4* EG4 = (const u32x4*)(P.ws + OFF_EG); float* W = (float*)(P.ws + OFF_W);
    LAS u32x4* list = (LAS u32x4*)(lds + wid * 16384);
#pragma unroll 2
    for (int i = 0; i < 8; ++i) {
        const u32x4 eg = EG4[(t0 + i) * 64 + lane];
        list[i * 128 + 2 * lane] = (u32x4){eg.x, eg.y, (unsigned)(2 * lane) | (unsigned)(i << 8), __float_as_uint(USC[eg.x])};
        list[i * 128 + 2 * lane + 1] = (u32x4){eg.z, eg.w, (unsigned)(2 * lane + 1) | (unsigned)(i << 8), __float_as_uint(USC[eg.z])};
    }
    constexpr int NQ = 256;
    u32x4 hp[4], hn[4]; f32x2 hsc = HS[t0], hsn = HS[t0 + 1];
#pragma unroll
    for (int c = 0; c < 2; ++c) { hp[2 * c] = *(const u32x4*)(H8 + t0 * 1024 + 512 * c); hp[2 * c + 1] = *(const u32x4*)(H8 + t0 * 1024 + 512 * c + 16);
                                  hn[2 * c] = *(const u32x4*)(H8 + (t0 + 1) * 1024 + 512 * c); hn[2 * c + 1] = *(const u32x4*)(H8 + (t0 + 1) * 1024 + 512 * c + 16); }
    int curtok = 0;
    UQuad q0, q1, q2, q3;
    uq_issue(q0, list, 0, NQ, g, U4); uq_issue(q1, list, 1, NQ, g, U4); uq_issue(q2, list, 2, NQ, g, U4); uq_issue(q3, list, 3, NQ, g, U4);
#define UQ_STEP(q, Jn) do { \
        const int tk = __builtin_amdgcn_readfirstlane((int)(q.ent.z >> 8)); \
        if (tk != curtok) { curtok = tk; _Pragma("unroll") for (int c = 0; c < 4; ++c) hp[c] = hn[c]; hsc = hsn; \
            if (tk + 1 < 8) { hsn = HS[t0 + tk + 1]; _Pragma("unroll") for (int c = 0; c < 2; ++c) { hn[2 * c] = *(const u32x4*)(H8 + (t0 + tk + 1) * 1024 + 512 * c); hn[2 * c + 1] = *(const u32x4*)(H8 + (t0 + tk + 1) * 1024 + 512 * c + 16); } } } \
        const float s = __uint_as_float(q.ent.w) * hsc.x * (uq_dot(q, hp) - 7.5f * hsc.y); \
        if (li == 0) W[(t0 + tk) * 128 + (q.ent.z & 255u)] = __uint_as_float(q.ent.y) * gelu_erf(s); \
        uq_issue(q, list, (Jn), NQ, g, U4); } while (0)
#pragma unroll 1
    for (int J = 0; J < NQ; J += 4) { UQ_STEP(q0, J + 4); UQ_STEP(q1, J + 5); UQ_STEP(q2, J + 6); UQ_STEP(q3, J + 7); }
#undef UQ_STEP
}
typedef int v4i_t __attribute__((ext_vector_type(4)));
struct VQuad { u32x4 r[2]; u32x2 ent; };
__device__ __forceinline__ void vq_issue(VQuad& q, const LAS u32x2* list, int J, int g, const unsigned char* V4) {
    const int jj = J < 32 ? J : 31;
    q.ent = list[4 * jj + g];
    const unsigned char* rp = V4 + (size_t)q.ent.x * 512;
    q.r[0] = *(const u32x4*)rp; q.r[1] = *(const u32x4*)(rp + 256);
}
__device__ __forceinline__ void vq_mma(const VQuad& q, v4i_t (&acc)[4], const unsigned sh, const u32x4 bm, const bool live) {
    const unsigned t = live ? ((q.ent.y & 255u) << sh) : 0u;
    const v4i_t B = {(int)(t & bm.x), (int)(t & bm.y), (int)(t & bm.z), (int)(t & bm.w)};
#pragma unroll
    for (int c = 0; c < 2; ++c) {
        const u32x4 r = q.r[c];
        const v4i_t lo = {(int)(r.x & 0x0F0F0F0Fu), (int)(r.y & 0x0F0F0F0Fu), (int)(r.z & 0x0F0F0F0Fu), (int)(r.w & 0x0F0F0F0Fu)};
        const v4i_t hi = {(int)((r.x >> 4) & 0x0F0F0F0Fu), (int)((r.y >> 4) & 0x0F0F0F0Fu), (int)((r.z >> 4) & 0x0F0F0F0Fu), (int)((r.w >> 4) & 0x0F0F0F0Fu)};
        acc[2 * c] = __builtin_amdgcn_mfma_i32_16x16x64_i8(lo, B, acc[2 * c], 0, 0, 0);
        acc[2 * c + 1] = __builtin_amdgcn_mfma_i32_16x16x64_i8(hi, B, acc[2 * c + 1], 0, 0, 0);
    }
}
__device__ __forceinline__ void peer_v_tokens(const Params& P, LAS unsigned char* lds, const size_t t0) {
    const int tid = tid_opaque(), lane = tid & 63, wid = tid >> 6, g = lane >> 4, li = lane & 15;
    const unsigned char* V4 = P.ws + OFF_V8 + li * 16; const float* VSC = (const float*)(P.ws + OFF_VSC);
    const u32x4* EG4 = (const u32x4*)(P.ws + OFF_EG); const f32x2* W2 = (const f32x2*)(P.ws + OFF_W);
    LAS u32x2* lists = (LAS u32x2*)(lds + wid * 8192);
    float swv[8], yoffv[8];
#pragma unroll
    for (int i = 0; i < 8; ++i) { const u32x4 eg = EG4[(t0 + i) * 64 + lane]; const f32x2 ww = W2[(t0 + i) * 64 + lane];
        const float w0 = ww.x * VSC[eg.x], w1 = ww.y * VSC[eg.z];
        float mx = fmaxf(fabsf(w0), fabsf(w1));
#pragma unroll
        for (int o = 1; o < 64; o <<= 1) mx = fmaxf(mx, __shfl_xor(mx, o));
        const float sw = fmaxf(mx * (1.0f / 127.0f), 1e-30f), inv = 1.0f / sw;
        const int q0 = (int)rintf(w0 * inv), q1 = (int)rintf(w1 * inv);
        *(LAS u32x4*)(lists + i * 128 + 2 * lane) = (u32x4){eg.x, (unsigned)q0, eg.z, (unsigned)q1};
        int qs = q0 + q1;
#pragma unroll
        for (int o = 1; o < 64; o <<= 1) qs += __shfl_xor(qs, o);
        swv[i] = sw; yoffv[i] = 7.5f * sw * (float)qs; }
    const unsigned sh = 8u * (unsigned)(li & 3);
    const u32x4 bm = {(li >> 2) == 0 ? 0xFFFFFFFFu : 0u, (li >> 2) == 1 ? 0xFFFFFFFFu : 0u, (li >> 2) == 2 ? 0xFFFFFFFFu : 0u, (li >> 2) == 3 ? 0xFFFFFFFFu : 0u};
#pragma unroll
    for (int i = 0; i < 8; ++i) {
        const size_t t = t0 + i;
        const LAS u32x2* list = lists + i * 128;
        v4i_t acc[4];
#pragma unroll
        for (int j = 0; j < 4; ++j) acc[j] = (v4i_t){0, 0, 0, 0};
        VQuad q0, q1, q2, q3;
        vq_issue(q0, list, 0, g, V4); vq_issue(q1, list, 1, g, V4); vq_issue(q2, list, 2, g, V4); vq_issue(q3, list, 3, g, V4);
#pragma unroll 1
        for (int J = 0; J < 32; J += 4) {
            vq_mma(q0, acc, sh, bm, true); vq_issue(q0, list, J + 4, g, V4);
            vq_mma(q1, acc, sh, bm, true); vq_issue(q1, list, J + 5, g, V4);
            vq_mma(q2, acc, sh, bm, true); vq_issue(q2, list, J + 6, g, V4);
            vq_mma(q3, acc, sh, bm, true); vq_issue(q3, list, J + 7, g, V4);
        }
        const float sw = swv[i], yoff = yoffv[i];
        const int dbase = 128 * g + 8 * (li >> 2) + (li & 3);
        const float* gt2 = (const float*)(P.ws + OFF_ADA) + (t >> 11) * 6144 + 5120;
        float* xr = P.out + t * 1024;
        float pre[16]; float s = 0.f;
#pragma unroll
        for (int c = 0; c < 2; ++c)
#pragma unroll
            for (int hf = 0; hf < 2; ++hf)
#pragma unroll
                for (int r = 0; r < 4; ++r) { const int d = dbase + 512 * c + 32 * r + 4 * hf;
                    const float yv = sw * (float)acc[2 * c + hf][r] - yoff;
                    const float pv = ALPHA * xr[d] + gt2[d] * yv; pre[8 * c + 4 * hf + r] = pv; s += pv; }
        const float mean = wave_sum(s) * (1.0f / 1024.0f); float s2 = 0.f;
#pragma unroll
        for (int e = 0; e < 16; ++e) { pre[e] -= mean; s2 += pre[e] * pre[e]; }
        const float rstd = rsqrtf(wave_sum(s2) * (1.0f / 1024.0f) + LN_EPS);
#pragma unroll
        for (int c = 0; c < 2; ++c)
#pragma unroll
            for (int hf = 0; hf < 2; ++hf)
#pragma unroll
                for (int r = 0; r < 4; ++r) { const int d = dbase + 512 * c + 32 * r + 4 * hf;
                    xr[d] = pre[8 * c + 4 * hf + r] * rstd * P.ln2_g[d] + P.ln2_b[d]; }
    }
}

#define XB_TMO      128
#define XB_XCNT(j)  (256  + 64 * (j))
#define XB_XSUB(j)  (1280 + 64 * (j))
#define XB_XGEN(j)  (2304 + 64 * (j))
#define XB_TOP      3328
#define XB_TOPGEN   3392
#define XCD_BAR_WORDS 3456
#define XB_SPIN_CAP (1u << 22)
__device__ __forceinline__ unsigned xb_ld(unsigned* p)              { return __hip_atomic_load(p, __ATOMIC_RELAXED, __HIP_MEMORY_SCOPE_AGENT); }
__device__ __forceinline__ unsigned xb_add(unsigned* p, unsigned v) { return __hip_atomic_fetch_add(p, v, __ATOMIC_RELAXED, __HIP_MEMORY_SCOPE_AGENT); }
#define XB_SPIN(cond, bar) do { unsigned _sp = 0; while (cond) { __builtin_amdgcn_s_sleep(1); \
    if ((++_sp & 255u) == 0u) { if (xb_ld(&(bar)[XB_TMO])) break; if (_sp > XB_SPIN_CAP) { atomicAdd(&(bar)[XB_TMO], 1u); break; } } } } while (0)
struct XcdBarrier { unsigned* bar; unsigned x; volatile LAS unsigned* st; };
__device__ __forceinline__ XcdBarrier xcd_barrier_post(unsigned* bar, volatile LAS unsigned* st) {
    XcdBarrier b; b.bar = bar; b.x = xcc_id(); b.st = st;
    if (threadIdx.x == 0) (void)xb_add(&bar[XB_XCNT(b.x)], 1u);
    return b;
}
__device__ __forceinline__ void xcd_barrier_complete(unsigned* bar, unsigned x, unsigned& nloc, unsigned& nx) {
    const unsigned G = gridDim.x * gridDim.y * gridDim.z;
    unsigned sum, cnt, mine, sp = 0u;
    for (;;) {
        sum = 0u; cnt = 0u; mine = 0u;
#pragma unroll
        for (unsigned j = 0; j < 16; ++j) { const unsigned c = xb_ld(&bar[XB_XCNT(j)]); sum += c; cnt += (c > 0u) ? 1u : 0u; mine = (j == x) ? c : mine; }
        if (sum == G) break;
        __builtin_amdgcn_s_sleep(1);
        if ((++sp & 255u) == 0u) { if (xb_ld(&bar[XB_TMO])) break; if (sp > XB_SPIN_CAP) { atomicAdd(&bar[XB_TMO], 1u); break; } }
    }
    nloc = mine > 0u ? mine : 1u; nx = cnt > 0u ? cnt : 1u;
}
__device__ __forceinline__ void xcd_barrier(const XcdBarrier& b) {
    asm volatile("s_waitcnt vmcnt(0)" ::: "memory");
    __syncthreads();
    if (threadIdx.x == 0) {
        unsigned* bar = b.bar;
        __builtin_amdgcn_s_waitcnt(0);
        unsigned nloc = b.st[0], nx = b.st[1];
        if (nloc == 0u) { xcd_barrier_complete(bar, b.x, nloc, nx); b.st[0] = nloc; b.st[1] = nx; }
        const unsigned old = xb_add(&bar[XB_XSUB(b.x)], 1u);
        const unsigned gen = old / nloc;
        if (old + 1u == (gen + 1u) * nloc) {
            __builtin_amdgcn_fence(__ATOMIC_RELEASE, "agent");
            asm volatile("s_waitcnt vmcnt(0)" ::: "memory");
            const unsigned og = xb_add(&bar[XB_TOP], 1u);
            const unsigned tg = og / nx;
            if (og + 1u == (tg + 1u) * nx) xb_add(&bar[XB_TOPGEN], 1u);
            else XB_SPIN(xb_ld(&bar[XB_TOPGEN]) == tg, bar);
            __builtin_amdgcn_fence(__ATOMIC_ACQUIRE, "agent");
            xb_add(&bar[XB_XGEN(b.x)], 1u);
            asm volatile("s_waitcnt vmcnt(0)" ::: "memory");
        } else {
            XB_SPIN(xb_ld(&bar[XB_XGEN(b.x)]) == gen, bar);
            __builtin_amdgcn_fence(__ATOMIC_ACQUIRE, "agent");
            asm volatile("s_waitcnt vmcnt(0)" ::: "memory");
        }
    }
    __syncthreads();
}

__global__ void __launch_bounds__(NTHR, 2) fwd_megakernel(Params P) {
    extern __shared__ __attribute__((aligned(16))) unsigned char shm[];
    LAS unsigned char* lds = (LAS unsigned char*)shm;
    cg::grid_group grid = cg::this_grid();
    const int G = gridDim.x, bid = blockIdx.x;
    volatile LAS unsigned* xst = (volatile LAS unsigned*)(lds + LDS_BYTES - 128);
    if (threadIdx.x == 0) { xst[0] = 0u; xst[1] = 0u; }
    __syncthreads();
    const XcdBarrier xb = xcd_barrier_post((unsigned*)(P.ws + OFF_BAR), xst);

#ifndef P3
#define P3 0xff
#endif
#ifndef PH
#define PH 0xff
#endif
    if (PH & 1) phase0a(P, lds);
    grid.sync();
    if (PH & 2) phase0b(P);
    xcd_barrier(xb);
    if (PH & 4) {
        pg8::Gemm g; g.A = (const bf16_t*)(P.ws + OFF_H); g.Bt = (const bf16_t*)(P.ws + OFF_WIN); g.M = NTOK; g.N = INCOLS; { int k_ = 512; asm volatile("" : "+s"(k_)); g.K = k_; g.lda = k_; }
        pg8::StaticOrder S; S.init(NTOK, INCOLS, G, bid);
        EpiProj E; E.ws = P.ws; E.lb = (const float*)(P.ws + OFF_LB); E.ng = P.hgrn_ng; E.kmean = (float*)(P.ws + OFF_KMEAN);
        pg8::gemm_phase<EpiProj, pg8::StaticOrder, true>(lds, g, S, E);
    }
    xcd_barrier(xb);
    if (PH & 8) for (int it = bid; it < 256; it += G) hgrn_item(P, it, lds);
    if (PH & 16) for (int u = bid; u < 2048; u += G) { const int bh = u & 255, jj = u >> 8; moba_unit(P, bh >> 3, bh & 7, (jj + bh) & 7, lds); }
    xcd_barrier(xb);
    if ((PH & 32) && bid < NTOK / 256) { const int pm = bid;
        if (P3 & 1) yb_norm_panel(P, pm);
        __syncthreads();
        if (P3 & 2) { pg8::Gemm g; g.A = (const bf16_t*)(P.ws + OFF_EG); g.Bt = (const bf16_t*)(P.ws + OFF_WBA); g.M = NTOK; g.N = 1024; { int k_ = 256; asm volatile("" : "+s"(k_)); g.K = k_; } g.lda = 512;
          pg8::PanelOrder S; S.pm = pm; S.npn = 4; EpiMixA E; E.GA = (bf16_t*)(P.ws + OFF_GA);
          pg8::gemm_phase<EpiMixA, pg8::PanelOrder, true>(lds, g, S, E); }
        __syncthreads();
        if (P3 & 4) { pg8::Gemm g; g.A = (const bf16_t*)(P.ws + OFF_EG + 512); g.Bt = (const bf16_t*)(P.ws + OFF_WBB); g.M = NTOK; g.N = 1024; { int k_ = 256; asm volatile("" : "+s"(k_)); g.K = k_; } g.lda = 512;
          pg8::PanelOrder S; S.pm = pm; S.npn = 4; EpiMixB E; E.GA = (const bf16_t*)(P.ws + OFF_GA); E.GB = (const bf16_t*)(P.ws + OFF_GB); E.M8 = P.ws + OFF_QA;
          pg8::gemm_phase<EpiMixB, pg8::PanelOrder, true>(lds, g, S, E); }
        __syncthreads();
        if (P3 & 8) { pg8::Gemm g; g.A = (const bf16_t*)(P.ws + OFF_QA); g.Bt = (const bf16_t*)(P.ws + OFF_WOUT); g.M = NTOK; g.N = 1024; { int k_ = 512; asm volatile("" : "+s"(k_)); g.K = k_; g.lda = k_; }
          pg8::PanelOrder S; S.pm = pm; S.npn = 4; EpiOut E; E.ada = (const float*)(P.ws + OFF_ADA); E.D = (bf16_t*)(P.ws + OFF_GB);
          pg8::gemm_phase<EpiOut, pg8::PanelOrder, true>(lds, g, S, E); }
        __syncthreads();
        if (P3 & 16) ln1_panel(P, pm);
        __syncthreads();
        if (P3 & 32) { pg8::Gemm g; g.A = (const bf16_t*)(P.ws + OFF_H); g.Bt = (const bf16_t*)(P.ws + OFF_WQ); g.M = NTOK; g.N = 1024; g.K = 1024; g.lda = 1024;
          pg8::PanelOrder S; S.pm = pm; S.npn = 4; EpiBf16 E; E.O = (bf16_t*)(P.ws + OFF_GB);
          pg8::gemm_phase<EpiBf16, pg8::PanelOrder>(lds, g, S, E); }
        __syncthreads();
        { const size_t tok0 = (size_t)pm * 256 + (tid_opaque() >> 6) * 32;
          peer_select_wave(P, tok0);
          __syncthreads();
#pragma unroll 1
          for (int sb = 0; sb < 4; ++sb) {
              peer_u_tokens(P, lds, tok0 + 8 * sb);
              __syncthreads();
              peer_v_tokens(P, lds, tok0 + 8 * sb);
              __syncthreads();
          } }
    }
}

extern "C" void kernel_launch(void* const* d_in, const int* in_sizes, int n_in, void* d_out, int out_size, void* d_ws, size_t ws_size, hipStream_t stream) {
    static int grid_blocks = 0;
    if (grid_blocks == 0) {
        if (n_in != 18 || out_size != NTOK * DM || ws_size < WS_END) { fprintf(stderr, "kernel_launch: unexpected shapes (n_in %d, out %d, ws %zu, need %zu)\n", n_in, out_size, ws_size, (size_t)WS_END); grid_blocks = -1; return; }
        int dev = 0, cus = 0, per_cu = 0;
        hipGetDevice(&dev);
        hipDeviceGetAttribute(&cus, hipDeviceAttributeMultiprocessorCount, dev);
        if (hipFuncSetAttribute((const void*)fwd_megakernel, hipFuncAttributeMaxDynamicSharedMemorySize, LDS_BYTES) != hipSuccess) fprintf(stderr, "kernel_launch: hipFuncSetAttribute failed\n");
        hipOccupancyMaxActiveBlocksPerMultiprocessor(&per_cu, (const void*)fwd_megakernel, NTHR, LDS_BYTES);
        if (per_cu < 1) { fprintf(stderr, "kernel_launch: occupancy query says %d blocks per CU\n", per_cu); per_cu = 1; }
        if (per_cu > 1) per_cu = 1;
        grid_blocks = cus * per_cu;
        if (grid_blocks != NTOK / 256) { fprintf(stderr, "kernel_launch: built for a %d-CU device (one 256-token panel per workgroup), found %d\n", NTOK / 256, grid_blocks); grid_blocks = -1; return; }
        (void)hipGetLastError();
    }
    if (grid_blocks < 0) return;
    Params p{};
    p.x = (const float*)d_in[0]; p.c = (const float*)d_in[1]; p.w_ada = (const float*)d_in[2]; p.b_ada = (const float*)d_in[3]; p.w_in = (const float*)d_in[4];
    p.w_ba = (const float*)d_in[5]; p.w_bb = (const float*)d_in[6]; p.w_out = (const float*)d_in[7]; p.hgrn_lb = (const float*)d_in[8]; p.hgrn_ng = (const float*)d_in[9];
    p.ln1_g = (const float*)d_in[10]; p.ln1_b = (const float*)d_in[11]; p.peer_wq = (const float*)d_in[12]; p.peer_sk = (const float*)d_in[13]; p.peer_u = (const float*)d_in[14];
    p.peer_v = (const float*)d_in[15]; p.ln2_g = (const float*)d_in[16]; p.ln2_b = (const float*)d_in[17];
    p.out = (float*)d_out; p.ws = (unsigned char*)d_ws;
    if (hipMemsetAsync((char*)d_ws + OFF_BAR, 0, XCD_BAR_WORDS * 4, stream) != hipSuccess) fprintf(stderr, "kernel_launch: memset of the barrier words failed\n");
    void* args[] = {&p};
    hipError_t e = hipLaunchCooperativeKernel((const void*)fwd_megakernel, dim3(grid_blocks), dim3(NTHR), args, LDS_BYTES, stream);
    if (e != hipSuccess) fprintf(stderr, "cooperative launch failed: %s (grid %d)\n", hipGetErrorString(e), grid_blocks);
}
```

```cpp
#include <hip/hip_runtime.h>
#include <hip/hip_cooperative_groups.h>
#include <cstdio>
#include <cstdint>
#include <type_traits>
namespace cg = cooperative_groups;

#define LAS __attribute__((address_space(3)))
typedef unsigned short bf16_t;
typedef short bf16x8 __attribute__((ext_vector_type(8)));
typedef short s16x4 __attribute__((ext_vector_type(4)));
typedef float f32x2 __attribute__((ext_vector_type(2)));
typedef float f32x4 __attribute__((ext_vector_type(4)));
typedef float f32x16 __attribute__((ext_vector_type(16)));
typedef unsigned u32x2 __attribute__((ext_vector_type(2)));
typedef unsigned u32x4 __attribute__((ext_vector_type(4)));

constexpr int NB = 32, SEQ = 2048, DM = 1024, NTOK = NB * SEQ;
constexpr int INCOLS = 5632;
constexpr int NTHR = 512;
constexpr int LDS_BYTES = 147456;
constexpr float ALPHA = 1.189207115002721f;
constexpr float LN_EPS = 1e-5f, RMS_EPS = 1e-6f;
constexpr float LOG2E = 1.4426950408889634f;

constexpr size_t SZ_T512 = (size_t)NTOK * 512 * 2, SZ_T1024 = (size_t)NTOK * 1024 * 2;
constexpr size_t OFF_ADA = 0;
constexpr size_t OFF_LB = OFF_ADA + 786432;
constexpr size_t OFF_KMEAN = OFF_LB + 4096;
constexpr size_t OFF_WIN = OFF_KMEAN + 524288;
constexpr size_t OFF_WBA = OFF_WIN + (size_t)5632 * 1024 * 2;
constexpr size_t OFF_WBB = OFF_WBA + 1048576;
constexpr size_t OFF_WOUT = OFF_WBB + 1048576;
constexpr size_t OFF_WQ = OFF_WOUT + 2097152;
constexpr size_t OFF_SK = OFF_WQ + 2097152;
constexpr size_t OFF_U8 = OFF_SK + 262144;
constexpr size_t OFF_USC = OFF_U8 + 8388608;
constexpr size_t OFF_V8 = OFF_U8 + 16777216;
constexpr size_t OFF_VSC = OFF_V8 + 8388608;
constexpr size_t OFF_CTR = OFF_V8 + 16777216;
constexpr size_t OFF_BAR = OFF_CTR + 4096;
constexpr size_t OFF_EG = OFF_BAR + 16384;
constexpr size_t OFF_H = OFF_EG + (size_t)NTOK * 128 * 8;
constexpr size_t OFF_QA = OFF_H + SZ_T1024;
constexpr size_t OFF_KA = OFF_QA + SZ_T512;
constexpr size_t OFF_VA = OFF_KA + SZ_T512;
constexpr size_t OFF_HQ = OFF_VA + SZ_T512;
constexpr size_t OFF_HK = OFF_HQ + SZ_T512;
constexpr size_t OFF_HI = OFF_HK + SZ_T512;
constexpr size_t OFF_HG = OFF_HI + SZ_T512;
constexpr size_t OFF_GA = OFF_HG + SZ_T512;
constexpr size_t OFF_GB = OFF_GA + SZ_T1024;
constexpr size_t WS_END = OFF_GB + SZ_T1024;
constexpr size_t OFF_H8 = OFF_VA;
constexpr size_t OFF_HS = OFF_HQ;
constexpr size_t OFF_W = OFF_KA;
constexpr size_t OFF_Y = OFF_KA;

struct Params {
    const float *x, *c, *w_ada, *b_ada, *w_in, *w_ba, *w_bb, *w_out, *hgrn_lb, *hgrn_ng, *ln1_g, *ln1_b, *peer_wq, *peer_sk, *peer_u, *peer_v, *ln2_g, *ln2_b;
    float* out;
    unsigned char* ws;
};

typedef __bf16 bf16v2 __attribute__((ext_vector_type(2)));
__device__ __forceinline__ unsigned cvt_pk_bf16(float lo, float hi) { return __builtin_bit_cast(unsigned, __builtin_convertvector((f32x2){lo, hi}, bf16v2)); }
__device__ __forceinline__ float bf_lo(unsigned w) { return __uint_as_float(w << 16); }
__device__ __forceinline__ float bf_hi(unsigned w) { return __uint_as_float(w & 0xffff0000u); }
__device__ __forceinline__ float sigmoidf_(float x) { return __builtin_amdgcn_rcpf(1.0f + __builtin_amdgcn_exp2f(-LOG2E * x)); }
__device__ __forceinline__ float wave_sum(float v) {
#pragma unroll
    for (int o = 1; o < 64; o <<= 1) v += __shfl_xor(v, o);
    return v;
}
__device__ __forceinline__ int tid_opaque() { int t = threadIdx.x; asm volatile("" : "+v"(t)); return t; }
__device__ __forceinline__ int crow(int r, int hi) { return (r & 3) + 8 * (r >> 2) + 4 * hi; }
#define MFMA32(a, b, c) __builtin_amdgcn_mfma_f32_32x32x16_bf16(a, b, c, 0, 0, 0)

namespace pg8 {
constexpr int BM = 256, BK = 64, HALF = 128, HTB = HALF * BK * 2, STAGE_BYTES = 8 * HTB, NXCD = 8, WGM = 8;
__host__ __device__ __forceinline__ int lds_byte(int r, int c) { const int st = (r >> 4) * 2 + (c >> 5), rr = r & 15, cc = c & 31, ob = rr * 64 + cc * 2; return st * 1024 + (ob ^ (((ob >> 9) & 1) << 5)); }
__host__ __device__ __forceinline__ void stage_rc(int b, int& R, int& C) { const int st = b / 1024, sb = b % 1024, swz = sb ^ (((sb >> 9) & 1) << 5); R = (st >> 1) * 16 + swz / 64; C = (st & 1) * 32 + (swz % 64) / 2; }
__host__ __device__ __forceinline__ int perm32(int rho) { const int n = rho >> 4, i = rho & 15; return 8 * (i >> 2) + 4 * n + (i & 3); }

struct Unit { int pm, pn; };
struct Gemm { const bf16_t* A; const bf16_t* Bt; int M, N, K, lda; };

struct StaticOrder {
    int nM, nN, nwg, G, c;
    __device__ void init(int M, int N, int G_, int c_) { nM = M / BM; nN = N / BM; nwg = nM * nN; G = G_; c = c_; }
    __device__ bool next(int i, Unit& u) const {
        const long L = (long)i * G + c; if (L >= nwg) return false;
        int wgid = (int)L; { const int q = nwg / NXCD, r = nwg % NXCD, xcd = wgid % NXCD, off = wgid / NXCD; wgid = (xcd < r ? xcd * (q + 1) : r * (q + 1) + (xcd - r) * q) + off; }
        const int nig = WGM * nN, gid = wgid / nig, fm = gid * WGM, gsz = (nM - fm) < WGM ? (nM - fm) : WGM;
        u.pm = fm + ((wgid % nig) % gsz); u.pn = (wgid % nig) / gsz; return true;
    }
};
struct PanelOrder {
    int pm, npn;
    __device__ bool next(int i, Unit& u) const { if (i >= npn) return false; u.pm = pm; u.pn = i; return true; }
};

template <class Epi, class Sched, bool MX = false>
__device__ __forceinline__ void gemm_phase(LAS unsigned char* lds, const Gemm g, const Sched& S, const Epi& E) {
    const int tid = tid_opaque(), wid = __builtin_amdgcn_readfirstlane(tid >> 6), lane = tid & 63, wr = wid >> 2, wc = wid & 3, fr = lane & 15, fq = lane >> 4;
    const int K = g.K, nt = K / BK;
    unsigned voffA, voffB;
    { int R, C; stage_rc(tid * 16, R, C); const int Rb = Epi::PERM ? ((R & ~31) + perm32(R & 31)) : R;
      voffA = (unsigned)(R * g.lda + C) * 2u; voffB = (unsigned)(Rb * K + C) * 2u; }
    const size_t rvoffA = (size_t)128 * g.lda, rvoffB = (size_t)128 * K;
    const size_t kstep = (size_t)(BK * 2);
    const size_t hstep = (size_t)HALF * K * 2;
    const size_t tstep = 2 * hstep;
    const size_t hstepA = (size_t)HALF * g.lda * 2, tstepA = 2 * hstepA;
    const unsigned ldsw = (unsigned)wid * 1024u;
    const int aoff = lds_byte(wr * 64 + fr, fq * 8), boff = lds_byte(wc * 32 + fr, fq * 8);
#define PG8_SA(b, h) (((b) * 2 + (h)) * HTB)
#define PG8_SB(b, h) ((4 + (b) * 2 + (h)) * HTB)
#define PG8_STAGE(bufoff, gbase, voff) do { unsigned vo_ = (voff); asm volatile("" : "+v"(vo_));     \
        _Pragma("unroll") for (int _i = 0; _i < 2; ++_i) \
        __builtin_amdgcn_global_load_lds((const unsigned*)((const char*)(gbase) + _i * r##voff + vo_), (LAS unsigned*)(lds + (bufoff) + ldsw + _i * 8192), 16, 0, 0); } while (0)
#define PG8_LDX(dst, off) do { const v4i_ lo_ = *(const LAS v4i_*)(lds + (off)), hi_ = *(const LAS v4i_*)(lds + (off) + 1024); dst = __builtin_shufflevector(lo_, hi_, 0, 1, 2, 3, 4, 5, 6, 7); } while (0)
#define PG8_LDA(dst, b, h) do { if constexpr (MX) { _Pragma("unroll") for (int m = 0; m < 4; ++m) PG8_LDX(dst##X[m], PG8_SA(b, h) + aoff + m * 2048); } \
        else { _Pragma("unroll") for (int m = 0; m < 4; ++m) _Pragma("unroll") for (int k = 0; k < 2; ++k) dst[m][k] = *(const LAS bf16x8*)(lds + PG8_SA(b, h) + aoff + m * 2048 + k * 1024); } } while (0)
#define PG8_LDB(dst, b, h) do { if constexpr (MX) { _Pragma("unroll") for (int n = 0; n < 2; ++n) PG8_LDX(dst##X[n], PG8_SB(b, h) + boff + n * 2048); } \
        else { _Pragma("unroll") for (int n = 0; n < 2; ++n) _Pragma("unroll") for (int k = 0; k < 2; ++k) dst[n][k] = *(const LAS bf16x8*)(lds + PG8_SB(b, h) + boff + n * 2048 + k * 1024); } } while (0)
#define PG8_MMA(ai, bj, At, Bt) do { __builtin_amdgcn_s_setprio(1); \
        if constexpr (MX) { _Pragma("unroll") for (int m = 0; m < 4; ++m) _Pragma("unroll") for (int n = 0; n < 2; ++n) \
            asm volatile("v_mfma_scale_f32_16x16x128_f8f6f4 %0, %1, %2, %0, %3, %3 op_sel_hi:[0,0,0]" : "+v"(acc[ai][bj][m][n]) : "v"(Bt##X[n]), "v"(At##X[m]), "v"(mxscale)); } \
        else { _Pragma("unroll") for (int m = 0; m < 4; ++m) _Pragma("unroll") for (int n = 0; n < 2; ++n) _Pragma("unroll") for (int k = 0; k < 2; ++k) \
            acc[ai][bj][m][n] = __builtin_amdgcn_mfma_f32_16x16x32_bf16(Bt[n][k], At[m][k], acc[ai][bj][m][n], 0, 0, 0); } \
        __builtin_amdgcn_s_setprio(0); } while (0)
#define PG8_WAIT_V(n) asm volatile("s_waitcnt vmcnt(" #n ")" ::: "memory")
#define PG8_WAIT_L(n) asm volatile("s_waitcnt lgkmcnt(" #n ")" ::: "memory")
#define PG8_BAR __builtin_amdgcn_s_barrier()
#define PG8_SCHED __builtin_amdgcn_sched_barrier(0)
    Unit cur, nxt; int ui = 0;
    if (!S.next(0, cur)) return;
    f32x4 acc[2][2][4][2];
#pragma unroll
    for (int a = 0; a < 2; ++a)
#pragma unroll
        for (int b = 0; b < 2; ++b)
#pragma unroll
            for (int m = 0; m < 4; ++m)
#pragma unroll
                for (int n = 0; n < 2; ++n) acc[a][b][m][n] = (f32x4){0.f, 0.f, 0.f, 0.f};
    typedef int v4i_ __attribute__((ext_vector_type(4))); typedef int v8i_ __attribute__((ext_vector_type(8)));
    bf16x8 At[4][2], B0[2][2], B1[2][2];
    v8i_ AtX[4], B0X[2], B1X[2];
    const int mxscale = 0x7f7f7f7f;
    const char* cA = (const char*)g.A + (size_t)cur.pm * tstepA; const char* cB = (const char*)g.Bt + (size_t)cur.pn * tstep;
    PG8_STAGE(PG8_SB(0, 0), cB, voffB); PG8_STAGE(PG8_SA(0, 0), cA, voffA); PG8_STAGE(PG8_SB(0, 1), cB + hstep, voffB); PG8_STAGE(PG8_SA(0, 1), cA + hstepA, voffA);
    if (wr == 1) PG8_BAR;
    PG8_WAIT_V(4); PG8_BAR;
    PG8_STAGE(PG8_SB(1, 0), cB + kstep, voffB); PG8_STAGE(PG8_SA(1, 0), cA + kstep, voffA); PG8_STAGE(PG8_SB(1, 1), cB + hstep + kstep, voffB);
    PG8_WAIT_V(6); PG8_BAR;
    for (;;) {
        const bool has_next = S.next(ui + 1, nxt);
        const char* nA = has_next ? (const char*)g.A + (size_t)nxt.pm * tstepA : cA; const char* nB = has_next ? (const char*)g.Bt + (size_t)nxt.pn * tstep : cB;
        for (int t = 0; t < nt; t += 2) {
            const bool last = (t == nt - 2);
            const char* a1 = cA + (size_t)(t + 1) * kstep;
            const char* a2 = last ? nA : cA + (size_t)(t + 2) * kstep; const char* b2 = last ? nB : cB + (size_t)(t + 2) * kstep;
            const char* a3 = a2 + kstep; const char* b3 = b2 + kstep;
            PG8_LDB(B0, 0, 0); PG8_SCHED; PG8_LDA(At, 0, 0); PG8_STAGE(PG8_SA(1, 1), a1 + hstepA, voffA);
            PG8_WAIT_L(8); PG8_BAR; PG8_WAIT_L(0); PG8_MMA(0, 0, At, B0); PG8_BAR; PG8_SCHED;
            PG8_LDB(B1, 0, 1); PG8_STAGE(PG8_SB(0, 0), b2, voffB);
            PG8_BAR; PG8_WAIT_L(0); PG8_MMA(0, 1, At, B1); PG8_BAR;
            PG8_LDA(At, 0, 1); PG8_STAGE(PG8_SA(0, 0), a2, voffA);
            PG8_BAR; PG8_WAIT_L(0); PG8_MMA(1, 0, At, B0); PG8_BAR; PG8_SCHED;
            PG8_STAGE(PG8_SB(0, 1), b2 + hstep, voffB);
            PG8_WAIT_V(6); PG8_BAR; PG8_MMA(1, 1, At, B1); PG8_BAR;
            PG8_LDB(B0, 1, 0); PG8_SCHED; PG8_LDA(At, 1, 0); PG8_STAGE(PG8_SA(0, 1), a2 + hstepA, voffA);
            PG8_WAIT_L(8); PG8_BAR; PG8_WAIT_L(0); PG8_MMA(0, 0, At, B0); PG8_BAR; PG8_SCHED;
            PG8_LDB(B1, 1, 1); PG8_STAGE(PG8_SB(1, 0), b3, voffB);
            PG8_BAR; PG8_WAIT_L(0); PG8_MMA(0, 1, At, B1); PG8_BAR;
            PG8_LDA(At, 1, 1); PG8_STAGE(PG8_SA(1, 0), a3, voffA);
            PG8_BAR; PG8_WAIT_L(0); PG8_MMA(1, 0, At, B0); PG8_BAR; PG8_SCHED;
            PG8_STAGE(PG8_SB(1, 1), b3 + hstep, voffB);
            PG8_WAIT_V(6); PG8_BAR; PG8_MMA(1, 1, At, B1); PG8_BAR;
        }
        if constexpr (MX) asm volatile("s_nop 15\n\ts_nop 15" ::: "memory");
        E(acc, cur, wr, wc, fr, fq);
        if (!has_next) break;
#pragma unroll
        for (int a = 0; a < 2; ++a)
#pragma unroll
            for (int b = 0; b < 2; ++b)
#pragma unroll
                for (int m = 0; m < 4; ++m)
#pragma unroll
                    for (int n = 0; n < 2; ++n) acc[a][b][m][n] = (f32x4){0.f, 0.f, 0.f, 0.f};
        cur = nxt; cA = nA; cB = nB; ++ui;
    }
    PG8_WAIT_V(0);
    if (wr == 0) PG8_BAR;
    PG8_BAR;
#undef PG8_SA
#undef PG8_SB
#undef PG8_STAGE
#undef PG8_LDX
#undef PG8_LDA
#undef PG8_LDB
#undef PG8_MMA
#undef PG8_WAIT_V
#undef PG8_WAIT_L
#undef PG8_BAR
#undef PG8_SCHED
}
}
using pg8::Unit;

struct EpiProj {
    static constexpr bool PERM = true;
    unsigned char* ws; const float* lb; const float* ng; float* kmean;
    __device__ __forceinline__ void operator()(const f32x4 (&acc)[2][2][4][2], const Unit& u, int wr, int wc, int fr, int fq) const {
        const int pn = u.pn; int seg, colt, ldc; size_t boff;
        if (pn < 14) { seg = pn >> 1; colt = (pn & 1) * 256; ldc = 512; boff = OFF_QA + (size_t)seg * SZ_T512; }
        else if (pn < 18) { seg = 7; colt = (pn - 14) * 256; ldc = 1024; boff = OFF_GA; }
        else { seg = 8; colt = (pn - 18) * 256; ldc = 1024; boff = OFF_GB; }
        bf16_t* base = (bf16_t*)(ws + boff);
        const int row0 = u.pm * 256 + wr * 64 + fr, col0 = colt + wc * 32 + 8 * fq;
        float pv[2][8];
#pragma unroll
        for (int bj = 0; bj < 2; ++bj)
#pragma unroll
            for (int e = 0; e < 8; ++e) pv[bj][e] = (seg == 4) ? (1.0f - lb[col0 + bj * 128 + e]) : ((seg == 6) ? ng[col0 + bj * 128 + e] : 0.f);
        float cs[2][8];
#pragma unroll
        for (int bj = 0; bj < 2; ++bj)
#pragma unroll
            for (int e = 0; e < 8; ++e) cs[bj][e] = 0.f;
#pragma unroll
        for (int ai = 0; ai < 2; ++ai)
#pragma unroll
            for (int m = 0; m < 4; ++m) {
                bf16_t* rowp = base + (size_t)(row0 + ai * 128 + m * 16) * ldc + col0;
#pragma unroll
                for (int bj = 0; bj < 2; ++bj) {
                    float v[8];
#pragma unroll
                    for (int e = 0; e < 4; ++e) { v[e] = acc[ai][bj][m][0][e] * (1.0f / 32.0f); v[4 + e] = acc[ai][bj][m][1][e] * (1.0f / 32.0f); }
                    if (seg == 0) {
#pragma unroll
                        for (int e = 0; e < 8; ++e) v[e] *= (0.125f * LOG2E);
                    } else if (seg == 1) {
#pragma unroll
                        for (int e = 0; e < 8; ++e) cs[bj][e] += v[e];
                    } else if (seg == 3) {
#pragma unroll
                        for (int e = 0; e < 8; ++e) v[e] = v[e] * sigmoidf_(v[e]);
                    } else if (seg == 4) {
#pragma unroll
                        for (int e = 0; e < 8; ++e) v[e] = pv[bj][e] * sigmoidf_(-v[e]);
                    } else if (seg == 6) {
#pragma unroll
                        for (int e = 0; e < 8; ++e) v[e] = pv[bj][e] * v[e] * sigmoidf_(v[e]);
                    } else if (seg >= 7) {
#pragma unroll
                        for (int e = 0; e < 8; ++e) v[e] = sigmoidf_(v[e]);
                    }
                    u32x4 w; w.x = cvt_pk_bf16(v[0], v[1]); w.y = cvt_pk_bf16(v[2], v[3]); w.z = cvt_pk_bf16(v[4], v[5]); w.w = cvt_pk_bf16(v[6], v[7]);
                    *(u32x4*)(rowp + bj * 128) = w;
                }
            }
        if (seg == 1) {
#pragma unroll
            for (int bj = 0; bj < 2; ++bj)
#pragma unroll
                for (int e = 0; e < 8; ++e) {
                    float s = cs[bj][e];
                    s += __shfl_xor(s, 1); s += __shfl_xor(s, 2); s += __shfl_xor(s, 4); s += __shfl_xor(s, 8);
                    if (fr == 0) atomicAdd(kmean + (size_t)u.pm * 512 + col0 + bj * 128 + e, s);
                }
        }
    }
};
struct EpiMixA {
    static constexpr bool PERM = true;
    bf16_t* GA;
    __device__ __forceinline__ void operator()(const f32x4 (&acc)[2][2][4][2], const Unit& u, int wr, int wc, int fr, int fq) const {
        const int row0 = u.pm * 256 + wr * 64 + fr, col0 = u.pn * 256 + wc * 32 + 8 * fq;
#pragma unroll
        for (int ai = 0; ai < 2; ++ai)
#pragma unroll
            for (int m = 0; m < 4; ++m) {
                bf16_t* rowp = GA + (size_t)(row0 + ai * 128 + m * 16) * 1024 + col0;
#pragma unroll
                for (int bj = 0; bj < 2; ++bj) {
                    const u32x4 g = *(const u32x4*)(rowp + bj * 128);
                    const f32x4 a0 = acc[ai][bj][m][0], a1 = acc[ai][bj][m][1];
                    u32x4 w;
                    constexpr float S = 1.0f / 32.0f;
                    w.x = cvt_pk_bf16(bf_lo(g.x) * a0[0] * S, bf_hi(g.x) * a0[1] * S); w.y = cvt_pk_bf16(bf_lo(g.y) * a0[2] * S, bf_hi(g.y) * a0[3] * S);
                    w.z = cvt_pk_bf16(bf_lo(g.z) * a1[0] * S, bf_hi(g.z) * a1[1] * S); w.w = cvt_pk_bf16(bf_lo(g.w) * a1[2] * S, bf_hi(g.w) * a1[3] * S);
                    *(u32x4*)(rowp + bj * 128) = w;
                }
            }
    }
};
struct EpiMixB {
    static constexpr bool PERM = true;
    const bf16_t* GA; const bf16_t* GB; unsigned char* M8;
    __device__ __forceinline__ void operator()(const f32x4 (&acc)[2][2][4][2], const Unit& u, int wr, int wc, int fr, int fq) const {
        const int row0 = u.pm * 256 + wr * 64 + fr, col0 = u.pn * 256 + wc * 32 + 8 * fq;
#pragma unroll
        for (int ai = 0; ai < 2; ++ai)
#pragma unroll
            for (int m = 0; m < 4; ++m) {
                const size_t off = (size_t)(row0 + ai * 128 + m * 16) * 1024 + col0;
#pragma unroll
                for (int bj = 0; bj < 2; ++bj) {
                    const u32x4 g = *(const u32x4*)(GB + off + bj * 128);
                    const u32x4 mx = *(const u32x4*)(GA + off + bj * 128);
                    const f32x4 a0 = acc[ai][bj][m][0], a1 = acc[ai][bj][m][1];
                    constexpr float S = 1.0f / 32.0f;
                    int w0 = __builtin_amdgcn_cvt_pk_fp8_f32(bf_lo(mx.x) + bf_lo(g.x) * a0[0] * S, bf_hi(mx.x) + bf_hi(g.x) * a0[1] * S, 0, false); w0 = __builtin_amdgcn_cvt_pk_fp8_f32(bf_lo(mx.y) + bf_lo(g.y) * a0[2] * S, bf_hi(mx.y) + bf_hi(g.y) * a0[3] * S, w0, true);
                    int w1 = __builtin_amdgcn_cvt_pk_fp8_f32(bf_lo(mx.z) + bf_lo(g.z) * a1[0] * S, bf_hi(mx.z) + bf_hi(g.z) * a1[1] * S, 0, false); w1 = __builtin_amdgcn_cvt_pk_fp8_f32(bf_lo(mx.w) + bf_lo(g.w) * a1[2] * S, bf_hi(mx.w) + bf_hi(g.w) * a1[3] * S, w1, true);
                    *(u32x2*)(M8 + off + bj * 128) = (u32x2){(unsigned)w0, (unsigned)w1};
                }
            }
    }
};
struct EpiOut {
    static constexpr bool PERM = true;
    const float* ada; bf16_t* D;
    __device__ __forceinline__ void operator()(const f32x4 (&acc)[2][2][4][2], const Unit& u, int wr, int wc, int fr, int fq) const {
        const int row0 = u.pm * 256 + wr * 64 + fr, col0 = u.pn * 256 + wc * 32 + 8 * fq;
        const float* gt1 = ada + (size_t)(u.pm >> 3) * 6144 + 2048 + col0;
        f32x4 g[2][2];
#pragma unroll
        for (int bj = 0; bj < 2; ++bj) { g[bj][0] = *(const f32x4*)(gt1 + bj * 128); g[bj][1] = *(const f32x4*)(gt1 + bj * 128 + 4); }
#pragma unroll
        for (int ai = 0; ai < 2; ++ai)
#pragma unroll
            for (int m = 0; m < 4; ++m) {
                bf16_t* rowp = D + (size_t)(row0 + ai * 128 + m * 16) * 1024 + col0;
#pragma unroll
                for (int bj = 0; bj < 2; ++bj) {
                    const f32x4 a0 = acc[ai][bj][m][0] * g[bj][0] * (1.0f / 32.0f), a1 = acc[ai][bj][m][1] * g[bj][1] * (1.0f / 32.0f);
                    u32x4 w; w.x = cvt_pk_bf16(a0[0], a0[1]); w.y = cvt_pk_bf16(a0[2], a0[3]); w.z = cvt_pk_bf16(a1[0], a1[1]); w.w = cvt_pk_bf16(a1[2], a1[3]);
                    *(u32x4*)(rowp + bj * 128) = w;
                }
            }
    }
};
struct EpiBf16 {
    static constexpr bool PERM = true;
    bf16_t* O;
    __device__ __forceinline__ void operator()(const f32x4 (&acc)[2][2][4][2], const Unit& u, int wr, int wc, int fr, int fq) const {
        const int row0 = u.pm * 256 + wr * 64 + fr, col0 = u.pn * 256 + wc * 32 + 8 * fq;
#pragma unroll
        for (int ai = 0; ai < 2; ++ai)
#pragma unroll
            for (int m = 0; m < 4; ++m) {
                bf16_t* rowp = O + (size_t)(row0 + ai * 128 + m * 16) * 1024 + col0;
#pragma unroll
                for (int bj = 0; bj < 2; ++bj) {
                    const f32x4 a0 = acc[ai][bj][m][0], a1 = acc[ai][bj][m][1];
                    u32x4 w; w.x = cvt_pk_bf16(a0[0], a0[1]); w.y = cvt_pk_bf16(a0[2], a0[3]); w.z = cvt_pk_bf16(a1[0], a1[1]); w.w = cvt_pk_bf16(a1[2], a1[3]);
                    *(u32x4*)(rowp + bj * 128) = w;
                }
            }
    }
};

__device__ void phase0a(const Params& P, LAS unsigned char* lds) {
    const int tid = tid_opaque(), G = gridDim.x, bid = blockIdx.x;
    for (int it = bid; it < 192; it += G) {
        LAS float* sc = (LAS float*)lds;
        for (int i = tid; i < 32 * 1024; i += NTHR) { const float cv = P.c[i]; sc[i] = cv * sigmoidf_(cv); }
        __syncthreads();
        const int kg = tid >> 5, col = tid & 31;
        float a[32];
#pragma unroll
        for (int b = 0; b < 32; ++b) a[b] = 0.f;
#pragma unroll 1
        for (int k = kg * 64; k < kg * 64 + 64; k += 8) {
            float w[8];
#pragma unroll
            for (int e = 0; e < 8; ++e) w[e] = __builtin_nontemporal_load(P.w_ada + (size_t)(k + e) * 6144 + it * 32 + col);
#pragma unroll
            for (int e4 = 0; e4 < 2; ++e4) {
#pragma unroll
                for (int b = 0; b < 32; ++b) { const f32x4 s = *(const LAS f32x4*)(sc + b * 1024 + k + 4 * e4); a[b] += s[0] * w[4 * e4] + s[1] * w[4 * e4 + 1] + s[2] * w[4 * e4 + 2] + s[3] * w[4 * e4 + 3]; }
                asm volatile("" ::: "memory");
            }
        }
        __syncthreads();
        LAS float* red = (LAS float*)lds;
#pragma unroll
        for (int b = 0; b < 32; ++b) red[(kg * 32 + b) * 32 + col] = a[b];
        __syncthreads();
        for (int o = tid; o < 1024; o += NTHR) { const int b = o >> 5, cc = o & 31; float s = 0.f;
#pragma unroll
            for (int g2 = 0; g2 < 16; ++g2) s += red[(g2 * 32 + b) * 32 + cc];
            ((float*)(P.ws + OFF_ADA))[(size_t)b * 6144 + it * 32 + cc] = s + P.b_ada[it * 32 + cc]; }
        __syncthreads();
    }
    const size_t gsz = (size_t)G * NTHR;
    { const int gt = bid * NTHR + tid, gs = G * NTHR;
      if (gt < 512) ((float*)(P.ws + OFF_LB))[gt] = sigmoidf_(P.hgrn_lb[gt] - P.hgrn_lb[512 + gt]);
      for (int i = gt; i < 32 * 8 * 512; i += gs) ((float*)(P.ws + OFF_KMEAN))[i] = 0.f; }
    {
        LAS float* tile = (LAS float*)lds;
        const int I0 = 16 * 88, I1 = I0 + 8 * 16, I2 = I1 + 8 * 16, I3 = I2 + 16 * 16, I4 = I3 + 16 * 16;
        for (int it = bid; it < I4; it += G) {
            const float* W; bf16_t* WT; int K, N, r;
            if (it < I0) { W = P.w_in; WT = (bf16_t*)(P.ws + OFF_WIN); K = 1024; N = 5632; r = it; }
            else if (it < I1) { W = P.w_ba; WT = (bf16_t*)(P.ws + OFF_WBA); K = 512; N = 1024; r = it - I0; }
            else if (it < I2) { W = P.w_bb; WT = (bf16_t*)(P.ws + OFF_WBB); K = 512; N = 1024; r = it - I1; }
            else if (it < I3) { W = P.w_out; WT = (bf16_t*)(P.ws + OFF_WOUT); K = 1024; N = 1024; r = it - I2; }
            else { W = P.peer_wq; WT = (bf16_t*)(P.ws + OFF_WQ); K = 1024; N = 1024; r = it - I3; }
            const int nb = N / 64, k0 = (r / nb) * 64, n0 = (r % nb) * 64;
#pragma unroll
            for (int ps = 0; ps < 2; ++ps) { const int kk = (tid >> 4) + 32 * ps, n4 = (tid & 15) * 4;
                const f32x4 v = *(const f32x4*)(W + (size_t)(k0 + kk) * N + n0 + n4);
                tile[kk * 65 + n4] = v[0]; tile[kk * 65 + n4 + 1] = v[1]; tile[kk * 65 + n4 + 2] = v[2]; tile[kk * 65 + n4 + 3] = v[3]; }
            __syncthreads();
            { const int n = tid >> 3, kc = (tid & 7) * 8;
              if (it < I3) {
                  int w0 = __builtin_amdgcn_cvt_pk_fp8_f32(32.f * tile[(kc + 0) * 65 + n], 32.f * tile[(kc + 1) * 65 + n], 0, false); w0 = __builtin_amdgcn_cvt_pk_fp8_f32(32.f * tile[(kc + 2) * 65 + n], 32.f * tile[(kc + 3) * 65 + n], w0, true);
                  int w1 = __builtin_amdgcn_cvt_pk_fp8_f32(32.f * tile[(kc + 4) * 65 + n], 32.f * tile[(kc + 5) * 65 + n], 0, false); w1 = __builtin_amdgcn_cvt_pk_fp8_f32(32.f * tile[(kc + 6) * 65 + n], 32.f * tile[(kc + 7) * 65 + n], w1, true);
                  *(u32x2*)((unsigned char*)WT + (size_t)(n0 + n) * K + k0 + kc) = (u32x2){(unsigned)w0, (unsigned)w1};
              } else { u32x4 w;
              w.x = cvt_pk_bf16(tile[(kc + 0) * 65 + n], tile[(kc + 1) * 65 + n]); w.y = cvt_pk_bf16(tile[(kc + 2) * 65 + n], tile[(kc + 3) * 65 + n]);
              w.z = cvt_pk_bf16(tile[(kc + 4) * 65 + n], tile[(kc + 5) * 65 + n]); w.w = cvt_pk_bf16(tile[(kc + 6) * 65 + n], tile[(kc + 7) * 65 + n]);
              *(u32x4*)(WT + (size_t)(n0 + n) * K + k0 + kc) = w; } }
            __syncthreads();
        }
    }
    {
        const size_t gtid = (size_t)bid * NTHR + tid_opaque();
        for (size_t i = gtid; i < 16384; i += gsz) {
            const float* src = P.peer_sk + i * 8; const f32x4 a = *(const f32x4*)src, b = *(const f32x4*)(src + 4);
            u32x4 w; w.x = cvt_pk_bf16(a[0], a[1]); w.y = cvt_pk_bf16(a[2], a[3]); w.z = cvt_pk_bf16(b[0], b[1]); w.w = cvt_pk_bf16(b[2], b[3]);
            *(u32x4*)((bf16_t*)(P.ws + OFF_SK) + i * 8) = w;
        }
        { const int lane = tid & 63, gw = bid * 8 + (tid >> 6), ngw = G * 8;
          for (int r = gw; r < 2 * 16384; r += ngw) {
              const bool isv = r >= 16384; const int e = isv ? r - 16384 : r;
              const float* s = (isv ? P.peer_v : P.peer_u) + (size_t)e * 1024 + lane * 16;
              f32x4 x[4]; float ss = 0.f;
#pragma unroll
              for (int q = 0; q < 4; ++q) { x[q] = __builtin_nontemporal_load((const f32x4*)(s + 4 * q)); ss += (x[q][0] * x[q][0] + x[q][1] * x[q][1]) + (x[q][2] * x[q][2] + x[q][3] * x[q][3]); }
              const float sc = fmaxf(sqrtf(wave_sum(ss) * (1.0f / 1024.0f)) * (2.6f / 7.5f), 1e-30f), inv = 1.0f / sc;
              unsigned nb[16];
#pragma unroll
              for (int q = 0; q < 4; ++q)
#pragma unroll
                  for (int el = 0; el < 4; ++el) nb[4 * q + el] = (unsigned)fminf(fmaxf(floorf(x[q][el] * inv) + 8.0f, 0.0f), 15.0f);
              u32x2 w;
              w.x = (nb[0] | (nb[4] << 4)) | ((nb[1] | (nb[5] << 4)) << 8) | ((nb[2] | (nb[6] << 4)) << 16) | ((nb[3] | (nb[7] << 4)) << 24);
              w.y = (nb[8] | (nb[12] << 4)) | ((nb[9] | (nb[13] << 4)) << 8) | ((nb[10] | (nb[14] << 4)) << 16) | ((nb[11] | (nb[15] << 4)) << 24);
              *(u32x2*)(P.ws + (isv ? OFF_V8 : OFF_U8) + (size_t)e * 512 + lane * 8) = w;
              if (lane == 0) ((float*)(P.ws + (isv ? OFF_VSC : OFF_USC)))[e] = sc;
          } }
    }
}
__device__ void phase0b(const Params& P) {
    const size_t gtid = (size_t)blockIdx.x * NTHR + threadIdx.x, gsz = (size_t)gridDim.x * NTHR;
    const float* ada = (const float*)(P.ws + OFF_ADA); bf16_t* H = (bf16_t*)(P.ws + OFF_H);
    for (size_t i = gtid; i < (size_t)NTOK * 128; i += gsz) {
        const size_t row = i >> 7; const int c8 = (int)(i & 127) * 8; const int b = (int)(row >> 11);
        const float* xr = P.x + row * 1024 + c8; const float* sh = ada + (size_t)b * 6144 + c8; const float* sc = sh + 1024;
        const f32x4 x0 = *(const f32x4*)xr, x1 = *(const f32x4*)(xr + 4), s0 = *(const f32x4*)sc, s1 = *(const f32x4*)(sc + 4), h0 = *(const f32x4*)sh, h1 = *(const f32x4*)(sh + 4);
        const f32x4 r0 = x0 * (s0 + 1.0f) + h0, r1 = x1 * (s1 + 1.0f) + h1;
        int w0 = __builtin_amdgcn_cvt_pk_fp8_f32(r0[0], r0[1], 0, false); w0 = __builtin_amdgcn_cvt_pk_fp8_f32(r0[2], r0[3], w0, true);
        int w1 = __builtin_amdgcn_cvt_pk_fp8_f32(r1[0], r1[1], 0, false); w1 = __builtin_amdgcn_cvt_pk_fp8_f32(r1[2], r1[3], w1, true);
        *(u32x2*)((unsigned char*)H + row * 1024 + c8) = (u32x2){(unsigned)w0, (unsigned)w1};
    }
}

__device__ __forceinline__ s16x4 tr4(const LAS unsigned char* p) { return __builtin_bit_cast(s16x4, __builtin_amdgcn_ds_read_tr16_b64_v4i16((LAS s16x4*)p)); }
__device__ void hgrn_item(const Params& P, int item, LAS unsigned char* lds) {
    const int tid = tid_opaque(), lane = tid & 63, wid = __builtin_amdgcn_readfirstlane(tid >> 6), r32 = lane & 31, hi = lane >> 5;
    const int b = item >> 3, h = (item >> 1) & 3, vh = item & 1;
    const bf16_t* HQ = (const bf16_t*)(P.ws + OFF_HQ); const bf16_t* HK = (const bf16_t*)(P.ws + OFF_HK); bf16_t* HI = (bf16_t*)(P.ws + OFF_HI);
    constexpr int SQ = 272, SKD = 320, SV = 192, SS = 192;
    constexpr int LQR = 0, LKR = 17408, LQB = 34816, LKD = 52224, LV = 72704, LS = 84992, LG = 109568, LT = 142336, LCL = 144384;
    LAS float* G = (LAS float*)(lds + LG); LAS float* TOT = (LAS float*)(lds + LT); LAS float* CL = (LAS float*)(lds + LCL);
    const size_t rowb = (size_t)b * SEQ;
    const int row = tid >> 3, seg = tid & 7;
    const bf16_t* qsrc = HQ + (rowb + row) * 512 + h * 128 + seg * 16; const bf16_t* ksrc = HK + (rowb + row) * 512 + h * 128 + seg * 16;
    bf16_t* vsrc = HI + (rowb + row) * 512 + h * 128 + vh * 64 + seg * 8;
    for (int i = tid; i < 128 * SS / 4; i += NTHR) ((LAS unsigned*)(lds + LS))[i] = 0u;
    f32x16 Sacc = {};
    const int di = wid >> 1, vi = wid & 1, ti = wid >> 1;
    const int tg = lane >> 4, tc = tg & 1, tI = lane & 15;
    const int trow = 4 * hi + (tI >> 2), tcol = 16 * tc + 4 * (tI & 3);
    u32x4 qn0 = *(const u32x4*)qsrc, qn1 = *(const u32x4*)(qsrc + 8), kn0 = *(const u32x4*)ksrc, kn1 = *(const u32x4*)(ksrc + 8), vn = *(const u32x4*)vsrc;
#pragma unroll 1
    for (int n = 0; n < SEQ / 64; ++n) {
        const u32x4 q0 = qn0, q1 = qn1, k0 = kn0, k1 = kn1, vv = vn;
        float qf[16] = {bf_lo(q0.x), bf_hi(q0.x), bf_lo(q0.y), bf_hi(q0.y), bf_lo(q0.z), bf_hi(q0.z), bf_lo(q0.w), bf_hi(q0.w), bf_lo(q1.x), bf_hi(q1.x), bf_lo(q1.y), bf_hi(q1.y), bf_lo(q1.z), bf_hi(q1.z), bf_lo(q1.w), bf_hi(q1.w)};
        float kf[16] = {bf_lo(k0.x), bf_hi(k0.x), bf_lo(k0.y), bf_hi(k0.y), bf_lo(k0.z), bf_hi(k0.z), bf_lo(k0.w), bf_hi(k0.w), bf_lo(k1.x), bf_hi(k1.x), bf_lo(k1.y), bf_hi(k1.y), bf_lo(k1.z), bf_hi(k1.z), bf_lo(k1.w), bf_hi(k1.w)};
#pragma unroll
        for (int e4 = 0; e4 < 4; ++e4) *(LAS f32x4*)(G + row * 128 + seg * 16 + 4 * e4) = (f32x4){__logf(1.0f - kf[4 * e4]), __logf(1.0f - kf[4 * e4 + 1]), __logf(1.0f - kf[4 * e4 + 2]), __logf(1.0f - kf[4 * e4 + 3])};
        *(LAS u32x4*)(lds + LV + row * SV + seg * 16) = vv;
        if (n + 1 < SEQ / 64) { const size_t o = (size_t)(n + 1) * 64 * 512; qn0 = *(const u32x4*)(qsrc + o); qn1 = *(const u32x4*)(qsrc + o + 8); kn0 = *(const u32x4*)(ksrc + o); kn1 = *(const u32x4*)(ksrc + o + 8); vn = *(const u32x4*)(vsrc + o); }
        __syncthreads();
        { const int d = tid & 127, q4 = tid >> 7; float s = 0.f;
#pragma unroll
          for (int i = 0; i < 16; ++i) { s += G[(16 * q4 + i) * 128 + d]; G[(16 * q4 + i) * 128 + d] = s; }
          TOT[q4 * 128 + d] = s; }
        __syncthreads();
        {
            const int qq = row >> 4;
#pragma unroll
            for (int e4 = 0; e4 < 4; ++e4) {
                const int d4 = seg * 16 + 4 * e4;
                const f32x4 t0 = *(const LAS f32x4*)(TOT + d4), t1 = *(const LAS f32x4*)(TOT + 128 + d4), t2 = *(const LAS f32x4*)(TOT + 256 + d4), t3 = *(const LAS f32x4*)(TOT + 384 + d4);
                const f32x4 off = (qq == 0) ? (f32x4){0.f, 0.f, 0.f, 0.f} : ((qq == 1) ? t0 : ((qq == 2) ? t0 + t1 : t0 + t1 + t2));
                const f32x4 bb = *(const LAS f32x4*)(G + row * 128 + d4) + off;
                const f32x4 bref = *(const LAS f32x4*)(G + 32 * 128 + d4) + t0 + t1, blast = t0 + t1 + t2 + t3;
                float vqb[4], vqr[4], vkr[4], vkd[4];
#pragma unroll
                for (int e = 0; e < 4; ++e) {
                    const float e1 = __expf(bb[e]), e2 = __expf(-bb[e]);
                    vqb[e] = qf[4 * e4 + e] * e1; vqr[e] = vqb[e] * __expf(-bref[e]);
                    const float ke = kf[4 * e4 + e] * e2; vkr[e] = ke * __expf(bref[e]); vkd[e] = ke * __expf(blast[e]);
                }
                *(LAS u32x2*)(lds + LQB + row * SQ + seg * 32 + 8 * e4) = (u32x2){cvt_pk_bf16(vqb[0], vqb[1]), cvt_pk_bf16(vqb[2], vqb[3])};
                *(LAS u32x2*)(lds + LQR + row * SQ + seg * 32 + 8 * e4) = (u32x2){cvt_pk_bf16(vqr[0], vqr[1]), cvt_pk_bf16(vqr[2], vqr[3])};
                *(LAS u32x2*)(lds + LKR + row * SQ + seg * 32 + 8 * e4) = (u32x2){cvt_pk_bf16(vkr[0], vkr[1]), cvt_pk_bf16(vkr[2], vkr[3])};
                *(LAS u32x2*)(lds + LKD + row * SKD + seg * 32 + 8 * e4) = (u32x2){cvt_pk_bf16(vkd[0], vkd[1]), cvt_pk_bf16(vkd[2], vkd[3])};
                if (row == 0) *(LAS f32x4*)(CL + d4) = (f32x4){__expf(blast[0]), __expf(blast[1]), __expf(blast[2]), __expf(blast[3])};
                asm volatile("" ::: "memory");
            }
        }
        __syncthreads();
        if (wid < 4) {
            f32x16 Z = {};
            for (int si = 0; si <= ti; ++si) {
                f32x16 X = {};
#pragma unroll
                for (int ks = 0; ks < 8; ++ks) {
                    const bf16x8 a = *(const LAS bf16x8*)(lds + LKR + (32 * si + r32) * SQ + (16 * ks + 8 * hi) * 2);
                    const bf16x8 bq = *(const LAS bf16x8*)(lds + LQR + (32 * ti + r32) * SQ + (16 * ks + 8 * hi) * 2);
                    X = MFMA32(a, bq, X);
                }
                if (si == ti) {
#pragma unroll
                    for (int r = 0; r < 16; ++r) if (crow(r, hi) > r32) X[r] = 0.f;
                }
#pragma unroll
                for (int s2 = 0; s2 < 2; ++s2) {
                    union { u32x4 u; bf16x8 v; } pa;
                    pa.u.x = cvt_pk_bf16(X[8 * s2 + 0], X[8 * s2 + 1]); pa.u.y = cvt_pk_bf16(X[8 * s2 + 2], X[8 * s2 + 3]); pa.u.z = cvt_pk_bf16(X[8 * s2 + 4], X[8 * s2 + 5]); pa.u.w = cvt_pk_bf16(X[8 * s2 + 6], X[8 * s2 + 7]);
                    const LAS unsigned char* vp = lds + LV + (32 * si + 16 * s2 + trow) * SV + (32 * vi + tcol) * 2;
                    const s16x4 lo = tr4(vp), hh = tr4(vp + 8 * SV);
                    const bf16x8 vf = {lo[0], lo[1], lo[2], lo[3], hh[0], hh[1], hh[2], hh[3]};
                    Z = MFMA32(pa.v, vf, Z);
                }
            }
#pragma unroll
            for (int ks = 0; ks < 8; ++ks) {
                const bf16x8 a = *(const LAS bf16x8*)(lds + LQB + (32 * ti + r32) * SQ + (16 * ks + 8 * hi) * 2);
                const LAS unsigned char* sp = lds + LS + (16 * ks + 8 * hi + (tI >> 2)) * SS + (32 * vi + tcol) * 2;
                const s16x4 lo = tr4(sp), hh = tr4(sp + 4 * SS);
                const bf16x8 sf = {lo[0], lo[1], lo[2], lo[3], hh[0], hh[1], hh[2], hh[3]};
                Z = MFMA32(a, sf, Z);
            }
            bf16_t* op = HI + (rowb + (size_t)n * 64 + 32 * ti) * 512 + h * 128 + vh * 64 + 32 * vi + r32;
#pragma unroll
            for (int r = 0; r < 16; ++r) op[(size_t)crow(r, hi) * 512] = (bf16_t)(cvt_pk_bf16(Z[r], 0.f) & 0xffffu);
        }
        {
#pragma unroll
            for (int r = 0; r < 16; ++r) Sacc[r] *= CL[32 * di + crow(r, hi)];
#pragma unroll
            for (int ks = 0; ks < 4; ++ks) {
                const LAS unsigned char* kp = lds + LKD + (16 * ks + 8 * hi + (tI >> 2)) * SKD + (32 * di + tcol) * 2;
                const s16x4 klo = tr4(kp), khi = tr4(kp + 4 * SKD);
                const bf16x8 ka = {klo[0], klo[1], klo[2], klo[3], khi[0], khi[1], khi[2], khi[3]};
                const LAS unsigned char* vp = lds + LV + (16 * ks + 8 * hi + (tI >> 2)) * SV + (32 * vi + tcol) * 2;
                const s16x4 vlo = tr4(vp), vhi = tr4(vp + 4 * SV);
                const bf16x8 vb = {vlo[0], vlo[1], vlo[2], vlo[3], vhi[0], vhi[1], vhi[2], vhi[3]};
                Sacc = MFMA32(ka, vb, Sacc);
            }
        }
        __syncthreads();
        {
            LAS bf16_t* sp = (LAS bf16_t*)(lds + LS + (32 * di) * SS + (32 * vi + r32) * 2);
#pragma unroll
            for (int r = 0; r < 16; ++r) sp[crow(r, hi) * (SS / 2)] = (bf16_t)(cvt_pk_bf16(Sacc[r], 0.f) & 0xffffu);
        }
    }
    __syncthreads();
}

__device__ void moba_unit(const Params& P, int b, int h, int j, LAS unsigned char* lds) {
    const int tid = tid_opaque(), lane = tid & 63, wid = tid >> 6, r32 = lane & 31, hi = lane >> 5;
    bf16_t* Q = (bf16_t*)(P.ws + OFF_QA); const bf16_t* Kg = (const bf16_t*)(P.ws + OFF_KA); const bf16_t* Vg = (const bf16_t*)(P.ws + OFF_VA);
    const float* kmean = (const float*)(P.ws + OFF_KMEAN);
    constexpr int KIMG = 64 * 144, VIMG = 64 * 192, LK = 0, LV = 4 * KIMG, LKM = 4 * KIMG + 4 * VIMG;
    LAS float* kmL = (LAS float*)(lds + LKM);
    const size_t rowb = (size_t)b * SEQ; const int q0 = j * 256;
    if (tid < j * 64) kmL[tid] = kmean[(size_t)(b * 8 + (tid >> 6)) * 512 + h * 64 + (tid & 63)];
    bf16_t* qrow = Q + (rowb + q0 + wid * 32 + r32) * 512 + h * 64;
    bf16x8 qf[4];
#pragma unroll
    for (int d0 = 0; d0 < 4; ++d0) qf[d0] = *(const bf16x8*)(qrow + 16 * d0 + 8 * hi);
    const int srow = tid >> 3, sch = tid & 7;
    const bf16_t* ksrc = Kg + (rowb + srow) * 512 + h * 64 + sch * 8; const bf16_t* vsrc = Vg + (rowb + srow) * 512 + h * 64 + sch * 8;
    const int ntile = 4 * (j + 1), npair = ntile >> 1;
    auto tile_key0 = [&](int i) -> size_t { const int blk = (i < 4) ? j : ((i - 4) >> 2), kt = (i < 4) ? i : ((i - 4) & 3); return (size_t)(blk * 256 + kt * 64); };
    u32x4 kreg[2], vreg[2];
#pragma unroll
    for (int s = 0; s < 2; ++s) { const size_t k0 = tile_key0(s); kreg[s] = *(const u32x4*)(ksrc + k0 * 512); vreg[s] = *(const u32x4*)(vsrc + k0 * 512); }
#pragma unroll
    for (int s = 0; s < 2; ++s) { *(LAS u32x4*)(lds + LK + s * KIMG + srow * 144 + sch * 16) = kreg[s]; *(LAS u32x4*)(lds + LV + s * VIMG + srow * 192 + sch * 16) = vreg[s]; }
    __syncthreads();
    unsigned sel = 0;
    if (j <= 3) sel = (1u << j) - 1u;
    else {
        float g[7];
#pragma unroll
        for (int n = 0; n < 7; ++n) { float s = 0.f;
            if (n < j) {
#pragma unroll
                for (int d0 = 0; d0 < 4; ++d0)
#pragma unroll
                    for (int e = 0; e < 8; ++e) s += __uint_as_float(((unsigned)(unsigned short)qf[d0][e]) << 16) * kmL[n * 64 + 16 * d0 + 8 * hi + e];
            }
            s += __shfl_xor(s, 32); g[n] = s; }
#pragma unroll
        for (int it = 0; it < 3; ++it) { float best = -INFINITY; int bi = 0;
#pragma unroll
            for (int n = 0; n < 7; ++n) if (n < j && !((sel >> n) & 1u) && g[n] > best) { best = g[n]; bi = n; }
            sel |= 1u << bi; }
    }
    const float ch = exp2f(-(float)(h + 1)) * LOG2E;
    const int qb = wid * 32 + r32;
    float m_run = -1e30f, l_run = 0.f;
    f32x16 o0 = {}, o1 = {};
    const int tg = lane >> 4, tc = tg & 1, ti = lane & 15;
    const int vlane = (4 * hi + (ti >> 2)) * 192 + (16 * tc + 4 * (ti & 3)) * 2;
#pragma unroll 1
    for (int ip = 0; ip < npair; ++ip) {
      const int pbuf = ip & 1;
      if (ip + 1 < npair) {
#pragma unroll
          for (int s = 0; s < 2; ++s) { const size_t k1 = tile_key0(2 * ip + 2 + s); kreg[s] = *(const u32x4*)(ksrc + k1 * 512); vreg[s] = *(const u32x4*)(vsrc + k1 * 512); }
      }
#pragma unroll
      for (int s2 = 0; s2 < 2; ++s2) {
        const int i = 2 * ip + s2, buf = pbuf * 2 + s2;
        const bool own = i < 4; const int blk = own ? j : ((i - 4) >> 2), kt = own ? i : ((i - 4) & 3);
        const bool lane_ok = own ? true : (((sel >> blk) & 1u) != 0u);
        const bool skip = own ? (64 * kt > 32 * wid + 31) : (__ballot(lane_ok) == 0ull);
        if (!skip) {
            LAS unsigned char* kb = lds + LK + buf * KIMG; LAS unsigned char* vb = lds + LV + buf * VIMG;
            f32x16 p0 = {}, p1 = {};
#pragma unroll
            for (int d0 = 0; d0 < 4; ++d0) {
                const bf16x8 kf0 = *(const LAS bf16x8*)(kb + r32 * 144 + (16 * d0 + 8 * hi) * 2);
                const bf16x8 kf1 = *(const LAS bf16x8*)(kb + (32 + r32) * 144 + (16 * d0 + 8 * hi) * 2);
                p0 = MFMA32(kf0, qf[d0], p0); p1 = MFMA32(kf1, qf[d0], p1);
            }
            const float kbase = ch * (float)((blk - j) * 256 + kt * 64);
            float mt = -1e30f;
#pragma unroll
            for (int r = 0; r < 16; ++r) {
                const int kl0 = crow(r, hi), kl1 = kl0 + 32;
                p0[r] = __builtin_fmaf(ch, (float)kl0, p0[r]); p1[r] = __builtin_fmaf(ch, (float)kl1, p1[r]);
                if (own) { if (kt * 64 + kl0 > qb) p0[r] = -1e30f; if (kt * 64 + kl1 > qb) p1[r] = -1e30f; }
                mt = fmaxf(mt, fmaxf(p0[r], p1[r]));
            }
            mt = lane_ok ? mt + kbase : -1e30f;
            mt = fmaxf(mt, __shfl_xor(mt, 32));
            if (__ballot(mt > m_run) != 0ull) {
                const float mnew = fmaxf(m_run, mt), alpha = __builtin_amdgcn_exp2f(m_run - mnew);
                m_run = mnew; l_run *= alpha;
#pragma unroll
                for (int r = 0; r < 16; ++r) { o0[r] *= alpha; o1[r] *= alpha; }
            }
            const float sh = lane_ok ? kbase - m_run : -1e30f;
            float rs = 0.f;
#pragma unroll
            for (int r = 0; r < 16; ++r) { p0[r] = __builtin_amdgcn_exp2f(p0[r] + sh); p1[r] = __builtin_amdgcn_exp2f(p1[r] + sh); rs += p0[r] + p1[r]; }
            l_run += rs;
#pragma unroll
            for (int sub = 0; sub < 2; ++sub)
#pragma unroll
                for (int s = 0; s < 2; ++s) {
                    union { u32x4 u; bf16x8 v; } pb;
                    if (sub == 0) { pb.u.x = cvt_pk_bf16(p0[8 * s + 0], p0[8 * s + 1]); pb.u.y = cvt_pk_bf16(p0[8 * s + 2], p0[8 * s + 3]); pb.u.z = cvt_pk_bf16(p0[8 * s + 4], p0[8 * s + 5]); pb.u.w = cvt_pk_bf16(p0[8 * s + 6], p0[8 * s + 7]); }
                    else { pb.u.x = cvt_pk_bf16(p1[8 * s + 0], p1[8 * s + 1]); pb.u.y = cvt_pk_bf16(p1[8 * s + 2], p1[8 * s + 3]); pb.u.z = cvt_pk_bf16(p1[8 * s + 4], p1[8 * s + 5]); pb.u.w = cvt_pk_bf16(p1[8 * s + 6], p1[8 * s + 7]); }
#pragma unroll
                    for (int dt = 0; dt < 2; ++dt) {
                        LAS unsigned char* va = vb + (32 * sub + 16 * s) * 192 + dt * 64 + vlane;
                        const s16x4 lo = __builtin_bit_cast(s16x4, __builtin_amdgcn_ds_read_tr16_b64_v4i16((LAS s16x4*)va));
                        const s16x4 hh = __builtin_bit_cast(s16x4, __builtin_amdgcn_ds_read_tr16_b64_v4i16((LAS s16x4*)(va + 8 * 192)));
                        const bf16x8 vf = {lo[0], lo[1], lo[2], lo[3], hh[0], hh[1], hh[2], hh[3]};
                        if (dt == 0) o0 = MFMA32(vf, pb.v, o0); else o1 = MFMA32(vf, pb.v, o1);
                    }
                }
        }
      }
      if (ip + 1 < npair) { const int nb = (pbuf ^ 1) * 2;
#pragma unroll
          for (int s = 0; s < 2; ++s) { *(LAS u32x4*)(lds + LK + (nb + s) * KIMG + srow * 144 + sch * 16) = kreg[s]; *(LAS u32x4*)(lds + LV + (nb + s) * VIMG + srow * 192 + sch * 16) = vreg[s]; } }
      __syncthreads();
    }
    l_run += __shfl_xor(l_run, 32);
    const float inv = 1.0f / l_run;
#pragma unroll
    for (int r4 = 0; r4 < 4; ++r4) {
        int w0 = __builtin_amdgcn_cvt_pk_fp8_f32(o0[4 * r4] * inv, o0[4 * r4 + 1] * inv, 0, false); w0 = __builtin_amdgcn_cvt_pk_fp8_f32(o0[4 * r4 + 2] * inv, o0[4 * r4 + 3] * inv, w0, true);
        int w1 = __builtin_amdgcn_cvt_pk_fp8_f32(o1[4 * r4] * inv, o1[4 * r4 + 1] * inv, 0, false); w1 = __builtin_amdgcn_cvt_pk_fp8_f32(o1[4 * r4 + 2] * inv, o1[4 * r4 + 3] * inv, w1, true);
        unsigned char* yrow = P.ws + OFF_EG + (rowb + q0 + wid * 32 + r32) * 1024 + h * 64;
        *(int*)(yrow + 8 * r4 + 4 * hi) = w0; *(int*)(yrow + 32 + 8 * r4 + 4 * hi) = w1;
    }
}

__device__ void yb_norm_panel(const Params& P, int pm) {
    const int tid = tid_opaque(), lane = tid & 63, wid = tid >> 6;
    bf16_t* HI = (bf16_t*)(P.ws + OFF_HI); const bf16_t* HG = (const bf16_t*)(P.ws + OFF_HG);
    for (int r = 0; r < 32; ++r) {
        const size_t off = ((size_t)pm * 256 + wid * 32 + r) * 512 + lane * 8;
        const u32x4 ov = *(const u32x4*)(HI + off), gv = *(const u32x4*)(HG + off);
        float o[8] = {bf_lo(ov.x), bf_hi(ov.x), bf_lo(ov.y), bf_hi(ov.y), bf_lo(ov.z), bf_hi(ov.z), bf_lo(ov.w), bf_hi(ov.w)};
        const float g[8] = {bf_lo(gv.x), bf_hi(gv.x), bf_lo(gv.y), bf_hi(gv.y), bf_lo(gv.z), bf_hi(gv.z), bf_lo(gv.w), bf_hi(gv.w)};
        float ss = 0.f;
#pragma unroll
        for (int e = 0; e < 8; ++e) ss += o[e] * o[e];
        ss += __shfl_xor(ss, 1); ss += __shfl_xor(ss, 2); ss += __shfl_xor(ss, 4); ss += __shfl_xor(ss, 8);
        const float rs = rsqrtf(ss * (1.0f / 128.0f) + RMS_EPS);
        int w0 = __builtin_amdgcn_cvt_pk_fp8_f32(o[0] * rs * g[0], o[1] * rs * g[1], 0, false); w0 = __builtin_amdgcn_cvt_pk_fp8_f32(o[2] * rs * g[2], o[3] * rs * g[3], w0, true);
        int w1 = __builtin_amdgcn_cvt_pk_fp8_f32(o[4] * rs * g[4], o[5] * rs * g[5], 0, false); w1 = __builtin_amdgcn_cvt_pk_fp8_f32(o[6] * rs * g[6], o[7] * rs * g[7], w1, true);
        *(u32x2*)(P.ws + OFF_EG + ((size_t)pm * 256 + wid * 32 + r) * 1024 + 512 + lane * 8) = (u32x2){(unsigned)w0, (unsigned)w1};
    }
}
__device__ void ln1_panel(const Params& P, int pm) {
    const int tid = tid_opaque(), lane = tid & 63, wid = tid >> 6;
    const float* ada = (const float*)(P.ws + OFF_ADA) + (size_t)(pm >> 3) * 6144; bf16_t* H = (bf16_t*)(P.ws + OFF_H);
    for (int r = 0; r < 32; ++r) {
        const size_t row = (size_t)pm * 256 + wid * 32 + r;
        float* xr = P.out + row * 1024 + lane * 4; const float* xin = P.x + row * 1024 + lane * 4; const bf16_t* dl = (const bf16_t*)(P.ws + OFF_GB) + row * 1024 + lane * 4;
        f32x4 v[4]; float s = 0.f;
#pragma unroll
        for (int jx = 0; jx < 4; ++jx) { const u32x2 dv = *(const u32x2*)(dl + 256 * jx); const f32x4 xv = __builtin_nontemporal_load((const f32x4*)(xin + 256 * jx));
            v[jx] = xv * ALPHA + (f32x4){bf_lo(dv.x), bf_hi(dv.x), bf_lo(dv.y), bf_hi(dv.y)}; s += (v[jx][0] + v[jx][1]) + (v[jx][2] + v[jx][3]); }
        const float mean = wave_sum(s) * (1.0f / 1024.0f); float s2 = 0.f;
#pragma unroll
        for (int jx = 0; jx < 4; ++jx) { v[jx] = v[jx] - mean; s2 += (v[jx][0] * v[jx][0] + v[jx][1] * v[jx][1]) + (v[jx][2] * v[jx][2] + v[jx][3] * v[jx][3]); }
        const float rstd = rsqrtf(wave_sum(s2) * (1.0f / 1024.0f) + LN_EPS);
#pragma unroll
        for (int jx = 0; jx < 4; ++jx) {
            const int c = lane * 4 + 256 * jx;
            const f32x4 g = *(const f32x4*)(P.ln1_g + c), bb = *(const f32x4*)(P.ln1_b + c), sh = *(const f32x4*)(ada + 3072 + c), sc = *(const f32x4*)(ada + 4096 + c);
            const f32x4 x1 = v[jx] * rstd * g + bb;
            *(f32x4*)(xr + 256 * jx) = x1;
            const f32x4 h2 = x1 * (sc + 1.0f) + sh;
            u32x2 w; w.x = cvt_pk_bf16(h2[0], h2[1]); w.y = cvt_pk_bf16(h2[2], h2[3]);
            *(u32x2*)(H + row * 1024 + c) = w;
            v[jx] = h2;
        }
        {
            float mx = 0.f;
#pragma unroll
            for (int jx = 0; jx < 4; ++jx) mx = fmaxf(mx, fmaxf(fmaxf(fabsf(v[jx][0]), fabsf(v[jx][1])), fmaxf(fabsf(v[jx][2]), fabsf(v[jx][3]))));
#pragma unroll
            for (int o = 1; o < 64; o <<= 1) mx = fmaxf(mx, __shfl_xor(mx, o));
            const float hs = fmaxf(mx * (1.0f / 127.0f), 1e-30f), inv = 1.0f / hs; int qs = 0;
#pragma unroll
            for (int jx = 0; jx < 4; ++jx) {
                const int q0 = (int)rintf(v[jx][0] * inv), q1 = (int)rintf(v[jx][1] * inv), q2 = (int)rintf(v[jx][2] * inv), q3 = (int)rintf(v[jx][3] * inv);
                qs += (q0 + q1) + (q2 + q3);
                *(unsigned*)(P.ws + OFF_H8 + row * 1024 + lane * 4 + 256 * jx) = (unsigned)(q0 & 255) | ((unsigned)(q1 & 255) << 8) | ((unsigned)(q2 & 255) << 16) | ((unsigned)(q3 & 255) << 24);
            }
#pragma unroll
            for (int o = 1; o < 64; o <<= 1) qs += __shfl_xor(qs, o);
            if (lane == 0) *(f32x2*)(P.ws + OFF_HS + row * 8) = (f32x2){hs, (float)qs};
        }
    }
}

#define CE16(A, i, j) do { const float hi_ = fmaxf(A[i], A[j]); A[j] = fminf(A[i], A[j]); A[i] = hi_; } while (0)
#define SORT16(A) do { CE16(A, 0, 1); CE16(A, 2, 3); CE16(A, 0, 2); CE16(A, 1, 3); CE16(A, 1, 2); CE16(A, 4, 5); CE16(A, 6, 7); CE16(A, 4, 6); CE16(A, 5, 7); CE16(A, 5, 6); CE16(A, 0, 4); CE16(A, 2, 6); CE16(A, 2, 4); CE16(A, 1, 5); CE16(A, 3, 7); CE16(A, 3, 5); CE16(A, 1, 2); CE16(A, 3, 4); CE16(A, 5, 6); CE16(A, 8, 9); CE16(A, 10, 11); CE16(A, 8, 10); CE16(A, 9, 11); CE16(A, 9, 10); CE16(A, 12, 13); CE16(A, 14, 15); CE16(A, 12, 14); CE16(A, 13, 15); CE16(A, 13, 14); CE16(A, 8, 12); CE16(A, 10, 14); CE16(A, 10, 12); CE16(A, 9, 13); CE16(A, 11, 15); CE16(A, 11, 13); CE16(A, 9, 10); CE16(A, 11, 12); CE16(A, 13, 14); CE16(A, 0, 8); CE16(A, 4, 12); CE16(A, 4, 8); CE16(A, 2, 10); CE16(A, 6, 14); CE16(A, 6, 10); CE16(A, 2, 4); CE16(A, 6, 8); CE16(A, 10, 12); CE16(A, 1, 9); CE16(A, 5, 13); CE16(A, 5, 9); CE16(A, 3, 11); CE16(A, 7, 15); CE16(A, 7, 11); CE16(A, 3, 5); CE16(A, 7, 9); CE16(A, 11, 13); CE16(A, 1, 2); CE16(A, 3, 4); CE16(A, 5, 6); CE16(A, 7, 8); CE16(A, 9, 10); CE16(A, 11, 12); CE16(A, 13, 14); } while (0)
#define BITONIC16(A) do { CE16(A, 0, 8); CE16(A, 1, 9); CE16(A, 2, 10); CE16(A, 3, 11); CE16(A, 4, 12); CE16(A, 5, 13); CE16(A, 6, 14); CE16(A, 7, 15); CE16(A, 0, 4); CE16(A, 1, 5); CE16(A, 2, 6); CE16(A, 3, 7); CE16(A, 8, 12); CE16(A, 9, 13); CE16(A, 10, 14); CE16(A, 11, 15); CE16(A, 0, 2); CE16(A, 1, 3); CE16(A, 4, 6); CE16(A, 5, 7); CE16(A, 8, 10); CE16(A, 9, 11); CE16(A, 12, 14); CE16(A, 13, 15); CE16(A, 0, 1); CE16(A, 2, 3); CE16(A, 4, 5); CE16(A, 6, 7); CE16(A, 8, 9); CE16(A, 10, 11); CE16(A, 12, 13); CE16(A, 14, 15); } while (0)
#define INS16(L, xin) do { float x_ = (xin); _Pragma("unroll") for (int k_ = 0; k_ < 16; ++k_) { const float hi_ = fmaxf(L[k_], x_); x_ = fminf(L[k_], x_); L[k_] = hi_; } } while (0)

__device__ void peer_select_wave(const Params& P, size_t tok0) {
    const int lane = tid_opaque() & 63, r32 = lane & 31, hi = lane >> 5;
    const bf16_t* QP = (const bf16_t*)(P.ws + OFF_GB) + (tok0 + r32) * 1024; const bf16_t* SK = (const bf16_t*)(P.ws + OFF_SK);
    u32x2* EG = (u32x2*)(P.ws + OFF_EG) + (tok0 + r32) * 128;
#pragma unroll 1
    for (int h = 0; h < 8; ++h) {
        float a0[16], a1[16];
#pragma unroll
        for (int k = 0; k < 16; ++k) { a0[k] = -INFINITY; a1[k] = -INFINITY; }
#pragma unroll
        for (int p = 0; p < 2; ++p) {
            const int hp = h * 2 + p;
            bf16x8 qf[4];
#pragma unroll
            for (int ks = 0; ks < 4; ++ks) qf[ks] = *(const bf16x8*)(QP + hp * 64 + 16 * ks + 8 * hi);
            float L[16];
#pragma unroll
            for (int kt = 0; kt < 4; ++kt) {
                f32x16 acc = {};
#pragma unroll
                for (int ks = 0; ks < 4; ++ks) { const bf16x8 kf = *(const bf16x8*)(SK + ((size_t)hp * 128 + 32 * kt + r32) * 64 + 16 * ks + 8 * hi); acc = MFMA32(kf, qf[ks], acc); }
                float S[16];
#pragma unroll
                for (int r = 0; r < 16; ++r) { const unsigned key = (unsigned)(32 * kt + crow(r, hi)); S[r] = __uint_as_float((__float_as_uint(acc[r]) & ~127u) | key); }
                SORT16(S);
                if (kt == 0) {
#pragma unroll
                    for (int k = 0; k < 16; ++k) L[k] = S[k];
                } else {
#pragma unroll
                    for (int k = 0; k < 16; ++k) L[k] = fmaxf(L[k], S[15 - k]);
                    BITONIC16(L);
                }
            }
            {
                float O[16];
#pragma unroll
                for (int k = 0; k < 16; ++k) O[k] = __shfl_xor(L[15 - k], 32);
#pragma unroll
                for (int k = 0; k < 16; ++k) L[k] = fmaxf(L[k], O[k]);
                BITONIC16(L);
            }
#pragma unroll
            for (int k = 0; k < 16; ++k) { a0[k] = (p == 0) ? L[k] : a0[k]; a1[k] = (p == 1) ? L[k] : a1[k]; }
        }
        float best[16];
#pragma unroll
        for (int k = 0; k < 16; ++k) best[k] = __uint_as_float((__float_as_uint(a0[0] + a1[k]) & ~255u) | (unsigned)k);
#pragma unroll
        for (int i = 1; i < 16; ++i)
#pragma unroll
            for (int jx = 0; jx < 16; ++jx)
                if ((i + 1) * (jx + 1) <= 16) {
                    const float cs = a0[i] + a1[jx];
                    const float cv = __uint_as_float((__float_as_uint(cs) & ~255u) | (unsigned)(i * 16 + jx));
                    INS16(best, cv);
                }
        unsigned pk0[4], pk1[4];
#pragma unroll
        for (int q = 0; q < 4; ++q) {
            pk0[q] = (__float_as_uint(a0[4 * q]) & 127u) | ((__float_as_uint(a0[4 * q + 1]) & 127u) << 8) | ((__float_as_uint(a0[4 * q + 2]) & 127u) << 16) | ((__float_as_uint(a0[4 * q + 3]) & 127u) << 24);
            pk1[q] = (__float_as_uint(a1[4 * q]) & 127u) | ((__float_as_uint(a1[4 * q + 1]) & 127u) << 8) | ((__float_as_uint(a1[4 * q + 2]) & 127u) << 16) | ((__float_as_uint(a1[4 * q + 3]) & 127u) << 24);
        }
        unsigned pay[16];
#pragma unroll
        for (int k = 0; k < 16; ++k) {
            const unsigned code = __float_as_uint(best[k]) & 255u, ci = code >> 4, cj = code & 15u;
            const unsigned qi = ci >> 2, qj = cj >> 2;
            const unsigned w0 = (qi == 0u) ? pk0[0] : ((qi == 1u) ? pk0[1] : ((qi == 2u) ? pk0[2] : pk0[3]));
            const unsigned w1 = (qj == 0u) ? pk1[0] : ((qj == 1u) ? pk1[1] : ((qj == 2u) ? pk1[2] : pk1[3]));
            pay[k] = (((w0 >> ((ci & 3u) * 8u)) & 127u) << 7) | ((w1 >> ((cj & 3u) * 8u)) & 127u);
        }
        float e[16], es = 0.f;
#pragma unroll
        for (int k = 0; k < 16; ++k) { e[k] = __expf(best[k] - best[0]); es += e[k]; }
        const float inv = 1.0f / es;
        if (hi == 0) {
#pragma unroll
            for (int k = 0; k < 16; ++k) { u32x2 w; w.x = pay[k]; w.y = __float_as_uint(e[k] * inv); EG[h * 16 + k] = w; }
        }
    }
}
__device__ __forceinline__ unsigned xcc_id() { return (unsigned)__builtin_amdgcn_s_getreg((3 << 11) | 20) & 0xFu; }
template <int CTRL> __device__ __forceinline__ float dpp_add(float x) { const int v = __builtin_amdgcn_update_dpp(0, __float_as_int(x), CTRL, 0xf, 0xf, true); return x + __int_as_float(v); }
__device__ __forceinline__ float wave_sum_fast(float x) {
    x = dpp_add<0xB1>(x); x = dpp_add<0x4E>(x); x = dpp_add<0x141>(x); x = dpp_add<0x140>(x);
    x += __shfl_xor(x, 16); x += __shfl_xor(x, 32); return x;
}
__device__ __forceinline__ float dot16_fp8(const float (&hv)[16], const u32x4 r) {
    float s = 0.f;
    { const f32x2 a = __builtin_amdgcn_cvt_pk_f32_fp8((int)r.x, false), b = __builtin_amdgcn_cvt_pk_f32_fp8((int)r.x, true); s += hv[0] * a.x + hv[1] * a.y + hv[2] * b.x + hv[3] * b.y; }
    { const f32x2 a = __builtin_amdgcn_cvt_pk_f32_fp8((int)r.y, false), b = __builtin_amdgcn_cvt_pk_f32_fp8((int)r.y, true); s += hv[4] * a.x + hv[5] * a.y + hv[6] * b.x + hv[7] * b.y; }
    { const f32x2 a = __builtin_amdgcn_cvt_pk_f32_fp8((int)r.z, false), b = __builtin_amdgcn_cvt_pk_f32_fp8((int)r.z, true); s += hv[8] * a.x + hv[9] * a.y + hv[10] * b.x + hv[11] * b.y; }
    { const f32x2 a = __builtin_amdgcn_cvt_pk_f32_fp8((int)r.w, false), b = __builtin_amdgcn_cvt_pk_f32_fp8((int)r.w, true); s += hv[12] * a.x + hv[13] * a.y + hv[14] * b.x + hv[15] * b.y; }
    return s;
}
template <int NP, class F> __device__ __forceinline__ void partition_queue(const Params& P, LAS unsigned char* lds, int ctr_base, F f) {
    const int tid = tid_opaque();
    LAS int* slot = (LAS int*)(lds + LDS_BYTES - 64);
    unsigned* ctr = (unsigned*)(P.ws + OFF_CTR) + ctr_base;
    const int myx = (int)(xcc_id() & 7u);
    for (int pp = 0; pp < NP; ++pp) {
        const int p = (myx * (NP / 8) + pp) % NP;
        for (;;) {
            if (tid == 0) *slot = (int)atomicAdd(ctr + p, 1u);
            __syncthreads();
            const int item = *slot;
            __syncthreads();
            if (item >= NTOK / 64) break;
            f(p, item);
        }
    }
}
__device__ __forceinline__ float dot2bf(unsigned a, bf16v2 b, float c) { return __builtin_amdgcn_fdot2_f32_bf16(__builtin_bit_cast(bf16v2, a), b, c, false); }
__device__ __forceinline__ float gelu_erf(float v) {
    const float av = fabsf(v), t = __builtin_amdgcn_rcpf(__builtin_fmaf(av, 0.2316418882f, 1.0f));
    float q = __builtin_fmaf(t, 0.5307027145f, -0.7265760135f); q = __builtin_fmaf(q, t, 0.7107068705f); q = __builtin_fmaf(q, t, -0.142248368f); q = __builtin_fmaf(q, t, 0.127414796f); q = q * t;
    const float m = v * (q * __builtin_amdgcn_exp2f(v * v * -0.72134752044f));
    return v < 0.f ? m : v - m;
}
struct UQuad { u32x4 r[2]; u32x4 ent; };
__device__ __forceinline__ void uq_issue(UQuad& q, const LAS u32x4* list, int J, int NQ, int g, const unsigned char* U4) {
    const int jj = J < NQ ? J : NQ - 1;
    q.ent = list[4 * jj + g];
    const unsigned char* rp = U4 + (size_t)q.ent.x * 512;
    q.r[0] = *(const u32x4*)rp; q.r[1] = *(const u32x4*)(rp + 256);
}
__device__ __forceinline__ int dot8_i4(unsigned w, unsigned hlo, unsigned hhi, int acc) {
    acc = __builtin_amdgcn_sdot4((int)hlo, (int)(w & 0x0F0F0F0Fu), acc, false);
    return __builtin_amdgcn_sdot4((int)hhi, (int)((w >> 4) & 0x0F0F0F0Fu), acc, false);
}
__device__ __forceinline__ float uq_dot(const UQuad& q, const u32x4 (&hp)[4]) {
    int a = 0, b = 0;
#pragma unroll
    for (int c = 0; c < 2; ++c) {
        const u32x4 r = q.r[c];
        a = dot8_i4(r.x, hp[2 * c].x, hp[2 * c].y, a); b = dot8_i4(r.y, hp[2 * c].z, hp[2 * c].w, b);
        a = dot8_i4(r.z, hp[2 * c + 1].x, hp[2 * c + 1].y, a); b = dot8_i4(r.w, hp[2 * c + 1].z, hp[2 * c + 1].w, b);
    }
    float s = (float)(a + b);
    s = dpp_add<0xB1>(s); s = dpp_add<0x4E>(s); s = dpp_add<0x141>(s); s = dpp_add<0x140>(s);
    return s;
}
__device__ __forceinline__ void peer_u_tokens(const Params& P, LAS unsigned char* lds, const size_t t0) {
    const int tid = tid_opaque(), lane = tid & 63, wid = tid >> 6, g = lane >> 4, li = lane & 15;
    const unsigned char* H8 = P.ws + OFF_H8 + li * 32; const unsigned char* U4 = P.ws + OFF_U8 + li * 16;
    const f32x2* HS = (const f32x2*)(P.ws + OFF_HS); const float* USC = (const float*)(P.ws + OFF_USC);
    const u32x4* EG4 = (const u32x4*)(P.ws + OFF_EG); float* W = (float*)(P.ws + OFF_W);
    LAS u32x4* list = (LAS u32x4*)(lds + wid * 16384);
#pragma unroll 2
    for (int i = 0; i < 8; ++i) {
        const u32x4 eg = EG4[(t0 + i) * 64 + lane];
        list[i * 128 + 2 * lane] = (u32x4){eg.x, eg.y, (unsigned)(2 * lane) | (unsigned)(i << 8), __float_as_uint(USC[eg.x])};
        list[i * 128 + 2 * lane + 1] = (u32x4){eg.z, eg.w, (unsigned)(2 * lane + 1) | (unsigned)(i << 8), __float_as_uint(USC[eg.z])};
    }
    constexpr int NQ = 256;
    u32x4 hp[4], hn[4]; f32x2 hsc = HS[t0], hsn = HS[t0 + 1];
#pragma unroll
    for (int c = 0; c < 2; ++c) { hp[2 * c] = *(const u32x4*)(H8 + t0 * 1024 + 512 * c); hp[2 * c + 1] = *(const u32x4*)(H8 + t0 * 1024 + 512 * c + 16);
                                  hn[2 * c] = *(const u32x4*)(H8 + (t0 + 1) * 1024 + 512 * c); hn[2 * c + 1] = *(const u32x4*)(H8 + (t0 + 1) * 1024 + 512 * c + 16); }
    int curtok = 0;
    UQuad q0, q1, q2, q3;
    uq_issue(q0, list, 0, NQ, g, U4); uq_issue(q1, list, 1, NQ, g, U4); uq_issue(q2, list, 2, NQ, g, U4); uq_issue(q3, list, 3, NQ, g, U4);
#define UQ_STEP(q, Jn) do { \
        const int tk = __builtin_amdgcn_readfirstlane((int)(q.ent.z >> 8)); \
        if (tk != curtok) { curtok = tk; _Pragma("unroll") for (int c = 0; c < 4; ++c) hp[c] = hn[c]; hsc = hsn; \
            if (tk + 1 < 8) { hsn = HS[t0 + tk + 1]; _Pragma("unroll") for (int c = 0; c < 2; ++c) { hn[2 * c] = *(const u32x4*)(H8 + (t0 + tk + 1) * 1024 + 512 * c); hn[2 * c + 1] = *(const u32x4*)(H8 + (t0 + tk + 1) * 1024 + 512 * c + 16); } } } \
        const float s = __uint_as_float(q.ent.w) * hsc.x * (uq_dot(q, hp) - 7.5f * hsc.y); \
        if (li == 0) W[(t0 + tk) * 128 + (q.ent.z & 255u)] = __uint_as_float(q.ent.y) * gelu_erf(s); \
        uq_issue(q, list, (Jn), NQ, g, U4); } while (0)
#pragma unroll 1
    for (int J = 0; J < NQ; J += 4) { UQ_STEP(q0, J + 4); UQ_STEP(q1, J + 5); UQ_STEP(q2, J + 6); UQ_STEP(q3, J + 7); }
#undef UQ_STEP
}
typedef int v4i_t __attribute__((ext_vector_type(4)));
struct VQuad { u32x4 r[2]; u32x2 ent; };
__device__ __forceinline__ void vq_issue(VQuad& q, const LAS u32x2* list, int J, int g, const unsigned char* V4) {
    const int jj = J < 32 ? J : 31;
    q.ent = list[4 * jj + g];
    const unsigned char* rp = V4 + (size_t)q.ent.x * 512;
    q.r[0] = *(const u32x4*)rp; q.r[1] = *(const u32x4*)(rp + 256);
}
__device__ __forceinline__ void vq_mma(const VQuad& q, v4i_t (&acc)[4], const unsigned sh, const u32x4 bm, const bool live) {
    const unsigned t = live ? ((q.ent.y & 255u) << sh) : 0u;
    const v4i_t B = {(int)(t & bm.x), (int)(t & bm.y), (int)(t & bm.z), (int)(t & bm.w)};
#pragma unroll
    for (int c = 0; c < 2; ++c) {
        const u32x4 r = q.r[c];
        const v4i_t lo = {(int)(r.x & 0x0F0F0F0Fu), (int)(r.y & 0x0F0F0F0Fu), (int)(r.z & 0x0F0F0F0Fu), (int)(r.w & 0x0F0F0F0Fu)};
        const v4i_t hi = {(int)((r.x >> 4) & 0x0F0F0F0Fu), (int)((r.y >> 4) & 0x0F0F0F0Fu), (int)((r.z >> 4) & 0x0F0F0F0Fu), (int)((r.w >> 4) & 0x0F0F0F0Fu)};
        acc[2 * c] = __builtin_amdgcn_mfma_i32_16x16x64_i8(lo, B, acc[2 * c], 0, 0, 0);
        acc[2 * c + 1] = __builtin_amdgcn_mfma_i32_16x16x64_i8(hi, B, acc[2 * c + 1], 0, 0, 0);
    }
}
__device__ __forceinline__ void peer_v_tokens(const Params& P, LAS unsigned char* lds, const size_t t0) {
    const int tid = tid_opaque(), lane = tid & 63, wid = tid >> 6, g = lane >> 4, li = lane & 15;
    const unsigned char* V4 = P.ws + OFF_V8 + li * 16; const float* VSC = (const float*)(P.ws + OFF_VSC);
    const u32x4* EG4 = (const u32x4*)(P.ws + OFF_EG); const f32x2* W2 = (const f32x2*)(P.ws + OFF_W);
    LAS u32x2* lists = (LAS u32x2*)(lds + wid * 8192);
    float swv[8], yoffv[8];
#pragma unroll
    for (int i = 0; i < 8; ++i) { const u32x4 eg = EG4[(t0 + i) * 64 + lane]; const f32x2 ww = W2[(t0 + i) * 64 + lane];
        const float w0 = ww.x * VSC[eg.x], w1 = ww.y * VSC[eg.z];
        float mx = fmaxf(fabsf(w0), fabsf(w1));
#pragma unroll
        for (int o = 1; o < 64; o <<= 1) mx = fmaxf(mx, __shfl_xor(mx, o));
        const float sw = fmaxf(mx * (1.0f / 127.0f), 1e-30f), inv = 1.0f / sw;
        const int q0 = (int)rintf(w0 * inv), q1 = (int)rintf(w1 * inv);
        *(LAS u32x4*)(lists + i * 128 + 2 * lane) = (u32x4){eg.x, (unsigned)q0, eg.z, (unsigned)q1};
        int qs = q0 + q1;
#pragma unroll
        for (int o = 1; o < 64; o <<= 1) qs += __shfl_xor(qs, o);
        swv[i] = sw; yoffv[i] = 7.5f * sw * (float)qs; }
    const unsigned sh = 8u * (unsigned)(li & 3);
    const u32x4 bm = {(li >> 2) == 0 ? 0xFFFFFFFFu : 0u, (li >> 2) == 1 ? 0xFFFFFFFFu : 0u, (li >> 2) == 2 ? 0xFFFFFFFFu : 0u, (li >> 2) == 3 ? 0xFFFFFFFFu : 0u};
#pragma unroll
    for (int i = 0; i < 8; ++i) {
        const size_t t = t0 + i;
        const LAS u32x2* list = lists + i * 128;
        v4i_t acc[4];
#pragma unroll
        for (int j = 0; j < 4; ++j) acc[j] = (v4i_t){0, 0, 0, 0};
        VQuad q0, q1, q2, q3;
        vq_issue(q0, list, 0, g, V4); vq_issue(q1, list, 1, g, V4); vq_issue(q2, list, 2, g, V4); vq_issue(q3, list, 3, g, V4);
#pragma unroll 1
        for (int J = 0; J < 32; J += 4) {
            vq_mma(q0, acc, sh, bm, true); vq_issue(q0, list, J + 4, g, V4);
            vq_mma(q1, acc, sh, bm, true); vq_issue(q1, list, J + 5, g, V4);
            vq_mma(q2, acc, sh, bm, true); vq_issue(q2, list, J + 6, g, V4);
            vq_mma(q3, acc, sh, bm, true); vq_issue(q3, list, J + 7, g, V4);
        }
        const float sw = swv[i], yoff = yoffv[i];
        const int dbase = 128 * g + 8 * (li >> 2) + (li & 3);
        const float* gt2 = (const float*)(P.ws + OFF_ADA) + (t >> 11) * 6144 + 5120;
        float* xr = P.out + t * 1024;
        float pre[16]; float s = 0.f;
#pragma unroll
        for (int c = 0; c < 2; ++c)
#pragma unroll
            for (int hf = 0; hf < 2; ++hf)
#pragma unroll
                for (int r = 0; r < 4; ++r) { const int d = dbase + 512 * c + 32 * r + 4 * hf;
                    const float yv = sw * (float)acc[2 * c + hf][r] - yoff;
                    const float pv = ALPHA * xr[d] + gt2[d] * yv; pre[8 * c + 4 * hf + r] = pv; s += pv; }
        const float mean = wave_sum(s) * (1.0f / 1024.0f); float s2 = 0.f;
#pragma unroll
        for (int e = 0; e < 16; ++e) { pre[e] -= mean; s2 += pre[e] * pre[e]; }
        const float rstd = rsqrtf(wave_sum(s2) * (1.0f / 1024.0f) + LN_EPS);
#pragma unroll
        for (int c = 0; c < 2; ++c)
#pragma unroll
            for (int hf = 0; hf < 2; ++hf)
#pragma unroll
                for (int r = 0; r < 4; ++r) { const int d = dbase + 512 * c + 32 * r + 4 * hf;
                    xr[d] = pre[8 * c + 4 * hf + r] * rstd * P.ln2_g[d] + P.ln2_b[d]; }
    }
}

#define XB_TMO      128
#define XB_XCNT(j)  (256  + 64 * (j))
#define XB_XSUB(j)  (1280 + 64 * (j))
#define XB_XGEN(j)  (2304 + 64 * (j))
#define XB_TOP      3328
#define XB_TOPGEN   3392
#define XCD_BAR_WORDS 3456
#define XB_SPIN_CAP (1u << 22)
__device__ __forceinline__ unsigned xb_ld(unsigned* p)              { return __hip_atomic_load(p, __ATOMIC_RELAXED, __HIP_MEMORY_SCOPE_AGENT); }
__device__ __forceinline__ unsigned xb_add(unsigned* p, unsigned v) { return __hip_atomic_fetch_add(p, v, __ATOMIC_RELAXED, __HIP_MEMORY_SCOPE_AGENT); }
#define XB_SPIN(cond, bar) do { unsigned _sp = 0; while (cond) { __builtin_amdgcn_s_sleep(1); \
    if ((++_sp & 255u) == 0u) { if (xb_ld(&(bar)[XB_TMO])) break; if (_sp > XB_SPIN_CAP) { atomicAdd(&(bar)[XB_TMO], 1u); break; } } } } while (0)
struct XcdBarrier { unsigned* bar; unsigned x; volatile LAS unsigned* st; };
__device__ __forceinline__ XcdBarrier xcd_barrier_post(unsigned* bar, volatile LAS unsigned* st) {
    XcdBarrier b; b.bar = bar; b.x = xcc_id(); b.st = st;
    if (threadIdx.x == 0) (void)xb_add(&bar[XB_XCNT(b.x)], 1u);
    return b;
}
__device__ __forceinline__ void xcd_barrier_complete(unsigned* bar, unsigned x, unsigned& nloc, unsigned& nx) {
    const unsigned G = gridDim.x * gridDim.y * gridDim.z;
    unsigned sum, cnt, mine, sp = 0u;
    for (;;) {
        sum = 0u; cnt = 0u; mine = 0u;
#pragma unroll
        for (unsigned j = 0; j < 16; ++j) { const unsigned c = xb_ld(&bar[XB_XCNT(j)]); sum += c; cnt += (c > 0u) ? 1u : 0u; mine = (j == x) ? c : mine; }
        if (sum == G) break;
        __builtin_amdgcn_s_sleep(1);
        if ((++sp & 255u) == 0u) { if (xb_ld(&bar[XB_TMO])) break; if (sp > XB_SPIN_CAP) { atomicAdd(&bar[XB_TMO], 1u); break; } }
    }
    nloc = mine > 0u ? mine : 1u; nx = cnt > 0u ? cnt : 1u;
}
__device__ __forceinline__ void xcd_barrier(const XcdBarrier& b) {
    asm volatile("s_waitcnt vmcnt(0)" ::: "memory");
    __syncthreads();
    if (threadIdx.x == 0) {
        unsigned* bar = b.bar;
        __builtin_amdgcn_s_waitcnt(0);
        unsigned nloc = b.st[0], nx = b.st[1];
        if (nloc == 0u) { xcd_barrier_complete(bar, b.x, nloc, nx); b.st[0] = nloc; b.st[1] = nx; }
        const unsigned old = xb_add(&bar[XB_XSUB(b.x)], 1u);
        const unsigned gen = old / nloc;
        if (old + 1u == (gen + 1u) * nloc) {
            __builtin_amdgcn_fence(__ATOMIC_RELEASE, "agent");
            asm volatile("s_waitcnt vmcnt(0)" ::: "memory");
            const unsigned og = xb_add(&bar[XB_TOP], 1u);
            const unsigned tg = og / nx;
            if (og + 1u == (tg + 1u) * nx) xb_add(&bar[XB_TOPGEN], 1u);
            else XB_SPIN(xb_ld(&bar[XB_TOPGEN]) == tg, bar);
            __builtin_amdgcn_fence(__ATOMIC_ACQUIRE, "agent");
            xb_add(&bar[XB_XGEN(b.x)], 1u);
            asm volatile("s_waitcnt vmcnt(0)" ::: "memory");
        } else {
            XB_SPIN(xb_ld(&bar[XB_XGEN(b.x)]) == gen, bar);
            __builtin_amdgcn_fence(__ATOMIC_ACQUIRE, "agent");
            asm volatile("s_waitcnt vmcnt(0)" ::: "memory");
        }
    }
    __syncthreads();
}

__global__ void __launch_bounds__(NTHR, 2) fwd_megakernel(Params P) {
    extern __shared__ __attribute__((aligned(16))) unsigned char shm[];
    LAS unsigned char* lds = (LAS unsigned char*)shm;
    cg::grid_group grid = cg::this_grid();
    const int G = gridDim.x, bid = blockIdx.x;
    volatile LAS unsigned* xst = (volatile LAS unsigned*)(lds + LDS_BYTES - 128);
    if (threadIdx.x == 0) { xst[0] = 0u; xst[1] = 0u; }
    __syncthreads();
    const XcdBarrier xb = xcd_barrier_post((unsigned*)(P.ws + OFF_BAR), xst);

#ifndef P3
#define P3 0xff
#endif
#ifndef PH
#define PH 0xff
#endif
    if (PH & 1) phase0a(P, lds);
    grid.sync();
    if (PH & 2) phase0b(P);
    xcd_barrier(xb);
    if (PH & 4) {
        pg8::Gemm g; g.A = (const bf16_t*)(P.ws + OFF_H); g.Bt = (const bf16_t*)(P.ws + OFF_WIN); g.M = NTOK; g.N = INCOLS; { int k_ = 512; asm volatile("" : "+s"(k_)); g.K = k_; g.lda = k_; }
        pg8::StaticOrder S; S.init(NTOK, INCOLS, G, bid);
        EpiProj E; E.ws = P.ws; E.lb = (const float*)(P.ws + OFF_LB); E.ng = P.hgrn_ng; E.kmean = (float*)(P.ws + OFF_KMEAN);
        pg8::gemm_phase<EpiProj, pg8::StaticOrder, true>(lds, g, S, E);
    }
    xcd_barrier(xb);
    if (PH & 8) for (int it = bid; it < 256; it += G) hgrn_item(P, it, lds);
    if (PH & 16) for (int u = bid; u < 2048; u += G) { const int bh = u & 255, jj = u >> 8; moba_unit(P, bh >> 3, bh & 7, (jj + bh) & 7, lds); }
    xcd_barrier(xb);
    if ((PH & 32) && bid < NTOK / 256) { const int pm = bid;
        if (P3 & 1) yb_norm_panel(P, pm);
        __syncthreads();
        if (P3 & 2) { pg8::Gemm g; g.A = (const bf16_t*)(P.ws + OFF_EG); g.Bt = (const bf16_t*)(P.ws + OFF_WBA); g.M = NTOK; g.N = 1024; { int k_ = 256; asm volatile("" : "+s"(k_)); g.K = k_; } g.lda = 512;
          pg8::PanelOrder S; S.pm = pm; S.npn = 4; EpiMixA E; E.GA = (bf16_t*)(P.ws + OFF_GA);
          pg8::gemm_phase<EpiMixA, pg8::PanelOrder, true>(lds, g, S, E); }
        __syncthreads();
        if (P3 & 4) { pg8::Gemm g; g.A = (const bf16_t*)(P.ws + OFF_EG + 512); g.Bt = (const bf16_t*)(P.ws + OFF_WBB); g.M = NTOK; g.N = 1024; { int k_ = 256; asm volatile("" : "+s"(k_)); g.K = k_; } g.lda = 512;
          pg8::PanelOrder S; S.pm = pm; S.npn = 4; EpiMixB E; E.GA = (const bf16_t*)(P.ws + OFF_GA); E.GB = (const bf16_t*)(P.ws + OFF_GB); E.M8 = P.ws + OFF_QA;
          pg8::gemm_phase<EpiMixB, pg8::PanelOrder, true>(lds, g, S, E); }
        __syncthreads();
        if (P3 & 8) { pg8::Gemm g; g.A = (const bf16_t*)(P.ws + OFF_QA); g.Bt = (const bf16_t*)(P.ws + OFF_WOUT); g.M = NTOK; g.N = 1024; { int k_ = 512; asm volatile("" : "+s"(k_)); g.K = k_; g.lda = k_; }
          pg8::PanelOrder S; S.pm = pm; S.npn = 4; EpiOut E; E.ada = (const float*)(P.ws + OFF_ADA); E.D = (bf16_t*)(P.ws + OFF_GB);
          pg8::gemm_phase<EpiOut, pg8::PanelOrder, true>(lds, g, S, E); }
        __syncthreads();
        if (P3 & 16) ln1_panel(P, pm);
        __syncthreads();
        if (P3 & 32) { pg8::Gemm g; g.A = (const bf16_t*)(P.ws + OFF_H); g.Bt = (const bf16_t*)(P.ws + OFF_WQ); g.M = NTOK; g.N = 1024; g.K = 1024; g.lda = 1024;
          pg8::PanelOrder S; S.pm = pm; S.npn = 4; EpiBf16 E; E.O = (bf16_t*)(P.ws + OFF_GB);
          pg8::gemm_phase<EpiBf16, pg8::PanelOrder>(lds, g, S, E); }
        __syncthreads();
        { const size_t tok0 = (size_t)pm * 256 + (tid_opaque() >> 6) * 32;
          peer_select_wave(P, tok0);
          __syncthreads();
#pragma unroll 1
          for (int sb = 0; sb < 4; ++sb) {
              peer_u_tokens(P, lds, tok0 + 8 * sb);
              __syncthreads();
              peer_v_tokens(P, lds, tok0 + 8 * sb);
              __syncthreads();
          } }
    }
}

extern "C" void kernel_launch(void* const* d_in, const int* in_sizes, int n_in, void* d_out, int out_size, void* d_ws, size_t ws_size, hipStream_t stream) {
    static int grid_blocks = 0;
    if (grid_blocks == 0) {
        if (n_in != 18 || out_size != NTOK * DM || ws_size < WS_END) { fprintf(stderr, "kernel_launch: unexpected shapes (n_in %d, out %d, ws %zu, need %zu)\n", n_in, out_size, ws_size, (size_t)WS_END); grid_blocks = -1; return; }
        int dev = 0, cus = 0, per_cu = 0;
        hipGetDevice(&dev);
        hipDeviceGetAttribute(&cus, hipDeviceAttributeMultiprocessorCount, dev);
        if (hipFuncSetAttribute((const void*)fwd_megakernel, hipFuncAttributeMaxDynamicSharedMemorySize, LDS_BYTES) != hipSuccess) fprintf(stderr, "kernel_launch: hipFuncSetAttribute failed\n");
        hipOccupancyMaxActiveBlocksPerMultiprocessor(&per_cu, (const void*)fwd_megakernel, NTHR, LDS_BYTES);
        if (per_cu < 1) { fprintf(stderr, "kernel_launch: occupancy query says %d blocks per CU\n", per_cu); per_cu = 1; }
        if (per_cu > 1) per_cu = 1;
        grid_blocks = cus * per_cu;
        if (grid_blocks != NTOK / 256) { fprintf(stderr, "kernel_launch: built for a %d-CU device (one 256-token panel per workgroup), found %d\n", NTOK / 256, grid_blocks); grid_blocks = -1; return; }
        (void)hipGetLastError();
    }
    if (grid_blocks < 0) return;
    Params p{};
    p.x = (const float*)d_in[0]; p.c = (const float*)d_in[1]; p.w_ada = (const float*)d_in[2]; p.b_ada = (const float*)d_in[3]; p.w_in = (const float*)d_in[4];
    p.w_ba = (const float*)d_in[5]; p.w_bb = (const float*)d_in[6]; p.w_out = (const float*)d_in[7]; p.hgrn_lb = (const float*)d_in[8]; p.hgrn_ng = (const float*)d_in[9];
    p.ln1_g = (const float*)d_in[10]; p.ln1_b = (const float*)d_in[11]; p.peer_wq = (const float*)d_in[12]; p.peer_sk = (const float*)d_in[13]; p.peer_u = (const float*)d_in[14];
    p.peer_v = (const float*)d_in[15]; p.ln2_g = (const float*)d_in[16]; p.ln2_b = (const float*)d_in[17];
    p.out = (float*)d_out; p.ws = (unsigned char*)d_ws;
    if (hipMemsetAsync((char*)d_ws + OFF_BAR, 0, XCD_BAR_WORDS * 4, stream) != hipSuccess) fprintf(stderr, "kernel_launch: memset of the barrier words failed\n");
    void* args[] = {&p};
    hipError_t e = hipLaunchCooperativeKernel((const void*)fwd_megakernel, dim3(grid_blocks), dim3(NTHR), args, LDS_BYTES, stream);
    if (e != hipSuccess) fprintf(stderr, "cooperative launch failed: %s (grid %d)\n", hipGetErrorString(e), grid_blocks);
}
```

```cpp
#include <hip/hip_runtime.h>
#include <hip/hip_cooperative_groups.h>
#include <cstdio>
#include <cstdint>
#include <type_traits>
namespace cg = cooperative_groups;

#define LAS __attribute__((address_space(3)))
typedef unsigned short bf16_t;
typedef short bf16x8 __attribute__((ext_vector_type(8)));
typedef short s16x4 __attribute__((ext_vector_type(4)));
typedef float f32x2 __attribute__((ext_vector_type(2)));
typedef float f32x4 __attribute__((ext_vector_type(4)));
typedef float f32x16 __attribute__((ext_vector_type(16)));
typedef unsigned u32x2 __attribute__((ext_vector_type(2)));
typedef unsigned u32x4 __attribute__((ext_vector_type(4)));

constexpr int NB = 32, SEQ = 2048, DM = 1024, NTOK = NB * SEQ;
constexpr int INCOLS = 5632;
constexpr int NTHR = 512;
constexpr int LDS_BYTES = 147456;
constexpr float ALPHA = 1.189207115002721f;
constexpr float LN_EPS = 1e-5f, RMS_EPS = 1e-6f;
constexpr float LOG2E = 1.4426950408889634f;

constexpr size_t SZ_T512 = (size_t)NTOK * 512 * 2, SZ_T1024 = (size_t)NTOK * 1024 * 2;
constexpr size_t OFF_ADA = 0;
constexpr size_t OFF_LB = OFF_ADA + 786432;
constexpr size_t OFF_KMEAN = OFF_LB + 4096;
constexpr size_t OFF_WIN = OFF_KMEAN + 524288;
constexpr size_t OFF_WBA = OFF_WIN + (size_t)5632 * 1024 * 2;
constexpr size_t OFF_WBB = OFF_WBA + 1048576;
constexpr size_t OFF_WOUT = OFF_WBB + 1048576;
constexpr size_t OFF_WQ = OFF_WOUT + 2097152;
constexpr size_t OFF_SK = OFF_WQ + 2097152;
constexpr size_t OFF_U8 = OFF_SK + 262144;
constexpr size_t OFF_USC = OFF_U8 + 8388608;
constexpr size_t OFF_V8 = OFF_U8 + 16777216;
constexpr size_t OFF_VSC = OFF_V8 + 8388608;
constexpr size_t OFF_CTR = OFF_V8 + 16777216;
constexpr size_t OFF_BAR = OFF_CTR + 4096;
constexpr size_t OFF_EG = OFF_BAR + 16384;
constexpr size_t OFF_H = OFF_EG + (size_t)NTOK * 128 * 8;
constexpr size_t OFF_QA = OFF_H + SZ_T1024;
constexpr size_t OFF_KA = OFF_QA + SZ_T512;
constexpr size_t OFF_VA = OFF_KA + SZ_T512;
constexpr size_t OFF_HQ = OFF_VA + SZ_T512;
constexpr size_t OFF_HK = OFF_HQ + SZ_T512;
constexpr size_t OFF_HI = OFF_HK + SZ_T512;
constexpr size_t OFF_HG = OFF_HI + SZ_T512;
constexpr size_t OFF_GA = OFF_HG + SZ_T512;
constexpr size_t OFF_GB = OFF_GA + SZ_T1024;
constexpr size_t WS_END = OFF_GB + SZ_T1024;
constexpr size_t OFF_H8 = OFF_VA;
constexpr size_t OFF_HS = OFF_HQ;
constexpr size_t OFF_W = OFF_KA;
constexpr size_t OFF_Y = OFF_KA;

struct Params {
    const float *x, *c, *w_ada, *b_ada, *w_in, *w_ba, *w_bb, *w_out, *hgrn_lb, *hgrn_ng, *ln1_g, *ln1_b, *peer_wq, *peer_sk, *peer_u, *peer_v, *ln2_g, *ln2_b;
    float* out;
    unsigned char* ws;
};

typedef __bf16 bf16v2 __attribute__((ext_vector_type(2)));
__device__ __forceinline__ unsigned cvt_pk_bf16(float lo, float hi) { return __builtin_bit_cast(unsigned, __builtin_convertvector((f32x2){lo, hi}, bf16v2)); }
__device__ __forceinline__ float bf_lo(unsigned w) { return __uint_as_float(w << 16); }
__device__ __forceinline__ float bf_hi(unsigned w) { return __uint_as_float(w & 0xffff0000u); }
__device__ __forceinline__ float sigmoidf_(float x) { return __builtin_amdgcn_rcpf(1.0f + __builtin_amdgcn_exp2f(-LOG2E * x)); }
__device__ __forceinline__ float wave_sum(float v) {
#pragma unroll
    for (int o = 1; o < 64; o <<= 1) v += __shfl_xor(v, o);
    return v;
}
__device__ __forceinline__ int tid_opaque() { int t = threadIdx.x; asm volatile("" : "+v"(t)); return t; }
__device__ __forceinline__ int crow(int r, int hi) { return (r & 3) + 8 * (r >> 2) + 4 * hi; }
#define MFMA32(a, b, c) __builtin_amdgcn_mfma_f32_32x32x16_bf16(a, b, c, 0, 0, 0)

namespace pg8 {
constexpr int BM = 256, BK = 64, HALF = 128, HTB = HALF * BK * 2, STAGE_BYTES = 8 * HTB, NXCD = 8, WGM = 8;
__host__ __device__ __forceinline__ int lds_byte(int r, int c) { const int st = (r >> 4) * 2 + (c >> 5), rr = r & 15, cc = c & 31, ob = rr * 64 + cc * 2; return st * 1024 + (ob ^ (((ob >> 9) & 1) << 5)); }
__host__ __device__ __forceinline__ void stage_rc(int b, int& R, int& C) { const int st = b / 1024, sb = b % 1024, swz = sb ^ (((sb >> 9) & 1) << 5); R = (st >> 1) * 16 + swz / 64; C = (st & 1) * 32 + (swz % 64) / 2; }
__host__ __device__ __forceinline__ int perm32(int rho) { const int n = rho >> 4, i = rho & 15; return 8 * (i >> 2) + 4 * n + (i & 3); }

struct Unit { int pm, pn; };
struct Gemm { const bf16_t* A; const bf16_t* Bt; int M, N, K, lda; };

struct StaticOrder {
    int nM, nN, nwg, G, c;
    __device__ void init(int M, int N, int G_, int c_) { nM = M / BM; nN = N / BM; nwg = nM * nN; G = G_; c = c_; }
    __device__ bool next(int i, Unit& u) const {
        const long L = (long)i * G + c; if (L >= nwg) return false;
        int wgid = (int)L; { const int q = nwg / NXCD, r = nwg % NXCD, xcd = wgid % NXCD, off = wgid / NXCD; wgid = (xcd < r ? xcd * (q + 1) : r * (q + 1) + (xcd - r) * q) + off; }
        const int nig = WGM * nN, gid = wgid / nig, fm = gid * WGM, gsz = (nM - fm) < WGM ? (nM - fm) : WGM;
        u.pm = fm + ((wgid % nig) % gsz); u.pn = (wgid % nig) / gsz; return true;
    }
};
struct PanelOrder {
    int pm, npn;
    __device__ bool next(int i, Unit& u) const { if (i >= npn) return false; u.pm = pm; u.pn = i; return true; }
};

template <class Epi, class Sched, bool MX = false>
__device__ __forceinline__ void gemm_phase(LAS unsigned char* lds, const Gemm g, const Sched& S, const Epi& E) {
    const int tid = tid_opaque(), wid = __builtin_amdgcn_readfirstlane(tid >> 6), lane = tid & 63, wr = wid >> 2, wc = wid & 3, fr = lane & 15, fq = lane >> 4;
    const int K = g.K, nt = K / BK;
    unsigned voffA, voffB;
    { int R, C; stage_rc(tid * 16, R, C); const int Rb = Epi::PERM ? ((R & ~31) + perm32(R & 31)) : R;
      voffA = (unsigned)(R * g.lda + C) * 2u; voffB = (unsigned)(Rb * K + C) * 2u; }
    const size_t rvoffA = (size_t)128 * g.lda, rvoffB = (size_t)128 * K;
    const size_t kstep = (size_t)(BK * 2);
    const size_t hstep = (size_t)HALF * K * 2;
    const size_t tstep = 2 * hstep;
    const size_t hstepA = (size_t)HALF * g.lda * 2, tstepA = 2 * hstepA;
    const unsigned ldsw = (unsigned)wid * 1024u;
    const int aoff = lds_byte(wr * 64 + fr, fq * 8), boff = lds_byte(wc * 32 + fr, fq * 8);
#define PG8_SA(b, h) (((b) * 2 + (h)) * HTB)
#define PG8_SB(b, h) ((4 + (b) * 2 + (h)) * HTB)
#define PG8_STAGE(bufoff, gbase, voff) do { unsigned vo_ = (voff); asm volatile("" : "+v"(vo_));     \
        _Pragma("unroll") for (int _i = 0; _i < 2; ++_i) \
        __builtin_amdgcn_global_load_lds((const unsigned*)((const char*)(gbase) + _i * r##voff + vo_), (LAS unsigned*)(lds + (bufoff) + ldsw + _i * 8192), 16, 0, 0); } while (0)
#define PG8_LDX(dst, off) do { const v4i_ lo_ = *(const LAS v4i_*)(lds + (off)), hi_ = *(const LAS v4i_*)(lds + (off) + 1024); dst = __builtin_shufflevector(lo_, hi_, 0, 1, 2, 3, 4, 5, 6, 7); } while (0)
#define PG8_LDA(dst, b, h) do { if constexpr (MX) { _Pragma("unroll") for (int m = 0; m < 4; ++m) PG8_LDX(dst##X[m], PG8_SA(b, h) + aoff + m * 2048); } \
        else { _Pragma("unroll") for (int m = 0; m < 4; ++m) _Pragma("unroll") for (int k = 0; k < 2; ++k) dst[m][k] = *(const LAS bf16x8*)(lds + PG8_SA(b, h) + aoff + m * 2048 + k * 1024); } } while (0)
#define PG8_LDB(dst, b, h) do { if constexpr (MX) { _Pragma("unroll") for (int n = 0; n < 2; ++n) PG8_LDX(dst##X[n], PG8_SB(b, h) + boff + n * 2048); } \
        else { _Pragma("unroll") for (int n = 0; n < 2; ++n) _Pragma("unroll") for (int k = 0; k < 2; ++k) dst[n][k] = *(const LAS bf16x8*)(lds + PG8_SB(b, h) + boff + n * 2048 + k * 1024); } } while (0)
#define PG8_MMA(ai, bj, At, Bt) do { __builtin_amdgcn_s_setprio(1); \
        if constexpr (MX) { _Pragma("unroll") for (int m = 0; m < 4; ++m) _Pragma("unroll") for (int n = 0; n < 2; ++n) \
            asm volatile("v_mfma_scale_f32_16x16x128_f8f6f4 %0, %1, %2, %0, %3, %3 op_sel_hi:[0,0,0]" : "+v"(acc[ai][bj][m][n]) : "v"(Bt##X[n]), "v"(At##X[m]), "v"(mxscale)); } \
        else { _Pragma("unroll") for (int m = 0; m < 4; ++m) _Pragma("unroll") for (int n = 0; n < 2; ++n) _Pragma("unroll") for (int k = 0; k < 2; ++k) \
            acc[ai][bj][m][n] = __builtin_amdgcn_mfma_f32_16x16x32_bf16(Bt[n][k], At[m][k], acc[ai][bj][m][n], 0, 0, 0); } \
        __builtin_amdgcn_s_setprio(0); } while (0)
#define PG8_WAIT_V(n) asm volatile("s_waitcnt vmcnt(" #n ")" ::: "memory")
#define PG8_WAIT_L(n) asm volatile("s_waitcnt lgkmcnt(" #n ")" ::: "memory")
#define PG8_BAR __builtin_amdgcn_s_barrier()
#define PG8_SCHED __builtin_amdgcn_sched_barrier(0)
    Unit cur, nxt; int ui = 0;
    if (!S.next(0, cur)) return;
    f32x4 acc[2][2][4][2];
#pragma unroll
    for (int a = 0; a < 2; ++a)
#pragma unroll
        for (int b = 0; b < 2; ++b)
#pragma unroll
            for (int m = 0; m < 4; ++m)
#pragma unroll
                for (int n = 0; n < 2; ++n) acc[a][b][m][n] = (f32x4){0.f, 0.f, 0.f, 0.f};
    typedef int v4i_ __attribute__((ext_vector_type(4))); typedef int v8i_ __attribute__((ext_vector_type(8)));
    bf16x8 At[4][2], B0[2][2], B1[2][2];
    v8i_ AtX[4], B0X[2], B1X[2];
    const int mxscale = 0x7f7f7f7f;
    const char* cA = (const char*)g.A + (size_t)cur.pm * tstepA; const char* cB = (const char*)g.Bt + (size_t)cur.pn * tstep;
    PG8_STAGE(PG8_SB(0, 0), cB, voffB); PG8_STAGE(PG8_SA(0, 0), cA, voffA); PG8_STAGE(PG8_SB(0, 1), cB + hstep, voffB); PG8_STAGE(PG8_SA(0, 1), cA + hstepA, voffA);
    if (wr == 1) PG8_BAR;
    PG8_WAIT_V(4); PG8_BAR;
    PG8_STAGE(PG8_SB(1, 0), cB + kstep, voffB); PG8_STAGE(PG8_SA(1, 0), cA + kstep, voffA); PG8_STAGE(PG8_SB(1, 1), cB + hstep + kstep, voffB);
    PG8_WAIT_V(6); PG8_BAR;
    for (;;) {
        const bool has_next = S.next(ui + 1, nxt);
        const char* nA = has_next ? (const char*)g.A + (size_t)nxt.pm * tstepA : cA; const char* nB = has_next ? (const char*)g.Bt + (size_t)nxt.pn * tstep : cB;
        for (int t = 0; t < nt; t += 2) {
            const bool last = (t == nt - 2);
            const char* a1 = cA + (size_t)(t + 1) * kstep;
            const char* a2 = last ? nA : cA + (size_t)(t + 2) * kstep; const char* b2 = last ? nB : cB + (size_t)(t + 2) * kstep;
            const char* a3 = a2 + kstep; const char* b3 = b2 + kstep;
            PG8_LDB(B0, 0, 0); PG8_SCHED; PG8_LDA(At, 0, 0); PG8_STAGE(PG8_SA(1, 1), a1 + hstepA, voffA);
            PG8_WAIT_L(8); PG8_BAR; PG8_WAIT_L(0); PG8_MMA(0, 0, At, B0); PG8_BAR; PG8_SCHED;
            PG8_LDB(B1, 0, 1); PG8_STAGE(PG8_SB(0, 0), b2, voffB);
            PG8_BAR; PG8_WAIT_L(0); PG8_MMA(0, 1, At, B1); PG8_BAR;
            PG8_LDA(At, 0, 1); PG8_STAGE(PG8_SA(0, 0), a2, voffA);
            PG8_BAR; PG8_WAIT_L(0); PG8_MMA(1, 0, At, B0); PG8_BAR; PG8_SCHED;
            PG8_STAGE(PG8_SB(0, 1), b2 + hstep, voffB);
            PG8_WAIT_V(6); PG8_BAR; PG8_MMA(1, 1, At, B1); PG8_BAR;
            PG8_LDB(B0, 1, 0); PG8_SCHED; PG8_LDA(At, 1, 0); PG8_STAGE(PG8_SA(0, 1), a2 + hstepA, voffA);
            PG8_WAIT_L(8); PG8_BAR; PG8_WAIT_L(0); PG8_MMA(0, 0, At, B0); PG8_BAR; PG8_SCHED;
            PG8_LDB(B1, 1, 1); PG8_STAGE(PG8_SB(1, 0), b3, voffB);
            PG8_BAR; PG8_WAIT_L(0); PG8_MMA(0, 1, At, B1); PG8_BAR;
            PG8_LDA(At, 1, 1); PG8_STAGE(PG8_SA(1, 0), a3, voffA);
            PG8_BAR; PG8_WAIT_L(0); PG8_MMA(1, 0, At, B0); PG8_BAR; PG8_SCHED;
            PG8_STAGE(PG8_SB(1, 1), b3 + hstep, voffB);
            PG8_WAIT_V(6); PG8_BAR; PG8_MMA(1, 1, At, B1); PG8_BAR;
        }
        if constexpr (MX) asm volatile("s_nop 15\n\ts_nop 15" ::: "memory");
        E(acc, cur, wr, wc, fr, fq);
        if (!has_next) break;
#pragma unroll
        for (int a = 0; a < 2; ++a)
#pragma unroll
            for (int b = 0; b < 2; ++b)
#pragma unroll
                for (int m = 0; m < 4; ++m)
#pragma unroll
                    for (int n = 0; n < 2; ++n) acc[a][b][m][n] = (f32x4){0.f, 0.f, 0.f, 0.f};
        cur = nxt; cA = nA; cB = nB; ++ui;
    }
    PG8_WAIT_V(0);
    if (wr == 0) PG8_BAR;
    PG8_BAR;
#undef PG8_SA
#undef PG8_SB
#undef PG8_STAGE
#undef PG8_LDX
#undef PG8_LDA
#undef PG8_LDB
#undef PG8_MMA
#undef PG8_WAIT_V
#undef PG8_WAIT_L
#undef PG8_BAR
#undef PG8_SCHED
}
}
using pg8::Unit;

struct EpiProj {
    static constexpr bool PERM = true;
    unsigned char* ws; const float* lb; const float* ng; float* kmean;
    __device__ __forceinline__ void operator()(const f32x4 (&acc)[2][2][4][2], const Unit& u, int wr, int wc, int fr, int fq) const {
        const int pn = u.pn; int seg, colt, ldc; size_t boff;
        if (pn < 14) { seg = pn >> 1; colt = (pn & 1) * 256; ldc = 512; boff = OFF_QA + (size_t)seg * SZ_T512; }
        else if (pn < 18) { seg = 7; colt = (pn - 14) * 256; ldc = 1024; boff = OFF_GA; }
        else { seg = 8; colt = (pn - 18) * 256; ldc = 1024; boff = OFF_GB; }
        bf16_t* base = (bf16_t*)(ws + boff);
        const int row0 = u.pm * 256 + wr * 64 + fr, col0 = colt + wc * 32 + 8 * fq;
        float pv[2][8];
#pragma unroll
        for (int bj = 0; bj < 2; ++bj)
#pragma unroll
            for (int e = 0; e < 8; ++e) pv[bj][e] = (seg == 4) ? (1.0f - lb[col0 + bj * 128 + e]) : ((seg == 6) ? ng[col0 + bj * 128 + e] : 0.f);
        float cs[2][8];
#pragma unroll
        for (int bj = 0; bj < 2; ++bj)
#pragma unroll
            for (int e = 0; e < 8; ++e) cs[bj][e] = 0.f;
#pragma unroll
        for (int ai = 0; ai < 2; ++ai)
#pragma unroll
            for (int m = 0; m < 4; ++m) {
                bf16_t* rowp = base + (size_t)(row0 + ai * 128 + m * 16) * ldc + col0;
#pragma unroll
                for (int bj = 0; bj < 2; ++bj) {
                    float v[8];
#pragma unroll
                    for (int e = 0; e < 4; ++e) { v[e] = acc[ai][bj][m][0][e] * (1.0f / 32.0f); v[4 + e] = acc[ai][bj][m][1][e] * (1.0f / 32.0f); }
                    if (seg == 0) {
#pragma unroll
                        for (int e = 0; e < 8; ++e) v[e] *= (0.125f * LOG2E);
                    } else if (seg == 1) {
#pragma unroll
                        for (int e = 0; e < 8; ++e) cs[bj][e] += v[e];
                    } else if (seg == 3) {
#pragma unroll
                        for (int e = 0; e < 8; ++e) v[e] = v[e] * sigmoidf_(v[e]);
                    } else if (seg == 4) {
#pragma unroll
                        for (int e = 0; e < 8; ++e) v[e] = pv[bj][e] * sigmoidf_(-v[e]);
                    } else if (seg == 6) {
#pragma unroll
                        for (int e = 0; e < 8; ++e) v[e] = pv[bj][e] * v[e] * sigmoidf_(v[e]);
                    } else if (seg >= 7) {
#pragma unroll
                        for (int e = 0; e < 8; ++e) v[e] = sigmoidf_(v[e]);
                    }
                    u32x4 w; w.x = cvt_pk_bf16(v[0], v[1]); w.y = cvt_pk_bf16(v[2], v[3]); w.z = cvt_pk_bf16(v[4], v[5]); w.w = cvt_pk_bf16(v[6], v[7]);
                    *(u32x4*)(rowp + bj * 128) = w;
                }
            }
        if (seg == 1) {
#pragma unroll
            for (int bj = 0; bj < 2; ++bj)
#pragma unroll
                for (int e = 0; e < 8; ++e) {
                    float s = cs[bj][e];
                    s += __shfl_xor(s, 1); s += __shfl_xor(s, 2); s += __shfl_xor(s, 4); s += __shfl_xor(s, 8);
                    if (fr == 0) atomicAdd(kmean + (size_t)u.pm * 512 + col0 + bj * 128 + e, s);
                }
        }
    }
};
struct EpiMixA {
    static constexpr bool PERM = true;
    bf16_t* GA;
    __device__ __forceinline__ void operator()(const f32x4 (&acc)[2][2][4][2], const Unit& u, int wr, int wc, int fr, int fq) const {
        const int row0 = u.pm * 256 + wr * 64 + fr, col0 = u.pn * 256 + wc * 32 + 8 * fq;
#pragma unroll
        for (int ai = 0; ai < 2; ++ai)
#pragma unroll
            for (int m = 0; m < 4; ++m) {
                bf16_t* rowp = GA + (size_t)(row0 + ai * 128 + m * 16) * 1024 + col0;
#pragma unroll
                for (int bj = 0; bj < 2; ++bj) {
                    const u32x4 g = *(const u32x4*)(rowp + bj * 128);
                    const f32x4 a0 = acc[ai][bj][m][0], a1 = acc[ai][bj][m][1];
                    u32x4 w;
                    constexpr float S = 1.0f / 32.0f;
                    w.x = cvt_pk_bf16(bf_lo(g.x) * a0[0] * S, bf_hi(g.x) * a0[1] * S); w.y = cvt_pk_bf16(bf_lo(g.y) * a0[2] * S, bf_hi(g.y) * a0[3] * S);
                    w.z = cvt_pk_bf16(bf_lo(g.z) * a1[0] * S, bf_hi(g.z) * a1[1] * S); w.w = cvt_pk_bf16(bf_lo(g.w) * a1[2] * S, bf_hi(g.w) * a1[3] * S);
                    *(u32x4*)(rowp + bj * 128) = w;
                }
            }
    }
};
struct EpiMixB {
    static constexpr bool PERM = true;
    const bf16_t* GA; const bf16_t* GB; unsigned char* M8;
    __device__ __forceinline__ void operator()(const f32x4 (&acc)[2][2][4][2], const Unit& u, int wr, int wc, int fr, int fq) const {
        const int row0 = u.pm * 256 + wr * 64 + fr, col0 = u.pn * 256 + wc * 32 + 8 * fq;
#pragma unroll
        for (int ai = 0; ai < 2; ++ai)
#pragma unroll
            for (int m = 0; m < 4; ++m) {
                const size_t off = (size_t)(row0 + ai * 128 + m * 16) * 1024 + col0;
#pragma unroll
                for (int bj = 0; bj < 2; ++bj) {
                    const u32x4 g = *(const u32x4*)(GB + off + bj * 128);
                    const u32x4 mx = *(const u32x4*)(GA + off + bj * 128);
                    const f32x4 a0 = acc[ai][bj][m][0], a1 = acc[ai][bj][m][1];
                    constexpr float S = 1.0f / 32.0f;
                    int w0 = __builtin_amdgcn_cvt_pk_fp8_f32(bf_lo(mx.x) + bf_lo(g.x) * a0[0] * S, bf_hi(mx.x) + bf_hi(g.x) * a0[1] * S, 0, false); w0 = __builtin_amdgcn_cvt_pk_fp8_f32(bf_lo(mx.y) + bf_lo(g.y) * a0[2] * S, bf_hi(mx.y) + bf_hi(g.y) * a0[3] * S, w0, true);
                    int w1 = __builtin_amdgcn_cvt_pk_fp8_f32(bf_lo(mx.z) + bf_lo(g.z) * a1[0] * S, bf_hi(mx.z) + bf_hi(g.z) * a1[1] * S, 0, false); w1 = __builtin_amdgcn_cvt_pk_fp8_f32(bf_lo(mx.w) + bf_lo(g.w) * a1[2] * S, bf_hi(mx.w) + bf_hi(g.w) * a1[3] * S, w1, true);
                    *(u32x2*)(M8 + off + bj * 128) = (u32x2){(unsigned)w0, (unsigned)w1};
                }
            }
    }
};
struct EpiOut {
    static constexpr bool PERM = true;
    const float* ada; bf16_t* D;
    __device__ __forceinline__ void operator()(const f32x4 (&acc)[2][2][4][2], const Unit& u, int wr, int wc, int fr, int fq) const {
        const int row0 = u.pm * 256 + wr * 64 + fr, col0 = u.pn * 256 + wc * 32 + 8 * fq;
        const float* gt1 = ada + (size_t)(u.pm >> 3) * 6144 + 2048 + col0;
        f32x4 g[2][2];
#pragma unroll
        for (int bj = 0; bj < 2; ++bj) { g[bj][0] = *(const f32x4*)(gt1 + bj * 128); g[bj][1] = *(const f32x4*)(gt1 + bj * 128 + 4); }
#pragma unroll
        for (int ai = 0; ai < 2; ++ai)
#pragma unroll
            for (int m = 0; m < 4; ++m) {
                bf16_t* rowp = D + (size_t)(row0 + ai * 128 + m * 16) * 1024 + col0;
#pragma unroll
                for (int bj = 0; bj < 2; ++bj) {
                    const f32x4 a0 = acc[ai][bj][m][0] * g[bj][0] * (1.0f / 32.0f), a1 = acc[ai][bj][m][1] * g[bj][1] * (1.0f / 32.0f);
                    u32x4 w; w.x = cvt_pk_bf16(a0[0], a0[1]); w.y = cvt_pk_bf16(a0[2], a0[3]); w.z = cvt_pk_bf16(a1[0], a1[1]); w.w = cvt_pk_bf16(a1[2], a1[3]);
                    *(u32x4*)(rowp + bj * 128) = w;
                }
            }
    }
};
struct EpiBf16 {
    static constexpr bool PERM = true;
    bf16_t* O;
    __device__ __forceinline__ void operator()(const f32x4 (&acc)[2][2][4][2], const Unit& u, int wr, int wc, int fr, int fq) const {
        const int row0 = u.pm * 256 + wr * 64 + fr, col0 = u.pn * 256 + wc * 32 + 8 * fq;
#pragma unroll
        for (int ai = 0; ai < 2; ++ai)
#pragma unroll
            for (int m = 0; m < 4; ++m) {
                bf16_t* rowp = O + (size_t)(row0 + ai * 128 + m * 16) * 1024 + col0;
#pragma unroll
                for (int bj = 0; bj < 2; ++bj) {
                    const f32x4 a0 = acc[ai][bj][m][0], a1 = acc[ai][bj][m][1];
                    u32x4 w; w.x = cvt_pk_bf16(a0[0], a0[1]); w.y = cvt_pk_bf16(a0[2], a0[3]); w.z = cvt_pk_bf16(a1[0], a1[1]); w.w = cvt_pk_bf16(a1[2], a1[3]);
                    *(u32x4*)(rowp + bj * 128) = w;
                }
            }
    }
};

__device__ void phase0a(const Params& P, LAS unsigned char* lds) {
    const int tid = tid_opaque(), G = gridDim.x, bid = blockIdx.x;
    for (int it = bid; it < 192; it += G) {
        LAS float* sc = (LAS float*)lds;
        for (int i = tid; i < 32 * 1024; i += NTHR) { const float cv = P.c[i]; sc[i] = cv * sigmoidf_(cv); }
        __syncthreads();
        const int kg = tid >> 5, col = tid & 31;
        float a[32];
#pragma unroll
        for (int b = 0; b < 32; ++b) a[b] = 0.f;
#pragma unroll 1
        for (int k = kg * 64; k < kg * 64 + 64; k += 8) {
            float w[8];
#pragma unroll
            for (int e = 0; e < 8; ++e) w[e] = __builtin_nontemporal_load(P.w_ada + (size_t)(k + e) * 6144 + it * 32 + col);
#pragma unroll
            for (int e4 = 0; e4 < 2; ++e4) {
#pragma unroll
                for (int b = 0; b < 32; ++b) { const f32x4 s = *(const LAS f32x4*)(sc + b * 1024 + k + 4 * e4); a[b] += s[0] * w[4 * e4] + s[1] * w[4 * e4 + 1] + s[2] * w[4 * e4 + 2] + s[3] * w[4 * e4 + 3]; }
                asm volatile("" ::: "memory");
            }
        }
        __syncthreads();
        LAS float* red = (LAS float*)lds;
#pragma unroll
        for (int b = 0; b < 32; ++b) red[(kg * 32 + b) * 32 + col] = a[b];
        __syncthreads();
        for (int o = tid; o < 1024; o += NTHR) { const int b = o >> 5, cc = o & 31; float s = 0.f;
#pragma unroll
            for (int g2 = 0; g2 < 16; ++g2) s += red[(g2 * 32 + b) * 32 + cc];
            ((float*)(P.ws + OFF_ADA))[(size_t)b * 6144 + it * 32 + cc] = s + P.b_ada[it * 32 + cc]; }
        __syncthreads();
    }
    const size_t gsz = (size_t)G * NTHR;
    { const int gt = bid * NTHR + tid, gs = G * NTHR;
      if (gt < 512) ((float*)(P.ws + OFF_LB))[gt] = sigmoidf_(P.hgrn_lb[gt] - P.hgrn_lb[512 + gt]);
      for (int i = gt; i < 32 * 8 * 512; i += gs) ((float*)(P.ws + OFF_KMEAN))[i] = 0.f; }
    {
        LAS float* tile = (LAS float*)lds;
        const int I0 = 16 * 88, I1 = I0 + 8 * 16, I2 = I1 + 8 * 16, I3 = I2 + 16 * 16, I4 = I3 + 16 * 16;
        for (int it = bid; it < I4; it += G) {
            const float* W; bf16_t* WT; int K, N, r;
            if (it < I0) { W = P.w_in; WT = (bf16_t*)(P.ws + OFF_WIN); K = 1024; N = 5632; r = it; }
            else if (it < I1) { W = P.w_ba; WT = (bf16_t*)(P.ws + OFF_WBA); K = 512; N = 1024; r = it - I0; }
            else if (it < I2) { W = P.w_bb; WT = (bf16_t*)(P.ws + OFF_WBB); K = 512; N = 1024; r = it - I1; }
            else if (it < I3) { W = P.w_out; WT = (bf16_t*)(P.ws + OFF_WOUT); K = 1024; N = 1024; r = it - I2; }
            else { W = P.peer_wq; WT = (bf16_t*)(P.ws + OFF_WQ); K = 1024; N = 1024; r = it - I3; }
            const int nb = N / 64, k0 = (r / nb) * 64, n0 = (r % nb) * 64;
#pragma unroll
            for (int ps = 0; ps < 2; ++ps) { const int kk = (tid >> 4) + 32 * ps, n4 = (tid & 15) * 4;
                const f32x4 v = *(const f32x4*)(W + (size_t)(k0 + kk) * N + n0 + n4);
                tile[kk * 65 + n4] = v[0]; tile[kk * 65 + n4 + 1] = v[1]; tile[kk * 65 + n4 + 2] = v[2]; tile[kk * 65 + n4 + 3] = v[3]; }
            __syncthreads();
            { const int n = tid >> 3, kc = (tid & 7) * 8;
              if (it < I3) {
                  int w0 = __builtin_amdgcn_cvt_pk_fp8_f32(32.f * tile[(kc + 0) * 65 + n], 32.f * tile[(kc + 1) * 65 + n], 0, false); w0 = __builtin_amdgcn_cvt_pk_fp8_f32(32.f * tile[(kc + 2) * 65 + n], 32.f * tile[(kc + 3) * 65 + n], w0, true);
                  int w1 = __builtin_amdgcn_cvt_pk_fp8_f32(32.f * tile[(kc + 4) * 65 + n], 32.f * tile[(kc + 5) * 65 + n], 0, false); w1 = __builtin_amdgcn_cvt_pk_fp8_f32(32.f * tile[(kc + 6) * 65 + n], 32.f * tile[(kc + 7) * 65 + n], w1, true);
                  *(u32x2*)((unsigned char*)WT + (size_t)(n0 + n) * K + k0 + kc) = (u32x2){(unsigned)w0, (unsigned)w1};
              } else { u32x4 w;
              w.x = cvt_pk_bf16(tile[(kc + 0) * 65 + n], tile[(kc + 1) * 65 + n]); w.y = cvt_pk_bf16(tile[(kc + 2) * 65 + n], tile[(kc + 3) * 65 + n]);
              w.z = cvt_pk_bf16(tile[(kc + 4) * 65 + n], tile[(kc + 5) * 65 + n]); w.w = cvt_pk_bf16(tile[(kc + 6) * 65 + n], tile[(kc + 7) * 65 + n]);
              *(u32x4*)(WT + (size_t)(n0 + n) * K + k0 + kc) = w; } }
            __syncthreads();
        }
    }
    {
        const size_t gtid = (size_t)bid * NTHR + tid_opaque();
        for (size_t i = gtid; i < 16384; i += gsz) {
            const float* src = P.peer_sk + i * 8; const f32x4 a = *(const f32x4*)src, b = *(const f32x4*)(src + 4);
            u32x4 w; w.x = cvt_pk_bf16(a[0], a[1]); w.y = cvt_pk_bf16(a[2], a[3]); w.z = cvt_pk_bf16(b[0], b[1]); w.w = cvt_pk_bf16(b[2], b[3]);
            *(u32x4*)((bf16_t*)(P.ws + OFF_SK) + i * 8) = w;
        }
        { const int lane = tid & 63, gw = bid * 8 + (tid >> 6), ngw = G * 8;
          for (int r = gw; r < 2 * 16384; r += ngw) {
              const bool isv = r >= 16384; const int e = isv ? r - 16384 : r;
              const float* s = (isv ? P.peer_v : P.peer_u) + (size_t)e * 1024 + lane * 16;
              f32x4 x[4]; float ss = 0.f;
#pragma unroll
              for (int q = 0; q < 4; ++q) { x[q] = __builtin_nontemporal_load((const f32x4*)(s + 4 * q)); ss += (x[q][0] * x[q][0] + x[q][1] * x[q][1]) + (x[q][2] * x[q][2] + x[q][3] * x[q][3]); }
              const float sc = fmaxf(sqrtf(wave_sum(ss) * (1.0f / 1024.0f)) * (2.6f / 7.5f), 1e-30f), inv = 1.0f / sc;
              unsigned nb[16];
#pragma unroll
              for (int q = 0; q < 4; ++q)
#pragma unroll
                  for (int el = 0; el < 4; ++el) nb[4 * q + el] = (unsigned)fminf(fmaxf(floorf(x[q][el] * inv) + 8.0f, 0.0f), 15.0f);
              u32x2 w;
              w.x = (nb[0] | (nb[4] << 4)) | ((nb[1] | (nb[5] << 4)) << 8) | ((nb[2] | (nb[6] << 4)) << 16) | ((nb[3] | (nb[7] << 4)) << 24);
              w.y = (nb[8] | (nb[12] << 4)) | ((nb[9] | (nb[13] << 4)) << 8) | ((nb[10] | (nb[14] << 4)) << 16) | ((nb[11] | (nb[15] << 4)) << 24);
              if (!isv) { w.x ^= 0x88888888u; w.y ^= 0x88888888u; }
              *(u32x2*)(P.ws + (isv ? OFF_V8 : OFF_U8) + (size_t)e * 512 + lane * 8) = w;
              if (lane == 0) ((float*)(P.ws + (isv ? OFF_VSC : OFF_USC)))[e] = sc;
          } }
    }
}
__device__ void phase0b(const Params& P) {
    const size_t gtid = (size_t)blockIdx.x * NTHR + threadIdx.x, gsz = (size_t)gridDim.x * NTHR;
    const float* ada = (const float*)(P.ws + OFF_ADA); bf16_t* H = (bf16_t*)(P.ws + OFF_H);
    for (size_t i = gtid; i < (size_t)NTOK * 128; i += gsz) {
        const size_t row = i >> 7; const int c8 = (int)(i & 127) * 8; const int b = (int)(row >> 11);
        const float* xr = P.x + row * 1024 + c8; const float* sh = ada + (size_t)b * 6144 + c8; const float* sc = sh + 1024;
        const f32x4 x0 = *(const f32x4*)xr, x1 = *(const f32x4*)(xr + 4), s0 = *(const f32x4*)sc, s1 = *(const f32x4*)(sc + 4), h0 = *(const f32x4*)sh, h1 = *(const f32x4*)(sh + 4);
        const f32x4 r0 = x0 * (s0 + 1.0f) + h0, r1 = x1 * (s1 + 1.0f) + h1;
        int w0 = __builtin_amdgcn_cvt_pk_fp8_f32(r0[0], r0[1], 0, false); w0 = __builtin_amdgcn_cvt_pk_fp8_f32(r0[2], r0[3], w0, true);
        int w1 = __builtin_amdgcn_cvt_pk_fp8_f32(r1[0], r1[1], 0, false); w1 = __builtin_amdgcn_cvt_pk_fp8_f32(r1[2], r1[3], w1, true);
        *(u32x2*)((unsigned char*)H + row * 1024 + c8) = (u32x2){(unsigned)w0, (unsigned)w1};
    }
}

__device__ __forceinline__ s16x4 tr4(const LAS unsigned char* p) { return __builtin_bit_cast(s16x4, __builtin_amdgcn_ds_read_tr16_b64_v4i16((LAS s16x4*)p)); }
__device__ void hgrn_item(const Params& P, int item, LAS unsigned char* lds) {
    const int tid = tid_opaque(), lane = tid & 63, wid = __builtin_amdgcn_readfirstlane(tid >> 6), r32 = lane & 31, hi = lane >> 5;
    const int b = item >> 3, h = (item >> 1) & 3, vh = item & 1;
    const bf16_t* HQ = (const bf16_t*)(P.ws + OFF_HQ); const bf16_t* HK = (const bf16_t*)(P.ws + OFF_HK); bf16_t* HI = (bf16_t*)(P.ws + OFF_HI);
    constexpr int SQ = 272, SKD = 320, SV = 192, SS = 192;
    constexpr int LQR = 0, LKR = 17408, LQB = 34816, LKD = 52224, LV = 72704, LS = 84992, LG = 109568, LT = 142336, LCL = 144384;
    LAS float* G = (LAS float*)(lds + LG); LAS float* TOT = (LAS float*)(lds + LT); LAS float* CL = (LAS float*)(lds + LCL);
    const size_t rowb = (size_t)b * SEQ;
    const int row = tid >> 3, seg = tid & 7;
    const bf16_t* qsrc = HQ + (rowb + row) * 512 + h * 128 + seg * 16; const bf16_t* ksrc = HK + (rowb + row) * 512 + h * 128 + seg * 16;
    bf16_t* vsrc = HI + (rowb + row) * 512 + h * 128 + vh * 64 + seg * 8;
    for (int i = tid; i < 128 * SS / 4; i += NTHR) ((LAS unsigned*)(lds + LS))[i] = 0u;
    f32x16 Sacc = {};
    const int di = wid >> 1, vi = wid & 1, ti = wid >> 1;
    const int tg = lane >> 4, tc = tg & 1, tI = lane & 15;
    const int trow = 4 * hi + (tI >> 2), tcol = 16 * tc + 4 * (tI & 3);
    u32x4 qn0 = *(const u32x4*)qsrc, qn1 = *(const u32x4*)(qsrc + 8), kn0 = *(const u32x4*)ksrc, kn1 = *(const u32x4*)(ksrc + 8), vn = *(const u32x4*)vsrc;
#pragma unroll 1
    for (int n = 0; n < SEQ / 64; ++n) {
        const u32x4 q0 = qn0, q1 = qn1, k0 = kn0, k1 = kn1, vv = vn;
        float qf[16] = {bf_lo(q0.x), bf_hi(q0.x), bf_lo(q0.y), bf_hi(q0.y), bf_lo(q0.z), bf_hi(q0.z), bf_lo(q0.w), bf_hi(q0.w), bf_lo(q1.x), bf_hi(q1.x), bf_lo(q1.y), bf_hi(q1.y), bf_lo(q1.z), bf_hi(q1.z), bf_lo(q1.w), bf_hi(q1.w)};
        float kf[16] = {bf_lo(k0.x), bf_hi(k0.x), bf_lo(k0.y), bf_hi(k0.y), bf_lo(k0.z), bf_hi(k0.z), bf_lo(k0.w), bf_hi(k0.w), bf_lo(k1.x), bf_hi(k1.x), bf_lo(k1.y), bf_hi(k1.y), bf_lo(k1.z), bf_hi(k1.z), bf_lo(k1.w), bf_hi(k1.w)};
#pragma unroll
        for (int e4 = 0; e4 < 4; ++e4) *(LAS f32x4*)(G + row * 128 + seg * 16 + 4 * e4) = (f32x4){__logf(1.0f - kf[4 * e4]), __logf(1.0f - kf[4 * e4 + 1]), __logf(1.0f - kf[4 * e4 + 2]), __logf(1.0f - kf[4 * e4 + 3])};
        *(LAS u32x4*)(lds + LV + row * SV + seg * 16) = vv;
        if (n + 1 < SEQ / 64) { const size_t o = (size_t)(n + 1) * 64 * 512; qn0 = *(const u32x4*)(qsrc + o); qn1 = *(const u32x4*)(qsrc + o + 8); kn0 = *(const u32x4*)(ksrc + o); kn1 = *(const u32x4*)(ksrc + o + 8); vn = *(const u32x4*)(vsrc + o); }
        __syncthreads();
        { const int d = tid & 127, q4 = tid >> 7; float s = 0.f;
#pragma unroll
          for (int i = 0; i < 16; ++i) { s += G[(16 * q4 + i) * 128 + d]; G[(16 * q4 + i) * 128 + d] = s; }
          TOT[q4 * 128 + d] = s; }
        __syncthreads();
        {
            const int qq = row >> 4;
#pragma unroll
            for (int e4 = 0; e4 < 4; ++e4) {
                const int d4 = seg * 16 + 4 * e4;
                const f32x4 t0 = *(const LAS f32x4*)(TOT + d4), t1 = *(const LAS f32x4*)(TOT + 128 + d4), t2 = *(const LAS f32x4*)(TOT + 256 + d4), t3 = *(const LAS f32x4*)(TOT + 384 + d4);
                const f32x4 off = (qq == 0) ? (f32x4){0.f, 0.f, 0.f, 0.f} : ((qq == 1) ? t0 : ((qq == 2) ? t0 + t1 : t0 + t1 + t2));
                const f32x4 bb = *(const LAS f32x4*)(G + row * 128 + d4) + off;
                const f32x4 bref = *(const LAS f32x4*)(G + 32 * 128 + d4) + t0 + t1, blast = t0 + t1 + t2 + t3;
                float vqb[4], vqr[4], vkr[4], vkd[4];
#pragma unroll
                for (int e = 0; e < 4; ++e) {
                    const float e1 = __expf(bb[e]), e2 = __expf(-bb[e]);
                    vqb[e] = qf[4 * e4 + e] * e1; vqr[e] = vqb[e] * __expf(-bref[e]);
                    const float ke = kf[4 * e4 + e] * e2; vkr[e] = ke * __expf(bref[e]); vkd[e] = ke * __expf(blast[e]);
                }
                *(LAS u32x2*)(lds + LQB + row * SQ + seg * 32 + 8 * e4) = (u32x2){cvt_pk_bf16(vqb[0], vqb[1]), cvt_pk_bf16(vqb[2], vqb[3])};
                *(LAS u32x2*)(lds + LQR + row * SQ + seg * 32 + 8 * e4) = (u32x2){cvt_pk_bf16(vqr[0], vqr[1]), cvt_pk_bf16(vqr[2], vqr[3])};
                *(LAS u32x2*)(lds + LKR + row * SQ + seg * 32 + 8 * e4) = (u32x2){cvt_pk_bf16(vkr[0], vkr[1]), cvt_pk_bf16(vkr[2], vkr[3])};
                *(LAS u32x2*)(lds + LKD + row * SKD + seg * 32 + 8 * e4) = (u32x2){cvt_pk_bf16(vkd[0], vkd[1]), cvt_pk_bf16(vkd[2], vkd[3])};
                if (row == 0) *(LAS f32x4*)(CL + d4) = (f32x4){__expf(blast[0]), __expf(blast[1]), __expf(blast[2]), __expf(blast[3])};
                asm volatile("" ::: "memory");
            }
        }
        __syncthreads();
        if (wid < 4) {
            f32x16 Z = {};
            for (int si = 0; si <= ti; ++si) {
                f32x16 X = {};
#pragma unroll
                for (int ks = 0; ks < 8; ++ks) {
                    const bf16x8 a = *(const LAS bf16x8*)(lds + LKR + (32 * si + r32) * SQ + (16 * ks + 8 * hi) * 2);
                    const bf16x8 bq = *(const LAS bf16x8*)(lds + LQR + (32 * ti + r32) * SQ + (16 * ks + 8 * hi) * 2);
                    X = MFMA32(a, bq, X);
                }
                if (si == ti) {
#pragma unroll
                    for (int r = 0; r < 16; ++r) if (crow(r, hi) > r32) X[r] = 0.f;
                }
#pragma unroll
                for (int s2 = 0; s2 < 2; ++s2) {
                    union { u32x4 u; bf16x8 v; } pa;
                    pa.u.x = cvt_pk_bf16(X[8 * s2 + 0], X[8 * s2 + 1]); pa.u.y = cvt_pk_bf16(X[8 * s2 + 2], X[8 * s2 + 3]); pa.u.z = cvt_pk_bf16(X[8 * s2 + 4], X[8 * s2 + 5]); pa.u.w = cvt_pk_bf16(X[8 * s2 + 6], X[8 * s2 + 7]);
                    const LAS unsigned char* vp = lds + LV + (32 * si + 16 * s2 + trow) * SV + (32 * vi + tcol) * 2;
                    const s16x4 lo = tr4(vp), hh = tr4(vp + 8 * SV);
                    const bf16x8 vf = {lo[0], lo[1], lo[2], lo[3], hh[0], hh[1], hh[2], hh[3]};
                    Z = MFMA32(pa.v, vf, Z);
                }
            }
#pragma unroll
            for (int ks = 0; ks < 8; ++ks) {
                const bf16x8 a = *(const LAS bf16x8*)(lds + LQB + (32 * ti + r32) * SQ + (16 * ks + 8 * hi) * 2);
                const LAS unsigned char* sp = lds + LS + (16 * ks + 8 * hi + (tI >> 2)) * SS + (32 * vi + tcol) * 2;
                const s16x4 lo = tr4(sp), hh = tr4(sp + 4 * SS);
                const bf16x8 sf = {lo[0], lo[1], lo[2], lo[3], hh[0], hh[1], hh[2], hh[3]};
                Z = MFMA32(a, sf, Z);
            }
            bf16_t* op = HI + (rowb + (size_t)n * 64 + 32 * ti) * 512 + h * 128 + vh * 64 + 32 * vi + r32;
#pragma unroll
            for (int r = 0; r < 16; ++r) op[(size_t)crow(r, hi) * 512] = (bf16_t)(cvt_pk_bf16(Z[r], 0.f) & 0xffffu);
        }
        {
#pragma unroll
            for (int r = 0; r < 16; ++r) Sacc[r] *= CL[32 * di + crow(r, hi)];
#pragma unroll
            for (int ks = 0; ks < 4; ++ks) {
                const LAS unsigned char* kp = lds + LKD + (16 * ks + 8 * hi + (tI >> 2)) * SKD + (32 * di + tcol) * 2;
                const s16x4 klo = tr4(kp), khi = tr4(kp + 4 * SKD);
                const bf16x8 ka = {klo[0], klo[1], klo[2], klo[3], khi[0], khi[1], khi[2], khi[3]};
                const LAS unsigned char* vp = lds + LV + (16 * ks + 8 * hi + (tI >> 2)) * SV + (32 * vi + tcol) * 2;
                const s16x4 vlo = tr4(vp), vhi = tr4(vp + 4 * SV);
                const bf16x8 vb = {vlo[0], vlo[1], vlo[2], vlo[3], vhi[0], vhi[1], vhi[2], vhi[3]};
                Sacc = MFMA32(ka, vb, Sacc);
            }
        }
        __syncthreads();
        {
            LAS bf16_t* sp = (LAS bf16_t*)(lds + LS + (32 * di) * SS + (32 * vi + r32) * 2);
#pragma unroll
            for (int r = 0; r < 16; ++r) sp[crow(r, hi) * (SS / 2)] = (bf16_t)(cvt_pk_bf16(Sacc[r], 0.f) & 0xffffu);
        }
    }
    __syncthreads();
}

__device__ void moba_unit(const Params& P, int b, int h, int j, LAS unsigned char* lds) {
    const int tid = tid_opaque(), lane = tid & 63, wid = tid >> 6, r32 = lane & 31, hi = lane >> 5;
    bf16_t* Q = (bf16_t*)(P.ws + OFF_QA); const bf16_t* Kg = (const bf16_t*)(P.ws + OFF_KA); const bf16_t* Vg = (const bf16_t*)(P.ws + OFF_VA);
    const float* kmean = (const float*)(P.ws + OFF_KMEAN);
    constexpr int KIMG = 64 * 144, VIMG = 64 * 192, LK = 0, LV = 4 * KIMG, LKM = 4 * KIMG + 4 * VIMG;
    LAS float* kmL = (LAS float*)(lds + LKM);
    const size_t rowb = (size_t)b * SEQ; const int q0 = j * 256;
    if (tid < j * 64) kmL[tid] = kmean[(size_t)(b * 8 + (tid >> 6)) * 512 + h * 64 + (tid & 63)];
    bf16_t* qrow = Q + (rowb + q0 + wid * 32 + r32) * 512 + h * 64;
    bf16x8 qf[4];
#pragma unroll
    for (int d0 = 0; d0 < 4; ++d0) qf[d0] = *(const bf16x8*)(qrow + 16 * d0 + 8 * hi);
    const int srow = tid >> 3, sch = tid & 7;
    const bf16_t* ksrc = Kg + (rowb + srow) * 512 + h * 64 + sch * 8; const bf16_t* vsrc = Vg + (rowb + srow) * 512 + h * 64 + sch * 8;
    const int ntile = 4 * (j + 1), npair = ntile >> 1;
    auto tile_key0 = [&](int i) -> size_t { const int blk = (i < 4) ? j : ((i - 4) >> 2), kt = (i < 4) ? i : ((i - 4) & 3); return (size_t)(blk * 256 + kt * 64); };
    u32x4 kreg[2], vreg[2];
#pragma unroll
    for (int s = 0; s < 2; ++s) { const size_t k0 = tile_key0(s); kreg[s] = *(const u32x4*)(ksrc + k0 * 512); vreg[s] = *(const u32x4*)(vsrc + k0 * 512); }
#pragma unroll
    for (int s = 0; s < 2; ++s) { *(LAS u32x4*)(lds + LK + s * KIMG + srow * 144 + sch * 16) = kreg[s]; *(LAS u32x4*)(lds + LV + s * VIMG + srow * 192 + sch * 16) = vreg[s]; }
    __syncthreads();
    unsigned sel = 0;
    if (j <= 3) sel = (1u << j) - 1u;
    else {
        float g[7];
#pragma unroll
        for (int n = 0; n < 7; ++n) { float s = 0.f;
            if (n < j) {
#pragma unroll
                for (int d0 = 0; d0 < 4; ++d0)
#pragma unroll
                    for (int e = 0; e < 8; ++e) s += __uint_as_float(((unsigned)(unsigned short)qf[d0][e]) << 16) * kmL[n * 64 + 16 * d0 + 8 * hi + e];
            }
            s += __shfl_xor(s, 32); g[n] = s; }
#pragma unroll
        for (int it = 0; it < 3; ++it) { float best = -INFINITY; int bi = 0;
#pragma unroll
            for (int n = 0; n < 7; ++n) if (n < j && !((sel >> n) & 1u) && g[n] > best) { best = g[n]; bi = n; }
            sel |= 1u << bi; }
    }
    const float ch = exp2f(-(float)(h + 1)) * LOG2E;
    const int qb = wid * 32 + r32;
    float m_run = -1e30f, l_run = 0.f;
    f32x16 o0 = {}, o1 = {};
    const int tg = lane >> 4, tc = tg & 1, ti = lane & 15;
    const int vlane = (4 * hi + (ti >> 2)) * 192 + (16 * tc + 4 * (ti & 3)) * 2;
#pragma unroll 1
    for (int ip = 0; ip < npair; ++ip) {
      const int pbuf = ip & 1;
      if (ip + 1 < npair) {
#pragma unroll
          for (int s = 0; s < 2; ++s) { const size_t k1 = tile_key0(2 * ip + 2 + s); kreg[s] = *(const u32x4*)(ksrc + k1 * 512); vreg[s] = *(const u32x4*)(vsrc + k1 * 512); }
      }
#pragma unroll
      for (int s2 = 0; s2 < 2; ++s2) {
        const int i = 2 * ip + s2, buf = pbuf * 2 + s2;
        const bool own = i < 4; const int blk = own ? j : ((i - 4) >> 2), kt = own ? i : ((i - 4) & 3);
        const bool lane_ok = own ? true : (((sel >> blk) & 1u) != 0u);
        const bool skip = own ? (64 * kt > 32 * wid + 31) : (__ballot(lane_ok) == 0ull);
        if (!skip) {
            LAS unsigned char* kb = lds + LK + buf * KIMG; LAS unsigned char* vb = lds + LV + buf * VIMG;
            f32x16 p0 = {}, p1 = {};
#pragma unroll
            for (int d0 = 0; d0 < 4; ++d0) {
                const bf16x8 kf0 = *(const LAS bf16x8*)(kb + r32 * 144 + (16 * d0 + 8 * hi) * 2);
                const bf16x8 kf1 = *(const LAS bf16x8*)(kb + (32 + r32) * 144 + (16 * d0 + 8 * hi) * 2);
                p0 = MFMA32(kf0, qf[d0], p0); p1 = MFMA32(kf1, qf[d0], p1);
            }
            const float kbase = ch * (float)((blk - j) * 256 + kt * 64);
            float mt = -1e30f;
#pragma unroll
            for (int r = 0; r < 16; ++r) {
                const int kl0 = crow(r, hi), kl1 = kl0 + 32;
                p0[r] = __builtin_fmaf(ch, (float)kl0, p0[r]); p1[r] = __builtin_fmaf(ch, (float)kl1, p1[r]);
                if (own) { if (kt * 64 + kl0 > qb) p0[r] = -1e30f; if (kt * 64 + kl1 > qb) p1[r] = -1e30f; }
                mt = fmaxf(mt, fmaxf(p0[r], p1[r]));
            }
            mt = lane_ok ? mt + kbase : -1e30f;
            mt = fmaxf(mt, __shfl_xor(mt, 32));
            if (__ballot(mt > m_run) != 0ull) {
                const float mnew = fmaxf(m_run, mt), alpha = __builtin_amdgcn_exp2f(m_run - mnew);
                m_run = mnew; l_run *= alpha;
#pragma unroll
                for (int r = 0; r < 16; ++r) { o0[r] *= alpha; o1[r] *= alpha; }
            }
            const float sh = lane_ok ? kbase - m_run : -1e30f;
            float rs = 0.f;
#pragma unroll
            for (int r = 0; r < 16; ++r) { p0[r] = __builtin_amdgcn_exp2f(p0[r] + sh); p1[r] = __builtin_amdgcn_exp2f(p1[r] + sh); rs += p0[r] + p1[r]; }
            l_run += rs;
#pragma unroll
            for (int sub = 0; sub < 2; ++sub)
#pragma unroll
                for (int s = 0; s < 2; ++s) {
                    union { u32x4 u; bf16x8 v; } pb;
                    if (sub == 0) { pb.u.x = cvt_pk_bf16(p0[8 * s + 0], p0[8 * s + 1]); pb.u.y = cvt_pk_bf16(p0[8 * s + 2], p0[8 * s + 3]); pb.u.z = cvt_pk_bf16(p0[8 * s + 4], p0[8 * s + 5]); pb.u.w = cvt_pk_bf16(p0[8 * s + 6], p0[8 * s + 7]); }
                    else { pb.u.x = cvt_pk_bf16(p1[8 * s + 0], p1[8 * s + 1]); pb.u.y = cvt_pk_bf16(p1[8 * s + 2], p1[8 * s + 3]); pb.u.z = cvt_pk_bf16(p1[8 * s + 4], p1[8 * s + 5]); pb.u.w = cvt_pk_bf16(p1[8 * s + 6], p1[8 * s + 7]); }
#pragma unroll
                    for (int dt = 0; dt < 2; ++dt) {
                        LAS unsigned char* va = vb + (32 * sub + 16 * s) * 192 + dt * 64 + vlane;
                        const s16x4 lo = __builtin_bit_cast(s16x4, __builtin_amdgcn_ds_read_tr16_b64_v4i16((LAS s16x4*)va));
                        const s16x4 hh = __builtin_bit_cast(s16x4, __builtin_amdgcn_ds_read_tr16_b64_v4i16((LAS s16x4*)(va + 8 * 192)));
                        const bf16x8 vf = {lo[0], lo[1], lo[2], lo[3], hh[0], hh[1], hh[2], hh[3]};
                        if (dt == 0) o0 = MFMA32(vf, pb.v, o0); else o1 = MFMA32(vf, pb.v, o1);
                    }
                }
        }
      }
      if (ip + 1 < npair) { const int nb = (pbuf ^ 1) * 2;
#pragma unroll
          for (int s = 0; s < 2; ++s) { *(LAS u32x4*)(lds + LK + (nb + s) * KIMG + srow * 144 + sch * 16) = kreg[s]; *(LAS u32x4*)(lds + LV + (nb + s) * VIMG + srow * 192 + sch * 16) = vreg[s]; } }
      __syncthreads();
    }
    l_run += __shfl_xor(l_run, 32);
    const float inv = 1.0f / l_run;
#pragma unroll
    for (int r4 = 0; r4 < 4; ++r4) {
        int w0 = __builtin_amdgcn_cvt_pk_fp8_f32(o0[4 * r4] * inv, o0[4 * r4 + 1] * inv, 0, false); w0 = __builtin_amdgcn_cvt_pk_fp8_f32(o0[4 * r4 + 2] * inv, o0[4 * r4 + 3] * inv, w0, true);
        int w1 = __builtin_amdgcn_cvt_pk_fp8_f32(o1[4 * r4] * inv, o1[4 * r4 + 1] * inv, 0, false); w1 = __builtin_amdgcn_cvt_pk_fp8_f32(o1[4 * r4 + 2] * inv, o1[4 * r4 + 3] * inv, w1, true);
        unsigned char* yrow = P.ws + OFF_EG + (rowb + q0 + wid * 32 + r32) * 1024 + h * 64;
        *(int*)(yrow + 8 * r4 + 4 * hi) = w0; *(int*)(yrow + 32 + 8 * r4 + 4 * hi) = w1;
    }
}

__device__ void yb_norm_panel(const Params& P, int pm) {
    const int tid = tid_opaque(), lane = tid & 63, wid = tid >> 6;
    bf16_t* HI = (bf16_t*)(P.ws + OFF_HI); const bf16_t* HG = (const bf16_t*)(P.ws + OFF_HG);
    for (int r = 0; r < 32; ++r) {
        const size_t off = ((size_t)pm * 256 + wid * 32 + r) * 512 + lane * 8;
        const u32x4 ov = *(const u32x4*)(HI + off), gv = *(const u32x4*)(HG + off);
        float o[8] = {bf_lo(ov.x), bf_hi(ov.x), bf_lo(ov.y), bf_hi(ov.y), bf_lo(ov.z), bf_hi(ov.z), bf_lo(ov.w), bf_hi(ov.w)};
        const float g[8] = {bf_lo(gv.x), bf_hi(gv.x), bf_lo(gv.y), bf_hi(gv.y), bf_lo(gv.z), bf_hi(gv.z), bf_lo(gv.w), bf_hi(gv.w)};
        float ss = 0.f;
#pragma unroll
        for (int e = 0; e < 8; ++e) ss += o[e] * o[e];
        ss += __shfl_xor(ss, 1); ss += __shfl_xor(ss, 2); ss += __shfl_xor(ss, 4); ss += __shfl_xor(ss, 8);
        const float rs = rsqrtf(ss * (1.0f / 128.0f) + RMS_EPS);
        int w0 = __builtin_amdgcn_cvt_pk_fp8_f32(o[0] * rs * g[0], o[1] * rs * g[1], 0, false); w0 = __builtin_amdgcn_cvt_pk_fp8_f32(o[2] * rs * g[2], o[3] * rs * g[3], w0, true);
        int w1 = __builtin_amdgcn_cvt_pk_fp8_f32(o[4] * rs * g[4], o[5] * rs * g[5], 0, false); w1 = __builtin_amdgcn_cvt_pk_fp8_f32(o[6] * rs * g[6], o[7] * rs * g[7], w1, true);
        *(u32x2*)(P.ws + OFF_EG + ((size_t)pm * 256 + wid * 32 + r) * 1024 + 512 + lane * 8) = (u32x2){(unsigned)w0, (unsigned)w1};
    }
}
__device__ void ln1_panel(const Params& P, int pm) {
    const int tid = tid_opaque(), lane = tid & 63, wid = tid >> 6;
    const float* ada = (const float*)(P.ws + OFF_ADA) + (size_t)(pm >> 3) * 6144; bf16_t* H = (bf16_t*)(P.ws + OFF_H);
    for (int r = 0; r < 32; ++r) {
        const size_t row = (size_t)pm * 256 + wid * 32 + r;
        float* xr = P.out + row * 1024 + lane * 4; const float* xin = P.x + row * 1024 + lane * 4; const bf16_t* dl = (const bf16_t*)(P.ws + OFF_GB) + row * 1024 + lane * 4;
        f32x4 v[4]; float s = 0.f;
#pragma unroll
        for (int jx = 0; jx < 4; ++jx) { const u32x2 dv = *(const u32x2*)(dl + 256 * jx); const f32x4 xv = __builtin_nontemporal_load((const f32x4*)(xin + 256 * jx));
            v[jx] = xv * ALPHA + (f32x4){bf_lo(dv.x), bf_hi(dv.x), bf_lo(dv.y), bf_hi(dv.y)}; s += (v[jx][0] + v[jx][1]) + (v[jx][2] + v[jx][3]); }
        const float mean = wave_sum(s) * (1.0f / 1024.0f); float s2 = 0.f;
#pragma unroll
        for (int jx = 0; jx < 4; ++jx) { v[jx] = v[jx] - mean; s2 += (v[jx][0] * v[jx][0] + v[jx][1] * v[jx][1]) + (v[jx][2] * v[jx][2] + v[jx][3] * v[jx][3]); }
        const float rstd = rsqrtf(wave_sum(s2) * (1.0f / 1024.0f) + LN_EPS);
#pragma unroll
        for (int jx = 0; jx < 4; ++jx) {
            const int c = lane * 4 + 256 * jx;
            const f32x4 g = *(const f32x4*)(P.ln1_g + c), bb = *(const f32x4*)(P.ln1_b + c), sh = *(const f32x4*)(ada + 3072 + c), sc = *(const f32x4*)(ada + 4096 + c);
            const f32x4 x1 = v[jx] * rstd * g + bb;
            *(f32x4*)(xr + 256 * jx) = x1;
            const f32x4 h2 = x1 * (sc + 1.0f) + sh;
            u32x2 w; w.x = cvt_pk_bf16(h2[0], h2[1]); w.y = cvt_pk_bf16(h2[2], h2[3]);
            *(u32x2*)(H + row * 1024 + c) = w;
            v[jx] = h2;
        }
        {
            float mx = 0.f;
#pragma unroll
            for (int jx = 0; jx < 4; ++jx) mx = fmaxf(mx, fmaxf(fmaxf(fabsf(v[jx][0]), fabsf(v[jx][1])), fmaxf(fabsf(v[jx][2]), fabsf(v[jx][3]))));
#pragma unroll
            for (int o = 1; o < 64; o <<= 1) mx = fmaxf(mx, __shfl_xor(mx, o));
            const float hs = fmaxf(mx * (1.0f / 119.0f), 1e-30f), inv = 1.0f / hs; int qs = 0;
            const int nsh = (lane & 1) * 4;
#pragma unroll
            for (int jx = 0; jx < 4; ++jx) {
                unsigned pa = 0u, pb = 0u;
#pragma unroll
                for (int k = 0; k < 4; ++k) { const int q = (int)rintf(v[jx][k] * inv); qs += q;
                    const int b = ((q + 8) & 15) - 8, a = (q - b) >> 4;
                    pa |= (unsigned)(a & 15) << (8 * k + nsh); pb |= (unsigned)(b & 15) << (8 * k + nsh); }
                pa |= __shfl_xor(pa, 1); pb |= __shfl_xor(pb, 1);
                if (!(lane & 1)) { unsigned* hp4 = (unsigned*)(P.ws + OFF_H8 + row * 1024) + (lane >> 1) + 32 * jx; hp4[0] = pa; hp4[128] = pb; }
            }
#pragma unroll
            for (int o = 1; o < 64; o <<= 1) qs += __shfl_xor(qs, o);
            if (lane == 0) *(f32x2*)(P.ws + OFF_HS + row * 8) = (f32x2){hs, (float)qs};
        }
    }
}

#define CE16(A, i, j) do { const float hi_ = fmaxf(A[i], A[j]); A[j] = fminf(A[i], A[j]); A[i] = hi_; } while (0)
#define SORT16(A) do { CE16(A, 0, 1); CE16(A, 2, 3); CE16(A, 0, 2); CE16(A, 1, 3); CE16(A, 1, 2); CE16(A, 4, 5); CE16(A, 6, 7); CE16(A, 4, 6); CE16(A, 5, 7); CE16(A, 5, 6); CE16(A, 0, 4); CE16(A, 2, 6); CE16(A, 2, 4); CE16(A, 1, 5); CE16(A, 3, 7); CE16(A, 3, 5); CE16(A, 1, 2); CE16(A, 3, 4); CE16(A, 5, 6); CE16(A, 8, 9); CE16(A, 10, 11); CE16(A, 8, 10); CE16(A, 9, 11); CE16(A, 9, 10); CE16(A, 12, 13); CE16(A, 14, 15); CE16(A, 12, 14); CE16(A, 13, 15); CE16(A, 13, 14); CE16(A, 8, 12); CE16(A, 10, 14); CE16(A, 10, 12); CE16(A, 9, 13); CE16(A, 11, 15); CE16(A, 11, 13); CE16(A, 9, 10); CE16(A, 11, 12); CE16(A, 13, 14); CE16(A, 0, 8); CE16(A, 4, 12); CE16(A, 4, 8); CE16(A, 2, 10); CE16(A, 6, 14); CE16(A, 6, 10); CE16(A, 2, 4); CE16(A, 6, 8); CE16(A, 10, 12); CE16(A, 1, 9); CE16(A, 5, 13); CE16(A, 5, 9); CE16(A, 3, 11); CE16(A, 7, 15); CE16(A, 7, 11); CE16(A, 3, 5); CE16(A, 7, 9); CE16(A, 11, 13); CE16(A, 1, 2); CE16(A, 3, 4); CE16(A, 5, 6); CE16(A, 7, 8); CE16(A, 9, 10); CE16(A, 11, 12); CE16(A, 13, 14); } while (0)
#define BITONIC16(A) do { CE16(A, 0, 8); CE16(A, 1, 9); CE16(A, 2, 10); CE16(A, 3, 11); CE16(A, 4, 12); CE16(A, 5, 13); CE16(A, 6, 14); CE16(A, 7, 15); CE16(A, 0, 4); CE16(A, 1, 5); CE16(A, 2, 6); CE16(A, 3, 7); CE16(A, 8, 12); CE16(A, 9, 13); CE16(A, 10, 14); CE16(A, 11, 15); CE16(A, 0, 2); CE16(A, 1, 3); CE16(A, 4, 6); CE16(A, 5, 7); CE16(A, 8, 10); CE16(A, 9, 11); CE16(A, 12, 14); CE16(A, 13, 15); CE16(A, 0, 1); CE16(A, 2, 3); CE16(A, 4, 5); CE16(A, 6, 7); CE16(A, 8, 9); CE16(A, 10, 11); CE16(A, 12, 13); CE16(A, 14, 15); } while (0)
#define INS16(L, xin) do { float x_ = (xin); _Pragma("unroll") for (int k_ = 0; k_ < 16; ++k_) { const float hi_ = fmaxf(L[k_], x_); x_ = fminf(L[k_], x_); L[k_] = hi_; } } while (0)

__device__ void peer_select_wave(const Params& P, size_t tok0) {
    const int lane = tid_opaque() & 63, r32 = lane & 31, hi = lane >> 5;
    const bf16_t* QP = (const bf16_t*)(P.ws + OFF_GB) + (tok0 + r32) * 1024; const bf16_t* SK = (const bf16_t*)(P.ws + OFF_SK);
    u32x2* EG = (u32x2*)(P.ws + OFF_EG) + (tok0 + r32) * 128;
#pragma unroll 1
    for (int h = 0; h < 8; ++h) {
        float a0[16], a1[16];
#pragma unroll
        for (int k = 0; k < 16; ++k) { a0[k] = -INFINITY; a1[k] = -INFINITY; }
#pragma unroll
        for (int p = 0; p < 2; ++p) {
            const int hp = h * 2 + p;
            bf16x8 qf[4];
#pragma unroll
            for (int ks = 0; ks < 4; ++ks) qf[ks] = *(const bf16x8*)(QP + hp * 64 + 16 * ks + 8 * hi);
            float L[16];
#pragma unroll
            for (int kt = 0; kt < 4; ++kt) {
                f32x16 acc = {};
#pragma unroll
                for (int ks = 0; ks < 4; ++ks) { const bf16x8 kf = *(const bf16x8*)(SK + ((size_t)hp * 128 + 32 * kt + r32) * 64 + 16 * ks + 8 * hi); acc = MFMA32(kf, qf[ks], acc); }
                float S[16];
#pragma unroll
                for (int r = 0; r < 16; ++r) { const unsigned key = (unsigned)(32 * kt + crow(r, hi)); S[r] = __uint_as_float((__float_as_uint(acc[r]) & ~127u) | key); }
                SORT16(S);
                if (kt == 0) {
#pragma unroll
                    for (int k = 0; k < 16; ++k) L[k] = S[k];
                } else {
#pragma unroll
                    for (int k = 0; k < 16; ++k) L[k] = fmaxf(L[k], S[15 - k]);
                    BITONIC16(L);
                }
            }
            {
                float O[16];
#pragma unroll
                for (int k = 0; k < 16; ++k) O[k] = __shfl_xor(L[15 - k], 32);
#pragma unroll
                for (int k = 0; k < 16; ++k) L[k] = fmaxf(L[k], O[k]);
                BITONIC16(L);
            }
#pragma unroll
            for (int k = 0; k < 16; ++k) { a0[k] = (p == 0) ? L[k] : a0[k]; a1[k] = (p == 1) ? L[k] : a1[k]; }
        }
        float best[16];
#pragma unroll
        for (int k = 0; k < 16; ++k) best[k] = __uint_as_float((__float_as_uint(a0[0] + a1[k]) & ~255u) | (unsigned)k);
#pragma unroll
        for (int i = 1; i < 16; ++i)
#pragma unroll
            for (int jx = 0; jx < 16; ++jx)
                if ((i + 1) * (jx + 1) <= 16) {
                    const float cs = a0[i] + a1[jx];
                    const float cv = __uint_as_float((__float_as_uint(cs) & ~255u) | (unsigned)(i * 16 + jx));
                    INS16(best, cv);
                }
        unsigned pk0[4], pk1[4];
#pragma unroll
        for (int q = 0; q < 4; ++q) {
            pk0[q] = (__float_as_uint(a0[4 * q]) & 127u) | ((__float_as_uint(a0[4 * q + 1]) & 127u) << 8) | ((__float_as_uint(a0[4 * q + 2]) & 127u) << 16) | ((__float_as_uint(a0[4 * q + 3]) & 127u) << 24);
            pk1[q] = (__float_as_uint(a1[4 * q]) & 127u) | ((__float_as_uint(a1[4 * q + 1]) & 127u) << 8) | ((__float_as_uint(a1[4 * q + 2]) & 127u) << 16) | ((__float_as_uint(a1[4 * q + 3]) & 127u) << 24);
        }
        unsigned pay[16];
#pragma unroll
        for (int k = 0; k < 16; ++k) {
            const unsigned code = __float_as_uint(best[k]) & 255u, ci = code >> 4, cj = code & 15u;
            const unsigned qi = ci >> 2, qj = cj >> 2;
            const unsigned w0 = (qi == 0u) ? pk0[0] : ((qi == 1u) ? pk0[1] : ((qi == 2u) ? pk0[2] : pk0[3]));
            const unsigned w1 = (qj == 0u) ? pk1[0] : ((qj == 1u) ? pk1[1] : ((qj == 2u) ? pk1[2] : pk1[3]));
            pay[k] = (((w0 >> ((ci & 3u) * 8u)) & 127u) << 7) | ((w1 >> ((cj & 3u) * 8u)) & 127u);
        }
        float e[16], es = 0.f;
#pragma unroll
        for (int k = 0; k < 16; ++k) { e[k] = __expf(best[k] - best[0]); es += e[k]; }
        const float inv = 1.0f / es;
        if (hi == 0) {
#pragma unroll
            for (int k = 0; k < 16; ++k) { u32x2 w; w.x = pay[k]; w.y = __float_as_uint(e[k] * inv); EG[h * 16 + k] = w; }
        }
    }
}
__device__ __forceinline__ unsigned xcc_id() { return (unsigned)__builtin_amdgcn_s_getreg((3 << 11) | 20) & 0xFu; }
template <int CTRL> __device__ __forceinline__ float dpp_add(float x) { const int v = __builtin_amdgcn_update_dpp(0, __float_as_int(x), CTRL, 0xf, 0xf, true); return x + __int_as_float(v); }
__device__ __forceinline__ float wave_sum_fast(float x) {
    x = dpp_add<0xB1>(x); x = dpp_add<0x4E>(x); x = dpp_add<0x141>(x); x = dpp_add<0x140>(x);
    x += __shfl_xor(x, 16); x += __shfl_xor(x, 32); return x;
}
__device__ __forceinline__ float dot16_fp8(const float (&hv)[16], const u32x4 r) {
    float s = 0.f;
    { const f32x2 a = __builtin_amdgcn_cvt_pk_f32_fp8((int)r.x, false), b = __builtin_amdgcn_cvt_pk_f32_fp8((int)r.x, true); s += hv[0] * a.x + hv[1] * a.y + hv[2] * b.x + hv[3] * b.y; }
    { const f32x2 a = __builtin_amdgcn_cvt_pk_f32_fp8((int)r.y, false), b = __builtin_amdgcn_cvt_pk_f32_fp8((int)r.y, true); s += hv[4] * a.x + hv[5] * a.y + hv[6] * b.x + hv[7] * b.y; }
    { const f32x2 a = __builtin_amdgcn_cvt_pk_f32_fp8((int)r.z, false), b = __builtin_amdgcn_cvt_pk_f32_fp8((int)r.z, true); s += hv[8] * a.x + hv[9] * a.y + hv[10] * b.x + hv[11] * b.y; }
    { const f32x2 a = __builtin_amdgcn_cvt_pk_f32_fp8((int)r.w, false), b = __builtin_amdgcn_cvt_pk_f32_fp8((int)r.w, true); s += hv[12] * a.x + hv[13] * a.y + hv[14] * b.x + hv[15] * b.y; }
    return s;
}
template <int NP, class F> __device__ __forceinline__ void partition_queue(const Params& P, LAS unsigned char* lds, int ctr_base, F f) {
    const int tid = tid_opaque();
    LAS int* slot = (LAS int*)(lds + LDS_BYTES - 64);
    unsigned* ctr = (unsigned*)(P.ws + OFF_CTR) + ctr_base;
    const int myx = (int)(xcc_id() & 7u);
    for (int pp = 0; pp < NP; ++pp) {
        const int p = (myx * (NP / 8) + pp) % NP;
        for (;;) {
            if (tid == 0) *slot = (int)atomicAdd(ctr + p, 1u);
            __syncthreads();
            const int item = *slot;
            __syncthreads();
            if (item >= NTOK / 64) break;
            f(p, item);
        }
    }
}
__device__ __forceinline__ float dot2bf(unsigned a, bf16v2 b, float c) { return __builtin_amdgcn_fdot2_f32_bf16(__builtin_bit_cast(bf16v2, a), b, c, false); }
__device__ __forceinline__ float gelu_erf(float v) {
    const float av = fabsf(v), t = __builtin_amdgcn_rcpf(__builtin_fmaf(av, 0.2316418882f, 1.0f));
    float q = __builtin_fmaf(t, 0.5307027145f, -0.7265760135f); q = __builtin_fmaf(q, t, 0.7107068705f); q = __builtin_fmaf(q, t, -0.142248368f); q = __builtin_fmaf(q, t, 0.127414796f); q = q * t;
    const float m = v * (q * __builtin_amdgcn_exp2f(v * v * -0.72134752044f));
    return v < 0.f ? m : v - m;
}
struct UQuad { u32x4 r[2]; u32x4 ent; };
__device__ __forceinline__ void uq_issue(UQuad& q, const LAS u32x4* list, int J, int NQ, int g, const unsigned char* U4) {
    const int jj = J < NQ ? J : NQ - 1;
    q.ent = list[4 * jj + g];
    const unsigned char* rp = U4 + (size_t)q.ent.x * 512;
    q.r[0] = *(const u32x4*)rp; q.r[1] = *(const u32x4*)(rp + 256);
}
__device__ __forceinline__ float uq_dot(const UQuad& q, const u32x4 (&hp)[4]) {
    int a = 0, b = 0;
#pragma unroll
    for (int c = 0; c < 2; ++c) {
        const u32x4 r = q.r[c];
        a = __builtin_amdgcn_sdot8((int)hp[c].x, (int)r.x, a, false); a = __builtin_amdgcn_sdot8((int)hp[c].y, (int)r.y, a, false);
        a = __builtin_amdgcn_sdot8((int)hp[c].z, (int)r.z, a, false); a = __builtin_amdgcn_sdot8((int)hp[c].w, (int)r.w, a, false);
        b = __builtin_amdgcn_sdot8((int)hp[2 + c].x, (int)r.x, b, false); b = __builtin_amdgcn_sdot8((int)hp[2 + c].y, (int)r.y, b, false);
        b = __builtin_amdgcn_sdot8((int)hp[2 + c].z, (int)r.z, b, false); b = __builtin_amdgcn_sdot8((int)hp[2 + c].w, (int)r.w, b, false);
    }
    float s = (float)(16 * a + b);
    s = dpp_add<0xB1>(s); s = dpp_add<0x4E>(s); s = dpp_add<0x141>(s); s = dpp_add<0x140>(s);
    return s;
}
__device__ __forceinline__ void peer_u_tokens(const Params& P, LAS unsigned char* lds, const size_t t0) {
    const int tid = tid_opaque(), lane = tid & 63, wid = tid >> 6, g = lane >> 4, li = lane & 15;
    const unsigned char* H8 = P.ws + OFF_H8 + li * 16; const unsigned char* U4 = P.ws + OFF_U8 + li * 16;
    const f32x2* HS = (const f32x2*)(P.ws + OFF_HS); const float* USC = (const float*)(P.ws + OFF_USC);
    const u32x4* EG4 = (const u32x4*)(P.ws + OFF_EG); float* W = (float*)(P.ws + OFF_W);
    LAS u32x4* list = (LAS u32x4*)(lds + wid * 16384);
#pragma unroll 2
    for (int i = 0; i < 8; ++i) {
        const u32x4 eg = EG4[(t0 + i) * 64 + lane];
        list[i * 128 + 2 * lane] = (u32x4){eg.x, eg.y, (unsigned)(2 * lane) | (unsigned)(i << 8), __float_as_uint(USC[eg.x])};
        list[i * 128 + 2 * lane + 1] = (u32x4){eg.z, eg.w, (unsigned)(2 * lane + 1) | (unsigned)(i << 8), __float_as_uint(USC[eg.z])};
    }
    constexpr int NQ = 256;
    u32x4 hp[4], hn[4]; f32x2 hsc = HS[t0], hsn = HS[t0 + 1];
#pragma unroll
    for (int c = 0; c < 2; ++c) { hp[c] = *(const u32x4*)(H8 + t0 * 1024 + 256 * c); hp[2 + c] = *(const u32x4*)(H8 + t0 * 1024 + 512 + 256 * c);
                                  hn[c] = *(const u32x4*)(H8 + (t0 + 1) * 1024 + 256 * c); hn[2 + c] = *(const u32x4*)(H8 + (t0 + 1) * 1024 + 512 + 256 * c); }
    int curtok = 0;
    UQuad q0, q1, q2, q3;
    uq_issue(q0, list, 0, NQ, g, U4); uq_issue(q1, list, 1, NQ, g, U4); uq_issue(q2, list, 2, NQ, g, U4); uq_issue(q3, list, 3, NQ, g, U4);
    float sv = 0.f; unsigned gv = 0u, zv = 0u;
#define UQ_STEP(q, Jn, kq) do { \
        const float s = __uint_as_float(q.ent.w) * hsc.x * (uq_dot(q, hp) + 0.5f * hsc.y); \
        if (li == (kq)) { sv = s; gv = q.ent.y; zv = q.ent.z; } \
        uq_issue(q, list, (Jn), NQ, g, U4); } while (0)
#pragma unroll 1
    for (int J = 0; J < NQ; J += 4) {
        const int tk = __builtin_amdgcn_readfirstlane((int)(q0.ent.z >> 8));
        if (tk != curtok) { curtok = tk;
#pragma unroll
            for (int c = 0; c < 4; ++c) hp[c] = hn[c];
            hsc = hsn;
            if (tk + 1 < 8) { hsn = HS[t0 + tk + 1];
#pragma unroll
                for (int c = 0; c < 2; ++c) { hn[c] = *(const u32x4*)(H8 + (t0 + tk + 1) * 1024 + 256 * c); hn[2 + c] = *(const u32x4*)(H8 + (t0 + tk + 1) * 1024 + 512 + 256 * c); } } }
        UQ_STEP(q0, J + 4, 0); UQ_STEP(q1, J + 5, 1); UQ_STEP(q2, J + 6, 2); UQ_STEP(q3, J + 7, 3);
        if (li < 4) W[(t0 + tk) * 128 + (zv & 255u)] = __uint_as_float(gv) * gelu_erf(sv); }
#undef UQ_STEP
}
typedef int v4i_t __attribute__((ext_vector_type(4)));
struct VQuad { u32x4 r[2]; u32x2 ent; };
__device__ __forceinline__ void vq_issue(VQuad& q, const LAS u32x2* list, int J, int g, const unsigned char* V4) {
    const int jj = J < 32 ? J : 31;
    q.ent = list[4 * jj + g];
    const unsigned char* rp = V4 + (size_t)q.ent.x * 512;
    q.r[0] = *(const u32x4*)rp; q.r[1] = *(const u32x4*)(rp + 256);
}
__device__ __forceinline__ void vq_mma(const VQuad& q, v4i_t (&acc)[4], const unsigned sh, const u32x4 bm, const bool live) {
    const unsigned t = live ? ((q.ent.y & 255u) << sh) : 0u;
    const v4i_t B = {(int)(t & bm.x), (int)(t & bm.y), (int)(t & bm.z), (int)(t & bm.w)};
#pragma unroll
    for (int c = 0; c < 2; ++c) {
        const u32x4 r = q.r[c];
        const v4i_t lo = {(int)(r.x & 0x0F0F0F0Fu), (int)(r.y & 0x0F0F0F0Fu), (int)(r.z & 0x0F0F0F0Fu), (int)(r.w & 0x0F0F0F0Fu)};
        const v4i_t hi = {(int)((r.x >> 4) & 0x0F0F0F0Fu), (int)((r.y >> 4) & 0x0F0F0F0Fu), (int)((r.z >> 4) & 0x0F0F0F0Fu), (int)((r.w >> 4) & 0x0F0F0F0Fu)};
        acc[2 * c] = __builtin_amdgcn_mfma_i32_16x16x64_i8(lo, B, acc[2 * c], 0, 0, 0);
        acc[2 * c + 1] = __builtin_amdgcn_mfma_i32_16x16x64_i8(hi, B, acc[2 * c + 1], 0, 0, 0);
    }
}
__device__ __forceinline__ void peer_v_tokens(const Params& P, LAS unsigned char* lds, const size_t t0) {
    const int tid = tid_opaque(), lane = tid & 63, wid = tid >> 6, g = lane >> 4, li = lane & 15;
    const unsigned char* V4 = P.ws + OFF_V8 + li * 16; const float* VSC = (const float*)(P.ws + OFF_VSC);
    const u32x4* EG4 = (const u32x4*)(P.ws + OFF_EG); const f32x2* W2 = (const f32x2*)(P.ws + OFF_W);
    LAS u32x2* lists = (LAS u32x2*)(lds + wid * 8192);
    float swv[8], yoffv[8];
#pragma unroll
    for (int i = 0; i < 8; ++i) { const u32x4 eg = EG4[(t0 + i) * 64 + lane]; const f32x2 ww = W2[(t0 + i) * 64 + lane];
        const float w0 = ww.x * VSC[eg.x], w1 = ww.y * VSC[eg.z];
        float mx = fmaxf(fabsf(w0), fabsf(w1));
#pragma unroll
        for (int o = 1; o < 64; o <<= 1) mx = fmaxf(mx, __shfl_xor(mx, o));
        const float sw = fmaxf(mx * (1.0f / 127.0f), 1e-30f), inv = 1.0f / sw;
        const int q0 = (int)rintf(w0 * inv), q1 = (int)rintf(w1 * inv);
        *(LAS u32x4*)(lists + i * 128 + 2 * lane) = (u32x4){eg.x, (unsigned)q0, eg.z, (unsigned)q1};
        int qs = q0 + q1;
#pragma unroll
        for (int o = 1; o < 64; o <<= 1) qs += __shfl_xor(qs, o);
        swv[i] = sw; yoffv[i] = 7.5f * sw * (float)qs; }
    const unsigned sh = 8u * (unsigned)(li & 3);
    const u32x4 bm = {(li >> 2) == 0 ? 0xFFFFFFFFu : 0u, (li >> 2) == 1 ? 0xFFFFFFFFu : 0u, (li >> 2) == 2 ? 0xFFFFFFFFu : 0u, (li >> 2) == 3 ? 0xFFFFFFFFu : 0u};
#pragma unroll
    for (int i = 0; i < 8; ++i) {
        const size_t t = t0 + i;
        const LAS u32x2* list = lists + i * 128;
        v4i_t acc[4];
#pragma unroll
        for (int j = 0; j < 4; ++j) acc[j] = (v4i_t){0, 0, 0, 0};
        VQuad q0, q1, q2, q3;
        vq_issue(q0, list, 0, g, V4); vq_issue(q1, list, 1, g, V4); vq_issue(q2, list, 2, g, V4); vq_issue(q3, list, 3, g, V4);
#pragma unroll 1
        for (int J = 0; J < 32; J += 4) {
            vq_mma(q0, acc, sh, bm, true); vq_issue(q0, list, J + 4, g, V4);
            vq_mma(q1, acc, sh, bm, true); vq_issue(q1, list, J + 5, g, V4);
            vq_mma(q2, acc, sh, bm, true); vq_issue(q2, list, J + 6, g, V4);
            vq_mma(q3, acc, sh, bm, true); vq_issue(q3, list, J + 7, g, V4);
        }
        const float sw = swv[i], yoff = yoffv[i];
        const int dbase = 128 * g + 8 * (li >> 2) + (li & 3);
        const float* gt2 = (const float*)(P.ws + OFF_ADA) + (t >> 11) * 6144 + 5120;
        float* xr = P.out + t * 1024;
        float pre[16]; float s = 0.f;
#pragma unroll
        for (int c = 0; c < 2; ++c)
#pragma unroll
            for (int hf = 0; hf < 2; ++hf)
#pragma unroll
                for (int r = 0; r < 4; ++r) { const int d = dbase + 512 * c + 32 * r + 4 * hf;
                    const float yv = sw * (float)acc[2 * c + hf][r] - yoff;
                    const float pv = ALPHA * xr[d] + gt2[d] * yv; pre[8 * c + 4 * hf + r] = pv; s += pv; }
        const float mean = wave_sum(s) * (1.0f / 1024.0f); float s2 = 0.f;
#pragma unroll
        for (int e = 0; e < 16; ++e) { pre[e] -= mean; s2 += pre[e] * pre[e]; }
        const float rstd = rsqrtf(wave_sum(s2) * (1.0f / 1024.0f) + LN_EPS);
#pragma unroll
        for (int c = 0; c < 2; ++c)
#pragma unroll
            for (int hf = 0; hf < 2; ++hf)
#pragma unroll
                for (int r = 0; r < 4; ++r) { const int d = dbase + 512 * c + 32 * r + 4 * hf;
                    xr[d] = pre[8 * c + 4 * hf + r] * rstd * P.ln2_g[d] + P.ln2_b[d]; }
    }
}

#define XB_TMO      128
#define XB_XCNT(j)  (256  + 64 * (j))
#define XB_XSUB(j)  (1280 + 64 * (j))
#define XB_XGEN(j)  (2304 + 64 * (j))
#define XB_TOP      3328
#define XB_TOPGEN   3392
#define XCD_BAR_WORDS 3456
#define XB_SPIN_CAP (1u << 22)
__device__ __forceinline__ unsigned xb_ld(unsigned* p)              { return __hip_atomic_load(p, __ATOMIC_RELAXED, __HIP_MEMORY_SCOPE_AGENT); }
__device__ __forceinline__ unsigned xb_add(unsigned* p, unsigned v) { return __hip_atomic_fetch_add(p, v, __ATOMIC_RELAXED, __HIP_MEMORY_SCOPE_AGENT); }
#define XB_SPIN(cond, bar) do { unsigned _sp = 0; while (cond) { __builtin_amdgcn_s_sleep(1); \
    if ((++_sp & 255u) == 0u) { if (xb_ld(&(bar)[XB_TMO])) break; if (_sp > XB_SPIN_CAP) { atomicAdd(&(bar)[XB_TMO], 1u); break; } } } } while (0)
struct XcdBarrier { unsigned* bar; unsigned x; volatile LAS unsigned* st; };
__device__ __forceinline__ XcdBarrier xcd_barrier_post(unsigned* bar, volatile LAS unsigned* st) {
    XcdBarrier b; b.bar = bar; b.x = xcc_id(); b.st = st;
    if (threadIdx.x == 0) (void)xb_add(&bar[XB_XCNT(b.x)], 1u);
    return b;
}
__device__ __forceinline__ void xcd_barrier_complete(unsigned* bar, unsigned x, unsigned& nloc, unsigned& nx) {
    const unsigned G = gridDim.x * gridDim.y * gridDim.z;
    unsigned sum, cnt, mine, sp = 0u;
    for (;;) {
        sum = 0u; cnt = 0u; mine = 0u;
#pragma unroll
        for (unsigned j = 0; j < 16; ++j) { const unsigned c = xb_ld(&bar[XB_XCNT(j)]); sum += c; cnt += (c > 0u) ? 1u : 0u; mine = (j == x) ? c : mine; }
        if (sum == G) break;
        __builtin_amdgcn_s_sleep(1);
        if ((++sp & 255u) == 0u) { if (xb_ld(&bar[XB_TMO])) break; if (sp > XB_SPIN_CAP) { atomicAdd(&bar[XB_TMO], 1u); break; } }
    }
    nloc = mine > 0u ? mine : 1u; nx = cnt > 0u ? cnt : 1u;
}
__device__ __forceinline__ void xcd_barrier(const XcdBarrier& b) {
    asm volatile("s_waitcnt vmcnt(0)" ::: "memory");
    __syncthreads();
    if (threadIdx.x == 0) {
        unsigned* bar = b.bar;
        __builtin_amdgcn_s_waitcnt(0);
        unsigned nloc = b.st[0], nx = b.st[1];
        if (nloc == 0u) { xcd_barrier_complete(bar, b.x, nloc, nx); b.st[0] = nloc; b.st[1] = nx; }
        const unsigned old = xb_add(&bar[XB_XSUB(b.x)], 1u);
        const unsigned gen = old / nloc;
        if (old + 1u == (gen + 1u) * nloc) {
            __builtin_amdgcn_fence(__ATOMIC_RELEASE, "agent");
            asm volatile("s_waitcnt vmcnt(0)" ::: "memory");
            const unsigned og = xb_add(&bar[XB_TOP], 1u);
            const unsigned tg = og / nx;
            if (og + 1u == (tg + 1u) * nx) xb_add(&bar[XB_TOPGEN], 1u);
            else XB_SPIN(xb_ld(&bar[XB_TOPGEN]) == tg, bar);
            __builtin_amdgcn_fence(__ATOMIC_ACQUIRE, "agent");
            xb_add(&bar[XB_XGEN(b.x)], 1u);
            asm volatile("s_waitcnt vmcnt(0)" ::: "memory");
        } else {
            XB_SPIN(xb_ld(&bar[XB_XGEN(b.x)]) == gen, bar);
            __builtin_amdgcn_fence(__ATOMIC_ACQUIRE, "agent");
            asm volatile("s_waitcnt vmcnt(0)" ::: "memory");
        }
    }
    __syncthreads();
}

__global__ void __launch_bounds__(NTHR, 2) fwd_megakernel(Params P) {
    extern __shared__ __attribute__((aligned(16))) unsigned char shm[];
    LAS unsigned char* lds = (LAS unsigned char*)shm;
    cg::grid_group grid = cg::this_grid();
    const int G = gridDim.x, bid = blockIdx.x;
    volatile LAS unsigned* xst = (volatile LAS unsigned*)(lds + LDS_BYTES - 128);
    if (threadIdx.x == 0) { xst[0] = 0u; xst[1] = 0u; }
    __syncthreads();
    const XcdBarrier xb = xcd_barrier_post((unsigned*)(P.ws + OFF_BAR), xst);

#ifndef P3
#define P3 0xff
#endif
#ifndef PH
#define PH 0xff
#endif
    if (PH & 1) phase0a(P, lds);
    grid.sync();
    if (PH & 2) phase0b(P);
    xcd_barrier(xb);
    if (PH & 4) {
        pg8::Gemm g; g.A = (const bf16_t*)(P.ws + OFF_H); g.Bt = (const bf16_t*)(P.ws + OFF_WIN); g.M = NTOK; g.N = INCOLS; { int k_ = 512; asm volatile("" : "+s"(k_)); g.K = k_; g.lda = k_; }
        pg8::StaticOrder S; S.init(NTOK, INCOLS, G, bid);
        EpiProj E; E.ws = P.ws; E.lb = (const float*)(P.ws + OFF_LB); E.ng = P.hgrn_ng; E.kmean = (float*)(P.ws + OFF_KMEAN);
        pg8::gemm_phase<EpiProj, pg8::StaticOrder, true>(lds, g, S, E);
    }
    xcd_barrier(xb);
    if (PH & 8) for (int it = bid; it < 256; it += G) hgrn_item(P, it, lds);
    if (PH & 16) for (int u = bid; u < 2048; u += G) { const int bh = u & 255, jj = u >> 8; moba_unit(P, bh >> 3, bh & 7, (jj + bh) & 7, lds); }
    xcd_barrier(xb);
    if ((PH & 32) && bid < NTOK / 256) { const int pm = bid;
        if (P3 & 1) yb_norm_panel(P, pm);
        __syncthreads();
        if (P3 & 2) { pg8::Gemm g; g.A = (const bf16_t*)(P.ws + OFF_EG); g.Bt = (const bf16_t*)(P.ws + OFF_WBA); g.M = NTOK; g.N = 1024; { int k_ = 256; asm volatile("" : "+s"(k_)); g.K = k_; } g.lda = 512;
          pg8::PanelOrder S; S.pm = pm; S.npn = 4; EpiMixA E; E.GA = (bf16_t*)(P.ws + OFF_GA);
          pg8::gemm_phase<EpiMixA, pg8::PanelOrder, true>(lds, g, S, E); }
        __syncthreads();
        if (P3 & 4) { pg8::Gemm g; g.A = (const bf16_t*)(P.ws + OFF_EG + 512); g.Bt = (const bf16_t*)(P.ws + OFF_WBB); g.M = NTOK; g.N = 1024; { int k_ = 256; asm volatile("" : "+s"(k_)); g.K = k_; } g.lda = 512;
          pg8::PanelOrder S; S.pm = pm; S.npn = 4; EpiMixB E; E.GA = (const bf16_t*)(P.ws + OFF_GA); E.GB = (const bf16_t*)(P.ws + OFF_GB); E.M8 = P.ws + OFF_QA;
          pg8::gemm_phase<EpiMixB, pg8::PanelOrder, true>(lds, g, S, E); }
        __syncthreads();
        if (P3 & 8) { pg8::Gemm g; g.A = (const bf16_t*)(P.ws + OFF_QA); g.Bt = (const bf16_t*)(P.ws + OFF_WOUT); g.M = NTOK; g.N = 1024; { int k_ = 512; asm volatile("" : "+s"(k_)); g.K = k_; g.lda = k_; }
          pg8::PanelOrder S; S.pm = pm; S.npn = 4; EpiOut E; E.ada = (const float*)(P.ws + OFF_ADA); E.D = (bf16_t*)(P.ws + OFF_GB);
          pg8::gemm_phase<EpiOut, pg8::PanelOrder, true>(lds, g, S, E); }
        __syncthreads();
        if (P3 & 16) ln1_panel(P, pm);
        __syncthreads();
        if (P3 & 32) { pg8::Gemm g; g.A = (const bf16_t*)(P.ws + OFF_H); g.Bt = (const bf16_t*)(P.ws + OFF_WQ); g.M = NTOK; g.N = 1024; g.K = 1024; g.lda = 1024;
          pg8::PanelOrder S; S.pm = pm; S.npn = 4; EpiBf16 E; E.O = (bf16_t*)(P.ws + OFF_GB);
          pg8::gemm_phase<EpiBf16, pg8::PanelOrder>(lds, g, S, E); }
        __syncthreads();
        { const size_t tok0 = (size_t)pm * 256 + (tid_opaque() >> 6) * 32;
          peer_select_wave(P, tok0);
          __syncthreads();
#pragma unroll 1
          for (int sb = 0; sb < 4; ++sb) {
              peer_u_tokens(P, lds, tok0 + 8 * sb);
              __syncthreads();
              peer_v_tokens(P, lds, tok0 + 8 * sb);
              __syncthreads();
          } }
    }
}

extern "C" void kernel_launch(void* const* d_in, const int* in_sizes, int n_in, void* d_out, int out_size, void* d_ws, size_t ws_size, hipStream_t stream) {
    static int grid_blocks = 0;
    if (grid_blocks == 0) {
        if (n_in != 18 || out_size != NTOK * DM || ws_size < WS_END) { fprintf(stderr, "kernel_launch: unexpected shapes (n_in %d, out %d, ws %zu, need %zu)\n", n_in, out_size, ws_size, (size_t)WS_END); grid_blocks = -1; return; }
        int dev = 0, cus = 0, per_cu = 0;
        hipGetDevice(&dev);
        hipDeviceGetAttribute(&cus, hipDeviceAttributeMultiprocessorCount, dev);
        if (hipFuncSetAttribute((const void*)fwd_megakernel, hipFuncAttributeMaxDynamicSharedMemorySize, LDS_BYTES) != hipSuccess) fprintf(stderr, "kernel_launch: hipFuncSetAttribute failed\n");
        hipOccupancyMaxActiveBlocksPerMultiprocessor(&per_cu, (const void*)fwd_megakernel, NTHR, LDS_BYTES);
        if (per_cu < 1) { fprintf(stderr, "kernel_launch: occupancy query says %d blocks per CU\n", per_cu); per_cu = 1; }
        if (per_cu > 1) per_cu = 1;
        grid_blocks = cus * per_cu;
        if (grid_blocks != NTOK / 256) { fprintf(stderr, "kernel_launch: built for a %d-CU device (one 256-token panel per workgroup), found %d\n", NTOK / 256, grid_blocks); grid_blocks = -1; return; }
        (void)hipGetLastError();
    }
    if (grid_blocks < 0) return;
    Params p{};
    p.x = (const float*)d_in[0]; p.c = (const float*)d_in[1]; p.w_ada = (const float*)d_in[2]; p.b_ada = (const float*)d_in[3]; p.w_in = (const float*)d_in[4];
    p.w_ba = (const float*)d_in[5]; p.w_bb = (const float*)d_in[6]; p.w_out = (const float*)d_in[7]; p.hgrn_lb = (const float*)d_in[8]; p.hgrn_ng = (const float*)d_in[9];
    p.ln1_g = (const float*)d_in[10]; p.ln1_b = (const float*)d_in[11]; p.peer_wq = (const float*)d_in[12]; p.peer_sk = (const float*)d_in[13]; p.peer_u = (const float*)d_in[14];
    p.peer_v = (const float*)d_in[15]; p.ln2_g = (const float*)d_in[16]; p.ln2_b = (const float*)d_in[17];
    p.out = (float*)d_out; p.ws = (unsigned char*)d_ws;
    if (hipMemsetAsync((char*)d_ws + OFF_BAR, 0, XCD_BAR_WORDS * 4, stream) != hipSuccess) fprintf(stderr, "kernel_launch: memset of the barrier words failed\n");
    void* args[] = {&p};
    hipError_t e = hipLaunchCooperativeKernel((const void*)fwd_megakernel, dim3(grid_blocks), dim3(NTHR), args, LDS_BYTES, stream);
    if (e != hipSuccess) fprintf(stderr, "cooperative launch failed: %s (grid %d)\n", hipGetErrorString(e), grid_blocks);
}
```

```cpp
#include <hip/hip_runtime.h>
#include <hip/hip_cooperative_groups.h>
#include <cstdio>
#include <cstdint>
#include <type_traits>
namespace cg = cooperative_groups;

#define LAS __attribute__((address_space(3)))
typedef unsigned short bf16_t;
typedef short bf16x8 __attribute__((ext_vector_type(8)));
typedef short s16x4 __attribute__((ext_vector_type(4)));
typedef float f32x2 __attribute__((ext_vector_type(2)));
typedef float f32x4 __attribute__((ext_vector_type(4)));
typedef float f32x16 __attribute__((ext_vector_type(16)));
typedef unsigned u32x2 __attribute__((ext_vector_type(2)));
typedef unsigned u32x4 __attribute__((ext_vector_type(4)));

constexpr int NB = 32, SEQ = 2048, DM = 1024, NTOK = NB * SEQ;
constexpr int INCOLS = 5632;
constexpr int NTHR = 512;
constexpr int LDS_BYTES = 147456;
constexpr float ALPHA = 1.189207115002721f;
constexpr float LN_EPS = 1e-5f, RMS_EPS = 1e-6f;
constexpr float LOG2E = 1.4426950408889634f;

constexpr size_t SZ_T512 = (size_t)NTOK * 512 * 2, SZ_T1024 = (size_t)NTOK * 1024 * 2;
constexpr size_t OFF_ADA = 0;
constexpr size_t OFF_LB = OFF_ADA + 786432;
constexpr size_t OFF_KMEAN = OFF_LB + 4096;
constexpr size_t OFF_WIN = OFF_KMEAN + 524288;
constexpr size_t OFF_WBA = OFF_WIN + (size_t)5632 * 1024 * 2;
constexpr size_t OFF_WBB = OFF_WBA + 1048576;
constexpr size_t OFF_WOUT = OFF_WBB + 1048576;
constexpr size_t OFF_WQ = OFF_WOUT + 2097152;
constexpr size_t OFF_SK = OFF_WQ + 2097152;
constexpr size_t OFF_U8 = OFF_SK + 262144;
constexpr size_t OFF_USC = OFF_U8 + 8388608;
constexpr size_t OFF_V8 = OFF_U8 + 16777216;
constexpr size_t OFF_VSC = OFF_V8 + 8388608;
constexpr size_t OFF_CTR = OFF_V8 + 16777216;
constexpr size_t OFF_BAR = OFF_CTR + 4096;
constexpr size_t OFF_EG = OFF_BAR + 16384;
constexpr size_t OFF_H = OFF_EG + (size_t)NTOK * 128 * 8;
constexpr size_t OFF_QA = OFF_H + SZ_T1024;
constexpr size_t OFF_KA = OFF_QA + SZ_T512;
constexpr size_t OFF_VA = OFF_KA + SZ_T512;
constexpr size_t OFF_HQ = OFF_VA + SZ_T512;
constexpr size_t OFF_HK = OFF_HQ + SZ_T512;
constexpr size_t OFF_HI = OFF_HK + SZ_T512;
constexpr size_t OFF_HG = OFF_HI + SZ_T512;
constexpr size_t OFF_GA = OFF_HG + SZ_T512;
constexpr size_t OFF_GB = OFF_GA + SZ_T1024;
constexpr size_t WS_END = OFF_GB + SZ_T1024;
constexpr size_t OFF_H8 = OFF_VA;
constexpr size_t OFF_HS = OFF_HQ;
constexpr size_t OFF_W = OFF_KA;
constexpr size_t OFF_Y = OFF_KA;

struct Params {
    const float *x, *c, *w_ada, *b_ada, *w_in, *w_ba, *w_bb, *w_out, *hgrn_lb, *hgrn_ng, *ln1_g, *ln1_b, *peer_wq, *peer_sk, *peer_u, *peer_v, *ln2_g, *ln2_b;
    float* out;
    unsigned char* ws;
};

typedef __bf16 bf16v2 __attribute__((ext_vector_type(2)));
__device__ __forceinline__ unsigned cvt_pk_bf16(float lo, float hi) { return __builtin_bit_cast(unsigned, __builtin_convertvector((f32x2){lo, hi}, bf16v2)); }
__device__ __forceinline__ float bf_lo(unsigned w) { return __uint_as_float(w << 16); }
__device__ __forceinline__ float bf_hi(unsigned w) { return __uint_as_float(w & 0xffff0000u); }
__device__ __forceinline__ float sigmoidf_(float x) { return __builtin_amdgcn_rcpf(1.0f + __builtin_amdgcn_exp2f(-LOG2E * x)); }
__device__ __forceinline__ float wave_sum(float v) {
#pragma unroll
    for (int o = 1; o < 64; o <<= 1) v += __shfl_xor(v, o);
    return v;
}
__device__ __forceinline__ int tid_opaque() { int t = threadIdx.x; asm volatile("" : "+v"(t)); return t; }
__device__ __forceinline__ int crow(int r, int hi) { return (r & 3) + 8 * (r >> 2) + 4 * hi; }
#define MFMA32(a, b, c) __builtin_amdgcn_mfma_f32_32x32x16_bf16(a, b, c, 0, 0, 0)

namespace pg8 {
constexpr int BM = 256, BK = 64, HALF = 128, HTB = HALF * BK * 2, STAGE_BYTES = 8 * HTB, NXCD = 8, WGM = 8;
__host__ __device__ __forceinline__ int lds_byte(int r, int c) { const int st = (r >> 4) * 2 + (c >> 5), rr = r & 15, cc = c & 31, ob = rr * 64 + cc * 2; return st * 1024 + (ob ^ (((ob >> 9) & 1) << 5)); }
__host__ __device__ __forceinline__ void stage_rc(int b, int& R, int& C) { const int st = b / 1024, sb = b % 1024, swz = sb ^ (((sb >> 9) & 1) << 5); R = (st >> 1) * 16 + swz / 64; C = (st & 1) * 32 + (swz % 64) / 2; }
__host__ __device__ __forceinline__ int perm32(int rho) { const int n = rho >> 4, i = rho & 15; return 8 * (i >> 2) + 4 * n + (i & 3); }

struct Unit { int pm, pn; };
struct Gemm { const bf16_t* A; const bf16_t* Bt; int M, N, K, lda; };

struct StaticOrder {
    int nM, nN, nwg, G, c;
    __device__ void init(int M, int N, int G_, int c_) { nM = M / BM; nN = N / BM; nwg = nM * nN; G = G_; c = c_; }
    __device__ bool next(int i, Unit& u) const {
        const long L = (long)i * G + c; if (L >= nwg) return false;
        int wgid = (int)L; { const int q = nwg / NXCD, r = nwg % NXCD, xcd = wgid % NXCD, off = wgid / NXCD; wgid = (xcd < r ? xcd * (q + 1) : r * (q + 1) + (xcd - r) * q) + off; }
        const int nig = WGM * nN, gid = wgid / nig, fm = gid * WGM, gsz = (nM - fm) < WGM ? (nM - fm) : WGM;
        u.pm = fm + ((wgid % nig) % gsz); u.pn = (wgid % nig) / gsz; return true;
    }
};
struct PanelOrder {
    int pm, npn;
    __device__ bool next(int i, Unit& u) const { if (i >= npn) return false; u.pm = pm; u.pn = i; return true; }
};

template <class Epi, class Sched, bool MX = false>
__device__ __forceinline__ void gemm_phase(LAS unsigned char* lds, const Gemm g, const Sched& S, const Epi& E) {
    const int tid = tid_opaque(), wid = __builtin_amdgcn_readfirstlane(tid >> 6), lane = tid & 63, wr = wid >> 2, wc = wid & 3, fr = lane & 15, fq = lane >> 4;
    const int K = g.K, nt = K / BK;
    unsigned voffA, voffB;
    { int R, C; stage_rc(tid * 16, R, C); const int Rb = Epi::PERM ? ((R & ~31) + perm32(R & 31)) : R;
      voffA = (unsigned)(R * g.lda + C) * 2u; voffB = (unsigned)(Rb * K + C) * 2u; }
    const size_t rvoffA = (size_t)128 * g.lda, rvoffB = (size_t)128 * K;
    const size_t kstep = (size_t)(BK * 2);
    const size_t hstep = (size_t)HALF * K * 2;
    const size_t tstep = 2 * hstep;
    const size_t hstepA = (size_t)HALF * g.lda * 2, tstepA = 2 * hstepA;
    const unsigned ldsw = (unsigned)wid * 1024u;
    const int aoff = lds_byte(wr * 64 + fr, fq * 8), boff = lds_byte(wc * 32 + fr, fq * 8);
#define PG8_SA(b, h) (((b) * 2 + (h)) * HTB)
#define PG8_SB(b, h) ((4 + (b) * 2 + (h)) * HTB)
#define PG8_STAGE(bufoff, gbase, voff) do { unsigned vo_ = (voff); asm volatile("" : "+v"(vo_));     \
        _Pragma("unroll") for (int _i = 0; _i < 2; ++_i) \
        __builtin_amdgcn_global_load_lds((const unsigned*)((const char*)(gbase) + _i * r##voff + vo_), (LAS unsigned*)(lds + (bufoff) + ldsw + _i * 8192), 16, 0, 0); } while (0)
#define PG8_LDX(dst, off) do { const v4i_ lo_ = *(const LAS v4i_*)(lds + (off)), hi_ = *(const LAS v4i_*)(lds + (off) + 1024); dst = __builtin_shufflevector(lo_, hi_, 0, 1, 2, 3, 4, 5, 6, 7); } while (0)
#define PG8_LDA(dst, b, h) do { if constexpr (MX) { _Pragma("unroll") for (int m = 0; m < 4; ++m) PG8_LDX(dst##X[m], PG8_SA(b, h) + aoff + m * 2048); } \
        else { _Pragma("unroll") for (int m = 0; m < 4; ++m) _Pragma("unroll") for (int k = 0; k < 2; ++k) dst[m][k] = *(const LAS bf16x8*)(lds + PG8_SA(b, h) + aoff + m * 2048 + k * 1024); } } while (0)
#define PG8_LDB(dst, b, h) do { if constexpr (MX) { _Pragma("unroll") for (int n = 0; n < 2; ++n) PG8_LDX(dst##X[n], PG8_SB(b, h) + boff + n * 2048); } \
        else { _Pragma("unroll") for (int n = 0; n < 2; ++n) _Pragma("unroll") for (int k = 0; k < 2; ++k) dst[n][k] = *(const LAS bf16x8*)(lds + PG8_SB(b, h) + boff + n * 2048 + k * 1024); } } while (0)
#define PG8_MMA(ai, bj, At, Bt) do { __builtin_amdgcn_s_setprio(1); \
        if constexpr (MX) { _Pragma("unroll") for (int m = 0; m < 4; ++m) _Pragma("unroll") for (int n = 0; n < 2; ++n) \
            asm volatile("v_mfma_scale_f32_16x16x128_f8f6f4 %0, %1, %2, %0, %3, %3 op_sel_hi:[0,0,0]" : "+v"(acc[ai][bj][m][n]) : "v"(Bt##X[n]), "v"(At##X[m]), "v"(mxscale)); } \
        else { _Pragma("unroll") for (int m = 0; m < 4; ++m) _Pragma("unroll") for (int n = 0; n < 2; ++n) _Pragma("unroll") for (int k = 0; k < 2; ++k) \
            acc[ai][bj][m][n] = __builtin_amdgcn_mfma_f32_16x16x32_bf16(Bt[n][k], At[m][k], acc[ai][bj][m][n], 0, 0, 0); } \
        __builtin_amdgcn_s_setprio(0); } while (0)
#define PG8_WAIT_V(n) asm volatile("s_waitcnt vmcnt(" #n ")" ::: "memory")
#define PG8_WAIT_L(n) asm volatile("s_waitcnt lgkmcnt(" #n ")" ::: "memory")
#define PG8_BAR __builtin_amdgcn_s_barrier()
#define PG8_SCHED __builtin_amdgcn_sched_barrier(0)
    Unit cur, nxt; int ui = 0;
    if (!S.next(0, cur)) return;
    f32x4 acc[2][2][4][2];
#pragma unroll
    for (int a = 0; a < 2; ++a)
#pragma unroll
        for (int b = 0; b < 2; ++b)
#pragma unroll
            for (int m = 0; m < 4; ++m)
#pragma unroll
                for (int n = 0; n < 2; ++n) acc[a][b][m][n] = (f32x4){0.f, 0.f, 0.f, 0.f};
    typedef int v4i_ __attribute__((ext_vector_type(4))); typedef int v8i_ __attribute__((ext_vector_type(8)));
    bf16x8 At[4][2], B0[2][2], B1[2][2];
    v8i_ AtX[4], B0X[2], B1X[2];
    const int mxscale = 0x7f7f7f7f;
    const char* cA = (const char*)g.A + (size_t)cur.pm * tstepA; const char* cB = (const char*)g.Bt + (size_t)cur.pn * tstep;
    PG8_STAGE(PG8_SB(0, 0), cB, voffB); PG8_STAGE(PG8_SA(0, 0), cA, voffA); PG8_STAGE(PG8_SB(0, 1), cB + hstep, voffB); PG8_STAGE(PG8_SA(0, 1), cA + hstepA, voffA);
    if (wr == 1) PG8_BAR;
    PG8_WAIT_V(4); PG8_BAR;
    PG8_STAGE(PG8_SB(1, 0), cB + kstep, voffB); PG8_STAGE(PG8_SA(1, 0), cA + kstep, voffA); PG8_STAGE(PG8_SB(1, 1), cB + hstep + kstep, voffB);
    PG8_WAIT_V(6); PG8_BAR;
    for (;;) {
        const bool has_next = S.next(ui + 1, nxt);
        const char* nA = has_next ? (const char*)g.A + (size_t)nxt.pm * tstepA : cA; const char* nB = has_next ? (const char*)g.Bt + (size_t)nxt.pn * tstep : cB;
        for (int t = 0; t < nt; t += 2) {
            const bool last = (t == nt - 2);
            const char* a1 = cA + (size_t)(t + 1) * kstep;
            const char* a2 = last ? nA : cA + (size_t)(t + 2) * kstep; const char* b2 = last ? nB : cB + (size_t)(t + 2) * kstep;
            const char* a3 = a2 + kstep; const char* b3 = b2 + kstep;
            PG8_LDB(B0, 0, 0); PG8_SCHED; PG8_LDA(At, 0, 0); PG8_STAGE(PG8_SA(1, 1), a1 + hstepA, voffA);
            PG8_WAIT_L(8); PG8_BAR; PG8_WAIT_L(0); PG8_MMA(0, 0, At, B0); PG8_BAR; PG8_SCHED;
            PG8_LDB(B1, 0, 1); PG8_STAGE(PG8_SB(0, 0), b2, voffB);
            PG8_BAR; PG8_WAIT_L(0); PG8_MMA(0, 1, At, B1); PG8_BAR;
            PG8_LDA(At, 0, 1); PG8_STAGE(PG8_SA(0, 0), a2, voffA);
            PG8_BAR; PG8_WAIT_L(0); PG8_MMA(1, 0, At, B0); PG8_BAR; PG8_SCHED;
            PG8_STAGE(PG8_SB(0, 1), b2 + hstep, voffB);
            PG8_WAIT_V(6); PG8_BAR; PG8_MMA(1, 1, At, B1); PG8_BAR;
            PG8_LDB(B0, 1, 0); PG8_SCHED; PG8_LDA(At, 1, 0); PG8_STAGE(PG8_SA(0, 1), a2 + hstepA, voffA);
            PG8_WAIT_L(8); PG8_BAR; PG8_WAIT_L(0); PG8_MMA(0, 0, At, B0); PG8_BAR; PG8_SCHED;
            PG8_LDB(B1, 1, 1); PG8_STAGE(PG8_SB(1, 0), b3, voffB);
            PG8_BAR; PG8_WAIT_L(0); PG8_MMA(0, 1, At, B1); PG8_BAR;
            PG8_LDA(At, 1, 1); PG8_STAGE(PG8_SA(1, 0), a3, voffA);
            PG8_BAR; PG8_WAIT_L(0); PG8_MMA(1, 0, At, B0); PG8_BAR; PG8_SCHED;
            PG8_STAGE(PG8_SB(1, 1), b3 + hstep, voffB);
            PG8_WAIT_V(6); PG8_BAR; PG8_MMA(1, 1, At, B1); PG8_BAR;
        }
        if constexpr (MX) asm volatile("s_nop 15\n\ts_nop 15" ::: "memory");
        E(acc, cur, wr, wc, fr, fq);
        if (!has_next) break;
#pragma unroll
        for (int a = 0; a < 2; ++a)
#pragma unroll
            for (int b = 0; b < 2; ++b)
#pragma unroll
                for (int m = 0; m < 4; ++m)
#pragma unroll
                    for (int n = 0; n < 2; ++n) acc[a][b][m][n] = (f32x4){0.f, 0.f, 0.f, 0.f};
        cur = nxt; cA = nA; cB = nB; ++ui;
    }
    PG8_WAIT_V(0);
    if (wr == 0) PG8_BAR;
    PG8_BAR;
#undef PG8_SA
#undef PG8_SB
#undef PG8_STAGE
#undef PG8_LDX
#undef PG8_LDA
#undef PG8_LDB
#undef PG8_MMA
#undef PG8_WAIT_V
#undef PG8_WAIT_L
#undef PG8_BAR
#undef PG8_SCHED
}
}
using pg8::Unit;

struct EpiProj {
    static constexpr bool PERM = true;
    unsigned char* ws; const float* lb; const float* ng; float* kmean;
    __device__ __forceinline__ void operator()(const f32x4 (&acc)[2][2][4][2], const Unit& u, int wr, int wc, int fr, int fq) const {
        const int pn = u.pn; int seg, colt, ldc; size_t boff;
        if (pn < 14) { seg = pn >> 1; colt = (pn & 1) * 256; ldc = 512; boff = OFF_QA + (size_t)seg * SZ_T512; }
        else if (pn < 18) { seg = 7; colt = (pn - 14) * 256; ldc = 1024; boff = OFF_GA; }
        else { seg = 8; colt = (pn - 18) * 256; ldc = 1024; boff = OFF_GB; }
        bf16_t* base = (bf16_t*)(ws + boff);
        const int row0 = u.pm * 256 + wr * 64 + fr, col0 = colt + wc * 32 + 8 * fq;
        float pv[2][8];
#pragma unroll
        for (int bj = 0; bj < 2; ++bj)
#pragma unroll
            for (int e = 0; e < 8; ++e) pv[bj][e] = (seg == 4) ? (1.0f - lb[col0 + bj * 128 + e]) : ((seg == 6) ? ng[col0 + bj * 128 + e] : 0.f);
        float cs[2][8];
#pragma unroll
        for (int bj = 0; bj < 2; ++bj)
#pragma unroll
            for (int e = 0; e < 8; ++e) cs[bj][e] = 0.f;
#pragma unroll
        for (int ai = 0; ai < 2; ++ai)
#pragma unroll
            for (int m = 0; m < 4; ++m) {
                bf16_t* rowp = base + (size_t)(row0 + ai * 128 + m * 16) * ldc + col0;
#pragma unroll
                for (int bj = 0; bj < 2; ++bj) {
                    float v[8];
#pragma unroll
                    for (int e = 0; e < 4; ++e) { v[e] = acc[ai][bj][m][0][e] * (1.0f / 32.0f); v[4 + e] = acc[ai][bj][m][1][e] * (1.0f / 32.0f); }
                    if (seg == 0) {
#pragma unroll
                        for (int e = 0; e < 8; ++e) v[e] *= (0.125f * LOG2E);
                    } else if (seg == 1) {
#pragma unroll
                        for (int e = 0; e < 8; ++e) cs[bj][e] += v[e];
                    } else if (seg == 3) {
#pragma unroll
                        for (int e = 0; e < 8; ++e) v[e] = v[e] * sigmoidf_(v[e]);
                    } else if (seg == 4) {
#pragma unroll
                        for (int e = 0; e < 8; ++e) v[e] = pv[bj][e] * sigmoidf_(-v[e]);
                    } else if (seg == 6) {
#pragma unroll
                        for (int e = 0; e < 8; ++e) v[e] = pv[bj][e] * v[e] * sigmoidf_(v[e]);
                    } else if (seg >= 7) {
#pragma unroll
                        for (int e = 0; e < 8; ++e) v[e] = sigmoidf_(v[e]);
                    }
                    u32x4 w; w.x = cvt_pk_bf16(v[0], v[1]); w.y = cvt_pk_bf16(v[2], v[3]); w.z = cvt_pk_bf16(v[4], v[5]); w.w = cvt_pk_bf16(v[6], v[7]);
                    *(u32x4*)(rowp + bj * 128) = w;
                }
            }
        if (seg == 1) {
#pragma unroll
            for (int bj = 0; bj < 2; ++bj)
#pragma unroll
                for (int e = 0; e < 8; ++e) {
                    float s = cs[bj][e];
                    s += __shfl_xor(s, 1); s += __shfl_xor(s, 2); s += __shfl_xor(s, 4); s += __shfl_xor(s, 8);
                    if (fr == 0) atomicAdd(kmean + (size_t)u.pm * 512 + col0 + bj * 128 + e, s);
                }
        }
    }
};
struct EpiMixA {
    static constexpr bool PERM = true;
    bf16_t* GA;
    __device__ __forceinline__ void operator()(const f32x4 (&acc)[2][2][4][2], const Unit& u, int wr, int wc, int fr, int fq) const {
        const int row0 = u.pm * 256 + wr * 64 + fr, col0 = u.pn * 256 + wc * 32 + 8 * fq;
#pragma unroll
        for (int ai = 0; ai < 2; ++ai)
#pragma unroll
            for (int m = 0; m < 4; ++m) {
                bf16_t* rowp = GA + (size_t)(row0 + ai * 128 + m * 16) * 1024 + col0;
#pragma unroll
                for (int bj = 0; bj < 2; ++bj) {
                    const u32x4 g = *(const u32x4*)(rowp + bj * 128);
                    const f32x4 a0 = acc[ai][bj][m][0], a1 = acc[ai][bj][m][1];
                    u32x4 w;
                    constexpr float S = 1.0f / 32.0f;
                    w.x = cvt_pk_bf16(bf_lo(g.x) * a0[0] * S, bf_hi(g.x) * a0[1] * S); w.y = cvt_pk_bf16(bf_lo(g.y) * a0[2] * S, bf_hi(g.y) * a0[3] * S);
                    w.z = cvt_pk_bf16(bf_lo(g.z) * a1[0] * S, bf_hi(g.z) * a1[1] * S); w.w = cvt_pk_bf16(bf_lo(g.w) * a1[2] * S, bf_hi(g.w) * a1[3] * S);
                    *(u32x4*)(rowp + bj * 128) = w;
                }
            }
    }
};
struct EpiMixB {
    static constexpr bool PERM = true;
    const bf16_t* GA; const bf16_t* GB; unsigned char* M8;
    __device__ __forceinline__ void operator()(const f32x4 (&acc)[2][2][4][2], const Unit& u, int wr, int wc, int fr, int fq) const {
        const int row0 = u.pm * 256 + wr * 64 + fr, col0 = u.pn * 256 + wc * 32 + 8 * fq;
#pragma unroll
        for (int ai = 0; ai < 2; ++ai)
#pragma unroll
            for (int m = 0; m < 4; ++m) {
                const size_t off = (size_t)(row0 + ai * 128 + m * 16) * 1024 + col0;
#pragma unroll
                for (int bj = 0; bj < 2; ++bj) {
                    const u32x4 g = *(const u32x4*)(GB + off + bj * 128);
                    const u32x4 mx = *(const u32x4*)(GA + off + bj * 128);
                    const f32x4 a0 = acc[ai][bj][m][0], a1 = acc[ai][bj][m][1];
                    constexpr float S = 1.0f / 32.0f;
                    int w0 = __builtin_amdgcn_cvt_pk_fp8_f32(bf_lo(mx.x) + bf_lo(g.x) * a0[0] * S, bf_hi(mx.x) + bf_hi(g.x) * a0[1] * S, 0, false); w0 = __builtin_amdgcn_cvt_pk_fp8_f32(bf_lo(mx.y) + bf_lo(g.y) * a0[2] * S, bf_hi(mx.y) + bf_hi(g.y) * a0[3] * S, w0, true);
                    int w1 = __builtin_amdgcn_cvt_pk_fp8_f32(bf_lo(mx.z) + bf_lo(g.z) * a1[0] * S, bf_hi(mx.z) + bf_hi(g.z) * a1[1] * S, 0, false); w1 = __builtin_amdgcn_cvt_pk_fp8_f32(bf_lo(mx.w) + bf_lo(g.w) * a1[2] * S, bf_hi(mx.w) + bf_hi(g.w) * a1[3] * S, w1, true);
                    *(u32x2*)(M8 + off + bj * 128) = (u32x2){(unsigned)w0, (unsigned)w1};
                }
            }
    }
};
struct EpiOut {
    static constexpr bool PERM = true;
    const float* ada; bf16_t* D;
    __device__ __forceinline__ void operator()(const f32x4 (&acc)[2][2][4][2], const Unit& u, int wr, int wc, int fr, int fq) const {
        const int row0 = u.pm * 256 + wr * 64 + fr, col0 = u.pn * 256 + wc * 32 + 8 * fq;
        const float* gt1 = ada + (size_t)(u.pm >> 3) * 6144 + 2048 + col0;
        f32x4 g[2][2];
#pragma unroll
        for (int bj = 0; bj < 2; ++bj) { g[bj][0] = *(const f32x4*)(gt1 + bj * 128); g[bj][1] = *(const f32x4*)(gt1 + bj * 128 + 4); }
#pragma unroll
        for (int ai = 0; ai < 2; ++ai)
#pragma unroll
            for (int m = 0; m < 4; ++m) {
                bf16_t* rowp = D + (size_t)(row0 + ai * 128 + m * 16) * 1024 + col0;
#pragma unroll
                for (int bj = 0; bj < 2; ++bj) {
                    const f32x4 a0 = acc[ai][bj][m][0] * g[bj][0] * (1.0f / 32.0f), a1 = acc[ai][bj][m][1] * g[bj][1] * (1.0f / 32.0f);
                    u32x4 w; w.x = cvt_pk_bf16(a0[0], a0[1]); w.y = cvt_pk_bf16(a0[2], a0[3]); w.z = cvt_pk_bf16(a1[0], a1[1]); w.w = cvt_pk_bf16(a1[2], a1[3]);
                    *(u32x4*)(rowp + bj * 128) = w;
                }
            }
    }
};
struct EpiBf16 {
    static constexpr bool PERM = true;
    bf16_t* O;
    __device__ __forceinline__ void operator()(const f32x4 (&acc)[2][2][4][2], const Unit& u, int wr, int wc, int fr, int fq) const {
        const int row0 = u.pm * 256 + wr * 64 + fr, col0 = u.pn * 256 + wc * 32 + 8 * fq;
#pragma unroll
        for (int ai = 0; ai < 2; ++ai)
#pragma unroll
            for (int m = 0; m < 4; ++m) {
                bf16_t* rowp = O + (size_t)(row0 + ai * 128 + m * 16) * 1024 + col0;
#pragma unroll
                for (int bj = 0; bj < 2; ++bj) {
                    const f32x4 a0 = acc[ai][bj][m][0], a1 = acc[ai][bj][m][1];
                    u32x4 w; w.x = cvt_pk_bf16(a0[0], a0[1]); w.y = cvt_pk_bf16(a0[2], a0[3]); w.z = cvt_pk_bf16(a1[0], a1[1]); w.w = cvt_pk_bf16(a1[2], a1[3]);
                    *(u32x4*)(rowp + bj * 128) = w;
                }
            }
    }
};

__device__ void phase0a(const Params& P, LAS unsigned char* lds) {
    const int tid = tid_opaque(), G = gridDim.x, bid = blockIdx.x;
    for (int it = bid; it < 192; it += G) {
        LAS float* sc = (LAS float*)lds;
        for (int i = tid; i < 32 * 1024; i += NTHR) { const float cv = P.c[i]; sc[i] = cv * sigmoidf_(cv); }
        __syncthreads();
        const int kg = tid >> 5, col = tid & 31;
        float a[32];
#pragma unroll
        for (int b = 0; b < 32; ++b) a[b] = 0.f;
#pragma unroll 1
        for (int k = kg * 64; k < kg * 64 + 64; k += 8) {
            float w[8];
#pragma unroll
            for (int e = 0; e < 8; ++e) w[e] = __builtin_nontemporal_load(P.w_ada + (size_t)(k + e) * 6144 + it * 32 + col);
#pragma unroll
            for (int e4 = 0; e4 < 2; ++e4) {
#pragma unroll
                for (int b = 0; b < 32; ++b) { const f32x4 s = *(const LAS f32x4*)(sc + b * 1024 + k + 4 * e4); a[b] += s[0] * w[4 * e4] + s[1] * w[4 * e4 + 1] + s[2] * w[4 * e4 + 2] + s[3] * w[4 * e4 + 3]; }
                asm volatile("" ::: "memory");
            }
        }
        __syncthreads();
        LAS float* red = (LAS float*)lds;
#pragma unroll
        for (int b = 0; b < 32; ++b) red[(kg * 32 + b) * 32 + col] = a[b];
        __syncthreads();
        for (int o = tid; o < 1024; o += NTHR) { const int b = o >> 5, cc = o & 31; float s = 0.f;
#pragma unroll
            for (int g2 = 0; g2 < 16; ++g2) s += red[(g2 * 32 + b) * 32 + cc];
            ((float*)(P.ws + OFF_ADA))[(size_t)b * 6144 + it * 32 + cc] = s + P.b_ada[it * 32 + cc]; }
        __syncthreads();
    }
    const size_t gsz = (size_t)G * NTHR;
    { const int gt = bid * NTHR + tid, gs = G * NTHR;
      if (gt < 512) ((float*)(P.ws + OFF_LB))[gt] = sigmoidf_(P.hgrn_lb[gt] - P.hgrn_lb[512 + gt]);
      for (int i = gt; i < 32 * 8 * 512; i += gs) ((float*)(P.ws + OFF_KMEAN))[i] = 0.f; }
    {
        LAS float* tile = (LAS float*)lds;
        const int I0 = 16 * 88, I1 = I0 + 8 * 16, I2 = I1 + 8 * 16, I3 = I2 + 16 * 16, I4 = I3 + 16 * 16;
        for (int it = bid; it < I4; it += G) {
            const float* W; bf16_t* WT; int K, N, r;
            if (it < I0) { W = P.w_in; WT = (bf16_t*)(P.ws + OFF_WIN); K = 1024; N = 5632; r = it; }
            else if (it < I1) { W = P.w_ba; WT = (bf16_t*)(P.ws + OFF_WBA); K = 512; N = 1024; r = it - I0; }
            else if (it < I2) { W = P.w_bb; WT = (bf16_t*)(P.ws + OFF_WBB); K = 512; N = 1024; r = it - I1; }
            else if (it < I3) { W = P.w_out; WT = (bf16_t*)(P.ws + OFF_WOUT); K = 1024; N = 1024; r = it - I2; }
            else { W = P.peer_wq; WT = (bf16_t*)(P.ws + OFF_WQ); K = 1024; N = 1024; r = it - I3; }
            const int nb = N / 64, k0 = (r / nb) * 64, n0 = (r % nb) * 64;
#pragma unroll
            for (int ps = 0; ps < 2; ++ps) { const int kk = (tid >> 4) + 32 * ps, n4 = (tid & 15) * 4;
                const f32x4 v = *(const f32x4*)(W + (size_t)(k0 + kk) * N + n0 + n4);
                tile[kk * 65 + n4] = v[0]; tile[kk * 65 + n4 + 1] = v[1]; tile[kk * 65 + n4 + 2] = v[2]; tile[kk * 65 + n4 + 3] = v[3]; }
            __syncthreads();
            { const int n = tid >> 3, kc = (tid & 7) * 8;
              if (it < I3) {
                  int w0 = __builtin_amdgcn_cvt_pk_fp8_f32(32.f * tile[(kc + 0) * 65 + n], 32.f * tile[(kc + 1) * 65 + n], 0, false); w0 = __builtin_amdgcn_cvt_pk_fp8_f32(32.f * tile[(kc + 2) * 65 + n], 32.f * tile[(kc + 3) * 65 + n], w0, true);
                  int w1 = __builtin_amdgcn_cvt_pk_fp8_f32(32.f * tile[(kc + 4) * 65 + n], 32.f * tile[(kc + 5) * 65 + n], 0, false); w1 = __builtin_amdgcn_cvt_pk_fp8_f32(32.f * tile[(kc + 6) * 65 + n], 32.f * tile[(kc + 7) * 65 + n], w1, true);
                  *(u32x2*)((unsigned char*)WT + (size_t)(n0 + n) * K + k0 + kc) = (u32x2){(unsigned)w0, (unsigned)w1};
              } else { u32x4 w;
              w.x = cvt_pk_bf16(tile[(kc + 0) * 65 + n], tile[(kc + 1) * 65 + n]); w.y = cvt_pk_bf16(tile[(kc + 2) * 65 + n], tile[(kc + 3) * 65 + n]);
              w.z = cvt_pk_bf16(tile[(kc + 4) * 65 + n], tile[(kc + 5) * 65 + n]); w.w = cvt_pk_bf16(tile[(kc + 6) * 65 + n], tile[(kc + 7) * 65 + n]);
              *(u32x4*)(WT + (size_t)(n0 + n) * K + k0 + kc) = w; } }
            __syncthreads();
        }
    }
    {
        const size_t gtid = (size_t)bid * NTHR + tid_opaque();
        for (size_t i = gtid; i < 16384; i += gsz) {
            const float* src = P.peer_sk + i * 8; const f32x4 a = *(const f32x4*)src, b = *(const f32x4*)(src + 4);
            u32x4 w; w.x = cvt_pk_bf16(a[0], a[1]); w.y = cvt_pk_bf16(a[2], a[3]); w.z = cvt_pk_bf16(b[0], b[1]); w.w = cvt_pk_bf16(b[2], b[3]);
            *(u32x4*)((bf16_t*)(P.ws + OFF_SK) + i * 8) = w;
        }
        { const int lane = tid & 63, gw = bid * 8 + (tid >> 6), ngw = G * 8;
          for (int r = gw; r < 2 * 16384; r += ngw) {
              const bool isv = r >= 16384; const int e = isv ? r - 16384 : r;
              const float* s = (isv ? P.peer_v : P.peer_u) + (size_t)e * 1024 + lane * 16;
              f32x4 x[4]; float ss = 0.f;
#pragma unroll
              for (int q = 0; q < 4; ++q) { x[q] = __builtin_nontemporal_load((const f32x4*)(s + 4 * q)); ss += (x[q][0] * x[q][0] + x[q][1] * x[q][1]) + (x[q][2] * x[q][2] + x[q][3] * x[q][3]); }
              const float sc = fmaxf(sqrtf(wave_sum(ss) * (1.0f / 1024.0f)) * (2.6f / 7.5f), 1e-30f), inv = 1.0f / sc;
              unsigned nb[16];
#pragma unroll
              for (int q = 0; q < 4; ++q)
#pragma unroll
                  for (int el = 0; el < 4; ++el) nb[4 * q + el] = (unsigned)fminf(fmaxf(floorf(x[q][el] * inv) + 8.0f, 0.0f), 15.0f);
              u32x2 w;
              w.x = (nb[0] | (nb[4] << 4)) | ((nb[1] | (nb[5] << 4)) << 8) | ((nb[2] | (nb[6] << 4)) << 16) | ((nb[3] | (nb[7] << 4)) << 24);
              w.y = (nb[8] | (nb[12] << 4)) | ((nb[9] | (nb[13] << 4)) << 8) | ((nb[10] | (nb[14] << 4)) << 16) | ((nb[11] | (nb[15] << 4)) << 24);
              if (!isv) { w.x ^= 0x88888888u; w.y ^= 0x88888888u; }
              else { w.x ^= 0x80808080u; w.y ^= 0x80808080u; }
              *(u32x2*)(P.ws + (isv ? OFF_V8 : OFF_U8) + (size_t)e * 512 + lane * 8) = w;
              if (lane == 0) ((float*)(P.ws + (isv ? OFF_VSC : OFF_USC)))[e] = sc;
          } }
    }
}
__device__ void phase0b(const Params& P) {
    const size_t gtid = (size_t)blockIdx.x * NTHR + threadIdx.x, gsz = (size_t)gridDim.x * NTHR;
    const float* ada = (const float*)(P.ws + OFF_ADA); bf16_t* H = (bf16_t*)(P.ws + OFF_H);
    for (size_t i = gtid; i < (size_t)NTOK * 128; i += gsz) {
        const size_t row = i >> 7; const int c8 = (int)(i & 127) * 8; const int b = (int)(row >> 11);
        const float* xr = P.x + row * 1024 + c8; const float* sh = ada + (size_t)b * 6144 + c8; const float* sc = sh + 1024;
        const f32x4 x0 = *(const f32x4*)xr, x1 = *(const f32x4*)(xr + 4), s0 = *(const f32x4*)sc, s1 = *(const f32x4*)(sc + 4), h0 = *(const f32x4*)sh, h1 = *(const f32x4*)(sh + 4);
        const f32x4 r0 = x0 * (s0 + 1.0f) + h0, r1 = x1 * (s1 + 1.0f) + h1;
        int w0 = __builtin_amdgcn_cvt_pk_fp8_f32(r0[0], r0[1], 0, false); w0 = __builtin_amdgcn_cvt_pk_fp8_f32(r0[2], r0[3], w0, true);
        int w1 = __builtin_amdgcn_cvt_pk_fp8_f32(r1[0], r1[1], 0, false); w1 = __builtin_amdgcn_cvt_pk_fp8_f32(r1[2], r1[3], w1, true);
        *(u32x2*)((unsigned char*)H + row * 1024 + c8) = (u32x2){(unsigned)w0, (unsigned)w1};
    }
}

__device__ __forceinline__ s16x4 tr4(const LAS unsigned char* p) { return __builtin_bit_cast(s16x4, __builtin_amdgcn_ds_read_tr16_b64_v4i16((LAS s16x4*)p)); }
__device__ void hgrn_item(const Params& P, int item, LAS unsigned char* lds) {
    const int tid = tid_opaque(), lane = tid & 63, wid = __builtin_amdgcn_readfirstlane(tid >> 6), r32 = lane & 31, hi = lane >> 5;
    const int b = item >> 3, h = (item >> 1) & 3, vh = item & 1;
    const bf16_t* HQ = (const bf16_t*)(P.ws + OFF_HQ); const bf16_t* HK = (const bf16_t*)(P.ws + OFF_HK); bf16_t* HI = (bf16_t*)(P.ws + OFF_HI);
    constexpr int SQ = 272, SKD = 320, SV = 192, SS = 192;
    constexpr int LQR = 0, LKR = 17408, LQB = 34816, LKD = 52224, LV = 72704, LS = 84992, LG = 109568, LT = 142336, LCL = 144384;
    LAS float* G = (LAS float*)(lds + LG); LAS float* TOT = (LAS float*)(lds + LT); LAS float* CL = (LAS float*)(lds + LCL);
    const size_t rowb = (size_t)b * SEQ;
    const int row = tid >> 3, seg = tid & 7;
    const bf16_t* qsrc = HQ + (rowb + row) * 512 + h * 128 + seg * 16; const bf16_t* ksrc = HK + (rowb + row) * 512 + h * 128 + seg * 16;
    bf16_t* vsrc = HI + (rowb + row) * 512 + h * 128 + vh * 64 + seg * 8;
    for (int i = tid; i < 128 * SS / 4; i += NTHR) ((LAS unsigned*)(lds + LS))[i] = 0u;
    f32x16 Sacc = {};
    const int di = wid >> 1, vi = wid & 1, ti = wid >> 1;
    const int tg = lane >> 4, tc = tg & 1, tI = lane & 15;
    const int trow = 4 * hi + (tI >> 2), tcol = 16 * tc + 4 * (tI & 3);
    u32x4 qn0 = *(const u32x4*)qsrc, qn1 = *(const u32x4*)(qsrc + 8), kn0 = *(const u32x4*)ksrc, kn1 = *(const u32x4*)(ksrc + 8), vn = *(const u32x4*)vsrc;
#pragma unroll 1
    for (int n = 0; n < SEQ / 64; ++n) {
        const u32x4 q0 = qn0, q1 = qn1, k0 = kn0, k1 = kn1, vv = vn;
        float qf[16] = {bf_lo(q0.x), bf_hi(q0.x), bf_lo(q0.y), bf_hi(q0.y), bf_lo(q0.z), bf_hi(q0.z), bf_lo(q0.w), bf_hi(q0.w), bf_lo(q1.x), bf_hi(q1.x), bf_lo(q1.y), bf_hi(q1.y), bf_lo(q1.z), bf_hi(q1.z), bf_lo(q1.w), bf_hi(q1.w)};
        float kf[16] = {bf_lo(k0.x), bf_hi(k0.x), bf_lo(k0.y), bf_hi(k0.y), bf_lo(k0.z), bf_hi(k0.z), bf_lo(k0.w), bf_hi(k0.w), bf_lo(k1.x), bf_hi(k1.x), bf_lo(k1.y), bf_hi(k1.y), bf_lo(k1.z), bf_hi(k1.z), bf_lo(k1.w), bf_hi(k1.w)};
#pragma unroll
        for (int e4 = 0; e4 < 4; ++e4) *(LAS f32x4*)(G + row * 128 + seg * 16 + 4 * e4) = (f32x4){__logf(1.0f - kf[4 * e4]), __logf(1.0f - kf[4 * e4 + 1]), __logf(1.0f - kf[4 * e4 + 2]), __logf(1.0f - kf[4 * e4 + 3])};
        *(LAS u32x4*)(lds + LV + row * SV + seg * 16) = vv;
        if (n + 1 < SEQ / 64) { const size_t o = (size_t)(n + 1) * 64 * 512; qn0 = *(const u32x4*)(qsrc + o); qn1 = *(const u32x4*)(qsrc + o + 8); kn0 = *(const u32x4*)(ksrc + o); kn1 = *(const u32x4*)(ksrc + o + 8); vn = *(const u32x4*)(vsrc + o); }
        __syncthreads();
        { const int d = tid & 127, q4 = tid >> 7; float s = 0.f;
#pragma unroll
          for (int i = 0; i < 16; ++i) { s += G[(16 * q4 + i) * 128 + d]; G[(16 * q4 + i) * 128 + d] = s; }
          TOT[q4 * 128 + d] = s; }
        __syncthreads();
        {
            const int qq = row >> 4;
#pragma unroll
            for (int e4 = 0; e4 < 4; ++e4) {
                const int d4 = seg * 16 + 4 * e4;
                const f32x4 t0 = *(const LAS f32x4*)(TOT + d4), t1 = *(const LAS f32x4*)(TOT + 128 + d4), t2 = *(const LAS f32x4*)(TOT + 256 + d4), t3 = *(const LAS f32x4*)(TOT + 384 + d4);
                const f32x4 off = (qq == 0) ? (f32x4){0.f, 0.f, 0.f, 0.f} : ((qq == 1) ? t0 : ((qq == 2) ? t0 + t1 : t0 + t1 + t2));
                const f32x4 bb = *(const LAS f32x4*)(G + row * 128 + d4) + off;
                const f32x4 bref = *(const LAS f32x4*)(G + 32 * 128 + d4) + t0 + t1, blast = t0 + t1 + t2 + t3;
                float vqb[4], vqr[4], vkr[4], vkd[4];
#pragma unroll
                for (int e = 0; e < 4; ++e) {
                    const float e1 = __expf(bb[e]), e2 = __expf(-bb[e]);
                    vqb[e] = qf[4 * e4 + e] * e1; vqr[e] = vqb[e] * __expf(-bref[e]);
                    const float ke = kf[4 * e4 + e] * e2; vkr[e] = ke * __expf(bref[e]); vkd[e] = ke * __expf(blast[e]);
                }
                *(LAS u32x2*)(lds + LQB + row * SQ + seg * 32 + 8 * e4) = (u32x2){cvt_pk_bf16(vqb[0], vqb[1]), cvt_pk_bf16(vqb[2], vqb[3])};
                *(LAS u32x2*)(lds + LQR + row * SQ + seg * 32 + 8 * e4) = (u32x2){cvt_pk_bf16(vqr[0], vqr[1]), cvt_pk_bf16(vqr[2], vqr[3])};
                *(LAS u32x2*)(lds + LKR + row * SQ + seg * 32 + 8 * e4) = (u32x2){cvt_pk_bf16(vkr[0], vkr[1]), cvt_pk_bf16(vkr[2], vkr[3])};
                *(LAS u32x2*)(lds + LKD + row * SKD + seg * 32 + 8 * e4) = (u32x2){cvt_pk_bf16(vkd[0], vkd[1]), cvt_pk_bf16(vkd[2], vkd[3])};
                if (row == 0) *(LAS f32x4*)(CL + d4) = (f32x4){__expf(blast[0]), __expf(blast[1]), __expf(blast[2]), __expf(blast[3])};
                asm volatile("" ::: "memory");
            }
        }
        __syncthreads();
        if (wid < 4) {
            f32x16 Z = {};
            for (int si = 0; si <= ti; ++si) {
                f32x16 X = {};
#pragma unroll
                for (int ks = 0; ks < 8; ++ks) {
                    const bf16x8 a = *(const LAS bf16x8*)(lds + LKR + (32 * si + r32) * SQ + (16 * ks + 8 * hi) * 2);
                    const bf16x8 bq = *(const LAS bf16x8*)(lds + LQR + (32 * ti + r32) * SQ + (16 * ks + 8 * hi) * 2);
                    X = MFMA32(a, bq, X);
                }
                if (si == ti) {
#pragma unroll
                    for (int r = 0; r < 16; ++r) if (crow(r, hi) > r32) X[r] = 0.f;
                }
#pragma unroll
                for (int s2 = 0; s2 < 2; ++s2) {
                    union { u32x4 u; bf16x8 v; } pa;
                    pa.u.x = cvt_pk_bf16(X[8 * s2 + 0], X[8 * s2 + 1]); pa.u.y = cvt_pk_bf16(X[8 * s2 + 2], X[8 * s2 + 3]); pa.u.z = cvt_pk_bf16(X[8 * s2 + 4], X[8 * s2 + 5]); pa.u.w = cvt_pk_bf16(X[8 * s2 + 6], X[8 * s2 + 7]);
                    const LAS unsigned char* vp = lds + LV + (32 * si + 16 * s2 + trow) * SV + (32 * vi + tcol) * 2;
                    const s16x4 lo = tr4(vp), hh = tr4(vp + 8 * SV);
                    const bf16x8 vf = {lo[0], lo[1], lo[2], lo[3], hh[0], hh[1], hh[2], hh[3]};
                    Z = MFMA32(pa.v, vf, Z);
                }
            }
#pragma unroll
            for (int ks = 0; ks < 8; ++ks) {
                const bf16x8 a = *(const LAS bf16x8*)(lds + LQB + (32 * ti + r32) * SQ + (16 * ks + 8 * hi) * 2);
                const LAS unsigned char* sp = lds + LS + (16 * ks + 8 * hi + (tI >> 2)) * SS + (32 * vi + tcol) * 2;
                const s16x4 lo = tr4(sp), hh = tr4(sp + 4 * SS);
                const bf16x8 sf = {lo[0], lo[1], lo[2], lo[3], hh[0], hh[1], hh[2], hh[3]};
                Z = MFMA32(a, sf, Z);
            }
            bf16_t* op = HI + (rowb + (size_t)n * 64 + 32 * ti) * 512 + h * 128 + vh * 64 + 32 * vi + r32;
#pragma unroll
            for (int r = 0; r < 16; ++r) op[(size_t)crow(r, hi) * 512] = (bf16_t)(cvt_pk_bf16(Z[r], 0.f) & 0xffffu);
        }
        {
#pragma unroll
            for (int r = 0; r < 16; ++r) Sacc[r] *= CL[32 * di + crow(r, hi)];
#pragma unroll
            for (int ks = 0; ks < 4; ++ks) {
                const LAS unsigned char* kp = lds + LKD + (16 * ks + 8 * hi + (tI >> 2)) * SKD + (32 * di + tcol) * 2;
                const s16x4 klo = tr4(kp), khi = tr4(kp + 4 * SKD);
                const bf16x8 ka = {klo[0], klo[1], klo[2], klo[3], khi[0], khi[1], khi[2], khi[3]};
                const LAS unsigned char* vp = lds + LV + (16 * ks + 8 * hi + (tI >> 2)) * SV + (32 * vi + tcol) * 2;
                const s16x4 vlo = tr4(vp), vhi = tr4(vp + 4 * SV);
                const bf16x8 vb = {vlo[0], vlo[1], vlo[2], vlo[3], vhi[0], vhi[1], vhi[2], vhi[3]};
                Sacc = MFMA32(ka, vb, Sacc);
            }
        }
        __syncthreads();
        {
            LAS bf16_t* sp = (LAS bf16_t*)(lds + LS + (32 * di) * SS + (32 * vi + r32) * 2);
#pragma unroll
            for (int r = 0; r < 16; ++r) sp[crow(r, hi) * (SS / 2)] = (bf16_t)(cvt_pk_bf16(Sacc[r], 0.f) & 0xffffu);
        }
    }
    __syncthreads();
}

__device__ void moba_unit(const Params& P, int b, int h, int j, LAS unsigned char* lds) {
    const int tid = tid_opaque(), lane = tid & 63, wid = tid >> 6, r32 = lane & 31, hi = lane >> 5;
    bf16_t* Q = (bf16_t*)(P.ws + OFF_QA); const bf16_t* Kg = (const bf16_t*)(P.ws + OFF_KA); const bf16_t* Vg = (const bf16_t*)(P.ws + OFF_VA);
    const float* kmean = (const float*)(P.ws + OFF_KMEAN);
    constexpr int KIMG = 64 * 144, VIMG = 64 * 192, LK = 0, LV = 4 * KIMG, LKM = 4 * KIMG + 4 * VIMG;
    LAS float* kmL = (LAS float*)(lds + LKM);
    const size_t rowb = (size_t)b * SEQ; const int q0 = j * 256;
    if (tid < j * 64) kmL[tid] = kmean[(size_t)(b * 8 + (tid >> 6)) * 512 + h * 64 + (tid & 63)];
    bf16_t* qrow = Q + (rowb + q0 + wid * 32 + r32) * 512 + h * 64;
    bf16x8 qf[4];
#pragma unroll
    for (int d0 = 0; d0 < 4; ++d0) qf[d0] = *(const bf16x8*)(qrow + 16 * d0 + 8 * hi);
    const int srow = tid >> 3, sch = tid & 7;
    const bf16_t* ksrc = Kg + (rowb + srow) * 512 + h * 64 + sch * 8; const bf16_t* vsrc = Vg + (rowb + srow) * 512 + h * 64 + sch * 8;
    const int ntile = 4 * (j + 1), npair = ntile >> 1;
    auto tile_key0 = [&](int i) -> size_t { const int blk = (i < 4) ? j : ((i - 4) >> 2), kt = (i < 4) ? i : ((i - 4) & 3); return (size_t)(blk * 256 + kt * 64); };
    u32x4 kreg[2], vreg[2];
#pragma unroll
    for (int s = 0; s < 2; ++s) { const size_t k0 = tile_key0(s); kreg[s] = *(const u32x4*)(ksrc + k0 * 512); vreg[s] = *(const u32x4*)(vsrc + k0 * 512); }
#pragma unroll
    for (int s = 0; s < 2; ++s) { *(LAS u32x4*)(lds + LK + s * KIMG + srow * 144 + sch * 16) = kreg[s]; *(LAS u32x4*)(lds + LV + s * VIMG + srow * 192 + sch * 16) = vreg[s]; }
    __syncthreads();
    unsigned sel = 0;
    if (j <= 3) sel = (1u << j) - 1u;
    else {
        float g[7];
#pragma unroll
        for (int n = 0; n < 7; ++n) { float s = 0.f;
            if (n < j) {
#pragma unroll
                for (int d0 = 0; d0 < 4; ++d0)
#pragma unroll
                    for (int e = 0; e < 8; ++e) s += __uint_as_float(((unsigned)(unsigned short)qf[d0][e]) << 16) * kmL[n * 64 + 16 * d0 + 8 * hi + e];
            }
            s += __shfl_xor(s, 32); g[n] = s; }
#pragma unroll
        for (int it = 0; it < 3; ++it) { float best = -INFINITY; int bi = 0;
#pragma unroll
            for (int n = 0; n < 7; ++n) if (n < j && !((sel >> n) & 1u) && g[n] > best) { best = g[n]; bi = n; }
            sel |= 1u << bi; }
    }
    const float ch = exp2f(-(float)(h + 1)) * LOG2E;
    const int qb = wid * 32 + r32;
    float m_run = -1e30f, l_run = 0.f;
    f32x16 o0 = {}, o1 = {};
    const int tg = lane >> 4, tc = tg & 1, ti = lane & 15;
    const int vlane = (4 * hi + (ti >> 2)) * 192 + (16 * tc + 4 * (ti & 3)) * 2;
#pragma unroll 1
    for (int ip = 0; ip < npair; ++ip) {
      const int pbuf = ip & 1;
      if (ip + 1 < npair) {
#pragma unroll
          for (int s = 0; s < 2; ++s) { const size_t k1 = tile_key0(2 * ip + 2 + s); kreg[s] = *(const u32x4*)(ksrc + k1 * 512); vreg[s] = *(const u32x4*)(vsrc + k1 * 512); }
      }
#pragma unroll
      for (int s2 = 0; s2 < 2; ++s2) {
        const int i = 2 * ip + s2, buf = pbuf * 2 + s2;
        const bool own = i < 4; const int blk = own ? j : ((i - 4) >> 2), kt = own ? i : ((i - 4) & 3);
        const bool lane_ok = own ? true : (((sel >> blk) & 1u) != 0u);
        const bool skip = own ? (64 * kt > 32 * wid + 31) : (__ballot(lane_ok) == 0ull);
        if (!skip) {
            LAS unsigned char* kb = lds + LK + buf * KIMG; LAS unsigned char* vb = lds + LV + buf * VIMG;
            f32x16 p0 = {}, p1 = {};
#pragma unroll
            for (int d0 = 0; d0 < 4; ++d0) {
                const bf16x8 kf0 = *(const LAS bf16x8*)(kb + r32 * 144 + (16 * d0 + 8 * hi) * 2);
                const bf16x8 kf1 = *(const LAS bf16x8*)(kb + (32 + r32) * 144 + (16 * d0 + 8 * hi) * 2);
                p0 = MFMA32(kf0, qf[d0], p0); p1 = MFMA32(kf1, qf[d0], p1);
            }
            const float kbase = ch * (float)((blk - j) * 256 + kt * 64);
            float mt = -1e30f;
#pragma unroll
            for (int r = 0; r < 16; ++r) {
                const int kl0 = crow(r, hi), kl1 = kl0 + 32;
                p0[r] = __builtin_fmaf(ch, (float)kl0, p0[r]); p1[r] = __builtin_fmaf(ch, (float)kl1, p1[r]);
                if (own) { if (kt * 64 + kl0 > qb) p0[r] = -1e30f; if (kt * 64 + kl1 > qb) p1[r] = -1e30f; }
                mt = fmaxf(mt, fmaxf(p0[r], p1[r]));
            }
            mt = lane_ok ? mt + kbase : -1e30f;
            mt = fmaxf(mt, __shfl_xor(mt, 32));
            if (__ballot(mt > m_run) != 0ull) {
                const float mnew = fmaxf(m_run, mt), alpha = __builtin_amdgcn_exp2f(m_run - mnew);
                m_run = mnew; l_run *= alpha;
#pragma unroll
                for (int r = 0; r < 16; ++r) { o0[r] *= alpha; o1[r] *= alpha; }
            }
            const float sh = lane_ok ? kbase - m_run : -1e30f;
            float rs = 0.f;
#pragma unroll
            for (int r = 0; r < 16; ++r) { p0[r] = __builtin_amdgcn_exp2f(p0[r] + sh); p1[r] = __builtin_amdgcn_exp2f(p1[r] + sh); rs += p0[r] + p1[r]; }
            l_run += rs;
#pragma unroll
            for (int sub = 0; sub < 2; ++sub)
#pragma unroll
                for (int s = 0; s < 2; ++s) {
                    union { u32x4 u; bf16x8 v; } pb;
                    if (sub == 0) { pb.u.x = cvt_pk_bf16(p0[8 * s + 0], p0[8 * s + 1]); pb.u.y = cvt_pk_bf16(p0[8 * s + 2], p0[8 * s + 3]); pb.u.z = cvt_pk_bf16(p0[8 * s + 4], p0[8 * s + 5]); pb.u.w = cvt_pk_bf16(p0[8 * s + 6], p0[8 * s + 7]); }
                    else { pb.u.x = cvt_pk_bf16(p1[8 * s + 0], p1[8 * s + 1]); pb.u.y = cvt_pk_bf16(p1[8 * s + 2], p1[8 * s + 3]); pb.u.z = cvt_pk_bf16(p1[8 * s + 4], p1[8 * s + 5]); pb.u.w = cvt_pk_bf16(p1[8 * s + 6], p1[8 * s + 7]); }
#pragma unroll
                    for (int dt = 0; dt < 2; ++dt) {
                        LAS unsigned char* va = vb + (32 * sub + 16 * s) * 192 + dt * 64 + vlane;
                        const s16x4 lo = __builtin_bit_cast(s16x4, __builtin_amdgcn_ds_read_tr16_b64_v4i16((LAS s16x4*)va));
                        const s16x4 hh = __builtin_bit_cast(s16x4, __builtin_amdgcn_ds_read_tr16_b64_v4i16((LAS s16x4*)(va + 8 * 192)));
                        const bf16x8 vf = {lo[0], lo[1], lo[2], lo[3], hh[0], hh[1], hh[2], hh[3]};
                        if (dt == 0) o0 = MFMA32(vf, pb.v, o0); else o1 = MFMA32(vf, pb.v, o1);
                    }
                }
        }
      }
      if (ip + 1 < npair) { const int nb = (pbuf ^ 1) * 2;
#pragma unroll
          for (int s = 0; s < 2; ++s) { *(LAS u32x4*)(lds + LK + (nb + s) * KIMG + srow * 144 + sch * 16) = kreg[s]; *(LAS u32x4*)(lds + LV + (nb + s) * VIMG + srow * 192 + sch * 16) = vreg[s]; } }
      __syncthreads();
    }
    l_run += __shfl_xor(l_run, 32);
    const float inv = 1.0f / l_run;
#pragma unroll
    for (int r4 = 0; r4 < 4; ++r4) {
        int w0 = __builtin_amdgcn_cvt_pk_fp8_f32(o0[4 * r4] * inv, o0[4 * r4 + 1] * inv, 0, false); w0 = __builtin_amdgcn_cvt_pk_fp8_f32(o0[4 * r4 + 2] * inv, o0[4 * r4 + 3] * inv, w0, true);
        int w1 = __builtin_amdgcn_cvt_pk_fp8_f32(o1[4 * r4] * inv, o1[4 * r4 + 1] * inv, 0, false); w1 = __builtin_amdgcn_cvt_pk_fp8_f32(o1[4 * r4 + 2] * inv, o1[4 * r4 + 3] * inv, w1, true);
        unsigned char* yrow = P.ws + OFF_EG + (rowb + q0 + wid * 32 + r32) * 1024 + h * 64;
        *(int*)(yrow + 8 * r4 + 4 * hi) = w0; *(int*)(yrow + 32 + 8 * r4 + 4 * hi) = w1;
    }
}

__device__ void yb_norm_panel(const Params& P, int pm) {
    const int tid = tid_opaque(), lane = tid & 63, wid = tid >> 6;
    bf16_t* HI = (bf16_t*)(P.ws + OFF_HI); const bf16_t* HG = (const bf16_t*)(P.ws + OFF_HG);
    for (int r = 0; r < 32; ++r) {
        const size_t off = ((size_t)pm * 256 + wid * 32 + r) * 512 + lane * 8;
        const u32x4 ov = *(const u32x4*)(HI + off), gv = *(const u32x4*)(HG + off);
        float o[8] = {bf_lo(ov.x), bf_hi(ov.x), bf_lo(ov.y), bf_hi(ov.y), bf_lo(ov.z), bf_hi(ov.z), bf_lo(ov.w), bf_hi(ov.w)};
        const float g[8] = {bf_lo(gv.x), bf_hi(gv.x), bf_lo(gv.y), bf_hi(gv.y), bf_lo(gv.z), bf_hi(gv.z), bf_lo(gv.w), bf_hi(gv.w)};
        float ss = 0.f;
#pragma unroll
        for (int e = 0; e < 8; ++e) ss += o[e] * o[e];
        ss += __shfl_xor(ss, 1); ss += __shfl_xor(ss, 2); ss += __shfl_xor(ss, 4); ss += __shfl_xor(ss, 8);
        const float rs = rsqrtf(ss * (1.0f / 128.0f) + RMS_EPS);
        int w0 = __builtin_amdgcn_cvt_pk_fp8_f32(o[0] * rs * g[0], o[1] * rs * g[1], 0, false); w0 = __builtin_amdgcn_cvt_pk_fp8_f32(o[2] * rs * g[2], o[3] * rs * g[3], w0, true);
        int w1 = __builtin_amdgcn_cvt_pk_fp8_f32(o[4] * rs * g[4], o[5] * rs * g[5], 0, false); w1 = __builtin_amdgcn_cvt_pk_fp8_f32(o[6] * rs * g[6], o[7] * rs * g[7], w1, true);
        *(u32x2*)(P.ws + OFF_EG + ((size_t)pm * 256 + wid * 32 + r) * 1024 + 512 + lane * 8) = (u32x2){(unsigned)w0, (unsigned)w1};
    }
}
__device__ void ln1_panel(const Params& P, int pm) {
    const int tid = tid_opaque(), lane = tid & 63, wid = tid >> 6;
    const float* ada = (const float*)(P.ws + OFF_ADA) + (size_t)(pm >> 3) * 6144; bf16_t* H = (bf16_t*)(P.ws + OFF_H);
    for (int r = 0; r < 32; ++r) {
        const size_t row = (size_t)pm * 256 + wid * 32 + r;
        float* xr = P.out + row * 1024 + lane * 4; const float* xin = P.x + row * 1024 + lane * 4; const bf16_t* dl = (const bf16_t*)(P.ws + OFF_GB) + row * 1024 + lane * 4;
        f32x4 v[4]; float s = 0.f;
#pragma unroll
        for (int jx = 0; jx < 4; ++jx) { const u32x2 dv = *(const u32x2*)(dl + 256 * jx); const f32x4 xv = __builtin_nontemporal_load((const f32x4*)(xin + 256 * jx));
            v[jx] = xv * ALPHA + (f32x4){bf_lo(dv.x), bf_hi(dv.x), bf_lo(dv.y), bf_hi(dv.y)}; s += (v[jx][0] + v[jx][1]) + (v[jx][2] + v[jx][3]); }
        const float mean = wave_sum(s) * (1.0f / 1024.0f); float s2 = 0.f;
#pragma unroll
        for (int jx = 0; jx < 4; ++jx) { v[jx] = v[jx] - mean; s2 += (v[jx][0] * v[jx][0] + v[jx][1] * v[jx][1]) + (v[jx][2] * v[jx][2] + v[jx][3] * v[jx][3]); }
        const float rstd = rsqrtf(wave_sum(s2) * (1.0f / 1024.0f) + LN_EPS);
#pragma unroll
        for (int jx = 0; jx < 4; ++jx) {
            const int c = lane * 4 + 256 * jx;
            const f32x4 g = *(const f32x4*)(P.ln1_g + c), bb = *(const f32x4*)(P.ln1_b + c), sh = *(const f32x4*)(ada + 3072 + c), sc = *(const f32x4*)(ada + 4096 + c);
            const f32x4 x1 = v[jx] * rstd * g + bb;
            *(f32x4*)(xr + 256 * jx) = x1;
            const f32x4 h2 = x1 * (sc + 1.0f) + sh;
            u32x2 w; w.x = cvt_pk_bf16(h2[0], h2[1]); w.y = cvt_pk_bf16(h2[2], h2[3]);
            *(u32x2*)(H + row * 1024 + c) = w;
            v[jx] = h2;
        }
        {
            float mx = 0.f;
#pragma unroll
            for (int jx = 0; jx < 4; ++jx) mx = fmaxf(mx, fmaxf(fmaxf(fabsf(v[jx][0]), fabsf(v[jx][1])), fmaxf(fabsf(v[jx][2]), fabsf(v[jx][3]))));
#pragma unroll
            for (int o = 1; o < 64; o <<= 1) mx = fmaxf(mx, __shfl_xor(mx, o));
            const float hs = fmaxf(mx * (1.0f / 119.0f), 1e-30f), inv = 1.0f / hs; int qs = 0;
            const int nsh = (lane & 1) * 4;
#pragma unroll
            for (int jx = 0; jx < 4; ++jx) {
                unsigned pa = 0u, pb = 0u;
#pragma unroll
                for (int k = 0; k < 4; ++k) { const int q = (int)rintf(v[jx][k] * inv); qs += q;
                    const int b = ((q + 8) & 15) - 8, a = (q - b) >> 4;
                    pa |= (unsigned)(a & 15) << (8 * k + nsh); pb |= (unsigned)(b & 15) << (8 * k + nsh); }
                pa |= __shfl_xor(pa, 1); pb |= __shfl_xor(pb, 1);
                if (!(lane & 1)) { unsigned* hp4 = (unsigned*)(P.ws + OFF_H8 + row * 1024) + (lane >> 1) + 32 * jx; hp4[0] = pa; hp4[128] = pb; }
            }
#pragma unroll
            for (int o = 1; o < 64; o <<= 1) qs += __shfl_xor(qs, o);
            if (lane == 0) *(f32x2*)(P.ws + OFF_HS + row * 8) = (f32x2){hs, (float)qs};
        }
    }
}

#define CE16(A, i, j) do { const float hi_ = fmaxf(A[i], A[j]); A[j] = fminf(A[i], A[j]); A[i] = hi_; } while (0)
#define SORT16(A) do { CE16(A, 0, 1); CE16(A, 2, 3); CE16(A, 0, 2); CE16(A, 1, 3); CE16(A, 1, 2); CE16(A, 4, 5); CE16(A, 6, 7); CE16(A, 4, 6); CE16(A, 5, 7); CE16(A, 5, 6); CE16(A, 0, 4); CE16(A, 2, 6); CE16(A, 2, 4); CE16(A, 1, 5); CE16(A, 3, 7); CE16(A, 3, 5); CE16(A, 1, 2); CE16(A, 3, 4); CE16(A, 5, 6); CE16(A, 8, 9); CE16(A, 10, 11); CE16(A, 8, 10); CE16(A, 9, 11); CE16(A, 9, 10); CE16(A, 12, 13); CE16(A, 14, 15); CE16(A, 12, 14); CE16(A, 13, 15); CE16(A, 13, 14); CE16(A, 8, 12); CE16(A, 10, 14); CE16(A, 10, 12); CE16(A, 9, 13); CE16(A, 11, 15); CE16(A, 11, 13); CE16(A, 9, 10); CE16(A, 11, 12); CE16(A, 13, 14); CE16(A, 0, 8); CE16(A, 4, 12); CE16(A, 4, 8); CE16(A, 2, 10); CE16(A, 6, 14); CE16(A, 6, 10); CE16(A, 2, 4); CE16(A, 6, 8); CE16(A, 10, 12); CE16(A, 1, 9); CE16(A, 5, 13); CE16(A, 5, 9); CE16(A, 3, 11); CE16(A, 7, 15); CE16(A, 7, 11); CE16(A, 3, 5); CE16(A, 7, 9); CE16(A, 11, 13); CE16(A, 1, 2); CE16(A, 3, 4); CE16(A, 5, 6); CE16(A, 7, 8); CE16(A, 9, 10); CE16(A, 11, 12); CE16(A, 13, 14); } while (0)
#define BITONIC16(A) do { CE16(A, 0, 8); CE16(A, 1, 9); CE16(A, 2, 10); CE16(A, 3, 11); CE16(A, 4, 12); CE16(A, 5, 13); CE16(A, 6, 14); CE16(A, 7, 15); CE16(A, 0, 4); CE16(A, 1, 5); CE16(A, 2, 6); CE16(A, 3, 7); CE16(A, 8, 12); CE16(A, 9, 13); CE16(A, 10, 14); CE16(A, 11, 15); CE16(A, 0, 2); CE16(A, 1, 3); CE16(A, 4, 6); CE16(A, 5, 7); CE16(A, 8, 10); CE16(A, 9, 11); CE16(A, 12, 14); CE16(A, 13, 15); CE16(A, 0, 1); CE16(A, 2, 3); CE16(A, 4, 5); CE16(A, 6, 7); CE16(A, 8, 9); CE16(A, 10, 11); CE16(A, 12, 13); CE16(A, 14, 15); } while (0)
#define INS16(L, xin) do { float x_ = (xin); _Pragma("unroll") for (int k_ = 0; k_ < 16; ++k_) { const float hi_ = fmaxf(L[k_], x_); x_ = fminf(L[k_], x_); L[k_] = hi_; } } while (0)

__device__ void peer_select_wave(const Params& P, size_t tok0) {
    const int lane = tid_opaque() & 63, r32 = lane & 31, hi = lane >> 5;
    const bf16_t* QP = (const bf16_t*)(P.ws + OFF_GB) + (tok0 + r32) * 1024; const bf16_t* SK = (const bf16_t*)(P.ws + OFF_SK);
    u32x2* EG = (u32x2*)(P.ws + OFF_EG) + (tok0 + r32) * 128;
#pragma unroll 1
    for (int h = 0; h < 8; ++h) {
        float a0[16], a1[16];
#pragma unroll
        for (int k = 0; k < 16; ++k) { a0[k] = -INFINITY; a1[k] = -INFINITY; }
#pragma unroll
        for (int p = 0; p < 2; ++p) {
            const int hp = h * 2 + p;
            bf16x8 qf[4];
#pragma unroll
            for (int ks = 0; ks < 4; ++ks) qf[ks] = *(const bf16x8*)(QP + hp * 64 + 16 * ks + 8 * hi);
            float L[16];
#pragma unroll
            for (int kt = 0; kt < 4; ++kt) {
                f32x16 acc = {};
#pragma unroll
                for (int ks = 0; ks < 4; ++ks) { const bf16x8 kf = *(const bf16x8*)(SK + ((size_t)hp * 128 + 32 * kt + r32) * 64 + 16 * ks + 8 * hi); acc = MFMA32(kf, qf[ks], acc); }
                float S[16];
#pragma unroll
                for (int r = 0; r < 16; ++r) { const unsigned key = (unsigned)(32 * kt + crow(r, hi)); S[r] = __uint_as_float((__float_as_uint(acc[r]) & ~127u) | key); }
                SORT16(S);
                if (kt == 0) {
#pragma unroll
                    for (int k = 0; k < 16; ++k) L[k] = S[k];
                } else {
#pragma unroll
                    for (int k = 0; k < 16; ++k) L[k] = fmaxf(L[k], S[15 - k]);
                    BITONIC16(L);
                }
            }
            {
                float O[16];
#pragma unroll
                for (int k = 0; k < 16; ++k) O[k] = __shfl_xor(L[15 - k], 32);
#pragma unroll
                for (int k = 0; k < 16; ++k) L[k] = fmaxf(L[k], O[k]);
                BITONIC16(L);
            }
#pragma unroll
            for (int k = 0; k < 16; ++k) { a0[k] = (p == 0) ? L[k] : a0[k]; a1[k] = (p == 1) ? L[k] : a1[k]; }
        }
        float best[16];
#pragma unroll
        for (int k = 0; k < 16; ++k) best[k] = __uint_as_float((__float_as_uint(a0[0] + a1[k]) & ~255u) | (unsigned)k);
#pragma unroll
        for (int i = 1; i < 16; ++i)
#pragma unroll
            for (int jx = 0; jx < 16; ++jx)
                if ((i + 1) * (jx + 1) <= 16) {
                    const float cs = a0[i] + a1[jx];
                    const float cv = __uint_as_float((__float_as_uint(cs) & ~255u) | (unsigned)(i * 16 + jx));
                    INS16(best, cv);
                }
        unsigned pk0[4], pk1[4];
#pragma unroll
        for (int q = 0; q < 4; ++q) {
            pk0[q] = (__float_as_uint(a0[4 * q]) & 127u) | ((__float_as_uint(a0[4 * q + 1]) & 127u) << 8) | ((__float_as_uint(a0[4 * q + 2]) & 127u) << 16) | ((__float_as_uint(a0[4 * q + 3]) & 127u) << 24);
            pk1[q] = (__float_as_uint(a1[4 * q]) & 127u) | ((__float_as_uint(a1[4 * q + 1]) & 127u) << 8) | ((__float_as_uint(a1[4 * q + 2]) & 127u) << 16) | ((__float_as_uint(a1[4 * q + 3]) & 127u) << 24);
        }
        unsigned pay[16];
#pragma unroll
        for (int k = 0; k < 16; ++k) {
            const unsigned code = __float_as_uint(best[k]) & 255u, ci = code >> 4, cj = code & 15u;
            const unsigned qi = ci >> 2, qj = cj >> 2;
            const unsigned w0 = (qi == 0u) ? pk0[0] : ((qi == 1u) ? pk0[1] : ((qi == 2u) ? pk0[2] : pk0[3]));
            const unsigned w1 = (qj == 0u) ? pk1[0] : ((qj == 1u) ? pk1[1] : ((qj == 2u) ? pk1[2] : pk1[3]));
            pay[k] = (((w0 >> ((ci & 3u) * 8u)) & 127u) << 7) | ((w1 >> ((cj & 3u) * 8u)) & 127u);
        }
        float e[16], es = 0.f;
#pragma unroll
        for (int k = 0; k < 16; ++k) { e[k] = __expf(best[k] - best[0]); es += e[k]; }
        const float inv = 1.0f / es;
        if (hi == 0) {
#pragma unroll
            for (int k = 0; k < 16; ++k) { u32x2 w; w.x = pay[k]; w.y = __float_as_uint(e[k] * inv); EG[h * 16 + k] = w; }
        }
    }
}
__device__ __forceinline__ unsigned xcc_id() { return (unsigned)__builtin_amdgcn_s_getreg((3 << 11) | 20) & 0xFu; }
template <int CTRL> __device__ __forceinline__ float dpp_add(float x) { const int v = __builtin_amdgcn_update_dpp(0, __float_as_int(x), CTRL, 0xf, 0xf, true); return x + __int_as_float(v); }
__device__ __forceinline__ float wave_sum_fast(float x) {
    x = dpp_add<0xB1>(x); x = dpp_add<0x4E>(x); x = dpp_add<0x141>(x); x = dpp_add<0x140>(x);
    x += __shfl_xor(x, 16); x += __shfl_xor(x, 32); return x;
}
template <int CTRL> __device__ __forceinline__ float dpp_max(float x) { const int v = __builtin_amdgcn_update_dpp(0, __float_as_int(x), CTRL, 0xf, 0xf, true); return fmaxf(x, __int_as_float(v)); }
template <int CTRL> __device__ __forceinline__ int dpp_addi(int x) { return x + __builtin_amdgcn_update_dpp(0, x, CTRL, 0xf, 0xf, true); }
__device__ __forceinline__ float wave_max_fast(float x) {
    x = dpp_max<0xB1>(x); x = dpp_max<0x4E>(x); x = dpp_max<0x141>(x); x = dpp_max<0x140>(x);
    x = fmaxf(x, __shfl_xor(x, 16)); x = fmaxf(x, __shfl_xor(x, 32)); return x;
}
__device__ __forceinline__ int wave_sum_int_fast(int x) {
    x = dpp_addi<0xB1>(x); x = dpp_addi<0x4E>(x); x = dpp_addi<0x141>(x); x = dpp_addi<0x140>(x);
    x += __shfl_xor(x, 16); x += __shfl_xor(x, 32); return x;
}
__device__ __forceinline__ float dot16_fp8(const float (&hv)[16], const u32x4 r) {
    float s = 0.f;
    { const f32x2 a = __builtin_amdgcn_cvt_pk_f32_fp8((int)r.x, false), b = __builtin_amdgcn_cvt_pk_f32_fp8((int)r.x, true); s += hv[0] * a.x + hv[1] * a.y + hv[2] * b.x + hv[3] * b.y; }
    { const f32x2 a = __builtin_amdgcn_cvt_pk_f32_fp8((int)r.y, false), b = __builtin_amdgcn_cvt_pk_f32_fp8((int)r.y, true); s += hv[4] * a.x + hv[5] * a.y + hv[6] * b.x + hv[7] * b.y; }
    { const f32x2 a = __builtin_amdgcn_cvt_pk_f32_fp8((int)r.z, false), b = __builtin_amdgcn_cvt_pk_f32_fp8((int)r.z, true); s += hv[8] * a.x + hv[9] * a.y + hv[10] * b.x + hv[11] * b.y; }
    { const f32x2 a = __builtin_amdgcn_cvt_pk_f32_fp8((int)r.w, false), b = __builtin_amdgcn_cvt_pk_f32_fp8((int)r.w, true); s += hv[12] * a.x + hv[13] * a.y + hv[14] * b.x + hv[15] * b.y; }
    return s;
}
template <int NP, class F> __device__ __forceinline__ void partition_queue(const Params& P, LAS unsigned char* lds, int ctr_base, F f) {
    const int tid = tid_opaque();
    LAS int* slot = (LAS int*)(lds + LDS_BYTES - 64);
    unsigned* ctr = (unsigned*)(P.ws + OFF_CTR) + ctr_base;
    const int myx = (int)(xcc_id() & 7u);
    for (int pp = 0; pp < NP; ++pp) {
        const int p = (myx * (NP / 8) + pp) % NP;
        for (;;) {
            if (tid == 0) *slot = (int)atomicAdd(ctr + p, 1u);
            __syncthreads();
            const int item = *slot;
            __syncthreads();
            if (item >= NTOK / 64) break;
            f(p, item);
        }
    }
}
__device__ __forceinline__ float dot2bf(unsigned a, bf16v2 b, float c) { return __builtin_amdgcn_fdot2_f32_bf16(__builtin_bit_cast(bf16v2, a), b, c, false); }
__device__ __forceinline__ float gelu_erf(float v) {
    const float av = fabsf(v), t = __builtin_amdgcn_rcpf(__builtin_fmaf(av, 0.2316418882f, 1.0f));
    float q = __builtin_fmaf(t, 0.5307027145f, -0.7265760135f); q = __builtin_fmaf(q, t, 0.7107068705f); q = __builtin_fmaf(q, t, -0.142248368f); q = __builtin_fmaf(q, t, 0.127414796f); q = q * t;
    const float m = v * (q * __builtin_amdgcn_exp2f(v * v * -0.72134752044f));
    return v < 0.f ? m : v - m;
}
struct UQuad { u32x4 r[2]; u32x4 ent, nxt; };
__device__ __forceinline__ void uq_issue(UQuad& q, const LAS u32x4* list, int J, int NQ, int g, const unsigned char* Ub, const unsigned lo) {
    q.ent = q.nxt;
    const unsigned char* rp = Ub + (q.ent.x * 512u + lo);
    q.r[0] = *(const u32x4*)rp; q.r[1] = *(const u32x4*)(rp + 256);
    const int jj = J < NQ ? J : NQ - 1;
    q.nxt = list[4 * jj + g];
}
__device__ __forceinline__ float uq_dot(const UQuad& q, const u32x4 (&hp)[4]) {
    int a = 0, b = 0;
#pragma unroll
    for (int c = 0; c < 2; ++c) {
        const u32x4 r = q.r[c];
        a = __builtin_amdgcn_sdot8((int)hp[c].x, (int)r.x, a, false); a = __builtin_amdgcn_sdot8((int)hp[c].y, (int)r.y, a, false);
        a = __builtin_amdgcn_sdot8((int)hp[c].z, (int)r.z, a, false); a = __builtin_amdgcn_sdot8((int)hp[c].w, (int)r.w, a, false);
        b = __builtin_amdgcn_sdot8((int)hp[2 + c].x, (int)r.x, b, false); b = __builtin_amdgcn_sdot8((int)hp[2 + c].y, (int)r.y, b, false);
        b = __builtin_amdgcn_sdot8((int)hp[2 + c].z, (int)r.z, b, false); b = __builtin_amdgcn_sdot8((int)hp[2 + c].w, (int)r.w, b, false);
    }
    float s = (float)(16 * a + b);
    s = dpp_add<0xB1>(s); s = dpp_add<0x4E>(s); s = dpp_add<0x141>(s); s = dpp_add<0x140>(s);
    return s;
}
__device__ __forceinline__ void peer_u_tokens(const Params& P, LAS unsigned char* lds, const size_t t0) {
    const int tid = tid_opaque(), lane = tid & 63, wid = tid >> 6, g = lane >> 4, li = lane & 15;
    const unsigned char* H8 = P.ws + OFF_H8 + li * 16; const unsigned char* Ub = P.ws + OFF_U8; const unsigned lo16 = (unsigned)li * 16u;
    const f32x2* HS = (const f32x2*)(P.ws + OFF_HS); const float* USC = (const float*)(P.ws + OFF_USC);
    const u32x4* EG4 = (const u32x4*)(P.ws + OFF_EG); float* W = (float*)(P.ws + OFF_W);
    LAS u32x4* list = (LAS u32x4*)(lds + wid * 16384);
#pragma unroll 2
    for (int i = 0; i < 8; ++i) {
        const u32x4 eg = EG4[(t0 + i) * 64 + lane];
        list[i * 128 + 2 * lane] = (u32x4){eg.x, eg.y, (unsigned)(2 * lane) | (unsigned)(i << 8), __float_as_uint(USC[eg.x])};
        list[i * 128 + 2 * lane + 1] = (u32x4){eg.z, eg.w, (unsigned)(2 * lane + 1) | (unsigned)(i << 8), __float_as_uint(USC[eg.z])};
    }
    constexpr int NQ = 256;
    u32x4 hp[4], hn[4]; f32x2 hsc = HS[t0], hsn = HS[t0 + 1];
#pragma unroll
    for (int c = 0; c < 2; ++c) { hp[c] = *(const u32x4*)(H8 + t0 * 1024 + 256 * c); hp[2 + c] = *(const u32x4*)(H8 + t0 * 1024 + 512 + 256 * c);
                                  hn[c] = *(const u32x4*)(H8 + (t0 + 1) * 1024 + 256 * c); hn[2 + c] = *(const u32x4*)(H8 + (t0 + 1) * 1024 + 512 + 256 * c); }
    int curtok = 0;
    UQuad q0, q1, q2, q3, q4, q5, q6, q7;
    q0.nxt = list[g]; q1.nxt = list[4 + g]; q2.nxt = list[8 + g]; q3.nxt = list[12 + g]; q4.nxt = list[16 + g]; q5.nxt = list[20 + g]; q6.nxt = list[24 + g]; q7.nxt = list[28 + g];
    uq_issue(q0, list, 8, NQ, g, Ub, lo16); uq_issue(q1, list, 9, NQ, g, Ub, lo16); uq_issue(q2, list, 10, NQ, g, Ub, lo16); uq_issue(q3, list, 11, NQ, g, Ub, lo16);
    uq_issue(q4, list, 12, NQ, g, Ub, lo16); uq_issue(q5, list, 13, NQ, g, Ub, lo16); uq_issue(q6, list, 14, NQ, g, Ub, lo16); uq_issue(q7, list, 15, NQ, g, Ub, lo16);
    float sv = 0.f; unsigned gv = 0u, zv = 0u;
#define UQ_PIN(q) asm volatile("" : "+v"(q.r[0]), "+v"(q.r[1]) :: "memory")
#define UQ_STEP(q, Jn, kq, qn) do { \
        const float s = __uint_as_float(q.ent.w) * hsc.x * (uq_dot(q, hp) + 0.5f * hsc.y); \
        if (li == (kq)) { sv = s; gv = q.ent.y; zv = q.ent.z; } \
        uq_issue(q, list, (Jn), NQ, g, Ub, lo16); UQ_PIN(qn); } while (0)
    UQ_PIN(q0);
#pragma unroll 1
    for (int J = 0; J < NQ; J += 8) {
        const int tk = __builtin_amdgcn_readfirstlane((int)(q0.ent.z >> 8));
        if (tk != curtok) { curtok = tk;
#pragma unroll
            for (int c = 0; c < 4; ++c) hp[c] = hn[c];
            hsc = hsn;
            if (tk + 1 < 8) { hsn = HS[t0 + tk + 1];
#pragma unroll
                for (int c = 0; c < 2; ++c) { hn[c] = *(const u32x4*)(H8 + (t0 + tk + 1) * 1024 + 256 * c); hn[2 + c] = *(const u32x4*)(H8 + (t0 + tk + 1) * 1024 + 512 + 256 * c); } } }
        UQ_STEP(q0, J + 16, 0, q1); UQ_STEP(q1, J + 17, 1, q2); UQ_STEP(q2, J + 18, 2, q3); UQ_STEP(q3, J + 19, 3, q4);
        UQ_STEP(q4, J + 20, 4, q5); UQ_STEP(q5, J + 21, 5, q6); UQ_STEP(q6, J + 22, 6, q7); UQ_STEP(q7, J + 23, 7, q0);
        if (li < 8) W[(t0 + tk) * 128 + (zv & 255u)] = __uint_as_float(gv) * gelu_erf(sv); }
#undef UQ_STEP
}
typedef int v4i_t __attribute__((ext_vector_type(4)));
struct VQuad { u32x4 r[2]; u32x2 ent, nxt; };
__device__ __forceinline__ void vq_issue(VQuad& q, const LAS u32x2* list, int J, int g, const unsigned char* Vb, const unsigned lo) {
    q.ent = q.nxt;
    const unsigned char* rp = Vb + (q.ent.x * 512u + lo);
    q.r[0] = *(const u32x4*)rp; q.r[1] = *(const u32x4*)(rp + 256);
    const int jj = J < 256 ? J : 255;
    q.nxt = list[4 * jj + g];
}
#define VQ_PIN(q) asm volatile("" : "+v"(q.r[0]), "+v"(q.r[1]) :: "memory")
__device__ __forceinline__ void vq_mma(const VQuad& q, v4i_t (&acc)[4], const u32x4 bm) {
    const unsigned t = q.ent.y;
    const v4i_t B = {(int)(t & bm.x), (int)(t & bm.y), (int)(t & bm.z), (int)(t & bm.w)};
#pragma unroll
    for (int c = 0; c < 2; ++c) {
        const u32x4 r = q.r[c];
        const v4i_t lo = {(int)(r.x & 0x0F0F0F0Fu), (int)(r.y & 0x0F0F0F0Fu), (int)(r.z & 0x0F0F0F0Fu), (int)(r.w & 0x0F0F0F0Fu)};
        const v4i_t raw = {(int)r.x, (int)r.y, (int)r.z, (int)r.w};
        acc[2 * c] = __builtin_amdgcn_mfma_i32_16x16x64_i8(lo, B, acc[2 * c], 0, 0, 0);
        acc[2 * c + 1] = __builtin_amdgcn_mfma_i32_16x16x64_i8(raw, B, acc[2 * c + 1], 0, 0, 0);
    }
}
__device__ __forceinline__ void peer_v_tokens(const Params& P, LAS unsigned char* lds, const size_t t0) {
    const int tid = tid_opaque(), lane = tid & 63, wid = tid >> 6, g = lane >> 4, li = lane & 15;
    const unsigned char* Vb = P.ws + OFF_V8; const unsigned lo16 = (unsigned)li * 16u; const float* VSC = (const float*)(P.ws + OFF_VSC);
    const u32x4* EG4 = (const u32x4*)(P.ws + OFF_EG); const f32x2* W2 = (const f32x2*)(P.ws + OFF_W);
    LAS u32x2* lists = (LAS u32x2*)(lds + wid * 8192);
    LAS f32x2* tokp = (LAS f32x2*)(lds + 65536 + wid * 64);
    {
        u32x4 egv[8]; f32x2 wwv[8];
#pragma unroll
        for (int i = 0; i < 8; ++i) { egv[i] = EG4[(t0 + i) * 64 + lane]; wwv[i] = W2[(t0 + i) * 64 + lane]; }
        float w0v[8], w1v[8];
#pragma unroll
        for (int i = 0; i < 8; ++i) { w0v[i] = wwv[i].x * VSC[egv[i].x]; w1v[i] = wwv[i].y * VSC[egv[i].z]; }
#pragma unroll
        for (int i = 0; i < 8; ++i) {
            const float mx = wave_max_fast(fmaxf(fabsf(w0v[i]), fabsf(w1v[i])));
            const float sw = fmaxf(mx * (1.0f / 127.0f), 1e-30f), inv = 1.0f / sw;
            const int q0 = (int)rintf(w0v[i] * inv), q1 = (int)rintf(w1v[i] * inv);
            *(LAS u32x4*)(lists + i * 128 + 2 * lane) = (u32x4){egv[i].x, ((unsigned)q0 & 255u) * 0x01010101u, egv[i].z, ((unsigned)q1 & 255u) * 0x01010101u};
            const int qs = wave_sum_int_fast(q0 + q1);
            if (lane == 0) tokp[i] = (f32x2){sw, 7.5f * sw * (float)qs}; }
    }
    const unsigned bsel = 0xFFu << (8u * (unsigned)(li & 3));
    const u32x4 bm = {(li >> 2) == 0 ? bsel : 0u, (li >> 2) == 1 ? bsel : 0u, (li >> 2) == 2 ? bsel : 0u, (li >> 2) == 3 ? bsel : 0u};
    const int dbase = 128 * g + 8 * (li >> 2) + (li & 3);
    float gt2v[16], lgv[16], lbv[16];
    { const float* gt2 = (const float*)(P.ws + OFF_ADA) + (t0 >> 11) * 6144 + 5120;
#pragma unroll
      for (int c = 0; c < 2; ++c)
#pragma unroll
          for (int hf = 0; hf < 2; ++hf)
#pragma unroll
              for (int r = 0; r < 4; ++r) { const int d = dbase + 512 * c + 32 * r + 4 * hf, e = 8 * c + 4 * hf + r; gt2v[e] = gt2[d]; lgv[e] = P.ln2_g[d]; lbv[e] = P.ln2_b[d]; } }
    VQuad q0, q1, q2, q3, q4, q5, q6, q7;
    q0.nxt = lists[g]; q1.nxt = lists[4 + g]; q2.nxt = lists[8 + g]; q3.nxt = lists[12 + g]; q4.nxt = lists[16 + g]; q5.nxt = lists[20 + g]; q6.nxt = lists[24 + g]; q7.nxt = lists[28 + g];
    vq_issue(q0, lists, 8, g, Vb, lo16); vq_issue(q1, lists, 9, g, Vb, lo16); vq_issue(q2, lists, 10, g, Vb, lo16); vq_issue(q3, lists, 11, g, Vb, lo16);
    vq_issue(q4, lists, 12, g, Vb, lo16); vq_issue(q5, lists, 13, g, Vb, lo16); vq_issue(q6, lists, 14, g, Vb, lo16); vq_issue(q7, lists, 15, g, Vb, lo16);
    VQ_PIN(q0);
#pragma unroll 1
    for (int i = 0; i < 8; ++i) {
        const size_t t = t0 + i;
        v4i_t acc[4];
#pragma unroll
        for (int j = 0; j < 4; ++j) acc[j] = (v4i_t){0, 0, 0, 0};
        float* xr = P.out + t * 1024;
        float xv[16];
#pragma unroll
        for (int c = 0; c < 2; ++c)
#pragma unroll
            for (int hf = 0; hf < 2; ++hf)
#pragma unroll
                for (int r = 0; r < 4; ++r) xv[8 * c + 4 * hf + r] = xr[dbase + 512 * c + 32 * r + 4 * hf];
#pragma unroll 1
        for (int J = 32 * i; J < 32 * i + 32; J += 8) {
            vq_mma(q0, acc, bm); vq_issue(q0, lists, J + 16, g, Vb, lo16); VQ_PIN(q1);
            vq_mma(q1, acc, bm); vq_issue(q1, lists, J + 17, g, Vb, lo16); VQ_PIN(q2);
            vq_mma(q2, acc, bm); vq_issue(q2, lists, J + 18, g, Vb, lo16); VQ_PIN(q3);
            vq_mma(q3, acc, bm); vq_issue(q3, lists, J + 19, g, Vb, lo16); VQ_PIN(q4);
            vq_mma(q4, acc, bm); vq_issue(q4, lists, J + 20, g, Vb, lo16); VQ_PIN(q5);
            vq_mma(q5, acc, bm); vq_issue(q5, lists, J + 21, g, Vb, lo16); VQ_PIN(q6);
            vq_mma(q6, acc, bm); vq_issue(q6, lists, J + 22, g, Vb, lo16); VQ_PIN(q7);
            vq_mma(q7, acc, bm); vq_issue(q7, lists, J + 23, g, Vb, lo16); VQ_PIN(q0);
        }
        const f32x2 tp = tokp[i]; const float sw = tp.x, yoff = tp.y;
        float pre[16]; float s = 0.f;
#pragma unroll
        for (int c = 0; c < 2; ++c)
#pragma unroll
            for (int hf = 0; hf < 2; ++hf)
#pragma unroll
                for (int r = 0; r < 4; ++r) { const int e = 8 * c + 4 * hf + r;
                    const float yv = hf == 0 ? sw * (float)acc[2 * c][r] - yoff : (sw * 0.0625f) * (float)(acc[2 * c + 1][r] - acc[2 * c][r]) + yoff * (1.0f / 15.0f);
                    const float pv = ALPHA * xv[e] + gt2v[e] * yv; pre[e] = pv; s += pv; }
        const float mean = wave_sum_fast(s) * (1.0f / 1024.0f); float s2 = 0.f;
#pragma unroll
        for (int e = 0; e < 16; ++e) { pre[e] -= mean; s2 += pre[e] * pre[e]; }
        const float rstd = rsqrtf(wave_sum_fast(s2) * (1.0f / 1024.0f) + LN_EPS);
#pragma unroll
        for (int c = 0; c < 2; ++c)
#pragma unroll
            for (int hf = 0; hf < 2; ++hf)
#pragma unroll
                for (int r = 0; r < 4; ++r) { const int e = 8 * c + 4 * hf + r;
                    xr[dbase + 512 * c + 32 * r + 4 * hf] = pre[e] * rstd * lgv[e] + lbv[e]; }
    }
}

#define XB_TMO      128
#define XB_XCNT(j)  (256  + 64 * (j))
#define XB_XSUB(j)  (1280 + 64 * (j))
#define XB_XGEN(j)  (2304 + 64 * (j))
#define XB_TOP      3328
#define XB_TOPGEN   3392
#define XCD_BAR_WORDS 3456
#define XB_SPIN_CAP (1u << 22)
__device__ __forceinline__ unsigned xb_ld(unsigned* p)              { return __hip_atomic_load(p, __ATOMIC_RELAXED, __HIP_MEMORY_SCOPE_AGENT); }
__device__ __forceinline__ unsigned xb_add(unsigned* p, unsigned v) { return __hip_atomic_fetch_add(p, v, __ATOMIC_RELAXED, __HIP_MEMORY_SCOPE_AGENT); }
#define XB_SPIN(cond, bar) do { unsigned _sp = 0; while (cond) { __builtin_amdgcn_s_sleep(1); \
    if ((++_sp & 255u) == 0u) { if (xb_ld(&(bar)[XB_TMO])) break; if (_sp > XB_SPIN_CAP) { atomicAdd(&(bar)[XB_TMO], 1u); break; } } } } while (0)
struct XcdBarrier { unsigned* bar; unsigned x; volatile LAS unsigned* st; };
__device__ __forceinline__ XcdBarrier xcd_barrier_post(unsigned* bar, volatile LAS unsigned* st) {
    XcdBarrier b; b.bar = bar; b.x = xcc_id(); b.st = st;
    if (threadIdx.x == 0) (void)xb_add(&bar[XB_XCNT(b.x)], 1u);
    return b;
}
__device__ __forceinline__ void xcd_barrier_complete(unsigned* bar, unsigned x, unsigned& nloc, unsigned& nx) {
    const unsigned G = gridDim.x * gridDim.y * gridDim.z;
    unsigned sum, cnt, mine, sp = 0u;
    for (;;) {
        sum = 0u; cnt = 0u; mine = 0u;
#pragma unroll
        for (unsigned j = 0; j < 16; ++j) { const unsigned c = xb_ld(&bar[XB_XCNT(j)]); sum += c; cnt += (c > 0u) ? 1u : 0u; mine = (j == x) ? c : mine; }
        if (sum == G) break;
        __builtin_amdgcn_s_sleep(1);
        if ((++sp & 255u) == 0u) { if (xb_ld(&bar[XB_TMO])) break; if (sp > XB_SPIN_CAP) { atomicAdd(&bar[XB_TMO], 1u); break; } }
    }
    nloc = mine > 0u ? mine : 1u; nx = cnt > 0u ? cnt : 1u;
}
__device__ __forceinline__ void xcd_barrier(const XcdBarrier& b) {
    asm volatile("s_waitcnt vmcnt(0)" ::: "memory");
    __syncthreads();
    if (threadIdx.x == 0) {
        unsigned* bar = b.bar;
        __builtin_amdgcn_s_waitcnt(0);
        unsigned nloc = b.st[0], nx = b.st[1];
        if (nloc == 0u) { xcd_barrier_complete(bar, b.x, nloc, nx); b.st[0] = nloc; b.st[1] = nx; }
        const unsigned old = xb_add(&bar[XB_XSUB(b.x)], 1u);
        const unsigned gen = old / nloc;
        if (old + 1u == (gen + 1u) * nloc) {
            __builtin_amdgcn_fence(__ATOMIC_RELEASE, "agent");
            asm volatile("s_waitcnt vmcnt(0)" ::: "memory");
            const unsigned og = xb_add(&bar[XB_TOP], 1u);
            const unsigned tg = og / nx;
            if (og + 1u == (tg + 1u) * nx) xb_add(&bar[XB_TOPGEN], 1u);
            else XB_SPIN(xb_ld(&bar[XB_TOPGEN]) == tg, bar);
            __builtin_amdgcn_fence(__ATOMIC_ACQUIRE, "agent");
            xb_add(&bar[XB_XGEN(b.x)], 1u);
            asm volatile("s_waitcnt vmcnt(0)" ::: "memory");
        } else {
            XB_SPIN(xb_ld(&bar[XB_XGEN(b.x)]) == gen, bar);
            __builtin_amdgcn_fence(__ATOMIC_ACQUIRE, "agent");
            asm volatile("s_waitcnt vmcnt(0)" ::: "memory");
        }
    }
    __syncthreads();
}

__global__ void __launch_bounds__(NTHR, 2) fwd_megakernel(Params P) {
    extern __shared__ __attribute__((aligned(16))) unsigned char shm[];
    LAS unsigned char* lds = (LAS unsigned char*)shm;
    cg::grid_group grid = cg::this_grid();
    const int G = gridDim.x, bid = blockIdx.x;
    volatile LAS unsigned* xst = (volatile LAS unsigned*)(lds + LDS_BYTES - 128);
    if (threadIdx.x == 0) { xst[0] = 0u; xst[1] = 0u; }
    __syncthreads();
    const XcdBarrier xb = xcd_barrier_post((unsigned*)(P.ws + OFF_BAR), xst);

#ifndef P3
#define P3 0xff
#endif
#ifndef PH
#define PH 0xff
#endif
    if (PH & 1) phase0a(P, lds);
    grid.sync();
    if (PH & 2) phase0b(P);
    xcd_barrier(xb);
    if (PH & 4) {
        pg8::Gemm g; g.A = (const bf16_t*)(P.ws + OFF_H); g.Bt = (const bf16_t*)(P.ws + OFF_WIN); g.M = NTOK; g.N = INCOLS; { int k_ = 512; asm volatile("" : "+s"(k_)); g.K = k_; g.lda = k_; }
        pg8::StaticOrder S; S.init(NTOK, INCOLS, G, bid);
        EpiProj E; E.ws = P.ws; E.lb = (const float*)(P.ws + OFF_LB); E.ng = P.hgrn_ng; E.kmean = (float*)(P.ws + OFF_KMEAN);
        pg8::gemm_phase<EpiProj, pg8::StaticOrder, true>(lds, g, S, E);
    }
    xcd_barrier(xb);
    if (PH & 8) for (int it = bid; it < 256; it += G) hgrn_item(P, it, lds);
    if (PH & 16) for (int u = bid; u < 2048; u += G) { const int bh = u & 255, jj = u >> 8; moba_unit(P, bh >> 3, bh & 7, (jj + bh) & 7, lds); }
    xcd_barrier(xb);
    if ((PH & 32) && bid < NTOK / 256) { const int pm = bid;
        if (P3 & 1) yb_norm_panel(P, pm);
        __syncthreads();
        if (P3 & 2) { pg8::Gemm g; g.A = (const bf16_t*)(P.ws + OFF_EG); g.Bt = (const bf16_t*)(P.ws + OFF_WBA); g.M = NTOK; g.N = 1024; { int k_ = 256; asm volatile("" : "+s"(k_)); g.K = k_; } g.lda = 512;
          pg8::PanelOrder S; S.pm = pm; S.npn = 4; EpiMixA E; E.GA = (bf16_t*)(P.ws + OFF_GA);
          pg8::gemm_phase<EpiMixA, pg8::PanelOrder, true>(lds, g, S, E); }
        __syncthreads();
        if (P3 & 4) { pg8::Gemm g; g.A = (const bf16_t*)(P.ws + OFF_EG + 512); g.Bt = (const bf16_t*)(P.ws + OFF_WBB); g.M = NTOK; g.N = 1024; { int k_ = 256; asm volatile("" : "+s"(k_)); g.K = k_; } g.lda = 512;
          pg8::PanelOrder S; S.pm = pm; S.npn = 4; EpiMixB E; E.GA = (const bf16_t*)(P.ws + OFF_GA); E.GB = (const bf16_t*)(P.ws + OFF_GB); E.M8 = P.ws + OFF_QA;
          pg8::gemm_phase<EpiMixB, pg8::PanelOrder, true>(lds, g, S, E); }
        __syncthreads();
        if (P3 & 8) { pg8::Gemm g; g.A = (const bf16_t*)(P.ws + OFF_QA); g.Bt = (const bf16_t*)(P.ws + OFF_WOUT); g.M = NTOK; g.N = 1024; { int k_ = 512; asm volatile("" : "+s"(k_)); g.K = k_; g.lda = k_; }
          pg8::PanelOrder S; S.pm = pm; S.npn = 4; EpiOut E; E.ada = (const float*)(P.ws + OFF_ADA); E.D = (bf16_t*)(P.ws + OFF_GB);
          pg8::gemm_phase<EpiOut, pg8::PanelOrder, true>(lds, g, S, E); }
        __syncthreads();
        if (P3 & 16) ln1_panel(P, pm);
        __syncthreads();
        if (P3 & 32) { pg8::Gemm g; g.A = (const bf16_t*)(P.ws + OFF_H); g.Bt = (const bf16_t*)(P.ws + OFF_WQ); g.M = NTOK; g.N = 1024; g.K = 1024; g.lda = 1024;
          pg8::PanelOrder S; S.pm = pm; S.npn = 4; EpiBf16 E; E.O = (bf16_t*)(P.ws + OFF_GB);
          pg8::gemm_phase<EpiBf16, pg8::PanelOrder>(lds, g, S, E); }
        __syncthreads();
        { const size_t tok0 = (size_t)pm * 256 + (tid_opaque() >> 6) * 32;
          peer_select_wave(P, tok0);
          __syncthreads();
#pragma unroll 1
          for (int sb = 0; sb < 4; ++sb) {
              peer_u_tokens(P, lds, tok0 + 8 * sb);
              __syncthreads();
              peer_v_tokens(P, lds, tok0 + 8 * sb);
              __syncthreads();
          } }
    }
}

extern "C" void kernel_launch(void* const* d_in, const int* in_sizes, int n_in, void* d_out, int out_size, void* d_ws, size_t ws_size, hipStream_t stream) {
    static int grid_blocks = 0;
    if (grid_blocks == 0) {
        if (n_in != 18 || out_size != NTOK * DM || ws_size < WS_END) { fprintf(stderr, "kernel_launch: unexpected shapes (n_in %d, out %d, ws %zu, need %zu)\n", n_in, out_size, ws_size, (size_t)WS_END); grid_blocks = -1; return; }
        int dev = 0, cus = 0, per_cu = 0;
        hipGetDevice(&dev);
        hipDeviceGetAttribute(&cus, hipDeviceAttributeMultiprocessorCount, dev);
        if (hipFuncSetAttribute((const void*)fwd_megakernel, hipFuncAttributeMaxDynamicSharedMemorySize, LDS_BYTES) != hipSuccess) fprintf(stderr, "kernel_launch: hipFuncSetAttribute failed\n");
        hipOccupancyMaxActiveBlocksPerMultiprocessor(&per_cu, (const void*)fwd_megakernel, NTHR, LDS_BYTES);
        if (per_cu < 1) { fprintf(stderr, "kernel_launch: occupancy query says %d blocks per CU\n", per_cu); per_cu = 1; }
        if (per_cu > 1) per_cu = 1;
        grid_blocks = cus * per_cu;
        if (grid_blocks != NTOK / 256) { fprintf(stderr, "kernel_launch: built for a %d-CU device (one 256-token panel per workgroup), found %d\n", NTOK / 256, grid_blocks); grid_blocks = -1; return; }
        (void)hipGetLastError();
    }
    if (grid_blocks < 0) return;
    Params p{};
    p.x = (const float*)d_in[0]; p.c = (const float*)d_in[1]; p.w_ada = (const float*)d_in[2]; p.b_ada = (const float*)d_in[3]; p.w_in = (const float*)d_in[4];
    p.w_ba = (const float*)d_in[5]; p.w_bb = (const float*)d_in[6]; p.w_out = (const float*)d_in[7]; p.hgrn_lb = (const float*)d_in[8]; p.hgrn_ng = (const float*)d_in[9];
    p.ln1_g = (const float*)d_in[10]; p.ln1_b = (const float*)d_in[11]; p.peer_wq = (const float*)d_in[12]; p.peer_sk = (const float*)d_in[13]; p.peer_u = (const float*)d_in[14];
    p.peer_v = (const float*)d_in[15]; p.ln2_g = (const float*)d_in[16]; p.ln2_b = (const float*)d_in[17];
    p.out = (float*)d_out; p.ws = (unsigned char*)d_ws;
    if (hipMemsetAsync((char*)d_ws + OFF_BAR, 0, XCD_BAR_WORDS * 4, stream) != hipSuccess) fprintf(stderr, "kernel_launch: memset of the barrier words failed\n");
    void* args[] = {&p};
    hipError_t e = hipLaunchCooperativeKernel((const void*)fwd_megakernel, dim3(grid_blocks), dim3(NTHR), args, LDS_BYTES, stream);
    if (e != hipSuccess) fprintf(stderr, "cooperative launch failed: %s (grid %d)\n", hipGetErrorString(e), grid_blocks);
}
```

```cpp
#include <hip/hip_runtime.h>
#include <hip/hip_cooperative_groups.h>
#include <cstdio>
#include <cstdint>
#include <type_traits>
namespace cg = cooperative_groups;

#define LAS __attribute__((address_space(3)))
typedef unsigned short bf16_t;
typedef short bf16x8 __attribute__((ext_vector_type(8)));
typedef short s16x4 __attribute__((ext_vector_type(4)));
typedef float f32x2 __attribute__((ext_vector_type(2)));
typedef float f32x4 __attribute__((ext_vector_type(4)));
typedef float f32x16 __attribute__((ext_vector_type(16)));
typedef unsigned u32x2 __attribute__((ext_vector_type(2)));
typedef unsigned u32x4 __attribute__((ext_vector_type(4)));

constexpr int NB = 32, SEQ = 2048, DM = 1024, NTOK = NB * SEQ;
constexpr int INCOLS = 5632;
constexpr int NTHR = 512;
constexpr int LDS_BYTES = 147456;
constexpr float ALPHA = 1.189207115002721f;
constexpr float LN_EPS = 1e-5f, RMS_EPS = 1e-6f;
constexpr float LOG2E = 1.4426950408889634f;

constexpr size_t SZ_T512 = (size_t)NTOK * 512 * 2, SZ_T1024 = (size_t)NTOK * 1024 * 2;
constexpr size_t OFF_ADA = 0;
constexpr size_t OFF_LB = OFF_ADA + 786432;
constexpr size_t OFF_KMEAN = OFF_LB + 4096;
constexpr size_t OFF_WIN = OFF_KMEAN + 524288;
constexpr size_t OFF_WBA = OFF_WIN + (size_t)5632 * 1024 * 2;
constexpr size_t OFF_WBB = OFF_WBA + 1048576;
constexpr size_t OFF_WOUT = OFF_WBB + 1048576;
constexpr size_t OFF_WQ = OFF_WOUT + 2097152;
constexpr size_t OFF_SK = OFF_WQ + 2097152;
constexpr size_t OFF_U8 = OFF_SK + 262144;
constexpr size_t OFF_USC = OFF_U8 + 8388608;
constexpr size_t OFF_V8 = OFF_U8 + 16777216;
constexpr size_t OFF_VSC = OFF_V8 + 8388608;
constexpr size_t OFF_CTR = OFF_V8 + 16777216;
constexpr size_t OFF_BAR = OFF_CTR + 4096;
constexpr size_t OFF_EG = OFF_BAR + 16384;
constexpr size_t OFF_H = OFF_EG + (size_t)NTOK * 128 * 8;
constexpr size_t OFF_QA = OFF_H + SZ_T1024;
constexpr size_t OFF_KA = OFF_QA + SZ_T512;
constexpr size_t OFF_VA = OFF_KA + SZ_T512;
constexpr size_t OFF_HQ = OFF_VA + SZ_T512;
constexpr size_t OFF_HK = OFF_HQ + SZ_T512;
constexpr size_t OFF_HI = OFF_HK + SZ_T512;
constexpr size_t OFF_HG = OFF_HI + SZ_T512;
constexpr size_t OFF_GA = OFF_HG + SZ_T512;
constexpr size_t OFF_GB = OFF_GA + SZ_T1024;
constexpr size_t WS_END = OFF_GB + SZ_T1024;
constexpr size_t OFF_H8 = OFF_VA;
constexpr size_t OFF_HS = OFF_HQ;
constexpr size_t OFF_W = OFF_KA;
constexpr size_t OFF_Y = OFF_KA;

struct Params {
    const float *x, *c, *w_ada, *b_ada, *w_in, *w_ba, *w_bb, *w_out, *hgrn_lb, *hgrn_ng, *ln1_g, *ln1_b, *peer_wq, *peer_sk, *peer_u, *peer_v, *ln2_g, *ln2_b;
    float* out;
    unsigned char* ws;
};

typedef __bf16 bf16v2 __attribute__((ext_vector_type(2)));
__device__ __forceinline__ unsigned cvt_pk_bf16(float lo, float hi) { return __builtin_bit_cast(unsigned, __builtin_convertvector((f32x2){lo, hi}, bf16v2)); }
__device__ __forceinline__ float bf_lo(unsigned w) { return __uint_as_float(w << 16); }
__device__ __forceinline__ float bf_hi(unsigned w) { return __uint_as_float(w & 0xffff0000u); }
__device__ __forceinline__ float sigmoidf_(float x) { return __builtin_amdgcn_rcpf(1.0f + __builtin_amdgcn_exp2f(-LOG2E * x)); }
__device__ __forceinline__ float wave_sum(float v) {
#pragma unroll
    for (int o = 1; o < 64; o <<= 1) v += __shfl_xor(v, o);
    return v;
}
__device__ __forceinline__ int tid_opaque() { int t = threadIdx.x; asm volatile("" : "+v"(t)); return t; }
__device__ __forceinline__ int crow(int r, int hi) { return (r & 3) + 8 * (r >> 2) + 4 * hi; }
#define MFMA32(a, b, c) __builtin_amdgcn_mfma_f32_32x32x16_bf16(a, b, c, 0, 0, 0)

namespace pg8 {
constexpr int BM = 256, BK = 64, HALF = 128, HTB = HALF * BK * 2, STAGE_BYTES = 8 * HTB, NXCD = 8, WGM = 8;
__host__ __device__ __forceinline__ int lds_byte(int r, int c) { const int st = (r >> 4) * 2 + (c >> 5), rr = r & 15, cc = c & 31, ob = rr * 64 + cc * 2; return st * 1024 + (ob ^ (((ob >> 9) & 1) << 5)); }
__host__ __device__ __forceinline__ void stage_rc(int b, int& R, int& C) { const int st = b / 1024, sb = b % 1024, swz = sb ^ (((sb >> 9) & 1) << 5); R = (st >> 1) * 16 + swz / 64; C = (st & 1) * 32 + (swz % 64) / 2; }
__host__ __device__ __forceinline__ int perm32(int rho) { const int n = rho >> 4, i = rho & 15; return 8 * (i >> 2) + 4 * n + (i & 3); }

struct Unit { int pm, pn; };
struct Gemm { const bf16_t* A; const bf16_t* Bt; int M, N, K, lda; };

struct StaticOrder {
    int nM, nN, nwg, G, c;
    __device__ void init(int M, int N, int G_, int c_) { nM = M / BM; nN = N / BM; nwg = nM * nN; G = G_; c = c_; }
    __device__ bool next(int i, Unit& u) const {
        const long L = (long)i * G + c; if (L >= nwg) return false;
        int wgid = (int)L; { const int q = nwg / NXCD, r = nwg % NXCD, xcd = wgid % NXCD, off = wgid / NXCD; wgid = (xcd < r ? xcd * (q + 1) : r * (q + 1) + (xcd - r) * q) + off; }
        const int nig = WGM * nN, gid = wgid / nig, fm = gid * WGM, gsz = (nM - fm) < WGM ? (nM - fm) : WGM;
        u.pm = fm + ((wgid % nig) % gsz); u.pn = (wgid % nig) / gsz; return true;
    }
};
struct PanelOrder {
    int pm, npn;
    __device__ bool next(int i, Unit& u) const { if (i >= npn) return false; u.pm = pm; u.pn = i; return true; }
};

template <class Epi, class Sched, bool MX = false>
__device__ __forceinline__ void gemm_phase(LAS unsigned char* lds, const Gemm g, const Sched& S, const Epi& E) {
    const int tid = tid_opaque(), wid = __builtin_amdgcn_readfirstlane(tid >> 6), lane = tid & 63, wr = wid >> 2, wc = wid & 3, fr = lane & 15, fq = lane >> 4;
    const int K = g.K, nt = K / BK;
    unsigned voffA, voffB;
    { int R, C; stage_rc(tid * 16, R, C); const int Rb = Epi::PERM ? ((R & ~31) + perm32(R & 31)) : R;
      voffA = (unsigned)(R * g.lda + C) * 2u; voffB = (unsigned)(Rb * K + C) * 2u; }
    const size_t rvoffA = (size_t)128 * g.lda, rvoffB = (size_t)128 * K;
    const size_t kstep = (size_t)(BK * 2);
    const size_t hstep = (size_t)HALF * K * 2;
    const size_t tstep = 2 * hstep;
    const size_t hstepA = (size_t)HALF * g.lda * 2, tstepA = 2 * hstepA;
    const unsigned ldsw = (unsigned)wid * 1024u;
    const int aoff = lds_byte(wr * 64 + fr, fq * 8), boff = lds_byte(wc * 32 + fr, fq * 8);
#define PG8_SA(b, h) (((b) * 2 + (h)) * HTB)
#define PG8_SB(b, h) ((4 + (b) * 2 + (h)) * HTB)
#define PG8_STAGE(bufoff, gbase, voff) do { unsigned vo_ = (voff); asm volatile("" : "+v"(vo_));     \
        _Pragma("unroll") for (int _i = 0; _i < 2; ++_i) \
        __builtin_amdgcn_global_load_lds((const unsigned*)((const char*)(gbase) + _i * r##voff + vo_), (LAS unsigned*)(lds + (bufoff) + ldsw + _i * 8192), 16, 0, 0); } while (0)
#define PG8_LDX(dst, off) do { const v4i_ lo_ = *(const LAS v4i_*)(lds + (off)), hi_ = *(const LAS v4i_*)(lds + (off) + 1024); dst = __builtin_shufflevector(lo_, hi_, 0, 1, 2, 3, 4, 5, 6, 7); } while (0)
#define PG8_LDA(dst, b, h) do { if constexpr (MX) { _Pragma("unroll") for (int m = 0; m < 4; ++m) PG8_LDX(dst##X[m], PG8_SA(b, h) + aoff + m * 2048); } \
        else { _Pragma("unroll") for (int m = 0; m < 4; ++m) _Pragma("unroll") for (int k = 0; k < 2; ++k) dst[m][k] = *(const LAS bf16x8*)(lds + PG8_SA(b, h) + aoff + m * 2048 + k * 1024); } } while (0)
#define PG8_LDB(dst, b, h) do { if constexpr (MX) { _Pragma("unroll") for (int n = 0; n < 2; ++n) PG8_LDX(dst##X[n], PG8_SB(b, h) + boff + n * 2048); } \
        else { _Pragma("unroll") for (int n = 0; n < 2; ++n) _Pragma("unroll") for (int k = 0; k < 2; ++k) dst[n][k] = *(const LAS bf16x8*)(lds + PG8_SB(b, h) + boff + n * 2048 + k * 1024); } } while (0)
#define PG8_MMA(ai, bj, At, Bt) do { __builtin_amdgcn_s_setprio(1); \
        if constexpr (MX) { _Pragma("unroll") for (int m = 0; m < 4; ++m) _Pragma("unroll") for (int n = 0; n < 2; ++n) \
            asm volatile("v_mfma_scale_f32_16x16x128_f8f6f4 %0, %1, %2, %0, %3, %4 op_sel_hi:[0,0,0]" : "+v"(acc[ai][bj][m][n]) : "v"(Bt##X[n]), "v"(At##X[m]), "v"(mxscale), "v"(mxscale5)); } \
        else { _Pragma("unroll") for (int m = 0; m < 4; ++m) _Pragma("unroll") for (int n = 0; n < 2; ++n) _Pragma("unroll") for (int k = 0; k < 2; ++k) \
            acc[ai][bj][m][n] = __builtin_amdgcn_mfma_f32_16x16x32_bf16(Bt[n][k], At[m][k], acc[ai][bj][m][n], 0, 0, 0); } \
        __builtin_amdgcn_s_setprio(0); } while (0)
#define PG8_WAIT_V(n) asm volatile("s_waitcnt vmcnt(" #n ")" ::: "memory")
#define PG8_WAIT_L(n) asm volatile("s_waitcnt lgkmcnt(" #n ")" ::: "memory")
#define PG8_BAR __builtin_amdgcn_s_barrier()
#define PG8_SCHED __builtin_amdgcn_sched_barrier(0)
    Unit cur, nxt; int ui = 0;
    if (!S.next(0, cur)) return;
    f32x4 acc[2][2][4][2];
#pragma unroll
    for (int a = 0; a < 2; ++a)
#pragma unroll
        for (int b = 0; b < 2; ++b)
#pragma unroll
            for (int m = 0; m < 4; ++m)
#pragma unroll
                for (int n = 0; n < 2; ++n) acc[a][b][m][n] = (f32x4){0.f, 0.f, 0.f, 0.f};
    typedef int v4i_ __attribute__((ext_vector_type(4))); typedef int v8i_ __attribute__((ext_vector_type(8)));
    bf16x8 At[4][2], B0[2][2], B1[2][2];
    v8i_ AtX[4], B0X[2], B1X[2];
    const int mxscale = 0x7f7f7f7f, mxscale5 = 0x7a7a7a7a;
    const char* cA = (const char*)g.A + (size_t)cur.pm * tstepA; const char* cB = (const char*)g.Bt + (size_t)cur.pn * tstep;
    PG8_STAGE(PG8_SB(0, 0), cB, voffB); PG8_STAGE(PG8_SA(0, 0), cA, voffA); PG8_STAGE(PG8_SB(0, 1), cB + hstep, voffB); PG8_STAGE(PG8_SA(0, 1), cA + hstepA, voffA);
    if (wr == 1) PG8_BAR;
    PG8_WAIT_V(4); PG8_BAR;
    PG8_STAGE(PG8_SB(1, 0), cB + kstep, voffB); PG8_STAGE(PG8_SA(1, 0), cA + kstep, voffA); PG8_STAGE(PG8_SB(1, 1), cB + hstep + kstep, voffB);
    PG8_WAIT_V(6); PG8_BAR;
    for (;;) {
        const bool has_next = S.next(ui + 1, nxt);
        const char* nA = has_next ? (const char*)g.A + (size_t)nxt.pm * tstepA : cA; const char* nB = has_next ? (const char*)g.Bt + (size_t)nxt.pn * tstep : cB;
        for (int t = 0; t < nt; t += 2) {
            const bool last = (t == nt - 2);
            const char* a1 = cA + (size_t)(t + 1) * kstep;
            const char* a2 = last ? nA : cA + (size_t)(t + 2) * kstep; const char* b2 = last ? nB : cB + (size_t)(t + 2) * kstep;
            const char* a3 = a2 + kstep; const char* b3 = b2 + kstep;
            PG8_LDB(B0, 0, 0); PG8_SCHED; PG8_LDA(At, 0, 0); PG8_STAGE(PG8_SA(1, 1), a1 + hstepA, voffA);
            PG8_WAIT_L(8); PG8_BAR; PG8_WAIT_L(0); PG8_MMA(0, 0, At, B0); PG8_BAR; PG8_SCHED;
            PG8_LDB(B1, 0, 1); PG8_STAGE(PG8_SB(0, 0), b2, voffB);
            PG8_BAR; PG8_WAIT_L(0); PG8_MMA(0, 1, At, B1); PG8_BAR;
            PG8_LDA(At, 0, 1); PG8_STAGE(PG8_SA(0, 0), a2, voffA);
            PG8_BAR; PG8_WAIT_L(0); PG8_MMA(1, 0, At, B0); PG8_BAR; PG8_SCHED;
            PG8_STAGE(PG8_SB(0, 1), b2 + hstep, voffB);
            PG8_WAIT_V(6); PG8_BAR; PG8_MMA(1, 1, At, B1); PG8_BAR;
            PG8_LDB(B0, 1, 0); PG8_SCHED; PG8_LDA(At, 1, 0); PG8_STAGE(PG8_SA(0, 1), a2 + hstepA, voffA);
            PG8_WAIT_L(8); PG8_BAR; PG8_WAIT_L(0); PG8_MMA(0, 0, At, B0); PG8_BAR; PG8_SCHED;
            PG8_LDB(B1, 1, 1); PG8_STAGE(PG8_SB(1, 0), b3, voffB);
            PG8_BAR; PG8_WAIT_L(0); PG8_MMA(0, 1, At, B1); PG8_BAR;
            PG8_LDA(At, 1, 1); PG8_STAGE(PG8_SA(1, 0), a3, voffA);
            PG8_BAR; PG8_WAIT_L(0); PG8_MMA(1, 0, At, B0); PG8_BAR; PG8_SCHED;
            PG8_STAGE(PG8_SB(1, 1), b3 + hstep, voffB);
            PG8_WAIT_V(6); PG8_BAR; PG8_MMA(1, 1, At, B1); PG8_BAR;
        }
        if constexpr (MX) asm volatile("s_nop 15\n\ts_nop 15" ::: "memory");
        if (wr == 0) PG8_BAR;
        E(acc, cur, wr, wc, fr, fq);
        if (wr == 1) PG8_BAR;
        if (!has_next) break;
#pragma unroll
        for (int a = 0; a < 2; ++a)
#pragma unroll
            for (int b = 0; b < 2; ++b)
#pragma unroll
                for (int m = 0; m < 4; ++m)
#pragma unroll
                    for (int n = 0; n < 2; ++n) acc[a][b][m][n] = (f32x4){0.f, 0.f, 0.f, 0.f};
        cur = nxt; cA = nA; cB = nB; ++ui;
    }
    PG8_WAIT_V(0);
    if (wr == 0) PG8_BAR;
    PG8_BAR;
#undef PG8_SA
#undef PG8_SB
#undef PG8_STAGE
#undef PG8_LDX
#undef PG8_LDA
#undef PG8_LDB
#undef PG8_MMA
#undef PG8_WAIT_V
#undef PG8_WAIT_L
#undef PG8_BAR
#undef PG8_SCHED
}
}
using pg8::Unit;

struct EpiProj {
    static constexpr bool PERM = true;
    unsigned char* ws; const float* lb; const float* ng; float* kmean;
    __device__ __forceinline__ void operator()(const f32x4 (&acc)[2][2][4][2], const Unit& u, int wr, int wc, int fr, int fq) const {
        const int pn = u.pn; int seg, colt, ldc; size_t boff;
        if (pn < 14) { seg = pn >> 1; colt = (pn & 1) * 256; ldc = 512; boff = OFF_QA + (size_t)seg * SZ_T512; }
        else if (pn < 18) { seg = 7; colt = (pn - 14) * 256; ldc = 1024; boff = OFF_GA; }
        else { seg = 8; colt = (pn - 18) * 256; ldc = 1024; boff = OFF_GB; }
        bf16_t* base = (bf16_t*)(ws + boff);
        const int row0 = u.pm * 256 + wr * 64 + fr, col0 = colt + wc * 32 + 8 * fq;
        float pv[2][8];
#pragma unroll
        for (int bj = 0; bj < 2; ++bj)
#pragma unroll
            for (int e = 0; e < 8; ++e) pv[bj][e] = (seg == 4) ? (1.0f - lb[col0 + bj * 128 + e]) : ((seg == 6) ? ng[col0 + bj * 128 + e] : 0.f);
        float cs[2][8];
#pragma unroll
        for (int bj = 0; bj < 2; ++bj)
#pragma unroll
            for (int e = 0; e < 8; ++e) cs[bj][e] = 0.f;
#pragma unroll
        for (int ai = 0; ai < 2; ++ai)
#pragma unroll
            for (int m = 0; m < 4; ++m) {
                bf16_t* rowp = base + (size_t)(row0 + ai * 128 + m * 16) * ldc + col0;
#pragma unroll
                for (int bj = 0; bj < 2; ++bj) {
                    float v[8];
#pragma unroll
                    for (int e = 0; e < 4; ++e) { v[e] = acc[ai][bj][m][0][e]; v[4 + e] = acc[ai][bj][m][1][e]; }
                    if (seg == 0) {
#pragma unroll
                        for (int e = 0; e < 8; ++e) v[e] *= (0.125f * LOG2E);
                    } else if (seg == 1) {
#pragma unroll
                        for (int e = 0; e < 8; ++e) cs[bj][e] += v[e];
                    } else if (seg == 3) {
#pragma unroll
                        for (int e = 0; e < 8; ++e) v[e] = v[e] * sigmoidf_(v[e]);
                    } else if (seg == 4) {
#pragma unroll
                        for (int e = 0; e < 8; ++e) v[e] = pv[bj][e] * sigmoidf_(-v[e]);
                    } else if (seg == 6) {
#pragma unroll
                        for (int e = 0; e < 8; ++e) v[e] = pv[bj][e] * v[e] * sigmoidf_(v[e]);
                    } else if (seg >= 7) {
#pragma unroll
                        for (int e = 0; e < 8; ++e) v[e] = sigmoidf_(v[e]);
                    }
                    u32x4 w; w.x = cvt_pk_bf16(v[0], v[1]); w.y = cvt_pk_bf16(v[2], v[3]); w.z = cvt_pk_bf16(v[4], v[5]); w.w = cvt_pk_bf16(v[6], v[7]);
                    *(u32x4*)(rowp + bj * 128) = w;
                }
            }
        if (seg == 1) {
#pragma unroll
            for (int bj = 0; bj < 2; ++bj)
#pragma unroll
                for (int e = 0; e < 8; ++e) {
                    float s = cs[bj][e];
                    s += __shfl_xor(s, 1); s += __shfl_xor(s, 2); s += __shfl_xor(s, 4); s += __shfl_xor(s, 8);
                    if (fr == 0) atomicAdd(kmean + (size_t)u.pm * 512 + col0 + bj * 128 + e, s);
                }
        }
    }
};
struct EpiMixA {
    static constexpr bool PERM = true;
    bf16_t* GA;
    __device__ __forceinline__ void operator()(const f32x4 (&acc)[2][2][4][2], const Unit& u, int wr, int wc, int fr, int fq) const {
        const int row0 = u.pm * 256 + wr * 64 + fr, col0 = u.pn * 256 + wc * 32 + 8 * fq;
#pragma unroll
        for (int ai = 0; ai < 2; ++ai)
#pragma unroll
            for (int m = 0; m < 4; ++m) {
                bf16_t* rowp = GA + (size_t)(row0 + ai * 128 + m * 16) * 1024 + col0;
#pragma unroll
                for (int bj = 0; bj < 2; ++bj) {
                    const u32x4 g = *(const u32x4*)(rowp + bj * 128);
                    const f32x4 a0 = acc[ai][bj][m][0], a1 = acc[ai][bj][m][1];
                    u32x4 w;
                    constexpr float S = 1.0f;
                    w.x = cvt_pk_bf16(bf_lo(g.x) * a0[0] * S, bf_hi(g.x) * a0[1] * S); w.y = cvt_pk_bf16(bf_lo(g.y) * a0[2] * S, bf_hi(g.y) * a0[3] * S);
                    w.z = cvt_pk_bf16(bf_lo(g.z) * a1[0] * S, bf_hi(g.z) * a1[1] * S); w.w = cvt_pk_bf16(bf_lo(g.w) * a1[2] * S, bf_hi(g.w) * a1[3] * S);
                    *(u32x4*)(rowp + bj * 128) = w;
                }
            }
    }
};
struct EpiMixB {
    static constexpr bool PERM = true;
    const bf16_t* GA; const bf16_t* GB; unsigned char* M8;
    __device__ __forceinline__ void operator()(const f32x4 (&acc)[2][2][4][2], const Unit& u, int wr, int wc, int fr, int fq) const {
        const int row0 = u.pm * 256 + wr * 64 + fr, col0 = u.pn * 256 + wc * 32 + 8 * fq;
#pragma unroll
        for (int ai = 0; ai < 2; ++ai)
#pragma unroll
            for (int m = 0; m < 4; ++m) {
                const size_t off = (size_t)(row0 + ai * 128 + m * 16) * 1024 + col0;
#pragma unroll
                for (int bj = 0; bj < 2; ++bj) {
                    const u32x4 g = *(const u32x4*)(GB + off + bj * 128);
                    const u32x4 mx = *(const u32x4*)(GA + off + bj * 128);
                    const f32x4 a0 = acc[ai][bj][m][0], a1 = acc[ai][bj][m][1];
                    constexpr float S = 1.0f;
                    int w0 = __builtin_amdgcn_cvt_pk_fp8_f32(bf_lo(mx.x) + bf_lo(g.x) * a0[0] * S, bf_hi(mx.x) + bf_hi(g.x) * a0[1] * S, 0, false); w0 = __builtin_amdgcn_cvt_pk_fp8_f32(bf_lo(mx.y) + bf_lo(g.y) * a0[2] * S, bf_hi(mx.y) + bf_hi(g.y) * a0[3] * S, w0, true);
                    int w1 = __builtin_amdgcn_cvt_pk_fp8_f32(bf_lo(mx.z) + bf_lo(g.z) * a1[0] * S, bf_hi(mx.z) + bf_hi(g.z) * a1[1] * S, 0, false); w1 = __builtin_amdgcn_cvt_pk_fp8_f32(bf_lo(mx.w) + bf_lo(g.w) * a1[2] * S, bf_hi(mx.w) + bf_hi(g.w) * a1[3] * S, w1, true);
                    *(u32x2*)(M8 + off + bj * 128) = (u32x2){(unsigned)w0, (unsigned)w1};
                }
            }
    }
};
struct EpiOut {
    static constexpr bool PERM = true;
    const float* ada; bf16_t* D;
    __device__ __forceinline__ void operator()(const f32x4 (&acc)[2][2][4][2], const Unit& u, int wr, int wc, int fr, int fq) const {
        const int row0 = u.pm * 256 + wr * 64 + fr, col0 = u.pn * 256 + wc * 32 + 8 * fq;
        const float* gt1 = ada + (size_t)(u.pm >> 3) * 6144 + 2048 + col0;
        f32x4 g[2][2];
#pragma unroll
        for (int bj = 0; bj < 2; ++bj) { g[bj][0] = *(const f32x4*)(gt1 + bj * 128); g[bj][1] = *(const f32x4*)(gt1 + bj * 128 + 4); }
#pragma unroll
        for (int ai = 0; ai < 2; ++ai)
#pragma unroll
            for (int m = 0; m < 4; ++m) {
                bf16_t* rowp = D + (size_t)(row0 + ai * 128 + m * 16) * 1024 + col0;
#pragma unroll
                for (int bj = 0; bj < 2; ++bj) {
                    const f32x4 a0 = acc[ai][bj][m][0] * g[bj][0], a1 = acc[ai][bj][m][1] * g[bj][1];
                    u32x4 w; w.x = cvt_pk_bf16(a0[0], a0[1]); w.y = cvt_pk_bf16(a0[2], a0[3]); w.z = cvt_pk_bf16(a1[0], a1[1]); w.w = cvt_pk_bf16(a1[2], a1[3]);
                    *(u32x4*)(rowp + bj * 128) = w;
                }
            }
    }
};
struct EpiBf16 {
    static constexpr bool PERM = true;
    bf16_t* O;
    __device__ __forceinline__ void operator()(const f32x4 (&acc)[2][2][4][2], const Unit& u, int wr, int wc, int fr, int fq) const {
        const int row0 = u.pm * 256 + wr * 64 + fr, col0 = u.pn * 256 + wc * 32 + 8 * fq;
#pragma unroll
        for (int ai = 0; ai < 2; ++ai)
#pragma unroll
            for (int m = 0; m < 4; ++m) {
                bf16_t* rowp = O + (size_t)(row0 + ai * 128 + m * 16) * 1024 + col0;
#pragma unroll
                for (int bj = 0; bj < 2; ++bj) {
                    const f32x4 a0 = acc[ai][bj][m][0], a1 = acc[ai][bj][m][1];
                    u32x4 w; w.x = cvt_pk_bf16(a0[0], a0[1]); w.y = cvt_pk_bf16(a0[2], a0[3]); w.z = cvt_pk_bf16(a1[0], a1[1]); w.w = cvt_pk_bf16(a1[2], a1[3]);
                    *(u32x4*)(rowp + bj * 128) = w;
                }
            }
    }
};

__device__ void phase0a(const Params& P, LAS unsigned char* lds) {
    const int tid = tid_opaque(), G = gridDim.x, bid = blockIdx.x;
    for (int it = bid; it < 192; it += G) {
        LAS float* sc = (LAS float*)lds;
        for (int i = tid; i < 32 * 1024; i += NTHR) { const float cv = P.c[i]; sc[i] = cv * sigmoidf_(cv); }
        __syncthreads();
        const int kg = tid >> 5, col = tid & 31;
        float a[32];
#pragma unroll
        for (int b = 0; b < 32; ++b) a[b] = 0.f;
#pragma unroll 1
        for (int k = kg * 64; k < kg * 64 + 64; k += 8) {
            float w[8];
#pragma unroll
            for (int e = 0; e < 8; ++e) w[e] = __builtin_nontemporal_load(P.w_ada + (size_t)(k + e) * 6144 + it * 32 + col);
#pragma unroll
            for (int e4 = 0; e4 < 2; ++e4) {
#pragma unroll
                for (int b = 0; b < 32; ++b) { const f32x4 s = *(const LAS f32x4*)(sc + b * 1024 + k + 4 * e4); a[b] += s[0] * w[4 * e4] + s[1] * w[4 * e4 + 1] + s[2] * w[4 * e4 + 2] + s[3] * w[4 * e4 + 3]; }
                asm volatile("" ::: "memory");
            }
        }
        __syncthreads();
        LAS float* red = (LAS float*)lds;
#pragma unroll
        for (int b = 0; b < 32; ++b) red[(kg * 32 + b) * 32 + col] = a[b];
        __syncthreads();
        for (int o = tid; o < 1024; o += NTHR) { const int b = o >> 5, cc = o & 31; float s = 0.f;
#pragma unroll
            for (int g2 = 0; g2 < 16; ++g2) s += red[(g2 * 32 + b) * 32 + cc];
            ((float*)(P.ws + OFF_ADA))[(size_t)b * 6144 + it * 32 + cc] = s + P.b_ada[it * 32 + cc]; }
        __syncthreads();
    }
    const size_t gsz = (size_t)G * NTHR;
    { const int gt = bid * NTHR + tid, gs = G * NTHR;
      if (gt < 512) ((float*)(P.ws + OFF_LB))[gt] = sigmoidf_(P.hgrn_lb[gt] - P.hgrn_lb[512 + gt]);
      for (int i = gt; i < 32 * 8 * 512; i += gs) ((float*)(P.ws + OFF_KMEAN))[i] = 0.f; }
    {
        LAS float* tile = (LAS float*)lds;
        const int I0 = 16 * 88, I1 = I0 + 8 * 16, I2 = I1 + 8 * 16, I3 = I2 + 16 * 16, I4 = I3 + 16 * 16;
        for (int it = bid; it < I4; it += G) {
            const float* W; bf16_t* WT; int K, N, r;
            if (it < I0) { W = P.w_in; WT = (bf16_t*)(P.ws + OFF_WIN); K = 1024; N = 5632; r = it; }
            else if (it < I1) { W = P.w_ba; WT = (bf16_t*)(P.ws + OFF_WBA); K = 512; N = 1024; r = it - I0; }
            else if (it < I2) { W = P.w_bb; WT = (bf16_t*)(P.ws + OFF_WBB); K = 512; N = 1024; r = it - I1; }
            else if (it < I3) { W = P.w_out; WT = (bf16_t*)(P.ws + OFF_WOUT); K = 1024; N = 1024; r = it - I2; }
            else { W = P.peer_wq; WT = (bf16_t*)(P.ws + OFF_WQ); K = 1024; N = 1024; r = it - I3; }
            const int nb = N / 64, k0 = (r / nb) * 64, n0 = (r % nb) * 64;
#pragma unroll
            for (int ps = 0; ps < 2; ++ps) { const int kk = (tid >> 4) + 32 * ps, n4 = (tid & 15) * 4;
                const f32x4 v = *(const f32x4*)(W + (size_t)(k0 + kk) * N + n0 + n4);
                tile[kk * 65 + n4] = v[0]; tile[kk * 65 + n4 + 1] = v[1]; tile[kk * 65 + n4 + 2] = v[2]; tile[kk * 65 + n4 + 3] = v[3]; }
            __syncthreads();
            { const int n = tid >> 3, kc = (tid & 7) * 8;
              if (it < I3) {
                  int w0 = __builtin_amdgcn_cvt_pk_fp8_f32(32.f * tile[(kc + 0) * 65 + n], 32.f * tile[(kc + 1) * 65 + n], 0, false); w0 = __builtin_amdgcn_cvt_pk_fp8_f32(32.f * tile[(kc + 2) * 65 + n], 32.f * tile[(kc + 3) * 65 + n], w0, true);
                  int w1 = __builtin_amdgcn_cvt_pk_fp8_f32(32.f * tile[(kc + 4) * 65 + n], 32.f * tile[(kc + 5) * 65 + n], 0, false); w1 = __builtin_amdgcn_cvt_pk_fp8_f32(32.f * tile[(kc + 6) * 65 + n], 32.f * tile[(kc + 7) * 65 + n], w1, true);
                  *(u32x2*)((unsigned char*)WT + (size_t)(n0 + n) * K + k0 + kc) = (u32x2){(unsigned)w0, (unsigned)w1};
              } else { u32x4 w;
              w.x = cvt_pk_bf16(tile[(kc + 0) * 65 + n], tile[(kc + 1) * 65 + n]); w.y = cvt_pk_bf16(tile[(kc + 2) * 65 + n], tile[(kc + 3) * 65 + n]);
              w.z = cvt_pk_bf16(tile[(kc + 4) * 65 + n], tile[(kc + 5) * 65 + n]); w.w = cvt_pk_bf16(tile[(kc + 6) * 65 + n], tile[(kc + 7) * 65 + n]);
              *(u32x4*)(WT + (size_t)(n0 + n) * K + k0 + kc) = w; } }
            __syncthreads();
        }
    }
    {
        const size_t gtid = (size_t)bid * NTHR + tid_opaque();
        for (size_t i = gtid; i < 16384; i += gsz) {
            const float* src = P.peer_sk + i * 8; const f32x4 a = *(const f32x4*)src, b = *(const f32x4*)(src + 4);
            u32x4 w; w.x = cvt_pk_bf16(a[0], a[1]); w.y = cvt_pk_bf16(a[2], a[3]); w.z = cvt_pk_bf16(b[0], b[1]); w.w = cvt_pk_bf16(b[2], b[3]);
            *(u32x4*)((bf16_t*)(P.ws + OFF_SK) + i * 8) = w;
        }
        { const int lane = tid & 63, gw = bid * 8 + (tid >> 6), ngw = G * 8;
          for (int r = gw; r < 2 * 16384; r += ngw) {
              const bool isv = r >= 16384; const int e = isv ? r - 16384 : r;
              const float* s = (isv ? P.peer_v : P.peer_u) + (size_t)e * 1024 + lane * 16;
              f32x4 x[4]; float ss = 0.f;
#pragma unroll
              for (int q = 0; q < 4; ++q) { x[q] = __builtin_nontemporal_load((const f32x4*)(s + 4 * q)); ss += (x[q][0] * x[q][0] + x[q][1] * x[q][1]) + (x[q][2] * x[q][2] + x[q][3] * x[q][3]); }
              const float sc = fmaxf(sqrtf(wave_sum(ss) * (1.0f / 1024.0f)) * (2.6f / 7.5f), 1e-30f), inv = 1.0f / sc;
              unsigned nb[16];
#pragma unroll
              for (int q = 0; q < 4; ++q)
#pragma unroll
                  for (int el = 0; el < 4; ++el) nb[4 * q + el] = (unsigned)fminf(fmaxf(floorf(x[q][el] * inv) + 8.0f, 0.0f), 15.0f);
              u32x2 w;
              w.x = (nb[0] | (nb[4] << 4)) | ((nb[1] | (nb[5] << 4)) << 8) | ((nb[2] | (nb[6] << 4)) << 16) | ((nb[3] | (nb[7] << 4)) << 24);
              w.y = (nb[8] | (nb[12] << 4)) | ((nb[9] | (nb[13] << 4)) << 8) | ((nb[10] | (nb[14] << 4)) << 16) | ((nb[11] | (nb[15] << 4)) << 24);
              if (!isv) { w.x ^= 0x88888888u; w.y ^= 0x88888888u; }
              else { w.x ^= 0x80808080u; w.y ^= 0x80808080u; }
              *(u32x2*)(P.ws + (isv ? OFF_V8 : OFF_U8) + (size_t)e * 512 + lane * 8) = w;
              if (lane == 0) ((float*)(P.ws + (isv ? OFF_VSC : OFF_USC)))[e] = sc;
          } }
    }
}
__device__ void phase0b(const Params& P) {
    const size_t gtid = (size_t)blockIdx.x * NTHR + threadIdx.x, gsz = (size_t)gridDim.x * NTHR;
    const float* ada = (const float*)(P.ws + OFF_ADA); bf16_t* H = (bf16_t*)(P.ws + OFF_H);
    for (size_t i = gtid; i < (size_t)NTOK * 128; i += gsz) {
        const size_t row = i >> 7; const int c8 = (int)(i & 127) * 8; const int b = (int)(row >> 11);
        const float* xr = P.x + row * 1024 + c8; const float* sh = ada + (size_t)b * 6144 + c8; const float* sc = sh + 1024;
        const f32x4 x0 = *(const f32x4*)xr, x1 = *(const f32x4*)(xr + 4), s0 = *(const f32x4*)sc, s1 = *(const f32x4*)(sc + 4), h0 = *(const f32x4*)sh, h1 = *(const f32x4*)(sh + 4);
        const f32x4 r0 = x0 * (s0 + 1.0f) + h0, r1 = x1 * (s1 + 1.0f) + h1;
        int w0 = __builtin_amdgcn_cvt_pk_fp8_f32(r0[0], r0[1], 0, false); w0 = __builtin_amdgcn_cvt_pk_fp8_f32(r0[2], r0[3], w0, true);
        int w1 = __builtin_amdgcn_cvt_pk_fp8_f32(r1[0], r1[1], 0, false); w1 = __builtin_amdgcn_cvt_pk_fp8_f32(r1[2], r1[3], w1, true);
        *(u32x2*)((unsigned char*)H + row * 1024 + c8) = (u32x2){(unsigned)w0, (unsigned)w1};
    }
}

__device__ __forceinline__ s16x4 tr4(const LAS unsigned char* p) { return __builtin_bit_cast(s16x4, __builtin_amdgcn_ds_read_tr16_b64_v4i16((LAS s16x4*)p)); }
__device__ void hgrn_item(const Params& P, int item, LAS unsigned char* lds) {
    const int tid = tid_opaque(), lane = tid & 63, wid = __builtin_amdgcn_readfirstlane(tid >> 6), r32 = lane & 31, hi = lane >> 5;
    const int b = item >> 3, h = (item >> 1) & 3, vh = item & 1;
    const bf16_t* HQ = (const bf16_t*)(P.ws + OFF_HQ); const bf16_t* HK = (const bf16_t*)(P.ws + OFF_HK); bf16_t* HI = (bf16_t*)(P.ws + OFF_HI);
    constexpr int SQ = 272, SKD = 320, SV = 192, SS = 192;
    constexpr int LQR = 0, LKR = 17408, LQB = 34816, LKD = 52224, LV = 72704, LS = 84992, LG = 109568, LT = 142336, LCL = 144384;
    LAS float* G = (LAS float*)(lds + LG); LAS float* TOT = (LAS float*)(lds + LT); LAS float* CL = (LAS float*)(lds + LCL);
    const size_t rowb = (size_t)b * SEQ;
    const int row = tid >> 3, seg = tid & 7;
    const bf16_t* qsrc = HQ + (rowb + row) * 512 + h * 128 + seg * 16; const bf16_t* ksrc = HK + (rowb + row) * 512 + h * 128 + seg * 16;
    bf16_t* vsrc = HI + (rowb + row) * 512 + h * 128 + vh * 64 + seg * 8;
    for (int i = tid; i < 128 * SS / 4; i += NTHR) ((LAS unsigned*)(lds + LS))[i] = 0u;
    f32x16 Sacc = {};
    const int di = wid >> 1, vi = wid & 1, ti = wid >> 1;
    const int tg = lane >> 4, tc = tg & 1, tI = lane & 15;
    const int trow = 4 * hi + (tI >> 2), tcol = 16 * tc + 4 * (tI & 3);
    u32x4 qn0 = *(const u32x4*)qsrc, qn1 = *(const u32x4*)(qsrc + 8), kn0 = *(const u32x4*)ksrc, kn1 = *(const u32x4*)(ksrc + 8), vn = *(const u32x4*)vsrc;
#pragma unroll 1
    for (int n = 0; n < SEQ / 64; ++n) {
        const u32x4 q0 = qn0, q1 = qn1, k0 = kn0, k1 = kn1, vv = vn;
        float qf[16] = {bf_lo(q0.x), bf_hi(q0.x), bf_lo(q0.y), bf_hi(q0.y), bf_lo(q0.z), bf_hi(q0.z), bf_lo(q0.w), bf_hi(q0.w), bf_lo(q1.x), bf_hi(q1.x), bf_lo(q1.y), bf_hi(q1.y), bf_lo(q1.z), bf_hi(q1.z), bf_lo(q1.w), bf_hi(q1.w)};
        float kf[16] = {bf_lo(k0.x), bf_hi(k0.x), bf_lo(k0.y), bf_hi(k0.y), bf_lo(k0.z), bf_hi(k0.z), bf_lo(k0.w), bf_hi(k0.w), bf_lo(k1.x), bf_hi(k1.x), bf_lo(k1.y), bf_hi(k1.y), bf_lo(k1.z), bf_hi(k1.z), bf_lo(k1.w), bf_hi(k1.w)};
#pragma unroll
        for (int e4 = 0; e4 < 4; ++e4) *(LAS f32x4*)(G + row * 128 + seg * 16 + 4 * e4) = (f32x4){__logf(1.0f - kf[4 * e4]), __logf(1.0f - kf[4 * e4 + 1]), __logf(1.0f - kf[4 * e4 + 2]), __logf(1.0f - kf[4 * e4 + 3])};
        *(LAS u32x4*)(lds + LV + row * SV + seg * 16) = vv;
        if (n + 1 < SEQ / 64) { const size_t o = (size_t)(n + 1) * 64 * 512; qn0 = *(const u32x4*)(qsrc + o); qn1 = *(const u32x4*)(qsrc + o + 8); kn0 = *(const u32x4*)(ksrc + o); kn1 = *(const u32x4*)(ksrc + o + 8); vn = *(const u32x4*)(vsrc + o); }
        __syncthreads();
        { const int d = tid & 127, q4 = tid >> 7; float s = 0.f;
#pragma unroll
          for (int i = 0; i < 16; ++i) { s += G[(16 * q4 + i) * 128 + d]; G[(16 * q4 + i) * 128 + d] = s; }
          TOT[q4 * 128 + d] = s; }
        __syncthreads();
        {
            const int qq = row >> 4;
#pragma unroll
            for (int e4 = 0; e4 < 4; ++e4) {
                const int d4 = seg * 16 + 4 * e4;
                const f32x4 t0 = *(const LAS f32x4*)(TOT + d4), t1 = *(const LAS f32x4*)(TOT + 128 + d4), t2 = *(const LAS f32x4*)(TOT + 256 + d4), t3 = *(const LAS f32x4*)(TOT + 384 + d4);
                const f32x4 off = (qq == 0) ? (f32x4){0.f, 0.f, 0.f, 0.f} : ((qq == 1) ? t0 : ((qq == 2) ? t0 + t1 : t0 + t1 + t2));
                const f32x4 bb = *(const LAS f32x4*)(G + row * 128 + d4) + off;
                const f32x4 bref = *(const LAS f32x4*)(G + 32 * 128 + d4) + t0 + t1, blast = t0 + t1 + t2 + t3;
                float vqb[4], vqr[4], vkr[4], vkd[4];
#pragma unroll
                for (int e = 0; e < 4; ++e) {
                    const float e1 = __expf(bb[e]), e2 = __expf(-bb[e]);
                    vqb[e] = qf[4 * e4 + e] * e1; vqr[e] = vqb[e] * __expf(-bref[e]);
                    const float ke = kf[4 * e4 + e] * e2; vkr[e] = ke * __expf(bref[e]); vkd[e] = ke * __expf(blast[e]);
                }
                *(LAS u32x2*)(lds + LQB + row * SQ + seg * 32 + 8 * e4) = (u32x2){cvt_pk_bf16(vqb[0], vqb[1]), cvt_pk_bf16(vqb[2], vqb[3])};
                *(LAS u32x2*)(lds + LQR + row * SQ + seg * 32 + 8 * e4) = (u32x2){cvt_pk_bf16(vqr[0], vqr[1]), cvt_pk_bf16(vqr[2], vqr[3])};
                *(LAS u32x2*)(lds + LKR + row * SQ + seg * 32 + 8 * e4) = (u32x2){cvt_pk_bf16(vkr[0], vkr[1]), cvt_pk_bf16(vkr[2], vkr[3])};
                *(LAS u32x2*)(lds + LKD + row * SKD + seg * 32 + 8 * e4) = (u32x2){cvt_pk_bf16(vkd[0], vkd[1]), cvt_pk_bf16(vkd[2], vkd[3])};
                if (row == 0) *(LAS f32x4*)(CL + d4) = (f32x4){__expf(blast[0]), __expf(blast[1]), __expf(blast[2]), __expf(blast[3])};
                asm volatile("" ::: "memory");
            }
        }
        __syncthreads();
        if (wid < 4) {
            f32x16 Z = {};
            for (int si = 0; si <= ti; ++si) {
                f32x16 X = {};
#pragma unroll
                for (int ks = 0; ks < 8; ++ks) {
                    const bf16x8 a = *(const LAS bf16x8*)(lds + LKR + (32 * si + r32) * SQ + (16 * ks + 8 * hi) * 2);
                    const bf16x8 bq = *(const LAS bf16x8*)(lds + LQR + (32 * ti + r32) * SQ + (16 * ks + 8 * hi) * 2);
                    X = MFMA32(a, bq, X);
                }
                if (si == ti) {
#pragma unroll
                    for (int r = 0; r < 16; ++r) if (crow(r, hi) > r32) X[r] = 0.f;
                }
#pragma unroll
                for (int s2 = 0; s2 < 2; ++s2) {
                    union { u32x4 u; bf16x8 v; } pa;
                    pa.u.x = cvt_pk_bf16(X[8 * s2 + 0], X[8 * s2 + 1]); pa.u.y = cvt_pk_bf16(X[8 * s2 + 2], X[8 * s2 + 3]); pa.u.z = cvt_pk_bf16(X[8 * s2 + 4], X[8 * s2 + 5]); pa.u.w = cvt_pk_bf16(X[8 * s2 + 6], X[8 * s2 + 7]);
                    const LAS unsigned char* vp = lds + LV + (32 * si + 16 * s2 + trow) * SV + (32 * vi + tcol) * 2;
                    const s16x4 lo = tr4(vp), hh = tr4(vp + 8 * SV);
                    const bf16x8 vf = {lo[0], lo[1], lo[2], lo[3], hh[0], hh[1], hh[2], hh[3]};
                    Z = MFMA32(pa.v, vf, Z);
                }
            }
#pragma unroll
            for (int ks = 0; ks < 8; ++ks) {
                const bf16x8 a = *(const LAS bf16x8*)(lds + LQB + (32 * ti + r32) * SQ + (16 * ks + 8 * hi) * 2);
                const LAS unsigned char* sp = lds + LS + (16 * ks + 8 * hi + (tI >> 2)) * SS + (32 * vi + tcol) * 2;
                const s16x4 lo = tr4(sp), hh = tr4(sp + 4 * SS);
                const bf16x8 sf = {lo[0], lo[1], lo[2], lo[3], hh[0], hh[1], hh[2], hh[3]};
                Z = MFMA32(a, sf, Z);
            }
            bf16_t* op = HI + (rowb + (size_t)n * 64 + 32 * ti) * 512 + h * 128 + vh * 64 + 32 * vi + r32;
#pragma unroll
            for (int r = 0; r < 16; ++r) op[(size_t)crow(r, hi) * 512] = (bf16_t)(cvt_pk_bf16(Z[r], 0.f) & 0xffffu);
        }
        {
#pragma unroll
            for (int r = 0; r < 16; ++r) Sacc[r] *= CL[32 * di + crow(r, hi)];
#pragma unroll
            for (int ks = 0; ks < 4; ++ks) {
                const LAS unsigned char* kp = lds + LKD + (16 * ks + 8 * hi + (tI >> 2)) * SKD + (32 * di + tcol) * 2;
                const s16x4 klo = tr4(kp), khi = tr4(kp + 4 * SKD);
                const bf16x8 ka = {klo[0], klo[1], klo[2], klo[3], khi[0], khi[1], khi[2], khi[3]};
                const LAS unsigned char* vp = lds + LV + (16 * ks + 8 * hi + (tI >> 2)) * SV + (32 * vi + tcol) * 2;
                const s16x4 vlo = tr4(vp), vhi = tr4(vp + 4 * SV);
                const bf16x8 vb = {vlo[0], vlo[1], vlo[2], vlo[3], vhi[0], vhi[1], vhi[2], vhi[3]};
                Sacc = MFMA32(ka, vb, Sacc);
            }
        }
        __syncthreads();
        {
            LAS bf16_t* sp = (LAS bf16_t*)(lds + LS + (32 * di) * SS + (32 * vi + r32) * 2);
#pragma unroll
            for (int r = 0; r < 16; ++r) sp[crow(r, hi) * (SS / 2)] = (bf16_t)(cvt_pk_bf16(Sacc[r], 0.f) & 0xffffu);
        }
    }
    __syncthreads();
}

__device__ void moba_unit(const Params& P, int b, int h, int j, LAS unsigned char* lds) {
    const int tid = tid_opaque(), lane = tid & 63, wid = tid >> 6, r32 = lane & 31, hi = lane >> 5;
    bf16_t* Q = (bf16_t*)(P.ws + OFF_QA); const bf16_t* Kg = (const bf16_t*)(P.ws + OFF_KA); const bf16_t* Vg = (const bf16_t*)(P.ws + OFF_VA);
    const float* kmean = (const float*)(P.ws + OFF_KMEAN);
    constexpr int KIMG = 64 * 144, VIMG = 64 * 192, LK = 0, LV = 4 * KIMG, LKM = 4 * KIMG + 4 * VIMG;
    LAS float* kmL = (LAS float*)(lds + LKM);
    const size_t rowb = (size_t)b * SEQ; const int q0 = j * 256;
    if (tid < j * 64) kmL[tid] = kmean[(size_t)(b * 8 + (tid >> 6)) * 512 + h * 64 + (tid & 63)];
    bf16_t* qrow = Q + (rowb + q0 + wid * 32 + r32) * 512 + h * 64;
    bf16x8 qf[4];
#pragma unroll
    for (int d0 = 0; d0 < 4; ++d0) qf[d0] = *(const bf16x8*)(qrow + 16 * d0 + 8 * hi);
    const int srow = tid >> 3, sch = tid & 7;
    const bf16_t* ksrc = Kg + (rowb + srow) * 512 + h * 64 + sch * 8; const bf16_t* vsrc = Vg + (rowb + srow) * 512 + h * 64 + sch * 8;
    const int ntile = 4 * (j + 1), npair = ntile >> 1;
    auto tile_key0 = [&](int i) -> size_t { const int blk = (i < 4) ? j : ((i - 4) >> 2), kt = (i < 4) ? i : ((i - 4) & 3); return (size_t)(blk * 256 + kt * 64); };
    u32x4 kreg[2], vreg[2];
#pragma unroll
    for (int s = 0; s < 2; ++s) { const size_t k0 = tile_key0(s); kreg[s] = *(const u32x4*)(ksrc + k0 * 512); vreg[s] = *(const u32x4*)(vsrc + k0 * 512); }
#pragma unroll
    for (int s = 0; s < 2; ++s) { *(LAS u32x4*)(lds + LK + s * KIMG + srow * 144 + sch * 16) = kreg[s]; *(LAS u32x4*)(lds + LV + s * VIMG + srow * 192 + sch * 16) = vreg[s]; }
    __syncthreads();
    unsigned sel = 0;
    if (j <= 3) sel = (1u << j) - 1u;
    else {
        float g[7];
#pragma unroll
        for (int n = 0; n < 7; ++n) { float s = 0.f;
            if (n < j) {
#pragma unroll
                for (int d0 = 0; d0 < 4; ++d0)
#pragma unroll
                    for (int e = 0; e < 8; ++e) s += __uint_as_float(((unsigned)(unsigned short)qf[d0][e]) << 16) * kmL[n * 64 + 16 * d0 + 8 * hi + e];
            }
            s += __shfl_xor(s, 32); g[n] = s; }
#pragma unroll
        for (int it = 0; it < 3; ++it) { float best = -INFINITY; int bi = 0;
#pragma unroll
            for (int n = 0; n < 7; ++n) if (n < j && !((sel >> n) & 1u) && g[n] > best) { best = g[n]; bi = n; }
            sel |= 1u << bi; }
    }
    const float ch = exp2f(-(float)(h + 1)) * LOG2E;
    const int qb = wid * 32 + r32;
    float m_run = -1e30f, l_run = 0.f;
    f32x16 o0 = {}, o1 = {};
    const int tg = lane >> 4, tc = tg & 1, ti = lane & 15;
    const int vlane = (4 * hi + (ti >> 2)) * 192 + (16 * tc + 4 * (ti & 3)) * 2;
#pragma unroll 1
    for (int ip = 0; ip < npair; ++ip) {
      const int pbuf = ip & 1;
      if (ip + 1 < npair) {
#pragma unroll
          for (int s = 0; s < 2; ++s) { const size_t k1 = tile_key0(2 * ip + 2 + s); kreg[s] = *(const u32x4*)(ksrc + k1 * 512); vreg[s] = *(const u32x4*)(vsrc + k1 * 512); }
      }
#pragma unroll
      for (int s2 = 0; s2 < 2; ++s2) {
        const int i = 2 * ip + s2, buf = pbuf * 2 + s2;
        const bool own = i < 4; const int blk = own ? j : ((i - 4) >> 2), kt = own ? i : ((i - 4) & 3);
        const bool lane_ok = own ? true : (((sel >> blk) & 1u) != 0u);
        const bool skip = own ? (64 * kt > 32 * wid + 31) : (__ballot(lane_ok) == 0ull);
        if (!skip) {
            LAS unsigned char* kb = lds + LK + buf * KIMG; LAS unsigned char* vb = lds + LV + buf * VIMG;
            f32x16 p0 = {}, p1 = {};
#pragma unroll
            for (int d0 = 0; d0 < 4; ++d0) {
                const bf16x8 kf0 = *(const LAS bf16x8*)(kb + r32 * 144 + (16 * d0 + 8 * hi) * 2);
                const bf16x8 kf1 = *(const LAS bf16x8*)(kb + (32 + r32) * 144 + (16 * d0 + 8 * hi) * 2);
                p0 = MFMA32(kf0, qf[d0], p0); p1 = MFMA32(kf1, qf[d0], p1);
            }
            const float kbase = ch * (float)((blk - j) * 256 + kt * 64);
            float mt = -1e30f;
#pragma unroll
            for (int r = 0; r < 16; ++r) {
                const int kl0 = crow(r, hi), kl1 = kl0 + 32;
                p0[r] = __builtin_fmaf(ch, (float)kl0, p0[r]); p1[r] = __builtin_fmaf(ch, (float)kl1, p1[r]);
                if (own) { if (kt * 64 + kl0 > qb) p0[r] = -1e30f; if (kt * 64 + kl1 > qb) p1[r] = -1e30f; }
                mt = fmaxf(mt, fmaxf(p0[r], p1[r]));
            }
            mt = lane_ok ? mt + kbase : -1e30f;
            mt = fmaxf(mt, __shfl_xor(mt, 32));
            if (__ballot(mt > m_run) != 0ull) {
                const float mnew = fmaxf(m_run, mt), alpha = __builtin_amdgcn_exp2f(m_run - mnew);
                m_run = mnew; l_run *= alpha;
#pragma unroll
                for (int r = 0; r < 16; ++r) { o0[r] *= alpha; o1[r] *= alpha; }
            }
            const float sh = lane_ok ? kbase - m_run : -1e30f;
            float rs = 0.f;
#pragma unroll
            for (int r = 0; r < 16; ++r) { p0[r] = __builtin_amdgcn_exp2f(p0[r] + sh); p1[r] = __builtin_amdgcn_exp2f(p1[r] + sh); rs += p0[r] + p1[r]; }
            l_run += rs;
#pragma unroll
            for (int sub = 0; sub < 2; ++sub)
#pragma unroll
                for (int s = 0; s < 2; ++s) {
                    union { u32x4 u; bf16x8 v; } pb;
                    if (sub == 0) { pb.u.x = cvt_pk_bf16(p0[8 * s + 0], p0[8 * s + 1]); pb.u.y = cvt_pk_bf16(p0[8 * s + 2], p0[8 * s + 3]); pb.u.z = cvt_pk_bf16(p0[8 * s + 4], p0[8 * s + 5]); pb.u.w = cvt_pk_bf16(p0[8 * s + 6], p0[8 * s + 7]); }
                    else { pb.u.x = cvt_pk_bf16(p1[8 * s + 0], p1[8 * s + 1]); pb.u.y = cvt_pk_bf16(p1[8 * s + 2], p1[8 * s + 3]); pb.u.z = cvt_pk_bf16(p1[8 * s + 4], p1[8 * s + 5]); pb.u.w = cvt_pk_bf16(p1[8 * s + 6], p1[8 * s + 7]); }
#pragma unroll
                    for (int dt = 0; dt < 2; ++dt) {
                        LAS unsigned char* va = vb + (32 * sub + 16 * s) * 192 + dt * 64 + vlane;
                        const s16x4 lo = __builtin_bit_cast(s16x4, __builtin_amdgcn_ds_read_tr16_b64_v4i16((LAS s16x4*)va));
                        const s16x4 hh = __builtin_bit_cast(s16x4, __builtin_amdgcn_ds_read_tr16_b64_v4i16((LAS s16x4*)(va + 8 * 192)));
                        const bf16x8 vf = {lo[0], lo[1], lo[2], lo[3], hh[0], hh[1], hh[2], hh[3]};
                        if (dt == 0) o0 = MFMA32(vf, pb.v, o0); else o1 = MFMA32(vf, pb.v, o1);
                    }
                }
        }
      }
      if (ip + 1 < npair) { const int nb = (pbuf ^ 1) * 2;
#pragma unroll
          for (int s = 0; s < 2; ++s) { *(LAS u32x4*)(lds + LK + (nb + s) * KIMG + srow * 144 + sch * 16) = kreg[s]; *(LAS u32x4*)(lds + LV + (nb + s) * VIMG + srow * 192 + sch * 16) = vreg[s]; } }
      __syncthreads();
    }
    l_run += __shfl_xor(l_run, 32);
    const float inv = 1.0f / l_run;
#pragma unroll
    for (int r4 = 0; r4 < 4; ++r4) {
        int w0 = __builtin_amdgcn_cvt_pk_fp8_f32(o0[4 * r4] * inv, o0[4 * r4 + 1] * inv, 0, false); w0 = __builtin_amdgcn_cvt_pk_fp8_f32(o0[4 * r4 + 2] * inv, o0[4 * r4 + 3] * inv, w0, true);
        int w1 = __builtin_amdgcn_cvt_pk_fp8_f32(o1[4 * r4] * inv, o1[4 * r4 + 1] * inv, 0, false); w1 = __builtin_amdgcn_cvt_pk_fp8_f32(o1[4 * r4 + 2] * inv, o1[4 * r4 + 3] * inv, w1, true);
        unsigned char* yrow = P.ws + OFF_EG + (rowb + q0 + wid * 32 + r32) * 1024 + h * 64;
        *(int*)(yrow + 8 * r4 + 4 * hi) = w0; *(int*)(yrow + 32 + 8 * r4 + 4 * hi) = w1;
    }
}

__device__ void yb_norm_panel(const Params& P, int pm) {
    const int tid = tid_opaque(), lane = tid & 63, wid = tid >> 6;
    bf16_t* HI = (bf16_t*)(P.ws + OFF_HI); const bf16_t* HG = (const bf16_t*)(P.ws + OFF_HG);
    for (int r = 0; r < 32; ++r) {
        const size_t off = ((size_t)pm * 256 + wid * 32 + r) * 512 + lane * 8;
        const u32x4 ov = *(const u32x4*)(HI + off), gv = *(const u32x4*)(HG + off);
        float o[8] = {bf_lo(ov.x), bf_hi(ov.x), bf_lo(ov.y), bf_hi(ov.y), bf_lo(ov.z), bf_hi(ov.z), bf_lo(ov.w), bf_hi(ov.w)};
        const float g[8] = {bf_lo(gv.x), bf_hi(gv.x), bf_lo(gv.y), bf_hi(gv.y), bf_lo(gv.z), bf_hi(gv.z), bf_lo(gv.w), bf_hi(gv.w)};
        float ss = 0.f;
#pragma unroll
        for (int e = 0; e < 8; ++e) ss += o[e] * o[e];
        ss += __shfl_xor(ss, 1); ss += __shfl_xor(ss, 2); ss += __shfl_xor(ss, 4); ss += __shfl_xor(ss, 8);
        const float rs = rsqrtf(ss * (1.0f / 128.0f) + RMS_EPS);
        int w0 = __builtin_amdgcn_cvt_pk_fp8_f32(o[0] * rs * g[0], o[1] * rs * g[1], 0, false); w0 = __builtin_amdgcn_cvt_pk_fp8_f32(o[2] * rs * g[2], o[3] * rs * g[3], w0, true);
        int w1 = __builtin_amdgcn_cvt_pk_fp8_f32(o[4] * rs * g[4], o[5] * rs * g[5], 0, false); w1 = __builtin_amdgcn_cvt_pk_fp8_f32(o[6] * rs * g[6], o[7] * rs * g[7], w1, true);
        *(u32x2*)(P.ws + OFF_EG + ((size_t)pm * 256 + wid * 32 + r) * 1024 + 512 + lane * 8) = (u32x2){(unsigned)w0, (unsigned)w1};
    }
}
__device__ void ln1_panel(const Params& P, int pm) {
    const int tid = tid_opaque(), lane = tid & 63, wid = tid >> 6;
    const float* ada = (const float*)(P.ws + OFF_ADA) + (size_t)(pm >> 3) * 6144; bf16_t* H = (bf16_t*)(P.ws + OFF_H);
    for (int r = 0; r < 32; ++r) {
        const size_t row = (size_t)pm * 256 + wid * 32 + r;
        float* xr = P.out + row * 1024 + lane * 4; const float* xin = P.x + row * 1024 + lane * 4; const bf16_t* dl = (const bf16_t*)(P.ws + OFF_GB) + row * 1024 + lane * 4;
        f32x4 v[4]; float s = 0.f;
#pragma unroll
        for (int jx = 0; jx < 4; ++jx) { const u32x2 dv = *(const u32x2*)(dl + 256 * jx); const f32x4 xv = __builtin_nontemporal_load((const f32x4*)(xin + 256 * jx));
            v[jx] = xv * ALPHA + (f32x4){bf_lo(dv.x), bf_hi(dv.x), bf_lo(dv.y), bf_hi(dv.y)}; s += (v[jx][0] + v[jx][1]) + (v[jx][2] + v[jx][3]); }
        const float mean = wave_sum(s) * (1.0f / 1024.0f); float s2 = 0.f;
#pragma unroll
        for (int jx = 0; jx < 4; ++jx) { v[jx] = v[jx] - mean; s2 += (v[jx][0] * v[jx][0] + v[jx][1] * v[jx][1]) + (v[jx][2] * v[jx][2] + v[jx][3] * v[jx][3]); }
        const float rstd = rsqrtf(wave_sum(s2) * (1.0f / 1024.0f) + LN_EPS);
#pragma unroll
        for (int jx = 0; jx < 4; ++jx) {
            const int c = lane * 4 + 256 * jx;
            const f32x4 g = *(const f32x4*)(P.ln1_g + c), bb = *(const f32x4*)(P.ln1_b + c), sh = *(const f32x4*)(ada + 3072 + c), sc = *(const f32x4*)(ada + 4096 + c);
            const f32x4 x1 = v[jx] * rstd * g + bb;
            *(f32x4*)(xr + 256 * jx) = x1;
            const f32x4 h2 = x1 * (sc + 1.0f) + sh;
            u32x2 w; w.x = cvt_pk_bf16(h2[0], h2[1]); w.y = cvt_pk_bf16(h2[2], h2[3]);
            *(u32x2*)(H + row * 1024 + c) = w;
            v[jx] = h2;
        }
        {
            float mx = 0.f;
#pragma unroll
            for (int jx = 0; jx < 4; ++jx) mx = fmaxf(mx, fmaxf(fmaxf(fabsf(v[jx][0]), fabsf(v[jx][1])), fmaxf(fabsf(v[jx][2]), fabsf(v[jx][3]))));
#pragma unroll
            for (int o = 1; o < 64; o <<= 1) mx = fmaxf(mx, __shfl_xor(mx, o));
            const float hs = fmaxf(mx * (1.0f / 119.0f), 1e-30f), inv = 1.0f / hs; int qs = 0;
            const int nsh = (lane & 1) * 4;
#pragma unroll
            for (int jx = 0; jx < 4; ++jx) {
                unsigned pa = 0u, pb = 0u;
#pragma unroll
                for (int k = 0; k < 4; ++k) { const int q = (int)rintf(v[jx][k] * inv); qs += q;
                    const int b = ((q + 8) & 15) - 8, a = (q - b) >> 4;
                    pa |= (unsigned)(a & 15) << (8 * k + nsh); pb |= (unsigned)(b & 15) << (8 * k + nsh); }
                pa |= __shfl_xor(pa, 1); pb |= __shfl_xor(pb, 1);
                if (!(lane & 1)) { unsigned* hp4 = (unsigned*)(P.ws + OFF_H8 + row * 1024) + (lane >> 1) + 32 * jx; hp4[0] = pa; hp4[128] = pb; }
            }
#pragma unroll
            for (int o = 1; o < 64; o <<= 1) qs += __shfl_xor(qs, o);
            if (lane == 0) *(f32x2*)(P.ws + OFF_HS + row * 8) = (f32x2){hs, (float)qs};
        }
    }
}

#define CE16(A, i, j) do { const float hi_ = fmaxf(A[i], A[j]); A[j] = fminf(A[i], A[j]); A[i] = hi_; } while (0)
#define SORT16(A) do { CE16(A, 0, 1); CE16(A, 2, 3); CE16(A, 0, 2); CE16(A, 1, 3); CE16(A, 1, 2); CE16(A, 4, 5); CE16(A, 6, 7); CE16(A, 4, 6); CE16(A, 5, 7); CE16(A, 5, 6); CE16(A, 0, 4); CE16(A, 2, 6); CE16(A, 2, 4); CE16(A, 1, 5); CE16(A, 3, 7); CE16(A, 3, 5); CE16(A, 1, 2); CE16(A, 3, 4); CE16(A, 5, 6); CE16(A, 8, 9); CE16(A, 10, 11); CE16(A, 8, 10); CE16(A, 9, 11); CE16(A, 9, 10); CE16(A, 12, 13); CE16(A, 14, 15); CE16(A, 12, 14); CE16(A, 13, 15); CE16(A, 13, 14); CE16(A, 8, 12); CE16(A, 10, 14); CE16(A, 10, 12); CE16(A, 9, 13); CE16(A, 11, 15); CE16(A, 11, 13); CE16(A, 9, 10); CE16(A, 11, 12); CE16(A, 13, 14); CE16(A, 0, 8); CE16(A, 4, 12); CE16(A, 4, 8); CE16(A, 2, 10); CE16(A, 6, 14); CE16(A, 6, 10); CE16(A, 2, 4); CE16(A, 6, 8); CE16(A, 10, 12); CE16(A, 1, 9); CE16(A, 5, 13); CE16(A, 5, 9); CE16(A, 3, 11); CE16(A, 7, 15); CE16(A, 7, 11); CE16(A, 3, 5); CE16(A, 7, 9); CE16(A, 11, 13); CE16(A, 1, 2); CE16(A, 3, 4); CE16(A, 5, 6); CE16(A, 7, 8); CE16(A, 9, 10); CE16(A, 11, 12); CE16(A, 13, 14); } while (0)
#define BITONIC16(A) do { CE16(A, 0, 8); CE16(A, 1, 9); CE16(A, 2, 10); CE16(A, 3, 11); CE16(A, 4, 12); CE16(A, 5, 13); CE16(A, 6, 14); CE16(A, 7, 15); CE16(A, 0, 4); CE16(A, 1, 5); CE16(A, 2, 6); CE16(A, 3, 7); CE16(A, 8, 12); CE16(A, 9, 13); CE16(A, 10, 14); CE16(A, 11, 15); CE16(A, 0, 2); CE16(A, 1, 3); CE16(A, 4, 6); CE16(A, 5, 7); CE16(A, 8, 10); CE16(A, 9, 11); CE16(A, 12, 14); CE16(A, 13, 15); CE16(A, 0, 1); CE16(A, 2, 3); CE16(A, 4, 5); CE16(A, 6, 7); CE16(A, 8, 9); CE16(A, 10, 11); CE16(A, 12, 13); CE16(A, 14, 15); } while (0)
#define INS16(L, xin) do { float x_ = (xin); _Pragma("unroll") for (int k_ = 0; k_ < 16; ++k_) { const float hi_ = fmaxf(L[k_], x_); x_ = fminf(L[k_], x_); L[k_] = hi_; } } while (0)

__device__ void peer_select_wave(const Params& P, size_t tok0) {
    const int lane = tid_opaque() & 63, r32 = lane & 31, hi = lane >> 5;
    const bf16_t* QP = (const bf16_t*)(P.ws + OFF_GB) + (tok0 + r32) * 1024; const bf16_t* SK = (const bf16_t*)(P.ws + OFF_SK);
    u32x2* EG = (u32x2*)(P.ws + OFF_EG) + (tok0 + r32) * 128;
#pragma unroll 1
    for (int h = 0; h < 8; ++h) {
        float a0[16], a1[16];
#pragma unroll
        for (int k = 0; k < 16; ++k) { a0[k] = -INFINITY; a1[k] = -INFINITY; }
#pragma unroll
        for (int p = 0; p < 2; ++p) {
            const int hp = h * 2 + p;
            bf16x8 qf[4];
#pragma unroll
            for (int ks = 0; ks < 4; ++ks) qf[ks] = *(const bf16x8*)(QP + hp * 64 + 16 * ks + 8 * hi);
            float L[16];
#pragma unroll
            for (int kt = 0; kt < 4; ++kt) {
                f32x16 acc = {};
#pragma unroll
                for (int ks = 0; ks < 4; ++ks) { const bf16x8 kf = *(const bf16x8*)(SK + ((size_t)hp * 128 + 32 * kt + r32) * 64 + 16 * ks + 8 * hi); acc = MFMA32(kf, qf[ks], acc); }
                float S[16];
#pragma unroll
                for (int r = 0; r < 16; ++r) { const unsigned key = (unsigned)(32 * kt + crow(r, hi)); S[r] = __uint_as_float((__float_as_uint(acc[r]) & ~127u) | key); }
                SORT16(S);
                if (kt == 0) {
#pragma unroll
                    for (int k = 0; k < 16; ++k) L[k] = S[k];
                } else {
#pragma unroll
                    for (int k = 0; k < 16; ++k) L[k] = fmaxf(L[k], S[15 - k]);
                    BITONIC16(L);
                }
            }
            {
                float O[16];
#pragma unroll
                for (int k = 0; k < 16; ++k) O[k] = __shfl_xor(L[15 - k], 32);
#pragma unroll
                for (int k = 0; k < 16; ++k) L[k] = fmaxf(L[k], O[k]);
                BITONIC16(L);
            }
#pragma unroll
            for (int k = 0; k < 16; ++k) { a0[k] = (p == 0) ? L[k] : a0[k]; a1[k] = (p == 1) ? L[k] : a1[k]; }
        }
        float best[16];
#pragma unroll
        for (int k = 0; k < 16; ++k) best[k] = __uint_as_float((__float_as_uint(a0[0] + a1[k]) & ~255u) | (unsigned)k);
#pragma unroll
        for (int i = 1; i < 16; ++i)
#pragma unroll
            for (int jx = 0; jx < 16; ++jx)
                if ((i + 1) * (jx + 1) <= 16) {
                    const float cs = a0[i] + a1[jx];
                    const float cv = __uint_as_float((__float_as_uint(cs) & ~255u) | (unsigned)(i * 16 + jx));
                    INS16(best, cv);
                }
        unsigned pk0[4], pk1[4];
#pragma unroll
        for (int q = 0; q < 4; ++q) {
            pk0[q] = (__float_as_uint(a0[4 * q]) & 127u) | ((__float_as_uint(a0[4 * q + 1]) & 127u) << 8) | ((__float_as_uint(a0[4 * q + 2]) & 127u) << 16) | ((__float_as_uint(a0[4 * q + 3]) & 127u) << 24);
            pk1[q] = (__float_as_uint(a1[4 * q]) & 127u) | ((__float_as_uint(a1[4 * q + 1]) & 127u) << 8) | ((__float_as_uint(a1[4 * q + 2]) & 127u) << 16) | ((__float_as_uint(a1[4 * q + 3]) & 127u) << 24);
        }
        unsigned pay[16];
#pragma unroll
        for (int k = 0; k < 16; ++k) {
            const unsigned code = __float_as_uint(best[k]) & 255u, ci = code >> 4, cj = code & 15u;
            const unsigned qi = ci >> 2, qj = cj >> 2;
            const unsigned w0 = (qi == 0u) ? pk0[0] : ((qi == 1u) ? pk0[1] : ((qi == 2u) ? pk0[2] : pk0[3]));
            const unsigned w1 = (qj == 0u) ? pk1[0] : ((qj == 1u) ? pk1[1] : ((qj == 2u) ? pk1[2] : pk1[3]));
            pay[k] = (((w0 >> ((ci & 3u) * 8u)) & 127u) << 7) | ((w1 >> ((cj & 3u) * 8u)) & 127u);
        }
        float e[16], es = 0.f;
#pragma unroll
        for (int k = 0; k < 16; ++k) { e[k] = __expf(best[k] - best[0]); es += e[k]; }
        const float inv = 1.0f / es;
        if (hi == 0) {
#pragma unroll
            for (int k = 0; k < 16; ++k) { u32x2 w; w.x = pay[k]; w.y = __float_as_uint(e[k] * inv); EG[h * 16 + k] = w; }
        }
    }
}
__device__ __forceinline__ unsigned xcc_id() { return (unsigned)__builtin_amdgcn_s_getreg((3 << 11) | 20) & 0xFu; }
template <int CTRL> __device__ __forceinline__ float dpp_add(float x) { const int v = __builtin_amdgcn_update_dpp(0, __float_as_int(x), CTRL, 0xf, 0xf, true); return x + __int_as_float(v); }
__device__ __forceinline__ float wave_sum_fast(float x) {
    x = dpp_add<0xB1>(x); x = dpp_add<0x4E>(x); x = dpp_add<0x141>(x); x = dpp_add<0x140>(x);
    x += __shfl_xor(x, 16); x += __shfl_xor(x, 32); return x;
}
template <int CTRL> __device__ __forceinline__ float dpp_max(float x) { const int v = __builtin_amdgcn_update_dpp(0, __float_as_int(x), CTRL, 0xf, 0xf, true); return fmaxf(x, __int_as_float(v)); }
template <int CTRL> __device__ __forceinline__ int dpp_addi(int x) { return x + __builtin_amdgcn_update_dpp(0, x, CTRL, 0xf, 0xf, true); }
__device__ __forceinline__ float wave_max_fast(float x) {
    x = dpp_max<0xB1>(x); x = dpp_max<0x4E>(x); x = dpp_max<0x141>(x); x = dpp_max<0x140>(x);
    x = fmaxf(x, __shfl_xor(x, 16)); x = fmaxf(x, __shfl_xor(x, 32)); return x;
}
__device__ __forceinline__ int wave_sum_int_fast(int x) {
    x = dpp_addi<0xB1>(x); x = dpp_addi<0x4E>(x); x = dpp_addi<0x141>(x); x = dpp_addi<0x140>(x);
    x += __shfl_xor(x, 16); x += __shfl_xor(x, 32); return x;
}
__device__ __forceinline__ float dot16_fp8(const float (&hv)[16], const u32x4 r) {
    float s = 0.f;
    { const f32x2 a = __builtin_amdgcn_cvt_pk_f32_fp8((int)r.x, false), b = __builtin_amdgcn_cvt_pk_f32_fp8((int)r.x, true); s += hv[0] * a.x + hv[1] * a.y + hv[2] * b.x + hv[3] * b.y; }
    { const f32x2 a = __builtin_amdgcn_cvt_pk_f32_fp8((int)r.y, false), b = __builtin_amdgcn_cvt_pk_f32_fp8((int)r.y, true); s += hv[4] * a.x + hv[5] * a.y + hv[6] * b.x + hv[7] * b.y; }
    { const f32x2 a = __builtin_amdgcn_cvt_pk_f32_fp8((int)r.z, false), b = __builtin_amdgcn_cvt_pk_f32_fp8((int)r.z, true); s += hv[8] * a.x + hv[9] * a.y + hv[10] * b.x + hv[11] * b.y; }
    { const f32x2 a = __builtin_amdgcn_cvt_pk_f32_fp8((int)r.w, false), b = __builtin_amdgcn_cvt_pk_f32_fp8((int)r.w, true); s += hv[12] * a.x + hv[13] * a.y + hv[14] * b.x + hv[15] * b.y; }
    return s;
}
template <int NP, class F> __device__ __forceinline__ void partition_queue(const Params& P, LAS unsigned char* lds, int ctr_base, F f) {
    const int tid = tid_opaque();
    LAS int* slot = (LAS int*)(lds + LDS_BYTES - 64);
    unsigned* ctr = (unsigned*)(P.ws + OFF_CTR) + ctr_base;
    const int myx = (int)(xcc_id() & 7u);
    for (int pp = 0; pp < NP; ++pp) {
        const int p = (myx * (NP / 8) + pp) % NP;
        for (;;) {
            if (tid == 0) *slot = (int)atomicAdd(ctr + p, 1u);
            __syncthreads();
            const int item = *slot;
            __syncthreads();
            if (item >= NTOK / 64) break;
            f(p, item);
        }
    }
}
__device__ __forceinline__ float dot2bf(unsigned a, bf16v2 b, float c) { return __builtin_amdgcn_fdot2_f32_bf16(__builtin_bit_cast(bf16v2, a), b, c, false); }
__device__ __forceinline__ float gelu_erf(float v) {
    const float av = fabsf(v), t = __builtin_amdgcn_rcpf(__builtin_fmaf(av, 0.2316418882f, 1.0f));
    float q = __builtin_fmaf(t, 0.5307027145f, -0.7265760135f); q = __builtin_fmaf(q, t, 0.7107068705f); q = __builtin_fmaf(q, t, -0.142248368f); q = __builtin_fmaf(q, t, 0.127414796f); q = q * t;
    const float m = v * (q * __builtin_amdgcn_exp2f(v * v * -0.72134752044f));
    return v < 0.f ? m : v - m;
}
struct UQuad { u32x4 r[2]; u32x4 ent, nxt; };
__device__ __forceinline__ void uq_issue(UQuad& q, const LAS u32x4* list, int J, int NQ, int g, const unsigned char* Ub, const unsigned lo) {
    q.ent = q.nxt;
    const unsigned char* rp = Ub + (q.ent.x * 512u + lo);
    q.r[0] = *(const u32x4*)rp; q.r[1] = *(const u32x4*)(rp + 256);
    const int jj = J < NQ ? J : NQ - 1;
    q.nxt = list[4 * jj + g];
}
__device__ __forceinline__ float uq_dot(const UQuad& q, const u32x4 (&hp)[4]) {
    int a = 0, b = 0;
#pragma unroll
    for (int c = 0; c < 2; ++c) {
        const u32x4 r = q.r[c];
        a = __builtin_amdgcn_sdot8((int)hp[c].x, (int)r.x, a, false); a = __builtin_amdgcn_sdot8((int)hp[c].y, (int)r.y, a, false);
        a = __builtin_amdgcn_sdot8((int)hp[c].z, (int)r.z, a, false); a = __builtin_amdgcn_sdot8((int)hp[c].w, (int)r.w, a, false);
        b = __builtin_amdgcn_sdot8((int)hp[2 + c].x, (int)r.x, b, false); b = __builtin_amdgcn_sdot8((int)hp[2 + c].y, (int)r.y, b, false);
        b = __builtin_amdgcn_sdot8((int)hp[2 + c].z, (int)r.z, b, false); b = __builtin_amdgcn_sdot8((int)hp[2 + c].w, (int)r.w, b, false);
    }
    float s = (float)(16 * a + b);
    s = dpp_add<0xB1>(s); s = dpp_add<0x4E>(s); s = dpp_add<0x141>(s); s = dpp_add<0x140>(s);
    return s;
}
__device__ __forceinline__ void peer_u_tokens(const Params& P, LAS unsigned char* lds, const size_t t0) {
    const int tid = tid_opaque(), lane = tid & 63, wid = tid >> 6, g = lane >> 4, li = lane & 15;
    const unsigned char* H8 = P.ws + OFF_H8 + li * 16; const unsigned char* Ub = P.ws + OFF_U8; const unsigned lo16 = (unsigned)li * 16u;
    const f32x2* HS = (const f32x2*)(P.ws + OFF_HS); const float* USC = (const float*)(P.ws + OFF_USC);
    const u32x4* EG4 = (const u32x4*)(P.ws + OFF_EG); float* W = (float*)(P.ws + OFF_W);
    LAS u32x4* list = (LAS u32x4*)(lds + wid * 16384);
    {
        u32x4 egv[8]; float s0[8], s1[8];
#pragma unroll
        for (int i = 0; i < 8; ++i) egv[i] = EG4[(t0 + i) * 64 + lane];
#pragma unroll
        for (int i = 0; i < 8; ++i) { s0[i] = USC[egv[i].x]; s1[i] = USC[egv[i].z]; }
#pragma unroll
        for (int i = 0; i < 8; ++i) {
            list[i * 128 + 2 * lane] = (u32x4){egv[i].x, egv[i].y, (unsigned)(2 * lane) | (unsigned)(i << 8), __float_as_uint(s0[i])};
            list[i * 128 + 2 * lane + 1] = (u32x4){egv[i].z, egv[i].w, (unsigned)(2 * lane + 1) | (unsigned)(i << 8), __float_as_uint(s1[i])};
        }
    }
    constexpr int NQ = 256;
    u32x4 hp[4], hn[4]; f32x2 hsc = HS[t0], hsn = HS[t0 + 1];
#pragma unroll
    for (int c = 0; c < 2; ++c) { hp[c] = *(const u32x4*)(H8 + t0 * 1024 + 256 * c); hp[2 + c] = *(const u32x4*)(H8 + t0 * 1024 + 512 + 256 * c);
                                  hn[c] = *(const u32x4*)(H8 + (t0 + 1) * 1024 + 256 * c); hn[2 + c] = *(const u32x4*)(H8 + (t0 + 1) * 1024 + 512 + 256 * c); }
    int curtok = 0;
    UQuad q0, q1, q2, q3, q4, q5, q6, q7;
    q0.nxt = list[g]; q1.nxt = list[4 + g]; q2.nxt = list[8 + g]; q3.nxt = list[12 + g]; q4.nxt = list[16 + g]; q5.nxt = list[20 + g]; q6.nxt = list[24 + g]; q7.nxt = list[28 + g];
    uq_issue(q0, list, 8, NQ, g, Ub, lo16); uq_issue(q1, list, 9, NQ, g, Ub, lo16); uq_issue(q2, list, 10, NQ, g, Ub, lo16); uq_issue(q3, list, 11, NQ, g, Ub, lo16);
    uq_issue(q4, list, 12, NQ, g, Ub, lo16); uq_issue(q5, list, 13, NQ, g, Ub, lo16); uq_issue(q6, list, 14, NQ, g, Ub, lo16); uq_issue(q7, list, 15, NQ, g, Ub, lo16);
    float sv = 0.f; unsigned gv = 0u, zv = 0u;
#define UQ_PIN(q) asm volatile("" : "+v"(q.r[0]), "+v"(q.r[1]) :: "memory")
#define UQ_STEP(q, Jn, kq, qn) do { \
        const float s = __uint_as_float(q.ent.w) * hsc.x * (uq_dot(q, hp) + 0.5f * hsc.y); \
        if (li == (kq)) { sv = s; gv = q.ent.y; zv = q.ent.z; } \
        uq_issue(q, list, (Jn), NQ, g, Ub, lo16); UQ_PIN(qn); } while (0)
    UQ_PIN(q0);
#pragma unroll 1
    for (int J = 0; J < NQ; J += 8) {
        const int tk = __builtin_amdgcn_readfirstlane((int)(q0.ent.z >> 8));
        if (tk != curtok) { curtok = tk;
#pragma unroll
            for (int c = 0; c < 4; ++c) hp[c] = hn[c];
            hsc = hsn;
            if (tk + 1 < 8) { hsn = HS[t0 + tk + 1];
#pragma unroll
                for (int c = 0; c < 2; ++c) { hn[c] = *(const u32x4*)(H8 + (t0 + tk + 1) * 1024 + 256 * c); hn[2 + c] = *(const u32x4*)(H8 + (t0 + tk + 1) * 1024 + 512 + 256 * c); } } }
        UQ_STEP(q0, J + 16, 0, q1); UQ_STEP(q1, J + 17, 1, q2); UQ_STEP(q2, J + 18, 2, q3); UQ_STEP(q3, J + 19, 3, q4);
        UQ_STEP(q4, J + 20, 4, q5); UQ_STEP(q5, J + 21, 5, q6); UQ_STEP(q6, J + 22, 6, q7); UQ_STEP(q7, J + 23, 7, q0);
        if (li < 8) W[(t0 + tk) * 128 + (zv & 255u)] = __uint_as_float(gv) * gelu_erf(sv); }
#undef UQ_STEP
}
typedef int v4i_t __attribute__((ext_vector_type(4)));
struct VQuad { u32x4 r[2]; u32x2 ent, nxt; };
__device__ __forceinline__ void vq_issue(VQuad& q, const LAS u32x2* list, int J, int g, const unsigned char* Vb, const unsigned lo) {
    q.ent = q.nxt;
    const unsigned char* rp = Vb + (q.ent.x * 512u + lo);
    q.r[0] = *(const u32x4*)rp; q.r[1] = *(const u32x4*)(rp + 256);
    const int jj = J < 256 ? J : 255;
    q.nxt = list[4 * jj + g];
}
#define VQ_PIN(q) asm volatile("" : "+v"(q.r[0]), "+v"(q.r[1]) :: "memory")
__device__ __forceinline__ void vq_mma(const VQuad& q, v4i_t (&acc)[4], const u32x4 bm) {
    const unsigned t = q.ent.y;
    const v4i_t B = {(int)(t & bm.x), (int)(t & bm.y), (int)(t & bm.z), (int)(t & bm.w)};
#pragma unroll
    for (int c = 0; c < 2; ++c) {
        const u32x4 r = q.r[c];
        const v4i_t lo = {(int)(r.x & 0x0F0F0F0Fu), (int)(r.y & 0x0F0F0F0Fu), (int)(r.z & 0x0F0F0F0Fu), (int)(r.w & 0x0F0F0F0Fu)};
        const v4i_t raw = {(int)r.x, (int)r.y, (int)r.z, (int)r.w};
        acc[2 * c] = __builtin_amdgcn_mfma_i32_16x16x64_i8(lo, B, acc[2 * c], 0, 0, 0);
        acc[2 * c + 1] = __builtin_amdgcn_mfma_i32_16x16x64_i8(raw, B, acc[2 * c + 1], 0, 0, 0);
    }
}
__device__ __forceinline__ void peer_v_tokens(const Params& P, LAS unsigned char* lds, const size_t t0) {
    const int tid = tid_opaque(), lane = tid & 63, wid = tid >> 6, g = lane >> 4, li = lane & 15;
    const unsigned char* Vb = P.ws + OFF_V8; const unsigned lo16 = (unsigned)li * 16u; const float* VSC = (const float*)(P.ws + OFF_VSC);
    const u32x4* EG4 = (const u32x4*)(P.ws + OFF_EG); const f32x2* W2 = (const f32x2*)(P.ws + OFF_W);
    LAS u32x2* lists = (LAS u32x2*)(lds + wid * 8192);
    LAS f32x2* tokp = (LAS f32x2*)(lds + 65536 + wid * 64);
    {
        u32x4 egv[8]; f32x2 wwv[8];
#pragma unroll
        for (int i = 0; i < 8; ++i) { egv[i] = EG4[(t0 + i) * 64 + lane]; wwv[i] = W2[(t0 + i) * 64 + lane]; }
        float w0v[8], w1v[8];
#pragma unroll
        for (int i = 0; i < 8; ++i) { w0v[i] = wwv[i].x * VSC[egv[i].x]; w1v[i] = wwv[i].y * VSC[egv[i].z]; }
#pragma unroll
        for (int i = 0; i < 8; ++i) {
            const float mx = wave_max_fast(fmaxf(fabsf(w0v[i]), fabsf(w1v[i])));
            const float sw = fmaxf(mx * (1.0f / 127.0f), 1e-30f), inv = 1.0f / sw;
            const int q0 = (int)rintf(w0v[i] * inv), q1 = (int)rintf(w1v[i] * inv);
            *(LAS u32x4*)(lists + i * 128 + 2 * lane) = (u32x4){egv[i].x, ((unsigned)q0 & 255u) * 0x01010101u, egv[i].z, ((unsigned)q1 & 255u) * 0x01010101u};
            const int qs = wave_sum_int_fast(q0 + q1);
            if (lane == 0) tokp[i] = (f32x2){sw, 7.5f * sw * (float)qs}; }
    }
    const unsigned bsel = 0xFFu << (8u * (unsigned)(li & 3));
    const u32x4 bm = {(li >> 2) == 0 ? bsel : 0u, (li >> 2) == 1 ? bsel : 0u, (li >> 2) == 2 ? bsel : 0u, (li >> 2) == 3 ? bsel : 0u};
    const int dbase = 128 * g + 8 * (li >> 2) + (li & 3);
    float gt2v[16], lgv[16], lbv[16];
    { const float* gt2 = (const float*)(P.ws + OFF_ADA) + (t0 >> 11) * 6144 + 5120;
#pragma unroll
      for (int c = 0; c < 2; ++c)
#pragma unroll
          for (int hf = 0; hf < 2; ++hf)
#pragma unroll
              for (int r = 0; r < 4; ++r) { const int d = dbase + 512 * c + 32 * r + 4 * hf, e = 8 * c + 4 * hf + r; gt2v[e] = gt2[d]; lgv[e] = P.ln2_g[d]; lbv[e] = P.ln2_b[d]; } }
    VQuad q0, q1, q2, q3, q4, q5, q6, q7;
    q0.nxt = lists[g]; q1.nxt = lists[4 + g]; q2.nxt = lists[8 + g]; q3.nxt = lists[12 + g]; q4.nxt = lists[16 + g]; q5.nxt = lists[20 + g]; q6.nxt = lists[24 + g]; q7.nxt = lists[28 + g];
    vq_issue(q0, lists, 8, g, Vb, lo16); vq_issue(q1, lists, 9, g, Vb, lo16); vq_issue(q2, lists, 10, g, Vb, lo16); vq_issue(q3, lists, 11, g, Vb, lo16);
    vq_issue(q4, lists, 12, g, Vb, lo16); vq_issue(q5, lists, 13, g, Vb, lo16); vq_issue(q6, lists, 14, g, Vb, lo16); vq_issue(q7, lists, 15, g, Vb, lo16);
    VQ_PIN(q0);
#pragma unroll 1
    for (int i = 0; i < 8; ++i) {
        const size_t t = t0 + i;
        v4i_t acc[4];
#pragma unroll
        for (int j = 0; j < 4; ++j) acc[j] = (v4i_t){0, 0, 0, 0};
        float* xr = P.out + t * 1024;
        float xv[16];
#pragma unroll
        for (int c = 0; c < 2; ++c)
#pragma unroll
            for (int hf = 0; hf < 2; ++hf)
#pragma unroll
                for (int r = 0; r < 4; ++r) xv[8 * c + 4 * hf + r] = xr[dbase + 512 * c + 32 * r + 4 * hf];
#pragma unroll 1
        for (int J = 32 * i; J < 32 * i + 32; J += 8) {
            vq_mma(q0, acc, bm); vq_issue(q0, lists, J + 16, g, Vb, lo16); VQ_PIN(q1);
            vq_mma(q1, acc, bm); vq_issue(q1, lists, J + 17, g, Vb, lo16); VQ_PIN(q2);
            vq_mma(q2, acc, bm); vq_issue(q2, lists, J + 18, g, Vb, lo16); VQ_PIN(q3);
            vq_mma(q3, acc, bm); vq_issue(q3, lists, J + 19, g, Vb, lo16); VQ_PIN(q4);
            vq_mma(q4, acc, bm); vq_issue(q4, lists, J + 20, g, Vb, lo16); VQ_PIN(q5);
            vq_mma(q5, acc, bm); vq_issue(q5, lists, J + 21, g, Vb, lo16); VQ_PIN(q6);
            vq_mma(q6, acc, bm); vq_issue(q6, lists, J + 22, g, Vb, lo16); VQ_PIN(q7);
            vq_mma(q7, acc, bm); vq_issue(q7, lists, J + 23, g, Vb, lo16); VQ_PIN(q0);
        }
        const f32x2 tp = tokp[i]; const float sw = tp.x, yoff = tp.y;
        float pre[16]; float s = 0.f;
#pragma unroll
        for (int c = 0; c < 2; ++c)
#pragma unroll
            for (int hf = 0; hf < 2; ++hf)
#pragma unroll
                for (int r = 0; r < 4; ++r) { const int e = 8 * c + 4 * hf + r;
                    const float yv = hf == 0 ? sw * (float)acc[2 * c][r] - yoff : (sw * 0.0625f) * (float)(acc[2 * c + 1][r] - acc[2 * c][r]) + yoff * (1.0f / 15.0f);
                    const float pv = ALPHA * xv[e] + gt2v[e] * yv; pre[e] = pv; s += pv; }
        const float mean = wave_sum_fast(s) * (1.0f / 1024.0f); float s2 = 0.f;
#pragma unroll
        for (int e = 0; e < 16; ++e) { pre[e] -= mean; s2 += pre[e] * pre[e]; }
        const float rstd = rsqrtf(wave_sum_fast(s2) * (1.0f / 1024.0f) + LN_EPS);
#pragma unroll
        for (int c = 0; c < 2; ++c)
#pragma unroll
            for (int hf = 0; hf < 2; ++hf)
#pragma unroll
                for (int r = 0; r < 4; ++r) { const int e = 8 * c + 4 * hf + r;
                    xr[dbase + 512 * c + 32 * r + 4 * hf] = pre[e] * rstd * lgv[e] + lbv[e]; }
    }
}

#define XB_TMO      128
#define XB_XCNT(j)  (256  + 64 * (j))
#define XB_XSUB(j)  (1280 + 64 * (j))
#define XB_XGEN(j)  (2304 + 64 * (j))
#define XB_TOP      3328
#define XB_TOPGEN   3392
#define XCD_BAR_WORDS 3456
#define XB_SPIN_CAP (1u << 22)
__device__ __forceinline__ unsigned xb_ld(unsigned* p)              { return __hip_atomic_load(p, __ATOMIC_RELAXED, __HIP_MEMORY_SCOPE_AGENT); }
__device__ __forceinline__ unsigned xb_add(unsigned* p, unsigned v) { return __hip_atomic_fetch_add(p, v, __ATOMIC_RELAXED, __HIP_MEMORY_SCOPE_AGENT); }
#define XB_SPIN(cond, bar) do { unsigned _sp = 0; while (cond) { __builtin_amdgcn_s_sleep(1); \
    if ((++_sp & 255u) == 0u) { if (xb_ld(&(bar)[XB_TMO])) break; if (_sp > XB_SPIN_CAP) { atomicAdd(&(bar)[XB_TMO], 1u); break; } } } } while (0)
struct XcdBarrier { unsigned* bar; unsigned x; volatile LAS unsigned* st; };
__device__ __forceinline__ XcdBarrier xcd_barrier_post(unsigned* bar, volatile LAS unsigned* st) {
    XcdBarrier b; b.bar = bar; b.x = xcc_id(); b.st = st;
    if (threadIdx.x == 0) (void)xb_add(&bar[XB_XCNT(b.x)], 1u);
    return b;
}
__device__ __forceinline__ void xcd_barrier_complete(unsigned* bar, unsigned x, unsigned& nloc, unsigned& nx) {
    const unsigned G = gridDim.x * gridDim.y * gridDim.z;
    unsigned sum, cnt, mine, sp = 0u;
    for (;;) {
        sum = 0u; cnt = 0u; mine = 0u;
#pragma unroll
        for (unsigned j = 0; j < 16; ++j) { const unsigned c = xb_ld(&bar[XB_XCNT(j)]); sum += c; cnt += (c > 0u) ? 1u : 0u; mine = (j == x) ? c : mine; }
        if (sum == G) break;
        __builtin_amdgcn_s_sleep(1);
        if ((++sp & 255u) == 0u) { if (xb_ld(&bar[XB_TMO])) break; if (sp > XB_SPIN_CAP) { atomicAdd(&bar[XB_TMO], 1u); break; } }
    }
    nloc = mine > 0u ? mine : 1u; nx = cnt > 0u ? cnt : 1u;
}
__device__ __forceinline__ void xcd_barrier(const XcdBarrier& b) {
    asm volatile("s_waitcnt vmcnt(0)" ::: "memory");
    __syncthreads();
    if (threadIdx.x == 0) {
        unsigned* bar = b.bar;
        __builtin_amdgcn_s_waitcnt(0);
        unsigned nloc = b.st[0], nx = b.st[1];
        if (nloc == 0u) { xcd_barrier_complete(bar, b.x, nloc, nx); b.st[0] = nloc; b.st[1] = nx; }
        const unsigned old = xb_add(&bar[XB_XSUB(b.x)], 1u);
        const unsigned gen = old / nloc;
        if (old + 1u == (gen + 1u) * nloc) {
            __builtin_amdgcn_fence(__ATOMIC_RELEASE, "agent");
            asm volatile("s_waitcnt vmcnt(0)" ::: "memory");
            const unsigned og = xb_add(&bar[XB_TOP], 1u);
            const unsigned tg = og / nx;
            if (og + 1u == (tg + 1u) * nx) xb_add(&bar[XB_TOPGEN], 1u);
            else XB_SPIN(xb_ld(&bar[XB_TOPGEN]) == tg, bar);
            __builtin_amdgcn_fence(__ATOMIC_ACQUIRE, "agent");
            xb_add(&bar[XB_XGEN(b.x)], 1u);
            asm volatile("s_waitcnt vmcnt(0)" ::: "memory");
        } else {
            XB_SPIN(xb_ld(&bar[XB_XGEN(b.x)]) == gen, bar);
            __builtin_amdgcn_fence(__ATOMIC_ACQUIRE, "agent");
            asm volatile("s_waitcnt vmcnt(0)" ::: "memory");
        }
    }
    __syncthreads();
}

__global__ void __launch_bounds__(NTHR, 2) fwd_megakernel(Params P) {
    extern __shared__ __attribute__((aligned(16))) unsigned char shm[];
    LAS unsigned char* lds = (LAS unsigned char*)shm;
    cg::grid_group grid = cg::this_grid();
    const int G = gridDim.x, bid = blockIdx.x;
    volatile LAS unsigned* xst = (volatile LAS unsigned*)(lds + LDS_BYTES - 128);
    if (threadIdx.x == 0) { xst[0] = 0u; xst[1] = 0u; }
    __syncthreads();
    const XcdBarrier xb = xcd_barrier_post((unsigned*)(P.ws + OFF_BAR), xst);

#ifndef P3
#define P3 0xff
#endif
#ifndef PH
#define PH 0xff
#endif
    if (PH & 1) phase0a(P, lds);
    grid.sync();
    if (PH & 2) phase0b(P);
    xcd_barrier(xb);
    if (PH & 4) {
        pg8::Gemm g; g.A = (const bf16_t*)(P.ws + OFF_H); g.Bt = (const bf16_t*)(P.ws + OFF_WIN); g.M = NTOK; g.N = INCOLS; { int k_ = 512; asm volatile("" : "+s"(k_)); g.K = k_; g.lda = k_; }
        pg8::StaticOrder S; S.init(NTOK, INCOLS, G, bid);
        EpiProj E; E.ws = P.ws; E.lb = (const float*)(P.ws + OFF_LB); E.ng = P.hgrn_ng; E.kmean = (float*)(P.ws + OFF_KMEAN);
        pg8::gemm_phase<EpiProj, pg8::StaticOrder, true>(lds, g, S, E);
    }
    xcd_barrier(xb);
    if (PH & 8) for (int it = bid; it < 256; it += G) hgrn_item(P, it, lds);
    if (PH & 16) for (int u = bid; u < 2048; u += G) { const int bh = u & 255, jj = u >> 8; moba_unit(P, bh >> 3, bh & 7, (jj + bh) & 7, lds); }
    xcd_barrier(xb);
    if ((PH & 32) && bid < NTOK / 256) { const int pm = bid;
        if (P3 & 1) yb_norm_panel(P, pm);
        __syncthreads();
        if (P3 & 2) { pg8::Gemm g; g.A = (const bf16_t*)(P.ws + OFF_EG); g.Bt = (const bf16_t*)(P.ws + OFF_WBA); g.M = NTOK; g.N = 1024; { int k_ = 256; asm volatile("" : "+s"(k_)); g.K = k_; } g.lda = 512;
          pg8::PanelOrder S; S.pm = pm; S.npn = 4; EpiMixA E; E.GA = (bf16_t*)(P.ws + OFF_GA);
          pg8::gemm_phase<EpiMixA, pg8::PanelOrder, true>(lds, g, S, E); }
        __syncthreads();
        if (P3 & 4) { pg8::Gemm g; g.A = (const bf16_t*)(P.ws + OFF_EG + 512); g.Bt = (const bf16_t*)(P.ws + OFF_WBB); g.M = NTOK; g.N = 1024; { int k_ = 256; asm volatile("" : "+s"(k_)); g.K = k_; } g.lda = 512;
          pg8::PanelOrder S; S.pm = pm; S.npn = 4; EpiMixB E; E.GA = (const bf16_t*)(P.ws + OFF_GA); E.GB = (const bf16_t*)(P.ws + OFF_GB); E.M8 = P.ws + OFF_QA;
          pg8::gemm_phase<EpiMixB, pg8::PanelOrder, true>(lds, g, S, E); }
        __syncthreads();
        if (P3 & 8) { pg8::Gemm g; g.A = (const bf16_t*)(P.ws + OFF_QA); g.Bt = (const bf16_t*)(P.ws + OFF_WOUT); g.M = NTOK; g.N = 1024; { int k_ = 512; asm volatile("" : "+s"(k_)); g.K = k_; g.lda = k_; }
          pg8::PanelOrder S; S.pm = pm; S.npn = 4; EpiOut E; E.ada = (const float*)(P.ws + OFF_ADA); E.D = (bf16_t*)(P.ws + OFF_GB);
          pg8::gemm_phase<EpiOut, pg8::PanelOrder, true>(lds, g, S, E); }
        __syncthreads();
        if (P3 & 16) ln1_panel(P, pm);
        __syncthreads();
        if (P3 & 32) { pg8::Gemm g; g.A = (const bf16_t*)(P.ws + OFF_H); g.Bt = (const bf16_t*)(P.ws + OFF_WQ); g.M = NTOK; g.N = 1024; g.K = 1024; g.lda = 1024;
          pg8::PanelOrder S; S.pm = pm; S.npn = 4; EpiBf16 E; E.O = (bf16_t*)(P.ws + OFF_GB);
          pg8::gemm_phase<EpiBf16, pg8::PanelOrder>(lds, g, S, E); }
        __syncthreads();
        { const size_t tok0 = (size_t)pm * 256 + (tid_opaque() >> 6) * 32;
          peer_select_wave(P, tok0);
          __syncthreads();
#pragma unroll 1
          for (int sb = 0; sb < 4; ++sb) {
              peer_u_tokens(P, lds, tok0 + 8 * sb);
              __syncthreads();
              peer_v_tokens(P, lds, tok0 + 8 * sb);
              __syncthreads();
          } }
    }
}

extern "C" void kernel_launch(void* const* d_in, const int* in_sizes, int n_in, void* d_out, int out_size, void* d_ws, size_t ws_size, hipStream_t stream) {
    static int grid_blocks = 0;
    if (grid_blocks == 0) {
        if (n_in != 18 || out_size != NTOK * DM || ws_size < WS_END) { fprintf(stderr, "kernel_launch: unexpected shapes (n_in %d, out %d, ws %zu, need %zu)\n", n_in, out_size, ws_size, (size_t)WS_END); grid_blocks = -1; return; }
        int dev = 0, cus = 0, per_cu = 0;
        hipGetDevice(&dev);
        hipDeviceGetAttribute(&cus, hipDeviceAttributeMultiprocessorCount, dev);
        if (hipFuncSetAttribute((const void*)fwd_megakernel, hipFuncAttributeMaxDynamicSharedMemorySize, LDS_BYTES) != hipSuccess) fprintf(stderr, "kernel_launch: hipFuncSetAttribute failed\n");
        hipOccupancyMaxActiveBlocksPerMultiprocessor(&per_cu, (const void*)fwd_megakernel, NTHR, LDS_BYTES);
        if (per_cu < 1) { fprintf(stderr, "kernel_launch: occupancy query says %d blocks per CU\n", per_cu); per_cu = 1; }
        if (per_cu > 1) per_cu = 1;
        grid_blocks = cus * per_cu;
        if (grid_blocks != NTOK / 256) { fprintf(stderr, "kernel_launch: built for a %d-CU device (one 256-token panel per workgroup), found %d\n", NTOK / 256, grid_blocks); grid_blocks = -1; return; }
        (void)hipGetLastError();
    }
    if (grid_blocks < 0) return;
    Params p{};
    p.x = (const float*)d_in[0]; p.c = (const float*)d_in[1]; p.w_ada = (const float*)d_in[2]; p.b_ada = (const float*)d_in[3]; p.w_in = (const float*)d_in[4];
    p.w_ba = (const float*)d_in[5]; p.w_bb = (const float*)d_in[6]; p.w_out = (const float*)d_in[7]; p.hgrn_lb = (const float*)d_in[8]; p.hgrn_ng = (const float*)d_in[9];
    p.ln1_g = (const float*)d_in[10]; p.ln1_b = (const float*)d_in[11]; p.peer_wq = (const float*)d_in[12]; p.peer_sk = (const float*)d_in[13]; p.peer_u = (const float*)d_in[14];
    p.peer_v = (const float*)d_in[15]; p.ln2_g = (const float*)d_in[16]; p.ln2_b = (const float*)d_in[17];
    p.out = (float*)d_out; p.ws = (unsigned char*)d_ws;
    if (hipMemsetAsync((char*)d_ws + OFF_BAR, 0, XCD_BAR_WORDS * 4, stream) != hipSuccess) fprintf(stderr, "kernel_launch: memset of the barrier words failed\n");
    void* args[] = {&p};
    hipError_t e = hipLaunchCooperativeKernel((const void*)fwd_megakernel, dim3(grid_blocks), dim3(NTHR), args, LDS_BYTES, stream);
    if (e != hipSuccess) fprintf(stderr, "cooperative launch failed: %s (grid %d)\n", hipGetErrorString(e), grid_blocks);
}
```

```cpp
#include <hip/hip_runtime.h>
#include <hip/hip_cooperative_groups.h>
#include <cstdio>
#include <cstdint>
#include <type_traits>
namespace cg = cooperative_groups;

#define LAS __attribute__((address_space(3)))
typedef unsigned short bf16_t;
typedef short bf16x8 __attribute__((ext_vector_type(8)));
typedef short s16x4 __attribute__((ext_vector_type(4)));
typedef float f32x2 __attribute__((ext_vector_type(2)));
typedef float f32x4 __attribute__((ext_vector_type(4)));
typedef float f32x16 __attribute__((ext_vector_type(16)));
typedef unsigned u32x2 __attribute__((ext_vector_type(2)));
typedef unsigned u32x4 __attribute__((ext_vector_type(4)));

constexpr int NB = 32, SEQ = 2048, DM = 1024, NTOK = NB * SEQ;
constexpr int INCOLS = 5632;
constexpr int NTHR = 512;
constexpr int LDS_BYTES = 147456;
constexpr float ALPHA = 1.189207115002721f;
constexpr float LN_EPS = 1e-5f, RMS_EPS = 1e-6f;
constexpr float LOG2E = 1.4426950408889634f;

constexpr size_t SZ_T512 = (size_t)NTOK * 512 * 2, SZ_T1024 = (size_t)NTOK * 1024 * 2;
constexpr size_t OFF_ADA = 0;
constexpr size_t OFF_LB = OFF_ADA + 786432;
constexpr size_t OFF_KMEAN = OFF_LB + 4096;
constexpr size_t OFF_WIN = OFF_KMEAN + 524288;
constexpr size_t OFF_WBA = OFF_WIN + (size_t)5632 * 1024 * 2;
constexpr size_t OFF_WBB = OFF_WBA + 1048576;
constexpr size_t OFF_WOUT = OFF_WBB + 1048576;
constexpr size_t OFF_WQ = OFF_WOUT + 2097152;
constexpr size_t OFF_SK = OFF_WQ + 2097152;
constexpr size_t OFF_U8 = OFF_SK + 262144;
constexpr size_t OFF_USC = OFF_U8 + 8388608;
constexpr size_t OFF_V8 = OFF_U8 + 16777216;
constexpr size_t OFF_VSC = OFF_V8 + 8388608;
constexpr size_t OFF_CTR = OFF_V8 + 16777216;
constexpr size_t OFF_BAR = OFF_CTR + 4096;
constexpr size_t OFF_EG = OFF_BAR + 16384;
constexpr size_t OFF_H = OFF_EG + (size_t)NTOK * 128 * 8;
constexpr size_t OFF_QA = OFF_H + SZ_T1024;
constexpr size_t OFF_KA = OFF_QA + SZ_T512;
constexpr size_t OFF_VA = OFF_KA + SZ_T512;
constexpr size_t OFF_HQ = OFF_VA + SZ_T512;
constexpr size_t OFF_HK = OFF_HQ + SZ_T512;
constexpr size_t OFF_HI = OFF_HK + SZ_T512;
constexpr size_t OFF_HG = OFF_HI + SZ_T512;
constexpr size_t OFF_GA = OFF_HG + SZ_T512;
constexpr size_t OFF_GB = OFF_GA + SZ_T1024;
constexpr size_t WS_END = OFF_GB + SZ_T1024;
constexpr size_t OFF_H8 = OFF_VA;
constexpr size_t OFF_HS = OFF_HQ;
constexpr size_t OFF_W = OFF_KA;
constexpr size_t OFF_Y = OFF_KA;

struct Params {
    const float *x, *c, *w_ada, *b_ada, *w_in, *w_ba, *w_bb, *w_out, *hgrn_lb, *hgrn_ng, *ln1_g, *ln1_b, *peer_wq, *peer_sk, *peer_u, *peer_v, *ln2_g, *ln2_b;
    float* out;
    unsigned char* ws;
};

typedef __bf16 bf16v2 __attribute__((ext_vector_type(2)));
__device__ __forceinline__ unsigned cvt_pk_bf16(float lo, float hi) { return __builtin_bit_cast(unsigned, __builtin_convertvector((f32x2){lo, hi}, bf16v2)); }
__device__ __forceinline__ float bf_lo(unsigned w) { return __uint_as_float(w << 16); }
__device__ __forceinline__ float bf_hi(unsigned w) { return __uint_as_float(w & 0xffff0000u); }
__device__ __forceinline__ float sigmoidf_(float x) { return __builtin_amdgcn_rcpf(1.0f + __builtin_amdgcn_exp2f(-LOG2E * x)); }
__device__ __forceinline__ float wave_sum(float v) {
#pragma unroll
    for (int o = 1; o < 64; o <<= 1) v += __shfl_xor(v, o);
    return v;
}
__device__ __forceinline__ int tid_opaque() { int t = threadIdx.x; asm volatile("" : "+v"(t)); return t; }
__device__ __forceinline__ int crow(int r, int hi) { return (r & 3) + 8 * (r >> 2) + 4 * hi; }
#define MFMA32(a, b, c) __builtin_amdgcn_mfma_f32_32x32x16_bf16(a, b, c, 0, 0, 0)

namespace pg8 {
constexpr int BM = 256, BK = 64, HALF = 128, HTB = HALF * BK * 2, STAGE_BYTES = 8 * HTB, NXCD = 8, WGM = 8;
__host__ __device__ __forceinline__ int lds_byte(int r, int c) { const int st = (r >> 4) * 2 + (c >> 5), rr = r & 15, cc = c & 31, ob = rr * 64 + cc * 2; return st * 1024 + (ob ^ (((ob >> 9) & 1) << 5)); }
__host__ __device__ __forceinline__ void stage_rc(int b, int& R, int& C) { const int st = b / 1024, sb = b % 1024, swz = sb ^ (((sb >> 9) & 1) << 5); R = (st >> 1) * 16 + swz / 64; C = (st & 1) * 32 + (swz % 64) / 2; }
__host__ __device__ __forceinline__ int perm32(int rho) { const int n = rho >> 4, i = rho & 15; return 8 * (i >> 2) + 4 * n + (i & 3); }

struct Unit { int pm, pn; };
struct Gemm { const bf16_t* A; const bf16_t* Bt; int M, N, K, lda; };

struct StaticOrder {
    int nM, nN, nwg, G, c;
    __device__ void init(int M, int N, int G_, int c_) { nM = M / BM; nN = N / BM; nwg = nM * nN; G = G_; c = c_; }
    __device__ bool next(int i, Unit& u) const {
        const long L = (long)i * G + c; if (L >= nwg) return false;
        int wgid = (int)L; { const int q = nwg / NXCD, r = nwg % NXCD, xcd = wgid % NXCD, off = wgid / NXCD; wgid = (xcd < r ? xcd * (q + 1) : r * (q + 1) + (xcd - r) * q) + off; }
        const int nig = WGM * nN, gid = wgid / nig, fm = gid * WGM, gsz = (nM - fm) < WGM ? (nM - fm) : WGM;
        u.pm = fm + ((wgid % nig) % gsz); u.pn = (wgid % nig) / gsz; return true;
    }
};
struct PanelOrder {
    int pm, npn;
    __device__ bool next(int i, Unit& u) const { if (i >= npn) return false; u.pm = pm; u.pn = i; return true; }
};

template <class Epi, class Sched, bool MX = false>
__device__ __forceinline__ void gemm_phase(LAS unsigned char* lds, const Gemm g, const Sched& S, const Epi& E) {
    const int tid = tid_opaque(), wid = __builtin_amdgcn_readfirstlane(tid >> 6), lane = tid & 63, wr = wid >> 2, wc = wid & 3, fr = lane & 15, fq = lane >> 4;
    const int K = g.K, nt = K / BK;
    unsigned voffA, voffB;
    { int R, C; stage_rc(tid * 16, R, C); const int Rb = Epi::PERM ? ((R & ~31) + perm32(R & 31)) : R;
      voffA = (unsigned)(R * g.lda + C) * 2u; voffB = (unsigned)(Rb * K + C) * 2u; }
    const size_t rvoffA = (size_t)128 * g.lda, rvoffB = (size_t)128 * K;
    const size_t kstep = (size_t)(BK * 2);
    const size_t hstep = (size_t)HALF * K * 2;
    const size_t tstep = 2 * hstep;
    const size_t hstepA = (size_t)HALF * g.lda * 2, tstepA = 2 * hstepA;
    const unsigned ldsw = (unsigned)wid * 1024u;
    const int aoff = lds_byte(wr * 64 + fr, fq * 8), boff = lds_byte(wc * 32 + fr, fq * 8);
#define PG8_SA(b, h) (((b) * 2 + (h)) * HTB)
#define PG8_SB(b, h) ((4 + (b) * 2 + (h)) * HTB)
#define PG8_STAGE(bufoff, gbase, voff) do { unsigned vo_ = (voff); asm volatile("" : "+v"(vo_));     \
        _Pragma("unroll") for (int _i = 0; _i < 2; ++_i) \
        __builtin_amdgcn_global_load_lds((const unsigned*)((const char*)(gbase) + _i * r##voff + vo_), (LAS unsigned*)(lds + (bufoff) + ldsw + _i * 8192), 16, 0, 0); } while (0)
#define PG8_LDX(dst, off) do { const v4i_ lo_ = *(const LAS v4i_*)(lds + (off)), hi_ = *(const LAS v4i_*)(lds + (off) + 1024); dst = __builtin_shufflevector(lo_, hi_, 0, 1, 2, 3, 4, 5, 6, 7); } while (0)
#define PG8_LDA(dst, b, h) do { if constexpr (MX) { _Pragma("unroll") for (int m = 0; m < 4; ++m) PG8_LDX(dst##X[m], PG8_SA(b, h) + aoff + m * 2048); } \
        else { _Pragma("unroll") for (int m = 0; m < 4; ++m) _Pragma("unroll") for (int k = 0; k < 2; ++k) dst[m][k] = *(const LAS bf16x8*)(lds + PG8_SA(b, h) + aoff + m * 2048 + k * 1024); } } while (0)
#define PG8_LDB(dst, b, h) do { if constexpr (MX) { _Pragma("unroll") for (int n = 0; n < 2; ++n) PG8_LDX(dst##X[n], PG8_SB(b, h) + boff + n * 2048); } \
        else { _Pragma("unroll") for (int n = 0; n < 2; ++n) _Pragma("unroll") for (int k = 0; k < 2; ++k) dst[n][k] = *(const LAS bf16x8*)(lds + PG8_SB(b, h) + boff + n * 2048 + k * 1024); } } while (0)
#define PG8_MMA(ai, bj, At, Bt) do { __builtin_amdgcn_s_setprio(1); \
        if constexpr (MX) { _Pragma("unroll") for (int m = 0; m < 4; ++m) _Pragma("unroll") for (int n = 0; n < 2; ++n) \
            asm volatile("v_mfma_scale_f32_16x16x128_f8f6f4 %0, %1, %2, %0, %3, %4 op_sel_hi:[0,0,0]" : "+v"(acc[ai][bj][m][n]) : "v"(Bt##X[n]), "v"(At##X[m]), "v"(mxscale), "v"(mxscale5)); } \
        else { _Pragma("unroll") for (int m = 0; m < 4; ++m) _Pragma("unroll") for (int n = 0; n < 2; ++n) _Pragma("unroll") for (int k = 0; k < 2; ++k) \
            acc[ai][bj][m][n] = __builtin_amdgcn_mfma_f32_16x16x32_bf16(Bt[n][k], At[m][k], acc[ai][bj][m][n], 0, 0, 0); } \
        __builtin_amdgcn_s_setprio(0); } while (0)
#define PG8_WAIT_V(n) asm volatile("s_waitcnt vmcnt(" #n ")" ::: "memory")
#define PG8_WAIT_L(n) asm volatile("s_waitcnt lgkmcnt(" #n ")" ::: "memory")
#define PG8_BAR __builtin_amdgcn_s_barrier()
#define PG8_SCHED __builtin_amdgcn_sched_barrier(0)
    Unit cur, nxt; int ui = 0;
    if (!S.next(0, cur)) return;
    f32x4 acc[2][2][4][2];
#pragma unroll
    for (int a = 0; a < 2; ++a)
#pragma unroll
        for (int b = 0; b < 2; ++b)
#pragma unroll
            for (int m = 0; m < 4; ++m)
#pragma unroll
                for (int n = 0; n < 2; ++n) acc[a][b][m][n] = (f32x4){0.f, 0.f, 0.f, 0.f};
    typedef int v4i_ __attribute__((ext_vector_type(4))); typedef int v8i_ __attribute__((ext_vector_type(8)));
    bf16x8 At[4][2], B0[2][2], B1[2][2];
    v8i_ AtX[4], B0X[2], B1X[2];
    const int mxscale = 0x7f7f7f7f, mxscale5 = 0x7a7a7a7a;
    const char* cA = (const char*)g.A + (size_t)cur.pm * tstepA; const char* cB = (const char*)g.Bt + (size_t)cur.pn * tstep;
    PG8_STAGE(PG8_SB(0, 0), cB, voffB); PG8_STAGE(PG8_SA(0, 0), cA, voffA); PG8_STAGE(PG8_SB(0, 1), cB + hstep, voffB); PG8_STAGE(PG8_SA(0, 1), cA + hstepA, voffA);
    if (wr == 1) PG8_BAR;
    PG8_WAIT_V(4); PG8_BAR;
    PG8_STAGE(PG8_SB(1, 0), cB + kstep, voffB); PG8_STAGE(PG8_SA(1, 0), cA + kstep, voffA); PG8_STAGE(PG8_SB(1, 1), cB + hstep + kstep, voffB);
    PG8_WAIT_V(6); PG8_BAR;
    for (;;) {
        const bool has_next = S.next(ui + 1, nxt);
        const char* nA = has_next ? (const char*)g.A + (size_t)nxt.pm * tstepA : cA; const char* nB = has_next ? (const char*)g.Bt + (size_t)nxt.pn * tstep : cB;
        for (int t = 0; t < nt; t += 2) {
            const bool last = (t == nt - 2);
            const char* a1 = cA + (size_t)(t + 1) * kstep;
            const char* a2 = last ? nA : cA + (size_t)(t + 2) * kstep; const char* b2 = last ? nB : cB + (size_t)(t + 2) * kstep;
            const char* a3 = a2 + kstep; const char* b3 = b2 + kstep;
            PG8_LDB(B0, 0, 0); PG8_SCHED; PG8_LDA(At, 0, 0); PG8_STAGE(PG8_SA(1, 1), a1 + hstepA, voffA);
            PG8_WAIT_L(8); PG8_BAR; PG8_WAIT_L(0); PG8_MMA(0, 0, At, B0); PG8_BAR; PG8_SCHED;
            PG8_LDB(B1, 0, 1); PG8_STAGE(PG8_SB(0, 0), b2, voffB);
            PG8_BAR; PG8_WAIT_L(0); PG8_MMA(0, 1, At, B1); PG8_BAR;
            PG8_LDA(At, 0, 1); PG8_STAGE(PG8_SA(0, 0), a2, voffA);
            PG8_BAR; PG8_WAIT_L(0); PG8_MMA(1, 0, At, B0); PG8_BAR; PG8_SCHED;
            PG8_STAGE(PG8_SB(0, 1), b2 + hstep, voffB);
            PG8_WAIT_V(6); PG8_BAR; PG8_MMA(1, 1, At, B1); PG8_BAR;
            PG8_LDB(B0, 1, 0); PG8_SCHED; PG8_LDA(At, 1, 0); PG8_STAGE(PG8_SA(0, 1), a2 + hstepA, voffA);
            PG8_WAIT_L(8); PG8_BAR; PG8_WAIT_L(0); PG8_MMA(0, 0, At, B0); PG8_BAR; PG8_SCHED;
            PG8_LDB(B1, 1, 1); PG8_STAGE(PG8_SB(1, 0), b3, voffB);
            PG8_BAR; PG8_WAIT_L(0); PG8_MMA(0, 1, At, B1); PG8_BAR;
            PG8_LDA(At, 1, 1); PG8_STAGE(PG8_SA(1, 0), a3, voffA);
            PG8_BAR; PG8_WAIT_L(0); PG8_MMA(1, 0, At, B0); PG8_BAR; PG8_SCHED;
            PG8_STAGE(PG8_SB(1, 1), b3 + hstep, voffB);
            PG8_WAIT_V(6); PG8_BAR; PG8_MMA(1, 1, At, B1); PG8_BAR;
        }
        if constexpr (MX) asm volatile("s_nop 15\n\ts_nop 15" ::: "memory");
        if (wr == 0) PG8_BAR;
        E(acc, cur, wr, wc, fr, fq);
        if (wr == 1) PG8_BAR;
        if (!has_next) break;
#pragma unroll
        for (int a = 0; a < 2; ++a)
#pragma unroll
            for (int b = 0; b < 2; ++b)
#pragma unroll
                for (int m = 0; m < 4; ++m)
#pragma unroll
                    for (int n = 0; n < 2; ++n) acc[a][b][m][n] = (f32x4){0.f, 0.f, 0.f, 0.f};
        cur = nxt; cA = nA; cB = nB; ++ui;
    }
    PG8_WAIT_V(0);
    if (wr == 0) PG8_BAR;
    PG8_BAR;
#undef PG8_SA
#undef PG8_SB
#undef PG8_STAGE
#undef PG8_LDX
#undef PG8_LDA
#undef PG8_LDB
#undef PG8_MMA
#undef PG8_WAIT_V
#undef PG8_WAIT_L
#undef PG8_BAR
#undef PG8_SCHED
}
}
using pg8::Unit;

struct EpiProj {
    static constexpr bool PERM = true;
    unsigned char* ws; const float* lb; const float* ng; float* kmean;
    __device__ __forceinline__ void operator()(const f32x4 (&acc)[2][2][4][2], const Unit& u, int wr, int wc, int fr, int fq) const {
        const int pn = u.pn; int seg, colt, ldc; size_t boff;
        if (pn < 14) { seg = pn >> 1; colt = (pn & 1) * 256; ldc = 512; boff = OFF_QA + (size_t)seg * SZ_T512; }
        else if (pn < 18) { seg = 7; colt = (pn - 14) * 256; ldc = 1024; boff = OFF_GA; }
        else { seg = 8; colt = (pn - 18) * 256; ldc = 1024; boff = OFF_GB; }
        bf16_t* base = (bf16_t*)(ws + boff);
        const int row0 = u.pm * 256 + wr * 64 + fr, col0 = colt + wc * 32 + 8 * fq;
        float pv[2][8];
#pragma unroll
        for (int bj = 0; bj < 2; ++bj)
#pragma unroll
            for (int e = 0; e < 8; ++e) pv[bj][e] = (seg == 4) ? (1.0f - lb[col0 + bj * 128 + e]) : ((seg == 6) ? ng[col0 + bj * 128 + e] : 0.f);
        float cs[2][8];
#pragma unroll
        for (int bj = 0; bj < 2; ++bj)
#pragma unroll
            for (int e = 0; e < 8; ++e) cs[bj][e] = 0.f;
#pragma unroll
        for (int ai = 0; ai < 2; ++ai)
#pragma unroll
            for (int m = 0; m < 4; ++m) {
                bf16_t* rowp = base + (size_t)(row0 + ai * 128 + m * 16) * ldc + col0;
#pragma unroll
                for (int bj = 0; bj < 2; ++bj) {
                    float v[8];
#pragma unroll
                    for (int e = 0; e < 4; ++e) { v[e] = acc[ai][bj][m][0][e]; v[4 + e] = acc[ai][bj][m][1][e]; }
                    if (seg == 0) {
#pragma unroll
                        for (int e = 0; e < 8; ++e) v[e] *= (0.125f * LOG2E);
                    } else if (seg == 1) {
#pragma unroll
                        for (int e = 0; e < 8; ++e) cs[bj][e] += v[e];
                    } else if (seg == 3) {
#pragma unroll
                        for (int e = 0; e < 8; ++e) v[e] = v[e] * sigmoidf_(v[e]);
                    } else if (seg == 4) {
#pragma unroll
                        for (int e = 0; e < 8; ++e) v[e] = pv[bj][e] * sigmoidf_(-v[e]);
                    } else if (seg == 6) {
#pragma unroll
                        for (int e = 0; e < 8; ++e) v[e] = pv[bj][e] * v[e] * sigmoidf_(v[e]);
                    } else if (seg >= 7) {
#pragma unroll
                        for (int e = 0; e < 8; ++e) v[e] = sigmoidf_(v[e]);
                    }
                    u32x4 w; w.x = cvt_pk_bf16(v[0], v[1]); w.y = cvt_pk_bf16(v[2], v[3]); w.z = cvt_pk_bf16(v[4], v[5]); w.w = cvt_pk_bf16(v[6], v[7]);
                    *(u32x4*)(rowp + bj * 128) = w;
                }
            }
        if (seg == 1) {
#pragma unroll
            for (int bj = 0; bj < 2; ++bj)
#pragma unroll
                for (int e = 0; e < 8; ++e) {
                    float s = cs[bj][e];
                    s += __shfl_xor(s, 1); s += __shfl_xor(s, 2); s += __shfl_xor(s, 4); s += __shfl_xor(s, 8);
                    if (fr == 0) atomicAdd(kmean + (size_t)u.pm * 512 + col0 + bj * 128 + e, s);
                }
        }
    }
};
struct EpiMixA {
    static constexpr bool PERM = true;
    bf16_t* GA;
    __device__ __forceinline__ void operator()(const f32x4 (&acc)[2][2][4][2], const Unit& u, int wr, int wc, int fr, int fq) const {
        const int row0 = u.pm * 256 + wr * 64 + fr, col0 = u.pn * 256 + wc * 32 + 8 * fq;
#pragma unroll
        for (int ai = 0; ai < 2; ++ai)
#pragma unroll
            for (int m = 0; m < 4; ++m) {
                bf16_t* rowp = GA + (size_t)(row0 + ai * 128 + m * 16) * 1024 + col0;
#pragma unroll
                for (int bj = 0; bj < 2; ++bj) {
                    const u32x4 g = *(const u32x4*)(rowp + bj * 128);
                    const f32x4 a0 = acc[ai][bj][m][0], a1 = acc[ai][bj][m][1];
                    u32x4 w;
                    constexpr float S = 1.0f;
                    w.x = cvt_pk_bf16(bf_lo(g.x) * a0[0] * S, bf_hi(g.x) * a0[1] * S); w.y = cvt_pk_bf16(bf_lo(g.y) * a0[2] * S, bf_hi(g.y) * a0[3] * S);
                    w.z = cvt_pk_bf16(bf_lo(g.z) * a1[0] * S, bf_hi(g.z) * a1[1] * S); w.w = cvt_pk_bf16(bf_lo(g.w) * a1[2] * S, bf_hi(g.w) * a1[3] * S);
                    *(u32x4*)(rowp + bj * 128) = w;
                }
            }
    }
};
struct EpiMixB {
    static constexpr bool PERM = true;
    const bf16_t* GA; const bf16_t* GB; unsigned char* M8;
    __device__ __forceinline__ void operator()(const f32x4 (&acc)[2][2][4][2], const Unit& u, int wr, int wc, int fr, int fq) const {
        const int row0 = u.pm * 256 + wr * 64 + fr, col0 = u.pn * 256 + wc * 32 + 8 * fq;
#pragma unroll
        for (int ai = 0; ai < 2; ++ai)
#pragma unroll
            for (int m = 0; m < 4; ++m) {
                const size_t off = (size_t)(row0 + ai * 128 + m * 16) * 1024 + col0;
#pragma unroll
                for (int bj = 0; bj < 2; ++bj) {
                    const u32x4 g = *(const u32x4*)(GB + off + bj * 128);
                    const u32x4 mx = *(const u32x4*)(GA + off + bj * 128);
                    const f32x4 a0 = acc[ai][bj][m][0], a1 = acc[ai][bj][m][1];
                    constexpr float S = 1.0f;
                    int w0 = __builtin_amdgcn_cvt_pk_fp8_f32(bf_lo(mx.x) + bf_lo(g.x) * a0[0] * S, bf_hi(mx.x) + bf_hi(g.x) * a0[1] * S, 0, false); w0 = __builtin_amdgcn_cvt_pk_fp8_f32(bf_lo(mx.y) + bf_lo(g.y) * a0[2] * S, bf_hi(mx.y) + bf_hi(g.y) * a0[3] * S, w0, true);
                    int w1 = __builtin_amdgcn_cvt_pk_fp8_f32(bf_lo(mx.z) + bf_lo(g.z) * a1[0] * S, bf_hi(mx.z) + bf_hi(g.z) * a1[1] * S, 0, false); w1 = __builtin_amdgcn_cvt_pk_fp8_f32(bf_lo(mx.w) + bf_lo(g.w) * a1[2] * S, bf_hi(mx.w) + bf_hi(g.w) * a1[3] * S, w1, true);
                    *(u32x2*)(M8 + off + bj * 128) = (u32x2){(unsigned)w0, (unsigned)w1};
                }
            }
    }
};
struct EpiOut {
    static constexpr bool PERM = true;
    const float* ada; bf16_t* D;
    __device__ __forceinline__ void operator()(const f32x4 (&acc)[2][2][4][2], const Unit& u, int wr, int wc, int fr, int fq) const {
        const int row0 = u.pm * 256 + wr * 64 + fr, col0 = u.pn * 256 + wc * 32 + 8 * fq;
        const float* gt1 = ada + (size_t)(u.pm >> 3) * 6144 + 2048 + col0;
        f32x4 g[2][2];
#pragma unroll
        for (int bj = 0; bj < 2; ++bj) { g[bj][0] = *(const f32x4*)(gt1 + bj * 128); g[bj][1] = *(const f32x4*)(gt1 + bj * 128 + 4); }
#pragma unroll
        for (int ai = 0; ai < 2; ++ai)
#pragma unroll
            for (int m = 0; m < 4; ++m) {
                bf16_t* rowp = D + (size_t)(row0 + ai * 128 + m * 16) * 1024 + col0;
#pragma unroll
                for (int bj = 0; bj < 2; ++bj) {
                    const f32x4 a0 = acc[ai][bj][m][0] * g[bj][0], a1 = acc[ai][bj][m][1] * g[bj][1];
                    u32x4 w; w.x = cvt_pk_bf16(a0[0], a0[1]); w.y = cvt_pk_bf16(a0[2], a0[3]); w.z = cvt_pk_bf16(a1[0], a1[1]); w.w = cvt_pk_bf16(a1[2], a1[3]);
                    *(u32x4*)(rowp + bj * 128) = w;
                }
            }
    }
};
struct EpiBf16 {
    static constexpr bool PERM = true;
    bf16_t* O;
    __device__ __forceinline__ void operator()(const f32x4 (&acc)[2][2][4][2], const Unit& u, int wr, int wc, int fr, int fq) const {
        const int row0 = u.pm * 256 + wr * 64 + fr, col0 = u.pn * 256 + wc * 32 + 8 * fq;
#pragma unroll
        for (int ai = 0; ai < 2; ++ai)
#pragma unroll
            for (int m = 0; m < 4; ++m) {
                bf16_t* rowp = O + (size_t)(row0 + ai * 128 + m * 16) * 1024 + col0;
#pragma unroll
                for (int bj = 0; bj < 2; ++bj) {
                    const f32x4 a0 = acc[ai][bj][m][0], a1 = acc[ai][bj][m][1];
                    u32x4 w; w.x = cvt_pk_bf16(a0[0], a0[1]); w.y = cvt_pk_bf16(a0[2], a0[3]); w.z = cvt_pk_bf16(a1[0], a1[1]); w.w = cvt_pk_bf16(a1[2], a1[3]);
                    *(u32x4*)(rowp + bj * 128) = w;
                }
            }
    }
};

__device__ void phase0a(const Params& P, LAS unsigned char* lds) {
    const int tid = tid_opaque(), G = gridDim.x, bid = blockIdx.x;
    for (int it = bid; it < 192; it += G) {
        LAS float* sc = (LAS float*)lds;
        for (int i = tid; i < 32 * 1024; i += NTHR) { const float cv = P.c[i]; sc[i] = cv * sigmoidf_(cv); }
        __syncthreads();
        const int kg = tid >> 5, col = tid & 31;
        float a[32];
#pragma unroll
        for (int b = 0; b < 32; ++b) a[b] = 0.f;
#pragma unroll 1
        for (int k = kg * 64; k < kg * 64 + 64; k += 8) {
            float w[8];
#pragma unroll
            for (int e = 0; e < 8; ++e) w[e] = __builtin_nontemporal_load(P.w_ada + (size_t)(k + e) * 6144 + it * 32 + col);
#pragma unroll
            for (int e4 = 0; e4 < 2; ++e4) {
#pragma unroll
                for (int b = 0; b < 32; ++b) { const f32x4 s = *(const LAS f32x4*)(sc + b * 1024 + k + 4 * e4); a[b] += s[0] * w[4 * e4] + s[1] * w[4 * e4 + 1] + s[2] * w[4 * e4 + 2] + s[3] * w[4 * e4 + 3]; }
                asm volatile("" ::: "memory");
            }
        }
        __syncthreads();
        LAS float* red = (LAS float*)lds;
#pragma unroll
        for (int b = 0; b < 32; ++b) red[(kg * 32 + b) * 32 + col] = a[b];
        __syncthreads();
        for (int o = tid; o < 1024; o += NTHR) { const int b = o >> 5, cc = o & 31; float s = 0.f;
#pragma unroll
            for (int g2 = 0; g2 < 16; ++g2) s += red[(g2 * 32 + b) * 32 + cc];
            ((float*)(P.ws + OFF_ADA))[(size_t)b * 6144 + it * 32 + cc] = s + P.b_ada[it * 32 + cc]; }
        __syncthreads();
    }
    const size_t gsz = (size_t)G * NTHR;
    { const int gt = bid * NTHR + tid, gs = G * NTHR;
      if (gt < 512) ((float*)(P.ws + OFF_LB))[gt] = sigmoidf_(P.hgrn_lb[gt] - P.hgrn_lb[512 + gt]);
      for (int i = gt; i < 32 * 8 * 512; i += gs) ((float*)(P.ws + OFF_KMEAN))[i] = 0.f; }
    {
        LAS float* tile = (LAS float*)lds;
        const int I0 = 16 * 88, I1 = I0 + 8 * 16, I2 = I1 + 8 * 16, I3 = I2 + 16 * 16, I4 = I3 + 16 * 16;
        for (int it = bid; it < I4; it += G) {
            const float* W; bf16_t* WT; int K, N, r;
            if (it < I0) { W = P.w_in; WT = (bf16_t*)(P.ws + OFF_WIN); K = 1024; N = 5632; r = it; }
            else if (it < I1) { W = P.w_ba; WT = (bf16_t*)(P.ws + OFF_WBA); K = 512; N = 1024; r = it - I0; }
            else if (it < I2) { W = P.w_bb; WT = (bf16_t*)(P.ws + OFF_WBB); K = 512; N = 1024; r = it - I1; }
            else if (it < I3) { W = P.w_out; WT = (bf16_t*)(P.ws + OFF_WOUT); K = 1024; N = 1024; r = it - I2; }
            else { W = P.peer_wq; WT = (bf16_t*)(P.ws + OFF_WQ); K = 1024; N = 1024; r = it - I3; }
            const int nb = N / 64, k0 = (r / nb) * 64, n0 = (r % nb) * 64;
#pragma unroll
            for (int ps = 0; ps < 2; ++ps) { const int kk = (tid >> 4) + 32 * ps, n4 = (tid & 15) * 4;
                const f32x4 v = *(const f32x4*)(W + (size_t)(k0 + kk) * N + n0 + n4);
                tile[kk * 65 + n4] = v[0]; tile[kk * 65 + n4 + 1] = v[1]; tile[kk * 65 + n4 + 2] = v[2]; tile[kk * 65 + n4 + 3] = v[3]; }
            __syncthreads();
            { const int n = tid >> 3, kc = (tid & 7) * 8;
              if (it < I3) {
                  int w0 = __builtin_amdgcn_cvt_pk_fp8_f32(32.f * tile[(kc + 0) * 65 + n], 32.f * tile[(kc + 1) * 65 + n], 0, false); w0 = __builtin_amdgcn_cvt_pk_fp8_f32(32.f * tile[(kc + 2) * 65 + n], 32.f * tile[(kc + 3) * 65 + n], w0, true);
                  int w1 = __builtin_amdgcn_cvt_pk_fp8_f32(32.f * tile[(kc + 4) * 65 + n], 32.f * tile[(kc + 5) * 65 + n], 0, false); w1 = __builtin_amdgcn_cvt_pk_fp8_f32(32.f * tile[(kc + 6) * 65 + n], 32.f * tile[(kc + 7) * 65 + n], w1, true);
                  *(u32x2*)((unsigned char*)WT + (size_t)(n0 + n) * K + k0 + kc) = (u32x2){(unsigned)w0, (unsigned)w1};
              } else { u32x4 w;
              w.x = cvt_pk_bf16(tile[(kc + 0) * 65 + n], tile[(kc + 1) * 65 + n]); w.y = cvt_pk_bf16(tile[(kc + 2) * 65 + n], tile[(kc + 3) * 65 + n]);
              w.z = cvt_pk_bf16(tile[(kc + 4) * 65 + n], tile[(kc + 5) * 65 + n]); w.w = cvt_pk_bf16(tile[(kc + 6) * 65 + n], tile[(kc + 7) * 65 + n]);
              *(u32x4*)(WT + (size_t)(n0 + n) * K + k0 + kc) = w; } }
            __syncthreads();
        }
    }
    {
        const size_t gtid = (size_t)bid * NTHR + tid_opaque();
        for (size_t i = gtid; i < 16384; i += gsz) {
            const float* src = P.peer_sk + i * 8; const f32x4 a = *(const f32x4*)src, b = *(const f32x4*)(src + 4);
            u32x4 w; w.x = cvt_pk_bf16(a[0], a[1]); w.y = cvt_pk_bf16(a[2], a[3]); w.z = cvt_pk_bf16(b[0], b[1]); w.w = cvt_pk_bf16(b[2], b[3]);
            *(u32x4*)((bf16_t*)(P.ws + OFF_SK) + i * 8) = w;
        }
        { const int lane = tid & 63, gw = bid * 8 + (tid >> 6), ngw = G * 8;
          for (int r = gw; r < 2 * 16384; r += ngw) {
              const bool isv = r >= 16384; const int e = isv ? r - 16384 : r;
              const float* s = (isv ? P.peer_v : P.peer_u) + (size_t)e * 1024 + lane * 16;
              f32x4 x[4]; float ss = 0.f;
#pragma unroll
              for (int q = 0; q < 4; ++q) { x[q] = __builtin_nontemporal_load((const f32x4*)(s + 4 * q)); ss += (x[q][0] * x[q][0] + x[q][1] * x[q][1]) + (x[q][2] * x[q][2] + x[q][3] * x[q][3]); }
              const float sc = fmaxf(sqrtf(wave_sum(ss) * (1.0f / 1024.0f)) * (2.6f / 7.5f), 1e-30f), inv = 1.0f / sc;
              unsigned nb[16];
#pragma unroll
              for (int q = 0; q < 4; ++q)
#pragma unroll
                  for (int el = 0; el < 4; ++el) nb[4 * q + el] = (unsigned)fminf(fmaxf(floorf(x[q][el] * inv) + 8.0f, 0.0f), 15.0f);
              u32x2 w;
              w.x = (nb[0] | (nb[4] << 4)) | ((nb[1] | (nb[5] << 4)) << 8) | ((nb[2] | (nb[6] << 4)) << 16) | ((nb[3] | (nb[7] << 4)) << 24);
              w.y = (nb[8] | (nb[12] << 4)) | ((nb[9] | (nb[13] << 4)) << 8) | ((nb[10] | (nb[14] << 4)) << 16) | ((nb[11] | (nb[15] << 4)) << 24);
              if (!isv) { w.x ^= 0x88888888u; w.y ^= 0x88888888u; }
              else { w.x ^= 0x80808080u; w.y ^= 0x80808080u; }
              *(u32x2*)(P.ws + (isv ? OFF_V8 : OFF_U8) + (size_t)e * 512 + lane * 8) = w;
              if (lane == 0) ((float*)(P.ws + (isv ? OFF_VSC : OFF_USC)))[e] = sc;
          } }
    }
}
__device__ void phase0b(const Params& P) {
    const size_t gtid = (size_t)blockIdx.x * NTHR + threadIdx.x, gsz = (size_t)gridDim.x * NTHR;
    const float* ada = (const float*)(P.ws + OFF_ADA); bf16_t* H = (bf16_t*)(P.ws + OFF_H);
    for (size_t i = gtid; i < (size_t)NTOK * 128; i += gsz) {
        const size_t row = i >> 7; const int c8 = (int)(i & 127) * 8; const int b = (int)(row >> 11);
        const float* xr = P.x + row * 1024 + c8; const float* sh = ada + (size_t)b * 6144 + c8; const float* sc = sh + 1024;
        const f32x4 x0 = *(const f32x4*)xr, x1 = *(const f32x4*)(xr + 4), s0 = *(const f32x4*)sc, s1 = *(const f32x4*)(sc + 4), h0 = *(const f32x4*)sh, h1 = *(const f32x4*)(sh + 4);
        const f32x4 r0 = x0 * (s0 + 1.0f) + h0, r1 = x1 * (s1 + 1.0f) + h1;
        int w0 = __builtin_amdgcn_cvt_pk_fp8_f32(r0[0], r0[1], 0, false); w0 = __builtin_amdgcn_cvt_pk_fp8_f32(r0[2], r0[3], w0, true);
        int w1 = __builtin_amdgcn_cvt_pk_fp8_f32(r1[0], r1[1], 0, false); w1 = __builtin_amdgcn_cvt_pk_fp8_f32(r1[2], r1[3], w1, true);
        *(u32x2*)((unsigned char*)H + row * 1024 + c8) = (u32x2){(unsigned)w0, (unsigned)w1};
    }
}

__device__ __forceinline__ s16x4 tr4(const LAS unsigned char* p) { return __builtin_bit_cast(s16x4, __builtin_amdgcn_ds_read_tr16_b64_v4i16((LAS s16x4*)p)); }
__device__ void hgrn_item(const Params& P, int item, LAS unsigned char* lds) {
    const int tid = tid_opaque(), lane = tid & 63, wid = __builtin_amdgcn_readfirstlane(tid >> 6), r32 = lane & 31, hi = lane >> 5;
    const int b = item >> 3, h = (item >> 1) & 3, vh = item & 1;
    const bf16_t* HQ = (const bf16_t*)(P.ws + OFF_HQ); const bf16_t* HK = (const bf16_t*)(P.ws + OFF_HK); bf16_t* HI = (bf16_t*)(P.ws + OFF_HI);
    constexpr int SQ = 272, SKD = 320, SV = 192, SS = 192;
    constexpr int LQR = 0, LKR = 17408, LQB = 34816, LKD = 52224, LV = 72704, LS = 84992, LG = 109568, LT = 142336, LCL = 144384;
    LAS float* G = (LAS float*)(lds + LG); LAS float* TOT = (LAS float*)(lds + LT); LAS float* CL = (LAS float*)(lds + LCL);
    const size_t rowb = (size_t)b * SEQ;
    const int row = tid >> 3, seg = tid & 7;
    const bf16_t* qsrc = HQ + (rowb + row) * 512 + h * 128 + seg * 16; const bf16_t* ksrc = HK + (rowb + row) * 512 + h * 128 + seg * 16;
    bf16_t* vsrc = HI + (rowb + row) * 512 + h * 128 + vh * 64 + seg * 8;
    for (int i = tid; i < 128 * SS / 4; i += NTHR) ((LAS unsigned*)(lds + LS))[i] = 0u;
    f32x16 Sacc = {};
    const int di = wid >> 1, vi = wid & 1, ti = wid >> 1;
    const int tg = lane >> 4, tc = tg & 1, tI = lane & 15;
    const int trow = 4 * hi + (tI >> 2), tcol = 16 * tc + 4 * (tI & 3);
    u32x4 qn0 = *(const u32x4*)qsrc, qn1 = *(const u32x4*)(qsrc + 8), kn0 = *(const u32x4*)ksrc, kn1 = *(const u32x4*)(ksrc + 8), vn = *(const u32x4*)vsrc;
#pragma unroll 1
    for (int n = 0; n < SEQ / 64; ++n) {
        const u32x4 q0 = qn0, q1 = qn1, k0 = kn0, k1 = kn1, vv = vn;
        float qf[16] = {bf_lo(q0.x), bf_hi(q0.x), bf_lo(q0.y), bf_hi(q0.y), bf_lo(q0.z), bf_hi(q0.z), bf_lo(q0.w), bf_hi(q0.w), bf_lo(q1.x), bf_hi(q1.x), bf_lo(q1.y), bf_hi(q1.y), bf_lo(q1.z), bf_hi(q1.z), bf_lo(q1.w), bf_hi(q1.w)};
        float kf[16] = {bf_lo(k0.x), bf_hi(k0.x), bf_lo(k0.y), bf_hi(k0.y), bf_lo(k0.z), bf_hi(k0.z), bf_lo(k0.w), bf_hi(k0.w), bf_lo(k1.x), bf_hi(k1.x), bf_lo(k1.y), bf_hi(k1.y), bf_lo(k1.z), bf_hi(k1.z), bf_lo(k1.w), bf_hi(k1.w)};
#pragma unroll
        for (int e4 = 0; e4 < 4; ++e4) *(LAS f32x4*)(G + row * 128 + seg * 16 + 4 * e4) = (f32x4){__logf(1.0f - kf[4 * e4]), __logf(1.0f - kf[4 * e4 + 1]), __logf(1.0f - kf[4 * e4 + 2]), __logf(1.0f - kf[4 * e4 + 3])};
        *(LAS u32x4*)(lds + LV + row * SV + seg * 16) = vv;
        if (n + 1 < SEQ / 64) { const size_t o = (size_t)(n + 1) * 64 * 512; qn0 = *(const u32x4*)(qsrc + o); qn1 = *(const u32x4*)(qsrc + o + 8); kn0 = *(const u32x4*)(ksrc + o); kn1 = *(const u32x4*)(ksrc + o + 8); vn = *(const u32x4*)(vsrc + o); }
        __syncthreads();
        { const int d = tid & 127, q4 = tid >> 7; float s = 0.f;
#pragma unroll
          for (int i = 0; i < 16; ++i) { s += G[(16 * q4 + i) * 128 + d]; G[(16 * q4 + i) * 128 + d] = s; }
          TOT[q4 * 128 + d] = s; }
        __syncthreads();
        {
            const int qq = row >> 4;
#pragma unroll
            for (int e4 = 0; e4 < 4; ++e4) {
                const int d4 = seg * 16 + 4 * e4;
                const f32x4 t0 = *(const LAS f32x4*)(TOT + d4), t1 = *(const LAS f32x4*)(TOT + 128 + d4), t2 = *(const LAS f32x4*)(TOT + 256 + d4), t3 = *(const LAS f32x4*)(TOT + 384 + d4);
                const f32x4 off = (qq == 0) ? (f32x4){0.f, 0.f, 0.f, 0.f} : ((qq == 1) ? t0 : ((qq == 2) ? t0 + t1 : t0 + t1 + t2));
                const f32x4 bb = *(const LAS f32x4*)(G + row * 128 + d4) + off;
                const f32x4 bref = *(const LAS f32x4*)(G + 32 * 128 + d4) + t0 + t1, blast = t0 + t1 + t2 + t3;
                float vqb[4], vqr[4], vkr[4], vkd[4];
#pragma unroll
                for (int e = 0; e < 4; ++e) {
                    const float e1 = __expf(bb[e]), e2 = __expf(-bb[e]);
                    vqb[e] = qf[4 * e4 + e] * e1; vqr[e] = vqb[e] * __expf(-bref[e]);
                    const float ke = kf[4 * e4 + e] * e2; vkr[e] = ke * __expf(bref[e]); vkd[e] = ke * __expf(blast[e]);
                }
                *(LAS u32x2*)(lds + LQB + row * SQ + seg * 32 + 8 * e4) = (u32x2){cvt_pk_bf16(vqb[0], vqb[1]), cvt_pk_bf16(vqb[2], vqb[3])};
                *(LAS u32x2*)(lds + LQR + row * SQ + seg * 32 + 8 * e4) = (u32x2){cvt_pk_bf16(vqr[0], vqr[1]), cvt_pk_bf16(vqr[2], vqr[3])};
                *(LAS u32x2*)(lds + LKR + row * SQ + seg * 32 + 8 * e4) = (u32x2){cvt_pk_bf16(vkr[0], vkr[1]), cvt_pk_bf16(vkr[2], vkr[3])};
                *(LAS u32x2*)(lds + LKD + row * SKD + seg * 32 + 8 * e4) = (u32x2){cvt_pk_bf16(vkd[0], vkd[1]), cvt_pk_bf16(vkd[2], vkd[3])};
                if (row == 0) *(LAS f32x4*)(CL + d4) = (f32x4){__expf(blast[0]), __expf(blast[1]), __expf(blast[2]), __expf(blast[3])};
                asm volatile("" ::: "memory");
            }
        }
        __syncthreads();
        if (wid < 4) {
            f32x16 Z = {};
            for (int si = 0; si <= ti; ++si) {
                f32x16 X = {};
#pragma unroll
                for (int ks = 0; ks < 8; ++ks) {
                    const bf16x8 a = *(const LAS bf16x8*)(lds + LKR + (32 * si + r32) * SQ + (16 * ks + 8 * hi) * 2);
                    const bf16x8 bq = *(const LAS bf16x8*)(lds + LQR + (32 * ti + r32) * SQ + (16 * ks + 8 * hi) * 2);
                    X = MFMA32(a, bq, X);
                }
                if (si == ti) {
#pragma unroll
                    for (int r = 0; r < 16; ++r) if (crow(r, hi) > r32) X[r] = 0.f;
                }
#pragma unroll
                for (int s2 = 0; s2 < 2; ++s2) {
                    union { u32x4 u; bf16x8 v; } pa;
                    pa.u.x = cvt_pk_bf16(X[8 * s2 + 0], X[8 * s2 + 1]); pa.u.y = cvt_pk_bf16(X[8 * s2 + 2], X[8 * s2 + 3]); pa.u.z = cvt_pk_bf16(X[8 * s2 + 4], X[8 * s2 + 5]); pa.u.w = cvt_pk_bf16(X[8 * s2 + 6], X[8 * s2 + 7]);
                    const LAS unsigned char* vp = lds + LV + (32 * si + 16 * s2 + trow) * SV + (32 * vi + tcol) * 2;
                    const s16x4 lo = tr4(vp), hh = tr4(vp + 8 * SV);
                    const bf16x8 vf = {lo[0], lo[1], lo[2], lo[3], hh[0], hh[1], hh[2], hh[3]};
                    Z = MFMA32(pa.v, vf, Z);
                }
            }
#pragma unroll
            for (int ks = 0; ks < 8; ++ks) {
                const bf16x8 a = *(const LAS bf16x8*)(lds + LQB + (32 * ti + r32) * SQ + (16 * ks + 8 * hi) * 2);
                const LAS unsigned char* sp = lds + LS + (16 * ks + 8 * hi + (tI >> 2)) * SS + (32 * vi + tcol) * 2;
                const s16x4 lo = tr4(sp), hh = tr4(sp + 4 * SS);
                const bf16x8 sf = {lo[0], lo[1], lo[2], lo[3], hh[0], hh[1], hh[2], hh[3]};
                Z = MFMA32(a, sf, Z);
            }
            bf16_t* op = HI + (rowb + (size_t)n * 64 + 32 * ti) * 512 + h * 128 + vh * 64 + 32 * vi + r32;
#pragma unroll
            for (int r = 0; r < 16; ++r) op[(size_t)crow(r, hi) * 512] = (bf16_t)(cvt_pk_bf16(Z[r], 0.f) & 0xffffu);
        }
        {
#pragma unroll
            for (int r = 0; r < 16; ++r) Sacc[r] *= CL[32 * di + crow(r, hi)];
#pragma unroll
            for (int ks = 0; ks < 4; ++ks) {
                const LAS unsigned char* kp = lds + LKD + (16 * ks + 8 * hi + (tI >> 2)) * SKD + (32 * di + tcol) * 2;
                const s16x4 klo = tr4(kp), khi = tr4(kp + 4 * SKD);
                const bf16x8 ka = {klo[0], klo[1], klo[2], klo[3], khi[0], khi[1], khi[2], khi[3]};
                const LAS unsigned char* vp = lds + LV + (16 * ks + 8 * hi + (tI >> 2)) * SV + (32 * vi + tcol) * 2;
                const s16x4 vlo = tr4(vp), vhi = tr4(vp + 4 * SV);
                const bf16x8 vb = {vlo[0], vlo[1], vlo[2], vlo[3], vhi[0], vhi[1], vhi[2], vhi[3]};
                Sacc = MFMA32(ka, vb, Sacc);
            }
        }
        __syncthreads();
        {
            LAS bf16_t* sp = (LAS bf16_t*)(lds + LS + (32 * di) * SS + (32 * vi + r32) * 2);
#pragma unroll
            for (int r = 0; r < 16; ++r) sp[crow(r, hi) * (SS / 2)] = (bf16_t)(cvt_pk_bf16(Sacc[r], 0.f) & 0xffffu);
        }
    }
    __syncthreads();
}

__device__ void moba_unit(const Params& P, int b, int h, int j, LAS unsigned char* lds) {
    const int tid = tid_opaque(), lane = tid & 63, wid = tid >> 6, r32 = lane & 31, hi = lane >> 5;
    bf16_t* Q = (bf16_t*)(P.ws + OFF_QA); const bf16_t* Kg = (const bf16_t*)(P.ws + OFF_KA); const bf16_t* Vg = (const bf16_t*)(P.ws + OFF_VA);
    const float* kmean = (const float*)(P.ws + OFF_KMEAN);
    constexpr int KIMG = 64 * 144, VIMG = 64 * 192, LK = 0, LV = 4 * KIMG, LKM = 4 * KIMG + 4 * VIMG;
    LAS float* kmL = (LAS float*)(lds + LKM);
    const size_t rowb = (size_t)b * SEQ; const int q0 = j * 256;
    if (tid < j * 64) kmL[tid] = kmean[(size_t)(b * 8 + (tid >> 6)) * 512 + h * 64 + (tid & 63)];
    bf16_t* qrow = Q + (rowb + q0 + wid * 32 + r32) * 512 + h * 64;
    bf16x8 qf[4];
#pragma unroll
    for (int d0 = 0; d0 < 4; ++d0) qf[d0] = *(const bf16x8*)(qrow + 16 * d0 + 8 * hi);
    const int srow = tid >> 3, sch = tid & 7;
    const bf16_t* ksrc = Kg + (rowb + srow) * 512 + h * 64 + sch * 8; const bf16_t* vsrc = Vg + (rowb + srow) * 512 + h * 64 + sch * 8;
    const int ntile = 4 * (j + 1), npair = ntile >> 1;
    auto tile_key0 = [&](int i) -> size_t { const int blk = (i < 4) ? j : ((i - 4) >> 2), kt = (i < 4) ? i : ((i - 4) & 3); return (size_t)(blk * 256 + kt * 64); };
    u32x4 kreg[2], vreg[2];
#pragma unroll
    for (int s = 0; s < 2; ++s) { const size_t k0 = tile_key0(s); kreg[s] = *(const u32x4*)(ksrc + k0 * 512); vreg[s] = *(const u32x4*)(vsrc + k0 * 512); }
#pragma unroll
    for (int s = 0; s < 2; ++s) { *(LAS u32x4*)(lds + LK + s * KIMG + srow * 144 + sch * 16) = kreg[s]; *(LAS u32x4*)(lds + LV + s * VIMG + srow * 192 + sch * 16) = vreg[s]; }
    __syncthreads();
    unsigned sel = 0;
    if (j <= 3) sel = (1u << j) - 1u;
    else {
        float g[7];
#pragma unroll
        for (int n = 0; n < 7; ++n) { float s = 0.f;
            if (n < j) {
#pragma unroll
                for (int d0 = 0; d0 < 4; ++d0)
#pragma unroll
                    for (int e = 0; e < 8; ++e) s += __uint_as_float(((unsigned)(unsigned short)qf[d0][e]) << 16) * kmL[n * 64 + 16 * d0 + 8 * hi + e];
            }
            s += __shfl_xor(s, 32); g[n] = s; }
#pragma unroll
        for (int it = 0; it < 3; ++it) { float best = -INFINITY; int bi = 0;
#pragma unroll
            for (int n = 0; n < 7; ++n) if (n < j && !((sel >> n) & 1u) && g[n] > best) { best = g[n]; bi = n; }
            sel |= 1u << bi; }
    }
    const float ch = exp2f(-(float)(h + 1)) * LOG2E;
    const int qb = wid * 32 + r32;
    float m_run = -1e30f, l_run = 0.f;
    f32x16 o0 = {}, o1 = {};
    const int tg = lane >> 4, tc = tg & 1, ti = lane & 15;
    const int vlane = (4 * hi + (ti >> 2)) * 192 + (16 * tc + 4 * (ti & 3)) * 2;
#pragma unroll 1
    for (int ip = 0; ip < npair; ++ip) {
      const int pbuf = ip & 1;
      if (ip + 1 < npair) {
#pragma unroll
          for (int s = 0; s < 2; ++s) { const size_t k1 = tile_key0(2 * ip + 2 + s); kreg[s] = *(const u32x4*)(ksrc + k1 * 512); vreg[s] = *(const u32x4*)(vsrc + k1 * 512); }
      }
#pragma unroll
      for (int s2 = 0; s2 < 2; ++s2) {
        const int i = 2 * ip + s2, buf = pbuf * 2 + s2;
        const bool own = i < 4; const int blk = own ? j : ((i - 4) >> 2), kt = own ? i : ((i - 4) & 3);
        const bool lane_ok = own ? true : (((sel >> blk) & 1u) != 0u);
        const bool skip = own ? (64 * kt > 32 * wid + 31) : (__ballot(lane_ok) == 0ull);
        if (!skip) {
            LAS unsigned char* kb = lds + LK + buf * KIMG; LAS unsigned char* vb = lds + LV + buf * VIMG;
            f32x16 p0 = {}, p1 = {};
#pragma unroll
            for (int d0 = 0; d0 < 4; ++d0) {
                const bf16x8 kf0 = *(const LAS bf16x8*)(kb + r32 * 144 + (16 * d0 + 8 * hi) * 2);
                const bf16x8 kf1 = *(const LAS bf16x8*)(kb + (32 + r32) * 144 + (16 * d0 + 8 * hi) * 2);
                p0 = MFMA32(kf0, qf[d0], p0); p1 = MFMA32(kf1, qf[d0], p1);
            }
            const float kbase = ch * (float)((blk - j) * 256 + kt * 64);
            float mt = -1e30f;
#pragma unroll
            for (int r = 0; r < 16; ++r) {
                const int kl0 = crow(r, hi), kl1 = kl0 + 32;
                p0[r] = __builtin_fmaf(ch, (float)kl0, p0[r]); p1[r] = __builtin_fmaf(ch, (float)kl1, p1[r]);
                if (own) { if (kt * 64 + kl0 > qb) p0[r] = -1e30f; if (kt * 64 + kl1 > qb) p1[r] = -1e30f; }
                mt = fmaxf(mt, fmaxf(p0[r], p1[r]));
            }
            mt = lane_ok ? mt + kbase : -1e30f;
            mt = fmaxf(mt, __shfl_xor(mt, 32));
            if (__ballot(mt > m_run) != 0ull) {
                const float mnew = fmaxf(m_run, mt), alpha = __builtin_amdgcn_exp2f(m_run - mnew);
                m_run = mnew; l_run *= alpha;
#pragma unroll
                for (int r = 0; r < 16; ++r) { o0[r] *= alpha; o1[r] *= alpha; }
            }
            const float sh = lane_ok ? kbase - m_run : -1e30f;
            float rs = 0.f;
#pragma unroll
            for (int r = 0; r < 16; ++r) { p0[r] = __builtin_amdgcn_exp2f(p0[r] + sh); p1[r] = __builtin_amdgcn_exp2f(p1[r] + sh); rs += p0[r] + p1[r]; }
            l_run += rs;
#pragma unroll
            for (int sub = 0; sub < 2; ++sub)
#pragma unroll
                for (int s = 0; s < 2; ++s) {
                    union { u32x4 u; bf16x8 v; } pb;
                    if (sub == 0) { pb.u.x = cvt_pk_bf16(p0[8 * s + 0], p0[8 * s + 1]); pb.u.y = cvt_pk_bf16(p0[8 * s + 2], p0[8 * s + 3]); pb.u.z = cvt_pk_bf16(p0[8 * s + 4], p0[8 * s + 5]); pb.u.w = cvt_pk_bf16(p0[8 * s + 6], p0[8 * s + 7]); }
                    else { pb.u.x = cvt_pk_bf16(p1[8 * s + 0], p1[8 * s + 1]); pb.u.y = cvt_pk_bf16(p1[8 * s + 2], p1[8 * s + 3]); pb.u.z = cvt_pk_bf16(p1[8 * s + 4], p1[8 * s + 5]); pb.u.w = cvt_pk_bf16(p1[8 * s + 6], p1[8 * s + 7]); }
#pragma unroll
                    for (int dt = 0; dt < 2; ++dt) {
                        LAS unsigned char* va = vb + (32 * sub + 16 * s) * 192 + dt * 64 + vlane;
                        const s16x4 lo = __builtin_bit_cast(s16x4, __builtin_amdgcn_ds_read_tr16_b64_v4i16((LAS s16x4*)va));
                        const s16x4 hh = __builtin_bit_cast(s16x4, __builtin_amdgcn_ds_read_tr16_b64_v4i16((LAS s16x4*)(va + 8 * 192)));
                        const bf16x8 vf = {lo[0], lo[1], lo[2], lo[3], hh[0], hh[1], hh[2], hh[3]};
                        if (dt == 0) o0 = MFMA32(vf, pb.v, o0); else o1 = MFMA32(vf, pb.v, o1);
                    }
                }
        }
      }
      if (ip + 1 < npair) { const int nb = (pbuf ^ 1) * 2;
#pragma unroll
          for (int s = 0; s < 2; ++s) { *(LAS u32x4*)(lds + LK + (nb + s) * KIMG + srow * 144 + sch * 16) = kreg[s]; *(LAS u32x4*)(lds + LV + (nb + s) * VIMG + srow * 192 + sch * 16) = vreg[s]; } }
      __syncthreads();
    }
    l_run += __shfl_xor(l_run, 32);
    const float inv = 1.0f / l_run;
#pragma unroll
    for (int r4 = 0; r4 < 4; ++r4) {
        int w0 = __builtin_amdgcn_cvt_pk_fp8_f32(o0[4 * r4] * inv, o0[4 * r4 + 1] * inv, 0, false); w0 = __builtin_amdgcn_cvt_pk_fp8_f32(o0[4 * r4 + 2] * inv, o0[4 * r4 + 3] * inv, w0, true);
        int w1 = __builtin_amdgcn_cvt_pk_fp8_f32(o1[4 * r4] * inv, o1[4 * r4 + 1] * inv, 0, false); w1 = __builtin_amdgcn_cvt_pk_fp8_f32(o1[4 * r4 + 2] * inv, o1[4 * r4 + 3] * inv, w1, true);
        unsigned char* yrow = P.ws + OFF_EG + (rowb + q0 + wid * 32 + r32) * 1024 + h * 64;
        *(int*)(yrow + 8 * r4 + 4 * hi) = w0; *(int*)(yrow + 32 + 8 * r4 + 4 * hi) = w1;
    }
}

__device__ void yb_norm_panel(const Params& P, int pm) {
    const int tid = tid_opaque(), lane = tid & 63, wid = tid >> 6;
    bf16_t* HI = (bf16_t*)(P.ws + OFF_HI); const bf16_t* HG = (const bf16_t*)(P.ws + OFF_HG);
    for (int r = 0; r < 32; ++r) {
        const size_t off = ((size_t)pm * 256 + wid * 32 + r) * 512 + lane * 8;
        const u32x4 ov = *(const u32x4*)(HI + off), gv = *(const u32x4*)(HG + off);
        float o[8] = {bf_lo(ov.x), bf_hi(ov.x), bf_lo(ov.y), bf_hi(ov.y), bf_lo(ov.z), bf_hi(ov.z), bf_lo(ov.w), bf_hi(ov.w)};
        const float g[8] = {bf_lo(gv.x), bf_hi(gv.x), bf_lo(gv.y), bf_hi(gv.y), bf_lo(gv.z), bf_hi(gv.z), bf_lo(gv.w), bf_hi(gv.w)};
        float ss = 0.f;
#pragma unroll
        for (int e = 0; e < 8; ++e) ss += o[e] * o[e];
        ss += __shfl_xor(ss, 1); ss += __shfl_xor(ss, 2); ss += __shfl_xor(ss, 4); ss += __shfl_xor(ss, 8);
        const float rs = rsqrtf(ss * (1.0f / 128.0f) + RMS_EPS);
        int w0 = __builtin_amdgcn_cvt_pk_fp8_f32(o[0] * rs * g[0], o[1] * rs * g[1], 0, false); w0 = __builtin_amdgcn_cvt_pk_fp8_f32(o[2] * rs * g[2], o[3] * rs * g[3], w0, true);
        int w1 = __builtin_amdgcn_cvt_pk_fp8_f32(o[4] * rs * g[4], o[5] * rs * g[5], 0, false); w1 = __builtin_amdgcn_cvt_pk_fp8_f32(o[6] * rs * g[6], o[7] * rs * g[7], w1, true);
        *(u32x2*)(P.ws + OFF_EG + ((size_t)pm * 256 + wid * 32 + r) * 1024 + 512 + lane * 8) = (u32x2){(unsigned)w0, (unsigned)w1};
    }
}
__device__ void ln1_panel(const Params& P, int pm) {
    const int tid = tid_opaque(), lane = tid & 63, wid = tid >> 6;
    const float* ada = (const float*)(P.ws + OFF_ADA) + (size_t)(pm >> 3) * 6144; bf16_t* H = (bf16_t*)(P.ws + OFF_H);
    for (int r = 0; r < 32; ++r) {
        const size_t row = (size_t)pm * 256 + wid * 32 + r;
        const float* xin = P.x + row * 1024 + lane * 4; const bf16_t* dl = (const bf16_t*)(P.ws + OFF_GB) + row * 1024 + lane * 4;
        f32x4 v[4]; float s = 0.f;
#pragma unroll
        for (int jx = 0; jx < 4; ++jx) { const u32x2 dv = *(const u32x2*)(dl + 256 * jx); const f32x4 xv = __builtin_nontemporal_load((const f32x4*)(xin + 256 * jx));
            v[jx] = xv * ALPHA + (f32x4){bf_lo(dv.x), bf_hi(dv.x), bf_lo(dv.y), bf_hi(dv.y)}; s += (v[jx][0] + v[jx][1]) + (v[jx][2] + v[jx][3]); }
        const float mean = wave_sum(s) * (1.0f / 1024.0f); float s2 = 0.f;
#pragma unroll
        for (int jx = 0; jx < 4; ++jx) { v[jx] = v[jx] - mean; s2 += (v[jx][0] * v[jx][0] + v[jx][1] * v[jx][1]) + (v[jx][2] * v[jx][2] + v[jx][3] * v[jx][3]); }
        const float rstd = rsqrtf(wave_sum(s2) * (1.0f / 1024.0f) + LN_EPS);
#pragma unroll
        for (int jx = 0; jx < 4; ++jx) {
            const int c = lane * 4 + 256 * jx;
            const f32x4 g = *(const f32x4*)(P.ln1_g + c), bb = *(const f32x4*)(P.ln1_b + c), sh = *(const f32x4*)(ada + 3072 + c), sc = *(const f32x4*)(ada + 4096 + c);
            const f32x4 x1 = v[jx] * rstd * g + bb;
            { u32x2 w1; w1.x = cvt_pk_bf16(x1[0], x1[1]); w1.y = cvt_pk_bf16(x1[2], x1[3]);
              *(u32x2*)((bf16_t*)(P.out + row * 1024) + c) = w1; }
            const f32x4 h2 = x1 * (sc + 1.0f) + sh;
            u32x2 w; w.x = cvt_pk_bf16(h2[0], h2[1]); w.y = cvt_pk_bf16(h2[2], h2[3]);
            *(u32x2*)(H + row * 1024 + c) = w;
            v[jx] = h2;
        }
        {
            float mx = 0.f;
#pragma unroll
            for (int jx = 0; jx < 4; ++jx) mx = fmaxf(mx, fmaxf(fmaxf(fabsf(v[jx][0]), fabsf(v[jx][1])), fmaxf(fabsf(v[jx][2]), fabsf(v[jx][3]))));
#pragma unroll
            for (int o = 1; o < 64; o <<= 1) mx = fmaxf(mx, __shfl_xor(mx, o));
            const float hs = fmaxf(mx * (1.0f / 119.0f), 1e-30f), inv = 1.0f / hs; int qs = 0;
            const int nsh = (lane & 1) * 4;
#pragma unroll
            for (int jx = 0; jx < 4; ++jx) {
                unsigned pa = 0u, pb = 0u;
#pragma unroll
                for (int k = 0; k < 4; ++k) { const int q = (int)rintf(v[jx][k] * inv); qs += q;
                    const int b = ((q + 8) & 15) - 8, a = (q - b) >> 4;
                    pa |= (unsigned)(a & 15) << (8 * k + nsh); pb |= (unsigned)(b & 15) << (8 * k + nsh); }
                pa |= __shfl_xor(pa, 1); pb |= __shfl_xor(pb, 1);
                if (!(lane & 1)) { unsigned* hp4 = (unsigned*)(P.ws + OFF_H8 + row * 1024) + (lane >> 1) + 32 * jx; hp4[0] = pa; hp4[128] = pb; }
            }
#pragma unroll
            for (int o = 1; o < 64; o <<= 1) qs += __shfl_xor(qs, o);
            if (lane == 0) *(f32x2*)(P.ws + OFF_HS + row * 8) = (f32x2){hs, (float)qs};
        }
    }
}

#define CE16(A, i, j) do { const float hi_ = fmaxf(A[i], A[j]); A[j] = fminf(A[i], A[j]); A[i] = hi_; } while (0)
#define SORT16(A) do { CE16(A, 0, 1); CE16(A, 2, 3); CE16(A, 0, 2); CE16(A, 1, 3); CE16(A, 1, 2); CE16(A, 4, 5); CE16(A, 6, 7); CE16(A, 4, 6); CE16(A, 5, 7); CE16(A, 5, 6); CE16(A, 0, 4); CE16(A, 2, 6); CE16(A, 2, 4); CE16(A, 1, 5); CE16(A, 3, 7); CE16(A, 3, 5); CE16(A, 1, 2); CE16(A, 3, 4); CE16(A, 5, 6); CE16(A, 8, 9); CE16(A, 10, 11); CE16(A, 8, 10); CE16(A, 9, 11); CE16(A, 9, 10); CE16(A, 12, 13); CE16(A, 14, 15); CE16(A, 12, 14); CE16(A, 13, 15); CE16(A, 13, 14); CE16(A, 8, 12); CE16(A, 10, 14); CE16(A, 10, 12); CE16(A, 9, 13); CE16(A, 11, 15); CE16(A, 11, 13); CE16(A, 9, 10); CE16(A, 11, 12); CE16(A, 13, 14); CE16(A, 0, 8); CE16(A, 4, 12); CE16(A, 4, 8); CE16(A, 2, 10); CE16(A, 6, 14); CE16(A, 6, 10); CE16(A, 2, 4); CE16(A, 6, 8); CE16(A, 10, 12); CE16(A, 1, 9); CE16(A, 5, 13); CE16(A, 5, 9); CE16(A, 3, 11); CE16(A, 7, 15); CE16(A, 7, 11); CE16(A, 3, 5); CE16(A, 7, 9); CE16(A, 11, 13); CE16(A, 1, 2); CE16(A, 3, 4); CE16(A, 5, 6); CE16(A, 7, 8); CE16(A, 9, 10); CE16(A, 11, 12); CE16(A, 13, 14); } while (0)
#define BITONIC16(A) do { CE16(A, 0, 8); CE16(A, 1, 9); CE16(A, 2, 10); CE16(A, 3, 11); CE16(A, 4, 12); CE16(A, 5, 13); CE16(A, 6, 14); CE16(A, 7, 15); CE16(A, 0, 4); CE16(A, 1, 5); CE16(A, 2, 6); CE16(A, 3, 7); CE16(A, 8, 12); CE16(A, 9, 13); CE16(A, 10, 14); CE16(A, 11, 15); CE16(A, 0, 2); CE16(A, 1, 3); CE16(A, 4, 6); CE16(A, 5, 7); CE16(A, 8, 10); CE16(A, 9, 11); CE16(A, 12, 14); CE16(A, 13, 15); CE16(A, 0, 1); CE16(A, 2, 3); CE16(A, 4, 5); CE16(A, 6, 7); CE16(A, 8, 9); CE16(A, 10, 11); CE16(A, 12, 13); CE16(A, 14, 15); } while (0)
#define INS16(L, xin) do { float x_ = (xin); _Pragma("unroll") for (int k_ = 0; k_ < 16; ++k_) { const float hi_ = fmaxf(L[k_], x_); x_ = fminf(L[k_], x_); L[k_] = hi_; } } while (0)

__device__ void peer_select_wave(const Params& P, size_t tok0) {
    const int lane = tid_opaque() & 63, r32 = lane & 31, hi = lane >> 5;
    const bf16_t* QP = (const bf16_t*)(P.ws + OFF_GB) + (tok0 + r32) * 1024; const bf16_t* SK = (const bf16_t*)(P.ws + OFF_SK);
    u32x2* EG = (u32x2*)(P.ws + OFF_EG) + (tok0 + r32) * 128;
#pragma unroll 1
    for (int h = 0; h < 8; ++h) {
        float a0[16], a1[16];
#pragma unroll
        for (int k = 0; k < 16; ++k) { a0[k] = -INFINITY; a1[k] = -INFINITY; }
#pragma unroll
        for (int p = 0; p < 2; ++p) {
            const int hp = h * 2 + p;
            bf16x8 qf[4];
#pragma unroll
            for (int ks = 0; ks < 4; ++ks) qf[ks] = *(const bf16x8*)(QP + hp * 64 + 16 * ks + 8 * hi);
            float L[16];
#pragma unroll
            for (int kt = 0; kt < 4; ++kt) {
                f32x16 acc = {};
#pragma unroll
                for (int ks = 0; ks < 4; ++ks) { const bf16x8 kf = *(const bf16x8*)(SK + ((size_t)hp * 128 + 32 * kt + r32) * 64 + 16 * ks + 8 * hi); acc = MFMA32(kf, qf[ks], acc); }
                float S[16];
#pragma unroll
                for (int r = 0; r < 16; ++r) { const unsigned key = (unsigned)(32 * kt + crow(r, hi)); S[r] = __uint_as_float((__float_as_uint(acc[r]) & ~127u) | key); }
                SORT16(S);
                if (kt == 0) {
#pragma unroll
                    for (int k = 0; k < 16; ++k) L[k] = S[k];
                } else {
#pragma unroll
                    for (int k = 0; k < 16; ++k) L[k] = fmaxf(L[k], S[15 - k]);
                    BITONIC16(L);
                }
            }
            {
                float O[16];
#pragma unroll
                for (int k = 0; k < 16; ++k) O[k] = __shfl_xor(L[15 - k], 32);
#pragma unroll
                for (int k = 0; k < 16; ++k) L[k] = fmaxf(L[k], O[k]);
                BITONIC16(L);
            }
#pragma unroll
            for (int k = 0; k < 16; ++k) { a0[k] = (p == 0) ? L[k] : a0[k]; a1[k] = (p == 1) ? L[k] : a1[k]; }
        }
        float best[16];
#pragma unroll
        for (int k = 0; k < 16; ++k) best[k] = __uint_as_float((__float_as_uint(a0[0] + a1[k]) & ~255u) | (unsigned)k);
#pragma unroll
        for (int i = 1; i < 16; ++i)
#pragma unroll
            for (int jx = 0; jx < 16; ++jx)
                if ((i + 1) * (jx + 1) <= 16) {
                    const float cs = a0[i] + a1[jx];
                    const float cv = __uint_as_float((__float_as_uint(cs) & ~255u) | (unsigned)(i * 16 + jx));
                    INS16(best, cv);
                }
        unsigned pk0[4], pk1[4];
#pragma unroll
        for (int q = 0; q < 4; ++q) {
            pk0[q] = (__float_as_uint(a0[4 * q]) & 127u) | ((__float_as_uint(a0[4 * q + 1]) & 127u) << 8) | ((__float_as_uint(a0[4 * q + 2]) & 127u) << 16) | ((__float_as_uint(a0[4 * q + 3]) & 127u) << 24);
            pk1[q] = (__float_as_uint(a1[4 * q]) & 127u) | ((__float_as_uint(a1[4 * q + 1]) & 127u) << 8) | ((__float_as_uint(a1[4 * q + 2]) & 127u) << 16) | ((__float_as_uint(a1[4 * q + 3]) & 127u) << 24);
        }
        unsigned pay[16];
#pragma unroll
        for (int k = 0; k < 16; ++k) {
            const unsigned code = __float_as_uint(best[k]) & 255u, ci = code >> 4, cj = code & 15u;
            const unsigned qi = ci >> 2, qj = cj >> 2;
            const unsigned w0 = (qi == 0u) ? pk0[0] : ((qi == 1u) ? pk0[1] : ((qi == 2u) ? pk0[2] : pk0[3]));
            const unsigned w1 = (qj == 0u) ? pk1[0] : ((qj == 1u) ? pk1[1] : ((qj == 2u) ? pk1[2] : pk1[3]));
            pay[k] = (((w0 >> ((ci & 3u) * 8u)) & 127u) << 7) | ((w1 >> ((cj & 3u) * 8u)) & 127u);
        }
        float e[16], es = 0.f;
#pragma unroll
        for (int k = 0; k < 16; ++k) { e[k] = __expf(best[k] - best[0]); es += e[k]; }
        const float inv = 1.0f / es;
        if (hi == 0) {
#pragma unroll
            for (int k = 0; k < 16; ++k) { u32x2 w; w.x = pay[k]; w.y = __float_as_uint(e[k] * inv); EG[h * 16 + k] = w; }
        }
    }
}
__device__ __forceinline__ unsigned xcc_id() { return (unsigned)__builtin_amdgcn_s_getreg((3 << 11) | 20) & 0xFu; }
template <int CTRL> __device__ __forceinline__ float dpp_add(float x) { const int v = __builtin_amdgcn_update_dpp(0, __float_as_int(x), CTRL, 0xf, 0xf, true); return x + __int_as_float(v); }
__device__ __forceinline__ float wave_sum_fast(float x) {
    x = dpp_add<0xB1>(x); x = dpp_add<0x4E>(x); x = dpp_add<0x141>(x); x = dpp_add<0x140>(x);
    x += __shfl_xor(x, 16); x += __shfl_xor(x, 32); return x;
}
template <int CTRL> __device__ __forceinline__ float dpp_max(float x) { const int v = __builtin_amdgcn_update_dpp(0, __float_as_int(x), CTRL, 0xf, 0xf, true); return fmaxf(x, __int_as_float(v)); }
template <int CTRL> __device__ __forceinline__ int dpp_addi(int x) { return x + __builtin_amdgcn_update_dpp(0, x, CTRL, 0xf, 0xf, true); }
__device__ __forceinline__ float wave_max_fast(float x) {
    x = dpp_max<0xB1>(x); x = dpp_max<0x4E>(x); x = dpp_max<0x141>(x); x = dpp_max<0x140>(x);
    x = fmaxf(x, __shfl_xor(x, 16)); x = fmaxf(x, __shfl_xor(x, 32)); return x;
}
__device__ __forceinline__ int wave_sum_int_fast(int x) {
    x = dpp_addi<0xB1>(x); x = dpp_addi<0x4E>(x); x = dpp_addi<0x141>(x); x = dpp_addi<0x140>(x);
    x += __shfl_xor(x, 16); x += __shfl_xor(x, 32); return x;
}
__device__ __forceinline__ float dot16_fp8(const float (&hv)[16], const u32x4 r) {
    float s = 0.f;
    { const f32x2 a = __builtin_amdgcn_cvt_pk_f32_fp8((int)r.x, false), b = __builtin_amdgcn_cvt_pk_f32_fp8((int)r.x, true); s += hv[0] * a.x + hv[1] * a.y + hv[2] * b.x + hv[3] * b.y; }
    { const f32x2 a = __builtin_amdgcn_cvt_pk_f32_fp8((int)r.y, false), b = __builtin_amdgcn_cvt_pk_f32_fp8((int)r.y, true); s += hv[4] * a.x + hv[5] * a.y + hv[6] * b.x + hv[7] * b.y; }
    { const f32x2 a = __builtin_amdgcn_cvt_pk_f32_fp8((int)r.z, false), b = __builtin_amdgcn_cvt_pk_f32_fp8((int)r.z, true); s += hv[8] * a.x + hv[9] * a.y + hv[10] * b.x + hv[11] * b.y; }
    { const f32x2 a = __builtin_amdgcn_cvt_pk_f32_fp8((int)r.w, false), b = __builtin_amdgcn_cvt_pk_f32_fp8((int)r.w, true); s += hv[12] * a.x + hv[13] * a.y + hv[14] * b.x + hv[15] * b.y; }
    return s;
}
template <int NP, class F> __device__ __forceinline__ void partition_queue(const Params& P, LAS unsigned char* lds, int ctr_base, F f) {
    const int tid = tid_opaque();
    LAS int* slot = (LAS int*)(lds + LDS_BYTES - 64);
    unsigned* ctr = (unsigned*)(P.ws + OFF_CTR) + ctr_base;
    const int myx = (int)(xcc_id() & 7u);
    for (int pp = 0; pp < NP; ++pp) {
        const int p = (myx * (NP / 8) + pp) % NP;
        for (;;) {
            if (tid == 0) *slot = (int)atomicAdd(ctr + p, 1u);
            __syncthreads();
            const int item = *slot;
            __syncthreads();
            if (item >= NTOK / 64) break;
            f(p, item);
        }
    }
}
__device__ __forceinline__ float dot2bf(unsigned a, bf16v2 b, float c) { return __builtin_amdgcn_fdot2_f32_bf16(__builtin_bit_cast(bf16v2, a), b, c, false); }
__device__ __forceinline__ float gelu_erf(float v) {
    const float av = fabsf(v), t = __builtin_amdgcn_rcpf(__builtin_fmaf(av, 0.2316418882f, 1.0f));
    float q = __builtin_fmaf(t, 0.5307027145f, -0.7265760135f); q = __builtin_fmaf(q, t, 0.7107068705f); q = __builtin_fmaf(q, t, -0.142248368f); q = __builtin_fmaf(q, t, 0.127414796f); q = q * t;
    const float m = v * (q * __builtin_amdgcn_exp2f(v * v * -0.72134752044f));
    return v < 0.f ? m : v - m;
}
struct UQuad { u32x4 r[2]; u32x4 ent, nxt; };
__device__ __forceinline__ void uq_issue(UQuad& q, const LAS u32x4* list, int J, int NQ, int g, const unsigned char* Ub, const unsigned lo) {
    q.ent = q.nxt;
    const unsigned char* rp = Ub + (q.ent.x * 512u + lo);
    q.r[0] = *(const u32x4*)rp; q.r[1] = *(const u32x4*)(rp + 256);
    const int jj = J < NQ ? J : NQ - 1;
    q.nxt = list[4 * jj + g];
}
__device__ __forceinline__ float uq_dot(const UQuad& q, const u32x4 (&hp)[4]) {
    int a = 0, b = 0;
#pragma unroll
    for (int c = 0; c < 2; ++c) {
        const u32x4 r = q.r[c];
        a = __builtin_amdgcn_sdot8((int)hp[c].x, (int)r.x, a, false); a = __builtin_amdgcn_sdot8((int)hp[c].y, (int)r.y, a, false);
        a = __builtin_amdgcn_sdot8((int)hp[c].z, (int)r.z, a, false); a = __builtin_amdgcn_sdot8((int)hp[c].w, (int)r.w, a, false);
        b = __builtin_amdgcn_sdot8((int)hp[2 + c].x, (int)r.x, b, false); b = __builtin_amdgcn_sdot8((int)hp[2 + c].y, (int)r.y, b, false);
        b = __builtin_amdgcn_sdot8((int)hp[2 + c].z, (int)r.z, b, false); b = __builtin_amdgcn_sdot8((int)hp[2 + c].w, (int)r.w, b, false);
    }
    float s = (float)(16 * a + b);
    s = dpp_add<0xB1>(s); s = dpp_add<0x4E>(s); s = dpp_add<0x141>(s); s = dpp_add<0x140>(s);
    return s;
}
__device__ __forceinline__ void peer_u_tokens(const Params& P, LAS unsigned char* lds, const size_t t0) {
    const int tid = tid_opaque(), lane = tid & 63, wid = tid >> 6, g = lane >> 4, li = lane & 15;
    const unsigned char* H8 = P.ws + OFF_H8 + li * 16; const unsigned char* Ub = P.ws + OFF_U8; const unsigned lo16 = (unsigned)li * 16u;
    const f32x2* HS = (const f32x2*)(P.ws + OFF_HS); const float* USC = (const float*)(P.ws + OFF_USC);
    const u32x4* EG4 = (const u32x4*)(P.ws + OFF_EG); float* W = (float*)(P.ws + OFF_W);
    LAS u32x4* list = (LAS u32x4*)(lds + wid * 16384);
    {
        u32x4 egv[8]; float s0[8], s1[8];
#pragma unroll
        for (int i = 0; i < 8; ++i) egv[i] = EG4[(t0 + i) * 64 + lane];
#pragma unroll
        for (int i = 0; i < 8; ++i) { s0[i] = USC[egv[i].x]; s1[i] = USC[egv[i].z]; }
#pragma unroll
        for (int i = 0; i < 8; ++i) {
            list[i * 128 + 2 * lane] = (u32x4){egv[i].x, egv[i].y, (unsigned)(2 * lane) | (unsigned)(i << 8), __float_as_uint(s0[i])};
            list[i * 128 + 2 * lane + 1] = (u32x4){egv[i].z, egv[i].w, (unsigned)(2 * lane + 1) | (unsigned)(i << 8), __float_as_uint(s1[i])};
        }
    }
    constexpr int NQ = 256;
    u32x4 hp[4], hn[4]; f32x2 hsc = HS[t0], hsn = HS[t0 + 1];
#pragma unroll
    for (int c = 0; c < 2; ++c) { hp[c] = *(const u32x4*)(H8 + t0 * 1024 + 256 * c); hp[2 + c] = *(const u32x4*)(H8 + t0 * 1024 + 512 + 256 * c);
                                  hn[c] = *(const u32x4*)(H8 + (t0 + 1) * 1024 + 256 * c); hn[2 + c] = *(const u32x4*)(H8 + (t0 + 1) * 1024 + 512 + 256 * c); }
    int curtok = 0;
    UQuad q0, q1, q2, q3, q4, q5, q6, q7;
    q0.nxt = list[g]; q1.nxt = list[4 + g]; q2.nxt = list[8 + g]; q3.nxt = list[12 + g]; q4.nxt = list[16 + g]; q5.nxt = list[20 + g]; q6.nxt = list[24 + g]; q7.nxt = list[28 + g];
    uq_issue(q0, list, 8, NQ, g, Ub, lo16); uq_issue(q1, list, 9, NQ, g, Ub, lo16); uq_issue(q2, list, 10, NQ, g, Ub, lo16); uq_issue(q3, list, 11, NQ, g, Ub, lo16);
    uq_issue(q4, list, 12, NQ, g, Ub, lo16); uq_issue(q5, list, 13, NQ, g, Ub, lo16); uq_issue(q6, list, 14, NQ, g, Ub, lo16); uq_issue(q7, list, 15, NQ, g, Ub, lo16);
    float sv = 0.f; unsigned gv = 0u, zv = 0u;
#define UQ_PIN(q) asm volatile("" : "+v"(q.r[0]), "+v"(q.r[1]) :: "memory")
#define UQ_STEP(q, Jn, kq, qn) do { \
        const float s = __uint_as_float(q.ent.w) * hsc.x * (uq_dot(q, hp) + 0.5f * hsc.y); \
        if (li == (kq)) { sv = s; gv = q.ent.y; zv = q.ent.z; } \
        uq_issue(q, list, (Jn), NQ, g, Ub, lo16); UQ_PIN(qn); } while (0)
    UQ_PIN(q0);
#pragma unroll 1
    for (int J = 0; J < NQ; J += 8) {
        const int tk = __builtin_amdgcn_readfirstlane((int)(q0.ent.z >> 8));
        if (tk != curtok) { curtok = tk;
#pragma unroll
            for (int c = 0; c < 4; ++c) hp[c] = hn[c];
            hsc = hsn;
            if (tk + 1 < 8) { hsn = HS[t0 + tk + 1];
#pragma unroll
                for (int c = 0; c < 2; ++c) { hn[c] = *(const u32x4*)(H8 + (t0 + tk + 1) * 1024 + 256 * c); hn[2 + c] = *(const u32x4*)(H8 + (t0 + tk + 1) * 1024 + 512 + 256 * c); } } }
        UQ_STEP(q0, J + 16, 0, q1); UQ_STEP(q1, J + 17, 1, q2); UQ_STEP(q2, J + 18, 2, q3); UQ_STEP(q3, J + 19, 3, q4);
        UQ_STEP(q4, J + 20, 4, q5); UQ_STEP(q5, J + 21, 5, q6); UQ_STEP(q6, J + 22, 6, q7); UQ_STEP(q7, J + 23, 7, q0);
        if (li < 8) W[(t0 + tk) * 128 + (zv & 255u)] = __uint_as_float(gv) * gelu_erf(sv); }
#undef UQ_STEP
}
typedef int v4i_t __attribute__((ext_vector_type(4)));
struct VQuad { u32x4 r[2]; u32x2 ent, nxt; };
__device__ __forceinline__ void vq_issue(VQuad& q, const LAS u32x2* list, int J, int g, const unsigned char* Vb, const unsigned lo) {
    q.ent = q.nxt;
    const unsigned char* rp = Vb + (q.ent.x * 512u + lo);
    q.r[0] = *(const u32x4*)rp; q.r[1] = *(const u32x4*)(rp + 256);
    const int jj = J < 256 ? J : 255;
    q.nxt = list[4 * jj + g];
}
#define VQ_PIN(q) asm volatile("" : "+v"(q.r[0]), "+v"(q.r[1]) :: "memory")
__device__ __forceinline__ void vq_mma(const VQuad& q, v4i_t (&acc)[4], const u32x4 bm) {
    const unsigned t = q.ent.y;
    const v4i_t B = {(int)(t & bm.x), (int)(t & bm.y), (int)(t & bm.z), (int)(t & bm.w)};
#pragma unroll
    for (int c = 0; c < 2; ++c) {
        const u32x4 r = q.r[c];
        const v4i_t lo = {(int)(r.x & 0x0F0F0F0Fu), (int)(r.y & 0x0F0F0F0Fu), (int)(r.z & 0x0F0F0F0Fu), (int)(r.w & 0x0F0F0F0Fu)};
        const v4i_t raw = {(int)r.x, (int)r.y, (int)r.z, (int)r.w};
        acc[2 * c] = __builtin_amdgcn_mfma_i32_16x16x64_i8(lo, B, acc[2 * c], 0, 0, 0);
        acc[2 * c + 1] = __builtin_amdgcn_mfma_i32_16x16x64_i8(raw, B, acc[2 * c + 1], 0, 0, 0);
    }
}
__device__ __forceinline__ void peer_v_tokens(const Params& P, LAS unsigned char* lds, const size_t t0) {
    const int tid = tid_opaque(), lane = tid & 63, wid = tid >> 6, g = lane >> 4, li = lane & 15;
    const unsigned char* Vb = P.ws + OFF_V8; const unsigned lo16 = (unsigned)li * 16u; const float* VSC = (const float*)(P.ws + OFF_VSC);
    const u32x4* EG4 = (const u32x4*)(P.ws + OFF_EG); const f32x2* W2 = (const f32x2*)(P.ws + OFF_W);
    LAS u32x2* lists = (LAS u32x2*)(lds + wid * 8192);
    LAS f32x2* tokp = (LAS f32x2*)(lds + 65536 + wid * 64);
    {
        u32x4 egv[8]; f32x2 wwv[8];
#pragma unroll
        for (int i = 0; i < 8; ++i) { egv[i] = EG4[(t0 + i) * 64 + lane]; wwv[i] = W2[(t0 + i) * 64 + lane]; }
        float w0v[8], w1v[8];
#pragma unroll
        for (int i = 0; i < 8; ++i) { w0v[i] = wwv[i].x * VSC[egv[i].x]; w1v[i] = wwv[i].y * VSC[egv[i].z]; }
#pragma unroll
        for (int i = 0; i < 8; ++i) {
            const float mx = wave_max_fast(fmaxf(fabsf(w0v[i]), fabsf(w1v[i])));
            const float sw = fmaxf(mx * (1.0f / 127.0f), 1e-30f), inv = 1.0f / sw;
            const int q0 = (int)rintf(w0v[i] * inv), q1 = (int)rintf(w1v[i] * inv);
            *(LAS u32x4*)(lists + i * 128 + 2 * lane) = (u32x4){egv[i].x, ((unsigned)q0 & 255u) * 0x01010101u, egv[i].z, ((unsigned)q1 & 255u) * 0x01010101u};
            const int qs = wave_sum_int_fast(q0 + q1);
            if (lane == 0) tokp[i] = (f32x2){sw, 7.5f * sw * (float)qs}; }
    }
    const unsigned bsel = 0xFFu << (8u * (unsigned)(li & 3));
    const u32x4 bm = {(li >> 2) == 0 ? bsel : 0u, (li >> 2) == 1 ? bsel : 0u, (li >> 2) == 2 ? bsel : 0u, (li >> 2) == 3 ? bsel : 0u};
    const int dbase = 128 * g + 8 * (li >> 2) + (li & 3);
    float gt2v[16], lgv[16], lbv[16];
    { const float* gt2 = (const float*)(P.ws + OFF_ADA) + (t0 >> 11) * 6144 + 5120;
#pragma unroll
      for (int c = 0; c < 2; ++c)
#pragma unroll
          for (int hf = 0; hf < 2; ++hf)
#pragma unroll
              for (int r = 0; r < 4; ++r) { const int d = dbase + 512 * c + 32 * r + 4 * hf, e = 8 * c + 4 * hf + r; gt2v[e] = gt2[d]; lgv[e] = P.ln2_g[d]; lbv[e] = P.ln2_b[d]; } }
    VQuad q0, q1, q2, q3, q4, q5, q6, q7;
    q0.nxt = lists[g]; q1.nxt = lists[4 + g]; q2.nxt = lists[8 + g]; q3.nxt = lists[12 + g]; q4.nxt = lists[16 + g]; q5.nxt = lists[20 + g]; q6.nxt = lists[24 + g]; q7.nxt = lists[28 + g];
    vq_issue(q0, lists, 8, g, Vb, lo16); vq_issue(q1, lists, 9, g, Vb, lo16); vq_issue(q2, lists, 10, g, Vb, lo16); vq_issue(q3, lists, 11, g, Vb, lo16);
    vq_issue(q4, lists, 12, g, Vb, lo16); vq_issue(q5, lists, 13, g, Vb, lo16); vq_issue(q6, lists, 14, g, Vb, lo16); vq_issue(q7, lists, 15, g, Vb, lo16);
    VQ_PIN(q0);
#pragma unroll 1
    for (int i = 0; i < 8; ++i) {
        const size_t t = t0 + i;
        v4i_t acc[4];
#pragma unroll
        for (int j = 0; j < 4; ++j) acc[j] = (v4i_t){0, 0, 0, 0};
        float* xr = P.out + t * 1024;
        float xv[16];
#pragma unroll
        for (int c = 0; c < 2; ++c)
#pragma unroll
            for (int hf = 0; hf < 2; ++hf)
#pragma unroll
                for (int r = 0; r < 4; ++r) xv[8 * c + 4 * hf + r] = __uint_as_float((unsigned)((const bf16_t*)xr)[dbase + 512 * c + 32 * r + 4 * hf] << 16);
#pragma unroll 1
        for (int J = 32 * i; J < 32 * i + 32; J += 8) {
            vq_mma(q0, acc, bm); vq_issue(q0, lists, J + 16, g, Vb, lo16); VQ_PIN(q1);
            vq_mma(q1, acc, bm); vq_issue(q1, lists, J + 17, g, Vb, lo16); VQ_PIN(q2);
            vq_mma(q2, acc, bm); vq_issue(q2, lists, J + 18, g, Vb, lo16); VQ_PIN(q3);
            vq_mma(q3, acc, bm); vq_issue(q3, lists, J + 19, g, Vb, lo16); VQ_PIN(q4);
            vq_mma(q4, acc, bm); vq_issue(q4, lists, J + 20, g, Vb, lo16); VQ_PIN(q5);
            vq_mma(q5, acc, bm); vq_issue(q5, lists, J + 21, g, Vb, lo16); VQ_PIN(q6);
            vq_mma(q6, acc, bm); vq_issue(q6, lists, J + 22, g, Vb, lo16); VQ_PIN(q7);
            vq_mma(q7, acc, bm); vq_issue(q7, lists, J + 23, g, Vb, lo16); VQ_PIN(q0);
        }
        const f32x2 tp = tokp[i]; const float sw = tp.x, yoff = tp.y;
        float pre[16]; float s = 0.f;
#pragma unroll
        for (int c = 0; c < 2; ++c)
#pragma unroll
            for (int hf = 0; hf < 2; ++hf)
#pragma unroll
                for (int r = 0; r < 4; ++r) { const int e = 8 * c + 4 * hf + r;
                    const float yv = hf == 0 ? sw * (float)acc[2 * c][r] - yoff : (sw * 0.0625f) * (float)(acc[2 * c + 1][r] - acc[2 * c][r]) + yoff * (1.0f / 15.0f);
                    const float pv = ALPHA * xv[e] + gt2v[e] * yv; pre[e] = pv; s += pv; }
        const float mean = wave_sum_fast(s) * (1.0f / 1024.0f); float s2 = 0.f;
#pragma unroll
        for (int e = 0; e < 16; ++e) { pre[e] -= mean; s2 += pre[e] * pre[e]; }
        const float rstd = rsqrtf(wave_sum_fast(s2) * (1.0f / 1024.0f) + LN_EPS);
#pragma unroll
        for (int c = 0; c < 2; ++c)
#pragma unroll
            for (int hf = 0; hf < 2; ++hf)
#pragma unroll
                for (int r = 0; r < 4; ++r) { const int e = 8 * c + 4 * hf + r;
                    xr[dbase + 512 * c + 32 * r + 4 * hf] = pre[e] * rstd * lgv[e] + lbv[e]; }
    }
}

#define XB_TMO      128
#define XB_XCNT(j)  (256  + 64 * (j))
#define XB_XSUB(j)  (1280 + 64 * (j))
#define XB_XGEN(j)  (2304 + 64 * (j))
#define XB_TOP      3328
#define XB_TOPGEN   3392
#define XCD_BAR_WORDS 3456
#define XB_SPIN_CAP (1u << 22)
__device__ __forceinline__ unsigned xb_ld(unsigned* p)              { return __hip_atomic_load(p, __ATOMIC_RELAXED, __HIP_MEMORY_SCOPE_AGENT); }
__device__ __forceinline__ unsigned xb_add(unsigned* p, unsigned v) { return __hip_atomic_fetch_add(p, v, __ATOMIC_RELAXED, __HIP_MEMORY_SCOPE_AGENT); }
#define XB_SPIN(cond, bar) do { unsigned _sp = 0; while (cond) { __builtin_amdgcn_s_sleep(1); \
    if ((++_sp & 255u) == 0u) { if (xb_ld(&(bar)[XB_TMO])) break; if (_sp > XB_SPIN_CAP) { atomicAdd(&(bar)[XB_TMO], 1u); break; } } } } while (0)
struct XcdBarrier { unsigned* bar; unsigned x; volatile LAS unsigned* st; };
__device__ __forceinline__ XcdBarrier xcd_barrier_post(unsigned* bar, volatile LAS unsigned* st) {
    XcdBarrier b; b.bar = bar; b.x = xcc_id(); b.st = st;
    if (threadIdx.x == 0) (void)xb_add(&bar[XB_XCNT(b.x)], 1u);
    return b;
}
__device__ __forceinline__ void xcd_barrier_complete(unsigned* bar, unsigned x, unsigned& nloc, unsigned& nx) {
    const unsigned G = gridDim.x * gridDim.y * gridDim.z;
    unsigned sum, cnt, mine, sp = 0u;
    for (;;) {
        sum = 0u; cnt = 0u; mine = 0u;
#pragma unroll
        for (unsigned j = 0; j < 16; ++j) { const unsigned c = xb_ld(&bar[XB_XCNT(j)]); sum += c; cnt += (c > 0u) ? 1u : 0u; mine = (j == x) ? c : mine; }
        if (sum == G) break;
        __builtin_amdgcn_s_sleep(1);
        if ((++sp & 255u) == 0u) { if (xb_ld(&bar[XB_TMO])) break; if (sp > XB_SPIN_CAP) { atomicAdd(&bar[XB_TMO], 1u); break; } }
    }
    nloc = mine > 0u ? mine : 1u; nx = cnt > 0u ? cnt : 1u;
}
__device__ __forceinline__ void xcd_barrier(const XcdBarrier& b) {
    asm volatile("s_waitcnt vmcnt(0)" ::: "memory");
    __syncthreads();
    if (threadIdx.x == 0) {
        unsigned* bar = b.bar;
        __builtin_amdgcn_s_waitcnt(0);
        unsigned nloc = b.st[0], nx = b.st[1];
        if (nloc == 0u) { xcd_barrier_complete(bar, b.x, nloc, nx); b.st[0] = nloc; b.st[1] = nx; }
        const unsigned old = xb_add(&bar[XB_XSUB(b.x)], 1u);
        const unsigned gen = old / nloc;
        if (old + 1u == (gen + 1u) * nloc) {
            __builtin_amdgcn_fence(__ATOMIC_RELEASE, "agent");
            asm volatile("s_waitcnt vmcnt(0)" ::: "memory");
            const unsigned og = xb_add(&bar[XB_TOP], 1u);
            const unsigned tg = og / nx;
            if (og + 1u == (tg + 1u) * nx) xb_add(&bar[XB_TOPGEN], 1u);
            else XB_SPIN(xb_ld(&bar[XB_TOPGEN]) == tg, bar);
            __builtin_amdgcn_fence(__ATOMIC_ACQUIRE, "agent");
            xb_add(&bar[XB_XGEN(b.x)], 1u);
            asm volatile("s_waitcnt vmcnt(0)" ::: "memory");
        } else {
            XB_SPIN(xb_ld(&bar[XB_XGEN(b.x)]) == gen, bar);
            __builtin_amdgcn_fence(__ATOMIC_ACQUIRE, "agent");
            asm volatile("s_waitcnt vmcnt(0)" ::: "memory");
        }
    }
    __syncthreads();
}

__global__ void __launch_bounds__(NTHR, 2) fwd_megakernel(Params P) {
    extern __shared__ __attribute__((aligned(16))) unsigned char shm[];
    LAS unsigned char* lds = (LAS unsigned char*)shm;
    cg::grid_group grid = cg::this_grid();
    const int G = gridDim.x, bid = blockIdx.x;
    volatile LAS unsigned* xst = (volatile LAS unsigned*)(lds + LDS_BYTES - 128);
    if (threadIdx.x == 0) { xst[0] = 0u; xst[1] = 0u; }
    __syncthreads();
    const XcdBarrier xb = xcd_barrier_post((unsigned*)(P.ws + OFF_BAR), xst);

#ifndef P3
#define P3 0xff
#endif
#ifndef PH
#define PH 0xff
#endif
    if (PH & 1) phase0a(P, lds);
    grid.sync();
    if (PH & 2) phase0b(P);
    xcd_barrier(xb);
    if (PH & 4) {
        pg8::Gemm g; g.A = (const bf16_t*)(P.ws + OFF_H); g.Bt = (const bf16_t*)(P.ws + OFF_WIN); g.M = NTOK; g.N = INCOLS; { int k_ = 512; asm volatile("" : "+s"(k_)); g.K = k_; g.lda = k_; }
        pg8::StaticOrder S; S.init(NTOK, INCOLS, G, bid);
        EpiProj E; E.ws = P.ws; E.lb = (const float*)(P.ws + OFF_LB); E.ng = P.hgrn_ng; E.kmean = (float*)(P.ws + OFF_KMEAN);
        pg8::gemm_phase<EpiProj, pg8::StaticOrder, true>(lds, g, S, E);
    }
    xcd_barrier(xb);
    if (PH & 8) for (int it = bid; it < 256; it += G) hgrn_item(P, it, lds);
    if (PH & 16) for (int u = bid; u < 2048; u += G) { const int bh = u & 255, jj = u >> 8; moba_unit(P, bh >> 3, bh & 7, (jj + bh) & 7, lds); }
    xcd_barrier(xb);
    if ((PH & 32) && bid < NTOK / 256) { const int pm = bid;
        if (P3 & 1) yb_norm_panel(P, pm);
        __syncthreads();
        if (P3 & 2) { pg8::Gemm g; g.A = (const bf16_t*)(P.ws + OFF_EG); g.Bt = (const bf16_t*)(P.ws + OFF_WBA); g.M = NTOK; g.N = 1024; { int k_ = 256; asm volatile("" : "+s"(k_)); g.K = k_; } g.lda = 512;
          pg8::PanelOrder S; S.pm = pm; S.npn = 4; EpiMixA E; E.GA = (bf16_t*)(P.ws + OFF_GA);
          pg8::gemm_phase<EpiMixA, pg8::PanelOrder, true>(lds, g, S, E); }
        __syncthreads();
        if (P3 & 4) { pg8::Gemm g; g.A = (const bf16_t*)(P.ws + OFF_EG + 512); g.Bt = (const bf16_t*)(P.ws + OFF_WBB); g.M = NTOK; g.N = 1024; { int k_ = 256; asm volatile("" : "+s"(k_)); g.K = k_; } g.lda = 512;
          pg8::PanelOrder S; S.pm = pm; S.npn = 4; EpiMixB E; E.GA = (const bf16_t*)(P.ws + OFF_GA); E.GB = (const bf16_t*)(P.ws + OFF_GB); E.M8 = P.ws + OFF_QA;
          pg8::gemm_phase<EpiMixB, pg8::PanelOrder, true>(lds, g, S, E); }
        __syncthreads();
        if (P3 & 8) { pg8::Gemm g; g.A = (const bf16_t*)(P.ws + OFF_QA); g.Bt = (const bf16_t*)(P.ws + OFF_WOUT); g.M = NTOK; g.N = 1024; { int k_ = 512; asm volatile("" : "+s"(k_)); g.K = k_; g.lda = k_; }
          pg8::PanelOrder S; S.pm = pm; S.npn = 4; EpiOut E; E.ada = (const float*)(P.ws + OFF_ADA); E.D = (bf16_t*)(P.ws + OFF_GB);
          pg8::gemm_phase<EpiOut, pg8::PanelOrder, true>(lds, g, S, E); }
        __syncthreads();
        if (P3 & 16) ln1_panel(P, pm);
        __syncthreads();
        if (P3 & 32) { pg8::Gemm g; g.A = (const bf16_t*)(P.ws + OFF_H); g.Bt = (const bf16_t*)(P.ws + OFF_WQ); g.M = NTOK; g.N = 1024; g.K = 1024; g.lda = 1024;
          pg8::PanelOrder S; S.pm = pm; S.npn = 4; EpiBf16 E; E.O = (bf16_t*)(P.ws + OFF_GB);
          pg8::gemm_phase<EpiBf16, pg8::PanelOrder>(lds, g, S, E); }
        __syncthreads();
        { const size_t tok0 = (size_t)pm * 256 + (tid_opaque() >> 6) * 32;
          peer_select_wave(P, tok0);
          __syncthreads();
#pragma unroll 1
          for (int sb = 0; sb < 4; ++sb) {
              peer_u_tokens(P, lds, tok0 + 8 * sb);
              __syncthreads();
              peer_v_tokens(P, lds, tok0 + 8 * sb);
              __syncthreads();
          } }
    }
}

extern "C" void kernel_launch(void* const* d_in, const int* in_sizes, int n_in, void* d_out, int out_size, void* d_ws, size_t ws_size, hipStream_t stream) {
    static int grid_blocks = 0;
    if (grid_blocks == 0) {
        if (n_in != 18 || out_size != NTOK * DM || ws_size < WS_END) { fprintf(stderr, "kernel_launch: unexpected shapes (n_in %d, out %d, ws %zu, need %zu)\n", n_in, out_size, ws_size, (size_t)WS_END); grid_blocks = -1; return; }
        int dev = 0, cus = 0, per_cu = 0;
        hipGetDevice(&dev);
        hipDeviceGetAttribute(&cus, hipDeviceAttributeMultiprocessorCount, dev);
        if (hipFuncSetAttribute((const void*)fwd_megakernel, hipFuncAttributeMaxDynamicSharedMemorySize, LDS_BYTES) != hipSuccess) fprintf(stderr, "kernel_launch: hipFuncSetAttribute failed\n");
        hipOccupancyMaxActiveBlocksPerMultiprocessor(&per_cu, (const void*)fwd_megakernel, NTHR, LDS_BYTES);
        if (per_cu < 1) { fprintf(stderr, "kernel_launch: occupancy query says %d blocks per CU\n", per_cu); per_cu = 1; }
        if (per_cu > 1) per_cu = 1;
        grid_blocks = cus * per_cu;
        if (grid_blocks != NTOK / 256) { fprintf(stderr, "kernel_launch: built for a %d-CU device (one 256-token panel per workgroup), found %d\n", NTOK / 256, grid_blocks); grid_blocks = -1; return; }
        (void)hipGetLastError();
    }
    if (grid_blocks < 0) return;
    Params p{};
    p.x = (const float*)d_in[0]; p.c = (const float*)d_in[1]; p.w_ada = (const float*)d_in[2]; p.b_ada = (const float*)d_in[3]; p.w_in = (const float*)d_in[4];
    p.w_ba = (const float*)d_in[5]; p.w_bb = (const float*)d_in[6]; p.w_out = (const float*)d_in[7]; p.hgrn_lb = (const float*)d_in[8]; p.hgrn_ng = (const float*)d_in[9];
    p.ln1_g = (const float*)d_in[10]; p.ln1_b = (const float*)d_in[11]; p.peer_wq = (const float*)d_in[12]; p.peer_sk = (const float*)d_in[13]; p.peer_u = (const float*)d_in[14];
    p.peer_v = (const float*)d_in[15]; p.ln2_g = (const float*)d_in[16]; p.ln2_b = (const float*)d_in[17];
    p.out = (float*)d_out; p.ws = (unsigned char*)d_ws;
    if (hipMemsetAsync((char*)d_ws + OFF_BAR, 0, XCD_BAR_WORDS * 4, stream) != hipSuccess) fprintf(stderr, "kernel_launch: memset of the barrier words failed\n");
    void* args[] = {&p};
    hipError_t e = hipLaunchCooperativeKernel((const void*)fwd_megakernel, dim3(grid_blocks), dim3(NTHR), args, LDS_BYTES, stream);
    if (e != hipSuccess) fprintf(stderr, "cooperative launch failed: %s (grid %d)\n", hipGetErrorString(e), grid_blocks);
}
```

```cpp
#include <hip/hip_runtime.h>
#include <hip/hip_cooperative_groups.h>
#include <cstdio>
#include <cstdint>
#include <type_traits>
namespace cg = cooperative_groups;

#define LAS __attribute__((address_space(3)))
typedef unsigned short bf16_t;
typedef short bf16x8 __attribute__((ext_vector_type(8)));
typedef short s16x4 __attribute__((ext_vector_type(4)));
typedef float f32x2 __attribute__((ext_vector_type(2)));
typedef float f32x4 __attribute__((ext_vector_type(4)));
typedef float f32x16 __attribute__((ext_vector_type(16)));
typedef unsigned u32x2 __attribute__((ext_vector_type(2)));
typedef unsigned u32x4 __attribute__((ext_vector_type(4)));

constexpr int NB = 32, SEQ = 2048, DM = 1024, NTOK = NB * SEQ;
constexpr int INCOLS = 5632;
constexpr int NTHR = 512;
constexpr int LDS_BYTES = 147456;
constexpr float ALPHA = 1.189207115002721f;
constexpr float LN_EPS = 1e-5f, RMS_EPS = 1e-6f;
constexpr float LOG2E = 1.4426950408889634f;

constexpr size_t SZ_T512 = (size_t)NTOK * 512 * 2, SZ_T1024 = (size_t)NTOK * 1024 * 2;
constexpr size_t OFF_ADA = 0;
constexpr size_t OFF_LB = OFF_ADA + 786432;
constexpr size_t OFF_KMEAN = OFF_LB + 4096;
constexpr size_t OFF_WIN = OFF_KMEAN + 524288;
constexpr size_t OFF_WBA = OFF_WIN + (size_t)5632 * 1024 * 2;
constexpr size_t OFF_WBB = OFF_WBA + 1048576;
constexpr size_t OFF_WOUT = OFF_WBB + 1048576;
constexpr size_t OFF_WQ = OFF_WOUT + 2097152;
constexpr size_t OFF_SK = OFF_WQ + 2097152;
constexpr size_t OFF_U8 = OFF_SK + 262144;
constexpr size_t OFF_USC = OFF_U8 + 8388608;
constexpr size_t OFF_V8 = OFF_U8 + 16777216;
constexpr size_t OFF_VSC = OFF_V8 + 8388608;
constexpr size_t OFF_CTR = OFF_V8 + 16777216;
constexpr size_t OFF_BAR = OFF_CTR + 4096;
constexpr size_t OFF_EG = OFF_BAR + 16384;
constexpr size_t OFF_H = OFF_EG + (size_t)NTOK * 128 * 8;
constexpr size_t OFF_QA = OFF_H + SZ_T1024;
constexpr size_t OFF_KA = OFF_QA + SZ_T512;
constexpr size_t OFF_VA = OFF_KA + SZ_T512;
constexpr size_t OFF_HQ = OFF_VA + SZ_T512;
constexpr size_t OFF_HK = OFF_HQ + SZ_T512;
constexpr size_t OFF_HI = OFF_HK + SZ_T512;
constexpr size_t OFF_HG = OFF_HI + SZ_T512;
constexpr size_t OFF_GA = OFF_HG + SZ_T512;
constexpr size_t OFF_GB = OFF_GA + SZ_T1024;
constexpr size_t WS_END = OFF_GB + SZ_T1024;
constexpr size_t OFF_H8 = OFF_VA;
constexpr size_t OFF_HS = OFF_HQ;
constexpr size_t OFF_W = OFF_KA;
constexpr size_t OFF_Y = OFF_KA;

struct Params {
    const float *x, *c, *w_ada, *b_ada, *w_in, *w_ba, *w_bb, *w_out, *hgrn_lb, *hgrn_ng, *ln1_g, *ln1_b, *peer_wq, *peer_sk, *peer_u, *peer_v, *ln2_g, *ln2_b;
    float* out;
    unsigned char* ws;
};

typedef __bf16 bf16v2 __attribute__((ext_vector_type(2)));
__device__ __forceinline__ unsigned cvt_pk_bf16(float lo, float hi) { return __builtin_bit_cast(unsigned, __builtin_convertvector((f32x2){lo, hi}, bf16v2)); }
__device__ __forceinline__ float bf_lo(unsigned w) { return __uint_as_float(w << 16); }
__device__ __forceinline__ float bf_hi(unsigned w) { return __uint_as_float(w & 0xffff0000u); }
__device__ __forceinline__ float sigmoidf_(float x) { return __builtin_amdgcn_rcpf(1.0f + __builtin_amdgcn_exp2f(-LOG2E * x)); }
__device__ __forceinline__ float wave_sum(float v) {
#pragma unroll
    for (int o = 1; o < 64; o <<= 1) v += __shfl_xor(v, o);
    return v;
}
__device__ __forceinline__ int tid_opaque() { int t = threadIdx.x; asm volatile("" : "+v"(t)); return t; }
__device__ __forceinline__ int crow(int r, int hi) { return (r & 3) + 8 * (r >> 2) + 4 * hi; }
#define MFMA32(a, b, c) __builtin_amdgcn_mfma_f32_32x32x16_bf16(a, b, c, 0, 0, 0)

namespace pg8 {
constexpr int BM = 256, BK = 64, HALF = 128, HTB = HALF * BK * 2, STAGE_BYTES = 8 * HTB, NXCD = 8, WGM = 8;
__host__ __device__ __forceinline__ int lds_byte(int r, int c) { const int st = (r >> 4) * 2 + (c >> 5), rr = r & 15, cc = c & 31, ob = rr * 64 + cc * 2; return st * 1024 + (ob ^ (((ob >> 9) & 1) << 5)); }
__host__ __device__ __forceinline__ void stage_rc(int b, int& R, int& C) { const int st = b / 1024, sb = b % 1024, swz = sb ^ (((sb >> 9) & 1) << 5); R = (st >> 1) * 16 + swz / 64; C = (st & 1) * 32 + (swz % 64) / 2; }
__host__ __device__ __forceinline__ int perm32(int rho) { const int n = rho >> 4, i = rho & 15; return 8 * (i >> 2) + 4 * n + (i & 3); }

struct Unit { int pm, pn; };
struct Gemm { const bf16_t* A; const bf16_t* Bt; int M, N, K, lda; };

struct StaticOrder {
    int nM, nN, nwg, G, c;
    __device__ void init(int M, int N, int G_, int c_) { nM = M / BM; nN = N / BM; nwg = nM * nN; G = G_; c = c_; }
    __device__ bool next(int i, Unit& u) const {
        const long L = (long)i * G + c; if (L >= nwg) return false;
        int wgid = (int)L; { const int q = nwg / NXCD, r = nwg % NXCD, xcd = wgid % NXCD, off = wgid / NXCD; wgid = (xcd < r ? xcd * (q + 1) : r * (q + 1) + (xcd - r) * q) + off; }
        const int nig = WGM * nN, gid = wgid / nig, fm = gid * WGM, gsz = (nM - fm) < WGM ? (nM - fm) : WGM;
        u.pm = fm + ((wgid % nig) % gsz); u.pn = (wgid % nig) / gsz; return true;
    }
};
struct PanelOrder {
    int pm, npn;
    __device__ bool next(int i, Unit& u) const { if (i >= npn) return false; u.pm = pm; u.pn = i; return true; }
};

template <class Epi, class Sched, bool MX = false>
__device__ __forceinline__ void gemm_phase(LAS unsigned char* lds, const Gemm g, const Sched& S, const Epi& E) {
    const int tid = tid_opaque(), wid = __builtin_amdgcn_readfirstlane(tid >> 6), lane = tid & 63, wr = wid >> 2, wc = wid & 3, fr = lane & 15, fq = lane >> 4;
    const int K = g.K, nt = K / BK;
    unsigned voffA, voffB;
    { int R, C; stage_rc(tid * 16, R, C); const int Rb = Epi::PERM ? ((R & ~31) + perm32(R & 31)) : R;
      voffA = (unsigned)(R * g.lda + C) * 2u; voffB = (unsigned)(Rb * K + C) * 2u; }
    const size_t rvoffA = (size_t)128 * g.lda, rvoffB = (size_t)128 * K;
    const size_t kstep = (size_t)(BK * 2);
    const size_t hstep = (size_t)HALF * K * 2;
    const size_t tstep = 2 * hstep;
    const size_t hstepA = (size_t)HALF * g.lda * 2, tstepA = 2 * hstepA;
    const unsigned ldsw = (unsigned)wid * 1024u;
    const int aoff = lds_byte(wr * 64 + fr, fq * 8), boff = lds_byte(wc * 32 + fr, fq * 8);
#define PG8_SA(b, h) (((b) * 2 + (h)) * HTB)
#define PG8_SB(b, h) ((4 + (b) * 2 + (h)) * HTB)
#define PG8_STAGE(bufoff, gbase, voff) do { unsigned vo_ = (voff); asm volatile("" : "+v"(vo_));     \
        _Pragma("unroll") for (int _i = 0; _i < 2; ++_i) \
        __builtin_amdgcn_global_load_lds((const unsigned*)((const char*)(gbase) + _i * r##voff + vo_), (LAS unsigned*)(lds + (bufoff) + ldsw + _i * 8192), 16, 0, 0); } while (0)
#define PG8_LDX(dst, off) do { const v4i_ lo_ = *(const LAS v4i_*)(lds + (off)), hi_ = *(const LAS v4i_*)(lds + (off) + 1024); dst = __builtin_shufflevector(lo_, hi_, 0, 1, 2, 3, 4, 5, 6, 7); } while (0)
#define PG8_LDA(dst, b, h) do { if constexpr (MX) { _Pragma("unroll") for (int m = 0; m < 4; ++m) PG8_LDX(dst##X[m], PG8_SA(b, h) + aoff + m * 2048); } \
        else { _Pragma("unroll") for (int m = 0; m < 4; ++m) _Pragma("unroll") for (int k = 0; k < 2; ++k) dst[m][k] = *(const LAS bf16x8*)(lds + PG8_SA(b, h) + aoff + m * 2048 + k * 1024); } } while (0)
#define PG8_LDB(dst, b, h) do { if constexpr (MX) { _Pragma("unroll") for (int n = 0; n < 2; ++n) PG8_LDX(dst##X[n], PG8_SB(b, h) + boff + n * 2048); } \
        else { _Pragma("unroll") for (int n = 0; n < 2; ++n) _Pragma("unroll") for (int k = 0; k < 2; ++k) dst[n][k] = *(const LAS bf16x8*)(lds + PG8_SB(b, h) + boff + n * 2048 + k * 1024); } } while (0)
#define PG8_MMA(ai, bj, At, Bt) do { __builtin_amdgcn_s_setprio(1); \
        if constexpr (MX) { _Pragma("unroll") for (int m = 0; m < 4; ++m) _Pragma("unroll") for (int n = 0; n < 2; ++n) \
            asm volatile("v_mfma_scale_f32_16x16x128_f8f6f4 %0, %1, %2, %0, %3, %4 op_sel_hi:[0,0,0]" : "+v"(acc[ai][bj][m][n]) : "v"(Bt##X[n]), "v"(At##X[m]), "v"(mxscale), "v"(mxscale5)); } \
        else { _Pragma("unroll") for (int m = 0; m < 4; ++m) _Pragma("unroll") for (int n = 0; n < 2; ++n) _Pragma("unroll") for (int k = 0; k < 2; ++k) \
            acc[ai][bj][m][n] = __builtin_amdgcn_mfma_f32_16x16x32_bf16(Bt[n][k], At[m][k], acc[ai][bj][m][n], 0, 0, 0); } \
        __builtin_amdgcn_s_setprio(0); } while (0)
#define PG8_WAIT_V(n) asm volatile("s_waitcnt vmcnt(" #n ")" ::: "memory")
#define PG8_WAIT_L(n) asm volatile("s_waitcnt lgkmcnt(" #n ")" ::: "memory")
#define PG8_BAR __builtin_amdgcn_s_barrier()
#define PG8_SCHED __builtin_amdgcn_sched_barrier(0)
    Unit cur, nxt; int ui = 0;
    if (!S.next(0, cur)) return;
    f32x4 acc[2][2][4][2];
#pragma unroll
    for (int a = 0; a < 2; ++a)
#pragma unroll
        for (int b = 0; b < 2; ++b)
#pragma unroll
            for (int m = 0; m < 4; ++m)
#pragma unroll
                for (int n = 0; n < 2; ++n) acc[a][b][m][n] = (f32x4){0.f, 0.f, 0.f, 0.f};
    typedef int v4i_ __attribute__((ext_vector_type(4))); typedef int v8i_ __attribute__((ext_vector_type(8)));
    bf16x8 At[4][2], B0[2][2], B1[2][2];
    v8i_ AtX[4], B0X[2], B1X[2];
    const int mxscale = 0x7f7f7f7f, mxscale5 = 0x7a7a7a7a;
    const char* cA = (const char*)g.A + (size_t)cur.pm * tstepA; const char* cB = (const char*)g.Bt + (size_t)cur.pn * tstep;
    PG8_STAGE(PG8_SB(0, 0), cB, voffB); PG8_STAGE(PG8_SA(0, 0), cA, voffA); PG8_STAGE(PG8_SB(0, 1), cB + hstep, voffB); PG8_STAGE(PG8_SA(0, 1), cA + hstepA, voffA);
    if (wr == 1) PG8_BAR;
    PG8_WAIT_V(4); PG8_BAR;
    PG8_STAGE(PG8_SB(1, 0), cB + kstep, voffB); PG8_STAGE(PG8_SA(1, 0), cA + kstep, voffA); PG8_STAGE(PG8_SB(1, 1), cB + hstep + kstep, voffB);
    PG8_WAIT_V(6); PG8_BAR;
    for (;;) {
        const bool has_next = S.next(ui + 1, nxt);
        const char* nA = has_next ? (const char*)g.A + (size_t)nxt.pm * tstepA : cA; const char* nB = has_next ? (const char*)g.Bt + (size_t)nxt.pn * tstep : cB;
        for (int t = 0; t < nt; t += 2) {
            const bool last = (t == nt - 2);
            const char* a1 = cA + (size_t)(t + 1) * kstep;
            const char* a2 = last ? nA : cA + (size_t)(t + 2) * kstep; const char* b2 = last ? nB : cB + (size_t)(t + 2) * kstep;
            const char* a3 = a2 + kstep; const char* b3 = b2 + kstep;
            PG8_LDB(B0, 0, 0); PG8_SCHED; PG8_LDA(At, 0, 0); PG8_STAGE(PG8_SA(1, 1), a1 + hstepA, voffA);
            PG8_WAIT_L(8); PG8_BAR; PG8_WAIT_L(0); PG8_MMA(0, 0, At, B0); PG8_BAR; PG8_SCHED;
            PG8_LDB(B1, 0, 1); PG8_STAGE(PG8_SB(0, 0), b2, voffB);
            PG8_BAR; PG8_WAIT_L(0); PG8_MMA(0, 1, At, B1); PG8_BAR;
            PG8_LDA(At, 0, 1); PG8_STAGE(PG8_SA(0, 0), a2, voffA);
            PG8_BAR; PG8_WAIT_L(0); PG8_MMA(1, 0, At, B0); PG8_BAR; PG8_SCHED;
            PG8_STAGE(PG8_SB(0, 1), b2 + hstep, voffB);
            PG8_WAIT_V(6); PG8_BAR; PG8_MMA(1, 1, At, B1); PG8_BAR;
            PG8_LDB(B0, 1, 0); PG8_SCHED; PG8_LDA(At, 1, 0); PG8_STAGE(PG8_SA(0, 1), a2 + hstepA, voffA);
            PG8_WAIT_L(8); PG8_BAR; PG8_WAIT_L(0); PG8_MMA(0, 0, At, B0); PG8_BAR; PG8_SCHED;
            PG8_LDB(B1, 1, 1); PG8_STAGE(PG8_SB(1, 0), b3, voffB);
            PG8_BAR; PG8_WAIT_L(0); PG8_MMA(0, 1, At, B1); PG8_BAR;
            PG8_LDA(At, 1, 1); PG8_STAGE(PG8_SA(1, 0), a3, voffA);
            PG8_BAR; PG8_WAIT_L(0); PG8_MMA(1, 0, At, B0); PG8_BAR; PG8_SCHED;
            PG8_STAGE(PG8_SB(1, 1), b3 + hstep, voffB);
            PG8_WAIT_V(6); PG8_BAR; PG8_MMA(1, 1, At, B1); PG8_BAR;
        }
        if constexpr (MX) asm volatile("s_nop 15\n\ts_nop 15" ::: "memory");
        if (wr == 0) PG8_BAR;
        E(acc, cur, wr, wc, fr, fq);
        if (wr == 1) PG8_BAR;
        if (!has_next) break;
#pragma unroll
        for (int a = 0; a < 2; ++a)
#pragma unroll
            for (int b = 0; b < 2; ++b)
#pragma unroll
                for (int m = 0; m < 4; ++m)
#pragma unroll
                    for (int n = 0; n < 2; ++n) acc[a][b][m][n] = (f32x4){0.f, 0.f, 0.f, 0.f};
        cur = nxt; cA = nA; cB = nB; ++ui;
    }
    PG8_WAIT_V(0);
    if (wr == 0) PG8_BAR;
    PG8_BAR;
#undef PG8_SA
#undef PG8_SB
#undef PG8_STAGE
#undef PG8_LDX
#undef PG8_LDA
#undef PG8_LDB
#undef PG8_MMA
#undef PG8_WAIT_V
#undef PG8_WAIT_L
#undef PG8_BAR
#undef PG8_SCHED
}
}
using pg8::Unit;

struct EpiProj {
    static constexpr bool PERM = true;
    unsigned char* ws; const float* lb; const float* ng; float* kmean;
    __device__ __forceinline__ void operator()(const f32x4 (&acc)[2][2][4][2], const Unit& u, int wr, int wc, int fr, int fq) const {
        const int pn = u.pn; int seg, colt, ldc; size_t boff;
        if (pn < 14) { seg = pn >> 1; colt = (pn & 1) * 256; ldc = 512; boff = OFF_QA + (size_t)seg * SZ_T512; }
        else if (pn < 18) { seg = 7; colt = (pn - 14) * 256; ldc = 1024; boff = OFF_GA; }
        else { seg = 8; colt = (pn - 18) * 256; ldc = 1024; boff = OFF_GB; }
        bf16_t* base = (bf16_t*)(ws + boff);
        const int row0 = u.pm * 256 + wr * 64 + fr, col0 = colt + wc * 32 + 8 * fq;
        float pv[2][8];
#pragma unroll
        for (int bj = 0; bj < 2; ++bj)
#pragma unroll
            for (int e = 0; e < 8; ++e) pv[bj][e] = (seg == 4) ? (1.0f - lb[col0 + bj * 128 + e]) : ((seg == 6) ? ng[col0 + bj * 128 + e] : 0.f);
        float cs[2][8];
#pragma unroll
        for (int bj = 0; bj < 2; ++bj)
#pragma unroll
            for (int e = 0; e < 8; ++e) cs[bj][e] = 0.f;
#pragma unroll
        for (int ai = 0; ai < 2; ++ai)
#pragma unroll
            for (int m = 0; m < 4; ++m) {
                bf16_t* rowp = base + (size_t)(row0 + ai * 128 + m * 16) * ldc + col0;
#pragma unroll
                for (int bj = 0; bj < 2; ++bj) {
                    float v[8];
#pragma unroll
                    for (int e = 0; e < 4; ++e) { v[e] = acc[ai][bj][m][0][e]; v[4 + e] = acc[ai][bj][m][1][e]; }
                    if (seg == 0) {
#pragma unroll
                        for (int e = 0; e < 8; ++e) v[e] *= (0.125f * LOG2E);
                    } else if (seg == 1) {
#pragma unroll
                        for (int e = 0; e < 8; ++e) cs[bj][e] += v[e];
                    } else if (seg == 3) {
#pragma unroll
                        for (int e = 0; e < 8; ++e) v[e] = v[e] * sigmoidf_(v[e]);
                    } else if (seg == 4) {
#pragma unroll
                        for (int e = 0; e < 8; ++e) v[e] = pv[bj][e] * sigmoidf_(-v[e]);
                    } else if (seg == 6) {
#pragma unroll
                        for (int e = 0; e < 8; ++e) v[e] = pv[bj][e] * v[e] * sigmoidf_(v[e]);
                    } else if (seg >= 7) {
#pragma unroll
                        for (int e = 0; e < 8; ++e) v[e] = sigmoidf_(v[e]);
                    }
                    u32x4 w; w.x = cvt_pk_bf16(v[0], v[1]); w.y = cvt_pk_bf16(v[2], v[3]); w.z = cvt_pk_bf16(v[4], v[5]); w.w = cvt_pk_bf16(v[6], v[7]);
                    *(u32x4*)(rowp + bj * 128) = w;
                }
            }
        if (seg == 1) {
#pragma unroll
            for (int bj = 0; bj < 2; ++bj)
#pragma unroll
                for (int e = 0; e < 8; ++e) {
                    float s = cs[bj][e];
                    s += __shfl_xor(s, 1); s += __shfl_xor(s, 2); s += __shfl_xor(s, 4); s += __shfl_xor(s, 8);
                    if (fr == 0) atomicAdd(kmean + (size_t)u.pm * 512 + col0 + bj * 128 + e, s);
                }
        }
    }
};
struct EpiMixA {
    static constexpr bool PERM = true;
    bf16_t* GA;
    __device__ __forceinline__ void operator()(const f32x4 (&acc)[2][2][4][2], const Unit& u, int wr, int wc, int fr, int fq) const {
        const int row0 = u.pm * 256 + wr * 64 + fr, col0 = u.pn * 256 + wc * 32 + 8 * fq;
#pragma unroll
        for (int ai = 0; ai < 2; ++ai)
#pragma unroll
            for (int m = 0; m < 4; ++m) {
                bf16_t* rowp = GA + (size_t)(row0 + ai * 128 + m * 16) * 1024 + col0;
#pragma unroll
                for (int bj = 0; bj < 2; ++bj) {
                    const u32x4 g = *(const u32x4*)(rowp + bj * 128);
                    const f32x4 a0 = acc[ai][bj][m][0], a1 = acc[ai][bj][m][1];
                    u32x4 w;
                    constexpr float S = 1.0f;
                    w.x = cvt_pk_bf16(bf_lo(g.x) * a0[0] * S, bf_hi(g.x) * a0[1] * S); w.y = cvt_pk_bf16(bf_lo(g.y) * a0[2] * S, bf_hi(g.y) * a0[3] * S);
                    w.z = cvt_pk_bf16(bf_lo(g.z) * a1[0] * S, bf_hi(g.z) * a1[1] * S); w.w = cvt_pk_bf16(bf_lo(g.w) * a1[2] * S, bf_hi(g.w) * a1[3] * S);
                    *(u32x4*)(rowp + bj * 128) = w;
                }
            }
    }
};
struct EpiMixB {
    static constexpr bool PERM = true;
    const bf16_t* GA; const bf16_t* GB; unsigned char* M8;
    __device__ __forceinline__ void operator()(const f32x4 (&acc)[2][2][4][2], const Unit& u, int wr, int wc, int fr, int fq) const {
        const int row0 = u.pm * 256 + wr * 64 + fr, col0 = u.pn * 256 + wc * 32 + 8 * fq;
#pragma unroll
        for (int ai = 0; ai < 2; ++ai)
#pragma unroll
            for (int m = 0; m < 4; ++m) {
                const size_t off = (size_t)(row0 + ai * 128 + m * 16) * 1024 + col0;
#pragma unroll
                for (int bj = 0; bj < 2; ++bj) {
                    const u32x4 g = *(const u32x4*)(GB + off + bj * 128);
                    const u32x4 mx = *(const u32x4*)(GA + off + bj * 128);
                    const f32x4 a0 = acc[ai][bj][m][0], a1 = acc[ai][bj][m][1];
                    constexpr float S = 1.0f;
                    int w0 = __builtin_amdgcn_cvt_pk_fp8_f32(bf_lo(mx.x) + bf_lo(g.x) * a0[0] * S, bf_hi(mx.x) + bf_hi(g.x) * a0[1] * S, 0, false); w0 = __builtin_amdgcn_cvt_pk_fp8_f32(bf_lo(mx.y) + bf_lo(g.y) * a0[2] * S, bf_hi(mx.y) + bf_hi(g.y) * a0[3] * S, w0, true);
                    int w1 = __builtin_amdgcn_cvt_pk_fp8_f32(bf_lo(mx.z) + bf_lo(g.z) * a1[0] * S, bf_hi(mx.z) + bf_hi(g.z) * a1[1] * S, 0, false); w1 = __builtin_amdgcn_cvt_pk_fp8_f32(bf_lo(mx.w) + bf_lo(g.w) * a1[2] * S, bf_hi(mx.w) + bf_hi(g.w) * a1[3] * S, w1, true);
                    *(u32x2*)(M8 + off + bj * 128) = (u32x2){(unsigned)w0, (unsigned)w1};
                }
            }
    }
};
struct EpiOut {
    static constexpr bool PERM = true;
    const float* ada; bf16_t* D;
    __device__ __forceinline__ void operator()(const f32x4 (&acc)[2][2][4][2], const Unit& u, int wr, int wc, int fr, int fq) const {
        const int row0 = u.pm * 256 + wr * 64 + fr, col0 = u.pn * 256 + wc * 32 + 8 * fq;
        const float* gt1 = ada + (size_t)(u.pm >> 3) * 6144 + 2048 + col0;
        f32x4 g[2][2];
#pragma unroll
        for (int bj = 0; bj < 2; ++bj) { g[bj][0] = *(const f32x4*)(gt1 + bj * 128); g[bj][1] = *(const f32x4*)(gt1 + bj * 128 + 4); }
#pragma unroll
        for (int ai = 0; ai < 2; ++ai)
#pragma unroll
            for (int m = 0; m < 4; ++m) {
                bf16_t* rowp = D + (size_t)(row0 + ai * 128 + m * 16) * 1024 + col0;
#pragma unroll
                for (int bj = 0; bj < 2; ++bj) {
                    const f32x4 a0 = acc[ai][bj][m][0] * g[bj][0], a1 = acc[ai][bj][m][1] * g[bj][1];
                    u32x4 w; w.x = cvt_pk_bf16(a0[0], a0[1]); w.y = cvt_pk_bf16(a0[2], a0[3]); w.z = cvt_pk_bf16(a1[0], a1[1]); w.w = cvt_pk_bf16(a1[2], a1[3]);
                    *(u32x4*)(rowp + bj * 128) = w;
                }
            }
    }
};
struct EpiBf16 {
    static constexpr bool PERM = true;
    bf16_t* O;
    __device__ __forceinline__ void operator()(const f32x4 (&acc)[2][2][4][2], const Unit& u, int wr, int wc, int fr, int fq) const {
        const int row0 = u.pm * 256 + wr * 64 + fr, col0 = u.pn * 256 + wc * 32 + 8 * fq;
#pragma unroll
        for (int ai = 0; ai < 2; ++ai)
#pragma unroll
            for (int m = 0; m < 4; ++m) {
                bf16_t* rowp = O + (size_t)(row0 + ai * 128 + m * 16) * 1024 + col0;
#pragma unroll
                for (int bj = 0; bj < 2; ++bj) {
                    const f32x4 a0 = acc[ai][bj][m][0], a1 = acc[ai][bj][m][1];
                    u32x4 w; w.x = cvt_pk_bf16(a0[0], a0[1]); w.y = cvt_pk_bf16(a0[2], a0[3]); w.z = cvt_pk_bf16(a1[0], a1[1]); w.w = cvt_pk_bf16(a1[2], a1[3]);
                    *(u32x4*)(rowp + bj * 128) = w;
                }
            }
    }
};

__device__ void phase0a(const Params& P, LAS unsigned char* lds) {
    const int tid = tid_opaque(), G = gridDim.x, bid = blockIdx.x;
    for (int it = bid; it < 192; it += G) {
        LAS float* sc = (LAS float*)lds;
        for (int i = tid; i < 32 * 1024; i += NTHR) { const float cv = P.c[i]; sc[i] = cv * sigmoidf_(cv); }
        __syncthreads();
        const int kg = tid >> 5, col = tid & 31;
        float a[32];
#pragma unroll
        for (int b = 0; b < 32; ++b) a[b] = 0.f;
#pragma unroll 1
        for (int k = kg * 64; k < kg * 64 + 64; k += 8) {
            float w[8];
#pragma unroll
            for (int e = 0; e < 8; ++e) w[e] = __builtin_nontemporal_load(P.w_ada + (size_t)(k + e) * 6144 + it * 32 + col);
#pragma unroll
            for (int e4 = 0; e4 < 2; ++e4) {
#pragma unroll
                for (int b = 0; b < 32; ++b) { const f32x4 s = *(const LAS f32x4*)(sc + b * 1024 + k + 4 * e4); a[b] += s[0] * w[4 * e4] + s[1] * w[4 * e4 + 1] + s[2] * w[4 * e4 + 2] + s[3] * w[4 * e4 + 3]; }
                asm volatile("" ::: "memory");
            }
        }
        __syncthreads();
        LAS float* red = (LAS float*)lds;
#pragma unroll
        for (int b = 0; b < 32; ++b) red[(kg * 32 + b) * 32 + col] = a[b];
        __syncthreads();
        for (int o = tid; o < 1024; o += NTHR) { const int b = o >> 5, cc = o & 31; float s = 0.f;
#pragma unroll
            for (int g2 = 0; g2 < 16; ++g2) s += red[(g2 * 32 + b) * 32 + cc];
            ((float*)(P.ws + OFF_ADA))[(size_t)b * 6144 + it * 32 + cc] = s + P.b_ada[it * 32 + cc]; }
        __syncthreads();
    }
    const size_t gsz = (size_t)G * NTHR;
    { const int gt = bid * NTHR + tid, gs = G * NTHR;
      if (gt < 512) ((float*)(P.ws + OFF_LB))[gt] = sigmoidf_(P.hgrn_lb[gt] - P.hgrn_lb[512 + gt]);
      for (int i = gt; i < 32 * 8 * 512; i += gs) ((float*)(P.ws + OFF_KMEAN))[i] = 0.f; }
    {
        LAS float* tile = (LAS float*)lds;
        const int I0 = 16 * 88, I1 = I0 + 8 * 16, I2 = I1 + 8 * 16, I3 = I2 + 16 * 16, I4 = I3 + 16 * 16;
        for (int it = bid; it < I4; it += G) {
            const float* W; bf16_t* WT; int K, N, r;
            if (it < I0) { W = P.w_in; WT = (bf16_t*)(P.ws + OFF_WIN); K = 1024; N = 5632; r = it; }
            else if (it < I1) { W = P.w_ba; WT = (bf16_t*)(P.ws + OFF_WBA); K = 512; N = 1024; r = it - I0; }
            else if (it < I2) { W = P.w_bb; WT = (bf16_t*)(P.ws + OFF_WBB); K = 512; N = 1024; r = it - I1; }
            else if (it < I3) { W = P.w_out; WT = (bf16_t*)(P.ws + OFF_WOUT); K = 1024; N = 1024; r = it - I2; }
            else { W = P.peer_wq; WT = (bf16_t*)(P.ws + OFF_WQ); K = 1024; N = 1024; r = it - I3; }
            const int nb = N / 64, k0 = (r / nb) * 64, n0 = (r % nb) * 64;
#pragma unroll
            for (int ps = 0; ps < 2; ++ps) { const int kk = (tid >> 4) + 32 * ps, n4 = (tid & 15) * 4;
                const f32x4 v = *(const f32x4*)(W + (size_t)(k0 + kk) * N + n0 + n4);
                tile[kk * 65 + n4] = v[0]; tile[kk * 65 + n4 + 1] = v[1]; tile[kk * 65 + n4 + 2] = v[2]; tile[kk * 65 + n4 + 3] = v[3]; }
            __syncthreads();
            { const int n = tid >> 3, kc = (tid & 7) * 8;
              if (it < I3) {
                  int w0 = __builtin_amdgcn_cvt_pk_fp8_f32(32.f * tile[(kc + 0) * 65 + n], 32.f * tile[(kc + 1) * 65 + n], 0, false); w0 = __builtin_amdgcn_cvt_pk_fp8_f32(32.f * tile[(kc + 2) * 65 + n], 32.f * tile[(kc + 3) * 65 + n], w0, true);
                  int w1 = __builtin_amdgcn_cvt_pk_fp8_f32(32.f * tile[(kc + 4) * 65 + n], 32.f * tile[(kc + 5) * 65 + n], 0, false); w1 = __builtin_amdgcn_cvt_pk_fp8_f32(32.f * tile[(kc + 6) * 65 + n], 32.f * tile[(kc + 7) * 65 + n], w1, true);
                  *(u32x2*)((unsigned char*)WT + (size_t)(n0 + n) * K + k0 + kc) = (u32x2){(unsigned)w0, (unsigned)w1};
              } else { u32x4 w;
              w.x = cvt_pk_bf16(tile[(kc + 0) * 65 + n], tile[(kc + 1) * 65 + n]); w.y = cvt_pk_bf16(tile[(kc + 2) * 65 + n], tile[(kc + 3) * 65 + n]);
              w.z = cvt_pk_bf16(tile[(kc + 4) * 65 + n], tile[(kc + 5) * 65 + n]); w.w = cvt_pk_bf16(tile[(kc + 6) * 65 + n], tile[(kc + 7) * 65 + n]);
              *(u32x4*)(WT + (size_t)(n0 + n) * K + k0 + kc) = w; } }
            __syncthreads();
        }
    }
    {
        const size_t gtid = (size_t)bid * NTHR + tid_opaque();
        for (size_t i = gtid; i < 16384; i += gsz) {
            const float* src = P.peer_sk + i * 8; const f32x4 a = *(const f32x4*)src, b = *(const f32x4*)(src + 4);
            u32x4 w; w.x = cvt_pk_bf16(a[0], a[1]); w.y = cvt_pk_bf16(a[2], a[3]); w.z = cvt_pk_bf16(b[0], b[1]); w.w = cvt_pk_bf16(b[2], b[3]);
            *(u32x4*)((bf16_t*)(P.ws + OFF_SK) + i * 8) = w;
        }
        { const int lane = tid & 63, gw = bid * 8 + (tid >> 6), ngw = G * 8;
          for (int r = gw; r < 2 * 16384; r += ngw) {
              const bool isv = r >= 16384; const int e = isv ? r - 16384 : r;
              const float* s = (isv ? P.peer_v : P.peer_u) + (size_t)e * 1024 + lane * 16;
              f32x4 x[4]; float ss = 0.f;
#pragma unroll
              for (int q = 0; q < 4; ++q) { x[q] = __builtin_nontemporal_load((const f32x4*)(s + 4 * q)); ss += (x[q][0] * x[q][0] + x[q][1] * x[q][1]) + (x[q][2] * x[q][2] + x[q][3] * x[q][3]); }
              const float sc = fmaxf(sqrtf(wave_sum(ss) * (1.0f / 1024.0f)) * (2.6f / 7.5f), 1e-30f), inv = 1.0f / sc;
              unsigned nb[16];
#pragma unroll
              for (int q = 0; q < 4; ++q)
#pragma unroll
                  for (int el = 0; el < 4; ++el) nb[4 * q + el] = (unsigned)fminf(fmaxf(floorf(x[q][el] * inv) + 8.0f, 0.0f), 15.0f);
              u32x2 w;
              w.x = (nb[0] | (nb[4] << 4)) | ((nb[1] | (nb[5] << 4)) << 8) | ((nb[2] | (nb[6] << 4)) << 16) | ((nb[3] | (nb[7] << 4)) << 24);
              w.y = (nb[8] | (nb[12] << 4)) | ((nb[9] | (nb[13] << 4)) << 8) | ((nb[10] | (nb[14] << 4)) << 16) | ((nb[11] | (nb[15] << 4)) << 24);
              if (!isv) { w.x ^= 0x88888888u; w.y ^= 0x88888888u; }
              else { w.x ^= 0x80808080u; w.y ^= 0x80808080u; }
              *(u32x2*)(P.ws + (isv ? OFF_V8 : OFF_U8) + (size_t)e * 512 + lane * 8) = w;
              if (lane == 0) ((float*)(P.ws + (isv ? OFF_VSC : OFF_USC)))[e] = sc;
          } }
    }
}
__device__ void phase0b(const Params& P) {
    const size_t gtid = (size_t)blockIdx.x * NTHR + threadIdx.x, gsz = (size_t)gridDim.x * NTHR;
    const float* ada = (const float*)(P.ws + OFF_ADA); bf16_t* H = (bf16_t*)(P.ws + OFF_H);
    for (size_t i = gtid; i < (size_t)NTOK * 128; i += gsz) {
        const size_t row = i >> 7; const int c8 = (int)(i & 127) * 8; const int b = (int)(row >> 11);
        const float* xr = P.x + row * 1024 + c8; const float* sh = ada + (size_t)b * 6144 + c8; const float* sc = sh + 1024;
        const f32x4 x0 = *(const f32x4*)xr, x1 = *(const f32x4*)(xr + 4), s0 = *(const f32x4*)sc, s1 = *(const f32x4*)(sc + 4), h0 = *(const f32x4*)sh, h1 = *(const f32x4*)(sh + 4);
        const f32x4 r0 = x0 * (s0 + 1.0f) + h0, r1 = x1 * (s1 + 1.0f) + h1;
        int w0 = __builtin_amdgcn_cvt_pk_fp8_f32(r0[0], r0[1], 0, false); w0 = __builtin_amdgcn_cvt_pk_fp8_f32(r0[2], r0[3], w0, true);
        int w1 = __builtin_amdgcn_cvt_pk_fp8_f32(r1[0], r1[1], 0, false); w1 = __builtin_amdgcn_cvt_pk_fp8_f32(r1[2], r1[3], w1, true);
        *(u32x2*)((unsigned char*)H + row * 1024 + c8) = (u32x2){(unsigned)w0, (unsigned)w1};
    }
}

__device__ __forceinline__ s16x4 tr4(const LAS unsigned char* p) { return __builtin_bit_cast(s16x4, __builtin_amdgcn_ds_read_tr16_b64_v4i16((LAS s16x4*)p)); }
__device__ void hgrn_item(const Params& P, int item, LAS unsigned char* lds) {
    const int tid = tid_opaque(), lane = tid & 63, wid = __builtin_amdgcn_readfirstlane(tid >> 6), r32 = lane & 31, hi = lane >> 5;
    const int b = item >> 3, h = (item >> 1) & 3, vh = item & 1;
    const bf16_t* HQ = (const bf16_t*)(P.ws + OFF_HQ); const bf16_t* HK = (const bf16_t*)(P.ws + OFF_HK); bf16_t* HI = (bf16_t*)(P.ws + OFF_HI);
    constexpr int SQ = 272, SKD = 320, SV = 192, SS = 192;
    constexpr int LQR = 0, LKR = 17408, LQB = 34816, LKD = 52224, LV = 72704, LS = 84992, LG = 109568, LT = 142336, LCL = 144384;
    LAS float* G = (LAS float*)(lds + LG); LAS float* TOT = (LAS float*)(lds + LT); LAS float* CL = (LAS float*)(lds + LCL);
    const size_t rowb = (size_t)b * SEQ;
    const int row = tid >> 3, seg = tid & 7;
    const bf16_t* qsrc = HQ + (rowb + row) * 512 + h * 128 + seg * 16; const bf16_t* ksrc = HK + (rowb + row) * 512 + h * 128 + seg * 16;
    bf16_t* vsrc = HI + (rowb + row) * 512 + h * 128 + vh * 64 + seg * 8;
    for (int i = tid; i < 128 * SS / 4; i += NTHR) ((LAS unsigned*)(lds + LS))[i] = 0u;
    f32x16 Sacc = {};
    const int di = wid >> 1, vi = wid & 1, ti = wid >> 1;
    const int tg = lane >> 4, tc = tg & 1, tI = lane & 15;
    const int trow = 4 * hi + (tI >> 2), tcol = 16 * tc + 4 * (tI & 3);
    u32x4 qn0 = *(const u32x4*)qsrc, qn1 = *(const u32x4*)(qsrc + 8), kn0 = *(const u32x4*)ksrc, kn1 = *(const u32x4*)(ksrc + 8), vn = *(const u32x4*)vsrc;
#pragma unroll 1
    for (int n = 0; n < SEQ / 64; ++n) {
        const u32x4 q0 = qn0, q1 = qn1, k0 = kn0, k1 = kn1, vv = vn;
        float qf[16] = {bf_lo(q0.x), bf_hi(q0.x), bf_lo(q0.y), bf_hi(q0.y), bf_lo(q0.z), bf_hi(q0.z), bf_lo(q0.w), bf_hi(q0.w), bf_lo(q1.x), bf_hi(q1.x), bf_lo(q1.y), bf_hi(q1.y), bf_lo(q1.z), bf_hi(q1.z), bf_lo(q1.w), bf_hi(q1.w)};
        float kf[16] = {bf_lo(k0.x), bf_hi(k0.x), bf_lo(k0.y), bf_hi(k0.y), bf_lo(k0.z), bf_hi(k0.z), bf_lo(k0.w), bf_hi(k0.w), bf_lo(k1.x), bf_hi(k1.x), bf_lo(k1.y), bf_hi(k1.y), bf_lo(k1.z), bf_hi(k1.z), bf_lo(k1.w), bf_hi(k1.w)};
#pragma unroll
        for (int e4 = 0; e4 < 4; ++e4) *(LAS f32x4*)(G + row * 128 + seg * 16 + 4 * e4) = (f32x4){__logf(1.0f - kf[4 * e4]), __logf(1.0f - kf[4 * e4 + 1]), __logf(1.0f - kf[4 * e4 + 2]), __logf(1.0f - kf[4 * e4 + 3])};
        *(LAS u32x4*)(lds + LV + row * SV + seg * 16) = vv;
        if (n + 1 < SEQ / 64) { const size_t o = (size_t)(n + 1) * 64 * 512; qn0 = *(const u32x4*)(qsrc + o); qn1 = *(const u32x4*)(qsrc + o + 8); kn0 = *(const u32x4*)(ksrc + o); kn1 = *(const u32x4*)(ksrc + o + 8); vn = *(const u32x4*)(vsrc + o); }
        __syncthreads();
        { const int d = tid & 127, q4 = tid >> 7; float s = 0.f;
#pragma unroll
          for (int i = 0; i < 16; ++i) { s += G[(16 * q4 + i) * 128 + d]; G[(16 * q4 + i) * 128 + d] = s; }
          TOT[q4 * 128 + d] = s; }
        __syncthreads();
        {
            const int qq = row >> 4;
#pragma unroll
            for (int e4 = 0; e4 < 4; ++e4) {
                const int d4 = seg * 16 + 4 * e4;
                const f32x4 t0 = *(const LAS f32x4*)(TOT + d4), t1 = *(const LAS f32x4*)(TOT + 128 + d4), t2 = *(const LAS f32x4*)(TOT + 256 + d4), t3 = *(const LAS f32x4*)(TOT + 384 + d4);
                const f32x4 off = (qq == 0) ? (f32x4){0.f, 0.f, 0.f, 0.f} : ((qq == 1) ? t0 : ((qq == 2) ? t0 + t1 : t0 + t1 + t2));
                const f32x4 bb = *(const LAS f32x4*)(G + row * 128 + d4) + off;
                const f32x4 bref = *(const LAS f32x4*)(G + 32 * 128 + d4) + t0 + t1, blast = t0 + t1 + t2 + t3;
                float vqb[4], vqr[4], vkr[4], vkd[4];
#pragma unroll
                for (int e = 0; e < 4; ++e) {
                    const float e1 = __expf(bb[e]), e2 = __expf(-bb[e]);
                    vqb[e] = qf[4 * e4 + e] * e1; vqr[e] = vqb[e] * __expf(-bref[e]);
                    const float ke = kf[4 * e4 + e] * e2; vkr[e] = ke * __expf(bref[e]); vkd[e] = ke * __expf(blast[e]);
                }
                *(LAS u32x2*)(lds + LQB + row * SQ + seg * 32 + 8 * e4) = (u32x2){cvt_pk_bf16(vqb[0], vqb[1]), cvt_pk_bf16(vqb[2], vqb[3])};
                *(LAS u32x2*)(lds + LQR + row * SQ + seg * 32 + 8 * e4) = (u32x2){cvt_pk_bf16(vqr[0], vqr[1]), cvt_pk_bf16(vqr[2], vqr[3])};
                *(LAS u32x2*)(lds + LKR + row * SQ + seg * 32 + 8 * e4) = (u32x2){cvt_pk_bf16(vkr[0], vkr[1]), cvt_pk_bf16(vkr[2], vkr[3])};
                *(LAS u32x2*)(lds + LKD + row * SKD + seg * 32 + 8 * e4) = (u32x2){cvt_pk_bf16(vkd[0], vkd[1]), cvt_pk_bf16(vkd[2], vkd[3])};
                if (row == 0) *(LAS f32x4*)(CL + d4) = (f32x4){__expf(blast[0]), __expf(blast[1]), __expf(blast[2]), __expf(blast[3])};
                asm volatile("" ::: "memory");
            }
        }
        __syncthreads();
        if (wid < 4) {
            f32x16 Z = {};
            for (int si = 0; si <= ti; ++si) {
                f32x16 X = {};
#pragma unroll
                for (int ks = 0; ks < 8; ++ks) {
                    const bf16x8 a = *(const LAS bf16x8*)(lds + LKR + (32 * si + r32) * SQ + (16 * ks + 8 * hi) * 2);
                    const bf16x8 bq = *(const LAS bf16x8*)(lds + LQR + (32 * ti + r32) * SQ + (16 * ks + 8 * hi) * 2);
                    X = MFMA32(a, bq, X);
                }
                if (si == ti) {
#pragma unroll
                    for (int r = 0; r < 16; ++r) if (crow(r, hi) > r32) X[r] = 0.f;
                }
#pragma unroll
                for (int s2 = 0; s2 < 2; ++s2) {
                    union { u32x4 u; bf16x8 v; } pa;
                    pa.u.x = cvt_pk_bf16(X[8 * s2 + 0], X[8 * s2 + 1]); pa.u.y = cvt_pk_bf16(X[8 * s2 + 2], X[8 * s2 + 3]); pa.u.z = cvt_pk_bf16(X[8 * s2 + 4], X[8 * s2 + 5]); pa.u.w = cvt_pk_bf16(X[8 * s2 + 6], X[8 * s2 + 7]);
                    const LAS unsigned char* vp = lds + LV + (32 * si + 16 * s2 + trow) * SV + (32 * vi + tcol) * 2;
                    const s16x4 lo = tr4(vp), hh = tr4(vp + 8 * SV);
                    const bf16x8 vf = {lo[0], lo[1], lo[2], lo[3], hh[0], hh[1], hh[2], hh[3]};
                    Z = MFMA32(pa.v, vf, Z);
                }
            }
#pragma unroll
            for (int ks = 0; ks < 8; ++ks) {
                const bf16x8 a = *(const LAS bf16x8*)(lds + LQB + (32 * ti + r32) * SQ + (16 * ks + 8 * hi) * 2);
                const LAS unsigned char* sp = lds + LS + (16 * ks + 8 * hi + (tI >> 2)) * SS + (32 * vi + tcol) * 2;
                const s16x4 lo = tr4(sp), hh = tr4(sp + 4 * SS);
                const bf16x8 sf = {lo[0], lo[1], lo[2], lo[3], hh[0], hh[1], hh[2], hh[3]};
                Z = MFMA32(a, sf, Z);
            }
            bf16_t* op = HI + (rowb + (size_t)n * 64 + 32 * ti) * 512 + h * 128 + vh * 64 + 32 * vi + r32;
#pragma unroll
            for (int r = 0; r < 16; ++r) op[(size_t)crow(r, hi) * 512] = (bf16_t)(cvt_pk_bf16(Z[r], 0.f) & 0xffffu);
        }
        {
#pragma unroll
            for (int r = 0; r < 16; ++r) Sacc[r] *= CL[32 * di + crow(r, hi)];
#pragma unroll
            for (int ks = 0; ks < 4; ++ks) {
                const LAS unsigned char* kp = lds + LKD + (16 * ks + 8 * hi + (tI >> 2)) * SKD + (32 * di + tcol) * 2;
                const s16x4 klo = tr4(kp), khi = tr4(kp + 4 * SKD);
                const bf16x8 ka = {klo[0], klo[1], klo[2], klo[3], khi[0], khi[1], khi[2], khi[3]};
                const LAS unsigned char* vp = lds + LV + (16 * ks + 8 * hi + (tI >> 2)) * SV + (32 * vi + tcol) * 2;
                const s16x4 vlo = tr4(vp), vhi = tr4(vp + 4 * SV);
                const bf16x8 vb = {vlo[0], vlo[1], vlo[2], vlo[3], vhi[0], vhi[1], vhi[2], vhi[3]};
                Sacc = MFMA32(ka, vb, Sacc);
            }
        }
        __syncthreads();
        {
            LAS bf16_t* sp = (LAS bf16_t*)(lds + LS + (32 * di) * SS + (32 * vi + r32) * 2);
#pragma unroll
            for (int r = 0; r < 16; ++r) sp[crow(r, hi) * (SS / 2)] = (bf16_t)(cvt_pk_bf16(Sacc[r], 0.f) & 0xffffu);
        }
    }
    __syncthreads();
}

__device__ void moba_unit(const Params& P, int b, int h, int j, LAS unsigned char* lds) {
    const int tid = tid_opaque(), lane = tid & 63, wid = tid >> 6, r32 = lane & 31, hi = lane >> 5;
    bf16_t* Q = (bf16_t*)(P.ws + OFF_QA); const bf16_t* Kg = (const bf16_t*)(P.ws + OFF_KA); const bf16_t* Vg = (const bf16_t*)(P.ws + OFF_VA);
    const float* kmean = (const float*)(P.ws + OFF_KMEAN);
    constexpr int KIMG = 64 * 144, VIMG = 64 * 192, LK = 0, LV = 4 * KIMG, LKM = 4 * KIMG + 4 * VIMG;
    LAS float* kmL = (LAS float*)(lds + LKM);
    const size_t rowb = (size_t)b * SEQ; const int q0 = j * 256;
    if (tid < j * 64) kmL[tid] = kmean[(size_t)(b * 8 + (tid >> 6)) * 512 + h * 64 + (tid & 63)];
    bf16_t* qrow = Q + (rowb + q0 + wid * 32 + r32) * 512 + h * 64;
    bf16x8 qf[4];
#pragma unroll
    for (int d0 = 0; d0 < 4; ++d0) qf[d0] = *(const bf16x8*)(qrow + 16 * d0 + 8 * hi);
    const int srow = tid >> 3, sch = tid & 7;
    const bf16_t* ksrc = Kg + (rowb + srow) * 512 + h * 64 + sch * 8; const bf16_t* vsrc = Vg + (rowb + srow) * 512 + h * 64 + sch * 8;
    const int ntile = 4 * (j + 1), npair = ntile >> 1;
    auto tile_key0 = [&](int i) -> size_t { const int blk = (i < 4) ? j : ((i - 4) >> 2), kt = (i < 4) ? i : ((i - 4) & 3); return (size_t)(blk * 256 + kt * 64); };
    u32x4 kreg[2], vreg[2];
#pragma unroll
    for (int s = 0; s < 2; ++s) { const size_t k0 = tile_key0(s); kreg[s] = *(const u32x4*)(ksrc + k0 * 512); vreg[s] = *(const u32x4*)(vsrc + k0 * 512); }
#pragma unroll
    for (int s = 0; s < 2; ++s) { *(LAS u32x4*)(lds + LK + s * KIMG + srow * 144 + sch * 16) = kreg[s]; *(LAS u32x4*)(lds + LV + s * VIMG + srow * 192 + sch * 16) = vreg[s]; }
    __syncthreads();
    unsigned sel = 0;
    if (j <= 3) sel = (1u << j) - 1u;
    else {
        float g[7];
#pragma unroll
        for (int n = 0; n < 7; ++n) { float s = 0.f;
            if (n < j) {
#pragma unroll
                for (int d0 = 0; d0 < 4; ++d0)
#pragma unroll
                    for (int e = 0; e < 8; ++e) s += __uint_as_float(((unsigned)(unsigned short)qf[d0][e]) << 16) * kmL[n * 64 + 16 * d0 + 8 * hi + e];
            }
            s += __shfl_xor(s, 32); g[n] = s; }
#pragma unroll
        for (int it = 0; it < 3; ++it) { float best = -INFINITY; int bi = 0;
#pragma unroll
            for (int n = 0; n < 7; ++n) if (n < j && !((sel >> n) & 1u) && g[n] > best) { best = g[n]; bi = n; }
            sel |= 1u << bi; }
    }
    const float ch = exp2f(-(float)(h + 1)) * LOG2E;
    const int qb = wid * 32 + r32;
    float m_run = -1e30f, l_run = 0.f;
    f32x16 o0 = {}, o1 = {};
    const int tg = lane >> 4, tc = tg & 1, ti = lane & 15;
    const int vlane = (4 * hi + (ti >> 2)) * 192 + (16 * tc + 4 * (ti & 3)) * 2;
#pragma unroll 1
    for (int ip = 0; ip < npair; ++ip) {
      const int pbuf = ip & 1;
      if (ip + 1 < npair) {
#pragma unroll
          for (int s = 0; s < 2; ++s) { const size_t k1 = tile_key0(2 * ip + 2 + s); kreg[s] = *(const u32x4*)(ksrc + k1 * 512); vreg[s] = *(const u32x4*)(vsrc + k1 * 512); }
      }
#pragma unroll
      for (int s2 = 0; s2 < 2; ++s2) {
        const int i = 2 * ip + s2, buf = pbuf * 2 + s2;
        const bool own = i < 4; const int blk = own ? j : ((i - 4) >> 2), kt = own ? i : ((i - 4) & 3);
        const bool lane_ok = own ? true : (((sel >> blk) & 1u) != 0u);
        const bool skip = own ? (64 * kt > 32 * wid + 31) : (__ballot(lane_ok) == 0ull);
        if (!skip) {
            LAS unsigned char* kb = lds + LK + buf * KIMG; LAS unsigned char* vb = lds + LV + buf * VIMG;
            f32x16 p0 = {}, p1 = {};
#pragma unroll
            for (int d0 = 0; d0 < 4; ++d0) {
                const bf16x8 kf0 = *(const LAS bf16x8*)(kb + r32 * 144 + (16 * d0 + 8 * hi) * 2);
                const bf16x8 kf1 = *(const LAS bf16x8*)(kb + (32 + r32) * 144 + (16 * d0 + 8 * hi) * 2);
                p0 = MFMA32(kf0, qf[d0], p0); p1 = MFMA32(kf1, qf[d0], p1);
            }
            const float kbase = ch * (float)((blk - j) * 256 + kt * 64);
            float mt = -1e30f;
#pragma unroll
            for (int r = 0; r < 16; ++r) {
                const int kl0 = crow(r, hi), kl1 = kl0 + 32;
                p0[r] = __builtin_fmaf(ch, (float)kl0, p0[r]); p1[r] = __builtin_fmaf(ch, (float)kl1, p1[r]);
                if (own) { if (kt * 64 + kl0 > qb) p0[r] = -1e30f; if (kt * 64 + kl1 > qb) p1[r] = -1e30f; }
                mt = fmaxf(mt, fmaxf(p0[r], p1[r]));
            }
            mt = lane_ok ? mt + kbase : -1e30f;
            mt = fmaxf(mt, __shfl_xor(mt, 32));
            if (__ballot(mt > m_run) != 0ull) {
                const float mnew = fmaxf(m_run, mt), alpha = __builtin_amdgcn_exp2f(m_run - mnew);
                m_run = mnew; l_run *= alpha;
#pragma unroll
                for (int r = 0; r < 16; ++r) { o0[r] *= alpha; o1[r] *= alpha; }
            }
            const float sh = lane_ok ? kbase - m_run : -1e30f;
            float rs = 0.f;
#pragma unroll
            for (int r = 0; r < 16; ++r) { p0[r] = __builtin_amdgcn_exp2f(p0[r] + sh); p1[r] = __builtin_amdgcn_exp2f(p1[r] + sh); rs += p0[r] + p1[r]; }
            l_run += rs;
#pragma unroll
            for (int sub = 0; sub < 2; ++sub)
#pragma unroll
                for (int s = 0; s < 2; ++s) {
                    union { u32x4 u; bf16x8 v; } pb;
                    if (sub == 0) { pb.u.x = cvt_pk_bf16(p0[8 * s + 0], p0[8 * s + 1]); pb.u.y = cvt_pk_bf16(p0[8 * s + 2], p0[8 * s + 3]); pb.u.z = cvt_pk_bf16(p0[8 * s + 4], p0[8 * s + 5]); pb.u.w = cvt_pk_bf16(p0[8 * s + 6], p0[8 * s + 7]); }
                    else { pb.u.x = cvt_pk_bf16(p1[8 * s + 0], p1[8 * s + 1]); pb.u.y = cvt_pk_bf16(p1[8 * s + 2], p1[8 * s + 3]); pb.u.z = cvt_pk_bf16(p1[8 * s + 4], p1[8 * s + 5]); pb.u.w = cvt_pk_bf16(p1[8 * s + 6], p1[8 * s + 7]); }
#pragma unroll
                    for (int dt = 0; dt < 2; ++dt) {
                        LAS unsigned char* va = vb + (32 * sub + 16 * s) * 192 + dt * 64 + vlane;
                        const s16x4 lo = __builtin_bit_cast(s16x4, __builtin_amdgcn_ds_read_tr16_b64_v4i16((LAS s16x4*)va));
                        const s16x4 hh = __builtin_bit_cast(s16x4, __builtin_amdgcn_ds_read_tr16_b64_v4i16((LAS s16x4*)(va + 8 * 192)));
                        const bf16x8 vf = {lo[0], lo[1], lo[2], lo[3], hh[0], hh[1], hh[2], hh[3]};
                        if (dt == 0) o0 = MFMA32(vf, pb.v, o0); else o1 = MFMA32(vf, pb.v, o1);
                    }
                }
        }
      }
      if (ip + 1 < npair) { const int nb = (pbuf ^ 1) * 2;
#pragma unroll
          for (int s = 0; s < 2; ++s) { *(LAS u32x4*)(lds + LK + (nb + s) * KIMG + srow * 144 + sch * 16) = kreg[s]; *(LAS u32x4*)(lds + LV + (nb + s) * VIMG + srow * 192 + sch * 16) = vreg[s]; } }
      __syncthreads();
    }
    l_run += __shfl_xor(l_run, 32);
    const float inv = 1.0f / l_run;
#pragma unroll
    for (int r4 = 0; r4 < 4; ++r4) {
        int w0 = __builtin_amdgcn_cvt_pk_fp8_f32(o0[4 * r4] * inv, o0[4 * r4 + 1] * inv, 0, false); w0 = __builtin_amdgcn_cvt_pk_fp8_f32(o0[4 * r4 + 2] * inv, o0[4 * r4 + 3] * inv, w0, true);
        int w1 = __builtin_amdgcn_cvt_pk_fp8_f32(o1[4 * r4] * inv, o1[4 * r4 + 1] * inv, 0, false); w1 = __builtin_amdgcn_cvt_pk_fp8_f32(o1[4 * r4 + 2] * inv, o1[4 * r4 + 3] * inv, w1, true);
        unsigned char* yrow = P.ws + OFF_EG + (rowb + q0 + wid * 32 + r32) * 1024 + h * 64;
        *(int*)(yrow + 8 * r4 + 4 * hi) = w0; *(int*)(yrow + 32 + 8 * r4 + 4 * hi) = w1;
    }
}

__device__ void yb_norm_panel(const Params& P, int pm) {
    const int tid = tid_opaque(), lane = tid & 63, wid = tid >> 6;
    bf16_t* HI = (bf16_t*)(P.ws + OFF_HI); const bf16_t* HG = (const bf16_t*)(P.ws + OFF_HG);
    for (int r = 0; r < 32; ++r) {
        const size_t off = ((size_t)pm * 256 + wid * 32 + r) * 512 + lane * 8;
        const u32x4 ov = *(const u32x4*)(HI + off), gv = *(const u32x4*)(HG + off);
        float o[8] = {bf_lo(ov.x), bf_hi(ov.x), bf_lo(ov.y), bf_hi(ov.y), bf_lo(ov.z), bf_hi(ov.z), bf_lo(ov.w), bf_hi(ov.w)};
        const float g[8] = {bf_lo(gv.x), bf_hi(gv.x), bf_lo(gv.y), bf_hi(gv.y), bf_lo(gv.z), bf_hi(gv.z), bf_lo(gv.w), bf_hi(gv.w)};
        float ss = 0.f;
#pragma unroll
        for (int e = 0; e < 8; ++e) ss += o[e] * o[e];
        ss += __shfl_xor(ss, 1); ss += __shfl_xor(ss, 2); ss += __shfl_xor(ss, 4); ss += __shfl_xor(ss, 8);
        const float rs = rsqrtf(ss * (1.0f / 128.0f) + RMS_EPS);
        int w0 = __builtin_amdgcn_cvt_pk_fp8_f32(o[0] * rs * g[0], o[1] * rs * g[1], 0, false); w0 = __builtin_amdgcn_cvt_pk_fp8_f32(o[2] * rs * g[2], o[3] * rs * g[3], w0, true);
        int w1 = __builtin_amdgcn_cvt_pk_fp8_f32(o[4] * rs * g[4], o[5] * rs * g[5], 0, false); w1 = __builtin_amdgcn_cvt_pk_fp8_f32(o[6] * rs * g[6], o[7] * rs * g[7], w1, true);
        *(u32x2*)(P.ws + OFF_EG + ((size_t)pm * 256 + wid * 32 + r) * 1024 + 512 + lane * 8) = (u32x2){(unsigned)w0, (unsigned)w1};
    }
}
__device__ void ln1_panel(const Params& P, int pm) {
    const int tid = tid_opaque(), lane = tid & 63, wid = tid >> 6;
    const float* ada = (const float*)(P.ws + OFF_ADA) + (size_t)(pm >> 3) * 6144; bf16_t* H = (bf16_t*)(P.ws + OFF_H);
    for (int r = 0; r < 32; ++r) {
        const size_t row = (size_t)pm * 256 + wid * 32 + r;
        const float* xin = P.x + row * 1024 + lane * 4; const bf16_t* dl = (const bf16_t*)(P.ws + OFF_GB) + row * 1024 + lane * 4;
        f32x4 v[4]; float s = 0.f;
#pragma unroll
        for (int jx = 0; jx < 4; ++jx) { const u32x2 dv = *(const u32x2*)(dl + 256 * jx); const f32x4 xv = __builtin_nontemporal_load((const f32x4*)(xin + 256 * jx));
            v[jx] = xv * ALPHA + (f32x4){bf_lo(dv.x), bf_hi(dv.x), bf_lo(dv.y), bf_hi(dv.y)}; s += (v[jx][0] + v[jx][1]) + (v[jx][2] + v[jx][3]); }
        const float mean = wave_sum(s) * (1.0f / 1024.0f); float s2 = 0.f;
#pragma unroll
        for (int jx = 0; jx < 4; ++jx) { v[jx] = v[jx] - mean; s2 += (v[jx][0] * v[jx][0] + v[jx][1] * v[jx][1]) + (v[jx][2] * v[jx][2] + v[jx][3] * v[jx][3]); }
        const float rstd = rsqrtf(wave_sum(s2) * (1.0f / 1024.0f) + LN_EPS);
#pragma unroll
        for (int jx = 0; jx < 4; ++jx) {
            const int c = lane * 4 + 256 * jx;
            const f32x4 g = *(const f32x4*)(P.ln1_g + c), bb = *(const f32x4*)(P.ln1_b + c), sh = *(const f32x4*)(ada + 3072 + c), sc = *(const f32x4*)(ada + 4096 + c);
            const f32x4 x1 = v[jx] * rstd * g + bb;
            { u32x2 w1; w1.x = cvt_pk_bf16(x1[0], x1[1]); w1.y = cvt_pk_bf16(x1[2], x1[3]);
              *(u32x2*)((bf16_t*)(P.out + row * 1024) + c) = w1; }
            const f32x4 h2 = x1 * (sc + 1.0f) + sh;
            u32x2 w; w.x = cvt_pk_bf16(h2[0], h2[1]); w.y = cvt_pk_bf16(h2[2], h2[3]);
            *(u32x2*)(H + row * 1024 + c) = w;
            v[jx] = h2;
        }
        {
            float mx = 0.f;
#pragma unroll
            for (int jx = 0; jx < 4; ++jx) mx = fmaxf(mx, fmaxf(fmaxf(fabsf(v[jx][0]), fabsf(v[jx][1])), fmaxf(fabsf(v[jx][2]), fabsf(v[jx][3]))));
#pragma unroll
            for (int o = 1; o < 64; o <<= 1) mx = fmaxf(mx, __shfl_xor(mx, o));
            const float hs = fmaxf(mx * (1.0f / 119.0f), 1e-30f), inv = 1.0f / hs; int qs = 0;
            const int nsh = (lane & 1) * 4;
#pragma unroll
            for (int jx = 0; jx < 4; ++jx) {
                unsigned pa = 0u, pb = 0u;
#pragma unroll
                for (int k = 0; k < 4; ++k) { const int q = (int)rintf(v[jx][k] * inv); qs += q;
                    const int b = ((q + 8) & 15) - 8, a = (q - b) >> 4;
                    pa |= (unsigned)(a & 15) << (8 * k + nsh); pb |= (unsigned)(b & 15) << (8 * k + nsh); }
                pa |= __shfl_xor(pa, 1); pb |= __shfl_xor(pb, 1);
                if (!(lane & 1)) { unsigned* hp4 = (unsigned*)(P.ws + OFF_H8 + row * 1024) + (lane >> 1) + 32 * jx; hp4[0] = pa; hp4[128] = pb; }
            }
#pragma unroll
            for (int o = 1; o < 64; o <<= 1) qs += __shfl_xor(qs, o);
            if (lane == 0) *(f32x2*)(P.ws + OFF_HS + row * 8) = (f32x2){hs, (float)qs};
        }
    }
}

#define CE16(A, i, j) do { const float hi_ = fmaxf(A[i], A[j]); A[j] = fminf(A[i], A[j]); A[i] = hi_; } while (0)
#define SORT16(A) do { CE16(A, 0, 1); CE16(A, 2, 3); CE16(A, 0, 2); CE16(A, 1, 3); CE16(A, 1, 2); CE16(A, 4, 5); CE16(A, 6, 7); CE16(A, 4, 6); CE16(A, 5, 7); CE16(A, 5, 6); CE16(A, 0, 4); CE16(A, 2, 6); CE16(A, 2, 4); CE16(A, 1, 5); CE16(A, 3, 7); CE16(A, 3, 5); CE16(A, 1, 2); CE16(A, 3, 4); CE16(A, 5, 6); CE16(A, 8, 9); CE16(A, 10, 11); CE16(A, 8, 10); CE16(A, 9, 11); CE16(A, 9, 10); CE16(A, 12, 13); CE16(A, 14, 15); CE16(A, 12, 14); CE16(A, 13, 15); CE16(A, 13, 14); CE16(A, 8, 12); CE16(A, 10, 14); CE16(A, 10, 12); CE16(A, 9, 13); CE16(A, 11, 15); CE16(A, 11, 13); CE16(A, 9, 10); CE16(A, 11, 12); CE16(A, 13, 14); CE16(A, 0, 8); CE16(A, 4, 12); CE16(A, 4, 8); CE16(A, 2, 10); CE16(A, 6, 14); CE16(A, 6, 10); CE16(A, 2, 4); CE16(A, 6, 8); CE16(A, 10, 12); CE16(A, 1, 9); CE16(A, 5, 13); CE16(A, 5, 9); CE16(A, 3, 11); CE16(A, 7, 15); CE16(A, 7, 11); CE16(A, 3, 5); CE16(A, 7, 9); CE16(A, 11, 13); CE16(A, 1, 2); CE16(A, 3, 4); CE16(A, 5, 6); CE16(A, 7, 8); CE16(A, 9, 10); CE16(A, 11, 12); CE16(A, 13, 14); } while (0)
#define BITONIC16(A) do { CE16(A, 0, 8); CE16(A, 1, 9); CE16(A, 2, 10); CE16(A, 3, 11); CE16(A, 4, 12); CE16(A, 5, 13); CE16(A, 6, 14); CE16(A, 7, 15); CE16(A, 0, 4); CE16(A, 1, 5); CE16(A, 2, 6); CE16(A, 3, 7); CE16(A, 8, 12); CE16(A, 9, 13); CE16(A, 10, 14); CE16(A, 11, 15); CE16(A, 0, 2); CE16(A, 1, 3); CE16(A, 4, 6); CE16(A, 5, 7); CE16(A, 8, 10); CE16(A, 9, 11); CE16(A, 12, 14); CE16(A, 13, 15); CE16(A, 0, 1); CE16(A, 2, 3); CE16(A, 4, 5); CE16(A, 6, 7); CE16(A, 8, 9); CE16(A, 10, 11); CE16(A, 12, 13); CE16(A, 14, 15); } while (0)
#define INS16(L, xin) do { float x_ = (xin); _Pragma("unroll") for (int k_ = 0; k_ < 16; ++k_) { const float hi_ = fmaxf(L[k_], x_); x_ = fminf(L[k_], x_); L[k_] = hi_; } } while (0)

__device__ void peer_select_wave(const Params& P, size_t tok0) {
    const int lane = tid_opaque() & 63, r32 = lane & 31, hi = lane >> 5;
    const bf16_t* QP = (const bf16_t*)(P.ws + OFF_GB) + (tok0 + r32) * 1024; const bf16_t* SK = (const bf16_t*)(P.ws + OFF_SK);
    u32x2* EG = (u32x2*)(P.ws + OFF_EG) + (tok0 + r32) * 128;
#pragma unroll 1
    for (int h = 0; h < 8; ++h) {
        float a0[16], a1[16];
#pragma unroll
        for (int k = 0; k < 16; ++k) { a0[k] = -INFINITY; a1[k] = -INFINITY; }
#pragma unroll
        for (int p = 0; p < 2; ++p) {
            const int hp = h * 2 + p;
            bf16x8 qf[4];
#pragma unroll
            for (int ks = 0; ks < 4; ++ks) qf[ks] = *(const bf16x8*)(QP + hp * 64 + 16 * ks + 8 * hi);
            float L[16];
#pragma unroll
            for (int kt = 0; kt < 4; ++kt) {
                f32x16 acc = {};
#pragma unroll
                for (int ks = 0; ks < 4; ++ks) { const bf16x8 kf = *(const bf16x8*)(SK + ((size_t)hp * 128 + 32 * kt + r32) * 64 + 16 * ks + 8 * hi); acc = MFMA32(kf, qf[ks], acc); }
                float S[16];
#pragma unroll
                for (int r = 0; r < 16; ++r) { const unsigned key = (unsigned)(32 * kt + crow(r, hi)); S[r] = __uint_as_float((__float_as_uint(acc[r]) & ~127u) | key); }
                SORT16(S);
                if (kt == 0) {
#pragma unroll
                    for (int k = 0; k < 16; ++k) L[k] = S[k];
                } else {
#pragma unroll
                    for (int k = 0; k < 16; ++k) L[k] = fmaxf(L[k], S[15 - k]);
                    BITONIC16(L);
                }
            }
            {
                float O[16];
#pragma unroll
                for (int k = 0; k < 16; ++k) O[k] = __shfl_xor(L[15 - k], 32);
#pragma unroll
                for (int k = 0; k < 16; ++k) L[k] = fmaxf(L[k], O[k]);
                BITONIC16(L);
            }
#pragma unroll
            for (int k = 0; k < 16; ++k) { a0[k] = (p == 0) ? L[k] : a0[k]; a1[k] = (p == 1) ? L[k] : a1[k]; }
        }
        float best[16];
#pragma unroll
        for (int k = 0; k < 16; ++k) best[k] = __uint_as_float((__float_as_uint(a0[0] + a1[k]) & ~255u) | (unsigned)k);
#define PKC(i, j) __uint_as_float((__float_as_uint(a0[i] + a1[j]) & ~255u) | (unsigned)((i) * 16 + (j)))
        {
            float A[16] = {PKC(1, 0), PKC(1, 1), PKC(1, 2), PKC(1, 3), PKC(1, 4), PKC(1, 5), PKC(1, 6), PKC(1, 7), PKC(15, 0), PKC(14, 0), PKC(13, 0), PKC(12, 0), PKC(11, 0), PKC(10, 0), PKC(9, 0), PKC(8, 0)};
            BITONIC16(A);
#pragma unroll
            for (int k = 0; k < 16; ++k) best[k] = fmaxf(best[k], A[15 - k]);
            BITONIC16(best);
            float B[16] = {PKC(2, 0), PKC(2, 1), PKC(2, 2), PKC(2, 3), PKC(2, 4), PKC(3, 0), PKC(3, 1), PKC(3, 2), PKC(3, 3), PKC(4, 0), PKC(4, 1), PKC(4, 2), PKC(5, 0), PKC(5, 1), PKC(6, 0), PKC(6, 1)};
            SORT16(B);
#pragma unroll
            for (int k = 0; k < 16; ++k) best[k] = fmaxf(best[k], B[15 - k]);
            BITONIC16(best);
            INS16(best, PKC(7, 0)); INS16(best, PKC(7, 1));
        }
#undef PKC
        unsigned pk0[4], pk1[4];
#pragma unroll
        for (int q = 0; q < 4; ++q) {
            pk0[q] = (__float_as_uint(a0[4 * q]) & 127u) | ((__float_as_uint(a0[4 * q + 1]) & 127u) << 8) | ((__float_as_uint(a0[4 * q + 2]) & 127u) << 16) | ((__float_as_uint(a0[4 * q + 3]) & 127u) << 24);
            pk1[q] = (__float_as_uint(a1[4 * q]) & 127u) | ((__float_as_uint(a1[4 * q + 1]) & 127u) << 8) | ((__float_as_uint(a1[4 * q + 2]) & 127u) << 16) | ((__float_as_uint(a1[4 * q + 3]) & 127u) << 24);
        }
        unsigned pay[16];
#pragma unroll
        for (int k = 0; k < 16; ++k) {
            const unsigned code = __float_as_uint(best[k]) & 255u, ci = code >> 4, cj = code & 15u;
            const unsigned qi = ci >> 2, qj = cj >> 2;
            const unsigned w0 = (qi == 0u) ? pk0[0] : ((qi == 1u) ? pk0[1] : ((qi == 2u) ? pk0[2] : pk0[3]));
            const unsigned w1 = (qj == 0u) ? pk1[0] : ((qj == 1u) ? pk1[1] : ((qj == 2u) ? pk1[2] : pk1[3]));
            pay[k] = (((w0 >> ((ci & 3u) * 8u)) & 127u) << 7) | ((w1 >> ((cj & 3u) * 8u)) & 127u);
        }
        float e[16], es = 0.f;
#pragma unroll
        for (int k = 0; k < 16; ++k) { e[k] = __expf(best[k] - best[0]); es += e[k]; }
        const float inv = 1.0f / es;
        if (hi == 0) {
#pragma unroll
            for (int k = 0; k < 16; ++k) { u32x2 w; w.x = pay[k]; w.y = __float_as_uint(e[k] * inv); EG[h * 16 + k] = w; }
        }
    }
}
__device__ __forceinline__ unsigned xcc_id() { return (unsigned)__builtin_amdgcn_s_getreg((3 << 11) | 20) & 0xFu; }
template <int CTRL> __device__ __forceinline__ float dpp_add(float x) { const int v = __builtin_amdgcn_update_dpp(0, __float_as_int(x), CTRL, 0xf, 0xf, true); return x + __int_as_float(v); }
__device__ __forceinline__ float wave_sum_fast(float x) {
    x = dpp_add<0xB1>(x); x = dpp_add<0x4E>(x); x = dpp_add<0x141>(x); x = dpp_add<0x140>(x);
    x += __shfl_xor(x, 16); x += __shfl_xor(x, 32); return x;
}
template <int CTRL> __device__ __forceinline__ float dpp_max(float x) { const int v = __builtin_amdgcn_update_dpp(0, __float_as_int(x), CTRL, 0xf, 0xf, true); return fmaxf(x, __int_as_float(v)); }
template <int CTRL> __device__ __forceinline__ int dpp_addi(int x) { return x + __builtin_amdgcn_update_dpp(0, x, CTRL, 0xf, 0xf, true); }
__device__ __forceinline__ float wave_max_fast(float x) {
    x = dpp_max<0xB1>(x); x = dpp_max<0x4E>(x); x = dpp_max<0x141>(x); x = dpp_max<0x140>(x);
    x = fmaxf(x, __shfl_xor(x, 16)); x = fmaxf(x, __shfl_xor(x, 32)); return x;
}
__device__ __forceinline__ int wave_sum_int_fast(int x) {
    x = dpp_addi<0xB1>(x); x = dpp_addi<0x4E>(x); x = dpp_addi<0x141>(x); x = dpp_addi<0x140>(x);
    x += __shfl_xor(x, 16); x += __shfl_xor(x, 32); return x;
}
__device__ __forceinline__ float dot16_fp8(const float (&hv)[16], const u32x4 r) {
    float s = 0.f;
    { const f32x2 a = __builtin_amdgcn_cvt_pk_f32_fp8((int)r.x, false), b = __builtin_amdgcn_cvt_pk_f32_fp8((int)r.x, true); s += hv[0] * a.x + hv[1] * a.y + hv[2] * b.x + hv[3] * b.y; }
    { const f32x2 a = __builtin_amdgcn_cvt_pk_f32_fp8((int)r.y, false), b = __builtin_amdgcn_cvt_pk_f32_fp8((int)r.y, true); s += hv[4] * a.x + hv[5] * a.y + hv[6] * b.x + hv[7] * b.y; }
    { const f32x2 a = __builtin_amdgcn_cvt_pk_f32_fp8((int)r.z, false), b = __builtin_amdgcn_cvt_pk_f32_fp8((int)r.z, true); s += hv[8] * a.x + hv[9] * a.y + hv[10] * b.x + hv[11] * b.y; }
    { const f32x2 a = __builtin_amdgcn_cvt_pk_f32_fp8((int)r.w, false), b = __builtin_amdgcn_cvt_pk_f32_fp8((int)r.w, true); s += hv[12] * a.x + hv[13] * a.y + hv[14] * b.x + hv[15] * b.y; }
    return s;
}
template <int NP, class F> __device__ __forceinline__ void partition_queue(const Params& P, LAS unsigned char* lds, int ctr_base, F f) {
    const int tid = tid_opaque();
    LAS int* slot = (LAS int*)(lds + LDS_BYTES - 64);
    unsigned* ctr = (unsigned*)(P.ws + OFF_CTR) + ctr_base;
    const int myx = (int)(xcc_id() & 7u);
    for (int pp = 0; pp < NP; ++pp) {
        const int p = (myx * (NP / 8) + pp) % NP;
        for (;;) {
            if (tid == 0) *slot = (int)atomicAdd(ctr + p, 1u);
            __syncthreads();
            const int item = *slot;
            __syncthreads();
            if (item >= NTOK / 64) break;
            f(p, item);
        }
    }
}
__device__ __forceinline__ float dot2bf(unsigned a, bf16v2 b, float c) { return __builtin_amdgcn_fdot2_f32_bf16(__builtin_bit_cast(bf16v2, a), b, c, false); }
__device__ __forceinline__ float gelu_erf(float v) {
    const float av = fabsf(v), t = __builtin_amdgcn_rcpf(__builtin_fmaf(av, 0.2316418882f, 1.0f));
    float q = __builtin_fmaf(t, 0.5307027145f, -0.7265760135f); q = __builtin_fmaf(q, t, 0.7107068705f); q = __builtin_fmaf(q, t, -0.142248368f); q = __builtin_fmaf(q, t, 0.127414796f); q = q * t;
    const float m = v * (q * __builtin_amdgcn_exp2f(v * v * -0.72134752044f));
    return v < 0.f ? m : v - m;
}
struct UQuad { u32x4 r[2]; u32x4 ent, nxt; };
__device__ __forceinline__ void uq_issue(UQuad& q, const LAS u32x4* list, int J, int NQ, int g, const unsigned char* Ub, const unsigned lo) {
    q.ent = q.nxt;
    const unsigned char* rp = Ub + (q.ent.x * 512u + lo);
    q.r[0] = *(const u32x4*)rp; q.r[1] = *(const u32x4*)(rp + 256);
    const int jj = J < NQ ? J : NQ - 1;
    q.nxt = list[4 * jj + g];
}
__device__ __forceinline__ float uq_dot(const UQuad& q, const u32x4 (&hp)[4]) {
    int a = 0, b = 0;
#pragma unroll
    for (int c = 0; c < 2; ++c) {
        const u32x4 r = q.r[c];
        a = __builtin_amdgcn_sdot8((int)hp[c].x, (int)r.x, a, false); a = __builtin_amdgcn_sdot8((int)hp[c].y, (int)r.y, a, false);
        a = __builtin_amdgcn_sdot8((int)hp[c].z, (int)r.z, a, false); a = __builtin_amdgcn_sdot8((int)hp[c].w, (int)r.w, a, false);
        b = __builtin_amdgcn_sdot8((int)hp[2 + c].x, (int)r.x, b, false); b = __builtin_amdgcn_sdot8((int)hp[2 + c].y, (int)r.y, b, false);
        b = __builtin_amdgcn_sdot8((int)hp[2 + c].z, (int)r.z, b, false); b = __builtin_amdgcn_sdot8((int)hp[2 + c].w, (int)r.w, b, false);
    }
    float s = (float)(16 * a + b);
    s = dpp_add<0xB1>(s); s = dpp_add<0x4E>(s); s = dpp_add<0x141>(s); s = dpp_add<0x140>(s);
    return s;
}
__device__ __forceinline__ void peer_u_tokens(const Params& P, LAS unsigned char* lds, const size_t t0) {
    const int tid = tid_opaque(), lane = tid & 63, wid = tid >> 6, g = lane >> 4, li = lane & 15;
    const unsigned char* H8 = P.ws + OFF_H8 + li * 16; const unsigned char* Ub = P.ws + OFF_U8; const unsigned lo16 = (unsigned)li * 16u;
    const f32x2* HS = (const f32x2*)(P.ws + OFF_HS); const float* USC = (const float*)(P.ws + OFF_USC);
    const u32x4* EG4 = (const u32x4*)(P.ws + OFF_EG); float* W = (float*)(P.ws + OFF_W);
    LAS u32x4* list = (LAS u32x4*)(lds + wid * 16384);
    {
        u32x4 egv[8]; float s0[8], s1[8];
#pragma unroll
        for (int i = 0; i < 8; ++i) egv[i] = EG4[(t0 + i) * 64 + lane];
#pragma unroll
        for (int i = 0; i < 8; ++i) { s0[i] = USC[egv[i].x]; s1[i] = USC[egv[i].z]; }
#pragma unroll
        for (int i = 0; i < 8; ++i) {
            list[i * 128 + 2 * lane] = (u32x4){egv[i].x, egv[i].y, (unsigned)(2 * lane) | (unsigned)(i << 8), __float_as_uint(s0[i])};
            list[i * 128 + 2 * lane + 1] = (u32x4){egv[i].z, egv[i].w, (unsigned)(2 * lane + 1) | (unsigned)(i << 8), __float_as_uint(s1[i])};
        }
    }
    constexpr int NQ = 256;
    u32x4 hp[4], hn[4]; f32x2 hsc = HS[t0], hsn = HS[t0 + 1];
#pragma unroll
    for (int c = 0; c < 2; ++c) { hp[c] = *(const u32x4*)(H8 + t0 * 1024 + 256 * c); hp[2 + c] = *(const u32x4*)(H8 + t0 * 1024 + 512 + 256 * c);
                                  hn[c] = *(const u32x4*)(H8 + (t0 + 1) * 1024 + 256 * c); hn[2 + c] = *(const u32x4*)(H8 + (t0 + 1) * 1024 + 512 + 256 * c); }
    int curtok = 0;
    UQuad q0, q1, q2, q3, q4, q5, q6, q7;
    q0.nxt = list[g]; q1.nxt = list[4 + g]; q2.nxt = list[8 + g]; q3.nxt = list[12 + g]; q4.nxt = list[16 + g]; q5.nxt = list[20 + g]; q6.nxt = list[24 + g]; q7.nxt = list[28 + g];
    uq_issue(q0, list, 8, NQ, g, Ub, lo16); uq_issue(q1, list, 9, NQ, g, Ub, lo16); uq_issue(q2, list, 10, NQ, g, Ub, lo16); uq_issue(q3, list, 11, NQ, g, Ub, lo16);
    uq_issue(q4, list, 12, NQ, g, Ub, lo16); uq_issue(q5, list, 13, NQ, g, Ub, lo16); uq_issue(q6, list, 14, NQ, g, Ub, lo16); uq_issue(q7, list, 15, NQ, g, Ub, lo16);
    float sv = 0.f; unsigned gv = 0u, zv = 0u;
#define UQ_PIN(q) asm volatile("" : "+v"(q.r[0]), "+v"(q.r[1]) :: "memory")
#define UQ_STEP(q, Jn, kq, qn) do { \
        const float s = __uint_as_float(q.ent.w) * hsc.x * (uq_dot(q, hp) + 0.5f * hsc.y); \
        if (li == (kq)) { sv = s; gv = q.ent.y; zv = q.ent.z; } \
        uq_issue(q, list, (Jn), NQ, g, Ub, lo16); UQ_PIN(qn); } while (0)
    UQ_PIN(q0);
#pragma unroll 1
    for (int J = 0; J < NQ; J += 8) {
        const int tk = __builtin_amdgcn_readfirstlane((int)(q0.ent.z >> 8));
        if (tk != curtok) { curtok = tk;
#pragma unroll
            for (int c = 0; c < 4; ++c) hp[c] = hn[c];
            hsc = hsn;
            if (tk + 1 < 8) { hsn = HS[t0 + tk + 1];
#pragma unroll
                for (int c = 0; c < 2; ++c) { hn[c] = *(const u32x4*)(H8 + (t0 + tk + 1) * 1024 + 256 * c); hn[2 + c] = *(const u32x4*)(H8 + (t0 + tk + 1) * 1024 + 512 + 256 * c); } } }
        UQ_STEP(q0, J + 16, 0, q1); UQ_STEP(q1, J + 17, 1, q2); UQ_STEP(q2, J + 18, 2, q3); UQ_STEP(q3, J + 19, 3, q4);
        UQ_STEP(q4, J + 20, 4, q5); UQ_STEP(q5, J + 21, 5, q6); UQ_STEP(q6, J + 22, 6, q7); UQ_STEP(q7, J + 23, 7, q0);
        if (li < 8) W[(t0 + tk) * 128 + (zv & 255u)] = __uint_as_float(gv) * gelu_erf(sv); }
#undef UQ_STEP
}
typedef int v4i_t __attribute__((ext_vector_type(4)));
struct VQuad { u32x4 r[2]; u32x2 ent, nxt; };
__device__ __forceinline__ void vq_issue(VQuad& q, const LAS u32x2* list, int J, int g, const unsigned char* Vb, const unsigned lo) {
    q.ent = q.nxt;
    const unsigned char* rp = Vb + (q.ent.x * 512u + lo);
    q.r[0] = *(const u32x4*)rp; q.r[1] = *(const u32x4*)(rp + 256);
    const int jj = J < 256 ? J : 255;
    q.nxt = list[4 * jj + g];
}
#define VQ_PIN(q) asm volatile("" : "+v"(q.r[0]), "+v"(q.r[1]) :: "memory")
__device__ __forceinline__ void vq_mma(const VQuad& q, v4i_t (&acc)[4], const u32x4 bm) {
    const unsigned t = q.ent.y;
    const v4i_t B = {(int)(t & bm.x), (int)(t & bm.y), (int)(t & bm.z), (int)(t & bm.w)};
#pragma unroll
    for (int c = 0; c < 2; ++c) {
        const u32x4 r = q.r[c];
        const v4i_t lo = {(int)(r.x & 0x0F0F0F0Fu), (int)(r.y & 0x0F0F0F0Fu), (int)(r.z & 0x0F0F0F0Fu), (int)(r.w & 0x0F0F0F0Fu)};
        const v4i_t raw = {(int)r.x, (int)r.y, (int)r.z, (int)r.w};
        acc[2 * c] = __builtin_amdgcn_mfma_i32_16x16x64_i8(lo, B, acc[2 * c], 0, 0, 0);
        acc[2 * c + 1] = __builtin_amdgcn_mfma_i32_16x16x64_i8(raw, B, acc[2 * c + 1], 0, 0, 0);
    }
}
__device__ __forceinline__ void peer_v_tokens(const Params& P, LAS unsigned char* lds, const size_t t0) {
    const int tid = tid_opaque(), lane = tid & 63, wid = tid >> 6, g = lane >> 4, li = lane & 15;
    const unsigned char* Vb = P.ws + OFF_V8; const unsigned lo16 = (unsigned)li * 16u; const float* VSC = (const float*)(P.ws + OFF_VSC);
    const u32x4* EG4 = (const u32x4*)(P.ws + OFF_EG); const f32x2* W2 = (const f32x2*)(P.ws + OFF_W);
    LAS u32x2* lists = (LAS u32x2*)(lds + wid * 8192);
    LAS f32x2* tokp = (LAS f32x2*)(lds + 65536 + wid * 64);
    {
        u32x4 egv[8]; f32x2 wwv[8];
#pragma unroll
        for (int i = 0; i < 8; ++i) { egv[i] = EG4[(t0 + i) * 64 + lane]; wwv[i] = W2[(t0 + i) * 64 + lane]; }
        float w0v[8], w1v[8];
#pragma unroll
        for (int i = 0; i < 8; ++i) { w0v[i] = wwv[i].x * VSC[egv[i].x]; w1v[i] = wwv[i].y * VSC[egv[i].z]; }
#pragma unroll
        for (int i = 0; i < 8; ++i) {
            const float mx = wave_max_fast(fmaxf(fabsf(w0v[i]), fabsf(w1v[i])));
            const float sw = fmaxf(mx * (1.0f / 127.0f), 1e-30f), inv = 1.0f / sw;
            const int q0 = (int)rintf(w0v[i] * inv), q1 = (int)rintf(w1v[i] * inv);
            *(LAS u32x4*)(lists + i * 128 + 2 * lane) = (u32x4){egv[i].x, ((unsigned)q0 & 255u) * 0x01010101u, egv[i].z, ((unsigned)q1 & 255u) * 0x01010101u};
            const int qs = wave_sum_int_fast(q0 + q1);
            if (lane == 0) tokp[i] = (f32x2){sw, 7.5f * sw * (float)qs}; }
    }
    const unsigned bsel = 0xFFu << (8u * (unsigned)(li & 3));
    const u32x4 bm = {(li >> 2) == 0 ? bsel : 0u, (li >> 2) == 1 ? bsel : 0u, (li >> 2) == 2 ? bsel : 0u, (li >> 2) == 3 ? bsel : 0u};
    const int dbase = 128 * g + 8 * (li >> 2) + (li & 3);
    float gt2v[16], lgv[16], lbv[16];
    { const float* gt2 = (const float*)(P.ws + OFF_ADA) + (t0 >> 11) * 6144 + 5120;
#pragma unroll
      for (int c = 0; c < 2; ++c)
#pragma unroll
          for (int hf = 0; hf < 2; ++hf)
#pragma unroll
              for (int r = 0; r < 4; ++r) { const int d = dbase + 512 * c + 32 * r + 4 * hf, e = 8 * c + 4 * hf + r; gt2v[e] = gt2[d]; lgv[e] = P.ln2_g[d]; lbv[e] = P.ln2_b[d]; } }
    VQuad q0, q1, q2, q3, q4, q5, q6, q7;
    q0.nxt = lists[g]; q1.nxt = lists[4 + g]; q2.nxt = lists[8 + g]; q3.nxt = lists[12 + g]; q4.nxt = lists[16 + g]; q5.nxt = lists[20 + g]; q6.nxt = lists[24 + g]; q7.nxt = lists[28 + g];
    vq_issue(q0, lists, 8, g, Vb, lo16); vq_issue(q1, lists, 9, g, Vb, lo16); vq_issue(q2, lists, 10, g, Vb, lo16); vq_issue(q3, lists, 11, g, Vb, lo16);
    vq_issue(q4, lists, 12, g, Vb, lo16); vq_issue(q5, lists, 13, g, Vb, lo16); vq_issue(q6, lists, 14, g, Vb, lo16); vq_issue(q7, lists, 15, g, Vb, lo16);
    VQ_PIN(q0);
#pragma unroll 1
    for (int i = 0; i < 8; ++i) {
        const size_t t = t0 + i;
        v4i_t acc[4];
#pragma unroll
        for (int j = 0; j < 4; ++j) acc[j] = (v4i_t){0, 0, 0, 0};
        float* xr = P.out + t * 1024;
        float xv[16];
#pragma unroll
        for (int c = 0; c < 2; ++c)
#pragma unroll
            for (int hf = 0; hf < 2; ++hf)
#pragma unroll
                for (int r = 0; r < 4; ++r) xv[8 * c + 4 * hf + r] = __uint_as_float((unsigned)((const bf16_t*)xr)[dbase + 512 * c + 32 * r + 4 * hf] << 16);
#pragma unroll 1
        for (int J = 32 * i; J < 32 * i + 32; J += 8) {
            vq_mma(q0, acc, bm); vq_issue(q0, lists, J + 16, g, Vb, lo16); VQ_PIN(q1);
            vq_mma(q1, acc, bm); vq_issue(q1, lists, J + 17, g, Vb, lo16); VQ_PIN(q2);
            vq_mma(q2, acc, bm); vq_issue(q2, lists, J + 18, g, Vb, lo16); VQ_PIN(q3);
            vq_mma(q3, acc, bm); vq_issue(q3, lists, J + 19, g, Vb, lo16); VQ_PIN(q4);
            vq_mma(q4, acc, bm); vq_issue(q4, lists, J + 20, g, Vb, lo16); VQ_PIN(q5);
            vq_mma(q5, acc, bm); vq_issue(q5, lists, J + 21, g, Vb, lo16); VQ_PIN(q6);
            vq_mma(q6, acc, bm); vq_issue(q6, lists, J + 22, g, Vb, lo16); VQ_PIN(q7);
            vq_mma(q7, acc, bm); vq_issue(q7, lists, J + 23, g, Vb, lo16); VQ_PIN(q0);
        }
        const f32x2 tp = tokp[i]; const float sw = tp.x, yoff = tp.y;
        float pre[16]; float s = 0.f;
#pragma unroll
        for (int c = 0; c < 2; ++c)
#pragma unroll
            for (int hf = 0; hf < 2; ++hf)
#pragma unroll
                for (int r = 0; r < 4; ++r) { const int e = 8 * c + 4 * hf + r;
                    const float yv = hf == 0 ? sw * (float)acc[2 * c][r] - yoff : (sw * 0.0625f) * (float)(acc[2 * c + 1][r] - acc[2 * c][r]) + yoff * (1.0f / 15.0f);
                    const float pv = ALPHA * xv[e] + gt2v[e] * yv; pre[e] = pv; s += pv; }
        const float mean = wave_sum_fast(s) * (1.0f / 1024.0f); float s2 = 0.f;
#pragma unroll
        for (int e = 0; e < 16; ++e) { pre[e] -= mean; s2 += pre[e] * pre[e]; }
        const float rstd = rsqrtf(wave_sum_fast(s2) * (1.0f / 1024.0f) + LN_EPS);
#pragma unroll
        for (int c = 0; c < 2; ++c)
#pragma unroll
            for (int hf = 0; hf < 2; ++hf)
#pragma unroll
                for (int r = 0; r < 4; ++r) { const int e = 8 * c + 4 * hf + r;
                    xr[dbase + 512 * c + 32 * r + 4 * hf] = pre[e] * rstd * lgv[e] + lbv[e]; }
    }
}

#define XB_TMO      128
#define XB_XCNT(j)  (256  + 64 * (j))
#define XB_XSUB(j)  (1280 + 64 * (j))
#define XB_XGEN(j)  (2304 + 64 * (j))
#define XB_TOP      3328
#define XB_TOPGEN   3392
#define XCD_BAR_WORDS 3456
#define XB_SPIN_CAP (1u << 22)
__device__ __forceinline__ unsigned xb_ld(unsigned* p)              { return __hip_atomic_load(p, __ATOMIC_RELAXED, __HIP_MEMORY_SCOPE_AGENT); }
__device__ __forceinline__ unsigned xb_add(unsigned* p, unsigned v) { return __hip_atomic_fetch_add(p, v, __ATOMIC_RELAXED, __HIP_MEMORY_SCOPE_AGENT); }
#define XB_SPIN(cond, bar) do { unsigned _sp = 0; while (cond) { __builtin_amdgcn_s_sleep(1); \
    if ((++_sp & 255u) == 0u) { if (xb_ld(&(bar)[XB_TMO])) break; if (_sp > XB_SPIN_CAP) { atomicAdd(&(bar)[XB_TMO], 1u); break; } } } } while (0)
struct XcdBarrier { unsigned* bar; unsigned x; volatile LAS unsigned* st; };
__device__ __forceinline__ XcdBarrier xcd_barrier_post(unsigned* bar, volatile LAS unsigned* st) {
    XcdBarrier b; b.bar = bar; b.x = xcc_id(); b.st = st;
    if (threadIdx.x == 0) (void)xb_add(&bar[XB_XCNT(b.x)], 1u);
    return b;
}
__device__ __forceinline__ void xcd_barrier_complete(unsigned* bar, unsigned x, unsigned& nloc, unsigned& nx) {
    const unsigned G = gridDim.x * gridDim.y * gridDim.z;
    unsigned sum, cnt, mine, sp = 0u;
    for (;;) {
        sum = 0u; cnt = 0u; mine = 0u;
#pragma unroll
        for (unsigned j = 0; j < 16; ++j) { const unsigned c = xb_ld(&bar[XB_XCNT(j)]); sum += c; cnt += (c > 0u) ? 1u : 0u; mine = (j == x) ? c : mine; }
        if (sum == G) break;
        __builtin_amdgcn_s_sleep(1);
        if ((++sp & 255u) == 0u) { if (xb_ld(&bar[XB_TMO])) break; if (sp > XB_SPIN_CAP) { atomicAdd(&bar[XB_TMO], 1u); break; } }
    }
    nloc = mine > 0u ? mine : 1u; nx = cnt > 0u ? cnt : 1u;
}
__device__ __forceinline__ void xcd_barrier(const XcdBarrier& b) {
    asm volatile("s_waitcnt vmcnt(0)" ::: "memory");
    __syncthreads();
    if (threadIdx.x == 0) {
        unsigned* bar = b.bar;
        __builtin_amdgcn_s_waitcnt(0);
        unsigned nloc = b.st[0], nx = b.st[1];
        if (nloc == 0u) { xcd_barrier_complete(bar, b.x, nloc, nx); b.st[0] = nloc; b.st[1] = nx; }
        const unsigned old = xb_add(&bar[XB_XSUB(b.x)], 1u);
        const unsigned gen = old / nloc;
        if (old + 1u == (gen + 1u) * nloc) {
            __builtin_amdgcn_fence(__ATOMIC_RELEASE, "agent");
            asm volatile("s_waitcnt vmcnt(0)" ::: "memory");
            const unsigned og = xb_add(&bar[XB_TOP], 1u);
            const unsigned tg = og / nx;
            if (og + 1u == (tg + 1u) * nx) xb_add(&bar[XB_TOPGEN], 1u);
            else XB_SPIN(xb_ld(&bar[XB_TOPGEN]) == tg, bar);
            __builtin_amdgcn_fence(__ATOMIC_ACQUIRE, "agent");
            xb_add(&bar[XB_XGEN(b.x)], 1u);
            asm volatile("s_waitcnt vmcnt(0)" ::: "memory");
        } else {
            XB_SPIN(xb_ld(&bar[XB_XGEN(b.x)]) == gen, bar);
            __builtin_amdgcn_fence(__ATOMIC_ACQUIRE, "agent");
            asm volatile("s_waitcnt vmcnt(0)" ::: "memory");
        }
    }
    __syncthreads();
}

__global__ void __launch_bounds__(NTHR, 2) fwd_megakernel(Params P) {
    extern __shared__ __attribute__((aligned(16))) unsigned char shm[];
    LAS unsigned char* lds = (LAS unsigned char*)shm;
    cg::grid_group grid = cg::this_grid();
    const int G = gridDim.x, bid = blockIdx.x;
    volatile LAS unsigned* xst = (volatile LAS unsigned*)(lds + LDS_BYTES - 128);
    if (threadIdx.x == 0) { xst[0] = 0u; xst[1] = 0u; }
    __syncthreads();
    const XcdBarrier xb = xcd_barrier_post((unsigned*)(P.ws + OFF_BAR), xst);

#ifndef P3
#define P3 0xff
#endif
#ifndef PH
#define PH 0xff
#endif
    if (PH & 1) phase0a(P, lds);
    grid.sync();
    if (PH & 2) phase0b(P);
    xcd_barrier(xb);
    if (PH & 4) {
        pg8::Gemm g; g.A = (const bf16_t*)(P.ws + OFF_H); g.Bt = (const bf16_t*)(P.ws + OFF_WIN); g.M = NTOK; g.N = INCOLS; { int k_ = 512; asm volatile("" : "+s"(k_)); g.K = k_; g.lda = k_; }
        pg8::StaticOrder S; S.init(NTOK, INCOLS, G, bid);
        EpiProj E; E.ws = P.ws; E.lb = (const float*)(P.ws + OFF_LB); E.ng = P.hgrn_ng; E.kmean = (float*)(P.ws + OFF_KMEAN);
        pg8::gemm_phase<EpiProj, pg8::StaticOrder, true>(lds, g, S, E);
    }
    xcd_barrier(xb);
    if (PH & 8) for (int it = bid; it < 256; it += G) hgrn_item(P, it, lds);
    if (PH & 16) for (int u = bid; u < 2048; u += G) { const int bh = u & 255, jj = u >> 8; moba_unit(P, bh >> 3, bh & 7, (jj + bh) & 7, lds); }
    xcd_barrier(xb);
    if ((PH & 32) && bid < NTOK / 256) { const int pm = bid;
        if (P3 & 1) yb_norm_panel(P, pm);
        __syncthreads();
        if (P3 & 2) { pg8::Gemm g; g.A = (const bf16_t*)(P.ws + OFF_EG); g.Bt = (const bf16_t*)(P.ws + OFF_WBA); g.M = NTOK; g.N = 1024; { int k_ = 256; asm volatile("" : "+s"(k_)); g.K = k_; } g.lda = 512;
          pg8::PanelOrder S; S.pm = pm; S.npn = 4; EpiMixA E; E.GA = (bf16_t*)(P.ws + OFF_GA);
          pg8::gemm_phase<EpiMixA, pg8::PanelOrder, true>(lds, g, S, E); }
        __syncthreads();
        if (P3 & 4) { pg8::Gemm g; g.A = (const bf16_t*)(P.ws + OFF_EG + 512); g.Bt = (const bf16_t*)(P.ws + OFF_WBB); g.M = NTOK; g.N = 1024; { int k_ = 256; asm volatile("" : "+s"(k_)); g.K = k_; } g.lda = 512;
          pg8::PanelOrder S; S.pm = pm; S.npn = 4; EpiMixB E; E.GA = (const bf16_t*)(P.ws + OFF_GA); E.GB = (const bf16_t*)(P.ws + OFF_GB); E.M8 = P.ws + OFF_QA;
          pg8::gemm_phase<EpiMixB, pg8::PanelOrder, true>(lds, g, S, E); }
        __syncthreads();
        if (P3 & 8) { pg8::Gemm g; g.A = (const bf16_t*)(P.ws + OFF_QA); g.Bt = (const bf16_t*)(P.ws + OFF_WOUT); g.M = NTOK; g.N = 1024; { int k_ = 512; asm volatile("" : "+s"(k_)); g.K = k_; g.lda = k_; }
          pg8::PanelOrder S; S.pm = pm; S.npn = 4; EpiOut E; E.ada = (const float*)(P.ws + OFF_ADA); E.D = (bf16_t*)(P.ws + OFF_GB);
          pg8::gemm_phase<EpiOut, pg8::PanelOrder, true>(lds, g, S, E); }
        __syncthreads();
        if (P3 & 16) ln1_panel(P, pm);
        __syncthreads();
        if (P3 & 32) { pg8::Gemm g; g.A = (const bf16_t*)(P.ws + OFF_H); g.Bt = (const bf16_t*)(P.ws + OFF_WQ); g.M = NTOK; g.N = 1024; g.K = 1024; g.lda = 1024;
          pg8::PanelOrder S; S.pm = pm; S.npn = 4; EpiBf16 E; E.O = (bf16_t*)(P.ws + OFF_GB);
          pg8::gemm_phase<EpiBf16, pg8::PanelOrder>(lds, g, S, E); }
        __syncthreads();
        { const size_t tok0 = (size_t)pm * 256 + (tid_opaque() >> 6) * 32;
          peer_select_wave(P, tok0);
          __syncthreads();
#pragma unroll 1
          for (int sb = 0; sb < 4; ++sb) {
              peer_u_tokens(P, lds, tok0 + 8 * sb);
              __syncthreads();
              peer_v_tokens(P, lds, tok0 + 8 * sb);
              __syncthreads();
          } }
    }
}

extern "C" void kernel_launch(void* const* d_in, const int* in_sizes, int n_in, void* d_out, int out_size, void* d_ws, size_t ws_size, hipStream_t stream) {
    static int grid_blocks = 0;
    if (grid_blocks == 0) {
        if (n_in != 18 || out_size != NTOK * DM || ws_size < WS_END) { fprintf(stderr, "kernel_launch: unexpected shapes (n_in %d, out %d, ws %zu, need %zu)\n", n_in, out_size, ws_size, (size_t)WS_END); grid_blocks = -1; return; }
        int dev = 0, cus = 0, per_cu = 0;
        hipGetDevice(&dev);
        hipDeviceGetAttribute(&cus, hipDeviceAttributeMultiprocessorCount, dev);
        if (hipFuncSetAttribute((const void*)fwd_megakernel, hipFuncAttributeMaxDynamicSharedMemorySize, LDS_BYTES) != hipSuccess) fprintf(stderr, "kernel_launch: hipFuncSetAttribute failed\n");
        hipOccupancyMaxActiveBlocksPerMultiprocessor(&per_cu, (const void*)fwd_megakernel, NTHR, LDS_BYTES);
        if (per_cu < 1) { fprintf(stderr, "kernel_launch: occupancy query says %d blocks per CU\n", per_cu); per_cu = 1; }
        if (per_cu > 1) per_cu = 1;
        grid_blocks = cus * per_cu;
        if (grid_blocks != NTOK / 256) { fprintf(stderr, "kernel_launch: built for a %d-CU device (one 256-token panel per workgroup), found %d\n", NTOK / 256, grid_blocks); grid_blocks = -1; return; }
        (void)hipGetLastError();
    }
    if (grid_blocks < 0) return;
    Params p{};
    p.x = (const float*)d_in[0]; p.c = (const float*)d_in[1]; p.w_ada = (const float*)d_in[2]; p.b_ada = (const float*)d_in[3]; p.w_in = (const float*)d_in[4];
    p.w_ba = (const float*)d_in[5]; p.w_bb = (const float*)d_in[6]; p.w_out = (const float*)d_in[7]; p.hgrn_lb = (const float*)d_in[8]; p.hgrn_ng = (const float*)d_in[9];
    p.ln1_g = (const float*)d_in[10]; p.ln1_b = (const float*)d_in[11]; p.peer_wq = (const float*)d_in[12]; p.peer_sk = (const float*)d_in[13]; p.peer_u = (const float*)d_in[14];
    p.peer_v = (const float*)d_in[15]; p.ln2_g = (const float*)d_in[16]; p.ln2_b = (const float*)d_in[17];
    p.out = (float*)d_out; p.ws = (unsigned char*)d_ws;
    if (hipMemsetAsync((char*)d_ws + OFF_BAR, 0, XCD_BAR_WORDS * 4, stream) != hipSuccess) fprintf(stderr, "kernel_launch: memset of the barrier words failed\n");
    void* args[] = {&p};
    hipError_t e = hipLaunchCooperativeKernel((const void*)fwd_megakernel, dim3(grid_blocks), dim3(NTHR), args, LDS_BYTES, stream);
    if (e != hipSuccess) fprintf(stderr, "cooperative launch failed: %s (grid %d)\n", hipGetErrorString(e), grid_blocks);
}
```

```cpp
#include <hip/hip_runtime.h>
#include <hip/hip_cooperative_groups.h>
#include <cstdio>
#include <cstdint>
#include <type_traits>
namespace cg = cooperative_groups;

#define LAS __attribute__((address_space(3)))
typedef unsigned short bf16_t;
typedef short bf16x8 __attribute__((ext_vector_type(8)));
typedef short s16x4 __attribute__((ext_vector_type(4)));
typedef float f32x2 __attribute__((ext_vector_type(2)));
typedef float f32x4 __attribute__((ext_vector_type(4)));
typedef float f32x16 __attribute__((ext_vector_type(16)));
typedef unsigned u32x2 __attribute__((ext_vector_type(2)));
typedef unsigned u32x4 __attribute__((ext_vector_type(4)));

constexpr int NB = 32, SEQ = 2048, DM = 1024, NTOK = NB * SEQ;
constexpr int INCOLS = 5632;
constexpr int NTHR = 512;
constexpr int LDS_BYTES = 147456;
constexpr float ALPHA = 1.189207115002721f;
constexpr float LN_EPS = 1e-5f, RMS_EPS = 1e-6f;
constexpr float LOG2E = 1.4426950408889634f;

constexpr size_t SZ_T512 = (size_t)NTOK * 512 * 2, SZ_T1024 = (size_t)NTOK * 1024 * 2;
constexpr size_t OFF_ADA = 0;
constexpr size_t OFF_LB = OFF_ADA + 786432;
constexpr size_t OFF_KMEAN = OFF_LB + 4096;
constexpr size_t OFF_WIN = OFF_KMEAN + 524288;
constexpr size_t OFF_WBA = OFF_WIN + (size_t)5632 * 1024 * 2;
constexpr size_t OFF_WBB = OFF_WBA + 1048576;
constexpr size_t OFF_WOUT = OFF_WBB + 1048576;
constexpr size_t OFF_WQ = OFF_WOUT + 2097152;
constexpr size_t OFF_SK = OFF_WQ + 2097152;
constexpr size_t OFF_U8 = OFF_SK + 262144;
constexpr size_t OFF_USC = OFF_U8 + 8388608;
constexpr size_t OFF_V8 = OFF_U8 + 16777216;
constexpr size_t OFF_VSC = OFF_V8 + 8388608;
constexpr size_t OFF_CTR = OFF_V8 + 16777216;
constexpr size_t OFF_BAR = OFF_CTR + 4096;
constexpr size_t OFF_EG = OFF_BAR + 16384;
constexpr size_t OFF_H = OFF_EG + (size_t)NTOK * 128 * 8;
constexpr size_t OFF_QA = OFF_H + SZ_T1024;
constexpr size_t OFF_KA = OFF_QA + SZ_T512;
constexpr size_t OFF_VA = OFF_KA + SZ_T512;
constexpr size_t OFF_HQ = OFF_VA + SZ_T512;
constexpr size_t OFF_HK = OFF_HQ + SZ_T512;
constexpr size_t OFF_HI = OFF_HK + SZ_T512;
constexpr size_t OFF_HG = OFF_HI + SZ_T512;
constexpr size_t OFF_GA = OFF_HG + SZ_T512;
constexpr size_t OFF_GB = OFF_GA + SZ_T1024;
constexpr size_t WS_END = OFF_GB + SZ_T1024;
constexpr size_t OFF_H8 = OFF_VA;
constexpr size_t OFF_HS = OFF_HQ;
constexpr size_t OFF_W = OFF_KA;
constexpr size_t OFF_Y = OFF_KA;

struct Params {
    const float *x, *c, *w_ada, *b_ada, *w_in, *w_ba, *w_bb, *w_out, *hgrn_lb, *hgrn_ng, *ln1_g, *ln1_b, *peer_wq, *peer_sk, *peer_u, *peer_v, *ln2_g, *ln2_b;
    float* out;
    unsigned char* ws;
};

typedef __bf16 bf16v2 __attribute__((ext_vector_type(2)));
__device__ __forceinline__ unsigned cvt_pk_bf16(float lo, float hi) { return __builtin_bit_cast(unsigned, __builtin_convertvector((f32x2){lo, hi}, bf16v2)); }
__device__ __forceinline__ float bf_lo(unsigned w) { return __uint_as_float(w << 16); }
__device__ __forceinline__ float bf_hi(unsigned w) { return __uint_as_float(w & 0xffff0000u); }
__device__ __forceinline__ float sigmoidf_(float x) { return __builtin_amdgcn_rcpf(1.0f + __builtin_amdgcn_exp2f(-LOG2E * x)); }
__device__ __forceinline__ float wave_sum(float v) {
#pragma unroll
    for (int o = 1; o < 64; o <<= 1) v += __shfl_xor(v, o);
    return v;
}
__device__ __forceinline__ int tid_opaque() { int t = threadIdx.x; asm volatile("" : "+v"(t)); return t; }
__device__ __forceinline__ int crow(int r, int hi) { return (r & 3) + 8 * (r >> 2) + 4 * hi; }
#define MFMA32(a, b, c) __builtin_amdgcn_mfma_f32_32x32x16_bf16(a, b, c, 0, 0, 0)

namespace pg8 {
constexpr int BM = 256, BK = 64, HALF = 128, HTB = HALF * BK * 2, STAGE_BYTES = 8 * HTB, NXCD = 8, WGM = 8;
__host__ __device__ __forceinline__ int lds_byte(int r, int c) { const int st = (r >> 4) * 2 + (c >> 5), rr = r & 15, cc = c & 31, ob = rr * 64 + cc * 2; return st * 1024 + (ob ^ (((ob >> 9) & 1) << 5)); }
__host__ __device__ __forceinline__ void stage_rc(int b, int& R, int& C) { const int st = b / 1024, sb = b % 1024, swz = sb ^ (((sb >> 9) & 1) << 5); R = (st >> 1) * 16 + swz / 64; C = (st & 1) * 32 + (swz % 64) / 2; }
__host__ __device__ __forceinline__ int perm32(int rho) { const int n = rho >> 4, i = rho & 15; return 8 * (i >> 2) + 4 * n + (i & 3); }

struct Unit { int pm, pn; };
struct Gemm { const bf16_t* A; const bf16_t* Bt; int M, N, K, lda; };

struct StaticOrder {
    int nM, nN, nwg, G, c;
    __device__ void init(int M, int N, int G_, int c_) { nM = M / BM; nN = N / BM; nwg = nM * nN; G = G_; c = c_; }
    __device__ bool next(int i, Unit& u) const {
        const long L = (long)i * G + c; if (L >= nwg) return false;
        int wgid = (int)L; { const int q = nwg / NXCD, r = nwg % NXCD, xcd = wgid % NXCD, off = wgid / NXCD; wgid = (xcd < r ? xcd * (q + 1) : r * (q + 1) + (xcd - r) * q) + off; }
        const int nig = WGM * nN, gid = wgid / nig, fm = gid * WGM, gsz = (nM - fm) < WGM ? (nM - fm) : WGM;
        u.pm = fm + ((wgid % nig) % gsz); u.pn = (wgid % nig) / gsz; return true;
    }
};
struct PanelOrder {
    int pm, npn;
    __device__ bool next(int i, Unit& u) const { if (i >= npn) return false; u.pm = pm; u.pn = i; return true; }
};

template <class Epi, class Sched, bool MX = false>
__device__ __forceinline__ void gemm_phase(LAS unsigned char* lds, const Gemm g, const Sched& S, const Epi& E) {
    const int tid = tid_opaque(), wid = __builtin_amdgcn_readfirstlane(tid >> 6), lane = tid & 63, wr = wid >> 2, wc = wid & 3, fr = lane & 15, fq = lane >> 4;
    const int K = g.K, nt = K / BK;
    unsigned voffA, voffB;
    { int R, C; stage_rc(tid * 16, R, C); const int Rb = Epi::PERM ? ((R & ~31) + perm32(R & 31)) : R;
      voffA = (unsigned)(R * g.lda + C) * 2u; voffB = (unsigned)(Rb * K + C) * 2u; }
    const size_t rvoffA = (size_t)128 * g.lda, rvoffB = (size_t)128 * K;
    const size_t kstep = (size_t)(BK * 2);
    const size_t hstep = (size_t)HALF * K * 2;
    const size_t tstep = 2 * hstep;
    const size_t hstepA = (size_t)HALF * g.lda * 2, tstepA = 2 * hstepA;
    const unsigned ldsw = (unsigned)wid * 1024u;
    const int aoff = lds_byte(wr * 64 + fr, fq * 8), boff = lds_byte(wc * 32 + fr, fq * 8);
#define PG8_SA(b, h) (((b) * 2 + (h)) * HTB)
#define PG8_SB(b, h) ((4 + (b) * 2 + (h)) * HTB)
#define PG8_STAGE(bufoff, gbase, voff) do { unsigned vo_ = (voff); asm volatile("" : "+v"(vo_));     \
        _Pragma("unroll") for (int _i = 0; _i < 2; ++_i) \
        __builtin_amdgcn_global_load_lds((const unsigned*)((const char*)(gbase) + _i * r##voff + vo_), (LAS unsigned*)(lds + (bufoff) + ldsw + _i * 8192), 16, 0, 0); } while (0)
#define PG8_LDX(dst, off) do { const v4i_ lo_ = *(const LAS v4i_*)(lds + (off)), hi_ = *(const LAS v4i_*)(lds + (off) + 1024); dst = __builtin_shufflevector(lo_, hi_, 0, 1, 2, 3, 4, 5, 6, 7); } while (0)
#define PG8_LDA(dst, b, h) do { if constexpr (MX) { _Pragma("unroll") for (int m = 0; m < 4; ++m) PG8_LDX(dst##X[m], PG8_SA(b, h) + aoff + m * 2048); } \
        else { _Pragma("unroll") for (int m = 0; m < 4; ++m) _Pragma("unroll") for (int k = 0; k < 2; ++k) dst[m][k] = *(const LAS bf16x8*)(lds + PG8_SA(b, h) + aoff + m * 2048 + k * 1024); } } while (0)
#define PG8_LDB(dst, b, h) do { if constexpr (MX) { _Pragma("unroll") for (int n = 0; n < 2; ++n) PG8_LDX(dst##X[n], PG8_SB(b, h) + boff + n * 2048); } \
        else { _Pragma("unroll") for (int n = 0; n < 2; ++n) _Pragma("unroll") for (int k = 0; k < 2; ++k) dst[n][k] = *(const LAS bf16x8*)(lds + PG8_SB(b, h) + boff + n * 2048 + k * 1024); } } while (0)
#define PG8_MMA(ai, bj, At, Bt) do { __builtin_amdgcn_s_setprio(1); \
        if constexpr (MX) { _Pragma("unroll") for (int m = 0; m < 4; ++m) _Pragma("unroll") for (int n = 0; n < 2; ++n) \
            asm volatile("v_mfma_scale_f32_16x16x128_f8f6f4 %0, %1, %2, %0, %3, %4 op_sel_hi:[0,0,0]" : "+v"(acc[ai][bj][m][n]) : "v"(Bt##X[n]), "v"(At##X[m]), "v"(mxscale), "v"(mxscale5)); } \
        else { _Pragma("unroll") for (int m = 0; m < 4; ++m) _Pragma("unroll") for (int n = 0; n < 2; ++n) _Pragma("unroll") for (int k = 0; k < 2; ++k) \
            acc[ai][bj][m][n] = __builtin_amdgcn_mfma_f32_16x16x32_bf16(Bt[n][k], At[m][k], acc[ai][bj][m][n], 0, 0, 0); } \
        __builtin_amdgcn_s_setprio(0); } while (0)
#define PG8_WAIT_V(n) asm volatile("s_waitcnt vmcnt(" #n ")" ::: "memory")
#define PG8_WAIT_L(n) asm volatile("s_waitcnt lgkmcnt(" #n ")" ::: "memory")
#define PG8_BAR __builtin_amdgcn_s_barrier()
#define PG8_SCHED __builtin_amdgcn_sched_barrier(0)
    Unit cur, nxt; int ui = 0;
    if (!S.next(0, cur)) return;
    f32x4 acc[2][2][4][2];
#pragma unroll
    for (int a = 0; a < 2; ++a)
#pragma unroll
        for (int b = 0; b < 2; ++b)
#pragma unroll
            for (int m = 0; m < 4; ++m)
#pragma unroll
                for (int n = 0; n < 2; ++n) acc[a][b][m][n] = (f32x4){0.f, 0.f, 0.f, 0.f};
    typedef int v4i_ __attribute__((ext_vector_type(4))); typedef int v8i_ __attribute__((ext_vector_type(8)));
    bf16x8 At[4][2], B0[2][2], B1[2][2];
    v8i_ AtX[4], B0X[2], B1X[2];
    const int mxscale = 0x7f7f7f7f, mxscale5 = 0x7a7a7a7a;
    const char* cA = (const char*)g.A + (size_t)cur.pm * tstepA; const char* cB = (const char*)g.Bt + (size_t)cur.pn * tstep;
    PG8_STAGE(PG8_SB(0, 0), cB, voffB); PG8_STAGE(PG8_SA(0, 0), cA, voffA); PG8_STAGE(PG8_SB(0, 1), cB + hstep, voffB); PG8_STAGE(PG8_SA(0, 1), cA + hstepA, voffA);
    if (wr == 1) PG8_BAR;
    PG8_WAIT_V(4); PG8_BAR;
    PG8_STAGE(PG8_SB(1, 0), cB + kstep, voffB); PG8_STAGE(PG8_SA(1, 0), cA + kstep, voffA); PG8_STAGE(PG8_SB(1, 1), cB + hstep + kstep, voffB);
    PG8_WAIT_V(6); PG8_BAR;
    for (;;) {
        const bool has_next = S.next(ui + 1, nxt);
        const char* nA = has_next ? (const char*)g.A + (size_t)nxt.pm * tstepA : cA; const char* nB = has_next ? (const char*)g.Bt + (size_t)nxt.pn * tstep : cB;
        for (int t = 0; t < nt; t += 2) {
            const bool last = (t == nt - 2);
            const char* a1 = cA + (size_t)(t + 1) * kstep;
            const char* a2 = last ? nA : cA + (size_t)(t + 2) * kstep; const char* b2 = last ? nB : cB + (size_t)(t + 2) * kstep;
            const char* a3 = a2 + kstep; const char* b3 = b2 + kstep;
            PG8_LDB(B0, 0, 0); PG8_SCHED; PG8_LDA(At, 0, 0); PG8_STAGE(PG8_SA(1, 1), a1 + hstepA, voffA);
            PG8_WAIT_L(8); PG8_BAR; PG8_WAIT_L(0); PG8_MMA(0, 0, At, B0); PG8_BAR; PG8_SCHED;
            PG8_LDB(B1, 0, 1); PG8_STAGE(PG8_SB(0, 0), b2, voffB);
            PG8_BAR; PG8_WAIT_L(0); PG8_MMA(0, 1, At, B1); PG8_BAR;
            PG8_LDA(At, 0, 1); PG8_STAGE(PG8_SA(0, 0), a2, voffA);
            PG8_BAR; PG8_WAIT_L(0); PG8_MMA(1, 0, At, B0); PG8_BAR; PG8_SCHED;
            PG8_STAGE(PG8_SB(0, 1), b2 + hstep, voffB);
            PG8_WAIT_V(6); PG8_BAR; PG8_MMA(1, 1, At, B1); PG8_BAR;
            PG8_LDB(B0, 1, 0); PG8_SCHED; PG8_LDA(At, 1, 0); PG8_STAGE(PG8_SA(0, 1), a2 + hstepA, voffA);
            PG8_WAIT_L(8); PG8_BAR; PG8_WAIT_L(0); PG8_MMA(0, 0, At, B0); PG8_BAR; PG8_SCHED;
            PG8_LDB(B1, 1, 1); PG8_STAGE(PG8_SB(1, 0), b3, voffB);
            PG8_BAR; PG8_WAIT_L(0); PG8_MMA(0, 1, At, B1); PG8_BAR;
            PG8_LDA(At, 1, 1); PG8_STAGE(PG8_SA(1, 0), a3, voffA);
            PG8_BAR; PG8_WAIT_L(0); PG8_MMA(1, 0, At, B0); PG8_BAR; PG8_SCHED;
            PG8_STAGE(PG8_SB(1, 1), b3 + hstep, voffB);
            PG8_WAIT_V(6); PG8_BAR; PG8_MMA(1, 1, At, B1); PG8_BAR;
        }
        if constexpr (MX) asm volatile("s_nop 15\n\ts_nop 15" ::: "memory");
        if (wr == 0) PG8_BAR;
        E(acc, cur, wr, wc, fr, fq);
        if (wr == 1) PG8_BAR;
        if (!has_next) break;
#pragma unroll
        for (int a = 0; a < 2; ++a)
#pragma unroll
            for (int b = 0; b < 2; ++b)
#pragma unroll
                for (int m = 0; m < 4; ++m)
#pragma unroll
                    for (int n = 0; n < 2; ++n) acc[a][b][m][n] = (f32x4){0.f, 0.f, 0.f, 0.f};
        cur = nxt; cA = nA; cB = nB; ++ui;
    }
    PG8_WAIT_V(0);
    if (wr == 0) PG8_BAR;
    PG8_BAR;
#undef PG8_SA
#undef PG8_SB
#undef PG8_STAGE
#undef PG8_LDX
#undef PG8_LDA
#undef PG8_LDB
#undef PG8_MMA
#undef PG8_WAIT_V
#undef PG8_WAIT_L
#undef PG8_BAR
#undef PG8_SCHED
}
}
using pg8::Unit;

struct EpiProj {
    static constexpr bool PERM = true;
    unsigned char* ws; const float* lb; const float* ng; float* kmean;
    __device__ __forceinline__ void operator()(const f32x4 (&acc)[2][2][4][2], const Unit& u, int wr, int wc, int fr, int fq) const {
        const int pn = u.pn; int seg, colt, ldc; size_t boff;
        if (pn < 14) { seg = pn >> 1; colt = (pn & 1) * 256; ldc = 512; boff = OFF_QA + (size_t)seg * SZ_T512; }
        else if (pn < 18) { seg = 7; colt = (pn - 14) * 256; ldc = 1024; boff = OFF_GA; }
        else { seg = 8; colt = (pn - 18) * 256; ldc = 1024; boff = OFF_GB; }
        bf16_t* base = (bf16_t*)(ws + boff);
        const int row0 = u.pm * 256 + wr * 64 + fr, col0 = colt + wc * 32 + 8 * fq;
        float pv[2][8];
#pragma unroll
        for (int bj = 0; bj < 2; ++bj)
#pragma unroll
            for (int e = 0; e < 8; ++e) pv[bj][e] = (seg == 4) ? (1.0f - lb[col0 + bj * 128 + e]) : ((seg == 6) ? ng[col0 + bj * 128 + e] : 0.f);
        float cs[2][8];
#pragma unroll
        for (int bj = 0; bj < 2; ++bj)
#pragma unroll
            for (int e = 0; e < 8; ++e) cs[bj][e] = 0.f;
#pragma unroll
        for (int ai = 0; ai < 2; ++ai)
#pragma unroll
            for (int m = 0; m < 4; ++m) {
                bf16_t* rowp = base + (size_t)(row0 + ai * 128 + m * 16) * ldc + col0;
#pragma unroll
                for (int bj = 0; bj < 2; ++bj) {
                    float v[8];
#pragma unroll
                    for (int e = 0; e < 4; ++e) { v[e] = acc[ai][bj][m][0][e]; v[4 + e] = acc[ai][bj][m][1][e]; }
                    if (seg == 0) {
#pragma unroll
                        for (int e = 0; e < 8; ++e) v[e] *= (0.125f * LOG2E);
                    } else if (seg == 1) {
#pragma unroll
                        for (int e = 0; e < 8; ++e) cs[bj][e] += v[e];
                    } else if (seg == 3) {
#pragma unroll
                        for (int e = 0; e < 8; ++e) v[e] = v[e] * sigmoidf_(v[e]);
                    } else if (seg == 4) {
#pragma unroll
                        for (int e = 0; e < 8; ++e) v[e] = pv[bj][e] * sigmoidf_(-v[e]);
                    } else if (seg == 6) {
#pragma unroll
                        for (int e = 0; e < 8; ++e) v[e] = pv[bj][e] * v[e] * sigmoidf_(v[e]);
                    } else if (seg >= 7) {
#pragma unroll
                        for (int e = 0; e < 8; ++e) v[e] = sigmoidf_(v[e]);
                    }
                    if (seg >= 7) {
                        int w0 = __builtin_amdgcn_cvt_pk_fp8_f32(v[0], v[1], 0, false); w0 = __builtin_amdgcn_cvt_pk_fp8_f32(v[2], v[3], w0, true);
                        int w1 = __builtin_amdgcn_cvt_pk_fp8_f32(v[4], v[5], 0, false); w1 = __builtin_amdgcn_cvt_pk_fp8_f32(v[6], v[7], w1, true);
                        *(u32x2*)((unsigned char*)rowp - col0 + bj * 128) = (u32x2){(unsigned)w0, (unsigned)w1};
                    } else {
                    u32x4 w; w.x = cvt_pk_bf16(v[0], v[1]); w.y = cvt_pk_bf16(v[2], v[3]); w.z = cvt_pk_bf16(v[4], v[5]); w.w = cvt_pk_bf16(v[6], v[7]);
                    *(u32x4*)(rowp + bj * 128) = w; }
                }
            }
        if (seg == 1) {
#pragma unroll
            for (int bj = 0; bj < 2; ++bj)
#pragma unroll
                for (int e = 0; e < 8; ++e) {
                    float s = cs[bj][e];
                    s += __shfl_xor(s, 1); s += __shfl_xor(s, 2); s += __shfl_xor(s, 4); s += __shfl_xor(s, 8);
                    if (fr == 0) atomicAdd(kmean + (size_t)u.pm * 512 + col0 + bj * 128 + e, s);
                }
        }
    }
};
__device__ __forceinline__ void fp8x8_to_f32(const u32x2 w, float (&f)[8]) {
    const f32x2 a = __builtin_amdgcn_cvt_pk_f32_fp8((int)w.x, false), b = __builtin_amdgcn_cvt_pk_f32_fp8((int)w.x, true), c = __builtin_amdgcn_cvt_pk_f32_fp8((int)w.y, false), d = __builtin_amdgcn_cvt_pk_f32_fp8((int)w.y, true);
    f[0] = a.x; f[1] = a.y; f[2] = b.x; f[3] = b.y; f[4] = c.x; f[5] = c.y; f[6] = d.x; f[7] = d.y;
}
struct EpiMixA {
    static constexpr bool PERM = true;
    unsigned char* GA;
    __device__ __forceinline__ void operator()(const f32x4 (&acc)[2][2][4][2], const Unit& u, int wr, int wc, int fr, int fq) const {
        asm volatile("" : "+v"(fr), "+v"(fq));
        const int row0 = u.pm * 256 + wr * 64 + fr, col0 = u.pn * 256 + wc * 32 + 8 * fq;
#pragma unroll
        for (int ai = 0; ai < 2; ++ai)
#pragma unroll
            for (int m = 0; m < 4; ++m) {
                unsigned char* rowp = GA + (size_t)(row0 + ai * 128 + m * 16) * 2048 + col0;
#pragma unroll
                for (int bj = 0; bj < 2; ++bj) {
                    float g[8]; fp8x8_to_f32(*(const u32x2*)(rowp + bj * 128), g);
                    const f32x4 a0 = acc[ai][bj][m][0], a1 = acc[ai][bj][m][1];
                    int w0 = __builtin_amdgcn_cvt_pk_fp8_f32(g[0] * a0[0], g[1] * a0[1], 0, false); w0 = __builtin_amdgcn_cvt_pk_fp8_f32(g[2] * a0[2], g[3] * a0[3], w0, true);
                    int w1 = __builtin_amdgcn_cvt_pk_fp8_f32(g[4] * a1[0], g[5] * a1[1], 0, false); w1 = __builtin_amdgcn_cvt_pk_fp8_f32(g[6] * a1[2], g[7] * a1[3], w1, true);
                    *(u32x2*)(rowp + bj * 128) = (u32x2){(unsigned)w0, (unsigned)w1};
                }
            }
    }
};
struct EpiMixB {
    static constexpr bool PERM = true;
    const unsigned char* GA; const unsigned char* GB; unsigned char* M8;
    __device__ __forceinline__ void operator()(const f32x4 (&acc)[2][2][4][2], const Unit& u, int wr, int wc, int fr, int fq) const {
        asm volatile("" : "+v"(fr), "+v"(fq));
        const int row0 = u.pm * 256 + wr * 64 + fr, col0 = u.pn * 256 + wc * 32 + 8 * fq;
#pragma unroll
        for (int ai = 0; ai < 2; ++ai)
#pragma unroll
            for (int m = 0; m < 4; ++m) {
                const size_t row = (size_t)(row0 + ai * 128 + m * 16);
#pragma unroll
                for (int bj = 0; bj < 2; ++bj) {
                    float g[8], pa[8]; fp8x8_to_f32(*(const u32x2*)(GB + row * 2048 + col0 + bj * 128), g); fp8x8_to_f32(*(const u32x2*)(GA + row * 2048 + col0 + bj * 128), pa);
                    const f32x4 a0 = acc[ai][bj][m][0], a1 = acc[ai][bj][m][1];
                    int w0 = __builtin_amdgcn_cvt_pk_fp8_f32(pa[0] + g[0] * a0[0], pa[1] + g[1] * a0[1], 0, false); w0 = __builtin_amdgcn_cvt_pk_fp8_f32(pa[2] + g[2] * a0[2], pa[3] + g[3] * a0[3], w0, true);
                    int w1 = __builtin_amdgcn_cvt_pk_fp8_f32(pa[4] + g[4] * a1[0], pa[5] + g[5] * a1[1], 0, false); w1 = __builtin_amdgcn_cvt_pk_fp8_f32(pa[6] + g[6] * a1[2], pa[7] + g[7] * a1[3], w1, true);
                    *(u32x2*)(M8 + row * 1024 + col0 + bj * 128) = (u32x2){(unsigned)w0, (unsigned)w1};
                }
            }
    }
};
struct EpiOut {
    static constexpr bool PERM = true;
    const float* ada; bf16_t* D;
    __device__ __forceinline__ void operator()(const f32x4 (&acc)[2][2][4][2], const Unit& u, int wr, int wc, int fr, int fq) const {
        const int row0 = u.pm * 256 + wr * 64 + fr, col0 = u.pn * 256 + wc * 32 + 8 * fq;
        const float* gt1 = ada + (size_t)(u.pm >> 3) * 6144 + 2048 + col0;
        f32x4 g[2][2];
#pragma unroll
        for (int bj = 0; bj < 2; ++bj) { g[bj][0] = *(const f32x4*)(gt1 + bj * 128); g[bj][1] = *(const f32x4*)(gt1 + bj * 128 + 4); }
#pragma unroll
        for (int ai = 0; ai < 2; ++ai)
#pragma unroll
            for (int m = 0; m < 4; ++m) {
                bf16_t* rowp = D + (size_t)(row0 + ai * 128 + m * 16) * 1024 + col0;
#pragma unroll
                for (int bj = 0; bj < 2; ++bj) {
                    const f32x4 a0 = acc[ai][bj][m][0] * g[bj][0], a1 = acc[ai][bj][m][1] * g[bj][1];
                    u32x4 w; w.x = cvt_pk_bf16(a0[0], a0[1]); w.y = cvt_pk_bf16(a0[2], a0[3]); w.z = cvt_pk_bf16(a1[0], a1[1]); w.w = cvt_pk_bf16(a1[2], a1[3]);
                    *(u32x4*)(rowp + bj * 128) = w;
                }
            }
    }
};
struct EpiBf16 {
    static constexpr bool PERM = true;
    bf16_t* O;
    __device__ __forceinline__ void operator()(const f32x4 (&acc)[2][2][4][2], const Unit& u, int wr, int wc, int fr, int fq) const {
        const int row0 = u.pm * 256 + wr * 64 + fr, col0 = u.pn * 256 + wc * 32 + 8 * fq;
#pragma unroll
        for (int ai = 0; ai < 2; ++ai)
#pragma unroll
            for (int m = 0; m < 4; ++m) {
                bf16_t* rowp = O + (size_t)(row0 + ai * 128 + m * 16) * 1024 + col0;
#pragma unroll
                for (int bj = 0; bj < 2; ++bj) {
                    const f32x4 a0 = acc[ai][bj][m][0], a1 = acc[ai][bj][m][1];
                    u32x4 w; w.x = cvt_pk_bf16(a0[0], a0[1]); w.y = cvt_pk_bf16(a0[2], a0[3]); w.z = cvt_pk_bf16(a1[0], a1[1]); w.w = cvt_pk_bf16(a1[2], a1[3]);
                    *(u32x4*)(rowp + bj * 128) = w;
                }
            }
    }
};

__device__ void phase0a(const Params& P, LAS unsigned char* lds) {
    const int tid = tid_opaque(), G = gridDim.x, bid = blockIdx.x;
    for (int it = bid; it < 192; it += G) {
        LAS float* sc = (LAS float*)lds;
        for (int i = tid; i < 32 * 1024; i += NTHR) { const float cv = P.c[i]; sc[i] = cv * sigmoidf_(cv); }
        __syncthreads();
        const int kg = tid >> 5, col = tid & 31;
        float a[32];
#pragma unroll
        for (int b = 0; b < 32; ++b) a[b] = 0.f;
#pragma unroll 1
        for (int k = kg * 64; k < kg * 64 + 64; k += 8) {
            float w[8];
#pragma unroll
            for (int e = 0; e < 8; ++e) w[e] = __builtin_nontemporal_load(P.w_ada + (size_t)(k + e) * 6144 + it * 32 + col);
#pragma unroll
            for (int e4 = 0; e4 < 2; ++e4) {
#pragma unroll
                for (int b = 0; b < 32; ++b) { const f32x4 s = *(const LAS f32x4*)(sc + b * 1024 + k + 4 * e4); a[b] += s[0] * w[4 * e4] + s[1] * w[4 * e4 + 1] + s[2] * w[4 * e4 + 2] + s[3] * w[4 * e4 + 3]; }
                asm volatile("" ::: "memory");
            }
        }
        __syncthreads();
        LAS float* red = (LAS float*)lds;
#pragma unroll
        for (int b = 0; b < 32; ++b) red[(kg * 32 + b) * 32 + col] = a[b];
        __syncthreads();
        for (int o = tid; o < 1024; o += NTHR) { const int b = o >> 5, cc = o & 31; float s = 0.f;
#pragma unroll
            for (int g2 = 0; g2 < 16; ++g2) s += red[(g2 * 32 + b) * 32 + cc];
            ((float*)(P.ws + OFF_ADA))[(size_t)b * 6144 + it * 32 + cc] = s + P.b_ada[it * 32 + cc]; }
        __syncthreads();
    }
    const size_t gsz = (size_t)G * NTHR;
    { const int gt = bid * NTHR + tid, gs = G * NTHR;
      if (gt < 512) ((float*)(P.ws + OFF_LB))[gt] = sigmoidf_(P.hgrn_lb[gt] - P.hgrn_lb[512 + gt]);
      for (int i = gt; i < 32 * 8 * 512; i += gs) ((float*)(P.ws + OFF_KMEAN))[i] = 0.f; }
    {
        LAS float* tile = (LAS float*)lds;
        const int I0 = 16 * 88, I1 = I0 + 8 * 16, I2 = I1 + 8 * 16, I3 = I2 + 16 * 16, I4 = I3 + 16 * 16;
        for (int it = bid; it < I4; it += G) {
            const float* W; bf16_t* WT; int K, N, r;
            if (it < I0) { W = P.w_in; WT = (bf16_t*)(P.ws + OFF_WIN); K = 1024; N = 5632; r = it; }
            else if (it < I1) { W = P.w_ba; WT = (bf16_t*)(P.ws + OFF_WBA); K = 512; N = 1024; r = it - I0; }
            else if (it < I2) { W = P.w_bb; WT = (bf16_t*)(P.ws + OFF_WBB); K = 512; N = 1024; r = it - I1; }
            else if (it < I3) { W = P.w_out; WT = (bf16_t*)(P.ws + OFF_WOUT); K = 1024; N = 1024; r = it - I2; }
            else { W = P.peer_wq; WT = (bf16_t*)(P.ws + OFF_WQ); K = 1024; N = 1024; r = it - I3; }
            const int nb = N / 64, k0 = (r / nb) * 64, n0 = (r % nb) * 64;
#pragma unroll
            for (int ps = 0; ps < 2; ++ps) { const int kk = (tid >> 4) + 32 * ps, n4 = (tid & 15) * 4;
                const f32x4 v = *(const f32x4*)(W + (size_t)(k0 + kk) * N + n0 + n4);
                tile[kk * 65 + n4] = v[0]; tile[kk * 65 + n4 + 1] = v[1]; tile[kk * 65 + n4 + 2] = v[2]; tile[kk * 65 + n4 + 3] = v[3]; }
            __syncthreads();
            { const int n = tid >> 3, kc = (tid & 7) * 8;
              if (it < I3) {
                  int w0 = __builtin_amdgcn_cvt_pk_fp8_f32(32.f * tile[(kc + 0) * 65 + n], 32.f * tile[(kc + 1) * 65 + n], 0, false); w0 = __builtin_amdgcn_cvt_pk_fp8_f32(32.f * tile[(kc + 2) * 65 + n], 32.f * tile[(kc + 3) * 65 + n], w0, true);
                  int w1 = __builtin_amdgcn_cvt_pk_fp8_f32(32.f * tile[(kc + 4) * 65 + n], 32.f * tile[(kc + 5) * 65 + n], 0, false); w1 = __builtin_amdgcn_cvt_pk_fp8_f32(32.f * tile[(kc + 6) * 65 + n], 32.f * tile[(kc + 7) * 65 + n], w1, true);
                  *(u32x2*)((unsigned char*)WT + (size_t)(n0 + n) * K + k0 + kc) = (u32x2){(unsigned)w0, (unsigned)w1};
              } else { u32x4 w;
              w.x = cvt_pk_bf16(tile[(kc + 0) * 65 + n], tile[(kc + 1) * 65 + n]); w.y = cvt_pk_bf16(tile[(kc + 2) * 65 + n], tile[(kc + 3) * 65 + n]);
              w.z = cvt_pk_bf16(tile[(kc + 4) * 65 + n], tile[(kc + 5) * 65 + n]); w.w = cvt_pk_bf16(tile[(kc + 6) * 65 + n], tile[(kc + 7) * 65 + n]);
              *(u32x4*)(WT + (size_t)(n0 + n) * K + k0 + kc) = w; } }
            __syncthreads();
        }
    }
    {
        const size_t gtid = (size_t)bid * NTHR + tid_opaque();
        for (size_t i = gtid; i < 16384; i += gsz) {
            const float* src = P.peer_sk + i * 8; const f32x4 a = *(const f32x4*)src, b = *(const f32x4*)(src + 4);
            u32x4 w; w.x = cvt_pk_bf16(a[0], a[1]); w.y = cvt_pk_bf16(a[2], a[3]); w.z = cvt_pk_bf16(b[0], b[1]); w.w = cvt_pk_bf16(b[2], b[3]);
            *(u32x4*)((bf16_t*)(P.ws + OFF_SK) + i * 8) = w;
        }
        { const int lane = tid & 63, gw = bid * 8 + (tid >> 6), ngw = G * 8;
          for (int r = gw; r < 2 * 16384; r += ngw) {
              const bool isv = r >= 16384; const int e = isv ? r - 16384 : r;
              const float* s = (isv ? P.peer_v : P.peer_u) + (size_t)e * 1024 + lane * 16;
              f32x4 x[4]; float ss = 0.f;
#pragma unroll
              for (int q = 0; q < 4; ++q) { x[q] = __builtin_nontemporal_load((const f32x4*)(s + 4 * q)); ss += (x[q][0] * x[q][0] + x[q][1] * x[q][1]) + (x[q][2] * x[q][2] + x[q][3] * x[q][3]); }
              const float sc = fmaxf(sqrtf(wave_sum(ss) * (1.0f / 1024.0f)) * (2.6f / 7.5f), 1e-30f), inv = 1.0f / sc;
              unsigned nb[16];
#pragma unroll
              for (int q = 0; q < 4; ++q)
#pragma unroll
                  for (int el = 0; el < 4; ++el) nb[4 * q + el] = (unsigned)fminf(fmaxf(floorf(x[q][el] * inv) + 8.0f, 0.0f), 15.0f);
              u32x2 w;
              w.x = (nb[0] | (nb[4] << 4)) | ((nb[1] | (nb[5] << 4)) << 8) | ((nb[2] | (nb[6] << 4)) << 16) | ((nb[3] | (nb[7] << 4)) << 24);
              w.y = (nb[8] | (nb[12] << 4)) | ((nb[9] | (nb[13] << 4)) << 8) | ((nb[10] | (nb[14] << 4)) << 16) | ((nb[11] | (nb[15] << 4)) << 24);
              if (!isv) { w.x ^= 0x88888888u; w.y ^= 0x88888888u; }
              else { w.x ^= 0x80808080u; w.y ^= 0x80808080u; }
              *(u32x2*)(P.ws + (isv ? OFF_V8 : OFF_U8) + (size_t)e * 512 + lane * 8) = w;
              if (lane == 0) ((float*)(P.ws + (isv ? OFF_VSC : OFF_USC)))[e] = sc;
          } }
    }
}
__device__ void phase0b(const Params& P) {
    const size_t gtid = (size_t)blockIdx.x * NTHR + threadIdx.x, gsz = (size_t)gridDim.x * NTHR;
    const float* ada = (const float*)(P.ws + OFF_ADA); bf16_t* H = (bf16_t*)(P.ws + OFF_H);
    for (size_t i = gtid; i < (size_t)NTOK * 128; i += gsz) {
        const size_t row = i >> 7; const int c8 = (int)(i & 127) * 8; const int b = (int)(row >> 11);
        const float* xr = P.x + row * 1024 + c8; const float* sh = ada + (size_t)b * 6144 + c8; const float* sc = sh + 1024;
        const f32x4 x0 = *(const f32x4*)xr, x1 = *(const f32x4*)(xr + 4), s0 = *(const f32x4*)sc, s1 = *(const f32x4*)(sc + 4), h0 = *(const f32x4*)sh, h1 = *(const f32x4*)(sh + 4);
        const f32x4 r0 = x0 * (s0 + 1.0f) + h0, r1 = x1 * (s1 + 1.0f) + h1;
        int w0 = __builtin_amdgcn_cvt_pk_fp8_f32(r0[0], r0[1], 0, false); w0 = __builtin_amdgcn_cvt_pk_fp8_f32(r0[2], r0[3], w0, true);
        int w1 = __builtin_amdgcn_cvt_pk_fp8_f32(r1[0], r1[1], 0, false); w1 = __builtin_amdgcn_cvt_pk_fp8_f32(r1[2], r1[3], w1, true);
        *(u32x2*)((unsigned char*)H + row * 1024 + c8) = (u32x2){(unsigned)w0, (unsigned)w1};
    }
}

__device__ __forceinline__ s16x4 tr4(const LAS unsigned char* p) { return __builtin_bit_cast(s16x4, __builtin_amdgcn_ds_read_tr16_b64_v4i16((LAS s16x4*)p)); }
__device__ void hgrn_item(const Params& P, int item, LAS unsigned char* lds) {
    const int tid = tid_opaque(), lane = tid & 63, wid = __builtin_amdgcn_readfirstlane(tid >> 6), r32 = lane & 31, hi = lane >> 5;
    const int b = item >> 3, h = (item >> 1) & 3, vh = item & 1;
    const bf16_t* HQ = (const bf16_t*)(P.ws + OFF_HQ); const bf16_t* HK = (const bf16_t*)(P.ws + OFF_HK); bf16_t* HI = (bf16_t*)(P.ws + OFF_HI);
    constexpr int SQ = 272, SKD = 320, SV = 192, SS = 192;
    constexpr int LQR = 0, LKR = 17408, LQB = 34816, LKD = 52224, LV = 72704, LS = 84992, LG = 109568, LT = 142336, LCL = 144384;
    LAS float* G = (LAS float*)(lds + LG); LAS float* TOT = (LAS float*)(lds + LT); LAS float* CL = (LAS float*)(lds + LCL);
    const size_t rowb = (size_t)b * SEQ;
    const int row = tid >> 3, seg = tid & 7;
    const bf16_t* qsrc = HQ + (rowb + row) * 512 + h * 128 + seg * 16; const bf16_t* ksrc = HK + (rowb + row) * 512 + h * 128 + seg * 16;
    bf16_t* vsrc = HI + (rowb + row) * 512 + h * 128 + vh * 64 + seg * 8;
    for (int i = tid; i < 128 * SS / 4; i += NTHR) ((LAS unsigned*)(lds + LS))[i] = 0u;
    f32x16 Sacc = {};
    const int di = wid >> 1, vi = wid & 1, ti = wid >> 1;
    const int tg = lane >> 4, tc = tg & 1, tI = lane & 15;
    const int trow = 4 * hi + (tI >> 2), tcol = 16 * tc + 4 * (tI & 3);
    u32x4 qn0 = *(const u32x4*)qsrc, qn1 = *(const u32x4*)(qsrc + 8), kn0 = *(const u32x4*)ksrc, kn1 = *(const u32x4*)(ksrc + 8), vn = *(const u32x4*)vsrc;
#pragma unroll 1
    for (int n = 0; n < SEQ / 64; ++n) {
        const u32x4 q0 = qn0, q1 = qn1, k0 = kn0, k1 = kn1, vv = vn;
        float qf[16] = {bf_lo(q0.x), bf_hi(q0.x), bf_lo(q0.y), bf_hi(q0.y), bf_lo(q0.z), bf_hi(q0.z), bf_lo(q0.w), bf_hi(q0.w), bf_lo(q1.x), bf_hi(q1.x), bf_lo(q1.y), bf_hi(q1.y), bf_lo(q1.z), bf_hi(q1.z), bf_lo(q1.w), bf_hi(q1.w)};
        float kf[16] = {bf_lo(k0.x), bf_hi(k0.x), bf_lo(k0.y), bf_hi(k0.y), bf_lo(k0.z), bf_hi(k0.z), bf_lo(k0.w), bf_hi(k0.w), bf_lo(k1.x), bf_hi(k1.x), bf_lo(k1.y), bf_hi(k1.y), bf_lo(k1.z), bf_hi(k1.z), bf_lo(k1.w), bf_hi(k1.w)};
#pragma unroll
        for (int e4 = 0; e4 < 4; ++e4) *(LAS f32x4*)(G + row * 128 + seg * 16 + 4 * e4) = (f32x4){__logf(1.0f - kf[4 * e4]), __logf(1.0f - kf[4 * e4 + 1]), __logf(1.0f - kf[4 * e4 + 2]), __logf(1.0f - kf[4 * e4 + 3])};
        *(LAS u32x4*)(lds + LV + row * SV + seg * 16) = vv;
        if (n + 1 < SEQ / 64) { const size_t o = (size_t)(n + 1) * 64 * 512; qn0 = *(const u32x4*)(qsrc + o); qn1 = *(const u32x4*)(qsrc + o + 8); kn0 = *(const u32x4*)(ksrc + o); kn1 = *(const u32x4*)(ksrc + o + 8); vn = *(const u32x4*)(vsrc + o); }
        __syncthreads();
        { const int d = tid & 127, q4 = tid >> 7; float s = 0.f;
#pragma unroll
          for (int i = 0; i < 16; ++i) { s += G[(16 * q4 + i) * 128 + d]; G[(16 * q4 + i) * 128 + d] = s; }
          TOT[q4 * 128 + d] = s; }
        __syncthreads();
        {
            const int qq = row >> 4;
#pragma unroll
            for (int e4 = 0; e4 < 4; ++e4) {
                const int d4 = seg * 16 + 4 * e4;
                const f32x4 t0 = *(const LAS f32x4*)(TOT + d4), t1 = *(const LAS f32x4*)(TOT + 128 + d4), t2 = *(const LAS f32x4*)(TOT + 256 + d4), t3 = *(const LAS f32x4*)(TOT + 384 + d4);
                const f32x4 off = (qq == 0) ? (f32x4){0.f, 0.f, 0.f, 0.f} : ((qq == 1) ? t0 : ((qq == 2) ? t0 + t1 : t0 + t1 + t2));
                const f32x4 bb = *(const LAS f32x4*)(G + row * 128 + d4) + off;
                const f32x4 bref = *(const LAS f32x4*)(G + 32 * 128 + d4) + t0 + t1, blast = t0 + t1 + t2 + t3;
                float vqb[4], vqr[4], vkr[4], vkd[4];
#pragma unroll
                for (int e = 0; e < 4; ++e) {
                    const float e1 = __expf(bb[e]), e2 = __expf(-bb[e]);
                    vqb[e] = qf[4 * e4 + e] * e1; vqr[e] = vqb[e] * __expf(-bref[e]);
                    const float ke = kf[4 * e4 + e] * e2; vkr[e] = ke * __expf(bref[e]); vkd[e] = ke * __expf(blast[e]);
                }
                *(LAS u32x2*)(lds + LQB + row * SQ + seg * 32 + 8 * e4) = (u32x2){cvt_pk_bf16(vqb[0], vqb[1]), cvt_pk_bf16(vqb[2], vqb[3])};
                *(LAS u32x2*)(lds + LQR + row * SQ + seg * 32 + 8 * e4) = (u32x2){cvt_pk_bf16(vqr[0], vqr[1]), cvt_pk_bf16(vqr[2], vqr[3])};
                *(LAS u32x2*)(lds + LKR + row * SQ + seg * 32 + 8 * e4) = (u32x2){cvt_pk_bf16(vkr[0], vkr[1]), cvt_pk_bf16(vkr[2], vkr[3])};
                *(LAS u32x2*)(lds + LKD + row * SKD + seg * 32 + 8 * e4) = (u32x2){cvt_pk_bf16(vkd[0], vkd[1]), cvt_pk_bf16(vkd[2], vkd[3])};
                if (row == 0) *(LAS f32x4*)(CL + d4) = (f32x4){__expf(blast[0]), __expf(blast[1]), __expf(blast[2]), __expf(blast[3])};
                asm volatile("" ::: "memory");
            }
        }
        __syncthreads();
        if (wid < 4) {
            f32x16 Z = {};
            for (int si = 0; si <= ti; ++si) {
                f32x16 X = {};
#pragma unroll
                for (int ks = 0; ks < 8; ++ks) {
                    const bf16x8 a = *(const LAS bf16x8*)(lds + LKR + (32 * si + r32) * SQ + (16 * ks + 8 * hi) * 2);
                    const bf16x8 bq = *(const LAS bf16x8*)(lds + LQR + (32 * ti + r32) * SQ + (16 * ks + 8 * hi) * 2);
                    X = MFMA32(a, bq, X);
                }
                if (si == ti) {
#pragma unroll
                    for (int r = 0; r < 16; ++r) if (crow(r, hi) > r32) X[r] = 0.f;
                }
#pragma unroll
                for (int s2 = 0; s2 < 2; ++s2) {
                    union { u32x4 u; bf16x8 v; } pa;
                    pa.u.x = cvt_pk_bf16(X[8 * s2 + 0], X[8 * s2 + 1]); pa.u.y = cvt_pk_bf16(X[8 * s2 + 2], X[8 * s2 + 3]); pa.u.z = cvt_pk_bf16(X[8 * s2 + 4], X[8 * s2 + 5]); pa.u.w = cvt_pk_bf16(X[8 * s2 + 6], X[8 * s2 + 7]);
                    const LAS unsigned char* vp = lds + LV + (32 * si + 16 * s2 + trow) * SV + (32 * vi + tcol) * 2;
                    const s16x4 lo = tr4(vp), hh = tr4(vp + 8 * SV);
                    const bf16x8 vf = {lo[0], lo[1], lo[2], lo[3], hh[0], hh[1], hh[2], hh[3]};
                    Z = MFMA32(pa.v, vf, Z);
                }
            }
#pragma unroll
            for (int ks = 0; ks < 8; ++ks) {
                const bf16x8 a = *(const LAS bf16x8*)(lds + LQB + (32 * ti + r32) * SQ + (16 * ks + 8 * hi) * 2);
                const LAS unsigned char* sp = lds + LS + (16 * ks + 8 * hi + (tI >> 2)) * SS + (32 * vi + tcol) * 2;
                const s16x4 lo = tr4(sp), hh = tr4(sp + 4 * SS);
                const bf16x8 sf = {lo[0], lo[1], lo[2], lo[3], hh[0], hh[1], hh[2], hh[3]};
                Z = MFMA32(a, sf, Z);
            }
            bf16_t* op = HI + (rowb + (size_t)n * 64 + 32 * ti) * 512 + h * 128 + vh * 64 + 32 * vi + r32;
#pragma unroll
            for (int r = 0; r < 16; ++r) op[(size_t)crow(r, hi) * 512] = (bf16_t)(cvt_pk_bf16(Z[r], 0.f) & 0xffffu);
        }
        {
#pragma unroll
            for (int r = 0; r < 16; ++r) Sacc[r] *= CL[32 * di + crow(r, hi)];
#pragma unroll
            for (int ks = 0; ks < 4; ++ks) {
                const LAS unsigned char* kp = lds + LKD + (16 * ks + 8 * hi + (tI >> 2)) * SKD + (32 * di + tcol) * 2;
                const s16x4 klo = tr4(kp), khi = tr4(kp + 4 * SKD);
                const bf16x8 ka = {klo[0], klo[1], klo[2], klo[3], khi[0], khi[1], khi[2], khi[3]};
                const LAS unsigned char* vp = lds + LV + (16 * ks + 8 * hi + (tI >> 2)) * SV + (32 * vi + tcol) * 2;
                const s16x4 vlo = tr4(vp), vhi = tr4(vp + 4 * SV);
                const bf16x8 vb = {vlo[0], vlo[1], vlo[2], vlo[3], vhi[0], vhi[1], vhi[2], vhi[3]};
                Sacc = MFMA32(ka, vb, Sacc);
            }
        }
        __syncthreads();
        {
            LAS bf16_t* sp = (LAS bf16_t*)(lds + LS + (32 * di) * SS + (32 * vi + r32) * 2);
#pragma unroll
            for (int r = 0; r < 16; ++r) sp[crow(r, hi) * (SS / 2)] = (bf16_t)(cvt_pk_bf16(Sacc[r], 0.f) & 0xffffu);
        }
    }
    __syncthreads();
}

__device__ void moba_unit(const Params& P, int b, int h, int j, LAS unsigned char* lds) {
    const int tid = tid_opaque(), lane = tid & 63, wid = tid >> 6, r32 = lane & 31, hi = lane >> 5;
    bf16_t* Q = (bf16_t*)(P.ws + OFF_QA); const bf16_t* Kg = (const bf16_t*)(P.ws + OFF_KA); const bf16_t* Vg = (const bf16_t*)(P.ws + OFF_VA);
    const float* kmean = (const float*)(P.ws + OFF_KMEAN);
    constexpr int KIMG = 64 * 144, VIMG = 64 * 192, LK = 0, LV = 4 * KIMG, LKM = 4 * KIMG + 4 * VIMG;
    LAS float* kmL = (LAS float*)(lds + LKM);
    const size_t rowb = (size_t)b * SEQ; const int q0 = j * 256;
    if (tid < j * 64) kmL[tid] = kmean[(size_t)(b * 8 + (tid >> 6)) * 512 + h * 64 + (tid & 63)];
    bf16_t* qrow = Q + (rowb + q0 + wid * 32 + r32) * 512 + h * 64;
    bf16x8 qf[4];
#pragma unroll
    for (int d0 = 0; d0 < 4; ++d0) qf[d0] = *(const bf16x8*)(qrow + 16 * d0 + 8 * hi);
    const int srow = tid >> 3, sch = tid & 7;
    const bf16_t* ksrc = Kg + (rowb + srow) * 512 + h * 64 + sch * 8; const bf16_t* vsrc = Vg + (rowb + srow) * 512 + h * 64 + sch * 8;
    const int ntile = 4 * (j + 1), npair = ntile >> 1;
    auto tile_key0 = [&](int i) -> size_t { const int blk = (i < 4) ? j : ((i - 4) >> 2), kt = (i < 4) ? i : ((i - 4) & 3); return (size_t)(blk * 256 + kt * 64); };
    u32x4 kreg[2], vreg[2];
#pragma unroll
    for (int s = 0; s < 2; ++s) { const size_t k0 = tile_key0(s); kreg[s] = *(const u32x4*)(ksrc + k0 * 512); vreg[s] = *(const u32x4*)(vsrc + k0 * 512); }
#pragma unroll
    for (int s = 0; s < 2; ++s) { *(LAS u32x4*)(lds + LK + s * KIMG + srow * 144 + sch * 16) = kreg[s]; *(LAS u32x4*)(lds + LV + s * VIMG + srow * 192 + sch * 16) = vreg[s]; }
    __syncthreads();
    unsigned sel = 0;
    if (j <= 3) sel = (1u << j) - 1u;
    else {
        float g[7];
#pragma unroll
        for (int n = 0; n < 7; ++n) { float s = 0.f;
            if (n < j) {
#pragma unroll
                for (int d0 = 0; d0 < 4; ++d0)
#pragma unroll
                    for (int e = 0; e < 8; ++e) s += __uint_as_float(((unsigned)(unsigned short)qf[d0][e]) << 16) * kmL[n * 64 + 16 * d0 + 8 * hi + e];
            }
            s += __shfl_xor(s, 32); g[n] = s; }
#pragma unroll
        for (int it = 0; it < 3; ++it) { float best = -INFINITY; int bi = 0;
#pragma unroll
            for (int n = 0; n < 7; ++n) if (n < j && !((sel >> n) & 1u) && g[n] > best) { best = g[n]; bi = n; }
            sel |= 1u << bi; }
    }
    const float ch = exp2f(-(float)(h + 1)) * LOG2E;
    const int qb = wid * 32 + r32;
    float m_run = -1e30f, l_run = 0.f;
    f32x16 o0 = {}, o1 = {};
    const int tg = lane >> 4, tc = tg & 1, ti = lane & 15;
    const int vlane = (4 * hi + (ti >> 2)) * 192 + (16 * tc + 4 * (ti & 3)) * 2;
#pragma unroll 1
    for (int ip = 0; ip < npair; ++ip) {
      const int pbuf = ip & 1;
      if (ip + 1 < npair) {
#pragma unroll
          for (int s = 0; s < 2; ++s) { const size_t k1 = tile_key0(2 * ip + 2 + s); kreg[s] = *(const u32x4*)(ksrc + k1 * 512); vreg[s] = *(const u32x4*)(vsrc + k1 * 512); }
      }
#pragma unroll
      for (int s2 = 0; s2 < 2; ++s2) {
        const int i = 2 * ip + s2, buf = pbuf * 2 + s2;
        const bool own = i < 4; const int blk = own ? j : ((i - 4) >> 2), kt = own ? i : ((i - 4) & 3);
        const bool lane_ok = own ? true : (((sel >> blk) & 1u) != 0u);
        const bool skip = own ? (64 * kt > 32 * wid + 31) : (__ballot(lane_ok) == 0ull);
        if (!skip) {
            LAS unsigned char* kb = lds + LK + buf * KIMG; LAS unsigned char* vb = lds + LV + buf * VIMG;
            f32x16 p0 = {}, p1 = {};
#pragma unroll
            for (int d0 = 0; d0 < 4; ++d0) {
                const bf16x8 kf0 = *(const LAS bf16x8*)(kb + r32 * 144 + (16 * d0 + 8 * hi) * 2);
                const bf16x8 kf1 = *(const LAS bf16x8*)(kb + (32 + r32) * 144 + (16 * d0 + 8 * hi) * 2);
                p0 = MFMA32(kf0, qf[d0], p0); p1 = MFMA32(kf1, qf[d0], p1);
            }
            const float kbase = ch * (float)((blk - j) * 256 + kt * 64);
            float mt = -1e30f;
#pragma unroll
            for (int r = 0; r < 16; ++r) {
                const int kl0 = crow(r, hi), kl1 = kl0 + 32;
                p0[r] = __builtin_fmaf(ch, (float)kl0, p0[r]); p1[r] = __builtin_fmaf(ch, (float)kl1, p1[r]);
                if (own) { if (kt * 64 + kl0 > qb) p0[r] = -1e30f; if (kt * 64 + kl1 > qb) p1[r] = -1e30f; }
                mt = fmaxf(mt, fmaxf(p0[r], p1[r]));
            }
            mt = lane_ok ? mt + kbase : -1e30f;
            mt = fmaxf(mt, __shfl_xor(mt, 32));
            if (__ballot(mt > m_run) != 0ull) {
                const float mnew = fmaxf(m_run, mt), alpha = __builtin_amdgcn_exp2f(m_run - mnew);
                m_run = mnew; l_run *= alpha;
#pragma unroll
                for (int r = 0; r < 16; ++r) { o0[r] *= alpha; o1[r] *= alpha; }
            }
            const float sh = lane_ok ? kbase - m_run : -1e30f;
            float rs = 0.f;
#pragma unroll
            for (int r = 0; r < 16; ++r) { p0[r] = __builtin_amdgcn_exp2f(p0[r] + sh); p1[r] = __builtin_amdgcn_exp2f(p1[r] + sh); rs += p0[r] + p1[r]; }
            l_run += rs;
#pragma unroll
            for (int sub = 0; sub < 2; ++sub)
#pragma unroll
                for (int s = 0; s < 2; ++s) {
                    union { u32x4 u; bf16x8 v; } pb;
                    if (sub == 0) { pb.u.x = cvt_pk_bf16(p0[8 * s + 0], p0[8 * s + 1]); pb.u.y = cvt_pk_bf16(p0[8 * s + 2], p0[8 * s + 3]); pb.u.z = cvt_pk_bf16(p0[8 * s + 4], p0[8 * s + 5]); pb.u.w = cvt_pk_bf16(p0[8 * s + 6], p0[8 * s + 7]); }
                    else { pb.u.x = cvt_pk_bf16(p1[8 * s + 0], p1[8 * s + 1]); pb.u.y = cvt_pk_bf16(p1[8 * s + 2], p1[8 * s + 3]); pb.u.z = cvt_pk_bf16(p1[8 * s + 4], p1[8 * s + 5]); pb.u.w = cvt_pk_bf16(p1[8 * s + 6], p1[8 * s + 7]); }
#pragma unroll
                    for (int dt = 0; dt < 2; ++dt) {
                        LAS unsigned char* va = vb + (32 * sub + 16 * s) * 192 + dt * 64 + vlane;
                        const s16x4 lo = __builtin_bit_cast(s16x4, __builtin_amdgcn_ds_read_tr16_b64_v4i16((LAS s16x4*)va));
                        const s16x4 hh = __builtin_bit_cast(s16x4, __builtin_amdgcn_ds_read_tr16_b64_v4i16((LAS s16x4*)(va + 8 * 192)));
                        const bf16x8 vf = {lo[0], lo[1], lo[2], lo[3], hh[0], hh[1], hh[2], hh[3]};
                        if (dt == 0) o0 = MFMA32(vf, pb.v, o0); else o1 = MFMA32(vf, pb.v, o1);
                    }
                }
        }
      }
      if (ip + 1 < npair) { const int nb = (pbuf ^ 1) * 2;
#pragma unroll
          for (int s = 0; s < 2; ++s) { *(LAS u32x4*)(lds + LK + (nb + s) * KIMG + srow * 144 + sch * 16) = kreg[s]; *(LAS u32x4*)(lds + LV + (nb + s) * VIMG + srow * 192 + sch * 16) = vreg[s]; } }
      __syncthreads();
    }
    l_run += __shfl_xor(l_run, 32);
    const float inv = 1.0f / l_run;
#pragma unroll
    for (int r4 = 0; r4 < 4; ++r4) {
        int w0 = __builtin_amdgcn_cvt_pk_fp8_f32(o0[4 * r4] * inv, o0[4 * r4 + 1] * inv, 0, false); w0 = __builtin_amdgcn_cvt_pk_fp8_f32(o0[4 * r4 + 2] * inv, o0[4 * r4 + 3] * inv, w0, true);
        int w1 = __builtin_amdgcn_cvt_pk_fp8_f32(o1[4 * r4] * inv, o1[4 * r4 + 1] * inv, 0, false); w1 = __builtin_amdgcn_cvt_pk_fp8_f32(o1[4 * r4 + 2] * inv, o1[4 * r4 + 3] * inv, w1, true);
        unsigned char* yrow = P.ws + OFF_EG + (rowb + q0 + wid * 32 + r32) * 1024 + h * 64;
        *(int*)(yrow + 8 * r4 + 4 * hi) = w0; *(int*)(yrow + 32 + 8 * r4 + 4 * hi) = w1;
    }
}

__device__ void yb_norm_panel(const Params& P, int pm) {
    const int tid = tid_opaque(), lane = tid & 63, wid = tid >> 6;
    bf16_t* HI = (bf16_t*)(P.ws + OFF_HI); const bf16_t* HG = (const bf16_t*)(P.ws + OFF_HG);
    for (int r = 0; r < 32; ++r) {
        const size_t off = ((size_t)pm * 256 + wid * 32 + r) * 512 + lane * 8;
        const u32x4 ov = *(const u32x4*)(HI + off), gv = *(const u32x4*)(HG + off);
        float o[8] = {bf_lo(ov.x), bf_hi(ov.x), bf_lo(ov.y), bf_hi(ov.y), bf_lo(ov.z), bf_hi(ov.z), bf_lo(ov.w), bf_hi(ov.w)};
        const float g[8] = {bf_lo(gv.x), bf_hi(gv.x), bf_lo(gv.y), bf_hi(gv.y), bf_lo(gv.z), bf_hi(gv.z), bf_lo(gv.w), bf_hi(gv.w)};
        float ss = 0.f;
#pragma unroll
        for (int e = 0; e < 8; ++e) ss += o[e] * o[e];
        ss += __shfl_xor(ss, 1); ss += __shfl_xor(ss, 2); ss += __shfl_xor(ss, 4); ss += __shfl_xor(ss, 8);
        const float rs = rsqrtf(ss * (1.0f / 128.0f) + RMS_EPS);
        int w0 = __builtin_amdgcn_cvt_pk_fp8_f32(o[0] * rs * g[0], o[1] * rs * g[1], 0, false); w0 = __builtin_amdgcn_cvt_pk_fp8_f32(o[2] * rs * g[2], o[3] * rs * g[3], w0, true);
        int w1 = __builtin_amdgcn_cvt_pk_fp8_f32(o[4] * rs * g[4], o[5] * rs * g[5], 0, false); w1 = __builtin_amdgcn_cvt_pk_fp8_f32(o[6] * rs * g[6], o[7] * rs * g[7], w1, true);
        *(u32x2*)(P.ws + OFF_EG + ((size_t)pm * 256 + wid * 32 + r) * 1024 + 512 + lane * 8) = (u32x2){(unsigned)w0, (unsigned)w1};
    }
}
__device__ void ln1_panel(const Params& P, int pm) {
    const int tid = tid_opaque(), lane = tid & 63, wid = tid >> 6;
    const float* ada = (const float*)(P.ws + OFF_ADA) + (size_t)(pm >> 3) * 6144; bf16_t* H = (bf16_t*)(P.ws + OFF_H);
    for (int r = 0; r < 32; ++r) {
        const size_t row = (size_t)pm * 256 + wid * 32 + r;
        const float* xin = P.x + row * 1024 + lane * 4; const bf16_t* dl = (const bf16_t*)(P.ws + OFF_GB) + row * 1024 + lane * 4;
        f32x4 v[4]; float s = 0.f;
#pragma unroll
        for (int jx = 0; jx < 4; ++jx) { const u32x2 dv = *(const u32x2*)(dl + 256 * jx); const f32x4 xv = __builtin_nontemporal_load((const f32x4*)(xin + 256 * jx));
            v[jx] = xv * ALPHA + (f32x4){bf_lo(dv.x), bf_hi(dv.x), bf_lo(dv.y), bf_hi(dv.y)}; s += (v[jx][0] + v[jx][1]) + (v[jx][2] + v[jx][3]); }
        const float mean = wave_sum(s) * (1.0f / 1024.0f); float s2 = 0.f;
#pragma unroll
        for (int jx = 0; jx < 4; ++jx) { v[jx] = v[jx] - mean; s2 += (v[jx][0] * v[jx][0] + v[jx][1] * v[jx][1]) + (v[jx][2] * v[jx][2] + v[jx][3] * v[jx][3]); }
        const float rstd = rsqrtf(wave_sum(s2) * (1.0f / 1024.0f) + LN_EPS);
#pragma unroll
        for (int jx = 0; jx < 4; ++jx) {
            const int c = lane * 4 + 256 * jx;
            const f32x4 g = *(const f32x4*)(P.ln1_g + c), bb = *(const f32x4*)(P.ln1_b + c), sh = *(const f32x4*)(ada + 3072 + c), sc = *(const f32x4*)(ada + 4096 + c);
            const f32x4 x1 = v[jx] * rstd * g + bb;
            { u32x2 w1; w1.x = cvt_pk_bf16(x1[0], x1[1]); w1.y = cvt_pk_bf16(x1[2], x1[3]);
              *(u32x2*)((bf16_t*)(P.out + row * 1024) + c) = w1; }
            const f32x4 h2 = x1 * (sc + 1.0f) + sh;
            u32x2 w; w.x = cvt_pk_bf16(h2[0], h2[1]); w.y = cvt_pk_bf16(h2[2], h2[3]);
            *(u32x2*)(H + row * 1024 + c) = w;
            v[jx] = h2;
        }
        {
            float mx = 0.f;
#pragma unroll
            for (int jx = 0; jx < 4; ++jx) mx = fmaxf(mx, fmaxf(fmaxf(fabsf(v[jx][0]), fabsf(v[jx][1])), fmaxf(fabsf(v[jx][2]), fabsf(v[jx][3]))));
#pragma unroll
            for (int o = 1; o < 64; o <<= 1) mx = fmaxf(mx, __shfl_xor(mx, o));
            const float hs = fmaxf(mx * (1.0f / 119.0f), 1e-30f), inv = 1.0f / hs; int qs = 0;
            const int nsh = (lane & 1) * 4;
#pragma unroll
            for (int jx = 0; jx < 4; ++jx) {
                unsigned pa = 0u, pb = 0u;
#pragma unroll
                for (int k = 0; k < 4; ++k) { const int q = (int)rintf(v[jx][k] * inv); qs += q;
                    const int b = ((q + 8) & 15) - 8, a = (q - b) >> 4;
                    pa |= (unsigned)(a & 15) << (8 * k + nsh); pb |= (unsigned)(b & 15) << (8 * k + nsh); }
                pa |= __shfl_xor(pa, 1); pb |= __shfl_xor(pb, 1);
                if (!(lane & 1)) { unsigned* hp4 = (unsigned*)(P.ws + OFF_H8 + row * 1024) + (lane >> 1) + 32 * jx; hp4[0] = pa; hp4[128] = pb; }
            }
#pragma unroll
            for (int o = 1; o < 64; o <<= 1) qs += __shfl_xor(qs, o);
            if (lane == 0) *(f32x2*)(P.ws + OFF_HS + row * 8) = (f32x2){hs, (float)qs};
        }
    }
}

#define CE16(A, i, j) do { const float hi_ = fmaxf(A[i], A[j]); A[j] = fminf(A[i], A[j]); A[i] = hi_; } while (0)
#define SORT16(A) do { CE16(A, 0, 1); CE16(A, 2, 3); CE16(A, 0, 2); CE16(A, 1, 3); CE16(A, 1, 2); CE16(A, 4, 5); CE16(A, 6, 7); CE16(A, 4, 6); CE16(A, 5, 7); CE16(A, 5, 6); CE16(A, 0, 4); CE16(A, 2, 6); CE16(A, 2, 4); CE16(A, 1, 5); CE16(A, 3, 7); CE16(A, 3, 5); CE16(A, 1, 2); CE16(A, 3, 4); CE16(A, 5, 6); CE16(A, 8, 9); CE16(A, 10, 11); CE16(A, 8, 10); CE16(A, 9, 11); CE16(A, 9, 10); CE16(A, 12, 13); CE16(A, 14, 15); CE16(A, 12, 14); CE16(A, 13, 15); CE16(A, 13, 14); CE16(A, 8, 12); CE16(A, 10, 14); CE16(A, 10, 12); CE16(A, 9, 13); CE16(A, 11, 15); CE16(A, 11, 13); CE16(A, 9, 10); CE16(A, 11, 12); CE16(A, 13, 14); CE16(A, 0, 8); CE16(A, 4, 12); CE16(A, 4, 8); CE16(A, 2, 10); CE16(A, 6, 14); CE16(A, 6, 10); CE16(A, 2, 4); CE16(A, 6, 8); CE16(A, 10, 12); CE16(A, 1, 9); CE16(A, 5, 13); CE16(A, 5, 9); CE16(A, 3, 11); CE16(A, 7, 15); CE16(A, 7, 11); CE16(A, 3, 5); CE16(A, 7, 9); CE16(A, 11, 13); CE16(A, 1, 2); CE16(A, 3, 4); CE16(A, 5, 6); CE16(A, 7, 8); CE16(A, 9, 10); CE16(A, 11, 12); CE16(A, 13, 14); } while (0)
#define BITONIC16(A) do { CE16(A, 0, 8); CE16(A, 1, 9); CE16(A, 2, 10); CE16(A, 3, 11); CE16(A, 4, 12); CE16(A, 5, 13); CE16(A, 6, 14); CE16(A, 7, 15); CE16(A, 0, 4); CE16(A, 1, 5); CE16(A, 2, 6); CE16(A, 3, 7); CE16(A, 8, 12); CE16(A, 9, 13); CE16(A, 10, 14); CE16(A, 11, 15); CE16(A, 0, 2); CE16(A, 1, 3); CE16(A, 4, 6); CE16(A, 5, 7); CE16(A, 8, 10); CE16(A, 9, 11); CE16(A, 12, 14); CE16(A, 13, 15); CE16(A, 0, 1); CE16(A, 2, 3); CE16(A, 4, 5); CE16(A, 6, 7); CE16(A, 8, 9); CE16(A, 10, 11); CE16(A, 12, 13); CE16(A, 14, 15); } while (0)
#define INS16(L, xin) do { float x_ = (xin); _Pragma("unroll") for (int k_ = 0; k_ < 16; ++k_) { const float hi_ = fmaxf(L[k_], x_); x_ = fminf(L[k_], x_); L[k_] = hi_; } } while (0)

__device__ void peer_select_wave(const Params& P, size_t tok0) {
    const int lane = tid_opaque() & 63, r32 = lane & 31, hi = lane >> 5;
    const bf16_t* QP = (const bf16_t*)(P.ws + OFF_GB) + (tok0 + r32) * 1024; const bf16_t* SK = (const bf16_t*)(P.ws + OFF_SK);
    u32x2* EG = (u32x2*)(P.ws + OFF_EG) + (tok0 + r32) * 128;
#pragma unroll 1
    for (int h = 0; h < 8; ++h) {
        float a0[16], a1[16];
#pragma unroll
        for (int k = 0; k < 16; ++k) { a0[k] = -INFINITY; a1[k] = -INFINITY; }
#pragma unroll
        for (int p = 0; p < 2; ++p) {
            const int hp = h * 2 + p;
            bf16x8 qf[4];
#pragma unroll
            for (int ks = 0; ks < 4; ++ks) qf[ks] = *(const bf16x8*)(QP + hp * 64 + 16 * ks + 8 * hi);
            float L[16];
#pragma unroll
            for (int kt = 0; kt < 4; ++kt) {
                f32x16 acc = {};
#pragma unroll
                for (int ks = 0; ks < 4; ++ks) { const bf16x8 kf = *(const bf16x8*)(SK + ((size_t)hp * 128 + 32 * kt + r32) * 64 + 16 * ks + 8 * hi); acc = MFMA32(kf, qf[ks], acc); }
                float S[16];
#pragma unroll
                for (int r = 0; r < 16; ++r) { const unsigned key = (unsigned)(32 * kt + crow(r, hi)); S[r] = __uint_as_float((__float_as_uint(acc[r]) & ~127u) | key); }
                SORT16(S);
                if (kt == 0) {
#pragma unroll
                    for (int k = 0; k < 16; ++k) L[k] = S[k];
                } else {
#pragma unroll
                    for (int k = 0; k < 16; ++k) L[k] = fmaxf(L[k], S[15 - k]);
                    BITONIC16(L);
                }
            }
            {
                float O[16];
#pragma unroll
                for (int k = 0; k < 16; ++k) O[k] = __shfl_xor(L[15 - k], 32);
#pragma unroll
                for (int k = 0; k < 16; ++k) L[k] = fmaxf(L[k], O[k]);
                BITONIC16(L);
            }
#pragma unroll
            for (int k = 0; k < 16; ++k) { a0[k] = (p == 0) ? L[k] : a0[k]; a1[k] = (p == 1) ? L[k] : a1[k]; }
        }
        float best[16];
#pragma unroll
        for (int k = 0; k < 16; ++k) best[k] = __uint_as_float((__float_as_uint(a0[0] + a1[k]) & ~255u) | (unsigned)k);
#define PKC(i, j) __uint_as_float((__float_as_uint(a0[i] + a1[j]) & ~255u) | (unsigned)((i) * 16 + (j)))
        {
            float A[16] = {PKC(1, 0), PKC(1, 1), PKC(1, 2), PKC(1, 3), PKC(1, 4), PKC(1, 5), PKC(1, 6), PKC(1, 7), PKC(15, 0), PKC(14, 0), PKC(13, 0), PKC(12, 0), PKC(11, 0), PKC(10, 0), PKC(9, 0), PKC(8, 0)};
            BITONIC16(A);
#pragma unroll
            for (int k = 0; k < 16; ++k) best[k] = fmaxf(best[k], A[15 - k]);
            BITONIC16(best);
            float B[16] = {PKC(2, 0), PKC(2, 1), PKC(2, 2), PKC(2, 3), PKC(2, 4), PKC(3, 0), PKC(3, 1), PKC(3, 2), PKC(3, 3), PKC(4, 0), PKC(4, 1), PKC(4, 2), PKC(5, 0), PKC(5, 1), PKC(6, 0), PKC(6, 1)};
            SORT16(B);
#pragma unroll
            for (int k = 0; k < 16; ++k) best[k] = fmaxf(best[k], B[15 - k]);
            BITONIC16(best);
            INS16(best, PKC(7, 0)); INS16(best, PKC(7, 1));
        }
#undef PKC
        unsigned pk0[4], pk1[4];
#pragma unroll
        for (int q = 0; q < 4; ++q) {
            pk0[q] = (__float_as_uint(a0[4 * q]) & 127u) | ((__float_as_uint(a0[4 * q + 1]) & 127u) << 8) | ((__float_as_uint(a0[4 * q + 2]) & 127u) << 16) | ((__float_as_uint(a0[4 * q + 3]) & 127u) << 24);
            pk1[q] = (__float_as_uint(a1[4 * q]) & 127u) | ((__float_as_uint(a1[4 * q + 1]) & 127u) << 8) | ((__float_as_uint(a1[4 * q + 2]) & 127u) << 16) | ((__float_as_uint(a1[4 * q + 3]) & 127u) << 24);
        }
        unsigned pay[16];
#pragma unroll
        for (int k = 0; k < 16; ++k) {
            const unsigned code = __float_as_uint(best[k]) & 255u, ci = code >> 4, cj = code & 15u;
            const unsigned qi = ci >> 2, qj = cj >> 2;
            const unsigned w0 = (qi == 0u) ? pk0[0] : ((qi == 1u) ? pk0[1] : ((qi == 2u) ? pk0[2] : pk0[3]));
            const unsigned w1 = (qj == 0u) ? pk1[0] : ((qj == 1u) ? pk1[1] : ((qj == 2u) ? pk1[2] : pk1[3]));
            pay[k] = (((w0 >> ((ci & 3u) * 8u)) & 127u) << 7) | ((w1 >> ((cj & 3u) * 8u)) & 127u);
        }
        float e[16], es = 0.f;
#pragma unroll
        for (int k = 0; k < 16; ++k) { e[k] = __expf(best[k] - best[0]); es += e[k]; }
        const float inv = 1.0f / es;
        if (hi == 0) {
#pragma unroll
            for (int k = 0; k < 16; ++k) { u32x2 w; w.x = pay[k]; w.y = __float_as_uint(e[k] * inv); EG[h * 16 + k] = w; }
        }
    }
}
__device__ __forceinline__ unsigned xcc_id() { return (unsigned)__builtin_amdgcn_s_getreg((3 << 11) | 20) & 0xFu; }
template <int CTRL> __device__ __forceinline__ float dpp_add(float x) { const int v = __builtin_amdgcn_update_dpp(0, __float_as_int(x), CTRL, 0xf, 0xf, true); return x + __int_as_float(v); }
__device__ __forceinline__ float wave_sum_fast(float x) {
    x = dpp_add<0xB1>(x); x = dpp_add<0x4E>(x); x = dpp_add<0x141>(x); x = dpp_add<0x140>(x);
    x += __shfl_xor(x, 16); x += __shfl_xor(x, 32); return x;
}
template <int CTRL> __device__ __forceinline__ float dpp_max(float x) { const int v = __builtin_amdgcn_update_dpp(0, __float_as_int(x), CTRL, 0xf, 0xf, true); return fmaxf(x, __int_as_float(v)); }
template <int CTRL> __device__ __forceinline__ int dpp_addi(int x) { return x + __builtin_amdgcn_update_dpp(0, x, CTRL, 0xf, 0xf, true); }
__device__ __forceinline__ float wave_max_fast(float x) {
    x = dpp_max<0xB1>(x); x = dpp_max<0x4E>(x); x = dpp_max<0x141>(x); x = dpp_max<0x140>(x);
    x = fmaxf(x, __shfl_xor(x, 16)); x = fmaxf(x, __shfl_xor(x, 32)); return x;
}
__device__ __forceinline__ int wave_sum_int_fast(int x) {
    x = dpp_addi<0xB1>(x); x = dpp_addi<0x4E>(x); x = dpp_addi<0x141>(x); x = dpp_addi<0x140>(x);
    x += __shfl_xor(x, 16); x += __shfl_xor(x, 32); return x;
}
__device__ __forceinline__ float dot16_fp8(const float (&hv)[16], const u32x4 r) {
    float s = 0.f;
    { const f32x2 a = __builtin_amdgcn_cvt_pk_f32_fp8((int)r.x, false), b = __builtin_amdgcn_cvt_pk_f32_fp8((int)r.x, true); s += hv[0] * a.x + hv[1] * a.y + hv[2] * b.x + hv[3] * b.y; }
    { const f32x2 a = __builtin_amdgcn_cvt_pk_f32_fp8((int)r.y, false), b = __builtin_amdgcn_cvt_pk_f32_fp8((int)r.y, true); s += hv[4] * a.x + hv[5] * a.y + hv[6] * b.x + hv[7] * b.y; }
    { const f32x2 a = __builtin_amdgcn_cvt_pk_f32_fp8((int)r.z, false), b = __builtin_amdgcn_cvt_pk_f32_fp8((int)r.z, true); s += hv[8] * a.x + hv[9] * a.y + hv[10] * b.x + hv[11] * b.y; }
    { const f32x2 a = __builtin_amdgcn_cvt_pk_f32_fp8((int)r.w, false), b = __builtin_amdgcn_cvt_pk_f32_fp8((int)r.w, true); s += hv[12] * a.x + hv[13] * a.y + hv[14] * b.x + hv[15] * b.y; }
    return s;
}
template <int NP, class F> __device__ __forceinline__ void partition_queue(const Params& P, LAS unsigned char* lds, int ctr_base, F f) {
    const int tid = tid_opaque();
    LAS int* slot = (LAS int*)(lds + LDS_BYTES - 64);
    unsigned* ctr = (unsigned*)(P.ws + OFF_CTR) + ctr_base;
    const int myx = (int)(xcc_id() & 7u);
    for (int pp = 0; pp < NP; ++pp) {
        const int p = (myx * (NP / 8) + pp) % NP;
        for (;;) {
            if (tid == 0) *slot = (int)atomicAdd(ctr + p, 1u);
            __syncthreads();
            const int item = *slot;
            __syncthreads();
            if (item >= NTOK / 64) break;
            f(p, item);
        }
    }
}
__device__ __forceinline__ float dot2bf(unsigned a, bf16v2 b, float c) { return __builtin_amdgcn_fdot2_f32_bf16(__builtin_bit_cast(bf16v2, a), b, c, false); }
__device__ __forceinline__ float gelu_erf(float v) {
    const float av = fabsf(v), t = __builtin_amdgcn_rcpf(__builtin_fmaf(av, 0.2316418882f, 1.0f));
    float q = __builtin_fmaf(t, 0.5307027145f, -0.7265760135f); q = __builtin_fmaf(q, t, 0.7107068705f); q = __builtin_fmaf(q, t, -0.142248368f); q = __builtin_fmaf(q, t, 0.127414796f); q = q * t;
    const float m = v * (q * __builtin_amdgcn_exp2f(v * v * -0.72134752044f));
    return v < 0.f ? m : v - m;
}
struct UQuad { u32x4 r[2]; u32x4 ent, nxt; };
__device__ __forceinline__ void uq_issue(UQuad& q, const LAS u32x4* list, int J, int NQ, int g, const unsigned char* Ub, const unsigned lo) {
    q.ent = q.nxt;
    const unsigned char* rp = Ub + (q.ent.x * 512u + lo);
    q.r[0] = *(const u32x4*)rp; q.r[1] = *(const u32x4*)(rp + 256);
    const int jj = J < NQ ? J : NQ - 1;
    q.nxt = list[4 * jj + g];
}
__device__ __forceinline__ float uq_dot(const UQuad& q, const u32x4 (&hp)[4]) {
    int a = 0, b = 0;
#pragma unroll
    for (int c = 0; c < 2; ++c) {
        const u32x4 r = q.r[c];
        a = __builtin_amdgcn_sdot8((int)hp[c].x, (int)r.x, a, false); a = __builtin_amdgcn_sdot8((int)hp[c].y, (int)r.y, a, false);
        a = __builtin_amdgcn_sdot8((int)hp[c].z, (int)r.z, a, false); a = __builtin_amdgcn_sdot8((int)hp[c].w, (int)r.w, a, false);
        b = __builtin_amdgcn_sdot8((int)hp[2 + c].x, (int)r.x, b, false); b = __builtin_amdgcn_sdot8((int)hp[2 + c].y, (int)r.y, b, false);
        b = __builtin_amdgcn_sdot8((int)hp[2 + c].z, (int)r.z, b, false); b = __builtin_amdgcn_sdot8((int)hp[2 + c].w, (int)r.w, b, false);
    }
    float s = (float)(16 * a + b);
    s = dpp_add<0xB1>(s); s = dpp_add<0x4E>(s); s = dpp_add<0x141>(s); s = dpp_add<0x140>(s);
    return s;
}
__device__ __forceinline__ void peer_u_tokens(const Params& P, LAS unsigned char* lds, const size_t t0) {
    const int tid = tid_opaque(), lane = tid & 63, wid = tid >> 6, g = lane >> 4, li = lane & 15;
    const unsigned char* H8 = P.ws + OFF_H8 + li * 16; const unsigned char* Ub = P.ws + OFF_U8; const unsigned lo16 = (unsigned)li * 16u;
    const f32x2* HS = (const f32x2*)(P.ws + OFF_HS); const float* USC = (const float*)(P.ws + OFF_USC);
    const u32x4* EG4 = (const u32x4*)(P.ws + OFF_EG); float* W = (float*)(P.ws + OFF_W);
    LAS u32x4* list = (LAS u32x4*)(lds + wid * 16384);
    {
        u32x4 egv[8]; float s0[8], s1[8];
#pragma unroll
        for (int i = 0; i < 8; ++i) egv[i] = EG4[(t0 + i) * 64 + lane];
#pragma unroll
        for (int i = 0; i < 8; ++i) { s0[i] = USC[egv[i].x]; s1[i] = USC[egv[i].z]; }
#pragma unroll
        for (int i = 0; i < 8; ++i) {
            list[i * 128 + 2 * lane] = (u32x4){egv[i].x, egv[i].y, (unsigned)(2 * lane) | (unsigned)(i << 8), __float_as_uint(s0[i])};
            list[i * 128 + 2 * lane + 1] = (u32x4){egv[i].z, egv[i].w, (unsigned)(2 * lane + 1) | (unsigned)(i << 8), __float_as_uint(s1[i])};
        }
    }
    constexpr int NQ = 256;
    u32x4 hp[4], hn[4]; f32x2 hsc = HS[t0], hsn = HS[t0 + 1];
#pragma unroll
    for (int c = 0; c < 2; ++c) { hp[c] = *(const u32x4*)(H8 + t0 * 1024 + 256 * c); hp[2 + c] = *(const u32x4*)(H8 + t0 * 1024 + 512 + 256 * c);
                                  hn[c] = *(const u32x4*)(H8 + (t0 + 1) * 1024 + 256 * c); hn[2 + c] = *(const u32x4*)(H8 + (t0 + 1) * 1024 + 512 + 256 * c); }
    int curtok = 0;
    UQuad q0, q1, q2, q3, q4, q5, q6, q7;
    q0.nxt = list[g]; q1.nxt = list[4 + g]; q2.nxt = list[8 + g]; q3.nxt = list[12 + g]; q4.nxt = list[16 + g]; q5.nxt = list[20 + g]; q6.nxt = list[24 + g]; q7.nxt = list[28 + g];
    uq_issue(q0, list, 8, NQ, g, Ub, lo16); uq_issue(q1, list, 9, NQ, g, Ub, lo16); uq_issue(q2, list, 10, NQ, g, Ub, lo16); uq_issue(q3, list, 11, NQ, g, Ub, lo16);
    uq_issue(q4, list, 12, NQ, g, Ub, lo16); uq_issue(q5, list, 13, NQ, g, Ub, lo16); uq_issue(q6, list, 14, NQ, g, Ub, lo16); uq_issue(q7, list, 15, NQ, g, Ub, lo16);
    float sv = 0.f; unsigned gv = 0u, zv = 0u;
#define UQ_PIN(q) asm volatile("" : "+v"(q.r[0]), "+v"(q.r[1]) :: "memory")
#define UQ_STEP(q, Jn, kq, qn) do { \
        const float s = __uint_as_float(q.ent.w) * hsc.x * (uq_dot(q, hp) + 0.5f * hsc.y); \
        if (li == (kq)) { sv = s; gv = q.ent.y; zv = q.ent.z; } \
        uq_issue(q, list, (Jn), NQ, g, Ub, lo16); UQ_PIN(qn); } while (0)
    UQ_PIN(q0);
#pragma unroll 1
    for (int J = 0; J < NQ; J += 8) {
        const int tk = __builtin_amdgcn_readfirstlane((int)(q0.ent.z >> 8));
        if (tk != curtok) { curtok = tk;
#pragma unroll
            for (int c = 0; c < 4; ++c) hp[c] = hn[c];
            hsc = hsn;
            if (tk + 1 < 8) { hsn = HS[t0 + tk + 1];
#pragma unroll
                for (int c = 0; c < 2; ++c) { hn[c] = *(const u32x4*)(H8 + (t0 + tk + 1) * 1024 + 256 * c); hn[2 + c] = *(const u32x4*)(H8 + (t0 + tk + 1) * 1024 + 512 + 256 * c); } } }
        UQ_STEP(q0, J + 16, 0, q1); UQ_STEP(q1, J + 17, 1, q2); UQ_STEP(q2, J + 18, 2, q3); UQ_STEP(q3, J + 19, 3, q4);
        UQ_STEP(q4, J + 20, 4, q5); UQ_STEP(q5, J + 21, 5, q6); UQ_STEP(q6, J + 22, 6, q7); UQ_STEP(q7, J + 23, 7, q0);
        if (li < 8) W[(t0 + tk) * 128 + (zv & 255u)] = __uint_as_float(gv) * gelu_erf(sv); }
#undef UQ_STEP
}
typedef int v4i_t __attribute__((ext_vector_type(4)));
struct VQuad { u32x4 r[2]; u32x2 ent, nxt; };
__device__ __forceinline__ void vq_issue(VQuad& q, const LAS u32x2* list, int J, int g, const unsigned char* Vb, const unsigned lo) {
    q.ent = q.nxt;
    const unsigned char* rp = Vb + (q.ent.x * 512u + lo);
    q.r[0] = *(const u32x4*)rp; q.r[1] = *(const u32x4*)(rp + 256);
    const int jj = J < 256 ? J : 255;
    q.nxt = list[4 * jj + g];
}
#define VQ_PIN(q) asm volatile("" : "+v"(q.r[0]), "+v"(q.r[1]) :: "memory")
__device__ __forceinline__ void vq_mma(const VQuad& q, v4i_t (&acc)[4], const u32x4 bm) {
    const unsigned t = q.ent.y;
    const v4i_t B = {(int)(t & bm.x), (int)(t & bm.y), (int)(t & bm.z), (int)(t & bm.w)};
#pragma unroll
    for (int c = 0; c < 2; ++c) {
        const u32x4 r = q.r[c];
        const v4i_t lo = {(int)(r.x & 0x0F0F0F0Fu), (int)(r.y & 0x0F0F0F0Fu), (int)(r.z & 0x0F0F0F0Fu), (int)(r.w & 0x0F0F0F0Fu)};
        const v4i_t raw = {(int)r.x, (int)r.y, (int)r.z, (int)r.w};
        acc[2 * c] = __builtin_amdgcn_mfma_i32_16x16x64_i8(lo, B, acc[2 * c], 0, 0, 0);
        acc[2 * c + 1] = __builtin_amdgcn_mfma_i32_16x16x64_i8(raw, B, acc[2 * c + 1], 0, 0, 0);
    }
}
__device__ __forceinline__ void peer_v_tokens(const Params& P, LAS unsigned char* lds, const size_t t0) {
    const int tid = tid_opaque(), lane = tid & 63, wid = tid >> 6, g = lane >> 4, li = lane & 15;
    const unsigned char* Vb = P.ws + OFF_V8; const unsigned lo16 = (unsigned)li * 16u; const float* VSC = (const float*)(P.ws + OFF_VSC);
    const u32x4* EG4 = (const u32x4*)(P.ws + OFF_EG); const f32x2* W2 = (const f32x2*)(P.ws + OFF_W);
    LAS u32x2* lists = (LAS u32x2*)(lds + wid * 8192);
    LAS f32x2* tokp = (LAS f32x2*)(lds + 65536 + wid * 64);
    {
        u32x4 egv[8]; f32x2 wwv[8];
#pragma unroll
        for (int i = 0; i < 8; ++i) { egv[i] = EG4[(t0 + i) * 64 + lane]; wwv[i] = W2[(t0 + i) * 64 + lane]; }
        float w0v[8], w1v[8];
#pragma unroll
        for (int i = 0; i < 8; ++i) { w0v[i] = wwv[i].x * VSC[egv[i].x]; w1v[i] = wwv[i].y * VSC[egv[i].z]; }
#pragma unroll
        for (int i = 0; i < 8; ++i) {
            const float mx = wave_max_fast(fmaxf(fabsf(w0v[i]), fabsf(w1v[i])));
            const float sw = fmaxf(mx * (1.0f / 127.0f), 1e-30f), inv = 1.0f / sw;
            const int q0 = (int)rintf(w0v[i] * inv), q1 = (int)rintf(w1v[i] * inv);
            *(LAS u32x4*)(lists + i * 128 + 2 * lane) = (u32x4){egv[i].x, ((unsigned)q0 & 255u) * 0x01010101u, egv[i].z, ((unsigned)q1 & 255u) * 0x01010101u};
            const int qs = wave_sum_int_fast(q0 + q1);
            if (lane == 0) tokp[i] = (f32x2){sw, 7.5f * sw * (float)qs}; }
    }
    const unsigned bsel = 0xFFu << (8u * (unsigned)(li & 3));
    const u32x4 bm = {(li >> 2) == 0 ? bsel : 0u, (li >> 2) == 1 ? bsel : 0u, (li >> 2) == 2 ? bsel : 0u, (li >> 2) == 3 ? bsel : 0u};
    const int dbase = 128 * g + 8 * (li >> 2) + (li & 3);
    float gt2v[16], lgv[16], lbv[16];
    { const float* gt2 = (const float*)(P.ws + OFF_ADA) + (t0 >> 11) * 6144 + 5120;
#pragma unroll
      for (int c = 0; c < 2; ++c)
#pragma unroll
          for (int hf = 0; hf < 2; ++hf)
#pragma unroll
              for (int r = 0; r < 4; ++r) { const int d = dbase + 512 * c + 32 * r + 4 * hf, e = 8 * c + 4 * hf + r; gt2v[e] = gt2[d]; lgv[e] = P.ln2_g[d]; lbv[e] = P.ln2_b[d]; } }
    VQuad q0, q1, q2, q3, q4, q5, q6, q7;
    q0.nxt = lists[g]; q1.nxt = lists[4 + g]; q2.nxt = lists[8 + g]; q3.nxt = lists[12 + g]; q4.nxt = lists[16 + g]; q5.nxt = lists[20 + g]; q6.nxt = lists[24 + g]; q7.nxt = lists[28 + g];
    vq_issue(q0, lists, 8, g, Vb, lo16); vq_issue(q1, lists, 9, g, Vb, lo16); vq_issue(q2, lists, 10, g, Vb, lo16); vq_issue(q3, lists, 11, g, Vb, lo16);
    vq_issue(q4, lists, 12, g, Vb, lo16); vq_issue(q5, lists, 13, g, Vb, lo16); vq_issue(q6, lists, 14, g, Vb, lo16); vq_issue(q7, lists, 15, g, Vb, lo16);
    VQ_PIN(q0);
#pragma unroll 1
    for (int i = 0; i < 8; ++i) {
        const size_t t = t0 + i;
        v4i_t acc[4];
#pragma unroll
        for (int j = 0; j < 4; ++j) acc[j] = (v4i_t){0, 0, 0, 0};
        float* xr = P.out + t * 1024;
        float xv[16];
#pragma unroll
        for (int c = 0; c < 2; ++c)
#pragma unroll
            for (int hf = 0; hf < 2; ++hf)
#pragma unroll
                for (int r = 0; r < 4; ++r) xv[8 * c + 4 * hf + r] = __uint_as_float((unsigned)((const bf16_t*)xr)[dbase + 512 * c + 32 * r + 4 * hf] << 16);
#pragma unroll 1
        for (int J = 32 * i; J < 32 * i + 32; J += 8) {
            vq_mma(q0, acc, bm); vq_issue(q0, lists, J + 16, g, Vb, lo16); VQ_PIN(q1);
            vq_mma(q1, acc, bm); vq_issue(q1, lists, J + 17, g, Vb, lo16); VQ_PIN(q2);
            vq_mma(q2, acc, bm); vq_issue(q2, lists, J + 18, g, Vb, lo16); VQ_PIN(q3);
            vq_mma(q3, acc, bm); vq_issue(q3, lists, J + 19, g, Vb, lo16); VQ_PIN(q4);
            vq_mma(q4, acc, bm); vq_issue(q4, lists, J + 20, g, Vb, lo16); VQ_PIN(q5);
            vq_mma(q5, acc, bm); vq_issue(q5, lists, J + 21, g, Vb, lo16); VQ_PIN(q6);
            vq_mma(q6, acc, bm); vq_issue(q6, lists, J + 22, g, Vb, lo16); VQ_PIN(q7);
            vq_mma(q7, acc, bm); vq_issue(q7, lists, J + 23, g, Vb, lo16); VQ_PIN(q0);
        }
        const f32x2 tp = tokp[i]; const float sw = tp.x, yoff = tp.y;
        float pre[16]; float s = 0.f;
#pragma unroll
        for (int c = 0; c < 2; ++c)
#pragma unroll
            for (int hf = 0; hf < 2; ++hf)
#pragma unroll
                for (int r = 0; r < 4; ++r) { const int e = 8 * c + 4 * hf + r;
                    const float yv = hf == 0 ? sw * (float)acc[2 * c][r] - yoff : (sw * 0.0625f) * (float)(acc[2 * c + 1][r] - acc[2 * c][r]) + yoff * (1.0f / 15.0f);
                    const float pv = ALPHA * xv[e] + gt2v[e] * yv; pre[e] = pv; s += pv; }
        const float mean = wave_sum_fast(s) * (1.0f / 1024.0f); float s2 = 0.f;
#pragma unroll
        for (int e = 0; e < 16; ++e) { pre[e] -= mean; s2 += pre[e] * pre[e]; }
        const float rstd = rsqrtf(wave_sum_fast(s2) * (1.0f / 1024.0f) + LN_EPS);
#pragma unroll
        for (int c = 0; c < 2; ++c)
#pragma unroll
            for (int hf = 0; hf < 2; ++hf)
#pragma unroll
                for (int r = 0; r < 4; ++r) { const int e = 8 * c + 4 * hf + r;
                    xr[dbase + 512 * c + 32 * r + 4 * hf] = pre[e] * rstd * lgv[e] + lbv[e]; }
    }
}

#define XB_TMO      128
#define XB_XCNT(j)  (256  + 64 * (j))
#define XB_XSUB(j)  (1280 + 64 * (j))
#define XB_XGEN(j)  (2304 + 64 * (j))
#define XB_TOP      3328
#define XB_TOPGEN   3392
#define XCD_BAR_WORDS 3456
#define XB_SPIN_CAP (1u << 22)
__device__ __forceinline__ unsigned xb_ld(unsigned* p)              { return __hip_atomic_load(p, __ATOMIC_RELAXED, __HIP_MEMORY_SCOPE_AGENT); }
__device__ __forceinline__ unsigned xb_add(unsigned* p, unsigned v) { return __hip_atomic_fetch_add(p, v, __ATOMIC_RELAXED, __HIP_MEMORY_SCOPE_AGENT); }
#define XB_SPIN(cond, bar) do { unsigned _sp = 0; while (cond) { __builtin_amdgcn_s_sleep(1); \
    if ((++_sp & 255u) == 0u) { if (xb_ld(&(bar)[XB_TMO])) break; if (_sp > XB_SPIN_CAP) { atomicAdd(&(bar)[XB_TMO], 1u); break; } } } } while (0)
struct XcdBarrier { unsigned* bar; unsigned x; volatile LAS unsigned* st; };
__device__ __forceinline__ XcdBarrier xcd_barrier_post(unsigned* bar, volatile LAS unsigned* st) {
    XcdBarrier b; b.bar = bar; b.x = xcc_id(); b.st = st;
    if (threadIdx.x == 0) (void)xb_add(&bar[XB_XCNT(b.x)], 1u);
    return b;
}
__device__ __forceinline__ void xcd_barrier_complete(unsigned* bar, unsigned x, unsigned& nloc, unsigned& nx) {
    const unsigned G = gridDim.x * gridDim.y * gridDim.z;
    unsigned sum, cnt, mine, sp = 0u;
    for (;;) {
        sum = 0u; cnt = 0u; mine = 0u;
#pragma unroll
        for (unsigned j = 0; j < 16; ++j) { const unsigned c = xb_ld(&bar[XB_XCNT(j)]); sum += c; cnt += (c > 0u) ? 1u : 0u; mine = (j == x) ? c : mine; }
        if (sum == G) break;
        __builtin_amdgcn_s_sleep(1);
        if ((++sp & 255u) == 0u) { if (xb_ld(&bar[XB_TMO])) break; if (sp > XB_SPIN_CAP) { atomicAdd(&bar[XB_TMO], 1u); break; } }
    }
    nloc = mine > 0u ? mine : 1u; nx = cnt > 0u ? cnt : 1u;
}
__device__ __forceinline__ void xcd_barrier(const XcdBarrier& b) {
    asm volatile("s_waitcnt vmcnt(0)" ::: "memory");
    __syncthreads();
    if (threadIdx.x == 0) {
        unsigned* bar = b.bar;
        __builtin_amdgcn_s_waitcnt(0);
        unsigned nloc = b.st[0], nx = b.st[1];
        if (nloc == 0u) { xcd_barrier_complete(bar, b.x, nloc, nx); b.st[0] = nloc; b.st[1] = nx; }
        const unsigned old = xb_add(&bar[XB_XSUB(b.x)], 1u);
        const unsigned gen = old / nloc;
        if (old + 1u == (gen + 1u) * nloc) {
            __builtin_amdgcn_fence(__ATOMIC_RELEASE, "agent");
            asm volatile("s_waitcnt vmcnt(0)" ::: "memory");
            const unsigned og = xb_add(&bar[XB_TOP], 1u);
            const unsigned tg = og / nx;
            if (og + 1u == (tg + 1u) * nx) xb_add(&bar[XB_TOPGEN], 1u);
            else XB_SPIN(xb_ld(&bar[XB_TOPGEN]) == tg, bar);
            __builtin_amdgcn_fence(__ATOMIC_ACQUIRE, "agent");
            xb_add(&bar[XB_XGEN(b.x)], 1u);
            asm volatile("s_waitcnt vmcnt(0)" ::: "memory");
        } else {
            XB_SPIN(xb_ld(&bar[XB_XGEN(b.x)]) == gen, bar);
            __builtin_amdgcn_fence(__ATOMIC_ACQUIRE, "agent");
            asm volatile("s_waitcnt vmcnt(0)" ::: "memory");
        }
    }
    __syncthreads();
}

__global__ void __launch_bounds__(NTHR, 2) fwd_megakernel(Params P) {
    extern __shared__ __attribute__((aligned(16))) unsigned char shm[];
    LAS unsigned char* lds = (LAS unsigned char*)shm;
    cg::grid_group grid = cg::this_grid();
    const int G = gridDim.x, bid = blockIdx.x;
    volatile LAS unsigned* xst = (volatile LAS unsigned*)(lds + LDS_BYTES - 128);
    if (threadIdx.x == 0) { xst[0] = 0u; xst[1] = 0u; }
    __syncthreads();
    const XcdBarrier xb = xcd_barrier_post((unsigned*)(P.ws + OFF_BAR), xst);

#ifndef P3
#define P3 0xff
#endif
#ifndef PH
#define PH 0xff
#endif
    if (PH & 1) phase0a(P, lds);
    grid.sync();
    if (PH & 2) phase0b(P);
    xcd_barrier(xb);
    if (PH & 4) {
        pg8::Gemm g; g.A = (const bf16_t*)(P.ws + OFF_H); g.Bt = (const bf16_t*)(P.ws + OFF_WIN); g.M = NTOK; g.N = INCOLS; { int k_ = 512; asm volatile("" : "+s"(k_)); g.K = k_; g.lda = k_; }
        pg8::StaticOrder S; S.init(NTOK, INCOLS, G, bid);
        EpiProj E; E.ws = P.ws; E.lb = (const float*)(P.ws + OFF_LB); E.ng = P.hgrn_ng; E.kmean = (float*)(P.ws + OFF_KMEAN);
        pg8::gemm_phase<EpiProj, pg8::StaticOrder, true>(lds, g, S, E);
    }
    xcd_barrier(xb);
    if (PH & 8) for (int it = bid; it < 256; it += G) hgrn_item(P, it, lds);
    if (PH & 16) for (int u = bid; u < 2048; u += G) { const int bh = u & 255, jj = u >> 8; moba_unit(P, bh >> 3, bh & 7, (jj + bh) & 7, lds); }
    xcd_barrier(xb);
    if ((PH & 32) && bid < NTOK / 256) { const int pm = bid;
        if (P3 & 1) yb_norm_panel(P, pm);
        __syncthreads();
        if (P3 & 2) { pg8::Gemm g; g.A = (const bf16_t*)(P.ws + OFF_EG); g.Bt = (const bf16_t*)(P.ws + OFF_WBA); g.M = NTOK; g.N = 1024; { int k_ = 256; asm volatile("" : "+s"(k_)); g.K = k_; } g.lda = 512;
          pg8::PanelOrder S; S.pm = pm; S.npn = 4; EpiMixA E; E.GA = P.ws + OFF_GA;
          pg8::gemm_phase<EpiMixA, pg8::PanelOrder, true>(lds, g, S, E); }
        __syncthreads();
        if (P3 & 4) { pg8::Gemm g; g.A = (const bf16_t*)(P.ws + OFF_EG + 512); g.Bt = (const bf16_t*)(P.ws + OFF_WBB); g.M = NTOK; g.N = 1024; { int k_ = 256; asm volatile("" : "+s"(k_)); g.K = k_; } g.lda = 512;
          pg8::PanelOrder S; S.pm = pm; S.npn = 4; EpiMixB E; E.GA = P.ws + OFF_GA; E.GB = P.ws + OFF_GB; E.M8 = P.ws + OFF_QA;
          pg8::gemm_phase<EpiMixB, pg8::PanelOrder, true>(lds, g, S, E); }
        __syncthreads();
        if (P3 & 8) { pg8::Gemm g; g.A = (const bf16_t*)(P.ws + OFF_QA); g.Bt = (const bf16_t*)(P.ws + OFF_WOUT); g.M = NTOK; g.N = 1024; { int k_ = 512; asm volatile("" : "+s"(k_)); g.K = k_; g.lda = k_; }
          pg8::PanelOrder S; S.pm = pm; S.npn = 4; EpiOut E; E.ada = (const float*)(P.ws + OFF_ADA); E.D = (bf16_t*)(P.ws + OFF_GB);
          pg8::gemm_phase<EpiOut, pg8::PanelOrder, true>(lds, g, S, E); }
        __syncthreads();
        if (P3 & 16) ln1_panel(P, pm);
        __syncthreads();
        if (P3 & 32) { pg8::Gemm g; g.A = (const bf16_t*)(P.ws + OFF_H); g.Bt = (const bf16_t*)(P.ws + OFF_WQ); g.M = NTOK; g.N = 1024; g.K = 1024; g.lda = 1024;
          pg8::PanelOrder S; S.pm = pm; S.npn = 4; EpiBf16 E; E.O = (bf16_t*)(P.ws + OFF_GB);
          pg8::gemm_phase<EpiBf16, pg8::PanelOrder>(lds, g, S, E); }
        __syncthreads();
        { const size_t tok0 = (size_t)pm * 256 + (tid_opaque() >> 6) * 32;
          peer_select_wave(P, tok0);
          __syncthreads();
#pragma unroll 1
          for (int sb = 0; sb < 4; ++sb) {
              peer_u_tokens(P, lds, tok0 + 8 * sb);
              __syncthreads();
              peer_v_tokens(P, lds, tok0 + 8 * sb);
              __syncthreads();
          } }
    }
}

extern "C" void kernel_launch(void* const* d_in, const int* in_sizes, int n_in, void* d_out, int out_size, void* d_ws, size_t ws_size, hipStream_t stream) {
    static int grid_blocks = 0;
    if (grid_blocks == 0) {
        if (n_in != 18 || out_size != NTOK * DM || ws_size < WS_END) { fprintf(stderr, "kernel_launch: unexpected shapes (n_in %d, out %d, ws %zu, need %zu)\n", n_in, out_size, ws_size, (size_t)WS_END); grid_blocks = -1; return; }
        int dev = 0, cus = 0, per_cu = 0;
        hipGetDevice(&dev);
        hipDeviceGetAttribute(&cus, hipDeviceAttributeMultiprocessorCount, dev);
        if (hipFuncSetAttribute((const void*)fwd_megakernel, hipFuncAttributeMaxDynamicSharedMemorySize, LDS_BYTES) != hipSuccess) fprintf(stderr, "kernel_launch: hipFuncSetAttribute failed\n");
        hipOccupancyMaxActiveBlocksPerMultiprocessor(&per_cu, (const void*)fwd_megakernel, NTHR, LDS_BYTES);
        if (per_cu < 1) { fprintf(stderr, "kernel_launch: occupancy query says %d blocks per CU\n", per_cu); per_cu = 1; }
        if (per_cu > 1) per_cu = 1;
        grid_blocks = cus * per_cu;
        if (grid_blocks != NTOK / 256) { fprintf(stderr, "kernel_launch: built for a %d-CU device (one 256-token panel per workgroup), found %d\n", NTOK / 256, grid_blocks); grid_blocks = -1; return; }
        (void)hipGetLastError();
    }
    if (grid_blocks < 0) return;
    Params p{};
    p.x = (const float*)d_in[0]; p.c = (const float*)d_in[1]; p.w_ada = (const float*)d_in[2]; p.b_ada = (const float*)d_in[3]; p.w_in = (const float*)d_in[4];
    p.w_ba = (const float*)d_in[5]; p.w_bb = (const float*)d_in[6]; p.w_out = (const float*)d_in[7]; p.hgrn_lb = (const float*)d_in[8]; p.hgrn_ng = (const float*)d_in[9];
    p.ln1_g = (const float*)d_in[10]; p.ln1_b = (const float*)d_in[11]; p.peer_wq = (const float*)d_in[12]; p.peer_sk = (const float*)d_in[13]; p.peer_u = (const float*)d_in[14];
    p.peer_v = (const float*)d_in[15]; p.ln2_g = (const float*)d_in[16]; p.ln2_b = (const float*)d_in[17];
    p.out = (float*)d_out; p.ws = (unsigned char*)d_ws;
    if (hipMemsetAsync((char*)d_ws + OFF_BAR, 0, XCD_BAR_WORDS * 4, stream) != hipSuccess) fprintf(stderr, "kernel_launch: memset of the barrier words failed\n");
    void* args[] = {&p};
    hipError_t e = hipLaunchCooperativeKernel((const void*)fwd_megakernel, dim3(grid_blocks), dim3(NTHR), args, LDS_BYTES, stream);
    if (e != hipSuccess) fprintf(stderr, "cooperative launch failed: %s (grid %d)\n", hipGetErrorString(e), grid_blocks);
}
```

```cpp
#include <hip/hip_runtime.h>
#include <hip/hip_cooperative_groups.h>
#include <cstdio>
#include <cstdint>
#include <type_traits>
namespace cg = cooperative_groups;

#define LAS __attribute__((address_space(3)))
typedef unsigned short bf16_t;
typedef short bf16x8 __attribute__((ext_vector_type(8)));
typedef short s16x4 __attribute__((ext_vector_type(4)));
typedef float f32x2 __attribute__((ext_vector_type(2)));
typedef float f32x4 __attribute__((ext_vector_type(4)));
typedef float f32x16 __attribute__((ext_vector_type(16)));
typedef unsigned u32x2 __attribute__((ext_vector_type(2)));
typedef unsigned u32x4 __attribute__((ext_vector_type(4)));

constexpr int NB = 32, SEQ = 2048, DM = 1024, NTOK = NB * SEQ;
constexpr int INCOLS = 5632;
constexpr int NTHR = 512;
constexpr int LDS_BYTES = 147456;
constexpr float ALPHA = 1.189207115002721f;
constexpr float LN_EPS = 1e-5f, RMS_EPS = 1e-6f;
constexpr float LOG2E = 1.4426950408889634f;

constexpr size_t SZ_T512 = (size_t)NTOK * 512 * 2, SZ_T1024 = (size_t)NTOK * 1024 * 2;
constexpr size_t OFF_ADA = 0;
constexpr size_t OFF_LB = OFF_ADA + 786432;
constexpr size_t OFF_KMEAN = OFF_LB + 4096;
constexpr size_t OFF_WIN = OFF_KMEAN + 524288;
constexpr size_t OFF_WBA = OFF_WIN + (size_t)5632 * 1024 * 2;
constexpr size_t OFF_WBB = OFF_WBA + 1048576;
constexpr size_t OFF_WOUT = OFF_WBB + 1048576;
constexpr size_t OFF_WQ = OFF_WOUT + 2097152;
constexpr size_t OFF_SK = OFF_WQ + 2097152;
constexpr size_t OFF_U8 = OFF_SK + 262144;
constexpr size_t OFF_USC = OFF_U8 + 8388608;
constexpr size_t OFF_V8 = OFF_U8 + 16777216;
constexpr size_t OFF_VSC = OFF_V8 + 8388608;
constexpr size_t OFF_CTR = OFF_V8 + 16777216;
constexpr size_t OFF_BAR = OFF_CTR + 4096;
constexpr size_t OFF_EG = OFF_BAR + 16384;
constexpr size_t OFF_H = OFF_EG + (size_t)NTOK * 128 * 8;
constexpr size_t OFF_QA = OFF_H + SZ_T1024;
constexpr size_t OFF_KA = OFF_QA + SZ_T512;
constexpr size_t OFF_VA = OFF_KA + SZ_T512;
constexpr size_t OFF_HQ = OFF_VA + SZ_T512;
constexpr size_t OFF_HK = OFF_HQ + SZ_T512;
constexpr size_t OFF_HI = OFF_HK + SZ_T512;
constexpr size_t OFF_HG = OFF_HI + SZ_T512;
constexpr size_t OFF_GA = OFF_HG + SZ_T512;
constexpr size_t OFF_GB = OFF_GA + SZ_T1024;
constexpr size_t WS_END = OFF_GB + SZ_T1024;
constexpr size_t OFF_H8 = OFF_VA;
constexpr size_t OFF_HS = OFF_HQ;
constexpr size_t OFF_W = OFF_KA;
constexpr size_t OFF_Y = OFF_KA;

struct Params {
    const float *x, *c, *w_ada, *b_ada, *w_in, *w_ba, *w_bb, *w_out, *hgrn_lb, *hgrn_ng, *ln1_g, *ln1_b, *peer_wq, *peer_sk, *peer_u, *peer_v, *ln2_g, *ln2_b;
    float* out;
    unsigned char* ws;
};

typedef __bf16 bf16v2 __attribute__((ext_vector_type(2)));
__device__ __forceinline__ unsigned cvt_pk_bf16(float lo, float hi) { return __builtin_bit_cast(unsigned, __builtin_convertvector((f32x2){lo, hi}, bf16v2)); }
__device__ __forceinline__ float bf_lo(unsigned w) { return __uint_as_float(w << 16); }
__device__ __forceinline__ float bf_hi(unsigned w) { return __uint_as_float(w & 0xffff0000u); }
__device__ __forceinline__ float sigmoidf_(float x) { return __builtin_amdgcn_rcpf(1.0f + __builtin_amdgcn_exp2f(-LOG2E * x)); }
__device__ __forceinline__ float wave_sum(float v) {
#pragma unroll
    for (int o = 1; o < 64; o <<= 1) v += __shfl_xor(v, o);
    return v;
}
__device__ __forceinline__ int tid_opaque() { int t = threadIdx.x; asm volatile("" : "+v"(t)); return t; }
__device__ __forceinline__ int crow(int r, int hi) { return (r & 3) + 8 * (r >> 2) + 4 * hi; }
#define MFMA32(a, b, c) __builtin_amdgcn_mfma_f32_32x32x16_bf16(a, b, c, 0, 0, 0)

namespace pg8 {
constexpr int BM = 256, BK = 64, HALF = 128, HTB = HALF * BK * 2, STAGE_BYTES = 8 * HTB, NXCD = 8, WGM = 8;
__host__ __device__ __forceinline__ int lds_byte(int r, int c) { const int st = (r >> 4) * 2 + (c >> 5), rr = r & 15, cc = c & 31, ob = rr * 64 + cc * 2; return st * 1024 + (ob ^ (((ob >> 9) & 1) << 5)); }
__host__ __device__ __forceinline__ void stage_rc(int b, int& R, int& C) { const int st = b / 1024, sb = b % 1024, swz = sb ^ (((sb >> 9) & 1) << 5); R = (st >> 1) * 16 + swz / 64; C = (st & 1) * 32 + (swz % 64) / 2; }
__host__ __device__ __forceinline__ int perm32(int rho) { const int n = rho >> 4, i = rho & 15; return 8 * (i >> 2) + 4 * n + (i & 3); }

struct Unit { int pm, pn; };
struct Gemm { const bf16_t* A; const bf16_t* Bt; int M, N, K, lda; };

struct StaticOrder {
    int nM, nN, nwg, G, c;
    __device__ void init(int M, int N, int G_, int c_) { nM = M / BM; nN = N / BM; nwg = nM * nN; G = G_; c = c_; }
    __device__ bool next(int i, Unit& u) const {
        const long L = (long)i * G + c; if (L >= nwg) return false;
        int wgid = (int)L; { const int q = nwg / NXCD, r = nwg % NXCD, xcd = wgid % NXCD, off = wgid / NXCD; wgid = (xcd < r ? xcd * (q + 1) : r * (q + 1) + (xcd - r) * q) + off; }
        const int nig = WGM * nN, gid = wgid / nig, fm = gid * WGM, gsz = (nM - fm) < WGM ? (nM - fm) : WGM;
        u.pm = fm + ((wgid % nig) % gsz); u.pn = (wgid % nig) / gsz; return true;
    }
};
struct PanelOrder {
    int pm, npn;
    __device__ bool next(int i, Unit& u) const { if (i >= npn) return false; u.pm = pm; u.pn = i; return true; }
};

template <class Epi, class Sched, bool MX = false>
__device__ __forceinline__ void gemm_phase(LAS unsigned char* lds, const Gemm g, const Sched& S, const Epi& E) {
    const int tid = tid_opaque(), wid = __builtin_amdgcn_readfirstlane(tid >> 6), lane = tid & 63, wr = wid >> 2, wc = wid & 3, fr = lane & 15, fq = lane >> 4;
    const int K = g.K, nt = K / BK;
    unsigned voffA, voffB;
    { int R, C; stage_rc(tid * 16, R, C); const int Rb = Epi::PERM ? ((R & ~31) + perm32(R & 31)) : R;
      voffA = (unsigned)(R * g.lda + C) * 2u; voffB = (unsigned)(Rb * K + C) * 2u; }
    const size_t rvoffA = (size_t)128 * g.lda, rvoffB = (size_t)128 * K;
    const size_t kstep = (size_t)(BK * 2);
    const size_t hstep = (size_t)HALF * K * 2;
    const size_t tstep = 2 * hstep;
    const size_t hstepA = (size_t)HALF * g.lda * 2, tstepA = 2 * hstepA;
    const unsigned ldsw = (unsigned)wid * 1024u;
    const int aoff = lds_byte(wr * 64 + fr, fq * 8), boff = lds_byte(wc * 32 + fr, fq * 8);
#define PG8_SA(b, h) (((b) * 2 + (h)) * HTB)
#define PG8_SB(b, h) ((4 + (b) * 2 + (h)) * HTB)
#define PG8_STAGE(bufoff, gbase, voff) do { unsigned vo_ = (voff); asm volatile("" : "+v"(vo_));     \
        _Pragma("unroll") for (int _i = 0; _i < 2; ++_i) \
        __builtin_amdgcn_global_load_lds((const unsigned*)((const char*)(gbase) + _i * r##voff + vo_), (LAS unsigned*)(lds + (bufoff) + ldsw + _i * 8192), 16, 0, 0); } while (0)
#define PG8_LDX(dst, off) do { const v4i_ lo_ = *(const LAS v4i_*)(lds + (off)), hi_ = *(const LAS v4i_*)(lds + (off) + 1024); dst = __builtin_shufflevector(lo_, hi_, 0, 1, 2, 3, 4, 5, 6, 7); } while (0)
#define PG8_LDA(dst, b, h) do { if constexpr (MX) { _Pragma("unroll") for (int m = 0; m < 4; ++m) PG8_LDX(dst##X[m], PG8_SA(b, h) + aoff + m * 2048); } \
        else { _Pragma("unroll") for (int m = 0; m < 4; ++m) _Pragma("unroll") for (int k = 0; k < 2; ++k) dst[m][k] = *(const LAS bf16x8*)(lds + PG8_SA(b, h) + aoff + m * 2048 + k * 1024); } } while (0)
#define PG8_LDB(dst, b, h) do { if constexpr (MX) { _Pragma("unroll") for (int n = 0; n < 2; ++n) PG8_LDX(dst##X[n], PG8_SB(b, h) + boff + n * 2048); } \
        else { _Pragma("unroll") for (int n = 0; n < 2; ++n) _Pragma("unroll") for (int k = 0; k < 2; ++k) dst[n][k] = *(const LAS bf16x8*)(lds + PG8_SB(b, h) + boff + n * 2048 + k * 1024); } } while (0)
#define PG8_MMA(ai, bj, At, Bt) do { __builtin_amdgcn_s_setprio(1); \
        if constexpr (MX) { _Pragma("unroll") for (int m = 0; m < 4; ++m) _Pragma("unroll") for (int n = 0; n < 2; ++n) \
            asm volatile("v_mfma_scale_f32_16x16x128_f8f6f4 %0, %1, %2, %0, %3, %4 op_sel_hi:[0,0,0]" : "+v"(acc[ai][bj][m][n]) : "v"(Bt##X[n]), "v"(At##X[m]), "v"(mxscale), "v"(mxscale5)); } \
        else { _Pragma("unroll") for (int m = 0; m < 4; ++m) _Pragma("unroll") for (int n = 0; n < 2; ++n) _Pragma("unroll") for (int k = 0; k < 2; ++k) \
            acc[ai][bj][m][n] = __builtin_amdgcn_mfma_f32_16x16x32_bf16(Bt[n][k], At[m][k], acc[ai][bj][m][n], 0, 0, 0); } \
        __builtin_amdgcn_s_setprio(0); } while (0)
#define PG8_WAIT_V(n) asm volatile("s_waitcnt vmcnt(" #n ")" ::: "memory")
#define PG8_WAIT_L(n) asm volatile("s_waitcnt lgkmcnt(" #n ")" ::: "memory")
#define PG8_BAR __builtin_amdgcn_s_barrier()
#define PG8_SCHED __builtin_amdgcn_sched_barrier(0)
    Unit cur, nxt; int ui = 0;
    if (!S.next(0, cur)) return;
    f32x4 acc[2][2][4][2];
#pragma unroll
    for (int a = 0; a < 2; ++a)
#pragma unroll
        for (int b = 0; b < 2; ++b)
#pragma unroll
            for (int m = 0; m < 4; ++m)
#pragma unroll
                for (int n = 0; n < 2; ++n) acc[a][b][m][n] = (f32x4){0.f, 0.f, 0.f, 0.f};
    typedef int v4i_ __attribute__((ext_vector_type(4))); typedef int v8i_ __attribute__((ext_vector_type(8)));
    bf16x8 At[4][2], B0[2][2], B1[2][2];
    v8i_ AtX[4], B0X[2], B1X[2];
    const int mxscale = 0x7f7f7f7f, mxscale5 = 0x7a7a7a7a;
    const char* cA = (const char*)g.A + (size_t)cur.pm * tstepA; const char* cB = (const char*)g.Bt + (size_t)cur.pn * tstep;
    PG8_STAGE(PG8_SB(0, 0), cB, voffB); PG8_STAGE(PG8_SA(0, 0), cA, voffA); PG8_STAGE(PG8_SB(0, 1), cB + hstep, voffB); PG8_STAGE(PG8_SA(0, 1), cA + hstepA, voffA);
    if (wr == 1) PG8_BAR;
    PG8_WAIT_V(4); PG8_BAR;
    PG8_STAGE(PG8_SB(1, 0), cB + kstep, voffB); PG8_STAGE(PG8_SA(1, 0), cA + kstep, voffA); PG8_STAGE(PG8_SB(1, 1), cB + hstep + kstep, voffB);
    PG8_WAIT_V(6); PG8_BAR;
    for (;;) {
        const bool has_next = S.next(ui + 1, nxt);
        const char* nA = has_next ? (const char*)g.A + (size_t)nxt.pm * tstepA : cA; const char* nB = has_next ? (const char*)g.Bt + (size_t)nxt.pn * tstep : cB;
        for (int t = 0; t < nt; t += 2) {
            const bool last = (t == nt - 2);
            const char* a1 = cA + (size_t)(t + 1) * kstep;
            const char* a2 = last ? nA : cA + (size_t)(t + 2) * kstep; const char* b2 = last ? nB : cB + (size_t)(t + 2) * kstep;
            const char* a3 = a2 + kstep; const char* b3 = b2 + kstep;
            PG8_LDB(B0, 0, 0); PG8_SCHED; PG8_LDA(At, 0, 0); PG8_STAGE(PG8_SA(1, 1), a1 + hstepA, voffA);
            PG8_WAIT_L(8); PG8_BAR; PG8_WAIT_L(0); PG8_MMA(0, 0, At, B0); PG8_BAR; PG8_SCHED;
            PG8_LDB(B1, 0, 1); PG8_STAGE(PG8_SB(0, 0), b2, voffB);
            PG8_BAR; PG8_WAIT_L(0); PG8_MMA(0, 1, At, B1); PG8_BAR;
            PG8_LDA(At, 0, 1); PG8_STAGE(PG8_SA(0, 0), a2, voffA);
            PG8_BAR; PG8_WAIT_L(0); PG8_MMA(1, 0, At, B0); PG8_BAR; PG8_SCHED;
            PG8_STAGE(PG8_SB(0, 1), b2 + hstep, voffB);
            PG8_WAIT_V(6); PG8_BAR; PG8_MMA(1, 1, At, B1); PG8_BAR;
            PG8_LDB(B0, 1, 0); PG8_SCHED; PG8_LDA(At, 1, 0); PG8_STAGE(PG8_SA(0, 1), a2 + hstepA, voffA);
            PG8_WAIT_L(8); PG8_BAR; PG8_WAIT_L(0); PG8_MMA(0, 0, At, B0); PG8_BAR; PG8_SCHED;
            PG8_LDB(B1, 1, 1); PG8_STAGE(PG8_SB(1, 0), b3, voffB);
            PG8_BAR; PG8_WAIT_L(0); PG8_MMA(0, 1, At, B1); PG8_BAR;
            PG8_LDA(At, 1, 1); PG8_STAGE(PG8_SA(1, 0), a3, voffA);
            PG8_BAR; PG8_WAIT_L(0); PG8_MMA(1, 0, At, B0); PG8_BAR; PG8_SCHED;
            PG8_STAGE(PG8_SB(1, 1), b3 + hstep, voffB);
            PG8_WAIT_V(6); PG8_BAR; PG8_MMA(1, 1, At, B1); PG8_BAR;
        }
        if constexpr (MX) asm volatile("s_nop 15\n\ts_nop 15" ::: "memory");
        if (wr == 0) PG8_BAR;
        E(acc, cur, wr, wc, fr, fq);
        if (wr == 1) PG8_BAR;
        if (!has_next) break;
#pragma unroll
        for (int a = 0; a < 2; ++a)
#pragma unroll
            for (int b = 0; b < 2; ++b)
#pragma unroll
                for (int m = 0; m < 4; ++m)
#pragma unroll
                    for (int n = 0; n < 2; ++n) acc[a][b][m][n] = (f32x4){0.f, 0.f, 0.f, 0.f};
        cur = nxt; cA = nA; cB = nB; ++ui;
    }
    PG8_WAIT_V(0);
    if (wr == 0) PG8_BAR;
    PG8_BAR;
#undef PG8_SA
#undef PG8_SB
#undef PG8_STAGE
#undef PG8_LDX
#undef PG8_LDA
#undef PG8_LDB
#undef PG8_MMA
#undef PG8_WAIT_V
#undef PG8_WAIT_L
#undef PG8_BAR
#undef PG8_SCHED
}
}
using pg8::Unit;

struct EpiProj {
    static constexpr bool PERM = true;
    unsigned char* ws; const float* lb; const float* ng; float* kmean;
    __device__ __forceinline__ void operator()(const f32x4 (&acc)[2][2][4][2], const Unit& u, int wr, int wc, int fr, int fq) const {
        const int pn = u.pn; int seg, colt, ldc; size_t boff;
        if (pn < 14) { seg = pn >> 1; colt = (pn & 1) * 256; ldc = 512; boff = OFF_QA + (size_t)seg * SZ_T512; }
        else if (pn < 18) { seg = 7; colt = (pn - 14) * 256; ldc = 1024; boff = OFF_GA; }
        else { seg = 8; colt = (pn - 18) * 256; ldc = 1024; boff = OFF_GB; }
        bf16_t* base = (bf16_t*)(ws + boff);
        const int row0 = u.pm * 256 + wr * 64 + fr, col0 = colt + wc * 32 + 8 * fq;
        float pv[2][8];
#pragma unroll
        for (int bj = 0; bj < 2; ++bj)
#pragma unroll
            for (int e = 0; e < 8; ++e) pv[bj][e] = (seg == 4) ? (1.0f - lb[col0 + bj * 128 + e]) : ((seg == 6) ? ng[col0 + bj * 128 + e] : 0.f);
        float cs[2][8];
#pragma unroll
        for (int bj = 0; bj < 2; ++bj)
#pragma unroll
            for (int e = 0; e < 8; ++e) cs[bj][e] = 0.f;
#pragma unroll
        for (int ai = 0; ai < 2; ++ai)
#pragma unroll
            for (int m = 0; m < 4; ++m) {
                bf16_t* rowp = base + (size_t)(row0 + ai * 128 + m * 16) * ldc + col0;
#pragma unroll
                for (int bj = 0; bj < 2; ++bj) {
                    float v[8];
#pragma unroll
                    for (int e = 0; e < 4; ++e) { v[e] = acc[ai][bj][m][0][e]; v[4 + e] = acc[ai][bj][m][1][e]; }
                    if (seg == 0) {
#pragma unroll
                        for (int e = 0; e < 8; ++e) v[e] *= (0.125f * LOG2E);
                    } else if (seg == 1) {
#pragma unroll
                        for (int e = 0; e < 8; ++e) cs[bj][e] += v[e];
                    } else if (seg == 3) {
#pragma unroll
                        for (int e = 0; e < 8; ++e) v[e] = v[e] * sigmoidf_(v[e]);
                    } else if (seg == 4) {
#pragma unroll
                        for (int e = 0; e < 8; ++e) v[e] = pv[bj][e] * sigmoidf_(-v[e]);
                    } else if (seg == 6) {
#pragma unroll
                        for (int e = 0; e < 8; ++e) v[e] = pv[bj][e] * v[e] * sigmoidf_(v[e]);
                    } else if (seg >= 7) {
#pragma unroll
                        for (int e = 0; e < 8; ++e) v[e] = sigmoidf_(v[e]);
                    }
                    if (seg >= 7) {
                        int w0 = __builtin_amdgcn_cvt_pk_fp8_f32(v[0], v[1], 0, false); w0 = __builtin_amdgcn_cvt_pk_fp8_f32(v[2], v[3], w0, true);
                        int w1 = __builtin_amdgcn_cvt_pk_fp8_f32(v[4], v[5], 0, false); w1 = __builtin_amdgcn_cvt_pk_fp8_f32(v[6], v[7], w1, true);
                        *(u32x2*)((unsigned char*)rowp - col0 + bj * 128) = (u32x2){(unsigned)w0, (unsigned)w1};
                    } else {
                    u32x4 w; w.x = cvt_pk_bf16(v[0], v[1]); w.y = cvt_pk_bf16(v[2], v[3]); w.z = cvt_pk_bf16(v[4], v[5]); w.w = cvt_pk_bf16(v[6], v[7]);
                    *(u32x4*)(rowp + bj * 128) = w; }
                }
            }
        if (seg == 1) {
#pragma unroll
            for (int bj = 0; bj < 2; ++bj)
#pragma unroll
                for (int e = 0; e < 8; ++e) {
                    float s = cs[bj][e];
                    s += __shfl_xor(s, 1); s += __shfl_xor(s, 2); s += __shfl_xor(s, 4); s += __shfl_xor(s, 8);
                    if (fr == 0) atomicAdd(kmean + (size_t)u.pm * 512 + col0 + bj * 128 + e, s);
                }
        }
    }
};
__device__ __forceinline__ void fp8x8_to_f32(const u32x2 w, float (&f)[8]) {
    const f32x2 a = __builtin_amdgcn_cvt_pk_f32_fp8((int)w.x, false), b = __builtin_amdgcn_cvt_pk_f32_fp8((int)w.x, true), c = __builtin_amdgcn_cvt_pk_f32_fp8((int)w.y, false), d = __builtin_amdgcn_cvt_pk_f32_fp8((int)w.y, true);
    f[0] = a.x; f[1] = a.y; f[2] = b.x; f[3] = b.y; f[4] = c.x; f[5] = c.y; f[6] = d.x; f[7] = d.y;
}
struct EpiMixA {
    static constexpr bool PERM = true;
    unsigned char* GA;
    __device__ __forceinline__ void operator()(const f32x4 (&acc)[2][2][4][2], const Unit& u, int wr, int wc, int fr, int fq) const {
        asm volatile("" : "+v"(fr), "+v"(fq));
        const int row0 = u.pm * 256 + wr * 64 + fr, col0 = u.pn * 256 + wc * 32 + 8 * fq;
#pragma unroll
        for (int ai = 0; ai < 2; ++ai)
#pragma unroll
            for (int m = 0; m < 4; ++m) {
                unsigned char* rowp = GA + (size_t)(row0 + ai * 128 + m * 16) * 2048 + col0;
#pragma unroll
                for (int bj = 0; bj < 2; ++bj) {
                    float g[8]; fp8x8_to_f32(*(const u32x2*)(rowp + bj * 128), g);
                    const f32x4 a0 = acc[ai][bj][m][0], a1 = acc[ai][bj][m][1];
                    int w0 = __builtin_amdgcn_cvt_pk_fp8_f32(g[0] * a0[0], g[1] * a0[1], 0, false); w0 = __builtin_amdgcn_cvt_pk_fp8_f32(g[2] * a0[2], g[3] * a0[3], w0, true);
                    int w1 = __builtin_amdgcn_cvt_pk_fp8_f32(g[4] * a1[0], g[5] * a1[1], 0, false); w1 = __builtin_amdgcn_cvt_pk_fp8_f32(g[6] * a1[2], g[7] * a1[3], w1, true);
                    *(u32x2*)(rowp + bj * 128) = (u32x2){(unsigned)w0, (unsigned)w1};
                }
            }
    }
};
struct EpiMixB {
    static constexpr bool PERM = true;
    const unsigned char* GA; const unsigned char* GB; unsigned char* M8;
    __device__ __forceinline__ void operator()(const f32x4 (&acc)[2][2][4][2], const Unit& u, int wr, int wc, int fr, int fq) const {
        asm volatile("" : "+v"(fr), "+v"(fq));
        const int row0 = u.pm * 256 + wr * 64 + fr, col0 = u.pn * 256 + wc * 32 + 8 * fq;
#pragma unroll
        for (int ai = 0; ai < 2; ++ai)
#pragma unroll
            for (int m = 0; m < 4; ++m) {
                const size_t row = (size_t)(row0 + ai * 128 + m * 16);
#pragma unroll
                for (int bj = 0; bj < 2; ++bj) {
                    float g[8], pa[8]; fp8x8_to_f32(*(const u32x2*)(GB + row * 2048 + col0 + bj * 128), g); fp8x8_to_f32(*(const u32x2*)(GA + row * 2048 + col0 + bj * 128), pa);
                    const f32x4 a0 = acc[ai][bj][m][0], a1 = acc[ai][bj][m][1];
                    int w0 = __builtin_amdgcn_cvt_pk_fp8_f32(pa[0] + g[0] * a0[0], pa[1] + g[1] * a0[1], 0, false); w0 = __builtin_amdgcn_cvt_pk_fp8_f32(pa[2] + g[2] * a0[2], pa[3] + g[3] * a0[3], w0, true);
                    int w1 = __builtin_amdgcn_cvt_pk_fp8_f32(pa[4] + g[4] * a1[0], pa[5] + g[5] * a1[1], 0, false); w1 = __builtin_amdgcn_cvt_pk_fp8_f32(pa[6] + g[6] * a1[2], pa[7] + g[7] * a1[3], w1, true);
                    *(u32x2*)(M8 + row * 1024 + col0 + bj * 128) = (u32x2){(unsigned)w0, (unsigned)w1};
                }
            }
    }
};
struct EpiOut {
    static constexpr bool PERM = true;
    const float* ada; bf16_t* D;
    __device__ __forceinline__ void operator()(const f32x4 (&acc)[2][2][4][2], const Unit& u, int wr, int wc, int fr, int fq) const {
        const int row0 = u.pm * 256 + wr * 64 + fr, col0 = u.pn * 256 + wc * 32 + 8 * fq;
        const float* gt1 = ada + (size_t)(u.pm >> 3) * 6144 + 2048 + col0;
        f32x4 g[2][2];
#pragma unroll
        for (int bj = 0; bj < 2; ++bj) { g[bj][0] = *(const f32x4*)(gt1 + bj * 128); g[bj][1] = *(const f32x4*)(gt1 + bj * 128 + 4); }
#pragma unroll
        for (int ai = 0; ai < 2; ++ai)
#pragma unroll
            for (int m = 0; m < 4; ++m) {
                bf16_t* rowp = D + (size_t)(row0 + ai * 128 + m * 16) * 1024 + col0;
#pragma unroll
                for (int bj = 0; bj < 2; ++bj) {
                    const f32x4 a0 = acc[ai][bj][m][0] * g[bj][0], a1 = acc[ai][bj][m][1] * g[bj][1];
                    int w0 = __builtin_amdgcn_cvt_pk_fp8_f32(a0[0], a0[1], 0, false); w0 = __builtin_amdgcn_cvt_pk_fp8_f32(a0[2], a0[3], w0, true);
                    int w1 = __builtin_amdgcn_cvt_pk_fp8_f32(a1[0], a1[1], 0, false); w1 = __builtin_amdgcn_cvt_pk_fp8_f32(a1[2], a1[3], w1, true);
                    *(u32x2*)((unsigned char*)rowp - col0 + bj * 128) = (u32x2){(unsigned)w0, (unsigned)w1};
                }
            }
    }
};
struct EpiBf16 {
    static constexpr bool PERM = true;
    bf16_t* O;
    __device__ __forceinline__ void operator()(const f32x4 (&acc)[2][2][4][2], const Unit& u, int wr, int wc, int fr, int fq) const {
        const int row0 = u.pm * 256 + wr * 64 + fr, col0 = u.pn * 256 + wc * 32 + 8 * fq;
#pragma unroll
        for (int ai = 0; ai < 2; ++ai)
#pragma unroll
            for (int m = 0; m < 4; ++m) {
                bf16_t* rowp = O + (size_t)(row0 + ai * 128 + m * 16) * 1024 + col0;
#pragma unroll
                for (int bj = 0; bj < 2; ++bj) {
                    const f32x4 a0 = acc[ai][bj][m][0], a1 = acc[ai][bj][m][1];
                    u32x4 w; w.x = cvt_pk_bf16(a0[0], a0[1]); w.y = cvt_pk_bf16(a0[2], a0[3]); w.z = cvt_pk_bf16(a1[0], a1[1]); w.w = cvt_pk_bf16(a1[2], a1[3]);
                    *(u32x4*)(rowp + bj * 128) = w;
                }
            }
    }
};

__device__ void phase0a(const Params& P, LAS unsigned char* lds) {
    const int tid = tid_opaque(), G = gridDim.x, bid = blockIdx.x;
    for (int it = bid; it < 192; it += G) {
        LAS float* sc = (LAS float*)lds;
        for (int i = tid; i < 32 * 1024; i += NTHR) { const float cv = P.c[i]; sc[i] = cv * sigmoidf_(cv); }
        __syncthreads();
        const int kg = tid >> 5, col = tid & 31;
        float a[32];
#pragma unroll
        for (int b = 0; b < 32; ++b) a[b] = 0.f;
#pragma unroll 1
        for (int k = kg * 64; k < kg * 64 + 64; k += 8) {
            float w[8];
#pragma unroll
            for (int e = 0; e < 8; ++e) w[e] = __builtin_nontemporal_load(P.w_ada + (size_t)(k + e) * 6144 + it * 32 + col);
#pragma unroll
            for (int e4 = 0; e4 < 2; ++e4) {
#pragma unroll
                for (int b = 0; b < 32; ++b) { const f32x4 s = *(const LAS f32x4*)(sc + b * 1024 + k + 4 * e4); a[b] += s[0] * w[4 * e4] + s[1] * w[4 * e4 + 1] + s[2] * w[4 * e4 + 2] + s[3] * w[4 * e4 + 3]; }
                asm volatile("" ::: "memory");
            }
        }
        __syncthreads();
        LAS float* red = (LAS float*)lds;
#pragma unroll
        for (int b = 0; b < 32; ++b) red[(kg * 32 + b) * 32 + col] = a[b];
        __syncthreads();
        for (int o = tid; o < 1024; o += NTHR) { const int b = o >> 5, cc = o & 31; float s = 0.f;
#pragma unroll
            for (int g2 = 0; g2 < 16; ++g2) s += red[(g2 * 32 + b) * 32 + cc];
            ((float*)(P.ws + OFF_ADA))[(size_t)b * 6144 + it * 32 + cc] = s + P.b_ada[it * 32 + cc]; }
        __syncthreads();
    }
    const size_t gsz = (size_t)G * NTHR;
    { const int gt = bid * NTHR + tid, gs = G * NTHR;
      if (gt < 512) ((float*)(P.ws + OFF_LB))[gt] = sigmoidf_(P.hgrn_lb[gt] - P.hgrn_lb[512 + gt]);
      for (int i = gt; i < 32 * 8 * 512; i += gs) ((float*)(P.ws + OFF_KMEAN))[i] = 0.f; }
    {
        LAS float* tile = (LAS float*)lds;
        const int I0 = 16 * 88, I1 = I0 + 8 * 16, I2 = I1 + 8 * 16, I3 = I2 + 16 * 16, I4 = I3 + 16 * 16;
        for (int it = bid; it < I4; it += G) {
            const float* W; bf16_t* WT; int K, N, r;
            if (it < I0) { W = P.w_in; WT = (bf16_t*)(P.ws + OFF_WIN); K = 1024; N = 5632; r = it; }
            else if (it < I1) { W = P.w_ba; WT = (bf16_t*)(P.ws + OFF_WBA); K = 512; N = 1024; r = it - I0; }
            else if (it < I2) { W = P.w_bb; WT = (bf16_t*)(P.ws + OFF_WBB); K = 512; N = 1024; r = it - I1; }
            else if (it < I3) { W = P.w_out; WT = (bf16_t*)(P.ws + OFF_WOUT); K = 1024; N = 1024; r = it - I2; }
            else { W = P.peer_wq; WT = (bf16_t*)(P.ws + OFF_WQ); K = 1024; N = 1024; r = it - I3; }
            const int nb = N / 64, k0 = (r / nb) * 64, n0 = (r % nb) * 64;
#pragma unroll
            for (int ps = 0; ps < 2; ++ps) { const int kk = (tid >> 4) + 32 * ps, n4 = (tid & 15) * 4;
                const f32x4 v = *(const f32x4*)(W + (size_t)(k0 + kk) * N + n0 + n4);
                tile[kk * 65 + n4] = v[0]; tile[kk * 65 + n4 + 1] = v[1]; tile[kk * 65 + n4 + 2] = v[2]; tile[kk * 65 + n4 + 3] = v[3]; }
            __syncthreads();
            { const int n = tid >> 3, kc = (tid & 7) * 8;
              if (it < I3) {
                  int w0 = __builtin_amdgcn_cvt_pk_fp8_f32(32.f * tile[(kc + 0) * 65 + n], 32.f * tile[(kc + 1) * 65 + n], 0, false); w0 = __builtin_amdgcn_cvt_pk_fp8_f32(32.f * tile[(kc + 2) * 65 + n], 32.f * tile[(kc + 3) * 65 + n], w0, true);
                  int w1 = __builtin_amdgcn_cvt_pk_fp8_f32(32.f * tile[(kc + 4) * 65 + n], 32.f * tile[(kc + 5) * 65 + n], 0, false); w1 = __builtin_amdgcn_cvt_pk_fp8_f32(32.f * tile[(kc + 6) * 65 + n], 32.f * tile[(kc + 7) * 65 + n], w1, true);
                  *(u32x2*)((unsigned char*)WT + (size_t)(n0 + n) * K + k0 + kc) = (u32x2){(unsigned)w0, (unsigned)w1};
              } else { u32x4 w;
              w.x = cvt_pk_bf16(tile[(kc + 0) * 65 + n], tile[(kc + 1) * 65 + n]); w.y = cvt_pk_bf16(tile[(kc + 2) * 65 + n], tile[(kc + 3) * 65 + n]);
              w.z = cvt_pk_bf16(tile[(kc + 4) * 65 + n], tile[(kc + 5) * 65 + n]); w.w = cvt_pk_bf16(tile[(kc + 6) * 65 + n], tile[(kc + 7) * 65 + n]);
              *(u32x4*)(WT + (size_t)(n0 + n) * K + k0 + kc) = w; } }
            __syncthreads();
        }
    }
    {
        const size_t gtid = (size_t)bid * NTHR + tid_opaque();
        for (size_t i = gtid; i < 16384; i += gsz) {
            const float* src = P.peer_sk + i * 8; const f32x4 a = *(const f32x4*)src, b = *(const f32x4*)(src + 4);
            u32x4 w; w.x = cvt_pk_bf16(a[0], a[1]); w.y = cvt_pk_bf16(a[2], a[3]); w.z = cvt_pk_bf16(b[0], b[1]); w.w = cvt_pk_bf16(b[2], b[3]);
            *(u32x4*)((bf16_t*)(P.ws + OFF_SK) + i * 8) = w;
        }
        { const int lane = tid & 63, gw = bid * 8 + (tid >> 6), ngw = G * 8;
          for (int r = gw; r < 2 * 16384; r += ngw) {
              const bool isv = r >= 16384; const int e = isv ? r - 16384 : r;
              const float* s = (isv ? P.peer_v : P.peer_u) + (size_t)e * 1024 + lane * 16;
              f32x4 x[4]; float ss = 0.f;
#pragma unroll
              for (int q = 0; q < 4; ++q) { x[q] = __builtin_nontemporal_load((const f32x4*)(s + 4 * q)); ss += (x[q][0] * x[q][0] + x[q][1] * x[q][1]) + (x[q][2] * x[q][2] + x[q][3] * x[q][3]); }
              const float sc = fmaxf(sqrtf(wave_sum(ss) * (1.0f / 1024.0f)) * (2.6f / 7.5f), 1e-30f), inv = 1.0f / sc;
              unsigned nb[16];
#pragma unroll
              for (int q = 0; q < 4; ++q)
#pragma unroll
                  for (int el = 0; el < 4; ++el) nb[4 * q + el] = (unsigned)fminf(fmaxf(floorf(x[q][el] * inv) + 8.0f, 0.0f), 15.0f);
              u32x2 w;
              w.x = (nb[0] | (nb[4] << 4)) | ((nb[1] | (nb[5] << 4)) << 8) | ((nb[2] | (nb[6] << 4)) << 16) | ((nb[3] | (nb[7] << 4)) << 24);
              w.y = (nb[8] | (nb[12] << 4)) | ((nb[9] | (nb[13] << 4)) << 8) | ((nb[10] | (nb[14] << 4)) << 16) | ((nb[11] | (nb[15] << 4)) << 24);
              if (!isv) { w.x ^= 0x88888888u; w.y ^= 0x88888888u; }
              else { w.x ^= 0x80808080u; w.y ^= 0x80808080u; }
              *(u32x2*)(P.ws + (isv ? OFF_V8 : OFF_U8) + (size_t)e * 512 + lane * 8) = w;
              if (lane == 0) ((float*)(P.ws + (isv ? OFF_VSC : OFF_USC)))[e] = sc;
          } }
    }
}
__device__ void phase0b(const Params& P) {
    const size_t gtid = (size_t)blockIdx.x * NTHR + threadIdx.x, gsz = (size_t)gridDim.x * NTHR;
    const float* ada = (const float*)(P.ws + OFF_ADA); bf16_t* H = (bf16_t*)(P.ws + OFF_H);
    for (size_t i = gtid; i < (size_t)NTOK * 128; i += gsz) {
        const size_t row = i >> 7; const int c8 = (int)(i & 127) * 8; const int b = (int)(row >> 11);
        const float* xr = P.x + row * 1024 + c8; const float* sh = ada + (size_t)b * 6144 + c8; const float* sc = sh + 1024;
        const f32x4 x0 = *(const f32x4*)xr, x1 = *(const f32x4*)(xr + 4), s0 = *(const f32x4*)sc, s1 = *(const f32x4*)(sc + 4), h0 = *(const f32x4*)sh, h1 = *(const f32x4*)(sh + 4);
        const f32x4 r0 = x0 * (s0 + 1.0f) + h0, r1 = x1 * (s1 + 1.0f) + h1;
        int w0 = __builtin_amdgcn_cvt_pk_fp8_f32(r0[0], r0[1], 0, false); w0 = __builtin_amdgcn_cvt_pk_fp8_f32(r0[2], r0[3], w0, true);
        int w1 = __builtin_amdgcn_cvt_pk_fp8_f32(r1[0], r1[1], 0, false); w1 = __builtin_amdgcn_cvt_pk_fp8_f32(r1[2], r1[3], w1, true);
        *(u32x2*)((unsigned char*)H + row * 1024 + c8) = (u32x2){(unsigned)w0, (unsigned)w1};
    }
}

__device__ __forceinline__ s16x4 tr4(const LAS unsigned char* p) { return __builtin_bit_cast(s16x4, __builtin_amdgcn_ds_read_tr16_b64_v4i16((LAS s16x4*)p)); }
__device__ void hgrn_item(const Params& P, int item, LAS unsigned char* lds) {
    const int tid = tid_opaque(), lane = tid & 63, wid = __builtin_amdgcn_readfirstlane(tid >> 6), r32 = lane & 31, hi = lane >> 5;
    const int b = item >> 3, h = (item >> 1) & 3, vh = item & 1;
    const bf16_t* HQ = (const bf16_t*)(P.ws + OFF_HQ); const bf16_t* HK = (const bf16_t*)(P.ws + OFF_HK); bf16_t* HI = (bf16_t*)(P.ws + OFF_HI);
    constexpr int SQ = 272, SKD = 320, SV = 192, SS = 192;
    constexpr int LQR = 0, LKR = 17408, LQB = 34816, LKD = 52224, LV = 72704, LS = 84992, LG = 109568, LT = 142336, LCL = 144384;
    LAS float* G = (LAS float*)(lds + LG); LAS float* TOT = (LAS float*)(lds + LT); LAS float* CL = (LAS float*)(lds + LCL);
    const size_t rowb = (size_t)b * SEQ;
    const int row = tid >> 3, seg = tid & 7;
    const bf16_t* qsrc = HQ + (rowb + row) * 512 + h * 128 + seg * 16; const bf16_t* ksrc = HK + (rowb + row) * 512 + h * 128 + seg * 16;
    bf16_t* vsrc = HI + (rowb + row) * 512 + h * 128 + vh * 64 + seg * 8;
    for (int i = tid; i < 128 * SS / 4; i += NTHR) ((LAS unsigned*)(lds + LS))[i] = 0u;
    f32x16 Sacc = {};
    const int di = wid >> 1, vi = wid & 1, ti = wid >> 1;
    const int tg = lane >> 4, tc = tg & 1, tI = lane & 15;
    const int trow = 4 * hi + (tI >> 2), tcol = 16 * tc + 4 * (tI & 3);
    u32x4 qn0 = *(const u32x4*)qsrc, qn1 = *(const u32x4*)(qsrc + 8), kn0 = *(const u32x4*)ksrc, kn1 = *(const u32x4*)(ksrc + 8), vn = *(const u32x4*)vsrc;
#pragma unroll 1
    for (int n = 0; n < SEQ / 64; ++n) {
        const u32x4 q0 = qn0, q1 = qn1, k0 = kn0, k1 = kn1, vv = vn;
        float qf[16] = {bf_lo(q0.x), bf_hi(q0.x), bf_lo(q0.y), bf_hi(q0.y), bf_lo(q0.z), bf_hi(q0.z), bf_lo(q0.w), bf_hi(q0.w), bf_lo(q1.x), bf_hi(q1.x), bf_lo(q1.y), bf_hi(q1.y), bf_lo(q1.z), bf_hi(q1.z), bf_lo(q1.w), bf_hi(q1.w)};
        float kf[16] = {bf_lo(k0.x), bf_hi(k0.x), bf_lo(k0.y), bf_hi(k0.y), bf_lo(k0.z), bf_hi(k0.z), bf_lo(k0.w), bf_hi(k0.w), bf_lo(k1.x), bf_hi(k1.x), bf_lo(k1.y), bf_hi(k1.y), bf_lo(k1.z), bf_hi(k1.z), bf_lo(k1.w), bf_hi(k1.w)};
#pragma unroll
        for (int e4 = 0; e4 < 4; ++e4) *(LAS f32x4*)(G + row * 128 + seg * 16 + 4 * e4) = (f32x4){__logf(1.0f - kf[4 * e4]), __logf(1.0f - kf[4 * e4 + 1]), __logf(1.0f - kf[4 * e4 + 2]), __logf(1.0f - kf[4 * e4 + 3])};
        *(LAS u32x4*)(lds + LV + row * SV + seg * 16) = vv;
        if (n + 1 < SEQ / 64) { const size_t o = (size_t)(n + 1) * 64 * 512; qn0 = *(const u32x4*)(qsrc + o); qn1 = *(const u32x4*)(qsrc + o + 8); kn0 = *(const u32x4*)(ksrc + o); kn1 = *(const u32x4*)(ksrc + o + 8); vn = *(const u32x4*)(vsrc + o); }
        __syncthreads();
        { const int d = tid & 127, q4 = tid >> 7; float s = 0.f;
#pragma unroll
          for (int i = 0; i < 16; ++i) { s += G[(16 * q4 + i) * 128 + d]; G[(16 * q4 + i) * 128 + d] = s; }
          TOT[q4 * 128 + d] = s; }
        __syncthreads();
        {
            const int qq = row >> 4;
#pragma unroll
            for (int e4 = 0; e4 < 4; ++e4) {
                const int d4 = seg * 16 + 4 * e4;
                const f32x4 t0 = *(const LAS f32x4*)(TOT + d4), t1 = *(const LAS f32x4*)(TOT + 128 + d4), t2 = *(const LAS f32x4*)(TOT + 256 + d4), t3 = *(const LAS f32x4*)(TOT + 384 + d4);
                const f32x4 off = (qq == 0) ? (f32x4){0.f, 0.f, 0.f, 0.f} : ((qq == 1) ? t0 : ((qq == 2) ? t0 + t1 : t0 + t1 + t2));
                const f32x4 bb = *(const LAS f32x4*)(G + row * 128 + d4) + off;
                const f32x4 bref = *(const LAS f32x4*)(G + 32 * 128 + d4) + t0 + t1, blast = t0 + t1 + t2 + t3;
                float vqb[4], vqr[4], vkr[4], vkd[4];
#pragma unroll
                for (int e = 0; e < 4; ++e) {
                    const float e1 = __expf(bb[e]), e2 = __expf(-bb[e]);
                    vqb[e] = qf[4 * e4 + e] * e1; vqr[e] = vqb[e] * __expf(-bref[e]);
                    const float ke = kf[4 * e4 + e] * e2; vkr[e] = ke * __expf(bref[e]); vkd[e] = ke * __expf(blast[e]);
                }
                *(LAS u32x2*)(lds + LQB + row * SQ + seg * 32 + 8 * e4) = (u32x2){cvt_pk_bf16(vqb[0], vqb[1]), cvt_pk_bf16(vqb[2], vqb[3])};
                *(LAS u32x2*)(lds + LQR + row * SQ + seg * 32 + 8 * e4) = (u32x2){cvt_pk_bf16(vqr[0], vqr[1]), cvt_pk_bf16(vqr[2], vqr[3])};
                *(LAS u32x2*)(lds + LKR + row * SQ + seg * 32 + 8 * e4) = (u32x2){cvt_pk_bf16(vkr[0], vkr[1]), cvt_pk_bf16(vkr[2], vkr[3])};
                *(LAS u32x2*)(lds + LKD + row * SKD + seg * 32 + 8 * e4) = (u32x2){cvt_pk_bf16(vkd[0], vkd[1]), cvt_pk_bf16(vkd[2], vkd[3])};
                if (row == 0) *(LAS f32x4*)(CL + d4) = (f32x4){__expf(blast[0]), __expf(blast[1]), __expf(blast[2]), __expf(blast[3])};
                asm volatile("" ::: "memory");
            }
        }
        __syncthreads();
        if (wid < 4) {
            f32x16 Z = {};
            for (int si = 0; si <= ti; ++si) {
                f32x16 X = {};
#pragma unroll
                for (int ks = 0; ks < 8; ++ks) {
                    const bf16x8 a = *(const LAS bf16x8*)(lds + LKR + (32 * si + r32) * SQ + (16 * ks + 8 * hi) * 2);
                    const bf16x8 bq = *(const LAS bf16x8*)(lds + LQR + (32 * ti + r32) * SQ + (16 * ks + 8 * hi) * 2);
                    X = MFMA32(a, bq, X);
                }
                if (si == ti) {
#pragma unroll
                    for (int r = 0; r < 16; ++r) if (crow(r, hi) > r32) X[r] = 0.f;
                }
#pragma unroll
                for (int s2 = 0; s2 < 2; ++s2) {
                    union { u32x4 u; bf16x8 v; } pa;
                    pa.u.x = cvt_pk_bf16(X[8 * s2 + 0], X[8 * s2 + 1]); pa.u.y = cvt_pk_bf16(X[8 * s2 + 2], X[8 * s2 + 3]); pa.u.z = cvt_pk_bf16(X[8 * s2 + 4], X[8 * s2 + 5]); pa.u.w = cvt_pk_bf16(X[8 * s2 + 6], X[8 * s2 + 7]);
                    const LAS unsigned char* vp = lds + LV + (32 * si + 16 * s2 + trow) * SV + (32 * vi + tcol) * 2;
                    const s16x4 lo = tr4(vp), hh = tr4(vp + 8 * SV);
                    const bf16x8 vf = {lo[0], lo[1], lo[2], lo[3], hh[0], hh[1], hh[2], hh[3]};
                    Z = MFMA32(pa.v, vf, Z);
                }
            }
#pragma unroll
            for (int ks = 0; ks < 8; ++ks) {
                const bf16x8 a = *(const LAS bf16x8*)(lds + LQB + (32 * ti + r32) * SQ + (16 * ks + 8 * hi) * 2);
                const LAS unsigned char* sp = lds + LS + (16 * ks + 8 * hi + (tI >> 2)) * SS + (32 * vi + tcol) * 2;
                const s16x4 lo = tr4(sp), hh = tr4(sp + 4 * SS);
                const bf16x8 sf = {lo[0], lo[1], lo[2], lo[3], hh[0], hh[1], hh[2], hh[3]};
                Z = MFMA32(a, sf, Z);
            }
            bf16_t* op = HI + (rowb + (size_t)n * 64 + 32 * ti) * 512 + h * 128 + vh * 64 + 32 * vi + r32;
#pragma unroll
            for (int r = 0; r < 16; ++r) op[(size_t)crow(r, hi) * 512] = (bf16_t)(cvt_pk_bf16(Z[r], 0.f) & 0xffffu);
        }
        {
#pragma unroll
            for (int r = 0; r < 16; ++r) Sacc[r] *= CL[32 * di + crow(r, hi)];
#pragma unroll
            for (int ks = 0; ks < 4; ++ks) {
                const LAS unsigned char* kp = lds + LKD + (16 * ks + 8 * hi + (tI >> 2)) * SKD + (32 * di + tcol) * 2;
                const s16x4 klo = tr4(kp), khi = tr4(kp + 4 * SKD);
                const bf16x8 ka = {klo[0], klo[1], klo[2], klo[3], khi[0], khi[1], khi[2], khi[3]};
                const LAS unsigned char* vp = lds + LV + (16 * ks + 8 * hi + (tI >> 2)) * SV + (32 * vi + tcol) * 2;
                const s16x4 vlo = tr4(vp), vhi = tr4(vp + 4 * SV);
                const bf16x8 vb = {vlo[0], vlo[1], vlo[2], vlo[3], vhi[0], vhi[1], vhi[2], vhi[3]};
                Sacc = MFMA32(ka, vb, Sacc);
            }
        }
        __syncthreads();
        {
            LAS bf16_t* sp = (LAS bf16_t*)(lds + LS + (32 * di) * SS + (32 * vi + r32) * 2);
#pragma unroll
            for (int r = 0; r < 16; ++r) sp[crow(r, hi) * (SS / 2)] = (bf16_t)(cvt_pk_bf16(Sacc[r], 0.f) & 0xffffu);
        }
    }
    __syncthreads();
}

__device__ void moba_unit(const Params& P, int b, int h, int j, LAS unsigned char* lds) {
    const int tid = tid_opaque(), lane = tid & 63, wid = tid >> 6, r32 = lane & 31, hi = lane >> 5;
    bf16_t* Q = (bf16_t*)(P.ws + OFF_QA); const bf16_t* Kg = (const bf16_t*)(P.ws + OFF_KA); const bf16_t* Vg = (const bf16_t*)(P.ws + OFF_VA);
    const float* kmean = (const float*)(P.ws + OFF_KMEAN);
    constexpr int KIMG = 64 * 144, VIMG = 64 * 192, LK = 0, LV = 4 * KIMG, LKM = 4 * KIMG + 4 * VIMG;
    LAS float* kmL = (LAS float*)(lds + LKM);
    const size_t rowb = (size_t)b * SEQ; const int q0 = j * 256;
    if (tid < j * 64) kmL[tid] = kmean[(size_t)(b * 8 + (tid >> 6)) * 512 + h * 64 + (tid & 63)];
    bf16_t* qrow = Q + (rowb + q0 + wid * 32 + r32) * 512 + h * 64;
    bf16x8 qf[4];
#pragma unroll
    for (int d0 = 0; d0 < 4; ++d0) qf[d0] = *(const bf16x8*)(qrow + 16 * d0 + 8 * hi);
    const int srow = tid >> 3, sch = tid & 7;
    const bf16_t* ksrc = Kg + (rowb + srow) * 512 + h * 64 + sch * 8; const bf16_t* vsrc = Vg + (rowb + srow) * 512 + h * 64 + sch * 8;
    const int ntile = 4 * (j + 1), npair = ntile >> 1;
    auto tile_key0 = [&](int i) -> size_t { const int blk = (i < 4) ? j : ((i - 4) >> 2), kt = (i < 4) ? i : ((i - 4) & 3); return (size_t)(blk * 256 + kt * 64); };
    u32x4 kreg[2], vreg[2];
#pragma unroll
    for (int s = 0; s < 2; ++s) { const size_t k0 = tile_key0(s); kreg[s] = *(const u32x4*)(ksrc + k0 * 512); vreg[s] = *(const u32x4*)(vsrc + k0 * 512); }
#pragma unroll
    for (int s = 0; s < 2; ++s) { *(LAS u32x4*)(lds + LK + s * KIMG + srow * 144 + sch * 16) = kreg[s]; *(LAS u32x4*)(lds + LV + s * VIMG + srow * 192 + sch * 16) = vreg[s]; }
    __syncthreads();
    unsigned sel = 0;
    if (j <= 3) sel = (1u << j) - 1u;
    else {
        float g[7];
#pragma unroll
        for (int n = 0; n < 7; ++n) { float s = 0.f;
            if (n < j) {
#pragma unroll
                for (int d0 = 0; d0 < 4; ++d0)
#pragma unroll
                    for (int e = 0; e < 8; ++e) s += __uint_as_float(((unsigned)(unsigned short)qf[d0][e]) << 16) * kmL[n * 64 + 16 * d0 + 8 * hi + e];
            }
            s += __shfl_xor(s, 32); g[n] = s; }
#pragma unroll
        for (int it = 0; it < 3; ++it) { float best = -INFINITY; int bi = 0;
#pragma unroll
            for (int n = 0; n < 7; ++n) if (n < j && !((sel >> n) & 1u) && g[n] > best) { best = g[n]; bi = n; }
            sel |= 1u << bi; }
    }
    const float ch = exp2f(-(float)(h + 1)) * LOG2E;
    const int qb = wid * 32 + r32;
    float m_run = -1e30f, l_run = 0.f;
    f32x16 o0 = {}, o1 = {};
    const int tg = lane >> 4, tc = tg & 1, ti = lane & 15;
    const int vlane = (4 * hi + (ti >> 2)) * 192 + (16 * tc + 4 * (ti & 3)) * 2;
#pragma unroll 1
    for (int ip = 0; ip < npair; ++ip) {
      const int pbuf = ip & 1;
      if (ip + 1 < npair) {
#pragma unroll
          for (int s = 0; s < 2; ++s) { const size_t k1 = tile_key0(2 * ip + 2 + s); kreg[s] = *(const u32x4*)(ksrc + k1 * 512); vreg[s] = *(const u32x4*)(vsrc + k1 * 512); }
      }
#pragma unroll
      for (int s2 = 0; s2 < 2; ++s2) {
        const int i = 2 * ip + s2, buf = pbuf * 2 + s2;
        const bool own = i < 4; const int blk = own ? j : ((i - 4) >> 2), kt = own ? i : ((i - 4) & 3);
        const bool lane_ok = own ? true : (((sel >> blk) & 1u) != 0u);
        const bool skip = own ? (64 * kt > 32 * wid + 31) : (__ballot(lane_ok) == 0ull);
        if (!skip) {
            LAS unsigned char* kb = lds + LK + buf * KIMG; LAS unsigned char* vb = lds + LV + buf * VIMG;
            f32x16 p0 = {}, p1 = {};
#pragma unroll
            for (int d0 = 0; d0 < 4; ++d0) {
                const bf16x8 kf0 = *(const LAS bf16x8*)(kb + r32 * 144 + (16 * d0 + 8 * hi) * 2);
                const bf16x8 kf1 = *(const LAS bf16x8*)(kb + (32 + r32) * 144 + (16 * d0 + 8 * hi) * 2);
                p0 = MFMA32(kf0, qf[d0], p0); p1 = MFMA32(kf1, qf[d0], p1);
            }
            const float kbase = ch * (float)((blk - j) * 256 + kt * 64);
            float mt = -1e30f;
#pragma unroll
            for (int r = 0; r < 16; ++r) {
                const int kl0 = crow(r, hi), kl1 = kl0 + 32;
                p0[r] = __builtin_fmaf(ch, (float)kl0, p0[r]); p1[r] = __builtin_fmaf(ch, (float)kl1, p1[r]);
                if (own) { if (kt * 64 + kl0 > qb) p0[r] = -1e30f; if (kt * 64 + kl1 > qb) p1[r] = -1e30f; }
                mt = fmaxf(mt, fmaxf(p0[r], p1[r]));
            }
            mt = lane_ok ? mt + kbase : -1e30f;
            mt = fmaxf(mt, __shfl_xor(mt, 32));
            if (__ballot(mt > m_run) != 0ull) {
                const float mnew = fmaxf(m_run, mt), alpha = __builtin_amdgcn_exp2f(m_run - mnew);
                m_run = mnew; l_run *= alpha;
#pragma unroll
                for (int r = 0; r < 16; ++r) { o0[r] *= alpha; o1[r] *= alpha; }
            }
            const float sh = lane_ok ? kbase - m_run : -1e30f;
            float rs = 0.f;
#pragma unroll
            for (int r = 0; r < 16; ++r) { p0[r] = __builtin_amdgcn_exp2f(p0[r] + sh); p1[r] = __builtin_amdgcn_exp2f(p1[r] + sh); rs += p0[r] + p1[r]; }
            l_run += rs;
#pragma unroll
            for (int sub = 0; sub < 2; ++sub)
#pragma unroll
                for (int s = 0; s < 2; ++s) {
                    union { u32x4 u; bf16x8 v; } pb;
                    if (sub == 0) { pb.u.x = cvt_pk_bf16(p0[8 * s + 0], p0[8 * s + 1]); pb.u.y = cvt_pk_bf16(p0[8 * s + 2], p0[8 * s + 3]); pb.u.z = cvt_pk_bf16(p0[8 * s + 4], p0[8 * s + 5]); pb.u.w = cvt_pk_bf16(p0[8 * s + 6], p0[8 * s + 7]); }
                    else { pb.u.x = cvt_pk_bf16(p1[8 * s + 0], p1[8 * s + 1]); pb.u.y = cvt_pk_bf16(p1[8 * s + 2], p1[8 * s + 3]); pb.u.z = cvt_pk_bf16(p1[8 * s + 4], p1[8 * s + 5]); pb.u.w = cvt_pk_bf16(p1[8 * s + 6], p1[8 * s + 7]); }
#pragma unroll
                    for (int dt = 0; dt < 2; ++dt) {
                        LAS unsigned char* va = vb + (32 * sub + 16 * s) * 192 + dt * 64 + vlane;
                        const s16x4 lo = __builtin_bit_cast(s16x4, __builtin_amdgcn_ds_read_tr16_b64_v4i16((LAS s16x4*)va));
                        const s16x4 hh = __builtin_bit_cast(s16x4, __builtin_amdgcn_ds_read_tr16_b64_v4i16((LAS s16x4*)(va + 8 * 192)));
                        const bf16x8 vf = {lo[0], lo[1], lo[2], lo[3], hh[0], hh[1], hh[2], hh[3]};
                        if (dt == 0) o0 = MFMA32(vf, pb.v, o0); else o1 = MFMA32(vf, pb.v, o1);
                    }
                }
        }
      }
      if (ip + 1 < npair) { const int nb = (pbuf ^ 1) * 2;
#pragma unroll
          for (int s = 0; s < 2; ++s) { *(LAS u32x4*)(lds + LK + (nb + s) * KIMG + srow * 144 + sch * 16) = kreg[s]; *(LAS u32x4*)(lds + LV + (nb + s) * VIMG + srow * 192 + sch * 16) = vreg[s]; } }
      __syncthreads();
    }
    l_run += __shfl_xor(l_run, 32);
    const float inv = 1.0f / l_run;
#pragma unroll
    for (int r4 = 0; r4 < 4; ++r4) {
        int w0 = __builtin_amdgcn_cvt_pk_fp8_f32(o0[4 * r4] * inv, o0[4 * r4 + 1] * inv, 0, false); w0 = __builtin_amdgcn_cvt_pk_fp8_f32(o0[4 * r4 + 2] * inv, o0[4 * r4 + 3] * inv, w0, true);
        int w1 = __builtin_amdgcn_cvt_pk_fp8_f32(o1[4 * r4] * inv, o1[4 * r4 + 1] * inv, 0, false); w1 = __builtin_amdgcn_cvt_pk_fp8_f32(o1[4 * r4 + 2] * inv, o1[4 * r4 + 3] * inv, w1, true);
        unsigned char* yrow = P.ws + OFF_EG + (rowb + q0 + wid * 32 + r32) * 1024 + h * 64;
        *(int*)(yrow + 8 * r4 + 4 * hi) = w0; *(int*)(yrow + 32 + 8 * r4 + 4 * hi) = w1;
    }
}

__device__ void yb_norm_panel(const Params& P, int pm) {
    const int tid = tid_opaque(), lane = tid & 63, wid = tid >> 6;
    bf16_t* HI = (bf16_t*)(P.ws + OFF_HI); const bf16_t* HG = (const bf16_t*)(P.ws + OFF_HG);
    for (int r = 0; r < 32; ++r) {
        const size_t off = ((size_t)pm * 256 + wid * 32 + r) * 512 + lane * 8;
        const u32x4 ov = *(const u32x4*)(HI + off), gv = *(const u32x4*)(HG + off);
        float o[8] = {bf_lo(ov.x), bf_hi(ov.x), bf_lo(ov.y), bf_hi(ov.y), bf_lo(ov.z), bf_hi(ov.z), bf_lo(ov.w), bf_hi(ov.w)};
        const float g[8] = {bf_lo(gv.x), bf_hi(gv.x), bf_lo(gv.y), bf_hi(gv.y), bf_lo(gv.z), bf_hi(gv.z), bf_lo(gv.w), bf_hi(gv.w)};
        float ss = 0.f;
#pragma unroll
        for (int e = 0; e < 8; ++e) ss += o[e] * o[e];
        ss += __shfl_xor(ss, 1); ss += __shfl_xor(ss, 2); ss += __shfl_xor(ss, 4); ss += __shfl_xor(ss, 8);
        const float rs = rsqrtf(ss * (1.0f / 128.0f) + RMS_EPS);
        int w0 = __builtin_amdgcn_cvt_pk_fp8_f32(o[0] * rs * g[0], o[1] * rs * g[1], 0, false); w0 = __builtin_amdgcn_cvt_pk_fp8_f32(o[2] * rs * g[2], o[3] * rs * g[3], w0, true);
        int w1 = __builtin_amdgcn_cvt_pk_fp8_f32(o[4] * rs * g[4], o[5] * rs * g[5], 0, false); w1 = __builtin_amdgcn_cvt_pk_fp8_f32(o[6] * rs * g[6], o[7] * rs * g[7], w1, true);
        *(u32x2*)(P.ws + OFF_EG + ((size_t)pm * 256 + wid * 32 + r) * 1024 + 512 + lane * 8) = (u32x2){(unsigned)w0, (unsigned)w1};
    }
}
__device__ void ln1_panel(const Params& P, int pm) {
    const int tid = tid_opaque(), lane = tid & 63, wid = tid >> 6;
    const float* ada = (const float*)(P.ws + OFF_ADA) + (size_t)(pm >> 3) * 6144; bf16_t* H = (bf16_t*)(P.ws + OFF_H);
    for (int r = 0; r < 32; ++r) {
        const size_t row = (size_t)pm * 256 + wid * 32 + r;
        const float* xin = P.x + row * 1024 + lane * 4; const unsigned char* dl = P.ws + OFF_GB + row * 2048 + lane * 4;
        f32x4 v[4]; float s = 0.f;
#pragma unroll
        for (int jx = 0; jx < 4; ++jx) { const int dv = *(const int*)(dl + 256 * jx); const f32x4 xv = __builtin_nontemporal_load((const f32x4*)(xin + 256 * jx));
            const f32x2 d01 = __builtin_amdgcn_cvt_pk_f32_fp8(dv, false), d23 = __builtin_amdgcn_cvt_pk_f32_fp8(dv, true);
            v[jx] = xv * ALPHA + (f32x4){d01.x, d01.y, d23.x, d23.y}; s += (v[jx][0] + v[jx][1]) + (v[jx][2] + v[jx][3]); }
        const float mean = wave_sum(s) * (1.0f / 1024.0f); float s2 = 0.f;
#pragma unroll
        for (int jx = 0; jx < 4; ++jx) { v[jx] = v[jx] - mean; s2 += (v[jx][0] * v[jx][0] + v[jx][1] * v[jx][1]) + (v[jx][2] * v[jx][2] + v[jx][3] * v[jx][3]); }
        const float rstd = rsqrtf(wave_sum(s2) * (1.0f / 1024.0f) + LN_EPS);
#pragma unroll
        for (int jx = 0; jx < 4; ++jx) {
            const int c = lane * 4 + 256 * jx;
            const f32x4 g = *(const f32x4*)(P.ln1_g + c), bb = *(const f32x4*)(P.ln1_b + c), sh = *(const f32x4*)(ada + 3072 + c), sc = *(const f32x4*)(ada + 4096 + c);
            const f32x4 x1 = v[jx] * rstd * g + bb;
            { u32x2 w1; w1.x = cvt_pk_bf16(x1[0], x1[1]); w1.y = cvt_pk_bf16(x1[2], x1[3]);
              *(u32x2*)((bf16_t*)(P.out + row * 1024) + c) = w1; }
            const f32x4 h2 = x1 * (sc + 1.0f) + sh;
            u32x2 w; w.x = cvt_pk_bf16(h2[0], h2[1]); w.y = cvt_pk_bf16(h2[2], h2[3]);
            *(u32x2*)(H + row * 1024 + c) = w;
            v[jx] = h2;
        }
        {
            float mx = 0.f;
#pragma unroll
            for (int jx = 0; jx < 4; ++jx) mx = fmaxf(mx, fmaxf(fmaxf(fabsf(v[jx][0]), fabsf(v[jx][1])), fmaxf(fabsf(v[jx][2]), fabsf(v[jx][3]))));
#pragma unroll
            for (int o = 1; o < 64; o <<= 1) mx = fmaxf(mx, __shfl_xor(mx, o));
            const float hs = fmaxf(mx * (1.0f / 119.0f), 1e-30f), inv = 1.0f / hs; int qs = 0;
            const int nsh = (lane & 1) * 4;
#pragma unroll
            for (int jx = 0; jx < 4; ++jx) {
                unsigned pa = 0u, pb = 0u;
#pragma unroll
                for (int k = 0; k < 4; ++k) { const int q = (int)rintf(v[jx][k] * inv); qs += q;
                    const int b = ((q + 8) & 15) - 8, a = (q - b) >> 4;
                    pa |= (unsigned)(a & 15) << (8 * k + nsh); pb |= (unsigned)(b & 15) << (8 * k + nsh); }
                pa |= __shfl_xor(pa, 1); pb |= __shfl_xor(pb, 1);
                if (!(lane & 1)) { unsigned* hp4 = (unsigned*)(P.ws + OFF_H8 + row * 1024) + (lane >> 1) + 32 * jx; hp4[0] = pa; hp4[128] = pb; }
            }
#pragma unroll
            for (int o = 1; o < 64; o <<= 1) qs += __shfl_xor(qs, o);
            if (lane == 0) *(f32x2*)(P.ws + OFF_HS + row * 8) = (f32x2){hs, (float)qs};
        }
    }
}

#define CE16(A, i, j) do { const float hi_ = fmaxf(A[i], A[j]); A[j] = fminf(A[i], A[j]); A[i] = hi_; } while (0)
#define SORT16(A) do { CE16(A, 0, 1); CE16(A, 2, 3); CE16(A, 0, 2); CE16(A, 1, 3); CE16(A, 1, 2); CE16(A, 4, 5); CE16(A, 6, 7); CE16(A, 4, 6); CE16(A, 5, 7); CE16(A, 5, 6); CE16(A, 0, 4); CE16(A, 2, 6); CE16(A, 2, 4); CE16(A, 1, 5); CE16(A, 3, 7); CE16(A, 3, 5); CE16(A, 1, 2); CE16(A, 3, 4); CE16(A, 5, 6); CE16(A, 8, 9); CE16(A, 10, 11); CE16(A, 8, 10); CE16(A, 9, 11); CE16(A, 9, 10); CE16(A, 12, 13); CE16(A, 14, 15); CE16(A, 12, 14); CE16(A, 13, 15); CE16(A, 13, 14); CE16(A, 8, 12); CE16(A, 10, 14); CE16(A, 10, 12); CE16(A, 9, 13); CE16(A, 11, 15); CE16(A, 11, 13); CE16(A, 9, 10); CE16(A, 11, 12); CE16(A, 13, 14); CE16(A, 0, 8); CE16(A, 4, 12); CE16(A, 4, 8); CE16(A, 2, 10); CE16(A, 6, 14); CE16(A, 6, 10); CE16(A, 2, 4); CE16(A, 6, 8); CE16(A, 10, 12); CE16(A, 1, 9); CE16(A, 5, 13); CE16(A, 5, 9); CE16(A, 3, 11); CE16(A, 7, 15); CE16(A, 7, 11); CE16(A, 3, 5); CE16(A, 7, 9); CE16(A, 11, 13); CE16(A, 1, 2); CE16(A, 3, 4); CE16(A, 5, 6); CE16(A, 7, 8); CE16(A, 9, 10); CE16(A, 11, 12); CE16(A, 13, 14); } while (0)
#define BITONIC16(A) do { CE16(A, 0, 8); CE16(A, 1, 9); CE16(A, 2, 10); CE16(A, 3, 11); CE16(A, 4, 12); CE16(A, 5, 13); CE16(A, 6, 14); CE16(A, 7, 15); CE16(A, 0, 4); CE16(A, 1, 5); CE16(A, 2, 6); CE16(A, 3, 7); CE16(A, 8, 12); CE16(A, 9, 13); CE16(A, 10, 14); CE16(A, 11, 15); CE16(A, 0, 2); CE16(A, 1, 3); CE16(A, 4, 6); CE16(A, 5, 7); CE16(A, 8, 10); CE16(A, 9, 11); CE16(A, 12, 14); CE16(A, 13, 15); CE16(A, 0, 1); CE16(A, 2, 3); CE16(A, 4, 5); CE16(A, 6, 7); CE16(A, 8, 9); CE16(A, 10, 11); CE16(A, 12, 13); CE16(A, 14, 15); } while (0)
#define INS16(L, xin) do { float x_ = (xin); _Pragma("unroll") for (int k_ = 0; k_ < 16; ++k_) { const float hi_ = fmaxf(L[k_], x_); x_ = fminf(L[k_], x_); L[k_] = hi_; } } while (0)

__device__ void peer_select_wave(const Params& P, size_t tok0) {
    const int lane = tid_opaque() & 63, r32 = lane & 31, hi = lane >> 5;
    const bf16_t* QP = (const bf16_t*)(P.ws + OFF_GB) + (tok0 + r32) * 1024; const bf16_t* SK = (const bf16_t*)(P.ws + OFF_SK);
    unsigned* EG = (unsigned*)(P.ws + OFF_EG) + (tok0 + r32) * 128;
#pragma unroll 1
    for (int h = 0; h < 8; ++h) {
        float a0[16], a1[16];
#pragma unroll
        for (int k = 0; k < 16; ++k) { a0[k] = -INFINITY; a1[k] = -INFINITY; }
#pragma unroll
        for (int p = 0; p < 2; ++p) {
            const int hp = h * 2 + p;
            bf16x8 qf[4];
#pragma unroll
            for (int ks = 0; ks < 4; ++ks) qf[ks] = *(const bf16x8*)(QP + hp * 64 + 16 * ks + 8 * hi);
            float L[16];
#pragma unroll
            for (int kt = 0; kt < 4; ++kt) {
                f32x16 acc = {};
#pragma unroll
                for (int ks = 0; ks < 4; ++ks) { const bf16x8 kf = *(const bf16x8*)(SK + ((size_t)hp * 128 + 32 * kt + r32) * 64 + 16 * ks + 8 * hi); acc = MFMA32(kf, qf[ks], acc); }
                float S[16];
#pragma unroll
                for (int r = 0; r < 16; ++r) { const unsigned key = (unsigned)(32 * kt + crow(r, hi)); S[r] = __uint_as_float((__float_as_uint(acc[r]) & ~127u) | key); }
                SORT16(S);
                if (kt == 0) {
#pragma unroll
                    for (int k = 0; k < 16; ++k) L[k] = S[k];
                } else {
#pragma unroll
                    for (int k = 0; k < 16; ++k) L[k] = fmaxf(L[k], S[15 - k]);
                    BITONIC16(L);
                }
            }
            {
                float O[16];
#pragma unroll
                for (int k = 0; k < 16; ++k) O[k] = __shfl_xor(L[15 - k], 32);
#pragma unroll
                for (int k = 0; k < 16; ++k) L[k] = fmaxf(L[k], O[k]);
                BITONIC16(L);
            }
#pragma unroll
            for (int k = 0; k < 16; ++k) { a0[k] = (p == 0) ? L[k] : a0[k]; a1[k] = (p == 1) ? L[k] : a1[k]; }
        }
        float best[16];
#pragma unroll
        for (int k = 0; k < 16; ++k) best[k] = __uint_as_float((__float_as_uint(a0[0] + a1[k]) & ~255u) | (unsigned)k);
#define PKC(i, j) __uint_as_float((__float_as_uint(a0[i] + a1[j]) & ~255u) | (unsigned)((i) * 16 + (j)))
        {
            float A[16] = {PKC(1, 0), PKC(1, 1), PKC(1, 2), PKC(1, 3), PKC(1, 4), PKC(1, 5), PKC(1, 6), PKC(1, 7), PKC(15, 0), PKC(14, 0), PKC(13, 0), PKC(12, 0), PKC(11, 0), PKC(10, 0), PKC(9, 0), PKC(8, 0)};
            BITONIC16(A);
#pragma unroll
            for (int k = 0; k < 16; ++k) best[k] = fmaxf(best[k], A[15 - k]);
            BITONIC16(best);
            float B[16] = {PKC(2, 0), PKC(2, 1), PKC(2, 2), PKC(2, 3), PKC(2, 4), PKC(3, 0), PKC(3, 1), PKC(3, 2), PKC(3, 3), PKC(4, 0), PKC(4, 1), PKC(4, 2), PKC(5, 0), PKC(5, 1), PKC(6, 0), PKC(6, 1)};
            SORT16(B);
#pragma unroll
            for (int k = 0; k < 16; ++k) best[k] = fmaxf(best[k], B[15 - k]);
            BITONIC16(best);
            INS16(best, PKC(7, 0)); INS16(best, PKC(7, 1));
        }
#undef PKC
        unsigned pk0[4], pk1[4];
#pragma unroll
        for (int q = 0; q < 4; ++q) {
            pk0[q] = (__float_as_uint(a0[4 * q]) & 127u) | ((__float_as_uint(a0[4 * q + 1]) & 127u) << 8) | ((__float_as_uint(a0[4 * q + 2]) & 127u) << 16) | ((__float_as_uint(a0[4 * q + 3]) & 127u) << 24);
            pk1[q] = (__float_as_uint(a1[4 * q]) & 127u) | ((__float_as_uint(a1[4 * q + 1]) & 127u) << 8) | ((__float_as_uint(a1[4 * q + 2]) & 127u) << 16) | ((__float_as_uint(a1[4 * q + 3]) & 127u) << 24);
        }
        unsigned pay[16];
#pragma unroll
        for (int k = 0; k < 16; ++k) {
            const unsigned code = __float_as_uint(best[k]) & 255u, ci = code >> 4, cj = code & 15u;
            const unsigned qi = ci >> 2, qj = cj >> 2;
            const unsigned w0 = (qi == 0u) ? pk0[0] : ((qi == 1u) ? pk0[1] : ((qi == 2u) ? pk0[2] : pk0[3]));
            const unsigned w1 = (qj == 0u) ? pk1[0] : ((qj == 1u) ? pk1[1] : ((qj == 2u) ? pk1[2] : pk1[3]));
            pay[k] = (((w0 >> ((ci & 3u) * 8u)) & 127u) << 7) | ((w1 >> ((cj & 3u) * 8u)) & 127u);
        }
        float e[16], es = 0.f;
#pragma unroll
        for (int k = 0; k < 16; ++k) { e[k] = __expf(best[k] - best[0]); es += e[k]; }
        const float inv = 1.0f / es;
        if (hi == 0) {
#pragma unroll
            for (int k = 0; k < 16; ++k) EG[h * 16 + k] = pay[k] | (cvt_pk_bf16(e[k] * inv, 0.f) << 16);
        }
    }
}
__device__ __forceinline__ unsigned xcc_id() { return (unsigned)__builtin_amdgcn_s_getreg((3 << 11) | 20) & 0xFu; }
template <int CTRL> __device__ __forceinline__ float dpp_add(float x) { const int v = __builtin_amdgcn_update_dpp(0, __float_as_int(x), CTRL, 0xf, 0xf, true); return x + __int_as_float(v); }
__device__ __forceinline__ float wave_sum_fast(float x) {
    x = dpp_add<0xB1>(x); x = dpp_add<0x4E>(x); x = dpp_add<0x141>(x); x = dpp_add<0x140>(x);
    x += __shfl_xor(x, 16); x += __shfl_xor(x, 32); return x;
}
template <int CTRL> __device__ __forceinline__ float dpp_max(float x) { const int v = __builtin_amdgcn_update_dpp(0, __float_as_int(x), CTRL, 0xf, 0xf, true); return fmaxf(x, __int_as_float(v)); }
template <int CTRL> __device__ __forceinline__ int dpp_addi(int x) { return x + __builtin_amdgcn_update_dpp(0, x, CTRL, 0xf, 0xf, true); }
__device__ __forceinline__ float wave_max_fast(float x) {
    x = dpp_max<0xB1>(x); x = dpp_max<0x4E>(x); x = dpp_max<0x141>(x); x = dpp_max<0x140>(x);
    x = fmaxf(x, __shfl_xor(x, 16)); x = fmaxf(x, __shfl_xor(x, 32)); return x;
}
__device__ __forceinline__ int wave_sum_int_fast(int x) {
    x = dpp_addi<0xB1>(x); x = dpp_addi<0x4E>(x); x = dpp_addi<0x141>(x); x = dpp_addi<0x140>(x);
    x += __shfl_xor(x, 16); x += __shfl_xor(x, 32); return x;
}
__device__ __forceinline__ float dot16_fp8(const float (&hv)[16], const u32x4 r) {
    float s = 0.f;
    { const f32x2 a = __builtin_amdgcn_cvt_pk_f32_fp8((int)r.x, false), b = __builtin_amdgcn_cvt_pk_f32_fp8((int)r.x, true); s += hv[0] * a.x + hv[1] * a.y + hv[2] * b.x + hv[3] * b.y; }
    { const f32x2 a = __builtin_amdgcn_cvt_pk_f32_fp8((int)r.y, false), b = __builtin_amdgcn_cvt_pk_f32_fp8((int)r.y, true); s += hv[4] * a.x + hv[5] * a.y + hv[6] * b.x + hv[7] * b.y; }
    { const f32x2 a = __builtin_amdgcn_cvt_pk_f32_fp8((int)r.z, false), b = __builtin_amdgcn_cvt_pk_f32_fp8((int)r.z, true); s += hv[8] * a.x + hv[9] * a.y + hv[10] * b.x + hv[11] * b.y; }
    { const f32x2 a = __builtin_amdgcn_cvt_pk_f32_fp8((int)r.w, false), b = __builtin_amdgcn_cvt_pk_f32_fp8((int)r.w, true); s += hv[12] * a.x + hv[13] * a.y + hv[14] * b.x + hv[15] * b.y; }
    return s;
}
template <int NP, class F> __device__ __forceinline__ void partition_queue(const Params& P, LAS unsigned char* lds, int ctr_base, F f) {
    const int tid = tid_opaque();
    LAS int* slot = (LAS int*)(lds + LDS_BYTES - 64);
    unsigned* ctr = (unsigned*)(P.ws + OFF_CTR) + ctr_base;
    const int myx = (int)(xcc_id() & 7u);
    for (int pp = 0; pp < NP; ++pp) {
        const int p = (myx * (NP / 8) + pp) % NP;
        for (;;) {
            if (tid == 0) *slot = (int)atomicAdd(ctr + p, 1u);
            __syncthreads();
            const int item = *slot;
            __syncthreads();
            if (item >= NTOK / 64) break;
            f(p, item);
        }
    }
}
__device__ __forceinline__ float dot2bf(unsigned a, bf16v2 b, float c) { return __builtin_amdgcn_fdot2_f32_bf16(__builtin_bit_cast(bf16v2, a), b, c, false); }
__device__ __forceinline__ float gelu_erf(float v) {
    const float av = fabsf(v), t = __builtin_amdgcn_rcpf(__builtin_fmaf(av, 0.2316418882f, 1.0f));
    float q = __builtin_fmaf(t, 0.5307027145f, -0.7265760135f); q = __builtin_fmaf(q, t, 0.7107068705f); q = __builtin_fmaf(q, t, -0.142248368f); q = __builtin_fmaf(q, t, 0.127414796f); q = q * t;
    const float m = v * (q * __builtin_amdgcn_exp2f(v * v * -0.72134752044f));
    return v < 0.f ? m : v - m;
}
struct UQuad { u32x4 r[2]; u32x4 ent, nxt; };
__device__ __forceinline__ void uq_issue(UQuad& q, const LAS u32x4* list, int J, int NQ, int g, const unsigned char* Ub, const unsigned lo) {
    q.ent = q.nxt;
    const unsigned char* rp = Ub + (q.ent.x * 512u + lo);
    q.r[0] = *(const u32x4*)rp; q.r[1] = *(const u32x4*)(rp + 256);
    const int jj = J < NQ ? J : NQ - 1;
    q.nxt = list[4 * jj + g];
}
__device__ __forceinline__ float uq_dot(const UQuad& q, const u32x4 (&hp)[4]) {
    int a = 0, b = 0;
#pragma unroll
    for (int c = 0; c < 2; ++c) {
        const u32x4 r = q.r[c];
        a = __builtin_amdgcn_sdot8((int)hp[c].x, (int)r.x, a, false); a = __builtin_amdgcn_sdot8((int)hp[c].y, (int)r.y, a, false);
        a = __builtin_amdgcn_sdot8((int)hp[c].z, (int)r.z, a, false); a = __builtin_amdgcn_sdot8((int)hp[c].w, (int)r.w, a, false);
        b = __builtin_amdgcn_sdot8((int)hp[2 + c].x, (int)r.x, b, false); b = __builtin_amdgcn_sdot8((int)hp[2 + c].y, (int)r.y, b, false);
        b = __builtin_amdgcn_sdot8((int)hp[2 + c].z, (int)r.z, b, false); b = __builtin_amdgcn_sdot8((int)hp[2 + c].w, (int)r.w, b, false);
    }
    float s = (float)(16 * a + b);
    s = dpp_add<0xB1>(s); s = dpp_add<0x4E>(s); s = dpp_add<0x141>(s); s = dpp_add<0x140>(s);
    return s;
}
__device__ __forceinline__ void peer_u_tokens(const Params& P, LAS unsigned char* lds, const size_t t0) {
    const int tid = tid_opaque(), lane = tid & 63, wid = tid >> 6, g = lane >> 4, li = lane & 15;
    const unsigned char* H8 = P.ws + OFF_H8 + li * 16; const unsigned char* Ub = P.ws + OFF_U8; const unsigned lo16 = (unsigned)li * 16u;
    const f32x2* HS = (const f32x2*)(P.ws + OFF_HS); const float* USC = (const float*)(P.ws + OFF_USC);
    const u32x2* EG2 = (const u32x2*)(P.ws + OFF_EG); unsigned* W = (unsigned*)(P.ws + OFF_W);
    LAS u32x4* list = (LAS u32x4*)(lds + wid * 16384);
    {
        u32x2 egv[8]; float s0[8], s1[8];
#pragma unroll
        for (int i = 0; i < 8; ++i) egv[i] = EG2[(t0 + i) * 64 + lane];
#pragma unroll
        for (int i = 0; i < 8; ++i) { s0[i] = USC[egv[i].x & 0xFFFFu]; s1[i] = USC[egv[i].y & 0xFFFFu]; }
#pragma unroll
        for (int i = 0; i < 8; ++i) {
            list[i * 128 + 2 * lane] = (u32x4){egv[i].x & 0xFFFFu, egv[i].x & 0xFFFF0000u, (unsigned)(2 * lane) | (unsigned)(i << 8), __float_as_uint(s0[i])};
            list[i * 128 + 2 * lane + 1] = (u32x4){egv[i].y & 0xFFFFu, egv[i].y & 0xFFFF0000u, (unsigned)(2 * lane + 1) | (unsigned)(i << 8), __float_as_uint(s1[i])};
        }
    }
    constexpr int NQ = 256;
    u32x4 hp[4], hn[4]; f32x2 hsc = HS[t0], hsn = HS[t0 + 1];
#pragma unroll
    for (int c = 0; c < 2; ++c) { hp[c] = *(const u32x4*)(H8 + t0 * 1024 + 256 * c); hp[2 + c] = *(const u32x4*)(H8 + t0 * 1024 + 512 + 256 * c);
                                  hn[c] = *(const u32x4*)(H8 + (t0 + 1) * 1024 + 256 * c); hn[2 + c] = *(const u32x4*)(H8 + (t0 + 1) * 1024 + 512 + 256 * c); }
    int curtok = 0;
    UQuad q0, q1, q2, q3, q4, q5, q6, q7;
    q0.nxt = list[g]; q1.nxt = list[4 + g]; q2.nxt = list[8 + g]; q3.nxt = list[12 + g]; q4.nxt = list[16 + g]; q5.nxt = list[20 + g]; q6.nxt = list[24 + g]; q7.nxt = list[28 + g];
    uq_issue(q0, list, 8, NQ, g, Ub, lo16); uq_issue(q1, list, 9, NQ, g, Ub, lo16); uq_issue(q2, list, 10, NQ, g, Ub, lo16); uq_issue(q3, list, 11, NQ, g, Ub, lo16);
    uq_issue(q4, list, 12, NQ, g, Ub, lo16); uq_issue(q5, list, 13, NQ, g, Ub, lo16); uq_issue(q6, list, 14, NQ, g, Ub, lo16); uq_issue(q7, list, 15, NQ, g, Ub, lo16);
    float sv = 0.f; unsigned gv = 0u, zv = 0u, ev = 0u;
#define UQ_PIN(q) asm volatile("" : "+v"(q.r[0]), "+v"(q.r[1]) :: "memory")
#define UQ_STEP(q, Jn, kq, qn) do { \
        const float s = __uint_as_float(q.ent.w) * hsc.x * (uq_dot(q, hp) + 0.5f * hsc.y); \
        if (li == (kq)) { sv = s; gv = q.ent.y; zv = q.ent.z; ev = q.ent.x; } \
        uq_issue(q, list, (Jn), NQ, g, Ub, lo16); UQ_PIN(qn); } while (0)
    UQ_PIN(q0);
#pragma unroll 1
    for (int J = 0; J < NQ; J += 8) {
        const int tk = __builtin_amdgcn_readfirstlane((int)(q0.ent.z >> 8));
        if (tk != curtok) { curtok = tk;
#pragma unroll
            for (int c = 0; c < 4; ++c) hp[c] = hn[c];
            hsc = hsn;
            if (tk + 1 < 8) { hsn = HS[t0 + tk + 1];
#pragma unroll
                for (int c = 0; c < 2; ++c) { hn[c] = *(const u32x4*)(H8 + (t0 + tk + 1) * 1024 + 256 * c); hn[2 + c] = *(const u32x4*)(H8 + (t0 + tk + 1) * 1024 + 512 + 256 * c); } } }
        UQ_STEP(q0, J + 16, 0, q1); UQ_STEP(q1, J + 17, 1, q2); UQ_STEP(q2, J + 18, 2, q3); UQ_STEP(q3, J + 19, 3, q4);
        UQ_STEP(q4, J + 20, 4, q5); UQ_STEP(q5, J + 21, 5, q6); UQ_STEP(q6, J + 22, 6, q7); UQ_STEP(q7, J + 23, 7, q0);
        if (li < 8) W[(t0 + tk) * 128 + (zv & 255u)] = ev | (cvt_pk_bf16(__uint_as_float(gv) * gelu_erf(sv), 0.f) << 16); }
#undef UQ_STEP
}
typedef int v4i_t __attribute__((ext_vector_type(4)));
struct VQuad { u32x4 r[2]; u32x2 ent, nxt; };
__device__ __forceinline__ void vq_issue(VQuad& q, const LAS u32x2* list, int J, int g, const unsigned char* Vb, const unsigned lo) {
    q.ent = q.nxt;
    const unsigned char* rp = Vb + (q.ent.x * 512u + lo);
    q.r[0] = *(const u32x4*)rp; q.r[1] = *(const u32x4*)(rp + 256);
    const int jj = J < 256 ? J : 255;
    q.nxt = list[4 * jj + g];
}
#define VQ_PIN(q) asm volatile("" : "+v"(q.r[0]), "+v"(q.r[1]) :: "memory")
__device__ __forceinline__ void vq_mma(const VQuad& q, v4i_t (&acc)[4], const u32x4 bm) {
    const unsigned t = q.ent.y;
    const v4i_t B = {(int)(t & bm.x), (int)(t & bm.y), (int)(t & bm.z), (int)(t & bm.w)};
#pragma unroll
    for (int c = 0; c < 2; ++c) {
        const u32x4 r = q.r[c];
        const v4i_t lo = {(int)(r.x & 0x0F0F0F0Fu), (int)(r.y & 0x0F0F0F0Fu), (int)(r.z & 0x0F0F0F0Fu), (int)(r.w & 0x0F0F0F0Fu)};
        const v4i_t raw = {(int)r.x, (int)r.y, (int)r.z, (int)r.w};
        acc[2 * c] = __builtin_amdgcn_mfma_i32_16x16x64_i8(lo, B, acc[2 * c], 0, 0, 0);
        acc[2 * c + 1] = __builtin_amdgcn_mfma_i32_16x16x64_i8(raw, B, acc[2 * c + 1], 0, 0, 0);
    }
}
__device__ __forceinline__ void peer_v_tokens(const Params& P, LAS unsigned char* lds, const size_t t0) {
    const int tid = tid_opaque(), lane = tid & 63, wid = tid >> 6, g = lane >> 4, li = lane & 15;
    const unsigned char* Vb = P.ws + OFF_V8; const unsigned lo16 = (unsigned)li * 16u; const float* VSC = (const float*)(P.ws + OFF_VSC);
    const u32x2* W2 = (const u32x2*)(P.ws + OFF_W);
    LAS u32x2* lists = (LAS u32x2*)(lds + wid * 8192);
    LAS f32x2* tokp = (LAS f32x2*)(lds + 65536 + wid * 64);
    {
        u32x2 egv[8]; f32x2 wwv[8];
#pragma unroll
        for (int i = 0; i < 8; ++i) { const u32x2 ew = W2[(t0 + i) * 64 + lane]; egv[i].x = ew.x & 0xFFFFu; egv[i].y = ew.y & 0xFFFFu; wwv[i] = (f32x2){__uint_as_float(ew.x & 0xFFFF0000u), __uint_as_float(ew.y & 0xFFFF0000u)}; }
        float w0v[8], w1v[8];
#pragma unroll
        for (int i = 0; i < 8; ++i) { w0v[i] = wwv[i].x * VSC[egv[i].x]; w1v[i] = wwv[i].y * VSC[egv[i].y]; }
#pragma unroll
        for (int i = 0; i < 8; ++i) {
            const float mx = wave_max_fast(fmaxf(fabsf(w0v[i]), fabsf(w1v[i])));
            const float sw = fmaxf(mx * (1.0f / 127.0f), 1e-30f), inv = 1.0f / sw;
            const int q0 = (int)rintf(w0v[i] * inv), q1 = (int)rintf(w1v[i] * inv);
            *(LAS u32x4*)(lists + i * 128 + 2 * lane) = (u32x4){egv[i].x, ((unsigned)q0 & 255u) * 0x01010101u, egv[i].y, ((unsigned)q1 & 255u) * 0x01010101u};
            const int qs = wave_sum_int_fast(q0 + q1);
            if (lane == 0) tokp[i] = (f32x2){sw, 7.5f * sw * (float)qs}; }
    }
    const unsigned bsel = 0xFFu << (8u * (unsigned)(li & 3));
    const u32x4 bm = {(li >> 2) == 0 ? bsel : 0u, (li >> 2) == 1 ? bsel : 0u, (li >> 2) == 2 ? bsel : 0u, (li >> 2) == 3 ? bsel : 0u};
    const int dbase = 128 * g + 8 * (li >> 2) + (li & 3);
    float gt2v[16], lgv[16], lbv[16];
    { const float* gt2 = (const float*)(P.ws + OFF_ADA) + (t0 >> 11) * 6144 + 5120;
#pragma unroll
      for (int c = 0; c < 2; ++c)
#pragma unroll
          for (int hf = 0; hf < 2; ++hf)
#pragma unroll
              for (int r = 0; r < 4; ++r) { const int d = dbase + 512 * c + 32 * r + 4 * hf, e = 8 * c + 4 * hf + r; gt2v[e] = gt2[d]; lgv[e] = P.ln2_g[d]; lbv[e] = P.ln2_b[d]; } }
    VQuad q0, q1, q2, q3, q4, q5, q6, q7;
    q0.nxt = lists[g]; q1.nxt = lists[4 + g]; q2.nxt = lists[8 + g]; q3.nxt = lists[12 + g]; q4.nxt = lists[16 + g]; q5.nxt = lists[20 + g]; q6.nxt = lists[24 + g]; q7.nxt = lists[28 + g];
    vq_issue(q0, lists, 8, g, Vb, lo16); vq_issue(q1, lists, 9, g, Vb, lo16); vq_issue(q2, lists, 10, g, Vb, lo16); vq_issue(q3, lists, 11, g, Vb, lo16);
    vq_issue(q4, lists, 12, g, Vb, lo16); vq_issue(q5, lists, 13, g, Vb, lo16); vq_issue(q6, lists, 14, g, Vb, lo16); vq_issue(q7, lists, 15, g, Vb, lo16);
    VQ_PIN(q0);
#pragma unroll 1
    for (int i = 0; i < 8; ++i) {
        const size_t t = t0 + i;
        v4i_t acc[4];
#pragma unroll
        for (int j = 0; j < 4; ++j) acc[j] = (v4i_t){0, 0, 0, 0};
        float* xr = P.out + t * 1024;
        float xv[16];
#pragma unroll
        for (int c = 0; c < 2; ++c)
#pragma unroll
            for (int hf = 0; hf < 2; ++hf)
#pragma unroll
                for (int r = 0; r < 4; ++r) xv[8 * c + 4 * hf + r] = __uint_as_float((unsigned)((const bf16_t*)xr)[dbase + 512 * c + 32 * r + 4 * hf] << 16);
#pragma unroll 1
        for (int J = 32 * i; J < 32 * i + 32; J += 8) {
            vq_mma(q0, acc, bm); vq_issue(q0, lists, J + 16, g, Vb, lo16); VQ_PIN(q1);
            vq_mma(q1, acc, bm); vq_issue(q1, lists, J + 17, g, Vb, lo16); VQ_PIN(q2);
            vq_mma(q2, acc, bm); vq_issue(q2, lists, J + 18, g, Vb, lo16); VQ_PIN(q3);
            vq_mma(q3, acc, bm); vq_issue(q3, lists, J + 19, g, Vb, lo16); VQ_PIN(q4);
            vq_mma(q4, acc, bm); vq_issue(q4, lists, J + 20, g, Vb, lo16); VQ_PIN(q5);
            vq_mma(q5, acc, bm); vq_issue(q5, lists, J + 21, g, Vb, lo16); VQ_PIN(q6);
            vq_mma(q6, acc, bm); vq_issue(q6, lists, J + 22, g, Vb, lo16); VQ_PIN(q7);
            vq_mma(q7, acc, bm); vq_issue(q7, lists, J + 23, g, Vb, lo16); VQ_PIN(q0);
        }
        const f32x2 tp = tokp[i]; const float sw = tp.x, yoff = tp.y;
        float pre[16]; float s = 0.f;
#pragma unroll
        for (int c = 0; c < 2; ++c)
#pragma unroll
            for (int hf = 0; hf < 2; ++hf)
#pragma unroll
                for (int r = 0; r < 4; ++r) { const int e = 8 * c + 4 * hf + r;
                    const float yv = hf == 0 ? sw * (float)acc[2 * c][r] - yoff : (sw * 0.0625f) * (float)(acc[2 * c + 1][r] - acc[2 * c][r]) + yoff * (1.0f / 15.0f);
                    const float pv = ALPHA * xv[e] + gt2v[e] * yv; pre[e] = pv; s += pv; }
        const float mean = wave_sum_fast(s) * (1.0f / 1024.0f); float s2 = 0.f;
#pragma unroll
        for (int e = 0; e < 16; ++e) { pre[e] -= mean; s2 += pre[e] * pre[e]; }
        const float rstd = rsqrtf(wave_sum_fast(s2) * (1.0f / 1024.0f) + LN_EPS);
#pragma unroll
        for (int c = 0; c < 2; ++c)
#pragma unroll
            for (int hf = 0; hf < 2; ++hf)
#pragma unroll
                for (int r = 0; r < 4; ++r) { const int e = 8 * c + 4 * hf + r;
                    xr[dbase + 512 * c + 32 * r + 4 * hf] = pre[e] * rstd * lgv[e] + lbv[e]; }
    }
}

#define XB_TMO      128
#define XB_XCNT(j)  (256  + 64 * (j))
#define XB_XSUB(j)  (1280 + 64 * (j))
#define XB_XGEN(j)  (2304 + 64 * (j))
#define XB_TOP      3328
#define XB_TOPGEN   3392
#define XCD_BAR_WORDS 3456
#define XB_SPIN_CAP (1u << 22)
__device__ __forceinline__ unsigned xb_ld(unsigned* p)              { return __hip_atomic_load(p, __ATOMIC_RELAXED, __HIP_MEMORY_SCOPE_AGENT); }
__device__ __forceinline__ unsigned xb_add(unsigned* p, unsigned v) { return __hip_atomic_fetch_add(p, v, __ATOMIC_RELAXED, __HIP_MEMORY_SCOPE_AGENT); }
#define XB_SPIN(cond, bar) do { unsigned _sp = 0; while (cond) { __builtin_amdgcn_s_sleep(1); \
    if ((++_sp & 255u) == 0u) { if (xb_ld(&(bar)[XB_TMO])) break; if (_sp > XB_SPIN_CAP) { atomicAdd(&(bar)[XB_TMO], 1u); break; } } } } while (0)
struct XcdBarrier { unsigned* bar; unsigned x; volatile LAS unsigned* st; };
__device__ __forceinline__ XcdBarrier xcd_barrier_post(unsigned* bar, volatile LAS unsigned* st) {
    XcdBarrier b; b.bar = bar; b.x = xcc_id(); b.st = st;
    if (threadIdx.x == 0) (void)xb_add(&bar[XB_XCNT(b.x)], 1u);
    return b;
}
__device__ __forceinline__ void xcd_barrier_complete(unsigned* bar, unsigned x, unsigned& nloc, unsigned& nx) {
    const unsigned G = gridDim.x * gridDim.y * gridDim.z;
    unsigned sum, cnt, mine, sp = 0u;
    for (;;) {
        sum = 0u; cnt = 0u; mine = 0u;
#pragma unroll
        for (unsigned j = 0; j < 16; ++j) { const unsigned c = xb_ld(&bar[XB_XCNT(j)]); sum += c; cnt += (c > 0u) ? 1u : 0u; mine = (j == x) ? c : mine; }
        if (sum == G) break;
        __builtin_amdgcn_s_sleep(1);
        if ((++sp & 255u) == 0u) { if (xb_ld(&bar[XB_TMO])) break; if (sp > XB_SPIN_CAP) { atomicAdd(&bar[XB_TMO], 1u); break; } }
    }
    nloc = mine > 0u ? mine : 1u; nx = cnt > 0u ? cnt : 1u;
}
__device__ __forceinline__ void xcd_barrier(const XcdBarrier& b) {
    asm volatile("s_waitcnt vmcnt(0)" ::: "memory");
    __syncthreads();
    if (threadIdx.x == 0) {
        unsigned* bar = b.bar;
        __builtin_amdgcn_s_waitcnt(0);
        unsigned nloc = b.st[0], nx = b.st[1];
        if (nloc == 0u) { xcd_barrier_complete(bar, b.x, nloc, nx); b.st[0] = nloc; b.st[1] = nx; }
        const unsigned old = xb_add(&bar[XB_XSUB(b.x)], 1u);
        const unsigned gen = old / nloc;
        if (old + 1u == (gen + 1u) * nloc) {
            __builtin_amdgcn_fence(__ATOMIC_RELEASE, "agent");
            asm volatile("s_waitcnt vmcnt(0)" ::: "memory");
            const unsigned og = xb_add(&bar[XB_TOP], 1u);
            const unsigned tg = og / nx;
            if (og + 1u == (tg + 1u) * nx) xb_add(&bar[XB_TOPGEN], 1u);
            else XB_SPIN(xb_ld(&bar[XB_TOPGEN]) == tg, bar);
            __builtin_amdgcn_fence(__ATOMIC_ACQUIRE, "agent");
            xb_add(&bar[XB_XGEN(b.x)], 1u);
            asm volatile("s_waitcnt vmcnt(0)" ::: "memory");
        } else {
            XB_SPIN(xb_ld(&bar[XB_XGEN(b.x)]) == gen, bar);
            __builtin_amdgcn_fence(__ATOMIC_ACQUIRE, "agent");
            asm volatile("s_waitcnt vmcnt(0)" ::: "memory");
        }
    }
    __syncthreads();
}

__global__ void __launch_bounds__(NTHR, 2) fwd_megakernel(Params P) {
    extern __shared__ __attribute__((aligned(16))) unsigned char shm[];
    LAS unsigned char* lds = (LAS unsigned char*)shm;
    cg::grid_group grid = cg::this_grid();
    const int G = gridDim.x, bid = blockIdx.x;
    volatile LAS unsigned* xst = (volatile LAS unsigned*)(lds + LDS_BYTES - 128);
    if (threadIdx.x == 0) { xst[0] = 0u; xst[1] = 0u; }
    __syncthreads();
    const XcdBarrier xb = xcd_barrier_post((unsigned*)(P.ws + OFF_BAR), xst);

#ifndef P3
#define P3 0xff
#endif
#ifndef PH
#define PH 0xff
#endif
    if (PH & 1) phase0a(P, lds);
    grid.sync();
    if (PH & 2) phase0b(P);
    xcd_barrier(xb);
    if (PH & 4) {
        pg8::Gemm g; g.A = (const bf16_t*)(P.ws + OFF_H); g.Bt = (const bf16_t*)(P.ws + OFF_WIN); g.M = NTOK; g.N = INCOLS; { int k_ = 512; asm volatile("" : "+s"(k_)); g.K = k_; g.lda = k_; }
        pg8::StaticOrder S; S.init(NTOK, INCOLS, G, bid);
        EpiProj E; E.ws = P.ws; E.lb = (const float*)(P.ws + OFF_LB); E.ng = P.hgrn_ng; E.kmean = (float*)(P.ws + OFF_KMEAN);
        pg8::gemm_phase<EpiProj, pg8::StaticOrder, true>(lds, g, S, E);
    }
    xcd_barrier(xb);
    if (PH & 8) for (int it = bid; it < 256; it += G) hgrn_item(P, it, lds);
    if (PH & 16) for (int u = bid; u < 2048; u += G) { const int bh = u & 255, jj = u >> 8; moba_unit(P, bh >> 3, bh & 7, (jj + bh) & 7, lds); }
    xcd_barrier(xb);
    if ((PH & 32) && bid < NTOK / 256) { const int pm = bid;
        if (P3 & 1) yb_norm_panel(P, pm);
        __syncthreads();
        if (P3 & 2) { pg8::Gemm g; g.A = (const bf16_t*)(P.ws + OFF_EG); g.Bt = (const bf16_t*)(P.ws + OFF_WBA); g.M = NTOK; g.N = 1024; { int k_ = 256; asm volatile("" : "+s"(k_)); g.K = k_; } g.lda = 512;
          pg8::PanelOrder S; S.pm = pm; S.npn = 4; EpiMixA E; E.GA = P.ws + OFF_GA;
          pg8::gemm_phase<EpiMixA, pg8::PanelOrder, true>(lds, g, S, E); }
        __syncthreads();
        if (P3 & 4) { pg8::Gemm g; g.A = (const bf16_t*)(P.ws + OFF_EG + 512); g.Bt = (const bf16_t*)(P.ws + OFF_WBB); g.M = NTOK; g.N = 1024; { int k_ = 256; asm volatile("" : "+s"(k_)); g.K = k_; } g.lda = 512;
          pg8::PanelOrder S; S.pm = pm; S.npn = 4; EpiMixB E; E.GA = P.ws + OFF_GA; E.GB = P.ws + OFF_GB; E.M8 = P.ws + OFF_QA;
          pg8::gemm_phase<EpiMixB, pg8::PanelOrder, true>(lds, g, S, E); }
        __syncthreads();
        if (P3 & 8) { pg8::Gemm g; g.A = (const bf16_t*)(P.ws + OFF_QA); g.Bt = (const bf16_t*)(P.ws + OFF_WOUT); g.M = NTOK; g.N = 1024; { int k_ = 512; asm volatile("" : "+s"(k_)); g.K = k_; g.lda = k_; }
          pg8::PanelOrder S; S.pm = pm; S.npn = 4; EpiOut E; E.ada = (const float*)(P.ws + OFF_ADA); E.D = (bf16_t*)(P.ws + OFF_GB);
          pg8::gemm_phase<EpiOut, pg8::PanelOrder, true>(lds, g, S, E); }
        __syncthreads();
        if (P3 & 16) ln1_panel(P, pm);
        __syncthreads();
        if (P3 & 32) { pg8::Gemm g; g.A = (const bf16_t*)(P.ws + OFF_H); g.Bt = (const bf16_t*)(P.ws + OFF_WQ); g.M = NTOK; g.N = 1024; g.K = 1024; g.lda = 1024;
          pg8::PanelOrder S; S.pm = pm; S.npn = 4; EpiBf16 E; E.O = (bf16_t*)(P.ws + OFF_GB);
          pg8::gemm_phase<EpiBf16, pg8::PanelOrder>(lds, g, S, E); }
        __syncthreads();
        { const size_t tok0 = (size_t)pm * 256 + (tid_opaque() >> 6) * 32;
          peer_select_wave(P, tok0);
          __syncthreads();
#pragma unroll 1
          for (int sb = 0; sb < 4; ++sb) {
              peer_u_tokens(P, lds, tok0 + 8 * sb);
              __syncthreads();
              peer_v_tokens(P, lds, tok0 + 8 * sb);
              __syncthreads();
          } }
    }
}

extern "C" void kernel_launch(void* const* d_in, const int* in_sizes, int n_in, void* d_out, int out_size, void* d_ws, size_t ws_size, hipStream_t stream) {
    static int grid_blocks = 0;
    if (grid_blocks == 0) {
        if (n_in != 18 || out_size != NTOK * DM || ws_size < WS_END) { fprintf(stderr, "kernel_launch: unexpected shapes (n_in %d, out %d, ws %zu, need %zu)\n", n_in, out_size, ws_size, (size_t)WS_END); grid_blocks = -1; return; }
        int dev = 0, cus = 0, per_cu = 0;
        hipGetDevice(&dev);
        hipDeviceGetAttribute(&cus, hipDeviceAttributeMultiprocessorCount, dev);
        if (hipFuncSetAttribute((const void*)fwd_megakernel, hipFuncAttributeMaxDynamicSharedMemorySize, LDS_BYTES) != hipSuccess) fprintf(stderr, "kernel_launch: hipFuncSetAttribute failed\n");
        hipOccupancyMaxActiveBlocksPerMultiprocessor(&per_cu, (const void*)fwd_megakernel, NTHR, LDS_BYTES);
        if (per_cu < 1) { fprintf(stderr, "kernel_launch: occupancy query says %d blocks per CU\n", per_cu); per_cu = 1; }
        if (per_cu > 1) per_cu = 1;
        grid_blocks = cus * per_cu;
        if (grid_blocks != NTOK / 256) { fprintf(stderr, "kernel_launch: built for a %d-CU device (one 256-token panel per workgroup), found %d\n", NTOK / 256, grid_blocks); grid_blocks = -1; return; }
        (void)hipGetLastError();
    }
    if (grid_blocks < 0) return;
    Params p{};
    p.x = (const float*)d_in[0]; p.c = (const float*)d_in[1]; p.w_ada = (const float*)d_in[2]; p.b_ada = (const float*)d_in[3]; p.w_in = (const float*)d_in[4];
    p.w_ba = (const float*)d_in[5]; p.w_bb = (const float*)d_in[6]; p.w_out = (const float*)d_in[7]; p.hgrn_lb = (const float*)d_in[8]; p.hgrn_ng = (const float*)d_in[9];
    p.ln1_g = (const float*)d_in[10]; p.ln1_b = (const float*)d_in[11]; p.peer_wq = (const float*)d_in[12]; p.peer_sk = (const float*)d_in[13]; p.peer_u = (const float*)d_in[14];
    p.peer_v = (const float*)d_in[15]; p.ln2_g = (const float*)d_in[16]; p.ln2_b = (const float*)d_in[17];
    p.out = (float*)d_out; p.ws = (unsigned char*)d_ws;
    if (hipMemsetAsync((char*)d_ws + OFF_BAR, 0, XCD_BAR_WORDS * 4, stream) != hipSuccess) fprintf(stderr, "kernel_launch: memset of the barrier words failed\n");
    void* args[] = {&p};
    hipError_t e = hipLaunchCooperativeKernel((const void*)fwd_megakernel, dim3(grid_blocks), dim3(NTHR), args, LDS_BYTES, stream);
    if (e != hipSuccess) fprintf(stderr, "cooperative launch failed: %s (grid %d)\n", hipGetErrorString(e), grid_blocks);
}
```

```cpp
#include <hip/hip_runtime.h>
#include <hip/hip_cooperative_groups.h>
#include <cstdio>
#include <cstdint>
#include <type_traits>
namespace cg = cooperative_groups;

#define LAS __attribute__((address_space(3)))
typedef unsigned short bf16_t;
typedef short bf16x8 __attribute__((ext_vector_type(8)));
typedef short s16x4 __attribute__((ext_vector_type(4)));
typedef float f32x2 __attribute__((ext_vector_type(2)));
typedef float f32x4 __attribute__((ext_vector_type(4)));
typedef float f32x16 __attribute__((ext_vector_type(16)));
typedef unsigned u32x2 __attribute__((ext_vector_type(2)));
typedef unsigned u32x4 __attribute__((ext_vector_type(4)));

constexpr int NB = 32, SEQ = 2048, DM = 1024, NTOK = NB * SEQ;
constexpr int INCOLS = 5632;
constexpr int NTHR = 512;
constexpr int LDS_BYTES = 147456;
constexpr float ALPHA = 1.189207115002721f;
constexpr float LN_EPS = 1e-5f, RMS_EPS = 1e-6f;
constexpr float LOG2E = 1.4426950408889634f;

constexpr size_t SZ_T512 = (size_t)NTOK * 512 * 2, SZ_T1024 = (size_t)NTOK * 1024 * 2;
constexpr size_t OFF_ADA = 0;
constexpr size_t OFF_LB = OFF_ADA + 786432;
constexpr size_t OFF_KMEAN = OFF_LB + 4096;
constexpr size_t OFF_WIN = OFF_KMEAN + 524288;
constexpr size_t OFF_WBA = OFF_WIN + (size_t)5632 * 1024 * 2;
constexpr size_t OFF_WBB = OFF_WBA + 1048576;
constexpr size_t OFF_WOUT = OFF_WBB + 1048576;
constexpr size_t OFF_WQ = OFF_WOUT + 2097152;
constexpr size_t OFF_SK = OFF_WQ + 2097152;
constexpr size_t OFF_U8 = OFF_SK + 262144;
constexpr size_t OFF_USC = OFF_U8 + 8388608;
constexpr size_t OFF_V8 = OFF_U8 + 16777216;
constexpr size_t OFF_VSC = OFF_V8 + 8388608;
constexpr size_t OFF_CTR = OFF_V8 + 16777216;
constexpr size_t OFF_BAR = OFF_CTR + 4096;
constexpr size_t OFF_EG = OFF_BAR + 16384;
constexpr size_t OFF_H = OFF_EG + (size_t)NTOK * 128 * 8;
constexpr size_t OFF_QA = OFF_H + SZ_T1024;
constexpr size_t OFF_KA = OFF_QA + SZ_T512;
constexpr size_t OFF_VA = OFF_KA + SZ_T512;
constexpr size_t OFF_HQ = OFF_VA + SZ_T512;
constexpr size_t OFF_HK = OFF_HQ + SZ_T512;
constexpr size_t OFF_HI = OFF_HK + SZ_T512;
constexpr size_t OFF_HG = OFF_HI + SZ_T512;
constexpr size_t OFF_GA = OFF_HG + SZ_T512;
constexpr size_t OFF_GB = OFF_GA + SZ_T1024;
constexpr size_t WS_END = OFF_GB + SZ_T1024;
constexpr size_t OFF_H8 = OFF_VA;
constexpr size_t OFF_HS = OFF_HQ;
constexpr size_t OFF_W = OFF_KA;
constexpr size_t OFF_Y = OFF_KA;

struct Params {
    const float *x, *c, *w_ada, *b_ada, *w_in, *w_ba, *w_bb, *w_out, *hgrn_lb, *hgrn_ng, *ln1_g, *ln1_b, *peer_wq, *peer_sk, *peer_u, *peer_v, *ln2_g, *ln2_b;
    float* out;
    unsigned char* ws;
};

typedef __bf16 bf16v2 __attribute__((ext_vector_type(2)));
__device__ __forceinline__ unsigned cvt_pk_bf16(float lo, float hi) { return __builtin_bit_cast(unsigned, __builtin_convertvector((f32x2){lo, hi}, bf16v2)); }
__device__ __forceinline__ float bf_lo(unsigned w) { return __uint_as_float(w << 16); }
__device__ __forceinline__ float bf_hi(unsigned w) { return __uint_as_float(w & 0xffff0000u); }
__device__ __forceinline__ float sigmoidf_(float x) { return __builtin_amdgcn_rcpf(1.0f + __builtin_amdgcn_exp2f(-LOG2E * x)); }
__device__ __forceinline__ float wave_sum(float v) {
#pragma unroll
    for (int o = 1; o < 64; o <<= 1) v += __shfl_xor(v, o);
    return v;
}
__device__ __forceinline__ int tid_opaque() { int t = threadIdx.x; asm volatile("" : "+v"(t)); return t; }
__device__ __forceinline__ int crow(int r, int hi) { return (r & 3) + 8 * (r >> 2) + 4 * hi; }
#define MFMA32(a, b, c) __builtin_amdgcn_mfma_f32_32x32x16_bf16(a, b, c, 0, 0, 0)

namespace pg8 {
constexpr int BM = 256, BK = 64, HALF = 128, HTB = HALF * BK * 2, STAGE_BYTES = 8 * HTB, NXCD = 8, WGM = 8;
__host__ __device__ __forceinline__ int lds_byte(int r, int c) { const int st = (r >> 4) * 2 + (c >> 5), rr = r & 15, cc = c & 31, ob = rr * 64 + cc * 2; return st * 1024 + (ob ^ (((ob >> 9) & 1) << 5)); }
__host__ __device__ __forceinline__ void stage_rc(int b, int& R, int& C) { const int st = b / 1024, sb = b % 1024, swz = sb ^ (((sb >> 9) & 1) << 5); R = (st >> 1) * 16 + swz / 64; C = (st & 1) * 32 + (swz % 64) / 2; }
__host__ __device__ __forceinline__ int perm32(int rho) { const int n = rho >> 4, i = rho & 15; return 8 * (i >> 2) + 4 * n + (i & 3); }

struct Unit { int pm, pn; };
struct Gemm { const bf16_t* A; const bf16_t* Bt; int M, N, K, lda; };

struct StaticOrder {
    int nM, nN, nwg, G, c;
    __device__ void init(int M, int N, int G_, int c_) { nM = M / BM; nN = N / BM; nwg = nM * nN; G = G_; c = c_; }
    __device__ bool next(int i, Unit& u) const {
        const long L = (long)i * G + c; if (L >= nwg) return false;
        int wgid = (int)L; { const int q = nwg / NXCD, r = nwg % NXCD, xcd = wgid % NXCD, off = wgid / NXCD; wgid = (xcd < r ? xcd * (q + 1) : r * (q + 1) + (xcd - r) * q) + off; }
        const int nig = WGM * nN, gid = wgid / nig, fm = gid * WGM, gsz = (nM - fm) < WGM ? (nM - fm) : WGM;
        u.pm = fm + ((wgid % nig) % gsz); u.pn = (wgid % nig) / gsz; return true;
    }
};
struct PanelOrder {
    int pm, npn;
    __device__ bool next(int i, Unit& u) const { if (i >= npn) return false; u.pm = pm; u.pn = i; return true; }
};

template <class Epi, class Sched, bool MX = false>
__device__ __forceinline__ void gemm_phase(LAS unsigned char* lds, const Gemm g, const Sched& S, const Epi& E) {
    const int tid = tid_opaque(), wid = __builtin_amdgcn_readfirstlane(tid >> 6), lane = tid & 63, wr = wid >> 2, wc = wid & 3, fr = lane & 15, fq = lane >> 4;
    const int K = g.K, nt = K / BK;
    unsigned voffA, voffB;
    { int R, C; stage_rc(tid * 16, R, C); const int Rb = Epi::PERM ? ((R & ~31) + perm32(R & 31)) : R;
      voffA = (unsigned)(R * g.lda + C) * 2u; voffB = (unsigned)(Rb * K + C) * 2u; }
    const size_t rvoffA = (size_t)128 * g.lda, rvoffB = (size_t)128 * K;
    const size_t kstep = (size_t)(BK * 2);
    const size_t hstep = (size_t)HALF * K * 2;
    const size_t tstep = 2 * hstep;
    const size_t hstepA = (size_t)HALF * g.lda * 2, tstepA = 2 * hstepA;
    const unsigned ldsw = (unsigned)wid * 1024u;
    const int aoff = lds_byte(wr * 64 + fr, fq * 8), boff = lds_byte(wc * 32 + fr, fq * 8);
#define PG8_SA(b, h) (((b) * 2 + (h)) * HTB)
#define PG8_SB(b, h) ((4 + (b) * 2 + (h)) * HTB)
#define PG8_STAGE(bufoff, gbase, voff) do { unsigned vo_ = (voff); asm volatile("" : "+v"(vo_));     \
        _Pragma("unroll") for (int _i = 0; _i < 2; ++_i) \
        __builtin_amdgcn_global_load_lds((const unsigned*)((const char*)(gbase) + _i * r##voff + vo_), (LAS unsigned*)(lds + (bufoff) + ldsw + _i * 8192), 16, 0, 0); } while (0)
#define PG8_LDX(dst, off) do { const v4i_ lo_ = *(const LAS v4i_*)(lds + (off)), hi_ = *(const LAS v4i_*)(lds + (off) + 1024); dst = __builtin_shufflevector(lo_, hi_, 0, 1, 2, 3, 4, 5, 6, 7); } while (0)
#define PG8_LDA(dst, b, h) do { if constexpr (MX) { _Pragma("unroll") for (int m = 0; m < 4; ++m) PG8_LDX(dst##X[m], PG8_SA(b, h) + aoff + m * 2048); } \
        else { _Pragma("unroll") for (int m = 0; m < 4; ++m) _Pragma("unroll") for (int k = 0; k < 2; ++k) dst[m][k] = *(const LAS bf16x8*)(lds + PG8_SA(b, h) + aoff + m * 2048 + k * 1024); } } while (0)
#define PG8_LDB(dst, b, h) do { if constexpr (MX) { _Pragma("unroll") for (int n = 0; n < 2; ++n) PG8_LDX(dst##X[n], PG8_SB(b, h) + boff + n * 2048); } \
        else { _Pragma("unroll") for (int n = 0; n < 2; ++n) _Pragma("unroll") for (int k = 0; k < 2; ++k) dst[n][k] = *(const LAS bf16x8*)(lds + PG8_SB(b, h) + boff + n * 2048 + k * 1024); } } while (0)
#define PG8_MMA(ai, bj, At, Bt) do { __builtin_amdgcn_s_setprio(1); \
        if constexpr (MX) { _Pragma("unroll") for (int m = 0; m < 4; ++m) _Pragma("unroll") for (int n = 0; n < 2; ++n) \
            asm volatile("v_mfma_scale_f32_16x16x128_f8f6f4 %0, %1, %2, %0, %3, %4 op_sel_hi:[0,0,0]" : "+v"(acc[ai][bj][m][n]) : "v"(Bt##X[n]), "v"(At##X[m]), "v"(mxscale), "v"(mxscale5)); } \
        else { _Pragma("unroll") for (int m = 0; m < 4; ++m) _Pragma("unroll") for (int n = 0; n < 2; ++n) _Pragma("unroll") for (int k = 0; k < 2; ++k) \
            acc[ai][bj][m][n] = __builtin_amdgcn_mfma_f32_16x16x32_bf16(Bt[n][k], At[m][k], acc[ai][bj][m][n], 0, 0, 0); } \
        __builtin_amdgcn_s_setprio(0); } while (0)
#define PG8_WAIT_V(n) asm volatile("s_waitcnt vmcnt(" #n ")" ::: "memory")
#define PG8_WAIT_L(n) asm volatile("s_waitcnt lgkmcnt(" #n ")" ::: "memory")
#define PG8_BAR __builtin_amdgcn_s_barrier()
#define PG8_SCHED __builtin_amdgcn_sched_barrier(0)
    Unit cur, nxt; int ui = 0;
    if (!S.next(0, cur)) return;
    f32x4 acc[2][2][4][2];
#pragma unroll
    for (int a = 0; a < 2; ++a)
#pragma unroll
        for (int b = 0; b < 2; ++b)
#pragma unroll
            for (int m = 0; m < 4; ++m)
#pragma unroll
                for (int n = 0; n < 2; ++n) acc[a][b][m][n] = (f32x4){0.f, 0.f, 0.f, 0.f};
    typedef int v4i_ __attribute__((ext_vector_type(4))); typedef int v8i_ __attribute__((ext_vector_type(8)));
    bf16x8 At[4][2], B0[2][2], B1[2][2];
    v8i_ AtX[4], B0X[2], B1X[2];
    const int mxscale = 0x7f7f7f7f, mxscale5 = 0x7a7a7a7a;
    const char* cA = (const char*)g.A + (size_t)cur.pm * tstepA; const char* cB = (const char*)g.Bt + (size_t)cur.pn * tstep;
    PG8_STAGE(PG8_SB(0, 0), cB, voffB); PG8_STAGE(PG8_SA(0, 0), cA, voffA); PG8_STAGE(PG8_SB(0, 1), cB + hstep, voffB); PG8_STAGE(PG8_SA(0, 1), cA + hstepA, voffA);
    if (wr == 1) PG8_BAR;
    PG8_WAIT_V(4); PG8_BAR;
    PG8_STAGE(PG8_SB(1, 0), cB + kstep, voffB); PG8_STAGE(PG8_SA(1, 0), cA + kstep, voffA); PG8_STAGE(PG8_SB(1, 1), cB + hstep + kstep, voffB);
    PG8_WAIT_V(6); PG8_BAR;
    for (;;) {
        const bool has_next = S.next(ui + 1, nxt);
        const char* nA = has_next ? (const char*)g.A + (size_t)nxt.pm * tstepA : cA; const char* nB = has_next ? (const char*)g.Bt + (size_t)nxt.pn * tstep : cB;
        for (int t = 0; t < nt; t += 2) {
            const bool last = (t == nt - 2);
            const char* a1 = cA + (size_t)(t + 1) * kstep;
            const char* a2 = last ? nA : cA + (size_t)(t + 2) * kstep; const char* b2 = last ? nB : cB + (size_t)(t + 2) * kstep;
            const char* a3 = a2 + kstep; const char* b3 = b2 + kstep;
            PG8_LDB(B0, 0, 0); PG8_SCHED; PG8_LDA(At, 0, 0); PG8_STAGE(PG8_SA(1, 1), a1 + hstepA, voffA);
            PG8_WAIT_L(8); PG8_BAR; PG8_WAIT_L(0); PG8_MMA(0, 0, At, B0); PG8_BAR; PG8_SCHED;
            PG8_LDB(B1, 0, 1); PG8_STAGE(PG8_SB(0, 0), b2, voffB);
            PG8_BAR; PG8_WAIT_L(0); PG8_MMA(0, 1, At, B1); PG8_BAR;
            PG8_LDA(At, 0, 1); PG8_STAGE(PG8_SA(0, 0), a2, voffA);
            PG8_BAR; PG8_WAIT_L(0); PG8_MMA(1, 0, At, B0); PG8_BAR; PG8_SCHED;
            PG8_STAGE(PG8_SB(0, 1), b2 + hstep, voffB);
            PG8_WAIT_V(6); PG8_BAR; PG8_MMA(1, 1, At, B1); PG8_BAR;
            PG8_LDB(B0, 1, 0); PG8_SCHED; PG8_LDA(At, 1, 0); PG8_STAGE(PG8_SA(0, 1), a2 + hstepA, voffA);
            PG8_WAIT_L(8); PG8_BAR; PG8_WAIT_L(0); PG8_MMA(0, 0, At, B0); PG8_BAR; PG8_SCHED;
            PG8_LDB(B1, 1, 1); PG8_STAGE(PG8_SB(1, 0), b3, voffB);
            PG8_BAR; PG8_WAIT_L(0); PG8_MMA(0, 1, At, B1); PG8_BAR;
            PG8_LDA(At, 1, 1); PG8_STAGE(PG8_SA(1, 0), a3, voffA);
            PG8_BAR; PG8_WAIT_L(0); PG8_MMA(1, 0, At, B0); PG8_BAR; PG8_SCHED;
            PG8_STAGE(PG8_SB(1, 1), b3 + hstep, voffB);
            PG8_WAIT_V(6); PG8_BAR; PG8_MMA(1, 1, At, B1); PG8_BAR;
        }
        if constexpr (MX) asm volatile("s_nop 15\n\ts_nop 15" ::: "memory");
        if (wr == 0) PG8_BAR;
        E(acc, cur, wr, wc, fr, fq);
        if (wr == 1) PG8_BAR;
        if (!has_next) break;
#pragma unroll
        for (int a = 0; a < 2; ++a)
#pragma unroll
            for (int b = 0; b < 2; ++b)
#pragma unroll
                for (int m = 0; m < 4; ++m)
#pragma unroll
                    for (int n = 0; n < 2; ++n) acc[a][b][m][n] = (f32x4){0.f, 0.f, 0.f, 0.f};
        cur = nxt; cA = nA; cB = nB; ++ui;
    }
    PG8_WAIT_V(0);
    if (wr == 0) PG8_BAR;
    PG8_BAR;
#undef PG8_SA
#undef PG8_SB
#undef PG8_STAGE
#undef PG8_LDX
#undef PG8_LDA
#undef PG8_LDB
#undef PG8_MMA
#undef PG8_WAIT_V
#undef PG8_WAIT_L
#undef PG8_BAR
#undef PG8_SCHED
}
}
using pg8::Unit;

struct EpiProj {
    static constexpr bool PERM = true;
    unsigned char* ws; const float* lb; const float* ng; float* kmean;
    __device__ __forceinline__ void operator()(const f32x4 (&acc)[2][2][4][2], const Unit& u, int wr, int wc, int fr, int fq) const {
        const int pn = u.pn; int seg, colt, ldc; size_t boff;
        if (pn < 14) { seg = pn >> 1; colt = (pn & 1) * 256; ldc = 512; boff = OFF_QA + (size_t)seg * SZ_T512; }
        else if (pn < 18) { seg = 7; colt = (pn - 14) * 256; ldc = 1024; boff = OFF_GA; }
        else { seg = 8; colt = (pn - 18) * 256; ldc = 1024; boff = OFF_GB; }
        bf16_t* base = (bf16_t*)(ws + boff);
        const int row0 = u.pm * 256 + wr * 64 + fr, col0 = colt + wc * 32 + 8 * fq;
        float pv[2][8];
#pragma unroll
        for (int bj = 0; bj < 2; ++bj)
#pragma unroll
            for (int e = 0; e < 8; ++e) pv[bj][e] = (seg == 4) ? (1.0f - lb[col0 + bj * 128 + e]) : ((seg == 6) ? ng[col0 + bj * 128 + e] : 0.f);
        float cs[2][8];
#pragma unroll
        for (int bj = 0; bj < 2; ++bj)
#pragma unroll
            for (int e = 0; e < 8; ++e) cs[bj][e] = 0.f;
#pragma unroll
        for (int ai = 0; ai < 2; ++ai)
#pragma unroll
            for (int m = 0; m < 4; ++m) {
                bf16_t* rowp = base + (size_t)(row0 + ai * 128 + m * 16) * ldc + col0;
#pragma unroll
                for (int bj = 0; bj < 2; ++bj) {
                    float v[8];
#pragma unroll
                    for (int e = 0; e < 4; ++e) { v[e] = acc[ai][bj][m][0][e]; v[4 + e] = acc[ai][bj][m][1][e]; }
                    if (seg == 0) {
#pragma unroll
                        for (int e = 0; e < 8; ++e) v[e] *= (0.125f * LOG2E);
                    } else if (seg == 1) {
#pragma unroll
                        for (int e = 0; e < 8; ++e) cs[bj][e] += v[e];
                    } else if (seg == 3) {
#pragma unroll
                        for (int e = 0; e < 8; ++e) v[e] = v[e] * sigmoidf_(v[e]);
                    } else if (seg == 4) {
#pragma unroll
                        for (int e = 0; e < 8; ++e) v[e] = pv[bj][e] * sigmoidf_(-v[e]);
                    } else if (seg == 6) {
#pragma unroll
                        for (int e = 0; e < 8; ++e) v[e] = pv[bj][e] * v[e] * sigmoidf_(v[e]);
                    } else if (seg >= 7) {
#pragma unroll
                        for (int e = 0; e < 8; ++e) v[e] = sigmoidf_(v[e]);
                    }
                    if (seg >= 7) {
                        int w0 = __builtin_amdgcn_cvt_pk_fp8_f32(v[0], v[1], 0, false); w0 = __builtin_amdgcn_cvt_pk_fp8_f32(v[2], v[3], w0, true);
                        int w1 = __builtin_amdgcn_cvt_pk_fp8_f32(v[4], v[5], 0, false); w1 = __builtin_amdgcn_cvt_pk_fp8_f32(v[6], v[7], w1, true);
                        *(u32x2*)((unsigned char*)rowp - col0 + bj * 128) = (u32x2){(unsigned)w0, (unsigned)w1};
                    } else {
                    u32x4 w; w.x = cvt_pk_bf16(v[0], v[1]); w.y = cvt_pk_bf16(v[2], v[3]); w.z = cvt_pk_bf16(v[4], v[5]); w.w = cvt_pk_bf16(v[6], v[7]);
                    *(u32x4*)(rowp + bj * 128) = w; }
                }
            }
        if (seg == 1) {
#pragma unroll
            for (int bj = 0; bj < 2; ++bj)
#pragma unroll
                for (int e = 0; e < 8; ++e) {
                    float s = cs[bj][e];
                    s += __shfl_xor(s, 1); s += __shfl_xor(s, 2); s += __shfl_xor(s, 4); s += __shfl_xor(s, 8);
                    if (fr == 0) atomicAdd(kmean + (size_t)u.pm * 512 + col0 + bj * 128 + e, s);
                }
        }
    }
};
__device__ __forceinline__ void fp8x8_to_f32(const u32x2 w, float (&f)[8]) {
    const f32x2 a = __builtin_amdgcn_cvt_pk_f32_fp8((int)w.x, false), b = __builtin_amdgcn_cvt_pk_f32_fp8((int)w.x, true), c = __builtin_amdgcn_cvt_pk_f32_fp8((int)w.y, false), d = __builtin_amdgcn_cvt_pk_f32_fp8((int)w.y, true);
    f[0] = a.x; f[1] = a.y; f[2] = b.x; f[3] = b.y; f[4] = c.x; f[5] = c.y; f[6] = d.x; f[7] = d.y;
}
struct EpiMixA {
    static constexpr bool PERM = true;
    unsigned char* GA;
    __device__ __forceinline__ void operator()(const f32x4 (&acc)[2][2][4][2], const Unit& u, int wr, int wc, int fr, int fq) const {
        asm volatile("" : "+v"(fr), "+v"(fq));
        const int row0 = u.pm * 256 + wr * 64 + fr, col0 = u.pn * 256 + wc * 32 + 8 * fq;
#pragma unroll
        for (int ai = 0; ai < 2; ++ai)
#pragma unroll
            for (int m = 0; m < 4; ++m) {
                unsigned char* rowp = GA + (size_t)(row0 + ai * 128 + m * 16) * 2048 + col0;
#pragma unroll
                for (int bj = 0; bj < 2; ++bj) {
                    float g[8]; fp8x8_to_f32(*(const u32x2*)(rowp + bj * 128), g);
                    const f32x4 a0 = acc[ai][bj][m][0], a1 = acc[ai][bj][m][1];
                    int w0 = __builtin_amdgcn_cvt_pk_fp8_f32(g[0] * a0[0], g[1] * a0[1], 0, false); w0 = __builtin_amdgcn_cvt_pk_fp8_f32(g[2] * a0[2], g[3] * a0[3], w0, true);
                    int w1 = __builtin_amdgcn_cvt_pk_fp8_f32(g[4] * a1[0], g[5] * a1[1], 0, false); w1 = __builtin_amdgcn_cvt_pk_fp8_f32(g[6] * a1[2], g[7] * a1[3], w1, true);
                    *(u32x2*)(rowp + bj * 128) = (u32x2){(unsigned)w0, (unsigned)w1};
                }
            }
    }
};
struct EpiMixB {
    static constexpr bool PERM = true;
    const unsigned char* GA; const unsigned char* GB; unsigned char* M8;
    __device__ __forceinline__ void operator()(const f32x4 (&acc)[2][2][4][2], const Unit& u, int wr, int wc, int fr, int fq) const {
        asm volatile("" : "+v"(fr), "+v"(fq));
        const int row0 = u.pm * 256 + wr * 64 + fr, col0 = u.pn * 256 + wc * 32 + 8 * fq;
#pragma unroll
        for (int ai = 0; ai < 2; ++ai)
#pragma unroll
            for (int m = 0; m < 4; ++m) {
                const size_t row = (size_t)(row0 + ai * 128 + m * 16);
#pragma unroll
                for (int bj = 0; bj < 2; ++bj) {
                    float g[8], pa[8]; fp8x8_to_f32(*(const u32x2*)(GB + row * 2048 + col0 + bj * 128), g); fp8x8_to_f32(*(const u32x2*)(GA + row * 2048 + col0 + bj * 128), pa);
                    const f32x4 a0 = acc[ai][bj][m][0], a1 = acc[ai][bj][m][1];
                    int w0 = __builtin_amdgcn_cvt_pk_fp8_f32(pa[0] + g[0] * a0[0], pa[1] + g[1] * a0[1], 0, false); w0 = __builtin_amdgcn_cvt_pk_fp8_f32(pa[2] + g[2] * a0[2], pa[3] + g[3] * a0[3], w0, true);
                    int w1 = __builtin_amdgcn_cvt_pk_fp8_f32(pa[4] + g[4] * a1[0], pa[5] + g[5] * a1[1], 0, false); w1 = __builtin_amdgcn_cvt_pk_fp8_f32(pa[6] + g[6] * a1[2], pa[7] + g[7] * a1[3], w1, true);
                    *(u32x2*)(M8 + row * 1024 + col0 + bj * 128) = (u32x2){(unsigned)w0, (unsigned)w1};
                }
            }
    }
};
struct EpiOut {
    static constexpr bool PERM = true;
    const float* ada; bf16_t* D;
    __device__ __forceinline__ void operator()(const f32x4 (&acc)[2][2][4][2], const Unit& u, int wr, int wc, int fr, int fq) const {
        const int row0 = u.pm * 256 + wr * 64 + fr, col0 = u.pn * 256 + wc * 32 + 8 * fq;
        const float* gt1 = ada + (size_t)(u.pm >> 3) * 6144 + 2048 + col0;
        f32x4 g[2][2];
#pragma unroll
        for (int bj = 0; bj < 2; ++bj) { g[bj][0] = *(const f32x4*)(gt1 + bj * 128); g[bj][1] = *(const f32x4*)(gt1 + bj * 128 + 4); }
#pragma unroll
        for (int ai = 0; ai < 2; ++ai)
#pragma unroll
            for (int m = 0; m < 4; ++m) {
                bf16_t* rowp = D + (size_t)(row0 + ai * 128 + m * 16) * 1024 + col0;
#pragma unroll
                for (int bj = 0; bj < 2; ++bj) {
                    const f32x4 a0 = acc[ai][bj][m][0] * g[bj][0], a1 = acc[ai][bj][m][1] * g[bj][1];
                    int w0 = __builtin_amdgcn_cvt_pk_fp8_f32(a0[0], a0[1], 0, false); w0 = __builtin_amdgcn_cvt_pk_fp8_f32(a0[2], a0[3], w0, true);
                    int w1 = __builtin_amdgcn_cvt_pk_fp8_f32(a1[0], a1[1], 0, false); w1 = __builtin_amdgcn_cvt_pk_fp8_f32(a1[2], a1[3], w1, true);
                    *(u32x2*)((unsigned char*)rowp - col0 + bj * 128) = (u32x2){(unsigned)w0, (unsigned)w1};
                }
            }
    }
};
struct EpiBf16 {
    static constexpr bool PERM = true;
    bf16_t* O;
    __device__ __forceinline__ void operator()(const f32x4 (&acc)[2][2][4][2], const Unit& u, int wr, int wc, int fr, int fq) const {
        const int row0 = u.pm * 256 + wr * 64 + fr, col0 = u.pn * 256 + wc * 32 + 8 * fq;
#pragma unroll
        for (int ai = 0; ai < 2; ++ai)
#pragma unroll
            for (int m = 0; m < 4; ++m) {
                bf16_t* rowp = O + (size_t)(row0 + ai * 128 + m * 16) * 1024 + col0;
#pragma unroll
                for (int bj = 0; bj < 2; ++bj) {
                    const f32x4 a0 = acc[ai][bj][m][0], a1 = acc[ai][bj][m][1];
                    u32x4 w; w.x = cvt_pk_bf16(a0[0], a0[1]); w.y = cvt_pk_bf16(a0[2], a0[3]); w.z = cvt_pk_bf16(a1[0], a1[1]); w.w = cvt_pk_bf16(a1[2], a1[3]);
                    *(u32x4*)(rowp + bj * 128) = w;
                }
            }
    }
};

__device__ void phase0a(const Params& P, LAS unsigned char* lds) {
    const int tid = tid_opaque(), G = gridDim.x, bid = blockIdx.x;
    for (int it = bid; it < 192; it += G) {
        LAS float* sc = (LAS float*)lds;
        for (int i = tid; i < 32 * 1024; i += NTHR) { const float cv = P.c[i]; sc[i] = cv * sigmoidf_(cv); }
        __syncthreads();
        const int kg = tid >> 5, col = tid & 31;
        float a[32];
#pragma unroll
        for (int b = 0; b < 32; ++b) a[b] = 0.f;
#pragma unroll 1
        for (int k = kg * 64; k < kg * 64 + 64; k += 8) {
            float w[8];
#pragma unroll
            for (int e = 0; e < 8; ++e) w[e] = __builtin_nontemporal_load(P.w_ada + (size_t)(k + e) * 6144 + it * 32 + col);
#pragma unroll
            for (int e4 = 0; e4 < 2; ++e4) {
#pragma unroll
                for (int b = 0; b < 32; ++b) { const f32x4 s = *(const LAS f32x4*)(sc + b * 1024 + k + 4 * e4); a[b] += s[0] * w[4 * e4] + s[1] * w[4 * e4 + 1] + s[2] * w[4 * e4 + 2] + s[3] * w[4 * e4 + 3]; }
                asm volatile("" ::: "memory");
            }
        }
        __syncthreads();
        LAS float* red = (LAS float*)lds;
#pragma unroll
        for (int b = 0; b < 32; ++b) red[(kg * 32 + b) * 32 + col] = a[b];
        __syncthreads();
        for (int o = tid; o < 1024; o += NTHR) { const int b = o >> 5, cc = o & 31; float s = 0.f;
#pragma unroll
            for (int g2 = 0; g2 < 16; ++g2) s += red[(g2 * 32 + b) * 32 + cc];
            ((float*)(P.ws + OFF_ADA))[(size_t)b * 6144 + it * 32 + cc] = s + P.b_ada[it * 32 + cc]; }
        __syncthreads();
    }
    const size_t gsz = (size_t)G * NTHR;
    { const int gt = bid * NTHR + tid, gs = G * NTHR;
      if (gt < 512) ((float*)(P.ws + OFF_LB))[gt] = sigmoidf_(P.hgrn_lb[gt] - P.hgrn_lb[512 + gt]);
      for (int i = gt; i < 32 * 8 * 512; i += gs) ((float*)(P.ws + OFF_KMEAN))[i] = 0.f; }
    {
        LAS float* tile = (LAS float*)lds;
        const int I0 = 16 * 88, I1 = I0 + 8 * 16, I2 = I1 + 8 * 16, I3 = I2 + 16 * 16, I4 = I3 + 16 * 16;
        for (int it = bid; it < I4; it += G) {
            const float* W; bf16_t* WT; int K, N, r;
            if (it < I0) { W = P.w_in; WT = (bf16_t*)(P.ws + OFF_WIN); K = 1024; N = 5632; r = it; }
            else if (it < I1) { W = P.w_ba; WT = (bf16_t*)(P.ws + OFF_WBA); K = 512; N = 1024; r = it - I0; }
            else if (it < I2) { W = P.w_bb; WT = (bf16_t*)(P.ws + OFF_WBB); K = 512; N = 1024; r = it - I1; }
            else if (it < I3) { W = P.w_out; WT = (bf16_t*)(P.ws + OFF_WOUT); K = 1024; N = 1024; r = it - I2; }
            else { W = P.peer_wq; WT = (bf16_t*)(P.ws + OFF_WQ); K = 1024; N = 1024; r = it - I3; }
            const int nb = N / 64, k0 = (r / nb) * 64, n0 = (r % nb) * 64;
#pragma unroll
            for (int ps = 0; ps < 2; ++ps) { const int kk = (tid >> 4) + 32 * ps, n4 = (tid & 15) * 4;
                const f32x4 v = *(const f32x4*)(W + (size_t)(k0 + kk) * N + n0 + n4);
                tile[kk * 65 + n4] = v[0]; tile[kk * 65 + n4 + 1] = v[1]; tile[kk * 65 + n4 + 2] = v[2]; tile[kk * 65 + n4 + 3] = v[3]; }
            __syncthreads();
            { const int n = tid >> 3, kc = (tid & 7) * 8;
              if (it < I3) {
                  int w0 = __builtin_amdgcn_cvt_pk_fp8_f32(32.f * tile[(kc + 0) * 65 + n], 32.f * tile[(kc + 1) * 65 + n], 0, false); w0 = __builtin_amdgcn_cvt_pk_fp8_f32(32.f * tile[(kc + 2) * 65 + n], 32.f * tile[(kc + 3) * 65 + n], w0, true);
                  int w1 = __builtin_amdgcn_cvt_pk_fp8_f32(32.f * tile[(kc + 4) * 65 + n], 32.f * tile[(kc + 5) * 65 + n], 0, false); w1 = __builtin_amdgcn_cvt_pk_fp8_f32(32.f * tile[(kc + 6) * 65 + n], 32.f * tile[(kc + 7) * 65 + n], w1, true);
                  *(u32x2*)((unsigned char*)WT + (size_t)(n0 + n) * K + k0 + kc) = (u32x2){(unsigned)w0, (unsigned)w1};
              } else { u32x4 w;
              w.x = cvt_pk_bf16(tile[(kc + 0) * 65 + n], tile[(kc + 1) * 65 + n]); w.y = cvt_pk_bf16(tile[(kc + 2) * 65 + n], tile[(kc + 3) * 65 + n]);
              w.z = cvt_pk_bf16(tile[(kc + 4) * 65 + n], tile[(kc + 5) * 65 + n]); w.w = cvt_pk_bf16(tile[(kc + 6) * 65 + n], tile[(kc + 7) * 65 + n]);
              *(u32x4*)(WT + (size_t)(n0 + n) * K + k0 + kc) = w; } }
            __syncthreads();
        }
    }
    {
        const size_t gtid = (size_t)bid * NTHR + tid_opaque();
        for (size_t i = gtid; i < 16384; i += gsz) {
            const float* src = P.peer_sk + i * 8; const f32x4 a = *(const f32x4*)src, b = *(const f32x4*)(src + 4);
            u32x4 w; w.x = cvt_pk_bf16(a[0], a[1]); w.y = cvt_pk_bf16(a[2], a[3]); w.z = cvt_pk_bf16(b[0], b[1]); w.w = cvt_pk_bf16(b[2], b[3]);
            *(u32x4*)((bf16_t*)(P.ws + OFF_SK) + i * 8) = w;
        }
        { const int lane = tid & 63, gw = bid * 8 + (tid >> 6), ngw = G * 8;
          for (int r = gw; r < 2 * 16384; r += ngw) {
              const bool isv = r >= 16384; const int e = isv ? r - 16384 : r;
              const float* s = (isv ? P.peer_v : P.peer_u) + (size_t)e * 1024 + lane * 16;
              f32x4 x[4]; float ss = 0.f;
#pragma unroll
              for (int q = 0; q < 4; ++q) { x[q] = __builtin_nontemporal_load((const f32x4*)(s + 4 * q)); ss += (x[q][0] * x[q][0] + x[q][1] * x[q][1]) + (x[q][2] * x[q][2] + x[q][3] * x[q][3]); }
              const float sc = fmaxf(sqrtf(wave_sum(ss) * (1.0f / 1024.0f)) * (2.6f / 7.5f), 1e-30f), inv = 1.0f / sc;
              unsigned nb[16];
#pragma unroll
              for (int q = 0; q < 4; ++q)
#pragma unroll
                  for (int el = 0; el < 4; ++el) nb[4 * q + el] = (unsigned)fminf(fmaxf(floorf(x[q][el] * inv) + 8.0f, 0.0f), 15.0f);
              u32x2 w;
              w.x = (nb[0] | (nb[4] << 4)) | ((nb[1] | (nb[5] << 4)) << 8) | ((nb[2] | (nb[6] << 4)) << 16) | ((nb[3] | (nb[7] << 4)) << 24);
              w.y = (nb[8] | (nb[12] << 4)) | ((nb[9] | (nb[13] << 4)) << 8) | ((nb[10] | (nb[14] << 4)) << 16) | ((nb[11] | (nb[15] << 4)) << 24);
              if (!isv) { w.x ^= 0x88888888u; w.y ^= 0x88888888u; }
              else { w.x ^= 0x80808080u; w.y ^= 0x80808080u; }
              *(u32x2*)(P.ws + (isv ? OFF_V8 : OFF_U8) + (size_t)e * 512 + lane * 8) = w;
              if (lane == 0) ((float*)(P.ws + (isv ? OFF_VSC : OFF_USC)))[e] = sc;
          } }
    }
}
__device__ void phase0b(const Params& P) {
    const size_t gtid = (size_t)blockIdx.x * NTHR + threadIdx.x, gsz = (size_t)gridDim.x * NTHR;
    const float* ada = (const float*)(P.ws + OFF_ADA); bf16_t* H = (bf16_t*)(P.ws + OFF_H);
    for (size_t i = gtid; i < (size_t)NTOK * 128; i += gsz) {
        const size_t row = i >> 7; const int c8 = (int)(i & 127) * 8; const int b = (int)(row >> 11);
        const float* xr = P.x + row * 1024 + c8; const float* sh = ada + (size_t)b * 6144 + c8; const float* sc = sh + 1024;
        const f32x4 x0 = *(const f32x4*)xr, x1 = *(const f32x4*)(xr + 4), s0 = *(const f32x4*)sc, s1 = *(const f32x4*)(sc + 4), h0 = *(const f32x4*)sh, h1 = *(const f32x4*)(sh + 4);
        const f32x4 r0 = x0 * (s0 + 1.0f) + h0, r1 = x1 * (s1 + 1.0f) + h1;
        int w0 = __builtin_amdgcn_cvt_pk_fp8_f32(r0[0], r0[1], 0, false); w0 = __builtin_amdgcn_cvt_pk_fp8_f32(r0[2], r0[3], w0, true);
        int w1 = __builtin_amdgcn_cvt_pk_fp8_f32(r1[0], r1[1], 0, false); w1 = __builtin_amdgcn_cvt_pk_fp8_f32(r1[2], r1[3], w1, true);
        *(u32x2*)((unsigned char*)H + row * 1024 + c8) = (u32x2){(unsigned)w0, (unsigned)w1};
    }
}

__device__ __forceinline__ s16x4 tr4(const LAS unsigned char* p) { return __builtin_bit_cast(s16x4, __builtin_amdgcn_ds_read_tr16_b64_v4i16((LAS s16x4*)p)); }
__device__ void hgrn_item(const Params& P, int item, LAS unsigned char* lds) {
    const int tid = tid_opaque(), lane = tid & 63, wid = __builtin_amdgcn_readfirstlane(tid >> 6), r32 = lane & 31, hi = lane >> 5;
    const int b = item >> 3, h = (item >> 1) & 3, vh = item & 1;
    const bf16_t* HQ = (const bf16_t*)(P.ws + OFF_HQ); const bf16_t* HK = (const bf16_t*)(P.ws + OFF_HK); bf16_t* HI = (bf16_t*)(P.ws + OFF_HI);
    constexpr int SQ = 272, SKD = 320, SV = 192, SS = 192;
    constexpr int LQR = 0, LKR = 17408, LQB = 34816, LKD = 52224, LV = 72704, LS = 84992, LG = 109568, LT = 142336, LCL = 144384;
    LAS float* G = (LAS float*)(lds + LG); LAS float* TOT = (LAS float*)(lds + LT); LAS float* CL = (LAS float*)(lds + LCL);
    const size_t rowb = (size_t)b * SEQ;
    const int row = tid >> 3, seg = tid & 7;
    const bf16_t* qsrc = HQ + (rowb + row) * 512 + h * 128 + seg * 16; const bf16_t* ksrc = HK + (rowb + row) * 512 + h * 128 + seg * 16;
    bf16_t* vsrc = HI + (rowb + row) * 512 + h * 128 + vh * 64 + seg * 8;
    for (int i = tid; i < 128 * SS / 4; i += NTHR) ((LAS unsigned*)(lds + LS))[i] = 0u;
    f32x16 Sacc = {};
    const int di = wid >> 1, vi = wid & 1, ti = wid >> 1;
    const int tg = lane >> 4, tc = tg & 1, tI = lane & 15;
    const int trow = 4 * hi + (tI >> 2), tcol = 16 * tc + 4 * (tI & 3);
    u32x4 qn0 = *(const u32x4*)qsrc, qn1 = *(const u32x4*)(qsrc + 8), kn0 = *(const u32x4*)ksrc, kn1 = *(const u32x4*)(ksrc + 8), vn = *(const u32x4*)vsrc;
#pragma unroll 1
    for (int n = 0; n < SEQ / 64; ++n) {
        const u32x4 q0 = qn0, q1 = qn1, k0 = kn0, k1 = kn1, vv = vn;
        float qf[16] = {bf_lo(q0.x), bf_hi(q0.x), bf_lo(q0.y), bf_hi(q0.y), bf_lo(q0.z), bf_hi(q0.z), bf_lo(q0.w), bf_hi(q0.w), bf_lo(q1.x), bf_hi(q1.x), bf_lo(q1.y), bf_hi(q1.y), bf_lo(q1.z), bf_hi(q1.z), bf_lo(q1.w), bf_hi(q1.w)};
        float kf[16] = {bf_lo(k0.x), bf_hi(k0.x), bf_lo(k0.y), bf_hi(k0.y), bf_lo(k0.z), bf_hi(k0.z), bf_lo(k0.w), bf_hi(k0.w), bf_lo(k1.x), bf_hi(k1.x), bf_lo(k1.y), bf_hi(k1.y), bf_lo(k1.z), bf_hi(k1.z), bf_lo(k1.w), bf_hi(k1.w)};
#pragma unroll
        for (int e4 = 0; e4 < 4; ++e4) *(LAS f32x4*)(G + row * 128 + seg * 16 + 4 * e4) = (f32x4){__logf(1.0f - kf[4 * e4]), __logf(1.0f - kf[4 * e4 + 1]), __logf(1.0f - kf[4 * e4 + 2]), __logf(1.0f - kf[4 * e4 + 3])};
        *(LAS u32x4*)(lds + LV + row * SV + seg * 16) = vv;
        if (n + 1 < SEQ / 64) { const size_t o = (size_t)(n + 1) * 64 * 512; qn0 = *(const u32x4*)(qsrc + o); qn1 = *(const u32x4*)(qsrc + o + 8); kn0 = *(const u32x4*)(ksrc + o); kn1 = *(const u32x4*)(ksrc + o + 8); vn = *(const u32x4*)(vsrc + o); }
        __syncthreads();
        { const int d = tid & 127, q4 = tid >> 7; float s = 0.f;
#pragma unroll
          for (int i = 0; i < 16; ++i) { s += G[(16 * q4 + i) * 128 + d]; G[(16 * q4 + i) * 128 + d] = s; }
          TOT[q4 * 128 + d] = s; }
        __syncthreads();
        {
            const int qq = row >> 4;
#pragma unroll
            for (int e4 = 0; e4 < 4; ++e4) {
                const int d4 = seg * 16 + 4 * e4;
                const f32x4 t0 = *(const LAS f32x4*)(TOT + d4), t1 = *(const LAS f32x4*)(TOT + 128 + d4), t2 = *(const LAS f32x4*)(TOT + 256 + d4), t3 = *(const LAS f32x4*)(TOT + 384 + d4);
                const f32x4 off = (qq == 0) ? (f32x4){0.f, 0.f, 0.f, 0.f} : ((qq == 1) ? t0 : ((qq == 2) ? t0 + t1 : t0 + t1 + t2));
                const f32x4 bb = *(const LAS f32x4*)(G + row * 128 + d4) + off;
                const f32x4 bref = *(const LAS f32x4*)(G + 32 * 128 + d4) + t0 + t1, blast = t0 + t1 + t2 + t3;
                float vqb[4], vqr[4], vkr[4], vkd[4];
#pragma unroll
                for (int e = 0; e < 4; ++e) {
                    const float e1 = __expf(bb[e]), e2 = __expf(-bb[e]);
                    vqb[e] = qf[4 * e4 + e] * e1; vqr[e] = vqb[e] * __expf(-bref[e]);
                    const float ke = kf[4 * e4 + e] * e2; vkr[e] = ke * __expf(bref[e]); vkd[e] = ke * __expf(blast[e]);
                }
                *(LAS u32x2*)(lds + LQB + row * SQ + seg * 32 + 8 * e4) = (u32x2){cvt_pk_bf16(vqb[0], vqb[1]), cvt_pk_bf16(vqb[2], vqb[3])};
                *(LAS u32x2*)(lds + LQR + row * SQ + seg * 32 + 8 * e4) = (u32x2){cvt_pk_bf16(vqr[0], vqr[1]), cvt_pk_bf16(vqr[2], vqr[3])};
                *(LAS u32x2*)(lds + LKR + row * SQ + seg * 32 + 8 * e4) = (u32x2){cvt_pk_bf16(vkr[0], vkr[1]), cvt_pk_bf16(vkr[2], vkr[3])};
                *(LAS u32x2*)(lds + LKD + row * SKD + seg * 32 + 8 * e4) = (u32x2){cvt_pk_bf16(vkd[0], vkd[1]), cvt_pk_bf16(vkd[2], vkd[3])};
                if (row == 0) *(LAS f32x4*)(CL + d4) = (f32x4){__expf(blast[0]), __expf(blast[1]), __expf(blast[2]), __expf(blast[3])};
                asm volatile("" ::: "memory");
            }
        }
        __syncthreads();
        if (wid < 4) {
            f32x16 Z = {};
            for (int si = 0; si <= ti; ++si) {
                f32x16 X = {};
#pragma unroll
                for (int ks = 0; ks < 8; ++ks) {
                    const bf16x8 a = *(const LAS bf16x8*)(lds + LKR + (32 * si + r32) * SQ + (16 * ks + 8 * hi) * 2);
                    const bf16x8 bq = *(const LAS bf16x8*)(lds + LQR + (32 * ti + r32) * SQ + (16 * ks + 8 * hi) * 2);
                    X = MFMA32(a, bq, X);
                }
                if (si == ti) {
#pragma unroll
                    for (int r = 0; r < 16; ++r) if (crow(r, hi) > r32) X[r] = 0.f;
                }
#pragma unroll
                for (int s2 = 0; s2 < 2; ++s2) {
                    union { u32x4 u; bf16x8 v; } pa;
                    pa.u.x = cvt_pk_bf16(X[8 * s2 + 0], X[8 * s2 + 1]); pa.u.y = cvt_pk_bf16(X[8 * s2 + 2], X[8 * s2 + 3]); pa.u.z = cvt_pk_bf16(X[8 * s2 + 4], X[8 * s2 + 5]); pa.u.w = cvt_pk_bf16(X[8 * s2 + 6], X[8 * s2 + 7]);
                    const LAS unsigned char* vp = lds + LV + (32 * si + 16 * s2 + trow) * SV + (32 * vi + tcol) * 2;
                    const s16x4 lo = tr4(vp), hh = tr4(vp + 8 * SV);
                    const bf16x8 vf = {lo[0], lo[1], lo[2], lo[3], hh[0], hh[1], hh[2], hh[3]};
                    Z = MFMA32(pa.v, vf, Z);
                }
            }
#pragma unroll
            for (int ks = 0; ks < 8; ++ks) {
                const bf16x8 a = *(const LAS bf16x8*)(lds + LQB + (32 * ti + r32) * SQ + (16 * ks + 8 * hi) * 2);
                const LAS unsigned char* sp = lds + LS + (16 * ks + 8 * hi + (tI >> 2)) * SS + (32 * vi + tcol) * 2;
                const s16x4 lo = tr4(sp), hh = tr4(sp + 4 * SS);
                const bf16x8 sf = {lo[0], lo[1], lo[2], lo[3], hh[0], hh[1], hh[2], hh[3]};
                Z = MFMA32(a, sf, Z);
            }
            bf16_t* op = HI + (rowb + (size_t)n * 64 + 32 * ti) * 512 + h * 128 + vh * 64 + 32 * vi + r32;
#pragma unroll
            for (int r = 0; r < 16; ++r) op[(size_t)crow(r, hi) * 512] = (bf16_t)(cvt_pk_bf16(Z[r], 0.f) & 0xffffu);
        }
        {
#pragma unroll
            for (int r = 0; r < 16; ++r) Sacc[r] *= CL[32 * di + crow(r, hi)];
#pragma unroll
            for (int ks = 0; ks < 4; ++ks) {
                const LAS unsigned char* kp = lds + LKD + (16 * ks + 8 * hi + (tI >> 2)) * SKD + (32 * di + tcol) * 2;
                const s16x4 klo = tr4(kp), khi = tr4(kp + 4 * SKD);
                const bf16x8 ka = {klo[0], klo[1], klo[2], klo[3], khi[0], khi[1], khi[2], khi[3]};
                const LAS unsigned char* vp = lds + LV + (16 * ks + 8 * hi + (tI >> 2)) * SV + (32 * vi + tcol) * 2;
                const s16x4 vlo = tr4(vp), vhi = tr4(vp + 4 * SV);
                const bf16x8 vb = {vlo[0], vlo[1], vlo[2], vlo[3], vhi[0], vhi[1], vhi[2], vhi[3]};
                Sacc = MFMA32(ka, vb, Sacc);
            }
        }
        __syncthreads();
        {
            LAS bf16_t* sp = (LAS bf16_t*)(lds + LS + (32 * di) * SS + (32 * vi + r32) * 2);
#pragma unroll
            for (int r = 0; r < 16; ++r) sp[crow(r, hi) * (SS / 2)] = (bf16_t)(cvt_pk_bf16(Sacc[r], 0.f) & 0xffffu);
        }
    }
    __syncthreads();
}

__device__ void moba_unit(const Params& P, int b, int h, int j, LAS unsigned char* lds) {
    const int tid = tid_opaque(), lane = tid & 63, wid = tid >> 6, r32 = lane & 31, hi = lane >> 5;
    bf16_t* Q = (bf16_t*)(P.ws + OFF_QA); const bf16_t* Kg = (const bf16_t*)(P.ws + OFF_KA); const bf16_t* Vg = (const bf16_t*)(P.ws + OFF_VA);
    const float* kmean = (const float*)(P.ws + OFF_KMEAN);
    constexpr int KIMG = 64 * 144, VIMG = 64 * 192, LK = 0, LV = 4 * KIMG, LKM = 4 * KIMG + 4 * VIMG;
    LAS float* kmL = (LAS float*)(lds + LKM);
    const size_t rowb = (size_t)b * SEQ; const int q0 = j * 256;
    if (tid < j * 64) kmL[tid] = kmean[(size_t)(b * 8 + (tid >> 6)) * 512 + h * 64 + (tid & 63)];
    bf16_t* qrow = Q + (rowb + q0 + wid * 32 + r32) * 512 + h * 64;
    bf16x8 qf[4];
#pragma unroll
    for (int d0 = 0; d0 < 4; ++d0) qf[d0] = *(const bf16x8*)(qrow + 16 * d0 + 8 * hi);
    const int srow = tid >> 3, sch = tid & 7;
    const bf16_t* ksrc = Kg + (rowb + srow) * 512 + h * 64 + sch * 8; const bf16_t* vsrc = Vg + (rowb + srow) * 512 + h * 64 + sch * 8;
    const int ntile = 4 * (j + 1), npair = ntile >> 1;
    auto tile_key0 = [&](int i) -> size_t { const int blk = (i < 4) ? j : ((i - 4) >> 2), kt = (i < 4) ? i : ((i - 4) & 3); return (size_t)(blk * 256 + kt * 64); };
    u32x4 kreg[2], vreg[2];
#pragma unroll
    for (int s = 0; s < 2; ++s) { const size_t k0 = tile_key0(s); kreg[s] = *(const u32x4*)(ksrc + k0 * 512); vreg[s] = *(const u32x4*)(vsrc + k0 * 512); }
#pragma unroll
    for (int s = 0; s < 2; ++s) { *(LAS u32x4*)(lds + LK + s * KIMG + srow * 144 + sch * 16) = kreg[s]; *(LAS u32x4*)(lds + LV + s * VIMG + srow * 192 + sch * 16) = vreg[s]; }
    __syncthreads();
    unsigned sel = 0;
    if (j <= 3) sel = (1u << j) - 1u;
    else {
        float g[7];
#pragma unroll
        for (int n = 0; n < 7; ++n) { float s = 0.f;
            if (n < j) {
#pragma unroll
                for (int d0 = 0; d0 < 4; ++d0)
#pragma unroll
                    for (int e = 0; e < 8; ++e) s += __uint_as_float(((unsigned)(unsigned short)qf[d0][e]) << 16) * kmL[n * 64 + 16 * d0 + 8 * hi + e];
            }
            s += __shfl_xor(s, 32); g[n] = s; }
#pragma unroll
        for (int it = 0; it < 3; ++it) { float best = -INFINITY; int bi = 0;
#pragma unroll
            for (int n = 0; n < 7; ++n) if (n < j && !((sel >> n) & 1u) && g[n] > best) { best = g[n]; bi = n; }
            sel |= 1u << bi; }
    }
    const float ch = exp2f(-(float)(h + 1)) * LOG2E;
    const int qb = wid * 32 + r32;
    float m_run = -1e30f;
    f32x16 o0 = {}, o1 = {}, o2 = {};
    f32x16 al0, al1;
#pragma unroll
    for (int r = 0; r < 16; ++r) { al0[r] = ch * (float)crow(r, hi); al1[r] = ch * (float)(crow(r, hi) + 32); }
    const bf16x8 ones8 = {(short)0x3F80, (short)0x3F80, (short)0x3F80, (short)0x3F80, (short)0x3F80, (short)0x3F80, (short)0x3F80, (short)0x3F80};
    const int tg = lane >> 4, tc = tg & 1, ti = lane & 15;
    const int vlane = (4 * hi + (ti >> 2)) * 192 + (16 * tc + 4 * (ti & 3)) * 2;
#pragma unroll 1
    for (int ip = 0; ip < npair; ++ip) {
      const int pbuf = ip & 1;
      if (ip + 1 < npair) {
#pragma unroll
          for (int s = 0; s < 2; ++s) { const size_t k1 = tile_key0(2 * ip + 2 + s); kreg[s] = *(const u32x4*)(ksrc + k1 * 512); vreg[s] = *(const u32x4*)(vsrc + k1 * 512); }
      }
#pragma unroll
      for (int s2 = 0; s2 < 2; ++s2) {
        const int i = 2 * ip + s2, buf = pbuf * 2 + s2;
        const bool own = i < 4; const int blk = own ? j : ((i - 4) >> 2), kt = own ? i : ((i - 4) & 3);
        const bool lane_ok = own ? true : (((sel >> blk) & 1u) != 0u);
        const bool skip = own ? (64 * kt > 32 * wid + 31) : (__ballot(lane_ok) == 0ull);
        if (!skip) {
            LAS unsigned char* kb = lds + LK + buf * KIMG; LAS unsigned char* vb = lds + LV + buf * VIMG;
            f32x16 p0, p1;
#pragma unroll
            for (int d0 = 0; d0 < 4; ++d0) {
                const bf16x8 kf0 = *(const LAS bf16x8*)(kb + r32 * 144 + (16 * d0 + 8 * hi) * 2);
                const bf16x8 kf1 = *(const LAS bf16x8*)(kb + (32 + r32) * 144 + (16 * d0 + 8 * hi) * 2);
                p0 = MFMA32(kf0, qf[d0], d0 == 0 ? al0 : p0); p1 = MFMA32(kf1, qf[d0], d0 == 0 ? al1 : p1);
            }
            const float kbase = ch * (float)((blk - j) * 256 + kt * 64);
            float mt = -1e30f;
#pragma unroll
            for (int r = 0; r < 16; ++r) {
                const int kl0 = crow(r, hi), kl1 = kl0 + 32;
                if (own) { if (kt * 64 + kl0 > qb) p0[r] = -1e30f; if (kt * 64 + kl1 > qb) p1[r] = -1e30f; }
                mt = fmaxf(mt, fmaxf(p0[r], p1[r]));
            }
            mt = lane_ok ? mt + kbase : -1e30f;
            mt = fmaxf(mt, __shfl_xor(mt, 32));
            if (__ballot(mt > m_run) != 0ull) {
                const float mnew = fmaxf(m_run, mt), alpha = __builtin_amdgcn_exp2f(m_run - mnew);
                m_run = mnew;
#pragma unroll
                for (int r = 0; r < 16; ++r) { o0[r] *= alpha; o1[r] *= alpha; o2[r] *= alpha; }
            }
            const float sh = lane_ok ? kbase - m_run : -1e30f;
#pragma unroll
            for (int r = 0; r < 16; ++r) { p0[r] = __builtin_amdgcn_exp2f(p0[r] + sh); p1[r] = __builtin_amdgcn_exp2f(p1[r] + sh); }
#pragma unroll
            for (int sub = 0; sub < 2; ++sub)
#pragma unroll
                for (int s = 0; s < 2; ++s) {
                    union { u32x4 u; bf16x8 v; } pb;
                    if (sub == 0) { pb.u.x = cvt_pk_bf16(p0[8 * s + 0], p0[8 * s + 1]); pb.u.y = cvt_pk_bf16(p0[8 * s + 2], p0[8 * s + 3]); pb.u.z = cvt_pk_bf16(p0[8 * s + 4], p0[8 * s + 5]); pb.u.w = cvt_pk_bf16(p0[8 * s + 6], p0[8 * s + 7]); }
                    else { pb.u.x = cvt_pk_bf16(p1[8 * s + 0], p1[8 * s + 1]); pb.u.y = cvt_pk_bf16(p1[8 * s + 2], p1[8 * s + 3]); pb.u.z = cvt_pk_bf16(p1[8 * s + 4], p1[8 * s + 5]); pb.u.w = cvt_pk_bf16(p1[8 * s + 6], p1[8 * s + 7]); }
#pragma unroll
                    for (int dt = 0; dt < 2; ++dt) {
                        LAS unsigned char* va = vb + (32 * sub + 16 * s) * 192 + dt * 64 + vlane;
                        const s16x4 lo = __builtin_bit_cast(s16x4, __builtin_amdgcn_ds_read_tr16_b64_v4i16((LAS s16x4*)va));
                        const s16x4 hh = __builtin_bit_cast(s16x4, __builtin_amdgcn_ds_read_tr16_b64_v4i16((LAS s16x4*)(va + 8 * 192)));
                        const bf16x8 vf = {lo[0], lo[1], lo[2], lo[3], hh[0], hh[1], hh[2], hh[3]};
                        if (dt == 0) o0 = MFMA32(vf, pb.v, o0); else o1 = MFMA32(vf, pb.v, o1);
                    }
                    o2 = MFMA32(ones8, pb.v, o2);
                }
        }
      }
      if (ip + 1 < npair) { const int nb = (pbuf ^ 1) * 2;
#pragma unroll
          for (int s = 0; s < 2; ++s) { *(LAS u32x4*)(lds + LK + (nb + s) * KIMG + srow * 144 + sch * 16) = kreg[s]; *(LAS u32x4*)(lds + LV + (nb + s) * VIMG + srow * 192 + sch * 16) = vreg[s]; } }
      __syncthreads();
    }
    const float inv = 1.0f / o2[0];
#pragma unroll
    for (int r4 = 0; r4 < 4; ++r4) {
        int w0 = __builtin_amdgcn_cvt_pk_fp8_f32(o0[4 * r4] * inv, o0[4 * r4 + 1] * inv, 0, false); w0 = __builtin_amdgcn_cvt_pk_fp8_f32(o0[4 * r4 + 2] * inv, o0[4 * r4 + 3] * inv, w0, true);
        int w1 = __builtin_amdgcn_cvt_pk_fp8_f32(o1[4 * r4] * inv, o1[4 * r4 + 1] * inv, 0, false); w1 = __builtin_amdgcn_cvt_pk_fp8_f32(o1[4 * r4 + 2] * inv, o1[4 * r4 + 3] * inv, w1, true);
        unsigned char* yrow = P.ws + OFF_EG + (rowb + q0 + wid * 32 + r32) * 1024 + h * 64;
        *(int*)(yrow + 8 * r4 + 4 * hi) = w0; *(int*)(yrow + 32 + 8 * r4 + 4 * hi) = w1;
    }
}

__device__ void yb_norm_panel(const Params& P, int pm) {
    const int tid = tid_opaque(), lane = tid & 63, wid = tid >> 6;
    bf16_t* HI = (bf16_t*)(P.ws + OFF_HI); const bf16_t* HG = (const bf16_t*)(P.ws + OFF_HG);
    for (int r = 0; r < 32; ++r) {
        const size_t off = ((size_t)pm * 256 + wid * 32 + r) * 512 + lane * 8;
        const u32x4 ov = *(const u32x4*)(HI + off), gv = *(const u32x4*)(HG + off);
        float o[8] = {bf_lo(ov.x), bf_hi(ov.x), bf_lo(ov.y), bf_hi(ov.y), bf_lo(ov.z), bf_hi(ov.z), bf_lo(ov.w), bf_hi(ov.w)};
        const float g[8] = {bf_lo(gv.x), bf_hi(gv.x), bf_lo(gv.y), bf_hi(gv.y), bf_lo(gv.z), bf_hi(gv.z), bf_lo(gv.w), bf_hi(gv.w)};
        float ss = 0.f;
#pragma unroll
        for (int e = 0; e < 8; ++e) ss += o[e] * o[e];
        ss += __shfl_xor(ss, 1); ss += __shfl_xor(ss, 2); ss += __shfl_xor(ss, 4); ss += __shfl_xor(ss, 8);
        const float rs = rsqrtf(ss * (1.0f / 128.0f) + RMS_EPS);
        int w0 = __builtin_amdgcn_cvt_pk_fp8_f32(o[0] * rs * g[0], o[1] * rs * g[1], 0, false); w0 = __builtin_amdgcn_cvt_pk_fp8_f32(o[2] * rs * g[2], o[3] * rs * g[3], w0, true);
        int w1 = __builtin_amdgcn_cvt_pk_fp8_f32(o[4] * rs * g[4], o[5] * rs * g[5], 0, false); w1 = __builtin_amdgcn_cvt_pk_fp8_f32(o[6] * rs * g[6], o[7] * rs * g[7], w1, true);
        *(u32x2*)(P.ws + OFF_EG + ((size_t)pm * 256 + wid * 32 + r) * 1024 + 512 + lane * 8) = (u32x2){(unsigned)w0, (unsigned)w1};
    }
}
__device__ void ln1_panel(const Params& P, int pm) {
    const int tid = tid_opaque(), lane = tid & 63, wid = tid >> 6;
    const float* ada = (const float*)(P.ws + OFF_ADA) + (size_t)(pm >> 3) * 6144; bf16_t* H = (bf16_t*)(P.ws + OFF_H);
    for (int r = 0; r < 32; ++r) {
        const size_t row = (size_t)pm * 256 + wid * 32 + r;
        const float* xin = P.x + row * 1024 + lane * 4; const unsigned char* dl = P.ws + OFF_GB + row * 2048 + lane * 4;
        f32x4 v[4]; float s = 0.f;
#pragma unroll
        for (int jx = 0; jx < 4; ++jx) { const int dv = *(const int*)(dl + 256 * jx); const f32x4 xv = __builtin_nontemporal_load((const f32x4*)(xin + 256 * jx));
            const f32x2 d01 = __builtin_amdgcn_cvt_pk_f32_fp8(dv, false), d23 = __builtin_amdgcn_cvt_pk_f32_fp8(dv, true);
            v[jx] = xv * ALPHA + (f32x4){d01.x, d01.y, d23.x, d23.y}; s += (v[jx][0] + v[jx][1]) + (v[jx][2] + v[jx][3]); }
        const float mean = wave_sum(s) * (1.0f / 1024.0f); float s2 = 0.f;
#pragma unroll
        for (int jx = 0; jx < 4; ++jx) { v[jx] = v[jx] - mean; s2 += (v[jx][0] * v[jx][0] + v[jx][1] * v[jx][1]) + (v[jx][2] * v[jx][2] + v[jx][3] * v[jx][3]); }
        const float rstd = rsqrtf(wave_sum(s2) * (1.0f / 1024.0f) + LN_EPS);
#pragma unroll
        for (int jx = 0; jx < 4; ++jx) {
            const int c = lane * 4 + 256 * jx;
            const f32x4 g = *(const f32x4*)(P.ln1_g + c), bb = *(const f32x4*)(P.ln1_b + c), sh = *(const f32x4*)(ada + 3072 + c), sc = *(const f32x4*)(ada + 4096 + c);
            const f32x4 x1 = v[jx] * rstd * g + bb;
            { u32x2 w1; w1.x = cvt_pk_bf16(x1[0], x1[1]); w1.y = cvt_pk_bf16(x1[2], x1[3]);
              *(u32x2*)((bf16_t*)(P.out + row * 1024) + c) = w1; }
            const f32x4 h2 = x1 * (sc + 1.0f) + sh;
            u32x2 w; w.x = cvt_pk_bf16(h2[0], h2[1]); w.y = cvt_pk_bf16(h2[2], h2[3]);
            *(u32x2*)(H + row * 1024 + c) = w;
            v[jx] = h2;
        }
        {
            float mx = 0.f;
#pragma unroll
            for (int jx = 0; jx < 4; ++jx) mx = fmaxf(mx, fmaxf(fmaxf(fabsf(v[jx][0]), fabsf(v[jx][1])), fmaxf(fabsf(v[jx][2]), fabsf(v[jx][3]))));
#pragma unroll
            for (int o = 1; o < 64; o <<= 1) mx = fmaxf(mx, __shfl_xor(mx, o));
            const float hs = fmaxf(mx * (1.0f / 119.0f), 1e-30f), inv = 1.0f / hs; int qs = 0;
            const int nsh = (lane & 1) * 4;
#pragma unroll
            for (int jx = 0; jx < 4; ++jx) {
                unsigned pa = 0u, pb = 0u;
#pragma unroll
                for (int k = 0; k < 4; ++k) { const int q = (int)rintf(v[jx][k] * inv); qs += q;
                    const int b = ((q + 8) & 15) - 8, a = (q - b) >> 4;
                    pa |= (unsigned)(a & 15) << (8 * k + nsh); pb |= (unsigned)(b & 15) << (8 * k + nsh); }
                pa |= __shfl_xor(pa, 1); pb |= __shfl_xor(pb, 1);
                if (!(lane & 1)) { unsigned* hp4 = (unsigned*)(P.ws + OFF_H8 + row * 1024) + (lane >> 1) + 32 * jx; hp4[0] = pa; hp4[128] = pb; }
            }
#pragma unroll
            for (int o = 1; o < 64; o <<= 1) qs += __shfl_xor(qs, o);
            if (lane == 0) *(f32x2*)(P.ws + OFF_HS + row * 8) = (f32x2){hs, (float)qs};
        }
    }
}

#define CE16(A, i, j) do { const float hi_ = fmaxf(A[i], A[j]); A[j] = fminf(A[i], A[j]); A[i] = hi_; } while (0)
#define SORT16(A) do { CE16(A, 0, 1); CE16(A, 2, 3); CE16(A, 0, 2); CE16(A, 1, 3); CE16(A, 1, 2); CE16(A, 4, 5); CE16(A, 6, 7); CE16(A, 4, 6); CE16(A, 5, 7); CE16(A, 5, 6); CE16(A, 0, 4); CE16(A, 2, 6); CE16(A, 2, 4); CE16(A, 1, 5); CE16(A, 3, 7); CE16(A, 3, 5); CE16(A, 1, 2); CE16(A, 3, 4); CE16(A, 5, 6); CE16(A, 8, 9); CE16(A, 10, 11); CE16(A, 8, 10); CE16(A, 9, 11); CE16(A, 9, 10); CE16(A, 12, 13); CE16(A, 14, 15); CE16(A, 12, 14); CE16(A, 13, 15); CE16(A, 13, 14); CE16(A, 8, 12); CE16(A, 10, 14); CE16(A, 10, 12); CE16(A, 9, 13); CE16(A, 11, 15); CE16(A, 11, 13); CE16(A, 9, 10); CE16(A, 11, 12); CE16(A, 13, 14); CE16(A, 0, 8); CE16(A, 4, 12); CE16(A, 4, 8); CE16(A, 2, 10); CE16(A, 6, 14); CE16(A, 6, 10); CE16(A, 2, 4); CE16(A, 6, 8); CE16(A, 10, 12); CE16(A, 1, 9); CE16(A, 5, 13); CE16(A, 5, 9); CE16(A, 3, 11); CE16(A, 7, 15); CE16(A, 7, 11); CE16(A, 3, 5); CE16(A, 7, 9); CE16(A, 11, 13); CE16(A, 1, 2); CE16(A, 3, 4); CE16(A, 5, 6); CE16(A, 7, 8); CE16(A, 9, 10); CE16(A, 11, 12); CE16(A, 13, 14); } while (0)
#define BITONIC16(A) do { CE16(A, 0, 8); CE16(A, 1, 9); CE16(A, 2, 10); CE16(A, 3, 11); CE16(A, 4, 12); CE16(A, 5, 13); CE16(A, 6, 14); CE16(A, 7, 15); CE16(A, 0, 4); CE16(A, 1, 5); CE16(A, 2, 6); CE16(A, 3, 7); CE16(A, 8, 12); CE16(A, 9, 13); CE16(A, 10, 14); CE16(A, 11, 15); CE16(A, 0, 2); CE16(A, 1, 3); CE16(A, 4, 6); CE16(A, 5, 7); CE16(A, 8, 10); CE16(A, 9, 11); CE16(A, 12, 14); CE16(A, 13, 15); CE16(A, 0, 1); CE16(A, 2, 3); CE16(A, 4, 5); CE16(A, 6, 7); CE16(A, 8, 9); CE16(A, 10, 11); CE16(A, 12, 13); CE16(A, 14, 15); } while (0)
#define INS16(L, xin) do { float x_ = (xin); _Pragma("unroll") for (int k_ = 0; k_ < 16; ++k_) { const float hi_ = fmaxf(L[k_], x_); x_ = fminf(L[k_], x_); L[k_] = hi_; } } while (0)

__device__ void peer_select_wave(const Params& P, size_t tok0) {
    const int lane = tid_opaque() & 63, r32 = lane & 31, hi = lane >> 5;
    const bf16_t* QP = (const bf16_t*)(P.ws + OFF_GB) + (tok0 + r32) * 1024; const bf16_t* SK = (const bf16_t*)(P.ws + OFF_SK);
    unsigned* EG = (unsigned*)(P.ws + OFF_EG) + (tok0 + r32) * 128;
#pragma unroll 1
    for (int h = 0; h < 8; ++h) {
        float a0[16], a1[16];
#pragma unroll
        for (int k = 0; k < 16; ++k) { a0[k] = -INFINITY; a1[k] = -INFINITY; }
#pragma unroll
        for (int p = 0; p < 2; ++p) {
            const int hp = h * 2 + p;
            bf16x8 qf[4];
#pragma unroll
            for (int ks = 0; ks < 4; ++ks) qf[ks] = *(const bf16x8*)(QP + hp * 64 + 16 * ks + 8 * hi);
            float L[16];
#pragma unroll
            for (int kt = 0; kt < 4; ++kt) {
                f32x16 acc = {};
#pragma unroll
                for (int ks = 0; ks < 4; ++ks) { const bf16x8 kf = *(const bf16x8*)(SK + ((size_t)hp * 128 + 32 * kt + r32) * 64 + 16 * ks + 8 * hi); acc = MFMA32(kf, qf[ks], acc); }
                float S[16];
#pragma unroll
                for (int r = 0; r < 16; ++r) { const unsigned key = (unsigned)(32 * kt + crow(r, hi)); S[r] = __uint_as_float((__float_as_uint(acc[r]) & ~127u) | key); }
                SORT16(S);
                if (kt == 0) {
#pragma unroll
                    for (int k = 0; k < 16; ++k) L[k] = S[k];
                } else {
#pragma unroll
                    for (int k = 0; k < 16; ++k) L[k] = fmaxf(L[k], S[15 - k]);
                    BITONIC16(L);
                }
            }
            {
                float O[16];
#pragma unroll
                for (int k = 0; k < 16; ++k) O[k] = __shfl_xor(L[15 - k], 32);
#pragma unroll
                for (int k = 0; k < 16; ++k) L[k] = fmaxf(L[k], O[k]);
                BITONIC16(L);
            }
#pragma unroll
            for (int k = 0; k < 16; ++k) { a0[k] = (p == 0) ? L[k] : a0[k]; a1[k] = (p == 1) ? L[k] : a1[k]; }
        }
        float best[16];
#pragma unroll
        for (int k = 0; k < 16; ++k) best[k] = __uint_as_float((__float_as_uint(a0[0] + a1[k]) & ~255u) | (unsigned)k);
#define PKC(i, j) __uint_as_float((__float_as_uint(a0[i] + a1[j]) & ~255u) | (unsigned)((i) * 16 + (j)))
        {
            float A[16] = {PKC(1, 0), PKC(1, 1), PKC(1, 2), PKC(1, 3), PKC(1, 4), PKC(1, 5), PKC(1, 6), PKC(1, 7), PKC(15, 0), PKC(14, 0), PKC(13, 0), PKC(12, 0), PKC(11, 0), PKC(10, 0), PKC(9, 0), PKC(8, 0)};
            BITONIC16(A);
#pragma unroll
            for (int k = 0; k < 16; ++k) best[k] = fmaxf(best[k], A[15 - k]);
            BITONIC16(best);
            float B[16] = {PKC(2, 0), PKC(2, 1), PKC(2, 2), PKC(2, 3), PKC(2, 4), PKC(3, 0), PKC(3, 1), PKC(3, 2), PKC(3, 3), PKC(4, 0), PKC(4, 1), PKC(4, 2), PKC(5, 0), PKC(5, 1), PKC(6, 0), PKC(6, 1)};
            SORT16(B);
#pragma unroll
            for (int k = 0; k < 16; ++k) best[k] = fmaxf(best[k], B[15 - k]);
            BITONIC16(best);
            INS16(best, PKC(7, 0)); INS16(best, PKC(7, 1));
        }
#undef PKC
        unsigned pk0[4], pk1[4];
#pragma unroll
        for (int q = 0; q < 4; ++q) {
            pk0[q] = (__float_as_uint(a0[4 * q]) & 127u) | ((__float_as_uint(a0[4 * q + 1]) & 127u) << 8) | ((__float_as_uint(a0[4 * q + 2]) & 127u) << 16) | ((__float_as_uint(a0[4 * q + 3]) & 127u) << 24);
            pk1[q] = (__float_as_uint(a1[4 * q]) & 127u) | ((__float_as_uint(a1[4 * q + 1]) & 127u) << 8) | ((__float_as_uint(a1[4 * q + 2]) & 127u) << 16) | ((__float_as_uint(a1[4 * q + 3]) & 127u) << 24);
        }
        unsigned pay[16];
#pragma unroll
        for (int k = 0; k < 16; ++k) {
            const unsigned code = __float_as_uint(best[k]) & 255u, ci = code >> 4, cj = code & 15u;
            const unsigned qi = ci >> 2, qj = cj >> 2;
            const unsigned w0 = (qi == 0u) ? pk0[0] : ((qi == 1u) ? pk0[1] : ((qi == 2u) ? pk0[2] : pk0[3]));
            const unsigned w1 = (qj == 0u) ? pk1[0] : ((qj == 1u) ? pk1[1] : ((qj == 2u) ? pk1[2] : pk1[3]));
            pay[k] = (((w0 >> ((ci & 3u) * 8u)) & 127u) << 7) | ((w1 >> ((cj & 3u) * 8u)) & 127u);
        }
        float e[16], es = 0.f;
#pragma unroll
        for (int k = 0; k < 16; ++k) { e[k] = __expf(best[k] - best[0]); es += e[k]; }
        const float inv = 1.0f / es;
        if (hi == 0) {
#pragma unroll
            for (int k = 0; k < 16; ++k) EG[h * 16 + k] = pay[k] | (cvt_pk_bf16(e[k] * inv, 0.f) << 16);
        }
    }
}
__device__ __forceinline__ unsigned xcc_id() { return (unsigned)__builtin_amdgcn_s_getreg((3 << 11) | 20) & 0xFu; }
template <int CTRL> __device__ __forceinline__ float dpp_add(float x) { const int v = __builtin_amdgcn_update_dpp(0, __float_as_int(x), CTRL, 0xf, 0xf, true); return x + __int_as_float(v); }
__device__ __forceinline__ float wave_sum_fast(float x) {
    x = dpp_add<0xB1>(x); x = dpp_add<0x4E>(x); x = dpp_add<0x141>(x); x = dpp_add<0x140>(x);
    x += __shfl_xor(x, 16); x += __shfl_xor(x, 32); return x;
}
template <int CTRL> __device__ __forceinline__ float dpp_max(float x) { const int v = __builtin_amdgcn_update_dpp(0, __float_as_int(x), CTRL, 0xf, 0xf, true); return fmaxf(x, __int_as_float(v)); }
template <int CTRL> __device__ __forceinline__ int dpp_addi(int x) { return x + __builtin_amdgcn_update_dpp(0, x, CTRL, 0xf, 0xf, true); }
__device__ __forceinline__ float wave_max_fast(float x) {
    x = dpp_max<0xB1>(x); x = dpp_max<0x4E>(x); x = dpp_max<0x141>(x); x = dpp_max<0x140>(x);
    x = fmaxf(x, __shfl_xor(x, 16)); x = fmaxf(x, __shfl_xor(x, 32)); return x;
}
__device__ __forceinline__ int wave_sum_int_fast(int x) {
    x = dpp_addi<0xB1>(x); x = dpp_addi<0x4E>(x); x = dpp_addi<0x141>(x); x = dpp_addi<0x140>(x);
    x += __shfl_xor(x, 16); x += __shfl_xor(x, 32); return x;
}
__device__ __forceinline__ float dot16_fp8(const float (&hv)[16], const u32x4 r) {
    float s = 0.f;
    { const f32x2 a = __builtin_amdgcn_cvt_pk_f32_fp8((int)r.x, false), b = __builtin_amdgcn_cvt_pk_f32_fp8((int)r.x, true); s += hv[0] * a.x + hv[1] * a.y + hv[2] * b.x + hv[3] * b.y; }
    { const f32x2 a = __builtin_amdgcn_cvt_pk_f32_fp8((int)r.y, false), b = __builtin_amdgcn_cvt_pk_f32_fp8((int)r.y, true); s += hv[4] * a.x + hv[5] * a.y + hv[6] * b.x + hv[7] * b.y; }
    { const f32x2 a = __builtin_amdgcn_cvt_pk_f32_fp8((int)r.z, false), b = __builtin_amdgcn_cvt_pk_f32_fp8((int)r.z, true); s += hv[8] * a.x + hv[9] * a.y + hv[10] * b.x + hv[11] * b.y; }
    { const f32x2 a = __builtin_amdgcn_cvt_pk_f32_fp8((int)r.w, false), b = __builtin_amdgcn_cvt_pk_f32_fp8((int)r.w, true); s += hv[12] * a.x + hv[13] * a.y + hv[14] * b.x + hv[15] * b.y; }
    return s;
}
template <int NP, class F> __device__ __forceinline__ void partition_queue(const Params& P, LAS unsigned char* lds, int ctr_base, F f) {
    const int tid = tid_opaque();
    LAS int* slot = (LAS int*)(lds + LDS_BYTES - 64);
    unsigned* ctr = (unsigned*)(P.ws + OFF_CTR) + ctr_base;
    const int myx = (int)(xcc_id() & 7u);
    for (int pp = 0; pp < NP; ++pp) {
        const int p = (myx * (NP / 8) + pp) % NP;
        for (;;) {
            if (tid == 0) *slot = (int)atomicAdd(ctr + p, 1u);
            __syncthreads();
            const int item = *slot;
            __syncthreads();
            if (item >= NTOK / 64) break;
            f(p, item);
        }
    }
}
__device__ __forceinline__ float dot2bf(unsigned a, bf16v2 b, float c) { return __builtin_amdgcn_fdot2_f32_bf16(__builtin_bit_cast(bf16v2, a), b, c, false); }
__device__ __forceinline__ float gelu_erf(float v) {
    const float av = fabsf(v), t = __builtin_amdgcn_rcpf(__builtin_fmaf(av, 0.2316418882f, 1.0f));
    float q = __builtin_fmaf(t, 0.5307027145f, -0.7265760135f); q = __builtin_fmaf(q, t, 0.7107068705f); q = __builtin_fmaf(q, t, -0.142248368f); q = __builtin_fmaf(q, t, 0.127414796f); q = q * t;
    const float m = v * (q * __builtin_amdgcn_exp2f(v * v * -0.72134752044f));
    return v < 0.f ? m : v - m;
}
struct UQuad { u32x4 r[2]; u32x4 ent, nxt; };
__device__ __forceinline__ void uq_issue(UQuad& q, const LAS u32x4* list, int J, int NQ, int g, const unsigned char* Ub, const unsigned lo) {
    q.ent = q.nxt;
    const unsigned char* rp = Ub + (q.ent.x * 512u + lo);
    q.r[0] = *(const u32x4*)rp; q.r[1] = *(const u32x4*)(rp + 256);
    const int jj = J < NQ ? J : NQ - 1;
    q.nxt = list[4 * jj + g];
}
__device__ __forceinline__ float uq_dot(const UQuad& q, const u32x4 (&hp)[4]) {
    int a = 0, b = 0;
#pragma unroll
    for (int c = 0; c < 2; ++c) {
        const u32x4 r = q.r[c];
        a = __builtin_amdgcn_sdot8((int)hp[c].x, (int)r.x, a, false); a = __builtin_amdgcn_sdot8((int)hp[c].y, (int)r.y, a, false);
        a = __builtin_amdgcn_sdot8((int)hp[c].z, (int)r.z, a, false); a = __builtin_amdgcn_sdot8((int)hp[c].w, (int)r.w, a, false);
        b = __builtin_amdgcn_sdot8((int)hp[2 + c].x, (int)r.x, b, false); b = __builtin_amdgcn_sdot8((int)hp[2 + c].y, (int)r.y, b, false);
        b = __builtin_amdgcn_sdot8((int)hp[2 + c].z, (int)r.z, b, false); b = __builtin_amdgcn_sdot8((int)hp[2 + c].w, (int)r.w, b, false);
    }
    float s = (float)(16 * a + b);
    s = dpp_add<0xB1>(s); s = dpp_add<0x4E>(s); s = dpp_add<0x141>(s); s = dpp_add<0x140>(s);
    return s;
}
__device__ __forceinline__ void peer_u_tokens(const Params& P, LAS unsigned char* lds, const size_t t0) {
    const int tid = tid_opaque(), lane = tid & 63, wid = tid >> 6, g = lane >> 4, li = lane & 15;
    const unsigned char* H8 = P.ws + OFF_H8 + li * 16; const unsigned char* Ub = P.ws + OFF_U8; const unsigned lo16 = (unsigned)li * 16u;
    const f32x2* HS = (const f32x2*)(P.ws + OFF_HS); const float* USC = (const float*)(P.ws + OFF_USC);
    const u32x2* EG2 = (const u32x2*)(P.ws + OFF_EG); unsigned* W = (unsigned*)(P.ws + OFF_W);
    LAS u32x4* list = (LAS u32x4*)(lds + wid * 16384);
    {
        u32x2 egv[8]; float s0[8], s1[8];
#pragma unroll
        for (int i = 0; i < 8; ++i) egv[i] = EG2[(t0 + i) * 64 + lane];
#pragma unroll
        for (int i = 0; i < 8; ++i) { s0[i] = USC[egv[i].x & 0xFFFFu]; s1[i] = USC[egv[i].y & 0xFFFFu]; }
#pragma unroll
        for (int i = 0; i < 8; ++i) {
            list[i * 128 + 2 * lane] = (u32x4){egv[i].x & 0xFFFFu, egv[i].x & 0xFFFF0000u, (unsigned)(2 * lane) | (unsigned)(i << 8), __float_as_uint(s0[i])};
            list[i * 128 + 2 * lane + 1] = (u32x4){egv[i].y & 0xFFFFu, egv[i].y & 0xFFFF0000u, (unsigned)(2 * lane + 1) | (unsigned)(i << 8), __float_as_uint(s1[i])};
        }
    }
    constexpr int NQ = 256;
    u32x4 hp[4], hn[4]; f32x2 hsc = HS[t0], hsn = HS[t0 + 1];
#pragma unroll
    for (int c = 0; c < 2; ++c) { hp[c] = *(const u32x4*)(H8 + t0 * 1024 + 256 * c); hp[2 + c] = *(const u32x4*)(H8 + t0 * 1024 + 512 + 256 * c);
                                  hn[c] = *(const u32x4*)(H8 + (t0 + 1) * 1024 + 256 * c); hn[2 + c] = *(const u32x4*)(H8 + (t0 + 1) * 1024 + 512 + 256 * c); }
    int curtok = 0;
    UQuad q0, q1, q2, q3, q4, q5, q6, q7;
    q0.nxt = list[g]; q1.nxt = list[4 + g]; q2.nxt = list[8 + g]; q3.nxt = list[12 + g]; q4.nxt = list[16 + g]; q5.nxt = list[20 + g]; q6.nxt = list[24 + g]; q7.nxt = list[28 + g];
    uq_issue(q0, list, 8, NQ, g, Ub, lo16); uq_issue(q1, list, 9, NQ, g, Ub, lo16); uq_issue(q2, list, 10, NQ, g, Ub, lo16); uq_issue(q3, list, 11, NQ, g, Ub, lo16);
    uq_issue(q4, list, 12, NQ, g, Ub, lo16); uq_issue(q5, list, 13, NQ, g, Ub, lo16); uq_issue(q6, list, 14, NQ, g, Ub, lo16); uq_issue(q7, list, 15, NQ, g, Ub, lo16);
    float sv = 0.f; unsigned gv = 0u, zv = 0u, ev = 0u;
#define UQ_PIN(q) asm volatile("" : "+v"(q.r[0]), "+v"(q.r[1]) :: "memory")
#define UQ_STEP(q, Jn, kq, qn) do { \
        const float s = __uint_as_float(q.ent.w) * hsc.x * (uq_dot(q, hp) + 0.5f * hsc.y); \
        if (li == (kq)) { sv = s; gv = q.ent.y; zv = q.ent.z; ev = q.ent.x; } \
        uq_issue(q, list, (Jn), NQ, g, Ub, lo16); UQ_PIN(qn); } while (0)
    UQ_PIN(q0);
#pragma unroll 1
    for (int J = 0; J < NQ; J += 8) {
        const int tk = __builtin_amdgcn_readfirstlane((int)(q0.ent.z >> 8));
        if (tk != curtok) { curtok = tk;
#pragma unroll
            for (int c = 0; c < 4; ++c) hp[c] = hn[c];
            hsc = hsn;
            if (tk + 1 < 8) { hsn = HS[t0 + tk + 1];
#pragma unroll
                for (int c = 0; c < 2; ++c) { hn[c] = *(const u32x4*)(H8 + (t0 + tk + 1) * 1024 + 256 * c); hn[2 + c] = *(const u32x4*)(H8 + (t0 + tk + 1) * 1024 + 512 + 256 * c); } } }
        UQ_STEP(q0, J + 16, 0, q1); UQ_STEP(q1, J + 17, 1, q2); UQ_STEP(q2, J + 18, 2, q3); UQ_STEP(q3, J + 19, 3, q4);
        UQ_STEP(q4, J + 20, 4, q5); UQ_STEP(q5, J + 21, 5, q6); UQ_STEP(q6, J + 22, 6, q7); UQ_STEP(q7, J + 23, 7, q0);
        if (li < 8) W[(t0 + tk) * 128 + (zv & 255u)] = ev | (cvt_pk_bf16(__uint_as_float(gv) * gelu_erf(sv), 0.f) << 16); }
#undef UQ_STEP
}
typedef int v4i_t __attribute__((ext_vector_type(4)));
struct VQuad { u32x4 r[2]; u32x2 ent, nxt; };
__device__ __forceinline__ void vq_issue(VQuad& q, const LAS u32x2* list, int J, int g, const unsigned char* Vb, const unsigned lo) {
    q.ent = q.nxt;
    const unsigned char* rp = Vb + (q.ent.x * 512u + lo);
    q.r[0] = *(const u32x4*)rp; q.r[1] = *(const u32x4*)(rp + 256);
    const int jj = J < 256 ? J : 255;
    q.nxt = list[4 * jj + g];
}
#define VQ_PIN(q) asm volatile("" : "+v"(q.r[0]), "+v"(q.r[1]) :: "memory")
__device__ __forceinline__ void vq_mma(const VQuad& q, v4i_t (&acc)[4], const u32x4 bm) {
    const unsigned t = q.ent.y;
    const v4i_t B = {(int)(t & bm.x), (int)(t & bm.y), (int)(t & bm.z), (int)(t & bm.w)};
#pragma unroll
    for (int c = 0; c < 2; ++c) {
        const u32x4 r = q.r[c];
        const v4i_t lo = {(int)(r.x & 0x0F0F0F0Fu), (int)(r.y & 0x0F0F0F0Fu), (int)(r.z & 0x0F0F0F0Fu), (int)(r.w & 0x0F0F0F0Fu)};
        const v4i_t raw = {(int)r.x, (int)r.y, (int)r.z, (int)r.w};
        acc[2 * c] = __builtin_amdgcn_mfma_i32_16x16x64_i8(lo, B, acc[2 * c], 0, 0, 0);
        acc[2 * c + 1] = __builtin_amdgcn_mfma_i32_16x16x64_i8(raw, B, acc[2 * c + 1], 0, 0, 0);
    }
}
__device__ __forceinline__ void peer_v_tokens(const Params& P, LAS unsigned char* lds, const size_t t0) {
    const int tid = tid_opaque(), lane = tid & 63, wid = tid >> 6, g = lane >> 4, li = lane & 15;
    const unsigned char* Vb = P.ws + OFF_V8; const unsigned lo16 = (unsigned)li * 16u; const float* VSC = (const float*)(P.ws + OFF_VSC);
    const u32x2* W2 = (const u32x2*)(P.ws + OFF_W);
    LAS u32x2* lists = (LAS u32x2*)(lds + wid * 8192);
    LAS f32x2* tokp = (LAS f32x2*)(lds + 65536 + wid * 64);
    {
        u32x2 egv[8]; f32x2 wwv[8];
#pragma unroll
        for (int i = 0; i < 8; ++i) { const u32x2 ew = W2[(t0 + i) * 64 + lane]; egv[i].x = ew.x & 0xFFFFu; egv[i].y = ew.y & 0xFFFFu; wwv[i] = (f32x2){__uint_as_float(ew.x & 0xFFFF0000u), __uint_as_float(ew.y & 0xFFFF0000u)}; }
        float w0v[8], w1v[8];
#pragma unroll
        for (int i = 0; i < 8; ++i) { w0v[i] = wwv[i].x * VSC[egv[i].x]; w1v[i] = wwv[i].y * VSC[egv[i].y]; }
#pragma unroll
        for (int i = 0; i < 8; ++i) {
            const float mx = wave_max_fast(fmaxf(fabsf(w0v[i]), fabsf(w1v[i])));
            const float sw = fmaxf(mx * (1.0f / 127.0f), 1e-30f), inv = 1.0f / sw;
            const int q0 = (int)rintf(w0v[i] * inv), q1 = (int)rintf(w1v[i] * inv);
            *(LAS u32x4*)(lists + i * 128 + 2 * lane) = (u32x4){egv[i].x, ((unsigned)q0 & 255u) * 0x01010101u, egv[i].y, ((unsigned)q1 & 255u) * 0x01010101u};
            const int qs = wave_sum_int_fast(q0 + q1);
            if (lane == 0) tokp[i] = (f32x2){sw, 7.5f * sw * (float)qs}; }
    }
    const unsigned bsel = 0xFFu << (8u * (unsigned)(li & 3));
    const u32x4 bm = {(li >> 2) == 0 ? bsel : 0u, (li >> 2) == 1 ? bsel : 0u, (li >> 2) == 2 ? bsel : 0u, (li >> 2) == 3 ? bsel : 0u};
    const int dbase = 128 * g + 8 * (li >> 2) + (li & 3);
    float gt2v[16], lgv[16], lbv[16];
    { const float* gt2 = (const float*)(P.ws + OFF_ADA) + (t0 >> 11) * 6144 + 5120;
#pragma unroll
      for (int c = 0; c < 2; ++c)
#pragma unroll
          for (int hf = 0; hf < 2; ++hf)
#pragma unroll
              for (int r = 0; r < 4; ++r) { const int d = dbase + 512 * c + 32 * r + 4 * hf, e = 8 * c + 4 * hf + r; gt2v[e] = gt2[d]; lgv[e] = P.ln2_g[d]; lbv[e] = P.ln2_b[d]; } }
    VQuad q0, q1, q2, q3, q4, q5, q6, q7;
    q0.nxt = lists[g]; q1.nxt = lists[4 + g]; q2.nxt = lists[8 + g]; q3.nxt = lists[12 + g]; q4.nxt = lists[16 + g]; q5.nxt = lists[20 + g]; q6.nxt = lists[24 + g]; q7.nxt = lists[28 + g];
    vq_issue(q0, lists, 8, g, Vb, lo16); vq_issue(q1, lists, 9, g, Vb, lo16); vq_issue(q2, lists, 10, g, Vb, lo16); vq_issue(q3, lists, 11, g, Vb, lo16);
    vq_issue(q4, lists, 12, g, Vb, lo16); vq_issue(q5, lists, 13, g, Vb, lo16); vq_issue(q6, lists, 14, g, Vb, lo16); vq_issue(q7, lists, 15, g, Vb, lo16);
    VQ_PIN(q0);
#pragma unroll 1
    for (int i = 0; i < 8; ++i) {
        const size_t t = t0 + i;
        v4i_t acc[4];
#pragma unroll
        for (int j = 0; j < 4; ++j) acc[j] = (v4i_t){0, 0, 0, 0};
        float* xr = P.out + t * 1024;
        float xv[16];
#pragma unroll
        for (int c = 0; c < 2; ++c)
#pragma unroll
            for (int hf = 0; hf < 2; ++hf)
#pragma unroll
                for (int r = 0; r < 4; ++r) xv[8 * c + 4 * hf + r] = __uint_as_float((unsigned)((const bf16_t*)xr)[dbase + 512 * c + 32 * r + 4 * hf] << 16);
#pragma unroll 1
        for (int J = 32 * i; J < 32 * i + 32; J += 8) {
            vq_mma(q0, acc, bm); vq_issue(q0, lists, J + 16, g, Vb, lo16); VQ_PIN(q1);
            vq_mma(q1, acc, bm); vq_issue(q1, lists, J + 17, g, Vb, lo16); VQ_PIN(q2);
            vq_mma(q2, acc, bm); vq_issue(q2, lists, J + 18, g, Vb, lo16); VQ_PIN(q3);
            vq_mma(q3, acc, bm); vq_issue(q3, lists, J + 19, g, Vb, lo16); VQ_PIN(q4);
            vq_mma(q4, acc, bm); vq_issue(q4, lists, J + 20, g, Vb, lo16); VQ_PIN(q5);
            vq_mma(q5, acc, bm); vq_issue(q5, lists, J + 21, g, Vb, lo16); VQ_PIN(q6);
            vq_mma(q6, acc, bm); vq_issue(q6, lists, J + 22, g, Vb, lo16); VQ_PIN(q7);
            vq_mma(q7, acc, bm); vq_issue(q7, lists, J + 23, g, Vb, lo16); VQ_PIN(q0);
        }
        const f32x2 tp = tokp[i]; const float sw = tp.x, yoff = tp.y;
        float pre[16]; float s = 0.f;
#pragma unroll
        for (int c = 0; c < 2; ++c)
#pragma unroll
            for (int hf = 0; hf < 2; ++hf)
#pragma unroll
                for (int r = 0; r < 4; ++r) { const int e = 8 * c + 4 * hf + r;
                    const float yv = hf == 0 ? sw * (float)acc[2 * c][r] - yoff : (sw * 0.0625f) * (float)(acc[2 * c + 1][r] - acc[2 * c][r]) + yoff * (1.0f / 15.0f);
                    const float pv = ALPHA * xv[e] + gt2v[e] * yv; pre[e] = pv; s += pv; }
        const float mean = wave_sum_fast(s) * (1.0f / 1024.0f); float s2 = 0.f;
#pragma unroll
        for (int e = 0; e < 16; ++e) { pre[e] -= mean; s2 += pre[e] * pre[e]; }
        const float rstd = rsqrtf(wave_sum_fast(s2) * (1.0f / 1024.0f) + LN_EPS);
#pragma unroll
        for (int c = 0; c < 2; ++c)
#pragma unroll
            for (int hf = 0; hf < 2; ++hf)
#pragma unroll
                for (int r = 0; r < 4; ++r) { const int e = 8 * c + 4 * hf + r;
                    xr[dbase + 512 * c + 32 * r + 4 * hf] = pre[e] * rstd * lgv[e] + lbv[e]; }
    }
}

#define XB_TMO      128
#define XB_XCNT(j)  (256  + 64 * (j))
#define XB_XSUB(j)  (1280 + 64 * (j))
#define XB_XGEN(j)  (2304 + 64 * (j))
#define XB_TOP      3328
#define XB_TOPGEN   3392
#define XCD_BAR_WORDS 3456
#define XB_SPIN_CAP (1u << 22)
__device__ __forceinline__ unsigned xb_ld(unsigned* p)              { return __hip_atomic_load(p, __ATOMIC_RELAXED, __HIP_MEMORY_SCOPE_AGENT); }
__device__ __forceinline__ unsigned xb_add(unsigned* p, unsigned v) { return __hip_atomic_fetch_add(p, v, __ATOMIC_RELAXED, __HIP_MEMORY_SCOPE_AGENT); }
#define XB_SPIN(cond, bar) do { unsigned _sp = 0; while (cond) { __builtin_amdgcn_s_sleep(1); \
    if ((++_sp & 255u) == 0u) { if (xb_ld(&(bar)[XB_TMO])) break; if (_sp > XB_SPIN_CAP) { atomicAdd(&(bar)[XB_TMO], 1u); break; } } } } while (0)
struct XcdBarrier { unsigned* bar; unsigned x; volatile LAS unsigned* st; };
__device__ __forceinline__ XcdBarrier xcd_barrier_post(unsigned* bar, volatile LAS unsigned* st) {
    XcdBarrier b; b.bar = bar; b.x = xcc_id(); b.st = st;
    if (threadIdx.x == 0) (void)xb_add(&bar[XB_XCNT(b.x)], 1u);
    return b;
}
__device__ __forceinline__ void xcd_barrier_complete(unsigned* bar, unsigned x, unsigned& nloc, unsigned& nx) {
    const unsigned G = gridDim.x * gridDim.y * gridDim.z;
    unsigned sum, cnt, mine, sp = 0u;
    for (;;) {
        sum = 0u; cnt = 0u; mine = 0u;
#pragma unroll
        for (unsigned j = 0; j < 16; ++j) { const unsigned c = xb_ld(&bar[XB_XCNT(j)]); sum += c; cnt += (c > 0u) ? 1u : 0u; mine = (j == x) ? c : mine; }
        if (sum == G) break;
        __builtin_amdgcn_s_sleep(1);
        if ((++sp & 255u) == 0u) { if (xb_ld(&bar[XB_TMO])) break; if (sp > XB_SPIN_CAP) { atomicAdd(&bar[XB_TMO], 1u); break; } }
    }
    nloc = mine > 0u ? mine : 1u; nx = cnt > 0u ? cnt : 1u;
}
__device__ __forceinline__ void xcd_barrier(const XcdBarrier& b) {
    asm volatile("s_waitcnt vmcnt(0)" ::: "memory");
    __syncthreads();
    if (threadIdx.x == 0) {
        unsigned* bar = b.bar;
        __builtin_amdgcn_s_waitcnt(0);
        unsigned nloc = b.st[0], nx = b.st[1];
        if (nloc == 0u) { xcd_barrier_complete(bar, b.x, nloc, nx); b.st[0] = nloc; b.st[1] = nx; }
        const unsigned old = xb_add(&bar[XB_XSUB(b.x)], 1u);
        const unsigned gen = old / nloc;
        if (old + 1u == (gen + 1u) * nloc) {
            __builtin_amdgcn_fence(__ATOMIC_RELEASE, "agent");
            asm volatile("s_waitcnt vmcnt(0)" ::: "memory");
            const unsigned og = xb_add(&bar[XB_TOP], 1u);
            const unsigned tg = og / nx;
            if (og + 1u == (tg + 1u) * nx) xb_add(&bar[XB_TOPGEN], 1u);
            else XB_SPIN(xb_ld(&bar[XB_TOPGEN]) == tg, bar);
            __builtin_amdgcn_fence(__ATOMIC_ACQUIRE, "agent");
            xb_add(&bar[XB_XGEN(b.x)], 1u);
            asm volatile("s_waitcnt vmcnt(0)" ::: "memory");
        } else {
            XB_SPIN(xb_ld(&bar[XB_XGEN(b.x)]) == gen, bar);
            __builtin_amdgcn_fence(__ATOMIC_ACQUIRE, "agent");
            asm volatile("s_waitcnt vmcnt(0)" ::: "memory");
        }
    }
    __syncthreads();
}

__global__ void __launch_bounds__(NTHR, 2) fwd_megakernel(Params P) {
    extern __shared__ __attribute__((aligned(16))) unsigned char shm[];
    LAS unsigned char* lds = (LAS unsigned char*)shm;
    cg::grid_group grid = cg::this_grid();
    const int G = gridDim.x, bid = blockIdx.x;
    volatile LAS unsigned* xst = (volatile LAS unsigned*)(lds + LDS_BYTES - 128);
    if (threadIdx.x == 0) { xst[0] = 0u; xst[1] = 0u; }
    __syncthreads();
    const XcdBarrier xb = xcd_barrier_post((unsigned*)(P.ws + OFF_BAR), xst);

#ifndef P3
#define P3 0xff
#endif
#ifndef PH
#define PH 0xff
#endif
    if (PH & 1) phase0a(P, lds);
    grid.sync();
    if (PH & 2) phase0b(P);
    xcd_barrier(xb);
    if (PH & 4) {
        pg8::Gemm g; g.A = (const bf16_t*)(P.ws + OFF_H); g.Bt = (const bf16_t*)(P.ws + OFF_WIN); g.M = NTOK; g.N = INCOLS; { int k_ = 512; asm volatile("" : "+s"(k_)); g.K = k_; g.lda = k_; }
        pg8::StaticOrder S; S.init(NTOK, INCOLS, G, bid);
        EpiProj E; E.ws = P.ws; E.lb = (const float*)(P.ws + OFF_LB); E.ng = P.hgrn_ng; E.kmean = (float*)(P.ws + OFF_KMEAN);
        pg8::gemm_phase<EpiProj, pg8::StaticOrder, true>(lds, g, S, E);
    }
    xcd_barrier(xb);
    if (PH & 8) for (int it = bid; it < 256; it += G) hgrn_item(P, it, lds);
    if (PH & 16) for (int u = bid; u < 2048; u += G) { const int bh = u & 255, jj = u >> 8; moba_unit(P, bh >> 3, bh & 7, (jj + bh) & 7, lds); }
    xcd_barrier(xb);
    if ((PH & 32) && bid < NTOK / 256) { const int pm = bid;
        if (P3 & 1) yb_norm_panel(P, pm);
        __syncthreads();
        if (P3 & 2) { pg8::Gemm g; g.A = (const bf16_t*)(P.ws + OFF_EG); g.Bt = (const bf16_t*)(P.ws + OFF_WBA); g.M = NTOK; g.N = 1024; { int k_ = 256; asm volatile("" : "+s"(k_)); g.K = k_; } g.lda = 512;
          pg8::PanelOrder S; S.pm = pm; S.npn = 4; EpiMixA E; E.GA = P.ws + OFF_GA;
          pg8::gemm_phase<EpiMixA, pg8::PanelOrder, true>(lds, g, S, E); }
        __syncthreads();
        if (P3 & 4) { pg8::Gemm g; g.A = (const bf16_t*)(P.ws + OFF_EG + 512); g.Bt = (const bf16_t*)(P.ws + OFF_WBB); g.M = NTOK; g.N = 1024; { int k_ = 256; asm volatile("" : "+s"(k_)); g.K = k_; } g.lda = 512;
          pg8::PanelOrder S; S.pm = pm; S.npn = 4; EpiMixB E; E.GA = P.ws + OFF_GA; E.GB = P.ws + OFF_GB; E.M8 = P.ws + OFF_QA;
          pg8::gemm_phase<EpiMixB, pg8::PanelOrder, true>(lds, g, S, E); }
        __syncthreads();
        if (P3 & 8) { pg8::Gemm g; g.A = (const bf16_t*)(P.ws + OFF_QA); g.Bt = (const bf16_t*)(P.ws + OFF_WOUT); g.M = NTOK; g.N = 1024; { int k_ = 512; asm volatile("" : "+s"(k_)); g.K = k_; g.lda = k_; }
          pg8::PanelOrder S; S.pm = pm; S.npn = 4; EpiOut E; E.ada = (const float*)(P.ws + OFF_ADA); E.D = (bf16_t*)(P.ws + OFF_GB);
          pg8::gemm_phase<EpiOut, pg8::PanelOrder, true>(lds, g, S, E); }
        __syncthreads();
        if (P3 & 16) ln1_panel(P, pm);
        __syncthreads();
        if (P3 & 32) { pg8::Gemm g; g.A = (const bf16_t*)(P.ws + OFF_H); g.Bt = (const bf16_t*)(P.ws + OFF_WQ); g.M = NTOK; g.N = 1024; g.K = 1024; g.lda = 1024;
          pg8::PanelOrder S; S.pm = pm; S.npn = 4; EpiBf16 E; E.O = (bf16_t*)(P.ws + OFF_GB);
          pg8::gemm_phase<EpiBf16, pg8::PanelOrder>(lds, g, S, E); }
        __syncthreads();
        { const size_t tok0 = (size_t)pm * 256 + (tid_opaque() >> 6) * 32;
          peer_select_wave(P, tok0);
          __syncthreads();
#pragma unroll 1
          for (int sb = 0; sb < 4; ++sb) {
              peer_u_tokens(P, lds, tok0 + 8 * sb);
              __syncthreads();
              peer_v_tokens(P, lds, tok0 + 8 * sb);
              __syncthreads();
          } }
    }
}

extern "C" void kernel_launch(void* const* d_in, const int* in_sizes, int n_in, void* d_out, int out_size, void* d_ws, size_t ws_size, hipStream_t stream) {
    static int grid_blocks = 0;
    if (grid_blocks == 0) {
        if (n_in != 18 || out_size != NTOK * DM || ws_size < WS_END) { fprintf(stderr, "kernel_launch: unexpected shapes (n_in %d, out %d, ws %zu, need %zu)\n", n_in, out_size, ws_size, (size_t)WS_END); grid_blocks = -1; return; }
        int dev = 0, cus = 0, per_cu = 0;
        hipGetDevice(&dev);
        hipDeviceGetAttribute(&cus, hipDeviceAttributeMultiprocessorCount, dev);
        if (hipFuncSetAttribute((const void*)fwd_megakernel, hipFuncAttributeMaxDynamicSharedMemorySize, LDS_BYTES) != hipSuccess) fprintf(stderr, "kernel_launch: hipFuncSetAttribute failed\n");
        hipOccupancyMaxActiveBlocksPerMultiprocessor(&per_cu, (const void*)fwd_megakernel, NTHR, LDS_BYTES);
        if (per_cu < 1) { fprintf(stderr, "kernel_launch: occupancy query says %d blocks per CU\n", per_cu); per_cu = 1; }
        if (per_cu > 1) per_cu = 1;
        grid_blocks = cus * per_cu;
        if (grid_blocks != NTOK / 256) { fprintf(stderr, "kernel_launch: built for a %d-CU device (one 256-token panel per workgroup), found %d\n", NTOK / 256, grid_blocks); grid_blocks = -1; return; }
        (void)hipGetLastError();
    }
    if (grid_blocks < 0) return;
    Params p{};
    p.x = (const float*)d_in[0]; p.c = (const float*)d_in[1]; p.w_ada = (const float*)d_in[2]; p.b_ada = (const float*)d_in[3]; p.w_in = (const float*)d_in[4];
    p.w_ba = (const float*)d_in[5]; p.w_bb = (const float*)d_in[6]; p.w_out = (const float*)d_in[7]; p.hgrn_lb = (const float*)d_in[8]; p.hgrn_ng = (const float*)d_in[9];
    p.ln1_g = (const float*)d_in[10]; p.ln1_b = (const float*)d_in[11]; p.peer_wq = (const float*)d_in[12]; p.peer_sk = (const float*)d_in[13]; p.peer_u = (const float*)d_in[14];
    p.peer_v = (const float*)d_in[15]; p.ln2_g = (const float*)d_in[16]; p.ln2_b = (const float*)d_in[17];
    p.out = (float*)d_out; p.ws = (unsigned char*)d_ws;
    if (hipMemsetAsync((char*)d_ws + OFF_BAR, 0, XCD_BAR_WORDS * 4, stream) != hipSuccess) fprintf(stderr, "kernel_launch: memset of the barrier words failed\n");
    void* args[] = {&p};
    hipError_t e = hipLaunchCooperativeKernel((const void*)fwd_megakernel, dim3(grid_blocks), dim3(NTHR), args, LDS_BYTES, stream);
    if (e != hipSuccess) fprintf(stderr, "cooperative launch failed: %s (grid %d)\n", hipGetErrorString(e), grid_blocks);
}
```

```cpp
#include <hip/hip_runtime.h>
#include <hip/hip_cooperative_groups.h>
#include <cstdio>
#include <cstdint>
#include <type_traits>
namespace cg = cooperative_groups;

#define LAS __attribute__((address_space(3)))
typedef unsigned short bf16_t;
typedef short bf16x8 __attribute__((ext_vector_type(8)));
typedef short s16x4 __attribute__((ext_vector_type(4)));
typedef float f32x2 __attribute__((ext_vector_type(2)));
typedef float f32x4 __attribute__((ext_vector_type(4)));
typedef float f32x16 __attribute__((ext_vector_type(16)));
typedef unsigned u32x2 __attribute__((ext_vector_type(2)));
typedef unsigned u32x4 __attribute__((ext_vector_type(4)));

constexpr int NB = 32, SEQ = 2048, DM = 1024, NTOK = NB * SEQ;
constexpr int INCOLS = 5632;
constexpr int NTHR = 512;
constexpr int LDS_BYTES = 147456;
constexpr float ALPHA = 1.189207115002721f;
constexpr float LN_EPS = 1e-5f, RMS_EPS = 1e-6f;
constexpr float LOG2E = 1.4426950408889634f;

constexpr size_t SZ_T512 = (size_t)NTOK * 512 * 2, SZ_T1024 = (size_t)NTOK * 1024 * 2;
constexpr size_t OFF_ADA = 0;
constexpr size_t OFF_LB = OFF_ADA + 786432;
constexpr size_t OFF_KMEAN = OFF_LB + 4096;
constexpr size_t OFF_WIN = OFF_KMEAN + 524288;
constexpr size_t OFF_WBA = OFF_WIN + (size_t)5632 * 1024 * 2;
constexpr size_t OFF_WBB = OFF_WBA + 1048576;
constexpr size_t OFF_WOUT = OFF_WBB + 1048576;
constexpr size_t OFF_WQ = OFF_WOUT + 2097152;
constexpr size_t OFF_SK = OFF_WQ + 2097152;
constexpr size_t OFF_U8 = OFF_SK + 262144;
constexpr size_t OFF_USC = OFF_U8 + 8388608;
constexpr size_t OFF_V8 = OFF_U8 + 16777216;
constexpr size_t OFF_VSC = OFF_V8 + 8388608;
constexpr size_t OFF_CTR = OFF_V8 + 16777216;
constexpr size_t OFF_BAR = OFF_CTR + 4096;
constexpr size_t OFF_EG = OFF_BAR + 16384;
constexpr size_t OFF_H = OFF_EG + (size_t)NTOK * 128 * 8;
constexpr size_t OFF_QA = OFF_H + SZ_T1024;
constexpr size_t OFF_KA = OFF_QA + SZ_T512;
constexpr size_t OFF_VA = OFF_KA + SZ_T512;
constexpr size_t OFF_HQ = OFF_VA + SZ_T512;
constexpr size_t OFF_HK = OFF_HQ + SZ_T512;
constexpr size_t OFF_HI = OFF_HK + SZ_T512;
constexpr size_t OFF_HG = OFF_HI + SZ_T512;
constexpr size_t OFF_GA = OFF_HG + SZ_T512;
constexpr size_t OFF_GB = OFF_GA + SZ_T1024;
constexpr size_t WS_END = OFF_GB + SZ_T1024;
constexpr size_t OFF_H8 = OFF_VA;
constexpr size_t OFF_HS = OFF_HQ;
constexpr size_t OFF_W = OFF_KA;
constexpr size_t OFF_Y = OFF_KA;

struct Params {
    const float *x, *c, *w_ada, *b_ada, *w_in, *w_ba, *w_bb, *w_out, *hgrn_lb, *hgrn_ng, *ln1_g, *ln1_b, *peer_wq, *peer_sk, *peer_u, *peer_v, *ln2_g, *ln2_b;
    float* out;
    unsigned char* ws;
};

typedef __bf16 bf16v2 __attribute__((ext_vector_type(2)));
__device__ __forceinline__ unsigned cvt_pk_bf16(float lo, float hi) { return __builtin_bit_cast(unsigned, __builtin_convertvector((f32x2){lo, hi}, bf16v2)); }
__device__ __forceinline__ float bf_lo(unsigned w) { return __uint_as_float(w << 16); }
__device__ __forceinline__ float bf_hi(unsigned w) { return __uint_as_float(w & 0xffff0000u); }
__device__ __forceinline__ float sigmoidf_(float x) { return __builtin_amdgcn_rcpf(1.0f + __builtin_amdgcn_exp2f(-LOG2E * x)); }
__device__ __forceinline__ float wave_sum(float v) {
#pragma unroll
    for (int o = 1; o < 64; o <<= 1) v += __shfl_xor(v, o);
    return v;
}
template <int CTRL> __device__ __forceinline__ float dpp_add(float x) { const int v = __builtin_amdgcn_update_dpp(0, __float_as_int(x), CTRL, 0xf, 0xf, true); return x + __int_as_float(v); }
__device__ __forceinline__ float wave_sum_fast(float x) {
    x = dpp_add<0xB1>(x); x = dpp_add<0x4E>(x); x = dpp_add<0x141>(x); x = dpp_add<0x140>(x);
    x += __shfl_xor(x, 16); x += __shfl_xor(x, 32); return x;
}
template <int CTRL> __device__ __forceinline__ float dpp_max(float x) { const int v = __builtin_amdgcn_update_dpp(0, __float_as_int(x), CTRL, 0xf, 0xf, true); return fmaxf(x, __int_as_float(v)); }
template <int CTRL> __device__ __forceinline__ int dpp_addi(int x) { return x + __builtin_amdgcn_update_dpp(0, x, CTRL, 0xf, 0xf, true); }
__device__ __forceinline__ float wave_max_fast(float x) {
    x = dpp_max<0xB1>(x); x = dpp_max<0x4E>(x); x = dpp_max<0x141>(x); x = dpp_max<0x140>(x);
    x = fmaxf(x, __shfl_xor(x, 16)); x = fmaxf(x, __shfl_xor(x, 32)); return x;
}
__device__ __forceinline__ int wave_sum_int_fast(int x) {
    x = dpp_addi<0xB1>(x); x = dpp_addi<0x4E>(x); x = dpp_addi<0x141>(x); x = dpp_addi<0x140>(x);
    x += __shfl_xor(x, 16); x += __shfl_xor(x, 32); return x;
}
__device__ __forceinline__ int tid_opaque() { int t = threadIdx.x; asm volatile("" : "+v"(t)); return t; }
__device__ __forceinline__ int crow(int r, int hi) { return (r & 3) + 8 * (r >> 2) + 4 * hi; }
#define MFMA32(a, b, c) __builtin_amdgcn_mfma_f32_32x32x16_bf16(a, b, c, 0, 0, 0)

namespace pg8 {
constexpr int BM = 256, BK = 64, HALF = 128, HTB = HALF * BK * 2, STAGE_BYTES = 8 * HTB, NXCD = 8, WGM = 8;
__host__ __device__ __forceinline__ int lds_byte(int r, int c) { const int st = (r >> 4) * 2 + (c >> 5), rr = r & 15, cc = c & 31, ob = rr * 64 + cc * 2; return st * 1024 + (ob ^ (((ob >> 9) & 1) << 5)); }
__host__ __device__ __forceinline__ void stage_rc(int b, int& R, int& C) { const int st = b / 1024, sb = b % 1024, swz = sb ^ (((sb >> 9) & 1) << 5); R = (st >> 1) * 16 + swz / 64; C = (st & 1) * 32 + (swz % 64) / 2; }
__host__ __device__ __forceinline__ int perm32(int rho) { const int n = rho >> 4, i = rho & 15; return 8 * (i >> 2) + 4 * n + (i & 3); }

struct Unit { int pm, pn; };
struct Gemm { const bf16_t* A; const bf16_t* Bt; int M, N, K, lda; };

struct StaticOrder {
    int nM, nN, nwg, G, c;
    __device__ void init(int M, int N, int G_, int c_) { nM = M / BM; nN = N / BM; nwg = nM * nN; G = G_; c = c_; }
    __device__ bool next(int i, Unit& u) const {
        const long L = (long)i * G + c; if (L >= nwg) return false;
        int wgid = (int)L; { const int q = nwg / NXCD, r = nwg % NXCD, xcd = wgid % NXCD, off = wgid / NXCD; wgid = (xcd < r ? xcd * (q + 1) : r * (q + 1) + (xcd - r) * q) + off; }
        const int nig = WGM * nN, gid = wgid / nig, fm = gid * WGM, gsz = (nM - fm) < WGM ? (nM - fm) : WGM;
        u.pm = fm + ((wgid % nig) % gsz); u.pn = (wgid % nig) / gsz; return true;
    }
};
struct PanelOrder {
    int pm, npn;
    __device__ bool next(int i, Unit& u) const { if (i >= npn) return false; u.pm = pm; u.pn = i; return true; }
};

template <class Epi, class Sched, bool MX = false>
__device__ __forceinline__ void gemm_phase(LAS unsigned char* lds, const Gemm g, const Sched& S, const Epi& E) {
    const int tid = tid_opaque(), wid = __builtin_amdgcn_readfirstlane(tid >> 6), lane = tid & 63, wr = wid >> 2, wc = wid & 3, fr = lane & 15, fq = lane >> 4;
    const int K = g.K, nt = K / BK;
    unsigned voffA, voffB;
    { int R, C; stage_rc(tid * 16, R, C); const int Rb = Epi::PERM ? ((R & ~31) + perm32(R & 31)) : R;
      voffA = (unsigned)(R * g.lda + C) * 2u; voffB = (unsigned)(Rb * K + C) * 2u; }
    const size_t rvoffA = (size_t)128 * g.lda, rvoffB = (size_t)128 * K;
    const size_t kstep = (size_t)(BK * 2);
    const size_t hstep = (size_t)HALF * K * 2;
    const size_t tstep = 2 * hstep;
    const size_t hstepA = (size_t)HALF * g.lda * 2, tstepA = 2 * hstepA;
    const unsigned ldsw = (unsigned)wid * 1024u;
    const int aoff = lds_byte(wr * 64 + fr, fq * 8), boff = lds_byte(wc * 32 + fr, fq * 8);
#define PG8_SA(b, h) (((b) * 2 + (h)) * HTB)
#define PG8_SB(b, h) ((4 + (b) * 2 + (h)) * HTB)
#define PG8_STAGE(bufoff, gbase, voff) do { unsigned vo_ = (voff); asm volatile("" : "+v"(vo_));     \
        _Pragma("unroll") for (int _i = 0; _i < 2; ++_i) \
        __builtin_amdgcn_global_load_lds((const unsigned*)((const char*)(gbase) + _i * r##voff + vo_), (LAS unsigned*)(lds + (bufoff) + ldsw + _i * 8192), 16, 0, 0); } while (0)
#define PG8_LDX(dst, off) do { const v4i_ lo_ = *(const LAS v4i_*)(lds + (off)), hi_ = *(const LAS v4i_*)(lds + (off) + 1024); dst = __builtin_shufflevector(lo_, hi_, 0, 1, 2, 3, 4, 5, 6, 7); } while (0)
#define PG8_LDA(dst, b, h) do { if constexpr (MX) { _Pragma("unroll") for (int m = 0; m < 4; ++m) PG8_LDX(dst##X[m], PG8_SA(b, h) + aoff + m * 2048); } \
        else { _Pragma("unroll") for (int m = 0; m < 4; ++m) _Pragma("unroll") for (int k = 0; k < 2; ++k) dst[m][k] = *(const LAS bf16x8*)(lds + PG8_SA(b, h) + aoff + m * 2048 + k * 1024); } } while (0)
#define PG8_LDB(dst, b, h) do { if constexpr (MX) { _Pragma("unroll") for (int n = 0; n < 2; ++n) PG8_LDX(dst##X[n], PG8_SB(b, h) + boff + n * 2048); } \
        else { _Pragma("unroll") for (int n = 0; n < 2; ++n) _Pragma("unroll") for (int k = 0; k < 2; ++k) dst[n][k] = *(const LAS bf16x8*)(lds + PG8_SB(b, h) + boff + n * 2048 + k * 1024); } } while (0)
#define PG8_MMA(ai, bj, At, Bt) do { __builtin_amdgcn_s_setprio(1); \
        if constexpr (MX) { _Pragma("unroll") for (int m = 0; m < 4; ++m) _Pragma("unroll") for (int n = 0; n < 2; ++n) \
            asm volatile("v_mfma_scale_f32_16x16x128_f8f6f4 %0, %1, %2, %0, %3, %4 op_sel_hi:[0,0,0]" : "+v"(acc[ai][bj][m][n]) : "v"(Bt##X[n]), "v"(At##X[m]), "v"(mxscale), "v"(mxscale5)); } \
        else { _Pragma("unroll") for (int m = 0; m < 4; ++m) _Pragma("unroll") for (int n = 0; n < 2; ++n) _Pragma("unroll") for (int k = 0; k < 2; ++k) \
            acc[ai][bj][m][n] = __builtin_amdgcn_mfma_f32_16x16x32_bf16(Bt[n][k], At[m][k], acc[ai][bj][m][n], 0, 0, 0); } \
        __builtin_amdgcn_s_setprio(0); } while (0)
#define PG8_WAIT_V(n) asm volatile("s_waitcnt vmcnt(" #n ")" ::: "memory")
#define PG8_WAIT_L(n) asm volatile("s_waitcnt lgkmcnt(" #n ")" ::: "memory")
#define PG8_BAR __builtin_amdgcn_s_barrier()
#define PG8_SCHED __builtin_amdgcn_sched_barrier(0)
    Unit cur, nxt; int ui = 0;
    if (!S.next(0, cur)) return;
    f32x4 acc[2][2][4][2];
#pragma unroll
    for (int a = 0; a < 2; ++a)
#pragma unroll
        for (int b = 0; b < 2; ++b)
#pragma unroll
            for (int m = 0; m < 4; ++m)
#pragma unroll
                for (int n = 0; n < 2; ++n) acc[a][b][m][n] = (f32x4){0.f, 0.f, 0.f, 0.f};
    typedef int v4i_ __attribute__((ext_vector_type(4))); typedef int v8i_ __attribute__((ext_vector_type(8)));
    bf16x8 At[4][2], B0[2][2], B1[2][2];
    v8i_ AtX[4], B0X[2], B1X[2];
    const int mxscale = 0x7f7f7f7f, mxscale5 = 0x7a7a7a7a;
    const char* cA = (const char*)g.A + (size_t)cur.pm * tstepA; const char* cB = (const char*)g.Bt + (size_t)cur.pn * tstep;
    PG8_STAGE(PG8_SB(0, 0), cB, voffB); PG8_STAGE(PG8_SA(0, 0), cA, voffA); PG8_STAGE(PG8_SB(0, 1), cB + hstep, voffB); PG8_STAGE(PG8_SA(0, 1), cA + hstepA, voffA);
    if (wr == 1) PG8_BAR;
    PG8_WAIT_V(4); PG8_BAR;
    PG8_STAGE(PG8_SB(1, 0), cB + kstep, voffB); PG8_STAGE(PG8_SA(1, 0), cA + kstep, voffA); PG8_STAGE(PG8_SB(1, 1), cB + hstep + kstep, voffB);
    PG8_WAIT_V(6); PG8_BAR;
    for (;;) {
        const bool has_next = S.next(ui + 1, nxt);
        const char* nA = has_next ? (const char*)g.A + (size_t)nxt.pm * tstepA : cA; const char* nB = has_next ? (const char*)g.Bt + (size_t)nxt.pn * tstep : cB;
        for (int t = 0; t < nt; t += 2) {
            const bool last = (t == nt - 2);
            const char* a1 = cA + (size_t)(t + 1) * kstep;
            const char* a2 = last ? nA : cA + (size_t)(t + 2) * kstep; const char* b2 = last ? nB : cB + (size_t)(t + 2) * kstep;
            const char* a3 = a2 + kstep; const char* b3 = b2 + kstep;
            PG8_LDB(B0, 0, 0); PG8_SCHED; PG8_LDA(At, 0, 0); PG8_STAGE(PG8_SA(1, 1), a1 + hstepA, voffA);
            PG8_WAIT_L(8); PG8_BAR; PG8_WAIT_L(0); PG8_MMA(0, 0, At, B0); PG8_BAR; PG8_SCHED;
            PG8_LDB(B1, 0, 1); PG8_STAGE(PG8_SB(0, 0), b2, voffB);
            PG8_BAR; PG8_WAIT_L(0); PG8_MMA(0, 1, At, B1); PG8_BAR;
            PG8_LDA(At, 0, 1); PG8_STAGE(PG8_SA(0, 0), a2, voffA);
            PG8_BAR; PG8_WAIT_L(0); PG8_MMA(1, 0, At, B0); PG8_BAR; PG8_SCHED;
            PG8_STAGE(PG8_SB(0, 1), b2 + hstep, voffB);
            PG8_WAIT_V(6); PG8_BAR; PG8_MMA(1, 1, At, B1); PG8_BAR;
            PG8_LDB(B0, 1, 0); PG8_SCHED; PG8_LDA(At, 1, 0); PG8_STAGE(PG8_SA(0, 1), a2 + hstepA, voffA);
            PG8_WAIT_L(8); PG8_BAR; PG8_WAIT_L(0); PG8_MMA(0, 0, At, B0); PG8_BAR; PG8_SCHED;
            PG8_LDB(B1, 1, 1); PG8_STAGE(PG8_SB(1, 0), b3, voffB);
            PG8_BAR; PG8_WAIT_L(0); PG8_MMA(0, 1, At, B1); PG8_BAR;
            PG8_LDA(At, 1, 1); PG8_STAGE(PG8_SA(1, 0), a3, voffA);
            PG8_BAR; PG8_WAIT_L(0); PG8_MMA(1, 0, At, B0); PG8_BAR; PG8_SCHED;
            PG8_STAGE(PG8_SB(1, 1), b3 + hstep, voffB);
            PG8_WAIT_V(6); PG8_BAR; PG8_MMA(1, 1, At, B1); PG8_BAR;
        }
        if constexpr (MX) asm volatile("s_nop 15\n\ts_nop 15" ::: "memory");
        if (wr == 0) PG8_BAR;
        E(acc, cur, wr, wc, fr, fq);
        if (wr == 1) PG8_BAR;
        if (!has_next) break;
#pragma unroll
        for (int a = 0; a < 2; ++a)
#pragma unroll
            for (int b = 0; b < 2; ++b)
#pragma unroll
                for (int m = 0; m < 4; ++m)
#pragma unroll
                    for (int n = 0; n < 2; ++n) acc[a][b][m][n] = (f32x4){0.f, 0.f, 0.f, 0.f};
        cur = nxt; cA = nA; cB = nB; ++ui;
    }
    PG8_WAIT_V(0);
    if (wr == 0) PG8_BAR;
    PG8_BAR;
#undef PG8_SA
#undef PG8_SB
#undef PG8_STAGE
#undef PG8_LDX
#undef PG8_LDA
#undef PG8_LDB
#undef PG8_MMA
#undef PG8_WAIT_V
#undef PG8_WAIT_L
#undef PG8_BAR
#undef PG8_SCHED
}
}
using pg8::Unit;

struct EpiProj {
    static constexpr bool PERM = true;
    unsigned char* ws; const float* lb; const float* ng; float* kmean;
    __device__ __forceinline__ void operator()(const f32x4 (&acc)[2][2][4][2], const Unit& u, int wr, int wc, int fr, int fq) const {
        const int pn = u.pn; int seg, colt, ldc; size_t boff;
        if (pn < 14) { seg = pn >> 1; colt = (pn & 1) * 256; ldc = 512; boff = OFF_QA + (size_t)seg * SZ_T512; }
        else if (pn < 18) { seg = 7; colt = (pn - 14) * 256; ldc = 1024; boff = OFF_GA; }
        else { seg = 8; colt = (pn - 18) * 256; ldc = 1024; boff = OFF_GB; }
        bf16_t* base = (bf16_t*)(ws + boff);
        const int row0 = u.pm * 256 + wr * 64 + fr, col0 = colt + wc * 32 + 8 * fq;
        float pv[2][8];
#pragma unroll
        for (int bj = 0; bj < 2; ++bj)
#pragma unroll
            for (int e = 0; e < 8; ++e) pv[bj][e] = (seg == 4) ? (1.0f - lb[col0 + bj * 128 + e]) : ((seg == 6) ? ng[col0 + bj * 128 + e] : 0.f);
        float cs[2][8];
#pragma unroll
        for (int bj = 0; bj < 2; ++bj)
#pragma unroll
            for (int e = 0; e < 8; ++e) cs[bj][e] = 0.f;
#pragma unroll
        for (int ai = 0; ai < 2; ++ai)
#pragma unroll
            for (int m = 0; m < 4; ++m) {
                bf16_t* rowp = base + (size_t)(row0 + ai * 128 + m * 16) * ldc + col0;
#pragma unroll
                for (int bj = 0; bj < 2; ++bj) {
                    float v[8];
#pragma unroll
                    for (int e = 0; e < 4; ++e) { v[e] = acc[ai][bj][m][0][e]; v[4 + e] = acc[ai][bj][m][1][e]; }
                    if (seg == 0) {
#pragma unroll
                        for (int e = 0; e < 8; ++e) v[e] *= (0.125f * LOG2E);
                    } else if (seg == 1) {
#pragma unroll
                        for (int e = 0; e < 8; ++e) cs[bj][e] += v[e];
                    } else if (seg == 3) {
#pragma unroll
                        for (int e = 0; e < 8; ++e) v[e] = v[e] * sigmoidf_(v[e]);
                    } else if (seg == 4) {
#pragma unroll
                        for (int e = 0; e < 8; ++e) v[e] = pv[bj][e] * sigmoidf_(-v[e]);
                    } else if (seg == 6) {
#pragma unroll
                        for (int e = 0; e < 8; ++e) v[e] = pv[bj][e] * v[e] * sigmoidf_(v[e]);
                    } else if (seg >= 7) {
#pragma unroll
                        for (int e = 0; e < 8; ++e) v[e] = sigmoidf_(v[e]);
                    }
                    if (seg >= 7) {
                        int w0 = __builtin_amdgcn_cvt_pk_fp8_f32(v[0], v[1], 0, false); w0 = __builtin_amdgcn_cvt_pk_fp8_f32(v[2], v[3], w0, true);
                        int w1 = __builtin_amdgcn_cvt_pk_fp8_f32(v[4], v[5], 0, false); w1 = __builtin_amdgcn_cvt_pk_fp8_f32(v[6], v[7], w1, true);
                        *(u32x2*)((unsigned char*)rowp - col0 + bj * 128) = (u32x2){(unsigned)w0, (unsigned)w1};
                    } else {
                    u32x4 w; w.x = cvt_pk_bf16(v[0], v[1]); w.y = cvt_pk_bf16(v[2], v[3]); w.z = cvt_pk_bf16(v[4], v[5]); w.w = cvt_pk_bf16(v[6], v[7]);
                    *(u32x4*)(rowp + bj * 128) = w; }
                }
            }
        if (seg == 1) {
#pragma unroll
            for (int bj = 0; bj < 2; ++bj)
#pragma unroll
                for (int e = 0; e < 8; ++e) {
                    float s = cs[bj][e];
                    s += __shfl_xor(s, 1); s += __shfl_xor(s, 2); s += __shfl_xor(s, 4); s += __shfl_xor(s, 8);
                    if (fr == 0) atomicAdd(kmean + (size_t)u.pm * 512 + col0 + bj * 128 + e, s);
                }
        }
    }
};
__device__ __forceinline__ void fp8x8_to_f32(const u32x2 w, float (&f)[8]) {
    const f32x2 a = __builtin_amdgcn_cvt_pk_f32_fp8((int)w.x, false), b = __builtin_amdgcn_cvt_pk_f32_fp8((int)w.x, true), c = __builtin_amdgcn_cvt_pk_f32_fp8((int)w.y, false), d = __builtin_amdgcn_cvt_pk_f32_fp8((int)w.y, true);
    f[0] = a.x; f[1] = a.y; f[2] = b.x; f[3] = b.y; f[4] = c.x; f[5] = c.y; f[6] = d.x; f[7] = d.y;
}
struct EpiMixA {
    static constexpr bool PERM = true;
    unsigned char* GA;
    __device__ __forceinline__ void operator()(const f32x4 (&acc)[2][2][4][2], const Unit& u, int wr, int wc, int fr, int fq) const {
        asm volatile("" : "+v"(fr), "+v"(fq));
        const int row0 = u.pm * 256 + wr * 64 + fr, col0 = u.pn * 256 + wc * 32 + 8 * fq;
#pragma unroll
        for (int ai = 0; ai < 2; ++ai)
#pragma unroll
            for (int m = 0; m < 4; ++m) {
                unsigned char* rowp = GA + (size_t)(row0 + ai * 128 + m * 16) * 2048 + col0;
#pragma unroll
                for (int bj = 0; bj < 2; ++bj) {
                    float g[8]; fp8x8_to_f32(*(const u32x2*)(rowp + bj * 128), g);
                    const f32x4 a0 = acc[ai][bj][m][0], a1 = acc[ai][bj][m][1];
                    int w0 = __builtin_amdgcn_cvt_pk_fp8_f32(g[0] * a0[0], g[1] * a0[1], 0, false); w0 = __builtin_amdgcn_cvt_pk_fp8_f32(g[2] * a0[2], g[3] * a0[3], w0, true);
                    int w1 = __builtin_amdgcn_cvt_pk_fp8_f32(g[4] * a1[0], g[5] * a1[1], 0, false); w1 = __builtin_amdgcn_cvt_pk_fp8_f32(g[6] * a1[2], g[7] * a1[3], w1, true);
                    *(u32x2*)(rowp + bj * 128) = (u32x2){(unsigned)w0, (unsigned)w1};
                }
            }
    }
};
struct EpiMixB {
    static constexpr bool PERM = true;
    const unsigned char* GA; const unsigned char* GB; unsigned char* M8;
    __device__ __forceinline__ void operator()(const f32x4 (&acc)[2][2][4][2], const Unit& u, int wr, int wc, int fr, int fq) const {
        asm volatile("" : "+v"(fr), "+v"(fq));
        const int row0 = u.pm * 256 + wr * 64 + fr, col0 = u.pn * 256 + wc * 32 + 8 * fq;
#pragma unroll
        for (int ai = 0; ai < 2; ++ai)
#pragma unroll
            for (int m = 0; m < 4; ++m) {
                const size_t row = (size_t)(row0 + ai * 128 + m * 16);
#pragma unroll
                for (int bj = 0; bj < 2; ++bj) {
                    float g[8], pa[8]; fp8x8_to_f32(*(const u32x2*)(GB + row * 2048 + col0 + bj * 128), g); fp8x8_to_f32(*(const u32x2*)(GA + row * 2048 + col0 + bj * 128), pa);
                    const f32x4 a0 = acc[ai][bj][m][0], a1 = acc[ai][bj][m][1];
                    int w0 = __builtin_amdgcn_cvt_pk_fp8_f32(pa[0] + g[0] * a0[0], pa[1] + g[1] * a0[1], 0, false); w0 = __builtin_amdgcn_cvt_pk_fp8_f32(pa[2] + g[2] * a0[2], pa[3] + g[3] * a0[3], w0, true);
                    int w1 = __builtin_amdgcn_cvt_pk_fp8_f32(pa[4] + g[4] * a1[0], pa[5] + g[5] * a1[1], 0, false); w1 = __builtin_amdgcn_cvt_pk_fp8_f32(pa[6] + g[6] * a1[2], pa[7] + g[7] * a1[3], w1, true);
                    *(u32x2*)(M8 + row * 1024 + col0 + bj * 128) = (u32x2){(unsigned)w0, (unsigned)w1};
                }
            }
    }
};
struct EpiOut {
    static constexpr bool PERM = true;
    const float* ada; bf16_t* D;
    __device__ __forceinline__ void operator()(const f32x4 (&acc)[2][2][4][2], const Unit& u, int wr, int wc, int fr, int fq) const {
        const int row0 = u.pm * 256 + wr * 64 + fr, col0 = u.pn * 256 + wc * 32 + 8 * fq;
        const float* gt1 = ada + (size_t)(u.pm >> 3) * 6144 + 2048 + col0;
        f32x4 g[2][2];
#pragma unroll
        for (int bj = 0; bj < 2; ++bj) { g[bj][0] = *(const f32x4*)(gt1 + bj * 128); g[bj][1] = *(const f32x4*)(gt1 + bj * 128 + 4); }
#pragma unroll
        for (int ai = 0; ai < 2; ++ai)
#pragma unroll
            for (int m = 0; m < 4; ++m) {
                bf16_t* rowp = D + (size_t)(row0 + ai * 128 + m * 16) * 1024 + col0;
#pragma unroll
                for (int bj = 0; bj < 2; ++bj) {
                    const f32x4 a0 = acc[ai][bj][m][0] * g[bj][0], a1 = acc[ai][bj][m][1] * g[bj][1];
                    int w0 = __builtin_amdgcn_cvt_pk_fp8_f32(a0[0], a0[1], 0, false); w0 = __builtin_amdgcn_cvt_pk_fp8_f32(a0[2], a0[3], w0, true);
                    int w1 = __builtin_amdgcn_cvt_pk_fp8_f32(a1[0], a1[1], 0, false); w1 = __builtin_amdgcn_cvt_pk_fp8_f32(a1[2], a1[3], w1, true);
                    *(u32x2*)((unsigned char*)rowp - col0 + bj * 128) = (u32x2){(unsigned)w0, (unsigned)w1};
                }
            }
    }
};
struct EpiBf16 {
    static constexpr bool PERM = true;
    bf16_t* O;
    __device__ __forceinline__ void operator()(const f32x4 (&acc)[2][2][4][2], const Unit& u, int wr, int wc, int fr, int fq) const {
        const int row0 = u.pm * 256 + wr * 64 + fr, col0 = u.pn * 256 + wc * 32 + 8 * fq;
#pragma unroll
        for (int ai = 0; ai < 2; ++ai)
#pragma unroll
            for (int m = 0; m < 4; ++m) {
                bf16_t* rowp = O + (size_t)(row0 + ai * 128 + m * 16) * 1024 + col0;
#pragma unroll
                for (int bj = 0; bj < 2; ++bj) {
                    const f32x4 a0 = acc[ai][bj][m][0], a1 = acc[ai][bj][m][1];
                    u32x4 w; w.x = cvt_pk_bf16(a0[0], a0[1]); w.y = cvt_pk_bf16(a0[2], a0[3]); w.z = cvt_pk_bf16(a1[0], a1[1]); w.w = cvt_pk_bf16(a1[2], a1[3]);
                    *(u32x4*)(rowp + bj * 128) = w;
                }
            }
    }
};

__device__ void phase0a(const Params& P, LAS unsigned char* lds) {
    const int tid = tid_opaque(), G = gridDim.x, bid = blockIdx.x;
    for (int it = bid; it < 192; it += G) {
        LAS float* sc = (LAS float*)lds;
        const int kg = tid >> 5, col = tid & 31;
        float w[64];
#pragma unroll
        for (int e = 0; e < 64; ++e) w[e] = __builtin_nontemporal_load(P.w_ada + (size_t)(kg * 64 + e) * 6144 + it * 32 + col);
        asm volatile("" ::: "memory");
#pragma unroll 1
        for (int i0 = 0; i0 < 64; i0 += 16) {
            float cv[16];
#pragma unroll
            for (int j = 0; j < 16; ++j) cv[j] = P.c[tid + (i0 + j) * NTHR];
#pragma unroll
            for (int j = 0; j < 16; ++j) sc[tid + (i0 + j) * NTHR] = cv[j] * sigmoidf_(cv[j]);
        }
        __syncthreads();
        float a[32];
#pragma unroll
        for (int b = 0; b < 32; ++b) a[b] = 0.f;
#pragma unroll
        for (int e4 = 0; e4 < 16; ++e4) {
#pragma unroll
            for (int b = 0; b < 32; ++b) { const f32x4 s = *(const LAS f32x4*)(sc + b * 1024 + kg * 64 + 4 * e4); a[b] += s[0] * w[4 * e4] + s[1] * w[4 * e4 + 1] + s[2] * w[4 * e4 + 2] + s[3] * w[4 * e4 + 3]; }
            asm volatile("" ::: "memory");
        }
        __syncthreads();
        LAS float* red = (LAS float*)lds;
#pragma unroll
        for (int b = 0; b < 32; ++b) red[(kg * 32 + b) * 32 + col] = a[b];
        __syncthreads();
        for (int o = tid; o < 1024; o += NTHR) { const int b = o >> 5, cc = o & 31; float s = 0.f;
#pragma unroll
            for (int g2 = 0; g2 < 16; ++g2) s += red[(g2 * 32 + b) * 32 + cc];
            ((float*)(P.ws + OFF_ADA))[(size_t)b * 6144 + it * 32 + cc] = s + P.b_ada[it * 32 + cc]; }
        __syncthreads();
    }
    const size_t gsz = (size_t)G * NTHR;
    { const int gt = bid * NTHR + tid, gs = G * NTHR;
      if (gt < 512) ((float*)(P.ws + OFF_LB))[gt] = sigmoidf_(P.hgrn_lb[gt] - P.hgrn_lb[512 + gt]);
      for (int i = gt; i < 32 * 8 * 512; i += gs) ((float*)(P.ws + OFF_KMEAN))[i] = 0.f; }
    {
        LAS float* tile = (LAS float*)lds;
        const int I0 = 16 * 88, I1 = I0 + 8 * 16, I2 = I1 + 8 * 16, I3 = I2 + 16 * 16, I4 = I3 + 16 * 16;
        for (int it = bid; it < I4; it += G) {
            const float* W; bf16_t* WT; int K, N, r;
            if (it < I0) { W = P.w_in; WT = (bf16_t*)(P.ws + OFF_WIN); K = 1024; N = 5632; r = it; }
            else if (it < I1) { W = P.w_ba; WT = (bf16_t*)(P.ws + OFF_WBA); K = 512; N = 1024; r = it - I0; }
            else if (it < I2) { W = P.w_bb; WT = (bf16_t*)(P.ws + OFF_WBB); K = 512; N = 1024; r = it - I1; }
            else if (it < I3) { W = P.w_out; WT = (bf16_t*)(P.ws + OFF_WOUT); K = 1024; N = 1024; r = it - I2; }
            else { W = P.peer_wq; WT = (bf16_t*)(P.ws + OFF_WQ); K = 1024; N = 1024; r = it - I3; }
            const int nb = N / 64, k0 = (r / nb) * 64, n0 = (r % nb) * 64;
#pragma unroll
            for (int ps = 0; ps < 2; ++ps) { const int kk = (tid >> 4) + 32 * ps, n4 = (tid & 15) * 4;
                const f32x4 v = *(const f32x4*)(W + (size_t)(k0 + kk) * N + n0 + n4);
                tile[kk * 65 + n4] = v[0]; tile[kk * 65 + n4 + 1] = v[1]; tile[kk * 65 + n4 + 2] = v[2]; tile[kk * 65 + n4 + 3] = v[3]; }
            __syncthreads();
            { const int n = tid >> 3, kc = (tid & 7) * 8;
              if (it < I3) {
                  int w0 = __builtin_amdgcn_cvt_pk_fp8_f32(32.f * tile[(kc + 0) * 65 + n], 32.f * tile[(kc + 1) * 65 + n], 0, false); w0 = __builtin_amdgcn_cvt_pk_fp8_f32(32.f * tile[(kc + 2) * 65 + n], 32.f * tile[(kc + 3) * 65 + n], w0, true);
                  int w1 = __builtin_amdgcn_cvt_pk_fp8_f32(32.f * tile[(kc + 4) * 65 + n], 32.f * tile[(kc + 5) * 65 + n], 0, false); w1 = __builtin_amdgcn_cvt_pk_fp8_f32(32.f * tile[(kc + 6) * 65 + n], 32.f * tile[(kc + 7) * 65 + n], w1, true);
                  *(u32x2*)((unsigned char*)WT + (size_t)(n0 + n) * K + k0 + kc) = (u32x2){(unsigned)w0, (unsigned)w1};
              } else { u32x4 w;
              w.x = cvt_pk_bf16(tile[(kc + 0) * 65 + n], tile[(kc + 1) * 65 + n]); w.y = cvt_pk_bf16(tile[(kc + 2) * 65 + n], tile[(kc + 3) * 65 + n]);
              w.z = cvt_pk_bf16(tile[(kc + 4) * 65 + n], tile[(kc + 5) * 65 + n]); w.w = cvt_pk_bf16(tile[(kc + 6) * 65 + n], tile[(kc + 7) * 65 + n]);
              *(u32x4*)(WT + (size_t)(n0 + n) * K + k0 + kc) = w; } }
            __syncthreads();
        }
    }
    {
        const size_t gtid = (size_t)bid * NTHR + tid_opaque();
        for (size_t i = gtid; i < 16384; i += gsz) {
            const float* src = P.peer_sk + i * 8; const f32x4 a = *(const f32x4*)src, b = *(const f32x4*)(src + 4);
            u32x4 w; w.x = cvt_pk_bf16(a[0], a[1]); w.y = cvt_pk_bf16(a[2], a[3]); w.z = cvt_pk_bf16(b[0], b[1]); w.w = cvt_pk_bf16(b[2], b[3]);
            *(u32x4*)((bf16_t*)(P.ws + OFF_SK) + i * 8) = w;
        }
        { const int lane = tid & 63, gw = bid * 8 + (tid >> 6), ngw = G * 8;
          for (int r0 = gw; r0 < 2 * 16384; r0 += 4 * ngw) {
              f32x4 x[4][4];
#pragma unroll
              for (int u = 0; u < 4; ++u) { const int r = min(r0 + u * ngw, 2 * 16384 - 1); const bool isv = r >= 16384; const int e = isv ? r - 16384 : r;
                  const float* s = (isv ? P.peer_v : P.peer_u) + (size_t)e * 1024 + lane * 4;
#pragma unroll
                  for (int q = 0; q < 4; ++q) x[u][q] = __builtin_nontemporal_load((const f32x4*)(s + 256 * q)); }
              asm volatile("" ::: "memory");
#pragma unroll
              for (int u = 0; u < 4; ++u) { const int r = r0 + u * ngw; if (r < 2 * 16384) { const bool isv = r >= 16384; const int e = isv ? r - 16384 : r;
                  float ss = 0.f;
#pragma unroll
                  for (int q = 0; q < 4; ++q) ss += (x[u][q][0] * x[u][q][0] + x[u][q][1] * x[u][q][1]) + (x[u][q][2] * x[u][q][2] + x[u][q][3] * x[u][q][3]);
                  const float sc = fmaxf(sqrtf(wave_sum_fast(ss) * (1.0f / 1024.0f)) * (2.6f / 7.5f), 1e-30f), inv = 1.0f / sc;
                  const int nsh = (lane & 1) * 4;
                  const unsigned flip = isv ? 0x80808080u : 0x88888888u;
                  unsigned* dst = (unsigned*)(P.ws + (isv ? OFF_V8 : OFF_U8) + (size_t)e * 512) + (lane >> 1);
#pragma unroll
                  for (int q = 0; q < 4; ++q) {
                      unsigned p = 0u;
#pragma unroll
                      for (int el = 0; el < 4; ++el) p |= (unsigned)fminf(fmaxf(floorf(x[u][q][el] * inv) + 8.0f, 0.0f), 15.0f) << (8 * el + nsh);
                      p |= (unsigned)__builtin_amdgcn_update_dpp(0, (int)p, 0xB1, 0xf, 0xf, true);
                      if (!(lane & 1)) dst[32 * q] = p ^ flip;
                  }
                  if (lane == 0) ((float*)(P.ws + (isv ? OFF_VSC : OFF_USC)))[e] = sc; } }
          } }
    }
}
__device__ void phase0b(const Params& P) {
    const size_t gtid = (size_t)blockIdx.x * NTHR + threadIdx.x, gsz = (size_t)gridDim.x * NTHR;
    const float* ada = (const float*)(P.ws + OFF_ADA); bf16_t* H = (bf16_t*)(P.ws + OFF_H);
    for (size_t i = gtid; i < (size_t)NTOK * 128; i += gsz) {
        const size_t row = i >> 7; const int c8 = (int)(i & 127) * 8; const int b = (int)(row >> 11);
        const float* xr = P.x + row * 1024 + c8; const float* sh = ada + (size_t)b * 6144 + c8; const float* sc = sh + 1024;
        const f32x4 x0 = *(const f32x4*)xr, x1 = *(const f32x4*)(xr + 4), s0 = *(const f32x4*)sc, s1 = *(const f32x4*)(sc + 4), h0 = *(const f32x4*)sh, h1 = *(const f32x4*)(sh + 4);
        const f32x4 r0 = x0 * (s0 + 1.0f) + h0, r1 = x1 * (s1 + 1.0f) + h1;
        int w0 = __builtin_amdgcn_cvt_pk_fp8_f32(r0[0], r0[1], 0, false); w0 = __builtin_amdgcn_cvt_pk_fp8_f32(r0[2], r0[3], w0, true);
        int w1 = __builtin_amdgcn_cvt_pk_fp8_f32(r1[0], r1[1], 0, false); w1 = __builtin_amdgcn_cvt_pk_fp8_f32(r1[2], r1[3], w1, true);
        *(u32x2*)((unsigned char*)H + row * 1024 + c8) = (u32x2){(unsigned)w0, (unsigned)w1};
    }
}

__device__ __forceinline__ s16x4 tr4(const LAS unsigned char* p) { return __builtin_bit_cast(s16x4, __builtin_amdgcn_ds_read_tr16_b64_v4i16((LAS s16x4*)p)); }
__device__ void hgrn_item(const Params& P, int item, LAS unsigned char* lds) {
    const int tid = tid_opaque(), lane = tid & 63, wid = __builtin_amdgcn_readfirstlane(tid >> 6), r32 = lane & 31, hi = lane >> 5;
    const int b = item >> 3, h = (item >> 1) & 3, vh = item & 1;
    const bf16_t* HQ = (const bf16_t*)(P.ws + OFF_HQ); const bf16_t* HK = (const bf16_t*)(P.ws + OFF_HK); bf16_t* HI = (bf16_t*)(P.ws + OFF_HI);
    constexpr int SQ = 272, SKD = 320, SV = 192, SS = 192;
    constexpr int LQR = 0, LKR = 17408, LQB = 34816, LKD = 52224, LV = 72704, LS = 84992, LG = 109568, LT = 142336, LCL = 144384;
    LAS float* G = (LAS float*)(lds + LG); LAS float* TOT = (LAS float*)(lds + LT); LAS float* CL = (LAS float*)(lds + LCL); LAS float* CH = (LAS float*)(lds + LCL + 512);
    const size_t rowb = (size_t)b * SEQ;
    const int row = tid >> 3, seg = tid & 7;
    const bf16_t* qsrc = HQ + (rowb + row) * 512 + h * 128 + seg * 16; const bf16_t* ksrc = HK + (rowb + row) * 512 + h * 128 + seg * 16;
    bf16_t* vsrc = HI + (rowb + row) * 512 + h * 128 + vh * 64 + seg * 8;
    for (int i = tid; i < 128 * SS / 4; i += NTHR) ((LAS unsigned*)(lds + LS))[i] = 0u;
    f32x16 Sacc = {};
    const int di = wid >> 1, vi = wid & 1, ti = wid >> 1;
    const int tg = lane >> 4, tc = tg & 1, tI = lane & 15;
    const int trow = 4 * hi + (tI >> 2), tcol = 16 * tc + 4 * (tI & 3);
    u32x4 qn0 = *(const u32x4*)qsrc, qn1 = *(const u32x4*)(qsrc + 8), kn0 = *(const u32x4*)ksrc, kn1 = *(const u32x4*)(ksrc + 8), vn = *(const u32x4*)vsrc;
#pragma unroll 1
    for (int n = 0; n < SEQ / 64; ++n) {
        const u32x4 q0 = qn0, q1 = qn1, k0 = kn0, k1 = kn1, vv = vn;
        float qf[16] = {bf_lo(q0.x), bf_hi(q0.x), bf_lo(q0.y), bf_hi(q0.y), bf_lo(q0.z), bf_hi(q0.z), bf_lo(q0.w), bf_hi(q0.w), bf_lo(q1.x), bf_hi(q1.x), bf_lo(q1.y), bf_hi(q1.y), bf_lo(q1.z), bf_hi(q1.z), bf_lo(q1.w), bf_hi(q1.w)};
        float kf[16] = {bf_lo(k0.x), bf_hi(k0.x), bf_lo(k0.y), bf_hi(k0.y), bf_lo(k0.z), bf_hi(k0.z), bf_lo(k0.w), bf_hi(k0.w), bf_lo(k1.x), bf_hi(k1.x), bf_lo(k1.y), bf_hi(k1.y), bf_lo(k1.z), bf_hi(k1.z), bf_lo(k1.w), bf_hi(k1.w)};
#pragma unroll
        for (int e4 = 0; e4 < 4; ++e4) *(LAS f32x4*)(G + row * 128 + seg * 16 + 4 * e4) = (f32x4){__logf(1.0f - kf[4 * e4]), __logf(1.0f - kf[4 * e4 + 1]), __logf(1.0f - kf[4 * e4 + 2]), __logf(1.0f - kf[4 * e4 + 3])};
        *(LAS u32x4*)(lds + LV + row * SV + seg * 16) = vv;
        if (n + 1 < SEQ / 64) { const size_t o = (size_t)(n + 1) * 64 * 512; qn0 = *(const u32x4*)(qsrc + o); qn1 = *(const u32x4*)(qsrc + o + 8); kn0 = *(const u32x4*)(ksrc + o); kn1 = *(const u32x4*)(ksrc + o + 8); vn = *(const u32x4*)(vsrc + o); }
        __syncthreads();
        { const int d = tid & 127, q4 = tid >> 7; float s = 0.f;
#pragma unroll
          for (int i = 0; i < 16; ++i) { s += G[(16 * q4 + i) * 128 + d]; G[(16 * q4 + i) * 128 + d] = s; }
          TOT[q4 * 128 + d] = s; }
        __syncthreads();
        {
            { const int d2 = 2 * lane;
              const f32x2 t0 = *(const LAS f32x2*)(TOT + d2), t1 = *(const LAS f32x2*)(TOT + 128 + d2), t2 = *(const LAS f32x2*)(TOT + 256 + d2), t3 = *(const LAS f32x2*)(TOT + 384 + d2);
              const f32x2 bref = *(const LAS f32x2*)(G + 32 * 128 + d2) + t0 + t1, blast = t0 + t1 + t2 + t3;
              *(LAS f32x2*)(CH + d2) = (f32x2){__expf(-bref.x), __expf(-bref.y)}; *(LAS f32x2*)(CH + 128 + d2) = (f32x2){__expf(bref.x), __expf(bref.y)}; *(LAS f32x2*)(CL + d2) = (f32x2){__expf(blast.x), __expf(blast.y)}; }
            const int qq = row >> 4;
#pragma unroll
            for (int e4 = 0; e4 < 4; ++e4) {
                const int d4 = seg * 16 + 4 * e4;
                const f32x4 t0 = *(const LAS f32x4*)(TOT + d4), t1 = *(const LAS f32x4*)(TOT + 128 + d4), t2 = *(const LAS f32x4*)(TOT + 256 + d4);
                const f32x4 off = (qq == 0) ? (f32x4){0.f, 0.f, 0.f, 0.f} : ((qq == 1) ? t0 : ((qq == 2) ? t0 + t1 : t0 + t1 + t2));
                const f32x4 bb = *(const LAS f32x4*)(G + row * 128 + d4) + off;
                const f32x4 enr = *(const LAS f32x4*)(CH + d4), epr = *(const LAS f32x4*)(CH + 128 + d4), epl = *(const LAS f32x4*)(CL + d4);
                float vqb[4], vqr[4], vkr[4], vkd[4];
#pragma unroll
                for (int e = 0; e < 4; ++e) {
                    const float e1 = __expf(bb[e]), e2 = __expf(-bb[e]);
                    vqb[e] = qf[4 * e4 + e] * e1; vqr[e] = vqb[e] * enr[e];
                    const float ke = kf[4 * e4 + e] * e2; vkr[e] = ke * epr[e]; vkd[e] = ke * epl[e];
                }
                *(LAS u32x2*)(lds + LQB + row * SQ + seg * 32 + 8 * e4) = (u32x2){cvt_pk_bf16(vqb[0], vqb[1]), cvt_pk_bf16(vqb[2], vqb[3])};
                *(LAS u32x2*)(lds + LQR + row * SQ + seg * 32 + 8 * e4) = (u32x2){cvt_pk_bf16(vqr[0], vqr[1]), cvt_pk_bf16(vqr[2], vqr[3])};
                *(LAS u32x2*)(lds + LKR + row * SQ + seg * 32 + 8 * e4) = (u32x2){cvt_pk_bf16(vkr[0], vkr[1]), cvt_pk_bf16(vkr[2], vkr[3])};
                *(LAS u32x2*)(lds + LKD + row * SKD + seg * 32 + 8 * e4) = (u32x2){cvt_pk_bf16(vkd[0], vkd[1]), cvt_pk_bf16(vkd[2], vkd[3])};
                asm volatile("" ::: "memory");
            }
        }
        __syncthreads();
        if (wid < 4) {
            f32x16 Z = {};
            for (int si = 0; si <= ti; ++si) {
                f32x16 X = {};
#pragma unroll
                for (int ks = 0; ks < 8; ++ks) {
                    const bf16x8 a = *(const LAS bf16x8*)(lds + LKR + (32 * si + r32) * SQ + (16 * ks + 8 * hi) * 2);
                    const bf16x8 bq = *(const LAS bf16x8*)(lds + LQR + (32 * ti + r32) * SQ + (16 * ks + 8 * hi) * 2);
                    X = MFMA32(a, bq, X);
                }
                if (si == ti) {
#pragma unroll
                    for (int r = 0; r < 16; ++r) if (crow(r, hi) > r32) X[r] = 0.f;
                }
#pragma unroll
                for (int s2 = 0; s2 < 2; ++s2) {
                    union { u32x4 u; bf16x8 v; } pa;
                    pa.u.x = cvt_pk_bf16(X[8 * s2 + 0], X[8 * s2 + 1]); pa.u.y = cvt_pk_bf16(X[8 * s2 + 2], X[8 * s2 + 3]); pa.u.z = cvt_pk_bf16(X[8 * s2 + 4], X[8 * s2 + 5]); pa.u.w = cvt_pk_bf16(X[8 * s2 + 6], X[8 * s2 + 7]);
                    const LAS unsigned char* vp = lds + LV + (32 * si + 16 * s2 + trow) * SV + (32 * vi + tcol) * 2;
                    const s16x4 lo = tr4(vp), hh = tr4(vp + 8 * SV);
                    const bf16x8 vf = {lo[0], lo[1], lo[2], lo[3], hh[0], hh[1], hh[2], hh[3]};
                    Z = MFMA32(pa.v, vf, Z);
                }
            }
#pragma unroll
            for (int ks = 0; ks < 8; ++ks) {
                const bf16x8 a = *(const LAS bf16x8*)(lds + LQB + (32 * ti + r32) * SQ + (16 * ks + 8 * hi) * 2);
                const LAS unsigned char* sp = lds + LS + (16 * ks + 8 * hi + (tI >> 2)) * SS + (32 * vi + tcol) * 2;
                const s16x4 lo = tr4(sp), hh = tr4(sp + 4 * SS);
                const bf16x8 sf = {lo[0], lo[1], lo[2], lo[3], hh[0], hh[1], hh[2], hh[3]};
                Z = MFMA32(a, sf, Z);
            }
            bf16_t* op = HI + (rowb + (size_t)n * 64 + 32 * ti) * 512 + h * 128 + vh * 64 + 32 * vi + r32;
#pragma unroll
            for (int r = 0; r < 16; ++r) op[(size_t)crow(r, hi) * 512] = (bf16_t)(cvt_pk_bf16(Z[r], 0.f) & 0xffffu);
        }
        {
#pragma unroll
            for (int r = 0; r < 16; ++r) Sacc[r] *= CL[32 * di + crow(r, hi)];
#pragma unroll
            for (int ks = 0; ks < 4; ++ks) {
                const LAS unsigned char* kp = lds + LKD + (16 * ks + 8 * hi + (tI >> 2)) * SKD + (32 * di + tcol) * 2;
                const s16x4 klo = tr4(kp), khi = tr4(kp + 4 * SKD);
                const bf16x8 ka = {klo[0], klo[1], klo[2], klo[3], khi[0], khi[1], khi[2], khi[3]};
                const LAS unsigned char* vp = lds + LV + (16 * ks + 8 * hi + (tI >> 2)) * SV + (32 * vi + tcol) * 2;
                const s16x4 vlo = tr4(vp), vhi = tr4(vp + 4 * SV);
                const bf16x8 vb = {vlo[0], vlo[1], vlo[2], vlo[3], vhi[0], vhi[1], vhi[2], vhi[3]};
                Sacc = MFMA32(ka, vb, Sacc);
            }
        }
        __syncthreads();
        {
            LAS bf16_t* sp = (LAS bf16_t*)(lds + LS + (32 * di) * SS + (32 * vi + r32) * 2);
#pragma unroll
            for (int r = 0; r < 16; ++r) sp[crow(r, hi) * (SS / 2)] = (bf16_t)(cvt_pk_bf16(Sacc[r], 0.f) & 0xffffu);
        }
    }
    __syncthreads();
}

__device__ void moba_unit(const Params& P, int b, int h, int j, LAS unsigned char* lds) {
    const int tid = tid_opaque(), lane = tid & 63, wid = tid >> 6, r32 = lane & 31, hi = lane >> 5;
    bf16_t* Q = (bf16_t*)(P.ws + OFF_QA); const bf16_t* Kg = (const bf16_t*)(P.ws + OFF_KA); const bf16_t* Vg = (const bf16_t*)(P.ws + OFF_VA);
    const float* kmean = (const float*)(P.ws + OFF_KMEAN);
    constexpr int KIMG = 64 * 144, VIMG = 64 * 192, LK = 0, LV = 4 * KIMG, LKM = 4 * KIMG + 4 * VIMG;
    LAS float* kmL = (LAS float*)(lds + LKM);
    const size_t rowb = (size_t)b * SEQ; const int q0 = j * 256;
    if (tid < j * 64) kmL[tid] = kmean[(size_t)(b * 8 + (tid >> 6)) * 512 + h * 64 + (tid & 63)];
    bf16_t* qrow = Q + (rowb + q0 + wid * 32 + r32) * 512 + h * 64;
    bf16x8 qf[4];
#pragma unroll
    for (int d0 = 0; d0 < 4; ++d0) qf[d0] = *(const bf16x8*)(qrow + 16 * d0 + 8 * hi);
    const int srow = tid >> 3, sch = tid & 7;
    const bf16_t* ksrc = Kg + (rowb + srow) * 512 + h * 64 + sch * 8; const bf16_t* vsrc = Vg + (rowb + srow) * 512 + h * 64 + sch * 8;
    const int ntile = 4 * (j + 1), npair = ntile >> 1;
    auto tile_key0 = [&](int i) -> size_t { const int blk = (i < 4) ? j : ((i - 4) >> 2), kt = (i < 4) ? i : ((i - 4) & 3); return (size_t)(blk * 256 + kt * 64); };
    u32x4 kreg[2], vreg[2];
#pragma unroll
    for (int s = 0; s < 2; ++s) { const size_t k0 = tile_key0(s); kreg[s] = *(const u32x4*)(ksrc + k0 * 512); vreg[s] = *(const u32x4*)(vsrc + k0 * 512); }
#pragma unroll
    for (int s = 0; s < 2; ++s) { *(LAS u32x4*)(lds + LK + s * KIMG + srow * 144 + sch * 16) = kreg[s]; *(LAS u32x4*)(lds + LV + s * VIMG + srow * 192 + sch * 16) = vreg[s]; }
    __syncthreads();
    unsigned sel = 0;
    if (j <= 3) sel = (1u << j) - 1u;
    else {
        float g[7];
#pragma unroll
        for (int n = 0; n < 7; ++n) { float s = 0.f;
            if (n < j) {
#pragma unroll
                for (int d0 = 0; d0 < 4; ++d0)
#pragma unroll
                    for (int e = 0; e < 8; ++e) s += __uint_as_float(((unsigned)(unsigned short)qf[d0][e]) << 16) * kmL[n * 64 + 16 * d0 + 8 * hi + e];
            }
            s += __shfl_xor(s, 32); g[n] = s; }
#pragma unroll
        for (int it = 0; it < 3; ++it) { float best = -INFINITY; int bi = 0;
#pragma unroll
            for (int n = 0; n < 7; ++n) if (n < j && !((sel >> n) & 1u) && g[n] > best) { best = g[n]; bi = n; }
            sel |= 1u << bi; }
    }
    const float ch = exp2f(-(float)(h + 1)) * LOG2E;
    const int qb = wid * 32 + r32;
    float m_run = -1e30f;
    f32x16 o0 = {}, o1 = {}, o2 = {};
    f32x16 al0, al1;
#pragma unroll
    for (int r = 0; r < 16; ++r) { al0[r] = ch * (float)crow(r, hi); al1[r] = ch * (float)(crow(r, hi) + 32); }
    const bf16x8 ones8 = {(short)0x3F80, (short)0x3F80, (short)0x3F80, (short)0x3F80, (short)0x3F80, (short)0x3F80, (short)0x3F80, (short)0x3F80};
    const int tg = lane >> 4, tc = tg & 1, ti = lane & 15;
    const int vlane = (4 * hi + (ti >> 2)) * 192 + (16 * tc + 4 * (ti & 3)) * 2;
#pragma unroll 1
    for (int ip = 0; ip < npair; ++ip) {
      const int pbuf = ip & 1;
      if (ip + 1 < npair) {
#pragma unroll
          for (int s = 0; s < 2; ++s) { const size_t k1 = tile_key0(2 * ip + 2 + s); kreg[s] = *(const u32x4*)(ksrc + k1 * 512); vreg[s] = *(const u32x4*)(vsrc + k1 * 512); }
      }
#pragma unroll
      for (int s2 = 0; s2 < 2; ++s2) {
        const int i = 2 * ip + s2, buf = pbuf * 2 + s2;
        const bool own = i < 4; const int blk = own ? j : ((i - 4) >> 2), kt = own ? i : ((i - 4) & 3);
        const bool lane_ok = own ? true : (((sel >> blk) & 1u) != 0u);
        const bool skip = own ? (64 * kt > 32 * wid + 31) : (__ballot(lane_ok) == 0ull);
        if (!skip) {
            LAS unsigned char* kb = lds + LK + buf * KIMG; LAS unsigned char* vb = lds + LV + buf * VIMG;
            f32x16 p0, p1;
#pragma unroll
            for (int d0 = 0; d0 < 4; ++d0) {
                const bf16x8 kf0 = *(const LAS bf16x8*)(kb + r32 * 144 + (16 * d0 + 8 * hi) * 2);
                const bf16x8 kf1 = *(const LAS bf16x8*)(kb + (32 + r32) * 144 + (16 * d0 + 8 * hi) * 2);
                p0 = MFMA32(kf0, qf[d0], d0 == 0 ? al0 : p0); p1 = MFMA32(kf1, qf[d0], d0 == 0 ? al1 : p1);
            }
            const float kbase = ch * (float)((blk - j) * 256 + kt * 64);
            float mt = -1e30f;
#pragma unroll
            for (int r = 0; r < 16; ++r) {
                const int kl0 = crow(r, hi), kl1 = kl0 + 32;
                if (own) { if (kt * 64 + kl0 > qb) p0[r] = -1e30f; if (kt * 64 + kl1 > qb) p1[r] = -1e30f; }
                mt = fmaxf(mt, fmaxf(p0[r], p1[r]));
            }
            mt = lane_ok ? mt + kbase : -1e30f;
            mt = fmaxf(mt, __shfl_xor(mt, 32));
            if (__ballot(mt > m_run) != 0ull) {
                const float mnew = fmaxf(m_run, mt), alpha = __builtin_amdgcn_exp2f(m_run - mnew);
                m_run = mnew;
#pragma unroll
                for (int r = 0; r < 16; ++r) { o0[r] *= alpha; o1[r] *= alpha; o2[r] *= alpha; }
            }
            const float sh = lane_ok ? kbase - m_run : -1e30f;
#pragma unroll
            for (int r = 0; r < 16; ++r) { p0[r] = __builtin_amdgcn_exp2f(p0[r] + sh); p1[r] = __builtin_amdgcn_exp2f(p1[r] + sh); }
#pragma unroll
            for (int sub = 0; sub < 2; ++sub)
#pragma unroll
                for (int s = 0; s < 2; ++s) {
                    union { u32x4 u; bf16x8 v; } pb;
                    if (sub == 0) { pb.u.x = cvt_pk_bf16(p0[8 * s + 0], p0[8 * s + 1]); pb.u.y = cvt_pk_bf16(p0[8 * s + 2], p0[8 * s + 3]); pb.u.z = cvt_pk_bf16(p0[8 * s + 4], p0[8 * s + 5]); pb.u.w = cvt_pk_bf16(p0[8 * s + 6], p0[8 * s + 7]); }
                    else { pb.u.x = cvt_pk_bf16(p1[8 * s + 0], p1[8 * s + 1]); pb.u.y = cvt_pk_bf16(p1[8 * s + 2], p1[8 * s + 3]); pb.u.z = cvt_pk_bf16(p1[8 * s + 4], p1[8 * s + 5]); pb.u.w = cvt_pk_bf16(p1[8 * s + 6], p1[8 * s + 7]); }
#pragma unroll
                    for (int dt = 0; dt < 2; ++dt) {
                        LAS unsigned char* va = vb + (32 * sub + 16 * s) * 192 + dt * 64 + vlane;
                        const s16x4 lo = __builtin_bit_cast(s16x4, __builtin_amdgcn_ds_read_tr16_b64_v4i16((LAS s16x4*)va));
                        const s16x4 hh = __builtin_bit_cast(s16x4, __builtin_amdgcn_ds_read_tr16_b64_v4i16((LAS s16x4*)(va + 8 * 192)));
                        const bf16x8 vf = {lo[0], lo[1], lo[2], lo[3], hh[0], hh[1], hh[2], hh[3]};
                        if (dt == 0) o0 = MFMA32(vf, pb.v, o0); else o1 = MFMA32(vf, pb.v, o1);
                    }
                    o2 = MFMA32(ones8, pb.v, o2);
                }
        }
      }
      if (ip + 1 < npair) { const int nb = (pbuf ^ 1) * 2;
#pragma unroll
          for (int s = 0; s < 2; ++s) { *(LAS u32x4*)(lds + LK + (nb + s) * KIMG + srow * 144 + sch * 16) = kreg[s]; *(LAS u32x4*)(lds + LV + (nb + s) * VIMG + srow * 192 + sch * 16) = vreg[s]; } }
      __syncthreads();
    }
    const float inv = 1.0f / o2[0];
#pragma unroll
    for (int r4 = 0; r4 < 4; ++r4) {
        int w0 = __builtin_amdgcn_cvt_pk_fp8_f32(o0[4 * r4] * inv, o0[4 * r4 + 1] * inv, 0, false); w0 = __builtin_amdgcn_cvt_pk_fp8_f32(o0[4 * r4 + 2] * inv, o0[4 * r4 + 3] * inv, w0, true);
        int w1 = __builtin_amdgcn_cvt_pk_fp8_f32(o1[4 * r4] * inv, o1[4 * r4 + 1] * inv, 0, false); w1 = __builtin_amdgcn_cvt_pk_fp8_f32(o1[4 * r4 + 2] * inv, o1[4 * r4 + 3] * inv, w1, true);
        unsigned char* yrow = P.ws + OFF_EG + (rowb + q0 + wid * 32 + r32) * 1024 + h * 64;
        *(int*)(yrow + 8 * r4 + 4 * hi) = w0; *(int*)(yrow + 32 + 8 * r4 + 4 * hi) = w1;
    }
}

__device__ void yb_norm_panel(const Params& P, int pm) {
    const int tid = tid_opaque(), lane = tid & 63, wid = tid >> 6;
    bf16_t* HI = (bf16_t*)(P.ws + OFF_HI); const bf16_t* HG = (const bf16_t*)(P.ws + OFF_HG);
    for (int r = 0; r < 32; ++r) {
        const size_t off = ((size_t)pm * 256 + wid * 32 + r) * 512 + lane * 8;
        const u32x4 ov = *(const u32x4*)(HI + off), gv = *(const u32x4*)(HG + off);
        float o[8] = {bf_lo(ov.x), bf_hi(ov.x), bf_lo(ov.y), bf_hi(ov.y), bf_lo(ov.z), bf_hi(ov.z), bf_lo(ov.w), bf_hi(ov.w)};
        const float g[8] = {bf_lo(gv.x), bf_hi(gv.x), bf_lo(gv.y), bf_hi(gv.y), bf_lo(gv.z), bf_hi(gv.z), bf_lo(gv.w), bf_hi(gv.w)};
        float ss = 0.f;
#pragma unroll
        for (int e = 0; e < 8; ++e) ss += o[e] * o[e];
        ss += __shfl_xor(ss, 1); ss += __shfl_xor(ss, 2); ss += __shfl_xor(ss, 4); ss += __shfl_xor(ss, 8);
        const float rs = rsqrtf(ss * (1.0f / 128.0f) + RMS_EPS);
        int w0 = __builtin_amdgcn_cvt_pk_fp8_f32(o[0] * rs * g[0], o[1] * rs * g[1], 0, false); w0 = __builtin_amdgcn_cvt_pk_fp8_f32(o[2] * rs * g[2], o[3] * rs * g[3], w0, true);
        int w1 = __builtin_amdgcn_cvt_pk_fp8_f32(o[4] * rs * g[4], o[5] * rs * g[5], 0, false); w1 = __builtin_amdgcn_cvt_pk_fp8_f32(o[6] * rs * g[6], o[7] * rs * g[7], w1, true);
        *(u32x2*)(P.ws + OFF_EG + ((size_t)pm * 256 + wid * 32 + r) * 1024 + 512 + lane * 8) = (u32x2){(unsigned)w0, (unsigned)w1};
    }
}
__device__ void ln1_panel(const Params& P, int pm) {
    const int tid = tid_opaque(), lane = tid & 63, wid = tid >> 6;
    const float* ada = (const float*)(P.ws + OFF_ADA) + (size_t)(pm >> 3) * 6144; bf16_t* H = (bf16_t*)(P.ws + OFF_H);
    for (int r = 0; r < 32; ++r) {
        const size_t row = (size_t)pm * 256 + wid * 32 + r;
        const float* xin = P.x + row * 1024 + lane * 4; const unsigned char* dl = P.ws + OFF_GB + row * 2048 + lane * 4;
        f32x4 v[4]; float s = 0.f;
#pragma unroll
        for (int jx = 0; jx < 4; ++jx) { const int dv = *(const int*)(dl + 256 * jx); const f32x4 xv = __builtin_nontemporal_load((const f32x4*)(xin + 256 * jx));
            const f32x2 d01 = __builtin_amdgcn_cvt_pk_f32_fp8(dv, false), d23 = __builtin_amdgcn_cvt_pk_f32_fp8(dv, true);
            v[jx] = xv * ALPHA + (f32x4){d01.x, d01.y, d23.x, d23.y}; s += (v[jx][0] + v[jx][1]) + (v[jx][2] + v[jx][3]); }
        const float mean = wave_sum(s) * (1.0f / 1024.0f); float s2 = 0.f;
#pragma unroll
        for (int jx = 0; jx < 4; ++jx) { v[jx] = v[jx] - mean; s2 += (v[jx][0] * v[jx][0] + v[jx][1] * v[jx][1]) + (v[jx][2] * v[jx][2] + v[jx][3] * v[jx][3]); }
        const float rstd = rsqrtf(wave_sum(s2) * (1.0f / 1024.0f) + LN_EPS);
#pragma unroll
        for (int jx = 0; jx < 4; ++jx) {
            const int c = lane * 4 + 256 * jx;
            const f32x4 g = *(const f32x4*)(P.ln1_g + c), bb = *(const f32x4*)(P.ln1_b + c), sh = *(const f32x4*)(ada + 3072 + c), sc = *(const f32x4*)(ada + 4096 + c);
            const f32x4 x1 = v[jx] * rstd * g + bb;
            { u32x2 w1; w1.x = cvt_pk_bf16(x1[0], x1[1]); w1.y = cvt_pk_bf16(x1[2], x1[3]);
              *(u32x2*)((bf16_t*)(P.out + row * 1024) + c) = w1; }
            const f32x4 h2 = x1 * (sc + 1.0f) + sh;
            u32x2 w; w.x = cvt_pk_bf16(h2[0], h2[1]); w.y = cvt_pk_bf16(h2[2], h2[3]);
            *(u32x2*)(H + row * 1024 + c) = w;
            v[jx] = h2;
        }
        {
            float mx = 0.f;
#pragma unroll
            for (int jx = 0; jx < 4; ++jx) mx = fmaxf(mx, fmaxf(fmaxf(fabsf(v[jx][0]), fabsf(v[jx][1])), fmaxf(fabsf(v[jx][2]), fabsf(v[jx][3]))));
#pragma unroll
            for (int o = 1; o < 64; o <<= 1) mx = fmaxf(mx, __shfl_xor(mx, o));
            const float hs = fmaxf(mx * (1.0f / 119.0f), 1e-30f), inv = 1.0f / hs; int qs = 0;
            const int nsh = (lane & 1) * 4;
#pragma unroll
            for (int jx = 0; jx < 4; ++jx) {
                unsigned pa = 0u, pb = 0u;
#pragma unroll
                for (int k = 0; k < 4; ++k) { const int q = (int)rintf(v[jx][k] * inv); qs += q;
                    const int b = ((q + 8) & 15) - 8, a = (q - b) >> 4;
                    pa |= (unsigned)(a & 15) << (8 * k + nsh); pb |= (unsigned)(b & 15) << (8 * k + nsh); }
                pa |= __shfl_xor(pa, 1); pb |= __shfl_xor(pb, 1);
                if (!(lane & 1)) { unsigned* hp4 = (unsigned*)(P.ws + OFF_H8 + row * 1024) + (lane >> 1) + 32 * jx; hp4[0] = pa; hp4[128] = pb; }
            }
#pragma unroll
            for (int o = 1; o < 64; o <<= 1) qs += __shfl_xor(qs, o);
            if (lane == 0) *(f32x2*)(P.ws + OFF_HS + row * 8) = (f32x2){hs, (float)qs};
        }
    }
}

#define CE16(A, i, j) do { const float hi_ = fmaxf(A[i], A[j]); A[j] = fminf(A[i], A[j]); A[i] = hi_; } while (0)
#define SORT16(A) do { CE16(A, 0, 1); CE16(A, 2, 3); CE16(A, 0, 2); CE16(A, 1, 3); CE16(A, 1, 2); CE16(A, 4, 5); CE16(A, 6, 7); CE16(A, 4, 6); CE16(A, 5, 7); CE16(A, 5, 6); CE16(A, 0, 4); CE16(A, 2, 6); CE16(A, 2, 4); CE16(A, 1, 5); CE16(A, 3, 7); CE16(A, 3, 5); CE16(A, 1, 2); CE16(A, 3, 4); CE16(A, 5, 6); CE16(A, 8, 9); CE16(A, 10, 11); CE16(A, 8, 10); CE16(A, 9, 11); CE16(A, 9, 10); CE16(A, 12, 13); CE16(A, 14, 15); CE16(A, 12, 14); CE16(A, 13, 15); CE16(A, 13, 14); CE16(A, 8, 12); CE16(A, 10, 14); CE16(A, 10, 12); CE16(A, 9, 13); CE16(A, 11, 15); CE16(A, 11, 13); CE16(A, 9, 10); CE16(A, 11, 12); CE16(A, 13, 14); CE16(A, 0, 8); CE16(A, 4, 12); CE16(A, 4, 8); CE16(A, 2, 10); CE16(A, 6, 14); CE16(A, 6, 10); CE16(A, 2, 4); CE16(A, 6, 8); CE16(A, 10, 12); CE16(A, 1, 9); CE16(A, 5, 13); CE16(A, 5, 9); CE16(A, 3, 11); CE16(A, 7, 15); CE16(A, 7, 11); CE16(A, 3, 5); CE16(A, 7, 9); CE16(A, 11, 13); CE16(A, 1, 2); CE16(A, 3, 4); CE16(A, 5, 6); CE16(A, 7, 8); CE16(A, 9, 10); CE16(A, 11, 12); CE16(A, 13, 14); } while (0)
#define BITONIC16(A) do { CE16(A, 0, 8); CE16(A, 1, 9); CE16(A, 2, 10); CE16(A, 3, 11); CE16(A, 4, 12); CE16(A, 5, 13); CE16(A, 6, 14); CE16(A, 7, 15); CE16(A, 0, 4); CE16(A, 1, 5); CE16(A, 2, 6); CE16(A, 3, 7); CE16(A, 8, 12); CE16(A, 9, 13); CE16(A, 10, 14); CE16(A, 11, 15); CE16(A, 0, 2); CE16(A, 1, 3); CE16(A, 4, 6); CE16(A, 5, 7); CE16(A, 8, 10); CE16(A, 9, 11); CE16(A, 12, 14); CE16(A, 13, 15); CE16(A, 0, 1); CE16(A, 2, 3); CE16(A, 4, 5); CE16(A, 6, 7); CE16(A, 8, 9); CE16(A, 10, 11); CE16(A, 12, 13); CE16(A, 14, 15); } while (0)
#define INS16(L, xin) do { float x_ = (xin); _Pragma("unroll") for (int k_ = 0; k_ < 16; ++k_) { const float hi_ = fmaxf(L[k_], x_); x_ = fminf(L[k_], x_); L[k_] = hi_; } } while (0)

__device__ void peer_select_wave(const Params& P, size_t tok0) {
    const int lane = tid_opaque() & 63, r32 = lane & 31, hi = lane >> 5;
    const bf16_t* QP = (const bf16_t*)(P.ws + OFF_GB) + (tok0 + r32) * 1024; const bf16_t* SK = (const bf16_t*)(P.ws + OFF_SK);
    unsigned* EG = (unsigned*)(P.ws + OFF_EG) + (tok0 + r32) * 128;
#pragma unroll 1
    for (int h = 0; h < 8; ++h) {
        float a0[16], a1[16];
#pragma unroll
        for (int k = 0; k < 16; ++k) { a0[k] = -INFINITY; a1[k] = -INFINITY; }
#pragma unroll
        for (int p = 0; p < 2; ++p) {
            const int hp = h * 2 + p;
            bf16x8 qf[4];
#pragma unroll
            for (int ks = 0; ks < 4; ++ks) qf[ks] = *(const bf16x8*)(QP + hp * 64 + 16 * ks + 8 * hi);
            float L[16];
#pragma unroll
            for (int kt = 0; kt < 4; ++kt) {
                f32x16 acc = {};
#pragma unroll
                for (int ks = 0; ks < 4; ++ks) { const bf16x8 kf = *(const bf16x8*)(SK + ((size_t)hp * 128 + 32 * kt + r32) * 64 + 16 * ks + 8 * hi); acc = MFMA32(kf, qf[ks], acc); }
                float S[16];
#pragma unroll
                for (int r = 0; r < 16; ++r) { const unsigned key = (unsigned)(32 * kt + crow(r, hi)); S[r] = __uint_as_float((__float_as_uint(acc[r]) & ~127u) | key); }
                SORT16(S);
                if (kt == 0) {
#pragma unroll
                    for (int k = 0; k < 16; ++k) L[k] = S[k];
                } else {
#pragma unroll
                    for (int k = 0; k < 16; ++k) L[k] = fmaxf(L[k], S[15 - k]);
                    BITONIC16(L);
                }
            }
            {
                float O[16];
#pragma unroll
                for (int k = 0; k < 16; ++k) O[k] = __shfl_xor(L[15 - k], 32);
#pragma unroll
                for (int k = 0; k < 16; ++k) L[k] = fmaxf(L[k], O[k]);
                BITONIC16(L);
            }
#pragma unroll
            for (int k = 0; k < 16; ++k) { a0[k] = (p == 0) ? L[k] : a0[k]; a1[k] = (p == 1) ? L[k] : a1[k]; }
        }
        float best[16];
#pragma unroll
        for (int k = 0; k < 16; ++k) best[k] = __uint_as_float((__float_as_uint(a0[0] + a1[k]) & ~255u) | (unsigned)k);
#define PKC(i, j) __uint_as_float((__float_as_uint(a0[i] + a1[j]) & ~255u) | (unsigned)((i) * 16 + (j)))
        {
            float A[16] = {PKC(1, 0), PKC(1, 1), PKC(1, 2), PKC(1, 3), PKC(1, 4), PKC(1, 5), PKC(1, 6), PKC(1, 7), PKC(15, 0), PKC(14, 0), PKC(13, 0), PKC(12, 0), PKC(11, 0), PKC(10, 0), PKC(9, 0), PKC(8, 0)};
            BITONIC16(A);
#pragma unroll
            for (int k = 0; k < 16; ++k) best[k] = fmaxf(best[k], A[15 - k]);
            BITONIC16(best);
            float B[16] = {PKC(2, 0), PKC(2, 1), PKC(2, 2), PKC(2, 3), PKC(2, 4), PKC(3, 0), PKC(3, 1), PKC(3, 2), PKC(3, 3), PKC(4, 0), PKC(4, 1), PKC(4, 2), PKC(5, 0), PKC(5, 1), PKC(6, 0), PKC(6, 1)};
            SORT16(B);
#pragma unroll
            for (int k = 0; k < 16; ++k) best[k] = fmaxf(best[k], B[15 - k]);
            BITONIC16(best);
            INS16(best, PKC(7, 0)); INS16(best, PKC(7, 1));
        }
#undef PKC
        unsigned pk0[4], pk1[4];
#pragma unroll
        for (int q = 0; q < 4; ++q) {
            pk0[q] = (__float_as_uint(a0[4 * q]) & 127u) | ((__float_as_uint(a0[4 * q + 1]) & 127u) << 8) | ((__float_as_uint(a0[4 * q + 2]) & 127u) << 16) | ((__float_as_uint(a0[4 * q + 3]) & 127u) << 24);
            pk1[q] = (__float_as_uint(a1[4 * q]) & 127u) | ((__float_as_uint(a1[4 * q + 1]) & 127u) << 8) | ((__float_as_uint(a1[4 * q + 2]) & 127u) << 16) | ((__float_as_uint(a1[4 * q + 3]) & 127u) << 24);
        }
        unsigned pay[16];
#pragma unroll
        for (int k = 0; k < 16; ++k) {
            const unsigned code = __float_as_uint(best[k]) & 255u, ci = code >> 4, cj = code & 15u;
            const unsigned qi = ci >> 2, qj = cj >> 2;
            const unsigned w0 = (qi == 0u) ? pk0[0] : ((qi == 1u) ? pk0[1] : ((qi == 2u) ? pk0[2] : pk0[3]));
            const unsigned w1 = (qj == 0u) ? pk1[0] : ((qj == 1u) ? pk1[1] : ((qj == 2u) ? pk1[2] : pk1[3]));
            pay[k] = (((w0 >> ((ci & 3u) * 8u)) & 127u) << 7) | ((w1 >> ((cj & 3u) * 8u)) & 127u);
        }
        float e[16], es = 0.f;
#pragma unroll
        for (int k = 0; k < 16; ++k) { e[k] = __expf(best[k] - best[0]); es += e[k]; }
        const float inv = 1.0f / es;
        if (hi == 0) {
#pragma unroll
            for (int k = 0; k < 16; ++k) EG[h * 16 + k] = pay[k] | (cvt_pk_bf16(e[k] * inv, 0.f) << 16);
        }
    }
}
__device__ __forceinline__ unsigned xcc_id() { return (unsigned)__builtin_amdgcn_s_getreg((3 << 11) | 20) & 0xFu; }
__device__ __forceinline__ float dot16_fp8(const float (&hv)[16], const u32x4 r) {
    float s = 0.f;
    { const f32x2 a = __builtin_amdgcn_cvt_pk_f32_fp8((int)r.x, false), b = __builtin_amdgcn_cvt_pk_f32_fp8((int)r.x, true); s += hv[0] * a.x + hv[1] * a.y + hv[2] * b.x + hv[3] * b.y; }
    { const f32x2 a = __builtin_amdgcn_cvt_pk_f32_fp8((int)r.y, false), b = __builtin_amdgcn_cvt_pk_f32_fp8((int)r.y, true); s += hv[4] * a.x + hv[5] * a.y + hv[6] * b.x + hv[7] * b.y; }
    { const f32x2 a = __builtin_amdgcn_cvt_pk_f32_fp8((int)r.z, false), b = __builtin_amdgcn_cvt_pk_f32_fp8((int)r.z, true); s += hv[8] * a.x + hv[9] * a.y + hv[10] * b.x + hv[11] * b.y; }
    { const f32x2 a = __builtin_amdgcn_cvt_pk_f32_fp8((int)r.w, false), b = __builtin_amdgcn_cvt_pk_f32_fp8((int)r.w, true); s += hv[12] * a.x + hv[13] * a.y + hv[14] * b.x + hv[15] * b.y; }
    return s;
}
template <int NP, class F> __device__ __forceinline__ void partition_queue(const Params& P, LAS unsigned char* lds, int ctr_base, F f) {
    const int tid = tid_opaque();
    LAS int* slot = (LAS int*)(lds + LDS_BYTES - 64);
    unsigned* ctr = (unsigned*)(P.ws + OFF_CTR) + ctr_base;
    const int myx = (int)(xcc_id() & 7u);
    for (int pp = 0; pp < NP; ++pp) {
        const int p = (myx * (NP / 8) + pp) % NP;
        for (;;) {
            if (tid == 0) *slot = (int)atomicAdd(ctr + p, 1u);
            __syncthreads();
            const int item = *slot;
            __syncthreads();
            if (item >= NTOK / 64) break;
            f(p, item);
        }
    }
}
__device__ __forceinline__ float dot2bf(unsigned a, bf16v2 b, float c) { return __builtin_amdgcn_fdot2_f32_bf16(__builtin_bit_cast(bf16v2, a), b, c, false); }
__device__ __forceinline__ float gelu_erf(float v) {
    const float av = fabsf(v), t = __builtin_amdgcn_rcpf(__builtin_fmaf(av, 0.2316418882f, 1.0f));
    float q = __builtin_fmaf(t, 0.5307027145f, -0.7265760135f); q = __builtin_fmaf(q, t, 0.7107068705f); q = __builtin_fmaf(q, t, -0.142248368f); q = __builtin_fmaf(q, t, 0.127414796f); q = q * t;
    const float m = v * (q * __builtin_amdgcn_exp2f(v * v * -0.72134752044f));
    return v < 0.f ? m : v - m;
}
struct UQuad { u32x4 r[2]; u32x4 ent, nxt; };
__device__ __forceinline__ void uq_issue(UQuad& q, const LAS u32x4* list, int J, int NQ, int g, const unsigned char* Ub, const unsigned lo) {
    q.ent = q.nxt;
    const unsigned char* rp = Ub + (q.ent.x * 512u + lo);
    q.r[0] = *(const u32x4*)rp; q.r[1] = *(const u32x4*)(rp + 256);
    const int jj = J < NQ ? J : NQ - 1;
    q.nxt = list[4 * jj + g];
}
__device__ __forceinline__ float uq_dot(const UQuad& q, const u32x4 (&hp)[4]) {
    int a = 0, b = 0;
#pragma unroll
    for (int c = 0; c < 2; ++c) {
        const u32x4 r = q.r[c];
        a = __builtin_amdgcn_sdot8((int)hp[c].x, (int)r.x, a, false); a = __builtin_amdgcn_sdot8((int)hp[c].y, (int)r.y, a, false);
        a = __builtin_amdgcn_sdot8((int)hp[c].z, (int)r.z, a, false); a = __builtin_amdgcn_sdot8((int)hp[c].w, (int)r.w, a, false);
        b = __builtin_amdgcn_sdot8((int)hp[2 + c].x, (int)r.x, b, false); b = __builtin_amdgcn_sdot8((int)hp[2 + c].y, (int)r.y, b, false);
        b = __builtin_amdgcn_sdot8((int)hp[2 + c].z, (int)r.z, b, false); b = __builtin_amdgcn_sdot8((int)hp[2 + c].w, (int)r.w, b, false);
    }
    float s = (float)(16 * a + b);
    s = dpp_add<0xB1>(s); s = dpp_add<0x4E>(s); s = dpp_add<0x141>(s); s = dpp_add<0x140>(s);
    return s;
}
__device__ __forceinline__ void peer_u_tokens(const Params& P, LAS unsigned char* lds, const size_t t0) {
    const int tid = tid_opaque(), lane = tid & 63, wid = tid >> 6, g = lane >> 4, li = lane & 15;
    const unsigned char* H8 = P.ws + OFF_H8 + li * 16; const unsigned char* Ub = P.ws + OFF_U8; const unsigned lo16 = (unsigned)li * 16u;
    const f32x2* HS = (const f32x2*)(P.ws + OFF_HS); const float* USC = (const float*)(P.ws + OFF_USC);
    const u32x2* EG2 = (const u32x2*)(P.ws + OFF_EG); unsigned* W = (unsigned*)(P.ws + OFF_W);
    LAS u32x4* list = (LAS u32x4*)(lds + wid * 16384);
    {
        u32x2 egv[8]; float s0[8], s1[8];
#pragma unroll
        for (int i = 0; i < 8; ++i) egv[i] = EG2[(t0 + i) * 64 + lane];
#pragma unroll
        for (int i = 0; i < 8; ++i) { s0[i] = USC[egv[i].x & 0xFFFFu]; s1[i] = USC[egv[i].y & 0xFFFFu]; }
#pragma unroll
        for (int i = 0; i < 8; ++i) {
            list[i * 128 + 2 * lane] = (u32x4){egv[i].x & 0xFFFFu, egv[i].x & 0xFFFF0000u, (unsigned)(2 * lane) | (unsigned)(i << 8), __float_as_uint(s0[i])};
            list[i * 128 + 2 * lane + 1] = (u32x4){egv[i].y & 0xFFFFu, egv[i].y & 0xFFFF0000u, (unsigned)(2 * lane + 1) | (unsigned)(i << 8), __float_as_uint(s1[i])};
        }
    }
    constexpr int NQ = 256;
    u32x4 hp[4], hn[4]; f32x2 hsc = HS[t0], hsn = HS[t0 + 1];
#pragma unroll
    for (int c = 0; c < 2; ++c) { hp[c] = *(const u32x4*)(H8 + t0 * 1024 + 256 * c); hp[2 + c] = *(const u32x4*)(H8 + t0 * 1024 + 512 + 256 * c);
                                  hn[c] = *(const u32x4*)(H8 + (t0 + 1) * 1024 + 256 * c); hn[2 + c] = *(const u32x4*)(H8 + (t0 + 1) * 1024 + 512 + 256 * c); }
    int curtok = 0;
    UQuad q0, q1, q2, q3, q4, q5, q6, q7;
    q0.nxt = list[g]; q1.nxt = list[4 + g]; q2.nxt = list[8 + g]; q3.nxt = list[12 + g]; q4.nxt = list[16 + g]; q5.nxt = list[20 + g]; q6.nxt = list[24 + g]; q7.nxt = list[28 + g];
    uq_issue(q0, list, 8, NQ, g, Ub, lo16); uq_issue(q1, list, 9, NQ, g, Ub, lo16); uq_issue(q2, list, 10, NQ, g, Ub, lo16); uq_issue(q3, list, 11, NQ, g, Ub, lo16);
    uq_issue(q4, list, 12, NQ, g, Ub, lo16); uq_issue(q5, list, 13, NQ, g, Ub, lo16); uq_issue(q6, list, 14, NQ, g, Ub, lo16); uq_issue(q7, list, 15, NQ, g, Ub, lo16);
    float sv = 0.f; unsigned gv = 0u, zv = 0u, ev = 0u;
#define UQ_PIN(q) asm volatile("" : "+v"(q.r[0]), "+v"(q.r[1]) :: "memory")
#define UQ_STEP(q, Jn, kq, qn) do { \
        const float s = __uint_as_float(q.ent.w) * hsc.x * (uq_dot(q, hp) + 0.5f * hsc.y); \
        if (li == (kq)) { sv = s; gv = q.ent.y; zv = q.ent.z; ev = q.ent.x; } \
        uq_issue(q, list, (Jn), NQ, g, Ub, lo16); UQ_PIN(qn); } while (0)
    UQ_PIN(q0);
#pragma unroll 1
    for (int J = 0; J < NQ; J += 8) {
        const int tk = __builtin_amdgcn_readfirstlane((int)(q0.ent.z >> 8));
        if (tk != curtok) { curtok = tk;
#pragma unroll
            for (int c = 0; c < 4; ++c) hp[c] = hn[c];
            hsc = hsn;
            if (tk + 1 < 8) { hsn = HS[t0 + tk + 1];
#pragma unroll
                for (int c = 0; c < 2; ++c) { hn[c] = *(const u32x4*)(H8 + (t0 + tk + 1) * 1024 + 256 * c); hn[2 + c] = *(const u32x4*)(H8 + (t0 + tk + 1) * 1024 + 512 + 256 * c); } } }
        UQ_STEP(q0, J + 16, 0, q1); UQ_STEP(q1, J + 17, 1, q2); UQ_STEP(q2, J + 18, 2, q3); UQ_STEP(q3, J + 19, 3, q4);
        UQ_STEP(q4, J + 20, 4, q5); UQ_STEP(q5, J + 21, 5, q6); UQ_STEP(q6, J + 22, 6, q7); UQ_STEP(q7, J + 23, 7, q0);
        if (li < 8) W[(t0 + tk) * 128 + (zv & 255u)] = ev | (cvt_pk_bf16(__uint_as_float(gv) * gelu_erf(sv), 0.f) << 16); }
#undef UQ_STEP
}
typedef int v4i_t __attribute__((ext_vector_type(4)));
struct VQuad { u32x4 r[2]; u32x2 ent, nxt; };
__device__ __forceinline__ void vq_issue(VQuad& q, const LAS u32x2* list, int J, int g, const unsigned char* Vb, const unsigned lo) {
    q.ent = q.nxt;
    const unsigned char* rp = Vb + (q.ent.x * 512u + lo);
    q.r[0] = *(const u32x4*)rp; q.r[1] = *(const u32x4*)(rp + 256);
    const int jj = J < 256 ? J : 255;
    q.nxt = list[4 * jj + g];
}
#define VQ_PIN(q) asm volatile("" : "+v"(q.r[0]), "+v"(q.r[1]) :: "memory")
__device__ __forceinline__ void vq_mma(const VQuad& q, v4i_t (&acc)[4], const u32x4 bm) {
    const unsigned t = q.ent.y;
    const v4i_t B = {(int)(t & bm.x), (int)(t & bm.y), (int)(t & bm.z), (int)(t & bm.w)};
#pragma unroll
    for (int c = 0; c < 2; ++c) {
        const u32x4 r = q.r[c];
        const v4i_t lo = {(int)(r.x & 0x0F0F0F0Fu), (int)(r.y & 0x0F0F0F0Fu), (int)(r.z & 0x0F0F0F0Fu), (int)(r.w & 0x0F0F0F0Fu)};
        const v4i_t raw = {(int)r.x, (int)r.y, (int)r.z, (int)r.w};
        acc[2 * c] = __builtin_amdgcn_mfma_i32_16x16x64_i8(lo, B, acc[2 * c], 0, 0, 0);
        acc[2 * c + 1] = __builtin_amdgcn_mfma_i32_16x16x64_i8(raw, B, acc[2 * c + 1], 0, 0, 0);
    }
}
__device__ __forceinline__ void peer_v_tokens(const Params& P, LAS unsigned char* lds, const size_t t0) {
    const int tid = tid_opaque(), lane = tid & 63, wid = tid >> 6, g = lane >> 4, li = lane & 15;
    const unsigned char* Vb = P.ws + OFF_V8; const unsigned lo16 = (unsigned)li * 16u; const float* VSC = (const float*)(P.ws + OFF_VSC);
    const u32x2* W2 = (const u32x2*)(P.ws + OFF_W);
    LAS u32x2* lists = (LAS u32x2*)(lds + wid * 8192);
    LAS f32x2* tokp = (LAS f32x2*)(lds + 65536 + wid * 64);
    {
        u32x2 egv[8]; f32x2 wwv[8];
#pragma unroll
        for (int i = 0; i < 8; ++i) { const u32x2 ew = W2[(t0 + i) * 64 + lane]; egv[i].x = ew.x & 0xFFFFu; egv[i].y = ew.y & 0xFFFFu; wwv[i] = (f32x2){__uint_as_float(ew.x & 0xFFFF0000u), __uint_as_float(ew.y & 0xFFFF0000u)}; }
        float w0v[8], w1v[8];
#pragma unroll
        for (int i = 0; i < 8; ++i) { w0v[i] = wwv[i].x * VSC[egv[i].x]; w1v[i] = wwv[i].y * VSC[egv[i].y]; }
#pragma unroll
        for (int i = 0; i < 8; ++i) {
            const float mx = wave_max_fast(fmaxf(fabsf(w0v[i]), fabsf(w1v[i])));
            const float sw = fmaxf(mx * (1.0f / 127.0f), 1e-30f), inv = 1.0f / sw;
            const int q0 = (int)rintf(w0v[i] * inv), q1 = (int)rintf(w1v[i] * inv);
            *(LAS u32x4*)(lists + i * 128 + 2 * lane) = (u32x4){egv[i].x, ((unsigned)q0 & 255u) * 0x01010101u, egv[i].y, ((unsigned)q1 & 255u) * 0x01010101u};
            const int qs = wave_sum_int_fast(q0 + q1);
            if (lane == 0) tokp[i] = (f32x2){sw, 7.5f * sw * (float)qs}; }
    }
    const unsigned bsel = 0xFFu << (8u * (unsigned)(li & 3));
    const u32x4 bm = {(li >> 2) == 0 ? bsel : 0u, (li >> 2) == 1 ? bsel : 0u, (li >> 2) == 2 ? bsel : 0u, (li >> 2) == 3 ? bsel : 0u};
    const int dbase = 128 * g + 8 * (li >> 2) + (li & 3);
    float gt2v[16], lgv[16], lbv[16];
    { const float* gt2 = (const float*)(P.ws + OFF_ADA) + (t0 >> 11) * 6144 + 5120;
#pragma unroll
      for (int c = 0; c < 2; ++c)
#pragma unroll
          for (int hf = 0; hf < 2; ++hf)
#pragma unroll
              for (int r = 0; r < 4; ++r) { const int d = dbase + 512 * c + 32 * r + 4 * hf, e = 8 * c + 4 * hf + r; gt2v[e] = gt2[d]; lgv[e] = P.ln2_g[d]; lbv[e] = P.ln2_b[d]; } }
    VQuad q0, q1, q2, q3, q4, q5, q6, q7;
    q0.nxt = lists[g]; q1.nxt = lists[4 + g]; q2.nxt = lists[8 + g]; q3.nxt = lists[12 + g]; q4.nxt = lists[16 + g]; q5.nxt = lists[20 + g]; q6.nxt = lists[24 + g]; q7.nxt = lists[28 + g];
    vq_issue(q0, lists, 8, g, Vb, lo16); vq_issue(q1, lists, 9, g, Vb, lo16); vq_issue(q2, lists, 10, g, Vb, lo16); vq_issue(q3, lists, 11, g, Vb, lo16);
    vq_issue(q4, lists, 12, g, Vb, lo16); vq_issue(q5, lists, 13, g, Vb, lo16); vq_issue(q6, lists, 14, g, Vb, lo16); vq_issue(q7, lists, 15, g, Vb, lo16);
    VQ_PIN(q0);
#pragma unroll 1
    for (int i = 0; i < 8; ++i) {
        const size_t t = t0 + i;
        v4i_t acc[4];
#pragma unroll
        for (int j = 0; j < 4; ++j) acc[j] = (v4i_t){0, 0, 0, 0};
        float* xr = P.out + t * 1024;
        float xv[16];
#pragma unroll
        for (int c = 0; c < 2; ++c)
#pragma unroll
            for (int hf = 0; hf < 2; ++hf)
#pragma unroll
                for (int r = 0; r < 4; ++r) xv[8 * c + 4 * hf + r] = __uint_as_float((unsigned)((const bf16_t*)xr)[dbase + 512 * c + 32 * r + 4 * hf] << 16);
#pragma unroll 1
        for (int J = 32 * i; J < 32 * i + 32; J += 8) {
            vq_mma(q0, acc, bm); vq_issue(q0, lists, J + 16, g, Vb, lo16); VQ_PIN(q1);
            vq_mma(q1, acc, bm); vq_issue(q1, lists, J + 17, g, Vb, lo16); VQ_PIN(q2);
            vq_mma(q2, acc, bm); vq_issue(q2, lists, J + 18, g, Vb, lo16); VQ_PIN(q3);
            vq_mma(q3, acc, bm); vq_issue(q3, lists, J + 19, g, Vb, lo16); VQ_PIN(q4);
            vq_mma(q4, acc, bm); vq_issue(q4, lists, J + 20, g, Vb, lo16); VQ_PIN(q5);
            vq_mma(q5, acc, bm); vq_issue(q5, lists, J + 21, g, Vb, lo16); VQ_PIN(q6);
            vq_mma(q6, acc, bm); vq_issue(q6, lists, J + 22, g, Vb, lo16); VQ_PIN(q7);
            vq_mma(q7, acc, bm); vq_issue(q7, lists, J + 23, g, Vb, lo16); VQ_PIN(q0);
        }
        const f32x2 tp = tokp[i]; const float sw = tp.x, yoff = tp.y;
        float pre[16]; float s = 0.f;
#pragma unroll
        for (int c = 0; c < 2; ++c)
#pragma unroll
            for (int hf = 0; hf < 2; ++hf)
#pragma unroll
                for (int r = 0; r < 4; ++r) { const int e = 8 * c + 4 * hf + r;
                    const float yv = hf == 0 ? sw * (float)acc[2 * c][r] - yoff : (sw * 0.0625f) * (float)(acc[2 * c + 1][r] - acc[2 * c][r]) + yoff * (1.0f / 15.0f);
                    const float pv = ALPHA * xv[e] + gt2v[e] * yv; pre[e] = pv; s += pv; }
        const float mean = wave_sum_fast(s) * (1.0f / 1024.0f); float s2 = 0.f;
#pragma unroll
        for (int e = 0; e < 16; ++e) { pre[e] -= mean; s2 += pre[e] * pre[e]; }
        const float rstd = rsqrtf(wave_sum_fast(s2) * (1.0f / 1024.0f) + LN_EPS);
#pragma unroll
        for (int c = 0; c < 2; ++c)
#pragma unroll
            for (int hf = 0; hf < 2; ++hf)
#pragma unroll
                for (int r = 0; r < 4; ++r) { const int e = 8 * c + 4 * hf + r;
                    xr[dbase + 512 * c + 32 * r + 4 * hf] = pre[e] * rstd * lgv[e] + lbv[e]; }
    }
}

#define XB_TMO      128
#define XB_XCNT(j)  (256  + 64 * (j))
#define XB_XSUB(j)  (1280 + 64 * (j))
#define XB_XGEN(j)  (2304 + 64 * (j))
#define XB_TOP      3328
#define XB_TOPGEN   3392
#define XCD_BAR_WORDS 3456
#define XB_SPIN_CAP (1u << 22)
__device__ __forceinline__ unsigned xb_ld(unsigned* p)              { return __hip_atomic_load(p, __ATOMIC_RELAXED, __HIP_MEMORY_SCOPE_AGENT); }
__device__ __forceinline__ unsigned xb_add(unsigned* p, unsigned v) { return __hip_atomic_fetch_add(p, v, __ATOMIC_RELAXED, __HIP_MEMORY_SCOPE_AGENT); }
#define XB_SPIN(cond, bar) do { unsigned _sp = 0; while (cond) { __builtin_amdgcn_s_sleep(1); \
    if ((++_sp & 255u) == 0u) { if (xb_ld(&(bar)[XB_TMO])) break; if (_sp > XB_SPIN_CAP) { atomicAdd(&(bar)[XB_TMO], 1u); break; } } } } while (0)
struct XcdBarrier { unsigned* bar; unsigned x; volatile LAS unsigned* st; };
__device__ __forceinline__ XcdBarrier xcd_barrier_post(unsigned* bar, volatile LAS unsigned* st) {
    XcdBarrier b; b.bar = bar; b.x = xcc_id(); b.st = st;
    if (threadIdx.x == 0) (void)xb_add(&bar[XB_XCNT(b.x)], 1u);
    return b;
}
__device__ __forceinline__ void xcd_barrier_complete(unsigned* bar, unsigned x, unsigned& nloc, unsigned& nx) {
    const unsigned G = gridDim.x * gridDim.y * gridDim.z;
    unsigned sum, cnt, mine, sp = 0u;
    for (;;) {
        sum = 0u; cnt = 0u; mine = 0u;
#pragma unroll
        for (unsigned j = 0; j < 16; ++j) { const unsigned c = xb_ld(&bar[XB_XCNT(j)]); sum += c; cnt += (c > 0u) ? 1u : 0u; mine = (j == x) ? c : mine; }
        if (sum == G) break;
        __builtin_amdgcn_s_sleep(1);
        if ((++sp & 255u) == 0u) { if (xb_ld(&bar[XB_TMO])) break; if (sp > XB_SPIN_CAP) { atomicAdd(&bar[XB_TMO], 1u); break; } }
    }
    nloc = mine > 0u ? mine : 1u; nx = cnt > 0u ? cnt : 1u;
}
__device__ __forceinline__ void xcd_barrier(const XcdBarrier& b) {
    asm volatile("s_waitcnt vmcnt(0)" ::: "memory");
    __syncthreads();
    if (threadIdx.x == 0) {
        unsigned* bar = b.bar;
        __builtin_amdgcn_s_waitcnt(0);
        unsigned nloc = b.st[0], nx = b.st[1];
        if (nloc == 0u) { xcd_barrier_complete(bar, b.x, nloc, nx); b.st[0] = nloc; b.st[1] = nx; }
        const unsigned old = xb_add(&bar[XB_XSUB(b.x)], 1u);
        const unsigned gen = old / nloc;
        if (old + 1u == (gen + 1u) * nloc) {
            __builtin_amdgcn_fence(__ATOMIC_RELEASE, "agent");
            asm volatile("s_waitcnt vmcnt(0)" ::: "memory");
            const unsigned og = xb_add(&bar[XB_TOP], 1u);
            const unsigned tg = og / nx;
            if (og + 1u == (tg + 1u) * nx) xb_add(&bar[XB_TOPGEN], 1u);
            else XB_SPIN(xb_ld(&bar[XB_TOPGEN]) == tg, bar);
            __builtin_amdgcn_fence(__ATOMIC_ACQUIRE, "agent");
            xb_add(&bar[XB_XGEN(b.x)], 1u);
            asm volatile("s_waitcnt vmcnt(0)" ::: "memory");
        } else {
            XB_SPIN(xb_ld(&bar[XB_XGEN(b.x)]) == gen, bar);
            __builtin_amdgcn_fence(__ATOMIC_ACQUIRE, "agent");
            asm volatile("s_waitcnt vmcnt(0)" ::: "memory");
        }
    }
    __syncthreads();
}

__global__ void __launch_bounds__(NTHR, 2) fwd_megakernel(Params P) {
    extern __shared__ __attribute__((aligned(16))) unsigned char shm[];
    LAS unsigned char* lds = (LAS unsigned char*)shm;
    cg::grid_group grid = cg::this_grid();
    const int G = gridDim.x, bid = blockIdx.x;
    volatile LAS unsigned* xst = (volatile LAS unsigned*)(lds + LDS_BYTES - 128);
    if (threadIdx.x == 0) { xst[0] = 0u; xst[1] = 0u; }
    __syncthreads();
    const XcdBarrier xb = xcd_barrier_post((unsigned*)(P.ws + OFF_BAR), xst);

#ifndef P3
#define P3 0xff
#endif
#ifndef PH
#define PH 0xff
#endif
    if (PH & 1) phase0a(P, lds);
    grid.sync();
    if (PH & 2) phase0b(P);
    xcd_barrier(xb);
    if (PH & 4) {
        pg8::Gemm g; g.A = (const bf16_t*)(P.ws + OFF_H); g.Bt = (const bf16_t*)(P.ws + OFF_WIN); g.M = NTOK; g.N = INCOLS; { int k_ = 512; asm volatile("" : "+s"(k_)); g.K = k_; g.lda = k_; }
        pg8::StaticOrder S; S.init(NTOK, INCOLS, G, bid);
        EpiProj E; E.ws = P.ws; E.lb = (const float*)(P.ws + OFF_LB); E.ng = P.hgrn_ng; E.kmean = (float*)(P.ws + OFF_KMEAN);
        pg8::gemm_phase<EpiProj, pg8::StaticOrder, true>(lds, g, S, E);
    }
    xcd_barrier(xb);
    if (PH & 8) for (int it = bid; it < 256; it += G) hgrn_item(P, it, lds);
    if (PH & 16) for (int u = bid; u < 2048; u += G) { const int bh = u & 255, jj = u >> 8; moba_unit(P, bh >> 3, bh & 7, (jj + bh) & 7, lds); }
    xcd_barrier(xb);
    if ((PH & 32) && bid < NTOK / 256) { const int pm = bid;
        if (P3 & 1) yb_norm_panel(P, pm);
        __syncthreads();
        if (P3 & 2) { pg8::Gemm g; g.A = (const bf16_t*)(P.ws + OFF_EG); g.Bt = (const bf16_t*)(P.ws + OFF_WBA); g.M = NTOK; g.N = 1024; { int k_ = 256; asm volatile("" : "+s"(k_)); g.K = k_; } g.lda = 512;
          pg8::PanelOrder S; S.pm = pm; S.npn = 4; EpiMixA E; E.GA = P.ws + OFF_GA;
          pg8::gemm_phase<EpiMixA, pg8::PanelOrder, true>(lds, g, S, E); }
        __syncthreads();
        if (P3 & 4) { pg8::Gemm g; g.A = (const bf16_t*)(P.ws + OFF_EG + 512); g.Bt = (const bf16_t*)(P.ws + OFF_WBB); g.M = NTOK; g.N = 1024; { int k_ = 256; asm volatile("" : "+s"(k_)); g.K = k_; } g.lda = 512;
          pg8::PanelOrder S; S.pm = pm; S.npn = 4; EpiMixB E; E.GA = P.ws + OFF_GA; E.GB = P.ws + OFF_GB; E.M8 = P.ws + OFF_QA;
          pg8::gemm_phase<EpiMixB, pg8::PanelOrder, true>(lds, g, S, E); }
        __syncthreads();
        if (P3 & 8) { pg8::Gemm g; g.A = (const bf16_t*)(P.ws + OFF_QA); g.Bt = (const bf16_t*)(P.ws + OFF_WOUT); g.M = NTOK; g.N = 1024; { int k_ = 512; asm volatile("" : "+s"(k_)); g.K = k_; g.lda = k_; }
          pg8::PanelOrder S; S.pm = pm; S.npn = 4; EpiOut E; E.ada = (const float*)(P.ws + OFF_ADA); E.D = (bf16_t*)(P.ws + OFF_GB);
          pg8::gemm_phase<EpiOut, pg8::PanelOrder, true>(lds, g, S, E); }
        __syncthreads();
        if (P3 & 16) ln1_panel(P, pm);
        __syncthreads();
        if (P3 & 32) { pg8::Gemm g; g.A = (const bf16_t*)(P.ws + OFF_H); g.Bt = (const bf16_t*)(P.ws + OFF_WQ); g.M = NTOK; g.N = 1024; g.K = 1024; g.lda = 1024;
          pg8::PanelOrder S; S.pm = pm; S.npn = 4; EpiBf16 E; E.O = (bf16_t*)(P.ws + OFF_GB);
          pg8::gemm_phase<EpiBf16, pg8::PanelOrder>(lds, g, S, E); }
        __syncthreads();
        { const size_t tok0 = (size_t)pm * 256 + (tid_opaque() >> 6) * 32;
          peer_select_wave(P, tok0);
          __syncthreads();
#pragma unroll 1
          for (int sb = 0; sb < 4; ++sb) {
              peer_u_tokens(P, lds, tok0 + 8 * sb);
              __syncthreads();
              peer_v_tokens(P, lds, tok0 + 8 * sb);
              __syncthreads();
          } }
    }
}

extern "C" void kernel_launch(void* const* d_in, const int* in_sizes, int n_in, void* d_out, int out_size, void* d_ws, size_t ws_size, hipStream_t stream) {
    static int grid_blocks = 0;
    if (grid_blocks == 0) {
        if (n_in != 18 || out_size != NTOK * DM || ws_size < WS_END) { fprintf(stderr, "kernel_launch: unexpected shapes (n_in %d, out %d, ws %zu, need %zu)\n", n_in, out_size, ws_size, (size_t)WS_END); grid_blocks = -1; return; }
        int dev = 0, cus = 0, per_cu = 0;
        hipGetDevice(&dev);
        hipDeviceGetAttribute(&cus, hipDeviceAttributeMultiprocessorCount, dev);
        if (hipFuncSetAttribute((const void*)fwd_megakernel, hipFuncAttributeMaxDynamicSharedMemorySize, LDS_BYTES) != hipSuccess) fprintf(stderr, "kernel_launch: hipFuncSetAttribute failed\n");
        hipOccupancyMaxActiveBlocksPerMultiprocessor(&per_cu, (const void*)fwd_megakernel, NTHR, LDS_BYTES);
        if (per_cu < 1) { fprintf(stderr, "kernel_launch: occupancy query says %d blocks per CU\n", per_cu); per_cu = 1; }
        if (per_cu > 1) per_cu = 1;
        grid_blocks = cus * per_cu;
        if (grid_blocks != NTOK / 256) { fprintf(stderr, "kernel_launch: built for a %d-CU device (one 256-token panel per workgroup), found %d\n", NTOK / 256, grid_blocks); grid_blocks = -1; return; }
        (void)hipGetLastError();
    }
    if (grid_blocks < 0) return;
    Params p{};
    p.x = (const float*)d_in[0]; p.c = (const float*)d_in[1]; p.w_ada = (const float*)d_in[2]; p.b_ada = (const float*)d_in[3]; p.w_in = (const float*)d_in[4];
    p.w_ba = (const float*)d_in[5]; p.w_bb = (const float*)d_in[6]; p.w_out = (const float*)d_in[7]; p.hgrn_lb = (const float*)d_in[8]; p.hgrn_ng = (const float*)d_in[9];
    p.ln1_g = (const float*)d_in[10]; p.ln1_b = (const float*)d_in[11]; p.peer_wq = (const float*)d_in[12]; p.peer_sk = (const float*)d_in[13]; p.peer_u = (const float*)d_in[14];
    p.peer_v = (const float*)d_in[15]; p.ln2_g = (const float*)d_in[16]; p.ln2_b = (const float*)d_in[17];
    p.out = (float*)d_out; p.ws = (unsigned char*)d_ws;
    if (hipMemsetAsync((char*)d_ws + OFF_BAR, 0, XCD_BAR_WORDS * 4, stream) != hipSuccess) fprintf(stderr, "kernel_launch: memset of the barrier words failed\n");
    void* args[] = {&p};
    hipError_t e = hipLaunchCooperativeKernel((const void*)fwd_megakernel, dim3(grid_blocks), dim3(NTHR), args, LDS_BYTES, stream);
    if (e != hipSuccess) fprintf(stderr, "cooperative launch failed: %s (grid %d)\n", hipGetErrorString(e), grid_blocks);
}
```

```cpp
#include <hip/hip_runtime.h>
#include <hip/hip_cooperative_groups.h>
#include <cstdio>
#include <cstdint>
#include <type_traits>
namespace cg = cooperative_groups;

#define LAS __attribute__((address_space(3)))
typedef unsigned short bf16_t;
typedef short bf16x8 __attribute__((ext_vector_type(8)));
typedef short s16x4 __attribute__((ext_vector_type(4)));
typedef float f32x2 __attribute__((ext_vector_type(2)));
typedef float f32x4 __attribute__((ext_vector_type(4)));
typedef float f32x16 __attribute__((ext_vector_type(16)));
typedef unsigned u32x2 __attribute__((ext_vector_type(2)));
typedef unsigned u32x4 __attribute__((ext_vector_type(4)));

constexpr int NB = 32, SEQ = 2048, DM = 1024, NTOK = NB * SEQ;
constexpr int INCOLS = 5632;
constexpr int NTHR = 512;
constexpr int LDS_BYTES = 147456;
constexpr float ALPHA = 1.189207115002721f;
constexpr float LN_EPS = 1e-5f, RMS_EPS = 1e-6f;
constexpr float LOG2E = 1.4426950408889634f;

constexpr size_t SZ_T512 = (size_t)NTOK * 512 * 2, SZ_T1024 = (size_t)NTOK * 1024 * 2;
constexpr size_t OFF_ADA = 0;
constexpr size_t OFF_LB = OFF_ADA + 786432;
constexpr size_t OFF_KMEAN = OFF_LB + 4096;
constexpr size_t OFF_WIN = OFF_KMEAN + 524288;
constexpr size_t OFF_WBA = OFF_WIN + (size_t)5632 * 1024 * 2;
constexpr size_t OFF_WBB = OFF_WBA + 1048576;
constexpr size_t OFF_WOUT = OFF_WBB + 1048576;
constexpr size_t OFF_WQ = OFF_WOUT + 2097152;
constexpr size_t OFF_SK = OFF_WQ + 2097152;
constexpr size_t OFF_U8 = OFF_SK + 262144;
constexpr size_t OFF_USC = OFF_U8 + 8388608;
constexpr size_t OFF_V8 = OFF_U8 + 16777216;
constexpr size_t OFF_VSC = OFF_V8 + 8388608;
constexpr size_t OFF_CTR = OFF_V8 + 16777216;
constexpr size_t OFF_BAR = OFF_CTR + 4096;
constexpr size_t OFF_EG = OFF_BAR + 16384;
constexpr size_t OFF_H = OFF_EG + (size_t)NTOK * 128 * 8;
constexpr size_t OFF_QA = OFF_H + SZ_T1024;
constexpr size_t OFF_KA = OFF_QA + SZ_T512;
constexpr size_t OFF_VA = OFF_KA + SZ_T512;
constexpr size_t OFF_HQ = OFF_VA + SZ_T512;
constexpr size_t OFF_HK = OFF_HQ + SZ_T512;
constexpr size_t OFF_HI = OFF_HK + SZ_T512;
constexpr size_t OFF_HG = OFF_HI + SZ_T512;
constexpr size_t OFF_GA = OFF_HG + SZ_T512;
constexpr size_t OFF_GB = OFF_GA + SZ_T1024;
constexpr size_t WS_END = OFF_GB + SZ_T1024;
constexpr size_t OFF_H8 = OFF_VA;
constexpr size_t OFF_HS = OFF_HQ;
constexpr size_t OFF_W = OFF_KA;
constexpr size_t OFF_Y = OFF_KA;

struct Params {
    const float *x, *c, *w_ada, *b_ada, *w_in, *w_ba, *w_bb, *w_out, *hgrn_lb, *hgrn_ng, *ln1_g, *ln1_b, *peer_wq, *peer_sk, *peer_u, *peer_v, *ln2_g, *ln2_b;
    float* out;
    unsigned char* ws;
};

typedef __bf16 bf16v2 __attribute__((ext_vector_type(2)));
__device__ __forceinline__ unsigned cvt_pk_bf16(float lo, float hi) { return __builtin_bit_cast(unsigned, __builtin_convertvector((f32x2){lo, hi}, bf16v2)); }
__device__ __forceinline__ float bf_lo(unsigned w) { return __uint_as_float(w << 16); }
__device__ __forceinline__ float bf_hi(unsigned w) { return __uint_as_float(w & 0xffff0000u); }
__device__ __forceinline__ float sigmoidf_(float x) { return __builtin_amdgcn_rcpf(1.0f + __builtin_amdgcn_exp2f(-LOG2E * x)); }
__device__ __forceinline__ float wave_sum(float v) {
#pragma unroll
    for (int o = 1; o < 64; o <<= 1) v += __shfl_xor(v, o);
    return v;
}
template <int CTRL> __device__ __forceinline__ float dpp_add(float x) { const int v = __builtin_amdgcn_update_dpp(0, __float_as_int(x), CTRL, 0xf, 0xf, true); return x + __int_as_float(v); }
__device__ __forceinline__ float wave_sum_fast(float x) {
    x = dpp_add<0xB1>(x); x = dpp_add<0x4E>(x); x = dpp_add<0x141>(x); x = dpp_add<0x140>(x);
    x += __shfl_xor(x, 16); x += __shfl_xor(x, 32); return x;
}
template <int CTRL> __device__ __forceinline__ float dpp_max(float x) { const int v = __builtin_amdgcn_update_dpp(0, __float_as_int(x), CTRL, 0xf, 0xf, true); return fmaxf(x, __int_as_float(v)); }
template <int CTRL> __device__ __forceinline__ int dpp_addi(int x) { return x + __builtin_amdgcn_update_dpp(0, x, CTRL, 0xf, 0xf, true); }
__device__ __forceinline__ float wave_max_fast(float x) {
    x = dpp_max<0xB1>(x); x = dpp_max<0x4E>(x); x = dpp_max<0x141>(x); x = dpp_max<0x140>(x);
    x = fmaxf(x, __shfl_xor(x, 16)); x = fmaxf(x, __shfl_xor(x, 32)); return x;
}
__device__ __forceinline__ int wave_sum_int_fast(int x) {
    x = dpp_addi<0xB1>(x); x = dpp_addi<0x4E>(x); x = dpp_addi<0x141>(x); x = dpp_addi<0x140>(x);
    x += __shfl_xor(x, 16); x += __shfl_xor(x, 32); return x;
}
__device__ __forceinline__ int tid_opaque() { int t = threadIdx.x; asm volatile("" : "+v"(t)); return t; }
__device__ __forceinline__ int crow(int r, int hi) { return (r & 3) + 8 * (r >> 2) + 4 * hi; }
#define MFMA32(a, b, c) __builtin_amdgcn_mfma_f32_32x32x16_bf16(a, b, c, 0, 0, 0)

namespace pg8 {
constexpr int BM = 256, BK = 64, HALF = 128, HTB = HALF * BK * 2, STAGE_BYTES = 8 * HTB, NXCD = 8, WGM = 8;
__host__ __device__ __forceinline__ int lds_byte(int r, int c) { const int st = (r >> 4) * 2 + (c >> 5), rr = r & 15, cc = c & 31, ob = rr * 64 + cc * 2; return st * 1024 + (ob ^ (((ob >> 9) & 1) << 5)); }
__host__ __device__ __forceinline__ void stage_rc(int b, int& R, int& C) { const int st = b / 1024, sb = b % 1024, swz = sb ^ (((sb >> 9) & 1) << 5); R = (st >> 1) * 16 + swz / 64; C = (st & 1) * 32 + (swz % 64) / 2; }
__host__ __device__ __forceinline__ int perm32(int rho) { const int n = rho >> 4, i = rho & 15; return 8 * (i >> 2) + 4 * n + (i & 3); }

struct Unit { int pm, pn; };
struct Gemm { const bf16_t* A; const bf16_t* Bt; int M, N, K, lda; };

struct StaticOrder {
    int nM, nN, nwg, G, c;
    __device__ void init(int M, int N, int G_, int c_) { nM = M / BM; nN = N / BM; nwg = nM * nN; G = G_; c = c_; }
    __device__ bool next(int i, Unit& u) const {
        const long L = (long)i * G + c; if (L >= nwg) return false;
        int wgid = (int)L; { const int q = nwg / NXCD, r = nwg % NXCD, xcd = wgid % NXCD, off = wgid / NXCD; wgid = (xcd < r ? xcd * (q + 1) : r * (q + 1) + (xcd - r) * q) + off; }
        const int nig = WGM * nN, gid = wgid / nig, fm = gid * WGM, gsz = (nM - fm) < WGM ? (nM - fm) : WGM;
        u.pm = fm + ((wgid % nig) % gsz); u.pn = (wgid % nig) / gsz; return true;
    }
};
struct PanelOrder {
    int pm, npn;
    __device__ bool next(int i, Unit& u) const { if (i >= npn) return false; u.pm = pm; u.pn = i; return true; }
};

template <class Epi, class Sched, bool MX = false>
__device__ __forceinline__ void gemm_phase(LAS unsigned char* lds, const Gemm g, const Sched& S, const Epi& E) {
    const int tid = tid_opaque(), wid = __builtin_amdgcn_readfirstlane(tid >> 6), lane = tid & 63, wr = wid >> 2, wc = wid & 3, fr = lane & 15, fq = lane >> 4;
    const int K = g.K, nt = K / BK;
    unsigned voffA, voffB;
    { int R, C; stage_rc(tid * 16, R, C); const int Rb = Epi::PERM ? ((R & ~31) + perm32(R & 31)) : R;
      voffA = (unsigned)(R * g.lda + C) * 2u; voffB = (unsigned)(Rb * K + C) * 2u; }
    const size_t rvoffA = (size_t)128 * g.lda, rvoffB = (size_t)128 * K;
    const size_t kstep = (size_t)(BK * 2);
    const size_t hstep = (size_t)HALF * K * 2;
    const size_t tstep = 2 * hstep;
    const size_t hstepA = (size_t)HALF * g.lda * 2, tstepA = 2 * hstepA;
    const unsigned ldsw = (unsigned)wid * 1024u;
    const int aoff = lds_byte(wr * 64 + fr, fq * 8), boff = lds_byte(wc * 32 + fr, fq * 8);
#define PG8_SA(b, h) (((b) * 2 + (h)) * HTB)
#define PG8_SB(b, h) ((4 + (b) * 2 + (h)) * HTB)
#define PG8_STAGE(bufoff, gbase, voff) do { unsigned vo_ = (voff); asm volatile("" : "+v"(vo_));     \
        _Pragma("unroll") for (int _i = 0; _i < 2; ++_i) \
        __builtin_amdgcn_global_load_lds((const unsigned*)((const char*)(gbase) + _i * r##voff + vo_), (LAS unsigned*)(lds + (bufoff) + ldsw + _i * 8192), 16, 0, 0); } while (0)
#define PG8_LDX(dst, off) do { const v4i_ lo_ = *(const LAS v4i_*)(lds + (off)), hi_ = *(const LAS v4i_*)(lds + (off) + 1024); dst = __builtin_shufflevector(lo_, hi_, 0, 1, 2, 3, 4, 5, 6, 7); } while (0)
#define PG8_LDA(dst, b, h) do { if constexpr (MX) { _Pragma("unroll") for (int m = 0; m < 4; ++m) PG8_LDX(dst##X[m], PG8_SA(b, h) + aoff + m * 2048); } \
        else { _Pragma("unroll") for (int m = 0; m < 4; ++m) _Pragma("unroll") for (int k = 0; k < 2; ++k) dst[m][k] = *(const LAS bf16x8*)(lds + PG8_SA(b, h) + aoff + m * 2048 + k * 1024); } } while (0)
#define PG8_LDB(dst, b, h) do { if constexpr (MX) { _Pragma("unroll") for (int n = 0; n < 2; ++n) PG8_LDX(dst##X[n], PG8_SB(b, h) + boff + n * 2048); } \
        else { _Pragma("unroll") for (int n = 0; n < 2; ++n) _Pragma("unroll") for (int k = 0; k < 2; ++k) dst[n][k] = *(const LAS bf16x8*)(lds + PG8_SB(b, h) + boff + n * 2048 + k * 1024); } } while (0)
#define PG8_MMA(ai, bj, At, Bt) do { __builtin_amdgcn_s_setprio(1); \
        if constexpr (MX) { _Pragma("unroll") for (int m = 0; m < 4; ++m) _Pragma("unroll") for (int n = 0; n < 2; ++n) \
            asm volatile("v_mfma_scale_f32_16x16x128_f8f6f4 %0, %1, %2, %0, %3, %4 op_sel_hi:[0,0,0]" : "+v"(acc[ai][bj][m][n]) : "v"(Bt##X[n]), "v"(At##X[m]), "v"(mxscale), "v"(mxscale5)); } \
        else { _Pragma("unroll") for (int m = 0; m < 4; ++m) _Pragma("unroll") for (int n = 0; n < 2; ++n) _Pragma("unroll") for (int k = 0; k < 2; ++k) \
            acc[ai][bj][m][n] = __builtin_amdgcn_mfma_f32_16x16x32_bf16(Bt[n][k], At[m][k], acc[ai][bj][m][n], 0, 0, 0); } \
        __builtin_amdgcn_s_setprio(0); } while (0)
#define PG8_WAIT_V(n) asm volatile("s_waitcnt vmcnt(" #n ")" ::: "memory")
#define PG8_WAIT_L(n) asm volatile("s_waitcnt lgkmcnt(" #n ")" ::: "memory")
#define PG8_BAR __builtin_amdgcn_s_barrier()
#define PG8_SCHED __builtin_amdgcn_sched_barrier(0)
    Unit cur, nxt; int ui = 0;
    if (!S.next(0, cur)) return;
    f32x4 acc[2][2][4][2];
#pragma unroll
    for (int a = 0; a < 2; ++a)
#pragma unroll
        for (int b = 0; b < 2; ++b)
#pragma unroll
            for (int m = 0; m < 4; ++m)
#pragma unroll
                for (int n = 0; n < 2; ++n) acc[a][b][m][n] = (f32x4){0.f, 0.f, 0.f, 0.f};
    typedef int v4i_ __attribute__((ext_vector_type(4))); typedef int v8i_ __attribute__((ext_vector_type(8)));
    bf16x8 At[4][2], B0[2][2], B1[2][2];
    v8i_ AtX[4], B0X[2], B1X[2];
    const int mxscale = 0x7f7f7f7f, mxscale5 = 0x7a7a7a7a;
    const char* cA = (const char*)g.A + (size_t)cur.pm * tstepA; const char* cB = (const char*)g.Bt + (size_t)cur.pn * tstep;
    PG8_STAGE(PG8_SB(0, 0), cB, voffB); PG8_STAGE(PG8_SA(0, 0), cA, voffA); PG8_STAGE(PG8_SB(0, 1), cB + hstep, voffB); PG8_STAGE(PG8_SA(0, 1), cA + hstepA, voffA);
    if (wr == 1) PG8_BAR;
    PG8_WAIT_V(4); PG8_BAR;
    PG8_STAGE(PG8_SB(1, 0), cB + kstep, voffB); PG8_STAGE(PG8_SA(1, 0), cA + kstep, voffA); PG8_STAGE(PG8_SB(1, 1), cB + hstep + kstep, voffB);
    PG8_WAIT_V(6); PG8_BAR;
    for (;;) {
        const bool has_next = S.next(ui + 1, nxt);
        const char* nA = has_next ? (const char*)g.A + (size_t)nxt.pm * tstepA : cA; const char* nB = has_next ? (const char*)g.Bt + (size_t)nxt.pn * tstep : cB;
        for (int t = 0; t < nt; t += 2) {
            const bool last = (t == nt - 2);
            const char* a1 = cA + (size_t)(t + 1) * kstep;
            const char* a2 = last ? nA : cA + (size_t)(t + 2) * kstep; const char* b2 = last ? nB : cB + (size_t)(t + 2) * kstep;
            const char* a3 = a2 + kstep; const char* b3 = b2 + kstep;
            PG8_LDB(B0, 0, 0); PG8_SCHED; PG8_LDA(At, 0, 0); PG8_STAGE(PG8_SA(1, 1), a1 + hstepA, voffA);
            PG8_WAIT_L(8); PG8_BAR; PG8_WAIT_L(0); PG8_MMA(0, 0, At, B0); PG8_BAR; PG8_SCHED;
            PG8_LDB(B1, 0, 1); PG8_STAGE(PG8_SB(0, 0), b2, voffB);
            PG8_BAR; PG8_WAIT_L(0); PG8_MMA(0, 1, At, B1); PG8_BAR;
            PG8_LDA(At, 0, 1); PG8_STAGE(PG8_SA(0, 0), a2, voffA);
            PG8_BAR; PG8_WAIT_L(0); PG8_MMA(1, 0, At, B0); PG8_BAR; PG8_SCHED;
            PG8_STAGE(PG8_SB(0, 1), b2 + hstep, voffB);
            PG8_WAIT_V(6); PG8_BAR; PG8_MMA(1, 1, At, B1); PG8_BAR;
            PG8_LDB(B0, 1, 0); PG8_SCHED; PG8_LDA(At, 1, 0); PG8_STAGE(PG8_SA(0, 1), a2 + hstepA, voffA);
            PG8_WAIT_L(8); PG8_BAR; PG8_WAIT_L(0); PG8_MMA(0, 0, At, B0); PG8_BAR; PG8_SCHED;
            PG8_LDB(B1, 1, 1); PG8_STAGE(PG8_SB(1, 0), b3, voffB);
            PG8_BAR; PG8_WAIT_L(0); PG8_MMA(0, 1, At, B1); PG8_BAR;
            PG8_LDA(At, 1, 1); PG8_STAGE(PG8_SA(1, 0), a3, voffA);
            PG8_BAR; PG8_WAIT_L(0); PG8_MMA(1, 0, At, B0); PG8_BAR; PG8_SCHED;
            PG8_STAGE(PG8_SB(1, 1), b3 + hstep, voffB);
            PG8_WAIT_V(6); PG8_BAR; PG8_MMA(1, 1, At, B1); PG8_BAR;
        }
        if constexpr (MX) asm volatile("s_nop 15\n\ts_nop 15" ::: "memory");
        if (wr == 0) PG8_BAR;
        E(acc, cur, wr, wc, fr, fq);
        if (wr == 1) PG8_BAR;
        if (!has_next) break;
#pragma unroll
        for (int a = 0; a < 2; ++a)
#pragma unroll
            for (int b = 0; b < 2; ++b)
#pragma unroll
                for (int m = 0; m < 4; ++m)
#pragma unroll
                    for (int n = 0; n < 2; ++n) acc[a][b][m][n] = (f32x4){0.f, 0.f, 0.f, 0.f};
        cur = nxt; cA = nA; cB = nB; ++ui;
    }
    PG8_WAIT_V(0);
    if (wr == 0) PG8_BAR;
    PG8_BAR;
#undef PG8_SA
#undef PG8_SB
#undef PG8_STAGE
#undef PG8_LDX
#undef PG8_LDA
#undef PG8_LDB
#undef PG8_MMA
#undef PG8_WAIT_V
#undef PG8_WAIT_L
#undef PG8_BAR
#undef PG8_SCHED
}
}
using pg8::Unit;

struct EpiProj {
    static constexpr bool PERM = true;
    unsigned char* ws; const float* lb; const float* ng; float* kmean;
    __device__ __forceinline__ void operator()(const f32x4 (&acc)[2][2][4][2], const Unit& u, int wr, int wc, int fr, int fq) const {
        const int pn = u.pn; int seg, colt, ldc; size_t boff;
        if (pn < 14) { seg = pn >> 1; colt = (pn & 1) * 256; ldc = 512; boff = OFF_QA + (size_t)seg * SZ_T512; }
        else if (pn < 18) { seg = 7; colt = (pn - 14) * 256; ldc = 1024; boff = OFF_GA; }
        else { seg = 8; colt = (pn - 18) * 256; ldc = 1024; boff = OFF_GB; }
        bf16_t* base = (bf16_t*)(ws + boff);
        const int row0 = u.pm * 256 + wr * 64 + fr, col0 = colt + wc * 32 + 8 * fq;
        float pv[2][8];
#pragma unroll
        for (int bj = 0; bj < 2; ++bj)
#pragma unroll
            for (int e = 0; e < 8; ++e) pv[bj][e] = (seg == 4) ? (1.0f - lb[col0 + bj * 128 + e]) : ((seg == 6) ? ng[col0 + bj * 128 + e] : 0.f);
        float cs[2][8];
#pragma unroll
        for (int bj = 0; bj < 2; ++bj)
#pragma unroll
            for (int e = 0; e < 8; ++e) cs[bj][e] = 0.f;
#pragma unroll
        for (int ai = 0; ai < 2; ++ai)
#pragma unroll
            for (int m = 0; m < 4; ++m) {
                bf16_t* rowp = base + (size_t)(row0 + ai * 128 + m * 16) * ldc + col0;
#pragma unroll
                for (int bj = 0; bj < 2; ++bj) {
                    float v[8];
#pragma unroll
                    for (int e = 0; e < 4; ++e) { v[e] = acc[ai][bj][m][0][e]; v[4 + e] = acc[ai][bj][m][1][e]; }
                    if (seg == 0) {
#pragma unroll
                        for (int e = 0; e < 8; ++e) v[e] *= (0.125f * LOG2E);
                    } else if (seg == 1) {
#pragma unroll
                        for (int e = 0; e < 8; ++e) cs[bj][e] += v[e];
                    } else if (seg == 3) {
#pragma unroll
                        for (int e = 0; e < 8; ++e) v[e] = v[e] * sigmoidf_(v[e]);
                    } else if (seg == 4) {
#pragma unroll
                        for (int e = 0; e < 8; ++e) v[e] = pv[bj][e] * sigmoidf_(-v[e]);
                    } else if (seg == 6) {
#pragma unroll
                        for (int e = 0; e < 8; ++e) v[e] = pv[bj][e] * v[e] * sigmoidf_(v[e]);
                    } else if (seg >= 7) {
#pragma unroll
                        for (int e = 0; e < 8; ++e) v[e] = sigmoidf_(v[e]);
                    }
                    if (seg >= 7) {
                        int w0 = __builtin_amdgcn_cvt_pk_fp8_f32(v[0], v[1], 0, false); w0 = __builtin_amdgcn_cvt_pk_fp8_f32(v[2], v[3], w0, true);
                        int w1 = __builtin_amdgcn_cvt_pk_fp8_f32(v[4], v[5], 0, false); w1 = __builtin_amdgcn_cvt_pk_fp8_f32(v[6], v[7], w1, true);
                        *(u32x2*)((unsigned char*)rowp - col0 + bj * 128) = (u32x2){(unsigned)w0, (unsigned)w1};
                    } else {
                    u32x4 w; w.x = cvt_pk_bf16(v[0], v[1]); w.y = cvt_pk_bf16(v[2], v[3]); w.z = cvt_pk_bf16(v[4], v[5]); w.w = cvt_pk_bf16(v[6], v[7]);
                    *(u32x4*)(rowp + bj * 128) = w; }
                }
            }
        if (seg == 1) {
#pragma unroll
            for (int bj = 0; bj < 2; ++bj)
#pragma unroll
                for (int e = 0; e < 8; ++e) {
                    float s = cs[bj][e];
                    s += __shfl_xor(s, 1); s += __shfl_xor(s, 2); s += __shfl_xor(s, 4); s += __shfl_xor(s, 8);
                    if (fr == 0) atomicAdd(kmean + (size_t)u.pm * 512 + col0 + bj * 128 + e, s);
                }
        }
    }
};
__device__ __forceinline__ void fp8x8_to_f32(const u32x2 w, float (&f)[8]) {
    const f32x2 a = __builtin_amdgcn_cvt_pk_f32_fp8((int)w.x, false), b = __builtin_amdgcn_cvt_pk_f32_fp8((int)w.x, true), c = __builtin_amdgcn_cvt_pk_f32_fp8((int)w.y, false), d = __builtin_amdgcn_cvt_pk_f32_fp8((int)w.y, true);
    f[0] = a.x; f[1] = a.y; f[2] = b.x; f[3] = b.y; f[4] = c.x; f[5] = c.y; f[6] = d.x; f[7] = d.y;
}
struct EpiMixA {
    static constexpr bool PERM = true;
    unsigned char* GA;
    __device__ __forceinline__ void operator()(const f32x4 (&acc)[2][2][4][2], const Unit& u, int wr, int wc, int fr, int fq) const {
        asm volatile("" : "+v"(fr), "+v"(fq));
        const int row0 = u.pm * 256 + wr * 64 + fr, col0 = u.pn * 256 + wc * 32 + 8 * fq;
#pragma unroll
        for (int ai = 0; ai < 2; ++ai)
#pragma unroll
            for (int m = 0; m < 4; ++m) {
                unsigned char* rowp = GA + (size_t)(row0 + ai * 128 + m * 16) * 2048 + col0;
#pragma unroll
                for (int bj = 0; bj < 2; ++bj) {
                    float g[8]; fp8x8_to_f32(*(const u32x2*)(rowp + bj * 128), g);
                    const f32x4 a0 = acc[ai][bj][m][0], a1 = acc[ai][bj][m][1];
                    int w0 = __builtin_amdgcn_cvt_pk_fp8_f32(g[0] * a0[0], g[1] * a0[1], 0, false); w0 = __builtin_amdgcn_cvt_pk_fp8_f32(g[2] * a0[2], g[3] * a0[3], w0, true);
                    int w1 = __builtin_amdgcn_cvt_pk_fp8_f32(g[4] * a1[0], g[5] * a1[1], 0, false); w1 = __builtin_amdgcn_cvt_pk_fp8_f32(g[6] * a1[2], g[7] * a1[3], w1, true);
                    *(u32x2*)(rowp + bj * 128) = (u32x2){(unsigned)w0, (unsigned)w1};
                }
            }
    }
};
struct EpiMixB {
    static constexpr bool PERM = true;
    const unsigned char* GA; const unsigned char* GB; unsigned char* M8;
    __device__ __forceinline__ void operator()(const f32x4 (&acc)[2][2][4][2], const Unit& u, int wr, int wc, int fr, int fq) const {
        asm volatile("" : "+v"(fr), "+v"(fq));
        const int row0 = u.pm * 256 + wr * 64 + fr, col0 = u.pn * 256 + wc * 32 + 8 * fq;
#pragma unroll
        for (int ai = 0; ai < 2; ++ai)
#pragma unroll
            for (int m = 0; m < 4; ++m) {
                const size_t row = (size_t)(row0 + ai * 128 + m * 16);
#pragma unroll
                for (int bj = 0; bj < 2; ++bj) {
                    float g[8], pa[8]; fp8x8_to_f32(*(const u32x2*)(GB + row * 2048 + col0 + bj * 128), g); fp8x8_to_f32(*(const u32x2*)(GA + row * 2048 + col0 + bj * 128), pa);
                    const f32x4 a0 = acc[ai][bj][m][0], a1 = acc[ai][bj][m][1];
                    int w0 = __builtin_amdgcn_cvt_pk_fp8_f32(pa[0] + g[0] * a0[0], pa[1] + g[1] * a0[1], 0, false); w0 = __builtin_amdgcn_cvt_pk_fp8_f32(pa[2] + g[2] * a0[2], pa[3] + g[3] * a0[3], w0, true);
                    int w1 = __builtin_amdgcn_cvt_pk_fp8_f32(pa[4] + g[4] * a1[0], pa[5] + g[5] * a1[1], 0, false); w1 = __builtin_amdgcn_cvt_pk_fp8_f32(pa[6] + g[6] * a1[2], pa[7] + g[7] * a1[3], w1, true);
                    *(u32x2*)(M8 + row * 1024 + col0 + bj * 128) = (u32x2){(unsigned)w0, (unsigned)w1};
                }
            }
    }
};
struct EpiOut {
    static constexpr bool PERM = true;
    const float* ada; bf16_t* D;
    __device__ __forceinline__ void operator()(const f32x4 (&acc)[2][2][4][2], const Unit& u, int wr, int wc, int fr, int fq) const {
        const int row0 = u.pm * 256 + wr * 64 + fr, col0 = u.pn * 256 + wc * 32 + 8 * fq;
        const float* gt1 = ada + (size_t)(u.pm >> 3) * 6144 + 2048 + col0;
        f32x4 g[2][2];
#pragma unroll
        for (int bj = 0; bj < 2; ++bj) { g[bj][0] = *(const f32x4*)(gt1 + bj * 128); g[bj][1] = *(const f32x4*)(gt1 + bj * 128 + 4); }
#pragma unroll
        for (int ai = 0; ai < 2; ++ai)
#pragma unroll
            for (int m = 0; m < 4; ++m) {
                bf16_t* rowp = D + (size_t)(row0 + ai * 128 + m * 16) * 1024 + col0;
#pragma unroll
                for (int bj = 0; bj < 2; ++bj) {
                    const f32x4 a0 = acc[ai][bj][m][0] * g[bj][0], a1 = acc[ai][bj][m][1] * g[bj][1];
                    int w0 = __builtin_amdgcn_cvt_pk_fp8_f32(a0[0], a0[1], 0, false); w0 = __builtin_amdgcn_cvt_pk_fp8_f32(a0[2], a0[3], w0, true);
                    int w1 = __builtin_amdgcn_cvt_pk_fp8_f32(a1[0], a1[1], 0, false); w1 = __builtin_amdgcn_cvt_pk_fp8_f32(a1[2], a1[3], w1, true);
                    *(u32x2*)((unsigned char*)rowp - col0 + bj * 128) = (u32x2){(unsigned)w0, (unsigned)w1};
                }
            }
    }
};
struct EpiBf16 {
    static constexpr bool PERM = true;
    bf16_t* O;
    __device__ __forceinline__ void operator()(const f32x4 (&acc)[2][2][4][2], const Unit& u, int wr, int wc, int fr, int fq) const {
        const int row0 = u.pm * 256 + wr * 64 + fr, col0 = u.pn * 256 + wc * 32 + 8 * fq;
#pragma unroll
        for (int ai = 0; ai < 2; ++ai)
#pragma unroll
            for (int m = 0; m < 4; ++m) {
                bf16_t* rowp = O + (size_t)(row0 + ai * 128 + m * 16) * 1024 + col0;
#pragma unroll
                for (int bj = 0; bj < 2; ++bj) {
                    const f32x4 a0 = acc[ai][bj][m][0], a1 = acc[ai][bj][m][1];
                    u32x4 w; w.x = cvt_pk_bf16(a0[0], a0[1]); w.y = cvt_pk_bf16(a0[2], a0[3]); w.z = cvt_pk_bf16(a1[0], a1[1]); w.w = cvt_pk_bf16(a1[2], a1[3]);
                    *(u32x4*)(rowp + bj * 128) = w;
                }
            }
    }
};

__device__ void phase0a(const Params& P, LAS unsigned char* lds) {
    const int tid = tid_opaque(), G = gridDim.x, bid = blockIdx.x;
    for (int it = bid; it < 192; it += G) {
        LAS float* sc = (LAS float*)lds;
        const int kg = tid >> 5, col = tid & 31;
        float w[64];
#pragma unroll
        for (int e = 0; e < 64; ++e) w[e] = __builtin_nontemporal_load(P.w_ada + (size_t)(kg * 64 + e) * 6144 + it * 32 + col);
        asm volatile("" ::: "memory");
#pragma unroll 1
        for (int i0 = 0; i0 < 64; i0 += 16) {
            float cv[16];
#pragma unroll
            for (int j = 0; j < 16; ++j) cv[j] = P.c[tid + (i0 + j) * NTHR];
#pragma unroll
            for (int j = 0; j < 16; ++j) sc[tid + (i0 + j) * NTHR] = cv[j] * sigmoidf_(cv[j]);
        }
        __syncthreads();
        float a[32];
#pragma unroll
        for (int b = 0; b < 32; ++b) a[b] = 0.f;
#pragma unroll
        for (int e4 = 0; e4 < 16; ++e4) {
#pragma unroll
            for (int b = 0; b < 32; ++b) { const f32x4 s = *(const LAS f32x4*)(sc + b * 1024 + kg * 64 + 4 * e4); a[b] += s[0] * w[4 * e4] + s[1] * w[4 * e4 + 1] + s[2] * w[4 * e4 + 2] + s[3] * w[4 * e4 + 3]; }
            asm volatile("" ::: "memory");
        }
        __syncthreads();
        LAS float* red = (LAS float*)lds;
#pragma unroll
        for (int b = 0; b < 32; ++b) red[(kg * 32 + b) * 32 + col] = a[b];
        __syncthreads();
        for (int o = tid; o < 1024; o += NTHR) { const int b = o >> 5, cc = o & 31; float s = 0.f;
#pragma unroll
            for (int g2 = 0; g2 < 16; ++g2) s += red[(g2 * 32 + b) * 32 + cc];
            ((float*)(P.ws + OFF_ADA))[(size_t)b * 6144 + it * 32 + cc] = s + P.b_ada[it * 32 + cc]; }
        __syncthreads();
    }
    const size_t gsz = (size_t)G * NTHR;
    { const int gt = bid * NTHR + tid, gs = G * NTHR;
      if (gt < 512) ((float*)(P.ws + OFF_LB))[gt] = sigmoidf_(P.hgrn_lb[gt] - P.hgrn_lb[512 + gt]);
      for (int i = gt; i < 32 * 8 * 512; i += gs) ((float*)(P.ws + OFF_KMEAN))[i] = 0.f; }
    {
        LAS float* tile = (LAS float*)lds;
        const int I0 = 16 * 88, I1 = I0 + 8 * 16, I2 = I1 + 8 * 16, I3 = I2 + 16 * 16, I4 = I3 + 16 * 16;
        for (int it = bid; it < I4; it += G) {
            const float* W; bf16_t* WT; int K, N, r;
            if (it < I0) { W = P.w_in; WT = (bf16_t*)(P.ws + OFF_WIN); K = 1024; N = 5632; r = it; }
            else if (it < I1) { W = P.w_ba; WT = (bf16_t*)(P.ws + OFF_WBA); K = 512; N = 1024; r = it - I0; }
            else if (it < I2) { W = P.w_bb; WT = (bf16_t*)(P.ws + OFF_WBB); K = 512; N = 1024; r = it - I1; }
            else if (it < I3) { W = P.w_out; WT = (bf16_t*)(P.ws + OFF_WOUT); K = 1024; N = 1024; r = it - I2; }
            else { W = P.peer_wq; WT = (bf16_t*)(P.ws + OFF_WQ); K = 1024; N = 1024; r = it - I3; }
            const int nb = N / 64, k0 = (r / nb) * 64, n0 = (r % nb) * 64;
#pragma unroll
            for (int ps = 0; ps < 2; ++ps) { const int kk = (tid >> 4) + 32 * ps, n4 = (tid & 15) * 4;
                const f32x4 v = *(const f32x4*)(W + (size_t)(k0 + kk) * N + n0 + n4);
                tile[kk * 65 + n4] = v[0]; tile[kk * 65 + n4 + 1] = v[1]; tile[kk * 65 + n4 + 2] = v[2]; tile[kk * 65 + n4 + 3] = v[3]; }
            __syncthreads();
            { const int n = tid >> 3, kc = (tid & 7) * 8;
              if (it < I3) {
                  int w0 = __builtin_amdgcn_cvt_pk_fp8_f32(32.f * tile[(kc + 0) * 65 + n], 32.f * tile[(kc + 1) * 65 + n], 0, false); w0 = __builtin_amdgcn_cvt_pk_fp8_f32(32.f * tile[(kc + 2) * 65 + n], 32.f * tile[(kc + 3) * 65 + n], w0, true);
                  int w1 = __builtin_amdgcn_cvt_pk_fp8_f32(32.f * tile[(kc + 4) * 65 + n], 32.f * tile[(kc + 5) * 65 + n], 0, false); w1 = __builtin_amdgcn_cvt_pk_fp8_f32(32.f * tile[(kc + 6) * 65 + n], 32.f * tile[(kc + 7) * 65 + n], w1, true);
                  *(u32x2*)((unsigned char*)WT + (size_t)(n0 + n) * K + k0 + kc) = (u32x2){(unsigned)w0, (unsigned)w1};
              } else { u32x4 w;
              w.x = cvt_pk_bf16(tile[(kc + 0) * 65 + n], tile[(kc + 1) * 65 + n]); w.y = cvt_pk_bf16(tile[(kc + 2) * 65 + n], tile[(kc + 3) * 65 + n]);
              w.z = cvt_pk_bf16(tile[(kc + 4) * 65 + n], tile[(kc + 5) * 65 + n]); w.w = cvt_pk_bf16(tile[(kc + 6) * 65 + n], tile[(kc + 7) * 65 + n]);
              *(u32x4*)(WT + (size_t)(n0 + n) * K + k0 + kc) = w; } }
            __syncthreads();
        }
    }
    {
        const size_t gtid = (size_t)bid * NTHR + tid_opaque();
        for (size_t i = gtid; i < 16384; i += gsz) {
            const float* src = P.peer_sk + i * 8; const f32x4 a = *(const f32x4*)src, b = *(const f32x4*)(src + 4);
            u32x4 w; w.x = cvt_pk_bf16(a[0], a[1]); w.y = cvt_pk_bf16(a[2], a[3]); w.z = cvt_pk_bf16(b[0], b[1]); w.w = cvt_pk_bf16(b[2], b[3]);
            *(u32x4*)((bf16_t*)(P.ws + OFF_SK) + i * 8) = w;
        }
        { const int lane = tid & 63, gw = bid * 8 + (tid >> 6), ngw = G * 8;
          for (int r0 = gw; r0 < 2 * 16384; r0 += 4 * ngw) {
              f32x4 x[4][4];
#pragma unroll
              for (int u = 0; u < 4; ++u) { const int r = min(r0 + u * ngw, 2 * 16384 - 1); const bool isv = r >= 16384; const int e = isv ? r - 16384 : r;
                  const float* s = (isv ? P.peer_v : P.peer_u) + (size_t)e * 1024 + lane * 4;
#pragma unroll
                  for (int q = 0; q < 4; ++q) x[u][q] = __builtin_nontemporal_load((const f32x4*)(s + 256 * q)); }
              asm volatile("" ::: "memory");
#pragma unroll
              for (int u = 0; u < 4; ++u) { const int r = r0 + u * ngw; if (r < 2 * 16384) { const bool isv = r >= 16384; const int e = isv ? r - 16384 : r;
                  float ss = 0.f;
#pragma unroll
                  for (int q = 0; q < 4; ++q) ss += (x[u][q][0] * x[u][q][0] + x[u][q][1] * x[u][q][1]) + (x[u][q][2] * x[u][q][2] + x[u][q][3] * x[u][q][3]);
                  const float sc = fmaxf(sqrtf(wave_sum_fast(ss) * (1.0f / 1024.0f)) * (2.6f / 7.5f), 1e-30f), inv = 1.0f / sc;
                  const int nsh = (lane & 1) * 4;
                  const unsigned flip = isv ? 0x80808080u : 0x88888888u;
                  unsigned* dst = (unsigned*)(P.ws + (isv ? OFF_V8 : OFF_U8) + (size_t)e * 512) + (lane >> 1);
#pragma unroll
                  for (int q = 0; q < 4; ++q) {
                      unsigned p = 0u;
#pragma unroll
                      for (int el = 0; el < 4; ++el) p |= (unsigned)fminf(fmaxf(floorf(x[u][q][el] * inv) + 8.0f, 0.0f), 15.0f) << (8 * el + nsh);
                      p |= (unsigned)__builtin_amdgcn_update_dpp(0, (int)p, 0xB1, 0xf, 0xf, true);
                      if (!(lane & 1)) dst[32 * q] = p ^ flip;
                  }
                  if (lane == 0) ((float*)(P.ws + (isv ? OFF_VSC : OFF_USC)))[e] = sc; } }
          } }
    }
}
__device__ void phase0b(const Params& P) {
    const size_t gtid = (size_t)blockIdx.x * NTHR + threadIdx.x, gsz = (size_t)gridDim.x * NTHR;
    const float* ada = (const float*)(P.ws + OFF_ADA); bf16_t* H = (bf16_t*)(P.ws + OFF_H);
    for (size_t i = gtid; i < (size_t)NTOK * 128; i += gsz) {
        const size_t row = i >> 7; const int c8 = (int)(i & 127) * 8; const int b = (int)(row >> 11);
        const float* xr = P.x + row * 1024 + c8; const float* sh = ada + (size_t)b * 6144 + c8; const float* sc = sh + 1024;
        const f32x4 x0 = *(const f32x4*)xr, x1 = *(const f32x4*)(xr + 4), s0 = *(const f32x4*)sc, s1 = *(const f32x4*)(sc + 4), h0 = *(const f32x4*)sh, h1 = *(const f32x4*)(sh + 4);
        const f32x4 r0 = x0 * (s0 + 1.0f) + h0, r1 = x1 * (s1 + 1.0f) + h1;
        int w0 = __builtin_amdgcn_cvt_pk_fp8_f32(r0[0], r0[1], 0, false); w0 = __builtin_amdgcn_cvt_pk_fp8_f32(r0[2], r0[3], w0, true);
        int w1 = __builtin_amdgcn_cvt_pk_fp8_f32(r1[0], r1[1], 0, false); w1 = __builtin_amdgcn_cvt_pk_fp8_f32(r1[2], r1[3], w1, true);
        *(u32x2*)((unsigned char*)H + row * 1024 + c8) = (u32x2){(unsigned)w0, (unsigned)w1};
    }
}

__device__ __forceinline__ s16x4 tr4(const LAS unsigned char* p) { return __builtin_bit_cast(s16x4, __builtin_amdgcn_ds_read_tr16_b64_v4i16((LAS s16x4*)p)); }
__device__ void hgrn_item(const Params& P, int item, LAS unsigned char* lds) {
    const int tid = tid_opaque(), lane = tid & 63, wid = __builtin_amdgcn_readfirstlane(tid >> 6), r32 = lane & 31, hi = lane >> 5;
    const int b = item >> 3, h = (item >> 1) & 3, vh = item & 1;
    const bf16_t* HQ = (const bf16_t*)(P.ws + OFF_HQ); const bf16_t* HK = (const bf16_t*)(P.ws + OFF_HK); bf16_t* HI = (bf16_t*)(P.ws + OFF_HI);
    constexpr int SQ = 272, SKD = 320, SV = 192, SS = 192;
    constexpr int LQR = 0, LKR = 17408, LQB = 34816, LKD = 52224, LV = 72704, LS = 84992, LG = 109568, LT = 142336, LCL = 144384;
    LAS float* G = (LAS float*)(lds + LG); LAS float* TOT = (LAS float*)(lds + LT); LAS float* CL = (LAS float*)(lds + LCL); LAS float* CH = (LAS float*)(lds + LCL + 512);
    const size_t rowb = (size_t)b * SEQ;
    const int row = tid >> 3, seg = tid & 7;
    const bf16_t* qsrc = HQ + (rowb + row) * 512 + h * 128 + seg * 16; const bf16_t* ksrc = HK + (rowb + row) * 512 + h * 128 + seg * 16;
    bf16_t* vsrc = HI + (rowb + row) * 512 + h * 128 + vh * 64 + seg * 8;
    for (int i = tid; i < 128 * SS / 4; i += NTHR) ((LAS unsigned*)(lds + LS))[i] = 0u;
    f32x16 Sacc = {};
    const int di = wid >> 1, vi = wid & 1, ti = wid >> 1;
    const int tg = lane >> 4, tc = tg & 1, tI = lane & 15;
    const int trow = 4 * hi + (tI >> 2), tcol = 16 * tc + 4 * (tI & 3);
    u32x4 qn0 = *(const u32x4*)qsrc, qn1 = *(const u32x4*)(qsrc + 8), kn0 = *(const u32x4*)ksrc, kn1 = *(const u32x4*)(ksrc + 8), vn = *(const u32x4*)vsrc;
#pragma unroll 1
    for (int n = 0; n < SEQ / 64; ++n) {
        const u32x4 q0 = qn0, q1 = qn1, k0 = kn0, k1 = kn1, vv = vn;
        float qf[16] = {bf_lo(q0.x), bf_hi(q0.x), bf_lo(q0.y), bf_hi(q0.y), bf_lo(q0.z), bf_hi(q0.z), bf_lo(q0.w), bf_hi(q0.w), bf_lo(q1.x), bf_hi(q1.x), bf_lo(q1.y), bf_hi(q1.y), bf_lo(q1.z), bf_hi(q1.z), bf_lo(q1.w), bf_hi(q1.w)};
        float kf[16] = {bf_lo(k0.x), bf_hi(k0.x), bf_lo(k0.y), bf_hi(k0.y), bf_lo(k0.z), bf_hi(k0.z), bf_lo(k0.w), bf_hi(k0.w), bf_lo(k1.x), bf_hi(k1.x), bf_lo(k1.y), bf_hi(k1.y), bf_lo(k1.z), bf_hi(k1.z), bf_lo(k1.w), bf_hi(k1.w)};
#pragma unroll
        for (int e4 = 0; e4 < 4; ++e4) *(LAS f32x4*)(G + row * 128 + seg * 16 + 4 * e4) = (f32x4){__logf(1.0f - kf[4 * e4]), __logf(1.0f - kf[4 * e4 + 1]), __logf(1.0f - kf[4 * e4 + 2]), __logf(1.0f - kf[4 * e4 + 3])};
        *(LAS u32x4*)(lds + LV + row * SV + seg * 16) = vv;
        if (n + 1 < SEQ / 64) { const size_t o = (size_t)(n + 1) * 64 * 512; qn0 = *(const u32x4*)(qsrc + o); qn1 = *(const u32x4*)(qsrc + o + 8); kn0 = *(const u32x4*)(ksrc + o); kn1 = *(const u32x4*)(ksrc + o + 8); vn = *(const u32x4*)(vsrc + o); }
        __syncthreads();
        { const int d = tid & 127, q4 = tid >> 7; float s = 0.f;
#pragma unroll
          for (int i = 0; i < 16; ++i) { s += G[(16 * q4 + i) * 128 + d]; G[(16 * q4 + i) * 128 + d] = s; }
          TOT[q4 * 128 + d] = s; }
        __syncthreads();
        {
            { const int d2 = 2 * lane;
              const f32x2 t0 = *(const LAS f32x2*)(TOT + d2), t1 = *(const LAS f32x2*)(TOT + 128 + d2), t2 = *(const LAS f32x2*)(TOT + 256 + d2), t3 = *(const LAS f32x2*)(TOT + 384 + d2);
              const f32x2 bref = *(const LAS f32x2*)(G + 32 * 128 + d2) + t0 + t1, blast = t0 + t1 + t2 + t3;
              *(LAS f32x2*)(CH + d2) = (f32x2){__expf(-bref.x), __expf(-bref.y)}; *(LAS f32x2*)(CH + 128 + d2) = (f32x2){__expf(bref.x), __expf(bref.y)}; *(LAS f32x2*)(CL + d2) = (f32x2){__expf(blast.x), __expf(blast.y)}; }
            const int qq = row >> 4;
#pragma unroll
            for (int e4 = 0; e4 < 4; ++e4) {
                const int d4 = seg * 16 + 4 * e4;
                const f32x4 t0 = *(const LAS f32x4*)(TOT + d4), t1 = *(const LAS f32x4*)(TOT + 128 + d4), t2 = *(const LAS f32x4*)(TOT + 256 + d4);
                const f32x4 off = (qq == 0) ? (f32x4){0.f, 0.f, 0.f, 0.f} : ((qq == 1) ? t0 : ((qq == 2) ? t0 + t1 : t0 + t1 + t2));
                const f32x4 bb = *(const LAS f32x4*)(G + row * 128 + d4) + off;
                const f32x4 enr = *(const LAS f32x4*)(CH + d4), epr = *(const LAS f32x4*)(CH + 128 + d4), epl = *(const LAS f32x4*)(CL + d4);
                float vqb[4], vqr[4], vkr[4], vkd[4];
#pragma unroll
                for (int e = 0; e < 4; ++e) {
                    const float e1 = __expf(bb[e]), e2 = __expf(-bb[e]);
                    vqb[e] = qf[4 * e4 + e] * e1; vqr[e] = vqb[e] * enr[e];
                    const float ke = kf[4 * e4 + e] * e2; vkr[e] = ke * epr[e]; vkd[e] = ke * epl[e];
                }
                *(LAS u32x2*)(lds + LQB + row * SQ + seg * 32 + 8 * e4) = (u32x2){cvt_pk_bf16(vqb[0], vqb[1]), cvt_pk_bf16(vqb[2], vqb[3])};
                *(LAS u32x2*)(lds + LQR + row * SQ + seg * 32 + 8 * e4) = (u32x2){cvt_pk_bf16(vqr[0], vqr[1]), cvt_pk_bf16(vqr[2], vqr[3])};
                *(LAS u32x2*)(lds + LKR + row * SQ + seg * 32 + 8 * e4) = (u32x2){cvt_pk_bf16(vkr[0], vkr[1]), cvt_pk_bf16(vkr[2], vkr[3])};
                *(LAS u32x2*)(lds + LKD + row * SKD + seg * 32 + 8 * e4) = (u32x2){cvt_pk_bf16(vkd[0], vkd[1]), cvt_pk_bf16(vkd[2], vkd[3])};
                asm volatile("" ::: "memory");
            }
        }
        __syncthreads();
        if (wid < 4) {
            f32x16 Z = {};
            for (int si = 0; si <= ti; ++si) {
                f32x16 X = {};
#pragma unroll
                for (int ks = 0; ks < 8; ++ks) {
                    const bf16x8 a = *(const LAS bf16x8*)(lds + LKR + (32 * si + r32) * SQ + (16 * ks + 8 * hi) * 2);
                    const bf16x8 bq = *(const LAS bf16x8*)(lds + LQR + (32 * ti + r32) * SQ + (16 * ks + 8 * hi) * 2);
                    X = MFMA32(a, bq, X);
                }
                if (si == ti) {
#pragma unroll
                    for (int r = 0; r < 16; ++r) if (crow(r, hi) > r32) X[r] = 0.f;
                }
#pragma unroll
                for (int s2 = 0; s2 < 2; ++s2) {
                    union { u32x4 u; bf16x8 v; } pa;
                    pa.u.x = cvt_pk_bf16(X[8 * s2 + 0], X[8 * s2 + 1]); pa.u.y = cvt_pk_bf16(X[8 * s2 + 2], X[8 * s2 + 3]); pa.u.z = cvt_pk_bf16(X[8 * s2 + 4], X[8 * s2 + 5]); pa.u.w = cvt_pk_bf16(X[8 * s2 + 6], X[8 * s2 + 7]);
                    const LAS unsigned char* vp = lds + LV + (32 * si + 16 * s2 + trow) * SV + (32 * vi + tcol) * 2;
                    const s16x4 lo = tr4(vp), hh = tr4(vp + 8 * SV);
                    const bf16x8 vf = {lo[0], lo[1], lo[2], lo[3], hh[0], hh[1], hh[2], hh[3]};
                    Z = MFMA32(pa.v, vf, Z);
                }
            }
#pragma unroll
            for (int ks = 0; ks < 8; ++ks) {
                const bf16x8 a = *(const LAS bf16x8*)(lds + LQB + (32 * ti + r32) * SQ + (16 * ks + 8 * hi) * 2);
                const LAS unsigned char* sp = lds + LS + (16 * ks + 8 * hi + (tI >> 2)) * SS + (32 * vi + tcol) * 2;
                const s16x4 lo = tr4(sp), hh = tr4(sp + 4 * SS);
                const bf16x8 sf = {lo[0], lo[1], lo[2], lo[3], hh[0], hh[1], hh[2], hh[3]};
                Z = MFMA32(a, sf, Z);
            }
            bf16_t* op = HI + (rowb + (size_t)n * 64 + 32 * ti) * 512 + h * 128 + vh * 64 + 32 * vi + r32;
#pragma unroll
            for (int r = 0; r < 16; ++r) op[(size_t)crow(r, hi) * 512] = (bf16_t)(cvt_pk_bf16(Z[r], 0.f) & 0xffffu);
        }
        {
#pragma unroll
            for (int r = 0; r < 16; ++r) Sacc[r] *= CL[32 * di + crow(r, hi)];
#pragma unroll
            for (int ks = 0; ks < 4; ++ks) {
                const LAS unsigned char* kp = lds + LKD + (16 * ks + 8 * hi + (tI >> 2)) * SKD + (32 * di + tcol) * 2;
                const s16x4 klo = tr4(kp), khi = tr4(kp + 4 * SKD);
                const bf16x8 ka = {klo[0], klo[1], klo[2], klo[3], khi[0], khi[1], khi[2], khi[3]};
                const LAS unsigned char* vp = lds + LV + (16 * ks + 8 * hi + (tI >> 2)) * SV + (32 * vi + tcol) * 2;
                const s16x4 vlo = tr4(vp), vhi = tr4(vp + 4 * SV);
                const bf16x8 vb = {vlo[0], vlo[1], vlo[2], vlo[3], vhi[0], vhi[1], vhi[2], vhi[3]};
                Sacc = MFMA32(ka, vb, Sacc);
            }
        }
        __syncthreads();
        {
            LAS bf16_t* sp = (LAS bf16_t*)(lds + LS + (32 * di) * SS + (32 * vi + r32) * 2);
#pragma unroll
            for (int r = 0; r < 16; ++r) sp[crow(r, hi) * (SS / 2)] = (bf16_t)(cvt_pk_bf16(Sacc[r], 0.f) & 0xffffu);
        }
    }
    __syncthreads();
}

__device__ void moba_unit(const Params& P, int b, int h, int j, LAS unsigned char* lds) {
    const int tid = tid_opaque(), lane = tid & 63, wid = tid >> 6, r32 = lane & 31, hi = lane >> 5;
    bf16_t* Q = (bf16_t*)(P.ws + OFF_QA); const bf16_t* Kg = (const bf16_t*)(P.ws + OFF_KA); const bf16_t* Vg = (const bf16_t*)(P.ws + OFF_VA);
    const float* kmean = (const float*)(P.ws + OFF_KMEAN);
    constexpr int KIMG = 64 * 144, VIMG = 64 * 192, LK = 0, LV = 4 * KIMG, LKM = 4 * KIMG + 4 * VIMG;
    LAS float* kmL = (LAS float*)(lds + LKM);
    const size_t rowb = (size_t)b * SEQ; const int q0 = j * 256;
    if (tid < j * 64) kmL[tid] = kmean[(size_t)(b * 8 + (tid >> 6)) * 512 + h * 64 + (tid & 63)];
    bf16_t* qrow = Q + (rowb + q0 + wid * 32 + r32) * 512 + h * 64;
    bf16x8 qf[4];
#pragma unroll
    for (int d0 = 0; d0 < 4; ++d0) qf[d0] = *(const bf16x8*)(qrow + 16 * d0 + 8 * hi);
    const int srow = tid >> 3, sch = tid & 7;
    const bf16_t* ksrc = Kg + (rowb + srow) * 512 + h * 64 + sch * 8; const bf16_t* vsrc = Vg + (rowb + srow) * 512 + h * 64 + sch * 8;
    const int ntile = 4 * (j + 1), npair = ntile >> 1;
    auto tile_key0 = [&](int i) -> size_t { const int blk = (i < 4) ? j : ((i - 4) >> 2), kt = (i < 4) ? i : ((i - 4) & 3); return (size_t)(blk * 256 + kt * 64); };
    u32x4 kreg[2], vreg[2];
#pragma unroll
    for (int s = 0; s < 2; ++s) { const size_t k0 = tile_key0(s); kreg[s] = *(const u32x4*)(ksrc + k0 * 512); vreg[s] = *(const u32x4*)(vsrc + k0 * 512); }
#pragma unroll
    for (int s = 0; s < 2; ++s) { *(LAS u32x4*)(lds + LK + s * KIMG + srow * 144 + sch * 16) = kreg[s]; *(LAS u32x4*)(lds + LV + s * VIMG + srow * 192 + sch * 16) = vreg[s]; }
    __syncthreads();
    unsigned sel = 0;
    if (j <= 3) sel = (1u << j) - 1u;
    else {
        float g[7];
#pragma unroll
        for (int n = 0; n < 7; ++n) { float s = 0.f;
            if (n < j) {
#pragma unroll
                for (int d0 = 0; d0 < 4; ++d0)
#pragma unroll
                    for (int e = 0; e < 8; ++e) s += __uint_as_float(((unsigned)(unsigned short)qf[d0][e]) << 16) * kmL[n * 64 + 16 * d0 + 8 * hi + e];
            }
            s += __shfl_xor(s, 32); g[n] = s; }
#pragma unroll
        for (int it = 0; it < 3; ++it) { float best = -INFINITY; int bi = 0;
#pragma unroll
            for (int n = 0; n < 7; ++n) if (n < j && !((sel >> n) & 1u) && g[n] > best) { best = g[n]; bi = n; }
            sel |= 1u << bi; }
    }
    const float ch = exp2f(-(float)(h + 1)) * LOG2E;
    const int qb = wid * 32 + r32;
    float m_run = -1e30f;
    f32x16 o0 = {}, o1 = {}, o2 = {};
    f32x16 al0, al1;
#pragma unroll
    for (int r = 0; r < 16; ++r) { al0[r] = ch * (float)crow(r, hi); al1[r] = ch * (float)(crow(r, hi) + 32); }
    const bf16x8 ones8 = {(short)0x3F80, (short)0x3F80, (short)0x3F80, (short)0x3F80, (short)0x3F80, (short)0x3F80, (short)0x3F80, (short)0x3F80};
    const int tg = lane >> 4, tc = tg & 1, ti = lane & 15;
    const int vlane = (4 * hi + (ti >> 2)) * 192 + (16 * tc + 4 * (ti & 3)) * 2;
#pragma unroll 1
    for (int ip = 0; ip < npair; ++ip) {
      const int pbuf = ip & 1;
      if (ip + 1 < npair) {
#pragma unroll
          for (int s = 0; s < 2; ++s) { const size_t k1 = tile_key0(2 * ip + 2 + s); kreg[s] = *(const u32x4*)(ksrc + k1 * 512); vreg[s] = *(const u32x4*)(vsrc + k1 * 512); }
      }
#pragma unroll
      for (int s2 = 0; s2 < 2; ++s2) {
        const int i = 2 * ip + s2, buf = pbuf * 2 + s2;
        const bool own = i < 4; const int blk = own ? j : ((i - 4) >> 2), kt = own ? i : ((i - 4) & 3);
        const bool lane_ok = own ? true : (((sel >> blk) & 1u) != 0u);
        const bool skip = own ? (64 * kt > 32 * wid + 31) : (__ballot(lane_ok) == 0ull);
        if (!skip) {
            LAS unsigned char* kb = lds + LK + buf * KIMG; LAS unsigned char* vb = lds + LV + buf * VIMG;
            f32x16 p0, p1;
#pragma unroll
            for (int d0 = 0; d0 < 4; ++d0) {
                const bf16x8 kf0 = *(const LAS bf16x8*)(kb + r32 * 144 + (16 * d0 + 8 * hi) * 2);
                const bf16x8 kf1 = *(const LAS bf16x8*)(kb + (32 + r32) * 144 + (16 * d0 + 8 * hi) * 2);
                p0 = MFMA32(kf0, qf[d0], d0 == 0 ? al0 : p0); p1 = MFMA32(kf1, qf[d0], d0 == 0 ? al1 : p1);
            }
            const float kbase = ch * (float)((blk - j) * 256 + kt * 64);
            float mt = -1e30f;
#pragma unroll
            for (int r = 0; r < 16; ++r) {
                const int kl0 = crow(r, hi), kl1 = kl0 + 32;
                if (own) { if (kt * 64 + kl0 > qb) p0[r] = -1e30f; if (kt * 64 + kl1 > qb) p1[r] = -1e30f; }
                mt = fmaxf(mt, fmaxf(p0[r], p1[r]));
            }
            mt = lane_ok ? mt + kbase : -1e30f;
            mt = fmaxf(mt, __shfl_xor(mt, 32));
            if (__ballot(mt > m_run) != 0ull) {
                const float mnew = fmaxf(m_run, mt), alpha = __builtin_amdgcn_exp2f(m_run - mnew);
                m_run = mnew;
#pragma unroll
                for (int r = 0; r < 16; ++r) { o0[r] *= alpha; o1[r] *= alpha; o2[r] *= alpha; }
            }
            const float sh = lane_ok ? kbase - m_run : -1e30f;
#pragma unroll
            for (int r = 0; r < 16; ++r) { p0[r] = __builtin_amdgcn_exp2f(p0[r] + sh); p1[r] = __builtin_amdgcn_exp2f(p1[r] + sh); }
#pragma unroll
            for (int sub = 0; sub < 2; ++sub)
#pragma unroll
                for (int s = 0; s < 2; ++s) {
                    union { u32x4 u; bf16x8 v; } pb;
                    if (sub == 0) { pb.u.x = cvt_pk_bf16(p0[8 * s + 0], p0[8 * s + 1]); pb.u.y = cvt_pk_bf16(p0[8 * s + 2], p0[8 * s + 3]); pb.u.z = cvt_pk_bf16(p0[8 * s + 4], p0[8 * s + 5]); pb.u.w = cvt_pk_bf16(p0[8 * s + 6], p0[8 * s + 7]); }
                    else { pb.u.x = cvt_pk_bf16(p1[8 * s + 0], p1[8 * s + 1]); pb.u.y = cvt_pk_bf16(p1[8 * s + 2], p1[8 * s + 3]); pb.u.z = cvt_pk_bf16(p1[8 * s + 4], p1[8 * s + 5]); pb.u.w = cvt_pk_bf16(p1[8 * s + 6], p1[8 * s + 7]); }
#pragma unroll
                    for (int dt = 0; dt < 2; ++dt) {
                        LAS unsigned char* va = vb + (32 * sub + 16 * s) * 192 + dt * 64 + vlane;
                        const s16x4 lo = __builtin_bit_cast(s16x4, __builtin_amdgcn_ds_read_tr16_b64_v4i16((LAS s16x4*)va));
                        const s16x4 hh = __builtin_bit_cast(s16x4, __builtin_amdgcn_ds_read_tr16_b64_v4i16((LAS s16x4*)(va + 8 * 192)));
                        const bf16x8 vf = {lo[0], lo[1], lo[2], lo[3], hh[0], hh[1], hh[2], hh[3]};
                        if (dt == 0) o0 = MFMA32(vf, pb.v, o0); else o1 = MFMA32(vf, pb.v, o1);
                    }
                    o2 = MFMA32(ones8, pb.v, o2);
                }
        }
      }
      if (ip + 1 < npair) { const int nb = (pbuf ^ 1) * 2;
#pragma unroll
          for (int s = 0; s < 2; ++s) { *(LAS u32x4*)(lds + LK + (nb + s) * KIMG + srow * 144 + sch * 16) = kreg[s]; *(LAS u32x4*)(lds + LV + (nb + s) * VIMG + srow * 192 + sch * 16) = vreg[s]; } }
      __syncthreads();
    }
    const float inv = 1.0f / o2[0];
#pragma unroll
    for (int r4 = 0; r4 < 4; ++r4) {
        int w0 = __builtin_amdgcn_cvt_pk_fp8_f32(o0[4 * r4] * inv, o0[4 * r4 + 1] * inv, 0, false); w0 = __builtin_amdgcn_cvt_pk_fp8_f32(o0[4 * r4 + 2] * inv, o0[4 * r4 + 3] * inv, w0, true);
        int w1 = __builtin_amdgcn_cvt_pk_fp8_f32(o1[4 * r4] * inv, o1[4 * r4 + 1] * inv, 0, false); w1 = __builtin_amdgcn_cvt_pk_fp8_f32(o1[4 * r4 + 2] * inv, o1[4 * r4 + 3] * inv, w1, true);
        unsigned char* yrow = P.ws + OFF_EG + (rowb + q0 + wid * 32 + r32) * 1024 + h * 64;
        *(int*)(yrow + 8 * r4 + 4 * hi) = w0; *(int*)(yrow + 32 + 8 * r4 + 4 * hi) = w1;
    }
}

__device__ void yb_norm_panel(const Params& P, int pm) {
    const int tid = tid_opaque(), lane = tid & 63, wid = tid >> 6;
    bf16_t* HI = (bf16_t*)(P.ws + OFF_HI); const bf16_t* HG = (const bf16_t*)(P.ws + OFF_HG);
    for (int r = 0; r < 32; ++r) {
        const size_t off = ((size_t)pm * 256 + wid * 32 + r) * 512 + lane * 8;
        const u32x4 ov = *(const u32x4*)(HI + off), gv = *(const u32x4*)(HG + off);
        float o[8] = {bf_lo(ov.x), bf_hi(ov.x), bf_lo(ov.y), bf_hi(ov.y), bf_lo(ov.z), bf_hi(ov.z), bf_lo(ov.w), bf_hi(ov.w)};
        const float g[8] = {bf_lo(gv.x), bf_hi(gv.x), bf_lo(gv.y), bf_hi(gv.y), bf_lo(gv.z), bf_hi(gv.z), bf_lo(gv.w), bf_hi(gv.w)};
        float ss = 0.f;
#pragma unroll
        for (int e = 0; e < 8; ++e) ss += o[e] * o[e];
        ss += __shfl_xor(ss, 1); ss += __shfl_xor(ss, 2); ss += __shfl_xor(ss, 4); ss += __shfl_xor(ss, 8);
        const float rs = rsqrtf(ss * (1.0f / 128.0f) + RMS_EPS);
        int w0 = __builtin_amdgcn_cvt_pk_fp8_f32(o[0] * rs * g[0], o[1] * rs * g[1], 0, false); w0 = __builtin_amdgcn_cvt_pk_fp8_f32(o[2] * rs * g[2], o[3] * rs * g[3], w0, true);
        int w1 = __builtin_amdgcn_cvt_pk_fp8_f32(o[4] * rs * g[4], o[5] * rs * g[5], 0, false); w1 = __builtin_amdgcn_cvt_pk_fp8_f32(o[6] * rs * g[6], o[7] * rs * g[7], w1, true);
        *(u32x2*)(P.ws + OFF_EG + ((size_t)pm * 256 + wid * 32 + r) * 1024 + 512 + lane * 8) = (u32x2){(unsigned)w0, (unsigned)w1};
    }
}
__device__ void ln1_panel(const Params& P, int pm) {
    const int tid = tid_opaque(), lane = tid & 63, wid = tid >> 6;
    const float* ada = (const float*)(P.ws + OFF_ADA) + (size_t)(pm >> 3) * 6144; bf16_t* H = (bf16_t*)(P.ws + OFF_H);
    for (int r = 0; r < 32; ++r) {
        const size_t row = (size_t)pm * 256 + wid * 32 + r;
        const float* xin = P.x + row * 1024 + lane * 4; const unsigned char* dl = P.ws + OFF_GB + row * 2048 + lane * 4;
        f32x4 v[4]; float s = 0.f;
#pragma unroll
        for (int jx = 0; jx < 4; ++jx) { const int dv = *(const int*)(dl + 256 * jx); const f32x4 xv = __builtin_nontemporal_load((const f32x4*)(xin + 256 * jx));
            const f32x2 d01 = __builtin_amdgcn_cvt_pk_f32_fp8(dv, false), d23 = __builtin_amdgcn_cvt_pk_f32_fp8(dv, true);
            v[jx] = xv * ALPHA + (f32x4){d01.x, d01.y, d23.x, d23.y}; s += (v[jx][0] + v[jx][1]) + (v[jx][2] + v[jx][3]); }
        const float mean = wave_sum(s) * (1.0f / 1024.0f); float s2 = 0.f;
#pragma unroll
        for (int jx = 0; jx < 4; ++jx) { v[jx] = v[jx] - mean; s2 += (v[jx][0] * v[jx][0] + v[jx][1] * v[jx][1]) + (v[jx][2] * v[jx][2] + v[jx][3] * v[jx][3]); }
        const float rstd = rsqrtf(wave_sum(s2) * (1.0f / 1024.0f) + LN_EPS);
#pragma unroll
        for (int jx = 0; jx < 4; ++jx) {
            const int c = lane * 4 + 256 * jx;
            const f32x4 g = *(const f32x4*)(P.ln1_g + c), bb = *(const f32x4*)(P.ln1_b + c), sh = *(const f32x4*)(ada + 3072 + c), sc = *(const f32x4*)(ada + 4096 + c);
            const f32x4 x1 = v[jx] * rstd * g + bb;
            { u32x2 w1; w1.x = cvt_pk_bf16(x1[0], x1[1]); w1.y = cvt_pk_bf16(x1[2], x1[3]);
              *(u32x2*)((bf16_t*)(P.out + row * 1024) + c) = w1; }
            const f32x4 h2 = x1 * (sc + 1.0f) + sh;
            u32x2 w; w.x = cvt_pk_bf16(h2[0], h2[1]); w.y = cvt_pk_bf16(h2[2], h2[3]);
            *(u32x2*)(H + row * 1024 + c) = w;
            v[jx] = h2;
        }
        {
            float mx = 0.f;
#pragma unroll
            for (int jx = 0; jx < 4; ++jx) mx = fmaxf(mx, fmaxf(fmaxf(fabsf(v[jx][0]), fabsf(v[jx][1])), fmaxf(fabsf(v[jx][2]), fabsf(v[jx][3]))));
#pragma unroll
            for (int o = 1; o < 64; o <<= 1) mx = fmaxf(mx, __shfl_xor(mx, o));
            const float hs = fmaxf(mx * (1.0f / 119.0f), 1e-30f), inv = 1.0f / hs; int qs = 0;
            const int nsh = (lane & 1) * 4;
#pragma unroll
            for (int jx = 0; jx < 4; ++jx) {
                unsigned pa = 0u, pb = 0u;
#pragma unroll
                for (int k = 0; k < 4; ++k) { const int q = (int)rintf(v[jx][k] * inv); qs += q;
                    const int b = ((q + 8) & 15) - 8, a = (q - b) >> 4;
                    pa |= (unsigned)(a & 15) << (8 * k + nsh); pb |= (unsigned)(b & 15) << (8 * k + nsh); }
                pa |= __shfl_xor(pa, 1); pb |= __shfl_xor(pb, 1);
                if (!(lane & 1)) { unsigned* hp4 = (unsigned*)(P.ws + OFF_H8 + row * 1024) + (lane >> 1) + 32 * jx; hp4[0] = pa; hp4[128] = pb; }
            }
#pragma unroll
            for (int o = 1; o < 64; o <<= 1) qs += __shfl_xor(qs, o);
            if (lane == 0) *(f32x2*)(P.ws + OFF_HS + row * 8) = (f32x2){hs, (float)qs};
        }
    }
}

#define CE16(A, i, j) do { const float hi_ = fmaxf(A[i], A[j]); A[j] = fminf(A[i], A[j]); A[i] = hi_; } while (0)
#define SORT16(A) do { CE16(A, 0, 1); CE16(A, 2, 3); CE16(A, 0, 2); CE16(A, 1, 3); CE16(A, 1, 2); CE16(A, 4, 5); CE16(A, 6, 7); CE16(A, 4, 6); CE16(A, 5, 7); CE16(A, 5, 6); CE16(A, 0, 4); CE16(A, 2, 6); CE16(A, 2, 4); CE16(A, 1, 5); CE16(A, 3, 7); CE16(A, 3, 5); CE16(A, 1, 2); CE16(A, 3, 4); CE16(A, 5, 6); CE16(A, 8, 9); CE16(A, 10, 11); CE16(A, 8, 10); CE16(A, 9, 11); CE16(A, 9, 10); CE16(A, 12, 13); CE16(A, 14, 15); CE16(A, 12, 14); CE16(A, 13, 15); CE16(A, 13, 14); CE16(A, 8, 12); CE16(A, 10, 14); CE16(A, 10, 12); CE16(A, 9, 13); CE16(A, 11, 15); CE16(A, 11, 13); CE16(A, 9, 10); CE16(A, 11, 12); CE16(A, 13, 14); CE16(A, 0, 8); CE16(A, 4, 12); CE16(A, 4, 8); CE16(A, 2, 10); CE16(A, 6, 14); CE16(A, 6, 10); CE16(A, 2, 4); CE16(A, 6, 8); CE16(A, 10, 12); CE16(A, 1, 9); CE16(A, 5, 13); CE16(A, 5, 9); CE16(A, 3, 11); CE16(A, 7, 15); CE16(A, 7, 11); CE16(A, 3, 5); CE16(A, 7, 9); CE16(A, 11, 13); CE16(A, 1, 2); CE16(A, 3, 4); CE16(A, 5, 6); CE16(A, 7, 8); CE16(A, 9, 10); CE16(A, 11, 12); CE16(A, 13, 14); } while (0)
#define BITONIC16(A) do { CE16(A, 0, 8); CE16(A, 1, 9); CE16(A, 2, 10); CE16(A, 3, 11); CE16(A, 4, 12); CE16(A, 5, 13); CE16(A, 6, 14); CE16(A, 7, 15); CE16(A, 0, 4); CE16(A, 1, 5); CE16(A, 2, 6); CE16(A, 3, 7); CE16(A, 8, 12); CE16(A, 9, 13); CE16(A, 10, 14); CE16(A, 11, 15); CE16(A, 0, 2); CE16(A, 1, 3); CE16(A, 4, 6); CE16(A, 5, 7); CE16(A, 8, 10); CE16(A, 9, 11); CE16(A, 12, 14); CE16(A, 13, 15); CE16(A, 0, 1); CE16(A, 2, 3); CE16(A, 4, 5); CE16(A, 6, 7); CE16(A, 8, 9); CE16(A, 10, 11); CE16(A, 12, 13); CE16(A, 14, 15); } while (0)
#define INS16(L, xin) do { float x_ = (xin); _Pragma("unroll") for (int k_ = 0; k_ < 16; ++k_) { const float hi_ = fmaxf(L[k_], x_); x_ = fminf(L[k_], x_); L[k_] = hi_; } } while (0)

__device__ void peer_select_wave(const Params& P, size_t tok0) {
    const int lane = tid_opaque() & 63, r32 = lane & 31, hi = lane >> 5;
    const bf16_t* QP = (const bf16_t*)(P.ws + OFF_GB) + (tok0 + r32) * 1024; const bf16_t* SK = (const bf16_t*)(P.ws + OFF_SK);
    unsigned* EG = (unsigned*)(P.ws + OFF_EG) + (tok0 + r32) * 128;
#pragma unroll 1
    for (int h = 0; h < 8; ++h) {
        float a0[16], a1[16];
#pragma unroll
        for (int k = 0; k < 16; ++k) { a0[k] = -INFINITY; a1[k] = -INFINITY; }
#pragma unroll
        for (int p = 0; p < 2; ++p) {
            const int hp = h * 2 + p;
            bf16x8 qf[4];
#pragma unroll
            for (int ks = 0; ks < 4; ++ks) qf[ks] = *(const bf16x8*)(QP + hp * 64 + 16 * ks + 8 * hi);
            float L[16];
#pragma unroll
            for (int kt = 0; kt < 4; ++kt) {
                f32x16 acc = {};
#pragma unroll
                for (int ks = 0; ks < 4; ++ks) { const bf16x8 kf = *(const bf16x8*)(SK + ((size_t)hp * 128 + 32 * kt + r32) * 64 + 16 * ks + 8 * hi); acc = MFMA32(kf, qf[ks], acc); }
                float S[16];
#pragma unroll
                for (int r = 0; r < 16; ++r) { const unsigned key = (unsigned)(32 * kt + crow(r, hi)); S[r] = __uint_as_float((__float_as_uint(acc[r]) & ~127u) | key); }
                SORT16(S);
                if (kt == 0) {
#pragma unroll
                    for (int k = 0; k < 16; ++k) L[k] = S[k];
                } else {
#pragma unroll
                    for (int k = 0; k < 16; ++k) L[k] = fmaxf(L[k], S[15 - k]);
                    BITONIC16(L);
                }
            }
            {
                float O[16];
#pragma unroll
                for (int k = 0; k < 16; ++k) O[k] = __shfl_xor(L[15 - k], 32);
#pragma unroll
                for (int k = 0; k < 16; ++k) L[k] = fmaxf(L[k], O[k]);
                BITONIC16(L);
            }
#pragma unroll
            for (int k = 0; k < 16; ++k) { a0[k] = (p == 0) ? L[k] : a0[k]; a1[k] = (p == 1) ? L[k] : a1[k]; }
        }
        float best[16];
#pragma unroll
        for (int k = 0; k < 16; ++k) best[k] = __uint_as_float((__float_as_uint(a0[0] + a1[k]) & ~255u) | (unsigned)k);
#define PKC(i, j) __uint_as_float((__float_as_uint(a0[i] + a1[j]) & ~255u) | (unsigned)((i) * 16 + (j)))
        {
            float A[16] = {PKC(1, 0), PKC(1, 1), PKC(1, 2), PKC(1, 3), PKC(1, 4), PKC(1, 5), PKC(1, 6), PKC(1, 7), PKC(15, 0), PKC(14, 0), PKC(13, 0), PKC(12, 0), PKC(11, 0), PKC(10, 0), PKC(9, 0), PKC(8, 0)};
            BITONIC16(A);
#pragma unroll
            for (int k = 0; k < 16; ++k) best[k] = fmaxf(best[k], A[15 - k]);
            BITONIC16(best);
            float B[16] = {PKC(2, 0), PKC(2, 1), PKC(2, 2), PKC(2, 3), PKC(2, 4), PKC(3, 0), PKC(3, 1), PKC(3, 2), PKC(3, 3), PKC(4, 0), PKC(4, 1), PKC(4, 2), PKC(5, 0), PKC(5, 1), PKC(6, 0), PKC(6, 1)};
            SORT16(B);
#pragma unroll
            for (int k = 0; k < 16; ++k) best[k] = fmaxf(best[k], B[15 - k]);
            BITONIC16(best);
            INS16(best, PKC(7, 0)); INS16(best, PKC(7, 1));
        }
#undef PKC
        unsigned pk0[4], pk1[4];
#pragma unroll
        for (int q = 0; q < 4; ++q) {
            pk0[q] = (__float_as_uint(a0[4 * q]) & 127u) | ((__float_as_uint(a0[4 * q + 1]) & 127u) << 8) | ((__float_as_uint(a0[4 * q + 2]) & 127u) << 16) | ((__float_as_uint(a0[4 * q + 3]) & 127u) << 24);
            pk1[q] = (__float_as_uint(a1[4 * q]) & 127u) | ((__float_as_uint(a1[4 * q + 1]) & 127u) << 8) | ((__float_as_uint(a1[4 * q + 2]) & 127u) << 16) | ((__float_as_uint(a1[4 * q + 3]) & 127u) << 24);
        }
        unsigned pay[16];
#pragma unroll
        for (int k = 0; k < 16; ++k) {
            const unsigned code = __float_as_uint(best[k]) & 255u, ci = code >> 4, cj = code & 15u;
            const unsigned qi = ci >> 2, qj = cj >> 2;
            const unsigned w0 = (qi == 0u) ? pk0[0] : ((qi == 1u) ? pk0[1] : ((qi == 2u) ? pk0[2] : pk0[3]));
            const unsigned w1 = (qj == 0u) ? pk1[0] : ((qj == 1u) ? pk1[1] : ((qj == 2u) ? pk1[2] : pk1[3]));
            pay[k] = (((w0 >> ((ci & 3u) * 8u)) & 127u) << 7) | ((w1 >> ((cj & 3u) * 8u)) & 127u);
        }
        float e[16], es = 0.f;
#pragma unroll
        for (int k = 0; k < 16; ++k) { e[k] = __expf(best[k] - best[0]); es += e[k]; }
        const float inv = 1.0f / es;
        if (hi == 0) {
#pragma unroll
            for (int k = 0; k < 16; ++k) EG[h * 16 + k] = pay[k] | (cvt_pk_bf16(e[k] * inv, 0.f) << 16);
        }
    }
}
__device__ __forceinline__ unsigned xcc_id() { return (unsigned)__builtin_amdgcn_s_getreg((3 << 11) | 20) & 0xFu; }
__device__ __forceinline__ float dot16_fp8(const float (&hv)[16], const u32x4 r) {
    float s = 0.f;
    { const f32x2 a = __builtin_amdgcn_cvt_pk_f32_fp8((int)r.x, false), b = __builtin_amdgcn_cvt_pk_f32_fp8((int)r.x, true); s += hv[0] * a.x + hv[1] * a.y + hv[2] * b.x + hv[3] * b.y; }
    { const f32x2 a = __builtin_amdgcn_cvt_pk_f32_fp8((int)r.y, false), b = __builtin_amdgcn_cvt_pk_f32_fp8((int)r.y, true); s += hv[4] * a.x + hv[5] * a.y + hv[6] * b.x + hv[7] * b.y; }
    { const f32x2 a = __builtin_amdgcn_cvt_pk_f32_fp8((int)r.z, false), b = __builtin_amdgcn_cvt_pk_f32_fp8((int)r.z, true); s += hv[8] * a.x + hv[9] * a.y + hv[10] * b.x + hv[11] * b.y; }
    { const f32x2 a = __builtin_amdgcn_cvt_pk_f32_fp8((int)r.w, false), b = __builtin_amdgcn_cvt_pk_f32_fp8((int)r.w, true); s += hv[12] * a.x + hv[13] * a.y + hv[14] * b.x + hv[15] * b.y; }
    return s;
}
template <int NP, class F> __device__ __forceinline__ void partition_queue(const Params& P, LAS unsigned char* lds, int ctr_base, F f) {
    const int tid = tid_opaque();
    LAS int* slot = (LAS int*)(lds + LDS_BYTES - 64);
    unsigned* ctr = (unsigned*)(P.ws + OFF_CTR) + ctr_base;
    const int myx = (int)(xcc_id() & 7u);
    for (int pp = 0; pp < NP; ++pp) {
        const int p = (myx * (NP / 8) + pp) % NP;
        for (;;) {
            if (tid == 0) *slot = (int)atomicAdd(ctr + p, 1u);
            __syncthreads();
            const int item = *slot;
            __syncthreads();
            if (item >= NTOK / 64) break;
            f(p, item);
        }
    }
}
__device__ __forceinline__ float dot2bf(unsigned a, bf16v2 b, float c) { return __builtin_amdgcn_fdot2_f32_bf16(__builtin_bit_cast(bf16v2, a), b, c, false); }
__device__ __forceinline__ float gelu_erf(float v) {
    const float av = fabsf(v), t = __builtin_amdgcn_rcpf(__builtin_fmaf(av, 0.2316418882f, 1.0f));
    float q = __builtin_fmaf(t, 0.5307027145f, -0.7265760135f); q = __builtin_fmaf(q, t, 0.7107068705f); q = __builtin_fmaf(q, t, -0.142248368f); q = __builtin_fmaf(q, t, 0.127414796f); q = q * t;
    const float m = v * (q * __builtin_amdgcn_exp2f(v * v * -0.72134752044f));
    return v < 0.f ? m : v - m;
}
struct UQuad { u32x4 r[2]; u32x4 ent, nxt; };
__device__ __forceinline__ void uq_issue(UQuad& q, const LAS u32x4* list, int J, int NQ, int g, const unsigned char* Ub, const unsigned lo) {
    q.ent = q.nxt;
    const unsigned char* rp = Ub + (q.ent.x * 512u + lo);
    q.r[0] = *(const u32x4*)rp; q.r[1] = *(const u32x4*)(rp + 256);
    const int jj = J < NQ ? J : NQ - 1;
    q.nxt = list[4 * jj + g];
}
__device__ __forceinline__ float uq_dot(const UQuad& q, const u32x4 (&hp)[4]) {
    int a = 0, b = 0;
#pragma unroll
    for (int c = 0; c < 2; ++c) {
        const u32x4 r = q.r[c];
        a = __builtin_amdgcn_sdot8((int)hp[c].x, (int)r.x, a, false); a = __builtin_amdgcn_sdot8((int)hp[c].y, (int)r.y, a, false);
        a = __builtin_amdgcn_sdot8((int)hp[c].z, (int)r.z, a, false); a = __builtin_amdgcn_sdot8((int)hp[c].w, (int)r.w, a, false);
        b = __builtin_amdgcn_sdot8((int)hp[2 + c].x, (int)r.x, b, false); b = __builtin_amdgcn_sdot8((int)hp[2 + c].y, (int)r.y, b, false);
        b = __builtin_amdgcn_sdot8((int)hp[2 + c].z, (int)r.z, b, false); b = __builtin_amdgcn_sdot8((int)hp[2 + c].w, (int)r.w, b, false);
    }
    float s = (float)(16 * a + b);
    s = dpp_add<0xB1>(s); s = dpp_add<0x4E>(s); s = dpp_add<0x141>(s); s = dpp_add<0x140>(s);
    return s;
}
__device__ __forceinline__ void peer_u_tokens(const Params& P, LAS unsigned char* lds, const size_t t0) {
    const int tid = tid_opaque(), lane = tid & 63, wid = tid >> 6, g = lane >> 4, li = lane & 15;
    const unsigned char* H8 = P.ws + OFF_H8 + li * 16; const unsigned char* Ub = P.ws + OFF_U8; const unsigned lo16 = (unsigned)li * 16u;
    const f32x2* HS = (const f32x2*)(P.ws + OFF_HS); const float* USC = (const float*)(P.ws + OFF_USC);
    const u32x2* EG2 = (const u32x2*)(P.ws + OFF_EG); unsigned* W = (unsigned*)(P.ws + OFF_W);
    LAS u32x4* list = (LAS u32x4*)(lds + wid * 16384);
    {
        u32x2 egv[8]; float s0[8], s1[8];
#pragma unroll
        for (int i = 0; i < 8; ++i) egv[i] = EG2[(t0 + i) * 64 + lane];
#pragma unroll
        for (int i = 0; i < 8; ++i) { s0[i] = USC[egv[i].x & 0xFFFFu]; s1[i] = USC[egv[i].y & 0xFFFFu]; }
#pragma unroll
        for (int i = 0; i < 8; ++i) {
            list[i * 128 + 2 * lane] = (u32x4){egv[i].x & 0xFFFFu, egv[i].x & 0xFFFF0000u, (unsigned)(2 * lane) | (unsigned)(i << 8), __float_as_uint(s0[i])};
            list[i * 128 + 2 * lane + 1] = (u32x4){egv[i].y & 0xFFFFu, egv[i].y & 0xFFFF0000u, (unsigned)(2 * lane + 1) | (unsigned)(i << 8), __float_as_uint(s1[i])};
        }
    }
    constexpr int NQ = 256;
    u32x4 hp[4], hn[4]; f32x2 hsc = HS[t0], hsn = HS[t0 + 1];
#pragma unroll
    for (int c = 0; c < 2; ++c) { hp[c] = *(const u32x4*)(H8 + t0 * 1024 + 256 * c); hp[2 + c] = *(const u32x4*)(H8 + t0 * 1024 + 512 + 256 * c);
                                  hn[c] = *(const u32x4*)(H8 + (t0 + 1) * 1024 + 256 * c); hn[2 + c] = *(const u32x4*)(H8 + (t0 + 1) * 1024 + 512 + 256 * c); }
    int curtok = 0;
    UQuad q0, q1, q2, q3, q4, q5, q6, q7;
    q0.nxt = list[g]; q1.nxt = list[4 + g]; q2.nxt = list[8 + g]; q3.nxt = list[12 + g]; q4.nxt = list[16 + g]; q5.nxt = list[20 + g]; q6.nxt = list[24 + g]; q7.nxt = list[28 + g];
    uq_issue(q0, list, 8, NQ, g, Ub, lo16); uq_issue(q1, list, 9, NQ, g, Ub, lo16); uq_issue(q2, list, 10, NQ, g, Ub, lo16); uq_issue(q3, list, 11, NQ, g, Ub, lo16);
    uq_issue(q4, list, 12, NQ, g, Ub, lo16); uq_issue(q5, list, 13, NQ, g, Ub, lo16); uq_issue(q6, list, 14, NQ, g, Ub, lo16); uq_issue(q7, list, 15, NQ, g, Ub, lo16);
    float sv = 0.f; unsigned gv = 0u, zv = 0u, ev = 0u;
#define UQ_PIN(q) asm volatile("" : "+v"(q.r[0]), "+v"(q.r[1]) :: "memory")
#define UQ_STEP(q, Jn, kq, qn) do { \
        const float s = __uint_as_float(q.ent.w) * hsc.x * (uq_dot(q, hp) + 0.5f * hsc.y); \
        if (li == (kq)) { sv = s; gv = q.ent.y; zv = q.ent.z; ev = q.ent.x; } \
        uq_issue(q, list, (Jn), NQ, g, Ub, lo16); UQ_PIN(qn); } while (0)
    UQ_PIN(q0);
#pragma unroll 1
    for (int J = 0; J < NQ; J += 8) {
        const int tk = __builtin_amdgcn_readfirstlane((int)(q0.ent.z >> 8));
        if (tk != curtok) { curtok = tk;
#pragma unroll
            for (int c = 0; c < 4; ++c) hp[c] = hn[c];
            hsc = hsn;
            if (tk + 1 < 8) { hsn = HS[t0 + tk + 1];
#pragma unroll
                for (int c = 0; c < 2; ++c) { hn[c] = *(const u32x4*)(H8 + (t0 + tk + 1) * 1024 + 256 * c); hn[2 + c] = *(const u32x4*)(H8 + (t0 + tk + 1) * 1024 + 512 + 256 * c); } } }
        UQ_STEP(q0, J + 16, 0, q1); UQ_STEP(q1, J + 17, 1, q2); UQ_STEP(q2, J + 18, 2, q3); UQ_STEP(q3, J + 19, 3, q4);
        UQ_STEP(q4, J + 20, 4, q5); UQ_STEP(q5, J + 21, 5, q6); UQ_STEP(q6, J + 22, 6, q7); UQ_STEP(q7, J + 23, 7, q0);
        if (li < 8) W[(t0 + tk) * 128 + (zv & 255u)] = ev | (cvt_pk_bf16(__uint_as_float(gv) * gelu_erf(sv), 0.f) << 16); }
#undef UQ_STEP
}
typedef int v4i_t __attribute__((ext_vector_type(4)));
struct VQuad { u32x4 r[2]; u32x2 ent, nxt; };
__device__ __forceinline__ void vq_issue(VQuad& q, const LAS u32x2* list, int J, int g, const unsigned char* Vb, const unsigned lo) {
    q.ent = q.nxt;
    const unsigned char* rp = Vb + (q.ent.x * 512u + lo);
    q.r[0] = *(const u32x4*)rp; q.r[1] = *(const u32x4*)(rp + 256);
    const int jj = J < 256 ? J : 255;
    q.nxt = list[4 * jj + g];
}
#define VQ_PIN(q) asm volatile("" : "+v"(q.r[0]), "+v"(q.r[1]) :: "memory")
__device__ __forceinline__ void vq_mma(const VQuad& q, v4i_t (&acc)[4], const u32x4 bm) {
    const unsigned t = q.ent.y;
    const v4i_t B = {(int)(t & bm.x), (int)(t & bm.y), (int)(t & bm.z), (int)(t & bm.w)};
#pragma unroll
    for (int c = 0; c < 2; ++c) {
        const u32x4 r = q.r[c];
        const v4i_t lo = {(int)(r.x & 0x0F0F0F0Fu), (int)(r.y & 0x0F0F0F0Fu), (int)(r.z & 0x0F0F0F0Fu), (int)(r.w & 0x0F0F0F0Fu)};
        const v4i_t raw = {(int)r.x, (int)r.y, (int)r.z, (int)r.w};
        acc[2 * c] = __builtin_amdgcn_mfma_i32_16x16x64_i8(lo, B, acc[2 * c], 0, 0, 0);
        acc[2 * c + 1] = __builtin_amdgcn_mfma_i32_16x16x64_i8(raw, B, acc[2 * c + 1], 0, 0, 0);
    }
}
__device__ __forceinline__ void peer_v_tokens(const Params& P, LAS unsigned char* lds, const size_t t0) {
    const int tid = tid_opaque(), lane = tid & 63, wid = tid >> 6, g = lane >> 4, li = lane & 15;
    const unsigned char* Vb = P.ws + OFF_V8; const unsigned lo16 = (unsigned)li * 16u; const float* VSC = (const float*)(P.ws + OFF_VSC);
    const u32x2* W2 = (const u32x2*)(P.ws + OFF_W);
    LAS u32x2* lists = (LAS u32x2*)(lds + wid * 8192);
    LAS f32x2* tokp = (LAS f32x2*)(lds + 65536 + wid * 64);
    {
        u32x2 egv[8]; f32x2 wwv[8];
#pragma unroll
        for (int i = 0; i < 8; ++i) { const u32x2 ew = W2[(t0 + i) * 64 + lane]; egv[i].x = ew.x & 0xFFFFu; egv[i].y = ew.y & 0xFFFFu; wwv[i] = (f32x2){__uint_as_float(ew.x & 0xFFFF0000u), __uint_as_float(ew.y & 0xFFFF0000u)}; }
        float w0v[8], w1v[8];
#pragma unroll
        for (int i = 0; i < 8; ++i) { w0v[i] = wwv[i].x * VSC[egv[i].x]; w1v[i] = wwv[i].y * VSC[egv[i].y]; }
#pragma unroll
        for (int i = 0; i < 8; ++i) {
            const float mx = wave_max_fast(fmaxf(fabsf(w0v[i]), fabsf(w1v[i])));
            const float sw = fmaxf(mx * (1.0f / 127.0f), 1e-30f), inv = 1.0f / sw;
            const int q0 = (int)rintf(w0v[i] * inv), q1 = (int)rintf(w1v[i] * inv);
            *(LAS u32x4*)(lists + i * 128 + 2 * lane) = (u32x4){egv[i].x, ((unsigned)q0 & 255u) * 0x01010101u, egv[i].y, ((unsigned)q1 & 255u) * 0x01010101u};
            const int qs = wave_sum_int_fast(q0 + q1);
            if (lane == 0) tokp[i] = (f32x2){sw, 7.5f * sw * (float)qs}; }
    }
    const unsigned bsel = 0xFFu << (8u * (unsigned)(li & 3));
    const u32x4 bm = {(li >> 2) == 0 ? bsel : 0u, (li >> 2) == 1 ? bsel : 0u, (li >> 2) == 2 ? bsel : 0u, (li >> 2) == 3 ? bsel : 0u};
    const int dbase = 128 * g + 8 * (li >> 2) + (li & 3);
    float gt2v[16], lgv[16], lbv[16];
    { const float* gt2 = (const float*)(P.ws + OFF_ADA) + (t0 >> 11) * 6144 + 5120;
#pragma unroll
      for (int c = 0; c < 2; ++c)
#pragma unroll
          for (int hf = 0; hf < 2; ++hf)
#pragma unroll
              for (int r = 0; r < 4; ++r) { const int d = dbase + 512 * c + 32 * r + 4 * hf, e = 8 * c + 4 * hf + r; gt2v[e] = gt2[d]; lgv[e] = P.ln2_g[d]; lbv[e] = P.ln2_b[d]; } }
    VQuad q0, q1, q2, q3, q4, q5, q6, q7;
    q0.nxt = lists[g]; q1.nxt = lists[4 + g]; q2.nxt = lists[8 + g]; q3.nxt = lists[12 + g]; q4.nxt = lists[16 + g]; q5.nxt = lists[20 + g]; q6.nxt = lists[24 + g]; q7.nxt = lists[28 + g];
    vq_issue(q0, lists, 8, g, Vb, lo16); vq_issue(q1, lists, 9, g, Vb, lo16); vq_issue(q2, lists, 10, g, Vb, lo16); vq_issue(q3, lists, 11, g, Vb, lo16);
    vq_issue(q4, lists, 12, g, Vb, lo16); vq_issue(q5, lists, 13, g, Vb, lo16); vq_issue(q6, lists, 14, g, Vb, lo16); vq_issue(q7, lists, 15, g, Vb, lo16);
    VQ_PIN(q0);
#pragma unroll 1
    for (int i = 0; i < 8; ++i) {
        const size_t t = t0 + i;
        v4i_t acc[4];
#pragma unroll
        for (int j = 0; j < 4; ++j) acc[j] = (v4i_t){0, 0, 0, 0};
        float* xr = P.out + t * 1024;
        float xv[16];
#pragma unroll
        for (int c = 0; c < 2; ++c)
#pragma unroll
            for (int hf = 0; hf < 2; ++hf)
#pragma unroll
                for (int r = 0; r < 4; ++r) xv[8 * c + 4 * hf + r] = __uint_as_float((unsigned)((const bf16_t*)xr)[dbase + 512 * c + 32 * r + 4 * hf] << 16);
#pragma unroll 1
        for (int J = 32 * i; J < 32 * i + 32; J += 8) {
            vq_mma(q0, acc, bm); vq_issue(q0, lists, J + 16, g, Vb, lo16); VQ_PIN(q1);
            vq_mma(q1, acc, bm); vq_issue(q1, lists, J + 17, g, Vb, lo16); VQ_PIN(q2);
            vq_mma(q2, acc, bm); vq_issue(q2, lists, J + 18, g, Vb, lo16); VQ_PIN(q3);
            vq_mma(q3, acc, bm); vq_issue(q3, lists, J + 19, g, Vb, lo16); VQ_PIN(q4);
            vq_mma(q4, acc, bm); vq_issue(q4, lists, J + 20, g, Vb, lo16); VQ_PIN(q5);
            vq_mma(q5, acc, bm); vq_issue(q5, lists, J + 21, g, Vb, lo16); VQ_PIN(q6);
            vq_mma(q6, acc, bm); vq_issue(q6, lists, J + 22, g, Vb, lo16); VQ_PIN(q7);
            vq_mma(q7, acc, bm); vq_issue(q7, lists, J + 23, g, Vb, lo16); VQ_PIN(q0);
        }
        const f32x2 tp = tokp[i]; const float sw = tp.x, yoff = tp.y;
        float pre[16]; float s = 0.f;
#pragma unroll
        for (int c = 0; c < 2; ++c)
#pragma unroll
            for (int hf = 0; hf < 2; ++hf)
#pragma unroll
                for (int r = 0; r < 4; ++r) { const int e = 8 * c + 4 * hf + r;
                    const float yv = hf == 0 ? sw * (float)acc[2 * c][r] - yoff : (sw * 0.0625f) * (float)(acc[2 * c + 1][r] - acc[2 * c][r]) + yoff * (1.0f / 15.0f);
                    const float pv = ALPHA * xv[e] + gt2v[e] * yv; pre[e] = pv; s += pv; }
        const float mean = wave_sum_fast(s) * (1.0f / 1024.0f); float s2 = 0.f;
#pragma unroll
        for (int e = 0; e < 16; ++e) { pre[e] -= mean; s2 += pre[e] * pre[e]; }
        const float rstd = rsqrtf(wave_sum_fast(s2) * (1.0f / 1024.0f) + LN_EPS);
#pragma unroll
        for (int c = 0; c < 2; ++c)
#pragma unroll
            for (int hf = 0; hf < 2; ++hf)
#pragma unroll
                for (int r = 0; r < 4; ++r) { const int e = 8 * c + 4 * hf + r;
                    xr[dbase + 512 * c + 32 * r + 4 * hf] = pre[e] * rstd * lgv[e] + lbv[e]; }
    }
}

#define XB_TMO      128
#define XB_XCNT(j)  (256  + 64 * (j))
#define XB_XSUB(j)  (1280 + 64 * (j))
#define XB_XGEN(j)  (2304 + 64 * (j))
#define XB_TOP      3328
#define XB_TOPGEN   3392
#define XCD_BAR_WORDS 3456
#define XB_SPIN_CAP (1u << 22)
__device__ __forceinline__ unsigned xb_ld(unsigned* p)              { return __hip_atomic_load(p, __ATOMIC_RELAXED, __HIP_MEMORY_SCOPE_AGENT); }
__device__ __forceinline__ unsigned xb_add(unsigned* p, unsigned v) { return __hip_atomic_fetch_add(p, v, __ATOMIC_RELAXED, __HIP_MEMORY_SCOPE_AGENT); }
#define XB_SPIN(cond, bar) do { unsigned _sp = 0; while (cond) { __builtin_amdgcn_s_sleep(1); \
    if ((++_sp & 255u) == 0u) { if (xb_ld(&(bar)[XB_TMO])) break; if (_sp > XB_SPIN_CAP) { atomicAdd(&(bar)[XB_TMO], 1u); break; } } } } while (0)
struct XcdBarrier { unsigned* bar; unsigned x; volatile LAS unsigned* st; };
__device__ __forceinline__ XcdBarrier xcd_barrier_post(unsigned* bar, volatile LAS unsigned* st) {
    XcdBarrier b; b.bar = bar; b.x = xcc_id(); b.st = st;
    if (threadIdx.x == 0) (void)xb_add(&bar[XB_XCNT(b.x)], 1u);
    return b;
}
__device__ __forceinline__ void xcd_barrier_complete(unsigned* bar, unsigned x, unsigned& nloc, unsigned& nx) {
    const unsigned G = gridDim.x * gridDim.y * gridDim.z;
    unsigned sum, cnt, mine, sp = 0u;
    for (;;) {
        sum = 0u; cnt = 0u; mine = 0u;
#pragma unroll
        for (unsigned j = 0; j < 16; ++j) { const unsigned c = xb_ld(&bar[XB_XCNT(j)]); sum += c; cnt += (c > 0u) ? 1u : 0u; mine = (j == x) ? c : mine; }
        if (sum == G) break;
        __builtin_amdgcn_s_sleep(1);
        if ((++sp & 255u) == 0u) { if (xb_ld(&bar[XB_TMO])) break; if (sp > XB_SPIN_CAP) { atomicAdd(&bar[XB_TMO], 1u); break; } }
    }
    nloc = mine > 0u ? mine : 1u; nx = cnt > 0u ? cnt : 1u;
}
__device__ __forceinline__ void xcd_barrier(const XcdBarrier& b) {
    asm volatile("s_waitcnt vmcnt(0)" ::: "memory");
    __syncthreads();
    if (threadIdx.x == 0) {
        unsigned* bar = b.bar;
        __builtin_amdgcn_s_waitcnt(0);
        unsigned nloc = b.st[0], nx = b.st[1];
        if (nloc == 0u) { xcd_barrier_complete(bar, b.x, nloc, nx); b.st[0] = nloc; b.st[1] = nx; }
        const unsigned old = xb_add(&bar[XB_XSUB(b.x)], 1u);
        const unsigned gen = old / nloc;
        if (old + 1u == (gen + 1u) * nloc) {
            __builtin_amdgcn_fence(__ATOMIC_RELEASE, "agent");
            asm volatile("s_waitcnt vmcnt(0)" ::: "memory");
            const unsigned og = xb_add(&bar[XB_TOP], 1u);
            const unsigned tg = og / nx;
            if (og + 1u == (tg + 1u) * nx) xb_add(&bar[XB_TOPGEN], 1u);
            else XB_SPIN(xb_ld(&bar[XB_TOPGEN]) == tg, bar);
            __builtin_amdgcn_fence(__ATOMIC_ACQUIRE, "agent");
            xb_add(&bar[XB_XGEN(b.x)], 1u);
            asm volatile("s_waitcnt vmcnt(0)" ::: "memory");
        } else {
            XB_SPIN(xb_ld(&bar[XB_XGEN(b.x)]) == gen, bar);
            __builtin_amdgcn_fence(__ATOMIC_ACQUIRE, "agent");
            asm volatile("s_waitcnt vmcnt(0)" ::: "memory");
        }
    }
    __syncthreads();
}

__global__ void __launch_bounds__(NTHR, 2) fwd_megakernel(Params P) {
    extern __shared__ __attribute__((aligned(16))) unsigned char shm[];
    LAS unsigned char* lds = (LAS unsigned char*)shm;
    cg::grid_group grid = cg::this_grid();
    const int G = gridDim.x, bid = blockIdx.x;
    volatile LAS unsigned* xst = (volatile LAS unsigned*)(lds + LDS_BYTES - 128);
    if (threadIdx.x == 0) { xst[0] = 0u; xst[1] = 0u; }
    __syncthreads();
    if (bid == 0) { unsigned* bw = (unsigned*)(P.ws + OFF_BAR); for (int i = threadIdx.x; i < XCD_BAR_WORDS; i += NTHR) bw[i] = 0u; __threadfence(); }

#ifndef P3
#define P3 0xff
#endif
#ifndef PH
#define PH 0xff
#endif
    if (PH & 1) phase0a(P, lds);
    grid.sync();
    const XcdBarrier xb = xcd_barrier_post((unsigned*)(P.ws + OFF_BAR), xst);
    if (PH & 2) phase0b(P);
    xcd_barrier(xb);
    if (PH & 4) {
        pg8::Gemm g; g.A = (const bf16_t*)(P.ws + OFF_H); g.Bt = (const bf16_t*)(P.ws + OFF_WIN); g.M = NTOK; g.N = INCOLS; { int k_ = 512; asm volatile("" : "+s"(k_)); g.K = k_; g.lda = k_; }
        pg8::StaticOrder S; S.init(NTOK, INCOLS, G, bid);
        EpiProj E; E.ws = P.ws; E.lb = (const float*)(P.ws + OFF_LB); E.ng = P.hgrn_ng; E.kmean = (float*)(P.ws + OFF_KMEAN);
        pg8::gemm_phase<EpiProj, pg8::StaticOrder, true>(lds, g, S, E);
    }
    xcd_barrier(xb);
    if (PH & 8) for (int it = bid; it < 256; it += G) hgrn_item(P, it, lds);
    if (PH & 16) for (int u = bid; u < 2048; u += G) { const int bh = u & 255, jj = u >> 8; moba_unit(P, bh >> 3, bh & 7, (jj + bh) & 7, lds); }
    xcd_barrier(xb);
    if ((PH & 32) && bid < NTOK / 256) { const int pm = bid;
        if (P3 & 1) yb_norm_panel(P, pm);
        __syncthreads();
        if (P3 & 2) { pg8::Gemm g; g.A = (const bf16_t*)(P.ws + OFF_EG); g.Bt = (const bf16_t*)(P.ws + OFF_WBA); g.M = NTOK; g.N = 1024; { int k_ = 256; asm volatile("" : "+s"(k_)); g.K = k_; } g.lda = 512;
          pg8::PanelOrder S; S.pm = pm; S.npn = 4; EpiMixA E; E.GA = P.ws + OFF_GA;
          pg8::gemm_phase<EpiMixA, pg8::PanelOrder, true>(lds, g, S, E); }
        __syncthreads();
        if (P3 & 4) { pg8::Gemm g; g.A = (const bf16_t*)(P.ws + OFF_EG + 512); g.Bt = (const bf16_t*)(P.ws + OFF_WBB); g.M = NTOK; g.N = 1024; { int k_ = 256; asm volatile("" : "+s"(k_)); g.K = k_; } g.lda = 512;
          pg8::PanelOrder S; S.pm = pm; S.npn = 4; EpiMixB E; E.GA = P.ws + OFF_GA; E.GB = P.ws + OFF_GB; E.M8 = P.ws + OFF_QA;
          pg8::gemm_phase<EpiMixB, pg8::PanelOrder, true>(lds, g, S, E); }
        __syncthreads();
        if (P3 & 8) { pg8::Gemm g; g.A = (const bf16_t*)(P.ws + OFF_QA); g.Bt = (const bf16_t*)(P.ws + OFF_WOUT); g.M = NTOK; g.N = 1024; { int k_ = 512; asm volatile("" : "+s"(k_)); g.K = k_; g.lda = k_; }
          pg8::PanelOrder S; S.pm = pm; S.npn = 4; EpiOut E; E.ada = (const float*)(P.ws + OFF_ADA); E.D = (bf16_t*)(P.ws + OFF_GB);
          pg8::gemm_phase<EpiOut, pg8::PanelOrder, true>(lds, g, S, E); }
        __syncthreads();
        if (P3 & 16) ln1_panel(P, pm);
        __syncthreads();
        if (P3 & 32) { pg8::Gemm g; g.A = (const bf16_t*)(P.ws + OFF_H); g.Bt = (const bf16_t*)(P.ws + OFF_WQ); g.M = NTOK; g.N = 1024; g.K = 1024; g.lda = 1024;
          pg8::PanelOrder S; S.pm = pm; S.npn = 4; EpiBf16 E; E.O = (bf16_t*)(P.ws + OFF_GB);
          pg8::gemm_phase<EpiBf16, pg8::PanelOrder>(lds, g, S, E); }
        __syncthreads();
        { const size_t tok0 = (size_t)pm * 256 + (tid_opaque() >> 6) * 32;
          peer_select_wave(P, tok0);
          __syncthreads();
#pragma unroll 1
          for (int sb = 0; sb < 4; ++sb) {
              peer_u_tokens(P, lds, tok0 + 8 * sb);
              __syncthreads();
              peer_v_tokens(P, lds, tok0 + 8 * sb);
              __syncthreads();
          } }
    }
}

extern "C" void kernel_launch(void* const* d_in, const int* in_sizes, int n_in, void* d_out, int out_size, void* d_ws, size_t ws_size, hipStream_t stream) {
    static int grid_blocks = 0;
    if (grid_blocks == 0) {
        if (n_in != 18 || out_size != NTOK * DM || ws_size < WS_END) { fprintf(stderr, "kernel_launch: unexpected shapes (n_in %d, out %d, ws %zu, need %zu)\n", n_in, out_size, ws_size, (size_t)WS_END); grid_blocks = -1; return; }
        int dev = 0, cus = 0, per_cu = 0;
        hipGetDevice(&dev);
        hipDeviceGetAttribute(&cus, hipDeviceAttributeMultiprocessorCount, dev);
        if (hipFuncSetAttribute((const void*)fwd_megakernel, hipFuncAttributeMaxDynamicSharedMemorySize, LDS_BYTES) != hipSuccess) fprintf(stderr, "kernel_launch: hipFuncSetAttribute failed\n");
        hipOccupancyMaxActiveBlocksPerMultiprocessor(&per_cu, (const void*)fwd_megakernel, NTHR, LDS_BYTES);
        if (per_cu < 1) { fprintf(stderr, "kernel_launch: occupancy query says %d blocks per CU\n", per_cu); per_cu = 1; }
        if (per_cu > 1) per_cu = 1;
        grid_blocks = cus * per_cu;
        if (grid_blocks != NTOK / 256) { fprintf(stderr, "kernel_launch: built for a %d-CU device (one 256-token panel per workgroup), found %d\n", NTOK / 256, grid_blocks); grid_blocks = -1; return; }
        (void)hipGetLastError();
    }
    if (grid_blocks < 0) return;
    Params p{};
    p.x = (const float*)d_in[0]; p.c = (const float*)d_in[1]; p.w_ada = (const float*)d_in[2]; p.b_ada = (const float*)d_in[3]; p.w_in = (const float*)d_in[4];
    p.w_ba = (const float*)d_in[5]; p.w_bb = (const float*)d_in[6]; p.w_out = (const float*)d_in[7]; p.hgrn_lb = (const float*)d_in[8]; p.hgrn_ng = (const float*)d_in[9];
    p.ln1_g = (const float*)d_in[10]; p.ln1_b = (const float*)d_in[11]; p.peer_wq = (const float*)d_in[12]; p.peer_sk = (const float*)d_in[13]; p.peer_u = (const float*)d_in[14];
    p.peer_v = (const float*)d_in[15]; p.ln2_g = (const float*)d_in[16]; p.ln2_b = (const float*)d_in[17];
    p.out = (float*)d_out; p.ws = (unsigned char*)d_ws;
    void* args[] = {&p};
    hipError_t e = hipLaunchCooperativeKernel((const void*)fwd_megakernel, dim3(grid_blocks), dim3(NTHR), args, LDS_BYTES, stream);
    if (e != hipSuccess) fprintf(stderr, "cooperative launch failed: %s (grid %d)\n", hipGetErrorString(e), grid_blocks);
}
```

```cpp
#include <hip/hip_runtime.h>
#include <hip/hip_cooperative_groups.h>
#include <cstdio>
#include <cstdint>
#include <type_traits>
namespace cg = cooperative_groups;

#define LAS __attribute__((address_space(3)))
typedef unsigned short bf16_t;
typedef short bf16x8 __attribute__((ext_vector_type(8)));
typedef short s16x4 __attribute__((ext_vector_type(4)));
typedef float f32x2 __attribute__((ext_vector_type(2)));
typedef float f32x4 __attribute__((ext_vector_type(4)));
typedef float f32x16 __attribute__((ext_vector_type(16)));
typedef unsigned u32x2 __attribute__((ext_vector_type(2)));
typedef unsigned u32x4 __attribute__((ext_vector_type(4)));

constexpr int NB = 32, SEQ = 2048, DM = 1024, NTOK = NB * SEQ;
constexpr int INCOLS = 5632;
constexpr int NTHR = 512;
constexpr int LDS_BYTES = 147456;
constexpr float ALPHA = 1.189207115002721f;
constexpr float LN_EPS = 1e-5f, RMS_EPS = 1e-6f;
constexpr float LOG2E = 1.4426950408889634f;

constexpr size_t SZ_T512 = (size_t)NTOK * 512 * 2, SZ_T1024 = (size_t)NTOK * 1024 * 2;
constexpr size_t OFF_ADA = 0;
constexpr size_t OFF_LB = OFF_ADA + 786432;
constexpr size_t OFF_KMEAN = OFF_LB + 4096;
constexpr size_t OFF_WIN = OFF_KMEAN + 524288;
constexpr size_t OFF_WBA = OFF_WIN + (size_t)5632 * 1024 * 2;
constexpr size_t OFF_WBB = OFF_WBA + 1048576;
constexpr size_t OFF_WOUT = OFF_WBB + 1048576;
constexpr size_t OFF_WQ = OFF_WOUT + 2097152;
constexpr size_t OFF_SK = OFF_WQ + 2097152;
constexpr size_t OFF_U8 = OFF_SK + 262144;
constexpr size_t OFF_USC = OFF_U8 + 8388608;
constexpr size_t OFF_V8 = OFF_U8 + 16777216;
constexpr size_t OFF_VSC = OFF_V8 + 8388608;
constexpr size_t OFF_CTR = OFF_V8 + 16777216;
constexpr size_t OFF_BAR = OFF_CTR + 4096;
constexpr size_t OFF_EG = OFF_BAR + 16384;
constexpr size_t OFF_H = OFF_EG + (size_t)NTOK * 128 * 8;
constexpr size_t OFF_QA = OFF_H + SZ_T1024;
constexpr size_t OFF_KA = OFF_QA + SZ_T512;
constexpr size_t OFF_VA = OFF_KA + SZ_T512;
constexpr size_t OFF_HQ = OFF_VA + SZ_T512;
constexpr size_t OFF_HK = OFF_HQ + SZ_T512;
constexpr size_t OFF_HI = OFF_HK + SZ_T512;
constexpr size_t OFF_HG = OFF_HI + SZ_T512;
constexpr size_t OFF_GA = OFF_HG + SZ_T512;
constexpr size_t OFF_GB = OFF_GA + SZ_T1024;
constexpr size_t WS_END = OFF_GB + SZ_T1024;
constexpr size_t OFF_H8 = OFF_VA;
constexpr size_t OFF_HS = OFF_HQ;
constexpr size_t OFF_W = OFF_KA;
constexpr size_t OFF_Y = OFF_KA;

struct Params {
    const float *x, *c, *w_ada, *b_ada, *w_in, *w_ba, *w_bb, *w_out, *hgrn_lb, *hgrn_ng, *ln1_g, *ln1_b, *peer_wq, *peer_sk, *peer_u, *peer_v, *ln2_g, *ln2_b;
    float* out;
    unsigned char* ws;
};

typedef __bf16 bf16v2 __attribute__((ext_vector_type(2)));
__device__ __forceinline__ unsigned cvt_pk_bf16(float lo, float hi) { return __builtin_bit_cast(unsigned, __builtin_convertvector((f32x2){lo, hi}, bf16v2)); }
__device__ __forceinline__ float bf_lo(unsigned w) { return __uint_as_float(w << 16); }
__device__ __forceinline__ float bf_hi(unsigned w) { return __uint_as_float(w & 0xffff0000u); }
__device__ __forceinline__ float sigmoidf_(float x) { return __builtin_amdgcn_rcpf(1.0f + __builtin_amdgcn_exp2f(-LOG2E * x)); }
__device__ __forceinline__ float wave_sum(float v) {
#pragma unroll
    for (int o = 1; o < 64; o <<= 1) v += __shfl_xor(v, o);
    return v;
}
template <int CTRL> __device__ __forceinline__ float dpp_add(float x) { const int v = __builtin_amdgcn_update_dpp(0, __float_as_int(x), CTRL, 0xf, 0xf, true); return x + __int_as_float(v); }
__device__ __forceinline__ float wave_sum_fast(float x) {
    x = dpp_add<0xB1>(x); x = dpp_add<0x4E>(x); x = dpp_add<0x141>(x); x = dpp_add<0x140>(x);
    x += __shfl_xor(x, 16); x += __shfl_xor(x, 32); return x;
}
template <int CTRL> __device__ __forceinline__ float dpp_max(float x) { const int v = __builtin_amdgcn_update_dpp(0, __float_as_int(x), CTRL, 0xf, 0xf, true); return fmaxf(x, __int_as_float(v)); }
template <int CTRL> __device__ __forceinline__ int dpp_addi(int x) { return x + __builtin_amdgcn_update_dpp(0, x, CTRL, 0xf, 0xf, true); }
__device__ __forceinline__ float wave_max_fast(float x) {
    x = dpp_max<0xB1>(x); x = dpp_max<0x4E>(x); x = dpp_max<0x141>(x); x = dpp_max<0x140>(x);
    x = fmaxf(x, __shfl_xor(x, 16)); x = fmaxf(x, __shfl_xor(x, 32)); return x;
}
__device__ __forceinline__ int wave_sum_int_fast(int x) {
    x = dpp_addi<0xB1>(x); x = dpp_addi<0x4E>(x); x = dpp_addi<0x141>(x); x = dpp_addi<0x140>(x);
    x += __shfl_xor(x, 16); x += __shfl_xor(x, 32); return x;
}
__device__ __forceinline__ int tid_opaque() { int t = threadIdx.x; asm volatile("" : "+v"(t)); return t; }
__device__ __forceinline__ int crow(int r, int hi) { return (r & 3) + 8 * (r >> 2) + 4 * hi; }
#define MFMA32(a, b, c) __builtin_amdgcn_mfma_f32_32x32x16_bf16(a, b, c, 0, 0, 0)

namespace pg8 {
constexpr int BM = 256, BK = 64, HALF = 128, HTB = HALF * BK * 2, STAGE_BYTES = 8 * HTB, NXCD = 8, WGM = 8;
__host__ __device__ __forceinline__ int lds_byte(int r, int c) { const int st = (r >> 4) * 2 + (c >> 5), rr = r & 15, cc = c & 31, ob = rr * 64 + cc * 2; return st * 1024 + (ob ^ (((ob >> 9) & 1) << 5)); }
__host__ __device__ __forceinline__ void stage_rc(int b, int& R, int& C) { const int st = b / 1024, sb = b % 1024, swz = sb ^ (((sb >> 9) & 1) << 5); R = (st >> 1) * 16 + swz / 64; C = (st & 1) * 32 + (swz % 64) / 2; }
__host__ __device__ __forceinline__ int perm32(int rho) { const int n = rho >> 4, i = rho & 15; return 8 * (i >> 2) + 4 * n + (i & 3); }

struct Unit { int pm, pn; };
struct Gemm { const bf16_t* A; const bf16_t* Bt; int M, N, K, lda; };

struct StaticOrder {
    int nM, nN, nwg, G, c;
    __device__ void init(int M, int N, int G_, int c_) { nM = M / BM; nN = N / BM; nwg = nM * nN; G = G_; c = c_; }
    __device__ bool next(int i, Unit& u) const {
        const long L = (long)i * G + c; if (L >= nwg) return false;
        int wgid = (int)L; { const int q = nwg / NXCD, r = nwg % NXCD, xcd = wgid % NXCD, off = wgid / NXCD; wgid = (xcd < r ? xcd * (q + 1) : r * (q + 1) + (xcd - r) * q) + off; }
        const int nig = WGM * nN, gid = wgid / nig, fm = gid * WGM, gsz = (nM - fm) < WGM ? (nM - fm) : WGM;
        u.pm = fm + ((wgid % nig) % gsz); u.pn = (wgid % nig) / gsz; return true;
    }
};
struct PanelOrder {
    int pm, npn;
    __device__ bool next(int i, Unit& u) const { if (i >= npn) return false; u.pm = pm; u.pn = i; return true; }
};

template <class Epi, class Sched, bool MX = false>
__device__ __forceinline__ void gemm_phase(LAS unsigned char* lds, const Gemm g, const Sched& S, const Epi& E) {
    const int tid = tid_opaque(), wid = __builtin_amdgcn_readfirstlane(tid >> 6), lane = tid & 63, wr = wid >> 2, wc = wid & 3, fr = lane & 15, fq = lane >> 4;
    const int K = g.K, nt = K / BK;
    unsigned voffA, voffB;
    { int R, C; stage_rc(tid * 16, R, C); const int Rb = Epi::PERM ? ((R & ~31) + perm32(R & 31)) : R;
      voffA = (unsigned)(R * g.lda + C) * 2u; voffB = (unsigned)(Rb * K + C) * 2u; }
    const size_t rvoffA = (size_t)128 * g.lda, rvoffB = (size_t)128 * K;
    const size_t kstep = (size_t)(BK * 2);
    const size_t hstep = (size_t)HALF * K * 2;
    const size_t tstep = 2 * hstep;
    const size_t hstepA = (size_t)HALF * g.lda * 2, tstepA = 2 * hstepA;
    const unsigned ldsw = (unsigned)wid * 1024u;
    const int aoff = lds_byte(wr * 64 + fr, fq * 8), boff = lds_byte(wc * 32 + fr, fq * 8);
#define PG8_SA(b, h) (((b) * 2 + (h)) * HTB)
#define PG8_SB(b, h) ((4 + (b) * 2 + (h)) * HTB)
#define PG8_STAGE(bufoff, gbase, voff) do { unsigned vo_ = (voff); asm volatile("" : "+v"(vo_));     \
        _Pragma("unroll") for (int _i = 0; _i < 2; ++_i) \
        __builtin_amdgcn_global_load_lds((const unsigned*)((const char*)(gbase) + _i * r##voff + vo_), (LAS unsigned*)(lds + (bufoff) + ldsw + _i * 8192), 16, 0, 0); } while (0)
#define PG8_LDX(dst, off) do { const v4i_ lo_ = *(const LAS v4i_*)(lds + (off)), hi_ = *(const LAS v4i_*)(lds + (off) + 1024); dst = __builtin_shufflevector(lo_, hi_, 0, 1, 2, 3, 4, 5, 6, 7); } while (0)
#define PG8_LDA(dst, b, h) do { if constexpr (MX) { _Pragma("unroll") for (int m = 0; m < 4; ++m) PG8_LDX(dst##X[m], PG8_SA(b, h) + aoff + m * 2048); } \
        else { _Pragma("unroll") for (int m = 0; m < 4; ++m) _Pragma("unroll") for (int k = 0; k < 2; ++k) dst[m][k] = *(const LAS bf16x8*)(lds + PG8_SA(b, h) + aoff + m * 2048 + k * 1024); } } while (0)
#define PG8_LDB(dst, b, h) do { if constexpr (MX) { _Pragma("unroll") for (int n = 0; n < 2; ++n) PG8_LDX(dst##X[n], PG8_SB(b, h) + boff + n * 2048); } \
        else { _Pragma("unroll") for (int n = 0; n < 2; ++n) _Pragma("unroll") for (int k = 0; k < 2; ++k) dst[n][k] = *(const LAS bf16x8*)(lds + PG8_SB(b, h) + boff + n * 2048 + k * 1024); } } while (0)
#define PG8_MMA(ai, bj, At, Bt) do { __builtin_amdgcn_s_setprio(1); \
        if constexpr (MX) { _Pragma("unroll") for (int m = 0; m < 4; ++m) _Pragma("unroll") for (int n = 0; n < 2; ++n) \
            asm volatile("v_mfma_scale_f32_16x16x128_f8f6f4 %0, %1, %2, %0, %3, %4 op_sel_hi:[0,0,0]" : "+v"(acc[ai][bj][m][n]) : "v"(Bt##X[n]), "v"(At##X[m]), "v"(mxscale), "v"(mxscale5)); } \
        else { _Pragma("unroll") for (int m = 0; m < 4; ++m) _Pragma("unroll") for (int n = 0; n < 2; ++n) _Pragma("unroll") for (int k = 0; k < 2; ++k) \
            acc[ai][bj][m][n] = __builtin_amdgcn_mfma_f32_16x16x32_bf16(Bt[n][k], At[m][k], acc[ai][bj][m][n], 0, 0, 0); } \
        __builtin_amdgcn_s_setprio(0); } while (0)
#define PG8_WAIT_V(n) asm volatile("s_waitcnt vmcnt(" #n ")" ::: "memory")
#define PG8_WAIT_L(n) asm volatile("s_waitcnt lgkmcnt(" #n ")" ::: "memory")
#define PG8_BAR __builtin_amdgcn_s_barrier()
#define PG8_SCHED __builtin_amdgcn_sched_barrier(0)
    Unit cur, nxt; int ui = 0;
    if (!S.next(0, cur)) return;
    f32x4 acc[2][2][4][2];
#pragma unroll
    for (int a = 0; a < 2; ++a)
#pragma unroll
        for (int b = 0; b < 2; ++b)
#pragma unroll
            for (int m = 0; m < 4; ++m)
#pragma unroll
                for (int n = 0; n < 2; ++n) acc[a][b][m][n] = (f32x4){0.f, 0.f, 0.f, 0.f};
    typedef int v4i_ __attribute__((ext_vector_type(4))); typedef int v8i_ __attribute__((ext_vector_type(8)));
    bf16x8 At[4][2], B0[2][2], B1[2][2];
    v8i_ AtX[4], B0X[2], B1X[2];
    const int mxscale = 0x7f7f7f7f, mxscale5 = 0x7a7a7a7a;
    const char* cA = (const char*)g.A + (size_t)cur.pm * tstepA; const char* cB = (const char*)g.Bt + (size_t)cur.pn * tstep;
    PG8_STAGE(PG8_SB(0, 0), cB, voffB); PG8_STAGE(PG8_SA(0, 0), cA, voffA); PG8_STAGE(PG8_SB(0, 1), cB + hstep, voffB); PG8_STAGE(PG8_SA(0, 1), cA + hstepA, voffA);
    if (wr == 1) PG8_BAR;
    PG8_WAIT_V(4); PG8_BAR;
    PG8_STAGE(PG8_SB(1, 0), cB + kstep, voffB); PG8_STAGE(PG8_SA(1, 0), cA + kstep, voffA); PG8_STAGE(PG8_SB(1, 1), cB + hstep + kstep, voffB);
    PG8_WAIT_V(6); PG8_BAR;
    for (;;) {
        const bool has_next = S.next(ui + 1, nxt);
        const char* nA = has_next ? (const char*)g.A + (size_t)nxt.pm * tstepA : cA; const char* nB = has_next ? (const char*)g.Bt + (size_t)nxt.pn * tstep : cB;
        for (int t = 0; t < nt; t += 2) {
            const bool last = (t == nt - 2);
            const char* a1 = cA + (size_t)(t + 1) * kstep;
            const char* a2 = last ? nA : cA + (size_t)(t + 2) * kstep; const char* b2 = last ? nB : cB + (size_t)(t + 2) * kstep;
            const char* a3 = a2 + kstep; const char* b3 = b2 + kstep;
            PG8_LDB(B0, 0, 0); PG8_SCHED; PG8_LDA(At, 0, 0); PG8_STAGE(PG8_SA(1, 1), a1 + hstepA, voffA);
            PG8_WAIT_L(8); PG8_BAR; PG8_WAIT_L(0); PG8_MMA(0, 0, At, B0); PG8_BAR; PG8_SCHED;
            PG8_LDB(B1, 0, 1); PG8_STAGE(PG8_SB(0, 0), b2, voffB);
            PG8_BAR; PG8_WAIT_L(0); PG8_MMA(0, 1, At, B1); PG8_BAR;
            PG8_LDA(At, 0, 1); PG8_STAGE(PG8_SA(0, 0), a2, voffA);
            PG8_BAR; PG8_WAIT_L(0); PG8_MMA(1, 0, At, B0); PG8_BAR; PG8_SCHED;
            PG8_STAGE(PG8_SB(0, 1), b2 + hstep, voffB);
            PG8_WAIT_V(6); PG8_BAR; PG8_MMA(1, 1, At, B1); PG8_BAR;
            PG8_LDB(B0, 1, 0); PG8_SCHED; PG8_LDA(At, 1, 0); PG8_STAGE(PG8_SA(0, 1), a2 + hstepA, voffA);
            PG8_WAIT_L(8); PG8_BAR; PG8_WAIT_L(0); PG8_MMA(0, 0, At, B0); PG8_BAR; PG8_SCHED;
            PG8_LDB(B1, 1, 1); PG8_STAGE(PG8_SB(1, 0), b3, voffB);
            PG8_BAR; PG8_WAIT_L(0); PG8_MMA(0, 1, At, B1); PG8_BAR;
            PG8_LDA(At, 1, 1); PG8_STAGE(PG8_SA(1, 0), a3, voffA);
            PG8_BAR; PG8_WAIT_L(0); PG8_MMA(1, 0, At, B0); PG8_BAR; PG8_SCHED;
            PG8_STAGE(PG8_SB(1, 1), b3 + hstep, voffB);
            PG8_WAIT_V(6); PG8_BAR; PG8_MMA(1, 1, At, B1); PG8_BAR;
            if constexpr (Epi::HAS_MID) if (t == nt / 2 - 2) {
                if constexpr (MX) asm volatile("s_nop 15\n\ts_nop 15" ::: "memory");
                if (wr == 0) PG8_BAR;
                E.mid(acc, cur, wr, wc, fr, fq);
                if (wr == 1) PG8_BAR;
            }
        }
        if constexpr (MX) asm volatile("s_nop 15\n\ts_nop 15" ::: "memory");
        if (wr == 0) PG8_BAR;
        E(acc, cur, wr, wc, fr, fq);
        if (wr == 1) PG8_BAR;
        if (!has_next) break;
#pragma unroll
        for (int a = 0; a < 2; ++a)
#pragma unroll
            for (int b = 0; b < 2; ++b)
#pragma unroll
                for (int m = 0; m < 4; ++m)
#pragma unroll
                    for (int n = 0; n < 2; ++n) acc[a][b][m][n] = (f32x4){0.f, 0.f, 0.f, 0.f};
        cur = nxt; cA = nA; cB = nB; ++ui;
    }
    PG8_WAIT_V(0);
    if (wr == 0) PG8_BAR;
    PG8_BAR;
#undef PG8_SA
#undef PG8_SB
#undef PG8_STAGE
#undef PG8_LDX
#undef PG8_LDA
#undef PG8_LDB
#undef PG8_MMA
#undef PG8_WAIT_V
#undef PG8_WAIT_L
#undef PG8_BAR
#undef PG8_SCHED
}
}
using pg8::Unit;

struct EpiProj {
    static constexpr bool PERM = true; static constexpr bool HAS_MID = false;
    unsigned char* ws; const float* lb; const float* ng; float* kmean;
    __device__ __forceinline__ void operator()(const f32x4 (&acc)[2][2][4][2], const Unit& u, int wr, int wc, int fr, int fq) const {
        const int pn = u.pn; int seg, colt, ldc; size_t boff;
        if (pn < 14) { seg = pn >> 1; colt = (pn & 1) * 256; ldc = 512; boff = OFF_QA + (size_t)seg * SZ_T512; }
        else if (pn < 18) { seg = 7; colt = (pn - 14) * 256; ldc = 1024; boff = OFF_GA; }
        else { seg = 8; colt = (pn - 18) * 256; ldc = 1024; boff = OFF_GB; }
        bf16_t* base = (bf16_t*)(ws + boff);
        const int row0 = u.pm * 256 + wr * 64 + fr, col0 = colt + wc * 32 + 8 * fq;
        float pv[2][8];
#pragma unroll
        for (int bj = 0; bj < 2; ++bj)
#pragma unroll
            for (int e = 0; e < 8; ++e) pv[bj][e] = (seg == 4) ? (1.0f - lb[col0 + bj * 128 + e]) : ((seg == 6) ? ng[col0 + bj * 128 + e] : 0.f);
        float cs[2][8];
#pragma unroll
        for (int bj = 0; bj < 2; ++bj)
#pragma unroll
            for (int e = 0; e < 8; ++e) cs[bj][e] = 0.f;
#pragma unroll
        for (int ai = 0; ai < 2; ++ai)
#pragma unroll
            for (int m = 0; m < 4; ++m) {
                bf16_t* rowp = base + (size_t)(row0 + ai * 128 + m * 16) * ldc + col0;
#pragma unroll
                for (int bj = 0; bj < 2; ++bj) {
                    float v[8];
#pragma unroll
                    for (int e = 0; e < 4; ++e) { v[e] = acc[ai][bj][m][0][e]; v[4 + e] = acc[ai][bj][m][1][e]; }
                    if (seg == 0) {
#pragma unroll
                        for (int e = 0; e < 8; ++e) v[e] *= (0.125f * LOG2E);
                    } else if (seg == 1) {
#pragma unroll
                        for (int e = 0; e < 8; ++e) cs[bj][e] += v[e];
                    } else if (seg == 3) {
#pragma unroll
                        for (int e = 0; e < 8; ++e) v[e] = v[e] * sigmoidf_(v[e]);
                    } else if (seg == 4) {
#pragma unroll
                        for (int e = 0; e < 8; ++e) v[e] = pv[bj][e] * sigmoidf_(-v[e]);
                    } else if (seg == 6) {
#pragma unroll
                        for (int e = 0; e < 8; ++e) v[e] = pv[bj][e] * v[e] * sigmoidf_(v[e]);
                    } else if (seg >= 7) {
#pragma unroll
                        for (int e = 0; e < 8; ++e) v[e] = sigmoidf_(v[e]);
                    }
                    if (seg >= 7) {
                        int w0 = __builtin_amdgcn_cvt_pk_fp8_f32(v[0], v[1], 0, false); w0 = __builtin_amdgcn_cvt_pk_fp8_f32(v[2], v[3], w0, true);
                        int w1 = __builtin_amdgcn_cvt_pk_fp8_f32(v[4], v[5], 0, false); w1 = __builtin_amdgcn_cvt_pk_fp8_f32(v[6], v[7], w1, true);
                        *(u32x2*)((unsigned char*)rowp - col0 + bj * 128) = (u32x2){(unsigned)w0, (unsigned)w1};
                    } else {
                    u32x4 w; w.x = cvt_pk_bf16(v[0], v[1]); w.y = cvt_pk_bf16(v[2], v[3]); w.z = cvt_pk_bf16(v[4], v[5]); w.w = cvt_pk_bf16(v[6], v[7]);
                    *(u32x4*)(rowp + bj * 128) = w; }
                }
            }
        if (seg == 1) {
#pragma unroll
            for (int bj = 0; bj < 2; ++bj)
#pragma unroll
                for (int e = 0; e < 8; ++e) {
                    float s = cs[bj][e];
                    s += __shfl_xor(s, 1); s += __shfl_xor(s, 2); s += __shfl_xor(s, 4); s += __shfl_xor(s, 8);
                    if (fr == 0) atomicAdd(kmean + (size_t)u.pm * 512 + col0 + bj * 128 + e, s);
                }
        }
    }
};
__device__ __forceinline__ void fp8x8_to_f32(const u32x2 w, float (&f)[8]) {
    const f32x2 a = __builtin_amdgcn_cvt_pk_f32_fp8((int)w.x, false), b = __builtin_amdgcn_cvt_pk_f32_fp8((int)w.x, true), c = __builtin_amdgcn_cvt_pk_f32_fp8((int)w.y, false), d = __builtin_amdgcn_cvt_pk_f32_fp8((int)w.y, true);
    f[0] = a.x; f[1] = a.y; f[2] = b.x; f[3] = b.y; f[4] = c.x; f[5] = c.y; f[6] = d.x; f[7] = d.y;
}
struct EpiMixAB {
    static constexpr bool PERM = true; static constexpr bool HAS_MID = true;
    const unsigned char* GA; const unsigned char* GB; unsigned char* M8;
    __device__ __forceinline__ void mid(f32x4 (&acc)[2][2][4][2], const Unit& u, int wr, int wc, int fr, int fq) const {
        asm volatile("" : "+v"(fr), "+v"(fq));
        const int row0 = u.pm * 256 + wr * 64 + fr, col0 = u.pn * 256 + wc * 32 + 8 * fq;
#pragma unroll
        for (int ai = 0; ai < 2; ++ai)
#pragma unroll
            for (int m = 0; m < 4; ++m) {
                const size_t row = (size_t)(row0 + ai * 128 + m * 16);
#pragma unroll
                for (int bj = 0; bj < 2; ++bj) {
                    float ga[8], gb[8]; fp8x8_to_f32(*(const u32x2*)(GA + row * 2048 + col0 + bj * 128), ga); fp8x8_to_f32(*(const u32x2*)(GB + row * 2048 + col0 + bj * 128), gb);
#pragma unroll
                    for (int e = 0; e < 4; ++e) { acc[ai][bj][m][0][e] *= ga[e] * __builtin_amdgcn_rcpf(fmaxf(gb[e], 0.0009765625f)); acc[ai][bj][m][1][e] *= ga[4 + e] * __builtin_amdgcn_rcpf(fmaxf(gb[4 + e], 0.0009765625f)); }
                }
            }
    }
    __device__ __forceinline__ void operator()(const f32x4 (&acc)[2][2][4][2], const Unit& u, int wr, int wc, int fr, int fq) const {
        asm volatile("" : "+v"(fr), "+v"(fq));
        const int row0 = u.pm * 256 + wr * 64 + fr, col0 = u.pn * 256 + wc * 32 + 8 * fq;
#pragma unroll
        for (int ai = 0; ai < 2; ++ai)
#pragma unroll
            for (int m = 0; m < 4; ++m) {
                const size_t row = (size_t)(row0 + ai * 128 + m * 16);
#pragma unroll
                for (int bj = 0; bj < 2; ++bj) {
                    float gb[8]; fp8x8_to_f32(*(const u32x2*)(GB + row * 2048 + col0 + bj * 128), gb);
#pragma unroll
                    for (int e = 0; e < 8; ++e) gb[e] = fmaxf(gb[e], 0.0009765625f);
                    const f32x4 a0 = acc[ai][bj][m][0], a1 = acc[ai][bj][m][1];
                    int w0 = __builtin_amdgcn_cvt_pk_fp8_f32(gb[0] * a0[0], gb[1] * a0[1], 0, false); w0 = __builtin_amdgcn_cvt_pk_fp8_f32(gb[2] * a0[2], gb[3] * a0[3], w0, true);
                    int w1 = __builtin_amdgcn_cvt_pk_fp8_f32(gb[4] * a1[0], gb[5] * a1[1], 0, false); w1 = __builtin_amdgcn_cvt_pk_fp8_f32(gb[6] * a1[2], gb[7] * a1[3], w1, true);
                    *(u32x2*)(M8 + row * 1024 + col0 + bj * 128) = (u32x2){(unsigned)w0, (unsigned)w1};
                }
            }
    }
};
struct EpiOut {
    static constexpr bool PERM = true; static constexpr bool HAS_MID = false;
    const float* ada; bf16_t* D;
    __device__ __forceinline__ void operator()(const f32x4 (&acc)[2][2][4][2], const Unit& u, int wr, int wc, int fr, int fq) const {
        const int row0 = u.pm * 256 + wr * 64 + fr, col0 = u.pn * 256 + wc * 32 + 8 * fq;
        const float* gt1 = ada + (size_t)(u.pm >> 3) * 6144 + 2048 + col0;
        f32x4 g[2][2];
#pragma unroll
        for (int bj = 0; bj < 2; ++bj) { g[bj][0] = *(const f32x4*)(gt1 + bj * 128); g[bj][1] = *(const f32x4*)(gt1 + bj * 128 + 4); }
#pragma unroll
        for (int ai = 0; ai < 2; ++ai)
#pragma unroll
            for (int m = 0; m < 4; ++m) {
                bf16_t* rowp = D + (size_t)(row0 + ai * 128 + m * 16) * 1024 + col0;
#pragma unroll
                for (int bj = 0; bj < 2; ++bj) {
                    const f32x4 a0 = acc[ai][bj][m][0] * g[bj][0], a1 = acc[ai][bj][m][1] * g[bj][1];
                    int w0 = __builtin_amdgcn_cvt_pk_fp8_f32(a0[0], a0[1], 0, false); w0 = __builtin_amdgcn_cvt_pk_fp8_f32(a0[2], a0[3], w0, true);
                    int w1 = __builtin_amdgcn_cvt_pk_fp8_f32(a1[0], a1[1], 0, false); w1 = __builtin_amdgcn_cvt_pk_fp8_f32(a1[2], a1[3], w1, true);
                    *(u32x2*)((unsigned char*)rowp - col0 + bj * 128) = (u32x2){(unsigned)w0, (unsigned)w1};
                }
            }
    }
};
struct EpiBf16 {
    static constexpr bool PERM = true; static constexpr bool HAS_MID = false;
    bf16_t* O;
    __device__ __forceinline__ void operator()(const f32x4 (&acc)[2][2][4][2], const Unit& u, int wr, int wc, int fr, int fq) const {
        const int row0 = u.pm * 256 + wr * 64 + fr, col0 = u.pn * 256 + wc * 32 + 8 * fq;
#pragma unroll
        for (int ai = 0; ai < 2; ++ai)
#pragma unroll
            for (int m = 0; m < 4; ++m) {
                bf16_t* rowp = O + (size_t)(row0 + ai * 128 + m * 16) * 1024 + col0;
#pragma unroll
                for (int bj = 0; bj < 2; ++bj) {
                    const f32x4 a0 = acc[ai][bj][m][0], a1 = acc[ai][bj][m][1];
                    u32x4 w; w.x = cvt_pk_bf16(a0[0], a0[1]); w.y = cvt_pk_bf16(a0[2], a0[3]); w.z = cvt_pk_bf16(a1[0], a1[1]); w.w = cvt_pk_bf16(a1[2], a1[3]);
                    *(u32x4*)(rowp + bj * 128) = w;
                }
            }
    }
};

__device__ void phase0a(const Params& P, LAS unsigned char* lds) {
    const int tid = tid_opaque(), G = gridDim.x, bid = blockIdx.x;
    for (int it = bid; it < 192; it += G) {
        LAS float* sc = (LAS float*)lds;
        const int kg = tid >> 5, col = tid & 31;
        float w[64];
#pragma unroll
        for (int e = 0; e < 64; ++e) w[e] = __builtin_nontemporal_load(P.w_ada + (size_t)(kg * 64 + e) * 6144 + it * 32 + col);
        asm volatile("" ::: "memory");
#pragma unroll 1
        for (int i0 = 0; i0 < 64; i0 += 16) {
            float cv[16];
#pragma unroll
            for (int j = 0; j < 16; ++j) cv[j] = P.c[tid + (i0 + j) * NTHR];
#pragma unroll
            for (int j = 0; j < 16; ++j) sc[tid + (i0 + j) * NTHR] = cv[j] * sigmoidf_(cv[j]);
        }
        __syncthreads();
        float a[32];
#pragma unroll
        for (int b = 0; b < 32; ++b) a[b] = 0.f;
#pragma unroll
        for (int e4 = 0; e4 < 16; ++e4) {
#pragma unroll
            for (int b = 0; b < 32; ++b) { const f32x4 s = *(const LAS f32x4*)(sc + b * 1024 + kg * 64 + 4 * e4); a[b] += s[0] * w[4 * e4] + s[1] * w[4 * e4 + 1] + s[2] * w[4 * e4 + 2] + s[3] * w[4 * e4 + 3]; }
            asm volatile("" ::: "memory");
        }
        __syncthreads();
        LAS float* red = (LAS float*)lds;
#pragma unroll
        for (int b = 0; b < 32; ++b) red[(kg * 32 + b) * 32 + col] = a[b];
        __syncthreads();
        for (int o = tid; o < 1024; o += NTHR) { const int b = o >> 5, cc = o & 31; float s = 0.f;
#pragma unroll
            for (int g2 = 0; g2 < 16; ++g2) s += red[(g2 * 32 + b) * 32 + cc];
            ((float*)(P.ws + OFF_ADA))[(size_t)b * 6144 + it * 32 + cc] = s + P.b_ada[it * 32 + cc]; }
        __syncthreads();
    }
    const size_t gsz = (size_t)G * NTHR;
    { const int gt = bid * NTHR + tid, gs = G * NTHR;
      if (gt < 512) ((float*)(P.ws + OFF_LB))[gt] = sigmoidf_(P.hgrn_lb[gt] - P.hgrn_lb[512 + gt]);
      for (int i = gt; i < 32 * 8 * 512; i += gs) ((float*)(P.ws + OFF_KMEAN))[i] = 0.f; }
    {
        LAS float* tile = (LAS float*)lds;
        const int I0 = 16 * 88, I1 = I0 + 8 * 16, I2 = I1 + 8 * 16, I3 = I2 + 16 * 16, I4 = I3 + 16 * 16;
        for (int it = bid; it < I4; it += G) {
            const float* W; bf16_t* WT; int K, N, r, Kp = 0, ko = 0;
            if (it < I0) { W = P.w_in; WT = (bf16_t*)(P.ws + OFF_WIN); K = 1024; N = 5632; r = it; }
            else if (it < I1) { W = P.w_ba; WT = (bf16_t*)(P.ws + OFF_WBA); K = 512; N = 1024; r = it - I0; Kp = 1024; }
            else if (it < I2) { W = P.w_bb; WT = (bf16_t*)(P.ws + OFF_WBA); K = 512; N = 1024; r = it - I1; Kp = 1024; ko = 512; }
            else if (it < I3) { W = P.w_out; WT = (bf16_t*)(P.ws + OFF_WOUT); K = 1024; N = 1024; r = it - I2; }
            else { W = P.peer_wq; WT = (bf16_t*)(P.ws + OFF_WQ); K = 1024; N = 1024; r = it - I3; }
            const int nb = N / 64, k0 = (r / nb) * 64, n0 = (r % nb) * 64;
#pragma unroll
            for (int ps = 0; ps < 2; ++ps) { const int kk = (tid >> 4) + 32 * ps, n4 = (tid & 15) * 4;
                const f32x4 v = *(const f32x4*)(W + (size_t)(k0 + kk) * N + n0 + n4);
                tile[kk * 65 + n4] = v[0]; tile[kk * 65 + n4 + 1] = v[1]; tile[kk * 65 + n4 + 2] = v[2]; tile[kk * 65 + n4 + 3] = v[3]; }
            __syncthreads();
            { const int n = tid >> 3, kc = (tid & 7) * 8;
              if (it < I3) {
                  int w0 = __builtin_amdgcn_cvt_pk_fp8_f32(32.f * tile[(kc + 0) * 65 + n], 32.f * tile[(kc + 1) * 65 + n], 0, false); w0 = __builtin_amdgcn_cvt_pk_fp8_f32(32.f * tile[(kc + 2) * 65 + n], 32.f * tile[(kc + 3) * 65 + n], w0, true);
                  int w1 = __builtin_amdgcn_cvt_pk_fp8_f32(32.f * tile[(kc + 4) * 65 + n], 32.f * tile[(kc + 5) * 65 + n], 0, false); w1 = __builtin_amdgcn_cvt_pk_fp8_f32(32.f * tile[(kc + 6) * 65 + n], 32.f * tile[(kc + 7) * 65 + n], w1, true);
                  *(u32x2*)((unsigned char*)WT + (size_t)(n0 + n) * (Kp ? Kp : K) + ko + k0 + kc) = (u32x2){(unsigned)w0, (unsigned)w1};
              } else { u32x4 w;
              w.x = cvt_pk_bf16(tile[(kc + 0) * 65 + n], tile[(kc + 1) * 65 + n]); w.y = cvt_pk_bf16(tile[(kc + 2) * 65 + n], tile[(kc + 3) * 65 + n]);
              w.z = cvt_pk_bf16(tile[(kc + 4) * 65 + n], tile[(kc + 5) * 65 + n]); w.w = cvt_pk_bf16(tile[(kc + 6) * 65 + n], tile[(kc + 7) * 65 + n]);
              *(u32x4*)(WT + (size_t)(n0 + n) * K + k0 + kc) = w; } }
            __syncthreads();
        }
    }
    {
        const size_t gtid = (size_t)bid * NTHR + tid_opaque();
        for (size_t i = gtid; i < 16384; i += gsz) {
            const float* src = P.peer_sk + i * 8; const f32x4 a = *(const f32x4*)src, b = *(const f32x4*)(src + 4);
            u32x4 w; w.x = cvt_pk_bf16(a[0], a[1]); w.y = cvt_pk_bf16(a[2], a[3]); w.z = cvt_pk_bf16(b[0], b[1]); w.w = cvt_pk_bf16(b[2], b[3]);
            *(u32x4*)((bf16_t*)(P.ws + OFF_SK) + i * 8) = w;
        }
        { const int lane = tid & 63, gw = bid * 8 + (tid >> 6), ngw = G * 8;
          for (int r0 = gw; r0 < 2 * 16384; r0 += 4 * ngw) {
              f32x4 x[4][4];
#pragma unroll
              for (int u = 0; u < 4; ++u) { const int r = min(r0 + u * ngw, 2 * 16384 - 1); const bool isv = r >= 16384; const int e = isv ? r - 16384 : r;
                  const float* s = (isv ? P.peer_v : P.peer_u) + (size_t)e * 1024 + lane * 4;
#pragma unroll
                  for (int q = 0; q < 4; ++q) x[u][q] = __builtin_nontemporal_load((const f32x4*)(s + 256 * q)); }
              asm volatile("" ::: "memory");
#pragma unroll
              for (int u = 0; u < 4; ++u) { const int r = r0 + u * ngw; if (r < 2 * 16384) { const bool isv = r >= 16384; const int e = isv ? r - 16384 : r;
                  float ss = 0.f;
#pragma unroll
                  for (int q = 0; q < 4; ++q) ss += (x[u][q][0] * x[u][q][0] + x[u][q][1] * x[u][q][1]) + (x[u][q][2] * x[u][q][2] + x[u][q][3] * x[u][q][3]);
                  const float sc = fmaxf(sqrtf(wave_sum_fast(ss) * (1.0f / 1024.0f)) * (2.6f / 7.5f), 1e-30f), inv = 1.0f / sc;
                  const int nsh = (lane & 1) * 4;
                  const unsigned flip = isv ? 0x80808080u : 0x88888888u;
                  unsigned* dst = (unsigned*)(P.ws + (isv ? OFF_V8 : OFF_U8) + (size_t)e * 512) + (lane >> 1);
#pragma unroll
                  for (int q = 0; q < 4; ++q) {
                      unsigned p = 0u;
#pragma unroll
                      for (int el = 0; el < 4; ++el) p |= (unsigned)fminf(fmaxf(floorf(x[u][q][el] * inv) + 8.0f, 0.0f), 15.0f) << (8 * el + nsh);
                      p |= (unsigned)__builtin_amdgcn_update_dpp(0, (int)p, 0xB1, 0xf, 0xf, true);
                      if (!(lane & 1)) dst[32 * q] = p ^ flip;
                  }
                  if (lane == 0) ((float*)(P.ws + (isv ? OFF_VSC : OFF_USC)))[e] = sc; } }
          } }
    }
}
__device__ void phase0b(const Params& P) {
    const size_t gtid = (size_t)blockIdx.x * NTHR + threadIdx.x, gsz = (size_t)gridDim.x * NTHR;
    const float* ada = (const float*)(P.ws + OFF_ADA); bf16_t* H = (bf16_t*)(P.ws + OFF_H);
    for (size_t i = gtid; i < (size_t)NTOK * 128; i += gsz) {
        const size_t row = i >> 7; const int c8 = (int)(i & 127) * 8; const int b = (int)(row >> 11);
        const float* xr = P.x + row * 1024 + c8; const float* sh = ada + (size_t)b * 6144 + c8; const float* sc = sh + 1024;
        const f32x4 x0 = *(const f32x4*)xr, x1 = *(const f32x4*)(xr + 4), s0 = *(const f32x4*)sc, s1 = *(const f32x4*)(sc + 4), h0 = *(const f32x4*)sh, h1 = *(const f32x4*)(sh + 4);
        const f32x4 r0 = x0 * (s0 + 1.0f) + h0, r1 = x1 * (s1 + 1.0f) + h1;
        int w0 = __builtin_amdgcn_cvt_pk_fp8_f32(r0[0], r0[1], 0, false); w0 = __builtin_amdgcn_cvt_pk_fp8_f32(r0[2], r0[3], w0, true);
        int w1 = __builtin_amdgcn_cvt_pk_fp8_f32(r1[0], r1[1], 0, false); w1 = __builtin_amdgcn_cvt_pk_fp8_f32(r1[2], r1[3], w1, true);
        *(u32x2*)((unsigned char*)H + row * 1024 + c8) = (u32x2){(unsigned)w0, (unsigned)w1};
    }
}

__device__ __forceinline__ s16x4 tr4(const LAS unsigned char* p) { return __builtin_bit_cast(s16x4, __builtin_amdgcn_ds_read_tr16_b64_v4i16((LAS s16x4*)p)); }
__device__ void hgrn_item(const Params& P, int item, LAS unsigned char* lds) {
    const int tid = tid_opaque(), lane = tid & 63, wid = __builtin_amdgcn_readfirstlane(tid >> 6), r32 = lane & 31, hi = lane >> 5;
    const int b = item >> 3, h = (item >> 1) & 3, vh = item & 1;
    const bf16_t* HQ = (const bf16_t*)(P.ws + OFF_HQ); const bf16_t* HK = (const bf16_t*)(P.ws + OFF_HK); bf16_t* HI = (bf16_t*)(P.ws + OFF_HI);
    constexpr int SQ = 272, SKD = 320, SV = 192, SS = 192;
    constexpr int LQR = 0, LKR = 17408, LQB = 34816, LKD = 52224, LV = 72704, LS = 84992, LG = 109568, LT = 142336, LCL = 144384;
    LAS float* G = (LAS float*)(lds + LG); LAS float* TOT = (LAS float*)(lds + LT); LAS float* CL = (LAS float*)(lds + LCL); LAS float* CH = (LAS float*)(lds + LCL + 512);
    const size_t rowb = (size_t)b * SEQ;
    const int row = tid >> 3, seg = tid & 7;
    const bf16_t* qsrc = HQ + (rowb + row) * 512 + h * 128 + seg * 16; const bf16_t* ksrc = HK + (rowb + row) * 512 + h * 128 + seg * 16;
    bf16_t* vsrc = HI + (rowb + row) * 512 + h * 128 + vh * 64 + seg * 8;
    for (int i = tid; i < 128 * SS / 4; i += NTHR) ((LAS unsigned*)(lds + LS))[i] = 0u;
    f32x16 Sacc = {};
    const int di = wid >> 1, vi = wid & 1, ti = wid >> 1;
    const int tg = lane >> 4, tc = tg & 1, tI = lane & 15;
    const int trow = 4 * hi + (tI >> 2), tcol = 16 * tc + 4 * (tI & 3);
    u32x4 qn0 = *(const u32x4*)qsrc, qn1 = *(const u32x4*)(qsrc + 8), kn0 = *(const u32x4*)ksrc, kn1 = *(const u32x4*)(ksrc + 8), vn = *(const u32x4*)vsrc;
#pragma unroll 1
    for (int n = 0; n < SEQ / 64; ++n) {
        const u32x4 q0 = qn0, q1 = qn1, k0 = kn0, k1 = kn1, vv = vn;
        float qf[16] = {bf_lo(q0.x), bf_hi(q0.x), bf_lo(q0.y), bf_hi(q0.y), bf_lo(q0.z), bf_hi(q0.z), bf_lo(q0.w), bf_hi(q0.w), bf_lo(q1.x), bf_hi(q1.x), bf_lo(q1.y), bf_hi(q1.y), bf_lo(q1.z), bf_hi(q1.z), bf_lo(q1.w), bf_hi(q1.w)};
        float kf[16] = {bf_lo(k0.x), bf_hi(k0.x), bf_lo(k0.y), bf_hi(k0.y), bf_lo(k0.z), bf_hi(k0.z), bf_lo(k0.w), bf_hi(k0.w), bf_lo(k1.x), bf_hi(k1.x), bf_lo(k1.y), bf_hi(k1.y), bf_lo(k1.z), bf_hi(k1.z), bf_lo(k1.w), bf_hi(k1.w)};
#pragma unroll
        for (int e4 = 0; e4 < 4; ++e4) *(LAS f32x4*)(G + row * 128 + seg * 16 + 4 * e4) = (f32x4){__logf(1.0f - kf[4 * e4]), __logf(1.0f - kf[4 * e4 + 1]), __logf(1.0f - kf[4 * e4 + 2]), __logf(1.0f - kf[4 * e4 + 3])};
        *(LAS u32x4*)(lds + LV + row * SV + seg * 16) = vv;
        if (n + 1 < SEQ / 64) { const size_t o = (size_t)(n + 1) * 64 * 512; qn0 = *(const u32x4*)(qsrc + o); qn1 = *(const u32x4*)(qsrc + o + 8); kn0 = *(const u32x4*)(ksrc + o); kn1 = *(const u32x4*)(ksrc + o + 8); vn = *(const u32x4*)(vsrc + o); }
        __syncthreads();
        { const int d = tid & 127, q4 = tid >> 7; float s = 0.f;
#pragma unroll
          for (int i = 0; i < 16; ++i) { s += G[(16 * q4 + i) * 128 + d]; G[(16 * q4 + i) * 128 + d] = s; }
          TOT[q4 * 128 + d] = s; }
        __syncthreads();
        {
            { const int d2 = 2 * lane;
              const f32x2 t0 = *(const LAS f32x2*)(TOT + d2), t1 = *(const LAS f32x2*)(TOT + 128 + d2), t2 = *(const LAS f32x2*)(TOT + 256 + d2), t3 = *(const LAS f32x2*)(TOT + 384 + d2);
              const f32x2 bref = *(const LAS f32x2*)(G + 32 * 128 + d2) + t0 + t1, blast = t0 + t1 + t2 + t3;
              *(LAS f32x2*)(CH + d2) = (f32x2){__expf(-bref.x), __expf(-bref.y)}; *(LAS f32x2*)(CH + 128 + d2) = (f32x2){__expf(bref.x), __expf(bref.y)}; *(LAS f32x2*)(CL + d2) = (f32x2){__expf(blast.x), __expf(blast.y)}; }
            const int qq = row >> 4;
#pragma unroll
            for (int e4 = 0; e4 < 4; ++e4) {
                const int d4 = seg * 16 + 4 * e4;
                const f32x4 t0 = *(const LAS f32x4*)(TOT + d4), t1 = *(const LAS f32x4*)(TOT + 128 + d4), t2 = *(const LAS f32x4*)(TOT + 256 + d4);
                const f32x4 off = (qq == 0) ? (f32x4){0.f, 0.f, 0.f, 0.f} : ((qq == 1) ? t0 : ((qq == 2) ? t0 + t1 : t0 + t1 + t2));
                const f32x4 bb = *(const LAS f32x4*)(G + row * 128 + d4) + off;
                const f32x4 enr = *(const LAS f32x4*)(CH + d4), epr = *(const LAS f32x4*)(CH + 128 + d4), epl = *(const LAS f32x4*)(CL + d4);
                float vqb[4], vqr[4], vkr[4], vkd[4];
#pragma unroll
                for (int e = 0; e < 4; ++e) {
                    const float e1 = __expf(bb[e]), e2 = __expf(-bb[e]);
                    vqb[e] = qf[4 * e4 + e] * e1; vqr[e] = vqb[e] * enr[e];
                    const float ke = kf[4 * e4 + e] * e2; vkr[e] = ke * epr[e]; vkd[e] = ke * epl[e];
                }
                *(LAS u32x2*)(lds + LQB + row * SQ + seg * 32 + 8 * e4) = (u32x2){cvt_pk_bf16(vqb[0], vqb[1]), cvt_pk_bf16(vqb[2], vqb[3])};
                *(LAS u32x2*)(lds + LQR + row * SQ + seg * 32 + 8 * e4) = (u32x2){cvt_pk_bf16(vqr[0], vqr[1]), cvt_pk_bf16(vqr[2], vqr[3])};
                *(LAS u32x2*)(lds + LKR + row * SQ + seg * 32 + 8 * e4) = (u32x2){cvt_pk_bf16(vkr[0], vkr[1]), cvt_pk_bf16(vkr[2], vkr[3])};
                *(LAS u32x2*)(lds + LKD + row * SKD + seg * 32 + 8 * e4) = (u32x2){cvt_pk_bf16(vkd[0], vkd[1]), cvt_pk_bf16(vkd[2], vkd[3])};
                asm volatile("" ::: "memory");
            }
        }
        __syncthreads();
        if (wid < 4) {
            f32x16 Z = {};
            for (int si = 0; si <= ti; ++si) {
                f32x16 X = {};
#pragma unroll
                for (int ks = 0; ks < 8; ++ks) {
                    const bf16x8 a = *(const LAS bf16x8*)(lds + LKR + (32 * si + r32) * SQ + (16 * ks + 8 * hi) * 2);
                    const bf16x8 bq = *(const LAS bf16x8*)(lds + LQR + (32 * ti + r32) * SQ + (16 * ks + 8 * hi) * 2);
                    X = MFMA32(a, bq, X);
                }
                if (si == ti) {
#pragma unroll
                    for (int r = 0; r < 16; ++r) if (crow(r, hi) > r32) X[r] = 0.f;
                }
#pragma unroll
                for (int s2 = 0; s2 < 2; ++s2) {
                    union { u32x4 u; bf16x8 v; } pa;
                    pa.u.x = cvt_pk_bf16(X[8 * s2 + 0], X[8 * s2 + 1]); pa.u.y = cvt_pk_bf16(X[8 * s2 + 2], X[8 * s2 + 3]); pa.u.z = cvt_pk_bf16(X[8 * s2 + 4], X[8 * s2 + 5]); pa.u.w = cvt_pk_bf16(X[8 * s2 + 6], X[8 * s2 + 7]);
                    const LAS unsigned char* vp = lds + LV + (32 * si + 16 * s2 + trow) * SV + (32 * vi + tcol) * 2;
                    const s16x4 lo = tr4(vp), hh = tr4(vp + 8 * SV);
                    const bf16x8 vf = {lo[0], lo[1], lo[2], lo[3], hh[0], hh[1], hh[2], hh[3]};
                    Z = MFMA32(pa.v, vf, Z);
                }
            }
#pragma unroll
            for (int ks = 0; ks < 8; ++ks) {
                const bf16x8 a = *(const LAS bf16x8*)(lds + LQB + (32 * ti + r32) * SQ + (16 * ks + 8 * hi) * 2);
                const LAS unsigned char* sp = lds + LS + (16 * ks + 8 * hi + (tI >> 2)) * SS + (32 * vi + tcol) * 2;
                const s16x4 lo = tr4(sp), hh = tr4(sp + 4 * SS);
                const bf16x8 sf = {lo[0], lo[1], lo[2], lo[3], hh[0], hh[1], hh[2], hh[3]};
                Z = MFMA32(a, sf, Z);
            }
            bf16_t* op = HI + (rowb + (size_t)n * 64 + 32 * ti) * 512 + h * 128 + vh * 64 + 32 * vi + r32;
#pragma unroll
            for (int r = 0; r < 16; ++r) op[(size_t)crow(r, hi) * 512] = (bf16_t)(cvt_pk_bf16(Z[r], 0.f) & 0xffffu);
        }
        {
#pragma unroll
            for (int r = 0; r < 16; ++r) Sacc[r] *= CL[32 * di + crow(r, hi)];
#pragma unroll
            for (int ks = 0; ks < 4; ++ks) {
                const LAS unsigned char* kp = lds + LKD + (16 * ks + 8 * hi + (tI >> 2)) * SKD + (32 * di + tcol) * 2;
                const s16x4 klo = tr4(kp), khi = tr4(kp + 4 * SKD);
                const bf16x8 ka = {klo[0], klo[1], klo[2], klo[3], khi[0], khi[1], khi[2], khi[3]};
                const LAS unsigned char* vp = lds + LV + (16 * ks + 8 * hi + (tI >> 2)) * SV + (32 * vi + tcol) * 2;
                const s16x4 vlo = tr4(vp), vhi = tr4(vp + 4 * SV);
                const bf16x8 vb = {vlo[0], vlo[1], vlo[2], vlo[3], vhi[0], vhi[1], vhi[2], vhi[3]};
                Sacc = MFMA32(ka, vb, Sacc);
            }
        }
        __syncthreads();
        {
            LAS bf16_t* sp = (LAS bf16_t*)(lds + LS + (32 * di) * SS + (32 * vi + r32) * 2);
#pragma unroll
            for (int r = 0; r < 16; ++r) sp[crow(r, hi) * (SS / 2)] = (bf16_t)(cvt_pk_bf16(Sacc[r], 0.f) & 0xffffu);
        }
    }
    __syncthreads();
}

__device__ void moba_unit(const Params& P, int b, int h, int j, LAS unsigned char* lds) {
    const int tid = tid_opaque(), lane = tid & 63, wid = tid >> 6, r32 = lane & 31, hi = lane >> 5;
    bf16_t* Q = (bf16_t*)(P.ws + OFF_QA); const bf16_t* Kg = (const bf16_t*)(P.ws + OFF_KA); const bf16_t* Vg = (const bf16_t*)(P.ws + OFF_VA);
    const float* kmean = (const float*)(P.ws + OFF_KMEAN);
    constexpr int KIMG = 64 * 144, VIMG = 64 * 192, LK = 0, LV = 4 * KIMG, LKM = 4 * KIMG + 4 * VIMG;
    LAS float* kmL = (LAS float*)(lds + LKM);
    const size_t rowb = (size_t)b * SEQ; const int q0 = j * 256;
    if (tid < j * 64) kmL[tid] = kmean[(size_t)(b * 8 + (tid >> 6)) * 512 + h * 64 + (tid & 63)];
    bf16_t* qrow = Q + (rowb + q0 + wid * 32 + r32) * 512 + h * 64;
    bf16x8 qf[4];
#pragma unroll
    for (int d0 = 0; d0 < 4; ++d0) qf[d0] = *(const bf16x8*)(qrow + 16 * d0 + 8 * hi);
    const int srow = tid >> 3, sch = tid & 7;
    const bf16_t* ksrc = Kg + (rowb + srow) * 512 + h * 64 + sch * 8; const bf16_t* vsrc = Vg + (rowb + srow) * 512 + h * 64 + sch * 8;
    const int ntile = 4 * (j + 1), npair = ntile >> 1;
    auto tile_key0 = [&](int i) -> size_t { const int blk = (i < 4) ? j : ((i - 4) >> 2), kt = (i < 4) ? i : ((i - 4) & 3); return (size_t)(blk * 256 + kt * 64); };
    u32x4 kreg[2], vreg[2];
#pragma unroll
    for (int s = 0; s < 2; ++s) { const size_t k0 = tile_key0(s); kreg[s] = *(const u32x4*)(ksrc + k0 * 512); vreg[s] = *(const u32x4*)(vsrc + k0 * 512); }
#pragma unroll
    for (int s = 0; s < 2; ++s) { *(LAS u32x4*)(lds + LK + s * KIMG + srow * 144 + sch * 16) = kreg[s]; *(LAS u32x4*)(lds + LV + s * VIMG + srow * 192 + sch * 16) = vreg[s]; }
    __syncthreads();
    unsigned sel = 0;
    if (j <= 3) sel = (1u << j) - 1u;
    else {
        float g[7];
#pragma unroll
        for (int n = 0; n < 7; ++n) { float s = 0.f;
            if (n < j) {
#pragma unroll
                for (int d0 = 0; d0 < 4; ++d0)
#pragma unroll
                    for (int e = 0; e < 8; ++e) s += __uint_as_float(((unsigned)(unsigned short)qf[d0][e]) << 16) * kmL[n * 64 + 16 * d0 + 8 * hi + e];
            }
            s += __shfl_xor(s, 32); g[n] = s; }
#pragma unroll
        for (int it = 0; it < 3; ++it) { float best = -INFINITY; int bi = 0;
#pragma unroll
            for (int n = 0; n < 7; ++n) if (n < j && !((sel >> n) & 1u) && g[n] > best) { best = g[n]; bi = n; }
            sel |= 1u << bi; }
    }
    const float ch = exp2f(-(float)(h + 1)) * LOG2E;
    const int qb = wid * 32 + r32;
    float m_run = -1e30f;
    f32x16 o0 = {}, o1 = {}, o2 = {};
    f32x16 al0, al1;
#pragma unroll
    for (int r = 0; r < 16; ++r) { al0[r] = ch * (float)crow(r, hi); al1[r] = ch * (float)(crow(r, hi) + 32); }
    const bf16x8 ones8 = {(short)0x3F80, (short)0x3F80, (short)0x3F80, (short)0x3F80, (short)0x3F80, (short)0x3F80, (short)0x3F80, (short)0x3F80};
    const int tg = lane >> 4, tc = tg & 1, ti = lane & 15;
    const int vlane = (4 * hi + (ti >> 2)) * 192 + (16 * tc + 4 * (ti & 3)) * 2;
#pragma unroll 1
    for (int ip = 0; ip < npair; ++ip) {
      const int pbuf = ip & 1;
      if (ip + 1 < npair) {
#pragma unroll
          for (int s = 0; s < 2; ++s) { const size_t k1 = tile_key0(2 * ip + 2 + s); kreg[s] = *(const u32x4*)(ksrc + k1 * 512); vreg[s] = *(const u32x4*)(vsrc + k1 * 512); }
      }
#pragma unroll
      for (int s2 = 0; s2 < 2; ++s2) {
        const int i = 2 * ip + s2, buf = pbuf * 2 + s2;
        const bool own = i < 4; const int blk = own ? j : ((i - 4) >> 2), kt = own ? i : ((i - 4) & 3);
        const bool lane_ok = own ? true : (((sel >> blk) & 1u) != 0u);
        const bool skip = own ? (64 * kt > 32 * wid + 31) : (__ballot(lane_ok) == 0ull);
        if (!skip) {
            LAS unsigned char* kb = lds + LK + buf * KIMG; LAS unsigned char* vb = lds + LV + buf * VIMG;
            f32x16 p0, p1;
#pragma unroll
            for (int d0 = 0; d0 < 4; ++d0) {
                const bf16x8 kf0 = *(const LAS bf16x8*)(kb + r32 * 144 + (16 * d0 + 8 * hi) * 2);
                const bf16x8 kf1 = *(const LAS bf16x8*)(kb + (32 + r32) * 144 + (16 * d0 + 8 * hi) * 2);
                p0 = MFMA32(kf0, qf[d0], d0 == 0 ? al0 : p0); p1 = MFMA32(kf1, qf[d0], d0 == 0 ? al1 : p1);
            }
            const float kbase = ch * (float)((blk - j) * 256 + kt * 64);
            float mt = -1e30f;
#pragma unroll
            for (int r = 0; r < 16; ++r) {
                const int kl0 = crow(r, hi), kl1 = kl0 + 32;
                if (own) { if (kt * 64 + kl0 > qb) p0[r] = -1e30f; if (kt * 64 + kl1 > qb) p1[r] = -1e30f; }
                mt = fmaxf(mt, fmaxf(p0[r], p1[r]));
            }
            mt = lane_ok ? mt + kbase : -1e30f;
            mt = fmaxf(mt, __shfl_xor(mt, 32));
            if (__ballot(mt > m_run) != 0ull) {
                const float mnew = fmaxf(m_run, mt), alpha = __builtin_amdgcn_exp2f(m_run - mnew);
                m_run = mnew;
#pragma unroll
                for (int r = 0; r < 16; ++r) { o0[r] *= alpha; o1[r] *= alpha; o2[r] *= alpha; }
            }
            const float sh = lane_ok ? kbase - m_run : -1e30f;
#pragma unroll
            for (int r = 0; r < 16; ++r) { p0[r] = __builtin_amdgcn_exp2f(p0[r] + sh); p1[r] = __builtin_amdgcn_exp2f(p1[r] + sh); }
#pragma unroll
            for (int sub = 0; sub < 2; ++sub)
#pragma unroll
                for (int s = 0; s < 2; ++s) {
                    union { u32x4 u; bf16x8 v; } pb;
                    if (sub == 0) { pb.u.x = cvt_pk_bf16(p0[8 * s + 0], p0[8 * s + 1]); pb.u.y = cvt_pk_bf16(p0[8 * s + 2], p0[8 * s + 3]); pb.u.z = cvt_pk_bf16(p0[8 * s + 4], p0[8 * s + 5]); pb.u.w = cvt_pk_bf16(p0[8 * s + 6], p0[8 * s + 7]); }
                    else { pb.u.x = cvt_pk_bf16(p1[8 * s + 0], p1[8 * s + 1]); pb.u.y = cvt_pk_bf16(p1[8 * s + 2], p1[8 * s + 3]); pb.u.z = cvt_pk_bf16(p1[8 * s + 4], p1[8 * s + 5]); pb.u.w = cvt_pk_bf16(p1[8 * s + 6], p1[8 * s + 7]); }
#pragma unroll
                    for (int dt = 0; dt < 2; ++dt) {
                        LAS unsigned char* va = vb + (32 * sub + 16 * s) * 192 + dt * 64 + vlane;
                        const s16x4 lo = __builtin_bit_cast(s16x4, __builtin_amdgcn_ds_read_tr16_b64_v4i16((LAS s16x4*)va));
                        const s16x4 hh = __builtin_bit_cast(s16x4, __builtin_amdgcn_ds_read_tr16_b64_v4i16((LAS s16x4*)(va + 8 * 192)));
                        const bf16x8 vf = {lo[0], lo[1], lo[2], lo[3], hh[0], hh[1], hh[2], hh[3]};
                        if (dt == 0) o0 = MFMA32(vf, pb.v, o0); else o1 = MFMA32(vf, pb.v, o1);
                    }
                    o2 = MFMA32(ones8, pb.v, o2);
                }
        }
      }
      if (ip + 1 < npair) { const int nb = (pbuf ^ 1) * 2;
#pragma unroll
          for (int s = 0; s < 2; ++s) { *(LAS u32x4*)(lds + LK + (nb + s) * KIMG + srow * 144 + sch * 16) = kreg[s]; *(LAS u32x4*)(lds + LV + (nb + s) * VIMG + srow * 192 + sch * 16) = vreg[s]; } }
      __syncthreads();
    }
    const float inv = 1.0f / o2[0];
#pragma unroll
    for (int r4 = 0; r4 < 4; ++r4) {
        int w0 = __builtin_amdgcn_cvt_pk_fp8_f32(o0[4 * r4] * inv, o0[4 * r4 + 1] * inv, 0, false); w0 = __builtin_amdgcn_cvt_pk_fp8_f32(o0[4 * r4 + 2] * inv, o0[4 * r4 + 3] * inv, w0, true);
        int w1 = __builtin_amdgcn_cvt_pk_fp8_f32(o1[4 * r4] * inv, o1[4 * r4 + 1] * inv, 0, false); w1 = __builtin_amdgcn_cvt_pk_fp8_f32(o1[4 * r4 + 2] * inv, o1[4 * r4 + 3] * inv, w1, true);
        unsigned char* yrow = P.ws + OFF_EG + (rowb + q0 + wid * 32 + r32) * 1024 + h * 64;
        *(int*)(yrow + 8 * r4 + 4 * hi) = w0; *(int*)(yrow + 32 + 8 * r4 + 4 * hi) = w1;
    }
}

__device__ void yb_norm_panel(const Params& P, int pm) {
    const int tid = tid_opaque(), lane = tid & 63, wid = tid >> 6;
    bf16_t* HI = (bf16_t*)(P.ws + OFF_HI); const bf16_t* HG = (const bf16_t*)(P.ws + OFF_HG);
    for (int r = 0; r < 32; ++r) {
        const size_t off = ((size_t)pm * 256 + wid * 32 + r) * 512 + lane * 8;
        const u32x4 ov = *(const u32x4*)(HI + off), gv = *(const u32x4*)(HG + off);
        float o[8] = {bf_lo(ov.x), bf_hi(ov.x), bf_lo(ov.y), bf_hi(ov.y), bf_lo(ov.z), bf_hi(ov.z), bf_lo(ov.w), bf_hi(ov.w)};
        const float g[8] = {bf_lo(gv.x), bf_hi(gv.x), bf_lo(gv.y), bf_hi(gv.y), bf_lo(gv.z), bf_hi(gv.z), bf_lo(gv.w), bf_hi(gv.w)};
        float ss = 0.f;
#pragma unroll
        for (int e = 0; e < 8; ++e) ss += o[e] * o[e];
        ss += __shfl_xor(ss, 1); ss += __shfl_xor(ss, 2); ss += __shfl_xor(ss, 4); ss += __shfl_xor(ss, 8);
        const float rs = rsqrtf(ss * (1.0f / 128.0f) + RMS_EPS);
        int w0 = __builtin_amdgcn_cvt_pk_fp8_f32(o[0] * rs * g[0], o[1] * rs * g[1], 0, false); w0 = __builtin_amdgcn_cvt_pk_fp8_f32(o[2] * rs * g[2], o[3] * rs * g[3], w0, true);
        int w1 = __builtin_amdgcn_cvt_pk_fp8_f32(o[4] * rs * g[4], o[5] * rs * g[5], 0, false); w1 = __builtin_amdgcn_cvt_pk_fp8_f32(o[6] * rs * g[6], o[7] * rs * g[7], w1, true);
        *(u32x2*)(P.ws + OFF_EG + ((size_t)pm * 256 + wid * 32 + r) * 1024 + 512 + lane * 8) = (u32x2){(unsigned)w0, (unsigned)w1};
    }
}
__device__ void ln1_panel(const Params& P, int pm) {
    const int tid = tid_opaque(), lane = tid & 63, wid = tid >> 6;
    const float* ada = (const float*)(P.ws + OFF_ADA) + (size_t)(pm >> 3) * 6144; bf16_t* H = (bf16_t*)(P.ws + OFF_H);
    for (int r = 0; r < 32; ++r) {
        const size_t row = (size_t)pm * 256 + wid * 32 + r;
        const float* xin = P.x + row * 1024 + lane * 4; const unsigned char* dl = P.ws + OFF_GB + row * 2048 + lane * 4;
        f32x4 v[4]; float s = 0.f;
#pragma unroll
        for (int jx = 0; jx < 4; ++jx) { const int dv = *(const int*)(dl + 256 * jx); const f32x4 xv = __builtin_nontemporal_load((const f32x4*)(xin + 256 * jx));
            const f32x2 d01 = __builtin_amdgcn_cvt_pk_f32_fp8(dv, false), d23 = __builtin_amdgcn_cvt_pk_f32_fp8(dv, true);
            v[jx] = xv * ALPHA + (f32x4){d01.x, d01.y, d23.x, d23.y}; s += (v[jx][0] + v[jx][1]) + (v[jx][2] + v[jx][3]); }
        const float mean = wave_sum(s) * (1.0f / 1024.0f); float s2 = 0.f;
#pragma unroll
        for (int jx = 0; jx < 4; ++jx) { v[jx] = v[jx] - mean; s2 += (v[jx][0] * v[jx][0] + v[jx][1] * v[jx][1]) + (v[jx][2] * v[jx][2] + v[jx][3] * v[jx][3]); }
        const float rstd = rsqrtf(wave_sum(s2) * (1.0f / 1024.0f) + LN_EPS);
#pragma unroll
        for (int jx = 0; jx < 4; ++jx) {
            const int c = lane * 4 + 256 * jx;
            const f32x4 g = *(const f32x4*)(P.ln1_g + c), bb = *(const f32x4*)(P.ln1_b + c), sh = *(const f32x4*)(ada + 3072 + c), sc = *(const f32x4*)(ada + 4096 + c);
            const f32x4 x1 = v[jx] * rstd * g + bb;
            { u32x2 w1; w1.x = cvt_pk_bf16(x1[0], x1[1]); w1.y = cvt_pk_bf16(x1[2], x1[3]);
              *(u32x2*)((bf16_t*)(P.out + row * 1024) + c) = w1; }
            const f32x4 h2 = x1 * (sc + 1.0f) + sh;
            u32x2 w; w.x = cvt_pk_bf16(h2[0], h2[1]); w.y = cvt_pk_bf16(h2[2], h2[3]);
            *(u32x2*)(H + row * 1024 + c) = w;
            v[jx] = h2;
        }
        {
            float mx = 0.f;
#pragma unroll
            for (int jx = 0; jx < 4; ++jx) mx = fmaxf(mx, fmaxf(fmaxf(fabsf(v[jx][0]), fabsf(v[jx][1])), fmaxf(fabsf(v[jx][2]), fabsf(v[jx][3]))));
#pragma unroll
            for (int o = 1; o < 64; o <<= 1) mx = fmaxf(mx, __shfl_xor(mx, o));
            const float hs = fmaxf(mx * (1.0f / 119.0f), 1e-30f), inv = 1.0f / hs; int qs = 0;
            const int nsh = (lane & 1) * 4;
#pragma unroll
            for (int jx = 0; jx < 4; ++jx) {
                unsigned pa = 0u, pb = 0u;
#pragma unroll
                for (int k = 0; k < 4; ++k) { const int q = (int)rintf(v[jx][k] * inv); qs += q;
                    const int b = ((q + 8) & 15) - 8, a = (q - b) >> 4;
                    pa |= (unsigned)(a & 15) << (8 * k + nsh); pb |= (unsigned)(b & 15) << (8 * k + nsh); }
                pa |= __shfl_xor(pa, 1); pb |= __shfl_xor(pb, 1);
                if (!(lane & 1)) { unsigned* hp4 = (unsigned*)(P.ws + OFF_H8 + row * 1024) + (lane >> 1) + 32 * jx; hp4[0] = pa; hp4[128] = pb; }
            }
#pragma unroll
            for (int o = 1; o < 64; o <<= 1) qs += __shfl_xor(qs, o);
            if (lane == 0) *(f32x2*)(P.ws + OFF_HS + row * 8) = (f32x2){hs, (float)qs};
        }
    }
}

#define CE16(A, i, j) do { const float hi_ = fmaxf(A[i], A[j]); A[j] = fminf(A[i], A[j]); A[i] = hi_; } while (0)
#define SORT16(A) do { CE16(A, 0, 1); CE16(A, 2, 3); CE16(A, 0, 2); CE16(A, 1, 3); CE16(A, 1, 2); CE16(A, 4, 5); CE16(A, 6, 7); CE16(A, 4, 6); CE16(A, 5, 7); CE16(A, 5, 6); CE16(A, 0, 4); CE16(A, 2, 6); CE16(A, 2, 4); CE16(A, 1, 5); CE16(A, 3, 7); CE16(A, 3, 5); CE16(A, 1, 2); CE16(A, 3, 4); CE16(A, 5, 6); CE16(A, 8, 9); CE16(A, 10, 11); CE16(A, 8, 10); CE16(A, 9, 11); CE16(A, 9, 10); CE16(A, 12, 13); CE16(A, 14, 15); CE16(A, 12, 14); CE16(A, 13, 15); CE16(A, 13, 14); CE16(A, 8, 12); CE16(A, 10, 14); CE16(A, 10, 12); CE16(A, 9, 13); CE16(A, 11, 15); CE16(A, 11, 13); CE16(A, 9, 10); CE16(A, 11, 12); CE16(A, 13, 14); CE16(A, 0, 8); CE16(A, 4, 12); CE16(A, 4, 8); CE16(A, 2, 10); CE16(A, 6, 14); CE16(A, 6, 10); CE16(A, 2, 4); CE16(A, 6, 8); CE16(A, 10, 12); CE16(A, 1, 9); CE16(A, 5, 13); CE16(A, 5, 9); CE16(A, 3, 11); CE16(A, 7, 15); CE16(A, 7, 11); CE16(A, 3, 5); CE16(A, 7, 9); CE16(A, 11, 13); CE16(A, 1, 2); CE16(A, 3, 4); CE16(A, 5, 6); CE16(A, 7, 8); CE16(A, 9, 10); CE16(A, 11, 12); CE16(A, 13, 14); } while (0)
#define BITONIC16(A) do { CE16(A, 0, 8); CE16(A, 1, 9); CE16(A, 2, 10); CE16(A, 3, 11); CE16(A, 4, 12); CE16(A, 5, 13); CE16(A, 6, 14); CE16(A, 7, 15); CE16(A, 0, 4); CE16(A, 1, 5); CE16(A, 2, 6); CE16(A, 3, 7); CE16(A, 8, 12); CE16(A, 9, 13); CE16(A, 10, 14); CE16(A, 11, 15); CE16(A, 0, 2); CE16(A, 1, 3); CE16(A, 4, 6); CE16(A, 5, 7); CE16(A, 8, 10); CE16(A, 9, 11); CE16(A, 12, 14); CE16(A, 13, 15); CE16(A, 0, 1); CE16(A, 2, 3); CE16(A, 4, 5); CE16(A, 6, 7); CE16(A, 8, 9); CE16(A, 10, 11); CE16(A, 12, 13); CE16(A, 14, 15); } while (0)
#define INS16(L, xin) do { float x_ = (xin); _Pragma("unroll") for (int k_ = 0; k_ < 16; ++k_) { const float hi_ = fmaxf(L[k_], x_); x_ = fminf(L[k_], x_); L[k_] = hi_; } } while (0)

__device__ void peer_select_wave(const Params& P, size_t tok0) {
    const int lane = tid_opaque() & 63, r32 = lane & 31, hi = lane >> 5;
    const bf16_t* QP = (const bf16_t*)(P.ws + OFF_GB) + (tok0 + r32) * 1024; const bf16_t* SK = (const bf16_t*)(P.ws + OFF_SK);
    unsigned* EG = (unsigned*)(P.ws + OFF_EG) + (tok0 + r32) * 128;
#pragma unroll 1
    for (int h = 0; h < 8; ++h) {
        float a0[16], a1[16];
#pragma unroll
        for (int k = 0; k < 16; ++k) { a0[k] = -INFINITY; a1[k] = -INFINITY; }
#pragma unroll
        for (int p = 0; p < 2; ++p) {
            const int hp = h * 2 + p;
            bf16x8 qf[4];
#pragma unroll
            for (int ks = 0; ks < 4; ++ks) qf[ks] = *(const bf16x8*)(QP + hp * 64 + 16 * ks + 8 * hi);
            float L[16];
#pragma unroll
            for (int kt = 0; kt < 4; ++kt) {
                f32x16 acc = {};
#pragma unroll
                for (int ks = 0; ks < 4; ++ks) { const bf16x8 kf = *(const bf16x8*)(SK + ((size_t)hp * 128 + 32 * kt + r32) * 64 + 16 * ks + 8 * hi); acc = MFMA32(kf, qf[ks], acc); }
                float S[16];
#pragma unroll
                for (int r = 0; r < 16; ++r) { const unsigned key = (unsigned)(32 * kt + crow(r, hi)); S[r] = __uint_as_float((__float_as_uint(acc[r]) & ~127u) | key); }
                SORT16(S);
                if (kt == 0) {
#pragma unroll
                    for (int k = 0; k < 16; ++k) L[k] = S[k];
                } else {
#pragma unroll
                    for (int k = 0; k < 16; ++k) L[k] = fmaxf(L[k], S[15 - k]);
                    BITONIC16(L);
                }
            }
            {
                float O[16];
#pragma unroll
                for (int k = 0; k < 16; ++k) O[k] = __shfl_xor(L[15 - k], 32);
#pragma unroll
                for (int k = 0; k < 16; ++k) L[k] = fmaxf(L[k], O[k]);
                BITONIC16(L);
            }
#pragma unroll
            for (int k = 0; k < 16; ++k) { a0[k] = (p == 0) ? L[k] : a0[k]; a1[k] = (p == 1) ? L[k] : a1[k]; }
        }
        float best[16];
#pragma unroll
        for (int k = 0; k < 16; ++k) best[k] = __uint_as_float((__float_as_uint(a0[0] + a1[k]) & ~255u) | (unsigned)k);
#define PKC(i, j) __uint_as_float((__float_as_uint(a0[i] + a1[j]) & ~255u) | (unsigned)((i) * 16 + (j)))
        {
            float A[16] = {PKC(1, 0), PKC(1, 1), PKC(1, 2), PKC(1, 3), PKC(1, 4), PKC(1, 5), PKC(1, 6), PKC(1, 7), PKC(15, 0), PKC(14, 0), PKC(13, 0), PKC(12, 0), PKC(11, 0), PKC(10, 0), PKC(9, 0), PKC(8, 0)};
            BITONIC16(A);
#pragma unroll
            for (int k = 0; k < 16; ++k) best[k] = fmaxf(best[k], A[15 - k]);
            BITONIC16(best);
            float B[16] = {PKC(2, 0), PKC(2, 1), PKC(2, 2), PKC(2, 3), PKC(2, 4), PKC(3, 0), PKC(3, 1), PKC(3, 2), PKC(3, 3), PKC(4, 0), PKC(4, 1), PKC(4, 2), PKC(5, 0), PKC(5, 1), PKC(6, 0), PKC(6, 1)};
            SORT16(B);
#pragma unroll
            for (int k = 0; k < 16; ++k) best[k] = fmaxf(best[k], B[15 - k]);
            BITONIC16(best);
            INS16(best, PKC(7, 0)); INS16(best, PKC(7, 1));
        }
#undef PKC
        unsigned pk0[4], pk1[4];
#pragma unroll
        for (int q = 0; q < 4; ++q) {
            pk0[q] = (__float_as_uint(a0[4 * q]) & 127u) | ((__float_as_uint(a0[4 * q + 1]) & 127u) << 8) | ((__float_as_uint(a0[4 * q + 2]) & 127u) << 16) | ((__float_as_uint(a0[4 * q + 3]) & 127u) << 24);
            pk1[q] = (__float_as_uint(a1[4 * q]) & 127u) | ((__float_as_uint(a1[4 * q + 1]) & 127u) << 8) | ((__float_as_uint(a1[4 * q + 2]) & 127u) << 16) | ((__float_as_uint(a1[4 * q + 3]) & 127u) << 24);
        }
        unsigned pay[16];
#pragma unroll
        for (int k = 0; k < 16; ++k) {
            const unsigned code = __float_as_uint(best[k]) & 255u, ci = code >> 4, cj = code & 15u;
            const unsigned qi = ci >> 2, qj = cj >> 2;
            const unsigned w0 = (qi == 0u) ? pk0[0] : ((qi == 1u) ? pk0[1] : ((qi == 2u) ? pk0[2] : pk0[3]));
            const unsigned w1 = (qj == 0u) ? pk1[0] : ((qj == 1u) ? pk1[1] : ((qj == 2u) ? pk1[2] : pk1[3]));
            pay[k] = (((w0 >> ((ci & 3u) * 8u)) & 127u) << 7) | ((w1 >> ((cj & 3u) * 8u)) & 127u);
        }
        float e[16], es = 0.f;
#pragma unroll
        for (int k = 0; k < 16; ++k) { e[k] = __expf(best[k] - best[0]); es += e[k]; }
        const float inv = 1.0f / es;
        if (hi == 0) {
#pragma unroll
            for (int k = 0; k < 16; ++k) EG[h * 16 + k] = pay[k] | (cvt_pk_bf16(e[k] * inv, 0.f) << 16);
        }
    }
}
__device__ __forceinline__ unsigned xcc_id() { return (unsigned)__builtin_amdgcn_s_getreg((3 << 11) | 20) & 0xFu; }
__device__ __forceinline__ float dot16_fp8(const float (&hv)[16], const u32x4 r) {
    float s = 0.f;
    { const f32x2 a = __builtin_amdgcn_cvt_pk_f32_fp8((int)r.x, false), b = __builtin_amdgcn_cvt_pk_f32_fp8((int)r.x, true); s += hv[0] * a.x + hv[1] * a.y + hv[2] * b.x + hv[3] * b.y; }
    { const f32x2 a = __builtin_amdgcn_cvt_pk_f32_fp8((int)r.y, false), b = __builtin_amdgcn_cvt_pk_f32_fp8((int)r.y, true); s += hv[4] * a.x + hv[5] * a.y + hv[6] * b.x + hv[7] * b.y; }
    { const f32x2 a = __builtin_amdgcn_cvt_pk_f32_fp8((int)r.z, false), b = __builtin_amdgcn_cvt_pk_f32_fp8((int)r.z, true); s += hv[8] * a.x + hv[9] * a.y + hv[10] * b.x + hv[11] * b.y; }
    { const f32x2 a = __builtin_amdgcn_cvt_pk_f32_fp8((int)r.w, false), b = __builtin_amdgcn_cvt_pk_f32_fp8((int)r.w, true); s += hv[12] * a.x + hv[13] * a.y + hv[14] * b.x + hv[15] * b.y; }
    return s;
}
template <int NP, class F> __device__ __forceinline__ void partition_queue(const Params& P, LAS unsigned char* lds, int ctr_base, F f) {
    const int tid = tid_opaque();
    LAS int* slot = (LAS int*)(lds + LDS_BYTES - 64);
    unsigned* ctr = (unsigned*)(P.ws + OFF_CTR) + ctr_base;
    const int myx = (int)(xcc_id() & 7u);
    for (int pp = 0; pp < NP; ++pp) {
        const int p = (myx * (NP / 8) + pp) % NP;
        for (;;) {
            if (tid == 0) *slot = (int)atomicAdd(ctr + p, 1u);
            __syncthreads();
            const int item = *slot;
            __syncthreads();
            if (item >= NTOK / 64) break;
            f(p, item);
        }
    }
}
__device__ __forceinline__ float dot2bf(unsigned a, bf16v2 b, float c) { return __builtin_amdgcn_fdot2_f32_bf16(__builtin_bit_cast(bf16v2, a), b, c, false); }
__device__ __forceinline__ float gelu_erf(float v) {
    const float av = fabsf(v), t = __builtin_amdgcn_rcpf(__builtin_fmaf(av, 0.2316418882f, 1.0f));
    float q = __builtin_fmaf(t, 0.5307027145f, -0.7265760135f); q = __builtin_fmaf(q, t, 0.7107068705f); q = __builtin_fmaf(q, t, -0.142248368f); q = __builtin_fmaf(q, t, 0.127414796f); q = q * t;
    const float m = v * (q * __builtin_amdgcn_exp2f(v * v * -0.72134752044f));
    return v < 0.f ? m : v - m;
}
struct UQuad { u32x4 r[2]; u32x4 ent, nxt; };
__device__ __forceinline__ void uq_issue(UQuad& q, const LAS u32x4* list, int J, int NQ, int g, const unsigned char* Ub, const unsigned lo) {
    q.ent = q.nxt;
    const unsigned char* rp = Ub + (q.ent.x * 512u + lo);
    q.r[0] = *(const u32x4*)rp; q.r[1] = *(const u32x4*)(rp + 256);
    const int jj = J < NQ ? J : NQ - 1;
    q.nxt = list[4 * jj + g];
}
__device__ __forceinline__ float uq_dot(const UQuad& q, const u32x4 (&hp)[4]) {
    int a = 0, b = 0;
#pragma unroll
    for (int c = 0; c < 2; ++c) {
        const u32x4 r = q.r[c];
        a = __builtin_amdgcn_sdot8((int)hp[c].x, (int)r.x, a, false); a = __builtin_amdgcn_sdot8((int)hp[c].y, (int)r.y, a, false);
        a = __builtin_amdgcn_sdot8((int)hp[c].z, (int)r.z, a, false); a = __builtin_amdgcn_sdot8((int)hp[c].w, (int)r.w, a, false);
        b = __builtin_amdgcn_sdot8((int)hp[2 + c].x, (int)r.x, b, false); b = __builtin_amdgcn_sdot8((int)hp[2 + c].y, (int)r.y, b, false);
        b = __builtin_amdgcn_sdot8((int)hp[2 + c].z, (int)r.z, b, false); b = __builtin_amdgcn_sdot8((int)hp[2 + c].w, (int)r.w, b, false);
    }
    float s = (float)(16 * a + b);
    s = dpp_add<0xB1>(s); s = dpp_add<0x4E>(s); s = dpp_add<0x141>(s); s = dpp_add<0x140>(s);
    return s;
}
__device__ __forceinline__ void peer_u_tokens(const Params& P, LAS unsigned char* lds, const size_t t0) {
    const int tid = tid_opaque(), lane = tid & 63, wid = tid >> 6, g = lane >> 4, li = lane & 15;
    const unsigned char* H8 = P.ws + OFF_H8 + li * 16; const unsigned char* Ub = P.ws + OFF_U8; const unsigned lo16 = (unsigned)li * 16u;
    const f32x2* HS = (const f32x2*)(P.ws + OFF_HS); const float* USC = (const float*)(P.ws + OFF_USC);
    const u32x2* EG2 = (const u32x2*)(P.ws + OFF_EG); unsigned* W = (unsigned*)(P.ws + OFF_W);
    LAS u32x4* list = (LAS u32x4*)(lds + wid * 16384);
    {
        u32x2 egv[8]; float s0[8], s1[8];
#pragma unroll
        for (int i = 0; i < 8; ++i) egv[i] = EG2[(t0 + i) * 64 + lane];
#pragma unroll
        for (int i = 0; i < 8; ++i) { s0[i] = USC[egv[i].x & 0xFFFFu]; s1[i] = USC[egv[i].y & 0xFFFFu]; }
#pragma unroll
        for (int i = 0; i < 8; ++i) {
            list[i * 128 + 2 * lane] = (u32x4){egv[i].x & 0xFFFFu, egv[i].x & 0xFFFF0000u, (unsigned)(2 * lane) | (unsigned)(i << 8), __float_as_uint(s0[i])};
            list[i * 128 + 2 * lane + 1] = (u32x4){egv[i].y & 0xFFFFu, egv[i].y & 0xFFFF0000u, (unsigned)(2 * lane + 1) | (unsigned)(i << 8), __float_as_uint(s1[i])};
        }
    }
    constexpr int NQ = 256;
    u32x4 hp[4], hn[4]; f32x2 hsc = HS[t0], hsn = HS[t0 + 1];
#pragma unroll
    for (int c = 0; c < 2; ++c) { hp[c] = *(const u32x4*)(H8 + t0 * 1024 + 256 * c); hp[2 + c] = *(const u32x4*)(H8 + t0 * 1024 + 512 + 256 * c);
                                  hn[c] = *(const u32x4*)(H8 + (t0 + 1) * 1024 + 256 * c); hn[2 + c] = *(const u32x4*)(H8 + (t0 + 1) * 1024 + 512 + 256 * c); }
    int curtok = 0;
    UQuad q0, q1, q2, q3, q4, q5, q6, q7;
    q0.nxt = list[g]; q1.nxt = list[4 + g]; q2.nxt = list[8 + g]; q3.nxt = list[12 + g]; q4.nxt = list[16 + g]; q5.nxt = list[20 + g]; q6.nxt = list[24 + g]; q7.nxt = list[28 + g];
    uq_issue(q0, list, 8, NQ, g, Ub, lo16); uq_issue(q1, list, 9, NQ, g, Ub, lo16); uq_issue(q2, list, 10, NQ, g, Ub, lo16); uq_issue(q3, list, 11, NQ, g, Ub, lo16);
    uq_issue(q4, list, 12, NQ, g, Ub, lo16); uq_issue(q5, list, 13, NQ, g, Ub, lo16); uq_issue(q6, list, 14, NQ, g, Ub, lo16); uq_issue(q7, list, 15, NQ, g, Ub, lo16);
    float sv = 0.f; unsigned gv = 0u, zv = 0u, ev = 0u;
#define UQ_PIN(q) asm volatile("" : "+v"(q.r[0]), "+v"(q.r[1]) :: "memory")
#define UQ_STEP(q, Jn, kq, qn) do { \
        const float s = __uint_as_float(q.ent.w) * hsc.x * (uq_dot(q, hp) + 0.5f * hsc.y); \
        if (li == (kq)) { sv = s; gv = q.ent.y; zv = q.ent.z; ev = q.ent.x; } \
        uq_issue(q, list, (Jn), NQ, g, Ub, lo16); UQ_PIN(qn); } while (0)
    UQ_PIN(q0);
#pragma unroll 1
    for (int J = 0; J < NQ; J += 8) {
        const int tk = __builtin_amdgcn_readfirstlane((int)(q0.ent.z >> 8));
        if (tk != curtok) { curtok = tk;
#pragma unroll
            for (int c = 0; c < 4; ++c) hp[c] = hn[c];
            hsc = hsn;
            if (tk + 1 < 8) { hsn = HS[t0 + tk + 1];
#pragma unroll
                for (int c = 0; c < 2; ++c) { hn[c] = *(const u32x4*)(H8 + (t0 + tk + 1) * 1024 + 256 * c); hn[2 + c] = *(const u32x4*)(H8 + (t0 + tk + 1) * 1024 + 512 + 256 * c); } } }
        UQ_STEP(q0, J + 16, 0, q1); UQ_STEP(q1, J + 17, 1, q2); UQ_STEP(q2, J + 18, 2, q3); UQ_STEP(q3, J + 19, 3, q4);
        UQ_STEP(q4, J + 20, 4, q5); UQ_STEP(q5, J + 21, 5, q6); UQ_STEP(q6, J + 22, 6, q7); UQ_STEP(q7, J + 23, 7, q0);
        if (li < 8) W[(t0 + tk) * 128 + (zv & 255u)] = ev | (cvt_pk_bf16(__uint_as_float(gv) * gelu_erf(sv), 0.f) << 16); }
#undef UQ_STEP
}
typedef int v4i_t __attribute__((ext_vector_type(4)));
struct VQuad { u32x4 r[2]; u32x2 ent, nxt; };
__device__ __forceinline__ void vq_issue(VQuad& q, const LAS u32x2* list, int J, int g, const unsigned char* Vb, const unsigned lo) {
    q.ent = q.nxt;
    const unsigned char* rp = Vb + (q.ent.x * 512u + lo);
    q.r[0] = *(const u32x4*)rp; q.r[1] = *(const u32x4*)(rp + 256);
    const int jj = J < 256 ? J : 255;
    q.nxt = list[4 * jj + g];
}
#define VQ_PIN(q) asm volatile("" : "+v"(q.r[0]), "+v"(q.r[1]) :: "memory")
__device__ __forceinline__ void vq_mma(const VQuad& q, v4i_t (&acc)[4], const u32x4 bm) {
    const unsigned t = q.ent.y;
    const v4i_t B = {(int)(t & bm.x), (int)(t & bm.y), (int)(t & bm.z), (int)(t & bm.w)};
#pragma unroll
    for (int c = 0; c < 2; ++c) {
        const u32x4 r = q.r[c];
        const v4i_t lo = {(int)(r.x & 0x0F0F0F0Fu), (int)(r.y & 0x0F0F0F0Fu), (int)(r.z & 0x0F0F0F0Fu), (int)(r.w & 0x0F0F0F0Fu)};
        const v4i_t raw = {(int)r.x, (int)r.y, (int)r.z, (int)r.w};
        acc[2 * c] = __builtin_amdgcn_mfma_i32_16x16x64_i8(lo, B, acc[2 * c], 0, 0, 0);
        acc[2 * c + 1] = __builtin_amdgcn_mfma_i32_16x16x64_i8(raw, B, acc[2 * c + 1], 0, 0, 0);
    }
}
__device__ __forceinline__ void peer_v_tokens(const Params& P, LAS unsigned char* lds, const size_t t0) {
    const int tid = tid_opaque(), lane = tid & 63, wid = tid >> 6, g = lane >> 4, li = lane & 15;
    const unsigned char* Vb = P.ws + OFF_V8; const unsigned lo16 = (unsigned)li * 16u; const float* VSC = (const float*)(P.ws + OFF_VSC);
    const u32x2* W2 = (const u32x2*)(P.ws + OFF_W);
    LAS u32x2* lists = (LAS u32x2*)(lds + wid * 8192);
    LAS f32x2* tokp = (LAS f32x2*)(lds + 65536 + wid * 64);
    {
        u32x2 egv[8]; f32x2 wwv[8];
#pragma unroll
        for (int i = 0; i < 8; ++i) { const u32x2 ew = W2[(t0 + i) * 64 + lane]; egv[i].x = ew.x & 0xFFFFu; egv[i].y = ew.y & 0xFFFFu; wwv[i] = (f32x2){__uint_as_float(ew.x & 0xFFFF0000u), __uint_as_float(ew.y & 0xFFFF0000u)}; }
        float w0v[8], w1v[8];
#pragma unroll
        for (int i = 0; i < 8; ++i) { w0v[i] = wwv[i].x * VSC[egv[i].x]; w1v[i] = wwv[i].y * VSC[egv[i].y]; }
#pragma unroll
        for (int i = 0; i < 8; ++i) {
            const float mx = wave_max_fast(fmaxf(fabsf(w0v[i]), fabsf(w1v[i])));
            const float sw = fmaxf(mx * (1.0f / 127.0f), 1e-30f), inv = 1.0f / sw;
            const int q0 = (int)rintf(w0v[i] * inv), q1 = (int)rintf(w1v[i] * inv);
            *(LAS u32x4*)(lists + i * 128 + 2 * lane) = (u32x4){egv[i].x, ((unsigned)q0 & 255u) * 0x01010101u, egv[i].y, ((unsigned)q1 & 255u) * 0x01010101u};
            const int qs = wave_sum_int_fast(q0 + q1);
            if (lane == 0) tokp[i] = (f32x2){sw, 7.5f * sw * (float)qs}; }
    }
    const unsigned bsel = 0xFFu << (8u * (unsigned)(li & 3));
    const u32x4 bm = {(li >> 2) == 0 ? bsel : 0u, (li >> 2) == 1 ? bsel : 0u, (li >> 2) == 2 ? bsel : 0u, (li >> 2) == 3 ? bsel : 0u};
    const int dbase = 128 * g + 8 * (li >> 2) + (li & 3);
    float gt2v[16], lgv[16], lbv[16];
    { const float* gt2 = (const float*)(P.ws + OFF_ADA) + (t0 >> 11) * 6144 + 5120;
#pragma unroll
      for (int c = 0; c < 2; ++c)
#pragma unroll
          for (int hf = 0; hf < 2; ++hf)
#pragma unroll
              for (int r = 0; r < 4; ++r) { const int d = dbase + 512 * c + 32 * r + 4 * hf, e = 8 * c + 4 * hf + r; gt2v[e] = gt2[d]; lgv[e] = P.ln2_g[d]; lbv[e] = P.ln2_b[d]; } }
    VQuad q0, q1, q2, q3, q4, q5, q6, q7;
    q0.nxt = lists[g]; q1.nxt = lists[4 + g]; q2.nxt = lists[8 + g]; q3.nxt = lists[12 + g]; q4.nxt = lists[16 + g]; q5.nxt = lists[20 + g]; q6.nxt = lists[24 + g]; q7.nxt = lists[28 + g];
    vq_issue(q0, lists, 8, g, Vb, lo16); vq_issue(q1, lists, 9, g, Vb, lo16); vq_issue(q2, lists, 10, g, Vb, lo16); vq_issue(q3, lists, 11, g, Vb, lo16);
    vq_issue(q4, lists, 12, g, Vb, lo16); vq_issue(q5, lists, 13, g, Vb, lo16); vq_issue(q6, lists, 14, g, Vb, lo16); vq_issue(q7, lists, 15, g, Vb, lo16);
    VQ_PIN(q0);
#pragma unroll 1
    for (int i = 0; i < 8; ++i) {
        const size_t t = t0 + i;
        v4i_t acc[4];
#pragma unroll
        for (int j = 0; j < 4; ++j) acc[j] = (v4i_t){0, 0, 0, 0};
        float* xr = P.out + t * 1024;
        float xv[16];
#pragma unroll
        for (int c = 0; c < 2; ++c)
#pragma unroll
            for (int hf = 0; hf < 2; ++hf)
#pragma unroll
                for (int r = 0; r < 4; ++r) xv[8 * c + 4 * hf + r] = __uint_as_float((unsigned)((const bf16_t*)xr)[dbase + 512 * c + 32 * r + 4 * hf] << 16);
#pragma unroll 1
        for (int J = 32 * i; J < 32 * i + 32; J += 8) {
            vq_mma(q0, acc, bm); vq_issue(q0, lists, J + 16, g, Vb, lo16); VQ_PIN(q1);
            vq_mma(q1, acc, bm); vq_issue(q1, lists, J + 17, g, Vb, lo16); VQ_PIN(q2);
            vq_mma(q2, acc, bm); vq_issue(q2, lists, J + 18, g, Vb, lo16); VQ_PIN(q3);
            vq_mma(q3, acc, bm); vq_issue(q3, lists, J + 19, g, Vb, lo16); VQ_PIN(q4);
            vq_mma(q4, acc, bm); vq_issue(q4, lists, J + 20, g, Vb, lo16); VQ_PIN(q5);
            vq_mma(q5, acc, bm); vq_issue(q5, lists, J + 21, g, Vb, lo16); VQ_PIN(q6);
            vq_mma(q6, acc, bm); vq_issue(q6, lists, J + 22, g, Vb, lo16); VQ_PIN(q7);
            vq_mma(q7, acc, bm); vq_issue(q7, lists, J + 23, g, Vb, lo16); VQ_PIN(q0);
        }
        const f32x2 tp = tokp[i]; const float sw = tp.x, yoff = tp.y;
        float pre[16]; float s = 0.f;
#pragma unroll
        for (int c = 0; c < 2; ++c)
#pragma unroll
            for (int hf = 0; hf < 2; ++hf)
#pragma unroll
                for (int r = 0; r < 4; ++r) { const int e = 8 * c + 4 * hf + r;
                    const float yv = hf == 0 ? sw * (float)acc[2 * c][r] - yoff : (sw * 0.0625f) * (float)(acc[2 * c + 1][r] - acc[2 * c][r]) + yoff * (1.0f / 15.0f);
                    const float pv = ALPHA * xv[e] + gt2v[e] * yv; pre[e] = pv; s += pv; }
        const float mean = wave_sum_fast(s) * (1.0f / 1024.0f); float s2 = 0.f;
#pragma unroll
        for (int e = 0; e < 16; ++e) { pre[e] -= mean; s2 += pre[e] * pre[e]; }
        const float rstd = rsqrtf(wave_sum_fast(s2) * (1.0f / 1024.0f) + LN_EPS);
#pragma unroll
        for (int c = 0; c < 2; ++c)
#pragma unroll
            for (int hf = 0; hf < 2; ++hf)
#pragma unroll
                for (int r = 0; r < 4; ++r) { const int e = 8 * c + 4 * hf + r;
                    xr[dbase + 512 * c + 32 * r + 4 * hf] = pre[e] * rstd * lgv[e] + lbv[e]; }
    }
}

#define XB_TMO      128
#define XB_XCNT(j)  (256  + 64 * (j))
#define XB_XSUB(j)  (1280 + 64 * (j))
#define XB_XGEN(j)  (2304 + 64 * (j))
#define XB_TOP      3328
#define XB_TOPGEN   3392
#define XCD_BAR_WORDS 3456
#define XB_SPIN_CAP (1u << 22)
__device__ __forceinline__ unsigned xb_ld(unsigned* p)              { return __hip_atomic_load(p, __ATOMIC_RELAXED, __HIP_MEMORY_SCOPE_AGENT); }
__device__ __forceinline__ unsigned xb_add(unsigned* p, unsigned v) { return __hip_atomic_fetch_add(p, v, __ATOMIC_RELAXED, __HIP_MEMORY_SCOPE_AGENT); }
#define XB_SPIN(cond, bar) do { unsigned _sp = 0; while (cond) { __builtin_amdgcn_s_sleep(1); \
    if ((++_sp & 255u) == 0u) { if (xb_ld(&(bar)[XB_TMO])) break; if (_sp > XB_SPIN_CAP) { atomicAdd(&(bar)[XB_TMO], 1u); break; } } } } while (0)
struct XcdBarrier { unsigned* bar; unsigned x; volatile LAS unsigned* st; };
__device__ __forceinline__ XcdBarrier xcd_barrier_post(unsigned* bar, volatile LAS unsigned* st) {
    XcdBarrier b; b.bar = bar; b.x = xcc_id(); b.st = st;
    if (threadIdx.x == 0) (void)xb_add(&bar[XB_XCNT(b.x)], 1u);
    return b;
}
__device__ __forceinline__ void xcd_barrier_complete(unsigned* bar, unsigned x, unsigned& nloc, unsigned& nx) {
    const unsigned G = gridDim.x * gridDim.y * gridDim.z;
    unsigned sum, cnt, mine, sp = 0u;
    for (;;) {
        sum = 0u; cnt = 0u; mine = 0u;
#pragma unroll
        for (unsigned j = 0; j < 16; ++j) { const unsigned c = xb_ld(&bar[XB_XCNT(j)]); sum += c; cnt += (c > 0u) ? 1u : 0u; mine = (j == x) ? c : mine; }
        if (sum == G) break;
        __builtin_amdgcn_s_sleep(1);
        if ((++sp & 255u) == 0u) { if (xb_ld(&bar[XB_TMO])) break; if (sp > XB_SPIN_CAP) { atomicAdd(&bar[XB_TMO], 1u); break; } }
    }
    nloc = mine > 0u ? mine : 1u; nx = cnt > 0u ? cnt : 1u;
}
__device__ __forceinline__ void xcd_barrier(const XcdBarrier& b) {
    asm volatile("s_waitcnt vmcnt(0)" ::: "memory");
    __syncthreads();
    if (threadIdx.x == 0) {
        unsigned* bar = b.bar;
        __builtin_amdgcn_s_waitcnt(0);
        unsigned nloc = b.st[0], nx = b.st[1];
        if (nloc == 0u) { xcd_barrier_complete(bar, b.x, nloc, nx); b.st[0] = nloc; b.st[1] = nx; }
        const unsigned old = xb_add(&bar[XB_XSUB(b.x)], 1u);
        const unsigned gen = old / nloc;
        if (old + 1u == (gen + 1u) * nloc) {
            __builtin_amdgcn_fence(__ATOMIC_RELEASE, "agent");
            asm volatile("s_waitcnt vmcnt(0)" ::: "memory");
            const unsigned og = xb_add(&bar[XB_TOP], 1u);
            const unsigned tg = og / nx;
            if (og + 1u == (tg + 1u) * nx) xb_add(&bar[XB_TOPGEN], 1u);
            else XB_SPIN(xb_ld(&bar[XB_TOPGEN]) == tg, bar);
            __builtin_amdgcn_fence(__ATOMIC_ACQUIRE, "agent");
            xb_add(&bar[XB_XGEN(b.x)], 1u);
            asm volatile("s_waitcnt vmcnt(0)" ::: "memory");
        } else {
            XB_SPIN(xb_ld(&bar[XB_XGEN(b.x)]) == gen, bar);
            __builtin_amdgcn_fence(__ATOMIC_ACQUIRE, "agent");
            asm volatile("s_waitcnt vmcnt(0)" ::: "memory");
        }
    }
    __syncthreads();
}

__global__ void __launch_bounds__(NTHR, 2) fwd_megakernel(Params P) {
    extern __shared__ __attribute__((aligned(16))) unsigned char shm[];
    LAS unsigned char* lds = (LAS unsigned char*)shm;
    cg::grid_group grid = cg::this_grid();
    const int G = gridDim.x, bid = blockIdx.x;
    volatile LAS unsigned* xst = (volatile LAS unsigned*)(lds + LDS_BYTES - 128);
    if (threadIdx.x == 0) { xst[0] = 0u; xst[1] = 0u; }
    __syncthreads();
    if (bid == 0) { unsigned* bw = (unsigned*)(P.ws + OFF_BAR); for (int i = threadIdx.x; i < XCD_BAR_WORDS; i += NTHR) bw[i] = 0u; __threadfence(); }

#ifndef P3
#define P3 0xff
#endif
#ifndef PH
#define PH 0xff
#endif
    if (PH & 1) phase0a(P, lds);
    grid.sync();
    const XcdBarrier xb = xcd_barrier_post((unsigned*)(P.ws + OFF_BAR), xst);
    if (PH & 2) phase0b(P);
    xcd_barrier(xb);
    if (PH & 4) {
        pg8::Gemm g; g.A = (const bf16_t*)(P.ws + OFF_H); g.Bt = (const bf16_t*)(P.ws + OFF_WIN); g.M = NTOK; g.N = INCOLS; { int k_ = 512; asm volatile("" : "+s"(k_)); g.K = k_; g.lda = k_; }
        pg8::StaticOrder S; S.init(NTOK, INCOLS, G, bid);
        EpiProj E; E.ws = P.ws; E.lb = (const float*)(P.ws + OFF_LB); E.ng = P.hgrn_ng; E.kmean = (float*)(P.ws + OFF_KMEAN);
        pg8::gemm_phase<EpiProj, pg8::StaticOrder, true>(lds, g, S, E);
    }
    xcd_barrier(xb);
    if (PH & 8) for (int it = bid; it < 256; it += G) hgrn_item(P, it, lds);
    if (PH & 16) for (int u = bid; u < 2048; u += G) { const int bh = u & 255, jj = u >> 8; moba_unit(P, bh >> 3, bh & 7, (jj + bh) & 7, lds); }
    xcd_barrier(xb);
    if ((PH & 32) && bid < NTOK / 256) { const int pm = bid;
        if (P3 & 1) yb_norm_panel(P, pm);
        __syncthreads();
        if (P3 & 2) { pg8::Gemm g; g.A = (const bf16_t*)(P.ws + OFF_EG); g.Bt = (const bf16_t*)(P.ws + OFF_WBA); g.M = NTOK; g.N = 1024; { int k_ = 512; asm volatile("" : "+s"(k_)); g.K = k_; g.lda = k_; }
          pg8::PanelOrder S; S.pm = pm; S.npn = 4; EpiMixAB E; E.GA = P.ws + OFF_GA; E.GB = P.ws + OFF_GB; E.M8 = P.ws + OFF_QA;
          pg8::gemm_phase<EpiMixAB, pg8::PanelOrder, true>(lds, g, S, E); }
        __syncthreads();
        if (P3 & 8) { pg8::Gemm g; g.A = (const bf16_t*)(P.ws + OFF_QA); g.Bt = (const bf16_t*)(P.ws + OFF_WOUT); g.M = NTOK; g.N = 1024; { int k_ = 512; asm volatile("" : "+s"(k_)); g.K = k_; g.lda = k_; }
          pg8::PanelOrder S; S.pm = pm; S.npn = 4; EpiOut E; E.ada = (const float*)(P.ws + OFF_ADA); E.D = (bf16_t*)(P.ws + OFF_GB);
          pg8::gemm_phase<EpiOut, pg8::PanelOrder, true>(lds, g, S, E); }
        __syncthreads();
        if (P3 & 16) ln1_panel(P, pm);
        __syncthreads();
        if (P3 & 32) { pg8::Gemm g; g.A = (const bf16_t*)(P.ws + OFF_H); g.Bt = (const bf16_t*)(P.ws + OFF_WQ); g.M = NTOK; g.N = 1024; g.K = 1024; g.lda = 1024;
          pg8::PanelOrder S; S.pm = pm; S.npn = 4; EpiBf16 E; E.O = (bf16_t*)(P.ws + OFF_GB);
          pg8::gemm_phase<EpiBf16, pg8::PanelOrder>(lds, g, S, E); }
        __syncthreads();
        { const size_t tok0 = (size_t)pm * 256 + (tid_opaque() >> 6) * 32;
          peer_select_wave(P, tok0);
          __syncthreads();
#pragma unroll 1
          for (int sb = 0; sb < 4; ++sb) {
              peer_u_tokens(P, lds, tok0 + 8 * sb);
              __syncthreads();
              peer_v_tokens(P, lds, tok0 + 8 * sb);
              __syncthreads();
          } }
    }
}

extern "C" void kernel_launch(void* const* d_in, const int* in_sizes, int n_in, void* d_out, int out_size, void* d_ws, size_t ws_size, hipStream_t stream) {
    static int grid_blocks = 0;
    if (grid_blocks == 0) {
        if (n_in != 18 || out_size != NTOK * DM || ws_size < WS_END) { fprintf(stderr, "kernel_launch: unexpected shapes (n_in %d, out %d, ws %zu, need %zu)\n", n_in, out_size, ws_size, (size_t)WS_END); grid_blocks = -1; return; }
        int dev = 0, cus = 0, per_cu = 0;
        hipGetDevice(&dev);
        hipDeviceGetAttribute(&cus, hipDeviceAttributeMultiprocessorCount, dev);
        if (hipFuncSetAttribute((const void*)fwd_megakernel, hipFuncAttributeMaxDynamicSharedMemorySize, LDS_BYTES) != hipSuccess) fprintf(stderr, "kernel_launch: hipFuncSetAttribute failed\n");
        hipOccupancyMaxActiveBlocksPerMultiprocessor(&per_cu, (const void*)fwd_megakernel, NTHR, LDS_BYTES);
        if (per_cu < 1) { fprintf(stderr, "kernel_launch: occupancy query says %d blocks per CU\n", per_cu); per_cu = 1; }
        if (per_cu > 1) per_cu = 1;
        grid_blocks = cus * per_cu;
        if (grid_blocks != NTOK / 256) { fprintf(stderr, "kernel_launch: built for a %d-CU device (one 256-token panel per workgroup), found %d\n", NTOK / 256, grid_blocks); grid_blocks = -1; return; }
        (void)hipGetLastError();
    }
    if (grid_blocks < 0) return;
    Params p{};
    p.x = (const float*)d_in[0]; p.c = (const float*)d_in[1]; p.w_ada = (const float*)d_in[2]; p.b_ada = (const float*)d_in[3]; p.w_in = (const float*)d_in[4];
    p.w_ba = (const float*)d_in[5]; p.w_bb = (const float*)d_in[6]; p.w_out = (const float*)d_in[7]; p.hgrn_lb = (const float*)d_in[8]; p.hgrn_ng = (const float*)d_in[9];
    p.ln1_g = (const float*)d_in[10]; p.ln1_b = (const float*)d_in[11]; p.peer_wq = (const float*)d_in[12]; p.peer_sk = (const float*)d_in[13]; p.peer_u = (const float*)d_in[14];
    p.peer_v = (const float*)d_in[15]; p.ln2_g = (const float*)d_in[16]; p.ln2_b = (const float*)d_in[17];
    p.out = (float*)d_out; p.ws = (unsigned char*)d_ws;
    void* args[] = {&p};
    hipError_t e = hipLaunchCooperativeKernel((const void*)fwd_megakernel, dim3(grid_blocks), dim3(NTHR), args, LDS_BYTES, stream);
    if (e != hipSuccess) fprintf(stderr, "cooperative launch failed: %s (grid %d)\n", hipGetErrorString(e), grid_blocks);
}
```
